# Optimizing an MI355X kernel written in HIP

```python
import jax, jax.numpy as jnp
from jax import lax
import numpy as np

D_MODEL = 2048
BATCH = 8
SEQ = 2048
DEPTH = 2
DEC_BATCH = 128
DEC_SEQ = 4
PAST_LEN = 8192
PAGE_SIZE = 128

D_MIX = D_MODEL
HEAD_DIM = 64
D_ATT = D_MIX // 2
N_HEADS = D_ATT // HEAD_DIM
N_KV_HEADS = 4
GROUP = N_HEADS // N_KV_HEADS
D_KV = N_KV_HEADS * HEAD_DIM
WINDOW = 128
ROPE_THETA = 10000.0
D_POOL = D_MIX // 4
POOL_WINDOWS = (2, 4, 8, 16)
N_POOL_GROUPS = len(POOL_WINDOWS)
POOL_GROUP_DIM = D_POOL // N_POOL_GROUPS
POOL_HIST = max(POOL_WINDOWS) - 1
D_SGU = D_MIX - D_ATT - D_POOL
CHUNK = 128
N_SGU_HEADS = 4
SGU_HEAD_DIM = D_SGU // N_SGU_HEADS
SPLIT_SIZES = (D_ATT, D_KV, D_KV, D_ATT, D_POOL, D_POOL, D_SGU, D_SGU, D_SGU)
D_IN = sum(SPLIT_SIZES)
EPS = 1e-6

kernel_name = "hymba_swa_pool_sgu_step"


def _rmsnorm(x, g):
    xf = x.astype(jnp.float32)
    xf = xf * lax.rsqrt(jnp.mean(xf * xf, axis=-1, keepdims=True) + EPS)
    return (xf * g.astype(jnp.float32)).astype(x.dtype)


def _layernorm(x, g, b):
    xf = x.astype(jnp.float32)
    mu = jnp.mean(xf, axis=-1, keepdims=True)
    var = jnp.mean(jnp.square(xf - mu), axis=-1, keepdims=True)
    y = (xf - mu) * lax.rsqrt(var + EPS) * g.astype(jnp.float32) + b.astype(jnp.float32)
    return y.astype(x.dtype)


def _rope(x, pos):
    half = HEAD_DIM // 2
    inv = ROPE_THETA ** (-jnp.arange(0, HEAD_DIM, 2, dtype=jnp.float32) / HEAD_DIM)
    ang = pos.astype(jnp.float32)[:, None] * inv[None, :]
    cos = jnp.cos(ang)[:, None, :]
    sin = jnp.sin(ang)[:, None, :]
    xf = x.astype(jnp.float32)
    x1, x2 = xf[..., :half], xf[..., half:]
    return jnp.concatenate([x1 * cos - x2 * sin, x2 * cos + x1 * sin], axis=-1).astype(x.dtype)


def _project(x, pre_g, w_in, pos):
    h = _rmsnorm(x, pre_g)
    z = h @ w_in
    offs = np.cumsum(SPLIT_SIZES)[:-1].tolist()
    q, k, v, g_att, xb, g_pool, u, vs, g_sgu = jnp.split(z, offs, axis=-1)
    B, S = x.shape[:2]
    q = _rope(q.reshape(B, S, N_HEADS, HEAD_DIM), pos)
    k = _rope(k.reshape(B, S, N_KV_HEADS, HEAD_DIM), pos)
    v = v.reshape(B, S, N_KV_HEADS, HEAD_DIM)
    return q, k, v, g_att, xb, g_pool, u, vs, g_sgu


def _sink_attend(q, k, v, mask, sinks):
    s = jnp.einsum('...qkgd,...skd->...kgqs', q, k,
                   preferred_element_type=jnp.float32) * (HEAD_DIM ** -0.5)
    s = jnp.where(mask, s, -jnp.inf)
    sink = sinks.astype(jnp.float32).reshape(N_KV_HEADS, GROUP, 1, 1)
    m = jnp.maximum(jnp.max(s, axis=-1, keepdims=True), sink)
    p = jnp.exp(s - m)
    p = p / (jnp.sum(p, axis=-1, keepdims=True) + jnp.exp(sink - m))
    return jnp.einsum('...kgqs,...skd->...qkgd', p.astype(v.dtype), v)


def _window_attn_prompt(q, k, v, sinks):
    B, S = q.shape[:2]
    nb = S // WINDOW
    qb = q.reshape(B, nb, WINDOW, N_KV_HEADS, GROUP, HEAD_DIM)
    kb = k.reshape(B, nb, WINDOW, N_KV_HEADS, HEAD_DIM)
    vb = v.reshape(B, nb, WINDOW, N_KV_HEADS, HEAD_DIM)
    pad = ((0, 0), (1, 0), (0, 0), (0, 0), (0, 0))
    kk = jnp.concatenate([jnp.pad(kb[:, :-1], pad), kb], axis=2)
    vv = jnp.concatenate([jnp.pad(vb[:, :-1], pad), vb], axis=2)
    i = jnp.arange(WINDOW)[:, None]
    j = jnp.arange(2 * WINDOW)[None, :]
    diff = i + WINDOW - j
    band = (diff >= 0) & (diff < WINDOW)
    mask = band[None] & ((jnp.arange(nb)[:, None, None] > 0) | (j[None] >= WINDOW))
    out = _sink_attend(qb, kk, vv, mask[:, None, None], sinks)
    return out.reshape(B, S, D_ATT)


def _window_attn_sample(q, k_new, v_new, k_hist, v_hist, sinks):
    Bd, T = q.shape[:2]
    Lb = k_hist.shape[1]
    k_all = jnp.concatenate([k_hist, k_new], axis=1)
    v_all = jnp.concatenate([v_hist, v_new], axis=1)
    qpos = PAST_LEN + jnp.arange(T)
    kpos = PAST_LEN - Lb + jnp.arange(Lb + T)
    d = qpos[:, None] - kpos[None, :]
    mask = (d >= 0) & (d < WINDOW)
    out = _sink_attend(q.reshape(Bd, T, N_KV_HEADS, GROUP, HEAD_DIM), k_all, v_all, mask, sinks)
    return out.reshape(Bd, T, D_ATT), k_all[:, T:], v_all[:, T:]


def _pool_mix(xb_ext, start, pool_w, pool_scale):
    B = xb_ext.shape[0]
    n = xb_ext.shape[1] - POOL_HIST
    xf = xb_ext.astype(jnp.float32)
    cs = jnp.pad(jnp.cumsum(xf, axis=1), ((0, 0), (1, 0), (0, 0)))
    hi = cs[:, POOL_HIST + 1:]
    pos = start + jnp.arange(n)
    outs = []
    for g, w in enumerate(POOL_WINDOWS):
        sl = slice(g * POOL_GROUP_DIM, (g + 1) * POOL_GROUP_DIM)
        lo = cs[:, POOL_HIST + 1 - w:POOL_HIST + 1 - w + n, sl]
        cnt = jnp.minimum(w, pos + 1).astype(jnp.float32)[:, None]
        outs.append((hi[..., sl] - lo) / cnt - xf[:, POOL_HIST:, sl])
    pooled = jnp.stack(outs, axis=2).astype(pool_w.dtype)
    mixed = jnp.einsum('bngc,gcd->bngd', pooled, pool_w)
    return mixed.reshape(B, n, D_POOL) * pool_scale


def _sgu(u, v, ln_g, ln_b, w_s, b_s, L):
    B, S = u.shape[:2]
    vn = _layernorm(v, ln_g, ln_b)
    vc = vn.reshape(B, S // L, L, N_SGU_HEADS, SGU_HEAD_DIM)
    tri = jnp.tril(jnp.ones((L, L), dtype=bool))
    wm = jnp.where(tri, w_s[:, :L, :L], 0)
    mixed = jnp.einsum('hts,bnshd->bnthd', wm, vc) + b_s[:, :L].T[:, :, None]
    out = u.reshape(B, S // L, L, N_SGU_HEADS, SGU_HEAD_DIM) * mixed
    return out.reshape(B, S, D_SGU), vn


def _finish(x, o_att, g_att, o_pool, g_pool, o_sgu, g_sgu, w_out, post_g):
    y = jnp.concatenate([o_att * jax.nn.silu(g_att),
                         o_pool * jax.nn.silu(g_pool),
                         o_sgu * jax.nn.silu(g_sgu)], axis=-1) @ w_out
    return x + _rmsnorm(y, post_g)


def setup_inputs(seed: int = 0) -> dict:
    key = jax.random.key(seed)
    ks = jax.random.split(key, 16)
    nrm = jax.random.normal
    win = min(WINDOW, PAST_LEN)
    return {
        "x_prompt": nrm(ks[0], (BATCH, SEQ, D_MODEL), jnp.float32),
        "x_sample": nrm(ks[1], (DEC_BATCH, DEC_SEQ, D_MODEL), jnp.float32),
        "cache_k": nrm(ks[2], (DEPTH, DEC_BATCH, win, N_KV_HEADS, HEAD_DIM), jnp.float32),
        "cache_v": nrm(ks[3], (DEPTH, DEC_BATCH, win, N_KV_HEADS, HEAD_DIM), jnp.float32),
        "state_pool": nrm(ks[4], (DEPTH, DEC_BATCH, POOL_HIST, D_POOL), jnp.float32),
        "w_in": nrm(ks[5], (DEPTH, D_MODEL, D_IN), jnp.float32) * D_MODEL ** -0.5,
        "w_out": nrm(ks[6], (DEPTH, D_MIX, D_MODEL), jnp.float32) * D_MIX ** -0.5,
        "norm_pre": 1.0 + 0.1 * nrm(ks[7], (DEPTH, D_MODEL), jnp.float32),
        "norm_post": 1.0 + 0.1 * nrm(ks[8], (DEPTH, D_MODEL), jnp.float32),
        "attn_sinks": 0.5 * nrm(ks[9], (DEPTH, N_HEADS), jnp.float32),
        "pool_w": nrm(ks[10], (DEPTH, N_POOL_GROUPS, POOL_GROUP_DIM, POOL_GROUP_DIM), jnp.float32) * POOL_GROUP_DIM ** -0.5,
        "pool_scale": 1.0 + 0.1 * nrm(ks[11], (DEPTH, D_POOL), jnp.float32),
        "sgu_ln_g": 1.0 + 0.1 * nrm(ks[12], (DEPTH, D_SGU), jnp.float32),
        "sgu_ln_b": 0.02 * nrm(ks[13], (DEPTH, D_SGU), jnp.float32),
        "sgu_w": nrm(ks[14], (DEPTH, N_SGU_HEADS, CHUNK, CHUNK), jnp.float32) * CHUNK ** -0.5,
        "sgu_b": 1.0 + 0.1 * nrm(ks[15], (DEPTH, N_SGU_HEADS, CHUNK), jnp.float32),
    }


def reference(x_prompt, x_sample, cache_k, cache_v, state_pool, w_in, w_out, norm_pre,
              norm_post, attn_sinks, pool_w, pool_scale, sgu_ln_g, sgu_ln_b, sgu_w, sgu_b):
    pos_p = jnp.arange(SEQ)
    pos_s = PAST_LEN + jnp.arange(DEC_SEQ)
    xp, xs = x_prompt, x_sample
    nk_p, nv_p, npool_p = [], [], []
    nk_s, nv_s, npool_s, nchunk_s = [], [], [], []
    for l in range(DEPTH):
        q, k, v, g_att, xb, g_pool, u, vs, g_sgu = _project(xp, norm_pre[l], w_in[l], pos_p)
        o_att = _window_attn_prompt(q, k, v, attn_sinks[l])
        xb_ext = jnp.pad(xb, ((0, 0), (POOL_HIST, 0), (0, 0)))
        o_pool = _pool_mix(xb_ext, 0, pool_w[l], pool_scale[l])
        o_sgu, _ = _sgu(u, vs, sgu_ln_g[l], sgu_ln_b[l], sgu_w[l], sgu_b[l], CHUNK)
        xp_next = _finish(xp, o_att, g_att, o_pool, g_pool, o_sgu, g_sgu, w_out[l], norm_post[l])
        nk_p.append(k[:, -WINDOW:])
        nv_p.append(v[:, -WINDOW:])
        npool_p.append(xb[:, -POOL_HIST:])
        xp = xp_next

        q, k, v, g_att, xb, g_pool, u, vs, g_sgu = _project(xs, norm_pre[l], w_in[l], pos_s)
        o_att, k_buf, v_buf = _window_attn_sample(q, k, v, cache_k[l], cache_v[l], attn_sinks[l])
        xb_ext = jnp.concatenate([state_pool[l].astype(xb.dtype), xb], axis=1)
        o_pool = _pool_mix(xb_ext, PAST_LEN, pool_w[l], pool_scale[l])
        o_sgu, vn = _sgu(u, vs, sgu_ln_g[l], sgu_ln_b[l], sgu_w[l], sgu_b[l], DEC_SEQ)
        xs = _finish(xs, o_att, g_att, o_pool, g_pool, o_sgu, g_sgu, w_out[l], norm_post[l])
        nk_s.append(k_buf)
        nv_s.append(v_buf)
        npool_s.append(xb_ext[:, -POOL_HIST:])
        nchunk_s.append(vn)

    return (xp, xs,
            jnp.stack(nk_p), jnp.stack(nv_p), jnp.stack(npool_p),
            jnp.stack(nk_s), jnp.stack(nv_s), jnp.stack(npool_s), jnp.stack(nchunk_s))
```

```cpp
#include <hip/hip_runtime.h>
#include <cstdio>
#include <cstdint>
#include <cmath>
namespace pg8 {
#define PG8_LAS __attribute__((address_space(3)))
typedef unsigned short bf16_t;
typedef short bf16x8 __attribute__((ext_vector_type(8)));
typedef float f32x4 __attribute__((ext_vector_type(4)));
typedef unsigned u32x4 __attribute__((ext_vector_type(4)));
constexpr int BM = 256, BK = 64, HALF = 128, HTB = HALF * BK * 2  , STAGE_BYTES = 8 * HTB, NXCD = 8, WGM = 8;

__host__ __device__ __forceinline__ int lds_byte(int r, int c) { const int st = (r >> 4) * 2 + (c >> 5), rr = r & 15, cc = c & 31, ob = rr * 64 + cc * 2; return st * 1024 + (ob ^ (((ob >> 9) & 1) << 5)); }
__host__ __device__ __forceinline__ void stage_rc(int b, int& R, int& C) { const int st = b / 1024, sb = b % 1024, swz = sb ^ (((sb >> 9) & 1) << 5); R = (st >> 1) * 16 + swz / 64; C = (st & 1) * 32 + (swz % 64) / 2; }
__host__ __device__ __forceinline__ int perm32(int rho) { const int n = rho >> 4, i = rho & 15; return 8 * (i >> 2) + 4 * n + (i & 3); }

struct Unit { int pm, pn; };
struct Gemm { const bf16_t* A; const bf16_t* Bt; int M, N, K; };

struct StaticOrder {
    int nM, nN, nwg, G, c;
    __host__ __device__ void init(int M, int N, int G_, int c_) { nM = M / BM; nN = N / BM; nwg = nM * nN; G = G_; c = c_; }
    __host__ __device__ bool next(int i, Unit& u) const {
        const long L = (long)i * G + c; if (L >= nwg) return false;
        int wgid = (int)L; { const int q = nwg / NXCD, r = nwg % NXCD, xcd = wgid % NXCD, off = wgid / NXCD; wgid = (xcd < r ? xcd * (q + 1) : r * (q + 1) + (xcd - r) * q) + off; }
        const int nig = WGM * nN, gid = wgid / nig, fm = gid * WGM, gsz = (nM - fm) < WGM ? (nM - fm) : WGM;
        u.pm = fm + ((wgid % nig) % gsz); u.pn = (wgid % nig) / gsz; return true;
    }
    __device__ __forceinline__ void a_ready(const Unit&) const {}
    __device__ __forceinline__ void done(const Unit&) const {}
};

constexpr int DM = 2048, MP = 16384, MS = 512, MT = MP + MS, DIN = 5120;
constexpr int ZW = 3584;
constexpr int Z_GA = 0, Z_XB = 1024, Z_GP = 1536, Z_U = 2048, Z_VS = 2560, Z_GS = 3072;
constexpr float LOG2E = 1.4426950408889634f, QSCALE = 0.125f * LOG2E, EPS = 1e-6f;

__device__ __forceinline__ unsigned cvt_pk_bf16(float lo, float hi) { unsigned r; asm("v_cvt_pk_bf16_f32 %0, %1, %2" : "=v"(r) : "v"(lo), "v"(hi)); return r; }
__device__ __forceinline__ float silu_f(float x) { return x * __builtin_amdgcn_rcpf(1.0f + __builtin_amdgcn_exp2f(-x * LOG2E)); }
__device__ __forceinline__ int vperm32(int x) { return ((x >> 2) & 1) * 16 + (x >> 3) * 4 + (x & 3); }

struct EpiPtrs { const __attribute__((address_space(1))) float* in[16]; __attribute__((address_space(1))) float* out; __attribute__((address_space(1))) unsigned char* ws; };
constexpr size_t EP_ROPE = (size_t)1 << 20, EP_QC = (size_t)192 << 20, EP_KC = (size_t)225 << 20, EP_VTP = (size_t)233 << 20, EP_Z2 = (size_t)241 << 20, EP_Y = (size_t)357 << 20;
constexpr size_t EO_KP = 34603008, EO_VP = 35127296, EO_PP = 35651584, EO_KS = 35774464, EO_VS = 44163072, EO_PS = 52551680;
struct EpiIn {
    static constexpr bool PERM = true, AFTER_DRAIN = false;
    int l;
    __device__ __forceinline__ void operator()(const f32x4 (&acc)[2][2][4][2], const Unit& u, int wr, int wc, int fr, int fq) const {
        const __attribute__((address_space(4))) EpiPtrs* kp = (const __attribute__((address_space(4))) EpiPtrs*)__builtin_amdgcn_kernarg_segment_ptr(); asm volatile("" : "+s"(kp));
        unsigned char* ws = (unsigned char*)kp->ws; float* outp = (float*)kp->out;
        bf16_t* Qc = (bf16_t*)(ws + EP_QC); bf16_t* Kc = (bf16_t*)(ws + EP_KC); bf16_t* VTP = (bf16_t*)(ws + EP_VTP); bf16_t* Z2 = (bf16_t*)(ws + EP_Z2); const float* rope = (const float*)(ws + EP_ROPE);
        float* oKp = outp + EO_KP + (size_t)l * 262144; float* oVp = outp + EO_VP + (size_t)l * 262144; float* oPp = outp + EO_PP + (size_t)l * 61440;
        float* oKs = outp + EO_KS + (size_t)l * 4194304; float* oVs = outp + EO_VS + (size_t)l * 4194304; float* oPs = outp + EO_PS + (size_t)l * 983040;
        const int pn = u.pn;
        const int row0 = u.pm * 256 + wr * 64 + fr;
        const int cw = wc * 32 + 8 * fq;
        if (pn < 5) {
#pragma unroll
            for (int ai = 0; ai < 2; ++ai)
#pragma unroll
                for (int m = 0; m < 4; ++m) {
                    const int row = row0 + ai * 128 + m * 16;
                    const bool smp = row >= MP;
                    const int tpos = smp ? 2048 + (row & 3) : (row & 2047);
                    const float* rp = rope + tpos * 64;
#pragma unroll
                    for (int bj = 0; bj < 2; ++bj) {
                        const int c = pn * 256 + bj * 128 + cw;
                        const int i0 = (c & 63) >> 1;
                        const f32x4 cs = *(const f32x4*)(rp + i0), sn = *(const f32x4*)(rp + 32 + i0);
                        const f32x4 v0 = acc[ai][bj][m][0], v1 = acc[ai][bj][m][1];
                        f32x4 o1, o2;
                        o1[0] = v0[0] * cs[0] - v0[1] * sn[0]; o2[0] = v0[1] * cs[0] + v0[0] * sn[0];
                        o1[1] = v0[2] * cs[1] - v0[3] * sn[1]; o2[1] = v0[3] * cs[1] + v0[2] * sn[1];
                        o1[2] = v1[0] * cs[2] - v1[1] * sn[2]; o2[2] = v1[1] * cs[2] + v1[0] * sn[2];
                        o1[3] = v1[2] * cs[3] - v1[3] * sn[3]; o2[3] = v1[3] * cs[3] + v1[2] * sn[3];
                        if (pn < 4) {
                            o1 = o1 * QSCALE; o2 = o2 * QSCALE;
                            u32x4 w; w.x = cvt_pk_bf16(o1[0], o2[0]); w.y = cvt_pk_bf16(o1[1], o2[1]); w.z = cvt_pk_bf16(o1[2], o2[2]); w.w = cvt_pk_bf16(o1[3], o2[3]);
                            *(u32x4*)(Qc + (size_t)row * 1024 + c) = w;
                        } else {
                            const int kvh = (c - 1024) >> 6;
                            if (!smp) {
                                const int b = row >> 11, t = row & 2047;
                                u32x4 w; w.x = cvt_pk_bf16(o1[0], o2[0]); w.y = cvt_pk_bf16(o1[1], o2[1]); w.z = cvt_pk_bf16(o1[2], o2[2]); w.w = cvt_pk_bf16(o1[3], o2[3]);
                                *(u32x4*)(Kc + ((size_t)((b * 4 + kvh) * 2048 + t)) * 64 + (c & 63)) = w;
                                if (t >= 1920) { float* o = oKp + ((size_t)((b * 128 + t - 1920) * 4 + kvh)) * 64 + i0; *(f32x4*)o = o1; *(f32x4*)(o + 32) = o2; }
                            } else {
                                const int bd = (row - MP) >> 2, tt = row & 3;
                                float* o = oKs + ((size_t)((bd * 128 + 124 + tt) * 4 + kvh)) * 64 + i0; *(f32x4*)o = o1; *(f32x4*)(o + 32) = o2;
                            }
                        }
                    }
                }
        } else if (pn == 5) {
#pragma unroll
            for (int ai = 0; ai < 2; ++ai)
#pragma unroll
                for (int m = 0; m < 4; ++m) {
                    const int row = row0 + ai * 128 + m * 16;
                    const bool smp = row >= MP;
#pragma unroll
                    for (int bj = 0; bj < 2; ++bj) {
                        const int cv = bj * 128 + cw;
                        const int kvh = cv >> 6, d0 = cv & 63;
                        const f32x4 v0 = acc[ai][bj][m][0], v1 = acc[ai][bj][m][1];
                        if (!smp) {
                            const int b = row >> 11, t = row & 2047;
                            bf16_t* vp = VTP + ((size_t)((b * 4 + kvh) * 64 + (t >> 5))) * 2048 + d0 * 32 + vperm32(t & 31);
                            const unsigned w0 = cvt_pk_bf16(v0[0], v0[1]), w1 = cvt_pk_bf16(v0[2], v0[3]), w2 = cvt_pk_bf16(v1[0], v1[1]), w3 = cvt_pk_bf16(v1[2], v1[3]);
                            vp[0] = (bf16_t)(w0 & 0xffffu); vp[32] = (bf16_t)(w0 >> 16); vp[64] = (bf16_t)(w1 & 0xffffu); vp[96] = (bf16_t)(w1 >> 16);
                            vp[128] = (bf16_t)(w2 & 0xffffu); vp[160] = (bf16_t)(w2 >> 16); vp[192] = (bf16_t)(w3 & 0xffffu); vp[224] = (bf16_t)(w3 >> 16);
                            if (t >= 1920) { float* o = oVp + ((size_t)((b * 128 + t - 1920) * 4 + kvh)) * 64 + d0; *(f32x4*)o = v0; *(f32x4*)(o + 4) = v1; }
                        } else {
                            const int bd = (row - MP) >> 2, tt = row & 3;
                            float* o = oVs + ((size_t)((bd * 128 + 124 + tt) * 4 + kvh)) * 64 + d0; *(f32x4*)o = v0; *(f32x4*)(o + 4) = v1;
                        }
                    }
                }
        } else {
            const bool gate = (pn < 10) || (pn == 12) || (pn == 13) || (pn >= 18);
            const bool isxb = (pn == 10) || (pn == 11);
#pragma unroll
            for (int ai = 0; ai < 2; ++ai)
#pragma unroll
                for (int m = 0; m < 4; ++m) {
                    const int row = row0 + ai * 128 + m * 16;
                    const bool smp = row >= MP;
#pragma unroll
                    for (int bj = 0; bj < 2; ++bj) {
                        const int c = pn * 256 + bj * 128 + cw;
                        f32x4 v0 = acc[ai][bj][m][0], v1 = acc[ai][bj][m][1];
                        if (isxb) {
                            const int cx = c - 2560;
                            if (!smp) { const int t = row & 2047; if (t >= 2033) { const int b = row >> 11; float* o = oPp + ((size_t)(b * 15 + t - 2033)) * 512 + cx; *(f32x4*)o = v0; *(f32x4*)(o + 4) = v1; } }
                            else { const int bd = (row - MP) >> 2, tt = row & 3; float* o = oPs + ((size_t)(bd * 15 + 11 + tt)) * 512 + cx; *(f32x4*)o = v0; *(f32x4*)(o + 4) = v1; }
                        }
                        if (gate) {
#pragma unroll
                            for (int j = 0; j < 4; ++j) { v0[j] = silu_f(v0[j]); v1[j] = silu_f(v1[j]); }
                        }
                        u32x4 w; w.x = cvt_pk_bf16(v0[0], v0[1]); w.y = cvt_pk_bf16(v0[2], v0[3]); w.z = cvt_pk_bf16(v1[0], v1[1]); w.w = cvt_pk_bf16(v1[2], v1[3]);
                        *(u32x4*)(Z2 + (size_t)row * ZW + (c - 1536)) = w;
                    }
                }
        }
    }
};

struct EpiOut {
    static constexpr bool PERM = false, AFTER_DRAIN = false;
    __device__ __forceinline__ void operator()(const f32x4 (&acc)[2][2][4][2], const Unit& u, int wr, int wc, int fr, int fq) const {
        const __attribute__((address_space(4))) EpiPtrs* kp = (const __attribute__((address_space(4))) EpiPtrs*)__builtin_amdgcn_kernarg_segment_ptr(); asm volatile("" : "+s"(kp));
        float* C = (float*)((unsigned char*)kp->ws + EP_Y); constexpr int ldc = DM;
        const int row0 = u.pm * BM + wr * 64 + fr, col0 = u.pn * BM + wc * 32 + 4 * fq;
#pragma unroll
        for (int ai = 0; ai < 2; ++ai)
#pragma unroll
            for (int m = 0; m < 4; ++m) { float* rowp = C + (size_t)(row0 + ai * HALF + m * 16) * ldc + col0;
#pragma unroll
                for (int bj = 0; bj < 2; ++bj)
#pragma unroll
                    for (int n = 0; n < 2; ++n) *(f32x4*)(rowp + bj * HALF + n * 16) = acc[ai][bj][m][n]; }
    }
};
template <class Epi, class Sched, bool ALIGN_EPI = false, bool SP2 = false>
__device__ __forceinline__ void gemm_phase(PG8_LAS unsigned char* lds, const Gemm g, const Sched& S, const Epi& E) {
    int tid_ = threadIdx.x; asm volatile("" : "+v"(tid_));
    const int tid = tid_, wid = __builtin_amdgcn_readfirstlane(tid >> 6), lane = tid & 63, wr = wid >> 2, wc = wid & 3, fr = lane & 15, fq = lane >> 4;
    const int K = g.K, nt = K / BK;
    unsigned voffA[2], voffB[2];
#pragma unroll
    for (int i = 0; i < 2; ++i) { int R, C; stage_rc(tid * 16 + i * 8192, R, C); const int Rb = Epi::PERM ? ((R & ~31) + perm32(R & 31)) : R;
        voffA[i] = (unsigned)(R * K + C) * 2u; voffB[i] = (unsigned)(Rb * K + C) * 2u; }
    const size_t kstep = (size_t)(BK * 2);
    const size_t hstep = (size_t)HALF * K * 2;
    const size_t tstep = 2 * hstep;
    const unsigned ldsw = (unsigned)wid * 1024u;
    const int aoff = lds_byte(wr * 64 + fr, fq * 8), boff = lds_byte(wc * 32 + fr, fq * 8);
#define PG8_SA(b, h) (((b) * 2 + (h)) * HTB)
#define PG8_SB(b, h) ((4 + (b) * 2 + (h)) * HTB)
#define PG8_STAGE(bufoff, gbase, voff) do { _Pragma("unroll") for (int _i = 0; _i < 2; ++_i) \
        __builtin_amdgcn_global_load_lds((const unsigned*)((const char*)(gbase) + (voff)[_i]), (PG8_LAS unsigned*)(lds + (bufoff) + ldsw + _i * 8192), 16, 0, 0); } while (0)
#define PG8_LDA(dst, b, h) do { _Pragma("unroll") for (int m = 0; m < 4; ++m) _Pragma("unroll") for (int k = 0; k < 2; ++k) dst[m][k] = *(const PG8_LAS bf16x8*)(lds + PG8_SA(b, h) + aoff + m * 2048 + k * 1024); } while (0)
#define PG8_LDB(dst, b, h) do { _Pragma("unroll") for (int n = 0; n < 2; ++n) _Pragma("unroll") for (int k = 0; k < 2; ++k) dst[n][k] = *(const PG8_LAS bf16x8*)(lds + PG8_SB(b, h) + boff + n * 2048 + k * 1024); } while (0)
#define PG8_MMA(ai, bj, At, Bt) do { __builtin_amdgcn_s_setprio(1); _Pragma("unroll") for (int m = 0; m < 4; ++m) _Pragma("unroll") for (int n = 0; n < 2; ++n) _Pragma("unroll") for (int k = 0; k < 2; ++k) \
        acc[ai][bj][m][n] = __builtin_amdgcn_mfma_f32_16x16x32_bf16(Bt[n][k], At[m][k], acc[ai][bj][m][n], 0, 0, 0); __builtin_amdgcn_s_setprio(0); } while (0)
#define PG8_WAIT_V(n) asm volatile("s_waitcnt vmcnt(" #n ")" ::: "memory")
#define PG8_WAIT_L(n) asm volatile("s_waitcnt lgkmcnt(" #n ")" ::: "memory")
#define PG8_BAR __builtin_amdgcn_s_barrier()
#define PG8_SCHED __builtin_amdgcn_sched_barrier(0)
    Unit cur, nxt; int ui = 0;
    if (!S.next(0, cur)) return;
    f32x4 acc[2][2][4][2];
#pragma unroll
    for (int a = 0; a < 2; ++a)
#pragma unroll
        for (int b = 0; b < 2; ++b)
#pragma unroll
            for (int m = 0; m < 4; ++m)
#pragma unroll
                for (int n = 0; n < 2; ++n) acc[a][b][m][n] = (f32x4){0.f, 0.f, 0.f, 0.f};
    bf16x8 At[4][2], B0[2][2], B1[2][2];
    const char* cA = (const char*)g.A + (size_t)cur.pm * tstep; const char* cB = (const char*)g.Bt + (size_t)cur.pn * tstep;
    S.a_ready(cur);
    if constexpr (SP2) {
        PG8_STAGE(PG8_SB(0, 0), cB, voffB); PG8_STAGE(PG8_SB(0, 1), cB + hstep, voffB); PG8_STAGE(PG8_SA(0, 0), cA, voffA); PG8_STAGE(PG8_SA(0, 1), cA + hstep, voffA);
        if (wr == 1) PG8_BAR;
        PG8_WAIT_V(2); PG8_BAR;
        PG8_STAGE(PG8_SB(1, 0), cB + kstep, voffB); PG8_STAGE(PG8_SA(1, 0), cA + kstep, voffA); PG8_STAGE(PG8_SB(1, 1), cB + hstep + kstep, voffB);
        PG8_WAIT_V(6); PG8_BAR;
    } else {
        PG8_STAGE(PG8_SB(0, 0), cB, voffB); PG8_STAGE(PG8_SA(0, 0), cA, voffA); PG8_STAGE(PG8_SB(0, 1), cB + hstep, voffB); PG8_STAGE(PG8_SA(0, 1), cA + hstep, voffA);
        if (wr == 1) PG8_BAR;
        PG8_WAIT_V(4); PG8_BAR;
        PG8_STAGE(PG8_SB(1, 0), cB + kstep, voffB); PG8_STAGE(PG8_SA(1, 0), cA + kstep, voffA); PG8_STAGE(PG8_SB(1, 1), cB + hstep + kstep, voffB);
        PG8_WAIT_V(6); PG8_BAR;
    }
    for (;;) {
        const bool has_next = S.next(ui + 1, nxt);
        const char* nA = has_next ? (const char*)g.A + (size_t)nxt.pm * tstep : cA; const char* nB = has_next ? (const char*)g.Bt + (size_t)nxt.pn * tstep : cB;
        for (int t = 0; t < nt; t += 2) {
            const bool last = (t == nt - 2);
            const char* a1 = cA + (size_t)(t + 1) * kstep;
            const char* a2 = last ? nA : cA + (size_t)(t + 2) * kstep; const char* b2 = last ? nB : cB + (size_t)(t + 2) * kstep;
            const char* a3 = a2 + kstep; const char* b3 = b2 + kstep;
            if (last && has_next) S.a_ready(nxt);
            if constexpr (SP2) {
            PG8_LDB(B0, 0, 0); PG8_LDB(B1, 0, 1); PG8_SCHED; PG8_LDA(At, 0, 0); PG8_STAGE(PG8_SA(1, 1), a1 + hstep, voffA);
            PG8_WAIT_V(8); PG8_WAIT_L(0); PG8_BAR; PG8_MMA(0, 0, At, B0); PG8_MMA(0, 1, At, B1); PG8_BAR; PG8_SCHED;
            PG8_LDA(At, 0, 1); PG8_STAGE(PG8_SB(0, 0), b2, voffB); PG8_STAGE(PG8_SB(0, 1), b2 + hstep, voffB); PG8_STAGE(PG8_SA(0, 0), a2, voffA);
            PG8_WAIT_V(8); PG8_WAIT_L(0); PG8_BAR; PG8_MMA(1, 0, At, B0); PG8_MMA(1, 1, At, B1); PG8_BAR; PG8_SCHED;
            PG8_LDB(B0, 1, 0); PG8_LDB(B1, 1, 1); PG8_SCHED; PG8_LDA(At, 1, 0); PG8_STAGE(PG8_SA(0, 1), a2 + hstep, voffA);
            PG8_WAIT_V(8); PG8_WAIT_L(0); PG8_BAR; PG8_MMA(0, 0, At, B0); PG8_MMA(0, 1, At, B1); PG8_BAR; PG8_SCHED;
            PG8_LDA(At, 1, 1); PG8_STAGE(PG8_SB(1, 0), b3, voffB); PG8_STAGE(PG8_SB(1, 1), b3 + hstep, voffB); PG8_STAGE(PG8_SA(1, 0), a3, voffA);
            PG8_WAIT_V(8); PG8_WAIT_L(0); PG8_BAR; PG8_MMA(1, 0, At, B0); PG8_MMA(1, 1, At, B1); PG8_BAR; PG8_SCHED;
            } else {
            PG8_LDB(B0, 0, 0); PG8_SCHED; PG8_LDA(At, 0, 0); PG8_STAGE(PG8_SA(1, 1), a1 + hstep, voffA);
            PG8_WAIT_L(8); PG8_BAR; PG8_WAIT_L(0); PG8_MMA(0, 0, At, B0); PG8_BAR; PG8_SCHED;
            PG8_LDB(B1, 0, 1); PG8_STAGE(PG8_SB(0, 0), b2, voffB);
            PG8_BAR; PG8_WAIT_L(0); PG8_MMA(0, 1, At, B1); PG8_BAR;
            PG8_LDA(At, 0, 1); PG8_STAGE(PG8_SA(0, 0), a2, voffA);
            PG8_BAR; PG8_WAIT_L(0); PG8_MMA(1, 0, At, B0); PG8_BAR; PG8_SCHED;
            PG8_STAGE(PG8_SB(0, 1), b2 + hstep, voffB);
            PG8_WAIT_V(6); PG8_BAR; PG8_MMA(1, 1, At, B1); PG8_BAR;
            PG8_LDB(B0, 1, 0); PG8_SCHED; PG8_LDA(At, 1, 0); PG8_STAGE(PG8_SA(0, 1), a2 + hstep, voffA);
            PG8_WAIT_L(8); PG8_BAR; PG8_WAIT_L(0); PG8_MMA(0, 0, At, B0); PG8_BAR; PG8_SCHED;
            PG8_LDB(B1, 1, 1); PG8_STAGE(PG8_SB(1, 0), b3, voffB);
            PG8_BAR; PG8_WAIT_L(0); PG8_MMA(0, 1, At, B1); PG8_BAR;
            PG8_LDA(At, 1, 1); PG8_STAGE(PG8_SA(1, 0), a3, voffA);
            PG8_BAR; PG8_WAIT_L(0); PG8_MMA(1, 0, At, B0); PG8_BAR; PG8_SCHED;
            PG8_STAGE(PG8_SB(1, 1), b3 + hstep, voffB);
            PG8_WAIT_V(6); PG8_BAR; PG8_MMA(1, 1, At, B1); PG8_BAR;
            }
        }
        if constexpr (ALIGN_EPI) { if (wr == 0) PG8_BAR; }
        if constexpr (!Epi::AFTER_DRAIN) { E(acc, cur, wr, wc, fr, fq); S.done(cur); }
        if (!has_next) break;
#pragma unroll
        for (int a = 0; a < 2; ++a)
#pragma unroll
            for (int b = 0; b < 2; ++b)
#pragma unroll
                for (int m = 0; m < 4; ++m)
#pragma unroll
                    for (int n = 0; n < 2; ++n) acc[a][b][m][n] = (f32x4){0.f, 0.f, 0.f, 0.f};
        cur = nxt; cA = nA; cB = nB; ++ui;
        if constexpr (ALIGN_EPI) { if (wr == 1) PG8_BAR; }
    }
    PG8_WAIT_V(0);
    if constexpr (!ALIGN_EPI) { if (wr == 0) PG8_BAR; }
    PG8_BAR;
    if constexpr (Epi::AFTER_DRAIN) { E.fused(acc, cur, wr, wc, fr, fq, lds, wid, lane); S.done(cur); }
#undef PG8_SA
#undef PG8_SB
#undef PG8_STAGE
#undef PG8_LDA
#undef PG8_LDB
#undef PG8_MMA
#undef PG8_WAIT_V
#undef PG8_WAIT_L
#undef PG8_BAR
#undef PG8_SCHED
}
}
#define GAS __attribute__((address_space(1)))
#define LAS __attribute__((address_space(3)))
typedef GAS unsigned gu32;
typedef GAS unsigned long long gu64;
#define RLX_AGENT __ATOMIC_RELAXED, __HIP_MEMORY_SCOPE_AGENT
#define VM_WAIT() asm volatile("s_waitcnt vmcnt(0)" ::: "memory")
__device__ __forceinline__ unsigned long long rt() { return __builtin_amdgcn_s_memrealtime(); }
__device__ __forceinline__ unsigned f2bf(float f) { unsigned u = __builtin_bit_cast(unsigned, f); return (u + 0x7fffu + ((u >> 16) & 1u)) >> 16; }
__device__ __forceinline__ unsigned pk2(float lo, float hi) { return f2bf(lo) | (f2bf(hi) << 16); }

#define XB_TMO      128
#define XB_XCNT(j)  (256  + 64 * (j))
#define XB_XSUB(j)  (1280 + 64 * (j))
#define XB_XGEN(j)  (2304 + 64 * (j))
#define XB_TOP      3328
#define XB_TOPGEN   3392
#define XCD_BAR_WORDS 3456
#define XB_SPIN_CAP (1u << 18)

__device__ __forceinline__ unsigned xb_ld(unsigned* p)              { return __hip_atomic_load(p, __ATOMIC_RELAXED, __HIP_MEMORY_SCOPE_AGENT); }
__device__ __forceinline__ unsigned xb_add(unsigned* p, unsigned v) { return __hip_atomic_fetch_add(p, v, __ATOMIC_RELAXED, __HIP_MEMORY_SCOPE_AGENT); }
__device__ __forceinline__ unsigned xb_xcc_id() { return (unsigned)__builtin_amdgcn_s_getreg((3 << 11) | 20) & 0xFu; }
#define XB_SPIN(cond, bar) do { unsigned _sp = 0; while (cond) { __builtin_amdgcn_s_sleep(1); \
    if ((++_sp & 255u) == 0u) { if (xb_ld(&(bar)[XB_TMO])) break; if (_sp > XB_SPIN_CAP) { atomicAdd(&(bar)[XB_TMO], 1u); break; } } } } while (0)

struct XcdBarrier {
    unsigned* bar; unsigned x;
    volatile LAS unsigned* st;
};

__device__ __forceinline__ XcdBarrier xcd_barrier_post(unsigned* bar, volatile LAS unsigned* st) {
    XcdBarrier b; b.bar = bar; b.x = xb_xcc_id(); b.st = st;
    if (threadIdx.x == 0) (void)xb_add(&bar[XB_XCNT(b.x)], 1u);
    return b;
}
__device__ __forceinline__ void xcd_barrier_complete(unsigned* bar, unsigned x, unsigned& nloc, unsigned& nx) {
    const unsigned G = gridDim.x * gridDim.y * gridDim.z;
    unsigned sum, cnt, mine, sp = 0u;
    for (;;) {
        sum = 0u; cnt = 0u; mine = 0u;
#pragma unroll
        for (unsigned j = 0; j < 16; ++j) { const unsigned c = xb_ld(&bar[XB_XCNT(j)]); sum += c; cnt += (c > 0u) ? 1u : 0u; mine = (j == x) ? c : mine; }
        if (sum == G) break;
        __builtin_amdgcn_s_sleep(1);
        if ((++sp & 255u) == 0u) { if (xb_ld(&bar[XB_TMO])) break; if (sp > XB_SPIN_CAP) { atomicAdd(&bar[XB_TMO], 1u); break; } }
    }
    nloc = mine > 0u ? mine : 1u; nx = cnt > 0u ? cnt : 1u;
}

__device__ __forceinline__ void xcd_barrier(const XcdBarrier& b) {
    asm volatile("s_waitcnt vmcnt(0)" ::: "memory");
    __syncthreads();
    if (threadIdx.x == 0) {
        unsigned* bar = b.bar;
        __builtin_amdgcn_s_waitcnt(0);
        unsigned nloc = b.st[0], nx = b.st[1];
        if (nloc == 0u) { xcd_barrier_complete(bar, b.x, nloc, nx); b.st[0] = nloc; b.st[1] = nx; }
        const unsigned old = xb_add(&bar[XB_XSUB(b.x)], 1u);
        const unsigned gen = old / nloc;
        if (old + 1u == (gen + 1u) * nloc) {
            __builtin_amdgcn_fence(__ATOMIC_RELEASE, "agent");
            asm volatile("s_waitcnt vmcnt(0)" ::: "memory");
            const unsigned og = xb_add(&bar[XB_TOP], 1u);
            const unsigned tg = og / nx;
            if (og + 1u == (tg + 1u) * nx) xb_add(&bar[XB_TOPGEN], 1u);
            else XB_SPIN(xb_ld(&bar[XB_TOPGEN]) == tg, bar);
            __builtin_amdgcn_fence(__ATOMIC_ACQUIRE, "agent");
            xb_add(&bar[XB_XGEN(b.x)], 1u);
            asm volatile("s_waitcnt vmcnt(0)" ::: "memory");
        } else {
            XB_SPIN(xb_ld(&bar[XB_XGEN(b.x)]) == gen, bar);
            __builtin_amdgcn_fence(__ATOMIC_ACQUIRE, "agent");
            asm volatile("s_waitcnt vmcnt(0)" ::: "memory");
        }
    }
    __syncthreads();
}

using pg8::bf16_t; using pg8::bf16x8; using pg8::f32x4; using pg8::u32x4;
using pg8::DM; using pg8::MP; using pg8::MS; using pg8::MT; using pg8::DIN; using pg8::ZW;
using pg8::Z_GA; using pg8::Z_XB; using pg8::Z_GP; using pg8::Z_U; using pg8::Z_VS; using pg8::Z_GS; using pg8::LOG2E; using pg8::EPS;
typedef float f32x16 __attribute__((ext_vector_type(16)));
typedef unsigned u32x2 __attribute__((ext_vector_type(2)));

constexpr int NWAVES = 8, NTHREADS = 512;
constexpr int LDS_BYTES = 147456;
constexpr int RING_OFF = 1024;

constexpr size_t O_YP = 0, O_YS = 33554432, O_KP = 34603008, O_VP = 35127296, O_PP = 35651584, O_KS = 35774464, O_VS = 44163072, O_PS = 52551680, O_CV = 54517760, O_END = 55042048;
constexpr size_t LS_KP = 262144, LS_PP = 61440, LS_KS = 4194304, LS_PS = 983040, LS_CV = 262144;
constexpr size_t MiB = 1u << 20;
constexpr size_t WS_CTL = 0, CTL_ZERO_BYTES = 65536;
constexpr size_t WS_ROPE = 1 * MiB, WS_SGUW = 2 * MiB, WS_PWT = 2 * MiB + 512 * 1024;
constexpr size_t WS_WTIN = 4 * MiB, WS_WTOUT = 44 * MiB, WS_H = 60 * MiB, WS_MIX = 126 * MiB, WS_QC = 192 * MiB, WS_KC = 225 * MiB, WS_VTP = 233 * MiB, WS_Z2 = 241 * MiB, WS_Y = 357 * MiB, WS_END = 489 * MiB;
constexpr int CW_BAR = 1024;

__constant__ double ROPE_INV[32] = {1.0, 0.7498942093324559, 0.5623413251903491, 0.4216965034285822, 0.31622776601683794, 0.23713737056616552, 0.1778279410038923, 0.1333521432163324, 0.1, 0.07498942093324558, 0.05623413251903491, 0.042169650342858224, 0.03162277660168379, 0.023713737056616554, 0.01778279410038923, 0.01333521432163324, 0.01, 0.007498942093324558, 0.005623413251903491, 0.004216965034285823, 0.0031622776601683794, 0.0023713737056616554, 0.0017782794100389228, 0.001333521432163324, 0.001, 0.0007498942093324559, 0.0005623413251903491, 0.00042169650342858224, 0.00031622776601683794, 0.00023713737056616554, 0.00017782794100389227, 0.0001333521432163324};

struct Args { const float* in[16]; float* out; unsigned char* ws; };

struct Frame {
    int tid, lane, wave, bid, G;
    const float *xp, *xs, *cache_k, *cache_v, *state_pool, *w_in, *w_out, *norm_pre, *norm_post, *sinks, *pool_w, *pool_scale, *ln_g, *ln_b, *sgu_w, *sgu_b;
    float* out;
    float* rope; bf16_t *SGUW, *PWT, *WTIN, *WTOUT, *H, *MIX, *Qc, *Kc, *VTP, *Z2; float* Y;
};

__device__ __forceinline__ float wave_sum(float v) {
#pragma unroll
    for (int o = 1; o < 64; o <<= 1) v += __shfl_xor(v, o);
    return v;
}
__device__ __forceinline__ float wave_max(float v) {
#pragma unroll
    for (int o = 1; o < 64; o <<= 1) v = fmaxf(v, __shfl_xor(v, o));
    return v;
}
__device__ __forceinline__ float bflo(unsigned w) { return __uint_as_float(w << 16); }
__device__ __forceinline__ float bfhi(unsigned w) { return __uint_as_float(w & 0xffff0000u); }
__device__ __forceinline__ void unpack8(const u32x4 w, float (&f)[8]) { f[0] = bflo(w.x); f[1] = bfhi(w.x); f[2] = bflo(w.y); f[3] = bfhi(w.y); f[4] = bflo(w.z); f[5] = bfhi(w.z); f[6] = bflo(w.w); f[7] = bfhi(w.w); }
__device__ __forceinline__ void unpack4(const u32x2 w, float (&f)[4]) { f[0] = bflo(w.x); f[1] = bfhi(w.x); f[2] = bflo(w.y); f[3] = bfhi(w.y); }
__device__ __forceinline__ u32x4 pack8(const float (&f)[8]) { u32x4 w; w.x = pg8::cvt_pk_bf16(f[0], f[1]); w.y = pg8::cvt_pk_bf16(f[2], f[3]); w.z = pg8::cvt_pk_bf16(f[4], f[5]); w.w = pg8::cvt_pk_bf16(f[6], f[7]); return w; }
__device__ __forceinline__ int crow(int r, int hi) { return (r & 3) + 8 * (r >> 2) + 4 * hi; }
#define LDS_WAIT() asm volatile("s_waitcnt lgkmcnt(0)" ::: "memory")

__device__ __forceinline__ void p0_transpose(const float* W, int K, int N, bf16_t* WT, bool permqk, LAS float* scr, int item, int lane) {
    const int nblk = N >> 6, kb = item / nblk, nb = item - kb * nblk, k0 = kb * 64, n0 = nb * 64;
#pragma unroll
    for (int i = 0; i < 16; ++i) { const int kk = 4 * i + (lane >> 4), nn = 4 * (lane & 15);
        const f32x4 v = *(const f32x4*)(W + (size_t)(k0 + kk) * N + n0 + nn); *(LAS f32x4*)(scr + kk * 68 + nn) = v; }
    LDS_WAIT();
    const int n = n0 + lane; int nrow = n;
    if (permqk && n < 1280) { const int p = n & 63; nrow = (n & ~63) + 2 * (p & 31) + (p >> 5); }
    bf16_t* dst = WT + (size_t)nrow * K + k0;
#pragma unroll
    for (int c = 0; c < 8; ++c) { float f[8];
#pragma unroll
        for (int j = 0; j < 8; ++j) f[j] = scr[(8 * c + j) * 68 + lane];
        *(u32x4*)(dst + 8 * c) = pack8(f); }
    LDS_WAIT();
}
__device__ __forceinline__ void prenorm_row(const float* xrow, const float* g, bf16_t* hrow, int lane) {
    f32x4 v[8]; float ss = 0.f;
#pragma unroll
    for (int j = 0; j < 8; ++j) { v[j] = *(const f32x4*)(xrow + 4 * lane + 256 * j); ss += (v[j][0] * v[j][0] + v[j][1] * v[j][1]) + (v[j][2] * v[j][2] + v[j][3] * v[j][3]); }
    ss = wave_sum(ss);
    const float r = rsqrtf(ss * (1.0f / 2048.0f) + EPS);
#pragma unroll
    for (int j = 0; j < 8; ++j) { const f32x4 gg = *(const f32x4*)(g + 4 * lane + 256 * j); const f32x4 o = v[j] * r * gg;
        u32x2 w; w.x = pg8::cvt_pk_bf16(o[0], o[1]); w.y = pg8::cvt_pk_bf16(o[2], o[3]); *(u32x2*)(hrow + 4 * lane + 256 * j) = w; }
}
__device__ __forceinline__ void p0_prologue(const Frame& F, LAS unsigned char* ring) {
    LAS float* scr = (LAS float*)(ring + F.wave * 17408);
    const int gw = F.bid * NWAVES + F.wave, NGW = F.G * NWAVES;
    constexpr int I_IN = 32 * 80, I_OUT = 32 * 32, NITEMS = 2 * (I_IN + I_OUT);
    for (int it = gw; it < NITEMS; it += NGW) {
        int r = it;
        if (r < 2 * I_IN) { const int l = r / I_IN; r -= l * I_IN; p0_transpose(F.w_in + (size_t)l * DM * DIN, DM, DIN, F.WTIN + (size_t)l * DIN * DM, true, scr, r, F.lane); }
        else { r -= 2 * I_IN; const int l = r / I_OUT; r -= l * I_OUT; p0_transpose(F.w_out + (size_t)l * DM * DM, DM, DM, F.WTOUT + (size_t)l * DM * DM, false, scr, r, F.lane); }
    }
    for (int m = gw; m < MT; m += NGW) { const float* xr = m < MP ? F.xp + (size_t)m * DM : F.xs + (size_t)(m - MP) * DM; prenorm_row(xr, F.norm_pre, F.H + (size_t)m * DM, F.lane); }
    const int gt = F.bid * NTHREADS + F.tid, NGT = F.G * NTHREADS;
    for (int e = gt; e < 2052 * 32; e += NGT) { const int tp = e >> 5, i = e & 31; const double pos = (double)(tp < 2048 ? tp : 8192 + (tp - 2048));
        const double rev = pos * ROPE_INV[i] * 0.15915494309189535; const float fr = (float)(rev - floor(rev));
        F.rope[tp * 64 + i] = __builtin_amdgcn_cosf(fr); F.rope[tp * 64 + 32 + i] = __builtin_amdgcn_sinf(fr); }
    for (int e = gt; e < 2 * 4 * 128 * 128; e += NGT) { const int s = e & 127, t = (e >> 7) & 127; const float w = F.sgu_w[e];
        F.SGUW[e] = (bf16_t)(pg8::cvt_pk_bf16(s <= t ? w : 0.f, 0.f) & 0xffffu); }
    for (int e = gt; e < 2 * 4 * 128 * 128; e += NGT) { const int c = e & 127, d = (e >> 7) & 127, lg = e >> 14;
        F.PWT[e] = (bf16_t)(pg8::cvt_pk_bf16(F.pool_w[((size_t)lg * 128 + c) * 128 + d], 0.f) & 0xffffu); }
}

__device__ __forceinline__ void attn_task(const Frame& F, int l, int b, int nb, int head, int qs, LAS unsigned char* wl) {
    const int lane = F.lane, r = lane & 31, hh = lane >> 5, kvh = head >> 2;
    LAS float* wsf = (LAS float*)wl; LAS bf16_t* stg = (LAS bf16_t*)(wl + 256);
    const int t0 = 128 * nb + 32 * qs;
    const size_t qrow0 = (size_t)b * 2048 + t0;
    const bf16_t* qp = F.Qc + (qrow0 + r) * 1024 + head * 64 + 8 * hh;
    bf16x8 qf[4];
#pragma unroll
    for (int s = 0; s < 4; ++s) qf[s] = *(const bf16x8*)(qp + 16 * s);
    const bf16_t* kbase = F.Kc + (size_t)(b * 4 + kvh) * 2048 * 64;
    const bf16_t* vbase = F.VTP + (size_t)(b * 4 + kvh) * 64 * 2048;
    const int cmin = (nb > 0) ? 0 : (4 - qs);
    f32x16 S[5];
#pragma unroll
    for (int c = 0; c < 5; ++c) {
        f32x16 a;
#pragma unroll
        for (int i = 0; i < 16; ++i) a[i] = 0.f;
        if (c >= cmin) {
            const bf16_t* kp = kbase + (size_t)(t0 - 128 + 32 * c + r) * 64 + 8 * hh;
#pragma unroll
            for (int s = 0; s < 4; ++s) a = __builtin_amdgcn_mfma_f32_32x32x16_bf16(*(const bf16x8*)(kp + 16 * s), qf[s], a, 0, 0, 0);
        }
        S[c] = a;
    }
    const float NEG = -INFINITY;
#pragma unroll
    for (int i = 0; i < 16; ++i) { const int kap = crow(i, hh); if (kap <= r) S[0][i] = NEG; if (kap > r) S[4][i] = NEG; }
    const float sink2 = F.sinks[l * 16 + head] * LOG2E;
    float m = sink2;
#pragma unroll
    for (int c = 0; c < 5; ++c) if (c >= cmin) {
#pragma unroll
        for (int i = 0; i < 16; ++i) m = fmaxf(m, S[c][i]); }
    m = fmaxf(m, __shfl_xor(m, 32));
    float sum = 0.f;
#pragma unroll
    for (int c = 0; c < 5; ++c) if (c >= cmin) {
#pragma unroll
        for (int i = 0; i < 16; ++i) { const float p = __builtin_amdgcn_exp2f(S[c][i] - m); S[c][i] = p; sum += p; } }
    sum += __shfl_xor(sum, 32);
    const float inv = 1.0f / (sum + __builtin_amdgcn_exp2f(sink2 - m));
    f32x16 o[2];
#pragma unroll
    for (int i = 0; i < 16; ++i) { o[0][i] = 0.f; o[1][i] = 0.f; }
#pragma unroll
    for (int c = 0; c < 5; ++c) if (c >= cmin) {
        const bf16_t* vt = vbase + (size_t)((t0 - 128 + 32 * c) >> 5) * 2048 + r * 32 + 16 * hh;
#pragma unroll
        for (int s = 0; s < 2; ++s) {
            u32x4 pw; pw.x = pg8::cvt_pk_bf16(S[c][8 * s + 0], S[c][8 * s + 1]); pw.y = pg8::cvt_pk_bf16(S[c][8 * s + 2], S[c][8 * s + 3]);
            pw.z = pg8::cvt_pk_bf16(S[c][8 * s + 4], S[c][8 * s + 5]); pw.w = pg8::cvt_pk_bf16(S[c][8 * s + 6], S[c][8 * s + 7]);
            const bf16x8 pa = __builtin_bit_cast(bf16x8, pw);
#pragma unroll
            for (int db = 0; db < 2; ++db) o[db] = __builtin_amdgcn_mfma_f32_32x32x16_bf16(pa, *(const bf16x8*)(vt + db * 1024 + 8 * s), o[db], 0, 0, 0);
        }
    }
    if (hh == 0) wsf[r] = inv;
    LDS_WAIT();
#pragma unroll
    for (int i = 0; i < 16; ++i) { const int q = crow(i, hh); const float rl = wsf[q];
        stg[q * 64 + r] = (bf16_t)(pg8::cvt_pk_bf16(o[0][i] * rl, 0.f) & 0xffffu);
        stg[q * 64 + 32 + r] = (bf16_t)(pg8::cvt_pk_bf16(o[1][i] * rl, 0.f) & 0xffffu); }
    LDS_WAIT();
#pragma unroll
    for (int i = 0; i < 4; ++i) { const int row = i * 8 + (lane >> 3), ch = lane & 7;
        const u32x4 ov = *(const LAS u32x4*)(stg + row * 64 + ch * 8);
        const u32x4 gv = *(const u32x4*)(F.Z2 + (qrow0 + row) * ZW + Z_GA + head * 64 + ch * 8);
        float of[8], gf[8]; unpack8(ov, of); unpack8(gv, gf);
#pragma unroll
        for (int j = 0; j < 8; ++j) of[j] *= gf[j];
        *(u32x4*)(F.MIX + (qrow0 + row) * DM + head * 64 + ch * 8) = pack8(of); }
    LDS_WAIT();
}

template <bool SAMPLE>
__device__ __forceinline__ void pool_unit(const Frame& F, int l, int g, int tile) {
    const int lane = F.lane, r = lane & 31, hh = lane >> 5, w = 2 << g;
    const size_t row = (size_t)(SAMPLE ? MP : 0) + 32 * tile + r;
    const int t = SAMPLE ? (int)(row & 3) : (int)(row & 2047);
    const int bd = SAMPLE ? (int)((row - MP) >> 2) : 0;
    const float icnt = SAMPLE ? 1.0f / (float)w : 1.0f / (float)(w < t + 1 ? w : t + 1);
    bf16x8 bfr[8];
#pragma unroll
    for (int s = 0; s < 8; ++s) {
        const int c0 = 128 * g + 16 * s + 8 * hh;
        float sum[8], cur[8];
#pragma unroll
        for (int j = 0; j < 8; ++j) { sum[j] = 0.f; cur[j] = 0.f; }
        for (int i = 0; i < w; ++i) {
            float f[8];
            const int e = t - i;
            if (e >= 0) { unpack8(*(const u32x4*)(F.Z2 + (row - i) * ZW + Z_XB + c0), f); }
            else if (SAMPLE) { const float* sp = F.state_pool + (((size_t)l * 128 + bd) * 15 + 15 + e) * 512 + c0;
                const f32x4 a = *(const f32x4*)sp, bq = *(const f32x4*)(sp + 4); f[0] = a[0]; f[1] = a[1]; f[2] = a[2]; f[3] = a[3]; f[4] = bq[0]; f[5] = bq[1]; f[6] = bq[2]; f[7] = bq[3]; }
            else {
#pragma unroll
                for (int j = 0; j < 8; ++j) f[j] = 0.f; }
#pragma unroll
            for (int j = 0; j < 8; ++j) sum[j] += f[j];
            if (i == 0) {
#pragma unroll
                for (int j = 0; j < 8; ++j) cur[j] = f[j]; }
        }
        float pf[8];
#pragma unroll
        for (int j = 0; j < 8; ++j) pf[j] = sum[j] * icnt - cur[j];
        bfr[s] = __builtin_bit_cast(bf16x8, pack8(pf));
    }
    f32x16 acc[4];
#pragma unroll
    for (int db = 0; db < 4; ++db) {
#pragma unroll
        for (int i = 0; i < 16; ++i) acc[db][i] = 0.f;
        const bf16_t* ap = F.PWT + ((size_t)(l * 4 + g) * 128 + 32 * db + r) * 128 + 8 * hh;
#pragma unroll
        for (int s = 0; s < 8; ++s) acc[db] = __builtin_amdgcn_mfma_f32_32x32x16_bf16(*(const bf16x8*)(ap + 16 * s), bfr[s], acc[db], 0, 0, 0);
    }
#pragma unroll
    for (int db = 0; db < 4; ++db)
#pragma unroll
        for (int q = 0; q < 4; ++q) {
            const int col = 128 * g + 32 * db + 8 * q + 4 * hh;
            const f32x4 sc = *(const f32x4*)(F.pool_scale + l * 512 + col);
            float gf[4]; unpack4(*(const u32x2*)(F.Z2 + row * ZW + Z_GP + col), gf);
            u32x2 wv; wv.x = pg8::cvt_pk_bf16(acc[db][4 * q + 0] * sc[0] * gf[0], acc[db][4 * q + 1] * sc[1] * gf[1]);
            wv.y = pg8::cvt_pk_bf16(acc[db][4 * q + 2] * sc[2] * gf[2], acc[db][4 * q + 3] * sc[3] * gf[3]);
            *(u32x2*)(F.MIX + row * DM + 1024 + col) = wv;
        }
}

__device__ __forceinline__ void sgu_unit(const Frame& F, int l, int ci, int hd, LAS unsigned char* ring) {
    LAS bf16_t* VnT = (LAS bf16_t*)ring;
    const int lane = F.lane, wv = F.wave;
    const size_t R0 = (size_t)128 * ci;
    {
        const int tl = lane >> 2, q4 = lane & 3;
        const bf16_t* vrow = F.Z2 + (R0 + 16 * wv + tl) * ZW + Z_VS;
        float s = 0.f, ss = 0.f;
#pragma unroll
        for (int i = 0; i < 16; ++i) { float f[8]; unpack8(*(const u32x4*)(vrow + 128 * q4 + 8 * i), f);
#pragma unroll
            for (int j = 0; j < 8; ++j) { s += f[j]; ss += f[j] * f[j]; } }
        s += __shfl_xor(s, 1); s += __shfl_xor(s, 2); ss += __shfl_xor(ss, 1); ss += __shfl_xor(ss, 2);
        const float mean = s * (1.0f / 512.0f), var = ss * (1.0f / 512.0f) - mean * mean, rstd = rsqrtf(var + EPS);
#pragma unroll
        for (int i = 0; i < 4; ++i) { const int d = 32 * q4 + 8 * i; float f[8]; unpack8(*(const u32x4*)(vrow + 128 * hd + d), f);
            const float* gp = F.ln_g + l * 512 + 128 * hd + d; const float* bp = F.ln_b + l * 512 + 128 * hd + d;
#pragma unroll
            for (int j = 0; j < 8; ++j) { const float vn = (f[j] - mean) * rstd * gp[j] + bp[j];
                VnT[(d + j) * 136 + 16 * wv + tl] = (bf16_t)(pg8::cvt_pk_bf16(vn, 0.f) & 0xffffu); } }
    }
    __syncthreads();
    {
        const int r = lane & 31, hh = lane >> 5, db = wv & 3; const int tbA = (wv >> 2) ? 1 : 0, tbB = (wv >> 2) ? 2 : 3;
        f32x16 accA, accB;
#pragma unroll
        for (int i = 0; i < 16; ++i) { accA[i] = 0.f; accB[i] = 0.f; }
        const bf16_t* Wb = F.SGUW + (size_t)(l * 4 + hd) * 128 * 128;
#pragma unroll
        for (int s = 0; s < 8; ++s) {
            if (s < 2 * (tbB + 1)) {
                const bf16x8 a = *(const LAS bf16x8*)(VnT + (32 * db + r) * 136 + 16 * s + 8 * hh);
                accB = __builtin_amdgcn_mfma_f32_32x32x16_bf16(a, *(const bf16x8*)(Wb + (32 * tbB + r) * 128 + 16 * s + 8 * hh), accB, 0, 0, 0);
                if (s < 2 * (tbA + 1)) accA = __builtin_amdgcn_mfma_f32_32x32x16_bf16(a, *(const bf16x8*)(Wb + (32 * tbA + r) * 128 + 16 * s + 8 * hh), accA, 0, 0, 0);
            }
        }
#pragma unroll
        for (int pass = 0; pass < 2; ++pass) {
            const int tb = pass ? tbB : tbA; const f32x16 acc = pass ? accB : accA;
            const int t = 32 * tb + r; const size_t row = R0 + t; const float bias = F.sgu_b[l * 512 + hd * 128 + t];
#pragma unroll
            for (int q = 0; q < 4; ++q) { const int col = 128 * hd + 32 * db + 8 * q + 4 * hh;
                float uf[4], gf[4]; unpack4(*(const u32x2*)(F.Z2 + row * ZW + Z_U + col), uf); unpack4(*(const u32x2*)(F.Z2 + row * ZW + Z_GS + col), gf);
                u32x2 wo; wo.x = pg8::cvt_pk_bf16((acc[4 * q + 0] + bias) * uf[0] * gf[0], (acc[4 * q + 1] + bias) * uf[1] * gf[1]);
                wo.y = pg8::cvt_pk_bf16((acc[4 * q + 2] + bias) * uf[2] * gf[2], (acc[4 * q + 3] + bias) * uf[3] * gf[3]);
                *(u32x2*)(F.MIX + row * DM + 1536 + col) = wo; }
        }
    }
    __syncthreads();
}

__device__ __forceinline__ void samp_attn(const Frame& F, int l, int bd, int kvh, LAS unsigned char* wl) {
    LAS float* qs = (LAS float*)wl;
    LAS float* ps = (LAS float*)(wl + 4096);
    const int lane = F.lane;
    float* oKs = F.out + O_KS + (size_t)l * LS_KS; float* oVs = F.out + O_VS + (size_t)l * LS_KS;
    {
        const int qi = lane >> 2, part = lane & 3, gq = qi >> 2, tt = qi & 3;
        const bf16_t* src = F.Qc + ((size_t)MP + 4 * bd + tt) * 1024 + (4 * kvh + gq) * 64 + 16 * part;
        float f0[8], f1[8]; unpack8(*(const u32x4*)src, f0); unpack8(*(const u32x4*)(src + 8), f1);
#pragma unroll
        for (int j = 0; j < 8; ++j) { const int p0 = 16 * part + j, p1 = p0 + 8;
            qs[qi * 64 + (p0 >> 1) + 32 * (p0 & 1)] = f0[j]; qs[qi * 64 + (p1 >> 1) + 32 * (p1 & 1)] = f1[j]; }
    }
    LDS_WAIT();
    float s0[16], s1[16], s2[16];
#pragma unroll
    for (int q = 0; q < 16; ++q) { s0[q] = 0.f; s1[q] = 0.f; s2[q] = 0.f; }
    const float* k0p = F.cache_k + (((size_t)l * 128 + bd) * 128 + lane) * 256 + kvh * 64;
    const float* k1p = k0p + 64 * 256;
    const float* k2p = oKs + (((size_t)bd * 128 + 124 + (lane & 3)) * 4 + kvh) * 64;
    float* c0p = oKs + (((size_t)bd * 128 + (lane >= 4 ? lane - 4 : 0)) * 4 + kvh) * 64;
    float* c1p = oKs + (((size_t)bd * 128 + lane + 60) * 4 + kvh) * 64;
    for (int ch = 0; ch < 16; ++ch) {
        const f32x4 kx0 = *(const f32x4*)(k0p + 4 * ch), kx1 = *(const f32x4*)(k1p + 4 * ch), kx2 = *(const f32x4*)(k2p + 4 * ch);
        if (lane >= 4) *(f32x4*)(c0p + 4 * ch) = kx0;
        *(f32x4*)(c1p + 4 * ch) = kx1;
#pragma unroll
        for (int q = 0; q < 16; ++q) { const f32x4 qv = *(const LAS f32x4*)(qs + q * 64 + 4 * ch);
            s0[q] += (qv[0] * kx0[0] + qv[1] * kx0[1]) + (qv[2] * kx0[2] + qv[3] * kx0[3]);
            s1[q] += (qv[0] * kx1[0] + qv[1] * kx1[1]) + (qv[2] * kx1[2] + qv[3] * kx1[3]);
            s2[q] += (qv[0] * kx2[0] + qv[1] * kx2[1]) + (qv[2] * kx2[2] + qv[3] * kx2[3]); }
    }
    float inv[16];
#pragma unroll
    for (int q = 0; q < 16; ++q) {
        const int tt = q & 3; const float sink2 = F.sinks[l * 16 + 4 * kvh + (q >> 2)] * LOG2E;
        const bool v0 = lane >= tt + 1, v2 = (lane < 4) && (lane <= tt);
        float m = s1[q]; if (v0) m = fmaxf(m, s0[q]); if (v2) m = fmaxf(m, s2[q]);
        m = fmaxf(wave_max(m), sink2);
        const float p0 = v0 ? __builtin_amdgcn_exp2f(s0[q] - m) : 0.f, p1 = __builtin_amdgcn_exp2f(s1[q] - m), p2 = v2 ? __builtin_amdgcn_exp2f(s2[q] - m) : 0.f;
        const float sum = wave_sum(p0 + p1 + p2);
        inv[q] = 1.0f / (sum + __builtin_amdgcn_exp2f(sink2 - m));
        ps[lane * 16 + q] = p0; ps[(lane + 64) * 16 + q] = p1; if (lane < 4) ps[(128 + lane) * 16 + q] = p2;
    }
    LDS_WAIT();
    float o[16];
#pragma unroll
    for (int q = 0; q < 16; ++q) o[q] = 0.f;
    const float* vcp = F.cache_v + (((size_t)l * 128 + bd) * 128) * 256 + kvh * 64 + lane;
    float* vop = oVs + ((size_t)bd * 128) * 256 + kvh * 64 + lane;
    for (int key = 0; key < 132; ++key) {
        float v;
        if (key < 128) { v = vcp[(size_t)key * 256]; if (key >= 4) vop[(size_t)(key - 4) * 256] = v; }
        else v = vop[(size_t)(key - 4) * 256];
#pragma unroll
        for (int q4 = 0; q4 < 4; ++q4) { const f32x4 pv = *(const LAS f32x4*)(ps + key * 16 + 4 * q4);
            o[4 * q4 + 0] += pv[0] * v; o[4 * q4 + 1] += pv[1] * v; o[4 * q4 + 2] += pv[2] * v; o[4 * q4 + 3] += pv[3] * v; }
    }
#pragma unroll
    for (int q = 0; q < 16; ++q) { const int tt = q & 3, head = 4 * kvh + (q >> 2); const size_t row = (size_t)MP + 4 * bd + tt;
        const float gv = __uint_as_float(((unsigned)F.Z2[row * ZW + Z_GA + head * 64 + lane]) << 16);
        F.MIX[row * DM + head * 64 + lane] = (bf16_t)(pg8::cvt_pk_bf16(o[q] * inv[q] * gv, 0.f) & 0xffffu); }
    LDS_WAIT();
}
__device__ __forceinline__ void samp_sgu(const Frame& F, int l, int bd) {
    const int lane = F.lane, c0 = 8 * lane, hd = lane >> 4;
    float* oCV = F.out + O_CV + (size_t)l * LS_CV;
    float gl[8], bl[8];
#pragma unroll
    for (int j = 0; j < 8; ++j) { gl[j] = F.ln_g[l * 512 + c0 + j]; bl[j] = F.ln_b[l * 512 + c0 + j]; }
    float vn[4][8];
#pragma unroll
    for (int tt = 0; tt < 4; ++tt) { const size_t row = (size_t)MP + 4 * bd + tt; float f[8]; unpack8(*(const u32x4*)(F.Z2 + row * ZW + Z_VS + c0), f);
        float s = 0.f, ss = 0.f;
#pragma unroll
        for (int j = 0; j < 8; ++j) { s += f[j]; ss += f[j] * f[j]; }
        s = wave_sum(s); ss = wave_sum(ss);
        const float mean = s * (1.0f / 512.0f), var = ss * (1.0f / 512.0f) - mean * mean, rstd = rsqrtf(var + EPS);
#pragma unroll
        for (int j = 0; j < 8; ++j) vn[tt][j] = (f[j] - mean) * rstd * gl[j] + bl[j];
        float* o = oCV + ((size_t)bd * 4 + tt) * 512 + c0;
        *(f32x4*)o = (f32x4){vn[tt][0], vn[tt][1], vn[tt][2], vn[tt][3]}; *(f32x4*)(o + 4) = (f32x4){vn[tt][4], vn[tt][5], vn[tt][6], vn[tt][7]}; }
#pragma unroll
    for (int tt = 0; tt < 4; ++tt) { const size_t row = (size_t)MP + 4 * bd + tt;
        float mx[8]; const float bias = F.sgu_b[l * 512 + hd * 128 + tt];
#pragma unroll
        for (int j = 0; j < 8; ++j) mx[j] = bias;
#pragma unroll
        for (int s2 = 0; s2 < 4; ++s2) if (s2 <= tt) { const float w = F.sgu_w[((size_t)(l * 4 + hd) * 128 + tt) * 128 + s2];
#pragma unroll
            for (int j = 0; j < 8; ++j) mx[j] += w * vn[s2][j]; }
        float uf[8], gf[8]; unpack8(*(const u32x4*)(F.Z2 + row * ZW + Z_U + c0), uf); unpack8(*(const u32x4*)(F.Z2 + row * ZW + Z_GS + c0), gf);
#pragma unroll
        for (int j = 0; j < 8; ++j) mx[j] = mx[j] * uf[j] * gf[j];
        *(u32x4*)(F.MIX + row * DM + 1536 + c0) = pack8(mx); }
}

__device__ __forceinline__ void p2_mixers(const Frame& F, int l, LAS unsigned char* ring) {
    for (int u = F.bid; u < 512; u += F.G) sgu_unit(F, l, u >> 2, u & 3, ring);
    LAS unsigned char* wl = ring + 102400 + F.wave * 4352;
    for (int a = F.bid; a < 512; a += F.G) { const int kvh = a & 3, nb = (a >> 2) & 15, b = a >> 6;
        const int head = 4 * kvh + (F.wave >> 1);
        attn_task(F, l, b, nb, head, 2 * (F.wave & 1), wl); attn_task(F, l, b, nb, head, 2 * (F.wave & 1) + 1, wl); }
    const int gw = F.bid * NWAVES + F.wave, NGW = F.G * NWAVES;
    for (int i = gw; i < 2048; i += NGW) pool_unit<false>(F, l, i & 3, i >> 2);
    LAS unsigned char* wls = ring + F.wave * 12544;
    for (int i = gw; i < 2048; i += NGW) {
        if ((i & 3) == 0) { const int k = i >> 2; samp_attn(F, l, k >> 2, k & 3, wls); }
        else if ((i & 15) == 1) { samp_sgu(F, l, i >> 4); }
        else if ((i & 31) == 2) { const int k = i >> 5; pool_unit<true>(F, l, k & 3, k >> 2); }
    }
    {
        const int gt = F.bid * NTHREADS + F.tid, NGT = F.G * NTHREADS;
        float* oPs = F.out + O_PS + (size_t)l * LS_PS; const float* sp = F.state_pool + (size_t)l * LS_PS;
        for (int e = gt; e < 128 * 11 * 128; e += NGT) { const int c4 = e & 127, rr = (e >> 7) % 11, bd = (e >> 7) / 11;
            *(f32x4*)(oPs + ((size_t)bd * 15 + rr) * 512 + 4 * c4) = *(const f32x4*)(sp + ((size_t)bd * 15 + rr + 4) * 512 + 4 * c4); }
    }
}

__device__ __forceinline__ void p4_rows(const Frame& F, int l) {
    const int lane = F.lane, gw = F.bid * NWAVES + F.wave, NGW = F.G * NWAVES;
    const float* pg = F.norm_post + l * DM; const float* g1 = F.norm_pre + DM;
    for (int row = gw; row < MT; row += NGW) {
        const float* yr = F.Y + (size_t)row * DM;
        const float* xr = (l == 0) ? (row < MP ? F.xp + (size_t)row * DM : F.xs + (size_t)(row - MP) * DM) : F.out + (size_t)row * DM;
        float* orow = F.out + (size_t)row * DM;
        f32x4 v[8]; float ss = 0.f;
#pragma unroll
        for (int j = 0; j < 8; ++j) { v[j] = *(const f32x4*)(yr + 4 * lane + 256 * j); ss += (v[j][0] * v[j][0] + v[j][1] * v[j][1]) + (v[j][2] * v[j][2] + v[j][3] * v[j][3]); }
        ss = wave_sum(ss);
        const float ry = rsqrtf(ss * (1.0f / 2048.0f) + EPS);
        float s1 = 0.f;
#pragma unroll
        for (int j = 0; j < 8; ++j) { const f32x4 xv = *(const f32x4*)(xr + 4 * lane + 256 * j); const f32x4 gg = *(const f32x4*)(pg + 4 * lane + 256 * j);
            const f32x4 x1 = xv + v[j] * ry * gg; v[j] = x1; *(f32x4*)(orow + 4 * lane + 256 * j) = x1;
            s1 += (x1[0] * x1[0] + x1[1] * x1[1]) + (x1[2] * x1[2] + x1[3] * x1[3]); }
        if (l == 0) {
            s1 = wave_sum(s1);
            const float r1 = rsqrtf(s1 * (1.0f / 2048.0f) + EPS);
            bf16_t* hrow = F.H + (size_t)row * DM;
#pragma unroll
            for (int j = 0; j < 8; ++j) { const f32x4 gg = *(const f32x4*)(g1 + 4 * lane + 256 * j); const f32x4 o = v[j] * r1 * gg;
                u32x2 w; w.x = pg8::cvt_pk_bf16(o[0], o[1]); w.y = pg8::cvt_pk_bf16(o[2], o[3]); *(u32x2*)(hrow + 4 * lane + 256 * j) = w; }
        }
    }
}

struct ArgsG { const __attribute__((address_space(1))) float* in[16]; __attribute__((address_space(1))) float* out; __attribute__((address_space(1))) unsigned char* ws; };
typedef const __attribute__((address_space(4))) ArgsG* KArgs;
__device__ __forceinline__ KArgs kargs() { KArgs p = (KArgs)__builtin_amdgcn_kernarg_segment_ptr(); asm volatile("" : "+s"(p)); return p; }
__device__ __forceinline__ void make_frame(Frame& F, KArgs a) {
    { int t_ = threadIdx.x; asm volatile("" : "+v"(t_)); F.tid = t_; } F.lane = F.tid & 63; F.wave = __builtin_amdgcn_readfirstlane(F.tid >> 6); F.bid = blockIdx.x; F.G = gridDim.x;
    F.xp = (const float*)a->in[0]; F.xs = (const float*)a->in[1]; F.cache_k = (const float*)a->in[2]; F.cache_v = (const float*)a->in[3]; F.state_pool = (const float*)a->in[4]; F.w_in = (const float*)a->in[5]; F.w_out = (const float*)a->in[6]; F.norm_pre = (const float*)a->in[7]; F.norm_post = (const float*)a->in[8];
    F.sinks = (const float*)a->in[9]; F.pool_w = (const float*)a->in[10]; F.pool_scale = (const float*)a->in[11]; F.ln_g = (const float*)a->in[12]; F.ln_b = (const float*)a->in[13]; F.sgu_w = (const float*)a->in[14]; F.sgu_b = (const float*)a->in[15];
    F.out = (float*)a->out;
    unsigned char* ws = (unsigned char*)a->ws;
    F.rope = (float*)(ws + WS_ROPE); F.SGUW = (bf16_t*)(ws + WS_SGUW); F.PWT = (bf16_t*)(ws + WS_PWT); F.WTIN = (bf16_t*)(ws + WS_WTIN); F.WTOUT = (bf16_t*)(ws + WS_WTOUT);
    F.H = (bf16_t*)(ws + WS_H); F.MIX = (bf16_t*)(ws + WS_MIX); F.Qc = (bf16_t*)(ws + WS_QC); F.Kc = (bf16_t*)(ws + WS_KC); F.VTP = (bf16_t*)(ws + WS_VTP); F.Z2 = (bf16_t*)(ws + WS_Z2); F.Y = (float*)(ws + WS_Y);
}

__global__ void __launch_bounds__(NTHREADS, 2) hymba_fwd(Args a_unused) {
    extern __shared__ __attribute__((aligned(16))) unsigned char lds[];
    LAS unsigned char* L = (LAS unsigned char*)lds;
    if (threadIdx.x < 256) ((LAS unsigned*)L)[threadIdx.x] = 0u;
    __syncthreads();
    XcdBarrier bar = xcd_barrier_post((unsigned*)((unsigned char*)kargs()->ws + WS_CTL) + CW_BAR, (volatile LAS unsigned*)L + 8);
    LAS unsigned char* ring = L + RING_OFF;
#ifndef NO_P0
    { Frame F; make_frame(F, kargs()); p0_prologue(F, ring); }
#endif
    xcd_barrier(bar);
#pragma unroll 1
    for (int l = 0; l < 2; ++l) {
#ifndef NO_P1
        {
            KArgs ka = kargs(); unsigned char* ws = (unsigned char*)ka->ws;
            pg8::Gemm g{(const bf16_t*)(ws + WS_H), (const bf16_t*)(ws + WS_WTIN) + (size_t)l * DIN * DM, MT, DIN, DM}; pg8::StaticOrder S; S.init(MT, DIN, (int)gridDim.x, (int)blockIdx.x);
            pg8::EpiIn E{l};
            pg8::gemm_phase<pg8::EpiIn, pg8::StaticOrder, true, true>(ring, g, S, E);
        }
#endif
        xcd_barrier(bar);
#ifndef NO_P2
        { Frame F; make_frame(F, kargs()); p2_mixers(F, l, ring); }
#endif
        xcd_barrier(bar);
#ifndef NO_P3
        {
            KArgs ka = kargs(); unsigned char* ws = (unsigned char*)ka->ws;
            pg8::Gemm g{(const bf16_t*)(ws + WS_MIX), (const bf16_t*)(ws + WS_WTOUT) + (size_t)l * DM * DM, MT, DM, DM}; pg8::StaticOrder S; S.init(MT, DM, (int)gridDim.x, (int)blockIdx.x);
            pg8::EpiOut E{};
            pg8::gemm_phase<pg8::EpiOut, pg8::StaticOrder, true, true>(ring, g, S, E);
        }
#endif
        xcd_barrier(bar);
#ifndef NO_P4
        { Frame F; make_frame(F, kargs()); p4_rows(F, l); }
#endif
        if (l == 0) xcd_barrier(bar);
    }
}

extern "C" void kernel_launch(void* const* d_in, const int* in_sizes, int n_in, void* d_out, int out_size, void* d_ws, size_t ws_size, hipStream_t stream) {
    static int grid = 0;
    if (grid == 0) {
        if (n_in != 16 || (size_t)out_size != O_END || ws_size < WS_END) { fprintf(stderr, "kernel_launch: unexpected shapes: n_in %d out %d ws %zu (need %zu)\n", n_in, out_size, ws_size, (size_t)WS_END); grid = -1; return; }
        int dev = 0, cus = 0, per_cu = 0;
        if (hipGetDevice(&dev) != hipSuccess || hipDeviceGetAttribute(&cus, hipDeviceAttributeMultiprocessorCount, dev) != hipSuccess) { fprintf(stderr, "kernel_launch: device query failed\n"); grid = -1; return; }
        if (hipFuncSetAttribute((const void*)hymba_fwd, hipFuncAttributeMaxDynamicSharedMemorySize, LDS_BYTES) != hipSuccess) { fprintf(stderr, "kernel_launch: hipFuncSetAttribute failed\n"); grid = -1; return; }
        if (hipOccupancyMaxActiveBlocksPerMultiprocessor(&per_cu, (const void*)hymba_fwd, NTHREADS, LDS_BYTES) != hipSuccess || per_cu < 1) { fprintf(stderr, "kernel_launch: occupancy query says %d blocks/CU\n", per_cu); (void)hipGetLastError(); grid = -1; return; }
        grid = cus;
    }
    if (grid < 0) return;
    (void)hipMemsetAsync((char*)d_ws + WS_CTL, 0, CTL_ZERO_BYTES, stream);
    Args a{};
    for (int i = 0; i < 16; ++i) a.in[i] = (const float*)d_in[i];
    a.out = (float*)d_out; a.ws = (unsigned char*)d_ws;
    void* params[] = {&a};
    hipError_t e = hipLaunchCooperativeKernel((const void*)hymba_fwd, dim3(grid), dim3(NTHREADS), params, LDS_BYTES, stream);
    if (e != hipSuccess) fprintf(stderr, "kernel_launch: cooperative launch failed: %s (grid %d)\n", hipGetErrorString(e), grid);
}
```

```cpp
#include <hip/hip_runtime.h>
#include <cstdio>
#include <cstdint>
#include <cmath>
namespace pg8 {
#define PG8_LAS __attribute__((address_space(3)))
typedef unsigned short bf16_t;
typedef short bf16x8 __attribute__((ext_vector_type(8)));
typedef float f32x4 __attribute__((ext_vector_type(4)));
typedef unsigned u32x4 __attribute__((ext_vector_type(4)));
constexpr int BM = 256, BK = 64, HALF = 128, HTB = HALF * BK * 2  , STAGE_BYTES = 8 * HTB, NXCD = 8, WGM = 8;

__host__ __device__ __forceinline__ int lds_byte(int r, int c) { const int st = (r >> 4) * 2 + (c >> 5), rr = r & 15, cc = c & 31, ob = rr * 64 + cc * 2; return st * 1024 + (ob ^ (((ob >> 9) & 1) << 5)); }
__host__ __device__ __forceinline__ void stage_rc(int b, int& R, int& C) { const int st = b / 1024, sb = b % 1024, swz = sb ^ (((sb >> 9) & 1) << 5); R = (st >> 1) * 16 + swz / 64; C = (st & 1) * 32 + (swz % 64) / 2; }
__host__ __device__ __forceinline__ int perm32(int rho) { const int n = rho >> 4, i = rho & 15; return 8 * (i >> 2) + 4 * n + (i & 3); }

struct Unit { int pm, pn; };
struct Gemm { const bf16_t* A; const bf16_t* Bt; int M, N, K; };

struct StaticOrder {
    int nM, nN, nwg, G, c;
    __host__ __device__ void init(int M, int N, int G_, int c_) { nM = M / BM; nN = N / BM; nwg = nM * nN; G = G_; c = c_; }
    __host__ __device__ bool next(int i, Unit& u) const {
        const long L = (long)i * G + c; if (L >= nwg) return false;
        int wgid = (int)L; { const int q = nwg / NXCD, r = nwg % NXCD, xcd = wgid % NXCD, off = wgid / NXCD; wgid = (xcd < r ? xcd * (q + 1) : r * (q + 1) + (xcd - r) * q) + off; }
        const int nig = WGM * nN, gid = wgid / nig, fm = gid * WGM, gsz = (nM - fm) < WGM ? (nM - fm) : WGM;
        u.pm = fm + ((wgid % nig) % gsz); u.pn = (wgid % nig) / gsz; return true;
    }
    __device__ __forceinline__ void a_ready(const Unit&) const {}
    __device__ __forceinline__ void done(const Unit&) const {}
};

constexpr int DM = 2048, MP = 16384, MS = 512, MT = MP + MS, DIN = 5120;
constexpr int ZW = 3584;
constexpr int Z_GA = 0, Z_XB = 1024, Z_GP = 1536, Z_U = 2048, Z_VS = 2560, Z_GS = 3072;
constexpr float LOG2E = 1.4426950408889634f, QSCALE = 0.125f * LOG2E, EPS = 1e-6f;

__device__ __forceinline__ unsigned cvt_pk_bf16(float lo, float hi) { unsigned r; asm("v_cvt_pk_bf16_f32 %0, %1, %2" : "=v"(r) : "v"(lo), "v"(hi)); return r; }
__device__ __forceinline__ float silu_f(float x) { return x * __builtin_amdgcn_rcpf(1.0f + __builtin_amdgcn_exp2f(-x * LOG2E)); }
__device__ __forceinline__ int vperm32(int x) { return ((x >> 2) & 1) * 16 + (x >> 3) * 4 + (x & 3); }

struct EpiPtrs { const __attribute__((address_space(1))) float* in[16]; __attribute__((address_space(1))) float* out; __attribute__((address_space(1))) unsigned char* ws; };
constexpr size_t EP_ROPE = (size_t)1 << 20, EP_QC = (size_t)192 << 20, EP_KC = (size_t)225 << 20, EP_VTP = (size_t)233 << 20, EP_Z2 = (size_t)241 << 20, EP_Y = (size_t)357 << 20;
constexpr size_t EO_KP = 34603008, EO_VP = 35127296, EO_PP = 35651584, EO_KS = 35774464, EO_VS = 44163072, EO_PS = 52551680;
struct EpiIn {
    static constexpr bool PERM = true, AFTER_DRAIN = false;
    int l;
    __device__ __forceinline__ void operator()(const f32x4 (&acc)[2][2][4][2], const Unit& u, int wr, int wc, int fr, int fq) const {
        const __attribute__((address_space(4))) EpiPtrs* kp = (const __attribute__((address_space(4))) EpiPtrs*)__builtin_amdgcn_kernarg_segment_ptr(); asm volatile("" : "+s"(kp));
        unsigned char* ws = (unsigned char*)kp->ws; float* outp = (float*)kp->out;
        bf16_t* Qc = (bf16_t*)(ws + EP_QC); bf16_t* Kc = (bf16_t*)(ws + EP_KC); bf16_t* VTP = (bf16_t*)(ws + EP_VTP); bf16_t* Z2 = (bf16_t*)(ws + EP_Z2); const float* rope = (const float*)(ws + EP_ROPE);
        float* oKp = outp + EO_KP + (size_t)l * 262144; float* oVp = outp + EO_VP + (size_t)l * 262144; float* oPp = outp + EO_PP + (size_t)l * 61440;
        float* oKs = outp + EO_KS + (size_t)l * 4194304; float* oVs = outp + EO_VS + (size_t)l * 4194304; float* oPs = outp + EO_PS + (size_t)l * 983040;
        const int pn = u.pn;
        const int row0 = u.pm * 256 + wr * 64 + fr;
        const int cw = wc * 32 + 8 * fq;
        if (pn < 5) {
#pragma unroll
            for (int ai = 0; ai < 2; ++ai)
#pragma unroll
                for (int m = 0; m < 4; ++m) {
                    const int row = row0 + ai * 128 + m * 16;
                    const bool smp = row >= MP;
                    const int tpos = smp ? 2048 + (row & 3) : (row & 2047);
                    const float* rp = rope + tpos * 64;
#pragma unroll
                    for (int bj = 0; bj < 2; ++bj) {
                        const int c = pn * 256 + bj * 128 + cw;
                        const int i0 = (c & 63) >> 1;
                        const f32x4 cs = *(const f32x4*)(rp + i0), sn = *(const f32x4*)(rp + 32 + i0);
                        const f32x4 v0 = acc[ai][bj][m][0], v1 = acc[ai][bj][m][1];
                        f32x4 o1, o2;
                        o1[0] = v0[0] * cs[0] - v0[1] * sn[0]; o2[0] = v0[1] * cs[0] + v0[0] * sn[0];
                        o1[1] = v0[2] * cs[1] - v0[3] * sn[1]; o2[1] = v0[3] * cs[1] + v0[2] * sn[1];
                        o1[2] = v1[0] * cs[2] - v1[1] * sn[2]; o2[2] = v1[1] * cs[2] + v1[0] * sn[2];
                        o1[3] = v1[2] * cs[3] - v1[3] * sn[3]; o2[3] = v1[3] * cs[3] + v1[2] * sn[3];
                        if (pn < 4) {
                            o1 = o1 * QSCALE; o2 = o2 * QSCALE;
                            u32x4 w; w.x = cvt_pk_bf16(o1[0], o2[0]); w.y = cvt_pk_bf16(o1[1], o2[1]); w.z = cvt_pk_bf16(o1[2], o2[2]); w.w = cvt_pk_bf16(o1[3], o2[3]);
                            *(u32x4*)(Qc + (size_t)row * 1024 + c) = w;
                        } else {
                            const int kvh = (c - 1024) >> 6;
                            if (!smp) {
                                const int b = row >> 11, t = row & 2047;
                                u32x4 w; w.x = cvt_pk_bf16(o1[0], o2[0]); w.y = cvt_pk_bf16(o1[1], o2[1]); w.z = cvt_pk_bf16(o1[2], o2[2]); w.w = cvt_pk_bf16(o1[3], o2[3]);
                                *(u32x4*)(Kc + ((size_t)((b * 4 + kvh) * 2048 + t)) * 64 + (c & 63)) = w;
                                if (t >= 1920) { float* o = oKp + ((size_t)((b * 128 + t - 1920) * 4 + kvh)) * 64 + i0; *(f32x4*)o = o1; *(f32x4*)(o + 32) = o2; }
                            } else {
                                const int bd = (row - MP) >> 2, tt = row & 3;
                                float* o = oKs + ((size_t)((bd * 128 + 124 + tt) * 4 + kvh)) * 64 + i0; *(f32x4*)o = o1; *(f32x4*)(o + 32) = o2;
                            }
                        }
                    }
                }
        } else if (pn == 5) {
#pragma unroll
            for (int ai = 0; ai < 2; ++ai)
#pragma unroll
                for (int m = 0; m < 4; ++m) {
                    const int row = row0 + ai * 128 + m * 16;
                    const bool smp = row >= MP;
#pragma unroll
                    for (int bj = 0; bj < 2; ++bj) {
                        const int cv = bj * 128 + cw;
                        const int kvh = cv >> 6, d0 = cv & 63;
                        const f32x4 v0 = acc[ai][bj][m][0], v1 = acc[ai][bj][m][1];
                        if (!smp) {
                            const int b = row >> 11, t = row & 2047;
                            bf16_t* vp = VTP + ((size_t)((b * 4 + kvh) * 64 + (t >> 5))) * 2048 + d0 * 32 + vperm32(t & 31);
                            const unsigned w0 = cvt_pk_bf16(v0[0], v0[1]), w1 = cvt_pk_bf16(v0[2], v0[3]), w2 = cvt_pk_bf16(v1[0], v1[1]), w3 = cvt_pk_bf16(v1[2], v1[3]);
                            vp[0] = (bf16_t)(w0 & 0xffffu); vp[32] = (bf16_t)(w0 >> 16); vp[64] = (bf16_t)(w1 & 0xffffu); vp[96] = (bf16_t)(w1 >> 16);
                            vp[128] = (bf16_t)(w2 & 0xffffu); vp[160] = (bf16_t)(w2 >> 16); vp[192] = (bf16_t)(w3 & 0xffffu); vp[224] = (bf16_t)(w3 >> 16);
                            if (t >= 1920) { float* o = oVp + ((size_t)((b * 128 + t - 1920) * 4 + kvh)) * 64 + d0; *(f32x4*)o = v0; *(f32x4*)(o + 4) = v1; }
                        } else {
                            const int bd = (row - MP) >> 2, tt = row & 3;
                            float* o = oVs + ((size_t)((bd * 128 + 124 + tt) * 4 + kvh)) * 64 + d0; *(f32x4*)o = v0; *(f32x4*)(o + 4) = v1;
                        }
                    }
                }
        } else {
            const bool gate = (pn < 10) || (pn == 12) || (pn == 13) || (pn >= 18);
            const bool isxb = (pn == 10) || (pn == 11);
#pragma unroll
            for (int ai = 0; ai < 2; ++ai)
#pragma unroll
                for (int m = 0; m < 4; ++m) {
                    const int row = row0 + ai * 128 + m * 16;
                    const bool smp = row >= MP;
#pragma unroll
                    for (int bj = 0; bj < 2; ++bj) {
                        const int c = pn * 256 + bj * 128 + cw;
                        f32x4 v0 = acc[ai][bj][m][0], v1 = acc[ai][bj][m][1];
                        if (isxb) {
                            const int cx = c - 2560;
                            if (!smp) { const int t = row & 2047; if (t >= 2033) { const int b = row >> 11; float* o = oPp + ((size_t)(b * 15 + t - 2033)) * 512 + cx; *(f32x4*)o = v0; *(f32x4*)(o + 4) = v1; } }
                            else { const int bd = (row - MP) >> 2, tt = row & 3; float* o = oPs + ((size_t)(bd * 15 + 11 + tt)) * 512 + cx; *(f32x4*)o = v0; *(f32x4*)(o + 4) = v1; }
                        }
                        if (gate) {
#pragma unroll
                            for (int j = 0; j < 4; ++j) { v0[j] = silu_f(v0[j]); v1[j] = silu_f(v1[j]); }
                        }
                        u32x4 w; w.x = cvt_pk_bf16(v0[0], v0[1]); w.y = cvt_pk_bf16(v0[2], v0[3]); w.z = cvt_pk_bf16(v1[0], v1[1]); w.w = cvt_pk_bf16(v1[2], v1[3]);
                        *(u32x4*)(Z2 + (size_t)row * ZW + (c - 1536)) = w;
                    }
                }
        }
    }
};

struct EpiOut {
    static constexpr bool PERM = false, AFTER_DRAIN = false;
    __device__ __forceinline__ void operator()(const f32x4 (&acc)[2][2][4][2], const Unit& u, int wr, int wc, int fr, int fq) const {
        const __attribute__((address_space(4))) EpiPtrs* kp = (const __attribute__((address_space(4))) EpiPtrs*)__builtin_amdgcn_kernarg_segment_ptr(); asm volatile("" : "+s"(kp));
        float* C = (float*)((unsigned char*)kp->ws + EP_Y); constexpr int ldc = DM;
        const int row0 = u.pm * BM + wr * 64 + fr, col0 = u.pn * BM + wc * 32 + 4 * fq;
#pragma unroll
        for (int ai = 0; ai < 2; ++ai)
#pragma unroll
            for (int m = 0; m < 4; ++m) { float* rowp = C + (size_t)(row0 + ai * HALF + m * 16) * ldc + col0;
#pragma unroll
                for (int bj = 0; bj < 2; ++bj)
#pragma unroll
                    for (int n = 0; n < 2; ++n) *(f32x4*)(rowp + bj * HALF + n * 16) = acc[ai][bj][m][n]; }
    }
};
template <class Epi, class Sched, bool ALIGN_EPI = false, bool SP2 = false>
__device__ __forceinline__ void gemm_phase(PG8_LAS unsigned char* lds, const Gemm g, const Sched& S, const Epi& E) {
    int tid_ = threadIdx.x; asm volatile("" : "+v"(tid_));
    const int tid = tid_, wid = __builtin_amdgcn_readfirstlane(tid >> 6), lane = tid & 63, wr = wid >> 2, wc = wid & 3, fr = lane & 15, fq = lane >> 4;
    const int K = g.K, nt = K / BK;
    unsigned voffA[2], voffB[2];
#pragma unroll
    for (int i = 0; i < 2; ++i) { int R, C; stage_rc(tid * 16 + i * 8192, R, C); const int Rb = Epi::PERM ? ((R & ~31) + perm32(R & 31)) : R;
        voffA[i] = (unsigned)(R * K + C) * 2u; voffB[i] = (unsigned)(Rb * K + C) * 2u; }
    const size_t kstep = (size_t)(BK * 2);
    const size_t hstep = (size_t)HALF * K * 2;
    const size_t tstep = 2 * hstep;
    const unsigned ldsw = (unsigned)wid * 1024u;
    const int aoff = lds_byte(wr * 64 + fr, fq * 8), boff = lds_byte(wc * 32 + fr, fq * 8);
#define PG8_SA(b, h) (((b) * 2 + (h)) * HTB)
#define PG8_SB(b, h) ((4 + (b) * 2 + (h)) * HTB)
#define PG8_STAGE(bufoff, gbase, voff) do { _Pragma("unroll") for (int _i = 0; _i < 2; ++_i) \
        __builtin_amdgcn_global_load_lds((const unsigned*)((const char*)(gbase) + (voff)[_i]), (PG8_LAS unsigned*)(lds + (bufoff) + ldsw + _i * 8192), 16, 0, 0); } while (0)
#define PG8_LDA(dst, b, h) do { _Pragma("unroll") for (int m = 0; m < 4; ++m) _Pragma("unroll") for (int k = 0; k < 2; ++k) dst[m][k] = *(const PG8_LAS bf16x8*)(lds + PG8_SA(b, h) + aoff + m * 2048 + k * 1024); } while (0)
#define PG8_LDB(dst, b, h) do { _Pragma("unroll") for (int n = 0; n < 2; ++n) _Pragma("unroll") for (int k = 0; k < 2; ++k) dst[n][k] = *(const PG8_LAS bf16x8*)(lds + PG8_SB(b, h) + boff + n * 2048 + k * 1024); } while (0)
#define PG8_MMA(ai, bj, At, Bt) do { __builtin_amdgcn_s_setprio(1); _Pragma("unroll") for (int m = 0; m < 4; ++m) _Pragma("unroll") for (int n = 0; n < 2; ++n) _Pragma("unroll") for (int k = 0; k < 2; ++k) \
        acc[ai][bj][m][n] = __builtin_amdgcn_mfma_f32_16x16x32_bf16(Bt[n][k], At[m][k], acc[ai][bj][m][n], 0, 0, 0); __builtin_amdgcn_s_setprio(0); } while (0)
#define PG8_WAIT_V(n) asm volatile("s_waitcnt vmcnt(" #n ")" ::: "memory")
#define PG8_WAIT_L(n) asm volatile("s_waitcnt lgkmcnt(" #n ")" ::: "memory")
#define PG8_BAR __builtin_amdgcn_s_barrier()
#define PG8_SCHED __builtin_amdgcn_sched_barrier(0)
    Unit cur, nxt; int ui = 0;
    if (!S.next(0, cur)) return;
    f32x4 acc[2][2][4][2];
#pragma unroll
    for (int a = 0; a < 2; ++a)
#pragma unroll
        for (int b = 0; b < 2; ++b)
#pragma unroll
            for (int m = 0; m < 4; ++m)
#pragma unroll
                for (int n = 0; n < 2; ++n) acc[a][b][m][n] = (f32x4){0.f, 0.f, 0.f, 0.f};
    bf16x8 At[4][2], B0[2][2], B1[2][2];
    const char* cA = (const char*)g.A + (size_t)cur.pm * tstep; const char* cB = (const char*)g.Bt + (size_t)cur.pn * tstep;
    S.a_ready(cur);
    if constexpr (SP2) {
        PG8_STAGE(PG8_SB(0, 0), cB, voffB); PG8_STAGE(PG8_SB(0, 1), cB + hstep, voffB); PG8_STAGE(PG8_SA(0, 0), cA, voffA); PG8_STAGE(PG8_SA(0, 1), cA + hstep, voffA);
        if (wr == 1) PG8_BAR;
        PG8_WAIT_V(2); PG8_BAR;
        PG8_STAGE(PG8_SB(1, 0), cB + kstep, voffB); PG8_STAGE(PG8_SA(1, 0), cA + kstep, voffA); PG8_STAGE(PG8_SB(1, 1), cB + hstep + kstep, voffB);
        PG8_WAIT_V(6); PG8_BAR;
    } else {
        PG8_STAGE(PG8_SB(0, 0), cB, voffB); PG8_STAGE(PG8_SA(0, 0), cA, voffA); PG8_STAGE(PG8_SB(0, 1), cB + hstep, voffB); PG8_STAGE(PG8_SA(0, 1), cA + hstep, voffA);
        if (wr == 1) PG8_BAR;
        PG8_WAIT_V(4); PG8_BAR;
        PG8_STAGE(PG8_SB(1, 0), cB + kstep, voffB); PG8_STAGE(PG8_SA(1, 0), cA + kstep, voffA); PG8_STAGE(PG8_SB(1, 1), cB + hstep + kstep, voffB);
        PG8_WAIT_V(6); PG8_BAR;
    }
    for (;;) {
        const bool has_next = S.next(ui + 1, nxt);
        const char* nA = has_next ? (const char*)g.A + (size_t)nxt.pm * tstep : cA; const char* nB = has_next ? (const char*)g.Bt + (size_t)nxt.pn * tstep : cB;
        for (int t = 0; t < nt; t += 2) {
            const bool last = (t == nt - 2);
            const char* a1 = cA + (size_t)(t + 1) * kstep;
            const char* a2 = last ? nA : cA + (size_t)(t + 2) * kstep; const char* b2 = last ? nB : cB + (size_t)(t + 2) * kstep;
            const char* a3 = a2 + kstep; const char* b3 = b2 + kstep;
            if (last && has_next) S.a_ready(nxt);
            if constexpr (SP2) {
            PG8_LDB(B0, 0, 0); PG8_LDB(B1, 0, 1); PG8_SCHED; PG8_LDA(At, 0, 0); PG8_STAGE(PG8_SA(1, 1), a1 + hstep, voffA);
            PG8_WAIT_V(8); PG8_WAIT_L(0); PG8_BAR; PG8_MMA(0, 0, At, B0); PG8_MMA(0, 1, At, B1); PG8_BAR; PG8_SCHED;
            PG8_LDA(At, 0, 1); PG8_STAGE(PG8_SB(0, 0), b2, voffB); PG8_STAGE(PG8_SB(0, 1), b2 + hstep, voffB); PG8_STAGE(PG8_SA(0, 0), a2, voffA);
            PG8_WAIT_V(8); PG8_WAIT_L(0); PG8_BAR; PG8_MMA(1, 0, At, B0); PG8_MMA(1, 1, At, B1); PG8_BAR; PG8_SCHED;
            PG8_LDB(B0, 1, 0); PG8_LDB(B1, 1, 1); PG8_SCHED; PG8_LDA(At, 1, 0); PG8_STAGE(PG8_SA(0, 1), a2 + hstep, voffA);
            PG8_WAIT_V(8); PG8_WAIT_L(0); PG8_BAR; PG8_MMA(0, 0, At, B0); PG8_MMA(0, 1, At, B1); PG8_BAR; PG8_SCHED;
            PG8_LDA(At, 1, 1); PG8_STAGE(PG8_SB(1, 0), b3, voffB); PG8_STAGE(PG8_SB(1, 1), b3 + hstep, voffB); PG8_STAGE(PG8_SA(1, 0), a3, voffA);
            PG8_WAIT_V(8); PG8_WAIT_L(0); PG8_BAR; PG8_MMA(1, 0, At, B0); PG8_MMA(1, 1, At, B1); PG8_BAR; PG8_SCHED;
            } else {
            PG8_LDB(B0, 0, 0); PG8_SCHED; PG8_LDA(At, 0, 0); PG8_STAGE(PG8_SA(1, 1), a1 + hstep, voffA);
            PG8_WAIT_L(8); PG8_BAR; PG8_WAIT_L(0); PG8_MMA(0, 0, At, B0); PG8_BAR; PG8_SCHED;
            PG8_LDB(B1, 0, 1); PG8_STAGE(PG8_SB(0, 0), b2, voffB);
            PG8_BAR; PG8_WAIT_L(0); PG8_MMA(0, 1, At, B1); PG8_BAR;
            PG8_LDA(At, 0, 1); PG8_STAGE(PG8_SA(0, 0), a2, voffA);
            PG8_BAR; PG8_WAIT_L(0); PG8_MMA(1, 0, At, B0); PG8_BAR; PG8_SCHED;
            PG8_STAGE(PG8_SB(0, 1), b2 + hstep, voffB);
            PG8_WAIT_V(6); PG8_BAR; PG8_MMA(1, 1, At, B1); PG8_BAR;
            PG8_LDB(B0, 1, 0); PG8_SCHED; PG8_LDA(At, 1, 0); PG8_STAGE(PG8_SA(0, 1), a2 + hstep, voffA);
            PG8_WAIT_L(8); PG8_BAR; PG8_WAIT_L(0); PG8_MMA(0, 0, At, B0); PG8_BAR; PG8_SCHED;
            PG8_LDB(B1, 1, 1); PG8_STAGE(PG8_SB(1, 0), b3, voffB);
            PG8_BAR; PG8_WAIT_L(0); PG8_MMA(0, 1, At, B1); PG8_BAR;
            PG8_LDA(At, 1, 1); PG8_STAGE(PG8_SA(1, 0), a3, voffA);
            PG8_BAR; PG8_WAIT_L(0); PG8_MMA(1, 0, At, B0); PG8_BAR; PG8_SCHED;
            PG8_STAGE(PG8_SB(1, 1), b3 + hstep, voffB);
            PG8_WAIT_V(6); PG8_BAR; PG8_MMA(1, 1, At, B1); PG8_BAR;
            }
        }
        if constexpr (ALIGN_EPI) { if (wr == 0) PG8_BAR; }
        if constexpr (!Epi::AFTER_DRAIN) { E(acc, cur, wr, wc, fr, fq); S.done(cur); }
        if (!has_next) break;
#pragma unroll
        for (int a = 0; a < 2; ++a)
#pragma unroll
            for (int b = 0; b < 2; ++b)
#pragma unroll
                for (int m = 0; m < 4; ++m)
#pragma unroll
                    for (int n = 0; n < 2; ++n) acc[a][b][m][n] = (f32x4){0.f, 0.f, 0.f, 0.f};
        cur = nxt; cA = nA; cB = nB; ++ui;
        if constexpr (ALIGN_EPI) { if (wr == 1) PG8_BAR; }
    }
    PG8_WAIT_V(0);
    if constexpr (!ALIGN_EPI) { if (wr == 0) PG8_BAR; }
    PG8_BAR;
    if constexpr (Epi::AFTER_DRAIN) { E.fused(acc, cur, wr, wc, fr, fq, lds, wid, lane); S.done(cur); }
#undef PG8_SA
#undef PG8_SB
#undef PG8_STAGE
#undef PG8_LDA
#undef PG8_LDB
#undef PG8_MMA
#undef PG8_WAIT_V
#undef PG8_WAIT_L
#undef PG8_BAR
#undef PG8_SCHED
}
}
#define GAS __attribute__((address_space(1)))
#define LAS __attribute__((address_space(3)))
typedef GAS unsigned gu32;
typedef GAS unsigned long long gu64;
#define RLX_AGENT __ATOMIC_RELAXED, __HIP_MEMORY_SCOPE_AGENT
#define VM_WAIT() asm volatile("s_waitcnt vmcnt(0)" ::: "memory")
__device__ __forceinline__ unsigned long long rt() { return __builtin_amdgcn_s_memrealtime(); }
__device__ __forceinline__ unsigned f2bf(float f) { unsigned u = __builtin_bit_cast(unsigned, f); return (u + 0x7fffu + ((u >> 16) & 1u)) >> 16; }
__device__ __forceinline__ unsigned pk2(float lo, float hi) { return f2bf(lo) | (f2bf(hi) << 16); }

#define XB_TMO      128
#define XB_XCNT(j)  (256  + 64 * (j))
#define XB_XSUB(j)  (1280 + 64 * (j))
#define XB_XGEN(j)  (2304 + 64 * (j))
#define XB_TOP      3328
#define XB_TOPGEN   3392
#define XCD_BAR_WORDS 3456
#define XB_SPIN_CAP (1u << 18)

__device__ __forceinline__ unsigned xb_ld(unsigned* p)              { return __hip_atomic_load(p, __ATOMIC_RELAXED, __HIP_MEMORY_SCOPE_AGENT); }
__device__ __forceinline__ unsigned xb_add(unsigned* p, unsigned v) { return __hip_atomic_fetch_add(p, v, __ATOMIC_RELAXED, __HIP_MEMORY_SCOPE_AGENT); }
__device__ __forceinline__ unsigned xb_xcc_id() { return (unsigned)__builtin_amdgcn_s_getreg((3 << 11) | 20) & 0xFu; }
#define XB_SPIN(cond, bar) do { unsigned _sp = 0; while (cond) { __builtin_amdgcn_s_sleep(1); \
    if ((++_sp & 255u) == 0u) { if (xb_ld(&(bar)[XB_TMO])) break; if (_sp > XB_SPIN_CAP) { atomicAdd(&(bar)[XB_TMO], 1u); break; } } } } while (0)

struct XcdBarrier {
    unsigned* bar; unsigned x;
    volatile LAS unsigned* st;
};

__device__ __forceinline__ XcdBarrier xcd_barrier_post(unsigned* bar, volatile LAS unsigned* st) {
    XcdBarrier b; b.bar = bar; b.x = xb_xcc_id(); b.st = st;
    if (threadIdx.x == 0) (void)xb_add(&bar[XB_XCNT(b.x)], 1u);
    return b;
}
__device__ __forceinline__ void xcd_barrier_complete(unsigned* bar, unsigned x, unsigned& nloc, unsigned& nx) {
    const unsigned G = gridDim.x * gridDim.y * gridDim.z;
    unsigned sum, cnt, mine, sp = 0u;
    for (;;) {
        sum = 0u; cnt = 0u; mine = 0u;
#pragma unroll
        for (unsigned j = 0; j < 16; ++j) { const unsigned c = xb_ld(&bar[XB_XCNT(j)]); sum += c; cnt += (c > 0u) ? 1u : 0u; mine = (j == x) ? c : mine; }
        if (sum == G) break;
        __builtin_amdgcn_s_sleep(1);
        if ((++sp & 255u) == 0u) { if (xb_ld(&bar[XB_TMO])) break; if (sp > XB_SPIN_CAP) { atomicAdd(&bar[XB_TMO], 1u); break; } }
    }
    nloc = mine > 0u ? mine : 1u; nx = cnt > 0u ? cnt : 1u;
}

__device__ __forceinline__ void xcd_barrier(const XcdBarrier& b) {
    asm volatile("s_waitcnt vmcnt(0)" ::: "memory");
    __syncthreads();
    if (threadIdx.x == 0) {
        unsigned* bar = b.bar;
        __builtin_amdgcn_s_waitcnt(0);
        unsigned nloc = b.st[0], nx = b.st[1];
        if (nloc == 0u) { xcd_barrier_complete(bar, b.x, nloc, nx); b.st[0] = nloc; b.st[1] = nx; }
        const unsigned old = xb_add(&bar[XB_XSUB(b.x)], 1u);
        const unsigned gen = old / nloc;
        if (old + 1u == (gen + 1u) * nloc) {
            __builtin_amdgcn_fence(__ATOMIC_RELEASE, "agent");
            asm volatile("s_waitcnt vmcnt(0)" ::: "memory");
            const unsigned og = xb_add(&bar[XB_TOP], 1u);
            const unsigned tg = og / nx;
            if (og + 1u == (tg + 1u) * nx) xb_add(&bar[XB_TOPGEN], 1u);
            else XB_SPIN(xb_ld(&bar[XB_TOPGEN]) == tg, bar);
            __builtin_amdgcn_fence(__ATOMIC_ACQUIRE, "agent");
            xb_add(&bar[XB_XGEN(b.x)], 1u);
            asm volatile("s_waitcnt vmcnt(0)" ::: "memory");
        } else {
            XB_SPIN(xb_ld(&bar[XB_XGEN(b.x)]) == gen, bar);
            __builtin_amdgcn_fence(__ATOMIC_ACQUIRE, "agent");
            asm volatile("s_waitcnt vmcnt(0)" ::: "memory");
        }
    }
    __syncthreads();
}

using pg8::bf16_t; using pg8::bf16x8; using pg8::f32x4; using pg8::u32x4;
using pg8::DM; using pg8::MP; using pg8::MS; using pg8::MT; using pg8::DIN; using pg8::ZW;
using pg8::Z_GA; using pg8::Z_XB; using pg8::Z_GP; using pg8::Z_U; using pg8::Z_VS; using pg8::Z_GS; using pg8::LOG2E; using pg8::EPS;
typedef float f32x16 __attribute__((ext_vector_type(16)));
typedef unsigned u32x2 __attribute__((ext_vector_type(2)));

constexpr int NWAVES = 8, NTHREADS = 512;
constexpr int LDS_BYTES = 147456;
constexpr int RING_OFF = 1024;

constexpr size_t O_YP = 0, O_YS = 33554432, O_KP = 34603008, O_VP = 35127296, O_PP = 35651584, O_KS = 35774464, O_VS = 44163072, O_PS = 52551680, O_CV = 54517760, O_END = 55042048;
constexpr size_t LS_KP = 262144, LS_PP = 61440, LS_KS = 4194304, LS_PS = 983040, LS_CV = 262144;
constexpr size_t MiB = 1u << 20;
constexpr size_t WS_CTL = 0, CTL_ZERO_BYTES = 65536;
constexpr size_t WS_ROPE = 1 * MiB, WS_SGUW = 2 * MiB, WS_PWT = 2 * MiB + 512 * 1024;
constexpr size_t WS_WTIN = 4 * MiB, WS_WTOUT = 44 * MiB, WS_H = 60 * MiB, WS_MIX = 126 * MiB, WS_QC = 192 * MiB, WS_KC = 225 * MiB, WS_VTP = 233 * MiB, WS_Z2 = 241 * MiB, WS_Y = 357 * MiB, WS_END = 489 * MiB;
constexpr int CW_BAR = 1024;

__constant__ double ROPE_INV[32] = {1.0, 0.7498942093324559, 0.5623413251903491, 0.4216965034285822, 0.31622776601683794, 0.23713737056616552, 0.1778279410038923, 0.1333521432163324, 0.1, 0.07498942093324558, 0.05623413251903491, 0.042169650342858224, 0.03162277660168379, 0.023713737056616554, 0.01778279410038923, 0.01333521432163324, 0.01, 0.007498942093324558, 0.005623413251903491, 0.004216965034285823, 0.0031622776601683794, 0.0023713737056616554, 0.0017782794100389228, 0.001333521432163324, 0.001, 0.0007498942093324559, 0.0005623413251903491, 0.00042169650342858224, 0.00031622776601683794, 0.00023713737056616554, 0.00017782794100389227, 0.0001333521432163324};

struct Args { const float* in[16]; float* out; unsigned char* ws; };

struct Frame {
    int tid, lane, wave, bid, G;
    const float *xp, *xs, *cache_k, *cache_v, *state_pool, *w_in, *w_out, *norm_pre, *norm_post, *sinks, *pool_w, *pool_scale, *ln_g, *ln_b, *sgu_w, *sgu_b;
    float* out;
    float* rope; bf16_t *SGUW, *PWT, *WTIN, *WTOUT, *H, *MIX, *Qc, *Kc, *VTP, *Z2; float* Y;
};

__device__ __forceinline__ float wave_sum(float v) {
#pragma unroll
    for (int o = 1; o < 64; o <<= 1) v += __shfl_xor(v, o);
    return v;
}
__device__ __forceinline__ float wave_max(float v) {
#pragma unroll
    for (int o = 1; o < 64; o <<= 1) v = fmaxf(v, __shfl_xor(v, o));
    return v;
}
__device__ __forceinline__ float bflo(unsigned w) { return __uint_as_float(w << 16); }
__device__ __forceinline__ float bfhi(unsigned w) { return __uint_as_float(w & 0xffff0000u); }
__device__ __forceinline__ void unpack8(const u32x4 w, float (&f)[8]) { f[0] = bflo(w.x); f[1] = bfhi(w.x); f[2] = bflo(w.y); f[3] = bfhi(w.y); f[4] = bflo(w.z); f[5] = bfhi(w.z); f[6] = bflo(w.w); f[7] = bfhi(w.w); }
__device__ __forceinline__ void unpack4(const u32x2 w, float (&f)[4]) { f[0] = bflo(w.x); f[1] = bfhi(w.x); f[2] = bflo(w.y); f[3] = bfhi(w.y); }
__device__ __forceinline__ u32x4 pack8(const float (&f)[8]) { u32x4 w; w.x = pg8::cvt_pk_bf16(f[0], f[1]); w.y = pg8::cvt_pk_bf16(f[2], f[3]); w.z = pg8::cvt_pk_bf16(f[4], f[5]); w.w = pg8::cvt_pk_bf16(f[6], f[7]); return w; }
__device__ __forceinline__ int crow(int r, int hi) { return (r & 3) + 8 * (r >> 2) + 4 * hi; }
#define LDS_WAIT() asm volatile("s_waitcnt lgkmcnt(0)" ::: "memory")


struct ArgsG { const __attribute__((address_space(1))) float* in[16]; __attribute__((address_space(1))) float* out; __attribute__((address_space(1))) unsigned char* ws; };
typedef const __attribute__((address_space(4))) ArgsG* KArgs;
__device__ __forceinline__ KArgs kargs() { KArgs p = (KArgs)__builtin_amdgcn_kernarg_segment_ptr(); asm volatile("" : "+s"(p)); return p; }
__device__ __forceinline__ void make_frame(Frame& F, KArgs a) {
    { int t_ = threadIdx.x; asm volatile("" : "+v"(t_)); F.tid = t_; } F.lane = F.tid & 63; F.wave = __builtin_amdgcn_readfirstlane(F.tid >> 6); F.bid = blockIdx.x; F.G = gridDim.x;
    F.xp = (const float*)a->in[0]; F.xs = (const float*)a->in[1]; F.cache_k = (const float*)a->in[2]; F.cache_v = (const float*)a->in[3]; F.state_pool = (const float*)a->in[4]; F.w_in = (const float*)a->in[5]; F.w_out = (const float*)a->in[6]; F.norm_pre = (const float*)a->in[7]; F.norm_post = (const float*)a->in[8];
    F.sinks = (const float*)a->in[9]; F.pool_w = (const float*)a->in[10]; F.pool_scale = (const float*)a->in[11]; F.ln_g = (const float*)a->in[12]; F.ln_b = (const float*)a->in[13]; F.sgu_w = (const float*)a->in[14]; F.sgu_b = (const float*)a->in[15];
    F.out = (float*)a->out;
    unsigned char* ws = (unsigned char*)a->ws;
    F.rope = (float*)(ws + WS_ROPE); F.SGUW = (bf16_t*)(ws + WS_SGUW); F.PWT = (bf16_t*)(ws + WS_PWT); F.WTIN = (bf16_t*)(ws + WS_WTIN); F.WTOUT = (bf16_t*)(ws + WS_WTOUT);
    F.H = (bf16_t*)(ws + WS_H); F.MIX = (bf16_t*)(ws + WS_MIX); F.Qc = (bf16_t*)(ws + WS_QC); F.Kc = (bf16_t*)(ws + WS_KC); F.VTP = (bf16_t*)(ws + WS_VTP); F.Z2 = (bf16_t*)(ws + WS_Z2); F.Y = (float*)(ws + WS_Y);
}

#define LOCAL_FRAME Frame F; make_frame(F, kargs())

#ifndef PROBE_SEL
#define PROBE_SEL 0
#endif
#if PROBE_SEL
#define STAMP(k) do { if (blockIdx.x == 0 && threadIdx.x == 0) ((LAS unsigned long long*)(L + 256))[k] = __builtin_amdgcn_s_memrealtime(); } while (0)
#define STAMP2(k) do { if (blockIdx.x == 0) { __syncthreads(); if (threadIdx.x == 0) ((LAS unsigned long long*)((LAS unsigned char*)ring - RING_OFF + 256))[k] = __builtin_amdgcn_s_memrealtime(); } } while (0)
#else
#define STAMP(k) do {} while (0)
#define STAMP2(k) do {} while (0)
#endif
#if PROBE_SEL == 1
#define PA0 0
#define PA1 1
#define PB0 1
#define PB1 2
#elif PROBE_SEL == 2
#define PA0 2
#define PA1 3
#define PB0 3
#define PB1 4
#elif PROBE_SEL == 3
#define PA0 4
#define PA1 5
#define PB0 8
#define PB1 9
#elif PROBE_SEL == 4
#define PA0 2
#define PA1 10
#define PB0 10
#define PB1 11
#elif PROBE_SEL == 5
#define PA0 11
#define PA1 12
#define PB0 12
#define PB1 13
#elif PROBE_SEL == 6
#define PA0 5
#define PA1 6
#define PB0 7
#define PB1 8
#endif

__device__ __forceinline__ void p0_transpose(const float* W, int K, int N, bf16_t* WT, bool permqk, LAS float* scr, int item, int lane) {
    const int nblk = N >> 6, kb = item / nblk, nb = item - kb * nblk, k0 = kb * 64, n0 = nb * 64;
#pragma unroll
    for (int i = 0; i < 16; ++i) { const int kk = 4 * i + (lane >> 4), nn = 4 * (lane & 15);
        const f32x4 v = *(const f32x4*)(W + (size_t)(k0 + kk) * N + n0 + nn); *(LAS f32x4*)(scr + kk * 68 + nn) = v; }
    LDS_WAIT();
    const int n = n0 + lane; int nrow = n;
    if (permqk && n < 1280) { const int p = n & 63; nrow = (n & ~63) + 2 * (p & 31) + (p >> 5); }
    bf16_t* dst = WT + (size_t)nrow * K + k0;
#pragma unroll
    for (int c = 0; c < 8; ++c) { float f[8];
#pragma unroll
        for (int j = 0; j < 8; ++j) f[j] = scr[(8 * c + j) * 68 + lane];
        *(u32x4*)(dst + 8 * c) = pack8(f); }
    LDS_WAIT();
}
__device__ __forceinline__ void prenorm_row(const float* xrow, const float* g, bf16_t* hrow, int lane) {
    f32x4 v[8]; float ss = 0.f;
#pragma unroll
    for (int j = 0; j < 8; ++j) { v[j] = *(const f32x4*)(xrow + 4 * lane + 256 * j); ss += (v[j][0] * v[j][0] + v[j][1] * v[j][1]) + (v[j][2] * v[j][2] + v[j][3] * v[j][3]); }
    ss = wave_sum(ss);
    const float r = rsqrtf(ss * (1.0f / 2048.0f) + EPS);
#pragma unroll
    for (int j = 0; j < 8; ++j) { const f32x4 gg = *(const f32x4*)(g + 4 * lane + 256 * j); const f32x4 o = v[j] * r * gg;
        u32x2 w; w.x = pg8::cvt_pk_bf16(o[0], o[1]); w.y = pg8::cvt_pk_bf16(o[2], o[3]); *(u32x2*)(hrow + 4 * lane + 256 * j) = w; }
}
__device__ __forceinline__ void p0_prologue(const Frame& F, LAS unsigned char* ring) {
    LAS float* scr = (LAS float*)(ring + F.wave * 17408);
    const int gw = F.bid * NWAVES + F.wave, NGW = F.G * NWAVES;
    constexpr int I_IN = 32 * 80, I_OUT = 32 * 32, NITEMS = 2 * (I_IN + I_OUT);
    for (int it = gw; it < NITEMS; it += NGW) {
        int r = it;
        if (r < 2 * I_IN) { const int l = r / I_IN; r -= l * I_IN; p0_transpose(F.w_in + (size_t)l * DM * DIN, DM, DIN, F.WTIN + (size_t)l * DIN * DM, true, scr, r, F.lane); }
        else { r -= 2 * I_IN; const int l = r / I_OUT; r -= l * I_OUT; p0_transpose(F.w_out + (size_t)l * DM * DM, DM, DM, F.WTOUT + (size_t)l * DM * DM, false, scr, r, F.lane); }
    }
    for (int m = gw; m < MT; m += NGW) { const float* xr = m < MP ? F.xp + (size_t)m * DM : F.xs + (size_t)(m - MP) * DM; prenorm_row(xr, F.norm_pre, F.H + (size_t)m * DM, F.lane); }
    const int gt = F.bid * NTHREADS + F.tid, NGT = F.G * NTHREADS;
    for (int e = gt; e < 2052 * 32; e += NGT) { const int tp = e >> 5, i = e & 31; const double pos = (double)(tp < 2048 ? tp : 8192 + (tp - 2048));
        const double rev = pos * ROPE_INV[i] * 0.15915494309189535; const float fr = (float)(rev - floor(rev));
        F.rope[tp * 64 + i] = __builtin_amdgcn_cosf(fr); F.rope[tp * 64 + 32 + i] = __builtin_amdgcn_sinf(fr); }
    for (int e = gt; e < 2 * 4 * 128 * 128; e += NGT) { const int s = e & 127, t = (e >> 7) & 127; const float w = F.sgu_w[e];
        F.SGUW[e] = (bf16_t)(pg8::cvt_pk_bf16(s <= t ? w : 0.f, 0.f) & 0xffffu); }
    for (int e = gt; e < 2 * 4 * 128 * 128; e += NGT) { const int c = e & 127, d = (e >> 7) & 127, lg = e >> 14;
        F.PWT[e] = (bf16_t)(pg8::cvt_pk_bf16(F.pool_w[((size_t)lg * 128 + c) * 128 + d], 0.f) & 0xffffu); }
}

constexpr int AT_K = 0, AT_V = 49152, AT_STG = 98304, AT_WSTRIDE = 4352;
__device__ __forceinline__ void attn_stage_kv(const Frame& F, int b, int kvh, int nbp, LAS unsigned char* ring) {
    const int tid = F.tid;
    const bf16_t* kg = F.Kc + ((size_t)(b * 4 + kvh) * 2048 + 256 * nbp - 128) * 64;
    const bf16_t* vg = F.VTP + ((size_t)(b * 4 + kvh) * 64 + 8 * nbp - 4) * 2048;
    u32x4 kv[6], vv[6];
#pragma unroll
    for (int i = 0; i < 6; ++i) { const int ch = tid + 512 * i, row0 = ch >> 3, c8 = ch & 7, row = (nbp > 0 || row0 >= 128) ? row0 : row0 + 128;
        kv[i] = *(const u32x4*)(kg + row * 64 + c8 * 8); }
#pragma unroll
    for (int i = 0; i < 6; ++i) { const int ch = tid + 512 * i, tile0 = ch >> 8, rem = ch & 255, d = rem >> 2, c4 = rem & 3, tile = (nbp > 0 || tile0 >= 4) ? tile0 : tile0 + 4;
        vv[i] = *(const u32x4*)(vg + tile * 2048 + d * 32 + c4 * 8); }
#pragma unroll
    for (int i = 0; i < 6; ++i) { const int ch = tid + 512 * i, row = ch >> 3, c8 = ch & 7;
        *(LAS u32x4*)(ring + AT_K + row * 128 + ((c8 ^ (row & 7)) << 4)) = kv[i]; }
#pragma unroll
    for (int i = 0; i < 6; ++i) { const int ch = tid + 512 * i, tile = ch >> 8, rem = ch & 255, d = rem >> 2, c4 = rem & 3;
        *(LAS u32x4*)(ring + AT_V + tile * 4096 + d * 64 + ((c4 ^ ((d >> 2) & 3)) << 4)) = vv[i]; }
}
__device__ __forceinline__ void attn_task(const Frame& F, int l, int b, int nbp, int head, int j, const bf16x8 (&qf)[4], LAS unsigned char* ring) {
    const int lane = F.lane, r = lane & 31, hh = lane >> 5;
    LAS unsigned char* wl = ring + AT_STG + F.wave * AT_WSTRIDE;
    LAS float* wsf = (LAS float*)wl; LAS bf16_t* stg = (LAS bf16_t*)(wl + 256);
    const size_t qrow0 = (size_t)b * 2048 + 256 * nbp + 32 * j;
    u32x4 gv[4];
#pragma unroll
    for (int i = 0; i < 4; ++i) gv[i] = *(const u32x4*)(F.Z2 + (qrow0 + i * 8 + (lane >> 3)) * ZW + Z_GA + head * 64 + (lane & 7) * 8);
    const int cmin = (nbp > 0) ? 0 : (j < 4 ? 4 - j : 0);
    f32x16 S[5];
#pragma unroll
    for (int c = 0; c < 5; ++c) {
        f32x16 a;
#pragma unroll
        for (int i = 0; i < 16; ++i) a[i] = 0.f;
        if (c >= cmin) {
            LAS unsigned char* kp = ring + AT_K + (32 * (j + c) + r) * 128;
#pragma unroll
            for (int s = 0; s < 4; ++s) a = __builtin_amdgcn_mfma_f32_32x32x16_bf16(*(const LAS bf16x8*)(kp + (((2 * s + hh) ^ (r & 7)) << 4)), qf[s], a, 0, 0, 0);
        }
        S[c] = a;
    }
    const float NEG = -INFINITY;
#pragma unroll
    for (int i = 0; i < 16; ++i) { const int kap = crow(i, hh); if (kap <= r) S[0][i] = NEG; if (kap > r) S[4][i] = NEG; }
    const float sink2 = F.sinks[l * 16 + head] * LOG2E;
    float m = sink2;
#pragma unroll
    for (int c = 0; c < 5; ++c) if (c >= cmin) {
#pragma unroll
        for (int i = 0; i < 16; ++i) m = fmaxf(m, S[c][i]); }
    m = fmaxf(m, __shfl_xor(m, 32));
    float sum = 0.f;
#pragma unroll
    for (int c = 0; c < 5; ++c) if (c >= cmin) {
#pragma unroll
        for (int i = 0; i < 16; ++i) { const float p = __builtin_amdgcn_exp2f(S[c][i] - m); S[c][i] = p; sum += p; } }
    sum += __shfl_xor(sum, 32);
    const float inv = 1.0f / (sum + __builtin_amdgcn_exp2f(sink2 - m));
    f32x16 o[2];
#pragma unroll
    for (int i = 0; i < 16; ++i) { o[0][i] = 0.f; o[1][i] = 0.f; }
#pragma unroll
    for (int c = 0; c < 5; ++c) if (c >= cmin) {
        LAS unsigned char* vt = ring + AT_V + (j + c) * 4096 + r * 64;
#pragma unroll
        for (int s = 0; s < 2; ++s) {
            u32x4 pw; pw.x = pg8::cvt_pk_bf16(S[c][8 * s + 0], S[c][8 * s + 1]); pw.y = pg8::cvt_pk_bf16(S[c][8 * s + 2], S[c][8 * s + 3]);
            pw.z = pg8::cvt_pk_bf16(S[c][8 * s + 4], S[c][8 * s + 5]); pw.w = pg8::cvt_pk_bf16(S[c][8 * s + 6], S[c][8 * s + 7]);
            const bf16x8 pa = __builtin_bit_cast(bf16x8, pw);
            const int sw = (((2 * hh + s) ^ ((r >> 2) & 3)) << 4);
#pragma unroll
            for (int db = 0; db < 2; ++db) o[db] = __builtin_amdgcn_mfma_f32_32x32x16_bf16(pa, *(const LAS bf16x8*)(vt + db * 2048 + sw), o[db], 0, 0, 0);
        }
    }
    if (hh == 0) wsf[r] = inv;
    LDS_WAIT();
#pragma unroll
    for (int i = 0; i < 16; ++i) { const int q = crow(i, hh); const float rl = wsf[q];
        stg[q * 64 + r] = (bf16_t)(pg8::cvt_pk_bf16(o[0][i] * rl, 0.f) & 0xffffu);
        stg[q * 64 + 32 + r] = (bf16_t)(pg8::cvt_pk_bf16(o[1][i] * rl, 0.f) & 0xffffu); }
    LDS_WAIT();
#pragma unroll
    for (int i = 0; i < 4; ++i) { const int row = i * 8 + (lane >> 3), ch = lane & 7;
        const u32x4 ov = *(const LAS u32x4*)(stg + row * 64 + ch * 8);
        float of[8], gf[8]; unpack8(ov, of); unpack8(gv[i], gf);
#pragma unroll
        for (int jj = 0; jj < 8; ++jj) of[jj] *= gf[jj];
        *(u32x4*)(F.MIX + (qrow0 + row) * DM + head * 64 + ch * 8) = pack8(of); }
    LDS_WAIT();
}
__device__ __forceinline__ void attn_unit(int l, int a, LAS unsigned char* ring) {
    LOCAL_FRAME;
    const int kvh = a & 3, nbp = (a >> 2) & 7, b = a >> 5;
    const int lane = F.lane, r = lane & 31, hh = lane >> 5;
    const int head = 4 * kvh + (F.wave >> 1), j0 = 4 * (F.wave & 1);
    const bf16_t* qp = F.Qc + ((size_t)b * 2048 + 256 * nbp + 32 * j0 + r) * 1024 + head * 64 + 8 * hh;
    bf16x8 qa[4], qb[4];
#pragma unroll
    for (int s = 0; s < 4; ++s) qa[s] = *(const bf16x8*)(qp + 16 * s);
#ifdef EXP_ZERO_LDS
    for (int e = F.tid; e < 134144 / 16; e += NTHREADS) *(LAS u32x4*)(ring + 16 * e) = (u32x4){0u, 0u, 0u, 0u};
    LDS_WAIT(); __syncthreads();
#endif
    attn_stage_kv(F, b, kvh, nbp, ring);
    LDS_WAIT();
    __syncthreads();
#pragma unroll
    for (int s = 0; s < 4; ++s) qb[s] = *(const bf16x8*)(qp + 32 * 1024 + 16 * s);
    attn_task(F, l, b, nbp, head, j0 + 0, qa, ring);
#pragma unroll
    for (int s = 0; s < 4; ++s) qa[s] = *(const bf16x8*)(qp + 64 * 1024 + 16 * s);
    attn_task(F, l, b, nbp, head, j0 + 1, qb, ring);
#pragma unroll
    for (int s = 0; s < 4; ++s) qb[s] = *(const bf16x8*)(qp + 96 * 1024 + 16 * s);
    attn_task(F, l, b, nbp, head, j0 + 2, qa, ring);
    attn_task(F, l, b, nbp, head, j0 + 3, qb, ring);
    __syncthreads();
}

template <bool SAMPLE, int G>
__device__ __forceinline__ void pool_unit(int l, int tile) {
    LOCAL_FRAME;
    constexpr int W = 2 << G;
    const int lane = F.lane, r = lane & 31, hh = lane >> 5;
    const size_t row = (size_t)(SAMPLE ? MP : 0) + 32 * tile + r;
    const int t = SAMPLE ? (int)(row & 3) : (int)(row & 2047);
    const int bd = SAMPLE ? (int)((row - MP) >> 2) : 0;
    const float icnt = SAMPLE ? 1.0f / (float)W : 1.0f / (float)(W < t + 1 ? W : t + 1);
    bf16x8 bfr[8];
#pragma unroll
    for (int s = 0; s < 8; ++s) {
        const int c0 = 128 * G + 16 * s + 8 * hh;
        float sum[8];
        if (!SAMPLE) {
            u32x4 x[W];
#pragma unroll
            for (int i = 0; i < W; ++i) { const int back = i <= t ? i : t;
                x[i] = *(const u32x4*)(F.Z2 + (row - back) * ZW + Z_XB + c0); }
            float cur[8]; unpack8(x[0], cur);
#pragma unroll
            for (int jj = 0; jj < 8; ++jj) sum[jj] = cur[jj];
#pragma unroll
            for (int i = 1; i < W; ++i) { float f[8]; unpack8(x[i], f); const float wgt = i <= t ? 1.f : 0.f;
#pragma unroll
                for (int jj = 0; jj < 8; ++jj) sum[jj] += wgt * f[jj]; }
#pragma unroll
            for (int jj = 0; jj < 8; ++jj) sum[jj] = sum[jj] * icnt - cur[jj];
        } else {
            float cur[8];
#pragma unroll
            for (int jj = 0; jj < 8; ++jj) { sum[jj] = 0.f; cur[jj] = 0.f; }
#pragma unroll 1
            for (int i = 0; i < W; ++i) { float f[8]; const int e = t - i;
                if (e >= 0) unpack8(*(const u32x4*)(F.Z2 + (row - i) * ZW + Z_XB + c0), f);
                else { const float* sp = F.state_pool + (((size_t)l * 128 + bd) * 15 + 15 + e) * 512 + c0;
                    const f32x4 a = *(const f32x4*)sp, bq = *(const f32x4*)(sp + 4); f[0] = a[0]; f[1] = a[1]; f[2] = a[2]; f[3] = a[3]; f[4] = bq[0]; f[5] = bq[1]; f[6] = bq[2]; f[7] = bq[3]; }
#pragma unroll
                for (int jj = 0; jj < 8; ++jj) sum[jj] += f[jj];
                if (i == 0) {
#pragma unroll
                    for (int jj = 0; jj < 8; ++jj) cur[jj] = f[jj]; } }
#pragma unroll
            for (int jj = 0; jj < 8; ++jj) sum[jj] = sum[jj] * icnt - cur[jj];
        }
        bfr[s] = __builtin_bit_cast(bf16x8, pack8(sum));
    }
    f32x16 acc[4];
#pragma unroll
    for (int db = 0; db < 4; ++db) {
#pragma unroll
        for (int i = 0; i < 16; ++i) acc[db][i] = 0.f;
        const bf16_t* ap = F.PWT + ((size_t)(l * 4 + G) * 128 + 32 * db + r) * 128 + 8 * hh;
#pragma unroll
        for (int s = 0; s < 8; ++s) acc[db] = __builtin_amdgcn_mfma_f32_32x32x16_bf16(*(const bf16x8*)(ap + 16 * s), bfr[s], acc[db], 0, 0, 0);
        __builtin_amdgcn_sched_barrier(0);
    }
#pragma unroll
    for (int db = 0; db < 4; ++db)
#pragma unroll
        for (int q = 0; q < 4; ++q) {
            const int col = 128 * G + 32 * db + 8 * q + 4 * hh;
            const f32x4 sc = *(const f32x4*)(F.pool_scale + l * 512 + col);
            float gf[4]; unpack4(*(const u32x2*)(F.Z2 + row * ZW + Z_GP + col), gf);
            u32x2 wv; wv.x = pg8::cvt_pk_bf16(acc[db][4 * q + 0] * sc[0] * gf[0], acc[db][4 * q + 1] * sc[1] * gf[1]);
            wv.y = pg8::cvt_pk_bf16(acc[db][4 * q + 2] * sc[2] * gf[2], acc[db][4 * q + 3] * sc[3] * gf[3]);
            *(u32x2*)(F.MIX + row * DM + 1024 + col) = wv;
        }
}
template <bool SAMPLE>
__device__ __forceinline__ void pool_dispatch(int l, int g, int tile) {
    if (g == 0) pool_unit<SAMPLE, 0>(l, tile); else if (g == 1) pool_unit<SAMPLE, 1>(l, tile); else if (g == 2) pool_unit<SAMPLE, 2>(l, tile); else pool_unit<SAMPLE, 3>(l, tile);
}

__device__ __forceinline__ void sgu_unit(int l, int ci, int hp, LAS unsigned char* ring) {
    LOCAL_FRAME;
    LAS bf16_t* VnT = (LAS bf16_t*)ring;
    const int lane = F.lane, wv = F.wave;
    const size_t R0 = (size_t)128 * ci;
    {
        const int tl = lane >> 2, q4 = lane & 3;
        const bf16_t* vrow = F.Z2 + (R0 + 16 * wv + tl) * ZW + Z_VS + 32 * q4;
        u32x4 x[4][4];
#pragma unroll
        for (int h = 0; h < 4; ++h)
#pragma unroll
            for (int i = 0; i < 4; ++i) x[h][i] = *(const u32x4*)(vrow + 128 * h + 8 * i);
        float s = 0.f, ss = 0.f;
#pragma unroll
        for (int h = 0; h < 4; ++h)
#pragma unroll
            for (int i = 0; i < 4; ++i) { float f[8]; unpack8(x[h][i], f);
#pragma unroll
                for (int jj = 0; jj < 8; ++jj) { s += f[jj]; ss += f[jj] * f[jj]; } }
        s += __shfl_xor(s, 1); s += __shfl_xor(s, 2); ss += __shfl_xor(ss, 1); ss += __shfl_xor(ss, 2);
        const float mean = s * (1.0f / 512.0f), var = ss * (1.0f / 512.0f) - mean * mean, rstd = rsqrtf(var + EPS);
#pragma unroll
        for (int h2 = 0; h2 < 2; ++h2) {
            const int hd = 2 * hp + h2;
#pragma unroll
            for (int i = 0; i < 4; ++i) { const int d = 32 * q4 + 8 * i;
                const u32x4 xv = hp ? x[2 + h2][i] : x[h2][i];
                float f[8]; unpack8(xv, f);
                const float* gp = F.ln_g + l * 512 + 128 * hd + d; const float* bp = F.ln_b + l * 512 + 128 * hd + d;
                const f32x4 g0 = *(const f32x4*)gp, g1 = *(const f32x4*)(gp + 4), b0 = *(const f32x4*)bp, b1 = *(const f32x4*)(bp + 4);
#pragma unroll
                for (int jj = 0; jj < 8; ++jj) { const float gg = jj < 4 ? g0[jj & 3] : g1[jj & 3], bb = jj < 4 ? b0[jj & 3] : b1[jj & 3];
                    const float vn = (f[jj] - mean) * rstd * gg + bb;
                    VnT[(h2 * 128 + d + jj) * 136 + 16 * wv + tl] = (bf16_t)(pg8::cvt_pk_bf16(vn, 0.f) & 0xffffu); } }
        }
    }
    LDS_WAIT();
    __syncthreads();
    {
        const int r = lane & 31, hh = lane >> 5, db = wv & 3; const int tbA = (wv >> 2) ? 1 : 0, tbB = (wv >> 2) ? 2 : 3;
#pragma unroll
        for (int h2 = 0; h2 < 2; ++h2) {
            const int hd = 2 * hp + h2;
            const bf16_t* Wb = F.SGUW + (size_t)(l * 4 + hd) * 128 * 128;
            bf16x8 wB[8], wA[4];
#pragma unroll
            for (int s = 0; s < 8; ++s) { wB[s] = (bf16x8){0, 0, 0, 0, 0, 0, 0, 0}; if (s < 2 * (tbB + 1)) wB[s] = *(const bf16x8*)(Wb + (32 * tbB + r) * 128 + 16 * s + 8 * hh); }
#pragma unroll
            for (int s = 0; s < 4; ++s) { wA[s] = (bf16x8){0, 0, 0, 0, 0, 0, 0, 0}; if (s < 2 * (tbA + 1)) wA[s] = *(const bf16x8*)(Wb + (32 * tbA + r) * 128 + 16 * s + 8 * hh); }
            u32x2 uu[2][4], gg[2][4]; float bias[2];
#pragma unroll
            for (int pass = 0; pass < 2; ++pass) { const int tb = pass ? tbB : tbA; const size_t row = R0 + 32 * tb + r; bias[pass] = F.sgu_b[l * 512 + hd * 128 + 32 * tb + r];
#pragma unroll
                for (int q = 0; q < 4; ++q) { const int col = 128 * hd + 32 * db + 8 * q + 4 * hh;
                    uu[pass][q] = *(const u32x2*)(F.Z2 + row * ZW + Z_U + col); gg[pass][q] = *(const u32x2*)(F.Z2 + row * ZW + Z_GS + col); } }
            f32x16 accA, accB;
#pragma unroll
            for (int i = 0; i < 16; ++i) { accA[i] = 0.f; accB[i] = 0.f; }
#pragma unroll
            for (int s = 0; s < 8; ++s) {
                if (s < 2 * (tbB + 1)) {
                    const bf16x8 a = *(const LAS bf16x8*)(VnT + (h2 * 128 + 32 * db + r) * 136 + 16 * s + 8 * hh);
                    accB = __builtin_amdgcn_mfma_f32_32x32x16_bf16(a, wB[s], accB, 0, 0, 0);
                    if (s < 4) { if (s < 2 * (tbA + 1)) accA = __builtin_amdgcn_mfma_f32_32x32x16_bf16(a, wA[s], accA, 0, 0, 0); }
                }
            }
#pragma unroll
            for (int pass = 0; pass < 2; ++pass) {
                const int tb = pass ? tbB : tbA; const f32x16 acc = pass ? accB : accA;
                const size_t row = R0 + 32 * tb + r; const float bs = bias[pass];
#pragma unroll
                for (int q = 0; q < 4; ++q) { const int col = 128 * hd + 32 * db + 8 * q + 4 * hh;
                    float uf[4], gf[4]; unpack4(uu[pass][q], uf); unpack4(gg[pass][q], gf);
                    u32x2 wo; wo.x = pg8::cvt_pk_bf16((acc[4 * q + 0] + bs) * uf[0] * gf[0], (acc[4 * q + 1] + bs) * uf[1] * gf[1]);
                    wo.y = pg8::cvt_pk_bf16((acc[4 * q + 2] + bs) * uf[2] * gf[2], (acc[4 * q + 3] + bs) * uf[3] * gf[3]);
                    *(u32x2*)(F.MIX + row * DM + 1536 + col) = wo; }
            }
        }
    }
    __syncthreads();
}

__device__ __forceinline__ void samp_attn(int l, int bd, int kvh, LAS unsigned char* wl) {
    LOCAL_FRAME;
    LAS float* ps = (LAS float*)wl;
    LAS float* invs = ps + 144 * 16;
    const int lane = F.lane, fr = lane & 15, fq = lane >> 4, gq = fr >> 2, tt = fr & 3;
    float* oKs = F.out + O_KS + (size_t)l * LS_KS; float* oVs = F.out + O_VS + (size_t)l * LS_KS;
    bf16x8 qfr[2];
    {
        const bf16_t* qsrc = F.Qc + ((size_t)MP + 4 * bd + tt) * 1024 + (4 * kvh + gq) * 64 + 16 * fq;
        const u32x4 qa = *(const u32x4*)qsrc, qb = *(const u32x4*)(qsrc + 8);
        u32x4 lo, hi;
        lo.x = (qa.x & 0xffffu) | (qa.y << 16); lo.y = (qa.z & 0xffffu) | (qa.w << 16); lo.z = (qb.x & 0xffffu) | (qb.y << 16); lo.w = (qb.z & 0xffffu) | (qb.w << 16);
        hi.x = (qa.x >> 16) | (qa.y & 0xffff0000u); hi.y = (qa.z >> 16) | (qa.w & 0xffff0000u); hi.z = (qb.x >> 16) | (qb.y & 0xffff0000u); hi.w = (qb.z >> 16) | (qb.w & 0xffff0000u);
        qfr[0] = __builtin_bit_cast(bf16x8, lo); qfr[1] = __builtin_bit_cast(bf16x8, hi);
    }
    const float* kc = F.cache_k + (((size_t)l * 128 + bd) * 128) * 256 + kvh * 64 + 8 * fq;
    const float* kn = oKs + (((size_t)bd * 128 + 124 + (fr & 3)) * 4 + kvh) * 64 + 8 * fq;
    float* kd = oKs + ((size_t)bd * 128 * 4 + kvh) * 64 + 8 * fq;
    f32x4 S[9];
#pragma unroll
    for (int T = 0; T < 9; ++T) S[T] = (f32x4){0.f, 0.f, 0.f, 0.f};
#pragma unroll
    for (int T0 = 0; T0 < 9; T0 += 3) {
        f32x4 x[3][2][2];
#pragma unroll
        for (int u = 0; u < 3; ++u) { const int T = T0 + u; const float* src = (T < 8) ? kc + (size_t)(16 * T + fr) * 256 : kn;
#pragma unroll
            for (int ks = 0; ks < 2; ++ks) { x[u][ks][0] = *(const f32x4*)(src + 32 * ks); x[u][ks][1] = *(const f32x4*)(src + 32 * ks + 4); } }
#pragma unroll
        for (int u = 0; u < 3; ++u) { const int T = T0 + u; const int key = 16 * T + fr;
            if (T < 8 && key >= 4) {
#pragma unroll
                for (int ks = 0; ks < 2; ++ks) { float* dst = kd + (size_t)(key - 4) * 256 + 32 * ks; *(f32x4*)dst = x[u][ks][0]; *(f32x4*)(dst + 4) = x[u][ks][1]; } } }
#pragma unroll
        for (int u = 0; u < 3; ++u)
#pragma unroll
            for (int ks = 0; ks < 2; ++ks) { u32x4 w; w.x = pg8::cvt_pk_bf16(x[u][ks][0][0], x[u][ks][0][1]); w.y = pg8::cvt_pk_bf16(x[u][ks][0][2], x[u][ks][0][3]);
                w.z = pg8::cvt_pk_bf16(x[u][ks][1][0], x[u][ks][1][1]); w.w = pg8::cvt_pk_bf16(x[u][ks][1][2], x[u][ks][1][3]);
                S[T0 + u] = __builtin_amdgcn_mfma_f32_16x16x32_bf16(__builtin_bit_cast(bf16x8, w), qfr[ks], S[T0 + u], 0, 0, 0); }
        __builtin_amdgcn_sched_barrier(0);
    }
    const float sink2 = F.sinks[l * 16 + 4 * kvh + gq] * LOG2E;
    float m = sink2;
#pragma unroll
    for (int T = 0; T < 9; ++T)
#pragma unroll
        for (int rg = 0; rg < 4; ++rg) { const int key = 16 * T + 4 * fq + rg; const bool ok = (T < 8) ? (key >= tt + 1) : (fq == 0 && rg <= tt);
            S[T][rg] = ok ? S[T][rg] : -INFINITY; m = fmaxf(m, S[T][rg]); }
    m = fmaxf(m, __shfl_xor(m, 16)); m = fmaxf(m, __shfl_xor(m, 32));
    float sum = 0.f;
#pragma unroll
    for (int T = 0; T < 9; ++T)
#pragma unroll
        for (int rg = 0; rg < 4; ++rg) { const float p = __builtin_amdgcn_exp2f(S[T][rg] - m); sum += p; ps[(16 * T + 4 * fq + rg) * 16 + fr] = p; }
    sum += __shfl_xor(sum, 16); sum += __shfl_xor(sum, 32);
    if (fq == 0) invs[fr] = 1.0f / (sum + __builtin_amdgcn_exp2f(sink2 - m));
    LDS_WAIT();
    const int kq = lane >> 4, dq = lane & 15;
    const float* vcp = F.cache_v + (((size_t)l * 128 + bd) * 128 + kq) * 256 + kvh * 64 + 4 * dq;
    float* vop = oVs + ((size_t)bd * 128 + kq) * 256 + kvh * 64 + 4 * dq;
#pragma unroll 1
    for (int pass = 0; pass < 2; ++pass) {
        float o[8][4];
#pragma unroll
        for (int q = 0; q < 8; ++q) { o[q][0] = 0.f; o[q][1] = 0.f; o[q][2] = 0.f; o[q][3] = 0.f; }
#pragma unroll 1
        for (int blk = 0; blk < 3; ++blk) {
            f32x4 vx[11];
#pragma unroll
            for (int ii = 0; ii < 11; ++ii) { const int i = blk * 11 + ii; const float* src = (i < 32) ? vcp + (size_t)i * 1024 : vop + (size_t)31 * 1024; vx[ii] = *(const f32x4*)src; }
            if (pass == 0) {
#pragma unroll
                for (int ii = 0; ii < 11; ++ii) { const int i = blk * 11 + ii; if (i >= 1 && i < 32) *(f32x4*)(vop + (size_t)(i - 1) * 1024) = vx[ii]; } }
#pragma unroll
            for (int ii = 0; ii < 11; ++ii) { const int key = 4 * (blk * 11 + ii) + kq;
                const f32x4 pa = *(const LAS f32x4*)(ps + key * 16 + 8 * pass), pb = *(const LAS f32x4*)(ps + key * 16 + 8 * pass + 4);
#pragma unroll
                for (int e = 0; e < 4; ++e) { o[0][e] += pa[0] * vx[ii][e]; o[1][e] += pa[1] * vx[ii][e]; o[2][e] += pa[2] * vx[ii][e]; o[3][e] += pa[3] * vx[ii][e];
                    o[4][e] += pb[0] * vx[ii][e]; o[5][e] += pb[1] * vx[ii][e]; o[6][e] += pb[2] * vx[ii][e]; o[7][e] += pb[3] * vx[ii][e]; }
                __builtin_amdgcn_sched_barrier(0); }
        }
#pragma unroll
        for (int q = 0; q < 8; ++q)
#pragma unroll
            for (int e = 0; e < 4; ++e) { float v = o[q][e]; v += __shfl_xor(v, 16); v += __shfl_xor(v, 32); o[q][e] = v; }
#pragma unroll
        for (int q = 0; q < 8; ++q) if ((q >> 1) == kq) { const int qq = 8 * pass + q, t2 = qq & 3, head = 4 * kvh + (qq >> 2); const size_t row = (size_t)MP + 4 * bd + t2;
            float gf[4]; unpack4(*(const u32x2*)(F.Z2 + row * ZW + Z_GA + head * 64 + 4 * dq), gf);
            const float iq = invs[qq];
            u32x2 wv; wv.x = pg8::cvt_pk_bf16(o[q][0] * iq * gf[0], o[q][1] * iq * gf[1]); wv.y = pg8::cvt_pk_bf16(o[q][2] * iq * gf[2], o[q][3] * iq * gf[3]);
            *(u32x2*)(F.MIX + row * DM + head * 64 + 4 * dq) = wv; }
    }
    LDS_WAIT();
}
__device__ __forceinline__ void samp_sgu(int l, int bd) {
    LOCAL_FRAME;
    const int lane = F.lane, c0 = 8 * lane, hd = lane >> 4;
    float* oCV = F.out + O_CV + (size_t)l * LS_CV;
    float gl[8], bl[8];
#pragma unroll
    for (int j = 0; j < 8; ++j) { gl[j] = F.ln_g[l * 512 + c0 + j]; bl[j] = F.ln_b[l * 512 + c0 + j]; }
    u32x4 xr[4], ur[4], gr[4];
#pragma unroll
    for (int tt = 0; tt < 4; ++tt) { const size_t row = (size_t)MP + 4 * bd + tt; xr[tt] = *(const u32x4*)(F.Z2 + row * ZW + Z_VS + c0); ur[tt] = *(const u32x4*)(F.Z2 + row * ZW + Z_U + c0); gr[tt] = *(const u32x4*)(F.Z2 + row * ZW + Z_GS + c0); }
    float vn[4][8];
#pragma unroll
    for (int tt = 0; tt < 4; ++tt) { float f[8]; unpack8(xr[tt], f);
        float s = 0.f, ss = 0.f;
#pragma unroll
        for (int j = 0; j < 8; ++j) { s += f[j]; ss += f[j] * f[j]; }
        s = wave_sum(s); ss = wave_sum(ss);
        const float mean = s * (1.0f / 512.0f), var = ss * (1.0f / 512.0f) - mean * mean, rstd = rsqrtf(var + EPS);
#pragma unroll
        for (int j = 0; j < 8; ++j) vn[tt][j] = (f[j] - mean) * rstd * gl[j] + bl[j];
        float* o = oCV + ((size_t)bd * 4 + tt) * 512 + c0;
        *(f32x4*)o = (f32x4){vn[tt][0], vn[tt][1], vn[tt][2], vn[tt][3]}; *(f32x4*)(o + 4) = (f32x4){vn[tt][4], vn[tt][5], vn[tt][6], vn[tt][7]}; }
#pragma unroll
    for (int tt = 0; tt < 4; ++tt) { const size_t row = (size_t)MP + 4 * bd + tt;
        float mx[8]; const float bias = F.sgu_b[l * 512 + hd * 128 + tt];
#pragma unroll
        for (int j = 0; j < 8; ++j) mx[j] = bias;
#pragma unroll
        for (int s2 = 0; s2 < 4; ++s2) if (s2 <= tt) { const float w = F.sgu_w[((size_t)(l * 4 + hd) * 128 + tt) * 128 + s2];
#pragma unroll
            for (int j = 0; j < 8; ++j) mx[j] += w * vn[s2][j]; }
        float uf[8], gf[8]; unpack8(ur[tt], uf); unpack8(gr[tt], gf);
#pragma unroll
        for (int j = 0; j < 8; ++j) mx[j] = mx[j] * uf[j] * gf[j];
        *(u32x4*)(F.MIX + row * DM + 1536 + c0) = pack8(mx); }
}

#ifdef HYBRID
__device__ __forceinline__ void attn_task_o(const Frame& F, int l, int b, int nb, int head, int qs, LAS unsigned char* wl) {
    const int lane = F.lane, r = lane & 31, hh = lane >> 5, kvh = head >> 2;
    LAS float* wsf = (LAS float*)wl; LAS bf16_t* stg = (LAS bf16_t*)(wl + 256);
    const int t0 = 128 * nb + 32 * qs;
    const size_t qrow0 = (size_t)b * 2048 + t0;
    const bf16_t* qp = F.Qc + (qrow0 + r) * 1024 + head * 64 + 8 * hh;
    bf16x8 qf[4];
#pragma unroll
    for (int s = 0; s < 4; ++s) qf[s] = *(const bf16x8*)(qp + 16 * s);
    const bf16_t* kbase = F.Kc + (size_t)(b * 4 + kvh) * 2048 * 64;
    const bf16_t* vbase = F.VTP + (size_t)(b * 4 + kvh) * 64 * 2048;
    const int cmin = (nb > 0) ? 0 : (4 - qs);
    f32x16 S[5];
#pragma unroll
    for (int c = 0; c < 5; ++c) {
        f32x16 a;
#pragma unroll
        for (int i = 0; i < 16; ++i) a[i] = 0.f;
        if (c >= cmin) {
            const bf16_t* kp = kbase + (size_t)(t0 - 128 + 32 * c + r) * 64 + 8 * hh;
#pragma unroll
            for (int s = 0; s < 4; ++s) a = __builtin_amdgcn_mfma_f32_32x32x16_bf16(*(const bf16x8*)(kp + 16 * s), qf[s], a, 0, 0, 0);
        }
        S[c] = a;
    }
    const float NEG = -INFINITY;
#pragma unroll
    for (int i = 0; i < 16; ++i) { const int kap = crow(i, hh); if (kap <= r) S[0][i] = NEG; if (kap > r) S[4][i] = NEG; }
    const float sink2 = F.sinks[l * 16 + head] * LOG2E;
    float m = sink2;
#pragma unroll
    for (int c = 0; c < 5; ++c) if (c >= cmin) {
#pragma unroll
        for (int i = 0; i < 16; ++i) m = fmaxf(m, S[c][i]); }
    m = fmaxf(m, __shfl_xor(m, 32));
    float sum = 0.f;
#pragma unroll
    for (int c = 0; c < 5; ++c) if (c >= cmin) {
#pragma unroll
        for (int i = 0; i < 16; ++i) { const float p = __builtin_amdgcn_exp2f(S[c][i] - m); S[c][i] = p; sum += p; } }
    sum += __shfl_xor(sum, 32);
    const float inv = 1.0f / (sum + __builtin_amdgcn_exp2f(sink2 - m));
    f32x16 o[2];
#pragma unroll
    for (int i = 0; i < 16; ++i) { o[0][i] = 0.f; o[1][i] = 0.f; }
#pragma unroll
    for (int c = 0; c < 5; ++c) if (c >= cmin) {
        const bf16_t* vt = vbase + (size_t)((t0 - 128 + 32 * c) >> 5) * 2048 + r * 32 + 16 * hh;
#pragma unroll
        for (int s = 0; s < 2; ++s) {
            u32x4 pw; pw.x = pg8::cvt_pk_bf16(S[c][8 * s + 0], S[c][8 * s + 1]); pw.y = pg8::cvt_pk_bf16(S[c][8 * s + 2], S[c][8 * s + 3]);
            pw.z = pg8::cvt_pk_bf16(S[c][8 * s + 4], S[c][8 * s + 5]); pw.w = pg8::cvt_pk_bf16(S[c][8 * s + 6], S[c][8 * s + 7]);
            const bf16x8 pa = __builtin_bit_cast(bf16x8, pw);
#pragma unroll
            for (int db = 0; db < 2; ++db) o[db] = __builtin_amdgcn_mfma_f32_32x32x16_bf16(pa, *(const bf16x8*)(vt + db * 1024 + 8 * s), o[db], 0, 0, 0);
        }
    }
    if (hh == 0) wsf[r] = inv;
    LDS_WAIT();
#pragma unroll
    for (int i = 0; i < 16; ++i) { const int q = crow(i, hh); const float rl = wsf[q];
        stg[q * 64 + r] = (bf16_t)(pg8::cvt_pk_bf16(o[0][i] * rl, 0.f) & 0xffffu);
        stg[q * 64 + 32 + r] = (bf16_t)(pg8::cvt_pk_bf16(o[1][i] * rl, 0.f) & 0xffffu); }
    LDS_WAIT();
#pragma unroll
    for (int i = 0; i < 4; ++i) { const int row = i * 8 + (lane >> 3), ch = lane & 7;
        const u32x4 ov = *(const LAS u32x4*)(stg + row * 64 + ch * 8);
        const u32x4 gv = *(const u32x4*)(F.Z2 + (qrow0 + row) * ZW + Z_GA + head * 64 + ch * 8);
        float of[8], gf[8]; unpack8(ov, of); unpack8(gv, gf);
#pragma unroll
        for (int j = 0; j < 8; ++j) of[j] *= gf[j];
        *(u32x4*)(F.MIX + (qrow0 + row) * DM + head * 64 + ch * 8) = pack8(of); }
    LDS_WAIT();
}

template <bool SAMPLE>
__device__ __forceinline__ void pool_unit_o(const Frame& F, int l, int g, int tile) {
    const int lane = F.lane, r = lane & 31, hh = lane >> 5, w = 2 << g;
    const size_t row = (size_t)(SAMPLE ? MP : 0) + 32 * tile + r;
    const int t = SAMPLE ? (int)(row & 3) : (int)(row & 2047);
    const int bd = SAMPLE ? (int)((row - MP) >> 2) : 0;
    const float icnt = SAMPLE ? 1.0f / (float)w : 1.0f / (float)(w < t + 1 ? w : t + 1);
    bf16x8 bfr[8];
#pragma unroll
    for (int s = 0; s < 8; ++s) {
        const int c0 = 128 * g + 16 * s + 8 * hh;
        float sum[8], cur[8];
#pragma unroll
        for (int j = 0; j < 8; ++j) { sum[j] = 0.f; cur[j] = 0.f; }
        for (int i = 0; i < w; ++i) {
            float f[8];
            const int e = t - i;
            if (e >= 0) { unpack8(*(const u32x4*)(F.Z2 + (row - i) * ZW + Z_XB + c0), f); }
            else if (SAMPLE) { const float* sp = F.state_pool + (((size_t)l * 128 + bd) * 15 + 15 + e) * 512 + c0;
                const f32x4 a = *(const f32x4*)sp, bq = *(const f32x4*)(sp + 4); f[0] = a[0]; f[1] = a[1]; f[2] = a[2]; f[3] = a[3]; f[4] = bq[0]; f[5] = bq[1]; f[6] = bq[2]; f[7] = bq[3]; }
            else {
#pragma unroll
                for (int j = 0; j < 8; ++j) f[j] = 0.f; }
#pragma unroll
            for (int j = 0; j < 8; ++j) sum[j] += f[j];
            if (i == 0) {
#pragma unroll
                for (int j = 0; j < 8; ++j) cur[j] = f[j]; }
        }
        float pf[8];
#pragma unroll
        for (int j = 0; j < 8; ++j) pf[j] = sum[j] * icnt - cur[j];
        bfr[s] = __builtin_bit_cast(bf16x8, pack8(pf));
    }
    f32x16 acc[4];
#pragma unroll
    for (int db = 0; db < 4; ++db) {
#pragma unroll
        for (int i = 0; i < 16; ++i) acc[db][i] = 0.f;
        const bf16_t* ap = F.PWT + ((size_t)(l * 4 + g) * 128 + 32 * db + r) * 128 + 8 * hh;
#pragma unroll
        for (int s = 0; s < 8; ++s) acc[db] = __builtin_amdgcn_mfma_f32_32x32x16_bf16(*(const bf16x8*)(ap + 16 * s), bfr[s], acc[db], 0, 0, 0);
    }
#pragma unroll
    for (int db = 0; db < 4; ++db)
#pragma unroll
        for (int q = 0; q < 4; ++q) {
            const int col = 128 * g + 32 * db + 8 * q + 4 * hh;
            const f32x4 sc = *(const f32x4*)(F.pool_scale + l * 512 + col);
            float gf[4]; unpack4(*(const u32x2*)(F.Z2 + row * ZW + Z_GP + col), gf);
            u32x2 wv; wv.x = pg8::cvt_pk_bf16(acc[db][4 * q + 0] * sc[0] * gf[0], acc[db][4 * q + 1] * sc[1] * gf[1]);
            wv.y = pg8::cvt_pk_bf16(acc[db][4 * q + 2] * sc[2] * gf[2], acc[db][4 * q + 3] * sc[3] * gf[3]);
            *(u32x2*)(F.MIX + row * DM + 1024 + col) = wv;
        }
}

__device__ __forceinline__ void sgu_unit_o(const Frame& F, int l, int ci, int hd, LAS unsigned char* ring) {
    LAS bf16_t* VnT = (LAS bf16_t*)ring;
    const int lane = F.lane, wv = F.wave;
    const size_t R0 = (size_t)128 * ci;
    {
        const int tl = lane >> 2, q4 = lane & 3;
        const bf16_t* vrow = F.Z2 + (R0 + 16 * wv + tl) * ZW + Z_VS;
        float s = 0.f, ss = 0.f;
#pragma unroll
        for (int i = 0; i < 16; ++i) { float f[8]; unpack8(*(const u32x4*)(vrow + 128 * q4 + 8 * i), f);
#pragma unroll
            for (int j = 0; j < 8; ++j) { s += f[j]; ss += f[j] * f[j]; } }
        s += __shfl_xor(s, 1); s += __shfl_xor(s, 2); ss += __shfl_xor(ss, 1); ss += __shfl_xor(ss, 2);
        const float mean = s * (1.0f / 512.0f), var = ss * (1.0f / 512.0f) - mean * mean, rstd = rsqrtf(var + EPS);
#pragma unroll
        for (int i = 0; i < 4; ++i) { const int d = 32 * q4 + 8 * i; float f[8]; unpack8(*(const u32x4*)(vrow + 128 * hd + d), f);
            const float* gp = F.ln_g + l * 512 + 128 * hd + d; const float* bp = F.ln_b + l * 512 + 128 * hd + d;
#pragma unroll
            for (int j = 0; j < 8; ++j) { const float vn = (f[j] - mean) * rstd * gp[j] + bp[j];
                VnT[(d + j) * 136 + 16 * wv + tl] = (bf16_t)(pg8::cvt_pk_bf16(vn, 0.f) & 0xffffu); } }
    }
    __syncthreads();
    {
        const int r = lane & 31, hh = lane >> 5, db = wv & 3; const int tbA = (wv >> 2) ? 1 : 0, tbB = (wv >> 2) ? 2 : 3;
        f32x16 accA, accB;
#pragma unroll
        for (int i = 0; i < 16; ++i) { accA[i] = 0.f; accB[i] = 0.f; }
        const bf16_t* Wb = F.SGUW + (size_t)(l * 4 + hd) * 128 * 128;
#pragma unroll
        for (int s = 0; s < 8; ++s) {
            if (s < 2 * (tbB + 1)) {
                const bf16x8 a = *(const LAS bf16x8*)(VnT + (32 * db + r) * 136 + 16 * s + 8 * hh);
                accB = __builtin_amdgcn_mfma_f32_32x32x16_bf16(a, *(const bf16x8*)(Wb + (32 * tbB + r) * 128 + 16 * s + 8 * hh), accB, 0, 0, 0);
                if (s < 2 * (tbA + 1)) accA = __builtin_amdgcn_mfma_f32_32x32x16_bf16(a, *(const bf16x8*)(Wb + (32 * tbA + r) * 128 + 16 * s + 8 * hh), accA, 0, 0, 0);
            }
        }
#pragma unroll
        for (int pass = 0; pass < 2; ++pass) {
            const int tb = pass ? tbB : tbA; const f32x16 acc = pass ? accB : accA;
            const int t = 32 * tb + r; const size_t row = R0 + t; const float bias = F.sgu_b[l * 512 + hd * 128 + t];
#pragma unroll
            for (int q = 0; q < 4; ++q) { const int col = 128 * hd + 32 * db + 8 * q + 4 * hh;
                float uf[4], gf[4]; unpack4(*(const u32x2*)(F.Z2 + row * ZW + Z_U + col), uf); unpack4(*(const u32x2*)(F.Z2 + row * ZW + Z_GS + col), gf);
                u32x2 wo; wo.x = pg8::cvt_pk_bf16((acc[4 * q + 0] + bias) * uf[0] * gf[0], (acc[4 * q + 1] + bias) * uf[1] * gf[1]);
                wo.y = pg8::cvt_pk_bf16((acc[4 * q + 2] + bias) * uf[2] * gf[2], (acc[4 * q + 3] + bias) * uf[3] * gf[3]);
                *(u32x2*)(F.MIX + row * DM + 1536 + col) = wo; }
        }
    }
    __syncthreads();
}

__device__ __forceinline__ void samp_attn_o(const Frame& F, int l, int bd, int kvh, LAS unsigned char* wl) {
    LAS float* qs = (LAS float*)wl;
    LAS float* ps = (LAS float*)(wl + 4096);
    const int lane = F.lane;
    float* oKs = F.out + O_KS + (size_t)l * LS_KS; float* oVs = F.out + O_VS + (size_t)l * LS_KS;
    {
        const int qi = lane >> 2, part = lane & 3, gq = qi >> 2, tt = qi & 3;
        const bf16_t* src = F.Qc + ((size_t)MP + 4 * bd + tt) * 1024 + (4 * kvh + gq) * 64 + 16 * part;
        float f0[8], f1[8]; unpack8(*(const u32x4*)src, f0); unpack8(*(const u32x4*)(src + 8), f1);
#pragma unroll
        for (int j = 0; j < 8; ++j) { const int p0 = 16 * part + j, p1 = p0 + 8;
            qs[qi * 64 + (p0 >> 1) + 32 * (p0 & 1)] = f0[j]; qs[qi * 64 + (p1 >> 1) + 32 * (p1 & 1)] = f1[j]; }
    }
    LDS_WAIT();
    float s0[16], s1[16], s2[16];
#pragma unroll
    for (int q = 0; q < 16; ++q) { s0[q] = 0.f; s1[q] = 0.f; s2[q] = 0.f; }
    const float* k0p = F.cache_k + (((size_t)l * 128 + bd) * 128 + lane) * 256 + kvh * 64;
    const float* k1p = k0p + 64 * 256;
    const float* k2p = oKs + (((size_t)bd * 128 + 124 + (lane & 3)) * 4 + kvh) * 64;
    float* c0p = oKs + (((size_t)bd * 128 + (lane >= 4 ? lane - 4 : 0)) * 4 + kvh) * 64;
    float* c1p = oKs + (((size_t)bd * 128 + lane + 60) * 4 + kvh) * 64;
    for (int ch = 0; ch < 16; ++ch) {
        const f32x4 kx0 = *(const f32x4*)(k0p + 4 * ch), kx1 = *(const f32x4*)(k1p + 4 * ch), kx2 = *(const f32x4*)(k2p + 4 * ch);
        if (lane >= 4) *(f32x4*)(c0p + 4 * ch) = kx0;
        *(f32x4*)(c1p + 4 * ch) = kx1;
#pragma unroll
        for (int q = 0; q < 16; ++q) { const f32x4 qv = *(const LAS f32x4*)(qs + q * 64 + 4 * ch);
            s0[q] += (qv[0] * kx0[0] + qv[1] * kx0[1]) + (qv[2] * kx0[2] + qv[3] * kx0[3]);
            s1[q] += (qv[0] * kx1[0] + qv[1] * kx1[1]) + (qv[2] * kx1[2] + qv[3] * kx1[3]);
            s2[q] += (qv[0] * kx2[0] + qv[1] * kx2[1]) + (qv[2] * kx2[2] + qv[3] * kx2[3]); }
    }
    float inv[16];
#pragma unroll
    for (int q = 0; q < 16; ++q) {
        const int tt = q & 3; const float sink2 = F.sinks[l * 16 + 4 * kvh + (q >> 2)] * LOG2E;
        const bool v0 = lane >= tt + 1, v2 = (lane < 4) && (lane <= tt);
        float m = s1[q]; if (v0) m = fmaxf(m, s0[q]); if (v2) m = fmaxf(m, s2[q]);
        m = fmaxf(wave_max(m), sink2);
        const float p0 = v0 ? __builtin_amdgcn_exp2f(s0[q] - m) : 0.f, p1 = __builtin_amdgcn_exp2f(s1[q] - m), p2 = v2 ? __builtin_amdgcn_exp2f(s2[q] - m) : 0.f;
        const float sum = wave_sum(p0 + p1 + p2);
        inv[q] = 1.0f / (sum + __builtin_amdgcn_exp2f(sink2 - m));
        ps[lane * 16 + q] = p0; ps[(lane + 64) * 16 + q] = p1; if (lane < 4) ps[(128 + lane) * 16 + q] = p2;
    }
    LDS_WAIT();
    float o[16];
#pragma unroll
    for (int q = 0; q < 16; ++q) o[q] = 0.f;
    const float* vcp = F.cache_v + (((size_t)l * 128 + bd) * 128) * 256 + kvh * 64 + lane;
    float* vop = oVs + ((size_t)bd * 128) * 256 + kvh * 64 + lane;
    for (int key = 0; key < 132; ++key) {
        float v;
        if (key < 128) { v = vcp[(size_t)key * 256]; if (key >= 4) vop[(size_t)(key - 4) * 256] = v; }
        else v = vop[(size_t)(key - 4) * 256];
#pragma unroll
        for (int q4 = 0; q4 < 4; ++q4) { const f32x4 pv = *(const LAS f32x4*)(ps + key * 16 + 4 * q4);
            o[4 * q4 + 0] += pv[0] * v; o[4 * q4 + 1] += pv[1] * v; o[4 * q4 + 2] += pv[2] * v; o[4 * q4 + 3] += pv[3] * v; }
    }
#pragma unroll
    for (int q = 0; q < 16; ++q) { const int tt = q & 3, head = 4 * kvh + (q >> 2); const size_t row = (size_t)MP + 4 * bd + tt;
        const float gv = __uint_as_float(((unsigned)F.Z2[row * ZW + Z_GA + head * 64 + lane]) << 16);
        F.MIX[row * DM + head * 64 + lane] = (bf16_t)(pg8::cvt_pk_bf16(o[q] * inv[q] * gv, 0.f) & 0xffffu); }
    LDS_WAIT();
}
__device__ __forceinline__ void samp_sgu_o(const Frame& F, int l, int bd) {
    const int lane = F.lane, c0 = 8 * lane, hd = lane >> 4;
    float* oCV = F.out + O_CV + (size_t)l * LS_CV;
    float gl[8], bl[8];
#pragma unroll
    for (int j = 0; j < 8; ++j) { gl[j] = F.ln_g[l * 512 + c0 + j]; bl[j] = F.ln_b[l * 512 + c0 + j]; }
    float vn[4][8];
#pragma unroll
    for (int tt = 0; tt < 4; ++tt) { const size_t row = (size_t)MP + 4 * bd + tt; float f[8]; unpack8(*(const u32x4*)(F.Z2 + row * ZW + Z_VS + c0), f);
        float s = 0.f, ss = 0.f;
#pragma unroll
        for (int j = 0; j < 8; ++j) { s += f[j]; ss += f[j] * f[j]; }
        s = wave_sum(s); ss = wave_sum(ss);
        const float mean = s * (1.0f / 512.0f), var = ss * (1.0f / 512.0f) - mean * mean, rstd = rsqrtf(var + EPS);
#pragma unroll
        for (int j = 0; j < 8; ++j) vn[tt][j] = (f[j] - mean) * rstd * gl[j] + bl[j];
        float* o = oCV + ((size_t)bd * 4 + tt) * 512 + c0;
        *(f32x4*)o = (f32x4){vn[tt][0], vn[tt][1], vn[tt][2], vn[tt][3]}; *(f32x4*)(o + 4) = (f32x4){vn[tt][4], vn[tt][5], vn[tt][6], vn[tt][7]}; }
#pragma unroll
    for (int tt = 0; tt < 4; ++tt) { const size_t row = (size_t)MP + 4 * bd + tt;
        float mx[8]; const float bias = F.sgu_b[l * 512 + hd * 128 + tt];
#pragma unroll
        for (int j = 0; j < 8; ++j) mx[j] = bias;
#pragma unroll
        for (int s2 = 0; s2 < 4; ++s2) if (s2 <= tt) { const float w = F.sgu_w[((size_t)(l * 4 + hd) * 128 + tt) * 128 + s2];
#pragma unroll
            for (int j = 0; j < 8; ++j) mx[j] += w * vn[s2][j]; }
        float uf[8], gf[8]; unpack8(*(const u32x4*)(F.Z2 + row * ZW + Z_U + c0), uf); unpack8(*(const u32x4*)(F.Z2 + row * ZW + Z_GS + c0), gf);
#pragma unroll
        for (int j = 0; j < 8; ++j) mx[j] = mx[j] * uf[j] * gf[j];
        *(u32x4*)(F.MIX + row * DM + 1536 + c0) = pack8(mx); }
}

#endif
__device__ __forceinline__ void p2_copy_state(int l) {
    LOCAL_FRAME;
    const int gt = F.bid * NTHREADS + F.tid, NGT = F.G * NTHREADS;
    float* oPs = F.out + O_PS + (size_t)l * LS_PS; const float* sp = F.state_pool + (size_t)l * LS_PS;
    for (int e = gt; e < 128 * 11 * 128; e += NGT) { const int c4 = e & 127, rr = (e >> 7) % 11, bd = (e >> 7) / 11;
        *(f32x4*)(oPs + ((size_t)bd * 15 + rr) * 512 + 4 * c4) = *(const f32x4*)(sp + ((size_t)bd * 15 + rr + 4) * 512 + 4 * c4); }
}
__device__ __forceinline__ void p2_mixers(int l, LAS unsigned char* ring) {
    const int bid = blockIdx.x, G = gridDim.x; int t_ = threadIdx.x; asm volatile("" : "+v"(t_)); const int wave = __builtin_amdgcn_readfirstlane(t_ >> 6);
#ifdef OLD_SGU
    { LOCAL_FRAME; for (int u = bid; u < 512; u += G) sgu_unit_o(F, l, u >> 2, u & 3, ring); }
#else
    for (int u = bid; u < 256; u += G) sgu_unit(l, u >> 1, u & 1, ring);
#endif
    if (l == 0) STAMP2(10);
#ifdef OLD_ATT
    { LOCAL_FRAME; LAS unsigned char* wl = ring + 102400 + F.wave * 4352;
      for (int a = bid; a < 512; a += G) { const int kvh = a & 3, nb = (a >> 2) & 15, b = a >> 6; const int head = 4 * kvh + (F.wave >> 1);
        attn_task_o(F, l, b, nb, head, 2 * (F.wave & 1), wl); attn_task_o(F, l, b, nb, head, 2 * (F.wave & 1) + 1, wl); } __syncthreads(); }
#else
    for (int a = bid; a < 256; a += G) attn_unit(l, a, ring);
#endif
    if (l == 0) STAMP2(11);
    const int gw = bid * NWAVES + wave, NGW = G * NWAVES;
#ifdef OLD_POOL
    { LOCAL_FRAME; for (int i = gw; i < 2048; i += NGW) pool_unit_o<false>(F, l, i & 3, i >> 2); }
#else
    for (int i = gw; i < 2048; i += NGW) pool_dispatch<false>(l, i & 3, i >> 2);
#endif
    if (l == 0) STAMP2(12);
    LAS unsigned char* wls = ring + wave * 9472;
    for (int i = gw; i < 2048; i += NGW) {
#ifdef OLD_SATT
        if ((i & 3) == 0) { const int k = i >> 2; LOCAL_FRAME; samp_attn_o(F, l, k >> 2, k & 3, ring + wave * 12544); }
        else
#else
        if ((i & 3) == 0) { const int k = i >> 2; samp_attn(l, k >> 2, k & 3, wls); }
        else
#endif
        if ((i & 15) == 1) { samp_sgu(l, i >> 4); }
        else if ((i & 31) == 2) { const int k = i >> 5; pool_dispatch<true>(l, k & 3, k >> 2); }
    }
    if (l == 0) STAMP2(13);
    p2_copy_state(l);
}

__device__ __forceinline__ void p4_rows(const Frame& F, int l) {
    const int lane = F.lane, gw = F.bid * NWAVES + F.wave, NGW = F.G * NWAVES;
    const float* pg = F.norm_post + l * DM; const float* g1 = F.norm_pre + DM;
    for (int row = gw; row < MT; row += NGW) {
        const float* yr = F.Y + (size_t)row * DM;
        const float* xr = (l == 0) ? (row < MP ? F.xp + (size_t)row * DM : F.xs + (size_t)(row - MP) * DM) : F.out + (size_t)row * DM;
        float* orow = F.out + (size_t)row * DM;
        f32x4 v[8]; float ss = 0.f;
#pragma unroll
        for (int j = 0; j < 8; ++j) { v[j] = *(const f32x4*)(yr + 4 * lane + 256 * j); ss += (v[j][0] * v[j][0] + v[j][1] * v[j][1]) + (v[j][2] * v[j][2] + v[j][3] * v[j][3]); }
        ss = wave_sum(ss);
        const float ry = rsqrtf(ss * (1.0f / 2048.0f) + EPS);
        float s1 = 0.f;
#pragma unroll
        for (int j = 0; j < 8; ++j) { const f32x4 xv = *(const f32x4*)(xr + 4 * lane + 256 * j); const f32x4 gg = *(const f32x4*)(pg + 4 * lane + 256 * j);
            const f32x4 x1 = xv + v[j] * ry * gg; v[j] = x1; *(f32x4*)(orow + 4 * lane + 256 * j) = x1;
            s1 += (x1[0] * x1[0] + x1[1] * x1[1]) + (x1[2] * x1[2] + x1[3] * x1[3]); }
        if (l == 0) {
            s1 = wave_sum(s1);
            const float r1 = rsqrtf(s1 * (1.0f / 2048.0f) + EPS);
            bf16_t* hrow = F.H + (size_t)row * DM;
#pragma unroll
            for (int j = 0; j < 8; ++j) { const f32x4 gg = *(const f32x4*)(g1 + 4 * lane + 256 * j); const f32x4 o = v[j] * r1 * gg;
                u32x2 w; w.x = pg8::cvt_pk_bf16(o[0], o[1]); w.y = pg8::cvt_pk_bf16(o[2], o[3]); *(u32x2*)(hrow + 4 * lane + 256 * j) = w; }
        }
    }
}

__global__ void __launch_bounds__(NTHREADS, 2) hymba_fwd(Args a_unused) {
    extern __shared__ __attribute__((aligned(16))) unsigned char lds[];
    LAS unsigned char* L = (LAS unsigned char*)lds;
    if (threadIdx.x < 256) ((LAS unsigned*)L)[threadIdx.x] = 0u;
    __syncthreads();
    XcdBarrier bar = xcd_barrier_post((unsigned*)((unsigned char*)kargs()->ws + WS_CTL) + CW_BAR, (volatile LAS unsigned*)L + 8);
    LAS unsigned char* ring = L + RING_OFF;
    STAMP(0);
#ifndef NO_P0
    { Frame F; make_frame(F, kargs()); p0_prologue(F, ring); }
#endif
    xcd_barrier(bar);
    STAMP(1);
#pragma unroll 1
    for (int l = 0; l < 2; ++l) {
#ifndef NO_P1
        {
            KArgs ka = kargs(); unsigned char* ws = (unsigned char*)ka->ws;
            pg8::Gemm g{(const bf16_t*)(ws + WS_H), (const bf16_t*)(ws + WS_WTIN) + (size_t)l * DIN * DM, MT, DIN, DM}; pg8::StaticOrder S; S.init(MT, DIN, (int)gridDim.x, (int)blockIdx.x);
            pg8::EpiIn E{l};
            pg8::gemm_phase<pg8::EpiIn, pg8::StaticOrder, true, true>(ring, g, S, E);
        }
#endif
        xcd_barrier(bar);
        STAMP(2 + 4 * l);
#ifndef NO_P2
        p2_mixers(l, ring);
#endif
        xcd_barrier(bar);
        STAMP(3 + 4 * l);
#ifndef NO_P3
        {
            KArgs ka = kargs(); unsigned char* ws = (unsigned char*)ka->ws;
            pg8::Gemm g{(const bf16_t*)(ws + WS_MIX), (const bf16_t*)(ws + WS_WTOUT) + (size_t)l * DM * DM, MT, DM, DM}; pg8::StaticOrder S; S.init(MT, DM, (int)gridDim.x, (int)blockIdx.x);
            pg8::EpiOut E{};
            pg8::gemm_phase<pg8::EpiOut, pg8::StaticOrder, true, true>(ring, g, S, E);
        }
#endif
        xcd_barrier(bar);
        STAMP(4 + 4 * l);
#ifndef NO_P4
        { Frame F; make_frame(F, kargs()); p4_rows(F, l); }
#endif
        if (l == 0) xcd_barrier(bar);
#if PROBE_SEL
        if (l == 1) __syncthreads();
#endif
        STAMP(5 + 4 * l);
    }
#if PROBE_SEL
    if (blockIdx.x == 0 && threadIdx.x == 0) {
        LAS unsigned long long* ts = (LAS unsigned long long*)(L + 256);
        unsigned long long da = (ts[PA1] - ts[PA0] + 400) / 800, db = (ts[PB1] - ts[PB0] + 400) / 800;
        if (da > 63) da = 63; if (db > 63) db = 63;
        const unsigned long long extra = (da + 64 * db) * 1600ull, t0 = __builtin_amdgcn_s_memrealtime();
        while (__builtin_amdgcn_s_memrealtime() - t0 < extra) __builtin_amdgcn_s_sleep(32);
    }
#endif
}

extern "C" void kernel_launch(void* const* d_in, const int* in_sizes, int n_in, void* d_out, int out_size, void* d_ws, size_t ws_size, hipStream_t stream) {
    static int grid = 0;
    if (grid == 0) {
        if (n_in != 16 || (size_t)out_size != O_END || ws_size < WS_END) { fprintf(stderr, "kernel_launch: unexpected shapes: n_in %d out %d ws %zu (need %zu)\n", n_in, out_size, ws_size, (size_t)WS_END); grid = -1; return; }
        int dev = 0, cus = 0, per_cu = 0;
        if (hipGetDevice(&dev) != hipSuccess || hipDeviceGetAttribute(&cus, hipDeviceAttributeMultiprocessorCount, dev) != hipSuccess) { fprintf(stderr, "kernel_launch: device query failed\n"); grid = -1; return; }
        if (hipFuncSetAttribute((const void*)hymba_fwd, hipFuncAttributeMaxDynamicSharedMemorySize, LDS_BYTES) != hipSuccess) { fprintf(stderr, "kernel_launch: hipFuncSetAttribute failed\n"); grid = -1; return; }
        if (hipOccupancyMaxActiveBlocksPerMultiprocessor(&per_cu, (const void*)hymba_fwd, NTHREADS, LDS_BYTES) != hipSuccess || per_cu < 1) { fprintf(stderr, "kernel_launch: occupancy query says %d blocks/CU\n", per_cu); (void)hipGetLastError(); grid = -1; return; }
        grid = cus;
    }
    if (grid < 0) return;
    (void)hipMemsetAsync((char*)d_ws + WS_CTL, 0, CTL_ZERO_BYTES, stream);
    Args a{};
    for (int i = 0; i < 16; ++i) a.in[i] = (const float*)d_in[i];
    a.out = (float*)d_out; a.ws = (unsigned char*)d_ws;
    void* params[] = {&a};
    hipError_t e = hipLaunchCooperativeKernel((const void*)hymba_fwd, dim3(grid), dim3(NTHREADS), params, LDS_BYTES, stream);
    if (e != hipSuccess) fprintf(stderr, "kernel_launch: cooperative launch failed: %s (grid %d)\n", hipGetErrorString(e), grid);
}
```

```cpp
#include <hip/hip_runtime.h>
#include <cstdio>
#include <cstdint>
#include <cmath>
namespace pg8 {
#define PG8_LAS __attribute__((address_space(3)))
typedef unsigned short bf16_t;
typedef short bf16x8 __attribute__((ext_vector_type(8)));
typedef float f32x4 __attribute__((ext_vector_type(4)));
typedef unsigned u32x4 __attribute__((ext_vector_type(4)));
constexpr int BM = 256, BK = 64, HALF = 128, HTB = HALF * BK * 2  , STAGE_BYTES = 8 * HTB, NXCD = 8, WGM = 8;

__host__ __device__ __forceinline__ int lds_byte(int r, int c) { const int st = (r >> 4) * 2 + (c >> 5), rr = r & 15, cc = c & 31, ob = rr * 64 + cc * 2; return st * 1024 + (ob ^ (((ob >> 9) & 1) << 5)); }
__host__ __device__ __forceinline__ void stage_rc(int b, int& R, int& C) { const int st = b / 1024, sb = b % 1024, swz = sb ^ (((sb >> 9) & 1) << 5); R = (st >> 1) * 16 + swz / 64; C = (st & 1) * 32 + (swz % 64) / 2; }
__host__ __device__ __forceinline__ int perm32(int rho) { const int n = rho >> 4, i = rho & 15; return 8 * (i >> 2) + 4 * n + (i & 3); }

struct Unit { int pm, pn; };
struct Gemm { const bf16_t* A; const bf16_t* Bt; int M, N, K; };

struct StaticOrder {
    int nM, nN, nwg, G, c;
    __host__ __device__ void init(int M, int N, int G_, int c_) { nM = M / BM; nN = N / BM; nwg = nM * nN; G = G_; c = c_; }
    __host__ __device__ bool next(int i, Unit& u) const {
        const long L = (long)i * G + c; if (L >= nwg) return false;
        int wgid = (int)L; { const int q = nwg / NXCD, r = nwg % NXCD, xcd = wgid % NXCD, off = wgid / NXCD; wgid = (xcd < r ? xcd * (q + 1) : r * (q + 1) + (xcd - r) * q) + off; }
        const int nig = WGM * nN, gid = wgid / nig, fm = gid * WGM, gsz = (nM - fm) < WGM ? (nM - fm) : WGM;
        u.pm = fm + ((wgid % nig) % gsz); u.pn = (wgid % nig) / gsz; return true;
    }
    __device__ __forceinline__ void a_ready(const Unit&) const {}
    __device__ __forceinline__ void done(const Unit&) const {}
};

constexpr int DM = 2048, MP = 16384, MS = 512, MT = MP + MS, DIN = 5120;
constexpr int ZW = 3584;
constexpr int Z_GA = 0, Z_XB = 1024, Z_GP = 1536, Z_U = 2048, Z_VS = 2560, Z_GS = 3072;
constexpr float LOG2E = 1.4426950408889634f, QSCALE = 0.125f * LOG2E, EPS = 1e-6f;

__device__ __forceinline__ unsigned cvt_pk_bf16(float lo, float hi) { unsigned r; asm("v_cvt_pk_bf16_f32 %0, %1, %2" : "=v"(r) : "v"(lo), "v"(hi)); return r; }
__device__ __forceinline__ float silu_f(float x) { return x * __builtin_amdgcn_rcpf(1.0f + __builtin_amdgcn_exp2f(-x * LOG2E)); }
__device__ __forceinline__ int vperm32(int x) { return ((x >> 2) & 1) * 16 + (x >> 3) * 4 + (x & 3); }

struct EpiPtrs { const __attribute__((address_space(1))) float* in[16]; __attribute__((address_space(1))) float* out; __attribute__((address_space(1))) unsigned char* ws; };
constexpr size_t EP_ROPE = (size_t)1 << 20, EP_QC = (size_t)192 << 20, EP_KC = (size_t)225 << 20, EP_VTP = (size_t)233 << 20, EP_Z2 = (size_t)241 << 20, EP_Y = (size_t)357 << 20;
constexpr size_t EO_KP = 34603008, EO_VP = 35127296, EO_PP = 35651584, EO_KS = 35774464, EO_VS = 44163072, EO_PS = 52551680;
struct EpiIn {
    static constexpr bool PERM = true, AFTER_DRAIN = false;
    int l;
    __device__ __forceinline__ void operator()(const f32x4 (&acc)[2][2][4][2], const Unit& u, int wr, int wc, int fr, int fq) const {
        const __attribute__((address_space(4))) EpiPtrs* kp = (const __attribute__((address_space(4))) EpiPtrs*)__builtin_amdgcn_kernarg_segment_ptr(); asm volatile("" : "+s"(kp));
        unsigned char* ws = (unsigned char*)kp->ws; float* outp = (float*)kp->out;
        bf16_t* Qc = (bf16_t*)(ws + EP_QC); bf16_t* Kc = (bf16_t*)(ws + EP_KC); bf16_t* VTP = (bf16_t*)(ws + EP_VTP); bf16_t* Z2 = (bf16_t*)(ws + EP_Z2); const float* rope = (const float*)(ws + EP_ROPE);
        float* oKp = outp + EO_KP + (size_t)l * 262144; float* oVp = outp + EO_VP + (size_t)l * 262144; float* oPp = outp + EO_PP + (size_t)l * 61440;
        float* oKs = outp + EO_KS + (size_t)l * 4194304; float* oVs = outp + EO_VS + (size_t)l * 4194304; float* oPs = outp + EO_PS + (size_t)l * 983040;
        const int pn = u.pn;
        const int row0 = u.pm * 256 + wr * 64 + fr;
        const int cw = wc * 32 + 8 * fq;
        if (pn < 5) {
#pragma unroll
            for (int ai = 0; ai < 2; ++ai)
#pragma unroll
                for (int m = 0; m < 4; ++m) {
                    const int row = row0 + ai * 128 + m * 16;
                    const bool smp = row >= MP;
                    const int tpos = smp ? 2048 + (row & 3) : (row & 2047);
                    const float* rp = rope + tpos * 64;
#pragma unroll
                    for (int bj = 0; bj < 2; ++bj) {
                        const int c = pn * 256 + bj * 128 + cw;
                        const int i0 = (c & 63) >> 1;
                        const f32x4 cs = *(const f32x4*)(rp + i0), sn = *(const f32x4*)(rp + 32 + i0);
                        const f32x4 v0 = acc[ai][bj][m][0], v1 = acc[ai][bj][m][1];
                        f32x4 o1, o2;
                        o1[0] = v0[0] * cs[0] - v0[1] * sn[0]; o2[0] = v0[1] * cs[0] + v0[0] * sn[0];
                        o1[1] = v0[2] * cs[1] - v0[3] * sn[1]; o2[1] = v0[3] * cs[1] + v0[2] * sn[1];
                        o1[2] = v1[0] * cs[2] - v1[1] * sn[2]; o2[2] = v1[1] * cs[2] + v1[0] * sn[2];
                        o1[3] = v1[2] * cs[3] - v1[3] * sn[3]; o2[3] = v1[3] * cs[3] + v1[2] * sn[3];
                        if (pn < 4) {
                            o1 = o1 * QSCALE; o2 = o2 * QSCALE;
                            u32x4 w; w.x = cvt_pk_bf16(o1[0], o2[0]); w.y = cvt_pk_bf16(o1[1], o2[1]); w.z = cvt_pk_bf16(o1[2], o2[2]); w.w = cvt_pk_bf16(o1[3], o2[3]);
                            *(u32x4*)(Qc + (size_t)row * 1024 + c) = w;
                        } else {
                            const int kvh = (c - 1024) >> 6;
                            if (!smp) {
                                const int b = row >> 11, t = row & 2047;
                                u32x4 w; w.x = cvt_pk_bf16(o1[0], o2[0]); w.y = cvt_pk_bf16(o1[1], o2[1]); w.z = cvt_pk_bf16(o1[2], o2[2]); w.w = cvt_pk_bf16(o1[3], o2[3]);
                                *(u32x4*)(Kc + ((size_t)((b * 4 + kvh) * 2048 + t)) * 64 + (c & 63)) = w;
                                if (t >= 1920) { float* o = oKp + ((size_t)((b * 128 + t - 1920) * 4 + kvh)) * 64 + i0; *(f32x4*)o = o1; *(f32x4*)(o + 32) = o2; }
                            } else {
                                const int bd = (row - MP) >> 2, tt = row & 3;
                                float* o = oKs + ((size_t)((bd * 128 + 124 + tt) * 4 + kvh)) * 64 + i0; *(f32x4*)o = o1; *(f32x4*)(o + 32) = o2;
                            }
                        }
                    }
                }
        } else if (pn == 5) {
#pragma unroll
            for (int ai = 0; ai < 2; ++ai)
#pragma unroll
                for (int m = 0; m < 4; ++m) {
                    const int row = row0 + ai * 128 + m * 16;
                    const bool smp = row >= MP;
#pragma unroll
                    for (int bj = 0; bj < 2; ++bj) {
                        const int cv = bj * 128 + cw;
                        const int kvh = cv >> 6, d0 = cv & 63;
                        const f32x4 v0 = acc[ai][bj][m][0], v1 = acc[ai][bj][m][1];
                        if (!smp) {
                            const int b = row >> 11, t = row & 2047;
                            bf16_t* vp = VTP + ((size_t)((b * 4 + kvh) * 64 + (t >> 5))) * 2048 + d0 * 32 + vperm32(t & 31);
                            const unsigned w0 = cvt_pk_bf16(v0[0], v0[1]), w1 = cvt_pk_bf16(v0[2], v0[3]), w2 = cvt_pk_bf16(v1[0], v1[1]), w3 = cvt_pk_bf16(v1[2], v1[3]);
                            vp[0] = (bf16_t)(w0 & 0xffffu); vp[32] = (bf16_t)(w0 >> 16); vp[64] = (bf16_t)(w1 & 0xffffu); vp[96] = (bf16_t)(w1 >> 16);
                            vp[128] = (bf16_t)(w2 & 0xffffu); vp[160] = (bf16_t)(w2 >> 16); vp[192] = (bf16_t)(w3 & 0xffffu); vp[224] = (bf16_t)(w3 >> 16);
                            if (t >= 1920) { float* o = oVp + ((size_t)((b * 128 + t - 1920) * 4 + kvh)) * 64 + d0; *(f32x4*)o = v0; *(f32x4*)(o + 4) = v1; }
                        } else {
                            const int bd = (row - MP) >> 2, tt = row & 3;
                            float* o = oVs + ((size_t)((bd * 128 + 124 + tt) * 4 + kvh)) * 64 + d0; *(f32x4*)o = v0; *(f32x4*)(o + 4) = v1;
                        }
                    }
                }
        } else {
            const bool gate = (pn < 10) || (pn == 12) || (pn == 13) || (pn >= 18);
            const bool isxb = (pn == 10) || (pn == 11);
#pragma unroll
            for (int ai = 0; ai < 2; ++ai)
#pragma unroll
                for (int m = 0; m < 4; ++m) {
                    const int row = row0 + ai * 128 + m * 16;
                    const bool smp = row >= MP;
#pragma unroll
                    for (int bj = 0; bj < 2; ++bj) {
                        const int c = pn * 256 + bj * 128 + cw;
                        f32x4 v0 = acc[ai][bj][m][0], v1 = acc[ai][bj][m][1];
                        if (isxb) {
                            const int cx = c - 2560;
                            if (!smp) { const int t = row & 2047; if (t >= 2033) { const int b = row >> 11; float* o = oPp + ((size_t)(b * 15 + t - 2033)) * 512 + cx; *(f32x4*)o = v0; *(f32x4*)(o + 4) = v1; } }
                            else { const int bd = (row - MP) >> 2, tt = row & 3; float* o = oPs + ((size_t)(bd * 15 + 11 + tt)) * 512 + cx; *(f32x4*)o = v0; *(f32x4*)(o + 4) = v1; }
                        }
                        if (gate) {
#pragma unroll
                            for (int j = 0; j < 4; ++j) { v0[j] = silu_f(v0[j]); v1[j] = silu_f(v1[j]); }
                        }
                        u32x4 w; w.x = cvt_pk_bf16(v0[0], v0[1]); w.y = cvt_pk_bf16(v0[2], v0[3]); w.z = cvt_pk_bf16(v1[0], v1[1]); w.w = cvt_pk_bf16(v1[2], v1[3]);
                        *(u32x4*)(Z2 + (size_t)row * ZW + (c - 1536)) = w;
                    }
                }
        }
    }
};

struct EpiOut {
    static constexpr bool PERM = true, AFTER_DRAIN = false;
    __device__ __forceinline__ void operator()(const f32x4 (&acc)[2][2][4][2], const Unit& u, int wr, int wc, int fr, int fq) const {
        const __attribute__((address_space(4))) EpiPtrs* kp = (const __attribute__((address_space(4))) EpiPtrs*)__builtin_amdgcn_kernarg_segment_ptr(); asm volatile("" : "+s"(kp));
        bf16_t* C = (bf16_t*)((unsigned char*)kp->ws + EP_Y);
        const int row0 = u.pm * BM + wr * 64 + fr, col0 = u.pn * BM + wc * 32 + 8 * fq;
#pragma unroll
        for (int ai = 0; ai < 2; ++ai)
#pragma unroll
            for (int m = 0; m < 4; ++m) { bf16_t* rowp = C + (size_t)(row0 + ai * HALF + m * 16) * DM + col0;
#pragma unroll
                for (int bj = 0; bj < 2; ++bj) { const f32x4 v0 = acc[ai][bj][m][0], v1 = acc[ai][bj][m][1];
                    u32x4 w; w.x = cvt_pk_bf16(v0[0], v0[1]); w.y = cvt_pk_bf16(v0[2], v0[3]); w.z = cvt_pk_bf16(v1[0], v1[1]); w.w = cvt_pk_bf16(v1[2], v1[3]);
                    *(u32x4*)(rowp + bj * HALF) = w; } }
    }
};
template <class Epi, class Sched, bool ALIGN_EPI = false, bool SP2 = false>
__device__ __forceinline__ void gemm_phase(PG8_LAS unsigned char* lds, const Gemm g, const Sched& S, const Epi& E) {
    int tid_ = threadIdx.x; asm volatile("" : "+v"(tid_));
    const int tid = tid_, wid = __builtin_amdgcn_readfirstlane(tid >> 6), lane = tid & 63, wr = wid >> 2, wc = wid & 3, fr = lane & 15, fq = lane >> 4;
    const int K = g.K, nt = K / BK;
    unsigned voffA[2], voffB[2];
#pragma unroll
    for (int i = 0; i < 2; ++i) { int R, C; stage_rc(tid * 16 + i * 8192, R, C); const int Rb = Epi::PERM ? ((R & ~31) + perm32(R & 31)) : R;
        voffA[i] = (unsigned)(R * K + C) * 2u; voffB[i] = (unsigned)(Rb * K + C) * 2u; }
    const size_t kstep = (size_t)(BK * 2);
    const size_t hstep = (size_t)HALF * K * 2;
    const size_t tstep = 2 * hstep;
    const unsigned ldsw = (unsigned)wid * 1024u;
    const int aoff = lds_byte(wr * 64 + fr, fq * 8), boff = lds_byte(wc * 32 + fr, fq * 8);
#define PG8_SA(b, h) (((b) * 2 + (h)) * HTB)
#define PG8_SB(b, h) ((4 + (b) * 2 + (h)) * HTB)
#define PG8_STAGE(bufoff, gbase, voff) do { _Pragma("unroll") for (int _i = 0; _i < 2; ++_i) \
        __builtin_amdgcn_global_load_lds((const unsigned*)((const char*)(gbase) + (voff)[_i]), (PG8_LAS unsigned*)(lds + (bufoff) + ldsw + _i * 8192), 16, 0, 0); } while (0)
#define PG8_LDA(dst, b, h) do { _Pragma("unroll") for (int m = 0; m < 4; ++m) _Pragma("unroll") for (int k = 0; k < 2; ++k) dst[m][k] = *(const PG8_LAS bf16x8*)(lds + PG8_SA(b, h) + aoff + m * 2048 + k * 1024); } while (0)
#define PG8_LDB(dst, b, h) do { _Pragma("unroll") for (int n = 0; n < 2; ++n) _Pragma("unroll") for (int k = 0; k < 2; ++k) dst[n][k] = *(const PG8_LAS bf16x8*)(lds + PG8_SB(b, h) + boff + n * 2048 + k * 1024); } while (0)
#define PG8_MMA(ai, bj, At, Bt) do { __builtin_amdgcn_s_setprio(1); _Pragma("unroll") for (int m = 0; m < 4; ++m) _Pragma("unroll") for (int n = 0; n < 2; ++n) _Pragma("unroll") for (int k = 0; k < 2; ++k) \
        acc[ai][bj][m][n] = __builtin_amdgcn_mfma_f32_16x16x32_bf16(Bt[n][k], At[m][k], acc[ai][bj][m][n], 0, 0, 0); __builtin_amdgcn_s_setprio(0); } while (0)
#define PG8_WAIT_V(n) asm volatile("s_waitcnt vmcnt(" #n ")" ::: "memory")
#define PG8_WAIT_L(n) asm volatile("s_waitcnt lgkmcnt(" #n ")" ::: "memory")
#define PG8_BAR __builtin_amdgcn_s_barrier()
#define PG8_SCHED __builtin_amdgcn_sched_barrier(0)
    Unit cur, nxt; int ui = 0;
    if (!S.next(0, cur)) return;
    f32x4 acc[2][2][4][2];
#pragma unroll
    for (int a = 0; a < 2; ++a)
#pragma unroll
        for (int b = 0; b < 2; ++b)
#pragma unroll
            for (int m = 0; m < 4; ++m)
#pragma unroll
                for (int n = 0; n < 2; ++n) acc[a][b][m][n] = (f32x4){0.f, 0.f, 0.f, 0.f};
    bf16x8 At[4][2], B0[2][2], B1[2][2];
    const char* cA = (const char*)g.A + (size_t)cur.pm * tstep; const char* cB = (const char*)g.Bt + (size_t)cur.pn * tstep;
    S.a_ready(cur);
    if constexpr (SP2) {
        PG8_STAGE(PG8_SB(0, 0), cB, voffB); PG8_STAGE(PG8_SB(0, 1), cB + hstep, voffB); PG8_STAGE(PG8_SA(0, 0), cA, voffA); PG8_STAGE(PG8_SA(0, 1), cA + hstep, voffA);
        if (wr == 1) PG8_BAR;
        PG8_WAIT_V(2); PG8_BAR;
        PG8_STAGE(PG8_SB(1, 0), cB + kstep, voffB); PG8_STAGE(PG8_SA(1, 0), cA + kstep, voffA); PG8_STAGE(PG8_SB(1, 1), cB + hstep + kstep, voffB);
        PG8_WAIT_V(6); PG8_BAR;
    } else {
        PG8_STAGE(PG8_SB(0, 0), cB, voffB); PG8_STAGE(PG8_SA(0, 0), cA, voffA); PG8_STAGE(PG8_SB(0, 1), cB + hstep, voffB); PG8_STAGE(PG8_SA(0, 1), cA + hstep, voffA);
        if (wr == 1) PG8_BAR;
        PG8_WAIT_V(4); PG8_BAR;
        PG8_STAGE(PG8_SB(1, 0), cB + kstep, voffB); PG8_STAGE(PG8_SA(1, 0), cA + kstep, voffA); PG8_STAGE(PG8_SB(1, 1), cB + hstep + kstep, voffB);
        PG8_WAIT_V(6); PG8_BAR;
    }
    for (;;) {
        const bool has_next = S.next(ui + 1, nxt);
        const char* nA = has_next ? (const char*)g.A + (size_t)nxt.pm * tstep : cA; const char* nB = has_next ? (const char*)g.Bt + (size_t)nxt.pn * tstep : cB;
        for (int t = 0; t < nt; t += 2) {
            const bool last = (t == nt - 2);
            const char* a1 = cA + (size_t)(t + 1) * kstep;
            const char* a2 = last ? nA : cA + (size_t)(t + 2) * kstep; const char* b2 = last ? nB : cB + (size_t)(t + 2) * kstep;
            const char* a3 = a2 + kstep; const char* b3 = b2 + kstep;
            if (last && has_next) S.a_ready(nxt);
            if constexpr (SP2) {
            PG8_LDB(B0, 0, 0); PG8_LDB(B1, 0, 1); PG8_SCHED; PG8_LDA(At, 0, 0); PG8_STAGE(PG8_SA(1, 1), a1 + hstep, voffA);
            PG8_WAIT_V(8); PG8_WAIT_L(0); PG8_BAR; PG8_MMA(0, 0, At, B0); PG8_MMA(0, 1, At, B1); PG8_BAR; PG8_SCHED;
            PG8_LDA(At, 0, 1); PG8_STAGE(PG8_SB(0, 0), b2, voffB); PG8_STAGE(PG8_SB(0, 1), b2 + hstep, voffB); PG8_STAGE(PG8_SA(0, 0), a2, voffA);
            PG8_WAIT_V(8); PG8_WAIT_L(0); PG8_BAR; PG8_MMA(1, 0, At, B0); PG8_MMA(1, 1, At, B1); PG8_BAR; PG8_SCHED;
            PG8_LDB(B0, 1, 0); PG8_LDB(B1, 1, 1); PG8_SCHED; PG8_LDA(At, 1, 0); PG8_STAGE(PG8_SA(0, 1), a2 + hstep, voffA);
            PG8_WAIT_V(8); PG8_WAIT_L(0); PG8_BAR; PG8_MMA(0, 0, At, B0); PG8_MMA(0, 1, At, B1); PG8_BAR; PG8_SCHED;
            PG8_LDA(At, 1, 1); PG8_STAGE(PG8_SB(1, 0), b3, voffB); PG8_STAGE(PG8_SB(1, 1), b3 + hstep, voffB); PG8_STAGE(PG8_SA(1, 0), a3, voffA);
            PG8_WAIT_V(8); PG8_WAIT_L(0); PG8_BAR; PG8_MMA(1, 0, At, B0); PG8_MMA(1, 1, At, B1); PG8_BAR; PG8_SCHED;
            } else {
            PG8_LDB(B0, 0, 0); PG8_SCHED; PG8_LDA(At, 0, 0); PG8_STAGE(PG8_SA(1, 1), a1 + hstep, voffA);
            PG8_WAIT_L(8); PG8_BAR; PG8_WAIT_L(0); PG8_MMA(0, 0, At, B0); PG8_BAR; PG8_SCHED;
            PG8_LDB(B1, 0, 1); PG8_STAGE(PG8_SB(0, 0), b2, voffB);
            PG8_BAR; PG8_WAIT_L(0); PG8_MMA(0, 1, At, B1); PG8_BAR;
            PG8_LDA(At, 0, 1); PG8_STAGE(PG8_SA(0, 0), a2, voffA);
            PG8_BAR; PG8_WAIT_L(0); PG8_MMA(1, 0, At, B0); PG8_BAR; PG8_SCHED;
            PG8_STAGE(PG8_SB(0, 1), b2 + hstep, voffB);
            PG8_WAIT_V(6); PG8_BAR; PG8_MMA(1, 1, At, B1); PG8_BAR;
            PG8_LDB(B0, 1, 0); PG8_SCHED; PG8_LDA(At, 1, 0); PG8_STAGE(PG8_SA(0, 1), a2 + hstep, voffA);
            PG8_WAIT_L(8); PG8_BAR; PG8_WAIT_L(0); PG8_MMA(0, 0, At, B0); PG8_BAR; PG8_SCHED;
            PG8_LDB(B1, 1, 1); PG8_STAGE(PG8_SB(1, 0), b3, voffB);
            PG8_BAR; PG8_WAIT_L(0); PG8_MMA(0, 1, At, B1); PG8_BAR;
            PG8_LDA(At, 1, 1); PG8_STAGE(PG8_SA(1, 0), a3, voffA);
            PG8_BAR; PG8_WAIT_L(0); PG8_MMA(1, 0, At, B0); PG8_BAR; PG8_SCHED;
            PG8_STAGE(PG8_SB(1, 1), b3 + hstep, voffB);
            PG8_WAIT_V(6); PG8_BAR; PG8_MMA(1, 1, At, B1); PG8_BAR;
            }
        }
        if constexpr (ALIGN_EPI) { if (wr == 0) PG8_BAR; }
        if constexpr (!Epi::AFTER_DRAIN) { E(acc, cur, wr, wc, fr, fq); S.done(cur); }
        if (!has_next) break;
#pragma unroll
        for (int a = 0; a < 2; ++a)
#pragma unroll
            for (int b = 0; b < 2; ++b)
#pragma unroll
                for (int m = 0; m < 4; ++m)
#pragma unroll
                    for (int n = 0; n < 2; ++n) acc[a][b][m][n] = (f32x4){0.f, 0.f, 0.f, 0.f};
        cur = nxt; cA = nA; cB = nB; ++ui;
        if constexpr (ALIGN_EPI) { if (wr == 1) PG8_BAR; }
    }
    PG8_WAIT_V(0);
    if constexpr (!ALIGN_EPI) { if (wr == 0) PG8_BAR; }
    PG8_BAR;
    if constexpr (Epi::AFTER_DRAIN) { E.fused(acc, cur, wr, wc, fr, fq, lds, wid, lane); S.done(cur); }
#undef PG8_SA
#undef PG8_SB
#undef PG8_STAGE
#undef PG8_LDA
#undef PG8_LDB
#undef PG8_MMA
#undef PG8_WAIT_V
#undef PG8_WAIT_L
#undef PG8_BAR
#undef PG8_SCHED
}
}
#define GAS __attribute__((address_space(1)))
#define LAS __attribute__((address_space(3)))
typedef GAS unsigned gu32;
typedef GAS unsigned long long gu64;
#define RLX_AGENT __ATOMIC_RELAXED, __HIP_MEMORY_SCOPE_AGENT
#define VM_WAIT() asm volatile("s_waitcnt vmcnt(0)" ::: "memory")
__device__ __forceinline__ unsigned long long rt() { return __builtin_amdgcn_s_memrealtime(); }
__device__ __forceinline__ unsigned f2bf(float f) { unsigned u = __builtin_bit_cast(unsigned, f); return (u + 0x7fffu + ((u >> 16) & 1u)) >> 16; }
__device__ __forceinline__ unsigned pk2(float lo, float hi) { return f2bf(lo) | (f2bf(hi) << 16); }

#define XB_TMO      128
#define XB_XCNT(j)  (256  + 64 * (j))
#define XB_XSUB(j)  (1280 + 64 * (j))
#define XB_XGEN(j)  (2304 + 64 * (j))
#define XB_TOP      3328
#define XB_TOPGEN   3392
#define XCD_BAR_WORDS 3456
#define XB_SPIN_CAP (1u << 18)

__device__ __forceinline__ unsigned xb_ld(unsigned* p)              { return __hip_atomic_load(p, __ATOMIC_RELAXED, __HIP_MEMORY_SCOPE_AGENT); }
__device__ __forceinline__ unsigned xb_add(unsigned* p, unsigned v) { return __hip_atomic_fetch_add(p, v, __ATOMIC_RELAXED, __HIP_MEMORY_SCOPE_AGENT); }
__device__ __forceinline__ unsigned xb_xcc_id() { return (unsigned)__builtin_amdgcn_s_getreg((3 << 11) | 20) & 0xFu; }
#define XB_SPIN(cond, bar) do { unsigned _sp = 0; while (cond) { __builtin_amdgcn_s_sleep(1); \
    if ((++_sp & 255u) == 0u) { if (xb_ld(&(bar)[XB_TMO])) break; if (_sp > XB_SPIN_CAP) { atomicAdd(&(bar)[XB_TMO], 1u); break; } } } } while (0)

struct XcdBarrier {
    unsigned* bar; unsigned x;
    volatile LAS unsigned* st;
};

__device__ __forceinline__ XcdBarrier xcd_barrier_post(unsigned* bar, volatile LAS unsigned* st) {
    XcdBarrier b; b.bar = bar; b.x = xb_xcc_id(); b.st = st;
    if (threadIdx.x == 0) (void)xb_add(&bar[XB_XCNT(b.x)], 1u);
    return b;
}
__device__ __forceinline__ void xcd_barrier_complete(unsigned* bar, unsigned x, unsigned& nloc, unsigned& nx) {
    const unsigned G = gridDim.x * gridDim.y * gridDim.z;
    unsigned sum, cnt, mine, sp = 0u;
    for (;;) {
        sum = 0u; cnt = 0u; mine = 0u;
#pragma unroll
        for (unsigned j = 0; j < 16; ++j) { const unsigned c = xb_ld(&bar[XB_XCNT(j)]); sum += c; cnt += (c > 0u) ? 1u : 0u; mine = (j == x) ? c : mine; }
        if (sum == G) break;
        __builtin_amdgcn_s_sleep(1);
        if ((++sp & 255u) == 0u) { if (xb_ld(&bar[XB_TMO])) break; if (sp > XB_SPIN_CAP) { atomicAdd(&bar[XB_TMO], 1u); break; } }
    }
    nloc = mine > 0u ? mine : 1u; nx = cnt > 0u ? cnt : 1u;
}

__device__ __forceinline__ void xcd_barrier(const XcdBarrier& b) {
    asm volatile("s_waitcnt vmcnt(0)" ::: "memory");
    __syncthreads();
    if (threadIdx.x == 0) {
        unsigned* bar = b.bar;
        __builtin_amdgcn_s_waitcnt(0);
        unsigned nloc = b.st[0], nx = b.st[1];
        if (nloc == 0u) { xcd_barrier_complete(bar, b.x, nloc, nx); b.st[0] = nloc; b.st[1] = nx; }
        const unsigned old = xb_add(&bar[XB_XSUB(b.x)], 1u);
        const unsigned gen = old / nloc;
        if (old + 1u == (gen + 1u) * nloc) {
            __builtin_amdgcn_fence(__ATOMIC_RELEASE, "agent");
            asm volatile("s_waitcnt vmcnt(0)" ::: "memory");
            const unsigned og = xb_add(&bar[XB_TOP], 1u);
            const unsigned tg = og / nx;
            if (og + 1u == (tg + 1u) * nx) xb_add(&bar[XB_TOPGEN], 1u);
            else XB_SPIN(xb_ld(&bar[XB_TOPGEN]) == tg, bar);
            __builtin_amdgcn_fence(__ATOMIC_ACQUIRE, "agent");
            xb_add(&bar[XB_XGEN(b.x)], 1u);
            asm volatile("s_waitcnt vmcnt(0)" ::: "memory");
        } else {
            XB_SPIN(xb_ld(&bar[XB_XGEN(b.x)]) == gen, bar);
            __builtin_amdgcn_fence(__ATOMIC_ACQUIRE, "agent");
            asm volatile("s_waitcnt vmcnt(0)" ::: "memory");
        }
    }
    __syncthreads();
}

using pg8::bf16_t; using pg8::bf16x8; using pg8::f32x4; using pg8::u32x4;
using pg8::DM; using pg8::MP; using pg8::MS; using pg8::MT; using pg8::DIN; using pg8::ZW;
using pg8::Z_GA; using pg8::Z_XB; using pg8::Z_GP; using pg8::Z_U; using pg8::Z_VS; using pg8::Z_GS; using pg8::LOG2E; using pg8::EPS;
typedef float f32x16 __attribute__((ext_vector_type(16)));
typedef unsigned u32x2 __attribute__((ext_vector_type(2)));

constexpr int NWAVES = 8, NTHREADS = 512;
constexpr int LDS_BYTES = 147456;
constexpr int RING_OFF = 1024;

constexpr size_t O_YP = 0, O_YS = 33554432, O_KP = 34603008, O_VP = 35127296, O_PP = 35651584, O_KS = 35774464, O_VS = 44163072, O_PS = 52551680, O_CV = 54517760, O_END = 55042048;
constexpr size_t LS_KP = 262144, LS_PP = 61440, LS_KS = 4194304, LS_PS = 983040, LS_CV = 262144;
constexpr size_t MiB = 1u << 20;
constexpr size_t WS_CTL = 0, CTL_ZERO_BYTES = 65536;
constexpr size_t WS_ROPE = 1 * MiB, WS_SGUW = 2 * MiB, WS_PWT = 2 * MiB + 512 * 1024;
constexpr size_t WS_WTIN = 4 * MiB, WS_WTOUT = 44 * MiB, WS_H = 60 * MiB, WS_MIX = 126 * MiB, WS_QC = 192 * MiB, WS_KC = 225 * MiB, WS_VTP = 233 * MiB, WS_Z2 = 241 * MiB, WS_Y = 357 * MiB, WS_END = 489 * MiB;
constexpr int CW_BAR = 1024;

__constant__ double ROPE_INV[32] = {1.0, 0.7498942093324559, 0.5623413251903491, 0.4216965034285822, 0.31622776601683794, 0.23713737056616552, 0.1778279410038923, 0.1333521432163324, 0.1, 0.07498942093324558, 0.05623413251903491, 0.042169650342858224, 0.03162277660168379, 0.023713737056616554, 0.01778279410038923, 0.01333521432163324, 0.01, 0.007498942093324558, 0.005623413251903491, 0.004216965034285823, 0.0031622776601683794, 0.0023713737056616554, 0.0017782794100389228, 0.001333521432163324, 0.001, 0.0007498942093324559, 0.0005623413251903491, 0.00042169650342858224, 0.00031622776601683794, 0.00023713737056616554, 0.00017782794100389227, 0.0001333521432163324};

struct Args { const float* in[16]; float* out; unsigned char* ws; };

struct Frame {
    int tid, lane, wave, bid, G;
    const float *xp, *xs, *cache_k, *cache_v, *state_pool, *w_in, *w_out, *norm_pre, *norm_post, *sinks, *pool_w, *pool_scale, *ln_g, *ln_b, *sgu_w, *sgu_b;
    float* out;
    float* rope; bf16_t *SGUW, *PWT, *WTIN, *WTOUT, *H, *MIX, *Qc, *Kc, *VTP, *Z2, *Yb;
};

__device__ __forceinline__ float wave_sum(float v) {
#pragma unroll
    for (int o = 1; o < 64; o <<= 1) v += __shfl_xor(v, o);
    return v;
}
__device__ __forceinline__ float wave_max(float v) {
#pragma unroll
    for (int o = 1; o < 64; o <<= 1) v = fmaxf(v, __shfl_xor(v, o));
    return v;
}
__device__ __forceinline__ float bflo(unsigned w) { return __uint_as_float(w << 16); }
__device__ __forceinline__ float bfhi(unsigned w) { return __uint_as_float(w & 0xffff0000u); }
__device__ __forceinline__ void unpack8(const u32x4 w, float (&f)[8]) { f[0] = bflo(w.x); f[1] = bfhi(w.x); f[2] = bflo(w.y); f[3] = bfhi(w.y); f[4] = bflo(w.z); f[5] = bfhi(w.z); f[6] = bflo(w.w); f[7] = bfhi(w.w); }
__device__ __forceinline__ void unpack4(const u32x2 w, float (&f)[4]) { f[0] = bflo(w.x); f[1] = bfhi(w.x); f[2] = bflo(w.y); f[3] = bfhi(w.y); }
__device__ __forceinline__ u32x4 pack8(const float (&f)[8]) { u32x4 w; w.x = pg8::cvt_pk_bf16(f[0], f[1]); w.y = pg8::cvt_pk_bf16(f[2], f[3]); w.z = pg8::cvt_pk_bf16(f[4], f[5]); w.w = pg8::cvt_pk_bf16(f[6], f[7]); return w; }
__device__ __forceinline__ int crow(int r, int hi) { return (r & 3) + 8 * (r >> 2) + 4 * hi; }
#define LDS_WAIT() asm volatile("s_waitcnt lgkmcnt(0)" ::: "memory")


struct ArgsG { const __attribute__((address_space(1))) float* in[16]; __attribute__((address_space(1))) float* out; __attribute__((address_space(1))) unsigned char* ws; };
typedef const __attribute__((address_space(4))) ArgsG* KArgs;
__device__ __forceinline__ KArgs kargs() { KArgs p = (KArgs)__builtin_amdgcn_kernarg_segment_ptr(); asm volatile("" : "+s"(p)); return p; }
__device__ __forceinline__ void make_frame(Frame& F, KArgs a) {
    { int t_ = threadIdx.x; asm volatile("" : "+v"(t_)); F.tid = t_; } F.lane = F.tid & 63; F.wave = __builtin_amdgcn_readfirstlane(F.tid >> 6); F.bid = blockIdx.x; F.G = gridDim.x;
    F.xp = (const float*)a->in[0]; F.xs = (const float*)a->in[1]; F.cache_k = (const float*)a->in[2]; F.cache_v = (const float*)a->in[3]; F.state_pool = (const float*)a->in[4]; F.w_in = (const float*)a->in[5]; F.w_out = (const float*)a->in[6]; F.norm_pre = (const float*)a->in[7]; F.norm_post = (const float*)a->in[8];
    F.sinks = (const float*)a->in[9]; F.pool_w = (const float*)a->in[10]; F.pool_scale = (const float*)a->in[11]; F.ln_g = (const float*)a->in[12]; F.ln_b = (const float*)a->in[13]; F.sgu_w = (const float*)a->in[14]; F.sgu_b = (const float*)a->in[15];
    F.out = (float*)a->out;
    unsigned char* ws = (unsigned char*)a->ws;
    F.rope = (float*)(ws + WS_ROPE); F.SGUW = (bf16_t*)(ws + WS_SGUW); F.PWT = (bf16_t*)(ws + WS_PWT); F.WTIN = (bf16_t*)(ws + WS_WTIN); F.WTOUT = (bf16_t*)(ws + WS_WTOUT);
    F.H = (bf16_t*)(ws + WS_H); F.MIX = (bf16_t*)(ws + WS_MIX); F.Qc = (bf16_t*)(ws + WS_QC); F.Kc = (bf16_t*)(ws + WS_KC); F.VTP = (bf16_t*)(ws + WS_VTP); F.Z2 = (bf16_t*)(ws + WS_Z2); F.Yb = (bf16_t*)(ws + WS_Y);
}

#define LOCAL_FRAME Frame F; make_frame(F, kargs())

constexpr int CW_Q = 8192;
constexpr int CW_ZS = 8192 + 64 * 8;
constexpr int CW_YS = 8192 + 64 * 16;
__device__ __forceinline__ unsigned* ctl_word(int idx) { return (unsigned*)((unsigned char*)kargs()->ws + WS_CTL) + idx; }
__device__ __forceinline__ int q_pop(unsigned* head, LAS unsigned char* L) {
    volatile LAS int* slot = (volatile LAS int*)(L + 64);
    __syncthreads();
    if (threadIdx.x == 0) *slot = (int)__hip_atomic_fetch_add(head, 1u, __ATOMIC_RELAXED, __HIP_MEMORY_SCOPE_AGENT);
    __syncthreads();
    return __builtin_amdgcn_readfirstlane(*slot);
}
__device__ __forceinline__ void publish(unsigned* ctr) {
    asm volatile("s_waitcnt vmcnt(0)" ::: "memory");
    __syncthreads();
    if (threadIdx.x == 0) { __builtin_amdgcn_fence(__ATOMIC_RELEASE, "agent"); asm volatile("s_waitcnt vmcnt(0)" ::: "memory");
        __hip_atomic_fetch_add(ctr, 1u, __ATOMIC_RELAXED, __HIP_MEMORY_SCOPE_AGENT); }
}
__device__ __forceinline__ void dep_wait(unsigned* ctr, unsigned need) {
    if (threadIdx.x == 0) {
        unsigned sp = 0;
        while (__hip_atomic_load(ctr, __ATOMIC_RELAXED, __HIP_MEMORY_SCOPE_AGENT) < need) { __builtin_amdgcn_s_sleep(16); if (++sp > (1u << 21)) break; }
        __builtin_amdgcn_fence(__ATOMIC_ACQUIRE, "agent"); asm volatile("s_waitcnt vmcnt(0)" ::: "memory");
    }
    __syncthreads();
}
struct OneUnit {
    pg8::Unit u;
    __device__ __forceinline__ bool next(int i, pg8::Unit& o) const { if (i) return false; o = u; return true; }
    __device__ __forceinline__ void a_ready(const pg8::Unit&) const {}
    __device__ __forceinline__ void done(const pg8::Unit&) const {}
};

#ifndef PROBE_SEL
#define PROBE_SEL 0
#endif
#if PROBE_SEL
#define STAMP(k) do { if (blockIdx.x == 0 && threadIdx.x == 0) ((LAS unsigned long long*)(L + 256))[k] = __builtin_amdgcn_s_memrealtime(); } while (0)
#define STAMP2(k) do { if (blockIdx.x == 0) { __syncthreads(); if (threadIdx.x == 0) ((LAS unsigned long long*)((LAS unsigned char*)ring - RING_OFF + 256))[k] = __builtin_amdgcn_s_memrealtime(); } } while (0)
#else
#define STAMP(k) do {} while (0)
#define STAMP2(k) do {} while (0)
#endif
#if PROBE_SEL == 1
#define PA0 0
#define PA1 1
#define PB0 1
#define PB1 2
#elif PROBE_SEL == 2
#define PA0 2
#define PA1 3
#define PB0 3
#define PB1 4
#elif PROBE_SEL == 3
#define PA0 4
#define PA1 5
#define PB0 8
#define PB1 9
#elif PROBE_SEL == 4
#define PA0 2
#define PA1 10
#define PB0 10
#define PB1 11
#elif PROBE_SEL == 5
#define PA0 11
#define PA1 12
#define PB0 12
#define PB1 13
#elif PROBE_SEL == 6
#define PA0 5
#define PA1 6
#define PB0 7
#define PB1 8
#endif

__device__ __forceinline__ void p0_transpose(const float* W, int K, int N, bf16_t* WT, bool permqk, LAS float* scr, int item, int lane) {
    const int nblk = N >> 6, kb = item / nblk, nb = item - kb * nblk, k0 = kb * 64, n0 = nb * 64;
#pragma unroll
    for (int i = 0; i < 16; ++i) { const int kk = 4 * i + (lane >> 4), nn = 4 * (lane & 15);
        const f32x4 v = *(const f32x4*)(W + (size_t)(k0 + kk) * N + n0 + nn); *(LAS f32x4*)(scr + kk * 68 + nn) = v; }
    LDS_WAIT();
    const int n = n0 + lane; int nrow = n;
    if (permqk && n < 1280) { const int p = n & 63; nrow = (n & ~63) + 2 * (p & 31) + (p >> 5); }
    bf16_t* dst = WT + (size_t)nrow * K + k0;
#pragma unroll
    for (int c = 0; c < 8; ++c) { float f[8];
#pragma unroll
        for (int j = 0; j < 8; ++j) f[j] = scr[(8 * c + j) * 68 + lane];
        *(u32x4*)(dst + 8 * c) = pack8(f); }
    LDS_WAIT();
}
__device__ __forceinline__ void prenorm_row(const float* xrow, const float* g, bf16_t* hrow, int lane) {
    f32x4 v[8]; float ss = 0.f;
#pragma unroll
    for (int j = 0; j < 8; ++j) { v[j] = *(const f32x4*)(xrow + 4 * lane + 256 * j); ss += (v[j][0] * v[j][0] + v[j][1] * v[j][1]) + (v[j][2] * v[j][2] + v[j][3] * v[j][3]); }
    ss = wave_sum(ss);
    const float r = rsqrtf(ss * (1.0f / 2048.0f) + EPS);
#pragma unroll
    for (int j = 0; j < 8; ++j) { const f32x4 gg = *(const f32x4*)(g + 4 * lane + 256 * j); const f32x4 o = v[j] * r * gg;
        u32x2 w; w.x = pg8::cvt_pk_bf16(o[0], o[1]); w.y = pg8::cvt_pk_bf16(o[2], o[3]); *(u32x2*)(hrow + 4 * lane + 256 * j) = w; }
}
__device__ __forceinline__ void p0_prologue(const Frame& F, LAS unsigned char* ring) {
    LAS float* scr = (LAS float*)(ring + F.wave * 17408);
    const int gw = F.bid * NWAVES + F.wave, NGW = F.G * NWAVES;
    constexpr int I_IN = 32 * 80, I_OUT = 32 * 32, NITEMS = 2 * (I_IN + I_OUT);
    for (int it = gw; it < NITEMS; it += NGW) {
        int r = it;
        if (r < 2 * I_IN) { const int l = r / I_IN; r -= l * I_IN; p0_transpose(F.w_in + (size_t)l * DM * DIN, DM, DIN, F.WTIN + (size_t)l * DIN * DM, true, scr, r, F.lane); }
        else { r -= 2 * I_IN; const int l = r / I_OUT; r -= l * I_OUT; p0_transpose(F.w_out + (size_t)l * DM * DM, DM, DM, F.WTOUT + (size_t)l * DM * DM, false, scr, r, F.lane); }
    }
    for (int m = gw; m < MT; m += NGW) { const float* xr = m < MP ? F.xp + (size_t)m * DM : F.xs + (size_t)(m - MP) * DM; prenorm_row(xr, F.norm_pre, F.H + (size_t)m * DM, F.lane); }
    const int gt = F.bid * NTHREADS + F.tid, NGT = F.G * NTHREADS;
    for (int e = gt; e < 2052 * 32; e += NGT) { const int tp = e >> 5, i = e & 31; const double pos = (double)(tp < 2048 ? tp : 8192 + (tp - 2048));
        const double rev = pos * ROPE_INV[i] * 0.15915494309189535; const float fr = (float)(rev - floor(rev));
        F.rope[tp * 64 + i] = __builtin_amdgcn_cosf(fr); F.rope[tp * 64 + 32 + i] = __builtin_amdgcn_sinf(fr); }
    for (int e = gt; e < 2 * 4 * 128 * 128; e += NGT) { const int s = e & 127, t = (e >> 7) & 127; const float w = F.sgu_w[e];
        F.SGUW[e] = (bf16_t)(pg8::cvt_pk_bf16(s <= t ? w : 0.f, 0.f) & 0xffffu); }
    for (int e = gt; e < 2 * 4 * 128 * 128; e += NGT) { const int c = e & 127, d = (e >> 7) & 127, lg = e >> 14;
        F.PWT[e] = (bf16_t)(pg8::cvt_pk_bf16(F.pool_w[((size_t)lg * 128 + c) * 128 + d], 0.f) & 0xffffu); }
}

constexpr int AT_K = 0, AT_V = 49152, AT_STG = 98304, AT_WSTRIDE = 4352;
__device__ __forceinline__ void attn_stage_kv(const Frame& F, int b, int kvh, int nbp, LAS unsigned char* ring) {
    const int tid = F.tid;
    const bf16_t* kg = F.Kc + ((size_t)(b * 4 + kvh) * 2048 + 256 * nbp - 128) * 64;
    const bf16_t* vg = F.VTP + ((size_t)(b * 4 + kvh) * 64 + 8 * nbp - 4) * 2048;
    u32x4 kv[6], vv[6];
#pragma unroll
    for (int i = 0; i < 6; ++i) { const int ch = tid + 512 * i, row0 = ch >> 3, c8 = ch & 7, row = (nbp > 0 || row0 >= 128) ? row0 : row0 + 128;
        kv[i] = *(const u32x4*)(kg + row * 64 + c8 * 8); }
#pragma unroll
    for (int i = 0; i < 6; ++i) { const int ch = tid + 512 * i, tile0 = ch >> 8, rem = ch & 255, d = rem >> 2, c4 = rem & 3, tile = (nbp > 0 || tile0 >= 4) ? tile0 : tile0 + 4;
        vv[i] = *(const u32x4*)(vg + tile * 2048 + d * 32 + c4 * 8); }
#pragma unroll
    for (int i = 0; i < 6; ++i) { const int ch = tid + 512 * i, row = ch >> 3, c8 = ch & 7;
        *(LAS u32x4*)(ring + AT_K + row * 128 + ((c8 ^ (row & 7)) << 4)) = kv[i]; }
#pragma unroll
    for (int i = 0; i < 6; ++i) { const int ch = tid + 512 * i, tile = ch >> 8, rem = ch & 255, d = rem >> 2, c4 = rem & 3;
        *(LAS u32x4*)(ring + AT_V + tile * 4096 + d * 64 + ((c4 ^ ((d >> 2) & 3)) << 4)) = vv[i]; }
}
__device__ __forceinline__ void attn_task(const Frame& F, int l, int b, int nbp, int head, int j, const bf16x8 (&qf)[4], LAS unsigned char* ring) {
    const int lane = F.lane, r = lane & 31, hh = lane >> 5;
    LAS unsigned char* wl = ring + AT_STG + F.wave * AT_WSTRIDE;
    LAS float* wsf = (LAS float*)wl; LAS bf16_t* stg = (LAS bf16_t*)(wl + 256);
    const size_t qrow0 = (size_t)b * 2048 + 256 * nbp + 32 * j;
    u32x4 gv[4];
#pragma unroll
    for (int i = 0; i < 4; ++i) gv[i] = *(const u32x4*)(F.Z2 + (qrow0 + i * 8 + (lane >> 3)) * ZW + Z_GA + head * 64 + (lane & 7) * 8);
    const int cmin = (nbp > 0) ? 0 : (j < 4 ? 4 - j : 0);
    f32x16 S[5];
#pragma unroll
    for (int c = 0; c < 5; ++c) {
        f32x16 a;
#pragma unroll
        for (int i = 0; i < 16; ++i) a[i] = 0.f;
        if (c >= cmin) {
            LAS unsigned char* kp = ring + AT_K + (32 * (j + c) + r) * 128;
#pragma unroll
            for (int s = 0; s < 4; ++s) a = __builtin_amdgcn_mfma_f32_32x32x16_bf16(*(const LAS bf16x8*)(kp + (((2 * s + hh) ^ (r & 7)) << 4)), qf[s], a, 0, 0, 0);
        }
        S[c] = a;
    }
    const float NEG = -INFINITY;
#pragma unroll
    for (int i = 0; i < 16; ++i) { const int kap = crow(i, hh); if (kap <= r) S[0][i] = NEG; if (kap > r) S[4][i] = NEG; }
    const float sink2 = F.sinks[l * 16 + head] * LOG2E;
    float m = sink2;
#pragma unroll
    for (int c = 0; c < 5; ++c) if (c >= cmin) {
#pragma unroll
        for (int i = 0; i < 16; ++i) m = fmaxf(m, S[c][i]); }
    m = fmaxf(m, __shfl_xor(m, 32));
    float sum = 0.f;
#pragma unroll
    for (int c = 0; c < 5; ++c) if (c >= cmin) {
#pragma unroll
        for (int i = 0; i < 16; ++i) { const float p = __builtin_amdgcn_exp2f(S[c][i] - m); S[c][i] = p; sum += p; } }
    sum += __shfl_xor(sum, 32);
    const float inv = 1.0f / (sum + __builtin_amdgcn_exp2f(sink2 - m));
    f32x16 o[2];
#pragma unroll
    for (int i = 0; i < 16; ++i) { o[0][i] = 0.f; o[1][i] = 0.f; }
#pragma unroll
    for (int c = 0; c < 5; ++c) if (c >= cmin) {
        LAS unsigned char* vt = ring + AT_V + (j + c) * 4096 + r * 64;
#pragma unroll
        for (int s = 0; s < 2; ++s) {
            u32x4 pw; pw.x = pg8::cvt_pk_bf16(S[c][8 * s + 0], S[c][8 * s + 1]); pw.y = pg8::cvt_pk_bf16(S[c][8 * s + 2], S[c][8 * s + 3]);
            pw.z = pg8::cvt_pk_bf16(S[c][8 * s + 4], S[c][8 * s + 5]); pw.w = pg8::cvt_pk_bf16(S[c][8 * s + 6], S[c][8 * s + 7]);
            const bf16x8 pa = __builtin_bit_cast(bf16x8, pw);
            const int sw = (((2 * hh + s) ^ ((r >> 2) & 3)) << 4);
#pragma unroll
            for (int db = 0; db < 2; ++db) o[db] = __builtin_amdgcn_mfma_f32_32x32x16_bf16(pa, *(const LAS bf16x8*)(vt + db * 2048 + sw), o[db], 0, 0, 0);
        }
    }
    if (hh == 0) wsf[r] = inv;
    LDS_WAIT();
#pragma unroll
    for (int i = 0; i < 16; ++i) { const int q = crow(i, hh); const float rl = wsf[q];
        stg[q * 64 + r] = (bf16_t)(pg8::cvt_pk_bf16(o[0][i] * rl, 0.f) & 0xffffu);
        stg[q * 64 + 32 + r] = (bf16_t)(pg8::cvt_pk_bf16(o[1][i] * rl, 0.f) & 0xffffu); }
    LDS_WAIT();
#pragma unroll
    for (int i = 0; i < 4; ++i) { const int row = i * 8 + (lane >> 3), ch = lane & 7;
        const u32x4 ov = *(const LAS u32x4*)(stg + row * 64 + ch * 8);
        float of[8], gf[8]; unpack8(ov, of); unpack8(gv[i], gf);
#pragma unroll
        for (int jj = 0; jj < 8; ++jj) of[jj] *= gf[jj];
        *(u32x4*)(F.MIX + (qrow0 + row) * DM + head * 64 + ch * 8) = pack8(of); }
    LDS_WAIT();
}
__device__ __forceinline__ void attn_unit(int l, int a, LAS unsigned char* ring) {
    LOCAL_FRAME;
    const int kvh = a & 3, nbp = (a >> 2) & 7, b = a >> 5;
    const int lane = F.lane, r = lane & 31, hh = lane >> 5;
    const int head = 4 * kvh + (F.wave >> 1), j0 = 4 * (F.wave & 1);
    const bf16_t* qp = F.Qc + ((size_t)b * 2048 + 256 * nbp + 32 * j0 + r) * 1024 + head * 64 + 8 * hh;
    bf16x8 qa[4], qb[4];
#pragma unroll
    for (int s = 0; s < 4; ++s) qa[s] = *(const bf16x8*)(qp + 16 * s);
#ifdef EXP_ZERO_LDS
    for (int e = F.tid; e < 134144 / 16; e += NTHREADS) *(LAS u32x4*)(ring + 16 * e) = (u32x4){0u, 0u, 0u, 0u};
    LDS_WAIT(); __syncthreads();
#endif
    attn_stage_kv(F, b, kvh, nbp, ring);
    LDS_WAIT();
    __syncthreads();
#pragma unroll
    for (int s = 0; s < 4; ++s) qb[s] = *(const bf16x8*)(qp + 32 * 1024 + 16 * s);
    attn_task(F, l, b, nbp, head, j0 + 0, qa, ring);
#pragma unroll
    for (int s = 0; s < 4; ++s) qa[s] = *(const bf16x8*)(qp + 64 * 1024 + 16 * s);
    attn_task(F, l, b, nbp, head, j0 + 1, qb, ring);
#pragma unroll
    for (int s = 0; s < 4; ++s) qb[s] = *(const bf16x8*)(qp + 96 * 1024 + 16 * s);
    attn_task(F, l, b, nbp, head, j0 + 2, qa, ring);
    attn_task(F, l, b, nbp, head, j0 + 3, qb, ring);
    __syncthreads();
}

template <bool SAMPLE, int G>
__device__ __forceinline__ void pool_unit(int l, int tile) {
    LOCAL_FRAME;
    constexpr int W = 2 << G;
    const int lane = F.lane, r = lane & 31, hh = lane >> 5;
    const size_t row = (size_t)(SAMPLE ? MP : 0) + 32 * tile + r;
    const int t = SAMPLE ? (int)(row & 3) : (int)(row & 2047);
    const int bd = SAMPLE ? (int)((row - MP) >> 2) : 0;
    const float icnt = SAMPLE ? 1.0f / (float)W : 1.0f / (float)(W < t + 1 ? W : t + 1);
    bf16x8 bfr[8];
#pragma unroll
    for (int s = 0; s < 8; ++s) {
        const int c0 = 128 * G + 16 * s + 8 * hh;
        float sum[8];
        if (!SAMPLE) {
            u32x4 x[W];
#pragma unroll
            for (int i = 0; i < W; ++i) { const int back = i <= t ? i : t;
                x[i] = *(const u32x4*)(F.Z2 + (row - back) * ZW + Z_XB + c0); }
            float cur[8]; unpack8(x[0], cur);
#pragma unroll
            for (int jj = 0; jj < 8; ++jj) sum[jj] = cur[jj];
#pragma unroll
            for (int i = 1; i < W; ++i) { float f[8]; unpack8(x[i], f); const float wgt = i <= t ? 1.f : 0.f;
#pragma unroll
                for (int jj = 0; jj < 8; ++jj) sum[jj] += wgt * f[jj]; }
#pragma unroll
            for (int jj = 0; jj < 8; ++jj) sum[jj] = sum[jj] * icnt - cur[jj];
        } else {
            float cur[8];
#pragma unroll
            for (int jj = 0; jj < 8; ++jj) { sum[jj] = 0.f; cur[jj] = 0.f; }
#pragma unroll 1
            for (int i = 0; i < W; ++i) { float f[8]; const int e = t - i;
                if (e >= 0) unpack8(*(const u32x4*)(F.Z2 + (row - i) * ZW + Z_XB + c0), f);
                else { const float* sp = F.state_pool + (((size_t)l * 128 + bd) * 15 + 15 + e) * 512 + c0;
                    const f32x4 a = *(const f32x4*)sp, bq = *(const f32x4*)(sp + 4); f[0] = a[0]; f[1] = a[1]; f[2] = a[2]; f[3] = a[3]; f[4] = bq[0]; f[5] = bq[1]; f[6] = bq[2]; f[7] = bq[3]; }
#pragma unroll
                for (int jj = 0; jj < 8; ++jj) sum[jj] += f[jj];
                if (i == 0) {
#pragma unroll
                    for (int jj = 0; jj < 8; ++jj) cur[jj] = f[jj]; } }
#pragma unroll
            for (int jj = 0; jj < 8; ++jj) sum[jj] = sum[jj] * icnt - cur[jj];
        }
        bfr[s] = __builtin_bit_cast(bf16x8, pack8(sum));
    }
    f32x16 acc[4];
#pragma unroll
    for (int db = 0; db < 4; ++db) {
#pragma unroll
        for (int i = 0; i < 16; ++i) acc[db][i] = 0.f;
        const bf16_t* ap = F.PWT + ((size_t)(l * 4 + G) * 128 + 32 * db + r) * 128 + 8 * hh;
#pragma unroll
        for (int s = 0; s < 8; ++s) acc[db] = __builtin_amdgcn_mfma_f32_32x32x16_bf16(*(const bf16x8*)(ap + 16 * s), bfr[s], acc[db], 0, 0, 0);
        __builtin_amdgcn_sched_barrier(0);
    }
#pragma unroll
    for (int db = 0; db < 4; ++db)
#pragma unroll
        for (int q = 0; q < 4; ++q) {
            const int col = 128 * G + 32 * db + 8 * q + 4 * hh;
            const f32x4 sc = *(const f32x4*)(F.pool_scale + l * 512 + col);
            float gf[4]; unpack4(*(const u32x2*)(F.Z2 + row * ZW + Z_GP + col), gf);
            u32x2 wv; wv.x = pg8::cvt_pk_bf16(acc[db][4 * q + 0] * sc[0] * gf[0], acc[db][4 * q + 1] * sc[1] * gf[1]);
            wv.y = pg8::cvt_pk_bf16(acc[db][4 * q + 2] * sc[2] * gf[2], acc[db][4 * q + 3] * sc[3] * gf[3]);
            *(u32x2*)(F.MIX + row * DM + 1024 + col) = wv;
        }
}
template <bool SAMPLE>
__device__ __forceinline__ void pool_dispatch(int l, int g, int tile) {
    if (g == 0) pool_unit<SAMPLE, 0>(l, tile); else if (g == 1) pool_unit<SAMPLE, 1>(l, tile); else if (g == 2) pool_unit<SAMPLE, 2>(l, tile); else pool_unit<SAMPLE, 3>(l, tile);
}

__device__ __forceinline__ void sgu_unit(int l, int ci, int hp, LAS unsigned char* ring) {
    LOCAL_FRAME;
    LAS bf16_t* VnT = (LAS bf16_t*)ring;
    const int lane = F.lane, wv = F.wave;
    const size_t R0 = (size_t)128 * ci;
    {
        const int tl = lane >> 2, q4 = lane & 3;
        const bf16_t* vrow = F.Z2 + (R0 + 16 * wv + tl) * ZW + Z_VS + 32 * q4;
        u32x4 x[4][4];
#pragma unroll
        for (int h = 0; h < 4; ++h)
#pragma unroll
            for (int i = 0; i < 4; ++i) x[h][i] = *(const u32x4*)(vrow + 128 * h + 8 * i);
        float s = 0.f, ss = 0.f;
#pragma unroll
        for (int h = 0; h < 4; ++h)
#pragma unroll
            for (int i = 0; i < 4; ++i) { float f[8]; unpack8(x[h][i], f);
#pragma unroll
                for (int jj = 0; jj < 8; ++jj) { s += f[jj]; ss += f[jj] * f[jj]; } }
        s += __shfl_xor(s, 1); s += __shfl_xor(s, 2); ss += __shfl_xor(ss, 1); ss += __shfl_xor(ss, 2);
        const float mean = s * (1.0f / 512.0f), var = ss * (1.0f / 512.0f) - mean * mean, rstd = rsqrtf(var + EPS);
#pragma unroll
        for (int h2 = 0; h2 < 2; ++h2) {
            const int hd = 2 * hp + h2;
#pragma unroll
            for (int i = 0; i < 4; ++i) { const int d = 32 * q4 + 8 * i;
                const u32x4 xv = hp ? x[2 + h2][i] : x[h2][i];
                float f[8]; unpack8(xv, f);
                const float* gp = F.ln_g + l * 512 + 128 * hd + d; const float* bp = F.ln_b + l * 512 + 128 * hd + d;
                const f32x4 g0 = *(const f32x4*)gp, g1 = *(const f32x4*)(gp + 4), b0 = *(const f32x4*)bp, b1 = *(const f32x4*)(bp + 4);
#pragma unroll
                for (int jj = 0; jj < 8; ++jj) { const float gg = jj < 4 ? g0[jj & 3] : g1[jj & 3], bb = jj < 4 ? b0[jj & 3] : b1[jj & 3];
                    const float vn = (f[jj] - mean) * rstd * gg + bb;
                    VnT[(h2 * 128 + d + jj) * 136 + 16 * wv + tl] = (bf16_t)(pg8::cvt_pk_bf16(vn, 0.f) & 0xffffu); } }
        }
    }
    LDS_WAIT();
    __syncthreads();
    {
        const int r = lane & 31, hh = lane >> 5, db = wv & 3; const int tbA = (wv >> 2) ? 1 : 0, tbB = (wv >> 2) ? 2 : 3;
#pragma unroll
        for (int h2 = 0; h2 < 2; ++h2) {
            const int hd = 2 * hp + h2;
            const bf16_t* Wb = F.SGUW + (size_t)(l * 4 + hd) * 128 * 128;
            bf16x8 wB[8], wA[4];
#pragma unroll
            for (int s = 0; s < 8; ++s) { wB[s] = (bf16x8){0, 0, 0, 0, 0, 0, 0, 0}; if (s < 2 * (tbB + 1)) wB[s] = *(const bf16x8*)(Wb + (32 * tbB + r) * 128 + 16 * s + 8 * hh); }
#pragma unroll
            for (int s = 0; s < 4; ++s) { wA[s] = (bf16x8){0, 0, 0, 0, 0, 0, 0, 0}; if (s < 2 * (tbA + 1)) wA[s] = *(const bf16x8*)(Wb + (32 * tbA + r) * 128 + 16 * s + 8 * hh); }
            u32x2 uu[2][4], gg[2][4]; float bias[2];
#pragma unroll
            for (int pass = 0; pass < 2; ++pass) { const int tb = pass ? tbB : tbA; const size_t row = R0 + 32 * tb + r; bias[pass] = F.sgu_b[l * 512 + hd * 128 + 32 * tb + r];
#pragma unroll
                for (int q = 0; q < 4; ++q) { const int col = 128 * hd + 32 * db + 8 * q + 4 * hh;
                    uu[pass][q] = *(const u32x2*)(F.Z2 + row * ZW + Z_U + col); gg[pass][q] = *(const u32x2*)(F.Z2 + row * ZW + Z_GS + col); } }
            f32x16 accA, accB;
#pragma unroll
            for (int i = 0; i < 16; ++i) { accA[i] = 0.f; accB[i] = 0.f; }
#pragma unroll
            for (int s = 0; s < 8; ++s) {
                if (s < 2 * (tbB + 1)) {
                    const bf16x8 a = *(const LAS bf16x8*)(VnT + (h2 * 128 + 32 * db + r) * 136 + 16 * s + 8 * hh);
                    accB = __builtin_amdgcn_mfma_f32_32x32x16_bf16(a, wB[s], accB, 0, 0, 0);
                    if (s < 4) { if (s < 2 * (tbA + 1)) accA = __builtin_amdgcn_mfma_f32_32x32x16_bf16(a, wA[s], accA, 0, 0, 0); }
                }
            }
#pragma unroll
            for (int pass = 0; pass < 2; ++pass) {
                const int tb = pass ? tbB : tbA; const f32x16 acc = pass ? accB : accA;
                const size_t row = R0 + 32 * tb + r; const float bs = bias[pass];
#pragma unroll
                for (int q = 0; q < 4; ++q) { const int col = 128 * hd + 32 * db + 8 * q + 4 * hh;
                    float uf[4], gf[4]; unpack4(uu[pass][q], uf); unpack4(gg[pass][q], gf);
                    u32x2 wo; wo.x = pg8::cvt_pk_bf16((acc[4 * q + 0] + bs) * uf[0] * gf[0], (acc[4 * q + 1] + bs) * uf[1] * gf[1]);
                    wo.y = pg8::cvt_pk_bf16((acc[4 * q + 2] + bs) * uf[2] * gf[2], (acc[4 * q + 3] + bs) * uf[3] * gf[3]);
                    *(u32x2*)(F.MIX + row * DM + 1536 + col) = wo; }
            }
        }
    }
    __syncthreads();
}

__device__ __forceinline__ void samp_attn(int l, int bd, int kvh, LAS unsigned char* wl) {
    LOCAL_FRAME;
    LAS float* ps = (LAS float*)wl;
    LAS float* invs = ps + 144 * 16;
    const int lane = F.lane, fr = lane & 15, fq = lane >> 4, gq = fr >> 2, tt = fr & 3;
    float* oKs = F.out + O_KS + (size_t)l * LS_KS; float* oVs = F.out + O_VS + (size_t)l * LS_KS;
    bf16x8 qfr[2];
    {
        const bf16_t* qsrc = F.Qc + ((size_t)MP + 4 * bd + tt) * 1024 + (4 * kvh + gq) * 64 + 16 * fq;
        const u32x4 qa = *(const u32x4*)qsrc, qb = *(const u32x4*)(qsrc + 8);
        u32x4 lo, hi;
        lo.x = (qa.x & 0xffffu) | (qa.y << 16); lo.y = (qa.z & 0xffffu) | (qa.w << 16); lo.z = (qb.x & 0xffffu) | (qb.y << 16); lo.w = (qb.z & 0xffffu) | (qb.w << 16);
        hi.x = (qa.x >> 16) | (qa.y & 0xffff0000u); hi.y = (qa.z >> 16) | (qa.w & 0xffff0000u); hi.z = (qb.x >> 16) | (qb.y & 0xffff0000u); hi.w = (qb.z >> 16) | (qb.w & 0xffff0000u);
        qfr[0] = __builtin_bit_cast(bf16x8, lo); qfr[1] = __builtin_bit_cast(bf16x8, hi);
    }
    const float* kc = F.cache_k + (((size_t)l * 128 + bd) * 128) * 256 + kvh * 64 + 8 * fq;
    const float* kn = oKs + (((size_t)bd * 128 + 124 + (fr & 3)) * 4 + kvh) * 64 + 8 * fq;
    float* kd = oKs + ((size_t)bd * 128 * 4 + kvh) * 64 + 8 * fq;
    f32x4 S[9];
#pragma unroll
    for (int T = 0; T < 9; ++T) S[T] = (f32x4){0.f, 0.f, 0.f, 0.f};
#pragma unroll
    for (int T0 = 0; T0 < 9; T0 += 3) {
        f32x4 x[3][2][2];
#pragma unroll
        for (int u = 0; u < 3; ++u) { const int T = T0 + u; const float* src = (T < 8) ? kc + (size_t)(16 * T + fr) * 256 : kn;
#pragma unroll
            for (int ks = 0; ks < 2; ++ks) { x[u][ks][0] = *(const f32x4*)(src + 32 * ks); x[u][ks][1] = *(const f32x4*)(src + 32 * ks + 4); } }
#pragma unroll
        for (int u = 0; u < 3; ++u) { const int T = T0 + u; const int key = 16 * T + fr;
            if (T < 8 && key >= 4) {
#pragma unroll
                for (int ks = 0; ks < 2; ++ks) { float* dst = kd + (size_t)(key - 4) * 256 + 32 * ks; *(f32x4*)dst = x[u][ks][0]; *(f32x4*)(dst + 4) = x[u][ks][1]; } } }
#pragma unroll
        for (int u = 0; u < 3; ++u)
#pragma unroll
            for (int ks = 0; ks < 2; ++ks) { u32x4 w; w.x = pg8::cvt_pk_bf16(x[u][ks][0][0], x[u][ks][0][1]); w.y = pg8::cvt_pk_bf16(x[u][ks][0][2], x[u][ks][0][3]);
                w.z = pg8::cvt_pk_bf16(x[u][ks][1][0], x[u][ks][1][1]); w.w = pg8::cvt_pk_bf16(x[u][ks][1][2], x[u][ks][1][3]);
                S[T0 + u] = __builtin_amdgcn_mfma_f32_16x16x32_bf16(__builtin_bit_cast(bf16x8, w), qfr[ks], S[T0 + u], 0, 0, 0); }
        __builtin_amdgcn_sched_barrier(0);
    }
    const float sink2 = F.sinks[l * 16 + 4 * kvh + gq] * LOG2E;
    float m = sink2;
#pragma unroll
    for (int T = 0; T < 9; ++T)
#pragma unroll
        for (int rg = 0; rg < 4; ++rg) { const int key = 16 * T + 4 * fq + rg; const bool ok = (T < 8) ? (key >= tt + 1) : (fq == 0 && rg <= tt);
            S[T][rg] = ok ? S[T][rg] : -INFINITY; m = fmaxf(m, S[T][rg]); }
    m = fmaxf(m, __shfl_xor(m, 16)); m = fmaxf(m, __shfl_xor(m, 32));
    float sum = 0.f;
#pragma unroll
    for (int T = 0; T < 9; ++T)
#pragma unroll
        for (int rg = 0; rg < 4; ++rg) { const float p = __builtin_amdgcn_exp2f(S[T][rg] - m); sum += p; ps[(16 * T + 4 * fq + rg) * 16 + fr] = p; }
    sum += __shfl_xor(sum, 16); sum += __shfl_xor(sum, 32);
    if (fq == 0) invs[fr] = 1.0f / (sum + __builtin_amdgcn_exp2f(sink2 - m));
    LDS_WAIT();
    const int kq = lane >> 4, dq = lane & 15;
    const float* vcp = F.cache_v + (((size_t)l * 128 + bd) * 128 + kq) * 256 + kvh * 64 + 4 * dq;
    float* vop = oVs + ((size_t)bd * 128 + kq) * 256 + kvh * 64 + 4 * dq;
#pragma unroll 1
    for (int pass = 0; pass < 2; ++pass) {
        float o[8][4];
#pragma unroll
        for (int q = 0; q < 8; ++q) { o[q][0] = 0.f; o[q][1] = 0.f; o[q][2] = 0.f; o[q][3] = 0.f; }
#pragma unroll 1
        for (int blk = 0; blk < 3; ++blk) {
            f32x4 vx[11];
#pragma unroll
            for (int ii = 0; ii < 11; ++ii) { const int i = blk * 11 + ii; const float* src = (i < 32) ? vcp + (size_t)i * 1024 : vop + (size_t)31 * 1024; vx[ii] = *(const f32x4*)src; }
            if (pass == 0) {
#pragma unroll
                for (int ii = 0; ii < 11; ++ii) { const int i = blk * 11 + ii; if (i >= 1 && i < 32) *(f32x4*)(vop + (size_t)(i - 1) * 1024) = vx[ii]; } }
#pragma unroll
            for (int ii = 0; ii < 11; ++ii) { const int key = 4 * (blk * 11 + ii) + kq;
                const f32x4 pa = *(const LAS f32x4*)(ps + key * 16 + 8 * pass), pb = *(const LAS f32x4*)(ps + key * 16 + 8 * pass + 4);
#pragma unroll
                for (int e = 0; e < 4; ++e) { o[0][e] += pa[0] * vx[ii][e]; o[1][e] += pa[1] * vx[ii][e]; o[2][e] += pa[2] * vx[ii][e]; o[3][e] += pa[3] * vx[ii][e];
                    o[4][e] += pb[0] * vx[ii][e]; o[5][e] += pb[1] * vx[ii][e]; o[6][e] += pb[2] * vx[ii][e]; o[7][e] += pb[3] * vx[ii][e]; }
                __builtin_amdgcn_sched_barrier(0); }
        }
#pragma unroll
        for (int q = 0; q < 8; ++q)
#pragma unroll
            for (int e = 0; e < 4; ++e) { float v = o[q][e]; v += __shfl_xor(v, 16); v += __shfl_xor(v, 32); o[q][e] = v; }
#pragma unroll
        for (int q = 0; q < 8; ++q) if ((q >> 1) == kq) { const int qq = 8 * pass + q, t2 = qq & 3, head = 4 * kvh + (qq >> 2); const size_t row = (size_t)MP + 4 * bd + t2;
            float gf[4]; unpack4(*(const u32x2*)(F.Z2 + row * ZW + Z_GA + head * 64 + 4 * dq), gf);
            const float iq = invs[qq];
            u32x2 wv; wv.x = pg8::cvt_pk_bf16(o[q][0] * iq * gf[0], o[q][1] * iq * gf[1]); wv.y = pg8::cvt_pk_bf16(o[q][2] * iq * gf[2], o[q][3] * iq * gf[3]);
            *(u32x2*)(F.MIX + row * DM + head * 64 + 4 * dq) = wv; }
    }
    LDS_WAIT();
}
__device__ __forceinline__ void samp_sgu(int l, int bd) {
    LOCAL_FRAME;
    const int lane = F.lane, c0 = 8 * lane, hd = lane >> 4;
    {
        float* oPs = F.out + O_PS + (size_t)l * LS_PS + (size_t)bd * 15 * 512; const float* sp = F.state_pool + (size_t)l * LS_PS + (size_t)bd * 15 * 512 + 4 * 512;
        f32x4 cp[22];
#pragma unroll
        for (int k = 0; k < 22; ++k) cp[k] = *(const f32x4*)(sp + 4 * (lane + 64 * k));
#pragma unroll
        for (int k = 0; k < 22; ++k) *(f32x4*)(oPs + 4 * (lane + 64 * k)) = cp[k];
    }
    float* oCV = F.out + O_CV + (size_t)l * LS_CV;
    float gl[8], bl[8];
#pragma unroll
    for (int j = 0; j < 8; ++j) { gl[j] = F.ln_g[l * 512 + c0 + j]; bl[j] = F.ln_b[l * 512 + c0 + j]; }
    u32x4 xr[4], ur[4], gr[4];
#pragma unroll
    for (int tt = 0; tt < 4; ++tt) { const size_t row = (size_t)MP + 4 * bd + tt; xr[tt] = *(const u32x4*)(F.Z2 + row * ZW + Z_VS + c0); ur[tt] = *(const u32x4*)(F.Z2 + row * ZW + Z_U + c0); gr[tt] = *(const u32x4*)(F.Z2 + row * ZW + Z_GS + c0); }
    float vn[4][8];
#pragma unroll
    for (int tt = 0; tt < 4; ++tt) { float f[8]; unpack8(xr[tt], f);
        float s = 0.f, ss = 0.f;
#pragma unroll
        for (int j = 0; j < 8; ++j) { s += f[j]; ss += f[j] * f[j]; }
        s = wave_sum(s); ss = wave_sum(ss);
        const float mean = s * (1.0f / 512.0f), var = ss * (1.0f / 512.0f) - mean * mean, rstd = rsqrtf(var + EPS);
#pragma unroll
        for (int j = 0; j < 8; ++j) vn[tt][j] = (f[j] - mean) * rstd * gl[j] + bl[j];
        float* o = oCV + ((size_t)bd * 4 + tt) * 512 + c0;
        *(f32x4*)o = (f32x4){vn[tt][0], vn[tt][1], vn[tt][2], vn[tt][3]}; *(f32x4*)(o + 4) = (f32x4){vn[tt][4], vn[tt][5], vn[tt][6], vn[tt][7]}; }
#pragma unroll
    for (int tt = 0; tt < 4; ++tt) { const size_t row = (size_t)MP + 4 * bd + tt;
        float mx[8]; const float bias = F.sgu_b[l * 512 + hd * 128 + tt];
#pragma unroll
        for (int j = 0; j < 8; ++j) mx[j] = bias;
#pragma unroll
        for (int s2 = 0; s2 < 4; ++s2) if (s2 <= tt) { const float w = F.sgu_w[((size_t)(l * 4 + hd) * 128 + tt) * 128 + s2];
#pragma unroll
            for (int j = 0; j < 8; ++j) mx[j] += w * vn[s2][j]; }
        float uf[8], gf[8]; unpack8(ur[tt], uf); unpack8(gr[tt], gf);
#pragma unroll
        for (int j = 0; j < 8; ++j) mx[j] = mx[j] * uf[j] * gf[j];
        *(u32x4*)(F.MIX + row * DM + 1536 + c0) = pack8(mx); }
}

#ifdef HYBRID
__device__ __forceinline__ void attn_task_o(const Frame& F, int l, int b, int nb, int head, int qs, LAS unsigned char* wl) {
    const int lane = F.lane, r = lane & 31, hh = lane >> 5, kvh = head >> 2;
    LAS float* wsf = (LAS float*)wl; LAS bf16_t* stg = (LAS bf16_t*)(wl + 256);
    const int t0 = 128 * nb + 32 * qs;
    const size_t qrow0 = (size_t)b * 2048 + t0;
    const bf16_t* qp = F.Qc + (qrow0 + r) * 1024 + head * 64 + 8 * hh;
    bf16x8 qf[4];
#pragma unroll
    for (int s = 0; s < 4; ++s) qf[s] = *(const bf16x8*)(qp + 16 * s);
    const bf16_t* kbase = F.Kc + (size_t)(b * 4 + kvh) * 2048 * 64;
    const bf16_t* vbase = F.VTP + (size_t)(b * 4 + kvh) * 64 * 2048;
    const int cmin = (nb > 0) ? 0 : (4 - qs);
    f32x16 S[5];
#pragma unroll
    for (int c = 0; c < 5; ++c) {
        f32x16 a;
#pragma unroll
        for (int i = 0; i < 16; ++i) a[i] = 0.f;
        if (c >= cmin) {
            const bf16_t* kp = kbase + (size_t)(t0 - 128 + 32 * c + r) * 64 + 8 * hh;
#pragma unroll
            for (int s = 0; s < 4; ++s) a = __builtin_amdgcn_mfma_f32_32x32x16_bf16(*(const bf16x8*)(kp + 16 * s), qf[s], a, 0, 0, 0);
        }
        S[c] = a;
    }
    const float NEG = -INFINITY;
#pragma unroll
    for (int i = 0; i < 16; ++i) { const int kap = crow(i, hh); if (kap <= r) S[0][i] = NEG; if (kap > r) S[4][i] = NEG; }
    const float sink2 = F.sinks[l * 16 + head] * LOG2E;
    float m = sink2;
#pragma unroll
    for (int c = 0; c < 5; ++c) if (c >= cmin) {
#pragma unroll
        for (int i = 0; i < 16; ++i) m = fmaxf(m, S[c][i]); }
    m = fmaxf(m, __shfl_xor(m, 32));
    float sum = 0.f;
#pragma unroll
    for (int c = 0; c < 5; ++c) if (c >= cmin) {
#pragma unroll
        for (int i = 0; i < 16; ++i) { const float p = __builtin_amdgcn_exp2f(S[c][i] - m); S[c][i] = p; sum += p; } }
    sum += __shfl_xor(sum, 32);
    const float inv = 1.0f / (sum + __builtin_amdgcn_exp2f(sink2 - m));
    f32x16 o[2];
#pragma unroll
    for (int i = 0; i < 16; ++i) { o[0][i] = 0.f; o[1][i] = 0.f; }
#pragma unroll
    for (int c = 0; c < 5; ++c) if (c >= cmin) {
        const bf16_t* vt = vbase + (size_t)((t0 - 128 + 32 * c) >> 5) * 2048 + r * 32 + 16 * hh;
#pragma unroll
        for (int s = 0; s < 2; ++s) {
            u32x4 pw; pw.x = pg8::cvt_pk_bf16(S[c][8 * s + 0], S[c][8 * s + 1]); pw.y = pg8::cvt_pk_bf16(S[c][8 * s + 2], S[c][8 * s + 3]);
            pw.z = pg8::cvt_pk_bf16(S[c][8 * s + 4], S[c][8 * s + 5]); pw.w = pg8::cvt_pk_bf16(S[c][8 * s + 6], S[c][8 * s + 7]);
            const bf16x8 pa = __builtin_bit_cast(bf16x8, pw);
#pragma unroll
            for (int db = 0; db < 2; ++db) o[db] = __builtin_amdgcn_mfma_f32_32x32x16_bf16(pa, *(const bf16x8*)(vt + db * 1024 + 8 * s), o[db], 0, 0, 0);
        }
    }
    if (hh == 0) wsf[r] = inv;
    LDS_WAIT();
#pragma unroll
    for (int i = 0; i < 16; ++i) { const int q = crow(i, hh); const float rl = wsf[q];
        stg[q * 64 + r] = (bf16_t)(pg8::cvt_pk_bf16(o[0][i] * rl, 0.f) & 0xffffu);
        stg[q * 64 + 32 + r] = (bf16_t)(pg8::cvt_pk_bf16(o[1][i] * rl, 0.f) & 0xffffu); }
    LDS_WAIT();
#pragma unroll
    for (int i = 0; i < 4; ++i) { const int row = i * 8 + (lane >> 3), ch = lane & 7;
        const u32x4 ov = *(const LAS u32x4*)(stg + row * 64 + ch * 8);
        const u32x4 gv = *(const u32x4*)(F.Z2 + (qrow0 + row) * ZW + Z_GA + head * 64 + ch * 8);
        float of[8], gf[8]; unpack8(ov, of); unpack8(gv, gf);
#pragma unroll
        for (int j = 0; j < 8; ++j) of[j] *= gf[j];
        *(u32x4*)(F.MIX + (qrow0 + row) * DM + head * 64 + ch * 8) = pack8(of); }
    LDS_WAIT();
}

template <bool SAMPLE>
__device__ __forceinline__ void pool_unit_o(const Frame& F, int l, int g, int tile) {
    const int lane = F.lane, r = lane & 31, hh = lane >> 5, w = 2 << g;
    const size_t row = (size_t)(SAMPLE ? MP : 0) + 32 * tile + r;
    const int t = SAMPLE ? (int)(row & 3) : (int)(row & 2047);
    const int bd = SAMPLE ? (int)((row - MP) >> 2) : 0;
    const float icnt = SAMPLE ? 1.0f / (float)w : 1.0f / (float)(w < t + 1 ? w : t + 1);
    bf16x8 bfr[8];
#pragma unroll
    for (int s = 0; s < 8; ++s) {
        const int c0 = 128 * g + 16 * s + 8 * hh;
        float sum[8], cur[8];
#pragma unroll
        for (int j = 0; j < 8; ++j) { sum[j] = 0.f; cur[j] = 0.f; }
        for (int i = 0; i < w; ++i) {
            float f[8];
            const int e = t - i;
            if (e >= 0) { unpack8(*(const u32x4*)(F.Z2 + (row - i) * ZW + Z_XB + c0), f); }
            else if (SAMPLE) { const float* sp = F.state_pool + (((size_t)l * 128 + bd) * 15 + 15 + e) * 512 + c0;
                const f32x4 a = *(const f32x4*)sp, bq = *(const f32x4*)(sp + 4); f[0] = a[0]; f[1] = a[1]; f[2] = a[2]; f[3] = a[3]; f[4] = bq[0]; f[5] = bq[1]; f[6] = bq[2]; f[7] = bq[3]; }
            else {
#pragma unroll
                for (int j = 0; j < 8; ++j) f[j] = 0.f; }
#pragma unroll
            for (int j = 0; j < 8; ++j) sum[j] += f[j];
            if (i == 0) {
#pragma unroll
                for (int j = 0; j < 8; ++j) cur[j] = f[j]; }
        }
        float pf[8];
#pragma unroll
        for (int j = 0; j < 8; ++j) pf[j] = sum[j] * icnt - cur[j];
        bfr[s] = __builtin_bit_cast(bf16x8, pack8(pf));
    }
    f32x16 acc[4];
#pragma unroll
    for (int db = 0; db < 4; ++db) {
#pragma unroll
        for (int i = 0; i < 16; ++i) acc[db][i] = 0.f;
        const bf16_t* ap = F.PWT + ((size_t)(l * 4 + g) * 128 + 32 * db + r) * 128 + 8 * hh;
#pragma unroll
        for (int s = 0; s < 8; ++s) acc[db] = __builtin_amdgcn_mfma_f32_32x32x16_bf16(*(const bf16x8*)(ap + 16 * s), bfr[s], acc[db], 0, 0, 0);
    }
#pragma unroll
    for (int db = 0; db < 4; ++db)
#pragma unroll
        for (int q = 0; q < 4; ++q) {
            const int col = 128 * g + 32 * db + 8 * q + 4 * hh;
            const f32x4 sc = *(const f32x4*)(F.pool_scale + l * 512 + col);
            float gf[4]; unpack4(*(const u32x2*)(F.Z2 + row * ZW + Z_GP + col), gf);
            u32x2 wv; wv.x = pg8::cvt_pk_bf16(acc[db][4 * q + 0] * sc[0] * gf[0], acc[db][4 * q + 1] * sc[1] * gf[1]);
            wv.y = pg8::cvt_pk_bf16(acc[db][4 * q + 2] * sc[2] * gf[2], acc[db][4 * q + 3] * sc[3] * gf[3]);
            *(u32x2*)(F.MIX + row * DM + 1024 + col) = wv;
        }
}

__device__ __forceinline__ void sgu_unit_o(const Frame& F, int l, int ci, int hd, LAS unsigned char* ring) {
    LAS bf16_t* VnT = (LAS bf16_t*)ring;
    const int lane = F.lane, wv = F.wave;
    const size_t R0 = (size_t)128 * ci;
    {
        const int tl = lane >> 2, q4 = lane & 3;
        const bf16_t* vrow = F.Z2 + (R0 + 16 * wv + tl) * ZW + Z_VS;
        float s = 0.f, ss = 0.f;
#pragma unroll
        for (int i = 0; i < 16; ++i) { float f[8]; unpack8(*(const u32x4*)(vrow + 128 * q4 + 8 * i), f);
#pragma unroll
            for (int j = 0; j < 8; ++j) { s += f[j]; ss += f[j] * f[j]; } }
        s += __shfl_xor(s, 1); s += __shfl_xor(s, 2); ss += __shfl_xor(ss, 1); ss += __shfl_xor(ss, 2);
        const float mean = s * (1.0f / 512.0f), var = ss * (1.0f / 512.0f) - mean * mean, rstd = rsqrtf(var + EPS);
#pragma unroll
        for (int i = 0; i < 4; ++i) { const int d = 32 * q4 + 8 * i; float f[8]; unpack8(*(const u32x4*)(vrow + 128 * hd + d), f);
            const float* gp = F.ln_g + l * 512 + 128 * hd + d; const float* bp = F.ln_b + l * 512 + 128 * hd + d;
#pragma unroll
            for (int j = 0; j < 8; ++j) { const float vn = (f[j] - mean) * rstd * gp[j] + bp[j];
                VnT[(d + j) * 136 + 16 * wv + tl] = (bf16_t)(pg8::cvt_pk_bf16(vn, 0.f) & 0xffffu); } }
    }
    __syncthreads();
    {
        const int r = lane & 31, hh = lane >> 5, db = wv & 3; const int tbA = (wv >> 2) ? 1 : 0, tbB = (wv >> 2) ? 2 : 3;
        f32x16 accA, accB;
#pragma unroll
        for (int i = 0; i < 16; ++i) { accA[i] = 0.f; accB[i] = 0.f; }
        const bf16_t* Wb = F.SGUW + (size_t)(l * 4 + hd) * 128 * 128;
#pragma unroll
        for (int s = 0; s < 8; ++s) {
            if (s < 2 * (tbB + 1)) {
                const bf16x8 a = *(const LAS bf16x8*)(VnT + (32 * db + r) * 136 + 16 * s + 8 * hh);
                accB = __builtin_amdgcn_mfma_f32_32x32x16_bf16(a, *(const bf16x8*)(Wb + (32 * tbB + r) * 128 + 16 * s + 8 * hh), accB, 0, 0, 0);
                if (s < 2 * (tbA + 1)) accA = __builtin_amdgcn_mfma_f32_32x32x16_bf16(a, *(const bf16x8*)(Wb + (32 * tbA + r) * 128 + 16 * s + 8 * hh), accA, 0, 0, 0);
            }
        }
#pragma unroll
        for (int pass = 0; pass < 2; ++pass) {
            const int tb = pass ? tbB : tbA; const f32x16 acc = pass ? accB : accA;
            const int t = 32 * tb + r; const size_t row = R0 + t; const float bias = F.sgu_b[l * 512 + hd * 128 + t];
#pragma unroll
            for (int q = 0; q < 4; ++q) { const int col = 128 * hd + 32 * db + 8 * q + 4 * hh;
                float uf[4], gf[4]; unpack4(*(const u32x2*)(F.Z2 + row * ZW + Z_U + col), uf); unpack4(*(const u32x2*)(F.Z2 + row * ZW + Z_GS + col), gf);
                u32x2 wo; wo.x = pg8::cvt_pk_bf16((acc[4 * q + 0] + bias) * uf[0] * gf[0], (acc[4 * q + 1] + bias) * uf[1] * gf[1]);
                wo.y = pg8::cvt_pk_bf16((acc[4 * q + 2] + bias) * uf[2] * gf[2], (acc[4 * q + 3] + bias) * uf[3] * gf[3]);
                *(u32x2*)(F.MIX + row * DM + 1536 + col) = wo; }
        }
    }
    __syncthreads();
}

__device__ __forceinline__ void samp_attn_o(const Frame& F, int l, int bd, int kvh, LAS unsigned char* wl) {
    LAS float* qs = (LAS float*)wl;
    LAS float* ps = (LAS float*)(wl + 4096);
    const int lane = F.lane;
    float* oKs = F.out + O_KS + (size_t)l * LS_KS; float* oVs = F.out + O_VS + (size_t)l * LS_KS;
    {
        const int qi = lane >> 2, part = lane & 3, gq = qi >> 2, tt = qi & 3;
        const bf16_t* src = F.Qc + ((size_t)MP + 4 * bd + tt) * 1024 + (4 * kvh + gq) * 64 + 16 * part;
        float f0[8], f1[8]; unpack8(*(const u32x4*)src, f0); unpack8(*(const u32x4*)(src + 8), f1);
#pragma unroll
        for (int j = 0; j < 8; ++j) { const int p0 = 16 * part + j, p1 = p0 + 8;
            qs[qi * 64 + (p0 >> 1) + 32 * (p0 & 1)] = f0[j]; qs[qi * 64 + (p1 >> 1) + 32 * (p1 & 1)] = f1[j]; }
    }
    LDS_WAIT();
    float s0[16], s1[16], s2[16];
#pragma unroll
    for (int q = 0; q < 16; ++q) { s0[q] = 0.f; s1[q] = 0.f; s2[q] = 0.f; }
    const float* k0p = F.cache_k + (((size_t)l * 128 + bd) * 128 + lane) * 256 + kvh * 64;
    const float* k1p = k0p + 64 * 256;
    const float* k2p = oKs + (((size_t)bd * 128 + 124 + (lane & 3)) * 4 + kvh) * 64;
    float* c0p = oKs + (((size_t)bd * 128 + (lane >= 4 ? lane - 4 : 0)) * 4 + kvh) * 64;
    float* c1p = oKs + (((size_t)bd * 128 + lane + 60) * 4 + kvh) * 64;
    for (int ch = 0; ch < 16; ++ch) {
        const f32x4 kx0 = *(const f32x4*)(k0p + 4 * ch), kx1 = *(const f32x4*)(k1p + 4 * ch), kx2 = *(const f32x4*)(k2p + 4 * ch);
        if (lane >= 4) *(f32x4*)(c0p + 4 * ch) = kx0;
        *(f32x4*)(c1p + 4 * ch) = kx1;
#pragma unroll
        for (int q = 0; q < 16; ++q) { const f32x4 qv = *(const LAS f32x4*)(qs + q * 64 + 4 * ch);
            s0[q] += (qv[0] * kx0[0] + qv[1] * kx0[1]) + (qv[2] * kx0[2] + qv[3] * kx0[3]);
            s1[q] += (qv[0] * kx1[0] + qv[1] * kx1[1]) + (qv[2] * kx1[2] + qv[3] * kx1[3]);
            s2[q] += (qv[0] * kx2[0] + qv[1] * kx2[1]) + (qv[2] * kx2[2] + qv[3] * kx2[3]); }
    }
    float inv[16];
#pragma unroll
    for (int q = 0; q < 16; ++q) {
        const int tt = q & 3; const float sink2 = F.sinks[l * 16 + 4 * kvh + (q >> 2)] * LOG2E;
        const bool v0 = lane >= tt + 1, v2 = (lane < 4) && (lane <= tt);
        float m = s1[q]; if (v0) m = fmaxf(m, s0[q]); if (v2) m = fmaxf(m, s2[q]);
        m = fmaxf(wave_max(m), sink2);
        const float p0 = v0 ? __builtin_amdgcn_exp2f(s0[q] - m) : 0.f, p1 = __builtin_amdgcn_exp2f(s1[q] - m), p2 = v2 ? __builtin_amdgcn_exp2f(s2[q] - m) : 0.f;
        const float sum = wave_sum(p0 + p1 + p2);
        inv[q] = 1.0f / (sum + __builtin_amdgcn_exp2f(sink2 - m));
        ps[lane * 16 + q] = p0; ps[(lane + 64) * 16 + q] = p1; if (lane < 4) ps[(128 + lane) * 16 + q] = p2;
    }
    LDS_WAIT();
    float o[16];
#pragma unroll
    for (int q = 0; q < 16; ++q) o[q] = 0.f;
    const float* vcp = F.cache_v + (((size_t)l * 128 + bd) * 128) * 256 + kvh * 64 + lane;
    float* vop = oVs + ((size_t)bd * 128) * 256 + kvh * 64 + lane;
    for (int key = 0; key < 132; ++key) {
        float v;
        if (key < 128) { v = vcp[(size_t)key * 256]; if (key >= 4) vop[(size_t)(key - 4) * 256] = v; }
        else v = vop[(size_t)(key - 4) * 256];
#pragma unroll
        for (int q4 = 0; q4 < 4; ++q4) { const f32x4 pv = *(const LAS f32x4*)(ps + key * 16 + 4 * q4);
            o[4 * q4 + 0] += pv[0] * v; o[4 * q4 + 1] += pv[1] * v; o[4 * q4 + 2] += pv[2] * v; o[4 * q4 + 3] += pv[3] * v; }
    }
#pragma unroll
    for (int q = 0; q < 16; ++q) { const int tt = q & 3, head = 4 * kvh + (q >> 2); const size_t row = (size_t)MP + 4 * bd + tt;
        const float gv = __uint_as_float(((unsigned)F.Z2[row * ZW + Z_GA + head * 64 + lane]) << 16);
        F.MIX[row * DM + head * 64 + lane] = (bf16_t)(pg8::cvt_pk_bf16(o[q] * inv[q] * gv, 0.f) & 0xffffu); }
    LDS_WAIT();
}
__device__ __forceinline__ void samp_sgu_o(const Frame& F, int l, int bd) {
    const int lane = F.lane, c0 = 8 * lane, hd = lane >> 4;
    float* oCV = F.out + O_CV + (size_t)l * LS_CV;
    float gl[8], bl[8];
#pragma unroll
    for (int j = 0; j < 8; ++j) { gl[j] = F.ln_g[l * 512 + c0 + j]; bl[j] = F.ln_b[l * 512 + c0 + j]; }
    float vn[4][8];
#pragma unroll
    for (int tt = 0; tt < 4; ++tt) { const size_t row = (size_t)MP + 4 * bd + tt; float f[8]; unpack8(*(const u32x4*)(F.Z2 + row * ZW + Z_VS + c0), f);
        float s = 0.f, ss = 0.f;
#pragma unroll
        for (int j = 0; j < 8; ++j) { s += f[j]; ss += f[j] * f[j]; }
        s = wave_sum(s); ss = wave_sum(ss);
        const float mean = s * (1.0f / 512.0f), var = ss * (1.0f / 512.0f) - mean * mean, rstd = rsqrtf(var + EPS);
#pragma unroll
        for (int j = 0; j < 8; ++j) vn[tt][j] = (f[j] - mean) * rstd * gl[j] + bl[j];
        float* o = oCV + ((size_t)bd * 4 + tt) * 512 + c0;
        *(f32x4*)o = (f32x4){vn[tt][0], vn[tt][1], vn[tt][2], vn[tt][3]}; *(f32x4*)(o + 4) = (f32x4){vn[tt][4], vn[tt][5], vn[tt][6], vn[tt][7]}; }
#pragma unroll
    for (int tt = 0; tt < 4; ++tt) { const size_t row = (size_t)MP + 4 * bd + tt;
        float mx[8]; const float bias = F.sgu_b[l * 512 + hd * 128 + tt];
#pragma unroll
        for (int j = 0; j < 8; ++j) mx[j] = bias;
#pragma unroll
        for (int s2 = 0; s2 < 4; ++s2) if (s2 <= tt) { const float w = F.sgu_w[((size_t)(l * 4 + hd) * 128 + tt) * 128 + s2];
#pragma unroll
            for (int j = 0; j < 8; ++j) mx[j] += w * vn[s2][j]; }
        float uf[8], gf[8]; unpack8(*(const u32x4*)(F.Z2 + row * ZW + Z_U + c0), uf); unpack8(*(const u32x4*)(F.Z2 + row * ZW + Z_GS + c0), gf);
#pragma unroll
        for (int j = 0; j < 8; ++j) mx[j] = mx[j] * uf[j] * gf[j];
        *(u32x4*)(F.MIX + row * DM + 1536 + c0) = pack8(mx); }
}

#endif
__device__ __forceinline__ void norm_row(const Frame& F, int l, int row) {
    const int lane = F.lane;
    const bf16_t* yr = F.Yb + (size_t)row * DM + 8 * lane;
    const float* xr = ((l == 0) ? (row < MP ? F.xp + (size_t)row * DM : F.xs + (size_t)(row - MP) * DM) : F.out + (size_t)row * DM) + 8 * lane;
    float* orow = F.out + (size_t)row * DM + 8 * lane;
    const float* pg = F.norm_post + l * DM + 8 * lane; const float* g1 = F.norm_pre + DM + 8 * lane;
    u32x4 yv[4]; f32x4 xv[4][2];
#pragma unroll
    for (int j = 0; j < 4; ++j) { yv[j] = *(const u32x4*)(yr + 512 * j); xv[j][0] = *(const f32x4*)(xr + 512 * j); xv[j][1] = *(const f32x4*)(xr + 512 * j + 4); }
    float y[4][8]; float ss = 0.f;
#pragma unroll
    for (int j = 0; j < 4; ++j) { unpack8(yv[j], y[j]);
#pragma unroll
        for (int e = 0; e < 8; ++e) ss += y[j][e] * y[j][e]; }
    ss = wave_sum(ss);
    const float ry = rsqrtf(ss * (1.0f / 2048.0f) + EPS);
    float s1 = 0.f;
#pragma unroll
    for (int j = 0; j < 4; ++j) { const f32x4 ga = *(const f32x4*)(pg + 512 * j), gb = *(const f32x4*)(pg + 512 * j + 4);
#pragma unroll
        for (int e = 0; e < 4; ++e) { y[j][e] = xv[j][0][e] + y[j][e] * ry * ga[e]; y[j][4 + e] = xv[j][1][e] + y[j][4 + e] * ry * gb[e]; }
        *(f32x4*)(orow + 512 * j) = (f32x4){y[j][0], y[j][1], y[j][2], y[j][3]}; *(f32x4*)(orow + 512 * j + 4) = (f32x4){y[j][4], y[j][5], y[j][6], y[j][7]};
#pragma unroll
        for (int e = 0; e < 8; ++e) s1 += y[j][e] * y[j][e]; }
    if (l == 0) {
        s1 = wave_sum(s1);
        const float r1 = rsqrtf(s1 * (1.0f / 2048.0f) + EPS);
        bf16_t* hrow = F.H + (size_t)row * DM + 8 * lane;
#pragma unroll
        for (int j = 0; j < 4; ++j) { const f32x4 ga = *(const f32x4*)(g1 + 512 * j), gb = *(const f32x4*)(g1 + 512 * j + 4); float o[8];
#pragma unroll
            for (int e = 0; e < 4; ++e) { o[e] = y[j][e] * r1 * ga[e]; o[4 + e] = y[j][4 + e] * r1 * gb[e]; }
            *(u32x4*)(hrow + 512 * j) = pack8(o); }
    }
}
__device__ __forceinline__ void norm_rows4(int l, int row0) { LOCAL_FRAME;
#pragma unroll 1
    for (int k = 0; k < 4; ++k) norm_row(F, l, row0 + k); }

constexpr int Q2_G = 40, Q2_AT = Q2_G + 256, Q2_SG = Q2_AT + 256, Q2_PO = Q2_SG + 256, Q2_SA = Q2_PO + 64, Q2_SS = Q2_SA + 16, Q2_SP = Q2_SS + 8;
__device__ __forceinline__ void slot2(int l, LAS unsigned char* L, LAS unsigned char* ring) {
    int t_ = threadIdx.x; asm volatile("" : "+v"(t_)); const int wave = __builtin_amdgcn_readfirstlane(t_ >> 6);
    unsigned* head = ctl_word(CW_Q + 64 * (2 * l));
#pragma unroll 1
    for (;;) {
        const int it = q_pop(head, L);
        if (it >= Q2_SP) break;
        if (it < Q2_G) {
            unsigned char* ws = (unsigned char*)kargs()->ws;
            pg8::Gemm g{(const bf16_t*)(ws + WS_H), (const bf16_t*)(ws + WS_WTIN) + (size_t)l * DIN * DM, MT, DIN, DM};
            OneUnit S; S.u.pm = 64 + it / 20; S.u.pn = it % 20;
            pg8::EpiIn E{l};
            pg8::gemm_phase<pg8::EpiIn, OneUnit, false, true>(ring, g, S, E);
            publish(ctl_word(CW_ZS + 64 * (2 * l + it / 20)));
        }
        else if (it < Q2_AT) attn_unit(l, it - Q2_G, ring);
        else if (it < Q2_SG) { const int u = it - Q2_AT; sgu_unit(l, u >> 1, u & 1, ring); }
        else if (it < Q2_PO) { const int i = 8 * (it - Q2_SG) + wave; pool_dispatch<false>(l, i & 3, i >> 2); }
        else if (it < Q2_SA) { const int i = it - Q2_PO; dep_wait(ctl_word(CW_ZS + 64 * (2 * l + (i >> 5))), 20u); const int k = 8 * i + wave; samp_attn(l, k >> 2, k & 3, ring + wave * 9472); }
        else if (it < Q2_SS) { const int i = it - Q2_SA; dep_wait(ctl_word(CW_ZS + 64 * (2 * l + (i >> 3))), 20u); samp_sgu(l, 8 * i + wave); }
        else { const int i = it - Q2_SS; dep_wait(ctl_word(CW_ZS + 64 * (2 * l + (i >> 2))), 20u); const int k = 8 * i + wave; pool_dispatch<true>(l, k & 3, k >> 2); }
    }
}
constexpr int Q4_G = 16, Q4_P = Q4_G + 512, Q4_S = Q4_P + 16;
__device__ __forceinline__ void slot4(int l, LAS unsigned char* L, LAS unsigned char* ring) {
    int t_ = threadIdx.x; asm volatile("" : "+v"(t_)); const int wave = __builtin_amdgcn_readfirstlane(t_ >> 6);
    unsigned* head = ctl_word(CW_Q + 64 * (2 * l + 1));
#pragma unroll 1
    for (;;) {
        const int it = q_pop(head, L);
        if (it >= Q4_S) break;
        if (it < Q4_G) {
            unsigned char* ws = (unsigned char*)kargs()->ws;
            pg8::Gemm g{(const bf16_t*)(ws + WS_MIX), (const bf16_t*)(ws + WS_WTOUT) + (size_t)l * DM * DM, MT, DM, DM};
            OneUnit S; S.u.pm = 64 + it / 8; S.u.pn = it % 8;
            pg8::EpiOut E{};
            pg8::gemm_phase<pg8::EpiOut, OneUnit, false, true>(ring, g, S, E);
            publish(ctl_word(CW_YS + 64 * (2 * l + it / 8)));
        }
        else if (it < Q4_P) norm_rows4(l, 32 * (it - Q4_G) + 4 * wave);
        else { const int i = it - Q4_P; dep_wait(ctl_word(CW_YS + 64 * (2 * l + (i >> 3))), 8u); norm_rows4(l, MP + 32 * i + 4 * wave); }
    }
}

__global__ void __launch_bounds__(NTHREADS, 2) hymba_fwd(Args a_unused) {
    extern __shared__ __attribute__((aligned(16))) unsigned char lds[];
    LAS unsigned char* L = (LAS unsigned char*)lds;
    if (threadIdx.x < 256) ((LAS unsigned*)L)[threadIdx.x] = 0u;
    __syncthreads();
    XcdBarrier bar = xcd_barrier_post((unsigned*)((unsigned char*)kargs()->ws + WS_CTL) + CW_BAR, (volatile LAS unsigned*)L + 8);
    LAS unsigned char* ring = L + RING_OFF;
    STAMP(0);
#ifndef NO_P0
    { Frame F; make_frame(F, kargs()); p0_prologue(F, ring); }
#endif
    xcd_barrier(bar);
    STAMP(1);
#pragma unroll 1
    for (int l = 0; l < 2; ++l) {
#ifndef NO_P1
        {
            KArgs ka = kargs(); unsigned char* ws = (unsigned char*)ka->ws;
            pg8::Gemm g{(const bf16_t*)(ws + WS_H), (const bf16_t*)(ws + WS_WTIN) + (size_t)l * DIN * DM, MP, DIN, DM}; pg8::StaticOrder S; S.init(MP, DIN, (int)gridDim.x, (int)blockIdx.x);
            pg8::EpiIn E{l};
            pg8::gemm_phase<pg8::EpiIn, pg8::StaticOrder, true, true>(ring, g, S, E);
        }
#endif
        xcd_barrier(bar);
        STAMP(2 + 4 * l);
#ifndef NO_P2
        slot2(l, L, ring);
#endif
        xcd_barrier(bar);
        STAMP(3 + 4 * l);
#ifndef NO_P3
        {
            KArgs ka = kargs(); unsigned char* ws = (unsigned char*)ka->ws;
            pg8::Gemm g{(const bf16_t*)(ws + WS_MIX), (const bf16_t*)(ws + WS_WTOUT) + (size_t)l * DM * DM, MP, DM, DM}; pg8::StaticOrder S; S.init(MP, DM, (int)gridDim.x, (int)blockIdx.x);
            pg8::EpiOut E{};
            pg8::gemm_phase<pg8::EpiOut, pg8::StaticOrder, true, true>(ring, g, S, E);
        }
#endif
        xcd_barrier(bar);
        STAMP(4 + 4 * l);
#ifndef NO_P4
        slot4(l, L, ring);
#endif
        if (l == 0) xcd_barrier(bar);
#if PROBE_SEL
        if (l == 1) __syncthreads();
#endif
        STAMP(5 + 4 * l);
    }
#if PROBE_SEL
    if (blockIdx.x == 0 && threadIdx.x == 0) {
        LAS unsigned long long* ts = (LAS unsigned long long*)(L + 256);
        unsigned long long da = (ts[PA1] - ts[PA0] + 400) / 800, db = (ts[PB1] - ts[PB0] + 400) / 800;
        if (da > 63) da = 63; if (db > 63) db = 63;
        const unsigned long long extra = (da + 64 * db) * 1600ull, t0 = __builtin_amdgcn_s_memrealtime();
        while (__builtin_amdgcn_s_memrealtime() - t0 < extra) __builtin_amdgcn_s_sleep(32);
    }
#endif
}

extern "C" void kernel_launch(void* const* d_in, const int* in_sizes, int n_in, void* d_out, int out_size, void* d_ws, size_t ws_size, hipStream_t stream) {
    static int grid = 0;
    if (grid == 0) {
        if (n_in != 16 || (size_t)out_size != O_END || ws_size < WS_END) { fprintf(stderr, "kernel_launch: unexpected shapes: n_in %d out %d ws %zu (need %zu)\n", n_in, out_size, ws_size, (size_t)WS_END); grid = -1; return; }
        int dev = 0, cus = 0, per_cu = 0;
        if (hipGetDevice(&dev) != hipSuccess || hipDeviceGetAttribute(&cus, hipDeviceAttributeMultiprocessorCount, dev) != hipSuccess) { fprintf(stderr, "kernel_launch: device query failed\n"); grid = -1; return; }
        if (hipFuncSetAttribute((const void*)hymba_fwd, hipFuncAttributeMaxDynamicSharedMemorySize, LDS_BYTES) != hipSuccess) { fprintf(stderr, "kernel_launch: hipFuncSetAttribute failed\n"); grid = -1; return; }
        if (hipOccupancyMaxActiveBlocksPerMultiprocessor(&per_cu, (const void*)hymba_fwd, NTHREADS, LDS_BYTES) != hipSuccess || per_cu < 1) { fprintf(stderr, "kernel_launch: occupancy query says %d blocks/CU\n", per_cu); (void)hipGetLastError(); grid = -1; return; }
        grid = cus;
    }
    if (grid < 0) return;
    (void)hipMemsetAsync((char*)d_ws + WS_CTL, 0, CTL_ZERO_BYTES, stream);
    Args a{};
    for (int i = 0; i < 16; ++i) a.in[i] = (const float*)d_in[i];
    a.out = (float*)d_out; a.ws = (unsigned char*)d_ws;
    void* params[] = {&a};
    hipError_t e = hipLaunchCooperativeKernel((const void*)hymba_fwd, dim3(grid), dim3(NTHREADS), params, LDS_BYTES, stream);
    if (e != hipSuccess) fprintf(stderr, "kernel_launch: cooperative launch failed: %s (grid %d)\n", hipGetErrorString(e), grid);
}
```

```cpp
#include <hip/hip_runtime.h>
#include <cstdio>
#include <cstdint>
#include <cmath>
namespace pg8 {
#define PG8_LAS __attribute__((address_space(3)))
typedef unsigned short bf16_t;
typedef short bf16x8 __attribute__((ext_vector_type(8)));
typedef float f32x4 __attribute__((ext_vector_type(4)));
typedef unsigned u32x4 __attribute__((ext_vector_type(4)));
constexpr int BM = 256, BK = 64, HALF = 128, HTB = HALF * BK * 2  , STAGE_BYTES = 8 * HTB, NXCD = 8, WGM = 8;

__host__ __device__ __forceinline__ int lds_byte(int r, int c) { const int st = (r >> 4) * 2 + (c >> 5), rr = r & 15, cc = c & 31, ob = rr * 64 + cc * 2; return st * 1024 + (ob ^ (((ob >> 9) & 1) << 5)); }
__host__ __device__ __forceinline__ void stage_rc(int b, int& R, int& C) { const int st = b / 1024, sb = b % 1024, swz = sb ^ (((sb >> 9) & 1) << 5); R = (st >> 1) * 16 + swz / 64; C = (st & 1) * 32 + (swz % 64) / 2; }
__host__ __device__ __forceinline__ int perm32(int rho) { const int n = rho >> 4, i = rho & 15; return 8 * (i >> 2) + 4 * n + (i & 3); }

struct Unit { int pm, pn; };
struct Gemm { const bf16_t* A; const bf16_t* Bt; int M, N, K; };

struct StaticOrder {
    int nM, nN, nwg, G, c;
    __host__ __device__ void init(int M, int N, int G_, int c_) { nM = M / BM; nN = N / BM; nwg = nM * nN; G = G_; c = c_; }
    __host__ __device__ bool next(int i, Unit& u) const {
        const long L = (long)i * G + c; if (L >= nwg) return false;
        int wgid = (int)L; { const int q = nwg / NXCD, r = nwg % NXCD, xcd = wgid % NXCD, off = wgid / NXCD; wgid = (xcd < r ? xcd * (q + 1) : r * (q + 1) + (xcd - r) * q) + off; }
        const int nig = WGM * nN, gid = wgid / nig, fm = gid * WGM, gsz = (nM - fm) < WGM ? (nM - fm) : WGM;
        u.pm = fm + ((wgid % nig) % gsz); u.pn = (wgid % nig) / gsz; return true;
    }
    __device__ __forceinline__ void a_ready(const Unit&) const {}
    __device__ __forceinline__ void done(const Unit&) const {}
};

constexpr int DM = 2048, MP = 16384, MS = 512, MT = MP + MS, DIN = 5120;
constexpr int ZW = 3584;
constexpr int Z_GA = 0, Z_XB = 1024, Z_GP = 1536, Z_U = 2048, Z_VS = 2560, Z_GS = 3072;
constexpr float LOG2E = 1.4426950408889634f, QSCALE = 0.125f * LOG2E, EPS = 1e-6f;

__device__ __forceinline__ unsigned cvt_pk_bf16(float lo, float hi) { unsigned r; asm("v_cvt_pk_bf16_f32 %0, %1, %2" : "=v"(r) : "v"(lo), "v"(hi)); return r; }
__device__ __forceinline__ float silu_f(float x) { return x * __builtin_amdgcn_rcpf(1.0f + __builtin_amdgcn_exp2f(-x * LOG2E)); }
__device__ __forceinline__ int vperm32(int x) { return ((x >> 2) & 1) * 16 + (x >> 3) * 4 + (x & 3); }

struct EpiPtrs { const __attribute__((address_space(1))) float* in[16]; __attribute__((address_space(1))) float* out; __attribute__((address_space(1))) unsigned char* ws; };
constexpr size_t EP_ROPE = (size_t)1 << 20, EP_QC = (size_t)192 << 20, EP_KC = (size_t)225 << 20, EP_VTP = (size_t)233 << 20, EP_Z2 = (size_t)241 << 20, EP_Y = (size_t)357 << 20;
constexpr size_t EO_KP = 34603008, EO_VP = 35127296, EO_PP = 35651584, EO_KS = 35774464, EO_VS = 44163072, EO_PS = 52551680;
struct EpiIn {
    static constexpr bool PERM = true, AFTER_DRAIN = false;
    int l;
    __device__ __forceinline__ void operator()(const f32x4 (&acc)[2][2][4][2], const Unit& u, int wr, int wc, int fr, int fq) const {
        const __attribute__((address_space(4))) EpiPtrs* kp = (const __attribute__((address_space(4))) EpiPtrs*)__builtin_amdgcn_kernarg_segment_ptr(); asm volatile("" : "+s"(kp));
        unsigned char* ws = (unsigned char*)kp->ws; float* outp = (float*)kp->out;
        bf16_t* Qc = (bf16_t*)(ws + EP_QC); bf16_t* Kc = (bf16_t*)(ws + EP_KC); bf16_t* VTP = (bf16_t*)(ws + EP_VTP); bf16_t* Z2 = (bf16_t*)(ws + EP_Z2); const float* rope = (const float*)(ws + EP_ROPE);
        float* oKp = outp + EO_KP + (size_t)l * 262144; float* oVp = outp + EO_VP + (size_t)l * 262144; float* oPp = outp + EO_PP + (size_t)l * 61440;
        float* oKs = outp + EO_KS + (size_t)l * 4194304; float* oVs = outp + EO_VS + (size_t)l * 4194304; float* oPs = outp + EO_PS + (size_t)l * 983040;
        const int pn = u.pn;
        const int row0 = u.pm * 256 + wr * 64 + fr;
        const int cw = wc * 32 + 8 * fq;
        if (pn < 5) {
#pragma unroll
            for (int ai = 0; ai < 2; ++ai)
#pragma unroll
                for (int m = 0; m < 4; ++m) {
                    const int row = row0 + ai * 128 + m * 16;
                    const bool smp = row >= MP;
                    const int tpos = smp ? 2048 + (row & 3) : (row & 2047);
                    const float* rp = rope + tpos * 64;
#pragma unroll
                    for (int bj = 0; bj < 2; ++bj) {
                        const int c = pn * 256 + bj * 128 + cw;
                        const int i0 = (c & 63) >> 1;
                        const f32x4 cs = *(const f32x4*)(rp + i0), sn = *(const f32x4*)(rp + 32 + i0);
                        const f32x4 v0 = acc[ai][bj][m][0], v1 = acc[ai][bj][m][1];
                        f32x4 o1, o2;
                        o1[0] = v0[0] * cs[0] - v0[1] * sn[0]; o2[0] = v0[1] * cs[0] + v0[0] * sn[0];
                        o1[1] = v0[2] * cs[1] - v0[3] * sn[1]; o2[1] = v0[3] * cs[1] + v0[2] * sn[1];
                        o1[2] = v1[0] * cs[2] - v1[1] * sn[2]; o2[2] = v1[1] * cs[2] + v1[0] * sn[2];
                        o1[3] = v1[2] * cs[3] - v1[3] * sn[3]; o2[3] = v1[3] * cs[3] + v1[2] * sn[3];
                        if (pn < 4) {
                            o1 = o1 * QSCALE; o2 = o2 * QSCALE;
                            u32x4 w; w.x = cvt_pk_bf16(o1[0], o2[0]); w.y = cvt_pk_bf16(o1[1], o2[1]); w.z = cvt_pk_bf16(o1[2], o2[2]); w.w = cvt_pk_bf16(o1[3], o2[3]);
                            *(u32x4*)(Qc + (size_t)row * 1024 + c) = w;
                        } else {
                            const int kvh = (c - 1024) >> 6;
                            if (!smp) {
                                const int b = row >> 11, t = row & 2047;
                                u32x4 w; w.x = cvt_pk_bf16(o1[0], o2[0]); w.y = cvt_pk_bf16(o1[1], o2[1]); w.z = cvt_pk_bf16(o1[2], o2[2]); w.w = cvt_pk_bf16(o1[3], o2[3]);
                                *(u32x4*)(Kc + ((size_t)((b * 4 + kvh) * 2048 + t)) * 64 + (c & 63)) = w;
                                if (t >= 1920) { float* o = oKp + ((size_t)((b * 128 + t - 1920) * 4 + kvh)) * 64 + i0; *(f32x4*)o = o1; *(f32x4*)(o + 32) = o2; }
                            } else {
                                const int bd = (row - MP) >> 2, tt = row & 3;
                                float* o = oKs + ((size_t)((bd * 128 + 124 + tt) * 4 + kvh)) * 64 + i0; *(f32x4*)o = o1; *(f32x4*)(o + 32) = o2;
                            }
                        }
                    }
                }
        } else if (pn == 5) {
#pragma unroll
            for (int ai = 0; ai < 2; ++ai)
#pragma unroll
                for (int m = 0; m < 4; ++m) {
                    const int row = row0 + ai * 128 + m * 16;
                    const bool smp = row >= MP;
#pragma unroll
                    for (int bj = 0; bj < 2; ++bj) {
                        const int cv = bj * 128 + cw;
                        const int kvh = cv >> 6, d0 = cv & 63;
                        const f32x4 v0 = acc[ai][bj][m][0], v1 = acc[ai][bj][m][1];
                        if (!smp) {
                            const int b = row >> 11, t = row & 2047;
                            bf16_t* vp = VTP + ((size_t)((b * 4 + kvh) * 64 + (t >> 5))) * 2048 + d0 * 32 + vperm32(t & 31);
                            const unsigned w0 = cvt_pk_bf16(v0[0], v0[1]), w1 = cvt_pk_bf16(v0[2], v0[3]), w2 = cvt_pk_bf16(v1[0], v1[1]), w3 = cvt_pk_bf16(v1[2], v1[3]);
                            vp[0] = (bf16_t)(w0 & 0xffffu); vp[32] = (bf16_t)(w0 >> 16); vp[64] = (bf16_t)(w1 & 0xffffu); vp[96] = (bf16_t)(w1 >> 16);
                            vp[128] = (bf16_t)(w2 & 0xffffu); vp[160] = (bf16_t)(w2 >> 16); vp[192] = (bf16_t)(w3 & 0xffffu); vp[224] = (bf16_t)(w3 >> 16);
                            if (t >= 1920) { float* o = oVp + ((size_t)((b * 128 + t - 1920) * 4 + kvh)) * 64 + d0; *(f32x4*)o = v0; *(f32x4*)(o + 4) = v1; }
                        } else {
                            const int bd = (row - MP) >> 2, tt = row & 3;
                            float* o = oVs + ((size_t)((bd * 128 + 124 + tt) * 4 + kvh)) * 64 + d0; *(f32x4*)o = v0; *(f32x4*)(o + 4) = v1;
                        }
                    }
                }
        } else {
            const bool gate = (pn < 10) || (pn == 12) || (pn == 13) || (pn >= 18);
            const bool isxb = (pn == 10) || (pn == 11);
#pragma unroll
            for (int ai = 0; ai < 2; ++ai)
#pragma unroll
                for (int m = 0; m < 4; ++m) {
                    const int row = row0 + ai * 128 + m * 16;
                    const bool smp = row >= MP;
#pragma unroll
                    for (int bj = 0; bj < 2; ++bj) {
                        const int c = pn * 256 + bj * 128 + cw;
                        f32x4 v0 = acc[ai][bj][m][0], v1 = acc[ai][bj][m][1];
                        if (isxb) {
                            const int cx = c - 2560;
                            if (!smp) { const int t = row & 2047; if (t >= 2033) { const int b = row >> 11; float* o = oPp + ((size_t)(b * 15 + t - 2033)) * 512 + cx; *(f32x4*)o = v0; *(f32x4*)(o + 4) = v1; } }
                            else { const int bd = (row - MP) >> 2, tt = row & 3; float* o = oPs + ((size_t)(bd * 15 + 11 + tt)) * 512 + cx; *(f32x4*)o = v0; *(f32x4*)(o + 4) = v1; }
                        }
                        if (gate) {
#pragma unroll
                            for (int j = 0; j < 4; ++j) { v0[j] = silu_f(v0[j]); v1[j] = silu_f(v1[j]); }
                        }
                        u32x4 w; w.x = cvt_pk_bf16(v0[0], v0[1]); w.y = cvt_pk_bf16(v0[2], v0[3]); w.z = cvt_pk_bf16(v1[0], v1[1]); w.w = cvt_pk_bf16(v1[2], v1[3]);
                        *(u32x4*)(Z2 + (size_t)row * ZW + (c - 1536)) = w;
                    }
                }
        }
    }
};

struct EpiOut {
    static constexpr bool PERM = true, AFTER_DRAIN = false;
    __device__ __forceinline__ void operator()(const f32x4 (&acc)[2][2][4][2], const Unit& u, int wr, int wc, int fr, int fq) const {
        const __attribute__((address_space(4))) EpiPtrs* kp = (const __attribute__((address_space(4))) EpiPtrs*)__builtin_amdgcn_kernarg_segment_ptr(); asm volatile("" : "+s"(kp));
        bf16_t* C = (bf16_t*)((unsigned char*)kp->ws + EP_Y);
        const int row0 = u.pm * BM + wr * 64 + fr, col0 = u.pn * BM + wc * 32 + 8 * fq;
#pragma unroll
        for (int ai = 0; ai < 2; ++ai)
#pragma unroll
            for (int m = 0; m < 4; ++m) { bf16_t* rowp = C + (size_t)(row0 + ai * HALF + m * 16) * DM + col0;
#pragma unroll
                for (int bj = 0; bj < 2; ++bj) { const f32x4 v0 = acc[ai][bj][m][0], v1 = acc[ai][bj][m][1];
                    u32x4 w; w.x = cvt_pk_bf16(v0[0], v0[1]); w.y = cvt_pk_bf16(v0[2], v0[3]); w.z = cvt_pk_bf16(v1[0], v1[1]); w.w = cvt_pk_bf16(v1[2], v1[3]);
                    *(u32x4*)(rowp + bj * HALF) = w; } }
    }
};
template <class Epi, class Sched, bool ALIGN_EPI = false, bool SP2 = false>
__device__ __forceinline__ void gemm_phase(PG8_LAS unsigned char* lds, const Gemm g, const Sched& S, const Epi& E) {
    int tid_ = threadIdx.x; asm volatile("" : "+v"(tid_));
    const int tid = tid_, wid = __builtin_amdgcn_readfirstlane(tid >> 6), lane = tid & 63, wr = wid >> 2, wc = wid & 3, fr = lane & 15, fq = lane >> 4;
    const int K = g.K, nt = K / BK;
    unsigned voffA[2], voffB[2];
#pragma unroll
    for (int i = 0; i < 2; ++i) { int R, C; stage_rc(tid * 16 + i * 8192, R, C); const int Rb = Epi::PERM ? ((R & ~31) + perm32(R & 31)) : R;
        voffA[i] = (unsigned)(R * K + C) * 2u; voffB[i] = (unsigned)(Rb * K + C) * 2u; }
    const size_t kstep = (size_t)(BK * 2);
    const size_t hstep = (size_t)HALF * K * 2;
    const size_t tstep = 2 * hstep;
    const unsigned ldsw = (unsigned)wid * 1024u;
    const int aoff = lds_byte(wr * 64 + fr, fq * 8), boff = lds_byte(wc * 32 + fr, fq * 8);
#define PG8_SA(b, h) (((b) * 2 + (h)) * HTB)
#define PG8_SB(b, h) ((4 + (b) * 2 + (h)) * HTB)
#define PG8_STAGE(bufoff, gbase, voff) do { _Pragma("unroll") for (int _i = 0; _i < 2; ++_i) \
        __builtin_amdgcn_global_load_lds((const unsigned*)((const char*)(gbase) + (voff)[_i]), (PG8_LAS unsigned*)(lds + (bufoff) + ldsw + _i * 8192), 16, 0, 0); } while (0)
#define PG8_LDA(dst, b, h) do { _Pragma("unroll") for (int m = 0; m < 4; ++m) _Pragma("unroll") for (int k = 0; k < 2; ++k) dst[m][k] = *(const PG8_LAS bf16x8*)(lds + PG8_SA(b, h) + aoff + m * 2048 + k * 1024); } while (0)
#define PG8_LDB(dst, b, h) do { _Pragma("unroll") for (int n = 0; n < 2; ++n) _Pragma("unroll") for (int k = 0; k < 2; ++k) dst[n][k] = *(const PG8_LAS bf16x8*)(lds + PG8_SB(b, h) + boff + n * 2048 + k * 1024); } while (0)
#define PG8_MMA(ai, bj, At, Bt) do { __builtin_amdgcn_s_setprio(1); _Pragma("unroll") for (int m = 0; m < 4; ++m) _Pragma("unroll") for (int n = 0; n < 2; ++n) _Pragma("unroll") for (int k = 0; k < 2; ++k) \
        acc[ai][bj][m][n] = __builtin_amdgcn_mfma_f32_16x16x32_bf16(Bt[n][k], At[m][k], acc[ai][bj][m][n], 0, 0, 0); __builtin_amdgcn_s_setprio(0); } while (0)
#define PG8_WAIT_V(n) asm volatile("s_waitcnt vmcnt(" #n ")" ::: "memory")
#define PG8_WAIT_L(n) asm volatile("s_waitcnt lgkmcnt(" #n ")" ::: "memory")
#define PG8_BAR __builtin_amdgcn_s_barrier()
#define PG8_SCHED __builtin_amdgcn_sched_barrier(0)
    Unit cur, nxt; int ui = 0;
    if (!S.next(0, cur)) return;
    f32x4 acc[2][2][4][2];
#pragma unroll
    for (int a = 0; a < 2; ++a)
#pragma unroll
        for (int b = 0; b < 2; ++b)
#pragma unroll
            for (int m = 0; m < 4; ++m)
#pragma unroll
                for (int n = 0; n < 2; ++n) acc[a][b][m][n] = (f32x4){0.f, 0.f, 0.f, 0.f};
    bf16x8 At[4][2], B0[2][2], B1[2][2];
    const char* cA = (const char*)g.A + (size_t)cur.pm * tstep; const char* cB = (const char*)g.Bt + (size_t)cur.pn * tstep;
    S.a_ready(cur);
    if constexpr (SP2) {
        PG8_STAGE(PG8_SB(0, 0), cB, voffB); PG8_STAGE(PG8_SB(0, 1), cB + hstep, voffB); PG8_STAGE(PG8_SA(0, 0), cA, voffA); PG8_STAGE(PG8_SA(0, 1), cA + hstep, voffA);
        if (wr == 1) PG8_BAR;
        PG8_WAIT_V(2); PG8_BAR;
        PG8_STAGE(PG8_SB(1, 0), cB + kstep, voffB); PG8_STAGE(PG8_SA(1, 0), cA + kstep, voffA); PG8_STAGE(PG8_SB(1, 1), cB + hstep + kstep, voffB);
        PG8_WAIT_V(6); PG8_BAR;
    } else {
        PG8_STAGE(PG8_SB(0, 0), cB, voffB); PG8_STAGE(PG8_SA(0, 0), cA, voffA); PG8_STAGE(PG8_SB(0, 1), cB + hstep, voffB); PG8_STAGE(PG8_SA(0, 1), cA + hstep, voffA);
        if (wr == 1) PG8_BAR;
        PG8_WAIT_V(4); PG8_BAR;
        PG8_STAGE(PG8_SB(1, 0), cB + kstep, voffB); PG8_STAGE(PG8_SA(1, 0), cA + kstep, voffA); PG8_STAGE(PG8_SB(1, 1), cB + hstep + kstep, voffB);
        PG8_WAIT_V(6); PG8_BAR;
    }
    for (;;) {
        const bool has_next = S.next(ui + 1, nxt);
        const char* nA = has_next ? (const char*)g.A + (size_t)nxt.pm * tstep : cA; const char* nB = has_next ? (const char*)g.Bt + (size_t)nxt.pn * tstep : cB;
        for (int t = 0; t < nt; t += 2) {
            const bool last = (t == nt - 2);
            const char* a1 = cA + (size_t)(t + 1) * kstep;
            const char* a2 = last ? nA : cA + (size_t)(t + 2) * kstep; const char* b2 = last ? nB : cB + (size_t)(t + 2) * kstep;
            const char* a3 = a2 + kstep; const char* b3 = b2 + kstep;
            if (last && has_next) S.a_ready(nxt);
            if constexpr (SP2) {
            PG8_LDB(B0, 0, 0); PG8_LDB(B1, 0, 1); PG8_SCHED; PG8_LDA(At, 0, 0); PG8_STAGE(PG8_SA(1, 1), a1 + hstep, voffA);
            PG8_WAIT_V(8); PG8_WAIT_L(0); PG8_BAR; PG8_MMA(0, 0, At, B0); PG8_MMA(0, 1, At, B1); PG8_BAR; PG8_SCHED;
            PG8_LDA(At, 0, 1); PG8_STAGE(PG8_SB(0, 0), b2, voffB); PG8_STAGE(PG8_SB(0, 1), b2 + hstep, voffB); PG8_STAGE(PG8_SA(0, 0), a2, voffA);
            PG8_WAIT_V(8); PG8_WAIT_L(0); PG8_BAR; PG8_MMA(1, 0, At, B0); PG8_MMA(1, 1, At, B1); PG8_BAR; PG8_SCHED;
            PG8_LDB(B0, 1, 0); PG8_LDB(B1, 1, 1); PG8_SCHED; PG8_LDA(At, 1, 0); PG8_STAGE(PG8_SA(0, 1), a2 + hstep, voffA);
            PG8_WAIT_V(8); PG8_WAIT_L(0); PG8_BAR; PG8_MMA(0, 0, At, B0); PG8_MMA(0, 1, At, B1); PG8_BAR; PG8_SCHED;
            PG8_LDA(At, 1, 1); PG8_STAGE(PG8_SB(1, 0), b3, voffB); PG8_STAGE(PG8_SB(1, 1), b3 + hstep, voffB); PG8_STAGE(PG8_SA(1, 0), a3, voffA);
            PG8_WAIT_V(8); PG8_WAIT_L(0); PG8_BAR; PG8_MMA(1, 0, At, B0); PG8_MMA(1, 1, At, B1); PG8_BAR; PG8_SCHED;
            } else {
            PG8_LDB(B0, 0, 0); PG8_SCHED; PG8_LDA(At, 0, 0); PG8_STAGE(PG8_SA(1, 1), a1 + hstep, voffA);
            PG8_WAIT_L(8); PG8_BAR; PG8_WAIT_L(0); PG8_MMA(0, 0, At, B0); PG8_BAR; PG8_SCHED;
            PG8_LDB(B1, 0, 1); PG8_STAGE(PG8_SB(0, 0), b2, voffB);
            PG8_BAR; PG8_WAIT_L(0); PG8_MMA(0, 1, At, B1); PG8_BAR;
            PG8_LDA(At, 0, 1); PG8_STAGE(PG8_SA(0, 0), a2, voffA);
            PG8_BAR; PG8_WAIT_L(0); PG8_MMA(1, 0, At, B0); PG8_BAR; PG8_SCHED;
            PG8_STAGE(PG8_SB(0, 1), b2 + hstep, voffB);
            PG8_WAIT_V(6); PG8_BAR; PG8_MMA(1, 1, At, B1); PG8_BAR;
            PG8_LDB(B0, 1, 0); PG8_SCHED; PG8_LDA(At, 1, 0); PG8_STAGE(PG8_SA(0, 1), a2 + hstep, voffA);
            PG8_WAIT_L(8); PG8_BAR; PG8_WAIT_L(0); PG8_MMA(0, 0, At, B0); PG8_BAR; PG8_SCHED;
            PG8_LDB(B1, 1, 1); PG8_STAGE(PG8_SB(1, 0), b3, voffB);
            PG8_BAR; PG8_WAIT_L(0); PG8_MMA(0, 1, At, B1); PG8_BAR;
            PG8_LDA(At, 1, 1); PG8_STAGE(PG8_SA(1, 0), a3, voffA);
            PG8_BAR; PG8_WAIT_L(0); PG8_MMA(1, 0, At, B0); PG8_BAR; PG8_SCHED;
            PG8_STAGE(PG8_SB(1, 1), b3 + hstep, voffB);
            PG8_WAIT_V(6); PG8_BAR; PG8_MMA(1, 1, At, B1); PG8_BAR;
            }
        }
        if constexpr (ALIGN_EPI) { if (wr == 0) PG8_BAR; }
        if constexpr (!Epi::AFTER_DRAIN) { E(acc, cur, wr, wc, fr, fq); S.done(cur); }
        if (!has_next) break;
#pragma unroll
        for (int a = 0; a < 2; ++a)
#pragma unroll
            for (int b = 0; b < 2; ++b)
#pragma unroll
                for (int m = 0; m < 4; ++m)
#pragma unroll
                    for (int n = 0; n < 2; ++n) acc[a][b][m][n] = (f32x4){0.f, 0.f, 0.f, 0.f};
        cur = nxt; cA = nA; cB = nB; ++ui;
        if constexpr (ALIGN_EPI) { if (wr == 1) PG8_BAR; }
    }
    PG8_WAIT_V(0);
    if constexpr (!ALIGN_EPI) { if (wr == 0) PG8_BAR; }
    PG8_BAR;
    if constexpr (Epi::AFTER_DRAIN) { E.fused(acc, cur, wr, wc, fr, fq, lds, wid, lane); S.done(cur); }
#undef PG8_SA
#undef PG8_SB
#undef PG8_STAGE
#undef PG8_LDA
#undef PG8_LDB
#undef PG8_MMA
#undef PG8_WAIT_V
#undef PG8_WAIT_L
#undef PG8_BAR
#undef PG8_SCHED
}
}
#define GAS __attribute__((address_space(1)))
#define LAS __attribute__((address_space(3)))
typedef GAS unsigned gu32;
typedef GAS unsigned long long gu64;
#define RLX_AGENT __ATOMIC_RELAXED, __HIP_MEMORY_SCOPE_AGENT
#define VM_WAIT() asm volatile("s_waitcnt vmcnt(0)" ::: "memory")
__device__ __forceinline__ unsigned long long rt() { return __builtin_amdgcn_s_memrealtime(); }
__device__ __forceinline__ unsigned f2bf(float f) { unsigned u = __builtin_bit_cast(unsigned, f); return (u + 0x7fffu + ((u >> 16) & 1u)) >> 16; }
__device__ __forceinline__ unsigned pk2(float lo, float hi) { return f2bf(lo) | (f2bf(hi) << 16); }

#define XB_TMO      128
#define XB_XCNT(j)  (256  + 64 * (j))
#define XB_XSUB(j)  (1280 + 64 * (j))
#define XB_XGEN(j)  (2304 + 64 * (j))
#define XB_TOP      3328
#define XB_TOPGEN   3392
#define XCD_BAR_WORDS 3456
#define XB_SPIN_CAP (1u << 18)

__device__ __forceinline__ unsigned xb_ld(unsigned* p)              { return __hip_atomic_load(p, __ATOMIC_RELAXED, __HIP_MEMORY_SCOPE_AGENT); }
__device__ __forceinline__ unsigned xb_add(unsigned* p, unsigned v) { return __hip_atomic_fetch_add(p, v, __ATOMIC_RELAXED, __HIP_MEMORY_SCOPE_AGENT); }
__device__ __forceinline__ unsigned xb_xcc_id() { return (unsigned)__builtin_amdgcn_s_getreg((3 << 11) | 20) & 0xFu; }
#define XB_SPIN(cond, bar) do { unsigned _sp = 0; while (cond) { __builtin_amdgcn_s_sleep(1); \
    if ((++_sp & 255u) == 0u) { if (xb_ld(&(bar)[XB_TMO])) break; if (_sp > XB_SPIN_CAP) { atomicAdd(&(bar)[XB_TMO], 1u); break; } } } } while (0)

struct XcdBarrier {
    unsigned* bar; unsigned x;
    volatile LAS unsigned* st;
};

__device__ __forceinline__ XcdBarrier xcd_barrier_post(unsigned* bar, volatile LAS unsigned* st) {
    XcdBarrier b; b.bar = bar; b.x = xb_xcc_id(); b.st = st;
    if (threadIdx.x == 0) (void)xb_add(&bar[XB_XCNT(b.x)], 1u);
    return b;
}
__device__ __forceinline__ void xcd_barrier_complete(unsigned* bar, unsigned x, unsigned& nloc, unsigned& nx) {
    const unsigned G = gridDim.x * gridDim.y * gridDim.z;
    unsigned sum, cnt, mine, sp = 0u;
    for (;;) {
        sum = 0u; cnt = 0u; mine = 0u;
#pragma unroll
        for (unsigned j = 0; j < 16; ++j) { const unsigned c = xb_ld(&bar[XB_XCNT(j)]); sum += c; cnt += (c > 0u) ? 1u : 0u; mine = (j == x) ? c : mine; }
        if (sum == G) break;
        __builtin_amdgcn_s_sleep(1);
        if ((++sp & 255u) == 0u) { if (xb_ld(&bar[XB_TMO])) break; if (sp > XB_SPIN_CAP) { atomicAdd(&bar[XB_TMO], 1u); break; } }
    }
    nloc = mine > 0u ? mine : 1u; nx = cnt > 0u ? cnt : 1u;
}

__device__ __forceinline__ void xcd_barrier(const XcdBarrier& b) {
    asm volatile("s_waitcnt vmcnt(0)" ::: "memory");
    __syncthreads();
    if (threadIdx.x == 0) {
        unsigned* bar = b.bar;
        __builtin_amdgcn_s_waitcnt(0);
        unsigned nloc = b.st[0], nx = b.st[1];
        if (nloc == 0u) { xcd_barrier_complete(bar, b.x, nloc, nx); b.st[0] = nloc; b.st[1] = nx; }
        const unsigned old = xb_add(&bar[XB_XSUB(b.x)], 1u);
        const unsigned gen = old / nloc;
        if (old + 1u == (gen + 1u) * nloc) {
            __builtin_amdgcn_fence(__ATOMIC_RELEASE, "agent");
            asm volatile("s_waitcnt vmcnt(0)" ::: "memory");
            const unsigned og = xb_add(&bar[XB_TOP], 1u);
            const unsigned tg = og / nx;
            if (og + 1u == (tg + 1u) * nx) xb_add(&bar[XB_TOPGEN], 1u);
            else XB_SPIN(xb_ld(&bar[XB_TOPGEN]) == tg, bar);
            __builtin_amdgcn_fence(__ATOMIC_ACQUIRE, "agent");
            xb_add(&bar[XB_XGEN(b.x)], 1u);
            asm volatile("s_waitcnt vmcnt(0)" ::: "memory");
        } else {
            XB_SPIN(xb_ld(&bar[XB_XGEN(b.x)]) == gen, bar);
            __builtin_amdgcn_fence(__ATOMIC_ACQUIRE, "agent");
            asm volatile("s_waitcnt vmcnt(0)" ::: "memory");
        }
    }
    __syncthreads();
}

using pg8::bf16_t; using pg8::bf16x8; using pg8::f32x4; using pg8::u32x4;
using pg8::DM; using pg8::MP; using pg8::MS; using pg8::MT; using pg8::DIN; using pg8::ZW;
using pg8::Z_GA; using pg8::Z_XB; using pg8::Z_GP; using pg8::Z_U; using pg8::Z_VS; using pg8::Z_GS; using pg8::LOG2E; using pg8::EPS;
typedef float f32x16 __attribute__((ext_vector_type(16)));
typedef unsigned u32x2 __attribute__((ext_vector_type(2)));

constexpr int NWAVES = 8, NTHREADS = 512;
constexpr int LDS_BYTES = 147456;
constexpr int RING_OFF = 1024;

constexpr size_t O_YP = 0, O_YS = 33554432, O_KP = 34603008, O_VP = 35127296, O_PP = 35651584, O_KS = 35774464, O_VS = 44163072, O_PS = 52551680, O_CV = 54517760, O_END = 55042048;
constexpr size_t LS_KP = 262144, LS_PP = 61440, LS_KS = 4194304, LS_PS = 983040, LS_CV = 262144;
constexpr size_t MiB = 1u << 20;
constexpr size_t WS_CTL = 0, CTL_ZERO_BYTES = 65536;
constexpr size_t WS_ROPE = 1 * MiB, WS_SGUW = 2 * MiB, WS_RSW = 2 * MiB + 256 * 1024, WS_PWT = 2 * MiB + 512 * 1024;
constexpr size_t WS_WTIN = 4 * MiB, WS_WTOUT = 44 * MiB, WS_H = 60 * MiB, WS_MIX = 126 * MiB, WS_QC = 192 * MiB, WS_KC = 225 * MiB, WS_VTP = 233 * MiB, WS_Z2 = 241 * MiB, WS_Y = 357 * MiB, WS_END = 489 * MiB;
constexpr int CW_BAR = 1024;

__constant__ double ROPE_INV[32] = {1.0, 0.7498942093324559, 0.5623413251903491, 0.4216965034285822, 0.31622776601683794, 0.23713737056616552, 0.1778279410038923, 0.1333521432163324, 0.1, 0.07498942093324558, 0.05623413251903491, 0.042169650342858224, 0.03162277660168379, 0.023713737056616554, 0.01778279410038923, 0.01333521432163324, 0.01, 0.007498942093324558, 0.005623413251903491, 0.004216965034285823, 0.0031622776601683794, 0.0023713737056616554, 0.0017782794100389228, 0.001333521432163324, 0.001, 0.0007498942093324559, 0.0005623413251903491, 0.00042169650342858224, 0.00031622776601683794, 0.00023713737056616554, 0.00017782794100389227, 0.0001333521432163324};

struct Args { const float* in[16]; float* out; unsigned char* ws; };

struct Frame {
    int tid, lane, wave, bid, G;
    const float *xp, *xs, *cache_k, *cache_v, *state_pool, *w_in, *w_out, *norm_pre, *norm_post, *sinks, *pool_w, *pool_scale, *ln_g, *ln_b, *sgu_w, *sgu_b;
    float* out;
    float* rope; float* RSW; bf16_t *SGUW, *PWT, *WTIN, *WTOUT, *H, *MIX, *Qc, *Kc, *VTP, *Z2, *Yb;
};

__device__ __forceinline__ float wave_sum(float v) {
#pragma unroll
    for (int o = 1; o < 64; o <<= 1) v += __shfl_xor(v, o);
    return v;
}
__device__ __forceinline__ float wave_max(float v) {
#pragma unroll
    for (int o = 1; o < 64; o <<= 1) v = fmaxf(v, __shfl_xor(v, o));
    return v;
}
__device__ __forceinline__ float bflo(unsigned w) { return __uint_as_float(w << 16); }
__device__ __forceinline__ float bfhi(unsigned w) { return __uint_as_float(w & 0xffff0000u); }
__device__ __forceinline__ void unpack8(const u32x4 w, float (&f)[8]) { f[0] = bflo(w.x); f[1] = bfhi(w.x); f[2] = bflo(w.y); f[3] = bfhi(w.y); f[4] = bflo(w.z); f[5] = bfhi(w.z); f[6] = bflo(w.w); f[7] = bfhi(w.w); }
__device__ __forceinline__ void unpack4(const u32x2 w, float (&f)[4]) { f[0] = bflo(w.x); f[1] = bfhi(w.x); f[2] = bflo(w.y); f[3] = bfhi(w.y); }
__device__ __forceinline__ u32x4 pack8(const float (&f)[8]) { u32x4 w; w.x = pg8::cvt_pk_bf16(f[0], f[1]); w.y = pg8::cvt_pk_bf16(f[2], f[3]); w.z = pg8::cvt_pk_bf16(f[4], f[5]); w.w = pg8::cvt_pk_bf16(f[6], f[7]); return w; }
__device__ __forceinline__ int crow(int r, int hi) { return (r & 3) + 8 * (r >> 2) + 4 * hi; }
#define LDS_WAIT() asm volatile("s_waitcnt lgkmcnt(0)" ::: "memory")


struct ArgsG { const __attribute__((address_space(1))) float* in[16]; __attribute__((address_space(1))) float* out; __attribute__((address_space(1))) unsigned char* ws; };
typedef const __attribute__((address_space(4))) ArgsG* KArgs;
__device__ __forceinline__ KArgs kargs() { KArgs p = (KArgs)__builtin_amdgcn_kernarg_segment_ptr(); asm volatile("" : "+s"(p)); return p; }
__device__ __forceinline__ void make_frame(Frame& F, KArgs a) {
    { int t_ = threadIdx.x; asm volatile("" : "+v"(t_)); F.tid = t_; } F.lane = F.tid & 63; F.wave = __builtin_amdgcn_readfirstlane(F.tid >> 6); F.bid = blockIdx.x; F.G = gridDim.x;
    F.xp = (const float*)a->in[0]; F.xs = (const float*)a->in[1]; F.cache_k = (const float*)a->in[2]; F.cache_v = (const float*)a->in[3]; F.state_pool = (const float*)a->in[4]; F.w_in = (const float*)a->in[5]; F.w_out = (const float*)a->in[6]; F.norm_pre = (const float*)a->in[7]; F.norm_post = (const float*)a->in[8];
    F.sinks = (const float*)a->in[9]; F.pool_w = (const float*)a->in[10]; F.pool_scale = (const float*)a->in[11]; F.ln_g = (const float*)a->in[12]; F.ln_b = (const float*)a->in[13]; F.sgu_w = (const float*)a->in[14]; F.sgu_b = (const float*)a->in[15];
    F.out = (float*)a->out;
    unsigned char* ws = (unsigned char*)a->ws;
    F.rope = (float*)(ws + WS_ROPE); F.RSW = (float*)(ws + WS_RSW); F.SGUW = (bf16_t*)(ws + WS_SGUW); F.PWT = (bf16_t*)(ws + WS_PWT); F.WTIN = (bf16_t*)(ws + WS_WTIN); F.WTOUT = (bf16_t*)(ws + WS_WTOUT);
    F.H = (bf16_t*)(ws + WS_H); F.MIX = (bf16_t*)(ws + WS_MIX); F.Qc = (bf16_t*)(ws + WS_QC); F.Kc = (bf16_t*)(ws + WS_KC); F.VTP = (bf16_t*)(ws + WS_VTP); F.Z2 = (bf16_t*)(ws + WS_Z2); F.Yb = (bf16_t*)(ws + WS_Y);
}

#define LOCAL_FRAME Frame F; make_frame(F, kargs())

constexpr int CW_Q = 8192;
constexpr int CW_ZS = 8192 + 64 * 8;
constexpr int CW_YS = 8192 + 64 * 16;
constexpr int CW_EV = 8192 + 64 * 32;
__device__ __forceinline__ unsigned* ctl_word(int idx) { return (unsigned*)((unsigned char*)kargs()->ws + WS_CTL) + idx; }
__device__ __forceinline__ int q_pop(unsigned* head, LAS unsigned char* L) {
    volatile LAS int* slot = (volatile LAS int*)(L + 64);
    __syncthreads();
    if (threadIdx.x == 0) *slot = (int)__hip_atomic_fetch_add(head, 1u, __ATOMIC_RELAXED, __HIP_MEMORY_SCOPE_AGENT);
    __syncthreads();
    return __builtin_amdgcn_readfirstlane(*slot);
}
__device__ __forceinline__ void publish(unsigned* ctr) {
    asm volatile("s_waitcnt vmcnt(0)" ::: "memory");
    __syncthreads();
    if (threadIdx.x == 0) { __builtin_amdgcn_fence(__ATOMIC_RELEASE, "agent"); asm volatile("s_waitcnt vmcnt(0)" ::: "memory");
        __hip_atomic_fetch_add(ctr, 1u, __ATOMIC_RELAXED, __HIP_MEMORY_SCOPE_AGENT); }
}
__device__ __forceinline__ void dep_wait(unsigned* ctr, unsigned need) {
    if (threadIdx.x == 0) {
        unsigned sp = 0;
        while (__hip_atomic_load(ctr, __ATOMIC_RELAXED, __HIP_MEMORY_SCOPE_AGENT) < need) { __builtin_amdgcn_s_sleep(16); if (++sp > (1u << 21)) break; }
        __builtin_amdgcn_fence(__ATOMIC_ACQUIRE, "agent"); asm volatile("s_waitcnt vmcnt(0)" ::: "memory");
    }
    __syncthreads();
}

#if PROBE_SEL >= 10
#define EV_T0() const unsigned long long ev_t0 = __builtin_amdgcn_s_memrealtime()
#define EV_MAX(k) do { if (threadIdx.x == 0) __hip_atomic_fetch_max(ctl_word(CW_EV + 64 * (k)), (unsigned)(__builtin_amdgcn_s_memrealtime() - ev_t0), __ATOMIC_RELAXED, __HIP_MEMORY_SCOPE_AGENT); } while (0)
#define EV_MIN(k) do { if (threadIdx.x == 0) __hip_atomic_fetch_max(ctl_word(CW_EV + 64 * (k)), 0x40000000u - (unsigned)(__builtin_amdgcn_s_memrealtime() - ev_t0), __ATOMIC_RELAXED, __HIP_MEMORY_SCOPE_AGENT); } while (0)
#else
#define EV_T0() do {} while (0)
#define EV_MAX(k) do {} while (0)
#define EV_MIN(k) do {} while (0)
#endif
struct OneUnit {
    pg8::Unit u;
    __device__ __forceinline__ bool next(int i, pg8::Unit& o) const { if (i) return false; o = u; return true; }
    __device__ __forceinline__ void a_ready(const pg8::Unit&) const {}
    __device__ __forceinline__ void done(const pg8::Unit&) const {}
};

#ifndef PROBE_SEL
#define PROBE_SEL 0
#endif
#if PROBE_SEL
#define STAMP(k) do { if (blockIdx.x == 0 && threadIdx.x == 0) ((LAS unsigned long long*)(L + 256))[k] = __builtin_amdgcn_s_memrealtime(); } while (0)
#define STAMP2(k) do { if (blockIdx.x == 0) { __syncthreads(); if (threadIdx.x == 0) ((LAS unsigned long long*)((LAS unsigned char*)ring - RING_OFF + 256))[k] = __builtin_amdgcn_s_memrealtime(); } } while (0)
#else
#define STAMP(k) do {} while (0)
#define STAMP2(k) do {} while (0)
#endif
#if PROBE_SEL == 1
#define PA0 0
#define PA1 1
#define PB0 1
#define PB1 2
#elif PROBE_SEL == 2
#define PA0 2
#define PA1 3
#define PB0 3
#define PB1 4
#elif PROBE_SEL == 3
#define PA0 4
#define PA1 5
#define PB0 8
#define PB1 9
#elif PROBE_SEL == 4
#define PA0 2
#define PA1 10
#define PB0 10
#define PB1 11
#elif PROBE_SEL == 5
#define PA0 11
#define PA1 12
#define PB0 12
#define PB1 13
#elif PROBE_SEL == 6
#define PA0 5
#define PA1 6
#define PB0 7
#define PB1 8
#elif PROBE_SEL == 10
#define PEA 0
#define PEA_MIN 0
#define PEB 1
#define PEB_MIN 1
#elif PROBE_SEL == 11
#define PEA 2
#define PEA_MIN 0
#define PEB 3
#define PEB_MIN 1
#elif PROBE_SEL == 12
#define PEA 4
#define PEA_MIN 0
#define PEB 5
#define PEB_MIN 0
#elif PROBE_SEL == 13
#define PEA 6
#define PEA_MIN 1
#define PEB 7
#define PEB_MIN 0
#endif

__device__ __forceinline__ void p0_transpose(const float* W, int K, int N, bf16_t* WT, bool permqk, LAS float* scr, int item, int lane) {
    const int nblk = N >> 6, kb = item / nblk, nb = item - kb * nblk, k0 = kb * 64, n0 = nb * 64;
#pragma unroll
    for (int i = 0; i < 16; ++i) { const int kk = 4 * i + (lane >> 4), nn = 4 * (lane & 15);
        const f32x4 v = *(const f32x4*)(W + (size_t)(k0 + kk) * N + n0 + nn); *(LAS f32x4*)(scr + kk * 68 + nn) = v; }
    LDS_WAIT();
    const int n = n0 + lane; int nrow = n;
    if (permqk && n < 1280) { const int p = n & 63; nrow = (n & ~63) + 2 * (p & 31) + (p >> 5); }
    bf16_t* dst = WT + (size_t)nrow * K + k0;
#pragma unroll
    for (int c = 0; c < 8; ++c) { float f[8];
#pragma unroll
        for (int j = 0; j < 8; ++j) f[j] = scr[(8 * c + j) * 68 + lane];
        *(u32x4*)(dst + 8 * c) = pack8(f); }
    LDS_WAIT();
}
__device__ __forceinline__ void prenorm_row(const float* xrow, const float* g, bf16_t* hrow, int lane) {
    f32x4 v[8]; float ss = 0.f;
#pragma unroll
    for (int j = 0; j < 8; ++j) { v[j] = *(const f32x4*)(xrow + 4 * lane + 256 * j); ss += (v[j][0] * v[j][0] + v[j][1] * v[j][1]) + (v[j][2] * v[j][2] + v[j][3] * v[j][3]); }
    ss = wave_sum(ss);
    const float r = rsqrtf(ss * (1.0f / 2048.0f) + EPS);
#pragma unroll
    for (int j = 0; j < 8; ++j) { const f32x4 gg = *(const f32x4*)(g + 4 * lane + 256 * j); const f32x4 o = v[j] * r * gg;
        u32x2 w; w.x = pg8::cvt_pk_bf16(o[0], o[1]); w.y = pg8::cvt_pk_bf16(o[2], o[3]); *(u32x2*)(hrow + 4 * lane + 256 * j) = w; }
}
__device__ __forceinline__ void p0_prologue(const Frame& F, LAS unsigned char* ring) {
    LAS float* scr = (LAS float*)(ring + F.wave * 17408);
    const int gw = F.bid * NWAVES + F.wave, NGW = F.G * NWAVES;
    constexpr int I_IN = 32 * 80, I_OUT = 32 * 32, NITEMS = 2 * (I_IN + I_OUT);
    for (int it = gw; it < NITEMS; it += NGW) {
        int r = it;
        if (r < 2 * I_IN) { const int l = r / I_IN; r -= l * I_IN; p0_transpose(F.w_in + (size_t)l * DM * DIN, DM, DIN, F.WTIN + (size_t)l * DIN * DM, true, scr, r, F.lane); }
        else { r -= 2 * I_IN; const int l = r / I_OUT; r -= l * I_OUT; p0_transpose(F.w_out + (size_t)l * DM * DM, DM, DM, F.WTOUT + (size_t)l * DM * DM, false, scr, r, F.lane); }
    }
    for (int m = gw; m < MT; m += NGW) { const float* xr = m < MP ? F.xp + (size_t)m * DM : F.xs + (size_t)(m - MP) * DM; prenorm_row(xr, F.norm_pre, F.H + (size_t)m * DM, F.lane); }
    const int gt = F.bid * NTHREADS + F.tid, NGT = F.G * NTHREADS;
    for (int e = gt; e < 2052 * 32; e += NGT) { const int tp = e >> 5, i = e & 31; const double pos = (double)(tp < 2048 ? tp : 8192 + (tp - 2048));
        const double rev = pos * ROPE_INV[i] * 0.15915494309189535; const float fr = (float)(rev - floor(rev));
        F.rope[tp * 64 + i] = __builtin_amdgcn_cosf(fr); F.rope[tp * 64 + 32 + i] = __builtin_amdgcn_sinf(fr); }
    for (int e = gt; e < 2 * 4 * 128 * 128; e += NGT) { const int s = e & 127, t = (e >> 7) & 127; const float w = F.sgu_w[e];
        F.SGUW[e] = (bf16_t)(pg8::cvt_pk_bf16(s <= t ? w : 0.f, 0.f) & 0xffffu); }
    for (int e = gt; e < 2 * 4 * 128; e += NGT) { const int t = e & 127; const float* wr = F.sgu_w + (size_t)e * 128; float acc = 0.f;
        for (int s2 = 0; s2 <= t; ++s2) acc += __uint_as_float(pg8::cvt_pk_bf16(wr[s2], 0.f) << 16);
        F.RSW[e] = acc; }
    for (int e = gt; e < 2 * 4 * 128 * 128; e += NGT) { const int c = e & 127, d = (e >> 7) & 127, lg = e >> 14;
        F.PWT[e] = (bf16_t)(pg8::cvt_pk_bf16(F.pool_w[((size_t)lg * 128 + c) * 128 + d], 0.f) & 0xffffu); }
}

constexpr int AT_K = 0, AT_V = 49152, AT_STG = 98304, AT_WSTRIDE = 4352;
__device__ __forceinline__ void attn_stage_kv(const Frame& F, int b, int kvh, int nbp, LAS unsigned char* ring) {
    const int tid = F.tid;
    const bf16_t* kg = F.Kc + ((size_t)(b * 4 + kvh) * 2048 + 256 * nbp - 128) * 64;
    const bf16_t* vg = F.VTP + ((size_t)(b * 4 + kvh) * 64 + 8 * nbp - 4) * 2048;
    u32x4 kv[6], vv[6];
#pragma unroll
    for (int i = 0; i < 6; ++i) { const int ch = tid + 512 * i, row0 = ch >> 3, c8 = ch & 7, row = (nbp > 0 || row0 >= 128) ? row0 : row0 + 128;
        kv[i] = *(const u32x4*)(kg + row * 64 + c8 * 8); }
#pragma unroll
    for (int i = 0; i < 6; ++i) { const int ch = tid + 512 * i, tile0 = ch >> 8, rem = ch & 255, d = rem >> 2, c4 = rem & 3, tile = (nbp > 0 || tile0 >= 4) ? tile0 : tile0 + 4;
        vv[i] = *(const u32x4*)(vg + tile * 2048 + d * 32 + c4 * 8); }
#pragma unroll
    for (int i = 0; i < 6; ++i) { const int ch = tid + 512 * i, row = ch >> 3, c8 = ch & 7;
        *(LAS u32x4*)(ring + AT_K + row * 128 + ((c8 ^ (row & 7)) << 4)) = kv[i]; }
#pragma unroll
    for (int i = 0; i < 6; ++i) { const int ch = tid + 512 * i, tile = ch >> 8, rem = ch & 255, d = rem >> 2, c4 = rem & 3;
        *(LAS u32x4*)(ring + AT_V + tile * 4096 + d * 64 + ((c4 ^ ((d >> 2) & 3)) << 4)) = vv[i]; }
}
__device__ __forceinline__ void attn_task(const Frame& F, int l, int b, int nbp, int head, int j, const bf16x8 (&qf)[4], LAS unsigned char* ring) {
    const int lane = F.lane, r = lane & 31, hh = lane >> 5;
    LAS unsigned char* wl = ring + AT_STG + F.wave * AT_WSTRIDE;
    LAS float* wsf = (LAS float*)wl; LAS bf16_t* stg = (LAS bf16_t*)(wl + 256);
    const size_t qrow0 = (size_t)b * 2048 + 256 * nbp + 32 * j;
    u32x4 gv[4];
#pragma unroll
    for (int i = 0; i < 4; ++i) gv[i] = *(const u32x4*)(F.Z2 + (qrow0 + i * 8 + (lane >> 3)) * ZW + Z_GA + head * 64 + (lane & 7) * 8);
    const int cmin = (nbp > 0) ? 0 : (j < 4 ? 4 - j : 0);
    f32x16 S[5];
#pragma unroll
    for (int c = 0; c < 5; ++c) {
        f32x16 a;
#pragma unroll
        for (int i = 0; i < 16; ++i) a[i] = 0.f;
        if (c >= cmin) {
            LAS unsigned char* kp = ring + AT_K + (32 * (j + c) + r) * 128;
#pragma unroll
            for (int s = 0; s < 4; ++s) a = __builtin_amdgcn_mfma_f32_32x32x16_bf16(*(const LAS bf16x8*)(kp + (((2 * s + hh) ^ (r & 7)) << 4)), qf[s], a, 0, 0, 0);
        }
        S[c] = a;
    }
    const float NEG = -INFINITY;
#pragma unroll
    for (int i = 0; i < 16; ++i) { const int kap = crow(i, hh); if (kap <= r) S[0][i] = NEG; if (kap > r) S[4][i] = NEG; }
    const float sink2 = F.sinks[l * 16 + head] * LOG2E;
    float m = sink2;
#pragma unroll
    for (int c = 0; c < 5; ++c) if (c >= cmin) {
#pragma unroll
        for (int i = 0; i < 16; ++i) m = fmaxf(m, S[c][i]); }
    m = fmaxf(m, __shfl_xor(m, 32));
    float sum = 0.f;
#pragma unroll
    for (int c = 0; c < 5; ++c) if (c >= cmin) {
#pragma unroll
        for (int i = 0; i < 16; ++i) { const float p = __builtin_amdgcn_exp2f(S[c][i] - m); S[c][i] = p; sum += p; } }
    sum += __shfl_xor(sum, 32);
    const float inv = 1.0f / (sum + __builtin_amdgcn_exp2f(sink2 - m));
    f32x16 o[2];
#pragma unroll
    for (int i = 0; i < 16; ++i) { o[0][i] = 0.f; o[1][i] = 0.f; }
#pragma unroll
    for (int c = 0; c < 5; ++c) if (c >= cmin) {
        LAS unsigned char* vt = ring + AT_V + (j + c) * 4096 + r * 64;
#pragma unroll
        for (int s = 0; s < 2; ++s) {
            u32x4 pw; pw.x = pg8::cvt_pk_bf16(S[c][8 * s + 0], S[c][8 * s + 1]); pw.y = pg8::cvt_pk_bf16(S[c][8 * s + 2], S[c][8 * s + 3]);
            pw.z = pg8::cvt_pk_bf16(S[c][8 * s + 4], S[c][8 * s + 5]); pw.w = pg8::cvt_pk_bf16(S[c][8 * s + 6], S[c][8 * s + 7]);
            const bf16x8 pa = __builtin_bit_cast(bf16x8, pw);
            const int sw = (((2 * hh + s) ^ ((r >> 2) & 3)) << 4);
#pragma unroll
            for (int db = 0; db < 2; ++db) o[db] = __builtin_amdgcn_mfma_f32_32x32x16_bf16(pa, *(const LAS bf16x8*)(vt + db * 2048 + sw), o[db], 0, 0, 0);
        }
    }
    if (hh == 0) wsf[r] = inv;
    LDS_WAIT();
#pragma unroll
    for (int i = 0; i < 16; ++i) { const int q = crow(i, hh); const float rl = wsf[q];
        stg[q * 64 + r] = (bf16_t)(pg8::cvt_pk_bf16(o[0][i] * rl, 0.f) & 0xffffu);
        stg[q * 64 + 32 + r] = (bf16_t)(pg8::cvt_pk_bf16(o[1][i] * rl, 0.f) & 0xffffu); }
    LDS_WAIT();
#pragma unroll
    for (int i = 0; i < 4; ++i) { const int row = i * 8 + (lane >> 3), ch = lane & 7;
        const u32x4 ov = *(const LAS u32x4*)(stg + row * 64 + ch * 8);
        float of[8], gf[8]; unpack8(ov, of); unpack8(gv[i], gf);
#pragma unroll
        for (int jj = 0; jj < 8; ++jj) of[jj] *= gf[jj];
        *(u32x4*)(F.MIX + (qrow0 + row) * DM + head * 64 + ch * 8) = pack8(of); }
    LDS_WAIT();
}
__device__ __forceinline__ void attn_unit(int l, int a, LAS unsigned char* ring) {
    LOCAL_FRAME;
    const int kvh = a & 3, nbp = (a >> 2) & 7, b = a >> 5;
    const int lane = F.lane, r = lane & 31, hh = lane >> 5;
    const int head = 4 * kvh + (F.wave >> 1), j0 = 4 * (F.wave & 1);
    const bf16_t* qp = F.Qc + ((size_t)b * 2048 + 256 * nbp + 32 * j0 + r) * 1024 + head * 64 + 8 * hh;
    bf16x8 qa[4], qb[4];
#pragma unroll
    for (int s = 0; s < 4; ++s) qa[s] = *(const bf16x8*)(qp + 16 * s);
#ifdef EXP_ZERO_LDS
    for (int e = F.tid; e < 134144 / 16; e += NTHREADS) *(LAS u32x4*)(ring + 16 * e) = (u32x4){0u, 0u, 0u, 0u};
    LDS_WAIT(); __syncthreads();
#endif
    attn_stage_kv(F, b, kvh, nbp, ring);
    LDS_WAIT();
    __syncthreads();
#pragma unroll
    for (int s = 0; s < 4; ++s) qb[s] = *(const bf16x8*)(qp + 32 * 1024 + 16 * s);
    attn_task(F, l, b, nbp, head, j0 + 0, qa, ring);
#pragma unroll
    for (int s = 0; s < 4; ++s) qa[s] = *(const bf16x8*)(qp + 64 * 1024 + 16 * s);
    attn_task(F, l, b, nbp, head, j0 + 1, qb, ring);
#pragma unroll
    for (int s = 0; s < 4; ++s) qb[s] = *(const bf16x8*)(qp + 96 * 1024 + 16 * s);
    attn_task(F, l, b, nbp, head, j0 + 2, qa, ring);
    attn_task(F, l, b, nbp, head, j0 + 3, qb, ring);
    __syncthreads();
}

constexpr int PL_STRIDE = 272, PL_WBYTES = 47 * 272;
template <int G>
__device__ __forceinline__ void pool_unit_p(int l, int tile, LAS unsigned char* wl) {
    LOCAL_FRAME;
    constexpr int W = 2 << G, HIST = W - 1, NROW = 32 + HIST, NLD = (NROW * 16 + 63) / 64;
    const int lane = F.lane, r = lane & 31, hh = lane >> 5;
    const size_t R0 = (size_t)32 * tile;
    const int t0 = (int)(R0 & 2047);
    {
        u32x4 x[NLD];
#pragma unroll
        for (int k = 0; k < NLD; ++k) { const int id = lane + 64 * k, lr = id >> 4, c16 = id & 15; const int lrc = lr < NROW ? lr : NROW - 1;
            const int back = HIST - lrc; const size_t grow = (back <= t0) ? R0 - back : R0;
            x[k] = *(const u32x4*)(F.Z2 + grow * ZW + Z_XB + 128 * G + 8 * c16); }
#pragma unroll
        for (int k = 0; k < NLD; ++k) { const int id = lane + 64 * k, lr = id >> 4, c16 = id & 15; if (lr < NROW) *(LAS u32x4*)(wl + lr * PL_STRIDE + c16 * 16) = x[k]; }
    }
    const size_t row = R0 + r; const int t = t0 + r;
    u32x2 gq[4][4];
#pragma unroll
    for (int db = 0; db < 4; ++db)
#pragma unroll
        for (int q = 0; q < 4; ++q) gq[db][q] = *(const u32x2*)(F.Z2 + row * ZW + Z_GP + 128 * G + 32 * db + 8 * q + 4 * hh);
    const float icnt = 1.0f / (float)(W < t + 1 ? W : t + 1);
    LDS_WAIT();
    bf16x8 bfr[8];
#pragma unroll
    for (int s = 0; s < 8; ++s) {
        LAS unsigned char* bp = wl + (r + HIST) * PL_STRIDE + (16 * s + 8 * hh) * 2;
        float cur[8], sum[8]; unpack8(*(const LAS u32x4*)bp, cur);
#pragma unroll
        for (int jj = 0; jj < 8; ++jj) sum[jj] = cur[jj];
#pragma unroll
        for (int i = 1; i < W; ++i) { float f[8]; unpack8(*(const LAS u32x4*)(bp - i * PL_STRIDE), f); const float wgt = i <= t ? 1.f : 0.f;
#pragma unroll
            for (int jj = 0; jj < 8; ++jj) sum[jj] += wgt * f[jj]; }
#pragma unroll
        for (int jj = 0; jj < 8; ++jj) sum[jj] = sum[jj] * icnt - cur[jj];
        bfr[s] = __builtin_bit_cast(bf16x8, pack8(sum));
        __builtin_amdgcn_sched_barrier(0);
    }
    f32x16 acc[4];
#pragma unroll
    for (int db = 0; db < 4; ++db) {
#pragma unroll
        for (int i = 0; i < 16; ++i) acc[db][i] = 0.f;
        const bf16_t* ap = F.PWT + ((size_t)(l * 4 + G) * 128 + 32 * db + r) * 128 + 8 * hh;
#pragma unroll
        for (int s = 0; s < 8; ++s) acc[db] = __builtin_amdgcn_mfma_f32_32x32x16_bf16(*(const bf16x8*)(ap + 16 * s), bfr[s], acc[db], 0, 0, 0);
        __builtin_amdgcn_sched_barrier(0);
    }
#pragma unroll
    for (int db = 0; db < 4; ++db)
#pragma unroll
        for (int q = 0; q < 4; ++q) {
            const int col = 128 * G + 32 * db + 8 * q + 4 * hh;
            const f32x4 sc = *(const f32x4*)(F.pool_scale + l * 512 + col);
            float gf[4]; unpack4(gq[db][q], gf);
            u32x2 wv; wv.x = pg8::cvt_pk_bf16(acc[db][4 * q + 0] * sc[0] * gf[0], acc[db][4 * q + 1] * sc[1] * gf[1]);
            wv.y = pg8::cvt_pk_bf16(acc[db][4 * q + 2] * sc[2] * gf[2], acc[db][4 * q + 3] * sc[3] * gf[3]);
            *(u32x2*)(F.MIX + row * DM + 1024 + col) = wv;
        }
    LDS_WAIT();
}
__device__ __forceinline__ void pool_prompt(int l, int g, int tile, LAS unsigned char* wl) {
    if (g == 0) pool_unit_p<0>(l, tile, wl); else if (g == 1) pool_unit_p<1>(l, tile, wl); else if (g == 2) pool_unit_p<2>(l, tile, wl); else pool_unit_p<3>(l, tile, wl);
}
template <int G>
__device__ __forceinline__ void pool_unit_s(int l, int tile) {
    LOCAL_FRAME;
    constexpr int W = 2 << G;
    const int lane = F.lane, r = lane & 31, hh = lane >> 5;
    const size_t row = (size_t)MP + 32 * tile + r;
    const int tt = (int)(row & 3), bd = (int)((row - MP) >> 2);
    const float* stb = F.state_pool + ((size_t)l * 128 + bd) * 15 * 512;
    const float icnt = 1.0f / (float)W;
    bf16x8 bfr[8];
#pragma unroll
    for (int s = 0; s < 8; ++s) {
        const int c0 = 128 * G + 16 * s + 8 * hh;
        float sum[8], cur[8];
        {
            constexpr int NL = W < 4 ? W : 4;
            u32x4 zn[NL]; f32x4 sa[NL], sb[NL];
#pragma unroll
            for (int i = 0; i < NL; ++i) { const int back = i <= tt ? i : tt; int si = 15 + tt - i; si = si > 14 ? 14 : si;
                zn[i] = *(const u32x4*)(F.Z2 + (row - back) * ZW + Z_XB + c0); sa[i] = *(const f32x4*)(stb + si * 512 + c0); sb[i] = *(const f32x4*)(stb + si * 512 + c0 + 4); }
            unpack8(zn[0], cur);
#pragma unroll
            for (int jj = 0; jj < 8; ++jj) sum[jj] = cur[jj];
#pragma unroll
            for (int i = 1; i < NL; ++i) { float f[8]; unpack8(zn[i], f); const bool nw = i <= tt;
#pragma unroll
                for (int jj = 0; jj < 4; ++jj) { sum[jj] += nw ? f[jj] : sa[i][jj]; sum[4 + jj] += nw ? f[4 + jj] : sb[i][jj]; } }
        }
#pragma unroll
        for (int i0 = 4; i0 < W; i0 += 4) {
            f32x4 sa[4], sb[4];
#pragma unroll
            for (int i = 0; i < 4; ++i) { const int si = 15 + tt - (i0 + i); sa[i] = *(const f32x4*)(stb + si * 512 + c0); sb[i] = *(const f32x4*)(stb + si * 512 + c0 + 4); }
#pragma unroll
            for (int i = 0; i < 4; ++i)
#pragma unroll
                for (int jj = 0; jj < 4; ++jj) { sum[jj] += sa[i][jj]; sum[4 + jj] += sb[i][jj]; }
        }
#pragma unroll
        for (int jj = 0; jj < 8; ++jj) sum[jj] = sum[jj] * icnt - cur[jj];
        bfr[s] = __builtin_bit_cast(bf16x8, pack8(sum));
        __builtin_amdgcn_sched_barrier(0);
    }
    f32x16 acc[4];
#pragma unroll
    for (int db = 0; db < 4; ++db) {
#pragma unroll
        for (int i = 0; i < 16; ++i) acc[db][i] = 0.f;
        const bf16_t* ap = F.PWT + ((size_t)(l * 4 + G) * 128 + 32 * db + r) * 128 + 8 * hh;
#pragma unroll
        for (int s = 0; s < 8; ++s) acc[db] = __builtin_amdgcn_mfma_f32_32x32x16_bf16(*(const bf16x8*)(ap + 16 * s), bfr[s], acc[db], 0, 0, 0);
        __builtin_amdgcn_sched_barrier(0);
    }
#pragma unroll
    for (int db = 0; db < 4; ++db)
#pragma unroll
        for (int q = 0; q < 4; ++q) {
            const int col = 128 * G + 32 * db + 8 * q + 4 * hh;
            const f32x4 sc = *(const f32x4*)(F.pool_scale + l * 512 + col);
            float gf[4]; unpack4(*(const u32x2*)(F.Z2 + row * ZW + Z_GP + col), gf);
            u32x2 wv; wv.x = pg8::cvt_pk_bf16(acc[db][4 * q + 0] * sc[0] * gf[0], acc[db][4 * q + 1] * sc[1] * gf[1]);
            wv.y = pg8::cvt_pk_bf16(acc[db][4 * q + 2] * sc[2] * gf[2], acc[db][4 * q + 3] * sc[3] * gf[3]);
            *(u32x2*)(F.MIX + row * DM + 1024 + col) = wv;
        }
}
__device__ __forceinline__ void pool_sample(int l, int g, int tile) {
    if (g == 0) pool_unit_s<0>(l, tile); else if (g == 1) pool_unit_s<1>(l, tile); else if (g == 2) pool_unit_s<2>(l, tile); else pool_unit_s<3>(l, tile);
}

struct SguOps { bf16x8 wB[8], wA[4]; u32x2 uu[2][4], gg[2][4]; float bias[2], rsw[2]; };
__device__ __forceinline__ void sgu_load_ops(SguOps& o, const Frame& F, int l, int hd, size_t R0, int r, int hh, int db, int tbA, int tbB) {
    const bf16_t* Wb = F.SGUW + (size_t)(l * 4 + hd) * 128 * 128;
#pragma unroll
    for (int s = 0; s < 8; ++s) { o.wB[s] = (bf16x8){0, 0, 0, 0, 0, 0, 0, 0}; if (s < 2 * (tbB + 1)) o.wB[s] = *(const bf16x8*)(Wb + (32 * tbB + r) * 128 + 16 * s + 8 * hh); }
#pragma unroll
    for (int s = 0; s < 4; ++s) { o.wA[s] = (bf16x8){0, 0, 0, 0, 0, 0, 0, 0}; if (s < 2 * (tbA + 1)) o.wA[s] = *(const bf16x8*)(Wb + (32 * tbA + r) * 128 + 16 * s + 8 * hh); }
#pragma unroll
    for (int pass = 0; pass < 2; ++pass) { const int tb = pass ? tbB : tbA; const size_t row = R0 + 32 * tb + r;
        o.bias[pass] = F.sgu_b[l * 512 + hd * 128 + 32 * tb + r]; o.rsw[pass] = F.RSW[(l * 4 + hd) * 128 + 32 * tb + r];
#pragma unroll
        for (int q = 0; q < 4; ++q) { const int col = 128 * hd + 32 * db + 8 * q + 4 * hh;
            o.uu[pass][q] = *(const u32x2*)(F.Z2 + row * ZW + Z_U + col); o.gg[pass][q] = *(const u32x2*)(F.Z2 + row * ZW + Z_GS + col); } }
}
__device__ __forceinline__ void sgu_mfma(const SguOps& o, LAS bf16_t* VnT, int h2, int r, int hh, int db, int tbA, int tbB, f32x16& accA, f32x16& accB) {
#pragma unroll
    for (int i = 0; i < 16; ++i) { accA[i] = 0.f; accB[i] = 0.f; }
#pragma unroll
    for (int s = 0; s < 8; ++s) {
        if (s < 2 * (tbB + 1)) {
            const bf16x8 a = *(const LAS bf16x8*)(VnT + (h2 * 128 + 32 * db + r) * 136 + 16 * s + 8 * hh);
            accB = __builtin_amdgcn_mfma_f32_32x32x16_bf16(a, o.wB[s], accB, 0, 0, 0);
            if (s < 4) { if (s < 2 * (tbA + 1)) accA = __builtin_amdgcn_mfma_f32_32x32x16_bf16(a, o.wA[s], accA, 0, 0, 0); }
        }
    }
}
__device__ __forceinline__ void sgu_epi(const SguOps& o, const Frame& F, int l, int hd, size_t R0, int r, int hh, int db, int tbA, int tbB, const f32x16& accA, const f32x16& accB) {
    f32x4 lg[4], lb[4];
#pragma unroll
    for (int q = 0; q < 4; ++q) { const int col = 128 * hd + 32 * db + 8 * q + 4 * hh; lg[q] = *(const f32x4*)(F.ln_g + l * 512 + col); lb[q] = *(const f32x4*)(F.ln_b + l * 512 + col); }
#pragma unroll
    for (int pass = 0; pass < 2; ++pass) {
        const int tb = pass ? tbB : tbA; const f32x16 acc = pass ? accB : accA;
        const size_t row = R0 + 32 * tb + r; const float bs = o.bias[pass], rs = o.rsw[pass];
#pragma unroll
        for (int q = 0; q < 4; ++q) { const int col = 128 * hd + 32 * db + 8 * q + 4 * hh;
            float uf[4], gf[4]; unpack4(o.uu[pass][q], uf); unpack4(o.gg[pass][q], gf);
            float m[4];
#pragma unroll
            for (int e = 0; e < 4; ++e) m[e] = (lg[q][e] * acc[4 * q + e] + lb[q][e] * rs + bs) * uf[e] * gf[e];
            u32x2 wo; wo.x = pg8::cvt_pk_bf16(m[0], m[1]); wo.y = pg8::cvt_pk_bf16(m[2], m[3]);
            *(u32x2*)(F.MIX + row * DM + 1536 + col) = wo; }
    }
}
__device__ __forceinline__ void sgu_unit(int l, int ci, int hp, LAS unsigned char* ring) {
    LOCAL_FRAME;
    LAS bf16_t* VnT = (LAS bf16_t*)ring;
    const int lane = F.lane, wv = F.wave;
    const size_t R0 = (size_t)128 * ci;
    const int r = lane & 31, hh = lane >> 5, db = wv & 3; const int tbA = (wv >> 2) ? 1 : 0, tbB = (wv >> 2) ? 2 : 3;
    SguOps op0;
    {
        const int tl = lane >> 2, q4 = lane & 3;
        const bf16_t* vrow = F.Z2 + (R0 + 16 * wv + tl) * ZW + Z_VS + 32 * q4;
        u32x4 x[4][4];
#pragma unroll
        for (int h = 0; h < 4; ++h)
#pragma unroll
            for (int i = 0; i < 4; ++i) x[h][i] = *(const u32x4*)(vrow + 128 * h + 8 * i);
        sgu_load_ops(op0, F, l, 2 * hp, R0, r, hh, db, tbA, tbB);
        float s = 0.f, ss = 0.f;
#pragma unroll
        for (int h = 0; h < 4; ++h)
#pragma unroll
            for (int i = 0; i < 4; ++i) { float f[8]; unpack8(x[h][i], f);
#pragma unroll
                for (int jj = 0; jj < 8; ++jj) { s += f[jj]; ss += f[jj] * f[jj]; } }
        s += __shfl_xor(s, 1); s += __shfl_xor(s, 2); ss += __shfl_xor(ss, 1); ss += __shfl_xor(ss, 2);
        const float mean = s * (1.0f / 512.0f), var = ss * (1.0f / 512.0f) - mean * mean, rstd = rsqrtf(var + EPS);
#pragma unroll
        for (int h2 = 0; h2 < 2; ++h2)
#pragma unroll
            for (int i = 0; i < 4; ++i) { const int d = 32 * q4 + 8 * i;
                const u32x4 xv = hp ? x[2 + h2][i] : x[h2][i];
                float f[8]; unpack8(xv, f);
#pragma unroll
                for (int jj = 0; jj < 8; ++jj) VnT[(h2 * 128 + d + jj) * 136 + 16 * wv + tl] = (bf16_t)(pg8::cvt_pk_bf16((f[jj] - mean) * rstd, 0.f) & 0xffffu); }
    }
    LDS_WAIT();
    __syncthreads();
    f32x16 accA, accB;
    sgu_mfma(op0, VnT, 0, r, hh, db, tbA, tbB, accA, accB);
    SguOps op1;
    sgu_load_ops(op1, F, l, 2 * hp + 1, R0, r, hh, db, tbA, tbB);
    sgu_epi(op0, F, l, 2 * hp, R0, r, hh, db, tbA, tbB, accA, accB);
    sgu_mfma(op1, VnT, 1, r, hh, db, tbA, tbB, accA, accB);
    sgu_epi(op1, F, l, 2 * hp + 1, R0, r, hh, db, tbA, tbB, accA, accB);
    __syncthreads();
}

__device__ __forceinline__ void samp_attn(int l, int bd, int kvh, LAS unsigned char* wl) {
    LOCAL_FRAME;
    LAS float* ps = (LAS float*)wl;
    LAS float* invs = ps + 144 * 16;
    const int lane = F.lane, fr = lane & 15, fq = lane >> 4, gq = fr >> 2, tt = fr & 3;
    float* oKs = F.out + O_KS + (size_t)l * LS_KS; float* oVs = F.out + O_VS + (size_t)l * LS_KS;
    bf16x8 qfr[2];
    {
        const bf16_t* qsrc = F.Qc + ((size_t)MP + 4 * bd + tt) * 1024 + (4 * kvh + gq) * 64 + 16 * fq;
        const u32x4 qa = *(const u32x4*)qsrc, qb = *(const u32x4*)(qsrc + 8);
        u32x4 lo, hi;
        lo.x = (qa.x & 0xffffu) | (qa.y << 16); lo.y = (qa.z & 0xffffu) | (qa.w << 16); lo.z = (qb.x & 0xffffu) | (qb.y << 16); lo.w = (qb.z & 0xffffu) | (qb.w << 16);
        hi.x = (qa.x >> 16) | (qa.y & 0xffff0000u); hi.y = (qa.z >> 16) | (qa.w & 0xffff0000u); hi.z = (qb.x >> 16) | (qb.y & 0xffff0000u); hi.w = (qb.z >> 16) | (qb.w & 0xffff0000u);
        qfr[0] = __builtin_bit_cast(bf16x8, lo); qfr[1] = __builtin_bit_cast(bf16x8, hi);
    }
    const float* kc = F.cache_k + (((size_t)l * 128 + bd) * 128) * 256 + kvh * 64 + 8 * fq;
    const float* kn = oKs + (((size_t)bd * 128 + 124 + (fr & 3)) * 4 + kvh) * 64 + 8 * fq;
    float* kd = oKs + ((size_t)bd * 128 * 4 + kvh) * 64 + 8 * fq;
    f32x4 S[9];
#pragma unroll
    for (int T = 0; T < 9; ++T) S[T] = (f32x4){0.f, 0.f, 0.f, 0.f};
#pragma unroll
    for (int T0 = 0; T0 < 9; T0 += 3) {
        f32x4 x[3][2][2];
#pragma unroll
        for (int u = 0; u < 3; ++u) { const int T = T0 + u; const float* src = (T < 8) ? kc + (size_t)(16 * T + fr) * 256 : kn;
#pragma unroll
            for (int ks = 0; ks < 2; ++ks) { x[u][ks][0] = *(const f32x4*)(src + 32 * ks); x[u][ks][1] = *(const f32x4*)(src + 32 * ks + 4); } }
#pragma unroll
        for (int u = 0; u < 3; ++u) { const int T = T0 + u; const int key = 16 * T + fr;
            if (T < 8 && key >= 4) {
#pragma unroll
                for (int ks = 0; ks < 2; ++ks) { float* dst = kd + (size_t)(key - 4) * 256 + 32 * ks; *(f32x4*)dst = x[u][ks][0]; *(f32x4*)(dst + 4) = x[u][ks][1]; } } }
#pragma unroll
        for (int u = 0; u < 3; ++u)
#pragma unroll
            for (int ks = 0; ks < 2; ++ks) { u32x4 w; w.x = pg8::cvt_pk_bf16(x[u][ks][0][0], x[u][ks][0][1]); w.y = pg8::cvt_pk_bf16(x[u][ks][0][2], x[u][ks][0][3]);
                w.z = pg8::cvt_pk_bf16(x[u][ks][1][0], x[u][ks][1][1]); w.w = pg8::cvt_pk_bf16(x[u][ks][1][2], x[u][ks][1][3]);
                S[T0 + u] = __builtin_amdgcn_mfma_f32_16x16x32_bf16(__builtin_bit_cast(bf16x8, w), qfr[ks], S[T0 + u], 0, 0, 0); }
        __builtin_amdgcn_sched_barrier(0);
    }
    const float sink2 = F.sinks[l * 16 + 4 * kvh + gq] * LOG2E;
    float m = sink2;
#pragma unroll
    for (int T = 0; T < 9; ++T)
#pragma unroll
        for (int rg = 0; rg < 4; ++rg) { const int key = 16 * T + 4 * fq + rg; const bool ok = (T < 8) ? (key >= tt + 1) : (fq == 0 && rg <= tt);
            S[T][rg] = ok ? S[T][rg] : -INFINITY; m = fmaxf(m, S[T][rg]); }
    m = fmaxf(m, __shfl_xor(m, 16)); m = fmaxf(m, __shfl_xor(m, 32));
    float sum = 0.f;
#pragma unroll
    for (int T = 0; T < 9; ++T)
#pragma unroll
        for (int rg = 0; rg < 4; ++rg) { const float p = __builtin_amdgcn_exp2f(S[T][rg] - m); sum += p; ps[(16 * T + 4 * fq + rg) * 16 + fr] = p; }
    sum += __shfl_xor(sum, 16); sum += __shfl_xor(sum, 32);
    if (fq == 0) invs[fr] = 1.0f / (sum + __builtin_amdgcn_exp2f(sink2 - m));
    LDS_WAIT();
    const int kq = lane >> 4, dq = lane & 15;
    const float* vcp = F.cache_v + (((size_t)l * 128 + bd) * 128 + kq) * 256 + kvh * 64 + 4 * dq;
    float* vop = oVs + ((size_t)bd * 128 + kq) * 256 + kvh * 64 + 4 * dq;
#pragma unroll 1
    for (int pass = 0; pass < 2; ++pass) {
        float o[8][4];
#pragma unroll
        for (int q = 0; q < 8; ++q) { o[q][0] = 0.f; o[q][1] = 0.f; o[q][2] = 0.f; o[q][3] = 0.f; }
#pragma unroll 1
        for (int blk = 0; blk < 3; ++blk) {
            f32x4 vx[11];
#pragma unroll
            for (int ii = 0; ii < 11; ++ii) { const int i = blk * 11 + ii; const float* src = (i < 32) ? vcp + (size_t)i * 1024 : vop + (size_t)31 * 1024; vx[ii] = *(const f32x4*)src; }
            if (pass == 0) {
#pragma unroll
                for (int ii = 0; ii < 11; ++ii) { const int i = blk * 11 + ii; if (i >= 1 && i < 32) *(f32x4*)(vop + (size_t)(i - 1) * 1024) = vx[ii]; } }
#pragma unroll
            for (int ii = 0; ii < 11; ++ii) { const int key = 4 * (blk * 11 + ii) + kq;
                const f32x4 pa = *(const LAS f32x4*)(ps + key * 16 + 8 * pass), pb = *(const LAS f32x4*)(ps + key * 16 + 8 * pass + 4);
#pragma unroll
                for (int e = 0; e < 4; ++e) { o[0][e] += pa[0] * vx[ii][e]; o[1][e] += pa[1] * vx[ii][e]; o[2][e] += pa[2] * vx[ii][e]; o[3][e] += pa[3] * vx[ii][e];
                    o[4][e] += pb[0] * vx[ii][e]; o[5][e] += pb[1] * vx[ii][e]; o[6][e] += pb[2] * vx[ii][e]; o[7][e] += pb[3] * vx[ii][e]; }
                __builtin_amdgcn_sched_barrier(0); }
        }
#pragma unroll
        for (int q = 0; q < 8; ++q)
#pragma unroll
            for (int e = 0; e < 4; ++e) { float v = o[q][e]; v += __shfl_xor(v, 16); v += __shfl_xor(v, 32); o[q][e] = v; }
#pragma unroll
        for (int q = 0; q < 8; ++q) if ((q >> 1) == kq) { const int qq = 8 * pass + q, t2 = qq & 3, head = 4 * kvh + (qq >> 2); const size_t row = (size_t)MP + 4 * bd + t2;
            float gf[4]; unpack4(*(const u32x2*)(F.Z2 + row * ZW + Z_GA + head * 64 + 4 * dq), gf);
            const float iq = invs[qq];
            u32x2 wv; wv.x = pg8::cvt_pk_bf16(o[q][0] * iq * gf[0], o[q][1] * iq * gf[1]); wv.y = pg8::cvt_pk_bf16(o[q][2] * iq * gf[2], o[q][3] * iq * gf[3]);
            *(u32x2*)(F.MIX + row * DM + head * 64 + 4 * dq) = wv; }
    }
    LDS_WAIT();
}
__device__ __forceinline__ void samp_sgu(int l, int bd) {
    LOCAL_FRAME;
    const int lane = F.lane, c0 = 8 * lane, hd = lane >> 4;
    {
        float* oPs = F.out + O_PS + (size_t)l * LS_PS + (size_t)bd * 15 * 512; const float* sp = F.state_pool + (size_t)l * LS_PS + (size_t)bd * 15 * 512 + 4 * 512;
        f32x4 cp[22];
#pragma unroll
        for (int k = 0; k < 22; ++k) cp[k] = *(const f32x4*)(sp + 4 * (lane + 64 * k));
#pragma unroll
        for (int k = 0; k < 22; ++k) *(f32x4*)(oPs + 4 * (lane + 64 * k)) = cp[k];
    }
    float* oCV = F.out + O_CV + (size_t)l * LS_CV;
    float gl[8], bl[8];
#pragma unroll
    for (int j = 0; j < 8; ++j) { gl[j] = F.ln_g[l * 512 + c0 + j]; bl[j] = F.ln_b[l * 512 + c0 + j]; }
    u32x4 xr[4], ur[4], gr[4];
#pragma unroll
    for (int tt = 0; tt < 4; ++tt) { const size_t row = (size_t)MP + 4 * bd + tt; xr[tt] = *(const u32x4*)(F.Z2 + row * ZW + Z_VS + c0); ur[tt] = *(const u32x4*)(F.Z2 + row * ZW + Z_U + c0); gr[tt] = *(const u32x4*)(F.Z2 + row * ZW + Z_GS + c0); }
    float vn[4][8];
#pragma unroll
    for (int tt = 0; tt < 4; ++tt) { float f[8]; unpack8(xr[tt], f);
        float s = 0.f, ss = 0.f;
#pragma unroll
        for (int j = 0; j < 8; ++j) { s += f[j]; ss += f[j] * f[j]; }
        s = wave_sum(s); ss = wave_sum(ss);
        const float mean = s * (1.0f / 512.0f), var = ss * (1.0f / 512.0f) - mean * mean, rstd = rsqrtf(var + EPS);
#pragma unroll
        for (int j = 0; j < 8; ++j) vn[tt][j] = (f[j] - mean) * rstd * gl[j] + bl[j];
        float* o = oCV + ((size_t)bd * 4 + tt) * 512 + c0;
        *(f32x4*)o = (f32x4){vn[tt][0], vn[tt][1], vn[tt][2], vn[tt][3]}; *(f32x4*)(o + 4) = (f32x4){vn[tt][4], vn[tt][5], vn[tt][6], vn[tt][7]}; }
#pragma unroll
    for (int tt = 0; tt < 4; ++tt) { const size_t row = (size_t)MP + 4 * bd + tt;
        float mx[8]; const float bias = F.sgu_b[l * 512 + hd * 128 + tt];
#pragma unroll
        for (int j = 0; j < 8; ++j) mx[j] = bias;
#pragma unroll
        for (int s2 = 0; s2 < 4; ++s2) if (s2 <= tt) { const float w = F.sgu_w[((size_t)(l * 4 + hd) * 128 + tt) * 128 + s2];
#pragma unroll
            for (int j = 0; j < 8; ++j) mx[j] += w * vn[s2][j]; }
        float uf[8], gf[8]; unpack8(ur[tt], uf); unpack8(gr[tt], gf);
#pragma unroll
        for (int j = 0; j < 8; ++j) mx[j] = mx[j] * uf[j] * gf[j];
        *(u32x4*)(F.MIX + row * DM + 1536 + c0) = pack8(mx); }
}

#ifdef HYBRID
__device__ __forceinline__ void attn_task_o(const Frame& F, int l, int b, int nb, int head, int qs, LAS unsigned char* wl) {
    const int lane = F.lane, r = lane & 31, hh = lane >> 5, kvh = head >> 2;
    LAS float* wsf = (LAS float*)wl; LAS bf16_t* stg = (LAS bf16_t*)(wl + 256);
    const int t0 = 128 * nb + 32 * qs;
    const size_t qrow0 = (size_t)b * 2048 + t0;
    const bf16_t* qp = F.Qc + (qrow0 + r) * 1024 + head * 64 + 8 * hh;
    bf16x8 qf[4];
#pragma unroll
    for (int s = 0; s < 4; ++s) qf[s] = *(const bf16x8*)(qp + 16 * s);
    const bf16_t* kbase = F.Kc + (size_t)(b * 4 + kvh) * 2048 * 64;
    const bf16_t* vbase = F.VTP + (size_t)(b * 4 + kvh) * 64 * 2048;
    const int cmin = (nb > 0) ? 0 : (4 - qs);
    f32x16 S[5];
#pragma unroll
    for (int c = 0; c < 5; ++c) {
        f32x16 a;
#pragma unroll
        for (int i = 0; i < 16; ++i) a[i] = 0.f;
        if (c >= cmin) {
            const bf16_t* kp = kbase + (size_t)(t0 - 128 + 32 * c + r) * 64 + 8 * hh;
#pragma unroll
            for (int s = 0; s < 4; ++s) a = __builtin_amdgcn_mfma_f32_32x32x16_bf16(*(const bf16x8*)(kp + 16 * s), qf[s], a, 0, 0, 0);
        }
        S[c] = a;
    }
    const float NEG = -INFINITY;
#pragma unroll
    for (int i = 0; i < 16; ++i) { const int kap = crow(i, hh); if (kap <= r) S[0][i] = NEG; if (kap > r) S[4][i] = NEG; }
    const float sink2 = F.sinks[l * 16 + head] * LOG2E;
    float m = sink2;
#pragma unroll
    for (int c = 0; c < 5; ++c) if (c >= cmin) {
#pragma unroll
        for (int i = 0; i < 16; ++i) m = fmaxf(m, S[c][i]); }
    m = fmaxf(m, __shfl_xor(m, 32));
    float sum = 0.f;
#pragma unroll
    for (int c = 0; c < 5; ++c) if (c >= cmin) {
#pragma unroll
        for (int i = 0; i < 16; ++i) { const float p = __builtin_amdgcn_exp2f(S[c][i] - m); S[c][i] = p; sum += p; } }
    sum += __shfl_xor(sum, 32);
    const float inv = 1.0f / (sum + __builtin_amdgcn_exp2f(sink2 - m));
    f32x16 o[2];
#pragma unroll
    for (int i = 0; i < 16; ++i) { o[0][i] = 0.f; o[1][i] = 0.f; }
#pragma unroll
    for (int c = 0; c < 5; ++c) if (c >= cmin) {
        const bf16_t* vt = vbase + (size_t)((t0 - 128 + 32 * c) >> 5) * 2048 + r * 32 + 16 * hh;
#pragma unroll
        for (int s = 0; s < 2; ++s) {
            u32x4 pw; pw.x = pg8::cvt_pk_bf16(S[c][8 * s + 0], S[c][8 * s + 1]); pw.y = pg8::cvt_pk_bf16(S[c][8 * s + 2], S[c][8 * s + 3]);
            pw.z = pg8::cvt_pk_bf16(S[c][8 * s + 4], S[c][8 * s + 5]); pw.w = pg8::cvt_pk_bf16(S[c][8 * s + 6], S[c][8 * s + 7]);
            const bf16x8 pa = __builtin_bit_cast(bf16x8, pw);
#pragma unroll
            for (int db = 0; db < 2; ++db) o[db] = __builtin_amdgcn_mfma_f32_32x32x16_bf16(pa, *(const bf16x8*)(vt + db * 1024 + 8 * s), o[db], 0, 0, 0);
        }
    }
    if (hh == 0) wsf[r] = inv;
    LDS_WAIT();
#pragma unroll
    for (int i = 0; i < 16; ++i) { const int q = crow(i, hh); const float rl = wsf[q];
        stg[q * 64 + r] = (bf16_t)(pg8::cvt_pk_bf16(o[0][i] * rl, 0.f) & 0xffffu);
        stg[q * 64 + 32 + r] = (bf16_t)(pg8::cvt_pk_bf16(o[1][i] * rl, 0.f) & 0xffffu); }
    LDS_WAIT();
#pragma unroll
    for (int i = 0; i < 4; ++i) { const int row = i * 8 + (lane >> 3), ch = lane & 7;
        const u32x4 ov = *(const LAS u32x4*)(stg + row * 64 + ch * 8);
        const u32x4 gv = *(const u32x4*)(F.Z2 + (qrow0 + row) * ZW + Z_GA + head * 64 + ch * 8);
        float of[8], gf[8]; unpack8(ov, of); unpack8(gv, gf);
#pragma unroll
        for (int j = 0; j < 8; ++j) of[j] *= gf[j];
        *(u32x4*)(F.MIX + (qrow0 + row) * DM + head * 64 + ch * 8) = pack8(of); }
    LDS_WAIT();
}

template <bool SAMPLE>
__device__ __forceinline__ void pool_unit_o(const Frame& F, int l, int g, int tile) {
    const int lane = F.lane, r = lane & 31, hh = lane >> 5, w = 2 << g;
    const size_t row = (size_t)(SAMPLE ? MP : 0) + 32 * tile + r;
    const int t = SAMPLE ? (int)(row & 3) : (int)(row & 2047);
    const int bd = SAMPLE ? (int)((row - MP) >> 2) : 0;
    const float icnt = SAMPLE ? 1.0f / (float)w : 1.0f / (float)(w < t + 1 ? w : t + 1);
    bf16x8 bfr[8];
#pragma unroll
    for (int s = 0; s < 8; ++s) {
        const int c0 = 128 * g + 16 * s + 8 * hh;
        float sum[8], cur[8];
#pragma unroll
        for (int j = 0; j < 8; ++j) { sum[j] = 0.f; cur[j] = 0.f; }
        for (int i = 0; i < w; ++i) {
            float f[8];
            const int e = t - i;
            if (e >= 0) { unpack8(*(const u32x4*)(F.Z2 + (row - i) * ZW + Z_XB + c0), f); }
            else if (SAMPLE) { const float* sp = F.state_pool + (((size_t)l * 128 + bd) * 15 + 15 + e) * 512 + c0;
                const f32x4 a = *(const f32x4*)sp, bq = *(const f32x4*)(sp + 4); f[0] = a[0]; f[1] = a[1]; f[2] = a[2]; f[3] = a[3]; f[4] = bq[0]; f[5] = bq[1]; f[6] = bq[2]; f[7] = bq[3]; }
            else {
#pragma unroll
                for (int j = 0; j < 8; ++j) f[j] = 0.f; }
#pragma unroll
            for (int j = 0; j < 8; ++j) sum[j] += f[j];
            if (i == 0) {
#pragma unroll
                for (int j = 0; j < 8; ++j) cur[j] = f[j]; }
        }
        float pf[8];
#pragma unroll
        for (int j = 0; j < 8; ++j) pf[j] = sum[j] * icnt - cur[j];
        bfr[s] = __builtin_bit_cast(bf16x8, pack8(pf));
    }
    f32x16 acc[4];
#pragma unroll
    for (int db = 0; db < 4; ++db) {
#pragma unroll
        for (int i = 0; i < 16; ++i) acc[db][i] = 0.f;
        const bf16_t* ap = F.PWT + ((size_t)(l * 4 + g) * 128 + 32 * db + r) * 128 + 8 * hh;
#pragma unroll
        for (int s = 0; s < 8; ++s) acc[db] = __builtin_amdgcn_mfma_f32_32x32x16_bf16(*(const bf16x8*)(ap + 16 * s), bfr[s], acc[db], 0, 0, 0);
    }
#pragma unroll
    for (int db = 0; db < 4; ++db)
#pragma unroll
        for (int q = 0; q < 4; ++q) {
            const int col = 128 * g + 32 * db + 8 * q + 4 * hh;
            const f32x4 sc = *(const f32x4*)(F.pool_scale + l * 512 + col);
            float gf[4]; unpack4(*(const u32x2*)(F.Z2 + row * ZW + Z_GP + col), gf);
            u32x2 wv; wv.x = pg8::cvt_pk_bf16(acc[db][4 * q + 0] * sc[0] * gf[0], acc[db][4 * q + 1] * sc[1] * gf[1]);
            wv.y = pg8::cvt_pk_bf16(acc[db][4 * q + 2] * sc[2] * gf[2], acc[db][4 * q + 3] * sc[3] * gf[3]);
            *(u32x2*)(F.MIX + row * DM + 1024 + col) = wv;
        }
}

__device__ __forceinline__ void sgu_unit_o(const Frame& F, int l, int ci, int hd, LAS unsigned char* ring) {
    LAS bf16_t* VnT = (LAS bf16_t*)ring;
    const int lane = F.lane, wv = F.wave;
    const size_t R0 = (size_t)128 * ci;
    {
        const int tl = lane >> 2, q4 = lane & 3;
        const bf16_t* vrow = F.Z2 + (R0 + 16 * wv + tl) * ZW + Z_VS;
        float s = 0.f, ss = 0.f;
#pragma unroll
        for (int i = 0; i < 16; ++i) { float f[8]; unpack8(*(const u32x4*)(vrow + 128 * q4 + 8 * i), f);
#pragma unroll
            for (int j = 0; j < 8; ++j) { s += f[j]; ss += f[j] * f[j]; } }
        s += __shfl_xor(s, 1); s += __shfl_xor(s, 2); ss += __shfl_xor(ss, 1); ss += __shfl_xor(ss, 2);
        const float mean = s * (1.0f / 512.0f), var = ss * (1.0f / 512.0f) - mean * mean, rstd = rsqrtf(var + EPS);
#pragma unroll
        for (int i = 0; i < 4; ++i) { const int d = 32 * q4 + 8 * i; float f[8]; unpack8(*(const u32x4*)(vrow + 128 * hd + d), f);
            const float* gp = F.ln_g + l * 512 + 128 * hd + d; const float* bp = F.ln_b + l * 512 + 128 * hd + d;
#pragma unroll
            for (int j = 0; j < 8; ++j) { const float vn = (f[j] - mean) * rstd * gp[j] + bp[j];
                VnT[(d + j) * 136 + 16 * wv + tl] = (bf16_t)(pg8::cvt_pk_bf16(vn, 0.f) & 0xffffu); } }
    }
    __syncthreads();
    {
        const int r = lane & 31, hh = lane >> 5, db = wv & 3; const int tbA = (wv >> 2) ? 1 : 0, tbB = (wv >> 2) ? 2 : 3;
        f32x16 accA, accB;
#pragma unroll
        for (int i = 0; i < 16; ++i) { accA[i] = 0.f; accB[i] = 0.f; }
        const bf16_t* Wb = F.SGUW + (size_t)(l * 4 + hd) * 128 * 128;
#pragma unroll
        for (int s = 0; s < 8; ++s) {
            if (s < 2 * (tbB + 1)) {
                const bf16x8 a = *(const LAS bf16x8*)(VnT + (32 * db + r) * 136 + 16 * s + 8 * hh);
                accB = __builtin_amdgcn_mfma_f32_32x32x16_bf16(a, *(const bf16x8*)(Wb + (32 * tbB + r) * 128 + 16 * s + 8 * hh), accB, 0, 0, 0);
                if (s < 2 * (tbA + 1)) accA = __builtin_amdgcn_mfma_f32_32x32x16_bf16(a, *(const bf16x8*)(Wb + (32 * tbA + r) * 128 + 16 * s + 8 * hh), accA, 0, 0, 0);
            }
        }
#pragma unroll
        for (int pass = 0; pass < 2; ++pass) {
            const int tb = pass ? tbB : tbA; const f32x16 acc = pass ? accB : accA;
            const int t = 32 * tb + r; const size_t row = R0 + t; const float bias = F.sgu_b[l * 512 + hd * 128 + t];
#pragma unroll
            for (int q = 0; q < 4; ++q) { const int col = 128 * hd + 32 * db + 8 * q + 4 * hh;
                float uf[4], gf[4]; unpack4(*(const u32x2*)(F.Z2 + row * ZW + Z_U + col), uf); unpack4(*(const u32x2*)(F.Z2 + row * ZW + Z_GS + col), gf);
                u32x2 wo; wo.x = pg8::cvt_pk_bf16((acc[4 * q + 0] + bias) * uf[0] * gf[0], (acc[4 * q + 1] + bias) * uf[1] * gf[1]);
                wo.y = pg8::cvt_pk_bf16((acc[4 * q + 2] + bias) * uf[2] * gf[2], (acc[4 * q + 3] + bias) * uf[3] * gf[3]);
                *(u32x2*)(F.MIX + row * DM + 1536 + col) = wo; }
        }
    }
    __syncthreads();
}

__device__ __forceinline__ void samp_attn_o(const Frame& F, int l, int bd, int kvh, LAS unsigned char* wl) {
    LAS float* qs = (LAS float*)wl;
    LAS float* ps = (LAS float*)(wl + 4096);
    const int lane = F.lane;
    float* oKs = F.out + O_KS + (size_t)l * LS_KS; float* oVs = F.out + O_VS + (size_t)l * LS_KS;
    {
        const int qi = lane >> 2, part = lane & 3, gq = qi >> 2, tt = qi & 3;
        const bf16_t* src = F.Qc + ((size_t)MP + 4 * bd + tt) * 1024 + (4 * kvh + gq) * 64 + 16 * part;
        float f0[8], f1[8]; unpack8(*(const u32x4*)src, f0); unpack8(*(const u32x4*)(src + 8), f1);
#pragma unroll
        for (int j = 0; j < 8; ++j) { const int p0 = 16 * part + j, p1 = p0 + 8;
            qs[qi * 64 + (p0 >> 1) + 32 * (p0 & 1)] = f0[j]; qs[qi * 64 + (p1 >> 1) + 32 * (p1 & 1)] = f1[j]; }
    }
    LDS_WAIT();
    float s0[16], s1[16], s2[16];
#pragma unroll
    for (int q = 0; q < 16; ++q) { s0[q] = 0.f; s1[q] = 0.f; s2[q] = 0.f; }
    const float* k0p = F.cache_k + (((size_t)l * 128 + bd) * 128 + lane) * 256 + kvh * 64;
    const float* k1p = k0p + 64 * 256;
    const float* k2p = oKs + (((size_t)bd * 128 + 124 + (lane & 3)) * 4 + kvh) * 64;
    float* c0p = oKs + (((size_t)bd * 128 + (lane >= 4 ? lane - 4 : 0)) * 4 + kvh) * 64;
    float* c1p = oKs + (((size_t)bd * 128 + lane + 60) * 4 + kvh) * 64;
    for (int ch = 0; ch < 16; ++ch) {
        const f32x4 kx0 = *(const f32x4*)(k0p + 4 * ch), kx1 = *(const f32x4*)(k1p + 4 * ch), kx2 = *(const f32x4*)(k2p + 4 * ch);
        if (lane >= 4) *(f32x4*)(c0p + 4 * ch) = kx0;
        *(f32x4*)(c1p + 4 * ch) = kx1;
#pragma unroll
        for (int q = 0; q < 16; ++q) { const f32x4 qv = *(const LAS f32x4*)(qs + q * 64 + 4 * ch);
            s0[q] += (qv[0] * kx0[0] + qv[1] * kx0[1]) + (qv[2] * kx0[2] + qv[3] * kx0[3]);
            s1[q] += (qv[0] * kx1[0] + qv[1] * kx1[1]) + (qv[2] * kx1[2] + qv[3] * kx1[3]);
            s2[q] += (qv[0] * kx2[0] + qv[1] * kx2[1]) + (qv[2] * kx2[2] + qv[3] * kx2[3]); }
    }
    float inv[16];
#pragma unroll
    for (int q = 0; q < 16; ++q) {
        const int tt = q & 3; const float sink2 = F.sinks[l * 16 + 4 * kvh + (q >> 2)] * LOG2E;
        const bool v0 = lane >= tt + 1, v2 = (lane < 4) && (lane <= tt);
        float m = s1[q]; if (v0) m = fmaxf(m, s0[q]); if (v2) m = fmaxf(m, s2[q]);
        m = fmaxf(wave_max(m), sink2);
        const float p0 = v0 ? __builtin_amdgcn_exp2f(s0[q] - m) : 0.f, p1 = __builtin_amdgcn_exp2f(s1[q] - m), p2 = v2 ? __builtin_amdgcn_exp2f(s2[q] - m) : 0.f;
        const float sum = wave_sum(p0 + p1 + p2);
        inv[q] = 1.0f / (sum + __builtin_amdgcn_exp2f(sink2 - m));
        ps[lane * 16 + q] = p0; ps[(lane + 64) * 16 + q] = p1; if (lane < 4) ps[(128 + lane) * 16 + q] = p2;
    }
    LDS_WAIT();
    float o[16];
#pragma unroll
    for (int q = 0; q < 16; ++q) o[q] = 0.f;
    const float* vcp = F.cache_v + (((size_t)l * 128 + bd) * 128) * 256 + kvh * 64 + lane;
    float* vop = oVs + ((size_t)bd * 128) * 256 + kvh * 64 + lane;
    for (int key = 0; key < 132; ++key) {
        float v;
        if (key < 128) { v = vcp[(size_t)key * 256]; if (key >= 4) vop[(size_t)(key - 4) * 256] = v; }
        else v = vop[(size_t)(key - 4) * 256];
#pragma unroll
        for (int q4 = 0; q4 < 4; ++q4) { const f32x4 pv = *(const LAS f32x4*)(ps + key * 16 + 4 * q4);
            o[4 * q4 + 0] += pv[0] * v; o[4 * q4 + 1] += pv[1] * v; o[4 * q4 + 2] += pv[2] * v; o[4 * q4 + 3] += pv[3] * v; }
    }
#pragma unroll
    for (int q = 0; q < 16; ++q) { const int tt = q & 3, head = 4 * kvh + (q >> 2); const size_t row = (size_t)MP + 4 * bd + tt;
        const float gv = __uint_as_float(((unsigned)F.Z2[row * ZW + Z_GA + head * 64 + lane]) << 16);
        F.MIX[row * DM + head * 64 + lane] = (bf16_t)(pg8::cvt_pk_bf16(o[q] * inv[q] * gv, 0.f) & 0xffffu); }
    LDS_WAIT();
}
__device__ __forceinline__ void samp_sgu_o(const Frame& F, int l, int bd) {
    const int lane = F.lane, c0 = 8 * lane, hd = lane >> 4;
    float* oCV = F.out + O_CV + (size_t)l * LS_CV;
    float gl[8], bl[8];
#pragma unroll
    for (int j = 0; j < 8; ++j) { gl[j] = F.ln_g[l * 512 + c0 + j]; bl[j] = F.ln_b[l * 512 + c0 + j]; }
    float vn[4][8];
#pragma unroll
    for (int tt = 0; tt < 4; ++tt) { const size_t row = (size_t)MP + 4 * bd + tt; float f[8]; unpack8(*(const u32x4*)(F.Z2 + row * ZW + Z_VS + c0), f);
        float s = 0.f, ss = 0.f;
#pragma unroll
        for (int j = 0; j < 8; ++j) { s += f[j]; ss += f[j] * f[j]; }
        s = wave_sum(s); ss = wave_sum(ss);
        const float mean = s * (1.0f / 512.0f), var = ss * (1.0f / 512.0f) - mean * mean, rstd = rsqrtf(var + EPS);
#pragma unroll
        for (int j = 0; j < 8; ++j) vn[tt][j] = (f[j] - mean) * rstd * gl[j] + bl[j];
        float* o = oCV + ((size_t)bd * 4 + tt) * 512 + c0;
        *(f32x4*)o = (f32x4){vn[tt][0], vn[tt][1], vn[tt][2], vn[tt][3]}; *(f32x4*)(o + 4) = (f32x4){vn[tt][4], vn[tt][5], vn[tt][6], vn[tt][7]}; }
#pragma unroll
    for (int tt = 0; tt < 4; ++tt) { const size_t row = (size_t)MP + 4 * bd + tt;
        float mx[8]; const float bias = F.sgu_b[l * 512 + hd * 128 + tt];
#pragma unroll
        for (int j = 0; j < 8; ++j) mx[j] = bias;
#pragma unroll
        for (int s2 = 0; s2 < 4; ++s2) if (s2 <= tt) { const float w = F.sgu_w[((size_t)(l * 4 + hd) * 128 + tt) * 128 + s2];
#pragma unroll
            for (int j = 0; j < 8; ++j) mx[j] += w * vn[s2][j]; }
        float uf[8], gf[8]; unpack8(*(const u32x4*)(F.Z2 + row * ZW + Z_U + c0), uf); unpack8(*(const u32x4*)(F.Z2 + row * ZW + Z_GS + c0), gf);
#pragma unroll
        for (int j = 0; j < 8; ++j) mx[j] = mx[j] * uf[j] * gf[j];
        *(u32x4*)(F.MIX + row * DM + 1536 + c0) = pack8(mx); }
}

#endif
__device__ __forceinline__ void norm_row(const Frame& F, int l, int row) {
    const int lane = F.lane;
    const bf16_t* yr = F.Yb + (size_t)row * DM + 8 * lane;
    const float* xr = ((l == 0) ? (row < MP ? F.xp + (size_t)row * DM : F.xs + (size_t)(row - MP) * DM) : F.out + (size_t)row * DM) + 8 * lane;
    float* orow = F.out + (size_t)row * DM + 8 * lane;
    const float* pg = F.norm_post + l * DM + 8 * lane; const float* g1 = F.norm_pre + DM + 8 * lane;
    u32x4 yv[4]; f32x4 xv[4][2];
#pragma unroll
    for (int j = 0; j < 4; ++j) { yv[j] = *(const u32x4*)(yr + 512 * j); xv[j][0] = *(const f32x4*)(xr + 512 * j); xv[j][1] = *(const f32x4*)(xr + 512 * j + 4); }
    float y[4][8]; float ss = 0.f;
#pragma unroll
    for (int j = 0; j < 4; ++j) { unpack8(yv[j], y[j]);
#pragma unroll
        for (int e = 0; e < 8; ++e) ss += y[j][e] * y[j][e]; }
    ss = wave_sum(ss);
    const float ry = rsqrtf(ss * (1.0f / 2048.0f) + EPS);
    float s1 = 0.f;
#pragma unroll
    for (int j = 0; j < 4; ++j) { const f32x4 ga = *(const f32x4*)(pg + 512 * j), gb = *(const f32x4*)(pg + 512 * j + 4);
#pragma unroll
        for (int e = 0; e < 4; ++e) { y[j][e] = xv[j][0][e] + y[j][e] * ry * ga[e]; y[j][4 + e] = xv[j][1][e] + y[j][4 + e] * ry * gb[e]; }
        *(f32x4*)(orow + 512 * j) = (f32x4){y[j][0], y[j][1], y[j][2], y[j][3]}; *(f32x4*)(orow + 512 * j + 4) = (f32x4){y[j][4], y[j][5], y[j][6], y[j][7]};
#pragma unroll
        for (int e = 0; e < 8; ++e) s1 += y[j][e] * y[j][e]; }
    if (l == 0) {
        s1 = wave_sum(s1);
        const float r1 = rsqrtf(s1 * (1.0f / 2048.0f) + EPS);
        bf16_t* hrow = F.H + (size_t)row * DM + 8 * lane;
#pragma unroll
        for (int j = 0; j < 4; ++j) { const f32x4 ga = *(const f32x4*)(g1 + 512 * j), gb = *(const f32x4*)(g1 + 512 * j + 4); float o[8];
#pragma unroll
            for (int e = 0; e < 4; ++e) { o[e] = y[j][e] * r1 * ga[e]; o[4 + e] = y[j][4 + e] * r1 * gb[e]; }
            *(u32x4*)(hrow + 512 * j) = pack8(o); }
    }
}
__device__ __forceinline__ void norm_rows4(int l, int row0) { LOCAL_FRAME;
#pragma unroll 1
    for (int k = 0; k < 4; ++k) norm_row(F, l, row0 + k); }

constexpr int Q2_G = 40, Q2_AT = Q2_G + 256, Q2_SG = Q2_AT + 256, Q2_SA = Q2_SG + 64, Q2_SS = Q2_SA + 16, Q2_SP = Q2_SS + 8, Q2_PO = Q2_SP + 256;
__device__ __forceinline__ void slot2(int l, LAS unsigned char* L, LAS unsigned char* ring) {
    int t_ = threadIdx.x; asm volatile("" : "+v"(t_)); const int wave = __builtin_amdgcn_readfirstlane(t_ >> 6);
    unsigned* head = ctl_word(CW_Q + 64 * (2 * l));
    EV_T0();
#pragma unroll 1
    for (;;) {
        const int it = q_pop(head, L);
        if (it >= Q2_PO) { if (l == 0) { EV_MAX(0); EV_MIN(1); } break; }
        if (it < Q2_G) {
            unsigned char* ws = (unsigned char*)kargs()->ws;
            pg8::Gemm g{(const bf16_t*)(ws + WS_H), (const bf16_t*)(ws + WS_WTIN) + (size_t)l * DIN * DM, MT, DIN, DM};
            OneUnit S; S.u.pm = 64 + it / 20; S.u.pn = it % 20;
            pg8::EpiIn E{l};
            pg8::gemm_phase<pg8::EpiIn, OneUnit, false, true>(ring, g, S, E);
            publish(ctl_word(CW_ZS + 64 * (2 * l + it / 20)));
            if (l == 0) { EV_MAX(2); EV_MIN(3); }
        }
        else if (it < Q2_AT) { attn_unit(l, it - Q2_G, ring); if (l == 0) EV_MAX(4); }
        else if (it < Q2_SG) { const int u = it - Q2_AT; sgu_unit(l, u >> 1, u & 1, ring); if (l == 0) EV_MAX(5); }
        else if (it < Q2_SA) { const int i = it - Q2_SG; dep_wait(ctl_word(CW_ZS + 64 * (2 * l + (i >> 5))), 20u); if (l == 0) EV_MIN(6); const int k = 8 * i + wave; samp_attn(l, k >> 2, k & 3, ring + wave * 9472); __syncthreads(); if (l == 0) EV_MAX(7); }
        else if (it < Q2_SS) { const int i = it - Q2_SA; dep_wait(ctl_word(CW_ZS + 64 * (2 * l + (i >> 3))), 20u); samp_sgu(l, 8 * i + wave); }
        else if (it < Q2_SP) { const int i = it - Q2_SS; dep_wait(ctl_word(CW_ZS + 64 * (2 * l + (i >> 2))), 20u); const int k = 8 * i + wave; pool_sample(l, k & 3, k >> 2); }
        else { const int i = 8 * (it - Q2_SP) + wave; pool_prompt(l, i & 3, i >> 2, ring + wave * PL_WBYTES); }
    }
}
constexpr int Q4_G = 16, Q4_P = Q4_G + 512, Q4_S = Q4_P + 16;
__device__ __forceinline__ void slot4(int l, LAS unsigned char* L, LAS unsigned char* ring) {
    int t_ = threadIdx.x; asm volatile("" : "+v"(t_)); const int wave = __builtin_amdgcn_readfirstlane(t_ >> 6);
    unsigned* head = ctl_word(CW_Q + 64 * (2 * l + 1));
#pragma unroll 1
    for (;;) {
        const int it = q_pop(head, L);
        if (it >= Q4_S) break;
        if (it < Q4_G) {
            unsigned char* ws = (unsigned char*)kargs()->ws;
            pg8::Gemm g{(const bf16_t*)(ws + WS_MIX), (const bf16_t*)(ws + WS_WTOUT) + (size_t)l * DM * DM, MT, DM, DM};
            OneUnit S; S.u.pm = 64 + it / 8; S.u.pn = it % 8;
            pg8::EpiOut E{};
            pg8::gemm_phase<pg8::EpiOut, OneUnit, false, true>(ring, g, S, E);
            publish(ctl_word(CW_YS + 64 * (2 * l + it / 8)));
        }
        else if (it < Q4_P) norm_rows4(l, 32 * (it - Q4_G) + 4 * wave);
        else { const int i = it - Q4_P; dep_wait(ctl_word(CW_YS + 64 * (2 * l + (i >> 3))), 8u); norm_rows4(l, MP + 32 * i + 4 * wave); }
    }
}

__global__ void __launch_bounds__(NTHREADS, 2) hymba_fwd(Args a_unused) {
    extern __shared__ __attribute__((aligned(16))) unsigned char lds[];
    LAS unsigned char* L = (LAS unsigned char*)lds;
    if (threadIdx.x < 256) ((LAS unsigned*)L)[threadIdx.x] = 0u;
    __syncthreads();
    XcdBarrier bar = xcd_barrier_post((unsigned*)((unsigned char*)kargs()->ws + WS_CTL) + CW_BAR, (volatile LAS unsigned*)L + 8);
    LAS unsigned char* ring = L + RING_OFF;
    STAMP(0);
#ifndef NO_P0
    { Frame F; make_frame(F, kargs()); p0_prologue(F, ring); }
#endif
    xcd_barrier(bar);
    STAMP(1);
#pragma unroll 1
    for (int l = 0; l < 2; ++l) {
#ifndef NO_P1
        {
            KArgs ka = kargs(); unsigned char* ws = (unsigned char*)ka->ws;
            pg8::Gemm g{(const bf16_t*)(ws + WS_H), (const bf16_t*)(ws + WS_WTIN) + (size_t)l * DIN * DM, MP, DIN, DM}; pg8::StaticOrder S; S.init(MP, DIN, (int)gridDim.x, (int)blockIdx.x);
            pg8::EpiIn E{l};
            pg8::gemm_phase<pg8::EpiIn, pg8::StaticOrder, true, true>(ring, g, S, E);
        }
#endif
        xcd_barrier(bar);
        STAMP(2 + 4 * l);
#ifndef NO_P2
        slot2(l, L, ring);
#endif
        xcd_barrier(bar);
        STAMP(3 + 4 * l);
#ifndef NO_P3
        {
            KArgs ka = kargs(); unsigned char* ws = (unsigned char*)ka->ws;
            pg8::Gemm g{(const bf16_t*)(ws + WS_MIX), (const bf16_t*)(ws + WS_WTOUT) + (size_t)l * DM * DM, MP, DM, DM}; pg8::StaticOrder S; S.init(MP, DM, (int)gridDim.x, (int)blockIdx.x);
            pg8::EpiOut E{};
            pg8::gemm_phase<pg8::EpiOut, pg8::StaticOrder, true, true>(ring, g, S, E);
        }
#endif
        xcd_barrier(bar);
        STAMP(4 + 4 * l);
#ifndef NO_P4
        slot4(l, L, ring);
#endif
        if (l == 0) xcd_barrier(bar);
#if PROBE_SEL
        if (l == 1) __syncthreads();
#endif
        STAMP(5 + 4 * l);
    }
#if PROBE_SEL
    if (blockIdx.x == 0 && threadIdx.x == 0) {
#if PROBE_SEL >= 10
        unsigned ea = __hip_atomic_load(ctl_word(CW_EV + 64 * PEA), __ATOMIC_RELAXED, __HIP_MEMORY_SCOPE_AGENT), eb = __hip_atomic_load(ctl_word(CW_EV + 64 * PEB), __ATOMIC_RELAXED, __HIP_MEMORY_SCOPE_AGENT);
        if (PEA_MIN) ea = 0x40000000u - ea; if (PEB_MIN) eb = 0x40000000u - eb;
        unsigned long long da = (ea + 400) / 800, db = (eb + 400) / 800;
#else
        LAS unsigned long long* ts = (LAS unsigned long long*)(L + 256);
        unsigned long long da = (ts[PA1] - ts[PA0] + 400) / 800, db = (ts[PB1] - ts[PB0] + 400) / 800;
#endif
        if (da > 63) da = 63; if (db > 63) db = 63;
        const unsigned long long extra = (da + 64 * db) * 1600ull, t0 = __builtin_amdgcn_s_memrealtime();
        while (__builtin_amdgcn_s_memrealtime() - t0 < extra) __builtin_amdgcn_s_sleep(32);
    }
#endif
}

extern "C" void kernel_launch(void* const* d_in, const int* in_sizes, int n_in, void* d_out, int out_size, void* d_ws, size_t ws_size, hipStream_t stream) {
    static int grid = 0;
    if (grid == 0) {
        if (n_in != 16 || (size_t)out_size != O_END || ws_size < WS_END) { fprintf(stderr, "kernel_launch: unexpected shapes: n_in %d out %d ws %zu (need %zu)\n", n_in, out_size, ws_size, (size_t)WS_END); grid = -1; return; }
        int dev = 0, cus = 0, per_cu = 0;
        if (hipGetDevice(&dev) != hipSuccess || hipDeviceGetAttribute(&cus, hipDeviceAttributeMultiprocessorCount, dev) != hipSuccess) { fprintf(stderr, "kernel_launch: device query failed\n"); grid = -1; return; }
        if (hipFuncSetAttribute((const void*)hymba_fwd, hipFuncAttributeMaxDynamicSharedMemorySize, LDS_BYTES) != hipSuccess) { fprintf(stderr, "kernel_launch: hipFuncSetAttribute failed\n"); grid = -1; return; }
        if (hipOccupancyMaxActiveBlocksPerMultiprocessor(&per_cu, (const void*)hymba_fwd, NTHREADS, LDS_BYTES) != hipSuccess || per_cu < 1) { fprintf(stderr, "kernel_launch: occupancy query says %d blocks/CU\n", per_cu); (void)hipGetLastError(); grid = -1; return; }
        grid = cus;
    }
    if (grid < 0) return;
    (void)hipMemsetAsync((char*)d_ws + WS_CTL, 0, CTL_ZERO_BYTES, stream);
    Args a{};
    for (int i = 0; i < 16; ++i) a.in[i] = (const float*)d_in[i];
    a.out = (float*)d_out; a.ws = (unsigned char*)d_ws;
    void* params[] = {&a};
    hipError_t e = hipLaunchCooperativeKernel((const void*)hymba_fwd, dim3(grid), dim3(NTHREADS), params, LDS_BYTES, stream);
    if (e != hipSuccess) fprintf(stderr, "kernel_launch: cooperative launch failed: %s (grid %d)\n", hipGetErrorString(e), grid);
}
```

```cpp
#include <hip/hip_runtime.h>
#include <cstdio>
#include <cstdint>
#include <cmath>
namespace pg8 {
#define PG8_LAS __attribute__((address_space(3)))
typedef unsigned short bf16_t;
typedef short bf16x8 __attribute__((ext_vector_type(8)));
typedef float f32x4 __attribute__((ext_vector_type(4)));
typedef unsigned u32x4 __attribute__((ext_vector_type(4)));
constexpr int BM = 256, BK = 64, HALF = 128, HTB = HALF * BK * 2  , STAGE_BYTES = 8 * HTB, NXCD = 8, WGM = 8;

__host__ __device__ __forceinline__ int lds_byte(int r, int c) { const int st = (r >> 4) * 2 + (c >> 5), rr = r & 15, cc = c & 31, ob = rr * 64 + cc * 2; return st * 1024 + (ob ^ (((ob >> 9) & 1) << 5)); }
__host__ __device__ __forceinline__ void stage_rc(int b, int& R, int& C) { const int st = b / 1024, sb = b % 1024, swz = sb ^ (((sb >> 9) & 1) << 5); R = (st >> 1) * 16 + swz / 64; C = (st & 1) * 32 + (swz % 64) / 2; }
__host__ __device__ __forceinline__ int perm32(int rho) { const int n = rho >> 4, i = rho & 15; return 8 * (i >> 2) + 4 * n + (i & 3); }

struct Unit { int pm, pn; };
struct Gemm { const bf16_t* A; const bf16_t* Bt; int M, N, K; };

struct StaticOrder {
    int nM, nN, nwg, G, c;
    __host__ __device__ void init(int M, int N, int G_, int c_) { nM = M / BM; nN = N / BM; nwg = nM * nN; G = G_; c = c_; }
    __host__ __device__ bool next(int i, Unit& u) const {
        const long L = (long)i * G + c; if (L >= nwg) return false;
        int wgid = (int)L; { const int q = nwg / NXCD, r = nwg % NXCD, xcd = wgid % NXCD, off = wgid / NXCD; wgid = (xcd < r ? xcd * (q + 1) : r * (q + 1) + (xcd - r) * q) + off; }
        const int nig = WGM * nN, gid = wgid / nig, fm = gid * WGM, gsz = (nM - fm) < WGM ? (nM - fm) : WGM;
        u.pm = fm + ((wgid % nig) % gsz); u.pn = (wgid % nig) / gsz; return true;
    }
    __device__ __forceinline__ void a_ready(const Unit&) const {}
    __device__ __forceinline__ void done(const Unit&) const {}
};

constexpr int DM = 2048, MP = 16384, MS = 512, MT = MP + MS, DIN = 5120;
constexpr int ZW = 3584;
constexpr int Z_GA = 0, Z_XB = 1024, Z_GP = 1536, Z_U = 2048, Z_VS = 2560, Z_GS = 3072;
constexpr float LOG2E = 1.4426950408889634f, QSCALE = 0.125f * LOG2E, EPS = 1e-6f;

__device__ __forceinline__ unsigned cvt_pk_bf16(float lo, float hi) { unsigned r; asm("v_cvt_pk_bf16_f32 %0, %1, %2" : "=v"(r) : "v"(lo), "v"(hi)); return r; }
__device__ __forceinline__ float silu_f(float x) { return x * __builtin_amdgcn_rcpf(1.0f + __builtin_amdgcn_exp2f(-x * LOG2E)); }
__device__ __forceinline__ int vperm32(int x) { return ((x >> 2) & 1) * 16 + (x >> 3) * 4 + (x & 3); }

struct EpiPtrs { const __attribute__((address_space(1))) float* in[16]; __attribute__((address_space(1))) float* out; __attribute__((address_space(1))) unsigned char* ws; };
constexpr size_t EP_ROPE = (size_t)1 << 20, EP_QC = (size_t)192 << 20, EP_KC = (size_t)225 << 20, EP_VTP = (size_t)233 << 20, EP_Z2 = (size_t)241 << 20, EP_Y = (size_t)357 << 20;
constexpr size_t EO_KP = 34603008, EO_VP = 35127296, EO_PP = 35651584, EO_KS = 35774464, EO_VS = 44163072, EO_PS = 52551680;
struct EpiIn {
    static constexpr bool PERM = true, AFTER_DRAIN = false;
    int l;
    __device__ __forceinline__ void operator()(const f32x4 (&acc)[2][2][4][2], const Unit& u, int wr, int wc, int fr, int fq) const {
        const __attribute__((address_space(4))) EpiPtrs* kp = (const __attribute__((address_space(4))) EpiPtrs*)__builtin_amdgcn_kernarg_segment_ptr(); asm volatile("" : "+s"(kp));
        unsigned char* ws = (unsigned char*)kp->ws; float* outp = (float*)kp->out;
        bf16_t* Qc = (bf16_t*)(ws + EP_QC); bf16_t* Kc = (bf16_t*)(ws + EP_KC); bf16_t* VTP = (bf16_t*)(ws + EP_VTP); bf16_t* Z2 = (bf16_t*)(ws + EP_Z2); const float* rope = (const float*)(ws + EP_ROPE);
        float* oKp = outp + EO_KP + (size_t)l * 262144; float* oVp = outp + EO_VP + (size_t)l * 262144; float* oPp = outp + EO_PP + (size_t)l * 61440;
        float* oKs = outp + EO_KS + (size_t)l * 4194304; float* oVs = outp + EO_VS + (size_t)l * 4194304; float* oPs = outp + EO_PS + (size_t)l * 983040;
        const int pn = u.pn;
        const int row0 = u.pm * 256 + wr * 64 + fr;
        const int cw = wc * 32 + 8 * fq;
        if (pn < 5) {
#pragma unroll
            for (int ai = 0; ai < 2; ++ai)
#pragma unroll
                for (int m = 0; m < 4; ++m) {
                    const int row = row0 + ai * 128 + m * 16;
                    const bool smp = row >= MP;
                    const int tpos = smp ? 2048 + (row & 3) : (row & 2047);
                    const float* rp = rope + tpos * 64;
#pragma unroll
                    for (int bj = 0; bj < 2; ++bj) {
                        const int c = pn * 256 + bj * 128 + cw;
                        const int i0 = (c & 63) >> 1;
                        const f32x4 cs = *(const f32x4*)(rp + i0), sn = *(const f32x4*)(rp + 32 + i0);
                        const f32x4 v0 = acc[ai][bj][m][0], v1 = acc[ai][bj][m][1];
                        f32x4 o1, o2;
                        o1[0] = v0[0] * cs[0] - v0[1] * sn[0]; o2[0] = v0[1] * cs[0] + v0[0] * sn[0];
                        o1[1] = v0[2] * cs[1] - v0[3] * sn[1]; o2[1] = v0[3] * cs[1] + v0[2] * sn[1];
                        o1[2] = v1[0] * cs[2] - v1[1] * sn[2]; o2[2] = v1[1] * cs[2] + v1[0] * sn[2];
                        o1[3] = v1[2] * cs[3] - v1[3] * sn[3]; o2[3] = v1[3] * cs[3] + v1[2] * sn[3];
                        if (pn < 4) {
                            o1 = o1 * QSCALE; o2 = o2 * QSCALE;
                            u32x4 w; w.x = cvt_pk_bf16(o1[0], o2[0]); w.y = cvt_pk_bf16(o1[1], o2[1]); w.z = cvt_pk_bf16(o1[2], o2[2]); w.w = cvt_pk_bf16(o1[3], o2[3]);
                            *(u32x4*)(Qc + (size_t)row * 1024 + c) = w;
                        } else {
                            const int kvh = (c - 1024) >> 6;
                            if (!smp) {
                                const int b = row >> 11, t = row & 2047;
                                u32x4 w; w.x = cvt_pk_bf16(o1[0], o2[0]); w.y = cvt_pk_bf16(o1[1], o2[1]); w.z = cvt_pk_bf16(o1[2], o2[2]); w.w = cvt_pk_bf16(o1[3], o2[3]);
                                *(u32x4*)(Kc + ((size_t)((b * 4 + kvh) * 2048 + t)) * 64 + (c & 63)) = w;
                                if (t >= 1920) { float* o = oKp + ((size_t)((b * 128 + t - 1920) * 4 + kvh)) * 64 + i0; *(f32x4*)o = o1; *(f32x4*)(o + 32) = o2; }
                            } else {
                                const int bd = (row - MP) >> 2, tt = row & 3;
                                float* o = oKs + ((size_t)((bd * 128 + 124 + tt) * 4 + kvh)) * 64 + i0; *(f32x4*)o = o1; *(f32x4*)(o + 32) = o2;
                            }
                        }
                    }
                }
        } else if (pn == 5) {
#pragma unroll
            for (int ai = 0; ai < 2; ++ai)
#pragma unroll
                for (int m = 0; m < 4; ++m) {
                    const int row = row0 + ai * 128 + m * 16;
                    const bool smp = row >= MP;
#pragma unroll
                    for (int bj = 0; bj < 2; ++bj) {
                        const int cv = bj * 128 + cw;
                        const int kvh = cv >> 6, d0 = cv & 63;
                        const f32x4 v0 = acc[ai][bj][m][0], v1 = acc[ai][bj][m][1];
                        if (!smp) {
                            const int b = row >> 11, t = row & 2047;
                            bf16_t* vp = VTP + ((size_t)((b * 4 + kvh) * 64 + (t >> 5))) * 2048 + d0 * 32 + vperm32(t & 31);
                            const unsigned w0 = cvt_pk_bf16(v0[0], v0[1]), w1 = cvt_pk_bf16(v0[2], v0[3]), w2 = cvt_pk_bf16(v1[0], v1[1]), w3 = cvt_pk_bf16(v1[2], v1[3]);
                            vp[0] = (bf16_t)(w0 & 0xffffu); vp[32] = (bf16_t)(w0 >> 16); vp[64] = (bf16_t)(w1 & 0xffffu); vp[96] = (bf16_t)(w1 >> 16);
                            vp[128] = (bf16_t)(w2 & 0xffffu); vp[160] = (bf16_t)(w2 >> 16); vp[192] = (bf16_t)(w3 & 0xffffu); vp[224] = (bf16_t)(w3 >> 16);
                            if (t >= 1920) { float* o = oVp + ((size_t)((b * 128 + t - 1920) * 4 + kvh)) * 64 + d0; *(f32x4*)o = v0; *(f32x4*)(o + 4) = v1; }
                        } else {
                            const int bd = (row - MP) >> 2, tt = row & 3;
                            float* o = oVs + ((size_t)((bd * 128 + 124 + tt) * 4 + kvh)) * 64 + d0; *(f32x4*)o = v0; *(f32x4*)(o + 4) = v1;
                        }
                    }
                }
        } else {
            const bool gate = (pn < 10) || (pn == 12) || (pn == 13) || (pn >= 18);
            const bool isxb = (pn == 10) || (pn == 11);
#pragma unroll
            for (int ai = 0; ai < 2; ++ai)
#pragma unroll
                for (int m = 0; m < 4; ++m) {
                    const int row = row0 + ai * 128 + m * 16;
                    const bool smp = row >= MP;
#pragma unroll
                    for (int bj = 0; bj < 2; ++bj) {
                        const int c = pn * 256 + bj * 128 + cw;
                        f32x4 v0 = acc[ai][bj][m][0], v1 = acc[ai][bj][m][1];
                        if (isxb) {
                            const int cx = c - 2560;
                            if (!smp) { const int t = row & 2047; if (t >= 2033) { const int b = row >> 11; float* o = oPp + ((size_t)(b * 15 + t - 2033)) * 512 + cx; *(f32x4*)o = v0; *(f32x4*)(o + 4) = v1; } }
                            else { const int bd = (row - MP) >> 2, tt = row & 3; float* o = oPs + ((size_t)(bd * 15 + 11 + tt)) * 512 + cx; *(f32x4*)o = v0; *(f32x4*)(o + 4) = v1; }
                        }
                        if (gate) {
#pragma unroll
                            for (int j = 0; j < 4; ++j) { v0[j] = silu_f(v0[j]); v1[j] = silu_f(v1[j]); }
                        }
                        u32x4 w; w.x = cvt_pk_bf16(v0[0], v0[1]); w.y = cvt_pk_bf16(v0[2], v0[3]); w.z = cvt_pk_bf16(v1[0], v1[1]); w.w = cvt_pk_bf16(v1[2], v1[3]);
                        *(u32x4*)(Z2 + (size_t)row * ZW + (c - 1536)) = w;
                    }
                }
        }
    }
};

struct EpiOut {
    static constexpr bool PERM = true, AFTER_DRAIN = false;
    __device__ __forceinline__ void operator()(const f32x4 (&acc)[2][2][4][2], const Unit& u, int wr, int wc, int fr, int fq) const {
        const __attribute__((address_space(4))) EpiPtrs* kp = (const __attribute__((address_space(4))) EpiPtrs*)__builtin_amdgcn_kernarg_segment_ptr(); asm volatile("" : "+s"(kp));
        bf16_t* C = (bf16_t*)((unsigned char*)kp->ws + EP_Y);
        const int row0 = u.pm * BM + wr * 64 + fr, col0 = u.pn * BM + wc * 32 + 8 * fq;
#pragma unroll
        for (int ai = 0; ai < 2; ++ai)
#pragma unroll
            for (int m = 0; m < 4; ++m) { bf16_t* rowp = C + (size_t)(row0 + ai * HALF + m * 16) * DM + col0;
#pragma unroll
                for (int bj = 0; bj < 2; ++bj) { const f32x4 v0 = acc[ai][bj][m][0], v1 = acc[ai][bj][m][1];
                    u32x4 w; w.x = cvt_pk_bf16(v0[0], v0[1]); w.y = cvt_pk_bf16(v0[2], v0[3]); w.z = cvt_pk_bf16(v1[0], v1[1]); w.w = cvt_pk_bf16(v1[2], v1[3]);
                    *(u32x4*)(rowp + bj * HALF) = w; } }
    }
};
template <class Epi, class Sched, bool ALIGN_EPI = false, bool SP2 = false>
__device__ __forceinline__ void gemm_phase(PG8_LAS unsigned char* lds, const Gemm g, const Sched& S, const Epi& E) {
    int tid_ = threadIdx.x; asm volatile("" : "+v"(tid_));
    const int tid = tid_, wid = __builtin_amdgcn_readfirstlane(tid >> 6), lane = tid & 63, wr = wid >> 2, wc = wid & 3, fr = lane & 15, fq = lane >> 4;
    const int K = g.K, nt = K / BK;
    unsigned voffA[2], voffB[2];
#pragma unroll
    for (int i = 0; i < 2; ++i) { int R, C; stage_rc(tid * 16 + i * 8192, R, C); const int Rb = Epi::PERM ? ((R & ~31) + perm32(R & 31)) : R;
        voffA[i] = (unsigned)(R * K + C) * 2u; voffB[i] = (unsigned)(Rb * K + C) * 2u; }
    const size_t kstep = (size_t)(BK * 2);
    const size_t hstep = (size_t)HALF * K * 2;
    const size_t tstep = 2 * hstep;
    const unsigned ldsw = (unsigned)wid * 1024u;
    const int aoff = lds_byte(wr * 64 + fr, fq * 8), boff = lds_byte(wc * 32 + fr, fq * 8);
#define PG8_SA(b, h) (((b) * 2 + (h)) * HTB)
#define PG8_SB(b, h) ((4 + (b) * 2 + (h)) * HTB)
#define PG8_STAGE(bufoff, gbase, voff) do { _Pragma("unroll") for (int _i = 0; _i < 2; ++_i) \
        __builtin_amdgcn_global_load_lds((const unsigned*)((const char*)(gbase) + (voff)[_i]), (PG8_LAS unsigned*)(lds + (bufoff) + ldsw + _i * 8192), 16, 0, 0); } while (0)
#define PG8_LDA(dst, b, h) do { _Pragma("unroll") for (int m = 0; m < 4; ++m) _Pragma("unroll") for (int k = 0; k < 2; ++k) dst[m][k] = *(const PG8_LAS bf16x8*)(lds + PG8_SA(b, h) + aoff + m * 2048 + k * 1024); } while (0)
#define PG8_LDB(dst, b, h) do { _Pragma("unroll") for (int n = 0; n < 2; ++n) _Pragma("unroll") for (int k = 0; k < 2; ++k) dst[n][k] = *(const PG8_LAS bf16x8*)(lds + PG8_SB(b, h) + boff + n * 2048 + k * 1024); } while (0)
#define PG8_MMA(ai, bj, At, Bt) do { __builtin_amdgcn_s_setprio(1); _Pragma("unroll") for (int m = 0; m < 4; ++m) _Pragma("unroll") for (int n = 0; n < 2; ++n) _Pragma("unroll") for (int k = 0; k < 2; ++k) \
        acc[ai][bj][m][n] = __builtin_amdgcn_mfma_f32_16x16x32_bf16(Bt[n][k], At[m][k], acc[ai][bj][m][n], 0, 0, 0); __builtin_amdgcn_s_setprio(0); } while (0)
#define PG8_WAIT_V(n) asm volatile("s_waitcnt vmcnt(" #n ")" ::: "memory")
#define PG8_WAIT_L(n) asm volatile("s_waitcnt lgkmcnt(" #n ")" ::: "memory")
#define PG8_BAR __builtin_amdgcn_s_barrier()
#define PG8_SCHED __builtin_amdgcn_sched_barrier(0)
    Unit cur, nxt; int ui = 0;
    if (!S.next(0, cur)) return;
    f32x4 acc[2][2][4][2];
#pragma unroll
    for (int a = 0; a < 2; ++a)
#pragma unroll
        for (int b = 0; b < 2; ++b)
#pragma unroll
            for (int m = 0; m < 4; ++m)
#pragma unroll
                for (int n = 0; n < 2; ++n) acc[a][b][m][n] = (f32x4){0.f, 0.f, 0.f, 0.f};
    bf16x8 At[4][2], B0[2][2], B1[2][2];
    const char* cA = (const char*)g.A + (size_t)cur.pm * tstep; const char* cB = (const char*)g.Bt + (size_t)cur.pn * tstep;
    S.a_ready(cur);
    if constexpr (SP2) {
        PG8_STAGE(PG8_SB(0, 0), cB, voffB); PG8_STAGE(PG8_SB(0, 1), cB + hstep, voffB); PG8_STAGE(PG8_SA(0, 0), cA, voffA); PG8_STAGE(PG8_SA(0, 1), cA + hstep, voffA);
        if (wr == 1) PG8_BAR;
        PG8_WAIT_V(2); PG8_BAR;
        PG8_STAGE(PG8_SB(1, 0), cB + kstep, voffB); PG8_STAGE(PG8_SA(1, 0), cA + kstep, voffA); PG8_STAGE(PG8_SB(1, 1), cB + hstep + kstep, voffB);
        PG8_WAIT_V(6); PG8_BAR;
    } else {
        PG8_STAGE(PG8_SB(0, 0), cB, voffB); PG8_STAGE(PG8_SA(0, 0), cA, voffA); PG8_STAGE(PG8_SB(0, 1), cB + hstep, voffB); PG8_STAGE(PG8_SA(0, 1), cA + hstep, voffA);
        if (wr == 1) PG8_BAR;
        PG8_WAIT_V(4); PG8_BAR;
        PG8_STAGE(PG8_SB(1, 0), cB + kstep, voffB); PG8_STAGE(PG8_SA(1, 0), cA + kstep, voffA); PG8_STAGE(PG8_SB(1, 1), cB + hstep + kstep, voffB);
        PG8_WAIT_V(6); PG8_BAR;
    }
    for (;;) {
        const bool has_next = S.next(ui + 1, nxt);
        const char* nA = has_next ? (const char*)g.A + (size_t)nxt.pm * tstep : cA; const char* nB = has_next ? (const char*)g.Bt + (size_t)nxt.pn * tstep : cB;
        for (int t = 0; t < nt; t += 2) {
            const bool last = (t == nt - 2);
            const char* a1 = cA + (size_t)(t + 1) * kstep;
            const char* a2 = last ? nA : cA + (size_t)(t + 2) * kstep; const char* b2 = last ? nB : cB + (size_t)(t + 2) * kstep;
            const char* a3 = a2 + kstep; const char* b3 = b2 + kstep;
            if (last && has_next) S.a_ready(nxt);
            if constexpr (SP2) {
            PG8_LDB(B0, 0, 0); PG8_LDB(B1, 0, 1); PG8_SCHED; PG8_LDA(At, 0, 0); PG8_STAGE(PG8_SA(1, 1), a1 + hstep, voffA);
            PG8_WAIT_V(8); PG8_WAIT_L(0); PG8_BAR; PG8_MMA(0, 0, At, B0); PG8_MMA(0, 1, At, B1); PG8_BAR; PG8_SCHED;
            PG8_LDA(At, 0, 1); PG8_STAGE(PG8_SB(0, 0), b2, voffB); PG8_STAGE(PG8_SB(0, 1), b2 + hstep, voffB); PG8_STAGE(PG8_SA(0, 0), a2, voffA);
            PG8_WAIT_V(8); PG8_WAIT_L(0); PG8_BAR; PG8_MMA(1, 0, At, B0); PG8_MMA(1, 1, At, B1); PG8_BAR; PG8_SCHED;
            PG8_LDB(B0, 1, 0); PG8_LDB(B1, 1, 1); PG8_SCHED; PG8_LDA(At, 1, 0); PG8_STAGE(PG8_SA(0, 1), a2 + hstep, voffA);
            PG8_WAIT_V(8); PG8_WAIT_L(0); PG8_BAR; PG8_MMA(0, 0, At, B0); PG8_MMA(0, 1, At, B1); PG8_BAR; PG8_SCHED;
            PG8_LDA(At, 1, 1); PG8_STAGE(PG8_SB(1, 0), b3, voffB); PG8_STAGE(PG8_SB(1, 1), b3 + hstep, voffB); PG8_STAGE(PG8_SA(1, 0), a3, voffA);
            PG8_WAIT_V(8); PG8_WAIT_L(0); PG8_BAR; PG8_MMA(1, 0, At, B0); PG8_MMA(1, 1, At, B1); PG8_BAR; PG8_SCHED;
            } else {
            PG8_LDB(B0, 0, 0); PG8_SCHED; PG8_LDA(At, 0, 0); PG8_STAGE(PG8_SA(1, 1), a1 + hstep, voffA);
            PG8_WAIT_L(8); PG8_BAR; PG8_WAIT_L(0); PG8_MMA(0, 0, At, B0); PG8_BAR; PG8_SCHED;
            PG8_LDB(B1, 0, 1); PG8_STAGE(PG8_SB(0, 0), b2, voffB);
            PG8_BAR; PG8_WAIT_L(0); PG8_MMA(0, 1, At, B1); PG8_BAR;
            PG8_LDA(At, 0, 1); PG8_STAGE(PG8_SA(0, 0), a2, voffA);
            PG8_BAR; PG8_WAIT_L(0); PG8_MMA(1, 0, At, B0); PG8_BAR; PG8_SCHED;
            PG8_STAGE(PG8_SB(0, 1), b2 + hstep, voffB);
            PG8_WAIT_V(6); PG8_BAR; PG8_MMA(1, 1, At, B1); PG8_BAR;
            PG8_LDB(B0, 1, 0); PG8_SCHED; PG8_LDA(At, 1, 0); PG8_STAGE(PG8_SA(0, 1), a2 + hstep, voffA);
            PG8_WAIT_L(8); PG8_BAR; PG8_WAIT_L(0); PG8_MMA(0, 0, At, B0); PG8_BAR; PG8_SCHED;
            PG8_LDB(B1, 1, 1); PG8_STAGE(PG8_SB(1, 0), b3, voffB);
            PG8_BAR; PG8_WAIT_L(0); PG8_MMA(0, 1, At, B1); PG8_BAR;
            PG8_LDA(At, 1, 1); PG8_STAGE(PG8_SA(1, 0), a3, voffA);
            PG8_BAR; PG8_WAIT_L(0); PG8_MMA(1, 0, At, B0); PG8_BAR; PG8_SCHED;
            PG8_STAGE(PG8_SB(1, 1), b3 + hstep, voffB);
            PG8_WAIT_V(6); PG8_BAR; PG8_MMA(1, 1, At, B1); PG8_BAR;
            }
        }
        if constexpr (ALIGN_EPI) { if (wr == 0) PG8_BAR; }
        if constexpr (!Epi::AFTER_DRAIN) { E(acc, cur, wr, wc, fr, fq); S.done(cur); }
        if (!has_next) break;
#pragma unroll
        for (int a = 0; a < 2; ++a)
#pragma unroll
            for (int b = 0; b < 2; ++b)
#pragma unroll
                for (int m = 0; m < 4; ++m)
#pragma unroll
                    for (int n = 0; n < 2; ++n) acc[a][b][m][n] = (f32x4){0.f, 0.f, 0.f, 0.f};
        cur = nxt; cA = nA; cB = nB; ++ui;
        if constexpr (ALIGN_EPI) { if (wr == 1) PG8_BAR; }
    }
    PG8_WAIT_V(0);
    if constexpr (!ALIGN_EPI) { if (wr == 0) PG8_BAR; }
    PG8_BAR;
    if constexpr (Epi::AFTER_DRAIN) { E.fused(acc, cur, wr, wc, fr, fq, lds, wid, lane); S.done(cur); }
#undef PG8_SA
#undef PG8_SB
#undef PG8_STAGE
#undef PG8_LDA
#undef PG8_LDB
#undef PG8_MMA
#undef PG8_WAIT_V
#undef PG8_WAIT_L
#undef PG8_BAR
#undef PG8_SCHED
}
}
#define GAS __attribute__((address_space(1)))
#define LAS __attribute__((address_space(3)))
typedef GAS unsigned gu32;
typedef GAS unsigned long long gu64;
#define RLX_AGENT __ATOMIC_RELAXED, __HIP_MEMORY_SCOPE_AGENT
#define VM_WAIT() asm volatile("s_waitcnt vmcnt(0)" ::: "memory")
__device__ __forceinline__ unsigned long long rt() { return __builtin_amdgcn_s_memrealtime(); }
__device__ __forceinline__ unsigned f2bf(float f) { unsigned u = __builtin_bit_cast(unsigned, f); return (u + 0x7fffu + ((u >> 16) & 1u)) >> 16; }
__device__ __forceinline__ unsigned pk2(float lo, float hi) { return f2bf(lo) | (f2bf(hi) << 16); }

#define XB_TMO      128
#define XB_XCNT(j)  (256  + 64 * (j))
#define XB_XSUB(j)  (1280 + 64 * (j))
#define XB_XGEN(j)  (2304 + 64 * (j))
#define XB_TOP      3328
#define XB_TOPGEN   3392
#define XCD_BAR_WORDS 3456
#define XB_SPIN_CAP (1u << 18)

__device__ __forceinline__ unsigned xb_ld(unsigned* p)              { return __hip_atomic_load(p, __ATOMIC_RELAXED, __HIP_MEMORY_SCOPE_AGENT); }
__device__ __forceinline__ unsigned xb_add(unsigned* p, unsigned v) { return __hip_atomic_fetch_add(p, v, __ATOMIC_RELAXED, __HIP_MEMORY_SCOPE_AGENT); }
__device__ __forceinline__ unsigned xb_xcc_id() { return (unsigned)__builtin_amdgcn_s_getreg((3 << 11) | 20) & 0xFu; }
#define XB_SPIN(cond, bar) do { unsigned _sp = 0; while (cond) { __builtin_amdgcn_s_sleep(1); \
    if ((++_sp & 255u) == 0u) { if (xb_ld(&(bar)[XB_TMO])) break; if (_sp > XB_SPIN_CAP) { atomicAdd(&(bar)[XB_TMO], 1u); break; } } } } while (0)

struct XcdBarrier {
    unsigned* bar; unsigned x;
    volatile LAS unsigned* st;
};

__device__ __forceinline__ XcdBarrier xcd_barrier_post(unsigned* bar, volatile LAS unsigned* st) {
    XcdBarrier b; b.bar = bar; b.x = xb_xcc_id(); b.st = st;
    if (threadIdx.x == 0) (void)xb_add(&bar[XB_XCNT(b.x)], 1u);
    return b;
}
__device__ __forceinline__ void xcd_barrier_complete(unsigned* bar, unsigned x, unsigned& nloc, unsigned& nx) {
    const unsigned G = gridDim.x * gridDim.y * gridDim.z;
    unsigned sum, cnt, mine, sp = 0u;
    for (;;) {
        sum = 0u; cnt = 0u; mine = 0u;
#pragma unroll
        for (unsigned j = 0; j < 16; ++j) { const unsigned c = xb_ld(&bar[XB_XCNT(j)]); sum += c; cnt += (c > 0u) ? 1u : 0u; mine = (j == x) ? c : mine; }
        if (sum == G) break;
        __builtin_amdgcn_s_sleep(1);
        if ((++sp & 255u) == 0u) { if (xb_ld(&bar[XB_TMO])) break; if (sp > XB_SPIN_CAP) { atomicAdd(&bar[XB_TMO], 1u); break; } }
    }
    nloc = mine > 0u ? mine : 1u; nx = cnt > 0u ? cnt : 1u;
}

__device__ __forceinline__ void xcd_barrier(const XcdBarrier& b) {
    asm volatile("s_waitcnt vmcnt(0)" ::: "memory");
    __syncthreads();
    if (threadIdx.x == 0) {
        unsigned* bar = b.bar;
        __builtin_amdgcn_s_waitcnt(0);
        unsigned nloc = b.st[0], nx = b.st[1];
        if (nloc == 0u) { xcd_barrier_complete(bar, b.x, nloc, nx); b.st[0] = nloc; b.st[1] = nx; }
        const unsigned old = xb_add(&bar[XB_XSUB(b.x)], 1u);
        const unsigned gen = old / nloc;
        if (old + 1u == (gen + 1u) * nloc) {
            __builtin_amdgcn_fence(__ATOMIC_RELEASE, "agent");
            asm volatile("s_waitcnt vmcnt(0)" ::: "memory");
            const unsigned og = xb_add(&bar[XB_TOP], 1u);
            const unsigned tg = og / nx;
            if (og + 1u == (tg + 1u) * nx) xb_add(&bar[XB_TOPGEN], 1u);
            else XB_SPIN(xb_ld(&bar[XB_TOPGEN]) == tg, bar);
            __builtin_amdgcn_fence(__ATOMIC_ACQUIRE, "agent");
            xb_add(&bar[XB_XGEN(b.x)], 1u);
            asm volatile("s_waitcnt vmcnt(0)" ::: "memory");
        } else {
            XB_SPIN(xb_ld(&bar[XB_XGEN(b.x)]) == gen, bar);
            __builtin_amdgcn_fence(__ATOMIC_ACQUIRE, "agent");
            asm volatile("s_waitcnt vmcnt(0)" ::: "memory");
        }
    }
    __syncthreads();
}

using pg8::bf16_t; using pg8::bf16x8; using pg8::f32x4; using pg8::u32x4;
using pg8::DM; using pg8::MP; using pg8::MS; using pg8::MT; using pg8::DIN; using pg8::ZW;
using pg8::Z_GA; using pg8::Z_XB; using pg8::Z_GP; using pg8::Z_U; using pg8::Z_VS; using pg8::Z_GS; using pg8::LOG2E; using pg8::EPS;
typedef float f32x16 __attribute__((ext_vector_type(16)));
typedef unsigned u32x2 __attribute__((ext_vector_type(2)));

constexpr int NWAVES = 8, NTHREADS = 512;
constexpr int LDS_BYTES = 147456;
constexpr int RING_OFF = 1024;

constexpr size_t O_YP = 0, O_YS = 33554432, O_KP = 34603008, O_VP = 35127296, O_PP = 35651584, O_KS = 35774464, O_VS = 44163072, O_PS = 52551680, O_CV = 54517760, O_END = 55042048;
constexpr size_t LS_KP = 262144, LS_PP = 61440, LS_KS = 4194304, LS_PS = 983040, LS_CV = 262144;
constexpr size_t MiB = 1u << 20;
constexpr size_t WS_CTL = 0, CTL_ZERO_BYTES = 65536;
constexpr size_t WS_ROPE = 1 * MiB, WS_SGUW = 2 * MiB, WS_RSW = 2 * MiB + 256 * 1024, WS_PWT = 2 * MiB + 512 * 1024;
constexpr size_t WS_WTIN = 4 * MiB, WS_WTOUT = 44 * MiB, WS_H = 60 * MiB, WS_MIX = 126 * MiB, WS_QC = 192 * MiB, WS_KC = 225 * MiB, WS_VTP = 233 * MiB, WS_Z2 = 241 * MiB, WS_Y = 357 * MiB, WS_END = 489 * MiB;
constexpr int CW_BAR = 1024;

__constant__ double ROPE_INV[32] = {1.0, 0.7498942093324559, 0.5623413251903491, 0.4216965034285822, 0.31622776601683794, 0.23713737056616552, 0.1778279410038923, 0.1333521432163324, 0.1, 0.07498942093324558, 0.05623413251903491, 0.042169650342858224, 0.03162277660168379, 0.023713737056616554, 0.01778279410038923, 0.01333521432163324, 0.01, 0.007498942093324558, 0.005623413251903491, 0.004216965034285823, 0.0031622776601683794, 0.0023713737056616554, 0.0017782794100389228, 0.001333521432163324, 0.001, 0.0007498942093324559, 0.0005623413251903491, 0.00042169650342858224, 0.00031622776601683794, 0.00023713737056616554, 0.00017782794100389227, 0.0001333521432163324};

struct Args { const float* in[16]; float* out; unsigned char* ws; };

struct Frame {
    int tid, lane, wave, bid, G;
    const float *xp, *xs, *cache_k, *cache_v, *state_pool, *w_in, *w_out, *norm_pre, *norm_post, *sinks, *pool_w, *pool_scale, *ln_g, *ln_b, *sgu_w, *sgu_b;
    float* out;
    float* rope; float* RSW; bf16_t *SGUW, *PWT, *WTIN, *WTOUT, *H, *MIX, *Qc, *Kc, *VTP, *Z2, *Yb;
};

__device__ __forceinline__ float wave_sum(float v) {
#pragma unroll
    for (int o = 1; o < 64; o <<= 1) v += __shfl_xor(v, o);
    return v;
}
__device__ __forceinline__ float wave_max(float v) {
#pragma unroll
    for (int o = 1; o < 64; o <<= 1) v = fmaxf(v, __shfl_xor(v, o));
    return v;
}
__device__ __forceinline__ float bflo(unsigned w) { return __uint_as_float(w << 16); }
__device__ __forceinline__ float bfhi(unsigned w) { return __uint_as_float(w & 0xffff0000u); }
__device__ __forceinline__ void unpack8(const u32x4 w, float (&f)[8]) { f[0] = bflo(w.x); f[1] = bfhi(w.x); f[2] = bflo(w.y); f[3] = bfhi(w.y); f[4] = bflo(w.z); f[5] = bfhi(w.z); f[6] = bflo(w.w); f[7] = bfhi(w.w); }
__device__ __forceinline__ void unpack4(const u32x2 w, float (&f)[4]) { f[0] = bflo(w.x); f[1] = bfhi(w.x); f[2] = bflo(w.y); f[3] = bfhi(w.y); }
__device__ __forceinline__ u32x4 pack8(const float (&f)[8]) { u32x4 w; w.x = pg8::cvt_pk_bf16(f[0], f[1]); w.y = pg8::cvt_pk_bf16(f[2], f[3]); w.z = pg8::cvt_pk_bf16(f[4], f[5]); w.w = pg8::cvt_pk_bf16(f[6], f[7]); return w; }
__device__ __forceinline__ int crow(int r, int hi) { return (r & 3) + 8 * (r >> 2) + 4 * hi; }
#define LDS_WAIT() asm volatile("s_waitcnt lgkmcnt(0)" ::: "memory")


struct ArgsG { const __attribute__((address_space(1))) float* in[16]; __attribute__((address_space(1))) float* out; __attribute__((address_space(1))) unsigned char* ws; };
typedef const __attribute__((address_space(4))) ArgsG* KArgs;
__device__ __forceinline__ KArgs kargs() { KArgs p = (KArgs)__builtin_amdgcn_kernarg_segment_ptr(); asm volatile("" : "+s"(p)); return p; }
__device__ __forceinline__ void make_frame(Frame& F, KArgs a) {
    { int t_ = threadIdx.x; asm volatile("" : "+v"(t_)); F.tid = t_; } F.lane = F.tid & 63; F.wave = __builtin_amdgcn_readfirstlane(F.tid >> 6); F.bid = blockIdx.x; F.G = gridDim.x;
    F.xp = (const float*)a->in[0]; F.xs = (const float*)a->in[1]; F.cache_k = (const float*)a->in[2]; F.cache_v = (const float*)a->in[3]; F.state_pool = (const float*)a->in[4]; F.w_in = (const float*)a->in[5]; F.w_out = (const float*)a->in[6]; F.norm_pre = (const float*)a->in[7]; F.norm_post = (const float*)a->in[8];
    F.sinks = (const float*)a->in[9]; F.pool_w = (const float*)a->in[10]; F.pool_scale = (const float*)a->in[11]; F.ln_g = (const float*)a->in[12]; F.ln_b = (const float*)a->in[13]; F.sgu_w = (const float*)a->in[14]; F.sgu_b = (const float*)a->in[15];
    F.out = (float*)a->out;
    unsigned char* ws = (unsigned char*)a->ws;
    F.rope = (float*)(ws + WS_ROPE); F.RSW = (float*)(ws + WS_RSW); F.SGUW = (bf16_t*)(ws + WS_SGUW); F.PWT = (bf16_t*)(ws + WS_PWT); F.WTIN = (bf16_t*)(ws + WS_WTIN); F.WTOUT = (bf16_t*)(ws + WS_WTOUT);
    F.H = (bf16_t*)(ws + WS_H); F.MIX = (bf16_t*)(ws + WS_MIX); F.Qc = (bf16_t*)(ws + WS_QC); F.Kc = (bf16_t*)(ws + WS_KC); F.VTP = (bf16_t*)(ws + WS_VTP); F.Z2 = (bf16_t*)(ws + WS_Z2); F.Yb = (bf16_t*)(ws + WS_Y);
}

#define LOCAL_FRAME Frame F; make_frame(F, kargs())

constexpr int CW_Q = 8192;
constexpr int CW_ZS = 8192 + 64 * 8;
constexpr int CW_YS = 8192 + 64 * 16;
constexpr int CW_EV = 8192 + 64 * 32;
__device__ __forceinline__ unsigned* ctl_word(int idx) { return (unsigned*)((unsigned char*)kargs()->ws + WS_CTL) + idx; }
__device__ __forceinline__ int q_pop(unsigned* head, LAS unsigned char* L) {
    volatile LAS int* slot = (volatile LAS int*)(L + 64);
    __syncthreads();
    if (threadIdx.x == 0) *slot = (int)__hip_atomic_fetch_add(head, 1u, __ATOMIC_RELAXED, __HIP_MEMORY_SCOPE_AGENT);
    __syncthreads();
    return __builtin_amdgcn_readfirstlane(*slot);
}
__device__ __forceinline__ void publish(unsigned* ctr) {
    asm volatile("s_waitcnt vmcnt(0)" ::: "memory");
    __syncthreads();
    if (threadIdx.x == 0) { __builtin_amdgcn_fence(__ATOMIC_RELEASE, "agent"); asm volatile("s_waitcnt vmcnt(0)" ::: "memory");
        __hip_atomic_fetch_add(ctr, 1u, __ATOMIC_RELAXED, __HIP_MEMORY_SCOPE_AGENT); }
}
__device__ __forceinline__ void dep_wait(unsigned* ctr, unsigned need) {
    if (threadIdx.x == 0) {
        unsigned sp = 0;
        while (__hip_atomic_load(ctr, __ATOMIC_RELAXED, __HIP_MEMORY_SCOPE_AGENT) < need) { __builtin_amdgcn_s_sleep(16); if (++sp > (1u << 21)) break; }
        __builtin_amdgcn_fence(__ATOMIC_ACQUIRE, "agent"); asm volatile("s_waitcnt vmcnt(0)" ::: "memory");
    }
    __syncthreads();
}

#if PROBE_SEL >= 10
#define EV_T0() const unsigned long long ev_t0 = __builtin_amdgcn_s_memrealtime()
#define EV_MAX(k) do { if (threadIdx.x == 0) __hip_atomic_fetch_max(ctl_word(CW_EV + 64 * (k)), (unsigned)(__builtin_amdgcn_s_memrealtime() - ev_t0), __ATOMIC_RELAXED, __HIP_MEMORY_SCOPE_AGENT); } while (0)
#define EV_MIN(k) do { if (threadIdx.x == 0) __hip_atomic_fetch_max(ctl_word(CW_EV + 64 * (k)), 0x40000000u - (unsigned)(__builtin_amdgcn_s_memrealtime() - ev_t0), __ATOMIC_RELAXED, __HIP_MEMORY_SCOPE_AGENT); } while (0)
#else
#define EV_T0() do {} while (0)
#define EV_MAX(k) do {} while (0)
#define EV_MIN(k) do {} while (0)
#endif
struct OneUnit {
    pg8::Unit u;
    __device__ __forceinline__ bool next(int i, pg8::Unit& o) const { if (i) return false; o = u; return true; }
    __device__ __forceinline__ void a_ready(const pg8::Unit&) const {}
    __device__ __forceinline__ void done(const pg8::Unit&) const {}
};

#ifndef PROBE_SEL
#define PROBE_SEL 0
#endif
#if PROBE_SEL
#define STAMP(k) do { if (blockIdx.x == 0 && threadIdx.x == 0) ((LAS unsigned long long*)(L + 256))[k] = __builtin_amdgcn_s_memrealtime(); } while (0)
#define STAMP2(k) do { if (blockIdx.x == 0) { __syncthreads(); if (threadIdx.x == 0) ((LAS unsigned long long*)((LAS unsigned char*)ring - RING_OFF + 256))[k] = __builtin_amdgcn_s_memrealtime(); } } while (0)
#else
#define STAMP(k) do {} while (0)
#define STAMP2(k) do {} while (0)
#endif
#if PROBE_SEL == 1
#define PA0 0
#define PA1 1
#define PB0 1
#define PB1 2
#elif PROBE_SEL == 2
#define PA0 2
#define PA1 3
#define PB0 3
#define PB1 4
#elif PROBE_SEL == 3
#define PA0 4
#define PA1 5
#define PB0 8
#define PB1 9
#elif PROBE_SEL == 4
#define PA0 2
#define PA1 10
#define PB0 10
#define PB1 11
#elif PROBE_SEL == 5
#define PA0 11
#define PA1 12
#define PB0 12
#define PB1 13
#elif PROBE_SEL == 6
#define PA0 5
#define PA1 6
#define PB0 7
#define PB1 8
#elif PROBE_SEL == 10
#define PEA 0
#define PEA_MIN 0
#define PEB 1
#define PEB_MIN 1
#elif PROBE_SEL == 11
#define PEA 2
#define PEA_MIN 0
#define PEB 3
#define PEB_MIN 1
#elif PROBE_SEL == 12
#define PEA 4
#define PEA_MIN 0
#define PEB 5
#define PEB_MIN 0
#elif PROBE_SEL == 14
#define PEA 8
#define PEA_MIN 0
#define PEB 9
#define PEB_MIN 0
#elif PROBE_SEL == 13
#define PEA 6
#define PEA_MIN 1
#define PEB 7
#define PEB_MIN 0
#endif

__device__ __forceinline__ void p0_transpose_blk(const float* W, int K, int N, bf16_t* WT, bool permqk, LAS unsigned char* T, int item, int tid) {
    const int nblk = N >> 8, kb = item / nblk, nb = item - kb * nblk, k0 = kb * 128, n0 = nb * 256;
    const int n4 = tid & 63, kr = tid >> 6;
    f32x4 v[16];
#pragma unroll
    for (int i = 0; i < 16; ++i) v[i] = *(const f32x4*)(W + (size_t)(k0 + 16 * kr + i) * N + n0 + 4 * n4);
#pragma unroll
    for (int e = 0; e < 4; ++e) {
        u32x4 lo, hi;
        lo.x = pg8::cvt_pk_bf16(v[0][e], v[1][e]); lo.y = pg8::cvt_pk_bf16(v[2][e], v[3][e]); lo.z = pg8::cvt_pk_bf16(v[4][e], v[5][e]); lo.w = pg8::cvt_pk_bf16(v[6][e], v[7][e]);
        hi.x = pg8::cvt_pk_bf16(v[8][e], v[9][e]); hi.y = pg8::cvt_pk_bf16(v[10][e], v[11][e]); hi.z = pg8::cvt_pk_bf16(v[12][e], v[13][e]); hi.w = pg8::cvt_pk_bf16(v[14][e], v[15][e]);
        LAS unsigned char* p = T + (64 * e + n4) * 272 + 32 * kr;
        *(LAS u32x4*)p = lo; *(LAS u32x4*)(p + 16) = hi;
    }
    LDS_WAIT();
    __syncthreads();
    {
        const int rho = tid >> 1, half = tid & 1, n = n0 + 4 * (rho & 63) + (rho >> 6);
        int nrow = n;
        if (permqk && n < 1280) { const int p = n & 63; nrow = (n & ~63) + 2 * (p & 31) + (p >> 5); }
        const LAS unsigned char* src = T + rho * 272 + 128 * half;
        bf16_t* dst = WT + (size_t)nrow * K + k0 + 64 * half;
        u32x4 o[8];
#pragma unroll
        for (int c = 0; c < 8; ++c) o[c] = *(const LAS u32x4*)(src + 16 * c);
#pragma unroll
        for (int c = 0; c < 8; ++c) *(u32x4*)(dst + 8 * c) = o[c];
    }
    LDS_WAIT();
    __syncthreads();
}
__device__ __forceinline__ void prenorm_row(const float* xrow, const float* g, bf16_t* hrow, int lane) {
    f32x4 v[8]; float ss = 0.f;
#pragma unroll
    for (int j = 0; j < 8; ++j) { v[j] = *(const f32x4*)(xrow + 4 * lane + 256 * j); ss += (v[j][0] * v[j][0] + v[j][1] * v[j][1]) + (v[j][2] * v[j][2] + v[j][3] * v[j][3]); }
    ss = wave_sum(ss);
    const float r = rsqrtf(ss * (1.0f / 2048.0f) + EPS);
#pragma unroll
    for (int j = 0; j < 8; ++j) { const f32x4 gg = *(const f32x4*)(g + 4 * lane + 256 * j); const f32x4 o = v[j] * r * gg;
        u32x2 w; w.x = pg8::cvt_pk_bf16(o[0], o[1]); w.y = pg8::cvt_pk_bf16(o[2], o[3]); *(u32x2*)(hrow + 4 * lane + 256 * j) = w; }
}
__device__ __forceinline__ void p0_prologue(const Frame& F, LAS unsigned char* ring) {
    const int gw = F.bid * NWAVES + F.wave, NGW = F.G * NWAVES;
    constexpr int I_IN = 16 * 20, I_OUT = 16 * 8, NITEMS = 2 * (I_IN + I_OUT);
    EV_T0();
    for (int it = F.bid; it < NITEMS; it += F.G) {
        int r = it;
        if (r < 2 * I_IN) { const int l = r / I_IN; r -= l * I_IN; p0_transpose_blk(F.w_in + (size_t)l * DM * DIN, DM, DIN, F.WTIN + (size_t)l * DIN * DM, true, ring, r, F.tid); }
        else { r -= 2 * I_IN; const int l = r / I_OUT; r -= l * I_OUT; p0_transpose_blk(F.w_out + (size_t)l * DM * DM, DM, DM, F.WTOUT + (size_t)l * DM * DM, false, ring, r, F.tid); }
    }
    __syncthreads(); EV_MAX(8);
    for (int m = gw; m < MT; m += NGW) { const float* xr = m < MP ? F.xp + (size_t)m * DM : F.xs + (size_t)(m - MP) * DM; prenorm_row(xr, F.norm_pre, F.H + (size_t)m * DM, F.lane); }
    __syncthreads(); EV_MAX(9);
    const int gt = F.bid * NTHREADS + F.tid, NGT = F.G * NTHREADS;
    for (int e = gt; e < 2052 * 32; e += NGT) { const int tp = e >> 5, i = e & 31; const double pos = (double)(tp < 2048 ? tp : 8192 + (tp - 2048));
        const double rev = pos * ROPE_INV[i] * 0.15915494309189535; const float fr = (float)(rev - floor(rev));
        F.rope[tp * 64 + i] = __builtin_amdgcn_cosf(fr); F.rope[tp * 64 + 32 + i] = __builtin_amdgcn_sinf(fr); }
    for (int e = gt; e < 2 * 4 * 128 * 128; e += NGT) { const int s = e & 127, t = (e >> 7) & 127; const float w = F.sgu_w[e];
        F.SGUW[e] = (bf16_t)(pg8::cvt_pk_bf16(s <= t ? w : 0.f, 0.f) & 0xffffu); }
    for (int e = gt; e < 2 * 4 * 128; e += NGT) { const int t = e & 127; const float* wr = F.sgu_w + (size_t)e * 128; float acc = 0.f;
        for (int s2 = 0; s2 <= t; ++s2) acc += __uint_as_float(pg8::cvt_pk_bf16(wr[s2], 0.f) << 16);
        F.RSW[e] = acc; }
    for (int e = gt; e < 2 * 4 * 128 * 128; e += NGT) { const int c = e & 127, d = (e >> 7) & 127, lg = e >> 14;
        F.PWT[e] = (bf16_t)(pg8::cvt_pk_bf16(F.pool_w[((size_t)lg * 128 + c) * 128 + d], 0.f) & 0xffffu); }
}

constexpr int AT_K = 0, AT_V = 49152, AT_STG = 98304, AT_WSTRIDE = 4352;
__device__ __forceinline__ void attn_stage_kv(const Frame& F, int b, int kvh, int nbp, LAS unsigned char* ring) {
    const int tid = F.tid;
    const bf16_t* kg = F.Kc + ((size_t)(b * 4 + kvh) * 2048 + 256 * nbp - 128) * 64;
    const bf16_t* vg = F.VTP + ((size_t)(b * 4 + kvh) * 64 + 8 * nbp - 4) * 2048;
    u32x4 kv[6], vv[6];
#pragma unroll
    for (int i = 0; i < 6; ++i) { const int ch = tid + 512 * i, row0 = ch >> 3, c8 = ch & 7, row = (nbp > 0 || row0 >= 128) ? row0 : row0 + 128;
        kv[i] = *(const u32x4*)(kg + row * 64 + c8 * 8); }
#pragma unroll
    for (int i = 0; i < 6; ++i) { const int ch = tid + 512 * i, tile0 = ch >> 8, rem = ch & 255, d = rem >> 2, c4 = rem & 3, tile = (nbp > 0 || tile0 >= 4) ? tile0 : tile0 + 4;
        vv[i] = *(const u32x4*)(vg + tile * 2048 + d * 32 + c4 * 8); }
#pragma unroll
    for (int i = 0; i < 6; ++i) { const int ch = tid + 512 * i, row = ch >> 3, c8 = ch & 7;
        *(LAS u32x4*)(ring + AT_K + row * 128 + ((c8 ^ (row & 7)) << 4)) = kv[i]; }
#pragma unroll
    for (int i = 0; i < 6; ++i) { const int ch = tid + 512 * i, tile = ch >> 8, rem = ch & 255, d = rem >> 2, c4 = rem & 3;
        *(LAS u32x4*)(ring + AT_V + tile * 4096 + d * 64 + ((c4 ^ ((d >> 2) & 3)) << 4)) = vv[i]; }
}
__device__ __forceinline__ void attn_task(const Frame& F, int l, int b, int nbp, int head, int j, const bf16x8 (&qf)[4], LAS unsigned char* ring) {
    const int lane = F.lane, r = lane & 31, hh = lane >> 5;
    LAS unsigned char* wl = ring + AT_STG + F.wave * AT_WSTRIDE;
    LAS float* wsf = (LAS float*)wl; LAS bf16_t* stg = (LAS bf16_t*)(wl + 256);
    const size_t qrow0 = (size_t)b * 2048 + 256 * nbp + 32 * j;
    u32x4 gv[4];
#pragma unroll
    for (int i = 0; i < 4; ++i) gv[i] = *(const u32x4*)(F.Z2 + (qrow0 + i * 8 + (lane >> 3)) * ZW + Z_GA + head * 64 + (lane & 7) * 8);
    const int cmin = (nbp > 0) ? 0 : (j < 4 ? 4 - j : 0);
    f32x16 S[5];
#pragma unroll
    for (int c = 0; c < 5; ++c) {
        f32x16 a;
#pragma unroll
        for (int i = 0; i < 16; ++i) a[i] = 0.f;
        if (c >= cmin) {
            LAS unsigned char* kp = ring + AT_K + (32 * (j + c) + r) * 128;
#pragma unroll
            for (int s = 0; s < 4; ++s) a = __builtin_amdgcn_mfma_f32_32x32x16_bf16(*(const LAS bf16x8*)(kp + (((2 * s + hh) ^ (r & 7)) << 4)), qf[s], a, 0, 0, 0);
        }
        S[c] = a;
    }
    const float NEG = -INFINITY;
#pragma unroll
    for (int i = 0; i < 16; ++i) { const int kap = crow(i, hh); if (kap <= r) S[0][i] = NEG; if (kap > r) S[4][i] = NEG; }
    const float sink2 = F.sinks[l * 16 + head] * LOG2E;
    float m = sink2;
#pragma unroll
    for (int c = 0; c < 5; ++c) if (c >= cmin) {
#pragma unroll
        for (int i = 0; i < 16; ++i) m = fmaxf(m, S[c][i]); }
    m = fmaxf(m, __shfl_xor(m, 32));
    float sum = 0.f;
#pragma unroll
    for (int c = 0; c < 5; ++c) if (c >= cmin) {
#pragma unroll
        for (int i = 0; i < 16; ++i) { const float p = __builtin_amdgcn_exp2f(S[c][i] - m); S[c][i] = p; sum += p; } }
    sum += __shfl_xor(sum, 32);
    const float inv = 1.0f / (sum + __builtin_amdgcn_exp2f(sink2 - m));
    f32x16 o[2];
#pragma unroll
    for (int i = 0; i < 16; ++i) { o[0][i] = 0.f; o[1][i] = 0.f; }
#pragma unroll
    for (int c = 0; c < 5; ++c) if (c >= cmin) {
        LAS unsigned char* vt = ring + AT_V + (j + c) * 4096 + r * 64;
#pragma unroll
        for (int s = 0; s < 2; ++s) {
            u32x4 pw; pw.x = pg8::cvt_pk_bf16(S[c][8 * s + 0], S[c][8 * s + 1]); pw.y = pg8::cvt_pk_bf16(S[c][8 * s + 2], S[c][8 * s + 3]);
            pw.z = pg8::cvt_pk_bf16(S[c][8 * s + 4], S[c][8 * s + 5]); pw.w = pg8::cvt_pk_bf16(S[c][8 * s + 6], S[c][8 * s + 7]);
            const bf16x8 pa = __builtin_bit_cast(bf16x8, pw);
            const int sw = (((2 * hh + s) ^ ((r >> 2) & 3)) << 4);
#pragma unroll
            for (int db = 0; db < 2; ++db) o[db] = __builtin_amdgcn_mfma_f32_32x32x16_bf16(pa, *(const LAS bf16x8*)(vt + db * 2048 + sw), o[db], 0, 0, 0);
        }
    }
    if (hh == 0) wsf[r] = inv;
    LDS_WAIT();
#pragma unroll
    for (int i = 0; i < 16; ++i) { const int q = crow(i, hh); const float rl = wsf[q];
        stg[q * 64 + r] = (bf16_t)(pg8::cvt_pk_bf16(o[0][i] * rl, 0.f) & 0xffffu);
        stg[q * 64 + 32 + r] = (bf16_t)(pg8::cvt_pk_bf16(o[1][i] * rl, 0.f) & 0xffffu); }
    LDS_WAIT();
#pragma unroll
    for (int i = 0; i < 4; ++i) { const int row = i * 8 + (lane >> 3), ch = lane & 7;
        const u32x4 ov = *(const LAS u32x4*)(stg + row * 64 + ch * 8);
        float of[8], gf[8]; unpack8(ov, of); unpack8(gv[i], gf);
#pragma unroll
        for (int jj = 0; jj < 8; ++jj) of[jj] *= gf[jj];
        *(u32x4*)(F.MIX + (qrow0 + row) * DM + head * 64 + ch * 8) = pack8(of); }
    LDS_WAIT();
}
__device__ __forceinline__ void attn_unit(int l, int a, LAS unsigned char* ring) {
    LOCAL_FRAME;
    const int kvh = a & 3, nbp = (a >> 2) & 7, b = a >> 5;
    const int lane = F.lane, r = lane & 31, hh = lane >> 5;
    const int head = 4 * kvh + (F.wave >> 1), j0 = 4 * (F.wave & 1);
    const bf16_t* qp = F.Qc + ((size_t)b * 2048 + 256 * nbp + 32 * j0 + r) * 1024 + head * 64 + 8 * hh;
    bf16x8 qa[4], qb[4];
#pragma unroll
    for (int s = 0; s < 4; ++s) qa[s] = *(const bf16x8*)(qp + 16 * s);
#ifdef EXP_ZERO_LDS
    for (int e = F.tid; e < 134144 / 16; e += NTHREADS) *(LAS u32x4*)(ring + 16 * e) = (u32x4){0u, 0u, 0u, 0u};
    LDS_WAIT(); __syncthreads();
#endif
    attn_stage_kv(F, b, kvh, nbp, ring);
    LDS_WAIT();
    __syncthreads();
#pragma unroll
    for (int s = 0; s < 4; ++s) qb[s] = *(const bf16x8*)(qp + 32 * 1024 + 16 * s);
    attn_task(F, l, b, nbp, head, j0 + 0, qa, ring);
#pragma unroll
    for (int s = 0; s < 4; ++s) qa[s] = *(const bf16x8*)(qp + 64 * 1024 + 16 * s);
    attn_task(F, l, b, nbp, head, j0 + 1, qb, ring);
#pragma unroll
    for (int s = 0; s < 4; ++s) qb[s] = *(const bf16x8*)(qp + 96 * 1024 + 16 * s);
    attn_task(F, l, b, nbp, head, j0 + 2, qa, ring);
    attn_task(F, l, b, nbp, head, j0 + 3, qb, ring);
    __syncthreads();
}

constexpr int PL_STRIDE = 272, PL_WBYTES = 47 * 272;
template <int G>
__device__ __forceinline__ void pool_unit_p(int l, int tile, LAS unsigned char* wl) {
    LOCAL_FRAME;
    constexpr int W = 2 << G, HIST = W - 1, NROW = 32 + HIST, NLD = (NROW * 16 + 63) / 64;
    const int lane = F.lane, r = lane & 31, hh = lane >> 5;
    const size_t R0 = (size_t)32 * tile;
    const int t0 = (int)(R0 & 2047);
    {
        u32x4 x[NLD];
#pragma unroll
        for (int k = 0; k < NLD; ++k) { const int id = lane + 64 * k, lr = id >> 4, c16 = id & 15; const int lrc = lr < NROW ? lr : NROW - 1;
            const int back = HIST - lrc; const size_t grow = (back <= t0) ? R0 - back : R0;
            x[k] = *(const u32x4*)(F.Z2 + grow * ZW + Z_XB + 128 * G + 8 * c16); }
#pragma unroll
        for (int k = 0; k < NLD; ++k) { const int id = lane + 64 * k, lr = id >> 4, c16 = id & 15; if (lr < NROW) *(LAS u32x4*)(wl + lr * PL_STRIDE + c16 * 16) = x[k]; }
    }
    const size_t row = R0 + r; const int t = t0 + r;
    u32x2 gq[4][4];
#pragma unroll
    for (int db = 0; db < 4; ++db)
#pragma unroll
        for (int q = 0; q < 4; ++q) gq[db][q] = *(const u32x2*)(F.Z2 + row * ZW + Z_GP + 128 * G + 32 * db + 8 * q + 4 * hh);
    const float icnt = 1.0f / (float)(W < t + 1 ? W : t + 1);
    LDS_WAIT();
    bf16x8 bfr[8];
#pragma unroll
    for (int s = 0; s < 8; ++s) {
        LAS unsigned char* bp = wl + (r + HIST) * PL_STRIDE + (16 * s + 8 * hh) * 2;
        float cur[8], sum[8]; unpack8(*(const LAS u32x4*)bp, cur);
#pragma unroll
        for (int jj = 0; jj < 8; ++jj) sum[jj] = cur[jj];
#pragma unroll
        for (int i = 1; i < W; ++i) { float f[8]; unpack8(*(const LAS u32x4*)(bp - i * PL_STRIDE), f); const float wgt = i <= t ? 1.f : 0.f;
#pragma unroll
            for (int jj = 0; jj < 8; ++jj) sum[jj] += wgt * f[jj]; }
#pragma unroll
        for (int jj = 0; jj < 8; ++jj) sum[jj] = sum[jj] * icnt - cur[jj];
        bfr[s] = __builtin_bit_cast(bf16x8, pack8(sum));
        __builtin_amdgcn_sched_barrier(0);
    }
    f32x16 acc[4];
#pragma unroll
    for (int db = 0; db < 4; ++db) {
#pragma unroll
        for (int i = 0; i < 16; ++i) acc[db][i] = 0.f;
        const bf16_t* ap = F.PWT + ((size_t)(l * 4 + G) * 128 + 32 * db + r) * 128 + 8 * hh;
#pragma unroll
        for (int s = 0; s < 8; ++s) acc[db] = __builtin_amdgcn_mfma_f32_32x32x16_bf16(*(const bf16x8*)(ap + 16 * s), bfr[s], acc[db], 0, 0, 0);
        __builtin_amdgcn_sched_barrier(0);
    }
#pragma unroll
    for (int db = 0; db < 4; ++db)
#pragma unroll
        for (int q = 0; q < 4; ++q) {
            const int col = 128 * G + 32 * db + 8 * q + 4 * hh;
            const f32x4 sc = *(const f32x4*)(F.pool_scale + l * 512 + col);
            float gf[4]; unpack4(gq[db][q], gf);
            u32x2 wv; wv.x = pg8::cvt_pk_bf16(acc[db][4 * q + 0] * sc[0] * gf[0], acc[db][4 * q + 1] * sc[1] * gf[1]);
            wv.y = pg8::cvt_pk_bf16(acc[db][4 * q + 2] * sc[2] * gf[2], acc[db][4 * q + 3] * sc[3] * gf[3]);
            *(u32x2*)(F.MIX + row * DM + 1024 + col) = wv;
        }
    LDS_WAIT();
}
__device__ __forceinline__ void pool_prompt(int l, int g, int tile, LAS unsigned char* wl) {
    if (g == 0) pool_unit_p<0>(l, tile, wl); else if (g == 1) pool_unit_p<1>(l, tile, wl); else if (g == 2) pool_unit_p<2>(l, tile, wl); else pool_unit_p<3>(l, tile, wl);
}
template <int G>
__device__ __forceinline__ void pool_unit_s(int l, int tile) {
    LOCAL_FRAME;
    constexpr int W = 2 << G;
    const int lane = F.lane, r = lane & 31, hh = lane >> 5;
    const size_t row = (size_t)MP + 32 * tile + r;
    const int tt = (int)(row & 3), bd = (int)((row - MP) >> 2);
    const float* stb = F.state_pool + ((size_t)l * 128 + bd) * 15 * 512;
    const float icnt = 1.0f / (float)W;
    bf16x8 bfr[8];
#pragma unroll
    for (int s = 0; s < 8; ++s) {
        const int c0 = 128 * G + 16 * s + 8 * hh;
        float sum[8], cur[8];
        {
            constexpr int NL = W < 4 ? W : 4;
            u32x4 zn[NL]; f32x4 sa[NL], sb[NL];
#pragma unroll
            for (int i = 0; i < NL; ++i) { const int back = i <= tt ? i : tt; int si = 15 + tt - i; si = si > 14 ? 14 : si;
                zn[i] = *(const u32x4*)(F.Z2 + (row - back) * ZW + Z_XB + c0); sa[i] = *(const f32x4*)(stb + si * 512 + c0); sb[i] = *(const f32x4*)(stb + si * 512 + c0 + 4); }
            unpack8(zn[0], cur);
#pragma unroll
            for (int jj = 0; jj < 8; ++jj) sum[jj] = cur[jj];
#pragma unroll
            for (int i = 1; i < NL; ++i) { float f[8]; unpack8(zn[i], f); const bool nw = i <= tt;
#pragma unroll
                for (int jj = 0; jj < 4; ++jj) { sum[jj] += nw ? f[jj] : sa[i][jj]; sum[4 + jj] += nw ? f[4 + jj] : sb[i][jj]; } }
        }
#pragma unroll
        for (int i0 = 4; i0 < W; i0 += 4) {
            f32x4 sa[4], sb[4];
#pragma unroll
            for (int i = 0; i < 4; ++i) { const int si = 15 + tt - (i0 + i); sa[i] = *(const f32x4*)(stb + si * 512 + c0); sb[i] = *(const f32x4*)(stb + si * 512 + c0 + 4); }
#pragma unroll
            for (int i = 0; i < 4; ++i)
#pragma unroll
                for (int jj = 0; jj < 4; ++jj) { sum[jj] += sa[i][jj]; sum[4 + jj] += sb[i][jj]; }
        }
#pragma unroll
        for (int jj = 0; jj < 8; ++jj) sum[jj] = sum[jj] * icnt - cur[jj];
        bfr[s] = __builtin_bit_cast(bf16x8, pack8(sum));
        __builtin_amdgcn_sched_barrier(0);
    }
    f32x16 acc[4];
#pragma unroll
    for (int db = 0; db < 4; ++db) {
#pragma unroll
        for (int i = 0; i < 16; ++i) acc[db][i] = 0.f;
        const bf16_t* ap = F.PWT + ((size_t)(l * 4 + G) * 128 + 32 * db + r) * 128 + 8 * hh;
#pragma unroll
        for (int s = 0; s < 8; ++s) acc[db] = __builtin_amdgcn_mfma_f32_32x32x16_bf16(*(const bf16x8*)(ap + 16 * s), bfr[s], acc[db], 0, 0, 0);
        __builtin_amdgcn_sched_barrier(0);
    }
#pragma unroll
    for (int db = 0; db < 4; ++db)
#pragma unroll
        for (int q = 0; q < 4; ++q) {
            const int col = 128 * G + 32 * db + 8 * q + 4 * hh;
            const f32x4 sc = *(const f32x4*)(F.pool_scale + l * 512 + col);
            float gf[4]; unpack4(*(const u32x2*)(F.Z2 + row * ZW + Z_GP + col), gf);
            u32x2 wv; wv.x = pg8::cvt_pk_bf16(acc[db][4 * q + 0] * sc[0] * gf[0], acc[db][4 * q + 1] * sc[1] * gf[1]);
            wv.y = pg8::cvt_pk_bf16(acc[db][4 * q + 2] * sc[2] * gf[2], acc[db][4 * q + 3] * sc[3] * gf[3]);
            *(u32x2*)(F.MIX + row * DM + 1024 + col) = wv;
        }
}
__device__ __forceinline__ void pool_sample(int l, int g, int tile) {
    if (g == 0) pool_unit_s<0>(l, tile); else if (g == 1) pool_unit_s<1>(l, tile); else if (g == 2) pool_unit_s<2>(l, tile); else pool_unit_s<3>(l, tile);
}

struct SguOps { bf16x8 wB[8], wA[4]; u32x2 uu[2][4], gg[2][4]; float bias[2], rsw[2]; };
__device__ __forceinline__ void sgu_load_ops(SguOps& o, const Frame& F, int l, int hd, size_t R0, int r, int hh, int db, int tbA, int tbB) {
    const bf16_t* Wb = F.SGUW + (size_t)(l * 4 + hd) * 128 * 128;
#pragma unroll
    for (int s = 0; s < 8; ++s) { o.wB[s] = (bf16x8){0, 0, 0, 0, 0, 0, 0, 0}; if (s < 2 * (tbB + 1)) o.wB[s] = *(const bf16x8*)(Wb + (32 * tbB + r) * 128 + 16 * s + 8 * hh); }
#pragma unroll
    for (int s = 0; s < 4; ++s) { o.wA[s] = (bf16x8){0, 0, 0, 0, 0, 0, 0, 0}; if (s < 2 * (tbA + 1)) o.wA[s] = *(const bf16x8*)(Wb + (32 * tbA + r) * 128 + 16 * s + 8 * hh); }
#pragma unroll
    for (int pass = 0; pass < 2; ++pass) { const int tb = pass ? tbB : tbA; const size_t row = R0 + 32 * tb + r;
        o.bias[pass] = F.sgu_b[l * 512 + hd * 128 + 32 * tb + r]; o.rsw[pass] = F.RSW[(l * 4 + hd) * 128 + 32 * tb + r];
#pragma unroll
        for (int q = 0; q < 4; ++q) { const int col = 128 * hd + 32 * db + 8 * q + 4 * hh;
            o.uu[pass][q] = *(const u32x2*)(F.Z2 + row * ZW + Z_U + col); o.gg[pass][q] = *(const u32x2*)(F.Z2 + row * ZW + Z_GS + col); } }
}
__device__ __forceinline__ void sgu_mfma(const SguOps& o, LAS bf16_t* VnT, int h2, int r, int hh, int db, int tbA, int tbB, f32x16& accA, f32x16& accB) {
#pragma unroll
    for (int i = 0; i < 16; ++i) { accA[i] = 0.f; accB[i] = 0.f; }
#pragma unroll
    for (int s = 0; s < 8; ++s) {
        if (s < 2 * (tbB + 1)) {
            const bf16x8 a = *(const LAS bf16x8*)(VnT + (h2 * 128 + 32 * db + r) * 136 + 16 * s + 8 * hh);
            accB = __builtin_amdgcn_mfma_f32_32x32x16_bf16(a, o.wB[s], accB, 0, 0, 0);
            if (s < 4) { if (s < 2 * (tbA + 1)) accA = __builtin_amdgcn_mfma_f32_32x32x16_bf16(a, o.wA[s], accA, 0, 0, 0); }
        }
    }
}
__device__ __forceinline__ void sgu_epi(const SguOps& o, const Frame& F, int l, int hd, size_t R0, int r, int hh, int db, int tbA, int tbB, const f32x16& accA, const f32x16& accB) {
    f32x4 lg[4], lb[4];
#pragma unroll
    for (int q = 0; q < 4; ++q) { const int col = 128 * hd + 32 * db + 8 * q + 4 * hh; lg[q] = *(const f32x4*)(F.ln_g + l * 512 + col); lb[q] = *(const f32x4*)(F.ln_b + l * 512 + col); }
#pragma unroll
    for (int pass = 0; pass < 2; ++pass) {
        const int tb = pass ? tbB : tbA; const f32x16 acc = pass ? accB : accA;
        const size_t row = R0 + 32 * tb + r; const float bs = o.bias[pass], rs = o.rsw[pass];
#pragma unroll
        for (int q = 0; q < 4; ++q) { const int col = 128 * hd + 32 * db + 8 * q + 4 * hh;
            float uf[4], gf[4]; unpack4(o.uu[pass][q], uf); unpack4(o.gg[pass][q], gf);
            float m[4];
#pragma unroll
            for (int e = 0; e < 4; ++e) m[e] = (lg[q][e] * acc[4 * q + e] + lb[q][e] * rs + bs) * uf[e] * gf[e];
            u32x2 wo; wo.x = pg8::cvt_pk_bf16(m[0], m[1]); wo.y = pg8::cvt_pk_bf16(m[2], m[3]);
            *(u32x2*)(F.MIX + row * DM + 1536 + col) = wo; }
    }
}
__device__ __forceinline__ void sgu_unit(int l, int ci, int hp, LAS unsigned char* ring) {
    LOCAL_FRAME;
    LAS bf16_t* VnT = (LAS bf16_t*)ring;
    const int lane = F.lane, wv = F.wave;
    const size_t R0 = (size_t)128 * ci;
    const int r = lane & 31, hh = lane >> 5, db = wv & 3; const int tbA = (wv >> 2) ? 1 : 0, tbB = (wv >> 2) ? 2 : 3;
    SguOps op0;
    {
        const int tl = lane >> 2, q4 = lane & 3;
        const bf16_t* vrow = F.Z2 + (R0 + 16 * wv + tl) * ZW + Z_VS + 32 * q4;
        u32x4 x[4][4];
#pragma unroll
        for (int h = 0; h < 4; ++h)
#pragma unroll
            for (int i = 0; i < 4; ++i) x[h][i] = *(const u32x4*)(vrow + 128 * h + 8 * i);
        sgu_load_ops(op0, F, l, 2 * hp, R0, r, hh, db, tbA, tbB);
        float s = 0.f, ss = 0.f;
#pragma unroll
        for (int h = 0; h < 4; ++h)
#pragma unroll
            for (int i = 0; i < 4; ++i) { float f[8]; unpack8(x[h][i], f);
#pragma unroll
                for (int jj = 0; jj < 8; ++jj) { s += f[jj]; ss += f[jj] * f[jj]; } }
        s += __shfl_xor(s, 1); s += __shfl_xor(s, 2); ss += __shfl_xor(ss, 1); ss += __shfl_xor(ss, 2);
        const float mean = s * (1.0f / 512.0f), var = ss * (1.0f / 512.0f) - mean * mean, rstd = rsqrtf(var + EPS);
#pragma unroll
        for (int h2 = 0; h2 < 2; ++h2)
#pragma unroll
            for (int i = 0; i < 4; ++i) { const int d = 32 * q4 + 8 * i;
                const u32x4 xv = hp ? x[2 + h2][i] : x[h2][i];
                float f[8]; unpack8(xv, f);
#pragma unroll
                for (int jj = 0; jj < 8; ++jj) VnT[(h2 * 128 + d + jj) * 136 + 16 * wv + tl] = (bf16_t)(pg8::cvt_pk_bf16((f[jj] - mean) * rstd, 0.f) & 0xffffu); }
    }
    LDS_WAIT();
    __syncthreads();
    f32x16 accA, accB;
    sgu_mfma(op0, VnT, 0, r, hh, db, tbA, tbB, accA, accB);
    SguOps op1;
    sgu_load_ops(op1, F, l, 2 * hp + 1, R0, r, hh, db, tbA, tbB);
    sgu_epi(op0, F, l, 2 * hp, R0, r, hh, db, tbA, tbB, accA, accB);
    sgu_mfma(op1, VnT, 1, r, hh, db, tbA, tbB, accA, accB);
    sgu_epi(op1, F, l, 2 * hp + 1, R0, r, hh, db, tbA, tbB, accA, accB);
    __syncthreads();
}

__device__ __forceinline__ void samp_attn(int l, int bd, int kvh, LAS unsigned char* wl) {
    LOCAL_FRAME;
    LAS float* ps = (LAS float*)wl;
    LAS float* invs = ps + 144 * 16;
    const int lane = F.lane, fr = lane & 15, fq = lane >> 4, gq = fr >> 2, tt = fr & 3;
    float* oKs = F.out + O_KS + (size_t)l * LS_KS; float* oVs = F.out + O_VS + (size_t)l * LS_KS;
    bf16x8 qfr[2];
    {
        const bf16_t* qsrc = F.Qc + ((size_t)MP + 4 * bd + tt) * 1024 + (4 * kvh + gq) * 64 + 16 * fq;
        const u32x4 qa = *(const u32x4*)qsrc, qb = *(const u32x4*)(qsrc + 8);
        u32x4 lo, hi;
        lo.x = (qa.x & 0xffffu) | (qa.y << 16); lo.y = (qa.z & 0xffffu) | (qa.w << 16); lo.z = (qb.x & 0xffffu) | (qb.y << 16); lo.w = (qb.z & 0xffffu) | (qb.w << 16);
        hi.x = (qa.x >> 16) | (qa.y & 0xffff0000u); hi.y = (qa.z >> 16) | (qa.w & 0xffff0000u); hi.z = (qb.x >> 16) | (qb.y & 0xffff0000u); hi.w = (qb.z >> 16) | (qb.w & 0xffff0000u);
        qfr[0] = __builtin_bit_cast(bf16x8, lo); qfr[1] = __builtin_bit_cast(bf16x8, hi);
    }
    const float* kc = F.cache_k + (((size_t)l * 128 + bd) * 128) * 256 + kvh * 64 + 8 * fq;
    const float* kn = oKs + (((size_t)bd * 128 + 124 + (fr & 3)) * 4 + kvh) * 64 + 8 * fq;
    float* kd = oKs + ((size_t)bd * 128 * 4 + kvh) * 64 + 8 * fq;
    f32x4 S[9];
#pragma unroll
    for (int T = 0; T < 9; ++T) S[T] = (f32x4){0.f, 0.f, 0.f, 0.f};
#pragma unroll
    for (int T0 = 0; T0 < 9; T0 += 3) {
        f32x4 x[3][2][2];
#pragma unroll
        for (int u = 0; u < 3; ++u) { const int T = T0 + u; const float* src = (T < 8) ? kc + (size_t)(16 * T + fr) * 256 : kn;
#pragma unroll
            for (int ks = 0; ks < 2; ++ks) { x[u][ks][0] = *(const f32x4*)(src + 32 * ks); x[u][ks][1] = *(const f32x4*)(src + 32 * ks + 4); } }
#pragma unroll
        for (int u = 0; u < 3; ++u) { const int T = T0 + u; const int key = 16 * T + fr;
            if (T < 8 && key >= 4) {
#pragma unroll
                for (int ks = 0; ks < 2; ++ks) { float* dst = kd + (size_t)(key - 4) * 256 + 32 * ks; *(f32x4*)dst = x[u][ks][0]; *(f32x4*)(dst + 4) = x[u][ks][1]; } } }
#pragma unroll
        for (int u = 0; u < 3; ++u)
#pragma unroll
            for (int ks = 0; ks < 2; ++ks) { u32x4 w; w.x = pg8::cvt_pk_bf16(x[u][ks][0][0], x[u][ks][0][1]); w.y = pg8::cvt_pk_bf16(x[u][ks][0][2], x[u][ks][0][3]);
                w.z = pg8::cvt_pk_bf16(x[u][ks][1][0], x[u][ks][1][1]); w.w = pg8::cvt_pk_bf16(x[u][ks][1][2], x[u][ks][1][3]);
                S[T0 + u] = __builtin_amdgcn_mfma_f32_16x16x32_bf16(__builtin_bit_cast(bf16x8, w), qfr[ks], S[T0 + u], 0, 0, 0); }
        __builtin_amdgcn_sched_barrier(0);
    }
    const float sink2 = F.sinks[l * 16 + 4 * kvh + gq] * LOG2E;
    float m = sink2;
#pragma unroll
    for (int T = 0; T < 9; ++T)
#pragma unroll
        for (int rg = 0; rg < 4; ++rg) { const int key = 16 * T + 4 * fq + rg; const bool ok = (T < 8) ? (key >= tt + 1) : (fq == 0 && rg <= tt);
            S[T][rg] = ok ? S[T][rg] : -INFINITY; m = fmaxf(m, S[T][rg]); }
    m = fmaxf(m, __shfl_xor(m, 16)); m = fmaxf(m, __shfl_xor(m, 32));
    float sum = 0.f;
#pragma unroll
    for (int T = 0; T < 9; ++T)
#pragma unroll
        for (int rg = 0; rg < 4; ++rg) { const float p = __builtin_amdgcn_exp2f(S[T][rg] - m); sum += p; ps[(16 * T + 4 * fq + rg) * 16 + fr] = p; }
    sum += __shfl_xor(sum, 16); sum += __shfl_xor(sum, 32);
    if (fq == 0) invs[fr] = 1.0f / (sum + __builtin_amdgcn_exp2f(sink2 - m));
    LDS_WAIT();
    const int kq = lane >> 4, dq = lane & 15;
    const float* vcp = F.cache_v + (((size_t)l * 128 + bd) * 128 + kq) * 256 + kvh * 64 + 4 * dq;
    float* vop = oVs + ((size_t)bd * 128 + kq) * 256 + kvh * 64 + 4 * dq;
#pragma unroll 1
    for (int pass = 0; pass < 2; ++pass) {
        float o[8][4];
#pragma unroll
        for (int q = 0; q < 8; ++q) { o[q][0] = 0.f; o[q][1] = 0.f; o[q][2] = 0.f; o[q][3] = 0.f; }
#pragma unroll 1
        for (int blk = 0; blk < 3; ++blk) {
            f32x4 vx[11];
#pragma unroll
            for (int ii = 0; ii < 11; ++ii) { const int i = blk * 11 + ii; const float* src = (i < 32) ? vcp + (size_t)i * 1024 : vop + (size_t)31 * 1024; vx[ii] = *(const f32x4*)src; }
            if (pass == 0) {
#pragma unroll
                for (int ii = 0; ii < 11; ++ii) { const int i = blk * 11 + ii; if (i >= 1 && i < 32) *(f32x4*)(vop + (size_t)(i - 1) * 1024) = vx[ii]; } }
#pragma unroll
            for (int ii = 0; ii < 11; ++ii) { const int key = 4 * (blk * 11 + ii) + kq;
                const f32x4 pa = *(const LAS f32x4*)(ps + key * 16 + 8 * pass), pb = *(const LAS f32x4*)(ps + key * 16 + 8 * pass + 4);
#pragma unroll
                for (int e = 0; e < 4; ++e) { o[0][e] += pa[0] * vx[ii][e]; o[1][e] += pa[1] * vx[ii][e]; o[2][e] += pa[2] * vx[ii][e]; o[3][e] += pa[3] * vx[ii][e];
                    o[4][e] += pb[0] * vx[ii][e]; o[5][e] += pb[1] * vx[ii][e]; o[6][e] += pb[2] * vx[ii][e]; o[7][e] += pb[3] * vx[ii][e]; }
                __builtin_amdgcn_sched_barrier(0); }
        }
#pragma unroll
        for (int q = 0; q < 8; ++q)
#pragma unroll
            for (int e = 0; e < 4; ++e) { float v = o[q][e]; v += __shfl_xor(v, 16); v += __shfl_xor(v, 32); o[q][e] = v; }
#pragma unroll
        for (int q = 0; q < 8; ++q) if ((q >> 1) == kq) { const int qq = 8 * pass + q, t2 = qq & 3, head = 4 * kvh + (qq >> 2); const size_t row = (size_t)MP + 4 * bd + t2;
            float gf[4]; unpack4(*(const u32x2*)(F.Z2 + row * ZW + Z_GA + head * 64 + 4 * dq), gf);
            const float iq = invs[qq];
            u32x2 wv; wv.x = pg8::cvt_pk_bf16(o[q][0] * iq * gf[0], o[q][1] * iq * gf[1]); wv.y = pg8::cvt_pk_bf16(o[q][2] * iq * gf[2], o[q][3] * iq * gf[3]);
            *(u32x2*)(F.MIX + row * DM + head * 64 + 4 * dq) = wv; }
    }
    LDS_WAIT();
}
__device__ __forceinline__ void samp_sgu(int l, int bd) {
    LOCAL_FRAME;
    const int lane = F.lane, c0 = 8 * lane, hd = lane >> 4;
    {
        float* oPs = F.out + O_PS + (size_t)l * LS_PS + (size_t)bd * 15 * 512; const float* sp = F.state_pool + (size_t)l * LS_PS + (size_t)bd * 15 * 512 + 4 * 512;
        f32x4 cp[22];
#pragma unroll
        for (int k = 0; k < 22; ++k) cp[k] = *(const f32x4*)(sp + 4 * (lane + 64 * k));
#pragma unroll
        for (int k = 0; k < 22; ++k) *(f32x4*)(oPs + 4 * (lane + 64 * k)) = cp[k];
    }
    float* oCV = F.out + O_CV + (size_t)l * LS_CV;
    float gl[8], bl[8];
#pragma unroll
    for (int j = 0; j < 8; ++j) { gl[j] = F.ln_g[l * 512 + c0 + j]; bl[j] = F.ln_b[l * 512 + c0 + j]; }
    u32x4 xr[4], ur[4], gr[4];
#pragma unroll
    for (int tt = 0; tt < 4; ++tt) { const size_t row = (size_t)MP + 4 * bd + tt; xr[tt] = *(const u32x4*)(F.Z2 + row * ZW + Z_VS + c0); ur[tt] = *(const u32x4*)(F.Z2 + row * ZW + Z_U + c0); gr[tt] = *(const u32x4*)(F.Z2 + row * ZW + Z_GS + c0); }
    float vn[4][8];
#pragma unroll
    for (int tt = 0; tt < 4; ++tt) { float f[8]; unpack8(xr[tt], f);
        float s = 0.f, ss = 0.f;
#pragma unroll
        for (int j = 0; j < 8; ++j) { s += f[j]; ss += f[j] * f[j]; }
        s = wave_sum(s); ss = wave_sum(ss);
        const float mean = s * (1.0f / 512.0f), var = ss * (1.0f / 512.0f) - mean * mean, rstd = rsqrtf(var + EPS);
#pragma unroll
        for (int j = 0; j < 8; ++j) vn[tt][j] = (f[j] - mean) * rstd * gl[j] + bl[j];
        float* o = oCV + ((size_t)bd * 4 + tt) * 512 + c0;
        *(f32x4*)o = (f32x4){vn[tt][0], vn[tt][1], vn[tt][2], vn[tt][3]}; *(f32x4*)(o + 4) = (f32x4){vn[tt][4], vn[tt][5], vn[tt][6], vn[tt][7]}; }
#pragma unroll
    for (int tt = 0; tt < 4; ++tt) { const size_t row = (size_t)MP + 4 * bd + tt;
        float mx[8]; const float bias = F.sgu_b[l * 512 + hd * 128 + tt];
#pragma unroll
        for (int j = 0; j < 8; ++j) mx[j] = bias;
#pragma unroll
        for (int s2 = 0; s2 < 4; ++s2) if (s2 <= tt) { const float w = F.sgu_w[((size_t)(l * 4 + hd) * 128 + tt) * 128 + s2];
#pragma unroll
            for (int j = 0; j < 8; ++j) mx[j] += w * vn[s2][j]; }
        float uf[8], gf[8]; unpack8(ur[tt], uf); unpack8(gr[tt], gf);
#pragma unroll
        for (int j = 0; j < 8; ++j) mx[j] = mx[j] * uf[j] * gf[j];
        *(u32x4*)(F.MIX + row * DM + 1536 + c0) = pack8(mx); }
}

#ifdef HYBRID
__device__ __forceinline__ void attn_task_o(const Frame& F, int l, int b, int nb, int head, int qs, LAS unsigned char* wl) {
    const int lane = F.lane, r = lane & 31, hh = lane >> 5, kvh = head >> 2;
    LAS float* wsf = (LAS float*)wl; LAS bf16_t* stg = (LAS bf16_t*)(wl + 256);
    const int t0 = 128 * nb + 32 * qs;
    const size_t qrow0 = (size_t)b * 2048 + t0;
    const bf16_t* qp = F.Qc + (qrow0 + r) * 1024 + head * 64 + 8 * hh;
    bf16x8 qf[4];
#pragma unroll
    for (int s = 0; s < 4; ++s) qf[s] = *(const bf16x8*)(qp + 16 * s);
    const bf16_t* kbase = F.Kc + (size_t)(b * 4 + kvh) * 2048 * 64;
    const bf16_t* vbase = F.VTP + (size_t)(b * 4 + kvh) * 64 * 2048;
    const int cmin = (nb > 0) ? 0 : (4 - qs);
    f32x16 S[5];
#pragma unroll
    for (int c = 0; c < 5; ++c) {
        f32x16 a;
#pragma unroll
        for (int i = 0; i < 16; ++i) a[i] = 0.f;
        if (c >= cmin) {
            const bf16_t* kp = kbase + (size_t)(t0 - 128 + 32 * c + r) * 64 + 8 * hh;
#pragma unroll
            for (int s = 0; s < 4; ++s) a = __builtin_amdgcn_mfma_f32_32x32x16_bf16(*(const bf16x8*)(kp + 16 * s), qf[s], a, 0, 0, 0);
        }
        S[c] = a;
    }
    const float NEG = -INFINITY;
#pragma unroll
    for (int i = 0; i < 16; ++i) { const int kap = crow(i, hh); if (kap <= r) S[0][i] = NEG; if (kap > r) S[4][i] = NEG; }
    const float sink2 = F.sinks[l * 16 + head] * LOG2E;
    float m = sink2;
#pragma unroll
    for (int c = 0; c < 5; ++c) if (c >= cmin) {
#pragma unroll
        for (int i = 0; i < 16; ++i) m = fmaxf(m, S[c][i]); }
    m = fmaxf(m, __shfl_xor(m, 32));
    float sum = 0.f;
#pragma unroll
    for (int c = 0; c < 5; ++c) if (c >= cmin) {
#pragma unroll
        for (int i = 0; i < 16; ++i) { const float p = __builtin_amdgcn_exp2f(S[c][i] - m); S[c][i] = p; sum += p; } }
    sum += __shfl_xor(sum, 32);
    const float inv = 1.0f / (sum + __builtin_amdgcn_exp2f(sink2 - m));
    f32x16 o[2];
#pragma unroll
    for (int i = 0; i < 16; ++i) { o[0][i] = 0.f; o[1][i] = 0.f; }
#pragma unroll
    for (int c = 0; c < 5; ++c) if (c >= cmin) {
        const bf16_t* vt = vbase + (size_t)((t0 - 128 + 32 * c) >> 5) * 2048 + r * 32 + 16 * hh;
#pragma unroll
        for (int s = 0; s < 2; ++s) {
            u32x4 pw; pw.x = pg8::cvt_pk_bf16(S[c][8 * s + 0], S[c][8 * s + 1]); pw.y = pg8::cvt_pk_bf16(S[c][8 * s + 2], S[c][8 * s + 3]);
            pw.z = pg8::cvt_pk_bf16(S[c][8 * s + 4], S[c][8 * s + 5]); pw.w = pg8::cvt_pk_bf16(S[c][8 * s + 6], S[c][8 * s + 7]);
            const bf16x8 pa = __builtin_bit_cast(bf16x8, pw);
#pragma unroll
            for (int db = 0; db < 2; ++db) o[db] = __builtin_amdgcn_mfma_f32_32x32x16_bf16(pa, *(const bf16x8*)(vt + db * 1024 + 8 * s), o[db], 0, 0, 0);
        }
    }
    if (hh == 0) wsf[r] = inv;
    LDS_WAIT();
#pragma unroll
    for (int i = 0; i < 16; ++i) { const int q = crow(i, hh); const float rl = wsf[q];
        stg[q * 64 + r] = (bf16_t)(pg8::cvt_pk_bf16(o[0][i] * rl, 0.f) & 0xffffu);
        stg[q * 64 + 32 + r] = (bf16_t)(pg8::cvt_pk_bf16(o[1][i] * rl, 0.f) & 0xffffu); }
    LDS_WAIT();
#pragma unroll
    for (int i = 0; i < 4; ++i) { const int row = i * 8 + (lane >> 3), ch = lane & 7;
        const u32x4 ov = *(const LAS u32x4*)(stg + row * 64 + ch * 8);
        const u32x4 gv = *(const u32x4*)(F.Z2 + (qrow0 + row) * ZW + Z_GA + head * 64 + ch * 8);
        float of[8], gf[8]; unpack8(ov, of); unpack8(gv, gf);
#pragma unroll
        for (int j = 0; j < 8; ++j) of[j] *= gf[j];
        *(u32x4*)(F.MIX + (qrow0 + row) * DM + head * 64 + ch * 8) = pack8(of); }
    LDS_WAIT();
}

template <bool SAMPLE>
__device__ __forceinline__ void pool_unit_o(const Frame& F, int l, int g, int tile) {
    const int lane = F.lane, r = lane & 31, hh = lane >> 5, w = 2 << g;
    const size_t row = (size_t)(SAMPLE ? MP : 0) + 32 * tile + r;
    const int t = SAMPLE ? (int)(row & 3) : (int)(row & 2047);
    const int bd = SAMPLE ? (int)((row - MP) >> 2) : 0;
    const float icnt = SAMPLE ? 1.0f / (float)w : 1.0f / (float)(w < t + 1 ? w : t + 1);
    bf16x8 bfr[8];
#pragma unroll
    for (int s = 0; s < 8; ++s) {
        const int c0 = 128 * g + 16 * s + 8 * hh;
        float sum[8], cur[8];
#pragma unroll
        for (int j = 0; j < 8; ++j) { sum[j] = 0.f; cur[j] = 0.f; }
        for (int i = 0; i < w; ++i) {
            float f[8];
            const int e = t - i;
            if (e >= 0) { unpack8(*(const u32x4*)(F.Z2 + (row - i) * ZW + Z_XB + c0), f); }
            else if (SAMPLE) { const float* sp = F.state_pool + (((size_t)l * 128 + bd) * 15 + 15 + e) * 512 + c0;
                const f32x4 a = *(const f32x4*)sp, bq = *(const f32x4*)(sp + 4); f[0] = a[0]; f[1] = a[1]; f[2] = a[2]; f[3] = a[3]; f[4] = bq[0]; f[5] = bq[1]; f[6] = bq[2]; f[7] = bq[3]; }
            else {
#pragma unroll
                for (int j = 0; j < 8; ++j) f[j] = 0.f; }
#pragma unroll
            for (int j = 0; j < 8; ++j) sum[j] += f[j];
            if (i == 0) {
#pragma unroll
                for (int j = 0; j < 8; ++j) cur[j] = f[j]; }
        }
        float pf[8];
#pragma unroll
        for (int j = 0; j < 8; ++j) pf[j] = sum[j] * icnt - cur[j];
        bfr[s] = __builtin_bit_cast(bf16x8, pack8(pf));
    }
    f32x16 acc[4];
#pragma unroll
    for (int db = 0; db < 4; ++db) {
#pragma unroll
        for (int i = 0; i < 16; ++i) acc[db][i] = 0.f;
        const bf16_t* ap = F.PWT + ((size_t)(l * 4 + g) * 128 + 32 * db + r) * 128 + 8 * hh;
#pragma unroll
        for (int s = 0; s < 8; ++s) acc[db] = __builtin_amdgcn_mfma_f32_32x32x16_bf16(*(const bf16x8*)(ap + 16 * s), bfr[s], acc[db], 0, 0, 0);
    }
#pragma unroll
    for (int db = 0; db < 4; ++db)
#pragma unroll
        for (int q = 0; q < 4; ++q) {
            const int col = 128 * g + 32 * db + 8 * q + 4 * hh;
            const f32x4 sc = *(const f32x4*)(F.pool_scale + l * 512 + col);
            float gf[4]; unpack4(*(const u32x2*)(F.Z2 + row * ZW + Z_GP + col), gf);
            u32x2 wv; wv.x = pg8::cvt_pk_bf16(acc[db][4 * q + 0] * sc[0] * gf[0], acc[db][4 * q + 1] * sc[1] * gf[1]);
            wv.y = pg8::cvt_pk_bf16(acc[db][4 * q + 2] * sc[2] * gf[2], acc[db][4 * q + 3] * sc[3] * gf[3]);
            *(u32x2*)(F.MIX + row * DM + 1024 + col) = wv;
        }
}

__device__ __forceinline__ void sgu_unit_o(const Frame& F, int l, int ci, int hd, LAS unsigned char* ring) {
    LAS bf16_t* VnT = (LAS bf16_t*)ring;
    const int lane = F.lane, wv = F.wave;
    const size_t R0 = (size_t)128 * ci;
    {
        const int tl = lane >> 2, q4 = lane & 3;
        const bf16_t* vrow = F.Z2 + (R0 + 16 * wv + tl) * ZW + Z_VS;
        float s = 0.f, ss = 0.f;
#pragma unroll
        for (int i = 0; i < 16; ++i) { float f[8]; unpack8(*(const u32x4*)(vrow + 128 * q4 + 8 * i), f);
#pragma unroll
            for (int j = 0; j < 8; ++j) { s += f[j]; ss += f[j] * f[j]; } }
        s += __shfl_xor(s, 1); s += __shfl_xor(s, 2); ss += __shfl_xor(ss, 1); ss += __shfl_xor(ss, 2);
        const float mean = s * (1.0f / 512.0f), var = ss * (1.0f / 512.0f) - mean * mean, rstd = rsqrtf(var + EPS);
#pragma unroll
        for (int i = 0; i < 4; ++i) { const int d = 32 * q4 + 8 * i; float f[8]; unpack8(*(const u32x4*)(vrow + 128 * hd + d), f);
            const float* gp = F.ln_g + l * 512 + 128 * hd + d; const float* bp = F.ln_b + l * 512 + 128 * hd + d;
#pragma unroll
            for (int j = 0; j < 8; ++j) { const float vn = (f[j] - mean) * rstd * gp[j] + bp[j];
                VnT[(d + j) * 136 + 16 * wv + tl] = (bf16_t)(pg8::cvt_pk_bf16(vn, 0.f) & 0xffffu); } }
    }
    __syncthreads();
    {
        const int r = lane & 31, hh = lane >> 5, db = wv & 3; const int tbA = (wv >> 2) ? 1 : 0, tbB = (wv >> 2) ? 2 : 3;
        f32x16 accA, accB;
#pragma unroll
        for (int i = 0; i < 16; ++i) { accA[i] = 0.f; accB[i] = 0.f; }
        const bf16_t* Wb = F.SGUW + (size_t)(l * 4 + hd) * 128 * 128;
#pragma unroll
        for (int s = 0; s < 8; ++s) {
            if (s < 2 * (tbB + 1)) {
                const bf16x8 a = *(const LAS bf16x8*)(VnT + (32 * db + r) * 136 + 16 * s + 8 * hh);
                accB = __builtin_amdgcn_mfma_f32_32x32x16_bf16(a, *(const bf16x8*)(Wb + (32 * tbB + r) * 128 + 16 * s + 8 * hh), accB, 0, 0, 0);
                if (s < 2 * (tbA + 1)) accA = __builtin_amdgcn_mfma_f32_32x32x16_bf16(a, *(const bf16x8*)(Wb + (32 * tbA + r) * 128 + 16 * s + 8 * hh), accA, 0, 0, 0);
            }
        }
#pragma unroll
        for (int pass = 0; pass < 2; ++pass) {
            const int tb = pass ? tbB : tbA; const f32x16 acc = pass ? accB : accA;
            const int t = 32 * tb + r; const size_t row = R0 + t; const float bias = F.sgu_b[l * 512 + hd * 128 + t];
#pragma unroll
            for (int q = 0; q < 4; ++q) { const int col = 128 * hd + 32 * db + 8 * q + 4 * hh;
                float uf[4], gf[4]; unpack4(*(const u32x2*)(F.Z2 + row * ZW + Z_U + col), uf); unpack4(*(const u32x2*)(F.Z2 + row * ZW + Z_GS + col), gf);
                u32x2 wo; wo.x = pg8::cvt_pk_bf16((acc[4 * q + 0] + bias) * uf[0] * gf[0], (acc[4 * q + 1] + bias) * uf[1] * gf[1]);
                wo.y = pg8::cvt_pk_bf16((acc[4 * q + 2] + bias) * uf[2] * gf[2], (acc[4 * q + 3] + bias) * uf[3] * gf[3]);
                *(u32x2*)(F.MIX + row * DM + 1536 + col) = wo; }
        }
    }
    __syncthreads();
}

__device__ __forceinline__ void samp_attn_o(const Frame& F, int l, int bd, int kvh, LAS unsigned char* wl) {
    LAS float* qs = (LAS float*)wl;
    LAS float* ps = (LAS float*)(wl + 4096);
    const int lane = F.lane;
    float* oKs = F.out + O_KS + (size_t)l * LS_KS; float* oVs = F.out + O_VS + (size_t)l * LS_KS;
    {
        const int qi = lane >> 2, part = lane & 3, gq = qi >> 2, tt = qi & 3;
        const bf16_t* src = F.Qc + ((size_t)MP + 4 * bd + tt) * 1024 + (4 * kvh + gq) * 64 + 16 * part;
        float f0[8], f1[8]; unpack8(*(const u32x4*)src, f0); unpack8(*(const u32x4*)(src + 8), f1);
#pragma unroll
        for (int j = 0; j < 8; ++j) { const int p0 = 16 * part + j, p1 = p0 + 8;
            qs[qi * 64 + (p0 >> 1) + 32 * (p0 & 1)] = f0[j]; qs[qi * 64 + (p1 >> 1) + 32 * (p1 & 1)] = f1[j]; }
    }
    LDS_WAIT();
    float s0[16], s1[16], s2[16];
#pragma unroll
    for (int q = 0; q < 16; ++q) { s0[q] = 0.f; s1[q] = 0.f; s2[q] = 0.f; }
    const float* k0p = F.cache_k + (((size_t)l * 128 + bd) * 128 + lane) * 256 + kvh * 64;
    const float* k1p = k0p + 64 * 256;
    const float* k2p = oKs + (((size_t)bd * 128 + 124 + (lane & 3)) * 4 + kvh) * 64;
    float* c0p = oKs + (((size_t)bd * 128 + (lane >= 4 ? lane - 4 : 0)) * 4 + kvh) * 64;
    float* c1p = oKs + (((size_t)bd * 128 + lane + 60) * 4 + kvh) * 64;
    for (int ch = 0; ch < 16; ++ch) {
        const f32x4 kx0 = *(const f32x4*)(k0p + 4 * ch), kx1 = *(const f32x4*)(k1p + 4 * ch), kx2 = *(const f32x4*)(k2p + 4 * ch);
        if (lane >= 4) *(f32x4*)(c0p + 4 * ch) = kx0;
        *(f32x4*)(c1p + 4 * ch) = kx1;
#pragma unroll
        for (int q = 0; q < 16; ++q) { const f32x4 qv = *(const LAS f32x4*)(qs + q * 64 + 4 * ch);
            s0[q] += (qv[0] * kx0[0] + qv[1] * kx0[1]) + (qv[2] * kx0[2] + qv[3] * kx0[3]);
            s1[q] += (qv[0] * kx1[0] + qv[1] * kx1[1]) + (qv[2] * kx1[2] + qv[3] * kx1[3]);
            s2[q] += (qv[0] * kx2[0] + qv[1] * kx2[1]) + (qv[2] * kx2[2] + qv[3] * kx2[3]); }
    }
    float inv[16];
#pragma unroll
    for (int q = 0; q < 16; ++q) {
        const int tt = q & 3; const float sink2 = F.sinks[l * 16 + 4 * kvh + (q >> 2)] * LOG2E;
        const bool v0 = lane >= tt + 1, v2 = (lane < 4) && (lane <= tt);
        float m = s1[q]; if (v0) m = fmaxf(m, s0[q]); if (v2) m = fmaxf(m, s2[q]);
        m = fmaxf(wave_max(m), sink2);
        const float p0 = v0 ? __builtin_amdgcn_exp2f(s0[q] - m) : 0.f, p1 = __builtin_amdgcn_exp2f(s1[q] - m), p2 = v2 ? __builtin_amdgcn_exp2f(s2[q] - m) : 0.f;
        const float sum = wave_sum(p0 + p1 + p2);
        inv[q] = 1.0f / (sum + __builtin_amdgcn_exp2f(sink2 - m));
        ps[lane * 16 + q] = p0; ps[(lane + 64) * 16 + q] = p1; if (lane < 4) ps[(128 + lane) * 16 + q] = p2;
    }
    LDS_WAIT();
    float o[16];
#pragma unroll
    for (int q = 0; q < 16; ++q) o[q] = 0.f;
    const float* vcp = F.cache_v + (((size_t)l * 128 + bd) * 128) * 256 + kvh * 64 + lane;
    float* vop = oVs + ((size_t)bd * 128) * 256 + kvh * 64 + lane;
    for (int key = 0; key < 132; ++key) {
        float v;
        if (key < 128) { v = vcp[(size_t)key * 256]; if (key >= 4) vop[(size_t)(key - 4) * 256] = v; }
        else v = vop[(size_t)(key - 4) * 256];
#pragma unroll
        for (int q4 = 0; q4 < 4; ++q4) { const f32x4 pv = *(const LAS f32x4*)(ps + key * 16 + 4 * q4);
            o[4 * q4 + 0] += pv[0] * v; o[4 * q4 + 1] += pv[1] * v; o[4 * q4 + 2] += pv[2] * v; o[4 * q4 + 3] += pv[3] * v; }
    }
#pragma unroll
    for (int q = 0; q < 16; ++q) { const int tt = q & 3, head = 4 * kvh + (q >> 2); const size_t row = (size_t)MP + 4 * bd + tt;
        const float gv = __uint_as_float(((unsigned)F.Z2[row * ZW + Z_GA + head * 64 + lane]) << 16);
        F.MIX[row * DM + head * 64 + lane] = (bf16_t)(pg8::cvt_pk_bf16(o[q] * inv[q] * gv, 0.f) & 0xffffu); }
    LDS_WAIT();
}
__device__ __forceinline__ void samp_sgu_o(const Frame& F, int l, int bd) {
    const int lane = F.lane, c0 = 8 * lane, hd = lane >> 4;
    float* oCV = F.out + O_CV + (size_t)l * LS_CV;
    float gl[8], bl[8];
#pragma unroll
    for (int j = 0; j < 8; ++j) { gl[j] = F.ln_g[l * 512 + c0 + j]; bl[j] = F.ln_b[l * 512 + c0 + j]; }
    float vn[4][8];
#pragma unroll
    for (int tt = 0; tt < 4; ++tt) { const size_t row = (size_t)MP + 4 * bd + tt; float f[8]; unpack8(*(const u32x4*)(F.Z2 + row * ZW + Z_VS + c0), f);
        float s = 0.f, ss = 0.f;
#pragma unroll
        for (int j = 0; j < 8; ++j) { s += f[j]; ss += f[j] * f[j]; }
        s = wave_sum(s); ss = wave_sum(ss);
        const float mean = s * (1.0f / 512.0f), var = ss * (1.0f / 512.0f) - mean * mean, rstd = rsqrtf(var + EPS);
#pragma unroll
        for (int j = 0; j < 8; ++j) vn[tt][j] = (f[j] - mean) * rstd * gl[j] + bl[j];
        float* o = oCV + ((size_t)bd * 4 + tt) * 512 + c0;
        *(f32x4*)o = (f32x4){vn[tt][0], vn[tt][1], vn[tt][2], vn[tt][3]}; *(f32x4*)(o + 4) = (f32x4){vn[tt][4], vn[tt][5], vn[tt][6], vn[tt][7]}; }
#pragma unroll
    for (int tt = 0; tt < 4; ++tt) { const size_t row = (size_t)MP + 4 * bd + tt;
        float mx[8]; const float bias = F.sgu_b[l * 512 + hd * 128 + tt];
#pragma unroll
        for (int j = 0; j < 8; ++j) mx[j] = bias;
#pragma unroll
        for (int s2 = 0; s2 < 4; ++s2) if (s2 <= tt) { const float w = F.sgu_w[((size_t)(l * 4 + hd) * 128 + tt) * 128 + s2];
#pragma unroll
            for (int j = 0; j < 8; ++j) mx[j] += w * vn[s2][j]; }
        float uf[8], gf[8]; unpack8(*(const u32x4*)(F.Z2 + row * ZW + Z_U + c0), uf); unpack8(*(const u32x4*)(F.Z2 + row * ZW + Z_GS + c0), gf);
#pragma unroll
        for (int j = 0; j < 8; ++j) mx[j] = mx[j] * uf[j] * gf[j];
        *(u32x4*)(F.MIX + row * DM + 1536 + c0) = pack8(mx); }
}

#endif
__device__ __forceinline__ void norm_row(const Frame& F, int l, int row) {
    const int lane = F.lane;
    const bf16_t* yr = F.Yb + (size_t)row * DM + 8 * lane;
    const float* xr = ((l == 0) ? (row < MP ? F.xp + (size_t)row * DM : F.xs + (size_t)(row - MP) * DM) : F.out + (size_t)row * DM) + 8 * lane;
    float* orow = F.out + (size_t)row * DM + 8 * lane;
    const float* pg = F.norm_post + l * DM + 8 * lane; const float* g1 = F.norm_pre + DM + 8 * lane;
    u32x4 yv[4]; f32x4 xv[4][2];
#pragma unroll
    for (int j = 0; j < 4; ++j) { yv[j] = *(const u32x4*)(yr + 512 * j); xv[j][0] = *(const f32x4*)(xr + 512 * j); xv[j][1] = *(const f32x4*)(xr + 512 * j + 4); }
    float y[4][8]; float ss = 0.f;
#pragma unroll
    for (int j = 0; j < 4; ++j) { unpack8(yv[j], y[j]);
#pragma unroll
        for (int e = 0; e < 8; ++e) ss += y[j][e] * y[j][e]; }
    ss = wave_sum(ss);
    const float ry = rsqrtf(ss * (1.0f / 2048.0f) + EPS);
    float s1 = 0.f;
#pragma unroll
    for (int j = 0; j < 4; ++j) { const f32x4 ga = *(const f32x4*)(pg + 512 * j), gb = *(const f32x4*)(pg + 512 * j + 4);
#pragma unroll
        for (int e = 0; e < 4; ++e) { y[j][e] = xv[j][0][e] + y[j][e] * ry * ga[e]; y[j][4 + e] = xv[j][1][e] + y[j][4 + e] * ry * gb[e]; }
        *(f32x4*)(orow + 512 * j) = (f32x4){y[j][0], y[j][1], y[j][2], y[j][3]}; *(f32x4*)(orow + 512 * j + 4) = (f32x4){y[j][4], y[j][5], y[j][6], y[j][7]};
#pragma unroll
        for (int e = 0; e < 8; ++e) s1 += y[j][e] * y[j][e]; }
    if (l == 0) {
        s1 = wave_sum(s1);
        const float r1 = rsqrtf(s1 * (1.0f / 2048.0f) + EPS);
        bf16_t* hrow = F.H + (size_t)row * DM + 8 * lane;
#pragma unroll
        for (int j = 0; j < 4; ++j) { const f32x4 ga = *(const f32x4*)(g1 + 512 * j), gb = *(const f32x4*)(g1 + 512 * j + 4); float o[8];
#pragma unroll
            for (int e = 0; e < 4; ++e) { o[e] = y[j][e] * r1 * ga[e]; o[4 + e] = y[j][4 + e] * r1 * gb[e]; }
            *(u32x4*)(hrow + 512 * j) = pack8(o); }
    }
}
__device__ __forceinline__ void norm_rows4(int l, int row0) { LOCAL_FRAME;
#pragma unroll 1
    for (int k = 0; k < 4; ++k) norm_row(F, l, row0 + k); }

constexpr int Q2_G = 40, Q2_AT = Q2_G + 256, Q2_SG = Q2_AT + 256, Q2_SA = Q2_SG + 64, Q2_SS = Q2_SA + 16, Q2_SP = Q2_SS + 8, Q2_PO = Q2_SP + 256;
__device__ __forceinline__ void slot2(int l, LAS unsigned char* L, LAS unsigned char* ring) {
    int t_ = threadIdx.x; asm volatile("" : "+v"(t_)); const int wave = __builtin_amdgcn_readfirstlane(t_ >> 6);
    unsigned* head = ctl_word(CW_Q + 64 * (2 * l));
    EV_T0();
#pragma unroll 1
    for (;;) {
        const int it = q_pop(head, L);
        if (it >= Q2_PO) { if (l == 0) { EV_MAX(0); EV_MIN(1); } break; }
        if (it < Q2_G) {
            unsigned char* ws = (unsigned char*)kargs()->ws;
            pg8::Gemm g{(const bf16_t*)(ws + WS_H), (const bf16_t*)(ws + WS_WTIN) + (size_t)l * DIN * DM, MT, DIN, DM};
            OneUnit S; S.u.pm = 64 + it / 20; S.u.pn = it % 20;
            pg8::EpiIn E{l};
            pg8::gemm_phase<pg8::EpiIn, OneUnit, false, true>(ring, g, S, E);
            publish(ctl_word(CW_ZS + 64 * (2 * l + it / 20)));
            if (l == 0) { EV_MAX(2); EV_MIN(3); }
        }
        else if (it < Q2_AT) { attn_unit(l, it - Q2_G, ring); if (l == 0) EV_MAX(4); }
        else if (it < Q2_SG) { const int u = it - Q2_AT; sgu_unit(l, u >> 1, u & 1, ring); if (l == 0) EV_MAX(5); }
        else if (it < Q2_SA) { const int i = it - Q2_SG; dep_wait(ctl_word(CW_ZS + 64 * (2 * l + (i >> 5))), 20u); if (l == 0) EV_MIN(6); const int k = 8 * i + wave; samp_attn(l, k >> 2, k & 3, ring + wave * 9472); __syncthreads(); if (l == 0) EV_MAX(7); }
        else if (it < Q2_SS) { const int i = it - Q2_SA; dep_wait(ctl_word(CW_ZS + 64 * (2 * l + (i >> 3))), 20u); samp_sgu(l, 8 * i + wave); }
        else if (it < Q2_SP) { const int i = it - Q2_SS; dep_wait(ctl_word(CW_ZS + 64 * (2 * l + (i >> 2))), 20u); const int k = 8 * i + wave; pool_sample(l, k & 3, k >> 2); }
        else { const int i = 8 * (it - Q2_SP) + wave; pool_prompt(l, i & 3, i >> 2, ring + wave * PL_WBYTES); }
    }
}
constexpr int Q4_G = 16, Q4_P = Q4_G + 512, Q4_S = Q4_P + 16;
__device__ __forceinline__ void slot4(int l, LAS unsigned char* L, LAS unsigned char* ring) {
    int t_ = threadIdx.x; asm volatile("" : "+v"(t_)); const int wave = __builtin_amdgcn_readfirstlane(t_ >> 6);
    unsigned* head = ctl_word(CW_Q + 64 * (2 * l + 1));
#pragma unroll 1
    for (;;) {
        const int it = q_pop(head, L);
        if (it >= Q4_S) break;
        if (it < Q4_G) {
            unsigned char* ws = (unsigned char*)kargs()->ws;
            pg8::Gemm g{(const bf16_t*)(ws + WS_MIX), (const bf16_t*)(ws + WS_WTOUT) + (size_t)l * DM * DM, MT, DM, DM};
            OneUnit S; S.u.pm = 64 + it / 8; S.u.pn = it % 8;
            pg8::EpiOut E{};
            pg8::gemm_phase<pg8::EpiOut, OneUnit, false, true>(ring, g, S, E);
            publish(ctl_word(CW_YS + 64 * (2 * l + it / 8)));
        }
        else if (it < Q4_P) norm_rows4(l, 32 * (it - Q4_G) + 4 * wave);
        else { const int i = it - Q4_P; dep_wait(ctl_word(CW_YS + 64 * (2 * l + (i >> 3))), 8u); norm_rows4(l, MP + 32 * i + 4 * wave); }
    }
}

__global__ void __launch_bounds__(NTHREADS, 2) hymba_fwd(Args a_unused) {
    extern __shared__ __attribute__((aligned(16))) unsigned char lds[];
    LAS unsigned char* L = (LAS unsigned char*)lds;
    if (threadIdx.x < 256) ((LAS unsigned*)L)[threadIdx.x] = 0u;
    __syncthreads();
    XcdBarrier bar = xcd_barrier_post((unsigned*)((unsigned char*)kargs()->ws + WS_CTL) + CW_BAR, (volatile LAS unsigned*)L + 8);
    LAS unsigned char* ring = L + RING_OFF;
    STAMP(0);
#ifndef NO_P0
    { Frame F; make_frame(F, kargs()); p0_prologue(F, ring); }
#endif
    xcd_barrier(bar);
    STAMP(1);
#pragma unroll 1
    for (int l = 0; l < 2; ++l) {
#ifndef NO_P1
        {
            KArgs ka = kargs(); unsigned char* ws = (unsigned char*)ka->ws;
            pg8::Gemm g{(const bf16_t*)(ws + WS_H), (const bf16_t*)(ws + WS_WTIN) + (size_t)l * DIN * DM, MP, DIN, DM}; pg8::StaticOrder S; S.init(MP, DIN, (int)gridDim.x, (int)blockIdx.x);
            pg8::EpiIn E{l};
            pg8::gemm_phase<pg8::EpiIn, pg8::StaticOrder, true, true>(ring, g, S, E);
        }
#endif
        xcd_barrier(bar);
        STAMP(2 + 4 * l);
#ifndef NO_P2
        slot2(l, L, ring);
#endif
        xcd_barrier(bar);
        STAMP(3 + 4 * l);
#ifndef NO_P3
        {
            KArgs ka = kargs(); unsigned char* ws = (unsigned char*)ka->ws;
            pg8::Gemm g{(const bf16_t*)(ws + WS_MIX), (const bf16_t*)(ws + WS_WTOUT) + (size_t)l * DM * DM, MP, DM, DM}; pg8::StaticOrder S; S.init(MP, DM, (int)gridDim.x, (int)blockIdx.x);
            pg8::EpiOut E{};
            pg8::gemm_phase<pg8::EpiOut, pg8::StaticOrder, true, true>(ring, g, S, E);
        }
#endif
        xcd_barrier(bar);
        STAMP(4 + 4 * l);
#ifndef NO_P4
        slot4(l, L, ring);
#endif
        if (l == 0) xcd_barrier(bar);
#if PROBE_SEL
        if (l == 1) __syncthreads();
#endif
        STAMP(5 + 4 * l);
    }
#if PROBE_SEL
    if (blockIdx.x == 0 && threadIdx.x == 0) {
#if PROBE_SEL >= 10
        unsigned ea = __hip_atomic_load(ctl_word(CW_EV + 64 * PEA), __ATOMIC_RELAXED, __HIP_MEMORY_SCOPE_AGENT), eb = __hip_atomic_load(ctl_word(CW_EV + 64 * PEB), __ATOMIC_RELAXED, __HIP_MEMORY_SCOPE_AGENT);
        if (PEA_MIN) ea = 0x40000000u - ea; if (PEB_MIN) eb = 0x40000000u - eb;
        unsigned long long da = (ea + 400) / 800, db = (eb + 400) / 800;
#else
        LAS unsigned long long* ts = (LAS unsigned long long*)(L + 256);
        unsigned long long da = (ts[PA1] - ts[PA0] + 400) / 800, db = (ts[PB1] - ts[PB0] + 400) / 800;
#endif
        if (da > 63) da = 63; if (db > 63) db = 63;
        const unsigned long long extra = (da + 64 * db) * 1600ull, t0 = __builtin_amdgcn_s_memrealtime();
        while (__builtin_amdgcn_s_memrealtime() - t0 < extra) __builtin_amdgcn_s_sleep(32);
    }
#endif
}

extern "C" void kernel_launch(void* const* d_in, const int* in_sizes, int n_in, void* d_out, int out_size, void* d_ws, size_t ws_size, hipStream_t stream) {
    static int grid = 0;
    if (grid == 0) {
        if (n_in != 16 || (size_t)out_size != O_END || ws_size < WS_END) { fprintf(stderr, "kernel_launch: unexpected shapes: n_in %d out %d ws %zu (need %zu)\n", n_in, out_size, ws_size, (size_t)WS_END); grid = -1; return; }
        int dev = 0, cus = 0, per_cu = 0;
        if (hipGetDevice(&dev) != hipSuccess || hipDeviceGetAttribute(&cus, hipDeviceAttributeMultiprocessorCount, dev) != hipSuccess) { fprintf(stderr, "kernel_launch: device query failed\n"); grid = -1; return; }
        if (hipFuncSetAttribute((const void*)hymba_fwd, hipFuncAttributeMaxDynamicSharedMemorySize, LDS_BYTES) != hipSuccess) { fprintf(stderr, "kernel_launch: hipFuncSetAttribute failed\n"); grid = -1; return; }
        if (hipOccupancyMaxActiveBlocksPerMultiprocessor(&per_cu, (const void*)hymba_fwd, NTHREADS, LDS_BYTES) != hipSuccess || per_cu < 1) { fprintf(stderr, "kernel_launch: occupancy query says %d blocks/CU\n", per_cu); (void)hipGetLastError(); grid = -1; return; }
        grid = cus;
    }
    if (grid < 0) return;
    (void)hipMemsetAsync((char*)d_ws + WS_CTL, 0, CTL_ZERO_BYTES, stream);
    Args a{};
    for (int i = 0; i < 16; ++i) a.in[i] = (const float*)d_in[i];
    a.out = (float*)d_out; a.ws = (unsigned char*)d_ws;
    void* params[] = {&a};
    hipError_t e = hipLaunchCooperativeKernel((const void*)hymba_fwd, dim3(grid), dim3(NTHREADS), params, LDS_BYTES, stream);
    if (e != hipSuccess) fprintf(stderr, "kernel_launch: cooperative launch failed: %s (grid %d)\n", hipGetErrorString(e), grid);
}
```

```cpp
#include <hip/hip_runtime.h>
#include <cstdio>
#include <cstdint>
#include <cmath>
namespace pg8 {
#define PG8_LAS __attribute__((address_space(3)))
typedef unsigned short bf16_t;
typedef short bf16x8 __attribute__((ext_vector_type(8)));
typedef float f32x4 __attribute__((ext_vector_type(4)));
typedef unsigned u32x4 __attribute__((ext_vector_type(4)));
constexpr int BM = 256, BK = 64, HALF = 128, HTB = HALF * BK * 2  , STAGE_BYTES = 8 * HTB, NXCD = 8, WGM = 8;

__host__ __device__ __forceinline__ int lds_byte(int r, int c) { const int st = (r >> 4) * 2 + (c >> 5), rr = r & 15, cc = c & 31, ob = rr * 64 + cc * 2; return st * 1024 + (ob ^ (((ob >> 9) & 1) << 5)); }
__host__ __device__ __forceinline__ void stage_rc(int b, int& R, int& C) { const int st = b / 1024, sb = b % 1024, swz = sb ^ (((sb >> 9) & 1) << 5); R = (st >> 1) * 16 + swz / 64; C = (st & 1) * 32 + (swz % 64) / 2; }
__host__ __device__ __forceinline__ int perm32(int rho) { const int n = rho >> 4, i = rho & 15; return 8 * (i >> 2) + 4 * n + (i & 3); }

struct Unit { int pm, pn; };
struct Gemm { const bf16_t* A; const bf16_t* Bt; int M, N, K; };

struct StaticOrder {
    int nM, nN, nwg, G, c;
    __host__ __device__ void init(int M, int N, int G_, int c_) { nM = M / BM; nN = N / BM; nwg = nM * nN; G = G_; c = c_; }
    __host__ __device__ bool next(int i, Unit& u) const {
        const long L = (long)i * G + c; if (L >= nwg) return false;
        int wgid = (int)L; { const int q = nwg / NXCD, r = nwg % NXCD, xcd = wgid % NXCD, off = wgid / NXCD; wgid = (xcd < r ? xcd * (q + 1) : r * (q + 1) + (xcd - r) * q) + off; }
        const int nig = WGM * nN, gid = wgid / nig, fm = gid * WGM, gsz = (nM - fm) < WGM ? (nM - fm) : WGM;
        u.pm = fm + ((wgid % nig) % gsz); u.pn = (wgid % nig) / gsz; return true;
    }
    __device__ __forceinline__ void a_ready(const Unit&) const {}
    __device__ __forceinline__ void done(const Unit&) const {}
};

constexpr int DM = 2048, MP = 16384, MS = 512, MT = MP + MS, DIN = 5120;
constexpr int ZW = 3584;
constexpr int Z_GA = 0, Z_XB = 1024, Z_GP = 1536, Z_U = 2048, Z_VS = 2560, Z_GS = 3072;
constexpr float LOG2E = 1.4426950408889634f, QSCALE = 0.125f * LOG2E, EPS = 1e-6f;

__device__ __forceinline__ unsigned cvt_pk_bf16(float lo, float hi) { unsigned r; asm("v_cvt_pk_bf16_f32 %0, %1, %2" : "=v"(r) : "v"(lo), "v"(hi)); return r; }
__device__ __forceinline__ float silu_f(float x) { return x * __builtin_amdgcn_rcpf(1.0f + __builtin_amdgcn_exp2f(-x * LOG2E)); }
__device__ __forceinline__ int vperm32(int x) { return ((x >> 2) & 1) * 16 + (x >> 3) * 4 + (x & 3); }

struct EpiPtrs { const __attribute__((address_space(1))) float* in[16]; __attribute__((address_space(1))) float* out; __attribute__((address_space(1))) unsigned char* ws; };
constexpr size_t EP_ROPE = (size_t)1 << 20, EP_QC = (size_t)192 << 20, EP_KC = (size_t)225 << 20, EP_VTP = (size_t)233 << 20, EP_Z2 = (size_t)241 << 20, EP_Y = (size_t)357 << 20;
constexpr size_t EO_KP = 34603008, EO_VP = 35127296, EO_PP = 35651584, EO_KS = 35774464, EO_VS = 44163072, EO_PS = 52551680;
struct EpiIn {
    static constexpr bool PERM = true, AFTER_DRAIN = false;
    int l;
    __device__ __forceinline__ void operator()(const f32x4 (&acc)[2][2][4][2], const Unit& u, int wr, int wc, int fr, int fq) const {
        const __attribute__((address_space(4))) EpiPtrs* kp = (const __attribute__((address_space(4))) EpiPtrs*)__builtin_amdgcn_kernarg_segment_ptr(); asm volatile("" : "+s"(kp));
        unsigned char* ws = (unsigned char*)kp->ws; float* outp = (float*)kp->out;
        bf16_t* Qc = (bf16_t*)(ws + EP_QC); bf16_t* Kc = (bf16_t*)(ws + EP_KC); bf16_t* VTP = (bf16_t*)(ws + EP_VTP); bf16_t* Z2 = (bf16_t*)(ws + EP_Z2); const float* rope = (const float*)(ws + EP_ROPE);
        float* oKp = outp + EO_KP + (size_t)l * 262144; float* oVp = outp + EO_VP + (size_t)l * 262144; float* oPp = outp + EO_PP + (size_t)l * 61440;
        float* oKs = outp + EO_KS + (size_t)l * 4194304; float* oVs = outp + EO_VS + (size_t)l * 4194304; float* oPs = outp + EO_PS + (size_t)l * 983040;
        const int pn = u.pn;
        const int row0 = u.pm * 256 + wr * 64 + fr;
        const int cw = wc * 32 + 8 * fq;
        if (pn < 5) {
#pragma unroll
            for (int ai = 0; ai < 2; ++ai)
#pragma unroll
                for (int m = 0; m < 4; ++m) {
                    const int row = row0 + ai * 128 + m * 16;
                    const bool smp = row >= MP;
                    const int tpos = smp ? 2048 + (row & 3) : (row & 2047);
                    const float* rp = rope + tpos * 64;
#pragma unroll
                    for (int bj = 0; bj < 2; ++bj) {
                        const int c = pn * 256 + bj * 128 + cw;
                        const int i0 = (c & 63) >> 1;
                        const f32x4 cs = *(const f32x4*)(rp + i0), sn = *(const f32x4*)(rp + 32 + i0);
                        const f32x4 v0 = acc[ai][bj][m][0], v1 = acc[ai][bj][m][1];
                        f32x4 o1, o2;
                        o1[0] = v0[0] * cs[0] - v0[1] * sn[0]; o2[0] = v0[1] * cs[0] + v0[0] * sn[0];
                        o1[1] = v0[2] * cs[1] - v0[3] * sn[1]; o2[1] = v0[3] * cs[1] + v0[2] * sn[1];
                        o1[2] = v1[0] * cs[2] - v1[1] * sn[2]; o2[2] = v1[1] * cs[2] + v1[0] * sn[2];
                        o1[3] = v1[2] * cs[3] - v1[3] * sn[3]; o2[3] = v1[3] * cs[3] + v1[2] * sn[3];
                        if (pn < 4) {
                            o1 = o1 * QSCALE; o2 = o2 * QSCALE;
                            u32x4 w; w.x = cvt_pk_bf16(o1[0], o2[0]); w.y = cvt_pk_bf16(o1[1], o2[1]); w.z = cvt_pk_bf16(o1[2], o2[2]); w.w = cvt_pk_bf16(o1[3], o2[3]);
                            *(u32x4*)(Qc + (size_t)row * 1024 + c) = w;
                        } else {
                            const int kvh = (c - 1024) >> 6;
                            if (!smp) {
                                const int b = row >> 11, t = row & 2047;
                                u32x4 w; w.x = cvt_pk_bf16(o1[0], o2[0]); w.y = cvt_pk_bf16(o1[1], o2[1]); w.z = cvt_pk_bf16(o1[2], o2[2]); w.w = cvt_pk_bf16(o1[3], o2[3]);
                                *(u32x4*)(Kc + ((size_t)((b * 4 + kvh) * 2048 + t)) * 64 + (c & 63)) = w;
                                if (t >= 1920) { float* o = oKp + ((size_t)((b * 128 + t - 1920) * 4 + kvh)) * 64 + i0; *(f32x4*)o = o1; *(f32x4*)(o + 32) = o2; }
                            } else {
                                const int bd = (row - MP) >> 2, tt = row & 3;
                                float* o = oKs + ((size_t)((bd * 128 + 124 + tt) * 4 + kvh)) * 64 + i0; *(f32x4*)o = o1; *(f32x4*)(o + 32) = o2;
                            }
                        }
                    }
                }
        } else if (pn == 5) {
#pragma unroll
            for (int ai = 0; ai < 2; ++ai)
#pragma unroll
                for (int m = 0; m < 4; ++m) {
                    const int row = row0 + ai * 128 + m * 16;
                    const bool smp = row >= MP;
#pragma unroll
                    for (int bj = 0; bj < 2; ++bj) {
                        const int cv = bj * 128 + cw;
                        const int kvh = cv >> 6, d0 = cv & 63;
                        const f32x4 v0 = acc[ai][bj][m][0], v1 = acc[ai][bj][m][1];
                        if (!smp) {
                            const int b = row >> 11, t = row & 2047;
                            bf16_t* vp = VTP + ((size_t)((b * 4 + kvh) * 64 + (t >> 5))) * 2048 + d0 * 32 + vperm32(t & 31);
                            const unsigned w0 = cvt_pk_bf16(v0[0], v0[1]), w1 = cvt_pk_bf16(v0[2], v0[3]), w2 = cvt_pk_bf16(v1[0], v1[1]), w3 = cvt_pk_bf16(v1[2], v1[3]);
                            vp[0] = (bf16_t)(w0 & 0xffffu); vp[32] = (bf16_t)(w0 >> 16); vp[64] = (bf16_t)(w1 & 0xffffu); vp[96] = (bf16_t)(w1 >> 16);
                            vp[128] = (bf16_t)(w2 & 0xffffu); vp[160] = (bf16_t)(w2 >> 16); vp[192] = (bf16_t)(w3 & 0xffffu); vp[224] = (bf16_t)(w3 >> 16);
                            if (t >= 1920) { float* o = oVp + ((size_t)((b * 128 + t - 1920) * 4 + kvh)) * 64 + d0; *(f32x4*)o = v0; *(f32x4*)(o + 4) = v1; }
                        } else {
                            const int bd = (row - MP) >> 2, tt = row & 3;
                            float* o = oVs + ((size_t)((bd * 128 + 124 + tt) * 4 + kvh)) * 64 + d0; *(f32x4*)o = v0; *(f32x4*)(o + 4) = v1;
                        }
                    }
                }
        } else {
            const bool gate = (pn < 10) || (pn == 12) || (pn == 13) || (pn >= 18);
            const bool isxb = (pn == 10) || (pn == 11);
#pragma unroll
            for (int ai = 0; ai < 2; ++ai)
#pragma unroll
                for (int m = 0; m < 4; ++m) {
                    const int row = row0 + ai * 128 + m * 16;
                    const bool smp = row >= MP;
#pragma unroll
                    for (int bj = 0; bj < 2; ++bj) {
                        const int c = pn * 256 + bj * 128 + cw;
                        f32x4 v0 = acc[ai][bj][m][0], v1 = acc[ai][bj][m][1];
                        if (isxb) {
                            const int cx = c - 2560;
                            if (!smp) { const int t = row & 2047; if (t >= 2033) { const int b = row >> 11; float* o = oPp + ((size_t)(b * 15 + t - 2033)) * 512 + cx; *(f32x4*)o = v0; *(f32x4*)(o + 4) = v1; } }
                            else { const int bd = (row - MP) >> 2, tt = row & 3; float* o = oPs + ((size_t)(bd * 15 + 11 + tt)) * 512 + cx; *(f32x4*)o = v0; *(f32x4*)(o + 4) = v1; }
                        }
                        if (gate) {
#pragma unroll
                            for (int j = 0; j < 4; ++j) { v0[j] = silu_f(v0[j]); v1[j] = silu_f(v1[j]); }
                        }
                        u32x4 w; w.x = cvt_pk_bf16(v0[0], v0[1]); w.y = cvt_pk_bf16(v0[2], v0[3]); w.z = cvt_pk_bf16(v1[0], v1[1]); w.w = cvt_pk_bf16(v1[2], v1[3]);
                        *(u32x4*)(Z2 + (size_t)row * ZW + (c - 1536)) = w;
                    }
                }
        }
    }
};

struct EpiOut {
    static constexpr bool PERM = true, AFTER_DRAIN = false;
    __device__ __forceinline__ void operator()(const f32x4 (&acc)[2][2][4][2], const Unit& u, int wr, int wc, int fr, int fq) const {
        const __attribute__((address_space(4))) EpiPtrs* kp = (const __attribute__((address_space(4))) EpiPtrs*)__builtin_amdgcn_kernarg_segment_ptr(); asm volatile("" : "+s"(kp));
        bf16_t* C = (bf16_t*)((unsigned char*)kp->ws + EP_Y);
        const int row0 = u.pm * BM + wr * 64 + fr, col0 = u.pn * BM + wc * 32 + 8 * fq;
#pragma unroll
        for (int ai = 0; ai < 2; ++ai)
#pragma unroll
            for (int m = 0; m < 4; ++m) { bf16_t* rowp = C + (size_t)(row0 + ai * HALF + m * 16) * DM + col0;
#pragma unroll
                for (int bj = 0; bj < 2; ++bj) { const f32x4 v0 = acc[ai][bj][m][0], v1 = acc[ai][bj][m][1];
                    u32x4 w; w.x = cvt_pk_bf16(v0[0], v0[1]); w.y = cvt_pk_bf16(v0[2], v0[3]); w.z = cvt_pk_bf16(v1[0], v1[1]); w.w = cvt_pk_bf16(v1[2], v1[3]);
                    *(u32x4*)(rowp + bj * HALF) = w; } }
    }
};
template <class Epi, class Sched, bool ALIGN_EPI = false, bool SP2 = false>
__device__ __forceinline__ void gemm_phase(PG8_LAS unsigned char* lds, const Gemm g, const Sched& S, const Epi& E) {
    int tid_ = threadIdx.x; asm volatile("" : "+v"(tid_));
    const int tid = tid_, wid = __builtin_amdgcn_readfirstlane(tid >> 6), lane = tid & 63, wr = wid >> 2, wc = wid & 3, fr = lane & 15, fq = lane >> 4;
    const int K = g.K, nt = K / BK;
    unsigned voffA[2], voffB[2];
#pragma unroll
    for (int i = 0; i < 2; ++i) { int R, C; stage_rc(tid * 16 + i * 8192, R, C); const int Rb = Epi::PERM ? ((R & ~31) + perm32(R & 31)) : R;
        voffA[i] = (unsigned)(R * K + C) * 2u; voffB[i] = (unsigned)(Rb * K + C) * 2u; }
    const size_t kstep = (size_t)(BK * 2);
    const size_t hstep = (size_t)HALF * K * 2;
    const size_t tstep = 2 * hstep;
    const unsigned ldsw = (unsigned)wid * 1024u;
    const int aoff = lds_byte(wr * 64 + fr, fq * 8), boff = lds_byte(wc * 32 + fr, fq * 8);
#define PG8_SA(b, h) (((b) * 2 + (h)) * HTB)
#define PG8_SB(b, h) ((4 + (b) * 2 + (h)) * HTB)
#define PG8_STAGE(bufoff, gbase, voff) do { _Pragma("unroll") for (int _i = 0; _i < 2; ++_i) \
        __builtin_amdgcn_global_load_lds((const unsigned*)((const char*)(gbase) + (voff)[_i]), (PG8_LAS unsigned*)(lds + (bufoff) + ldsw + _i * 8192), 16, 0, 0); } while (0)
#define PG8_LDA(dst, b, h) do { _Pragma("unroll") for (int m = 0; m < 4; ++m) _Pragma("unroll") for (int k = 0; k < 2; ++k) dst[m][k] = *(const PG8_LAS bf16x8*)(lds + PG8_SA(b, h) + aoff + m * 2048 + k * 1024); } while (0)
#define PG8_LDB(dst, b, h) do { _Pragma("unroll") for (int n = 0; n < 2; ++n) _Pragma("unroll") for (int k = 0; k < 2; ++k) dst[n][k] = *(const PG8_LAS bf16x8*)(lds + PG8_SB(b, h) + boff + n * 2048 + k * 1024); } while (0)
#define PG8_MMA(ai, bj, At, Bt) do { __builtin_amdgcn_s_setprio(1); _Pragma("unroll") for (int m = 0; m < 4; ++m) _Pragma("unroll") for (int n = 0; n < 2; ++n) _Pragma("unroll") for (int k = 0; k < 2; ++k) \
        acc[ai][bj][m][n] = __builtin_amdgcn_mfma_f32_16x16x32_bf16(Bt[n][k], At[m][k], acc[ai][bj][m][n], 0, 0, 0); __builtin_amdgcn_s_setprio(0); } while (0)
#define PG8_WAIT_V(n) asm volatile("s_waitcnt vmcnt(" #n ")" ::: "memory")
#define PG8_WAIT_L(n) asm volatile("s_waitcnt lgkmcnt(" #n ")" ::: "memory")
#define PG8_BAR __builtin_amdgcn_s_barrier()
#define PG8_SCHED __builtin_amdgcn_sched_barrier(0)
    Unit cur, nxt; int ui = 0;
    if (!S.next(0, cur)) return;
    f32x4 acc[2][2][4][2];
#pragma unroll
    for (int a = 0; a < 2; ++a)
#pragma unroll
        for (int b = 0; b < 2; ++b)
#pragma unroll
            for (int m = 0; m < 4; ++m)
#pragma unroll
                for (int n = 0; n < 2; ++n) acc[a][b][m][n] = (f32x4){0.f, 0.f, 0.f, 0.f};
    bf16x8 At[4][2], B0[2][2], B1[2][2];
    const char* cA = (const char*)g.A + (size_t)cur.pm * tstep; const char* cB = (const char*)g.Bt + (size_t)cur.pn * tstep;
    S.a_ready(cur);
    if constexpr (SP2) {
        PG8_STAGE(PG8_SB(0, 0), cB, voffB); PG8_STAGE(PG8_SB(0, 1), cB + hstep, voffB); PG8_STAGE(PG8_SA(0, 0), cA, voffA); PG8_STAGE(PG8_SA(0, 1), cA + hstep, voffA);
        if (wr == 1) PG8_BAR;
        PG8_WAIT_V(2); PG8_BAR;
        PG8_STAGE(PG8_SB(1, 0), cB + kstep, voffB); PG8_STAGE(PG8_SA(1, 0), cA + kstep, voffA); PG8_STAGE(PG8_SB(1, 1), cB + hstep + kstep, voffB);
        PG8_WAIT_V(6); PG8_BAR;
    } else {
        PG8_STAGE(PG8_SB(0, 0), cB, voffB); PG8_STAGE(PG8_SA(0, 0), cA, voffA); PG8_STAGE(PG8_SB(0, 1), cB + hstep, voffB); PG8_STAGE(PG8_SA(0, 1), cA + hstep, voffA);
        if (wr == 1) PG8_BAR;
        PG8_WAIT_V(4); PG8_BAR;
        PG8_STAGE(PG8_SB(1, 0), cB + kstep, voffB); PG8_STAGE(PG8_SA(1, 0), cA + kstep, voffA); PG8_STAGE(PG8_SB(1, 1), cB + hstep + kstep, voffB);
        PG8_WAIT_V(6); PG8_BAR;
    }
    for (;;) {
        const bool has_next = S.next(ui + 1, nxt);
        const char* nA = has_next ? (const char*)g.A + (size_t)nxt.pm * tstep : cA; const char* nB = has_next ? (const char*)g.Bt + (size_t)nxt.pn * tstep : cB;
        for (int t = 0; t < nt; t += 2) {
            const bool last = (t == nt - 2);
            const char* a1 = cA + (size_t)(t + 1) * kstep;
            const char* a2 = last ? nA : cA + (size_t)(t + 2) * kstep; const char* b2 = last ? nB : cB + (size_t)(t + 2) * kstep;
            const char* a3 = a2 + kstep; const char* b3 = b2 + kstep;
            if (last && has_next) S.a_ready(nxt);
            if constexpr (SP2) {
            PG8_LDB(B0, 0, 0); PG8_LDB(B1, 0, 1); PG8_SCHED; PG8_LDA(At, 0, 0); PG8_STAGE(PG8_SA(1, 1), a1 + hstep, voffA);
            PG8_WAIT_V(8); PG8_WAIT_L(0); PG8_BAR; PG8_MMA(0, 0, At, B0); PG8_MMA(0, 1, At, B1); PG8_BAR; PG8_SCHED;
            PG8_LDA(At, 0, 1); PG8_STAGE(PG8_SB(0, 0), b2, voffB); PG8_STAGE(PG8_SB(0, 1), b2 + hstep, voffB); PG8_STAGE(PG8_SA(0, 0), a2, voffA);
            PG8_WAIT_V(8); PG8_WAIT_L(0); PG8_BAR; PG8_MMA(1, 0, At, B0); PG8_MMA(1, 1, At, B1); PG8_BAR; PG8_SCHED;
            PG8_LDB(B0, 1, 0); PG8_LDB(B1, 1, 1); PG8_SCHED; PG8_LDA(At, 1, 0); PG8_STAGE(PG8_SA(0, 1), a2 + hstep, voffA);
            PG8_WAIT_V(8); PG8_WAIT_L(0); PG8_BAR; PG8_MMA(0, 0, At, B0); PG8_MMA(0, 1, At, B1); PG8_BAR; PG8_SCHED;
            PG8_LDA(At, 1, 1); PG8_STAGE(PG8_SB(1, 0), b3, voffB); PG8_STAGE(PG8_SB(1, 1), b3 + hstep, voffB); PG8_STAGE(PG8_SA(1, 0), a3, voffA);
            PG8_WAIT_V(8); PG8_WAIT_L(0); PG8_BAR; PG8_MMA(1, 0, At, B0); PG8_MMA(1, 1, At, B1); PG8_BAR; PG8_SCHED;
            } else {
            PG8_LDB(B0, 0, 0); PG8_SCHED; PG8_LDA(At, 0, 0); PG8_STAGE(PG8_SA(1, 1), a1 + hstep, voffA);
            PG8_WAIT_L(8); PG8_BAR; PG8_WAIT_L(0); PG8_MMA(0, 0, At, B0); PG8_BAR; PG8_SCHED;
            PG8_LDB(B1, 0, 1); PG8_STAGE(PG8_SB(0, 0), b2, voffB);
            PG8_BAR; PG8_WAIT_L(0); PG8_MMA(0, 1, At, B1); PG8_BAR;
            PG8_LDA(At, 0, 1); PG8_STAGE(PG8_SA(0, 0), a2, voffA);
            PG8_BAR; PG8_WAIT_L(0); PG8_MMA(1, 0, At, B0); PG8_BAR; PG8_SCHED;
            PG8_STAGE(PG8_SB(0, 1), b2 + hstep, voffB);
            PG8_WAIT_V(6); PG8_BAR; PG8_MMA(1, 1, At, B1); PG8_BAR;
            PG8_LDB(B0, 1, 0); PG8_SCHED; PG8_LDA(At, 1, 0); PG8_STAGE(PG8_SA(0, 1), a2 + hstep, voffA);
            PG8_WAIT_L(8); PG8_BAR; PG8_WAIT_L(0); PG8_MMA(0, 0, At, B0); PG8_BAR; PG8_SCHED;
            PG8_LDB(B1, 1, 1); PG8_STAGE(PG8_SB(1, 0), b3, voffB);
            PG8_BAR; PG8_WAIT_L(0); PG8_MMA(0, 1, At, B1); PG8_BAR;
            PG8_LDA(At, 1, 1); PG8_STAGE(PG8_SA(1, 0), a3, voffA);
            PG8_BAR; PG8_WAIT_L(0); PG8_MMA(1, 0, At, B0); PG8_BAR; PG8_SCHED;
            PG8_STAGE(PG8_SB(1, 1), b3 + hstep, voffB);
            PG8_WAIT_V(6); PG8_BAR; PG8_MMA(1, 1, At, B1); PG8_BAR;
            }
        }
        if constexpr (ALIGN_EPI) { if (wr == 0) PG8_BAR; }
        if constexpr (!Epi::AFTER_DRAIN) { E(acc, cur, wr, wc, fr, fq); S.done(cur); }
        if (!has_next) break;
#pragma unroll
        for (int a = 0; a < 2; ++a)
#pragma unroll
            for (int b = 0; b < 2; ++b)
#pragma unroll
                for (int m = 0; m < 4; ++m)
#pragma unroll
                    for (int n = 0; n < 2; ++n) acc[a][b][m][n] = (f32x4){0.f, 0.f, 0.f, 0.f};
        cur = nxt; cA = nA; cB = nB; ++ui;
        if constexpr (ALIGN_EPI) { if (wr == 1) PG8_BAR; }
    }
    PG8_WAIT_V(0);
    if constexpr (!ALIGN_EPI) { if (wr == 0) PG8_BAR; }
    PG8_BAR;
    if constexpr (Epi::AFTER_DRAIN) { E.fused(acc, cur, wr, wc, fr, fq, lds, wid, lane); S.done(cur); }
#undef PG8_SA
#undef PG8_SB
#undef PG8_STAGE
#undef PG8_LDA
#undef PG8_LDB
#undef PG8_MMA
#undef PG8_WAIT_V
#undef PG8_WAIT_L
#undef PG8_BAR
#undef PG8_SCHED
}
}
#define GAS __attribute__((address_space(1)))
#define LAS __attribute__((address_space(3)))
typedef GAS unsigned gu32;
typedef GAS unsigned long long gu64;
#define RLX_AGENT __ATOMIC_RELAXED, __HIP_MEMORY_SCOPE_AGENT
#define VM_WAIT() asm volatile("s_waitcnt vmcnt(0)" ::: "memory")
__device__ __forceinline__ unsigned long long rt() { return __builtin_amdgcn_s_memrealtime(); }
__device__ __forceinline__ unsigned f2bf(float f) { unsigned u = __builtin_bit_cast(unsigned, f); return (u + 0x7fffu + ((u >> 16) & 1u)) >> 16; }
__device__ __forceinline__ unsigned pk2(float lo, float hi) { return f2bf(lo) | (f2bf(hi) << 16); }

#define XB_TMO      128
#define XB_XCNT(j)  (256  + 64 * (j))
#define XB_XSUB(j)  (1280 + 64 * (j))
#define XB_XGEN(j)  (2304 + 64 * (j))
#define XB_TOP      3328
#define XB_TOPGEN   3392
#define XCD_BAR_WORDS 3456
#define XB_SPIN_CAP (1u << 18)

__device__ __forceinline__ unsigned xb_ld(unsigned* p)              { return __hip_atomic_load(p, __ATOMIC_RELAXED, __HIP_MEMORY_SCOPE_AGENT); }
__device__ __forceinline__ unsigned xb_add(unsigned* p, unsigned v) { return __hip_atomic_fetch_add(p, v, __ATOMIC_RELAXED, __HIP_MEMORY_SCOPE_AGENT); }
__device__ __forceinline__ unsigned xb_xcc_id() { return (unsigned)__builtin_amdgcn_s_getreg((3 << 11) | 20) & 0xFu; }
#define XB_SPIN(cond, bar) do { unsigned _sp = 0; while (cond) { __builtin_amdgcn_s_sleep(1); \
    if ((++_sp & 255u) == 0u) { if (xb_ld(&(bar)[XB_TMO])) break; if (_sp > XB_SPIN_CAP) { atomicAdd(&(bar)[XB_TMO], 1u); break; } } } } while (0)

struct XcdBarrier {
    unsigned* bar; unsigned x;
    volatile LAS unsigned* st;
};

__device__ __forceinline__ XcdBarrier xcd_barrier_post(unsigned* bar, volatile LAS unsigned* st) {
    XcdBarrier b; b.bar = bar; b.x = xb_xcc_id(); b.st = st;
    if (threadIdx.x == 0) (void)xb_add(&bar[XB_XCNT(b.x)], 1u);
    return b;
}
__device__ __forceinline__ void xcd_barrier_complete(unsigned* bar, unsigned x, unsigned& nloc, unsigned& nx) {
    const unsigned G = gridDim.x * gridDim.y * gridDim.z;
    unsigned sum, cnt, mine, sp = 0u;
    for (;;) {
        sum = 0u; cnt = 0u; mine = 0u;
#pragma unroll
        for (unsigned j = 0; j < 16; ++j) { const unsigned c = xb_ld(&bar[XB_XCNT(j)]); sum += c; cnt += (c > 0u) ? 1u : 0u; mine = (j == x) ? c : mine; }
        if (sum == G) break;
        __builtin_amdgcn_s_sleep(1);
        if ((++sp & 255u) == 0u) { if (xb_ld(&bar[XB_TMO])) break; if (sp > XB_SPIN_CAP) { atomicAdd(&bar[XB_TMO], 1u); break; } }
    }
    nloc = mine > 0u ? mine : 1u; nx = cnt > 0u ? cnt : 1u;
}

__device__ __forceinline__ void xcd_barrier(const XcdBarrier& b) {
    asm volatile("s_waitcnt vmcnt(0)" ::: "memory");
    __syncthreads();
    if (threadIdx.x == 0) {
        unsigned* bar = b.bar;
        __builtin_amdgcn_s_waitcnt(0);
        unsigned nloc = b.st[0], nx = b.st[1];
        if (nloc == 0u) { xcd_barrier_complete(bar, b.x, nloc, nx); b.st[0] = nloc; b.st[1] = nx; }
        const unsigned old = xb_add(&bar[XB_XSUB(b.x)], 1u);
        const unsigned gen = old / nloc;
        if (old + 1u == (gen + 1u) * nloc) {
            __builtin_amdgcn_fence(__ATOMIC_RELEASE, "agent");
            asm volatile("s_waitcnt vmcnt(0)" ::: "memory");
            const unsigned og = xb_add(&bar[XB_TOP], 1u);
            const unsigned tg = og / nx;
            if (og + 1u == (tg + 1u) * nx) xb_add(&bar[XB_TOPGEN], 1u);
            else XB_SPIN(xb_ld(&bar[XB_TOPGEN]) == tg, bar);
            __builtin_amdgcn_fence(__ATOMIC_ACQUIRE, "agent");
            xb_add(&bar[XB_XGEN(b.x)], 1u);
            asm volatile("s_waitcnt vmcnt(0)" ::: "memory");
        } else {
            XB_SPIN(xb_ld(&bar[XB_XGEN(b.x)]) == gen, bar);
            __builtin_amdgcn_fence(__ATOMIC_ACQUIRE, "agent");
            asm volatile("s_waitcnt vmcnt(0)" ::: "memory");
        }
    }
    __syncthreads();
}

using pg8::bf16_t; using pg8::bf16x8; using pg8::f32x4; using pg8::u32x4;
using pg8::DM; using pg8::MP; using pg8::MS; using pg8::MT; using pg8::DIN; using pg8::ZW;
using pg8::Z_GA; using pg8::Z_XB; using pg8::Z_GP; using pg8::Z_U; using pg8::Z_VS; using pg8::Z_GS; using pg8::LOG2E; using pg8::EPS;
typedef float f32x16 __attribute__((ext_vector_type(16)));
typedef unsigned u32x2 __attribute__((ext_vector_type(2)));

constexpr int NWAVES = 8, NTHREADS = 512;
constexpr int LDS_BYTES = 147456;
constexpr int RING_OFF = 1024;

constexpr size_t O_YP = 0, O_YS = 33554432, O_KP = 34603008, O_VP = 35127296, O_PP = 35651584, O_KS = 35774464, O_VS = 44163072, O_PS = 52551680, O_CV = 54517760, O_END = 55042048;
constexpr size_t LS_KP = 262144, LS_PP = 61440, LS_KS = 4194304, LS_PS = 983040, LS_CV = 262144;
constexpr size_t MiB = 1u << 20;
constexpr size_t WS_CTL = 0, CTL_ZERO_BYTES = 65536;
constexpr size_t WS_ROPE = 1 * MiB, WS_SGUW = 2 * MiB, WS_RSW = 2 * MiB + 256 * 1024, WS_PWT = 2 * MiB + 512 * 1024;
constexpr size_t WS_WTIN = 4 * MiB, WS_WTOUT = 44 * MiB, WS_H = 60 * MiB, WS_MIX = 126 * MiB, WS_QC = 192 * MiB, WS_KC = 225 * MiB, WS_VTP = 233 * MiB, WS_Z2 = 241 * MiB, WS_Y = 357 * MiB, WS_END = 489 * MiB;
constexpr int CW_BAR = 1024;

__constant__ double ROPE_INV[32] = {1.0, 0.7498942093324559, 0.5623413251903491, 0.4216965034285822, 0.31622776601683794, 0.23713737056616552, 0.1778279410038923, 0.1333521432163324, 0.1, 0.07498942093324558, 0.05623413251903491, 0.042169650342858224, 0.03162277660168379, 0.023713737056616554, 0.01778279410038923, 0.01333521432163324, 0.01, 0.007498942093324558, 0.005623413251903491, 0.004216965034285823, 0.0031622776601683794, 0.0023713737056616554, 0.0017782794100389228, 0.001333521432163324, 0.001, 0.0007498942093324559, 0.0005623413251903491, 0.00042169650342858224, 0.00031622776601683794, 0.00023713737056616554, 0.00017782794100389227, 0.0001333521432163324};

struct Args { const float* in[16]; float* out; unsigned char* ws; };

struct Frame {
    int tid, lane, wave, bid, G;
    const float *xp, *xs, *cache_k, *cache_v, *state_pool, *w_in, *w_out, *norm_pre, *norm_post, *sinks, *pool_w, *pool_scale, *ln_g, *ln_b, *sgu_w, *sgu_b;
    float* out;
    float* rope; float* RSW; bf16_t *SGUW, *PWT, *WTIN, *WTOUT, *H, *MIX, *Qc, *Kc, *VTP, *Z2, *Yb;
};

__device__ __forceinline__ float wave_sum(float v) {
#pragma unroll
    for (int o = 1; o < 64; o <<= 1) v += __shfl_xor(v, o);
    return v;
}
__device__ __forceinline__ float wave_max(float v) {
#pragma unroll
    for (int o = 1; o < 64; o <<= 1) v = fmaxf(v, __shfl_xor(v, o));
    return v;
}
__device__ __forceinline__ float bflo(unsigned w) { return __uint_as_float(w << 16); }
__device__ __forceinline__ float bfhi(unsigned w) { return __uint_as_float(w & 0xffff0000u); }
__device__ __forceinline__ void unpack8(const u32x4 w, float (&f)[8]) { f[0] = bflo(w.x); f[1] = bfhi(w.x); f[2] = bflo(w.y); f[3] = bfhi(w.y); f[4] = bflo(w.z); f[5] = bfhi(w.z); f[6] = bflo(w.w); f[7] = bfhi(w.w); }
__device__ __forceinline__ void unpack4(const u32x2 w, float (&f)[4]) { f[0] = bflo(w.x); f[1] = bfhi(w.x); f[2] = bflo(w.y); f[3] = bfhi(w.y); }
__device__ __forceinline__ u32x4 pack8(const float (&f)[8]) { u32x4 w; w.x = pg8::cvt_pk_bf16(f[0], f[1]); w.y = pg8::cvt_pk_bf16(f[2], f[3]); w.z = pg8::cvt_pk_bf16(f[4], f[5]); w.w = pg8::cvt_pk_bf16(f[6], f[7]); return w; }
__device__ __forceinline__ int crow(int r, int hi) { return (r & 3) + 8 * (r >> 2) + 4 * hi; }
#define LDS_WAIT() asm volatile("s_waitcnt lgkmcnt(0)" ::: "memory")


struct ArgsG { const __attribute__((address_space(1))) float* in[16]; __attribute__((address_space(1))) float* out; __attribute__((address_space(1))) unsigned char* ws; };
typedef const __attribute__((address_space(4))) ArgsG* KArgs;
__device__ __forceinline__ KArgs kargs() { KArgs p = (KArgs)__builtin_amdgcn_kernarg_segment_ptr(); asm volatile("" : "+s"(p)); return p; }
__device__ __forceinline__ void make_frame(Frame& F, KArgs a) {
    { int t_ = threadIdx.x; asm volatile("" : "+v"(t_)); F.tid = t_; } F.lane = F.tid & 63; F.wave = __builtin_amdgcn_readfirstlane(F.tid >> 6); F.bid = blockIdx.x; F.G = gridDim.x;
    F.xp = (const float*)a->in[0]; F.xs = (const float*)a->in[1]; F.cache_k = (const float*)a->in[2]; F.cache_v = (const float*)a->in[3]; F.state_pool = (const float*)a->in[4]; F.w_in = (const float*)a->in[5]; F.w_out = (const float*)a->in[6]; F.norm_pre = (const float*)a->in[7]; F.norm_post = (const float*)a->in[8];
    F.sinks = (const float*)a->in[9]; F.pool_w = (const float*)a->in[10]; F.pool_scale = (const float*)a->in[11]; F.ln_g = (const float*)a->in[12]; F.ln_b = (const float*)a->in[13]; F.sgu_w = (const float*)a->in[14]; F.sgu_b = (const float*)a->in[15];
    F.out = (float*)a->out;
    unsigned char* ws = (unsigned char*)a->ws;
    F.rope = (float*)(ws + WS_ROPE); F.RSW = (float*)(ws + WS_RSW); F.SGUW = (bf16_t*)(ws + WS_SGUW); F.PWT = (bf16_t*)(ws + WS_PWT); F.WTIN = (bf16_t*)(ws + WS_WTIN); F.WTOUT = (bf16_t*)(ws + WS_WTOUT);
    F.H = (bf16_t*)(ws + WS_H); F.MIX = (bf16_t*)(ws + WS_MIX); F.Qc = (bf16_t*)(ws + WS_QC); F.Kc = (bf16_t*)(ws + WS_KC); F.VTP = (bf16_t*)(ws + WS_VTP); F.Z2 = (bf16_t*)(ws + WS_Z2); F.Yb = (bf16_t*)(ws + WS_Y);
}

#define LOCAL_FRAME Frame F; make_frame(F, kargs())

constexpr int CW_Q = 8192;
constexpr int CW_ZS = 8192 + 64 * 8;
constexpr int CW_YS = 8192 + 64 * 16;
constexpr int CW_EV = 8192 + 64 * 32;
__device__ __forceinline__ unsigned* ctl_word(int idx) { return (unsigned*)((unsigned char*)kargs()->ws + WS_CTL) + idx; }
__device__ __forceinline__ int q_pop(unsigned* head, LAS unsigned char* L) {
    volatile LAS int* slot = (volatile LAS int*)(L + 64);
    __syncthreads();
    if (threadIdx.x == 0) *slot = (int)__hip_atomic_fetch_add(head, 1u, __ATOMIC_RELAXED, __HIP_MEMORY_SCOPE_AGENT);
    __syncthreads();
    return __builtin_amdgcn_readfirstlane(*slot);
}
__device__ __forceinline__ void publish(unsigned* ctr) {
    asm volatile("s_waitcnt vmcnt(0)" ::: "memory");
    __syncthreads();
    if (threadIdx.x == 0) { __builtin_amdgcn_fence(__ATOMIC_RELEASE, "agent"); asm volatile("s_waitcnt vmcnt(0)" ::: "memory");
        __hip_atomic_fetch_add(ctr, 1u, __ATOMIC_RELAXED, __HIP_MEMORY_SCOPE_AGENT); }
}
__device__ __forceinline__ void dep_wait(unsigned* ctr, unsigned need) {
    if (threadIdx.x == 0) {
        unsigned sp = 0;
        while (__hip_atomic_load(ctr, __ATOMIC_RELAXED, __HIP_MEMORY_SCOPE_AGENT) < need) { __builtin_amdgcn_s_sleep(16); if (++sp > (1u << 21)) break; }
        __builtin_amdgcn_fence(__ATOMIC_ACQUIRE, "agent"); asm volatile("s_waitcnt vmcnt(0)" ::: "memory");
    }
    __syncthreads();
}

#if PROBE_SEL >= 10
#define EV_T0() const unsigned long long ev_t0 = __builtin_amdgcn_s_memrealtime()
#define EV_MAX(k) do { if (threadIdx.x == 0) __hip_atomic_fetch_max(ctl_word(CW_EV + 64 * (k)), (unsigned)(__builtin_amdgcn_s_memrealtime() - ev_t0), __ATOMIC_RELAXED, __HIP_MEMORY_SCOPE_AGENT); } while (0)
#define EV_MIN(k) do { if (threadIdx.x == 0) __hip_atomic_fetch_max(ctl_word(CW_EV + 64 * (k)), 0x40000000u - (unsigned)(__builtin_amdgcn_s_memrealtime() - ev_t0), __ATOMIC_RELAXED, __HIP_MEMORY_SCOPE_AGENT); } while (0)
#else
#define EV_T0() do {} while (0)
#define EV_MAX(k) do {} while (0)
#define EV_MIN(k) do {} while (0)
#endif
struct OneUnit {
    pg8::Unit u;
    __device__ __forceinline__ bool next(int i, pg8::Unit& o) const { if (i) return false; o = u; return true; }
    __device__ __forceinline__ void a_ready(const pg8::Unit&) const {}
    __device__ __forceinline__ void done(const pg8::Unit&) const {}
};

#ifndef PROBE_SEL
#define PROBE_SEL 0
#endif
#if PROBE_SEL
#define STAMP(k) do { if (blockIdx.x == 0 && threadIdx.x == 0) ((LAS unsigned long long*)(L + 256))[k] = __builtin_amdgcn_s_memrealtime(); } while (0)
#define STAMP2(k) do { if (blockIdx.x == 0) { __syncthreads(); if (threadIdx.x == 0) ((LAS unsigned long long*)((LAS unsigned char*)ring - RING_OFF + 256))[k] = __builtin_amdgcn_s_memrealtime(); } } while (0)
#else
#define STAMP(k) do {} while (0)
#define STAMP2(k) do {} while (0)
#endif
#if PROBE_SEL == 1
#define PA0 0
#define PA1 1
#define PB0 1
#define PB1 2
#elif PROBE_SEL == 2
#define PA0 2
#define PA1 3
#define PB0 3
#define PB1 4
#elif PROBE_SEL == 3
#define PA0 4
#define PA1 5
#define PB0 8
#define PB1 9
#elif PROBE_SEL == 4
#define PA0 2
#define PA1 10
#define PB0 10
#define PB1 11
#elif PROBE_SEL == 5
#define PA0 11
#define PA1 12
#define PB0 12
#define PB1 13
#elif PROBE_SEL == 6
#define PA0 5
#define PA1 6
#define PB0 7
#define PB1 8
#elif PROBE_SEL == 10
#define PEA 0
#define PEA_MIN 0
#define PEB 1
#define PEB_MIN 1
#elif PROBE_SEL == 11
#define PEA 2
#define PEA_MIN 0
#define PEB 3
#define PEB_MIN 1
#elif PROBE_SEL == 12
#define PEA 4
#define PEA_MIN 0
#define PEB 5
#define PEB_MIN 0
#elif PROBE_SEL == 14
#define PEA 8
#define PEA_MIN 0
#define PEB 9
#define PEB_MIN 0
#elif PROBE_SEL == 13
#define PEA 6
#define PEA_MIN 1
#define PEB 7
#define PEB_MIN 0
#endif

__device__ __forceinline__ void p0_transpose_blk(const float* W, int K, int N, bf16_t* WT, bool permqk, LAS unsigned char* T, int item, int tid) {
    const int nblk = N >> 8, kb = item / nblk, nb = item - kb * nblk, k0 = kb * 128, n0 = nb * 256;
    const int n4 = tid & 63, kr = tid >> 6;
    f32x4 v[16];
#pragma unroll
    for (int i = 0; i < 16; ++i) v[i] = __builtin_nontemporal_load((const f32x4*)(W + (size_t)(k0 + 16 * kr + i) * N + n0 + 4 * n4));
#pragma unroll
    for (int e = 0; e < 4; ++e) {
        u32x4 lo, hi;
        lo.x = pg8::cvt_pk_bf16(v[0][e], v[1][e]); lo.y = pg8::cvt_pk_bf16(v[2][e], v[3][e]); lo.z = pg8::cvt_pk_bf16(v[4][e], v[5][e]); lo.w = pg8::cvt_pk_bf16(v[6][e], v[7][e]);
        hi.x = pg8::cvt_pk_bf16(v[8][e], v[9][e]); hi.y = pg8::cvt_pk_bf16(v[10][e], v[11][e]); hi.z = pg8::cvt_pk_bf16(v[12][e], v[13][e]); hi.w = pg8::cvt_pk_bf16(v[14][e], v[15][e]);
        LAS unsigned char* p = T + (64 * e + n4) * 272 + 32 * kr;
        *(LAS u32x4*)p = lo; *(LAS u32x4*)(p + 16) = hi;
    }
    LDS_WAIT();
    __syncthreads();
    {
        const int rho = tid >> 1, half = tid & 1, n = n0 + 4 * (rho & 63) + (rho >> 6);
        int nrow = n;
        if (permqk && n < 1280) { const int p = n & 63; nrow = (n & ~63) + 2 * (p & 31) + (p >> 5); }
        const LAS unsigned char* src = T + rho * 272 + 128 * half;
        bf16_t* dst = WT + (size_t)nrow * K + k0 + 64 * half;
        u32x4 o[8];
#pragma unroll
        for (int c = 0; c < 8; ++c) o[c] = *(const LAS u32x4*)(src + 16 * c);
#pragma unroll
        for (int c = 0; c < 8; ++c) *(u32x4*)(dst + 8 * c) = o[c];
    }
    LDS_WAIT();
    __syncthreads();
}
__device__ __forceinline__ void prenorm_finish(const f32x4 (&v)[8], const float* g, bf16_t* hrow, int lane) {
    float ss = 0.f;
#pragma unroll
    for (int j = 0; j < 8; ++j) ss += (v[j][0] * v[j][0] + v[j][1] * v[j][1]) + (v[j][2] * v[j][2] + v[j][3] * v[j][3]);
    ss = wave_sum(ss);
    const float r = rsqrtf(ss * (1.0f / 2048.0f) + EPS);
#pragma unroll
    for (int j = 0; j < 8; ++j) { const f32x4 gg = *(const f32x4*)(g + 4 * lane + 256 * j); const f32x4 o = v[j] * r * gg;
        u32x2 w; w.x = pg8::cvt_pk_bf16(o[0], o[1]); w.y = pg8::cvt_pk_bf16(o[2], o[3]); *(u32x2*)(hrow + 4 * lane + 256 * j) = w; }
}
__device__ __forceinline__ void p0_prologue(const Frame& F, LAS unsigned char* ring) {
    const int gw = F.bid * NWAVES + F.wave, NGW = F.G * NWAVES;
    constexpr int I_IN = 16 * 20, I_OUT = 16 * 8, NITEMS = 2 * (I_IN + I_OUT);
    EV_T0();
    for (int it = F.bid; it < NITEMS; it += F.G) {
        int r = it;
        if (r < 2 * I_IN) { const int l = r / I_IN; r -= l * I_IN; p0_transpose_blk(F.w_in + (size_t)l * DM * DIN, DM, DIN, F.WTIN + (size_t)l * DIN * DM, true, ring, r, F.tid); }
        else { r -= 2 * I_IN; const int l = r / I_OUT; r -= l * I_OUT; p0_transpose_blk(F.w_out + (size_t)l * DM * DM, DM, DM, F.WTOUT + (size_t)l * DM * DM, false, ring, r, F.tid); }
    }
    __syncthreads(); EV_MAX(8);
    for (int m = 2 * gw; m < MT; m += 2 * NGW) {
        const float* xa = m < MP ? F.xp + (size_t)m * DM : F.xs + (size_t)(m - MP) * DM; const float* xb = (m + 1) < MP ? F.xp + (size_t)(m + 1) * DM : F.xs + (size_t)(m + 1 - MP) * DM;
        f32x4 va[8], vb[8];
#pragma unroll
        for (int j = 0; j < 8; ++j) { va[j] = __builtin_nontemporal_load((const f32x4*)(xa + 4 * F.lane + 256 * j)); vb[j] = __builtin_nontemporal_load((const f32x4*)(xb + 4 * F.lane + 256 * j)); }
        prenorm_finish(va, F.norm_pre, F.H + (size_t)m * DM, F.lane); prenorm_finish(vb, F.norm_pre, F.H + (size_t)(m + 1) * DM, F.lane); }
    __syncthreads(); EV_MAX(9);
    const int gt = F.bid * NTHREADS + F.tid, NGT = F.G * NTHREADS;
    for (int e = gt; e < 2052 * 32; e += NGT) { const int tp = e >> 5, i = e & 31; const double pos = (double)(tp < 2048 ? tp : 8192 + (tp - 2048));
        const double rev = pos * ROPE_INV[i] * 0.15915494309189535; const float fr = (float)(rev - floor(rev));
        F.rope[tp * 64 + i] = __builtin_amdgcn_cosf(fr); F.rope[tp * 64 + 32 + i] = __builtin_amdgcn_sinf(fr); }
    for (int e = gt; e < 2 * 4 * 128 * 128; e += NGT) { const int s = e & 127, t = (e >> 7) & 127; const float w = F.sgu_w[e];
        F.SGUW[e] = (bf16_t)(pg8::cvt_pk_bf16(s <= t ? w : 0.f, 0.f) & 0xffffu); }
    for (int e = gt; e < 2 * 4 * 128; e += NGT) { const int t = e & 127; const float* wr = F.sgu_w + (size_t)e * 128; float acc = 0.f;
        for (int s2 = 0; s2 <= t; ++s2) acc += __uint_as_float(pg8::cvt_pk_bf16(wr[s2], 0.f) << 16);
        F.RSW[e] = acc; }
    for (int e = gt; e < 2 * 4 * 128 * 128; e += NGT) { const int c = e & 127, d = (e >> 7) & 127, lg = e >> 14;
        F.PWT[e] = (bf16_t)(pg8::cvt_pk_bf16(F.pool_w[((size_t)lg * 128 + c) * 128 + d], 0.f) & 0xffffu); }
}

constexpr int AT_K = 0, AT_V = 49152, AT_STG = 98304, AT_WSTRIDE = 4352;
__device__ __forceinline__ void attn_stage_kv(const Frame& F, int b, int kvh, int nbp, LAS unsigned char* ring) {
    const int tid = F.tid;
    const bf16_t* kg = F.Kc + ((size_t)(b * 4 + kvh) * 2048 + 256 * nbp - 128) * 64;
    const bf16_t* vg = F.VTP + ((size_t)(b * 4 + kvh) * 64 + 8 * nbp - 4) * 2048;
    u32x4 kv[6], vv[6];
#pragma unroll
    for (int i = 0; i < 6; ++i) { const int ch = tid + 512 * i, row0 = ch >> 3, c8 = ch & 7, row = (nbp > 0 || row0 >= 128) ? row0 : row0 + 128;
        kv[i] = __builtin_nontemporal_load((const u32x4*)(kg + row * 64 + c8 * 8)); }
#pragma unroll
    for (int i = 0; i < 6; ++i) { const int ch = tid + 512 * i, tile0 = ch >> 8, rem = ch & 255, d = rem >> 2, c4 = rem & 3, tile = (nbp > 0 || tile0 >= 4) ? tile0 : tile0 + 4;
        vv[i] = __builtin_nontemporal_load((const u32x4*)(vg + tile * 2048 + d * 32 + c4 * 8)); }
#pragma unroll
    for (int i = 0; i < 6; ++i) { const int ch = tid + 512 * i, row = ch >> 3, c8 = ch & 7;
        *(LAS u32x4*)(ring + AT_K + row * 128 + ((c8 ^ (row & 7)) << 4)) = kv[i]; }
#pragma unroll
    for (int i = 0; i < 6; ++i) { const int ch = tid + 512 * i, tile = ch >> 8, rem = ch & 255, d = rem >> 2, c4 = rem & 3;
        *(LAS u32x4*)(ring + AT_V + tile * 4096 + d * 64 + ((c4 ^ ((d >> 2) & 3)) << 4)) = vv[i]; }
}
__device__ __forceinline__ void attn_task(const Frame& F, int l, int b, int nbp, int head, int j, const bf16x8 (&qf)[4], LAS unsigned char* ring) {
    const int lane = F.lane, r = lane & 31, hh = lane >> 5;
    LAS unsigned char* wl = ring + AT_STG + F.wave * AT_WSTRIDE;
    LAS float* wsf = (LAS float*)wl; LAS bf16_t* stg = (LAS bf16_t*)(wl + 256);
    const size_t qrow0 = (size_t)b * 2048 + 256 * nbp + 32 * j;
    u32x4 gv[4];
#pragma unroll
    for (int i = 0; i < 4; ++i) gv[i] = __builtin_nontemporal_load((const u32x4*)(F.Z2 + (qrow0 + i * 8 + (lane >> 3)) * ZW + Z_GA + head * 64 + (lane & 7) * 8));
    const int cmin = (nbp > 0) ? 0 : (j < 4 ? 4 - j : 0);
    f32x16 S[5];
#pragma unroll
    for (int c = 0; c < 5; ++c) {
        f32x16 a;
#pragma unroll
        for (int i = 0; i < 16; ++i) a[i] = 0.f;
        if (c >= cmin) {
            LAS unsigned char* kp = ring + AT_K + (32 * (j + c) + r) * 128;
#pragma unroll
            for (int s = 0; s < 4; ++s) a = __builtin_amdgcn_mfma_f32_32x32x16_bf16(*(const LAS bf16x8*)(kp + (((2 * s + hh) ^ (r & 7)) << 4)), qf[s], a, 0, 0, 0);
        }
        S[c] = a;
    }
    const float NEG = -INFINITY;
#pragma unroll
    for (int i = 0; i < 16; ++i) { const int kap = crow(i, hh); if (kap <= r) S[0][i] = NEG; if (kap > r) S[4][i] = NEG; }
    const float sink2 = F.sinks[l * 16 + head] * LOG2E;
    float m = sink2;
#pragma unroll
    for (int c = 0; c < 5; ++c) if (c >= cmin) {
#pragma unroll
        for (int i = 0; i < 16; ++i) m = fmaxf(m, S[c][i]); }
    m = fmaxf(m, __shfl_xor(m, 32));
    float sum = 0.f;
#pragma unroll
    for (int c = 0; c < 5; ++c) if (c >= cmin) {
#pragma unroll
        for (int i = 0; i < 16; ++i) { const float p = __builtin_amdgcn_exp2f(S[c][i] - m); S[c][i] = p; sum += p; } }
    sum += __shfl_xor(sum, 32);
    const float inv = 1.0f / (sum + __builtin_amdgcn_exp2f(sink2 - m));
    f32x16 o[2];
#pragma unroll
    for (int i = 0; i < 16; ++i) { o[0][i] = 0.f; o[1][i] = 0.f; }
#pragma unroll
    for (int c = 0; c < 5; ++c) if (c >= cmin) {
        LAS unsigned char* vt = ring + AT_V + (j + c) * 4096 + r * 64;
#pragma unroll
        for (int s = 0; s < 2; ++s) {
            u32x4 pw; pw.x = pg8::cvt_pk_bf16(S[c][8 * s + 0], S[c][8 * s + 1]); pw.y = pg8::cvt_pk_bf16(S[c][8 * s + 2], S[c][8 * s + 3]);
            pw.z = pg8::cvt_pk_bf16(S[c][8 * s + 4], S[c][8 * s + 5]); pw.w = pg8::cvt_pk_bf16(S[c][8 * s + 6], S[c][8 * s + 7]);
            const bf16x8 pa = __builtin_bit_cast(bf16x8, pw);
            const int sw = (((2 * hh + s) ^ ((r >> 2) & 3)) << 4);
#pragma unroll
            for (int db = 0; db < 2; ++db) o[db] = __builtin_amdgcn_mfma_f32_32x32x16_bf16(pa, *(const LAS bf16x8*)(vt + db * 2048 + sw), o[db], 0, 0, 0);
        }
    }
    if (hh == 0) wsf[r] = inv;
    LDS_WAIT();
#pragma unroll
    for (int i = 0; i < 16; ++i) { const int q = crow(i, hh); const float rl = wsf[q];
        stg[q * 64 + r] = (bf16_t)(pg8::cvt_pk_bf16(o[0][i] * rl, 0.f) & 0xffffu);
        stg[q * 64 + 32 + r] = (bf16_t)(pg8::cvt_pk_bf16(o[1][i] * rl, 0.f) & 0xffffu); }
    LDS_WAIT();
#pragma unroll
    for (int i = 0; i < 4; ++i) { const int row = i * 8 + (lane >> 3), ch = lane & 7;
        const u32x4 ov = *(const LAS u32x4*)(stg + row * 64 + ch * 8);
        float of[8], gf[8]; unpack8(ov, of); unpack8(gv[i], gf);
#pragma unroll
        for (int jj = 0; jj < 8; ++jj) of[jj] *= gf[jj];
        *(u32x4*)(F.MIX + (qrow0 + row) * DM + head * 64 + ch * 8) = pack8(of); }
    LDS_WAIT();
}
__device__ __forceinline__ void attn_unit(int l, int a, LAS unsigned char* ring) {
    LOCAL_FRAME;
    const int kvh = a & 3, nbp = (a >> 2) & 7, b = a >> 5;
    const int lane = F.lane, r = lane & 31, hh = lane >> 5;
    const int head = 4 * kvh + (F.wave >> 1), j0 = 4 * (F.wave & 1);
    const bf16_t* qp = F.Qc + ((size_t)b * 2048 + 256 * nbp + 32 * j0 + r) * 1024 + head * 64 + 8 * hh;
    bf16x8 qa[4], qb[4];
#pragma unroll
    for (int s = 0; s < 4; ++s) qa[s] = __builtin_nontemporal_load((const bf16x8*)(qp + 16 * s));
#ifdef EXP_ZERO_LDS
    for (int e = F.tid; e < 134144 / 16; e += NTHREADS) *(LAS u32x4*)(ring + 16 * e) = (u32x4){0u, 0u, 0u, 0u};
    LDS_WAIT(); __syncthreads();
#endif
    attn_stage_kv(F, b, kvh, nbp, ring);
    LDS_WAIT();
    __syncthreads();
#pragma unroll
    for (int s = 0; s < 4; ++s) qb[s] = __builtin_nontemporal_load((const bf16x8*)(qp + 32 * 1024 + 16 * s));
    attn_task(F, l, b, nbp, head, j0 + 0, qa, ring);
#pragma unroll
    for (int s = 0; s < 4; ++s) qa[s] = __builtin_nontemporal_load((const bf16x8*)(qp + 64 * 1024 + 16 * s));
    attn_task(F, l, b, nbp, head, j0 + 1, qb, ring);
#pragma unroll
    for (int s = 0; s < 4; ++s) qb[s] = __builtin_nontemporal_load((const bf16x8*)(qp + 96 * 1024 + 16 * s));
    attn_task(F, l, b, nbp, head, j0 + 2, qa, ring);
    attn_task(F, l, b, nbp, head, j0 + 3, qb, ring);
    __syncthreads();
}

constexpr int PL_STRIDE = 272, PL_WBYTES = 47 * 272;
template <int G>
__device__ __forceinline__ void pool_unit_p(int l, int tile, LAS unsigned char* wl) {
    LOCAL_FRAME;
    constexpr int W = 2 << G, HIST = W - 1, NROW = 32 + HIST, NLD = (NROW * 16 + 63) / 64;
    const int lane = F.lane, r = lane & 31, hh = lane >> 5;
    const size_t R0 = (size_t)32 * tile;
    const int t0 = (int)(R0 & 2047);
    {
        u32x4 x[NLD];
#pragma unroll
        for (int k = 0; k < NLD; ++k) { const int id = lane + 64 * k, lr = id >> 4, c16 = id & 15; const int lrc = lr < NROW ? lr : NROW - 1;
            const int back = HIST - lrc; const size_t grow = (back <= t0) ? R0 - back : R0;
            x[k] = __builtin_nontemporal_load((const u32x4*)(F.Z2 + grow * ZW + Z_XB + 128 * G + 8 * c16)); }
#pragma unroll
        for (int k = 0; k < NLD; ++k) { const int id = lane + 64 * k, lr = id >> 4, c16 = id & 15; if (lr < NROW) *(LAS u32x4*)(wl + lr * PL_STRIDE + c16 * 16) = x[k]; }
    }
    const size_t row = R0 + r; const int t = t0 + r;
    u32x2 gq[4][4];
#pragma unroll
    for (int db = 0; db < 4; ++db)
#pragma unroll
        for (int q = 0; q < 4; ++q) gq[db][q] = __builtin_nontemporal_load((const u32x2*)(F.Z2 + row * ZW + Z_GP + 128 * G + 32 * db + 8 * q + 4 * hh));
    const float icnt = 1.0f / (float)(W < t + 1 ? W : t + 1);
    LDS_WAIT();
    bf16x8 bfr[8];
#pragma unroll
    for (int s = 0; s < 8; ++s) {
        LAS unsigned char* bp = wl + (r + HIST) * PL_STRIDE + (16 * s + 8 * hh) * 2;
        float cur[8], sum[8]; unpack8(*(const LAS u32x4*)bp, cur);
#pragma unroll
        for (int jj = 0; jj < 8; ++jj) sum[jj] = cur[jj];
#pragma unroll
        for (int i = 1; i < W; ++i) { float f[8]; unpack8(*(const LAS u32x4*)(bp - i * PL_STRIDE), f); const float wgt = i <= t ? 1.f : 0.f;
#pragma unroll
            for (int jj = 0; jj < 8; ++jj) sum[jj] += wgt * f[jj]; }
#pragma unroll
        for (int jj = 0; jj < 8; ++jj) sum[jj] = sum[jj] * icnt - cur[jj];
        bfr[s] = __builtin_bit_cast(bf16x8, pack8(sum));
        __builtin_amdgcn_sched_barrier(0);
    }
    f32x16 acc[4];
#pragma unroll
    for (int db = 0; db < 4; ++db) {
#pragma unroll
        for (int i = 0; i < 16; ++i) acc[db][i] = 0.f;
        const bf16_t* ap = F.PWT + ((size_t)(l * 4 + G) * 128 + 32 * db + r) * 128 + 8 * hh;
#pragma unroll
        for (int s = 0; s < 8; ++s) acc[db] = __builtin_amdgcn_mfma_f32_32x32x16_bf16(*(const bf16x8*)(ap + 16 * s), bfr[s], acc[db], 0, 0, 0);
        __builtin_amdgcn_sched_barrier(0);
    }
#pragma unroll
    for (int db = 0; db < 4; ++db)
#pragma unroll
        for (int q = 0; q < 4; ++q) {
            const int col = 128 * G + 32 * db + 8 * q + 4 * hh;
            const f32x4 sc = *(const f32x4*)(F.pool_scale + l * 512 + col);
            float gf[4]; unpack4(gq[db][q], gf);
            u32x2 wv; wv.x = pg8::cvt_pk_bf16(acc[db][4 * q + 0] * sc[0] * gf[0], acc[db][4 * q + 1] * sc[1] * gf[1]);
            wv.y = pg8::cvt_pk_bf16(acc[db][4 * q + 2] * sc[2] * gf[2], acc[db][4 * q + 3] * sc[3] * gf[3]);
            *(u32x2*)(F.MIX + row * DM + 1024 + col) = wv;
        }
    LDS_WAIT();
}
__device__ __forceinline__ void pool_prompt(int l, int g, int tile, LAS unsigned char* wl) {
    if (g == 0) pool_unit_p<0>(l, tile, wl); else if (g == 1) pool_unit_p<1>(l, tile, wl); else if (g == 2) pool_unit_p<2>(l, tile, wl); else pool_unit_p<3>(l, tile, wl);
}
template <int G>
__device__ __forceinline__ void pool_unit_s(int l, int tile) {
    LOCAL_FRAME;
    constexpr int W = 2 << G;
    const int lane = F.lane, r = lane & 31, hh = lane >> 5;
    const size_t row = (size_t)MP + 32 * tile + r;
    const int tt = (int)(row & 3), bd = (int)((row - MP) >> 2);
    const float* stb = F.state_pool + ((size_t)l * 128 + bd) * 15 * 512;
    const float icnt = 1.0f / (float)W;
    bf16x8 bfr[8];
#pragma unroll
    for (int s = 0; s < 8; ++s) {
        const int c0 = 128 * G + 16 * s + 8 * hh;
        float sum[8], cur[8];
        {
            constexpr int NL = W < 4 ? W : 4;
            u32x4 zn[NL]; f32x4 sa[NL], sb[NL];
#pragma unroll
            for (int i = 0; i < NL; ++i) { const int back = i <= tt ? i : tt; int si = 15 + tt - i; si = si > 14 ? 14 : si;
                zn[i] = *(const u32x4*)(F.Z2 + (row - back) * ZW + Z_XB + c0); sa[i] = *(const f32x4*)(stb + si * 512 + c0); sb[i] = *(const f32x4*)(stb + si * 512 + c0 + 4); }
            unpack8(zn[0], cur);
#pragma unroll
            for (int jj = 0; jj < 8; ++jj) sum[jj] = cur[jj];
#pragma unroll
            for (int i = 1; i < NL; ++i) { float f[8]; unpack8(zn[i], f); const bool nw = i <= tt;
#pragma unroll
                for (int jj = 0; jj < 4; ++jj) { sum[jj] += nw ? f[jj] : sa[i][jj]; sum[4 + jj] += nw ? f[4 + jj] : sb[i][jj]; } }
        }
#pragma unroll
        for (int i0 = 4; i0 < W; i0 += 4) {
            f32x4 sa[4], sb[4];
#pragma unroll
            for (int i = 0; i < 4; ++i) { const int si = 15 + tt - (i0 + i); sa[i] = *(const f32x4*)(stb + si * 512 + c0); sb[i] = *(const f32x4*)(stb + si * 512 + c0 + 4); }
#pragma unroll
            for (int i = 0; i < 4; ++i)
#pragma unroll
                for (int jj = 0; jj < 4; ++jj) { sum[jj] += sa[i][jj]; sum[4 + jj] += sb[i][jj]; }
        }
#pragma unroll
        for (int jj = 0; jj < 8; ++jj) sum[jj] = sum[jj] * icnt - cur[jj];
        bfr[s] = __builtin_bit_cast(bf16x8, pack8(sum));
        __builtin_amdgcn_sched_barrier(0);
    }
    f32x16 acc[4];
#pragma unroll
    for (int db = 0; db < 4; ++db) {
#pragma unroll
        for (int i = 0; i < 16; ++i) acc[db][i] = 0.f;
        const bf16_t* ap = F.PWT + ((size_t)(l * 4 + G) * 128 + 32 * db + r) * 128 + 8 * hh;
#pragma unroll
        for (int s = 0; s < 8; ++s) acc[db] = __builtin_amdgcn_mfma_f32_32x32x16_bf16(*(const bf16x8*)(ap + 16 * s), bfr[s], acc[db], 0, 0, 0);
        __builtin_amdgcn_sched_barrier(0);
    }
#pragma unroll
    for (int db = 0; db < 4; ++db)
#pragma unroll
        for (int q = 0; q < 4; ++q) {
            const int col = 128 * G + 32 * db + 8 * q + 4 * hh;
            const f32x4 sc = *(const f32x4*)(F.pool_scale + l * 512 + col);
            float gf[4]; unpack4(*(const u32x2*)(F.Z2 + row * ZW + Z_GP + col), gf);
            u32x2 wv; wv.x = pg8::cvt_pk_bf16(acc[db][4 * q + 0] * sc[0] * gf[0], acc[db][4 * q + 1] * sc[1] * gf[1]);
            wv.y = pg8::cvt_pk_bf16(acc[db][4 * q + 2] * sc[2] * gf[2], acc[db][4 * q + 3] * sc[3] * gf[3]);
            *(u32x2*)(F.MIX + row * DM + 1024 + col) = wv;
        }
}
__device__ __forceinline__ void pool_sample(int l, int g, int tile) {
    if (g == 0) pool_unit_s<0>(l, tile); else if (g == 1) pool_unit_s<1>(l, tile); else if (g == 2) pool_unit_s<2>(l, tile); else pool_unit_s<3>(l, tile);
}

struct SguOps { bf16x8 wB[8], wA[4]; u32x2 uu[2][4], gg[2][4]; float bias[2], rsw[2]; };
__device__ __forceinline__ void sgu_load_ops(SguOps& o, const Frame& F, int l, int hd, size_t R0, int r, int hh, int db, int tbA, int tbB) {
    const bf16_t* Wb = F.SGUW + (size_t)(l * 4 + hd) * 128 * 128;
#pragma unroll
    for (int s = 0; s < 8; ++s) { o.wB[s] = (bf16x8){0, 0, 0, 0, 0, 0, 0, 0}; if (s < 2 * (tbB + 1)) o.wB[s] = *(const bf16x8*)(Wb + (32 * tbB + r) * 128 + 16 * s + 8 * hh); }
#pragma unroll
    for (int s = 0; s < 4; ++s) { o.wA[s] = (bf16x8){0, 0, 0, 0, 0, 0, 0, 0}; if (s < 2 * (tbA + 1)) o.wA[s] = *(const bf16x8*)(Wb + (32 * tbA + r) * 128 + 16 * s + 8 * hh); }
#pragma unroll
    for (int pass = 0; pass < 2; ++pass) { const int tb = pass ? tbB : tbA; const size_t row = R0 + 32 * tb + r;
        o.bias[pass] = F.sgu_b[l * 512 + hd * 128 + 32 * tb + r]; o.rsw[pass] = F.RSW[(l * 4 + hd) * 128 + 32 * tb + r];
#pragma unroll
        for (int q = 0; q < 4; ++q) { const int col = 128 * hd + 32 * db + 8 * q + 4 * hh;
            o.uu[pass][q] = __builtin_nontemporal_load((const u32x2*)(F.Z2 + row * ZW + Z_U + col)); o.gg[pass][q] = __builtin_nontemporal_load((const u32x2*)(F.Z2 + row * ZW + Z_GS + col)); } }
}
__device__ __forceinline__ void sgu_mfma(const SguOps& o, LAS bf16_t* VnT, int h2, int r, int hh, int db, int tbA, int tbB, f32x16& accA, f32x16& accB) {
#pragma unroll
    for (int i = 0; i < 16; ++i) { accA[i] = 0.f; accB[i] = 0.f; }
#pragma unroll
    for (int s = 0; s < 8; ++s) {
        if (s < 2 * (tbB + 1)) {
            const bf16x8 a = *(const LAS bf16x8*)(VnT + (h2 * 128 + 32 * db + r) * 136 + 16 * s + 8 * hh);
            accB = __builtin_amdgcn_mfma_f32_32x32x16_bf16(a, o.wB[s], accB, 0, 0, 0);
            if (s < 4) { if (s < 2 * (tbA + 1)) accA = __builtin_amdgcn_mfma_f32_32x32x16_bf16(a, o.wA[s], accA, 0, 0, 0); }
        }
    }
}
__device__ __forceinline__ void sgu_epi(const SguOps& o, const Frame& F, int l, int hd, size_t R0, int r, int hh, int db, int tbA, int tbB, const f32x16& accA, const f32x16& accB) {
    f32x4 lg[4], lb[4];
#pragma unroll
    for (int q = 0; q < 4; ++q) { const int col = 128 * hd + 32 * db + 8 * q + 4 * hh; lg[q] = *(const f32x4*)(F.ln_g + l * 512 + col); lb[q] = *(const f32x4*)(F.ln_b + l * 512 + col); }
#pragma unroll
    for (int pass = 0; pass < 2; ++pass) {
        const int tb = pass ? tbB : tbA; const f32x16 acc = pass ? accB : accA;
        const size_t row = R0 + 32 * tb + r; const float bs = o.bias[pass], rs = o.rsw[pass];
#pragma unroll
        for (int q = 0; q < 4; ++q) { const int col = 128 * hd + 32 * db + 8 * q + 4 * hh;
            float uf[4], gf[4]; unpack4(o.uu[pass][q], uf); unpack4(o.gg[pass][q], gf);
            float m[4];
#pragma unroll
            for (int e = 0; e < 4; ++e) m[e] = (lg[q][e] * acc[4 * q + e] + lb[q][e] * rs + bs) * uf[e] * gf[e];
            u32x2 wo; wo.x = pg8::cvt_pk_bf16(m[0], m[1]); wo.y = pg8::cvt_pk_bf16(m[2], m[3]);
            *(u32x2*)(F.MIX + row * DM + 1536 + col) = wo; }
    }
}
__device__ __forceinline__ void sgu_unit(int l, int ci, int hp, LAS unsigned char* ring) {
    LOCAL_FRAME;
    LAS bf16_t* VnT = (LAS bf16_t*)ring;
    const int lane = F.lane, wv = F.wave;
    const size_t R0 = (size_t)128 * ci;
    const int r = lane & 31, hh = lane >> 5, db = wv & 3; const int tbA = (wv >> 2) ? 1 : 0, tbB = (wv >> 2) ? 2 : 3;
    SguOps op0;
    {
        const int tl = lane >> 2, q4 = lane & 3;
        const bf16_t* vrow = F.Z2 + (R0 + 16 * wv + tl) * ZW + Z_VS + 32 * q4;
        u32x4 x[4][4];
#pragma unroll
        for (int h = 0; h < 4; ++h)
#pragma unroll
            for (int i = 0; i < 4; ++i) x[h][i] = *(const u32x4*)(vrow + 128 * h + 8 * i);
        sgu_load_ops(op0, F, l, 2 * hp, R0, r, hh, db, tbA, tbB);
        float s = 0.f, ss = 0.f;
#pragma unroll
        for (int h = 0; h < 4; ++h)
#pragma unroll
            for (int i = 0; i < 4; ++i) { float f[8]; unpack8(x[h][i], f);
#pragma unroll
                for (int jj = 0; jj < 8; ++jj) { s += f[jj]; ss += f[jj] * f[jj]; } }
        s += __shfl_xor(s, 1); s += __shfl_xor(s, 2); ss += __shfl_xor(ss, 1); ss += __shfl_xor(ss, 2);
        const float mean = s * (1.0f / 512.0f), var = ss * (1.0f / 512.0f) - mean * mean, rstd = rsqrtf(var + EPS);
#pragma unroll
        for (int h2 = 0; h2 < 2; ++h2)
#pragma unroll
            for (int i = 0; i < 4; ++i) { const int d = 32 * q4 + 8 * i;
                const u32x4 xv = hp ? x[2 + h2][i] : x[h2][i];
                float f[8]; unpack8(xv, f);
#pragma unroll
                for (int jj = 0; jj < 8; ++jj) VnT[(h2 * 128 + d + jj) * 136 + 16 * wv + tl] = (bf16_t)(pg8::cvt_pk_bf16((f[jj] - mean) * rstd, 0.f) & 0xffffu); }
    }
    LDS_WAIT();
    __syncthreads();
    f32x16 accA, accB;
    sgu_mfma(op0, VnT, 0, r, hh, db, tbA, tbB, accA, accB);
    SguOps op1;
    sgu_load_ops(op1, F, l, 2 * hp + 1, R0, r, hh, db, tbA, tbB);
    sgu_epi(op0, F, l, 2 * hp, R0, r, hh, db, tbA, tbB, accA, accB);
    sgu_mfma(op1, VnT, 1, r, hh, db, tbA, tbB, accA, accB);
    sgu_epi(op1, F, l, 2 * hp + 1, R0, r, hh, db, tbA, tbB, accA, accB);
    __syncthreads();
}

__device__ __forceinline__ void samp_attn(int l, int bd, int kvh, LAS unsigned char* wl) {
    LOCAL_FRAME;
    LAS float* ps = (LAS float*)wl;
    LAS float* invs = ps + 144 * 16;
    const int lane = F.lane, fr = lane & 15, fq = lane >> 4, gq = fr >> 2, tt = fr & 3;
    float* oKs = F.out + O_KS + (size_t)l * LS_KS; float* oVs = F.out + O_VS + (size_t)l * LS_KS;
    bf16x8 qfr[2];
    {
        const bf16_t* qsrc = F.Qc + ((size_t)MP + 4 * bd + tt) * 1024 + (4 * kvh + gq) * 64 + 16 * fq;
        const u32x4 qa = *(const u32x4*)qsrc, qb = *(const u32x4*)(qsrc + 8);
        u32x4 lo, hi;
        lo.x = (qa.x & 0xffffu) | (qa.y << 16); lo.y = (qa.z & 0xffffu) | (qa.w << 16); lo.z = (qb.x & 0xffffu) | (qb.y << 16); lo.w = (qb.z & 0xffffu) | (qb.w << 16);
        hi.x = (qa.x >> 16) | (qa.y & 0xffff0000u); hi.y = (qa.z >> 16) | (qa.w & 0xffff0000u); hi.z = (qb.x >> 16) | (qb.y & 0xffff0000u); hi.w = (qb.z >> 16) | (qb.w & 0xffff0000u);
        qfr[0] = __builtin_bit_cast(bf16x8, lo); qfr[1] = __builtin_bit_cast(bf16x8, hi);
    }
    const float* kc = F.cache_k + (((size_t)l * 128 + bd) * 128) * 256 + kvh * 64 + 8 * fq;
    const float* kn = oKs + (((size_t)bd * 128 + 124 + (fr & 3)) * 4 + kvh) * 64 + 8 * fq;
    float* kd = oKs + ((size_t)bd * 128 * 4 + kvh) * 64 + 8 * fq;
    f32x4 S[9];
#pragma unroll
    for (int T = 0; T < 9; ++T) S[T] = (f32x4){0.f, 0.f, 0.f, 0.f};
#pragma unroll
    for (int T0 = 0; T0 < 9; T0 += 3) {
        f32x4 x[3][2][2];
#pragma unroll
        for (int u = 0; u < 3; ++u) { const int T = T0 + u; const float* src = (T < 8) ? kc + (size_t)(16 * T + fr) * 256 : kn;
#pragma unroll
            for (int ks = 0; ks < 2; ++ks) { x[u][ks][0] = __builtin_nontemporal_load((const f32x4*)(src + 32 * ks)); x[u][ks][1] = __builtin_nontemporal_load((const f32x4*)(src + 32 * ks + 4)); } }
#pragma unroll
        for (int u = 0; u < 3; ++u) { const int T = T0 + u; const int key = 16 * T + fr;
            if (T < 8 && key >= 4) {
#pragma unroll
                for (int ks = 0; ks < 2; ++ks) { float* dst = kd + (size_t)(key - 4) * 256 + 32 * ks; __builtin_nontemporal_store(x[u][ks][0], (f32x4*)dst); __builtin_nontemporal_store(x[u][ks][1], (f32x4*)(dst + 4)); } } }
#pragma unroll
        for (int u = 0; u < 3; ++u)
#pragma unroll
            for (int ks = 0; ks < 2; ++ks) { u32x4 w; w.x = pg8::cvt_pk_bf16(x[u][ks][0][0], x[u][ks][0][1]); w.y = pg8::cvt_pk_bf16(x[u][ks][0][2], x[u][ks][0][3]);
                w.z = pg8::cvt_pk_bf16(x[u][ks][1][0], x[u][ks][1][1]); w.w = pg8::cvt_pk_bf16(x[u][ks][1][2], x[u][ks][1][3]);
                S[T0 + u] = __builtin_amdgcn_mfma_f32_16x16x32_bf16(__builtin_bit_cast(bf16x8, w), qfr[ks], S[T0 + u], 0, 0, 0); }
        __builtin_amdgcn_sched_barrier(0);
    }
    const float sink2 = F.sinks[l * 16 + 4 * kvh + gq] * LOG2E;
    float m = sink2;
#pragma unroll
    for (int T = 0; T < 9; ++T)
#pragma unroll
        for (int rg = 0; rg < 4; ++rg) { const int key = 16 * T + 4 * fq + rg; const bool ok = (T < 8) ? (key >= tt + 1) : (fq == 0 && rg <= tt);
            S[T][rg] = ok ? S[T][rg] : -INFINITY; m = fmaxf(m, S[T][rg]); }
    m = fmaxf(m, __shfl_xor(m, 16)); m = fmaxf(m, __shfl_xor(m, 32));
    float sum = 0.f;
#pragma unroll
    for (int T = 0; T < 9; ++T)
#pragma unroll
        for (int rg = 0; rg < 4; ++rg) { const float p = __builtin_amdgcn_exp2f(S[T][rg] - m); sum += p; ps[(16 * T + 4 * fq + rg) * 16 + fr] = p; }
    sum += __shfl_xor(sum, 16); sum += __shfl_xor(sum, 32);
    if (fq == 0) invs[fr] = 1.0f / (sum + __builtin_amdgcn_exp2f(sink2 - m));
    LDS_WAIT();
    const int kq = lane >> 4, dq = lane & 15;
    const float* vcp = F.cache_v + (((size_t)l * 128 + bd) * 128 + kq) * 256 + kvh * 64 + 4 * dq;
    float* vop = oVs + ((size_t)bd * 128 + kq) * 256 + kvh * 64 + 4 * dq;
#pragma unroll 1
    for (int pass = 0; pass < 2; ++pass) {
        float o[8][4];
#pragma unroll
        for (int q = 0; q < 8; ++q) { o[q][0] = 0.f; o[q][1] = 0.f; o[q][2] = 0.f; o[q][3] = 0.f; }
#pragma unroll 1
        for (int blk = 0; blk < 3; ++blk) {
            f32x4 vx[11];
#pragma unroll
            for (int ii = 0; ii < 11; ++ii) { const int i = blk * 11 + ii; const float* src = (i < 32) ? vcp + (size_t)i * 1024 : vop + (size_t)31 * 1024; vx[ii] = __builtin_nontemporal_load((const f32x4*)src); }
            if (pass == 0) {
#pragma unroll
                for (int ii = 0; ii < 11; ++ii) { const int i = blk * 11 + ii; if (i >= 1 && i < 32) __builtin_nontemporal_store(vx[ii], (f32x4*)(vop + (size_t)(i - 1) * 1024)); } }
#pragma unroll
            for (int ii = 0; ii < 11; ++ii) { const int key = 4 * (blk * 11 + ii) + kq;
                const f32x4 pa = *(const LAS f32x4*)(ps + key * 16 + 8 * pass), pb = *(const LAS f32x4*)(ps + key * 16 + 8 * pass + 4);
#pragma unroll
                for (int e = 0; e < 4; ++e) { o[0][e] += pa[0] * vx[ii][e]; o[1][e] += pa[1] * vx[ii][e]; o[2][e] += pa[2] * vx[ii][e]; o[3][e] += pa[3] * vx[ii][e];
                    o[4][e] += pb[0] * vx[ii][e]; o[5][e] += pb[1] * vx[ii][e]; o[6][e] += pb[2] * vx[ii][e]; o[7][e] += pb[3] * vx[ii][e]; }
                __builtin_amdgcn_sched_barrier(0); }
        }
#pragma unroll
        for (int q = 0; q < 8; ++q)
#pragma unroll
            for (int e = 0; e < 4; ++e) { float v = o[q][e]; v += __shfl_xor(v, 16); v += __shfl_xor(v, 32); o[q][e] = v; }
#pragma unroll
        for (int q = 0; q < 8; ++q) if ((q >> 1) == kq) { const int qq = 8 * pass + q, t2 = qq & 3, head = 4 * kvh + (qq >> 2); const size_t row = (size_t)MP + 4 * bd + t2;
            float gf[4]; unpack4(*(const u32x2*)(F.Z2 + row * ZW + Z_GA + head * 64 + 4 * dq), gf);
            const float iq = invs[qq];
            u32x2 wv; wv.x = pg8::cvt_pk_bf16(o[q][0] * iq * gf[0], o[q][1] * iq * gf[1]); wv.y = pg8::cvt_pk_bf16(o[q][2] * iq * gf[2], o[q][3] * iq * gf[3]);
            *(u32x2*)(F.MIX + row * DM + head * 64 + 4 * dq) = wv; }
    }
    LDS_WAIT();
}
__device__ __forceinline__ void samp_sgu(int l, int bd) {
    LOCAL_FRAME;
    const int lane = F.lane, c0 = 8 * lane, hd = lane >> 4;
    {
        float* oPs = F.out + O_PS + (size_t)l * LS_PS + (size_t)bd * 15 * 512; const float* sp = F.state_pool + (size_t)l * LS_PS + (size_t)bd * 15 * 512 + 4 * 512;
        f32x4 cp[22];
#pragma unroll
        for (int k = 0; k < 22; ++k) cp[k] = __builtin_nontemporal_load((const f32x4*)(sp + 4 * (lane + 64 * k)));
#pragma unroll
        for (int k = 0; k < 22; ++k) __builtin_nontemporal_store(cp[k], (f32x4*)(oPs + 4 * (lane + 64 * k)));
    }
    float* oCV = F.out + O_CV + (size_t)l * LS_CV;
    float gl[8], bl[8];
#pragma unroll
    for (int j = 0; j < 8; ++j) { gl[j] = F.ln_g[l * 512 + c0 + j]; bl[j] = F.ln_b[l * 512 + c0 + j]; }
    u32x4 xr[4], ur[4], gr[4];
#pragma unroll
    for (int tt = 0; tt < 4; ++tt) { const size_t row = (size_t)MP + 4 * bd + tt; xr[tt] = *(const u32x4*)(F.Z2 + row * ZW + Z_VS + c0); ur[tt] = *(const u32x4*)(F.Z2 + row * ZW + Z_U + c0); gr[tt] = *(const u32x4*)(F.Z2 + row * ZW + Z_GS + c0); }
    float vn[4][8];
#pragma unroll
    for (int tt = 0; tt < 4; ++tt) { float f[8]; unpack8(xr[tt], f);
        float s = 0.f, ss = 0.f;
#pragma unroll
        for (int j = 0; j < 8; ++j) { s += f[j]; ss += f[j] * f[j]; }
        s = wave_sum(s); ss = wave_sum(ss);
        const float mean = s * (1.0f / 512.0f), var = ss * (1.0f / 512.0f) - mean * mean, rstd = rsqrtf(var + EPS);
#pragma unroll
        for (int j = 0; j < 8; ++j) vn[tt][j] = (f[j] - mean) * rstd * gl[j] + bl[j];
        float* o = oCV + ((size_t)bd * 4 + tt) * 512 + c0;
        *(f32x4*)o = (f32x4){vn[tt][0], vn[tt][1], vn[tt][2], vn[tt][3]}; *(f32x4*)(o + 4) = (f32x4){vn[tt][4], vn[tt][5], vn[tt][6], vn[tt][7]}; }
#pragma unroll
    for (int tt = 0; tt < 4; ++tt) { const size_t row = (size_t)MP + 4 * bd + tt;
        float mx[8]; const float bias = F.sgu_b[l * 512 + hd * 128 + tt];
#pragma unroll
        for (int j = 0; j < 8; ++j) mx[j] = bias;
#pragma unroll
        for (int s2 = 0; s2 < 4; ++s2) if (s2 <= tt) { const float w = F.sgu_w[((size_t)(l * 4 + hd) * 128 + tt) * 128 + s2];
#pragma unroll
            for (int j = 0; j < 8; ++j) mx[j] += w * vn[s2][j]; }
        float uf[8], gf[8]; unpack8(ur[tt], uf); unpack8(gr[tt], gf);
#pragma unroll
        for (int j = 0; j < 8; ++j) mx[j] = mx[j] * uf[j] * gf[j];
        *(u32x4*)(F.MIX + row * DM + 1536 + c0) = pack8(mx); }
}

#ifdef HYBRID
__device__ __forceinline__ void attn_task_o(const Frame& F, int l, int b, int nb, int head, int qs, LAS unsigned char* wl) {
    const int lane = F.lane, r = lane & 31, hh = lane >> 5, kvh = head >> 2;
    LAS float* wsf = (LAS float*)wl; LAS bf16_t* stg = (LAS bf16_t*)(wl + 256);
    const int t0 = 128 * nb + 32 * qs;
    const size_t qrow0 = (size_t)b * 2048 + t0;
    const bf16_t* qp = F.Qc + (qrow0 + r) * 1024 + head * 64 + 8 * hh;
    bf16x8 qf[4];
#pragma unroll
    for (int s = 0; s < 4; ++s) qf[s] = *(const bf16x8*)(qp + 16 * s);
    const bf16_t* kbase = F.Kc + (size_t)(b * 4 + kvh) * 2048 * 64;
    const bf16_t* vbase = F.VTP + (size_t)(b * 4 + kvh) * 64 * 2048;
    const int cmin = (nb > 0) ? 0 : (4 - qs);
    f32x16 S[5];
#pragma unroll
    for (int c = 0; c < 5; ++c) {
        f32x16 a;
#pragma unroll
        for (int i = 0; i < 16; ++i) a[i] = 0.f;
        if (c >= cmin) {
            const bf16_t* kp = kbase + (size_t)(t0 - 128 + 32 * c + r) * 64 + 8 * hh;
#pragma unroll
            for (int s = 0; s < 4; ++s) a = __builtin_amdgcn_mfma_f32_32x32x16_bf16(*(const bf16x8*)(kp + 16 * s), qf[s], a, 0, 0, 0);
        }
        S[c] = a;
    }
    const float NEG = -INFINITY;
#pragma unroll
    for (int i = 0; i < 16; ++i) { const int kap = crow(i, hh); if (kap <= r) S[0][i] = NEG; if (kap > r) S[4][i] = NEG; }
    const float sink2 = F.sinks[l * 16 + head] * LOG2E;
    float m = sink2;
#pragma unroll
    for (int c = 0; c < 5; ++c) if (c >= cmin) {
#pragma unroll
        for (int i = 0; i < 16; ++i) m = fmaxf(m, S[c][i]); }
    m = fmaxf(m, __shfl_xor(m, 32));
    float sum = 0.f;
#pragma unroll
    for (int c = 0; c < 5; ++c) if (c >= cmin) {
#pragma unroll
        for (int i = 0; i < 16; ++i) { const float p = __builtin_amdgcn_exp2f(S[c][i] - m); S[c][i] = p; sum += p; } }
    sum += __shfl_xor(sum, 32);
    const float inv = 1.0f / (sum + __builtin_amdgcn_exp2f(sink2 - m));
    f32x16 o[2];
#pragma unroll
    for (int i = 0; i < 16; ++i) { o[0][i] = 0.f; o[1][i] = 0.f; }
#pragma unroll
    for (int c = 0; c < 5; ++c) if (c >= cmin) {
        const bf16_t* vt = vbase + (size_t)((t0 - 128 + 32 * c) >> 5) * 2048 + r * 32 + 16 * hh;
#pragma unroll
        for (int s = 0; s < 2; ++s) {
            u32x4 pw; pw.x = pg8::cvt_pk_bf16(S[c][8 * s + 0], S[c][8 * s + 1]); pw.y = pg8::cvt_pk_bf16(S[c][8 * s + 2], S[c][8 * s + 3]);
            pw.z = pg8::cvt_pk_bf16(S[c][8 * s + 4], S[c][8 * s + 5]); pw.w = pg8::cvt_pk_bf16(S[c][8 * s + 6], S[c][8 * s + 7]);
            const bf16x8 pa = __builtin_bit_cast(bf16x8, pw);
#pragma unroll
            for (int db = 0; db < 2; ++db) o[db] = __builtin_amdgcn_mfma_f32_32x32x16_bf16(pa, *(const bf16x8*)(vt + db * 1024 + 8 * s), o[db], 0, 0, 0);
        }
    }
    if (hh == 0) wsf[r] = inv;
    LDS_WAIT();
#pragma unroll
    for (int i = 0; i < 16; ++i) { const int q = crow(i, hh); const float rl = wsf[q];
        stg[q * 64 + r] = (bf16_t)(pg8::cvt_pk_bf16(o[0][i] * rl, 0.f) & 0xffffu);
        stg[q * 64 + 32 + r] = (bf16_t)(pg8::cvt_pk_bf16(o[1][i] * rl, 0.f) & 0xffffu); }
    LDS_WAIT();
#pragma unroll
    for (int i = 0; i < 4; ++i) { const int row = i * 8 + (lane >> 3), ch = lane & 7;
        const u32x4 ov = *(const LAS u32x4*)(stg + row * 64 + ch * 8);
        const u32x4 gv = *(const u32x4*)(F.Z2 + (qrow0 + row) * ZW + Z_GA + head * 64 + ch * 8);
        float of[8], gf[8]; unpack8(ov, of); unpack8(gv, gf);
#pragma unroll
        for (int j = 0; j < 8; ++j) of[j] *= gf[j];
        *(u32x4*)(F.MIX + (qrow0 + row) * DM + head * 64 + ch * 8) = pack8(of); }
    LDS_WAIT();
}

template <bool SAMPLE>
__device__ __forceinline__ void pool_unit_o(const Frame& F, int l, int g, int tile) {
    const int lane = F.lane, r = lane & 31, hh = lane >> 5, w = 2 << g;
    const size_t row = (size_t)(SAMPLE ? MP : 0) + 32 * tile + r;
    const int t = SAMPLE ? (int)(row & 3) : (int)(row & 2047);
    const int bd = SAMPLE ? (int)((row - MP) >> 2) : 0;
    const float icnt = SAMPLE ? 1.0f / (float)w : 1.0f / (float)(w < t + 1 ? w : t + 1);
    bf16x8 bfr[8];
#pragma unroll
    for (int s = 0; s < 8; ++s) {
        const int c0 = 128 * g + 16 * s + 8 * hh;
        float sum[8], cur[8];
#pragma unroll
        for (int j = 0; j < 8; ++j) { sum[j] = 0.f; cur[j] = 0.f; }
        for (int i = 0; i < w; ++i) {
            float f[8];
            const int e = t - i;
            if (e >= 0) { unpack8(*(const u32x4*)(F.Z2 + (row - i) * ZW + Z_XB + c0), f); }
            else if (SAMPLE) { const float* sp = F.state_pool + (((size_t)l * 128 + bd) * 15 + 15 + e) * 512 + c0;
                const f32x4 a = *(const f32x4*)sp, bq = *(const f32x4*)(sp + 4); f[0] = a[0]; f[1] = a[1]; f[2] = a[2]; f[3] = a[3]; f[4] = bq[0]; f[5] = bq[1]; f[6] = bq[2]; f[7] = bq[3]; }
            else {
#pragma unroll
                for (int j = 0; j < 8; ++j) f[j] = 0.f; }
#pragma unroll
            for (int j = 0; j < 8; ++j) sum[j] += f[j];
            if (i == 0) {
#pragma unroll
                for (int j = 0; j < 8; ++j) cur[j] = f[j]; }
        }
        float pf[8];
#pragma unroll
        for (int j = 0; j < 8; ++j) pf[j] = sum[j] * icnt - cur[j];
        bfr[s] = __builtin_bit_cast(bf16x8, pack8(pf));
    }
    f32x16 acc[4];
#pragma unroll
    for (int db = 0; db < 4; ++db) {
#pragma unroll
        for (int i = 0; i < 16; ++i) acc[db][i] = 0.f;
        const bf16_t* ap = F.PWT + ((size_t)(l * 4 + g) * 128 + 32 * db + r) * 128 + 8 * hh;
#pragma unroll
        for (int s = 0; s < 8; ++s) acc[db] = __builtin_amdgcn_mfma_f32_32x32x16_bf16(*(const bf16x8*)(ap + 16 * s), bfr[s], acc[db], 0, 0, 0);
    }
#pragma unroll
    for (int db = 0; db < 4; ++db)
#pragma unroll
        for (int q = 0; q < 4; ++q) {
            const int col = 128 * g + 32 * db + 8 * q + 4 * hh;
            const f32x4 sc = *(const f32x4*)(F.pool_scale + l * 512 + col);
            float gf[4]; unpack4(*(const u32x2*)(F.Z2 + row * ZW + Z_GP + col), gf);
            u32x2 wv; wv.x = pg8::cvt_pk_bf16(acc[db][4 * q + 0] * sc[0] * gf[0], acc[db][4 * q + 1] * sc[1] * gf[1]);
            wv.y = pg8::cvt_pk_bf16(acc[db][4 * q + 2] * sc[2] * gf[2], acc[db][4 * q + 3] * sc[3] * gf[3]);
            *(u32x2*)(F.MIX + row * DM + 1024 + col) = wv;
        }
}

__device__ __forceinline__ void sgu_unit_o(const Frame& F, int l, int ci, int hd, LAS unsigned char* ring) {
    LAS bf16_t* VnT = (LAS bf16_t*)ring;
    const int lane = F.lane, wv = F.wave;
    const size_t R0 = (size_t)128 * ci;
    {
        const int tl = lane >> 2, q4 = lane & 3;
        const bf16_t* vrow = F.Z2 + (R0 + 16 * wv + tl) * ZW + Z_VS;
        float s = 0.f, ss = 0.f;
#pragma unroll
        for (int i = 0; i < 16; ++i) { float f[8]; unpack8(*(const u32x4*)(vrow + 128 * q4 + 8 * i), f);
#pragma unroll
            for (int j = 0; j < 8; ++j) { s += f[j]; ss += f[j] * f[j]; } }
        s += __shfl_xor(s, 1); s += __shfl_xor(s, 2); ss += __shfl_xor(ss, 1); ss += __shfl_xor(ss, 2);
        const float mean = s * (1.0f / 512.0f), var = ss * (1.0f / 512.0f) - mean * mean, rstd = rsqrtf(var + EPS);
#pragma unroll
        for (int i = 0; i < 4; ++i) { const int d = 32 * q4 + 8 * i; float f[8]; unpack8(*(const u32x4*)(vrow + 128 * hd + d), f);
            const float* gp = F.ln_g + l * 512 + 128 * hd + d; const float* bp = F.ln_b + l * 512 + 128 * hd + d;
#pragma unroll
            for (int j = 0; j < 8; ++j) { const float vn = (f[j] - mean) * rstd * gp[j] + bp[j];
                VnT[(d + j) * 136 + 16 * wv + tl] = (bf16_t)(pg8::cvt_pk_bf16(vn, 0.f) & 0xffffu); } }
    }
    __syncthreads();
    {
        const int r = lane & 31, hh = lane >> 5, db = wv & 3; const int tbA = (wv >> 2) ? 1 : 0, tbB = (wv >> 2) ? 2 : 3;
        f32x16 accA, accB;
#pragma unroll
        for (int i = 0; i < 16; ++i) { accA[i] = 0.f; accB[i] = 0.f; }
        const bf16_t* Wb = F.SGUW + (size_t)(l * 4 + hd) * 128 * 128;
#pragma unroll
        for (int s = 0; s < 8; ++s) {
            if (s < 2 * (tbB + 1)) {
                const bf16x8 a = *(const LAS bf16x8*)(VnT + (32 * db + r) * 136 + 16 * s + 8 * hh);
                accB = __builtin_amdgcn_mfma_f32_32x32x16_bf16(a, *(const bf16x8*)(Wb + (32 * tbB + r) * 128 + 16 * s + 8 * hh), accB, 0, 0, 0);
                if (s < 2 * (tbA + 1)) accA = __builtin_amdgcn_mfma_f32_32x32x16_bf16(a, *(const bf16x8*)(Wb + (32 * tbA + r) * 128 + 16 * s + 8 * hh), accA, 0, 0, 0);
            }
        }
#pragma unroll
        for (int pass = 0; pass < 2; ++pass) {
            const int tb = pass ? tbB : tbA; const f32x16 acc = pass ? accB : accA;
            const int t = 32 * tb + r; const size_t row = R0 + t; const float bias = F.sgu_b[l * 512 + hd * 128 + t];
#pragma unroll
            for (int q = 0; q < 4; ++q) { const int col = 128 * hd + 32 * db + 8 * q + 4 * hh;
                float uf[4], gf[4]; unpack4(*(const u32x2*)(F.Z2 + row * ZW + Z_U + col), uf); unpack4(*(const u32x2*)(F.Z2 + row * ZW + Z_GS + col), gf);
                u32x2 wo; wo.x = pg8::cvt_pk_bf16((acc[4 * q + 0] + bias) * uf[0] * gf[0], (acc[4 * q + 1] + bias) * uf[1] * gf[1]);
                wo.y = pg8::cvt_pk_bf16((acc[4 * q + 2] + bias) * uf[2] * gf[2], (acc[4 * q + 3] + bias) * uf[3] * gf[3]);
                *(u32x2*)(F.MIX + row * DM + 1536 + col) = wo; }
        }
    }
    __syncthreads();
}

__device__ __forceinline__ void samp_attn_o(const Frame& F, int l, int bd, int kvh, LAS unsigned char* wl) {
    LAS float* qs = (LAS float*)wl;
    LAS float* ps = (LAS float*)(wl + 4096);
    const int lane = F.lane;
    float* oKs = F.out + O_KS + (size_t)l * LS_KS; float* oVs = F.out + O_VS + (size_t)l * LS_KS;
    {
        const int qi = lane >> 2, part = lane & 3, gq = qi >> 2, tt = qi & 3;
        const bf16_t* src = F.Qc + ((size_t)MP + 4 * bd + tt) * 1024 + (4 * kvh + gq) * 64 + 16 * part;
        float f0[8], f1[8]; unpack8(*(const u32x4*)src, f0); unpack8(*(const u32x4*)(src + 8), f1);
#pragma unroll
        for (int j = 0; j < 8; ++j) { const int p0 = 16 * part + j, p1 = p0 + 8;
            qs[qi * 64 + (p0 >> 1) + 32 * (p0 & 1)] = f0[j]; qs[qi * 64 + (p1 >> 1) + 32 * (p1 & 1)] = f1[j]; }
    }
    LDS_WAIT();
    float s0[16], s1[16], s2[16];
#pragma unroll
    for (int q = 0; q < 16; ++q) { s0[q] = 0.f; s1[q] = 0.f; s2[q] = 0.f; }
    const float* k0p = F.cache_k + (((size_t)l * 128 + bd) * 128 + lane) * 256 + kvh * 64;
    const float* k1p = k0p + 64 * 256;
    const float* k2p = oKs + (((size_t)bd * 128 + 124 + (lane & 3)) * 4 + kvh) * 64;
    float* c0p = oKs + (((size_t)bd * 128 + (lane >= 4 ? lane - 4 : 0)) * 4 + kvh) * 64;
    float* c1p = oKs + (((size_t)bd * 128 + lane + 60) * 4 + kvh) * 64;
    for (int ch = 0; ch < 16; ++ch) {
        const f32x4 kx0 = *(const f32x4*)(k0p + 4 * ch), kx1 = *(const f32x4*)(k1p + 4 * ch), kx2 = *(const f32x4*)(k2p + 4 * ch);
        if (lane >= 4) *(f32x4*)(c0p + 4 * ch) = kx0;
        *(f32x4*)(c1p + 4 * ch) = kx1;
#pragma unroll
        for (int q = 0; q < 16; ++q) { const f32x4 qv = *(const LAS f32x4*)(qs + q * 64 + 4 * ch);
            s0[q] += (qv[0] * kx0[0] + qv[1] * kx0[1]) + (qv[2] * kx0[2] + qv[3] * kx0[3]);
            s1[q] += (qv[0] * kx1[0] + qv[1] * kx1[1]) + (qv[2] * kx1[2] + qv[3] * kx1[3]);
            s2[q] += (qv[0] * kx2[0] + qv[1] * kx2[1]) + (qv[2] * kx2[2] + qv[3] * kx2[3]); }
    }
    float inv[16];
#pragma unroll
    for (int q = 0; q < 16; ++q) {
        const int tt = q & 3; const float sink2 = F.sinks[l * 16 + 4 * kvh + (q >> 2)] * LOG2E;
        const bool v0 = lane >= tt + 1, v2 = (lane < 4) && (lane <= tt);
        float m = s1[q]; if (v0) m = fmaxf(m, s0[q]); if (v2) m = fmaxf(m, s2[q]);
        m = fmaxf(wave_max(m), sink2);
        const float p0 = v0 ? __builtin_amdgcn_exp2f(s0[q] - m) : 0.f, p1 = __builtin_amdgcn_exp2f(s1[q] - m), p2 = v2 ? __builtin_amdgcn_exp2f(s2[q] - m) : 0.f;
        const float sum = wave_sum(p0 + p1 + p2);
        inv[q] = 1.0f / (sum + __builtin_amdgcn_exp2f(sink2 - m));
        ps[lane * 16 + q] = p0; ps[(lane + 64) * 16 + q] = p1; if (lane < 4) ps[(128 + lane) * 16 + q] = p2;
    }
    LDS_WAIT();
    float o[16];
#pragma unroll
    for (int q = 0; q < 16; ++q) o[q] = 0.f;
    const float* vcp = F.cache_v + (((size_t)l * 128 + bd) * 128) * 256 + kvh * 64 + lane;
    float* vop = oVs + ((size_t)bd * 128) * 256 + kvh * 64 + lane;
    for (int key = 0; key < 132; ++key) {
        float v;
        if (key < 128) { v = vcp[(size_t)key * 256]; if (key >= 4) vop[(size_t)(key - 4) * 256] = v; }
        else v = vop[(size_t)(key - 4) * 256];
#pragma unroll
        for (int q4 = 0; q4 < 4; ++q4) { const f32x4 pv = *(const LAS f32x4*)(ps + key * 16 + 4 * q4);
            o[4 * q4 + 0] += pv[0] * v; o[4 * q4 + 1] += pv[1] * v; o[4 * q4 + 2] += pv[2] * v; o[4 * q4 + 3] += pv[3] * v; }
    }
#pragma unroll
    for (int q = 0; q < 16; ++q) { const int tt = q & 3, head = 4 * kvh + (q >> 2); const size_t row = (size_t)MP + 4 * bd + tt;
        const float gv = __uint_as_float(((unsigned)F.Z2[row * ZW + Z_GA + head * 64 + lane]) << 16);
        F.MIX[row * DM + head * 64 + lane] = (bf16_t)(pg8::cvt_pk_bf16(o[q] * inv[q] * gv, 0.f) & 0xffffu); }
    LDS_WAIT();
}
__device__ __forceinline__ void samp_sgu_o(const Frame& F, int l, int bd) {
    const int lane = F.lane, c0 = 8 * lane, hd = lane >> 4;
    float* oCV = F.out + O_CV + (size_t)l * LS_CV;
    float gl[8], bl[8];
#pragma unroll
    for (int j = 0; j < 8; ++j) { gl[j] = F.ln_g[l * 512 + c0 + j]; bl[j] = F.ln_b[l * 512 + c0 + j]; }
    float vn[4][8];
#pragma unroll
    for (int tt = 0; tt < 4; ++tt) { const size_t row = (size_t)MP + 4 * bd + tt; float f[8]; unpack8(*(const u32x4*)(F.Z2 + row * ZW + Z_VS + c0), f);
        float s = 0.f, ss = 0.f;
#pragma unroll
        for (int j = 0; j < 8; ++j) { s += f[j]; ss += f[j] * f[j]; }
        s = wave_sum(s); ss = wave_sum(ss);
        const float mean = s * (1.0f / 512.0f), var = ss * (1.0f / 512.0f) - mean * mean, rstd = rsqrtf(var + EPS);
#pragma unroll
        for (int j = 0; j < 8; ++j) vn[tt][j] = (f[j] - mean) * rstd * gl[j] + bl[j];
        float* o = oCV + ((size_t)bd * 4 + tt) * 512 + c0;
        *(f32x4*)o = (f32x4){vn[tt][0], vn[tt][1], vn[tt][2], vn[tt][3]}; *(f32x4*)(o + 4) = (f32x4){vn[tt][4], vn[tt][5], vn[tt][6], vn[tt][7]}; }
#pragma unroll
    for (int tt = 0; tt < 4; ++tt) { const size_t row = (size_t)MP + 4 * bd + tt;
        float mx[8]; const float bias = F.sgu_b[l * 512 + hd * 128 + tt];
#pragma unroll
        for (int j = 0; j < 8; ++j) mx[j] = bias;
#pragma unroll
        for (int s2 = 0; s2 < 4; ++s2) if (s2 <= tt) { const float w = F.sgu_w[((size_t)(l * 4 + hd) * 128 + tt) * 128 + s2];
#pragma unroll
            for (int j = 0; j < 8; ++j) mx[j] += w * vn[s2][j]; }
        float uf[8], gf[8]; unpack8(*(const u32x4*)(F.Z2 + row * ZW + Z_U + c0), uf); unpack8(*(const u32x4*)(F.Z2 + row * ZW + Z_GS + c0), gf);
#pragma unroll
        for (int j = 0; j < 8; ++j) mx[j] = mx[j] * uf[j] * gf[j];
        *(u32x4*)(F.MIX + row * DM + 1536 + c0) = pack8(mx); }
}

#endif
struct NormRowIn { u32x4 yv[4]; f32x4 xv[4][2]; };
__device__ __forceinline__ void norm_row_load(NormRowIn& in, const Frame& F, int l, int row) {
    const int lane = F.lane;
    const bf16_t* yr = F.Yb + (size_t)row * DM + 8 * lane;
    const float* xr = ((l == 0) ? (row < MP ? F.xp + (size_t)row * DM : F.xs + (size_t)(row - MP) * DM) : F.out + (size_t)row * DM) + 8 * lane;
#pragma unroll
    for (int j = 0; j < 4; ++j) { in.yv[j] = __builtin_nontemporal_load((const u32x4*)(yr + 512 * j)); in.xv[j][0] = __builtin_nontemporal_load((const f32x4*)(xr + 512 * j)); in.xv[j][1] = __builtin_nontemporal_load((const f32x4*)(xr + 512 * j + 4)); }
}
__device__ __forceinline__ void norm_row_finish(const NormRowIn& in, const Frame& F, int l, int row) {
    const int lane = F.lane;
    float* orow = F.out + (size_t)row * DM + 8 * lane;
    const float* pg = F.norm_post + l * DM + 8 * lane; const float* g1 = F.norm_pre + DM + 8 * lane;
    float y[4][8]; float ss = 0.f;
#pragma unroll
    for (int j = 0; j < 4; ++j) { unpack8(in.yv[j], y[j]);
#pragma unroll
        for (int e = 0; e < 8; ++e) ss += y[j][e] * y[j][e]; }
    ss = wave_sum(ss);
    const float ry = rsqrtf(ss * (1.0f / 2048.0f) + EPS);
    float s1 = 0.f;
#pragma unroll
    for (int j = 0; j < 4; ++j) { const f32x4 ga = *(const f32x4*)(pg + 512 * j), gb = *(const f32x4*)(pg + 512 * j + 4);
#pragma unroll
        for (int e = 0; e < 4; ++e) { y[j][e] = in.xv[j][0][e] + y[j][e] * ry * ga[e]; y[j][4 + e] = in.xv[j][1][e] + y[j][4 + e] * ry * gb[e]; }
        __builtin_nontemporal_store((f32x4){y[j][0], y[j][1], y[j][2], y[j][3]}, (f32x4*)(orow + 512 * j)); __builtin_nontemporal_store((f32x4){y[j][4], y[j][5], y[j][6], y[j][7]}, (f32x4*)(orow + 512 * j + 4));
#pragma unroll
        for (int e = 0; e < 8; ++e) s1 += y[j][e] * y[j][e]; }
    if (l == 0) {
        s1 = wave_sum(s1);
        const float r1 = rsqrtf(s1 * (1.0f / 2048.0f) + EPS);
        bf16_t* hrow = F.H + (size_t)row * DM + 8 * lane;
#pragma unroll
        for (int j = 0; j < 4; ++j) { const f32x4 ga = *(const f32x4*)(g1 + 512 * j), gb = *(const f32x4*)(g1 + 512 * j + 4); float o[8];
#pragma unroll
            for (int e = 0; e < 4; ++e) { o[e] = y[j][e] * r1 * ga[e]; o[4 + e] = y[j][4 + e] * r1 * gb[e]; }
            *(u32x4*)(hrow + 512 * j) = pack8(o); }
    }
}
__device__ __forceinline__ void norm_rows4(int l, int row0) { LOCAL_FRAME;
#pragma unroll 1
    for (int k = 0; k < 4; k += 2) { NormRowIn a, b; norm_row_load(a, F, l, row0 + k); norm_row_load(b, F, l, row0 + k + 1);
        norm_row_finish(a, F, l, row0 + k); norm_row_finish(b, F, l, row0 + k + 1); } }

constexpr int Q2_G = 40, Q2_AT = Q2_G + 256, Q2_SG = Q2_AT + 256, Q2_SA = Q2_SG + 64, Q2_SS = Q2_SA + 16, Q2_SP = Q2_SS + 8, Q2_PO = Q2_SP + 256;
__device__ __forceinline__ void slot2(int l, LAS unsigned char* L, LAS unsigned char* ring) {
    int t_ = threadIdx.x; asm volatile("" : "+v"(t_)); const int wave = __builtin_amdgcn_readfirstlane(t_ >> 6);
    unsigned* head = ctl_word(CW_Q + 64 * (2 * l));
    EV_T0();
#pragma unroll 1
    for (;;) {
        const int it = q_pop(head, L);
        if (it >= Q2_PO) { if (l == 0) { EV_MAX(0); EV_MIN(1); } break; }
        if (it < Q2_G) {
            unsigned char* ws = (unsigned char*)kargs()->ws;
            pg8::Gemm g{(const bf16_t*)(ws + WS_H), (const bf16_t*)(ws + WS_WTIN) + (size_t)l * DIN * DM, MT, DIN, DM};
            OneUnit S; S.u.pm = 64 + it / 20; S.u.pn = it % 20;
            pg8::EpiIn E{l};
            pg8::gemm_phase<pg8::EpiIn, OneUnit, false, true>(ring, g, S, E);
            publish(ctl_word(CW_ZS + 64 * (2 * l + it / 20)));
            if (l == 0) { EV_MAX(2); EV_MIN(3); }
        }
        else if (it < Q2_AT) { attn_unit(l, it - Q2_G, ring); if (l == 0) EV_MAX(4); }
        else if (it < Q2_SG) { const int u = it - Q2_AT; sgu_unit(l, u >> 1, u & 1, ring); if (l == 0) EV_MAX(5); }
        else if (it < Q2_SA) { const int i = it - Q2_SG; dep_wait(ctl_word(CW_ZS + 64 * (2 * l + (i >> 5))), 20u); if (l == 0) EV_MIN(6); const int k = 8 * i + wave; samp_attn(l, k >> 2, k & 3, ring + wave * 9472); __syncthreads(); if (l == 0) EV_MAX(7); }
        else if (it < Q2_SS) { const int i = it - Q2_SA; dep_wait(ctl_word(CW_ZS + 64 * (2 * l + (i >> 3))), 20u); samp_sgu(l, 8 * i + wave); }
        else if (it < Q2_SP) { const int i = it - Q2_SS; dep_wait(ctl_word(CW_ZS + 64 * (2 * l + (i >> 2))), 20u); const int k = 8 * i + wave; pool_sample(l, k & 3, k >> 2); }
        else { const int i = 8 * (it - Q2_SP) + wave; pool_prompt(l, i & 3, i >> 2, ring + wave * PL_WBYTES); }
    }
}
constexpr int Q4_G = 16, Q4_P = Q4_G + 512, Q4_S = Q4_P + 16;
__device__ __forceinline__ void slot4(int l, LAS unsigned char* L, LAS unsigned char* ring) {
    int t_ = threadIdx.x; asm volatile("" : "+v"(t_)); const int wave = __builtin_amdgcn_readfirstlane(t_ >> 6);
    unsigned* head = ctl_word(CW_Q + 64 * (2 * l + 1));
#pragma unroll 1
    for (;;) {
        const int it = q_pop(head, L);
        if (it >= Q4_S) break;
        if (it < Q4_G) {
            unsigned char* ws = (unsigned char*)kargs()->ws;
            pg8::Gemm g{(const bf16_t*)(ws + WS_MIX), (const bf16_t*)(ws + WS_WTOUT) + (size_t)l * DM * DM, MT, DM, DM};
            OneUnit S; S.u.pm = 64 + it / 8; S.u.pn = it % 8;
            pg8::EpiOut E{};
            pg8::gemm_phase<pg8::EpiOut, OneUnit, false, true>(ring, g, S, E);
            publish(ctl_word(CW_YS + 64 * (2 * l + it / 8)));
        }
        else if (it < Q4_P) norm_rows4(l, 32 * (it - Q4_G) + 4 * wave);
        else { const int i = it - Q4_P; dep_wait(ctl_word(CW_YS + 64 * (2 * l + (i >> 3))), 8u); norm_rows4(l, MP + 32 * i + 4 * wave); }
    }
}

__global__ void __launch_bounds__(NTHREADS, 2) hymba_fwd(Args a_unused) {
    extern __shared__ __attribute__((aligned(16))) unsigned char lds[];
    LAS unsigned char* L = (LAS unsigned char*)lds;
    if (threadIdx.x < 256) ((LAS unsigned*)L)[threadIdx.x] = 0u;
    __syncthreads();
    XcdBarrier bar = xcd_barrier_post((unsigned*)((unsigned char*)kargs()->ws + WS_CTL) + CW_BAR, (volatile LAS unsigned*)L + 8);
    LAS unsigned char* ring = L + RING_OFF;
    STAMP(0);
#ifndef NO_P0
    { Frame F; make_frame(F, kargs()); p0_prologue(F, ring); }
#endif
    xcd_barrier(bar);
    STAMP(1);
#pragma unroll 1
    for (int l = 0; l < 2; ++l) {
#ifndef NO_P1
        {
            KArgs ka = kargs(); unsigned char* ws = (unsigned char*)ka->ws;
            pg8::Gemm g{(const bf16_t*)(ws + WS_H), (const bf16_t*)(ws + WS_WTIN) + (size_t)l * DIN * DM, MP, DIN, DM}; pg8::StaticOrder S; S.init(MP, DIN, (int)gridDim.x, (int)blockIdx.x);
            pg8::EpiIn E{l};
            pg8::gemm_phase<pg8::EpiIn, pg8::StaticOrder, true, true>(ring, g, S, E);
        }
#endif
        xcd_barrier(bar);
        STAMP(2 + 4 * l);
#ifndef NO_P2
        slot2(l, L, ring);
#endif
        xcd_barrier(bar);
        STAMP(3 + 4 * l);
#ifndef NO_P3
        {
            KArgs ka = kargs(); unsigned char* ws = (unsigned char*)ka->ws;
            pg8::Gemm g{(const bf16_t*)(ws + WS_MIX), (const bf16_t*)(ws + WS_WTOUT) + (size_t)l * DM * DM, MP, DM, DM}; pg8::StaticOrder S; S.init(MP, DM, (int)gridDim.x, (int)blockIdx.x);
            pg8::EpiOut E{};
            pg8::gemm_phase<pg8::EpiOut, pg8::StaticOrder, true, true>(ring, g, S, E);
        }
#endif
        xcd_barrier(bar);
        STAMP(4 + 4 * l);
#ifndef NO_P4
        slot4(l, L, ring);
#endif
        if (l == 0) xcd_barrier(bar);
#if PROBE_SEL
        if (l == 1) __syncthreads();
#endif
        STAMP(5 + 4 * l);
    }
#if PROBE_SEL
    if (blockIdx.x == 0 && threadIdx.x == 0) {
#if PROBE_SEL >= 10
        unsigned ea = __hip_atomic_load(ctl_word(CW_EV + 64 * PEA), __ATOMIC_RELAXED, __HIP_MEMORY_SCOPE_AGENT), eb = __hip_atomic_load(ctl_word(CW_EV + 64 * PEB), __ATOMIC_RELAXED, __HIP_MEMORY_SCOPE_AGENT);
        if (PEA_MIN) ea = 0x40000000u - ea; if (PEB_MIN) eb = 0x40000000u - eb;
        unsigned long long da = (ea + 400) / 800, db = (eb + 400) / 800;
#else
        LAS unsigned long long* ts = (LAS unsigned long long*)(L + 256);
        unsigned long long da = (ts[PA1] - ts[PA0] + 400) / 800, db = (ts[PB1] - ts[PB0] + 400) / 800;
#endif
        if (da > 63) da = 63; if (db > 63) db = 63;
        const unsigned long long extra = (da + 64 * db) * 1600ull, t0 = __builtin_amdgcn_s_memrealtime();
        while (__builtin_amdgcn_s_memrealtime() - t0 < extra) __builtin_amdgcn_s_sleep(32);
    }
#endif
}

extern "C" void kernel_launch(void* const* d_in, const int* in_sizes, int n_in, void* d_out, int out_size, void* d_ws, size_t ws_size, hipStream_t stream) {
    static int grid = 0;
    if (grid == 0) {
        if (n_in != 16 || (size_t)out_size != O_END || ws_size < WS_END) { fprintf(stderr, "kernel_launch: unexpected shapes: n_in %d out %d ws %zu (need %zu)\n", n_in, out_size, ws_size, (size_t)WS_END); grid = -1; return; }
        int dev = 0, cus = 0, per_cu = 0;
        if (hipGetDevice(&dev) != hipSuccess || hipDeviceGetAttribute(&cus, hipDeviceAttributeMultiprocessorCount, dev) != hipSuccess) { fprintf(stderr, "kernel_launch: device query failed\n"); grid = -1; return; }
        if (hipFuncSetAttribute((const void*)hymba_fwd, hipFuncAttributeMaxDynamicSharedMemorySize, LDS_BYTES) != hipSuccess) { fprintf(stderr, "kernel_launch: hipFuncSetAttribute failed\n"); grid = -1; return; }
        if (hipOccupancyMaxActiveBlocksPerMultiprocessor(&per_cu, (const void*)hymba_fwd, NTHREADS, LDS_BYTES) != hipSuccess || per_cu < 1) { fprintf(stderr, "kernel_launch: occupancy query says %d blocks/CU\n", per_cu); (void)hipGetLastError(); grid = -1; return; }
        grid = cus;
    }
    if (grid < 0) return;
    (void)hipMemsetAsync((char*)d_ws + WS_CTL, 0, CTL_ZERO_BYTES, stream);
    Args a{};
    for (int i = 0; i < 16; ++i) a.in[i] = (const float*)d_in[i];
    a.out = (float*)d_out; a.ws = (unsigned char*)d_ws;
    void* params[] = {&a};
    hipError_t e = hipLaunchCooperativeKernel((const void*)hymba_fwd, dim3(grid), dim3(NTHREADS), params, LDS_BYTES, stream);
    if (e != hipSuccess) fprintf(stderr, "kernel_launch: cooperative launch failed: %s (grid %d)\n", hipGetErrorString(e), grid);
}
```

```cpp
#include <hip/hip_runtime.h>
#include <cstdio>
#include <cstdint>
#include <cmath>
namespace pg8 {
#define PG8_LAS __attribute__((address_space(3)))
typedef unsigned short bf16_t;
typedef short bf16x8 __attribute__((ext_vector_type(8)));
typedef float f32x4 __attribute__((ext_vector_type(4)));
typedef unsigned u32x4 __attribute__((ext_vector_type(4)));
constexpr int BM = 256, BK = 64, HALF = 128, HTB = HALF * BK * 2  , STAGE_BYTES = 8 * HTB, NXCD = 8, WGM = 8;

__host__ __device__ __forceinline__ int lds_byte(int r, int c) { const int st = (r >> 4) * 2 + (c >> 5), rr = r & 15, cc = c & 31, ob = rr * 64 + cc * 2; return st * 1024 + (ob ^ (((ob >> 9) & 1) << 5)); }
__host__ __device__ __forceinline__ void stage_rc(int b, int& R, int& C) { const int st = b / 1024, sb = b % 1024, swz = sb ^ (((sb >> 9) & 1) << 5); R = (st >> 1) * 16 + swz / 64; C = (st & 1) * 32 + (swz % 64) / 2; }
__host__ __device__ __forceinline__ int perm32(int rho) { const int n = rho >> 4, i = rho & 15; return 8 * (i >> 2) + 4 * n + (i & 3); }

struct Unit { int pm, pn; };
struct Gemm { const bf16_t* A; const bf16_t* Bt; int M, N, K; };

struct StaticOrder {
    int nM, nN, nwg, G, c;
    __host__ __device__ void init(int M, int N, int G_, int c_) { nM = M / BM; nN = N / BM; nwg = nM * nN; G = G_; c = c_; }
    __host__ __device__ bool next(int i, Unit& u) const {
        const long L = (long)i * G + c; if (L >= nwg) return false;
        int wgid = (int)L; { const int q = nwg / NXCD, r = nwg % NXCD, xcd = wgid % NXCD, off = wgid / NXCD; wgid = (xcd < r ? xcd * (q + 1) : r * (q + 1) + (xcd - r) * q) + off; }
        const int nig = WGM * nN, gid = wgid / nig, fm = gid * WGM, gsz = (nM - fm) < WGM ? (nM - fm) : WGM;
        u.pm = fm + ((wgid % nig) % gsz); u.pn = (wgid % nig) / gsz; return true;
    }
    __device__ __forceinline__ void a_ready(const Unit&) const {}
    __device__ __forceinline__ void done(const Unit&) const {}
};

constexpr int DM = 2048, MP = 16384, MS = 512, MT = MP + MS, DIN = 5120;
constexpr int ZW = 3584;
constexpr int Z_GA = 0, Z_XB = 1024, Z_GP = 1536, Z_U = 2048, Z_VS = 2560, Z_GS = 3072;
constexpr float LOG2E = 1.4426950408889634f, QSCALE = 0.125f * LOG2E, EPS = 1e-6f;

__device__ __forceinline__ unsigned cvt_pk_bf16(float lo, float hi) { unsigned r; asm("v_cvt_pk_bf16_f32 %0, %1, %2" : "=v"(r) : "v"(lo), "v"(hi)); return r; }
__device__ __forceinline__ float silu_f(float x) { return x * __builtin_amdgcn_rcpf(1.0f + __builtin_amdgcn_exp2f(-x * LOG2E)); }
__device__ __forceinline__ int vperm32(int x) { return ((x >> 2) & 1) * 16 + (x >> 3) * 4 + (x & 3); }

struct EpiPtrs { const __attribute__((address_space(1))) float* in[16]; __attribute__((address_space(1))) float* out; __attribute__((address_space(1))) unsigned char* ws; };
constexpr size_t EP_ROPE = (size_t)1 << 20, EP_QC = (size_t)192 << 20, EP_KC = (size_t)225 << 20, EP_VTP = (size_t)233 << 20, EP_Z2 = (size_t)241 << 20, EP_Y = (size_t)357 << 20;
constexpr size_t EO_KP = 34603008, EO_VP = 35127296, EO_PP = 35651584, EO_KS = 35774464, EO_VS = 44163072, EO_PS = 52551680;
struct EpiIn {
    static constexpr bool PERM = true, AFTER_DRAIN = false;
    int l;
    __device__ __forceinline__ void operator()(const f32x4 (&acc)[2][2][4][2], const Unit& u, int wr, int wc, int fr, int fq) const {
        const __attribute__((address_space(4))) EpiPtrs* kp = (const __attribute__((address_space(4))) EpiPtrs*)__builtin_amdgcn_kernarg_segment_ptr(); asm volatile("" : "+s"(kp));
        unsigned char* ws = (unsigned char*)kp->ws; float* outp = (float*)kp->out;
        bf16_t* Qc = (bf16_t*)(ws + EP_QC); bf16_t* Kc = (bf16_t*)(ws + EP_KC); bf16_t* VTP = (bf16_t*)(ws + EP_VTP); bf16_t* Z2 = (bf16_t*)(ws + EP_Z2); const float* rope = (const float*)(ws + EP_ROPE);
        float* oKp = outp + EO_KP + (size_t)l * 262144; float* oVp = outp + EO_VP + (size_t)l * 262144; float* oPp = outp + EO_PP + (size_t)l * 61440;
        float* oKs = outp + EO_KS + (size_t)l * 4194304; float* oVs = outp + EO_VS + (size_t)l * 4194304; float* oPs = outp + EO_PS + (size_t)l * 983040;
        const int pn = u.pn;
        const int row0 = u.pm * 256 + wr * 64 + fr;
        const int cw = wc * 32 + 8 * fq;
        if (pn < 5) {
#pragma unroll
            for (int ai = 0; ai < 2; ++ai)
#pragma unroll
                for (int m = 0; m < 4; ++m) {
                    const int row = row0 + ai * 128 + m * 16;
                    const bool smp = row >= MP;
                    const int tpos = smp ? 2048 + (row & 3) : (row & 2047);
                    const float* rp = rope + tpos * 64;
#pragma unroll
                    for (int bj = 0; bj < 2; ++bj) {
                        const int c = pn * 256 + bj * 128 + cw;
                        const int i0 = (c & 63) >> 1;
                        const f32x4 cs = *(const f32x4*)(rp + i0), sn = *(const f32x4*)(rp + 32 + i0);
                        const f32x4 v0 = acc[ai][bj][m][0], v1 = acc[ai][bj][m][1];
                        f32x4 o1, o2;
                        o1[0] = v0[0] * cs[0] - v0[1] * sn[0]; o2[0] = v0[1] * cs[0] + v0[0] * sn[0];
                        o1[1] = v0[2] * cs[1] - v0[3] * sn[1]; o2[1] = v0[3] * cs[1] + v0[2] * sn[1];
                        o1[2] = v1[0] * cs[2] - v1[1] * sn[2]; o2[2] = v1[1] * cs[2] + v1[0] * sn[2];
                        o1[3] = v1[2] * cs[3] - v1[3] * sn[3]; o2[3] = v1[3] * cs[3] + v1[2] * sn[3];
                        if (pn < 4) {
                            o1 = o1 * QSCALE; o2 = o2 * QSCALE;
                            u32x4 w; w.x = cvt_pk_bf16(o1[0], o2[0]); w.y = cvt_pk_bf16(o1[1], o2[1]); w.z = cvt_pk_bf16(o1[2], o2[2]); w.w = cvt_pk_bf16(o1[3], o2[3]);
                            *(u32x4*)(Qc + (size_t)row * 1024 + c) = w;
                        } else {
                            const int kvh = (c - 1024) >> 6;
                            if (!smp) {
                                const int b = row >> 11, t = row & 2047;
                                u32x4 w; w.x = cvt_pk_bf16(o1[0], o2[0]); w.y = cvt_pk_bf16(o1[1], o2[1]); w.z = cvt_pk_bf16(o1[2], o2[2]); w.w = cvt_pk_bf16(o1[3], o2[3]);
                                *(u32x4*)(Kc + ((size_t)((b * 4 + kvh) * 2048 + t)) * 64 + (c & 63)) = w;
                                if (t >= 1920) { float* o = oKp + ((size_t)((b * 128 + t - 1920) * 4 + kvh)) * 64 + i0; *(f32x4*)o = o1; *(f32x4*)(o + 32) = o2; }
                            } else {
                                const int bd = (row - MP) >> 2, tt = row & 3;
                                float* o = oKs + ((size_t)((bd * 128 + 124 + tt) * 4 + kvh)) * 64 + i0; *(f32x4*)o = o1; *(f32x4*)(o + 32) = o2;
                            }
                        }
                    }
                }
        } else if (pn == 5) {
#pragma unroll
            for (int ai = 0; ai < 2; ++ai)
#pragma unroll
                for (int m = 0; m < 4; ++m) {
                    const int row = row0 + ai * 128 + m * 16;
                    const bool smp = row >= MP;
#pragma unroll
                    for (int bj = 0; bj < 2; ++bj) {
                        const int cv = bj * 128 + cw;
                        const int kvh = cv >> 6, d0 = cv & 63;
                        const f32x4 v0 = acc[ai][bj][m][0], v1 = acc[ai][bj][m][1];
                        if (!smp) {
                            const int b = row >> 11, t = row & 2047;
                            bf16_t* vp = VTP + ((size_t)((b * 4 + kvh) * 64 + (t >> 5))) * 2048 + d0 * 32 + vperm32(t & 31);
                            const unsigned w0 = cvt_pk_bf16(v0[0], v0[1]), w1 = cvt_pk_bf16(v0[2], v0[3]), w2 = cvt_pk_bf16(v1[0], v1[1]), w3 = cvt_pk_bf16(v1[2], v1[3]);
                            vp[0] = (bf16_t)(w0 & 0xffffu); vp[32] = (bf16_t)(w0 >> 16); vp[64] = (bf16_t)(w1 & 0xffffu); vp[96] = (bf16_t)(w1 >> 16);
                            vp[128] = (bf16_t)(w2 & 0xffffu); vp[160] = (bf16_t)(w2 >> 16); vp[192] = (bf16_t)(w3 & 0xffffu); vp[224] = (bf16_t)(w3 >> 16);
                            if (t >= 1920) { float* o = oVp + ((size_t)((b * 128 + t - 1920) * 4 + kvh)) * 64 + d0; *(f32x4*)o = v0; *(f32x4*)(o + 4) = v1; }
                        } else {
                            const int bd = (row - MP) >> 2, tt = row & 3;
                            float* o = oVs + ((size_t)((bd * 128 + 124 + tt) * 4 + kvh)) * 64 + d0; *(f32x4*)o = v0; *(f32x4*)(o + 4) = v1;
                        }
                    }
                }
        } else {
            const bool gate = (pn < 10) || (pn == 12) || (pn == 13) || (pn >= 18);
            const bool isxb = (pn == 10) || (pn == 11);
#pragma unroll
            for (int ai = 0; ai < 2; ++ai)
#pragma unroll
                for (int m = 0; m < 4; ++m) {
                    const int row = row0 + ai * 128 + m * 16;
                    const bool smp = row >= MP;
#pragma unroll
                    for (int bj = 0; bj < 2; ++bj) {
                        const int c = pn * 256 + bj * 128 + cw;
                        f32x4 v0 = acc[ai][bj][m][0], v1 = acc[ai][bj][m][1];
                        if (isxb) {
                            const int cx = c - 2560;
                            if (!smp) { const int t = row & 2047; if (t >= 2033) { const int b = row >> 11; float* o = oPp + ((size_t)(b * 15 + t - 2033)) * 512 + cx; *(f32x4*)o = v0; *(f32x4*)(o + 4) = v1; } }
                            else { const int bd = (row - MP) >> 2, tt = row & 3; float* o = oPs + ((size_t)(bd * 15 + 11 + tt)) * 512 + cx; *(f32x4*)o = v0; *(f32x4*)(o + 4) = v1; }
                        }
                        if (gate) {
#pragma unroll
                            for (int j = 0; j < 4; ++j) { v0[j] = silu_f(v0[j]); v1[j] = silu_f(v1[j]); }
                        }
                        u32x4 w; w.x = cvt_pk_bf16(v0[0], v0[1]); w.y = cvt_pk_bf16(v0[2], v0[3]); w.z = cvt_pk_bf16(v1[0], v1[1]); w.w = cvt_pk_bf16(v1[2], v1[3]);
                        *(u32x4*)(Z2 + (size_t)row * ZW + (c - 1536)) = w;
                    }
                }
        }
    }
};

struct EpiOut {
    static constexpr bool PERM = true, AFTER_DRAIN = false;
    __device__ __forceinline__ void operator()(const f32x4 (&acc)[2][2][4][2], const Unit& u, int wr, int wc, int fr, int fq) const {
        const __attribute__((address_space(4))) EpiPtrs* kp = (const __attribute__((address_space(4))) EpiPtrs*)__builtin_amdgcn_kernarg_segment_ptr(); asm volatile("" : "+s"(kp));
        bf16_t* C = (bf16_t*)((unsigned char*)kp->ws + EP_Y);
        const int row0 = u.pm * BM + wr * 64 + fr, col0 = u.pn * BM + wc * 32 + 8 * fq;
#pragma unroll
        for (int ai = 0; ai < 2; ++ai)
#pragma unroll
            for (int m = 0; m < 4; ++m) { bf16_t* rowp = C + (size_t)(row0 + ai * HALF + m * 16) * DM + col0;
#pragma unroll
                for (int bj = 0; bj < 2; ++bj) { const f32x4 v0 = acc[ai][bj][m][0], v1 = acc[ai][bj][m][1];
                    u32x4 w; w.x = cvt_pk_bf16(v0[0], v0[1]); w.y = cvt_pk_bf16(v0[2], v0[3]); w.z = cvt_pk_bf16(v1[0], v1[1]); w.w = cvt_pk_bf16(v1[2], v1[3]);
                    *(u32x4*)(rowp + bj * HALF) = w; } }
    }
};
template <class Epi, class Sched, bool ALIGN_EPI = false, bool SP2 = false>
__device__ __forceinline__ void gemm_phase(PG8_LAS unsigned char* lds, const Gemm g, const Sched& S, const Epi& E) {
    int tid_ = threadIdx.x; asm volatile("" : "+v"(tid_));
    const int tid = tid_, wid = __builtin_amdgcn_readfirstlane(tid >> 6), lane = tid & 63, wr = wid >> 2, wc = wid & 3, fr = lane & 15, fq = lane >> 4;
    const int K = g.K, nt = K / BK;
    unsigned voffA[2], voffB[2];
#pragma unroll
    for (int i = 0; i < 2; ++i) { int R, C; stage_rc(tid * 16 + i * 8192, R, C); const int Rb = Epi::PERM ? ((R & ~31) + perm32(R & 31)) : R;
        voffA[i] = (unsigned)(R * K + C) * 2u; voffB[i] = (unsigned)(Rb * K + C) * 2u; }
    const size_t kstep = (size_t)(BK * 2);
    const size_t hstep = (size_t)HALF * K * 2;
    const size_t tstep = 2 * hstep;
    const unsigned ldsw = (unsigned)wid * 1024u;
    const int aoff = lds_byte(wr * 64 + fr, fq * 8), boff = lds_byte(wc * 32 + fr, fq * 8);
#define PG8_SA(b, h) (((b) * 2 + (h)) * HTB)
#define PG8_SB(b, h) ((4 + (b) * 2 + (h)) * HTB)
#define PG8_STAGE(bufoff, gbase, voff) do { _Pragma("unroll") for (int _i = 0; _i < 2; ++_i) \
        __builtin_amdgcn_global_load_lds((const unsigned*)((const char*)(gbase) + (voff)[_i]), (PG8_LAS unsigned*)(lds + (bufoff) + ldsw + _i * 8192), 16, 0, 0); } while (0)
#define PG8_LDA(dst, b, h) do { _Pragma("unroll") for (int m = 0; m < 4; ++m) _Pragma("unroll") for (int k = 0; k < 2; ++k) dst[m][k] = *(const PG8_LAS bf16x8*)(lds + PG8_SA(b, h) + aoff + m * 2048 + k * 1024); } while (0)
#define PG8_LDB(dst, b, h) do { _Pragma("unroll") for (int n = 0; n < 2; ++n) _Pragma("unroll") for (int k = 0; k < 2; ++k) dst[n][k] = *(const PG8_LAS bf16x8*)(lds + PG8_SB(b, h) + boff + n * 2048 + k * 1024); } while (0)
#define PG8_MMA(ai, bj, At, Bt) do { __builtin_amdgcn_s_setprio(1); _Pragma("unroll") for (int m = 0; m < 4; ++m) _Pragma("unroll") for (int n = 0; n < 2; ++n) _Pragma("unroll") for (int k = 0; k < 2; ++k) \
        acc[ai][bj][m][n] = __builtin_amdgcn_mfma_f32_16x16x32_bf16(Bt[n][k], At[m][k], acc[ai][bj][m][n], 0, 0, 0); __builtin_amdgcn_s_setprio(0); } while (0)
#define PG8_WAIT_V(n) asm volatile("s_waitcnt vmcnt(" #n ")" ::: "memory")
#define PG8_WAIT_L(n) asm volatile("s_waitcnt lgkmcnt(" #n ")" ::: "memory")
#define PG8_BAR __builtin_amdgcn_s_barrier()
#define PG8_SCHED __builtin_amdgcn_sched_barrier(0)
    Unit cur, nxt; int ui = 0;
    if (!S.next(0, cur)) return;
    f32x4 acc[2][2][4][2];
#pragma unroll
    for (int a = 0; a < 2; ++a)
#pragma unroll
        for (int b = 0; b < 2; ++b)
#pragma unroll
            for (int m = 0; m < 4; ++m)
#pragma unroll
                for (int n = 0; n < 2; ++n) acc[a][b][m][n] = (f32x4){0.f, 0.f, 0.f, 0.f};
    bf16x8 At[4][2], B0[2][2], B1[2][2];
    const char* cA = (const char*)g.A + (size_t)cur.pm * tstep; const char* cB = (const char*)g.Bt + (size_t)cur.pn * tstep;
    S.a_ready(cur);
    if constexpr (SP2) {
        PG8_STAGE(PG8_SB(0, 0), cB, voffB); PG8_STAGE(PG8_SB(0, 1), cB + hstep, voffB); PG8_STAGE(PG8_SA(0, 0), cA, voffA); PG8_STAGE(PG8_SA(0, 1), cA + hstep, voffA);
        if (wr == 1) PG8_BAR;
        PG8_WAIT_V(2); PG8_BAR;
        PG8_STAGE(PG8_SB(1, 0), cB + kstep, voffB); PG8_STAGE(PG8_SA(1, 0), cA + kstep, voffA); PG8_STAGE(PG8_SB(1, 1), cB + hstep + kstep, voffB);
        PG8_WAIT_V(6); PG8_BAR;
    } else {
        PG8_STAGE(PG8_SB(0, 0), cB, voffB); PG8_STAGE(PG8_SA(0, 0), cA, voffA); PG8_STAGE(PG8_SB(0, 1), cB + hstep, voffB); PG8_STAGE(PG8_SA(0, 1), cA + hstep, voffA);
        if (wr == 1) PG8_BAR;
        PG8_WAIT_V(4); PG8_BAR;
        PG8_STAGE(PG8_SB(1, 0), cB + kstep, voffB); PG8_STAGE(PG8_SA(1, 0), cA + kstep, voffA); PG8_STAGE(PG8_SB(1, 1), cB + hstep + kstep, voffB);
        PG8_WAIT_V(6); PG8_BAR;
    }
    for (;;) {
        const bool has_next = S.next(ui + 1, nxt);
        const char* nA = has_next ? (const char*)g.A + (size_t)nxt.pm * tstep : cA; const char* nB = has_next ? (const char*)g.Bt + (size_t)nxt.pn * tstep : cB;
        for (int t = 0; t < nt; t += 2) {
            const bool last = (t == nt - 2);
            const char* a1 = cA + (size_t)(t + 1) * kstep;
            const char* a2 = last ? nA : cA + (size_t)(t + 2) * kstep; const char* b2 = last ? nB : cB + (size_t)(t + 2) * kstep;
            const char* a3 = a2 + kstep; const char* b3 = b2 + kstep;
            if (last && has_next) S.a_ready(nxt);
            if constexpr (SP2) {
            PG8_LDB(B0, 0, 0); PG8_LDB(B1, 0, 1); PG8_SCHED; PG8_LDA(At, 0, 0); PG8_STAGE(PG8_SA(1, 1), a1 + hstep, voffA);
            PG8_WAIT_V(8); PG8_WAIT_L(0); PG8_BAR; PG8_MMA(0, 0, At, B0); PG8_MMA(0, 1, At, B1); PG8_BAR; PG8_SCHED;
            PG8_LDA(At, 0, 1); PG8_STAGE(PG8_SB(0, 0), b2, voffB); PG8_STAGE(PG8_SB(0, 1), b2 + hstep, voffB); PG8_STAGE(PG8_SA(0, 0), a2, voffA);
            PG8_WAIT_V(8); PG8_WAIT_L(0); PG8_BAR; PG8_MMA(1, 0, At, B0); PG8_MMA(1, 1, At, B1); PG8_BAR; PG8_SCHED;
            PG8_LDB(B0, 1, 0); PG8_LDB(B1, 1, 1); PG8_SCHED; PG8_LDA(At, 1, 0); PG8_STAGE(PG8_SA(0, 1), a2 + hstep, voffA);
            PG8_WAIT_V(8); PG8_WAIT_L(0); PG8_BAR; PG8_MMA(0, 0, At, B0); PG8_MMA(0, 1, At, B1); PG8_BAR; PG8_SCHED;
            PG8_LDA(At, 1, 1); PG8_STAGE(PG8_SB(1, 0), b3, voffB); PG8_STAGE(PG8_SB(1, 1), b3 + hstep, voffB); PG8_STAGE(PG8_SA(1, 0), a3, voffA);
            PG8_WAIT_V(8); PG8_WAIT_L(0); PG8_BAR; PG8_MMA(1, 0, At, B0); PG8_MMA(1, 1, At, B1); PG8_BAR; PG8_SCHED;
            } else {
            PG8_LDB(B0, 0, 0); PG8_SCHED; PG8_LDA(At, 0, 0); PG8_STAGE(PG8_SA(1, 1), a1 + hstep, voffA);
            PG8_WAIT_L(8); PG8_BAR; PG8_WAIT_L(0); PG8_MMA(0, 0, At, B0); PG8_BAR; PG8_SCHED;
            PG8_LDB(B1, 0, 1); PG8_STAGE(PG8_SB(0, 0), b2, voffB);
            PG8_BAR; PG8_WAIT_L(0); PG8_MMA(0, 1, At, B1); PG8_BAR;
            PG8_LDA(At, 0, 1); PG8_STAGE(PG8_SA(0, 0), a2, voffA);
            PG8_BAR; PG8_WAIT_L(0); PG8_MMA(1, 0, At, B0); PG8_BAR; PG8_SCHED;
            PG8_STAGE(PG8_SB(0, 1), b2 + hstep, voffB);
            PG8_WAIT_V(6); PG8_BAR; PG8_MMA(1, 1, At, B1); PG8_BAR;
            PG8_LDB(B0, 1, 0); PG8_SCHED; PG8_LDA(At, 1, 0); PG8_STAGE(PG8_SA(0, 1), a2 + hstep, voffA);
            PG8_WAIT_L(8); PG8_BAR; PG8_WAIT_L(0); PG8_MMA(0, 0, At, B0); PG8_BAR; PG8_SCHED;
            PG8_LDB(B1, 1, 1); PG8_STAGE(PG8_SB(1, 0), b3, voffB);
            PG8_BAR; PG8_WAIT_L(0); PG8_MMA(0, 1, At, B1); PG8_BAR;
            PG8_LDA(At, 1, 1); PG8_STAGE(PG8_SA(1, 0), a3, voffA);
            PG8_BAR; PG8_WAIT_L(0); PG8_MMA(1, 0, At, B0); PG8_BAR; PG8_SCHED;
            PG8_STAGE(PG8_SB(1, 1), b3 + hstep, voffB);
            PG8_WAIT_V(6); PG8_BAR; PG8_MMA(1, 1, At, B1); PG8_BAR;
            }
        }
        if constexpr (ALIGN_EPI) { if (wr == 0) PG8_BAR; }
        if constexpr (!Epi::AFTER_DRAIN) { E(acc, cur, wr, wc, fr, fq); S.done(cur); }
        if (!has_next) break;
#pragma unroll
        for (int a = 0; a < 2; ++a)
#pragma unroll
            for (int b = 0; b < 2; ++b)
#pragma unroll
                for (int m = 0; m < 4; ++m)
#pragma unroll
                    for (int n = 0; n < 2; ++n) acc[a][b][m][n] = (f32x4){0.f, 0.f, 0.f, 0.f};
        cur = nxt; cA = nA; cB = nB; ++ui;
        if constexpr (ALIGN_EPI) { if (wr == 1) PG8_BAR; }
    }
    PG8_WAIT_V(0);
    if constexpr (!ALIGN_EPI) { if (wr == 0) PG8_BAR; }
    PG8_BAR;
    if constexpr (Epi::AFTER_DRAIN) { E.fused(acc, cur, wr, wc, fr, fq, lds, wid, lane); S.done(cur); }
#undef PG8_SA
#undef PG8_SB
#undef PG8_STAGE
#undef PG8_LDA
#undef PG8_LDB
#undef PG8_MMA
#undef PG8_WAIT_V
#undef PG8_WAIT_L
#undef PG8_BAR
#undef PG8_SCHED
}
}
#define GAS __attribute__((address_space(1)))
#define LAS __attribute__((address_space(3)))
typedef GAS unsigned gu32;
typedef GAS unsigned long long gu64;
#define RLX_AGENT __ATOMIC_RELAXED, __HIP_MEMORY_SCOPE_AGENT
#define VM_WAIT() asm volatile("s_waitcnt vmcnt(0)" ::: "memory")
__device__ __forceinline__ unsigned long long rt() { return __builtin_amdgcn_s_memrealtime(); }
__device__ __forceinline__ unsigned f2bf(float f) { unsigned u = __builtin_bit_cast(unsigned, f); return (u + 0x7fffu + ((u >> 16) & 1u)) >> 16; }
__device__ __forceinline__ unsigned pk2(float lo, float hi) { return f2bf(lo) | (f2bf(hi) << 16); }

#define XB_TMO      128
#define XB_XCNT(j)  (256  + 64 * (j))
#define XB_XSUB(j)  (1280 + 64 * (j))
#define XB_XGEN(j)  (2304 + 64 * (j))
#define XB_TOP      3328
#define XB_TOPGEN   3392
#define XCD_BAR_WORDS 3456
#define XB_SPIN_CAP (1u << 18)

__device__ __forceinline__ unsigned xb_ld(unsigned* p)              { return __hip_atomic_load(p, __ATOMIC_RELAXED, __HIP_MEMORY_SCOPE_AGENT); }
__device__ __forceinline__ unsigned xb_add(unsigned* p, unsigned v) { return __hip_atomic_fetch_add(p, v, __ATOMIC_RELAXED, __HIP_MEMORY_SCOPE_AGENT); }
__device__ __forceinline__ unsigned xb_xcc_id() { return (unsigned)__builtin_amdgcn_s_getreg((3 << 11) | 20) & 0xFu; }
#define XB_SPIN(cond, bar) do { unsigned _sp = 0; while (cond) { __builtin_amdgcn_s_sleep(1); \
    if ((++_sp & 255u) == 0u) { if (xb_ld(&(bar)[XB_TMO])) break; if (_sp > XB_SPIN_CAP) { atomicAdd(&(bar)[XB_TMO], 1u); break; } } } } while (0)

struct XcdBarrier {
    unsigned* bar; unsigned x;
    volatile LAS unsigned* st;
};

__device__ __forceinline__ XcdBarrier xcd_barrier_post(unsigned* bar, volatile LAS unsigned* st) {
    XcdBarrier b; b.bar = bar; b.x = xb_xcc_id(); b.st = st;
    if (threadIdx.x == 0) (void)xb_add(&bar[XB_XCNT(b.x)], 1u);
    return b;
}
__device__ __forceinline__ void xcd_barrier_complete(unsigned* bar, unsigned x, unsigned& nloc, unsigned& nx) {
    const unsigned G = gridDim.x * gridDim.y * gridDim.z;
    unsigned sum, cnt, mine, sp = 0u;
    for (;;) {
        sum = 0u; cnt = 0u; mine = 0u;
#pragma unroll
        for (unsigned j = 0; j < 16; ++j) { const unsigned c = xb_ld(&bar[XB_XCNT(j)]); sum += c; cnt += (c > 0u) ? 1u : 0u; mine = (j == x) ? c : mine; }
        if (sum == G) break;
        __builtin_amdgcn_s_sleep(1);
        if ((++sp & 255u) == 0u) { if (xb_ld(&bar[XB_TMO])) break; if (sp > XB_SPIN_CAP) { atomicAdd(&bar[XB_TMO], 1u); break; } }
    }
    nloc = mine > 0u ? mine : 1u; nx = cnt > 0u ? cnt : 1u;
}

__device__ __forceinline__ void xcd_barrier(const XcdBarrier& b) {
    asm volatile("s_waitcnt vmcnt(0)" ::: "memory");
    __syncthreads();
    if (threadIdx.x == 0) {
        unsigned* bar = b.bar;
        __builtin_amdgcn_s_waitcnt(0);
        unsigned nloc = b.st[0], nx = b.st[1];
        if (nloc == 0u) { xcd_barrier_complete(bar, b.x, nloc, nx); b.st[0] = nloc; b.st[1] = nx; }
        const unsigned old = xb_add(&bar[XB_XSUB(b.x)], 1u);
        const unsigned gen = old / nloc;
        if (old + 1u == (gen + 1u) * nloc) {
            __builtin_amdgcn_fence(__ATOMIC_RELEASE, "agent");
            asm volatile("s_waitcnt vmcnt(0)" ::: "memory");
            const unsigned og = xb_add(&bar[XB_TOP], 1u);
            const unsigned tg = og / nx;
            if (og + 1u == (tg + 1u) * nx) xb_add(&bar[XB_TOPGEN], 1u);
            else XB_SPIN(xb_ld(&bar[XB_TOPGEN]) == tg, bar);
            __builtin_amdgcn_fence(__ATOMIC_ACQUIRE, "agent");
            xb_add(&bar[XB_XGEN(b.x)], 1u);
            asm volatile("s_waitcnt vmcnt(0)" ::: "memory");
        } else {
            XB_SPIN(xb_ld(&bar[XB_XGEN(b.x)]) == gen, bar);
            __builtin_amdgcn_fence(__ATOMIC_ACQUIRE, "agent");
            asm volatile("s_waitcnt vmcnt(0)" ::: "memory");
        }
    }
    __syncthreads();
}

using pg8::bf16_t; using pg8::bf16x8; using pg8::f32x4; using pg8::u32x4;
using pg8::DM; using pg8::MP; using pg8::MS; using pg8::MT; using pg8::DIN; using pg8::ZW;
using pg8::Z_GA; using pg8::Z_XB; using pg8::Z_GP; using pg8::Z_U; using pg8::Z_VS; using pg8::Z_GS; using pg8::LOG2E; using pg8::EPS;
typedef float f32x16 __attribute__((ext_vector_type(16)));
typedef unsigned u32x2 __attribute__((ext_vector_type(2)));
typedef short v4i16_t __attribute__((ext_vector_type(4)));

constexpr int NWAVES = 8, NTHREADS = 512;
constexpr int LDS_BYTES = 147456;
constexpr int RING_OFF = 1024;

constexpr size_t O_YP = 0, O_YS = 33554432, O_KP = 34603008, O_VP = 35127296, O_PP = 35651584, O_KS = 35774464, O_VS = 44163072, O_PS = 52551680, O_CV = 54517760, O_END = 55042048;
constexpr size_t LS_KP = 262144, LS_PP = 61440, LS_KS = 4194304, LS_PS = 983040, LS_CV = 262144;
constexpr size_t MiB = 1u << 20;
constexpr size_t WS_CTL = 0, CTL_ZERO_BYTES = 65536;
constexpr size_t WS_ROPE = 1 * MiB, WS_SGUW = 2 * MiB, WS_RSW = 2 * MiB + 256 * 1024, WS_PWT = 2 * MiB + 512 * 1024;
constexpr size_t WS_WTIN = 4 * MiB, WS_WTOUT = 44 * MiB, WS_H = 60 * MiB, WS_MIX = 126 * MiB, WS_QC = 192 * MiB, WS_KC = 225 * MiB, WS_VTP = 233 * MiB, WS_Z2 = 241 * MiB, WS_Y = 357 * MiB, WS_END = 489 * MiB;
constexpr int CW_BAR = 1024;

__constant__ double ROPE_INV[32] = {1.0, 0.7498942093324559, 0.5623413251903491, 0.4216965034285822, 0.31622776601683794, 0.23713737056616552, 0.1778279410038923, 0.1333521432163324, 0.1, 0.07498942093324558, 0.05623413251903491, 0.042169650342858224, 0.03162277660168379, 0.023713737056616554, 0.01778279410038923, 0.01333521432163324, 0.01, 0.007498942093324558, 0.005623413251903491, 0.004216965034285823, 0.0031622776601683794, 0.0023713737056616554, 0.0017782794100389228, 0.001333521432163324, 0.001, 0.0007498942093324559, 0.0005623413251903491, 0.00042169650342858224, 0.00031622776601683794, 0.00023713737056616554, 0.00017782794100389227, 0.0001333521432163324};

struct Args { const float* in[16]; float* out; unsigned char* ws; };

struct Frame {
    int tid, lane, wave, bid, G;
    const float *xp, *xs, *cache_k, *cache_v, *state_pool, *w_in, *w_out, *norm_pre, *norm_post, *sinks, *pool_w, *pool_scale, *ln_g, *ln_b, *sgu_w, *sgu_b;
    float* out;
    float* rope; float* RSW; bf16_t *SGUW, *PWT, *WTIN, *WTOUT, *H, *MIX, *Qc, *Kc, *VTP, *Z2, *Yb;
};

__device__ __forceinline__ float wave_sum(float v) {
#pragma unroll
    for (int o = 1; o < 64; o <<= 1) v += __shfl_xor(v, o);
    return v;
}
__device__ __forceinline__ float wave_max(float v) {
#pragma unroll
    for (int o = 1; o < 64; o <<= 1) v = fmaxf(v, __shfl_xor(v, o));
    return v;
}
__device__ __forceinline__ float bflo(unsigned w) { return __uint_as_float(w << 16); }
__device__ __forceinline__ float bfhi(unsigned w) { return __uint_as_float(w & 0xffff0000u); }
__device__ __forceinline__ void unpack8(const u32x4 w, float (&f)[8]) { f[0] = bflo(w.x); f[1] = bfhi(w.x); f[2] = bflo(w.y); f[3] = bfhi(w.y); f[4] = bflo(w.z); f[5] = bfhi(w.z); f[6] = bflo(w.w); f[7] = bfhi(w.w); }
__device__ __forceinline__ void unpack4(const u32x2 w, float (&f)[4]) { f[0] = bflo(w.x); f[1] = bfhi(w.x); f[2] = bflo(w.y); f[3] = bfhi(w.y); }
__device__ __forceinline__ u32x4 pack8(const float (&f)[8]) { u32x4 w; w.x = pg8::cvt_pk_bf16(f[0], f[1]); w.y = pg8::cvt_pk_bf16(f[2], f[3]); w.z = pg8::cvt_pk_bf16(f[4], f[5]); w.w = pg8::cvt_pk_bf16(f[6], f[7]); return w; }
__device__ __forceinline__ int crow(int r, int hi) { return (r & 3) + 8 * (r >> 2) + 4 * hi; }
#define LDS_WAIT() asm volatile("s_waitcnt lgkmcnt(0)" ::: "memory")


struct ArgsG { const __attribute__((address_space(1))) float* in[16]; __attribute__((address_space(1))) float* out; __attribute__((address_space(1))) unsigned char* ws; };
typedef const __attribute__((address_space(4))) ArgsG* KArgs;
__device__ __forceinline__ KArgs kargs() { KArgs p = (KArgs)__builtin_amdgcn_kernarg_segment_ptr(); asm volatile("" : "+s"(p)); return p; }
__device__ __forceinline__ void make_frame(Frame& F, KArgs a) {
    { int t_ = threadIdx.x; asm volatile("" : "+v"(t_)); F.tid = t_; } F.lane = F.tid & 63; F.wave = __builtin_amdgcn_readfirstlane(F.tid >> 6); F.bid = blockIdx.x; F.G = gridDim.x;
    F.xp = (const float*)a->in[0]; F.xs = (const float*)a->in[1]; F.cache_k = (const float*)a->in[2]; F.cache_v = (const float*)a->in[3]; F.state_pool = (const float*)a->in[4]; F.w_in = (const float*)a->in[5]; F.w_out = (const float*)a->in[6]; F.norm_pre = (const float*)a->in[7]; F.norm_post = (const float*)a->in[8];
    F.sinks = (const float*)a->in[9]; F.pool_w = (const float*)a->in[10]; F.pool_scale = (const float*)a->in[11]; F.ln_g = (const float*)a->in[12]; F.ln_b = (const float*)a->in[13]; F.sgu_w = (const float*)a->in[14]; F.sgu_b = (const float*)a->in[15];
    F.out = (float*)a->out;
    unsigned char* ws = (unsigned char*)a->ws;
    F.rope = (float*)(ws + WS_ROPE); F.RSW = (float*)(ws + WS_RSW); F.SGUW = (bf16_t*)(ws + WS_SGUW); F.PWT = (bf16_t*)(ws + WS_PWT); F.WTIN = (bf16_t*)(ws + WS_WTIN); F.WTOUT = (bf16_t*)(ws + WS_WTOUT);
    F.H = (bf16_t*)(ws + WS_H); F.MIX = (bf16_t*)(ws + WS_MIX); F.Qc = (bf16_t*)(ws + WS_QC); F.Kc = (bf16_t*)(ws + WS_KC); F.VTP = (bf16_t*)(ws + WS_VTP); F.Z2 = (bf16_t*)(ws + WS_Z2); F.Yb = (bf16_t*)(ws + WS_Y);
}

#define LOCAL_FRAME Frame F; make_frame(F, kargs())

constexpr int CW_Q = 8192;
constexpr int CW_ZS = 8192 + 64 * 8;
constexpr int CW_YS = 8192 + 64 * 16;
constexpr int CW_EV = 8192 + 64 * 32;
__device__ __forceinline__ unsigned* ctl_word(int idx) { return (unsigned*)((unsigned char*)kargs()->ws + WS_CTL) + idx; }
__device__ __forceinline__ int q_pop(unsigned* head, LAS unsigned char* L) {
    volatile LAS int* slot = (volatile LAS int*)(L + 64);
    __syncthreads();
    if (threadIdx.x == 0) *slot = (int)__hip_atomic_fetch_add(head, 1u, __ATOMIC_RELAXED, __HIP_MEMORY_SCOPE_AGENT);
    __syncthreads();
    return __builtin_amdgcn_readfirstlane(*slot);
}
__device__ __forceinline__ void publish(unsigned* ctr) {
    asm volatile("s_waitcnt vmcnt(0)" ::: "memory");
    __syncthreads();
    if (threadIdx.x == 0) { __builtin_amdgcn_fence(__ATOMIC_RELEASE, "agent"); asm volatile("s_waitcnt vmcnt(0)" ::: "memory");
        __hip_atomic_fetch_add(ctr, 1u, __ATOMIC_RELAXED, __HIP_MEMORY_SCOPE_AGENT); }
}
__device__ __forceinline__ void dep_wait(unsigned* ctr, unsigned need) {
    if (threadIdx.x == 0) {
        unsigned sp = 0;
        while (__hip_atomic_load(ctr, __ATOMIC_RELAXED, __HIP_MEMORY_SCOPE_AGENT) < need) { __builtin_amdgcn_s_sleep(16); if (++sp > (1u << 21)) break; }
        __builtin_amdgcn_fence(__ATOMIC_ACQUIRE, "agent"); asm volatile("s_waitcnt vmcnt(0)" ::: "memory");
    }
    __syncthreads();
}

#if PROBE_SEL >= 10
#define EV_T0() const unsigned long long ev_t0 = __builtin_amdgcn_s_memrealtime()
#define EV_MAX(k) do { if (threadIdx.x == 0) __hip_atomic_fetch_max(ctl_word(CW_EV + 64 * (k)), (unsigned)(__builtin_amdgcn_s_memrealtime() - ev_t0), __ATOMIC_RELAXED, __HIP_MEMORY_SCOPE_AGENT); } while (0)
#define EV_MIN(k) do { if (threadIdx.x == 0) __hip_atomic_fetch_max(ctl_word(CW_EV + 64 * (k)), 0x40000000u - (unsigned)(__builtin_amdgcn_s_memrealtime() - ev_t0), __ATOMIC_RELAXED, __HIP_MEMORY_SCOPE_AGENT); } while (0)
#else
#define EV_T0() do {} while (0)
#define EV_MAX(k) do {} while (0)
#define EV_MIN(k) do {} while (0)
#endif
struct OneUnit {
    pg8::Unit u;
    __device__ __forceinline__ bool next(int i, pg8::Unit& o) const { if (i) return false; o = u; return true; }
    __device__ __forceinline__ void a_ready(const pg8::Unit&) const {}
    __device__ __forceinline__ void done(const pg8::Unit&) const {}
};

#ifndef PROBE_SEL
#define PROBE_SEL 0
#endif
#if PROBE_SEL
#define STAMP(k) do { if (blockIdx.x == 0 && threadIdx.x == 0) ((LAS unsigned long long*)(L + 256))[k] = __builtin_amdgcn_s_memrealtime(); } while (0)
#define STAMP2(k) do { if (blockIdx.x == 0) { __syncthreads(); if (threadIdx.x == 0) ((LAS unsigned long long*)((LAS unsigned char*)ring - RING_OFF + 256))[k] = __builtin_amdgcn_s_memrealtime(); } } while (0)
#else
#define STAMP(k) do {} while (0)
#define STAMP2(k) do {} while (0)
#endif
#if PROBE_SEL == 1
#define PA0 0
#define PA1 1
#define PB0 1
#define PB1 2
#elif PROBE_SEL == 2
#define PA0 2
#define PA1 3
#define PB0 3
#define PB1 4
#elif PROBE_SEL == 3
#define PA0 4
#define PA1 5
#define PB0 8
#define PB1 9
#elif PROBE_SEL == 4
#define PA0 2
#define PA1 10
#define PB0 10
#define PB1 11
#elif PROBE_SEL == 5
#define PA0 11
#define PA1 12
#define PB0 12
#define PB1 13
#elif PROBE_SEL == 7
#define PA0 1
#define PA1 2
#define PB0 0
#define PB1 1
#elif PROBE_SEL == 8
#define PA0 3
#define PA1 4
#define PB0 2
#define PB1 3
#elif PROBE_SEL == 9
#define PA0 6
#define PA1 7
#define PB0 4
#define PB1 5
#elif PROBE_SEL == 6
#define PA0 5
#define PA1 6
#define PB0 7
#define PB1 8
#elif PROBE_SEL == 10
#define PEA 0
#define PEA_MIN 0
#define PEB 1
#define PEB_MIN 1
#elif PROBE_SEL == 11
#define PEA 2
#define PEA_MIN 0
#define PEB 3
#define PEB_MIN 1
#elif PROBE_SEL == 12
#define PEA 4
#define PEA_MIN 0
#define PEB 5
#define PEB_MIN 0
#elif PROBE_SEL == 14
#define PEA 8
#define PEA_MIN 0
#define PEB 9
#define PEB_MIN 0
#elif PROBE_SEL == 13
#define PEA 6
#define PEA_MIN 1
#define PEB 7
#define PEB_MIN 0
#endif

__device__ __forceinline__ void p0_transpose_blk(const float* W, int K, int N, bf16_t* WT, bool permqk, LAS unsigned char* T, int item, int tid) {
    const int nblk = N >> 8, kb = item / nblk, nb = item - kb * nblk, k0 = kb * 128, n0 = nb * 256;
    const int n4 = tid & 63, kr = tid >> 6;
    f32x4 v[16];
#pragma unroll
    for (int i = 0; i < 16; ++i) v[i] = __builtin_nontemporal_load((const f32x4*)(W + (size_t)(k0 + 16 * kr + i) * N + n0 + 4 * n4));
#pragma unroll
    for (int e = 0; e < 4; ++e) {
        u32x4 lo, hi;
        lo.x = pg8::cvt_pk_bf16(v[0][e], v[1][e]); lo.y = pg8::cvt_pk_bf16(v[2][e], v[3][e]); lo.z = pg8::cvt_pk_bf16(v[4][e], v[5][e]); lo.w = pg8::cvt_pk_bf16(v[6][e], v[7][e]);
        hi.x = pg8::cvt_pk_bf16(v[8][e], v[9][e]); hi.y = pg8::cvt_pk_bf16(v[10][e], v[11][e]); hi.z = pg8::cvt_pk_bf16(v[12][e], v[13][e]); hi.w = pg8::cvt_pk_bf16(v[14][e], v[15][e]);
        LAS unsigned char* p = T + (64 * e + n4) * 272 + 32 * kr;
        *(LAS u32x4*)p = lo; *(LAS u32x4*)(p + 16) = hi;
    }
    LDS_WAIT();
    __syncthreads();
    {
        const int rho = tid >> 1, half = tid & 1, n = n0 + 4 * (rho & 63) + (rho >> 6);
        int nrow = n;
        if (permqk && n < 1280) { const int p = n & 63; nrow = (n & ~63) + 2 * (p & 31) + (p >> 5); }
        const LAS unsigned char* src = T + rho * 272 + 128 * half;
        bf16_t* dst = WT + (size_t)nrow * K + k0 + 64 * half;
        u32x4 o[8];
#pragma unroll
        for (int c = 0; c < 8; ++c) o[c] = *(const LAS u32x4*)(src + 16 * c);
#pragma unroll
        for (int c = 0; c < 8; ++c) *(u32x4*)(dst + 8 * c) = o[c];
    }
    LDS_WAIT();
    __syncthreads();
}
__device__ __forceinline__ void prenorm_finish(const f32x4 (&v)[8], const float* g, bf16_t* hrow, int lane) {
    float ss = 0.f;
#pragma unroll
    for (int j = 0; j < 8; ++j) ss += (v[j][0] * v[j][0] + v[j][1] * v[j][1]) + (v[j][2] * v[j][2] + v[j][3] * v[j][3]);
    ss = wave_sum(ss);
    const float r = rsqrtf(ss * (1.0f / 2048.0f) + EPS);
#pragma unroll
    for (int j = 0; j < 8; ++j) { const f32x4 gg = *(const f32x4*)(g + 4 * lane + 256 * j); const f32x4 o = v[j] * r * gg;
        u32x2 w; w.x = pg8::cvt_pk_bf16(o[0], o[1]); w.y = pg8::cvt_pk_bf16(o[2], o[3]); *(u32x2*)(hrow + 4 * lane + 256 * j) = w; }
}
__device__ __forceinline__ void p0_prologue(const Frame& F, LAS unsigned char* ring) {
    const int gw = F.bid * NWAVES + F.wave, NGW = F.G * NWAVES;
    constexpr int I_IN = 16 * 20, I_OUT = 16 * 8, NITEMS = 2 * (I_IN + I_OUT);
    EV_T0();
    for (int it = F.bid; it < NITEMS; it += F.G) {
        int r = it;
        if (r < 2 * I_IN) { const int l = r / I_IN; r -= l * I_IN; p0_transpose_blk(F.w_in + (size_t)l * DM * DIN, DM, DIN, F.WTIN + (size_t)l * DIN * DM, true, ring, r, F.tid); }
        else { r -= 2 * I_IN; const int l = r / I_OUT; r -= l * I_OUT; p0_transpose_blk(F.w_out + (size_t)l * DM * DM, DM, DM, F.WTOUT + (size_t)l * DM * DM, false, ring, r, F.tid); }
    }
    __syncthreads(); EV_MAX(8);
    for (int m = 2 * gw; m < MT; m += 2 * NGW) {
        const float* xa = m < MP ? F.xp + (size_t)m * DM : F.xs + (size_t)(m - MP) * DM; const float* xb = (m + 1) < MP ? F.xp + (size_t)(m + 1) * DM : F.xs + (size_t)(m + 1 - MP) * DM;
        f32x4 va[8], vb[8];
#pragma unroll
        for (int j = 0; j < 8; ++j) { va[j] = __builtin_nontemporal_load((const f32x4*)(xa + 4 * F.lane + 256 * j)); vb[j] = __builtin_nontemporal_load((const f32x4*)(xb + 4 * F.lane + 256 * j)); }
        prenorm_finish(va, F.norm_pre, F.H + (size_t)m * DM, F.lane); prenorm_finish(vb, F.norm_pre, F.H + (size_t)(m + 1) * DM, F.lane); }
    __syncthreads(); EV_MAX(9);
    const int gt = F.bid * NTHREADS + F.tid, NGT = F.G * NTHREADS;
    for (int e = gt; e < 2052 * 32; e += NGT) { const int tp = e >> 5, i = e & 31; const double pos = (double)(tp < 2048 ? tp : 8192 + (tp - 2048));
        const double rev = pos * ROPE_INV[i] * 0.15915494309189535; const float fr = (float)(rev - floor(rev));
        F.rope[tp * 64 + i] = __builtin_amdgcn_cosf(fr); F.rope[tp * 64 + 32 + i] = __builtin_amdgcn_sinf(fr); }
    for (int e = gt; e < 2 * 4 * 128 * 128; e += NGT) { const int s = e & 127, t = (e >> 7) & 127; const float w = F.sgu_w[e];
        F.SGUW[e] = (bf16_t)(pg8::cvt_pk_bf16(s <= t ? w : 0.f, 0.f) & 0xffffu); }
    for (int e = gt; e < 2 * 4 * 128; e += NGT) { const int t = e & 127; const float* wr = F.sgu_w + (size_t)e * 128; float acc = 0.f;
        for (int s2 = 0; s2 <= t; ++s2) acc += __uint_as_float(pg8::cvt_pk_bf16(wr[s2], 0.f) << 16);
        F.RSW[e] = acc; }
    for (int e = gt; e < 2 * 4 * 128 * 128; e += NGT) { const int c = e & 127, d = (e >> 7) & 127, lg = e >> 14;
        F.PWT[e] = (bf16_t)(pg8::cvt_pk_bf16(F.pool_w[((size_t)lg * 128 + c) * 128 + d], 0.f) & 0xffffu); }
}

constexpr int AT_K = 0, AT_V = 49152, AT_STG = 98304, AT_WSTRIDE = 4352;
__device__ __forceinline__ void attn_stage_kv(const Frame& F, int b, int kvh, int nbp, LAS unsigned char* ring) {
    const int tid = F.tid;
    const bf16_t* kg = F.Kc + ((size_t)(b * 4 + kvh) * 2048 + 256 * nbp - 128) * 64;
    const bf16_t* vg = F.VTP + ((size_t)(b * 4 + kvh) * 64 + 8 * nbp - 4) * 2048;
    u32x4 kv[6], vv[6];
#pragma unroll
    for (int i = 0; i < 6; ++i) { const int ch = tid + 512 * i, row0 = ch >> 3, c8 = ch & 7, row = (nbp > 0 || row0 >= 128) ? row0 : row0 + 128;
        kv[i] = __builtin_nontemporal_load((const u32x4*)(kg + row * 64 + c8 * 8)); }
#pragma unroll
    for (int i = 0; i < 6; ++i) { const int ch = tid + 512 * i, tile0 = ch >> 8, rem = ch & 255, d = rem >> 2, c4 = rem & 3, tile = (nbp > 0 || tile0 >= 4) ? tile0 : tile0 + 4;
        vv[i] = __builtin_nontemporal_load((const u32x4*)(vg + tile * 2048 + d * 32 + c4 * 8)); }
#pragma unroll
    for (int i = 0; i < 6; ++i) { const int ch = tid + 512 * i, row = ch >> 3, c8 = ch & 7;
        *(LAS u32x4*)(ring + AT_K + row * 128 + ((c8 ^ (row & 7)) << 4)) = kv[i]; }
#pragma unroll
    for (int i = 0; i < 6; ++i) { const int ch = tid + 512 * i, tile = ch >> 8, rem = ch & 255, d = rem >> 2, c4 = rem & 3;
        *(LAS u32x4*)(ring + AT_V + tile * 4096 + d * 64 + ((c4 ^ ((d >> 2) & 3)) << 4)) = vv[i]; }
}
__device__ __forceinline__ void attn_task(const Frame& F, int l, int b, int nbp, int head, int j, const bf16x8 (&qf)[4], LAS unsigned char* ring) {
    const int lane = F.lane, r = lane & 31, hh = lane >> 5;
    LAS unsigned char* wl = ring + AT_STG + F.wave * AT_WSTRIDE;
    LAS float* wsf = (LAS float*)wl; LAS bf16_t* stg = (LAS bf16_t*)(wl + 256);
    const size_t qrow0 = (size_t)b * 2048 + 256 * nbp + 32 * j;
    u32x4 gv[4];
#pragma unroll
    for (int i = 0; i < 4; ++i) gv[i] = __builtin_nontemporal_load((const u32x4*)(F.Z2 + (qrow0 + i * 8 + (lane >> 3)) * ZW + Z_GA + head * 64 + (lane & 7) * 8));
    const int cmin = (nbp > 0) ? 0 : (j < 4 ? 4 - j : 0);
    f32x16 S[5];
#pragma unroll
    for (int c = 0; c < 5; ++c) {
        f32x16 a;
#pragma unroll
        for (int i = 0; i < 16; ++i) a[i] = 0.f;
        if (c >= cmin) {
            LAS unsigned char* kp = ring + AT_K + (32 * (j + c) + r) * 128;
#pragma unroll
            for (int s = 0; s < 4; ++s) a = __builtin_amdgcn_mfma_f32_32x32x16_bf16(*(const LAS bf16x8*)(kp + (((2 * s + hh) ^ (r & 7)) << 4)), qf[s], a, 0, 0, 0);
        }
        S[c] = a;
    }
    const float NEG = -INFINITY;
#pragma unroll
    for (int i = 0; i < 16; ++i) { const int kap = crow(i, hh); if (kap <= r) S[0][i] = NEG; if (kap > r) S[4][i] = NEG; }
    const float sink2 = F.sinks[l * 16 + head] * LOG2E;
    float m = sink2;
#pragma unroll
    for (int c = 0; c < 5; ++c) if (c >= cmin) {
#pragma unroll
        for (int i = 0; i < 16; ++i) m = fmaxf(m, S[c][i]); }
    m = fmaxf(m, __shfl_xor(m, 32));
    float sum = 0.f;
#pragma unroll
    for (int c = 0; c < 5; ++c) if (c >= cmin) {
#pragma unroll
        for (int i = 0; i < 16; ++i) { const float p = __builtin_amdgcn_exp2f(S[c][i] - m); S[c][i] = p; sum += p; } }
    sum += __shfl_xor(sum, 32);
    const float inv = 1.0f / (sum + __builtin_amdgcn_exp2f(sink2 - m));
    f32x16 o[2];
#pragma unroll
    for (int i = 0; i < 16; ++i) { o[0][i] = 0.f; o[1][i] = 0.f; }
#pragma unroll
    for (int c = 0; c < 5; ++c) if (c >= cmin) {
        LAS unsigned char* vt = ring + AT_V + (j + c) * 4096 + r * 64;
#pragma unroll
        for (int s = 0; s < 2; ++s) {
            u32x4 pw; pw.x = pg8::cvt_pk_bf16(S[c][8 * s + 0], S[c][8 * s + 1]); pw.y = pg8::cvt_pk_bf16(S[c][8 * s + 2], S[c][8 * s + 3]);
            pw.z = pg8::cvt_pk_bf16(S[c][8 * s + 4], S[c][8 * s + 5]); pw.w = pg8::cvt_pk_bf16(S[c][8 * s + 6], S[c][8 * s + 7]);
            const bf16x8 pa = __builtin_bit_cast(bf16x8, pw);
            const int sw = (((2 * hh + s) ^ ((r >> 2) & 3)) << 4);
#pragma unroll
            for (int db = 0; db < 2; ++db) o[db] = __builtin_amdgcn_mfma_f32_32x32x16_bf16(pa, *(const LAS bf16x8*)(vt + db * 2048 + sw), o[db], 0, 0, 0);
        }
    }
    if (hh == 0) wsf[r] = inv;
    LDS_WAIT();
#pragma unroll
    for (int i = 0; i < 16; ++i) { const int q = crow(i, hh); const float rl = wsf[q];
        stg[q * 64 + r] = (bf16_t)(pg8::cvt_pk_bf16(o[0][i] * rl, 0.f) & 0xffffu);
        stg[q * 64 + 32 + r] = (bf16_t)(pg8::cvt_pk_bf16(o[1][i] * rl, 0.f) & 0xffffu); }
    LDS_WAIT();
#pragma unroll
    for (int i = 0; i < 4; ++i) { const int row = i * 8 + (lane >> 3), ch = lane & 7;
        const u32x4 ov = *(const LAS u32x4*)(stg + row * 64 + ch * 8);
        float of[8], gf[8]; unpack8(ov, of); unpack8(gv[i], gf);
#pragma unroll
        for (int jj = 0; jj < 8; ++jj) of[jj] *= gf[jj];
        *(u32x4*)(F.MIX + (qrow0 + row) * DM + head * 64 + ch * 8) = pack8(of); }
    LDS_WAIT();
}
__device__ __forceinline__ void attn_unit(int l, int a, LAS unsigned char* ring) {
    LOCAL_FRAME;
    const int kvh = a & 3, nbp = (a >> 2) & 7, b = a >> 5;
    const int lane = F.lane, r = lane & 31, hh = lane >> 5;
    const int head = 4 * kvh + (F.wave >> 1), j0 = 4 * (F.wave & 1);
    const bf16_t* qp = F.Qc + ((size_t)b * 2048 + 256 * nbp + 32 * j0 + r) * 1024 + head * 64 + 8 * hh;
    bf16x8 qa[4], qb[4];
#pragma unroll
    for (int s = 0; s < 4; ++s) qa[s] = __builtin_nontemporal_load((const bf16x8*)(qp + 16 * s));
#ifdef EXP_ZERO_LDS
    for (int e = F.tid; e < 134144 / 16; e += NTHREADS) *(LAS u32x4*)(ring + 16 * e) = (u32x4){0u, 0u, 0u, 0u};
    LDS_WAIT(); __syncthreads();
#endif
    attn_stage_kv(F, b, kvh, nbp, ring);
    LDS_WAIT();
    __syncthreads();
#pragma unroll
    for (int s = 0; s < 4; ++s) qb[s] = __builtin_nontemporal_load((const bf16x8*)(qp + 32 * 1024 + 16 * s));
    attn_task(F, l, b, nbp, head, j0 + 0, qa, ring);
#pragma unroll
    for (int s = 0; s < 4; ++s) qa[s] = __builtin_nontemporal_load((const bf16x8*)(qp + 64 * 1024 + 16 * s));
    attn_task(F, l, b, nbp, head, j0 + 1, qb, ring);
#pragma unroll
    for (int s = 0; s < 4; ++s) qb[s] = __builtin_nontemporal_load((const bf16x8*)(qp + 96 * 1024 + 16 * s));
    attn_task(F, l, b, nbp, head, j0 + 2, qa, ring);
    attn_task(F, l, b, nbp, head, j0 + 3, qb, ring);
    __syncthreads();
}

constexpr int PL_STRIDE = 272, PL_WBYTES = 47 * 272;
template <int G>
__device__ __forceinline__ void pool_unit_p(int l, int tile, LAS unsigned char* wl) {
    LOCAL_FRAME;
    constexpr int W = 2 << G, HIST = W - 1, NROW = 32 + HIST, NLD = (NROW * 16 + 63) / 64;
    const int lane = F.lane, r = lane & 31, hh = lane >> 5;
    const size_t R0 = (size_t)32 * tile;
    const int t0 = (int)(R0 & 2047);
    {
        u32x4 x[NLD];
#pragma unroll
        for (int k = 0; k < NLD; ++k) { const int id = lane + 64 * k, lr = id >> 4, c16 = id & 15; const int lrc = lr < NROW ? lr : NROW - 1;
            const int back = HIST - lrc; const size_t grow = (back <= t0) ? R0 - back : R0;
            x[k] = __builtin_nontemporal_load((const u32x4*)(F.Z2 + grow * ZW + Z_XB + 128 * G + 8 * c16)); }
#pragma unroll
        for (int k = 0; k < NLD; ++k) { const int id = lane + 64 * k, lr = id >> 4, c16 = id & 15; if (lr < NROW) *(LAS u32x4*)(wl + lr * PL_STRIDE + c16 * 16) = x[k]; }
    }
    const size_t row = R0 + r; const int t = t0 + r;
    u32x2 gq[4][4];
#pragma unroll
    for (int db = 0; db < 4; ++db)
#pragma unroll
        for (int q = 0; q < 4; ++q) gq[db][q] = __builtin_nontemporal_load((const u32x2*)(F.Z2 + row * ZW + Z_GP + 128 * G + 32 * db + 8 * q + 4 * hh));
    const float icnt = 1.0f / (float)(W < t + 1 ? W : t + 1);
    LDS_WAIT();
    bf16x8 bfr[8];
#pragma unroll
    for (int s = 0; s < 8; ++s) {
        LAS unsigned char* bp = wl + (r + HIST) * PL_STRIDE + (16 * s + 8 * hh) * 2;
        float cur[8], sum[8]; unpack8(*(const LAS u32x4*)bp, cur);
#pragma unroll
        for (int jj = 0; jj < 8; ++jj) sum[jj] = cur[jj];
#pragma unroll
        for (int i = 1; i < W; ++i) { float f[8]; unpack8(*(const LAS u32x4*)(bp - i * PL_STRIDE), f); const float wgt = i <= t ? 1.f : 0.f;
#pragma unroll
            for (int jj = 0; jj < 8; ++jj) sum[jj] += wgt * f[jj]; }
#pragma unroll
        for (int jj = 0; jj < 8; ++jj) sum[jj] = sum[jj] * icnt - cur[jj];
        bfr[s] = __builtin_bit_cast(bf16x8, pack8(sum));
        __builtin_amdgcn_sched_barrier(0);
    }
    f32x16 acc[4];
#pragma unroll
    for (int db = 0; db < 4; ++db) {
#pragma unroll
        for (int i = 0; i < 16; ++i) acc[db][i] = 0.f;
        const bf16_t* ap = F.PWT + ((size_t)(l * 4 + G) * 128 + 32 * db + r) * 128 + 8 * hh;
#pragma unroll
        for (int s = 0; s < 8; ++s) acc[db] = __builtin_amdgcn_mfma_f32_32x32x16_bf16(*(const bf16x8*)(ap + 16 * s), bfr[s], acc[db], 0, 0, 0);
        __builtin_amdgcn_sched_barrier(0);
    }
#pragma unroll
    for (int db = 0; db < 4; ++db)
#pragma unroll
        for (int q = 0; q < 4; ++q) {
            const int col = 128 * G + 32 * db + 8 * q + 4 * hh;
            const f32x4 sc = *(const f32x4*)(F.pool_scale + l * 512 + col);
            float gf[4]; unpack4(gq[db][q], gf);
            u32x2 wv; wv.x = pg8::cvt_pk_bf16(acc[db][4 * q + 0] * sc[0] * gf[0], acc[db][4 * q + 1] * sc[1] * gf[1]);
            wv.y = pg8::cvt_pk_bf16(acc[db][4 * q + 2] * sc[2] * gf[2], acc[db][4 * q + 3] * sc[3] * gf[3]);
            *(u32x2*)(F.MIX + row * DM + 1024 + col) = wv;
        }
    LDS_WAIT();
}
__device__ __forceinline__ void pool_prompt(int l, int g, int tile, LAS unsigned char* wl) {
    if (g == 0) pool_unit_p<0>(l, tile, wl); else if (g == 1) pool_unit_p<1>(l, tile, wl); else if (g == 2) pool_unit_p<2>(l, tile, wl); else pool_unit_p<3>(l, tile, wl);
}
template <int G>
__device__ __forceinline__ void pool_unit_s(int l, int tile) {
    LOCAL_FRAME;
    constexpr int W = 2 << G;
    const int lane = F.lane, r = lane & 31, hh = lane >> 5;
    const size_t row = (size_t)MP + 32 * tile + r;
    const int tt = (int)(row & 3), bd = (int)((row - MP) >> 2);
    const float* stb = F.state_pool + ((size_t)l * 128 + bd) * 15 * 512;
    const float icnt = 1.0f / (float)W;
    bf16x8 bfr[8];
#pragma unroll
    for (int s = 0; s < 8; ++s) {
        const int c0 = 128 * G + 16 * s + 8 * hh;
        float sum[8], cur[8];
        {
            constexpr int NL = W < 4 ? W : 4;
            u32x4 zn[NL]; f32x4 sa[NL], sb[NL];
#pragma unroll
            for (int i = 0; i < NL; ++i) { const int back = i <= tt ? i : tt; int si = 15 + tt - i; si = si > 14 ? 14 : si;
                zn[i] = *(const u32x4*)(F.Z2 + (row - back) * ZW + Z_XB + c0); sa[i] = *(const f32x4*)(stb + si * 512 + c0); sb[i] = *(const f32x4*)(stb + si * 512 + c0 + 4); }
            unpack8(zn[0], cur);
#pragma unroll
            for (int jj = 0; jj < 8; ++jj) sum[jj] = cur[jj];
#pragma unroll
            for (int i = 1; i < NL; ++i) { float f[8]; unpack8(zn[i], f); const bool nw = i <= tt;
#pragma unroll
                for (int jj = 0; jj < 4; ++jj) { sum[jj] += nw ? f[jj] : sa[i][jj]; sum[4 + jj] += nw ? f[4 + jj] : sb[i][jj]; } }
        }
#pragma unroll
        for (int i0 = 4; i0 < W; i0 += 4) {
            f32x4 sa[4], sb[4];
#pragma unroll
            for (int i = 0; i < 4; ++i) { const int si = 15 + tt - (i0 + i); sa[i] = *(const f32x4*)(stb + si * 512 + c0); sb[i] = *(const f32x4*)(stb + si * 512 + c0 + 4); }
#pragma unroll
            for (int i = 0; i < 4; ++i)
#pragma unroll
                for (int jj = 0; jj < 4; ++jj) { sum[jj] += sa[i][jj]; sum[4 + jj] += sb[i][jj]; }
        }
#pragma unroll
        for (int jj = 0; jj < 8; ++jj) sum[jj] = sum[jj] * icnt - cur[jj];
        bfr[s] = __builtin_bit_cast(bf16x8, pack8(sum));
        __builtin_amdgcn_sched_barrier(0);
    }
    f32x16 acc[4];
#pragma unroll
    for (int db = 0; db < 4; ++db) {
#pragma unroll
        for (int i = 0; i < 16; ++i) acc[db][i] = 0.f;
        const bf16_t* ap = F.PWT + ((size_t)(l * 4 + G) * 128 + 32 * db + r) * 128 + 8 * hh;
#pragma unroll
        for (int s = 0; s < 8; ++s) acc[db] = __builtin_amdgcn_mfma_f32_32x32x16_bf16(*(const bf16x8*)(ap + 16 * s), bfr[s], acc[db], 0, 0, 0);
        __builtin_amdgcn_sched_barrier(0);
    }
#pragma unroll
    for (int db = 0; db < 4; ++db)
#pragma unroll
        for (int q = 0; q < 4; ++q) {
            const int col = 128 * G + 32 * db + 8 * q + 4 * hh;
            const f32x4 sc = *(const f32x4*)(F.pool_scale + l * 512 + col);
            float gf[4]; unpack4(*(const u32x2*)(F.Z2 + row * ZW + Z_GP + col), gf);
            u32x2 wv; wv.x = pg8::cvt_pk_bf16(acc[db][4 * q + 0] * sc[0] * gf[0], acc[db][4 * q + 1] * sc[1] * gf[1]);
            wv.y = pg8::cvt_pk_bf16(acc[db][4 * q + 2] * sc[2] * gf[2], acc[db][4 * q + 3] * sc[3] * gf[3]);
            *(u32x2*)(F.MIX + row * DM + 1024 + col) = wv;
        }
}
__device__ __forceinline__ void pool_sample(int l, int g, int tile) {
    if (g == 0) pool_unit_s<0>(l, tile); else if (g == 1) pool_unit_s<1>(l, tile); else if (g == 2) pool_unit_s<2>(l, tile); else pool_unit_s<3>(l, tile);
}

struct SguOps { bf16x8 wB[8], wA[4]; u32x2 uu[2][4], gg[2][4]; float bias[2], rsw[2]; };
__device__ __forceinline__ void sgu_load_ops(SguOps& o, const Frame& F, int l, int hd, size_t R0, int r, int hh, int db, int tbA, int tbB) {
    const bf16_t* Wb = F.SGUW + (size_t)(l * 4 + hd) * 128 * 128;
#pragma unroll
    for (int s = 0; s < 8; ++s) { o.wB[s] = (bf16x8){0, 0, 0, 0, 0, 0, 0, 0}; if (s < 2 * (tbB + 1)) o.wB[s] = *(const bf16x8*)(Wb + (32 * tbB + r) * 128 + 16 * s + 8 * hh); }
#pragma unroll
    for (int s = 0; s < 4; ++s) { o.wA[s] = (bf16x8){0, 0, 0, 0, 0, 0, 0, 0}; if (s < 2 * (tbA + 1)) o.wA[s] = *(const bf16x8*)(Wb + (32 * tbA + r) * 128 + 16 * s + 8 * hh); }
#pragma unroll
    for (int pass = 0; pass < 2; ++pass) { const int tb = pass ? tbB : tbA; const size_t row = R0 + 32 * tb + r;
        o.bias[pass] = F.sgu_b[l * 512 + hd * 128 + 32 * tb + r]; o.rsw[pass] = F.RSW[(l * 4 + hd) * 128 + 32 * tb + r];
#pragma unroll
        for (int q = 0; q < 4; ++q) { const int col = 128 * hd + 32 * db + 8 * q + 4 * hh;
            o.uu[pass][q] = __builtin_nontemporal_load((const u32x2*)(F.Z2 + row * ZW + Z_U + col)); o.gg[pass][q] = __builtin_nontemporal_load((const u32x2*)(F.Z2 + row * ZW + Z_GS + col)); } }
}
__device__ __forceinline__ void sgu_mfma(const SguOps& o, LAS bf16_t* VnT, int h2, int r, int hh, int db, int tbA, int tbB, f32x16& accA, f32x16& accB) {
#pragma unroll
    for (int i = 0; i < 16; ++i) { accA[i] = 0.f; accB[i] = 0.f; }
#pragma unroll
    for (int s = 0; s < 8; ++s) {
        if (s < 2 * (tbB + 1)) {
            const LAS unsigned char* ap = (const LAS unsigned char*)VnT + (h2 * 128 + 16 * s + 8 * hh + ((r & 15) >> 2)) * 320 + (32 * db + (r & 16) + 4 * (r & 3)) * 2;
            const v4i16_t lo = __builtin_amdgcn_ds_read_tr16_b64_v4i16((LAS v4i16_t*)ap), hi = __builtin_amdgcn_ds_read_tr16_b64_v4i16((LAS v4i16_t*)(ap + 4 * 320));
            const bf16x8 a = (bf16x8){lo[0], lo[1], lo[2], lo[3], hi[0], hi[1], hi[2], hi[3]};
            accB = __builtin_amdgcn_mfma_f32_32x32x16_bf16(a, o.wB[s], accB, 0, 0, 0);
            if (s < 4) { if (s < 2 * (tbA + 1)) accA = __builtin_amdgcn_mfma_f32_32x32x16_bf16(a, o.wA[s], accA, 0, 0, 0); }
        }
    }
}
__device__ __forceinline__ void sgu_epi(const SguOps& o, const Frame& F, int l, int hd, size_t R0, int r, int hh, int db, int tbA, int tbB, const f32x16& accA, const f32x16& accB) {
    f32x4 lg[4], lb[4];
#pragma unroll
    for (int q = 0; q < 4; ++q) { const int col = 128 * hd + 32 * db + 8 * q + 4 * hh; lg[q] = *(const f32x4*)(F.ln_g + l * 512 + col); lb[q] = *(const f32x4*)(F.ln_b + l * 512 + col); }
#pragma unroll
    for (int pass = 0; pass < 2; ++pass) {
        const int tb = pass ? tbB : tbA; const f32x16 acc = pass ? accB : accA;
        const size_t row = R0 + 32 * tb + r; const float bs = o.bias[pass], rs = o.rsw[pass];
#pragma unroll
        for (int q = 0; q < 4; ++q) { const int col = 128 * hd + 32 * db + 8 * q + 4 * hh;
            float uf[4], gf[4]; unpack4(o.uu[pass][q], uf); unpack4(o.gg[pass][q], gf);
            float m[4];
#pragma unroll
            for (int e = 0; e < 4; ++e) m[e] = (lg[q][e] * acc[4 * q + e] + lb[q][e] * rs + bs) * uf[e] * gf[e];
            u32x2 wo; wo.x = pg8::cvt_pk_bf16(m[0], m[1]); wo.y = pg8::cvt_pk_bf16(m[2], m[3]);
            *(u32x2*)(F.MIX + row * DM + 1536 + col) = wo; }
    }
}
__device__ __forceinline__ void sgu_unit(int l, int ci, int hp, LAS unsigned char* ring) {
    LOCAL_FRAME;
    LAS bf16_t* VnT = (LAS bf16_t*)ring;
    const int lane = F.lane, wv = F.wave;
    const size_t R0 = (size_t)128 * ci;
    const int r = lane & 31, hh = lane >> 5, db = wv & 3; const int tbA = (wv >> 2) ? 1 : 0, tbB = (wv >> 2) ? 2 : 3;
    SguOps op0;
    {
        const int tl = lane >> 2, q4 = lane & 3;
        const bf16_t* vrow = F.Z2 + (R0 + 16 * wv + tl) * ZW + Z_VS + 32 * q4;
        u32x4 x[4][4];
#pragma unroll
        for (int h = 0; h < 4; ++h)
#pragma unroll
            for (int i = 0; i < 4; ++i) x[h][i] = *(const u32x4*)(vrow + 128 * h + 8 * i);
        sgu_load_ops(op0, F, l, 2 * hp, R0, r, hh, db, tbA, tbB);
        float s = 0.f, ss = 0.f;
#pragma unroll
        for (int h = 0; h < 4; ++h)
#pragma unroll
            for (int i = 0; i < 4; ++i) { float f[8]; unpack8(x[h][i], f);
#pragma unroll
                for (int jj = 0; jj < 8; ++jj) { s += f[jj]; ss += f[jj] * f[jj]; } }
        s += __shfl_xor(s, 1); s += __shfl_xor(s, 2); ss += __shfl_xor(ss, 1); ss += __shfl_xor(ss, 2);
        const float mean = s * (1.0f / 512.0f), var = ss * (1.0f / 512.0f) - mean * mean, rstd = rsqrtf(var + EPS);
#pragma unroll
        for (int h2 = 0; h2 < 2; ++h2)
#pragma unroll
            for (int i = 0; i < 4; ++i) { const int d = 32 * q4 + 8 * i;
                const u32x4 xv = hp ? x[2 + h2][i] : x[h2][i];
                float f[8]; unpack8(xv, f);
#pragma unroll
                for (int jj = 0; jj < 8; ++jj) f[jj] = (f[jj] - mean) * rstd;
                *(LAS u32x4*)((LAS unsigned char*)VnT + (h2 * 128 + 16 * wv + tl) * 320 + d * 2) = pack8(f); }
    }
    LDS_WAIT();
    __syncthreads();
    f32x16 accA, accB;
    sgu_mfma(op0, VnT, 0, r, hh, db, tbA, tbB, accA, accB);
    SguOps op1;
    sgu_load_ops(op1, F, l, 2 * hp + 1, R0, r, hh, db, tbA, tbB);
    sgu_epi(op0, F, l, 2 * hp, R0, r, hh, db, tbA, tbB, accA, accB);
    sgu_mfma(op1, VnT, 1, r, hh, db, tbA, tbB, accA, accB);
    sgu_epi(op1, F, l, 2 * hp + 1, R0, r, hh, db, tbA, tbB, accA, accB);
    __syncthreads();
}

__device__ __forceinline__ void samp_attn(int l, int bd, int kvh, LAS unsigned char* wl) {
    LOCAL_FRAME;
    LAS float* ps = (LAS float*)wl;
    LAS float* invs = ps + 144 * 16;
    const int lane = F.lane, fr = lane & 15, fq = lane >> 4, gq = fr >> 2, tt = fr & 3;
    float* oKs = F.out + O_KS + (size_t)l * LS_KS; float* oVs = F.out + O_VS + (size_t)l * LS_KS;
    bf16x8 qfr[2];
    {
        const bf16_t* qsrc = F.Qc + ((size_t)MP + 4 * bd + tt) * 1024 + (4 * kvh + gq) * 64 + 16 * fq;
        const u32x4 qa = *(const u32x4*)qsrc, qb = *(const u32x4*)(qsrc + 8);
        u32x4 lo, hi;
        lo.x = (qa.x & 0xffffu) | (qa.y << 16); lo.y = (qa.z & 0xffffu) | (qa.w << 16); lo.z = (qb.x & 0xffffu) | (qb.y << 16); lo.w = (qb.z & 0xffffu) | (qb.w << 16);
        hi.x = (qa.x >> 16) | (qa.y & 0xffff0000u); hi.y = (qa.z >> 16) | (qa.w & 0xffff0000u); hi.z = (qb.x >> 16) | (qb.y & 0xffff0000u); hi.w = (qb.z >> 16) | (qb.w & 0xffff0000u);
        qfr[0] = __builtin_bit_cast(bf16x8, lo); qfr[1] = __builtin_bit_cast(bf16x8, hi);
    }
    const float* kc = F.cache_k + (((size_t)l * 128 + bd) * 128) * 256 + kvh * 64 + 8 * fq;
    const float* kn = oKs + (((size_t)bd * 128 + 124 + (fr & 3)) * 4 + kvh) * 64 + 8 * fq;
    float* kd = oKs + ((size_t)bd * 128 * 4 + kvh) * 64 + 8 * fq;
    f32x4 S[9];
#pragma unroll
    for (int T = 0; T < 9; ++T) S[T] = (f32x4){0.f, 0.f, 0.f, 0.f};
#pragma unroll
    for (int T0 = 0; T0 < 9; T0 += 3) {
        f32x4 x[3][2][2];
#pragma unroll
        for (int u = 0; u < 3; ++u) { const int T = T0 + u; const float* src = (T < 8) ? kc + (size_t)(16 * T + fr) * 256 : kn;
#pragma unroll
            for (int ks = 0; ks < 2; ++ks) { x[u][ks][0] = __builtin_nontemporal_load((const f32x4*)(src + 32 * ks)); x[u][ks][1] = __builtin_nontemporal_load((const f32x4*)(src + 32 * ks + 4)); } }
#pragma unroll
        for (int u = 0; u < 3; ++u) { const int T = T0 + u; const int key = 16 * T + fr;
            if (T < 8 && key >= 4) {
#pragma unroll
                for (int ks = 0; ks < 2; ++ks) { float* dst = kd + (size_t)(key - 4) * 256 + 32 * ks; __builtin_nontemporal_store(x[u][ks][0], (f32x4*)dst); __builtin_nontemporal_store(x[u][ks][1], (f32x4*)(dst + 4)); } } }
#pragma unroll
        for (int u = 0; u < 3; ++u)
#pragma unroll
            for (int ks = 0; ks < 2; ++ks) { u32x4 w; w.x = pg8::cvt_pk_bf16(x[u][ks][0][0], x[u][ks][0][1]); w.y = pg8::cvt_pk_bf16(x[u][ks][0][2], x[u][ks][0][3]);
                w.z = pg8::cvt_pk_bf16(x[u][ks][1][0], x[u][ks][1][1]); w.w = pg8::cvt_pk_bf16(x[u][ks][1][2], x[u][ks][1][3]);
                S[T0 + u] = __builtin_amdgcn_mfma_f32_16x16x32_bf16(__builtin_bit_cast(bf16x8, w), qfr[ks], S[T0 + u], 0, 0, 0); }
        __builtin_amdgcn_sched_barrier(0);
    }
    const float sink2 = F.sinks[l * 16 + 4 * kvh + gq] * LOG2E;
    float m = sink2;
#pragma unroll
    for (int T = 0; T < 9; ++T)
#pragma unroll
        for (int rg = 0; rg < 4; ++rg) { const int key = 16 * T + 4 * fq + rg; const bool ok = (T < 8) ? (key >= tt + 1) : (fq == 0 && rg <= tt);
            S[T][rg] = ok ? S[T][rg] : -INFINITY; m = fmaxf(m, S[T][rg]); }
    m = fmaxf(m, __shfl_xor(m, 16)); m = fmaxf(m, __shfl_xor(m, 32));
    float sum = 0.f;
#pragma unroll
    for (int T = 0; T < 9; ++T)
#pragma unroll
        for (int rg = 0; rg < 4; ++rg) { const float p = __builtin_amdgcn_exp2f(S[T][rg] - m); sum += p; ps[(16 * T + 4 * fq + rg) * 16 + fr] = p; }
    sum += __shfl_xor(sum, 16); sum += __shfl_xor(sum, 32);
    if (fq == 0) invs[fr] = 1.0f / (sum + __builtin_amdgcn_exp2f(sink2 - m));
    LDS_WAIT();
    const int kq = lane >> 4, dq = lane & 15;
    const float* vcp = F.cache_v + (((size_t)l * 128 + bd) * 128 + kq) * 256 + kvh * 64 + 4 * dq;
    float* vop = oVs + ((size_t)bd * 128 + kq) * 256 + kvh * 64 + 4 * dq;
#pragma unroll 1
    for (int pass = 0; pass < 2; ++pass) {
        float o[8][4];
#pragma unroll
        for (int q = 0; q < 8; ++q) { o[q][0] = 0.f; o[q][1] = 0.f; o[q][2] = 0.f; o[q][3] = 0.f; }
#pragma unroll 1
        for (int blk = 0; blk < 3; ++blk) {
            f32x4 vx[11];
#pragma unroll
            for (int ii = 0; ii < 11; ++ii) { const int i = blk * 11 + ii; const float* src = (i < 32) ? vcp + (size_t)i * 1024 : vop + (size_t)31 * 1024; vx[ii] = __builtin_nontemporal_load((const f32x4*)src); }
            if (pass == 0) {
#pragma unroll
                for (int ii = 0; ii < 11; ++ii) { const int i = blk * 11 + ii; if (i >= 1 && i < 32) __builtin_nontemporal_store(vx[ii], (f32x4*)(vop + (size_t)(i - 1) * 1024)); } }
#pragma unroll
            for (int ii = 0; ii < 11; ++ii) { const int key = 4 * (blk * 11 + ii) + kq;
                const f32x4 pa = *(const LAS f32x4*)(ps + key * 16 + 8 * pass), pb = *(const LAS f32x4*)(ps + key * 16 + 8 * pass + 4);
#pragma unroll
                for (int e = 0; e < 4; ++e) { o[0][e] += pa[0] * vx[ii][e]; o[1][e] += pa[1] * vx[ii][e]; o[2][e] += pa[2] * vx[ii][e]; o[3][e] += pa[3] * vx[ii][e];
                    o[4][e] += pb[0] * vx[ii][e]; o[5][e] += pb[1] * vx[ii][e]; o[6][e] += pb[2] * vx[ii][e]; o[7][e] += pb[3] * vx[ii][e]; }
                __builtin_amdgcn_sched_barrier(0); }
        }
#pragma unroll
        for (int q = 0; q < 8; ++q)
#pragma unroll
            for (int e = 0; e < 4; ++e) { float v = o[q][e]; v += __shfl_xor(v, 16); v += __shfl_xor(v, 32); o[q][e] = v; }
#pragma unroll
        for (int q = 0; q < 8; ++q) if ((q >> 1) == kq) { const int qq = 8 * pass + q, t2 = qq & 3, head = 4 * kvh + (qq >> 2); const size_t row = (size_t)MP + 4 * bd + t2;
            float gf[4]; unpack4(*(const u32x2*)(F.Z2 + row * ZW + Z_GA + head * 64 + 4 * dq), gf);
            const float iq = invs[qq];
            u32x2 wv; wv.x = pg8::cvt_pk_bf16(o[q][0] * iq * gf[0], o[q][1] * iq * gf[1]); wv.y = pg8::cvt_pk_bf16(o[q][2] * iq * gf[2], o[q][3] * iq * gf[3]);
            *(u32x2*)(F.MIX + row * DM + head * 64 + 4 * dq) = wv; }
    }
    LDS_WAIT();
}
__device__ __forceinline__ void samp_sgu(int l, int bd) {
    LOCAL_FRAME;
    const int lane = F.lane, c0 = 8 * lane, hd = lane >> 4;
    {
        float* oPs = F.out + O_PS + (size_t)l * LS_PS + (size_t)bd * 15 * 512; const float* sp = F.state_pool + (size_t)l * LS_PS + (size_t)bd * 15 * 512 + 4 * 512;
        f32x4 cp[22];
#pragma unroll
        for (int k = 0; k < 22; ++k) cp[k] = __builtin_nontemporal_load((const f32x4*)(sp + 4 * (lane + 64 * k)));
#pragma unroll
        for (int k = 0; k < 22; ++k) __builtin_nontemporal_store(cp[k], (f32x4*)(oPs + 4 * (lane + 64 * k)));
    }
    float* oCV = F.out + O_CV + (size_t)l * LS_CV;
    float gl[8], bl[8];
#pragma unroll
    for (int j = 0; j < 8; ++j) { gl[j] = F.ln_g[l * 512 + c0 + j]; bl[j] = F.ln_b[l * 512 + c0 + j]; }
    u32x4 xr[4], ur[4], gr[4];
#pragma unroll
    for (int tt = 0; tt < 4; ++tt) { const size_t row = (size_t)MP + 4 * bd + tt; xr[tt] = *(const u32x4*)(F.Z2 + row * ZW + Z_VS + c0); ur[tt] = *(const u32x4*)(F.Z2 + row * ZW + Z_U + c0); gr[tt] = *(const u32x4*)(F.Z2 + row * ZW + Z_GS + c0); }
    float vn[4][8];
#pragma unroll
    for (int tt = 0; tt < 4; ++tt) { float f[8]; unpack8(xr[tt], f);
        float s = 0.f, ss = 0.f;
#pragma unroll
        for (int j = 0; j < 8; ++j) { s += f[j]; ss += f[j] * f[j]; }
        s = wave_sum(s); ss = wave_sum(ss);
        const float mean = s * (1.0f / 512.0f), var = ss * (1.0f / 512.0f) - mean * mean, rstd = rsqrtf(var + EPS);
#pragma unroll
        for (int j = 0; j < 8; ++j) vn[tt][j] = (f[j] - mean) * rstd * gl[j] + bl[j];
        float* o = oCV + ((size_t)bd * 4 + tt) * 512 + c0;
        *(f32x4*)o = (f32x4){vn[tt][0], vn[tt][1], vn[tt][2], vn[tt][3]}; *(f32x4*)(o + 4) = (f32x4){vn[tt][4], vn[tt][5], vn[tt][6], vn[tt][7]}; }
#pragma unroll
    for (int tt = 0; tt < 4; ++tt) { const size_t row = (size_t)MP + 4 * bd + tt;
        float mx[8]; const float bias = F.sgu_b[l * 512 + hd * 128 + tt];
#pragma unroll
        for (int j = 0; j < 8; ++j) mx[j] = bias;
#pragma unroll
        for (int s2 = 0; s2 < 4; ++s2) if (s2 <= tt) { const float w = F.sgu_w[((size_t)(l * 4 + hd) * 128 + tt) * 128 + s2];
#pragma unroll
            for (int j = 0; j < 8; ++j) mx[j] += w * vn[s2][j]; }
        float uf[8], gf[8]; unpack8(ur[tt], uf); unpack8(gr[tt], gf);
#pragma unroll
        for (int j = 0; j < 8; ++j) mx[j] = mx[j] * uf[j] * gf[j];
        *(u32x4*)(F.MIX + row * DM + 1536 + c0) = pack8(mx); }
}

#ifdef HYBRID
__device__ __forceinline__ void attn_task_o(const Frame& F, int l, int b, int nb, int head, int qs, LAS unsigned char* wl) {
    const int lane = F.lane, r = lane & 31, hh = lane >> 5, kvh = head >> 2;
    LAS float* wsf = (LAS float*)wl; LAS bf16_t* stg = (LAS bf16_t*)(wl + 256);
    const int t0 = 128 * nb + 32 * qs;
    const size_t qrow0 = (size_t)b * 2048 + t0;
    const bf16_t* qp = F.Qc + (qrow0 + r) * 1024 + head * 64 + 8 * hh;
    bf16x8 qf[4];
#pragma unroll
    for (int s = 0; s < 4; ++s) qf[s] = *(const bf16x8*)(qp + 16 * s);
    const bf16_t* kbase = F.Kc + (size_t)(b * 4 + kvh) * 2048 * 64;
    const bf16_t* vbase = F.VTP + (size_t)(b * 4 + kvh) * 64 * 2048;
    const int cmin = (nb > 0) ? 0 : (4 - qs);
    f32x16 S[5];
#pragma unroll
    for (int c = 0; c < 5; ++c) {
        f32x16 a;
#pragma unroll
        for (int i = 0; i < 16; ++i) a[i] = 0.f;
        if (c >= cmin) {
            const bf16_t* kp = kbase + (size_t)(t0 - 128 + 32 * c + r) * 64 + 8 * hh;
#pragma unroll
            for (int s = 0; s < 4; ++s) a = __builtin_amdgcn_mfma_f32_32x32x16_bf16(*(const bf16x8*)(kp + 16 * s), qf[s], a, 0, 0, 0);
        }
        S[c] = a;
    }
    const float NEG = -INFINITY;
#pragma unroll
    for (int i = 0; i < 16; ++i) { const int kap = crow(i, hh); if (kap <= r) S[0][i] = NEG; if (kap > r) S[4][i] = NEG; }
    const float sink2 = F.sinks[l * 16 + head] * LOG2E;
    float m = sink2;
#pragma unroll
    for (int c = 0; c < 5; ++c) if (c >= cmin) {
#pragma unroll
        for (int i = 0; i < 16; ++i) m = fmaxf(m, S[c][i]); }
    m = fmaxf(m, __shfl_xor(m, 32));
    float sum = 0.f;
#pragma unroll
    for (int c = 0; c < 5; ++c) if (c >= cmin) {
#pragma unroll
        for (int i = 0; i < 16; ++i) { const float p = __builtin_amdgcn_exp2f(S[c][i] - m); S[c][i] = p; sum += p; } }
    sum += __shfl_xor(sum, 32);
    const float inv = 1.0f / (sum + __builtin_amdgcn_exp2f(sink2 - m));
    f32x16 o[2];
#pragma unroll
    for (int i = 0; i < 16; ++i) { o[0][i] = 0.f; o[1][i] = 0.f; }
#pragma unroll
    for (int c = 0; c < 5; ++c) if (c >= cmin) {
        const bf16_t* vt = vbase + (size_t)((t0 - 128 + 32 * c) >> 5) * 2048 + r * 32 + 16 * hh;
#pragma unroll
        for (int s = 0; s < 2; ++s) {
            u32x4 pw; pw.x = pg8::cvt_pk_bf16(S[c][8 * s + 0], S[c][8 * s + 1]); pw.y = pg8::cvt_pk_bf16(S[c][8 * s + 2], S[c][8 * s + 3]);
            pw.z = pg8::cvt_pk_bf16(S[c][8 * s + 4], S[c][8 * s + 5]); pw.w = pg8::cvt_pk_bf16(S[c][8 * s + 6], S[c][8 * s + 7]);
            const bf16x8 pa = __builtin_bit_cast(bf16x8, pw);
#pragma unroll
            for (int db = 0; db < 2; ++db) o[db] = __builtin_amdgcn_mfma_f32_32x32x16_bf16(pa, *(const bf16x8*)(vt + db * 1024 + 8 * s), o[db], 0, 0, 0);
        }
    }
    if (hh == 0) wsf[r] = inv;
    LDS_WAIT();
#pragma unroll
    for (int i = 0; i < 16; ++i) { const int q = crow(i, hh); const float rl = wsf[q];
        stg[q * 64 + r] = (bf16_t)(pg8::cvt_pk_bf16(o[0][i] * rl, 0.f) & 0xffffu);
        stg[q * 64 + 32 + r] = (bf16_t)(pg8::cvt_pk_bf16(o[1][i] * rl, 0.f) & 0xffffu); }
    LDS_WAIT();
#pragma unroll
    for (int i = 0; i < 4; ++i) { const int row = i * 8 + (lane >> 3), ch = lane & 7;
        const u32x4 ov = *(const LAS u32x4*)(stg + row * 64 + ch * 8);
        const u32x4 gv = *(const u32x4*)(F.Z2 + (qrow0 + row) * ZW + Z_GA + head * 64 + ch * 8);
        float of[8], gf[8]; unpack8(ov, of); unpack8(gv, gf);
#pragma unroll
        for (int j = 0; j < 8; ++j) of[j] *= gf[j];
        *(u32x4*)(F.MIX + (qrow0 + row) * DM + head * 64 + ch * 8) = pack8(of); }
    LDS_WAIT();
}

template <bool SAMPLE>
__device__ __forceinline__ void pool_unit_o(const Frame& F, int l, int g, int tile) {
    const int lane = F.lane, r = lane & 31, hh = lane >> 5, w = 2 << g;
    const size_t row = (size_t)(SAMPLE ? MP : 0) + 32 * tile + r;
    const int t = SAMPLE ? (int)(row & 3) : (int)(row & 2047);
    const int bd = SAMPLE ? (int)((row - MP) >> 2) : 0;
    const float icnt = SAMPLE ? 1.0f / (float)w : 1.0f / (float)(w < t + 1 ? w : t + 1);
    bf16x8 bfr[8];
#pragma unroll
    for (int s = 0; s < 8; ++s) {
        const int c0 = 128 * g + 16 * s + 8 * hh;
        float sum[8], cur[8];
#pragma unroll
        for (int j = 0; j < 8; ++j) { sum[j] = 0.f; cur[j] = 0.f; }
        for (int i = 0; i < w; ++i) {
            float f[8];
            const int e = t - i;
            if (e >= 0) { unpack8(*(const u32x4*)(F.Z2 + (row - i) * ZW + Z_XB + c0), f); }
            else if (SAMPLE) { const float* sp = F.state_pool + (((size_t)l * 128 + bd) * 15 + 15 + e) * 512 + c0;
                const f32x4 a = *(const f32x4*)sp, bq = *(const f32x4*)(sp + 4); f[0] = a[0]; f[1] = a[1]; f[2] = a[2]; f[3] = a[3]; f[4] = bq[0]; f[5] = bq[1]; f[6] = bq[2]; f[7] = bq[3]; }
            else {
#pragma unroll
                for (int j = 0; j < 8; ++j) f[j] = 0.f; }
#pragma unroll
            for (int j = 0; j < 8; ++j) sum[j] += f[j];
            if (i == 0) {
#pragma unroll
                for (int j = 0; j < 8; ++j) cur[j] = f[j]; }
        }
        float pf[8];
#pragma unroll
        for (int j = 0; j < 8; ++j) pf[j] = sum[j] * icnt - cur[j];
        bfr[s] = __builtin_bit_cast(bf16x8, pack8(pf));
    }
    f32x16 acc[4];
#pragma unroll
    for (int db = 0; db < 4; ++db) {
#pragma unroll
        for (int i = 0; i < 16; ++i) acc[db][i] = 0.f;
        const bf16_t* ap = F.PWT + ((size_t)(l * 4 + g) * 128 + 32 * db + r) * 128 + 8 * hh;
#pragma unroll
        for (int s = 0; s < 8; ++s) acc[db] = __builtin_amdgcn_mfma_f32_32x32x16_bf16(*(const bf16x8*)(ap + 16 * s), bfr[s], acc[db], 0, 0, 0);
    }
#pragma unroll
    for (int db = 0; db < 4; ++db)
#pragma unroll
        for (int q = 0; q < 4; ++q) {
            const int col = 128 * g + 32 * db + 8 * q + 4 * hh;
            const f32x4 sc = *(const f32x4*)(F.pool_scale + l * 512 + col);
            float gf[4]; unpack4(*(const u32x2*)(F.Z2 + row * ZW + Z_GP + col), gf);
            u32x2 wv; wv.x = pg8::cvt_pk_bf16(acc[db][4 * q + 0] * sc[0] * gf[0], acc[db][4 * q + 1] * sc[1] * gf[1]);
            wv.y = pg8::cvt_pk_bf16(acc[db][4 * q + 2] * sc[2] * gf[2], acc[db][4 * q + 3] * sc[3] * gf[3]);
            *(u32x2*)(F.MIX + row * DM + 1024 + col) = wv;
        }
}

__device__ __forceinline__ void sgu_unit_o(const Frame& F, int l, int ci, int hd, LAS unsigned char* ring) {
    LAS bf16_t* VnT = (LAS bf16_t*)ring;
    const int lane = F.lane, wv = F.wave;
    const size_t R0 = (size_t)128 * ci;
    {
        const int tl = lane >> 2, q4 = lane & 3;
        const bf16_t* vrow = F.Z2 + (R0 + 16 * wv + tl) * ZW + Z_VS;
        float s = 0.f, ss = 0.f;
#pragma unroll
        for (int i = 0; i < 16; ++i) { float f[8]; unpack8(*(const u32x4*)(vrow + 128 * q4 + 8 * i), f);
#pragma unroll
            for (int j = 0; j < 8; ++j) { s += f[j]; ss += f[j] * f[j]; } }
        s += __shfl_xor(s, 1); s += __shfl_xor(s, 2); ss += __shfl_xor(ss, 1); ss += __shfl_xor(ss, 2);
        const float mean = s * (1.0f / 512.0f), var = ss * (1.0f / 512.0f) - mean * mean, rstd = rsqrtf(var + EPS);
#pragma unroll
        for (int i = 0; i < 4; ++i) { const int d = 32 * q4 + 8 * i; float f[8]; unpack8(*(const u32x4*)(vrow + 128 * hd + d), f);
            const float* gp = F.ln_g + l * 512 + 128 * hd + d; const float* bp = F.ln_b + l * 512 + 128 * hd + d;
#pragma unroll
            for (int j = 0; j < 8; ++j) { const float vn = (f[j] - mean) * rstd * gp[j] + bp[j];
                VnT[(d + j) * 136 + 16 * wv + tl] = (bf16_t)(pg8::cvt_pk_bf16(vn, 0.f) & 0xffffu); } }
    }
    __syncthreads();
    {
        const int r = lane & 31, hh = lane >> 5, db = wv & 3; const int tbA = (wv >> 2) ? 1 : 0, tbB = (wv >> 2) ? 2 : 3;
        f32x16 accA, accB;
#pragma unroll
        for (int i = 0; i < 16; ++i) { accA[i] = 0.f; accB[i] = 0.f; }
        const bf16_t* Wb = F.SGUW + (size_t)(l * 4 + hd) * 128 * 128;
#pragma unroll
        for (int s = 0; s < 8; ++s) {
            if (s < 2 * (tbB + 1)) {
                const bf16x8 a = *(const LAS bf16x8*)(VnT + (32 * db + r) * 136 + 16 * s + 8 * hh);
                accB = __builtin_amdgcn_mfma_f32_32x32x16_bf16(a, *(const bf16x8*)(Wb + (32 * tbB + r) * 128 + 16 * s + 8 * hh), accB, 0, 0, 0);
                if (s < 2 * (tbA + 1)) accA = __builtin_amdgcn_mfma_f32_32x32x16_bf16(a, *(const bf16x8*)(Wb + (32 * tbA + r) * 128 + 16 * s + 8 * hh), accA, 0, 0, 0);
            }
        }
#pragma unroll
        for (int pass = 0; pass < 2; ++pass) {
            const int tb = pass ? tbB : tbA; const f32x16 acc = pass ? accB : accA;
            const int t = 32 * tb + r; const size_t row = R0 + t; const float bias = F.sgu_b[l * 512 + hd * 128 + t];
#pragma unroll
            for (int q = 0; q < 4; ++q) { const int col = 128 * hd + 32 * db + 8 * q + 4 * hh;
                float uf[4], gf[4]; unpack4(*(const u32x2*)(F.Z2 + row * ZW + Z_U + col), uf); unpack4(*(const u32x2*)(F.Z2 + row * ZW + Z_GS + col), gf);
                u32x2 wo; wo.x = pg8::cvt_pk_bf16((acc[4 * q + 0] + bias) * uf[0] * gf[0], (acc[4 * q + 1] + bias) * uf[1] * gf[1]);
                wo.y = pg8::cvt_pk_bf16((acc[4 * q + 2] + bias) * uf[2] * gf[2], (acc[4 * q + 3] + bias) * uf[3] * gf[3]);
                *(u32x2*)(F.MIX + row * DM + 1536 + col) = wo; }
        }
    }
    __syncthreads();
}

__device__ __forceinline__ void samp_attn_o(const Frame& F, int l, int bd, int kvh, LAS unsigned char* wl) {
    LAS float* qs = (LAS float*)wl;
    LAS float* ps = (LAS float*)(wl + 4096);
    const int lane = F.lane;
    float* oKs = F.out + O_KS + (size_t)l * LS_KS; float* oVs = F.out + O_VS + (size_t)l * LS_KS;
    {
        const int qi = lane >> 2, part = lane & 3, gq = qi >> 2, tt = qi & 3;
        const bf16_t* src = F.Qc + ((size_t)MP + 4 * bd + tt) * 1024 + (4 * kvh + gq) * 64 + 16 * part;
        float f0[8], f1[8]; unpack8(*(const u32x4*)src, f0); unpack8(*(const u32x4*)(src + 8), f1);
#pragma unroll
        for (int j = 0; j < 8; ++j) { const int p0 = 16 * part + j, p1 = p0 + 8;
            qs[qi * 64 + (p0 >> 1) + 32 * (p0 & 1)] = f0[j]; qs[qi * 64 + (p1 >> 1) + 32 * (p1 & 1)] = f1[j]; }
    }
    LDS_WAIT();
    float s0[16], s1[16], s2[16];
#pragma unroll
    for (int q = 0; q < 16; ++q) { s0[q] = 0.f; s1[q] = 0.f; s2[q] = 0.f; }
    const float* k0p = F.cache_k + (((size_t)l * 128 + bd) * 128 + lane) * 256 + kvh * 64;
    const float* k1p = k0p + 64 * 256;
    const float* k2p = oKs + (((size_t)bd * 128 + 124 + (lane & 3)) * 4 + kvh) * 64;
    float* c0p = oKs + (((size_t)bd * 128 + (lane >= 4 ? lane - 4 : 0)) * 4 + kvh) * 64;
    float* c1p = oKs + (((size_t)bd * 128 + lane + 60) * 4 + kvh) * 64;
    for (int ch = 0; ch < 16; ++ch) {
        const f32x4 kx0 = *(const f32x4*)(k0p + 4 * ch), kx1 = *(const f32x4*)(k1p + 4 * ch), kx2 = *(const f32x4*)(k2p + 4 * ch);
        if (lane >= 4) *(f32x4*)(c0p + 4 * ch) = kx0;
        *(f32x4*)(c1p + 4 * ch) = kx1;
#pragma unroll
        for (int q = 0; q < 16; ++q) { const f32x4 qv = *(const LAS f32x4*)(qs + q * 64 + 4 * ch);
            s0[q] += (qv[0] * kx0[0] + qv[1] * kx0[1]) + (qv[2] * kx0[2] + qv[3] * kx0[3]);
            s1[q] += (qv[0] * kx1[0] + qv[1] * kx1[1]) + (qv[2] * kx1[2] + qv[3] * kx1[3]);
            s2[q] += (qv[0] * kx2[0] + qv[1] * kx2[1]) + (qv[2] * kx2[2] + qv[3] * kx2[3]); }
    }
    float inv[16];
#pragma unroll
    for (int q = 0; q < 16; ++q) {
        const int tt = q & 3; const float sink2 = F.sinks[l * 16 + 4 * kvh + (q >> 2)] * LOG2E;
        const bool v0 = lane >= tt + 1, v2 = (lane < 4) && (lane <= tt);
        float m = s1[q]; if (v0) m = fmaxf(m, s0[q]); if (v2) m = fmaxf(m, s2[q]);
        m = fmaxf(wave_max(m), sink2);
        const float p0 = v0 ? __builtin_amdgcn_exp2f(s0[q] - m) : 0.f, p1 = __builtin_amdgcn_exp2f(s1[q] - m), p2 = v2 ? __builtin_amdgcn_exp2f(s2[q] - m) : 0.f;
        const float sum = wave_sum(p0 + p1 + p2);
        inv[q] = 1.0f / (sum + __builtin_amdgcn_exp2f(sink2 - m));
        ps[lane * 16 + q] = p0; ps[(lane + 64) * 16 + q] = p1; if (lane < 4) ps[(128 + lane) * 16 + q] = p2;
    }
    LDS_WAIT();
    float o[16];
#pragma unroll
    for (int q = 0; q < 16; ++q) o[q] = 0.f;
    const float* vcp = F.cache_v + (((size_t)l * 128 + bd) * 128) * 256 + kvh * 64 + lane;
    float* vop = oVs + ((size_t)bd * 128) * 256 + kvh * 64 + lane;
    for (int key = 0; key < 132; ++key) {
        float v;
        if (key < 128) { v = vcp[(size_t)key * 256]; if (key >= 4) vop[(size_t)(key - 4) * 256] = v; }
        else v = vop[(size_t)(key - 4) * 256];
#pragma unroll
        for (int q4 = 0; q4 < 4; ++q4) { const f32x4 pv = *(const LAS f32x4*)(ps + key * 16 + 4 * q4);
            o[4 * q4 + 0] += pv[0] * v; o[4 * q4 + 1] += pv[1] * v; o[4 * q4 + 2] += pv[2] * v; o[4 * q4 + 3] += pv[3] * v; }
    }
#pragma unroll
    for (int q = 0; q < 16; ++q) { const int tt = q & 3, head = 4 * kvh + (q >> 2); const size_t row = (size_t)MP + 4 * bd + tt;
        const float gv = __uint_as_float(((unsigned)F.Z2[row * ZW + Z_GA + head * 64 + lane]) << 16);
        F.MIX[row * DM + head * 64 + lane] = (bf16_t)(pg8::cvt_pk_bf16(o[q] * inv[q] * gv, 0.f) & 0xffffu); }
    LDS_WAIT();
}
__device__ __forceinline__ void samp_sgu_o(const Frame& F, int l, int bd) {
    const int lane = F.lane, c0 = 8 * lane, hd = lane >> 4;
    float* oCV = F.out + O_CV + (size_t)l * LS_CV;
    float gl[8], bl[8];
#pragma unroll
    for (int j = 0; j < 8; ++j) { gl[j] = F.ln_g[l * 512 + c0 + j]; bl[j] = F.ln_b[l * 512 + c0 + j]; }
    float vn[4][8];
#pragma unroll
    for (int tt = 0; tt < 4; ++tt) { const size_t row = (size_t)MP + 4 * bd + tt; float f[8]; unpack8(*(const u32x4*)(F.Z2 + row * ZW + Z_VS + c0), f);
        float s = 0.f, ss = 0.f;
#pragma unroll
        for (int j = 0; j < 8; ++j) { s += f[j]; ss += f[j] * f[j]; }
        s = wave_sum(s); ss = wave_sum(ss);
        const float mean = s * (1.0f / 512.0f), var = ss * (1.0f / 512.0f) - mean * mean, rstd = rsqrtf(var + EPS);
#pragma unroll
        for (int j = 0; j < 8; ++j) vn[tt][j] = (f[j] - mean) * rstd * gl[j] + bl[j];
        float* o = oCV + ((size_t)bd * 4 + tt) * 512 + c0;
        *(f32x4*)o = (f32x4){vn[tt][0], vn[tt][1], vn[tt][2], vn[tt][3]}; *(f32x4*)(o + 4) = (f32x4){vn[tt][4], vn[tt][5], vn[tt][6], vn[tt][7]}; }
#pragma unroll
    for (int tt = 0; tt < 4; ++tt) { const size_t row = (size_t)MP + 4 * bd + tt;
        float mx[8]; const float bias = F.sgu_b[l * 512 + hd * 128 + tt];
#pragma unroll
        for (int j = 0; j < 8; ++j) mx[j] = bias;
#pragma unroll
        for (int s2 = 0; s2 < 4; ++s2) if (s2 <= tt) { const float w = F.sgu_w[((size_t)(l * 4 + hd) * 128 + tt) * 128 + s2];
#pragma unroll
            for (int j = 0; j < 8; ++j) mx[j] += w * vn[s2][j]; }
        float uf[8], gf[8]; unpack8(*(const u32x4*)(F.Z2 + row * ZW + Z_U + c0), uf); unpack8(*(const u32x4*)(F.Z2 + row * ZW + Z_GS + c0), gf);
#pragma unroll
        for (int j = 0; j < 8; ++j) mx[j] = mx[j] * uf[j] * gf[j];
        *(u32x4*)(F.MIX + row * DM + 1536 + c0) = pack8(mx); }
}

#endif
struct NormRowIn { u32x4 yv[4]; f32x4 xv[4][2]; };
__device__ __forceinline__ void norm_row_load(NormRowIn& in, const Frame& F, int l, int row) {
    const int lane = F.lane;
    const bf16_t* yr = F.Yb + (size_t)row * DM + 8 * lane;
    const float* xr = ((l == 0) ? (row < MP ? F.xp + (size_t)row * DM : F.xs + (size_t)(row - MP) * DM) : F.out + (size_t)row * DM) + 8 * lane;
#pragma unroll
    for (int j = 0; j < 4; ++j) { in.yv[j] = __builtin_nontemporal_load((const u32x4*)(yr + 512 * j)); in.xv[j][0] = __builtin_nontemporal_load((const f32x4*)(xr + 512 * j)); in.xv[j][1] = __builtin_nontemporal_load((const f32x4*)(xr + 512 * j + 4)); }
}
__device__ __forceinline__ void norm_row_finish(const NormRowIn& in, const Frame& F, int l, int row) {
    const int lane = F.lane;
    float* orow = F.out + (size_t)row * DM + 8 * lane;
    const float* pg = F.norm_post + l * DM + 8 * lane; const float* g1 = F.norm_pre + DM + 8 * lane;
    float y[4][8]; float ss = 0.f;
#pragma unroll
    for (int j = 0; j < 4; ++j) { unpack8(in.yv[j], y[j]);
#pragma unroll
        for (int e = 0; e < 8; ++e) ss += y[j][e] * y[j][e]; }
    ss = wave_sum(ss);
    const float ry = rsqrtf(ss * (1.0f / 2048.0f) + EPS);
    float s1 = 0.f;
#pragma unroll
    for (int j = 0; j < 4; ++j) { const f32x4 ga = *(const f32x4*)(pg + 512 * j), gb = *(const f32x4*)(pg + 512 * j + 4);
#pragma unroll
        for (int e = 0; e < 4; ++e) { y[j][e] = in.xv[j][0][e] + y[j][e] * ry * ga[e]; y[j][4 + e] = in.xv[j][1][e] + y[j][4 + e] * ry * gb[e]; }
        __builtin_nontemporal_store((f32x4){y[j][0], y[j][1], y[j][2], y[j][3]}, (f32x4*)(orow + 512 * j)); __builtin_nontemporal_store((f32x4){y[j][4], y[j][5], y[j][6], y[j][7]}, (f32x4*)(orow + 512 * j + 4));
#pragma unroll
        for (int e = 0; e < 8; ++e) s1 += y[j][e] * y[j][e]; }
    if (l == 0) {
        s1 = wave_sum(s1);
        const float r1 = rsqrtf(s1 * (1.0f / 2048.0f) + EPS);
        bf16_t* hrow = F.H + (size_t)row * DM + 8 * lane;
#pragma unroll
        for (int j = 0; j < 4; ++j) { const f32x4 ga = *(const f32x4*)(g1 + 512 * j), gb = *(const f32x4*)(g1 + 512 * j + 4); float o[8];
#pragma unroll
            for (int e = 0; e < 4; ++e) { o[e] = y[j][e] * r1 * ga[e]; o[4 + e] = y[j][4 + e] * r1 * gb[e]; }
            *(u32x4*)(hrow + 512 * j) = pack8(o); }
    }
}
__device__ __forceinline__ void norm_rows4(int l, int row0) { LOCAL_FRAME;
#pragma unroll 1
    for (int k = 0; k < 4; k += 2) { NormRowIn a, b; norm_row_load(a, F, l, row0 + k); norm_row_load(b, F, l, row0 + k + 1);
        norm_row_finish(a, F, l, row0 + k); norm_row_finish(b, F, l, row0 + k + 1); } }

constexpr int Q2_G = 40, Q2_AT = Q2_G + 256, Q2_SG = Q2_AT + 256, Q2_SA = Q2_SG + 64, Q2_SS = Q2_SA + 16, Q2_SP = Q2_SS + 8, Q2_PO = Q2_SP + 256;
__device__ __forceinline__ void slot2(int l, LAS unsigned char* L, LAS unsigned char* ring) {
    int t_ = threadIdx.x; asm volatile("" : "+v"(t_)); const int wave = __builtin_amdgcn_readfirstlane(t_ >> 6);
    unsigned* head = ctl_word(CW_Q + 64 * (2 * l));
    EV_T0();
#pragma unroll 1
    for (;;) {
        const int it = q_pop(head, L);
        if (it >= Q2_PO) { if (l == 0) { EV_MAX(0); EV_MIN(1); } break; }
        if (it < Q2_G) {
            unsigned char* ws = (unsigned char*)kargs()->ws;
            pg8::Gemm g{(const bf16_t*)(ws + WS_H), (const bf16_t*)(ws + WS_WTIN) + (size_t)l * DIN * DM, MT, DIN, DM};
            OneUnit S; S.u.pm = 64 + it / 20; S.u.pn = it % 20;
            pg8::EpiIn E{l};
            pg8::gemm_phase<pg8::EpiIn, OneUnit, false, true>(ring, g, S, E);
            publish(ctl_word(CW_ZS + 64 * (2 * l + it / 20)));
            if (l == 0) { EV_MAX(2); EV_MIN(3); }
        }
        else if (it < Q2_AT) { attn_unit(l, it - Q2_G, ring); if (l == 0) EV_MAX(4); }
        else if (it < Q2_SG) { const int u = it - Q2_AT; sgu_unit(l, u >> 1, u & 1, ring); if (l == 0) EV_MAX(5); }
        else if (it < Q2_SA) { const int i = it - Q2_SG; dep_wait(ctl_word(CW_ZS + 64 * (2 * l + (i >> 5))), 20u); if (l == 0) EV_MIN(6); const int k = 8 * i + wave; samp_attn(l, k >> 2, k & 3, ring + wave * 9472); __syncthreads(); if (l == 0) EV_MAX(7); }
        else if (it < Q2_SS) { const int i = it - Q2_SA; dep_wait(ctl_word(CW_ZS + 64 * (2 * l + (i >> 3))), 20u); samp_sgu(l, 8 * i + wave); }
        else if (it < Q2_SP) { const int i = it - Q2_SS; dep_wait(ctl_word(CW_ZS + 64 * (2 * l + (i >> 2))), 20u); const int k = 8 * i + wave; pool_sample(l, k & 3, k >> 2); }
        else { const int i = 8 * (it - Q2_SP) + wave; pool_prompt(l, i & 3, i >> 2, ring + wave * PL_WBYTES); }
    }
}
constexpr int Q4_G = 16, Q4_P = Q4_G + 512, Q4_S = Q4_P + 16;
__device__ __forceinline__ void slot4(int l, LAS unsigned char* L, LAS unsigned char* ring) {
    int t_ = threadIdx.x; asm volatile("" : "+v"(t_)); const int wave = __builtin_amdgcn_readfirstlane(t_ >> 6);
    unsigned* head = ctl_word(CW_Q + 64 * (2 * l + 1));
#pragma unroll 1
    for (;;) {
        const int it = q_pop(head, L);
        if (it >= Q4_S) break;
        if (it < Q4_G) {
            unsigned char* ws = (unsigned char*)kargs()->ws;
            pg8::Gemm g{(const bf16_t*)(ws + WS_MIX), (const bf16_t*)(ws + WS_WTOUT) + (size_t)l * DM * DM, MT, DM, DM};
            OneUnit S; S.u.pm = 64 + it / 8; S.u.pn = it % 8;
            pg8::EpiOut E{};
            pg8::gemm_phase<pg8::EpiOut, OneUnit, false, true>(ring, g, S, E);
            publish(ctl_word(CW_YS + 64 * (2 * l + it / 8)));
        }
        else if (it < Q4_P) norm_rows4(l, 32 * (it - Q4_G) + 4 * wave);
        else { const int i = it - Q4_P; dep_wait(ctl_word(CW_YS + 64 * (2 * l + (i >> 3))), 8u); norm_rows4(l, MP + 32 * i + 4 * wave); }
    }
}

__global__ void __launch_bounds__(NTHREADS, 2) hymba_fwd(Args a_unused) {
    extern __shared__ __attribute__((aligned(16))) unsigned char lds[];
    LAS unsigned char* L = (LAS unsigned char*)lds;
    if (threadIdx.x < 256) ((LAS unsigned*)L)[threadIdx.x] = 0u;
    __syncthreads();
    XcdBarrier bar = xcd_barrier_post((unsigned*)((unsigned char*)kargs()->ws + WS_CTL) + CW_BAR, (volatile LAS unsigned*)L + 8);
    LAS unsigned char* ring = L + RING_OFF;
    STAMP(0);
#ifndef NO_P0
    { Frame F; make_frame(F, kargs()); p0_prologue(F, ring); }
#endif
    xcd_barrier(bar);
    STAMP(1);
#pragma unroll 1
    for (int l = 0; l < 2; ++l) {
#ifndef NO_P1
        {
            KArgs ka = kargs(); unsigned char* ws = (unsigned char*)ka->ws;
            pg8::Gemm g{(const bf16_t*)(ws + WS_H), (const bf16_t*)(ws + WS_WTIN) + (size_t)l * DIN * DM, MP, DIN, DM}; pg8::StaticOrder S; S.init(MP, DIN, (int)gridDim.x, (int)blockIdx.x);
            pg8::EpiIn E{l};
            pg8::gemm_phase<pg8::EpiIn, pg8::StaticOrder, true, true>(ring, g, S, E);
        }
#endif
        xcd_barrier(bar);
        STAMP(2 + 4 * l);
#ifndef NO_P2
        slot2(l, L, ring);
#endif
        xcd_barrier(bar);
        STAMP(3 + 4 * l);
#ifndef NO_P3
        {
            KArgs ka = kargs(); unsigned char* ws = (unsigned char*)ka->ws;
            pg8::Gemm g{(const bf16_t*)(ws + WS_MIX), (const bf16_t*)(ws + WS_WTOUT) + (size_t)l * DM * DM, MP, DM, DM}; pg8::StaticOrder S; S.init(MP, DM, (int)gridDim.x, (int)blockIdx.x);
            pg8::EpiOut E{};
            pg8::gemm_phase<pg8::EpiOut, pg8::StaticOrder, true, true>(ring, g, S, E);
        }
#endif
        xcd_barrier(bar);
        STAMP(4 + 4 * l);
#ifndef NO_P4
        slot4(l, L, ring);
#endif
        if (l == 0) xcd_barrier(bar);
#if PROBE_SEL
        if (l == 1) __syncthreads();
#endif
        STAMP(5 + 4 * l);
    }
#if PROBE_SEL
    if (blockIdx.x == 0 && threadIdx.x == 0) {
#if PROBE_SEL >= 10
        unsigned ea = __hip_atomic_load(ctl_word(CW_EV + 64 * PEA), __ATOMIC_RELAXED, __HIP_MEMORY_SCOPE_AGENT), eb = __hip_atomic_load(ctl_word(CW_EV + 64 * PEB), __ATOMIC_RELAXED, __HIP_MEMORY_SCOPE_AGENT);
        if (PEA_MIN) ea = 0x40000000u - ea; if (PEB_MIN) eb = 0x40000000u - eb;
        unsigned long long da = (ea + 400) / 800, db = (eb + 400) / 800;
#else
        LAS unsigned long long* ts = (LAS unsigned long long*)(L + 256);
        unsigned long long da = (ts[PA1] - ts[PA0] + 400) / 800, db = (ts[PB1] - ts[PB0] + 400) / 800;
#endif
        if (da > 63) da = 63; if (db > 63) db = 63;
        const unsigned long long extra = (da + 64 * db) * 1600ull, t0 = __builtin_amdgcn_s_memrealtime();
        while (__builtin_amdgcn_s_memrealtime() - t0 < extra) __builtin_amdgcn_s_sleep(32);
    }
#endif
}

extern "C" void kernel_launch(void* const* d_in, const int* in_sizes, int n_in, void* d_out, int out_size, void* d_ws, size_t ws_size, hipStream_t stream) {
    static int grid = 0;
    if (grid == 0) {
        if (n_in != 16 || (size_t)out_size != O_END || ws_size < WS_END) { fprintf(stderr, "kernel_launch: unexpected shapes: n_in %d out %d ws %zu (need %zu)\n", n_in, out_size, ws_size, (size_t)WS_END); grid = -1; return; }
        int dev = 0, cus = 0, per_cu = 0;
        if (hipGetDevice(&dev) != hipSuccess || hipDeviceGetAttribute(&cus, hipDeviceAttributeMultiprocessorCount, dev) != hipSuccess) { fprintf(stderr, "kernel_launch: device query failed\n"); grid = -1; return; }
        if (hipFuncSetAttribute((const void*)hymba_fwd, hipFuncAttributeMaxDynamicSharedMemorySize, LDS_BYTES) != hipSuccess) { fprintf(stderr, "kernel_launch: hipFuncSetAttribute failed\n"); grid = -1; return; }
        if (hipOccupancyMaxActiveBlocksPerMultiprocessor(&per_cu, (const void*)hymba_fwd, NTHREADS, LDS_BYTES) != hipSuccess || per_cu < 1) { fprintf(stderr, "kernel_launch: occupancy query says %d blocks/CU\n", per_cu); (void)hipGetLastError(); grid = -1; return; }
        grid = cus;
    }
    if (grid < 0) return;
    (void)hipMemsetAsync((char*)d_ws + WS_CTL, 0, CTL_ZERO_BYTES, stream);
    Args a{};
    for (int i = 0; i < 16; ++i) a.in[i] = (const float*)d_in[i];
    a.out = (float*)d_out; a.ws = (unsigned char*)d_ws;
    void* params[] = {&a};
    hipError_t e = hipLaunchCooperativeKernel((const void*)hymba_fwd, dim3(grid), dim3(NTHREADS), params, LDS_BYTES, stream);
    if (e != hipSuccess) fprintf(stderr, "kernel_launch: cooperative launch failed: %s (grid %d)\n", hipGetErrorString(e), grid);
}
```

```cpp
#include <hip/hip_runtime.h>
#include <cstdio>
#include <cstdint>
#include <cmath>
namespace pg8 {
#define PG8_LAS __attribute__((address_space(3)))
typedef unsigned short bf16_t;
typedef short bf16x8 __attribute__((ext_vector_type(8)));
typedef float f32x4 __attribute__((ext_vector_type(4)));
typedef unsigned u32x4 __attribute__((ext_vector_type(4)));
constexpr int BM = 256, BK = 64, HALF = 128, HTB = HALF * BK * 2  , STAGE_BYTES = 8 * HTB, NXCD = 8, WGM = 8;

__host__ __device__ __forceinline__ int lds_byte(int r, int c) { const int st = (r >> 4) * 2 + (c >> 5), rr = r & 15, cc = c & 31, ob = rr * 64 + cc * 2; return st * 1024 + (ob ^ (((ob >> 9) & 1) << 5)); }
__host__ __device__ __forceinline__ void stage_rc(int b, int& R, int& C) { const int st = b / 1024, sb = b % 1024, swz = sb ^ (((sb >> 9) & 1) << 5); R = (st >> 1) * 16 + swz / 64; C = (st & 1) * 32 + (swz % 64) / 2; }
__host__ __device__ __forceinline__ int perm32(int rho) { const int n = rho >> 4, i = rho & 15; return 8 * (i >> 2) + 4 * n + (i & 3); }

struct Unit { int pm, pn; };
struct Gemm { const bf16_t* A; const bf16_t* Bt; int M, N, K; };

struct StaticOrder {
    int nM, nN, nwg, G, c;
    __host__ __device__ void init(int M, int N, int G_, int c_) { nM = M / BM; nN = N / BM; nwg = nM * nN; G = G_; c = c_; }
    __host__ __device__ bool next(int i, Unit& u) const {
        const long L = (long)i * G + c; if (L >= nwg) return false;
        int wgid = (int)L; { const int q = nwg / NXCD, r = nwg % NXCD, xcd = wgid % NXCD, off = wgid / NXCD; wgid = (xcd < r ? xcd * (q + 1) : r * (q + 1) + (xcd - r) * q) + off; }
        const int nig = WGM * nN, gid = wgid / nig, fm = gid * WGM, gsz = (nM - fm) < WGM ? (nM - fm) : WGM;
        u.pm = fm + ((wgid % nig) % gsz); u.pn = (wgid % nig) / gsz; return true;
    }
    __device__ __forceinline__ void a_ready(const Unit&) const {}
    __device__ __forceinline__ void done(const Unit&) const {}
};

constexpr int DM = 2048, MP = 16384, MS = 512, MT = MP + MS, DIN = 5120;
constexpr int ZW = 3584;
constexpr int Z_GA = 0, Z_XB = 1024, Z_GP = 1536, Z_U = 2048, Z_VS = 2560, Z_GS = 3072;
constexpr float LOG2E = 1.4426950408889634f, QSCALE = 0.125f * LOG2E, EPS = 1e-6f;

__device__ __forceinline__ unsigned cvt_pk_bf16(float lo, float hi) { unsigned r; asm("v_cvt_pk_bf16_f32 %0, %1, %2" : "=v"(r) : "v"(lo), "v"(hi)); return r; }
__device__ __forceinline__ float silu_f(float x) { return x * __builtin_amdgcn_rcpf(1.0f + __builtin_amdgcn_exp2f(-x * LOG2E)); }
__device__ __forceinline__ int vperm32(int x) { return ((x >> 2) & 1) * 16 + (x >> 3) * 4 + (x & 3); }

struct EpiPtrs { const __attribute__((address_space(1))) float* in[16]; __attribute__((address_space(1))) float* out; __attribute__((address_space(1))) unsigned char* ws; };
constexpr size_t EP_ROPE = (size_t)1 << 20, EP_QC = (size_t)192 << 20, EP_KC = (size_t)225 << 20, EP_VTP = (size_t)233 << 20, EP_Z2 = (size_t)241 << 20, EP_Y = (size_t)357 << 20;
constexpr size_t EO_KP = 34603008, EO_VP = 35127296, EO_PP = 35651584, EO_KS = 35774464, EO_VS = 44163072, EO_PS = 52551680;
struct EpiIn {
    static constexpr bool PERM = true, AFTER_DRAIN = false;
    int l;
    __device__ __forceinline__ void operator()(const f32x4 (&acc)[2][2][4][2], const Unit& u, int wr, int wc, int fr, int fq) const {
        const __attribute__((address_space(4))) EpiPtrs* kp = (const __attribute__((address_space(4))) EpiPtrs*)__builtin_amdgcn_kernarg_segment_ptr(); asm volatile("" : "+s"(kp));
        unsigned char* ws = (unsigned char*)kp->ws; float* outp = (float*)kp->out;
        bf16_t* Qc = (bf16_t*)(ws + EP_QC); bf16_t* Kc = (bf16_t*)(ws + EP_KC); bf16_t* VTP = (bf16_t*)(ws + EP_VTP); bf16_t* Z2 = (bf16_t*)(ws + EP_Z2); const float* rope = (const float*)(ws + EP_ROPE);
        float* oKp = outp + EO_KP + (size_t)l * 262144; float* oVp = outp + EO_VP + (size_t)l * 262144; float* oPp = outp + EO_PP + (size_t)l * 61440;
        float* oKs = outp + EO_KS + (size_t)l * 4194304; float* oVs = outp + EO_VS + (size_t)l * 4194304; float* oPs = outp + EO_PS + (size_t)l * 983040;
        const int pn = u.pn;
        const int row0 = u.pm * 256 + wr * 64 + fr;
        const int cw = wc * 32 + 8 * fq;
        if (pn < 5) {
#pragma unroll
            for (int ai = 0; ai < 2; ++ai)
#pragma unroll
                for (int m = 0; m < 4; ++m) {
                    const int row = row0 + ai * 128 + m * 16;
                    const bool smp = row >= MP;
                    const int tpos = smp ? 2048 + (row & 3) : (row & 2047);
                    const float* rp = rope + tpos * 64;
#pragma unroll
                    for (int bj = 0; bj < 2; ++bj) {
                        const int c = pn * 256 + bj * 128 + cw;
                        const int i0 = (c & 63) >> 1;
                        const f32x4 cs = *(const f32x4*)(rp + i0), sn = *(const f32x4*)(rp + 32 + i0);
                        const f32x4 v0 = acc[ai][bj][m][0], v1 = acc[ai][bj][m][1];
                        f32x4 o1, o2;
                        o1[0] = v0[0] * cs[0] - v0[1] * sn[0]; o2[0] = v0[1] * cs[0] + v0[0] * sn[0];
                        o1[1] = v0[2] * cs[1] - v0[3] * sn[1]; o2[1] = v0[3] * cs[1] + v0[2] * sn[1];
                        o1[2] = v1[0] * cs[2] - v1[1] * sn[2]; o2[2] = v1[1] * cs[2] + v1[0] * sn[2];
                        o1[3] = v1[2] * cs[3] - v1[3] * sn[3]; o2[3] = v1[3] * cs[3] + v1[2] * sn[3];
                        if (pn < 4) {
                            o1 = o1 * QSCALE; o2 = o2 * QSCALE;
                            u32x4 w; w.x = cvt_pk_bf16(o1[0], o2[0]); w.y = cvt_pk_bf16(o1[1], o2[1]); w.z = cvt_pk_bf16(o1[2], o2[2]); w.w = cvt_pk_bf16(o1[3], o2[3]);
                            *(u32x4*)(Qc + (size_t)row * 1024 + c) = w;
                        } else {
                            const int kvh = (c - 1024) >> 6;
                            if (!smp) {
                                const int b = row >> 11, t = row & 2047;
                                u32x4 w; w.x = cvt_pk_bf16(o1[0], o2[0]); w.y = cvt_pk_bf16(o1[1], o2[1]); w.z = cvt_pk_bf16(o1[2], o2[2]); w.w = cvt_pk_bf16(o1[3], o2[3]);
                                *(u32x4*)(Kc + ((size_t)((b * 4 + kvh) * 2048 + t)) * 64 + (c & 63)) = w;
                                if (t >= 1920) { float* o = oKp + ((size_t)((b * 128 + t - 1920) * 4 + kvh)) * 64 + i0; *(f32x4*)o = o1; *(f32x4*)(o + 32) = o2; }
                            } else {
                                const int bd = (row - MP) >> 2, tt = row & 3;
                                float* o = oKs + ((size_t)((bd * 128 + 124 + tt) * 4 + kvh)) * 64 + i0; *(f32x4*)o = o1; *(f32x4*)(o + 32) = o2;
                            }
                        }
                    }
                }
        } else if (pn == 5) {
#pragma unroll
            for (int ai = 0; ai < 2; ++ai)
#pragma unroll
                for (int m = 0; m < 4; ++m) {
                    const int row = row0 + ai * 128 + m * 16;
                    const bool smp = row >= MP;
#pragma unroll
                    for (int bj = 0; bj < 2; ++bj) {
                        const int cv = bj * 128 + cw;
                        const int kvh = cv >> 6, d0 = cv & 63;
                        const f32x4 v0 = acc[ai][bj][m][0], v1 = acc[ai][bj][m][1];
                        if (!smp) {
                            const int b = row >> 11, t = row & 2047;
                            bf16_t* vp = VTP + ((size_t)((b * 4 + kvh) * 64 + (t >> 5))) * 2048 + d0 * 32 + vperm32(t & 31);
                            const unsigned w0 = cvt_pk_bf16(v0[0], v0[1]), w1 = cvt_pk_bf16(v0[2], v0[3]), w2 = cvt_pk_bf16(v1[0], v1[1]), w3 = cvt_pk_bf16(v1[2], v1[3]);
                            vp[0] = (bf16_t)(w0 & 0xffffu); vp[32] = (bf16_t)(w0 >> 16); vp[64] = (bf16_t)(w1 & 0xffffu); vp[96] = (bf16_t)(w1 >> 16);
                            vp[128] = (bf16_t)(w2 & 0xffffu); vp[160] = (bf16_t)(w2 >> 16); vp[192] = (bf16_t)(w3 & 0xffffu); vp[224] = (bf16_t)(w3 >> 16);
                            if (t >= 1920) { float* o = oVp + ((size_t)((b * 128 + t - 1920) * 4 + kvh)) * 64 + d0; *(f32x4*)o = v0; *(f32x4*)(o + 4) = v1; }
                        } else {
                            const int bd = (row - MP) >> 2, tt = row & 3;
                            float* o = oVs + ((size_t)((bd * 128 + 124 + tt) * 4 + kvh)) * 64 + d0; *(f32x4*)o = v0; *(f32x4*)(o + 4) = v1;
                        }
                    }
                }
        } else {
            const bool gate = (pn < 10) || (pn == 12) || (pn == 13) || (pn >= 18);
            const bool isxb = (pn == 10) || (pn == 11);
#pragma unroll
            for (int ai = 0; ai < 2; ++ai)
#pragma unroll
                for (int m = 0; m < 4; ++m) {
                    const int row = row0 + ai * 128 + m * 16;
                    const bool smp = row >= MP;
#pragma unroll
                    for (int bj = 0; bj < 2; ++bj) {
                        const int c = pn * 256 + bj * 128 + cw;
                        f32x4 v0 = acc[ai][bj][m][0], v1 = acc[ai][bj][m][1];
                        if (isxb) {
                            const int cx = c - 2560;
                            if (!smp) { const int t = row & 2047; if (t >= 2033) { const int b = row >> 11; float* o = oPp + ((size_t)(b * 15 + t - 2033)) * 512 + cx; *(f32x4*)o = v0; *(f32x4*)(o + 4) = v1; } }
                            else { const int bd = (row - MP) >> 2, tt = row & 3; float* o = oPs + ((size_t)(bd * 15 + 11 + tt)) * 512 + cx; *(f32x4*)o = v0; *(f32x4*)(o + 4) = v1; }
                        }
                        if (gate) {
#pragma unroll
                            for (int j = 0; j < 4; ++j) { v0[j] = silu_f(v0[j]); v1[j] = silu_f(v1[j]); }
                        }
                        u32x4 w; w.x = cvt_pk_bf16(v0[0], v0[1]); w.y = cvt_pk_bf16(v0[2], v0[3]); w.z = cvt_pk_bf16(v1[0], v1[1]); w.w = cvt_pk_bf16(v1[2], v1[3]);
                        *(u32x4*)(Z2 + (size_t)row * ZW + (c - 1536)) = w;
                    }
                }
        }
    }
};

struct EpiOut {
    static constexpr bool PERM = true, AFTER_DRAIN = false;
    __device__ __forceinline__ void operator()(const f32x4 (&acc)[2][2][4][2], const Unit& u, int wr, int wc, int fr, int fq) const {
        const __attribute__((address_space(4))) EpiPtrs* kp = (const __attribute__((address_space(4))) EpiPtrs*)__builtin_amdgcn_kernarg_segment_ptr(); asm volatile("" : "+s"(kp));
        bf16_t* C = (bf16_t*)((unsigned char*)kp->ws + EP_Y);
        const int row0 = u.pm * BM + wr * 64 + fr, col0 = u.pn * BM + wc * 32 + 8 * fq;
#pragma unroll
        for (int ai = 0; ai < 2; ++ai)
#pragma unroll
            for (int m = 0; m < 4; ++m) { bf16_t* rowp = C + (size_t)(row0 + ai * HALF + m * 16) * DM + col0;
#pragma unroll
                for (int bj = 0; bj < 2; ++bj) { const f32x4 v0 = acc[ai][bj][m][0], v1 = acc[ai][bj][m][1];
                    u32x4 w; w.x = cvt_pk_bf16(v0[0], v0[1]); w.y = cvt_pk_bf16(v0[2], v0[3]); w.z = cvt_pk_bf16(v1[0], v1[1]); w.w = cvt_pk_bf16(v1[2], v1[3]);
                    *(u32x4*)(rowp + bj * HALF) = w; } }
    }
};
template <class Epi, class Sched, bool ALIGN_EPI = false, bool SP2 = false>
__device__ __forceinline__ void gemm_phase(PG8_LAS unsigned char* lds, const Gemm g, const Sched& S, const Epi& E) {
    int tid_ = threadIdx.x; asm volatile("" : "+v"(tid_));
    const int tid = tid_, wid = __builtin_amdgcn_readfirstlane(tid >> 6), lane = tid & 63, wr = wid >> 2, wc = wid & 3, fr = lane & 15, fq = lane >> 4;
    const int K = g.K, nt = K / BK;
    unsigned voffA[2], voffB[2];
#pragma unroll
    for (int i = 0; i < 2; ++i) { int R, C; stage_rc(tid * 16 + i * 8192, R, C); const int Rb = Epi::PERM ? ((R & ~31) + perm32(R & 31)) : R;
        voffA[i] = (unsigned)(R * K + C) * 2u; voffB[i] = (unsigned)(Rb * K + C) * 2u; }
    const size_t kstep = (size_t)(BK * 2);
    const size_t hstep = (size_t)HALF * K * 2;
    const size_t tstep = 2 * hstep;
    const unsigned ldsw = (unsigned)wid * 1024u;
    const int aoff = lds_byte(wr * 64 + fr, fq * 8), boff = lds_byte(wc * 32 + fr, fq * 8);
#define PG8_SA(b, h) (((b) * 2 + (h)) * HTB)
#define PG8_SB(b, h) ((4 + (b) * 2 + (h)) * HTB)
#define PG8_STAGE(bufoff, gbase, voff) do { _Pragma("unroll") for (int _i = 0; _i < 2; ++_i) \
        __builtin_amdgcn_global_load_lds((const unsigned*)((const char*)(gbase) + (voff)[_i]), (PG8_LAS unsigned*)(lds + (bufoff) + ldsw + _i * 8192), 16, 0, 0); } while (0)
#define PG8_LDA(dst, b, h) do { _Pragma("unroll") for (int m = 0; m < 4; ++m) _Pragma("unroll") for (int k = 0; k < 2; ++k) dst[m][k] = *(const PG8_LAS bf16x8*)(lds + PG8_SA(b, h) + aoff + m * 2048 + k * 1024); } while (0)
#define PG8_LDB(dst, b, h) do { _Pragma("unroll") for (int n = 0; n < 2; ++n) _Pragma("unroll") for (int k = 0; k < 2; ++k) dst[n][k] = *(const PG8_LAS bf16x8*)(lds + PG8_SB(b, h) + boff + n * 2048 + k * 1024); } while (0)
#define PG8_MMA(ai, bj, At, Bt) do { __builtin_amdgcn_s_setprio(1); _Pragma("unroll") for (int m = 0; m < 4; ++m) _Pragma("unroll") for (int n = 0; n < 2; ++n) _Pragma("unroll") for (int k = 0; k < 2; ++k) \
        acc[ai][bj][m][n] = __builtin_amdgcn_mfma_f32_16x16x32_bf16(Bt[n][k], At[m][k], acc[ai][bj][m][n], 0, 0, 0); __builtin_amdgcn_s_setprio(0); } while (0)
#define PG8_WAIT_V(n) asm volatile("s_waitcnt vmcnt(" #n ")" ::: "memory")
#define PG8_WAIT_L(n) asm volatile("s_waitcnt lgkmcnt(" #n ")" ::: "memory")
#define PG8_BAR __builtin_amdgcn_s_barrier()
#define PG8_SCHED __builtin_amdgcn_sched_barrier(0)
    Unit cur, nxt; int ui = 0;
    if (!S.next(0, cur)) return;
    f32x4 acc[2][2][4][2];
#pragma unroll
    for (int a = 0; a < 2; ++a)
#pragma unroll
        for (int b = 0; b < 2; ++b)
#pragma unroll
            for (int m = 0; m < 4; ++m)
#pragma unroll
                for (int n = 0; n < 2; ++n) acc[a][b][m][n] = (f32x4){0.f, 0.f, 0.f, 0.f};
    bf16x8 At[4][2], B0[2][2], B1[2][2];
    const char* cA = (const char*)g.A + (size_t)cur.pm * tstep; const char* cB = (const char*)g.Bt + (size_t)cur.pn * tstep;
    S.a_ready(cur);
    if constexpr (SP2) {
        PG8_STAGE(PG8_SB(0, 0), cB, voffB); PG8_STAGE(PG8_SB(0, 1), cB + hstep, voffB); PG8_STAGE(PG8_SA(0, 0), cA, voffA); PG8_STAGE(PG8_SA(0, 1), cA + hstep, voffA);
        if (wr == 1) PG8_BAR;
        PG8_WAIT_V(2); PG8_BAR;
        PG8_STAGE(PG8_SB(1, 0), cB + kstep, voffB); PG8_STAGE(PG8_SA(1, 0), cA + kstep, voffA); PG8_STAGE(PG8_SB(1, 1), cB + hstep + kstep, voffB);
        PG8_WAIT_V(6); PG8_BAR;
    } else {
        PG8_STAGE(PG8_SB(0, 0), cB, voffB); PG8_STAGE(PG8_SA(0, 0), cA, voffA); PG8_STAGE(PG8_SB(0, 1), cB + hstep, voffB); PG8_STAGE(PG8_SA(0, 1), cA + hstep, voffA);
        if (wr == 1) PG8_BAR;
        PG8_WAIT_V(4); PG8_BAR;
        PG8_STAGE(PG8_SB(1, 0), cB + kstep, voffB); PG8_STAGE(PG8_SA(1, 0), cA + kstep, voffA); PG8_STAGE(PG8_SB(1, 1), cB + hstep + kstep, voffB);
        PG8_WAIT_V(6); PG8_BAR;
    }
    for (;;) {
        const bool has_next = S.next(ui + 1, nxt);
        const char* nA = has_next ? (const char*)g.A + (size_t)nxt.pm * tstep : cA; const char* nB = has_next ? (const char*)g.Bt + (size_t)nxt.pn * tstep : cB;
        for (int t = 0; t < nt; t += 2) {
            const bool last = (t == nt - 2);
            const char* a1 = cA + (size_t)(t + 1) * kstep;
            const char* a2 = last ? nA : cA + (size_t)(t + 2) * kstep; const char* b2 = last ? nB : cB + (size_t)(t + 2) * kstep;
            const char* a3 = a2 + kstep; const char* b3 = b2 + kstep;
            if (last && has_next) S.a_ready(nxt);
            if constexpr (SP2) {
            PG8_LDB(B0, 0, 0); PG8_LDB(B1, 0, 1); PG8_SCHED; PG8_LDA(At, 0, 0); PG8_STAGE(PG8_SA(1, 1), a1 + hstep, voffA);
            PG8_WAIT_V(8); PG8_WAIT_L(0); PG8_BAR; PG8_MMA(0, 0, At, B0); PG8_MMA(0, 1, At, B1); PG8_BAR; PG8_SCHED;
            PG8_LDA(At, 0, 1); PG8_STAGE(PG8_SB(0, 0), b2, voffB); PG8_STAGE(PG8_SB(0, 1), b2 + hstep, voffB); PG8_STAGE(PG8_SA(0, 0), a2, voffA);
            PG8_WAIT_V(8); PG8_WAIT_L(0); PG8_BAR; PG8_MMA(1, 0, At, B0); PG8_MMA(1, 1, At, B1); PG8_BAR; PG8_SCHED;
            PG8_LDB(B0, 1, 0); PG8_LDB(B1, 1, 1); PG8_SCHED; PG8_LDA(At, 1, 0); PG8_STAGE(PG8_SA(0, 1), a2 + hstep, voffA);
            PG8_WAIT_V(8); PG8_WAIT_L(0); PG8_BAR; PG8_MMA(0, 0, At, B0); PG8_MMA(0, 1, At, B1); PG8_BAR; PG8_SCHED;
            PG8_LDA(At, 1, 1); PG8_STAGE(PG8_SB(1, 0), b3, voffB); PG8_STAGE(PG8_SB(1, 1), b3 + hstep, voffB); PG8_STAGE(PG8_SA(1, 0), a3, voffA);
            PG8_WAIT_V(8); PG8_WAIT_L(0); PG8_BAR; PG8_MMA(1, 0, At, B0); PG8_MMA(1, 1, At, B1); PG8_BAR; PG8_SCHED;
            } else {
            PG8_LDB(B0, 0, 0); PG8_SCHED; PG8_LDA(At, 0, 0); PG8_STAGE(PG8_SA(1, 1), a1 + hstep, voffA);
            PG8_WAIT_L(8); PG8_BAR; PG8_WAIT_L(0); PG8_MMA(0, 0, At, B0); PG8_BAR; PG8_SCHED;
            PG8_LDB(B1, 0, 1); PG8_STAGE(PG8_SB(0, 0), b2, voffB);
            PG8_BAR; PG8_WAIT_L(0); PG8_MMA(0, 1, At, B1); PG8_BAR;
            PG8_LDA(At, 0, 1); PG8_STAGE(PG8_SA(0, 0), a2, voffA);
            PG8_BAR; PG8_WAIT_L(0); PG8_MMA(1, 0, At, B0); PG8_BAR; PG8_SCHED;
            PG8_STAGE(PG8_SB(0, 1), b2 + hstep, voffB);
            PG8_WAIT_V(6); PG8_BAR; PG8_MMA(1, 1, At, B1); PG8_BAR;
            PG8_LDB(B0, 1, 0); PG8_SCHED; PG8_LDA(At, 1, 0); PG8_STAGE(PG8_SA(0, 1), a2 + hstep, voffA);
            PG8_WAIT_L(8); PG8_BAR; PG8_WAIT_L(0); PG8_MMA(0, 0, At, B0); PG8_BAR; PG8_SCHED;
            PG8_LDB(B1, 1, 1); PG8_STAGE(PG8_SB(1, 0), b3, voffB);
            PG8_BAR; PG8_WAIT_L(0); PG8_MMA(0, 1, At, B1); PG8_BAR;
            PG8_LDA(At, 1, 1); PG8_STAGE(PG8_SA(1, 0), a3, voffA);
            PG8_BAR; PG8_WAIT_L(0); PG8_MMA(1, 0, At, B0); PG8_BAR; PG8_SCHED;
            PG8_STAGE(PG8_SB(1, 1), b3 + hstep, voffB);
            PG8_WAIT_V(6); PG8_BAR; PG8_MMA(1, 1, At, B1); PG8_BAR;
            }
        }
        if constexpr (ALIGN_EPI) { if (wr == 0) PG8_BAR; }
        if constexpr (!Epi::AFTER_DRAIN) { E(acc, cur, wr, wc, fr, fq); S.done(cur); }
        if (!has_next) break;
#pragma unroll
        for (int a = 0; a < 2; ++a)
#pragma unroll
            for (int b = 0; b < 2; ++b)
#pragma unroll
                for (int m = 0; m < 4; ++m)
#pragma unroll
                    for (int n = 0; n < 2; ++n) acc[a][b][m][n] = (f32x4){0.f, 0.f, 0.f, 0.f};
        cur = nxt; cA = nA; cB = nB; ++ui;
        if constexpr (ALIGN_EPI) { if (wr == 1) PG8_BAR; }
    }
    PG8_WAIT_V(0);
    if constexpr (!ALIGN_EPI) { if (wr == 0) PG8_BAR; }
    PG8_BAR;
    if constexpr (Epi::AFTER_DRAIN) { E.fused(acc, cur, wr, wc, fr, fq, lds, wid, lane); S.done(cur); }
#undef PG8_SA
#undef PG8_SB
#undef PG8_STAGE
#undef PG8_LDA
#undef PG8_LDB
#undef PG8_MMA
#undef PG8_WAIT_V
#undef PG8_WAIT_L
#undef PG8_BAR
#undef PG8_SCHED
}
}
#define GAS __attribute__((address_space(1)))
#define LAS __attribute__((address_space(3)))
typedef GAS unsigned gu32;
typedef GAS unsigned long long gu64;
#define RLX_AGENT __ATOMIC_RELAXED, __HIP_MEMORY_SCOPE_AGENT
#define VM_WAIT() asm volatile("s_waitcnt vmcnt(0)" ::: "memory")
__device__ __forceinline__ unsigned long long rt() { return __builtin_amdgcn_s_memrealtime(); }
__device__ __forceinline__ unsigned f2bf(float f) { unsigned u = __builtin_bit_cast(unsigned, f); return (u + 0x7fffu + ((u >> 16) & 1u)) >> 16; }
__device__ __forceinline__ unsigned pk2(float lo, float hi) { return f2bf(lo) | (f2bf(hi) << 16); }

#define XB_TMO      128
#define XB_XCNT(j)  (256  + 64 * (j))
#define XB_XSUB(j)  (1280 + 64 * (j))
#define XB_XGEN(j)  (2304 + 64 * (j))
#define XB_TOP      3328
#define XB_TOPGEN   3392
#define XCD_BAR_WORDS 3456
#define XB_SPIN_CAP (1u << 18)

__device__ __forceinline__ unsigned xb_ld(unsigned* p)              { return __hip_atomic_load(p, __ATOMIC_RELAXED, __HIP_MEMORY_SCOPE_AGENT); }
__device__ __forceinline__ unsigned xb_add(unsigned* p, unsigned v) { return __hip_atomic_fetch_add(p, v, __ATOMIC_RELAXED, __HIP_MEMORY_SCOPE_AGENT); }
__device__ __forceinline__ unsigned xb_xcc_id() { return (unsigned)__builtin_amdgcn_s_getreg((3 << 11) | 20) & 0xFu; }
#define XB_SPIN(cond, bar) do { unsigned _sp = 0; while (cond) { __builtin_amdgcn_s_sleep(1); \
    if ((++_sp & 255u) == 0u) { if (xb_ld(&(bar)[XB_TMO])) break; if (_sp > XB_SPIN_CAP) { atomicAdd(&(bar)[XB_TMO], 1u); break; } } } } while (0)

struct XcdBarrier {
    unsigned* bar; unsigned x;
    volatile LAS unsigned* st;
};

__device__ __forceinline__ XcdBarrier xcd_barrier_post(unsigned* bar, volatile LAS unsigned* st) {
    XcdBarrier b; b.bar = bar; b.x = xb_xcc_id(); b.st = st;
    if (threadIdx.x == 0) (void)xb_add(&bar[XB_XCNT(b.x)], 1u);
    return b;
}
__device__ __forceinline__ void xcd_barrier_complete(unsigned* bar, unsigned x, unsigned& nloc, unsigned& nx) {
    const unsigned G = gridDim.x * gridDim.y * gridDim.z;
    unsigned sum, cnt, mine, sp = 0u;
    for (;;) {
        sum = 0u; cnt = 0u; mine = 0u;
#pragma unroll
        for (unsigned j = 0; j < 16; ++j) { const unsigned c = xb_ld(&bar[XB_XCNT(j)]); sum += c; cnt += (c > 0u) ? 1u : 0u; mine = (j == x) ? c : mine; }
        if (sum == G) break;
        __builtin_amdgcn_s_sleep(1);
        if ((++sp & 255u) == 0u) { if (xb_ld(&bar[XB_TMO])) break; if (sp > XB_SPIN_CAP) { atomicAdd(&bar[XB_TMO], 1u); break; } }
    }
    nloc = mine > 0u ? mine : 1u; nx = cnt > 0u ? cnt : 1u;
}

__device__ __forceinline__ void xcd_barrier(const XcdBarrier& b) {
    asm volatile("s_waitcnt vmcnt(0)" ::: "memory");
    __syncthreads();
    if (threadIdx.x == 0) {
        unsigned* bar = b.bar;
        __builtin_amdgcn_s_waitcnt(0);
        unsigned nloc = b.st[0], nx = b.st[1];
        if (nloc == 0u) { xcd_barrier_complete(bar, b.x, nloc, nx); b.st[0] = nloc; b.st[1] = nx; }
        const unsigned old = xb_add(&bar[XB_XSUB(b.x)], 1u);
        const unsigned gen = old / nloc;
        if (old + 1u == (gen + 1u) * nloc) {
            __builtin_amdgcn_fence(__ATOMIC_RELEASE, "agent");
            asm volatile("s_waitcnt vmcnt(0)" ::: "memory");
            const unsigned og = xb_add(&bar[XB_TOP], 1u);
            const unsigned tg = og / nx;
            if (og + 1u == (tg + 1u) * nx) xb_add(&bar[XB_TOPGEN], 1u);
            else XB_SPIN(xb_ld(&bar[XB_TOPGEN]) == tg, bar);
            __builtin_amdgcn_fence(__ATOMIC_ACQUIRE, "agent");
            xb_add(&bar[XB_XGEN(b.x)], 1u);
            asm volatile("s_waitcnt vmcnt(0)" ::: "memory");
        } else {
            XB_SPIN(xb_ld(&bar[XB_XGEN(b.x)]) == gen, bar);
            __builtin_amdgcn_fence(__ATOMIC_ACQUIRE, "agent");
            asm volatile("s_waitcnt vmcnt(0)" ::: "memory");
        }
    }
    __syncthreads();
}

using pg8::bf16_t; using pg8::bf16x8; using pg8::f32x4; using pg8::u32x4;
using pg8::DM; using pg8::MP; using pg8::MS; using pg8::MT; using pg8::DIN; using pg8::ZW;
using pg8::Z_GA; using pg8::Z_XB; using pg8::Z_GP; using pg8::Z_U; using pg8::Z_VS; using pg8::Z_GS; using pg8::LOG2E; using pg8::EPS;
typedef float f32x16 __attribute__((ext_vector_type(16)));
typedef unsigned u32x2 __attribute__((ext_vector_type(2)));
typedef short v4i16_t __attribute__((ext_vector_type(4)));

constexpr int NWAVES = 8, NTHREADS = 512;
constexpr int LDS_BYTES = 147456;
constexpr int RING_OFF = 1024;

constexpr size_t O_YP = 0, O_YS = 33554432, O_KP = 34603008, O_VP = 35127296, O_PP = 35651584, O_KS = 35774464, O_VS = 44163072, O_PS = 52551680, O_CV = 54517760, O_END = 55042048;
constexpr size_t LS_KP = 262144, LS_PP = 61440, LS_KS = 4194304, LS_PS = 983040, LS_CV = 262144;
constexpr size_t MiB = 1u << 20;
constexpr size_t WS_CTL = 0, CTL_ZERO_BYTES = 65536;
constexpr size_t WS_ROPE = 1 * MiB, WS_SGUW = 2 * MiB, WS_RSW = 2 * MiB + 256 * 1024, WS_PWT = 2 * MiB + 512 * 1024;
constexpr size_t WS_WTIN = 4 * MiB, WS_WTOUT = 44 * MiB, WS_H = 60 * MiB, WS_MIX = 126 * MiB, WS_QC = 192 * MiB, WS_KC = 225 * MiB, WS_VTP = 233 * MiB, WS_Z2 = 241 * MiB, WS_Y = 357 * MiB, WS_END = 489 * MiB;
constexpr int CW_BAR = 1024;

__constant__ double ROPE_INV[32] = {1.0, 0.7498942093324559, 0.5623413251903491, 0.4216965034285822, 0.31622776601683794, 0.23713737056616552, 0.1778279410038923, 0.1333521432163324, 0.1, 0.07498942093324558, 0.05623413251903491, 0.042169650342858224, 0.03162277660168379, 0.023713737056616554, 0.01778279410038923, 0.01333521432163324, 0.01, 0.007498942093324558, 0.005623413251903491, 0.004216965034285823, 0.0031622776601683794, 0.0023713737056616554, 0.0017782794100389228, 0.001333521432163324, 0.001, 0.0007498942093324559, 0.0005623413251903491, 0.00042169650342858224, 0.00031622776601683794, 0.00023713737056616554, 0.00017782794100389227, 0.0001333521432163324};

struct Args { const float* in[16]; float* out; unsigned char* ws; };

struct Frame {
    int tid, lane, wave, bid, G;
    const float *xp, *xs, *cache_k, *cache_v, *state_pool, *w_in, *w_out, *norm_pre, *norm_post, *sinks, *pool_w, *pool_scale, *ln_g, *ln_b, *sgu_w, *sgu_b;
    float* out;
    float* rope; float* RSW; bf16_t *SGUW, *PWT, *WTIN, *WTOUT, *H, *MIX, *Qc, *Kc, *VTP, *Z2, *Yb;
};

__device__ __forceinline__ float wave_sum(float v) {
#pragma unroll
    for (int o = 1; o < 64; o <<= 1) v += __shfl_xor(v, o);
    return v;
}
__device__ __forceinline__ float wave_max(float v) {
#pragma unroll
    for (int o = 1; o < 64; o <<= 1) v = fmaxf(v, __shfl_xor(v, o));
    return v;
}
__device__ __forceinline__ float bflo(unsigned w) { return __uint_as_float(w << 16); }
__device__ __forceinline__ float bfhi(unsigned w) { return __uint_as_float(w & 0xffff0000u); }
__device__ __forceinline__ void unpack8(const u32x4 w, float (&f)[8]) { f[0] = bflo(w.x); f[1] = bfhi(w.x); f[2] = bflo(w.y); f[3] = bfhi(w.y); f[4] = bflo(w.z); f[5] = bfhi(w.z); f[6] = bflo(w.w); f[7] = bfhi(w.w); }
__device__ __forceinline__ void unpack4(const u32x2 w, float (&f)[4]) { f[0] = bflo(w.x); f[1] = bfhi(w.x); f[2] = bflo(w.y); f[3] = bfhi(w.y); }
__device__ __forceinline__ u32x4 pack8(const float (&f)[8]) { u32x4 w; w.x = pg8::cvt_pk_bf16(f[0], f[1]); w.y = pg8::cvt_pk_bf16(f[2], f[3]); w.z = pg8::cvt_pk_bf16(f[4], f[5]); w.w = pg8::cvt_pk_bf16(f[6], f[7]); return w; }
__device__ __forceinline__ int crow(int r, int hi) { return (r & 3) + 8 * (r >> 2) + 4 * hi; }
#define LDS_WAIT() asm volatile("s_waitcnt lgkmcnt(0)" ::: "memory")


struct ArgsG { const __attribute__((address_space(1))) float* in[16]; __attribute__((address_space(1))) float* out; __attribute__((address_space(1))) unsigned char* ws; };
typedef const __attribute__((address_space(4))) ArgsG* KArgs;
__device__ __forceinline__ KArgs kargs() { KArgs p = (KArgs)__builtin_amdgcn_kernarg_segment_ptr(); asm volatile("" : "+s"(p)); return p; }
__device__ __forceinline__ void make_frame(Frame& F, KArgs a) {
    { int t_ = threadIdx.x; asm volatile("" : "+v"(t_)); F.tid = t_; } F.lane = F.tid & 63; F.wave = __builtin_amdgcn_readfirstlane(F.tid >> 6); F.bid = blockIdx.x; F.G = gridDim.x;
    F.xp = (const float*)a->in[0]; F.xs = (const float*)a->in[1]; F.cache_k = (const float*)a->in[2]; F.cache_v = (const float*)a->in[3]; F.state_pool = (const float*)a->in[4]; F.w_in = (const float*)a->in[5]; F.w_out = (const float*)a->in[6]; F.norm_pre = (const float*)a->in[7]; F.norm_post = (const float*)a->in[8];
    F.sinks = (const float*)a->in[9]; F.pool_w = (const float*)a->in[10]; F.pool_scale = (const float*)a->in[11]; F.ln_g = (const float*)a->in[12]; F.ln_b = (const float*)a->in[13]; F.sgu_w = (const float*)a->in[14]; F.sgu_b = (const float*)a->in[15];
    F.out = (float*)a->out;
    unsigned char* ws = (unsigned char*)a->ws;
    F.rope = (float*)(ws + WS_ROPE); F.RSW = (float*)(ws + WS_RSW); F.SGUW = (bf16_t*)(ws + WS_SGUW); F.PWT = (bf16_t*)(ws + WS_PWT); F.WTIN = (bf16_t*)(ws + WS_WTIN); F.WTOUT = (bf16_t*)(ws + WS_WTOUT);
    F.H = (bf16_t*)(ws + WS_H); F.MIX = (bf16_t*)(ws + WS_MIX); F.Qc = (bf16_t*)(ws + WS_QC); F.Kc = (bf16_t*)(ws + WS_KC); F.VTP = (bf16_t*)(ws + WS_VTP); F.Z2 = (bf16_t*)(ws + WS_Z2); F.Yb = (bf16_t*)(ws + WS_Y);
}

#define LOCAL_FRAME Frame F; make_frame(F, kargs())

constexpr int CW_Q = 8192;
constexpr int CW_ZS = 8192 + 64 * 8;
constexpr int CW_YS = 8192 + 64 * 16;
constexpr int CW_EV = 8192 + 64 * 32;
__device__ __forceinline__ unsigned* ctl_word(int idx) { return (unsigned*)((unsigned char*)kargs()->ws + WS_CTL) + idx; }
__device__ __forceinline__ int q_pop(unsigned* head, LAS unsigned char* L) {
    volatile LAS int* slot = (volatile LAS int*)(L + 64);
    __syncthreads();
    if (threadIdx.x == 0) *slot = (int)__hip_atomic_fetch_add(head, 1u, __ATOMIC_RELAXED, __HIP_MEMORY_SCOPE_AGENT);
    __syncthreads();
    return __builtin_amdgcn_readfirstlane(*slot);
}
__device__ __forceinline__ void publish(unsigned* ctr) {
    asm volatile("s_waitcnt vmcnt(0)" ::: "memory");
    __syncthreads();
    if (threadIdx.x == 0) { __builtin_amdgcn_fence(__ATOMIC_RELEASE, "agent"); asm volatile("s_waitcnt vmcnt(0)" ::: "memory");
        __hip_atomic_fetch_add(ctr, 1u, __ATOMIC_RELAXED, __HIP_MEMORY_SCOPE_AGENT); }
}
__device__ __forceinline__ void dep_wait(unsigned* ctr, unsigned need) {
    if (threadIdx.x == 0) {
        unsigned sp = 0;
        while (__hip_atomic_load(ctr, __ATOMIC_RELAXED, __HIP_MEMORY_SCOPE_AGENT) < need) { __builtin_amdgcn_s_sleep(16); if (++sp > (1u << 21)) break; }
        __builtin_amdgcn_fence(__ATOMIC_ACQUIRE, "agent"); asm volatile("s_waitcnt vmcnt(0)" ::: "memory");
    }
    __syncthreads();
}

#if PROBE_SEL >= 10
#define EV_T0() const unsigned long long ev_t0 = __builtin_amdgcn_s_memrealtime()
#define EV_MAX(k) do { if (threadIdx.x == 0) __hip_atomic_fetch_max(ctl_word(CW_EV + 64 * (k)), (unsigned)(__builtin_amdgcn_s_memrealtime() - ev_t0), __ATOMIC_RELAXED, __HIP_MEMORY_SCOPE_AGENT); } while (0)
#define EV_MIN(k) do { if (threadIdx.x == 0) __hip_atomic_fetch_max(ctl_word(CW_EV + 64 * (k)), 0x40000000u - (unsigned)(__builtin_amdgcn_s_memrealtime() - ev_t0), __ATOMIC_RELAXED, __HIP_MEMORY_SCOPE_AGENT); } while (0)
#else
#define EV_T0() do {} while (0)
#define EV_MAX(k) do {} while (0)
#define EV_MIN(k) do {} while (0)
#endif
struct OneUnit {
    pg8::Unit u;
    __device__ __forceinline__ bool next(int i, pg8::Unit& o) const { if (i) return false; o = u; return true; }
    __device__ __forceinline__ void a_ready(const pg8::Unit&) const {}
    __device__ __forceinline__ void done(const pg8::Unit&) const {}
};

#ifndef PROBE_SEL
#define PROBE_SEL 0
#endif
#if PROBE_SEL
#define STAMP(k) do { if (blockIdx.x == 0 && threadIdx.x == 0) ((LAS unsigned long long*)(L + 256))[k] = __builtin_amdgcn_s_memrealtime(); } while (0)
#define STAMP2(k) do { if (blockIdx.x == 0) { __syncthreads(); if (threadIdx.x == 0) ((LAS unsigned long long*)((LAS unsigned char*)ring - RING_OFF + 256))[k] = __builtin_amdgcn_s_memrealtime(); } } while (0)
#else
#define STAMP(k) do {} while (0)
#define STAMP2(k) do {} while (0)
#endif
#if PROBE_SEL == 1
#define PA0 0
#define PA1 1
#define PB0 1
#define PB1 2
#elif PROBE_SEL == 2
#define PA0 2
#define PA1 3
#define PB0 3
#define PB1 4
#elif PROBE_SEL == 3
#define PA0 4
#define PA1 5
#define PB0 8
#define PB1 9
#elif PROBE_SEL == 4
#define PA0 2
#define PA1 10
#define PB0 10
#define PB1 11
#elif PROBE_SEL == 5
#define PA0 11
#define PA1 12
#define PB0 12
#define PB1 13
#elif PROBE_SEL == 7
#define PA0 1
#define PA1 2
#define PB0 0
#define PB1 1
#elif PROBE_SEL == 8
#define PA0 3
#define PA1 4
#define PB0 2
#define PB1 3
#elif PROBE_SEL == 9
#define PA0 6
#define PA1 7
#define PB0 4
#define PB1 5
#elif PROBE_SEL == 6
#define PA0 5
#define PA1 6
#define PB0 7
#define PB1 8
#elif PROBE_SEL == 10
#define PEA 0
#define PEA_MIN 0
#define PEB 1
#define PEB_MIN 1
#elif PROBE_SEL == 11
#define PEA 2
#define PEA_MIN 0
#define PEB 3
#define PEB_MIN 1
#elif PROBE_SEL == 12
#define PEA 4
#define PEA_MIN 0
#define PEB 5
#define PEB_MIN 0
#elif PROBE_SEL == 14
#define PEA 8
#define PEA_MIN 0
#define PEB 9
#define PEB_MIN 0
#elif PROBE_SEL == 13
#define PEA 6
#define PEA_MIN 1
#define PEB 7
#define PEB_MIN 0
#endif

__device__ __forceinline__ void p0_transpose_blk(const float* W, int K, int N, bf16_t* WT, bool permqk, LAS unsigned char* T, int item, int tid) {
    const int nblk = N >> 8, kb = item / nblk, nb = item - kb * nblk, k0 = kb * 128, n0 = nb * 256;
    const int n4 = tid & 63, kr = tid >> 6;
    f32x4 v[16];
#pragma unroll
    for (int i = 0; i < 16; ++i) v[i] = __builtin_nontemporal_load((const f32x4*)(W + (size_t)(k0 + 16 * kr + i) * N + n0 + 4 * n4));
#pragma unroll
    for (int e = 0; e < 4; ++e) {
        u32x4 lo, hi;
        lo.x = pg8::cvt_pk_bf16(v[0][e], v[1][e]); lo.y = pg8::cvt_pk_bf16(v[2][e], v[3][e]); lo.z = pg8::cvt_pk_bf16(v[4][e], v[5][e]); lo.w = pg8::cvt_pk_bf16(v[6][e], v[7][e]);
        hi.x = pg8::cvt_pk_bf16(v[8][e], v[9][e]); hi.y = pg8::cvt_pk_bf16(v[10][e], v[11][e]); hi.z = pg8::cvt_pk_bf16(v[12][e], v[13][e]); hi.w = pg8::cvt_pk_bf16(v[14][e], v[15][e]);
        LAS unsigned char* p = T + (64 * e + n4) * 272 + 32 * kr;
        *(LAS u32x4*)p = lo; *(LAS u32x4*)(p + 16) = hi;
    }
    LDS_WAIT();
    __syncthreads();
    {
        const int rho = tid >> 1, half = tid & 1, n = n0 + 4 * (rho & 63) + (rho >> 6);
        int nrow = n;
        if (permqk && n < 1280) { const int p = n & 63; nrow = (n & ~63) + 2 * (p & 31) + (p >> 5); }
        const LAS unsigned char* src = T + rho * 272 + 128 * half;
        bf16_t* dst = WT + (size_t)nrow * K + k0 + 64 * half;
        u32x4 o[8];
#pragma unroll
        for (int c = 0; c < 8; ++c) o[c] = *(const LAS u32x4*)(src + 16 * c);
#pragma unroll
        for (int c = 0; c < 8; ++c) *(u32x4*)(dst + 8 * c) = o[c];
    }
    LDS_WAIT();
    __syncthreads();
}
__device__ __forceinline__ void prenorm_finish(const f32x4 (&v)[8], const float* g, bf16_t* hrow, int lane) {
    float ss = 0.f;
#pragma unroll
    for (int j = 0; j < 8; ++j) ss += (v[j][0] * v[j][0] + v[j][1] * v[j][1]) + (v[j][2] * v[j][2] + v[j][3] * v[j][3]);
    ss = wave_sum(ss);
    const float r = rsqrtf(ss * (1.0f / 2048.0f) + EPS);
#pragma unroll
    for (int j = 0; j < 8; ++j) { const f32x4 gg = *(const f32x4*)(g + 4 * lane + 256 * j); const f32x4 o = v[j] * r * gg;
        u32x2 w; w.x = pg8::cvt_pk_bf16(o[0], o[1]); w.y = pg8::cvt_pk_bf16(o[2], o[3]); *(u32x2*)(hrow + 4 * lane + 256 * j) = w; }
}
constexpr int TR_IN = 16 * 20, TR_OUT = 16 * 8, TR_ITEMS = TR_IN + TR_OUT;
__device__ __forceinline__ void transpose_item(const Frame& F, int l, int r, LAS unsigned char* ring) {
    if (r < TR_IN) p0_transpose_blk(F.w_in + (size_t)l * DM * DIN, DM, DIN, F.WTIN + (size_t)l * DIN * DM, true, ring, r, F.tid);
    else p0_transpose_blk(F.w_out + (size_t)l * DM * DM, DM, DM, F.WTOUT + (size_t)l * DM * DM, false, ring, r - TR_IN, F.tid);
}
__device__ __forceinline__ void p0_prologue(const Frame& F, LAS unsigned char* ring) {
    const int gw = F.bid * NWAVES + F.wave, NGW = F.G * NWAVES;
    EV_T0();
    for (int it = F.bid; it < TR_ITEMS; it += F.G) transpose_item(F, 0, it, ring);
    __syncthreads(); EV_MAX(8);
    for (int m = 2 * gw; m < MT; m += 2 * NGW) {
        const float* xa = m < MP ? F.xp + (size_t)m * DM : F.xs + (size_t)(m - MP) * DM; const float* xb = (m + 1) < MP ? F.xp + (size_t)(m + 1) * DM : F.xs + (size_t)(m + 1 - MP) * DM;
        f32x4 va[8], vb[8];
#pragma unroll
        for (int j = 0; j < 8; ++j) { va[j] = __builtin_nontemporal_load((const f32x4*)(xa + 4 * F.lane + 256 * j)); vb[j] = __builtin_nontemporal_load((const f32x4*)(xb + 4 * F.lane + 256 * j)); }
        prenorm_finish(va, F.norm_pre, F.H + (size_t)m * DM, F.lane); prenorm_finish(vb, F.norm_pre, F.H + (size_t)(m + 1) * DM, F.lane); }
    __syncthreads(); EV_MAX(9);
    const int gt = F.bid * NTHREADS + F.tid, NGT = F.G * NTHREADS;
    for (int e = gt; e < 2052 * 32; e += NGT) { const int tp = e >> 5, i = e & 31; const double pos = (double)(tp < 2048 ? tp : 8192 + (tp - 2048));
        const double rev = pos * ROPE_INV[i] * 0.15915494309189535; const float fr = (float)(rev - floor(rev));
        F.rope[tp * 64 + i] = __builtin_amdgcn_cosf(fr); F.rope[tp * 64 + 32 + i] = __builtin_amdgcn_sinf(fr); }
    for (int e = gt; e < 2 * 4 * 128 * 128; e += NGT) { const int s = e & 127, t = (e >> 7) & 127; const float w = F.sgu_w[e];
        F.SGUW[e] = (bf16_t)(pg8::cvt_pk_bf16(s <= t ? w : 0.f, 0.f) & 0xffffu); }
    for (int e = gt; e < 2 * 4 * 128; e += NGT) { const int t = e & 127; const float* wr = F.sgu_w + (size_t)e * 128; float acc = 0.f;
        for (int s2 = 0; s2 <= t; ++s2) acc += __uint_as_float(pg8::cvt_pk_bf16(wr[s2], 0.f) << 16);
        F.RSW[e] = acc; }
    for (int e = gt; e < 2 * 4 * 128 * 128; e += NGT) { const int c = e & 127, d = (e >> 7) & 127, lg = e >> 14;
        F.PWT[e] = (bf16_t)(pg8::cvt_pk_bf16(F.pool_w[((size_t)lg * 128 + c) * 128 + d], 0.f) & 0xffffu); }
}

constexpr int AT_K = 0, AT_V = 49152, AT_STG = 98304, AT_WSTRIDE = 4352;
__device__ __forceinline__ void attn_stage_kv(const Frame& F, int b, int kvh, int nbp, LAS unsigned char* ring) {
    const int tid = F.tid;
    const bf16_t* kg = F.Kc + ((size_t)(b * 4 + kvh) * 2048 + 256 * nbp - 128) * 64;
    const bf16_t* vg = F.VTP + ((size_t)(b * 4 + kvh) * 64 + 8 * nbp - 4) * 2048;
    u32x4 kv[6], vv[6];
#pragma unroll
    for (int i = 0; i < 6; ++i) { const int ch = tid + 512 * i, row0 = ch >> 3, c8 = ch & 7, row = (nbp > 0 || row0 >= 128) ? row0 : row0 + 128;
        kv[i] = __builtin_nontemporal_load((const u32x4*)(kg + row * 64 + c8 * 8)); }
#pragma unroll
    for (int i = 0; i < 6; ++i) { const int ch = tid + 512 * i, tile0 = ch >> 8, rem = ch & 255, d = rem >> 2, c4 = rem & 3, tile = (nbp > 0 || tile0 >= 4) ? tile0 : tile0 + 4;
        vv[i] = __builtin_nontemporal_load((const u32x4*)(vg + tile * 2048 + d * 32 + c4 * 8)); }
#pragma unroll
    for (int i = 0; i < 6; ++i) { const int ch = tid + 512 * i, row = ch >> 3, c8 = ch & 7;
        *(LAS u32x4*)(ring + AT_K + row * 128 + ((c8 ^ (row & 7)) << 4)) = kv[i]; }
#pragma unroll
    for (int i = 0; i < 6; ++i) { const int ch = tid + 512 * i, tile = ch >> 8, rem = ch & 255, d = rem >> 2, c4 = rem & 3;
        *(LAS u32x4*)(ring + AT_V + tile * 4096 + d * 64 + ((c4 ^ ((d >> 2) & 3)) << 4)) = vv[i]; }
}
__device__ __forceinline__ void attn_task(const Frame& F, int l, int b, int nbp, int head, int j, const bf16x8 (&qf)[4], LAS unsigned char* ring) {
    const int lane = F.lane, r = lane & 31, hh = lane >> 5;
    LAS unsigned char* wl = ring + AT_STG + F.wave * AT_WSTRIDE;
    LAS float* wsf = (LAS float*)wl; LAS bf16_t* stg = (LAS bf16_t*)(wl + 256);
    const size_t qrow0 = (size_t)b * 2048 + 256 * nbp + 32 * j;
    u32x4 gv[4];
#pragma unroll
    for (int i = 0; i < 4; ++i) gv[i] = __builtin_nontemporal_load((const u32x4*)(F.Z2 + (qrow0 + i * 8 + (lane >> 3)) * ZW + Z_GA + head * 64 + (lane & 7) * 8));
    const int cmin = (nbp > 0) ? 0 : (j < 4 ? 4 - j : 0);
    f32x16 S[5];
#pragma unroll
    for (int c = 0; c < 5; ++c) {
        f32x16 a;
#pragma unroll
        for (int i = 0; i < 16; ++i) a[i] = 0.f;
        if (c >= cmin) {
            LAS unsigned char* kp = ring + AT_K + (32 * (j + c) + r) * 128;
#pragma unroll
            for (int s = 0; s < 4; ++s) a = __builtin_amdgcn_mfma_f32_32x32x16_bf16(*(const LAS bf16x8*)(kp + (((2 * s + hh) ^ (r & 7)) << 4)), qf[s], a, 0, 0, 0);
        }
        S[c] = a;
    }
    const float NEG = -INFINITY;
#pragma unroll
    for (int i = 0; i < 16; ++i) { const int kap = crow(i, hh); if (kap <= r) S[0][i] = NEG; if (kap > r) S[4][i] = NEG; }
    const float sink2 = F.sinks[l * 16 + head] * LOG2E;
    float m = sink2;
#pragma unroll
    for (int c = 0; c < 5; ++c) if (c >= cmin) {
#pragma unroll
        for (int i = 0; i < 16; ++i) m = fmaxf(m, S[c][i]); }
    m = fmaxf(m, __shfl_xor(m, 32));
    float sum = 0.f;
#pragma unroll
    for (int c = 0; c < 5; ++c) if (c >= cmin) {
#pragma unroll
        for (int i = 0; i < 16; ++i) { const float p = __builtin_amdgcn_exp2f(S[c][i] - m); S[c][i] = p; sum += p; } }
    sum += __shfl_xor(sum, 32);
    const float inv = 1.0f / (sum + __builtin_amdgcn_exp2f(sink2 - m));
    f32x16 o[2];
#pragma unroll
    for (int i = 0; i < 16; ++i) { o[0][i] = 0.f; o[1][i] = 0.f; }
#pragma unroll
    for (int c = 0; c < 5; ++c) if (c >= cmin) {
        LAS unsigned char* vt = ring + AT_V + (j + c) * 4096 + r * 64;
#pragma unroll
        for (int s = 0; s < 2; ++s) {
            u32x4 pw; pw.x = pg8::cvt_pk_bf16(S[c][8 * s + 0], S[c][8 * s + 1]); pw.y = pg8::cvt_pk_bf16(S[c][8 * s + 2], S[c][8 * s + 3]);
            pw.z = pg8::cvt_pk_bf16(S[c][8 * s + 4], S[c][8 * s + 5]); pw.w = pg8::cvt_pk_bf16(S[c][8 * s + 6], S[c][8 * s + 7]);
            const bf16x8 pa = __builtin_bit_cast(bf16x8, pw);
            const int sw = (((2 * hh + s) ^ ((r >> 2) & 3)) << 4);
#pragma unroll
            for (int db = 0; db < 2; ++db) o[db] = __builtin_amdgcn_mfma_f32_32x32x16_bf16(pa, *(const LAS bf16x8*)(vt + db * 2048 + sw), o[db], 0, 0, 0);
        }
    }
    if (hh == 0) wsf[r] = inv;
    LDS_WAIT();
#pragma unroll
    for (int i = 0; i < 16; ++i) { const int q = crow(i, hh); const float rl = wsf[q];
        stg[q * 64 + r] = (bf16_t)(pg8::cvt_pk_bf16(o[0][i] * rl, 0.f) & 0xffffu);
        stg[q * 64 + 32 + r] = (bf16_t)(pg8::cvt_pk_bf16(o[1][i] * rl, 0.f) & 0xffffu); }
    LDS_WAIT();
#pragma unroll
    for (int i = 0; i < 4; ++i) { const int row = i * 8 + (lane >> 3), ch = lane & 7;
        const u32x4 ov = *(const LAS u32x4*)(stg + row * 64 + ch * 8);
        float of[8], gf[8]; unpack8(ov, of); unpack8(gv[i], gf);
#pragma unroll
        for (int jj = 0; jj < 8; ++jj) of[jj] *= gf[jj];
        *(u32x4*)(F.MIX + (qrow0 + row) * DM + head * 64 + ch * 8) = pack8(of); }
    LDS_WAIT();
}
__device__ __forceinline__ void attn_unit(int l, int a, LAS unsigned char* ring) {
    LOCAL_FRAME;
    const int kvh = a & 3, nbp = (a >> 2) & 7, b = a >> 5;
    const int lane = F.lane, r = lane & 31, hh = lane >> 5;
    const int head = 4 * kvh + (F.wave >> 1), j0 = 4 * (F.wave & 1);
    const bf16_t* qp = F.Qc + ((size_t)b * 2048 + 256 * nbp + 32 * j0 + r) * 1024 + head * 64 + 8 * hh;
    bf16x8 qa[4], qb[4];
#pragma unroll
    for (int s = 0; s < 4; ++s) qa[s] = __builtin_nontemporal_load((const bf16x8*)(qp + 16 * s));
#ifdef EXP_ZERO_LDS
    for (int e = F.tid; e < 134144 / 16; e += NTHREADS) *(LAS u32x4*)(ring + 16 * e) = (u32x4){0u, 0u, 0u, 0u};
    LDS_WAIT(); __syncthreads();
#endif
    attn_stage_kv(F, b, kvh, nbp, ring);
    LDS_WAIT();
    __syncthreads();
#pragma unroll
    for (int s = 0; s < 4; ++s) qb[s] = __builtin_nontemporal_load((const bf16x8*)(qp + 32 * 1024 + 16 * s));
    attn_task(F, l, b, nbp, head, j0 + 0, qa, ring);
#pragma unroll
    for (int s = 0; s < 4; ++s) qa[s] = __builtin_nontemporal_load((const bf16x8*)(qp + 64 * 1024 + 16 * s));
    attn_task(F, l, b, nbp, head, j0 + 1, qb, ring);
#pragma unroll
    for (int s = 0; s < 4; ++s) qb[s] = __builtin_nontemporal_load((const bf16x8*)(qp + 96 * 1024 + 16 * s));
    attn_task(F, l, b, nbp, head, j0 + 2, qa, ring);
    attn_task(F, l, b, nbp, head, j0 + 3, qb, ring);
    __syncthreads();
}

constexpr int PL_STRIDE = 272, PL_WBYTES = 47 * 272;
template <int G>
__device__ __forceinline__ void pool_unit_p(int l, int tile, LAS unsigned char* wl) {
    LOCAL_FRAME;
    constexpr int W = 2 << G, HIST = W - 1, NROW = 32 + HIST, NLD = (NROW * 16 + 63) / 64;
    const int lane = F.lane, r = lane & 31, hh = lane >> 5;
    const size_t R0 = (size_t)32 * tile;
    const int t0 = (int)(R0 & 2047);
    {
        u32x4 x[NLD];
#pragma unroll
        for (int k = 0; k < NLD; ++k) { const int id = lane + 64 * k, lr = id >> 4, c16 = id & 15; const int lrc = lr < NROW ? lr : NROW - 1;
            const int back = HIST - lrc; const size_t grow = (back <= t0) ? R0 - back : R0;
            x[k] = __builtin_nontemporal_load((const u32x4*)(F.Z2 + grow * ZW + Z_XB + 128 * G + 8 * c16)); }
#pragma unroll
        for (int k = 0; k < NLD; ++k) { const int id = lane + 64 * k, lr = id >> 4, c16 = id & 15; if (lr < NROW) *(LAS u32x4*)(wl + lr * PL_STRIDE + c16 * 16) = x[k]; }
    }
    const size_t row = R0 + r; const int t = t0 + r;
    u32x2 gq[4][4];
#pragma unroll
    for (int db = 0; db < 4; ++db)
#pragma unroll
        for (int q = 0; q < 4; ++q) gq[db][q] = __builtin_nontemporal_load((const u32x2*)(F.Z2 + row * ZW + Z_GP + 128 * G + 32 * db + 8 * q + 4 * hh));
    const float icnt = 1.0f / (float)(W < t + 1 ? W : t + 1);
    LDS_WAIT();
    bf16x8 bfr[8];
#pragma unroll
    for (int s = 0; s < 8; ++s) {
        LAS unsigned char* bp = wl + (r + HIST) * PL_STRIDE + (16 * s + 8 * hh) * 2;
        float cur[8], sum[8]; unpack8(*(const LAS u32x4*)bp, cur);
#pragma unroll
        for (int jj = 0; jj < 8; ++jj) sum[jj] = cur[jj];
#pragma unroll
        for (int i = 1; i < W; ++i) { float f[8]; unpack8(*(const LAS u32x4*)(bp - i * PL_STRIDE), f); const float wgt = i <= t ? 1.f : 0.f;
#pragma unroll
            for (int jj = 0; jj < 8; ++jj) sum[jj] += wgt * f[jj]; }
#pragma unroll
        for (int jj = 0; jj < 8; ++jj) sum[jj] = sum[jj] * icnt - cur[jj];
        bfr[s] = __builtin_bit_cast(bf16x8, pack8(sum));
        __builtin_amdgcn_sched_barrier(0);
    }
    f32x16 acc[4];
#pragma unroll
    for (int db = 0; db < 4; ++db) {
#pragma unroll
        for (int i = 0; i < 16; ++i) acc[db][i] = 0.f;
        const bf16_t* ap = F.PWT + ((size_t)(l * 4 + G) * 128 + 32 * db + r) * 128 + 8 * hh;
#pragma unroll
        for (int s = 0; s < 8; ++s) acc[db] = __builtin_amdgcn_mfma_f32_32x32x16_bf16(*(const bf16x8*)(ap + 16 * s), bfr[s], acc[db], 0, 0, 0);
        __builtin_amdgcn_sched_barrier(0);
    }
#pragma unroll
    for (int db = 0; db < 4; ++db)
#pragma unroll
        for (int q = 0; q < 4; ++q) {
            const int col = 128 * G + 32 * db + 8 * q + 4 * hh;
            const f32x4 sc = *(const f32x4*)(F.pool_scale + l * 512 + col);
            float gf[4]; unpack4(gq[db][q], gf);
            u32x2 wv; wv.x = pg8::cvt_pk_bf16(acc[db][4 * q + 0] * sc[0] * gf[0], acc[db][4 * q + 1] * sc[1] * gf[1]);
            wv.y = pg8::cvt_pk_bf16(acc[db][4 * q + 2] * sc[2] * gf[2], acc[db][4 * q + 3] * sc[3] * gf[3]);
            *(u32x2*)(F.MIX + row * DM + 1024 + col) = wv;
        }
    LDS_WAIT();
}
__device__ __forceinline__ void pool_prompt(int l, int g, int tile, LAS unsigned char* wl) {
    if (g == 0) pool_unit_p<0>(l, tile, wl); else if (g == 1) pool_unit_p<1>(l, tile, wl); else if (g == 2) pool_unit_p<2>(l, tile, wl); else pool_unit_p<3>(l, tile, wl);
}
template <int G>
__device__ __forceinline__ void pool_unit_s(int l, int tile) {
    LOCAL_FRAME;
    constexpr int W = 2 << G;
    const int lane = F.lane, r = lane & 31, hh = lane >> 5;
    const size_t row = (size_t)MP + 32 * tile + r;
    const int tt = (int)(row & 3), bd = (int)((row - MP) >> 2);
    const float* stb = F.state_pool + ((size_t)l * 128 + bd) * 15 * 512;
    const float icnt = 1.0f / (float)W;
    bf16x8 bfr[8];
#pragma unroll
    for (int s = 0; s < 8; ++s) {
        const int c0 = 128 * G + 16 * s + 8 * hh;
        float sum[8], cur[8];
        {
            constexpr int NL = W < 4 ? W : 4;
            u32x4 zn[NL]; f32x4 sa[NL], sb[NL];
#pragma unroll
            for (int i = 0; i < NL; ++i) { const int back = i <= tt ? i : tt; int si = 15 + tt - i; si = si > 14 ? 14 : si;
                zn[i] = *(const u32x4*)(F.Z2 + (row - back) * ZW + Z_XB + c0); sa[i] = *(const f32x4*)(stb + si * 512 + c0); sb[i] = *(const f32x4*)(stb + si * 512 + c0 + 4); }
            unpack8(zn[0], cur);
#pragma unroll
            for (int jj = 0; jj < 8; ++jj) sum[jj] = cur[jj];
#pragma unroll
            for (int i = 1; i < NL; ++i) { float f[8]; unpack8(zn[i], f); const bool nw = i <= tt;
#pragma unroll
                for (int jj = 0; jj < 4; ++jj) { sum[jj] += nw ? f[jj] : sa[i][jj]; sum[4 + jj] += nw ? f[4 + jj] : sb[i][jj]; } }
        }
#pragma unroll
        for (int i0 = 4; i0 < W; i0 += 4) {
            f32x4 sa[4], sb[4];
#pragma unroll
            for (int i = 0; i < 4; ++i) { const int si = 15 + tt - (i0 + i); sa[i] = *(const f32x4*)(stb + si * 512 + c0); sb[i] = *(const f32x4*)(stb + si * 512 + c0 + 4); }
#pragma unroll
            for (int i = 0; i < 4; ++i)
#pragma unroll
                for (int jj = 0; jj < 4; ++jj) { sum[jj] += sa[i][jj]; sum[4 + jj] += sb[i][jj]; }
        }
#pragma unroll
        for (int jj = 0; jj < 8; ++jj) sum[jj] = sum[jj] * icnt - cur[jj];
        bfr[s] = __builtin_bit_cast(bf16x8, pack8(sum));
        __builtin_amdgcn_sched_barrier(0);
    }
    f32x16 acc[4];
#pragma unroll
    for (int db = 0; db < 4; ++db) {
#pragma unroll
        for (int i = 0; i < 16; ++i) acc[db][i] = 0.f;
        const bf16_t* ap = F.PWT + ((size_t)(l * 4 + G) * 128 + 32 * db + r) * 128 + 8 * hh;
#pragma unroll
        for (int s = 0; s < 8; ++s) acc[db] = __builtin_amdgcn_mfma_f32_32x32x16_bf16(*(const bf16x8*)(ap + 16 * s), bfr[s], acc[db], 0, 0, 0);
        __builtin_amdgcn_sched_barrier(0);
    }
#pragma unroll
    for (int db = 0; db < 4; ++db)
#pragma unroll
        for (int q = 0; q < 4; ++q) {
            const int col = 128 * G + 32 * db + 8 * q + 4 * hh;
            const f32x4 sc = *(const f32x4*)(F.pool_scale + l * 512 + col);
            float gf[4]; unpack4(*(const u32x2*)(F.Z2 + row * ZW + Z_GP + col), gf);
            u32x2 wv; wv.x = pg8::cvt_pk_bf16(acc[db][4 * q + 0] * sc[0] * gf[0], acc[db][4 * q + 1] * sc[1] * gf[1]);
            wv.y = pg8::cvt_pk_bf16(acc[db][4 * q + 2] * sc[2] * gf[2], acc[db][4 * q + 3] * sc[3] * gf[3]);
            *(u32x2*)(F.MIX + row * DM + 1024 + col) = wv;
        }
}
__device__ __forceinline__ void pool_sample(int l, int g, int tile) {
    if (g == 0) pool_unit_s<0>(l, tile); else if (g == 1) pool_unit_s<1>(l, tile); else if (g == 2) pool_unit_s<2>(l, tile); else pool_unit_s<3>(l, tile);
}

struct SguOps { bf16x8 wB[8], wA[4]; u32x2 uu[2][4], gg[2][4]; float bias[2], rsw[2]; };
__device__ __forceinline__ void sgu_load_ops(SguOps& o, const Frame& F, int l, int hd, size_t R0, int r, int hh, int db, int tbA, int tbB) {
    const bf16_t* Wb = F.SGUW + (size_t)(l * 4 + hd) * 128 * 128;
#pragma unroll
    for (int s = 0; s < 8; ++s) { o.wB[s] = (bf16x8){0, 0, 0, 0, 0, 0, 0, 0}; if (s < 2 * (tbB + 1)) o.wB[s] = *(const bf16x8*)(Wb + (32 * tbB + r) * 128 + 16 * s + 8 * hh); }
#pragma unroll
    for (int s = 0; s < 4; ++s) { o.wA[s] = (bf16x8){0, 0, 0, 0, 0, 0, 0, 0}; if (s < 2 * (tbA + 1)) o.wA[s] = *(const bf16x8*)(Wb + (32 * tbA + r) * 128 + 16 * s + 8 * hh); }
#pragma unroll
    for (int pass = 0; pass < 2; ++pass) { const int tb = pass ? tbB : tbA; const size_t row = R0 + 32 * tb + r;
        o.bias[pass] = F.sgu_b[l * 512 + hd * 128 + 32 * tb + r]; o.rsw[pass] = F.RSW[(l * 4 + hd) * 128 + 32 * tb + r];
#pragma unroll
        for (int q = 0; q < 4; ++q) { const int col = 128 * hd + 32 * db + 8 * q + 4 * hh;
            o.uu[pass][q] = __builtin_nontemporal_load((const u32x2*)(F.Z2 + row * ZW + Z_U + col)); o.gg[pass][q] = __builtin_nontemporal_load((const u32x2*)(F.Z2 + row * ZW + Z_GS + col)); } }
}
__device__ __forceinline__ void sgu_mfma(const SguOps& o, LAS bf16_t* VnT, int h2, int r, int hh, int db, int tbA, int tbB, f32x16& accA, f32x16& accB) {
#pragma unroll
    for (int i = 0; i < 16; ++i) { accA[i] = 0.f; accB[i] = 0.f; }
#pragma unroll
    for (int s = 0; s < 8; ++s) {
        if (s < 2 * (tbB + 1)) {
            const LAS unsigned char* ap = (const LAS unsigned char*)VnT + (h2 * 128 + 16 * s + 8 * hh + ((r & 15) >> 2)) * 320 + (32 * db + (r & 16) + 4 * (r & 3)) * 2;
            const v4i16_t lo = __builtin_amdgcn_ds_read_tr16_b64_v4i16((LAS v4i16_t*)ap), hi = __builtin_amdgcn_ds_read_tr16_b64_v4i16((LAS v4i16_t*)(ap + 4 * 320));
            const bf16x8 a = (bf16x8){lo[0], lo[1], lo[2], lo[3], hi[0], hi[1], hi[2], hi[3]};
            accB = __builtin_amdgcn_mfma_f32_32x32x16_bf16(a, o.wB[s], accB, 0, 0, 0);
            if (s < 4) { if (s < 2 * (tbA + 1)) accA = __builtin_amdgcn_mfma_f32_32x32x16_bf16(a, o.wA[s], accA, 0, 0, 0); }
        }
    }
}
__device__ __forceinline__ void sgu_epi(const SguOps& o, const Frame& F, int l, int hd, size_t R0, int r, int hh, int db, int tbA, int tbB, const f32x16& accA, const f32x16& accB) {
    f32x4 lg[4], lb[4];
#pragma unroll
    for (int q = 0; q < 4; ++q) { const int col = 128 * hd + 32 * db + 8 * q + 4 * hh; lg[q] = *(const f32x4*)(F.ln_g + l * 512 + col); lb[q] = *(const f32x4*)(F.ln_b + l * 512 + col); }
#pragma unroll
    for (int pass = 0; pass < 2; ++pass) {
        const int tb = pass ? tbB : tbA; const f32x16 acc = pass ? accB : accA;
        const size_t row = R0 + 32 * tb + r; const float bs = o.bias[pass], rs = o.rsw[pass];
#pragma unroll
        for (int q = 0; q < 4; ++q) { const int col = 128 * hd + 32 * db + 8 * q + 4 * hh;
            float uf[4], gf[4]; unpack4(o.uu[pass][q], uf); unpack4(o.gg[pass][q], gf);
            float m[4];
#pragma unroll
            for (int e = 0; e < 4; ++e) m[e] = (lg[q][e] * acc[4 * q + e] + lb[q][e] * rs + bs) * uf[e] * gf[e];
            u32x2 wo; wo.x = pg8::cvt_pk_bf16(m[0], m[1]); wo.y = pg8::cvt_pk_bf16(m[2], m[3]);
            *(u32x2*)(F.MIX + row * DM + 1536 + col) = wo; }
    }
}
__device__ __forceinline__ void sgu_unit(int l, int ci, int hp, LAS unsigned char* ring) {
    LOCAL_FRAME;
    LAS bf16_t* VnT = (LAS bf16_t*)ring;
    const int lane = F.lane, wv = F.wave;
    const size_t R0 = (size_t)128 * ci;
    const int r = lane & 31, hh = lane >> 5, db = wv & 3; const int tbA = (wv >> 2) ? 1 : 0, tbB = (wv >> 2) ? 2 : 3;
    SguOps op0;
    {
        const int tl = lane >> 2, q4 = lane & 3;
        const bf16_t* vrow = F.Z2 + (R0 + 16 * wv + tl) * ZW + Z_VS + 32 * q4;
        u32x4 x[4][4];
#pragma unroll
        for (int h = 0; h < 4; ++h)
#pragma unroll
            for (int i = 0; i < 4; ++i) x[h][i] = *(const u32x4*)(vrow + 128 * h + 8 * i);
        sgu_load_ops(op0, F, l, 2 * hp, R0, r, hh, db, tbA, tbB);
        float s = 0.f, ss = 0.f;
#pragma unroll
        for (int h = 0; h < 4; ++h)
#pragma unroll
            for (int i = 0; i < 4; ++i) { float f[8]; unpack8(x[h][i], f);
#pragma unroll
                for (int jj = 0; jj < 8; ++jj) { s += f[jj]; ss += f[jj] * f[jj]; } }
        s += __shfl_xor(s, 1); s += __shfl_xor(s, 2); ss += __shfl_xor(ss, 1); ss += __shfl_xor(ss, 2);
        const float mean = s * (1.0f / 512.0f), var = ss * (1.0f / 512.0f) - mean * mean, rstd = rsqrtf(var + EPS);
#pragma unroll
        for (int h2 = 0; h2 < 2; ++h2)
#pragma unroll
            for (int i = 0; i < 4; ++i) { const int d = 32 * q4 + 8 * i;
                const u32x4 xv = hp ? x[2 + h2][i] : x[h2][i];
                float f[8]; unpack8(xv, f);
#pragma unroll
                for (int jj = 0; jj < 8; ++jj) f[jj] = (f[jj] - mean) * rstd;
                *(LAS u32x4*)((LAS unsigned char*)VnT + (h2 * 128 + 16 * wv + tl) * 320 + d * 2) = pack8(f); }
    }
    LDS_WAIT();
    __syncthreads();
    f32x16 accA, accB;
    sgu_mfma(op0, VnT, 0, r, hh, db, tbA, tbB, accA, accB);
    SguOps op1;
    sgu_load_ops(op1, F, l, 2 * hp + 1, R0, r, hh, db, tbA, tbB);
    sgu_epi(op0, F, l, 2 * hp, R0, r, hh, db, tbA, tbB, accA, accB);
    sgu_mfma(op1, VnT, 1, r, hh, db, tbA, tbB, accA, accB);
    sgu_epi(op1, F, l, 2 * hp + 1, R0, r, hh, db, tbA, tbB, accA, accB);
    __syncthreads();
}

__device__ __forceinline__ void samp_attn(int l, int bd, int kvh, LAS unsigned char* wl) {
    LOCAL_FRAME;
    LAS float* ps = (LAS float*)wl;
    LAS float* invs = ps + 144 * 16;
    const int lane = F.lane, fr = lane & 15, fq = lane >> 4, gq = fr >> 2, tt = fr & 3;
    float* oKs = F.out + O_KS + (size_t)l * LS_KS; float* oVs = F.out + O_VS + (size_t)l * LS_KS;
    bf16x8 qfr[2];
    {
        const bf16_t* qsrc = F.Qc + ((size_t)MP + 4 * bd + tt) * 1024 + (4 * kvh + gq) * 64 + 16 * fq;
        const u32x4 qa = *(const u32x4*)qsrc, qb = *(const u32x4*)(qsrc + 8);
        u32x4 lo, hi;
        lo.x = (qa.x & 0xffffu) | (qa.y << 16); lo.y = (qa.z & 0xffffu) | (qa.w << 16); lo.z = (qb.x & 0xffffu) | (qb.y << 16); lo.w = (qb.z & 0xffffu) | (qb.w << 16);
        hi.x = (qa.x >> 16) | (qa.y & 0xffff0000u); hi.y = (qa.z >> 16) | (qa.w & 0xffff0000u); hi.z = (qb.x >> 16) | (qb.y & 0xffff0000u); hi.w = (qb.z >> 16) | (qb.w & 0xffff0000u);
        qfr[0] = __builtin_bit_cast(bf16x8, lo); qfr[1] = __builtin_bit_cast(bf16x8, hi);
    }
    const float* kc = F.cache_k + (((size_t)l * 128 + bd) * 128) * 256 + kvh * 64 + 8 * fq;
    const float* kn = oKs + (((size_t)bd * 128 + 124 + (fr & 3)) * 4 + kvh) * 64 + 8 * fq;
    float* kd = oKs + ((size_t)bd * 128 * 4 + kvh) * 64 + 8 * fq;
    f32x4 S[9];
#pragma unroll
    for (int T = 0; T < 9; ++T) S[T] = (f32x4){0.f, 0.f, 0.f, 0.f};
#pragma unroll
    for (int T0 = 0; T0 < 9; T0 += 3) {
        f32x4 x[3][2][2];
#pragma unroll
        for (int u = 0; u < 3; ++u) { const int T = T0 + u; const float* src = (T < 8) ? kc + (size_t)(16 * T + fr) * 256 : kn;
#pragma unroll
            for (int ks = 0; ks < 2; ++ks) { x[u][ks][0] = __builtin_nontemporal_load((const f32x4*)(src + 32 * ks)); x[u][ks][1] = __builtin_nontemporal_load((const f32x4*)(src + 32 * ks + 4)); } }
#pragma unroll
        for (int u = 0; u < 3; ++u) { const int T = T0 + u; const int key = 16 * T + fr;
            if (T < 8 && key >= 4) {
#pragma unroll
                for (int ks = 0; ks < 2; ++ks) { float* dst = kd + (size_t)(key - 4) * 256 + 32 * ks; __builtin_nontemporal_store(x[u][ks][0], (f32x4*)dst); __builtin_nontemporal_store(x[u][ks][1], (f32x4*)(dst + 4)); } } }
#pragma unroll
        for (int u = 0; u < 3; ++u)
#pragma unroll
            for (int ks = 0; ks < 2; ++ks) { u32x4 w; w.x = pg8::cvt_pk_bf16(x[u][ks][0][0], x[u][ks][0][1]); w.y = pg8::cvt_pk_bf16(x[u][ks][0][2], x[u][ks][0][3]);
                w.z = pg8::cvt_pk_bf16(x[u][ks][1][0], x[u][ks][1][1]); w.w = pg8::cvt_pk_bf16(x[u][ks][1][2], x[u][ks][1][3]);
                S[T0 + u] = __builtin_amdgcn_mfma_f32_16x16x32_bf16(__builtin_bit_cast(bf16x8, w), qfr[ks], S[T0 + u], 0, 0, 0); }
        __builtin_amdgcn_sched_barrier(0);
    }
    const float sink2 = F.sinks[l * 16 + 4 * kvh + gq] * LOG2E;
    float m = sink2;
#pragma unroll
    for (int T = 0; T < 9; ++T)
#pragma unroll
        for (int rg = 0; rg < 4; ++rg) { const int key = 16 * T + 4 * fq + rg; const bool ok = (T < 8) ? (key >= tt + 1) : (fq == 0 && rg <= tt);
            S[T][rg] = ok ? S[T][rg] : -INFINITY; m = fmaxf(m, S[T][rg]); }
    m = fmaxf(m, __shfl_xor(m, 16)); m = fmaxf(m, __shfl_xor(m, 32));
    float sum = 0.f;
#pragma unroll
    for (int T = 0; T < 9; ++T)
#pragma unroll
        for (int rg = 0; rg < 4; ++rg) { const float p = __builtin_amdgcn_exp2f(S[T][rg] - m); sum += p; ps[(16 * T + 4 * fq + rg) * 16 + fr] = p; }
    sum += __shfl_xor(sum, 16); sum += __shfl_xor(sum, 32);
    if (fq == 0) invs[fr] = 1.0f / (sum + __builtin_amdgcn_exp2f(sink2 - m));
    LDS_WAIT();
    const int kq = lane >> 4, dq = lane & 15;
    const float* vcp = F.cache_v + (((size_t)l * 128 + bd) * 128 + kq) * 256 + kvh * 64 + 4 * dq;
    float* vop = oVs + ((size_t)bd * 128 + kq) * 256 + kvh * 64 + 4 * dq;
#pragma unroll 1
    for (int pass = 0; pass < 2; ++pass) {
        float o[8][4];
#pragma unroll
        for (int q = 0; q < 8; ++q) { o[q][0] = 0.f; o[q][1] = 0.f; o[q][2] = 0.f; o[q][3] = 0.f; }
#pragma unroll 1
        for (int blk = 0; blk < 3; ++blk) {
            f32x4 vx[11];
#pragma unroll
            for (int ii = 0; ii < 11; ++ii) { const int i = blk * 11 + ii; const float* src = (i < 32) ? vcp + (size_t)i * 1024 : vop + (size_t)31 * 1024; vx[ii] = __builtin_nontemporal_load((const f32x4*)src); }
            if (pass == 0) {
#pragma unroll
                for (int ii = 0; ii < 11; ++ii) { const int i = blk * 11 + ii; if (i >= 1 && i < 32) __builtin_nontemporal_store(vx[ii], (f32x4*)(vop + (size_t)(i - 1) * 1024)); } }
#pragma unroll
            for (int ii = 0; ii < 11; ++ii) { const int key = 4 * (blk * 11 + ii) + kq;
                const f32x4 pa = *(const LAS f32x4*)(ps + key * 16 + 8 * pass), pb = *(const LAS f32x4*)(ps + key * 16 + 8 * pass + 4);
#pragma unroll
                for (int e = 0; e < 4; ++e) { o[0][e] += pa[0] * vx[ii][e]; o[1][e] += pa[1] * vx[ii][e]; o[2][e] += pa[2] * vx[ii][e]; o[3][e] += pa[3] * vx[ii][e];
                    o[4][e] += pb[0] * vx[ii][e]; o[5][e] += pb[1] * vx[ii][e]; o[6][e] += pb[2] * vx[ii][e]; o[7][e] += pb[3] * vx[ii][e]; }
                __builtin_amdgcn_sched_barrier(0); }
        }
#pragma unroll
        for (int q = 0; q < 8; ++q)
#pragma unroll
            for (int e = 0; e < 4; ++e) { float v = o[q][e]; v += __shfl_xor(v, 16); v += __shfl_xor(v, 32); o[q][e] = v; }
#pragma unroll
        for (int q = 0; q < 8; ++q) if ((q >> 1) == kq) { const int qq = 8 * pass + q, t2 = qq & 3, head = 4 * kvh + (qq >> 2); const size_t row = (size_t)MP + 4 * bd + t2;
            float gf[4]; unpack4(*(const u32x2*)(F.Z2 + row * ZW + Z_GA + head * 64 + 4 * dq), gf);
            const float iq = invs[qq];
            u32x2 wv; wv.x = pg8::cvt_pk_bf16(o[q][0] * iq * gf[0], o[q][1] * iq * gf[1]); wv.y = pg8::cvt_pk_bf16(o[q][2] * iq * gf[2], o[q][3] * iq * gf[3]);
            *(u32x2*)(F.MIX + row * DM + head * 64 + 4 * dq) = wv; }
    }
    LDS_WAIT();
}
__device__ __forceinline__ void samp_sgu(int l, int bd) {
    LOCAL_FRAME;
    const int lane = F.lane, c0 = 8 * lane, hd = lane >> 4;
    {
        float* oPs = F.out + O_PS + (size_t)l * LS_PS + (size_t)bd * 15 * 512; const float* sp = F.state_pool + (size_t)l * LS_PS + (size_t)bd * 15 * 512 + 4 * 512;
        f32x4 cp[22];
#pragma unroll
        for (int k = 0; k < 22; ++k) cp[k] = __builtin_nontemporal_load((const f32x4*)(sp + 4 * (lane + 64 * k)));
#pragma unroll
        for (int k = 0; k < 22; ++k) __builtin_nontemporal_store(cp[k], (f32x4*)(oPs + 4 * (lane + 64 * k)));
    }
    float* oCV = F.out + O_CV + (size_t)l * LS_CV;
    float gl[8], bl[8];
#pragma unroll
    for (int j = 0; j < 8; ++j) { gl[j] = F.ln_g[l * 512 + c0 + j]; bl[j] = F.ln_b[l * 512 + c0 + j]; }
    u32x4 xr[4], ur[4], gr[4];
#pragma unroll
    for (int tt = 0; tt < 4; ++tt) { const size_t row = (size_t)MP + 4 * bd + tt; xr[tt] = *(const u32x4*)(F.Z2 + row * ZW + Z_VS + c0); ur[tt] = *(const u32x4*)(F.Z2 + row * ZW + Z_U + c0); gr[tt] = *(const u32x4*)(F.Z2 + row * ZW + Z_GS + c0); }
    float vn[4][8];
#pragma unroll
    for (int tt = 0; tt < 4; ++tt) { float f[8]; unpack8(xr[tt], f);
        float s = 0.f, ss = 0.f;
#pragma unroll
        for (int j = 0; j < 8; ++j) { s += f[j]; ss += f[j] * f[j]; }
        s = wave_sum(s); ss = wave_sum(ss);
        const float mean = s * (1.0f / 512.0f), var = ss * (1.0f / 512.0f) - mean * mean, rstd = rsqrtf(var + EPS);
#pragma unroll
        for (int j = 0; j < 8; ++j) vn[tt][j] = (f[j] - mean) * rstd * gl[j] + bl[j];
        float* o = oCV + ((size_t)bd * 4 + tt) * 512 + c0;
        *(f32x4*)o = (f32x4){vn[tt][0], vn[tt][1], vn[tt][2], vn[tt][3]}; *(f32x4*)(o + 4) = (f32x4){vn[tt][4], vn[tt][5], vn[tt][6], vn[tt][7]}; }
#pragma unroll
    for (int tt = 0; tt < 4; ++tt) { const size_t row = (size_t)MP + 4 * bd + tt;
        float mx[8]; const float bias = F.sgu_b[l * 512 + hd * 128 + tt];
#pragma unroll
        for (int j = 0; j < 8; ++j) mx[j] = bias;
#pragma unroll
        for (int s2 = 0; s2 < 4; ++s2) if (s2 <= tt) { const float w = F.sgu_w[((size_t)(l * 4 + hd) * 128 + tt) * 128 + s2];
#pragma unroll
            for (int j = 0; j < 8; ++j) mx[j] += w * vn[s2][j]; }
        float uf[8], gf[8]; unpack8(ur[tt], uf); unpack8(gr[tt], gf);
#pragma unroll
        for (int j = 0; j < 8; ++j) mx[j] = mx[j] * uf[j] * gf[j];
        *(u32x4*)(F.MIX + row * DM + 1536 + c0) = pack8(mx); }
}

#ifdef HYBRID
__device__ __forceinline__ void attn_task_o(const Frame& F, int l, int b, int nb, int head, int qs, LAS unsigned char* wl) {
    const int lane = F.lane, r = lane & 31, hh = lane >> 5, kvh = head >> 2;
    LAS float* wsf = (LAS float*)wl; LAS bf16_t* stg = (LAS bf16_t*)(wl + 256);
    const int t0 = 128 * nb + 32 * qs;
    const size_t qrow0 = (size_t)b * 2048 + t0;
    const bf16_t* qp = F.Qc + (qrow0 + r) * 1024 + head * 64 + 8 * hh;
    bf16x8 qf[4];
#pragma unroll
    for (int s = 0; s < 4; ++s) qf[s] = *(const bf16x8*)(qp + 16 * s);
    const bf16_t* kbase = F.Kc + (size_t)(b * 4 + kvh) * 2048 * 64;
    const bf16_t* vbase = F.VTP + (size_t)(b * 4 + kvh) * 64 * 2048;
    const int cmin = (nb > 0) ? 0 : (4 - qs);
    f32x16 S[5];
#pragma unroll
    for (int c = 0; c < 5; ++c) {
        f32x16 a;
#pragma unroll
        for (int i = 0; i < 16; ++i) a[i] = 0.f;
        if (c >= cmin) {
            const bf16_t* kp = kbase + (size_t)(t0 - 128 + 32 * c + r) * 64 + 8 * hh;
#pragma unroll
            for (int s = 0; s < 4; ++s) a = __builtin_amdgcn_mfma_f32_32x32x16_bf16(*(const bf16x8*)(kp + 16 * s), qf[s], a, 0, 0, 0);
        }
        S[c] = a;
    }
    const float NEG = -INFINITY;
#pragma unroll
    for (int i = 0; i < 16; ++i) { const int kap = crow(i, hh); if (kap <= r) S[0][i] = NEG; if (kap > r) S[4][i] = NEG; }
    const float sink2 = F.sinks[l * 16 + head] * LOG2E;
    float m = sink2;
#pragma unroll
    for (int c = 0; c < 5; ++c) if (c >= cmin) {
#pragma unroll
        for (int i = 0; i < 16; ++i) m = fmaxf(m, S[c][i]); }
    m = fmaxf(m, __shfl_xor(m, 32));
    float sum = 0.f;
#pragma unroll
    for (int c = 0; c < 5; ++c) if (c >= cmin) {
#pragma unroll
        for (int i = 0; i < 16; ++i) { const float p = __builtin_amdgcn_exp2f(S[c][i] - m); S[c][i] = p; sum += p; } }
    sum += __shfl_xor(sum, 32);
    const float inv = 1.0f / (sum + __builtin_amdgcn_exp2f(sink2 - m));
    f32x16 o[2];
#pragma unroll
    for (int i = 0; i < 16; ++i) { o[0][i] = 0.f; o[1][i] = 0.f; }
#pragma unroll
    for (int c = 0; c < 5; ++c) if (c >= cmin) {
        const bf16_t* vt = vbase + (size_t)((t0 - 128 + 32 * c) >> 5) * 2048 + r * 32 + 16 * hh;
#pragma unroll
        for (int s = 0; s < 2; ++s) {
            u32x4 pw; pw.x = pg8::cvt_pk_bf16(S[c][8 * s + 0], S[c][8 * s + 1]); pw.y = pg8::cvt_pk_bf16(S[c][8 * s + 2], S[c][8 * s + 3]);
            pw.z = pg8::cvt_pk_bf16(S[c][8 * s + 4], S[c][8 * s + 5]); pw.w = pg8::cvt_pk_bf16(S[c][8 * s + 6], S[c][8 * s + 7]);
            const bf16x8 pa = __builtin_bit_cast(bf16x8, pw);
#pragma unroll
            for (int db = 0; db < 2; ++db) o[db] = __builtin_amdgcn_mfma_f32_32x32x16_bf16(pa, *(const bf16x8*)(vt + db * 1024 + 8 * s), o[db], 0, 0, 0);
        }
    }
    if (hh == 0) wsf[r] = inv;
    LDS_WAIT();
#pragma unroll
    for (int i = 0; i < 16; ++i) { const int q = crow(i, hh); const float rl = wsf[q];
        stg[q * 64 + r] = (bf16_t)(pg8::cvt_pk_bf16(o[0][i] * rl, 0.f) & 0xffffu);
        stg[q * 64 + 32 + r] = (bf16_t)(pg8::cvt_pk_bf16(o[1][i] * rl, 0.f) & 0xffffu); }
    LDS_WAIT();
#pragma unroll
    for (int i = 0; i < 4; ++i) { const int row = i * 8 + (lane >> 3), ch = lane & 7;
        const u32x4 ov = *(const LAS u32x4*)(stg + row * 64 + ch * 8);
        const u32x4 gv = *(const u32x4*)(F.Z2 + (qrow0 + row) * ZW + Z_GA + head * 64 + ch * 8);
        float of[8], gf[8]; unpack8(ov, of); unpack8(gv, gf);
#pragma unroll
        for (int j = 0; j < 8; ++j) of[j] *= gf[j];
        *(u32x4*)(F.MIX + (qrow0 + row) * DM + head * 64 + ch * 8) = pack8(of); }
    LDS_WAIT();
}

template <bool SAMPLE>
__device__ __forceinline__ void pool_unit_o(const Frame& F, int l, int g, int tile) {
    const int lane = F.lane, r = lane & 31, hh = lane >> 5, w = 2 << g;
    const size_t row = (size_t)(SAMPLE ? MP : 0) + 32 * tile + r;
    const int t = SAMPLE ? (int)(row & 3) : (int)(row & 2047);
    const int bd = SAMPLE ? (int)((row - MP) >> 2) : 0;
    const float icnt = SAMPLE ? 1.0f / (float)w : 1.0f / (float)(w < t + 1 ? w : t + 1);
    bf16x8 bfr[8];
#pragma unroll
    for (int s = 0; s < 8; ++s) {
        const int c0 = 128 * g + 16 * s + 8 * hh;
        float sum[8], cur[8];
#pragma unroll
        for (int j = 0; j < 8; ++j) { sum[j] = 0.f; cur[j] = 0.f; }
        for (int i = 0; i < w; ++i) {
            float f[8];
            const int e = t - i;
            if (e >= 0) { unpack8(*(const u32x4*)(F.Z2 + (row - i) * ZW + Z_XB + c0), f); }
            else if (SAMPLE) { const float* sp = F.state_pool + (((size_t)l * 128 + bd) * 15 + 15 + e) * 512 + c0;
                const f32x4 a = *(const f32x4*)sp, bq = *(const f32x4*)(sp + 4); f[0] = a[0]; f[1] = a[1]; f[2] = a[2]; f[3] = a[3]; f[4] = bq[0]; f[5] = bq[1]; f[6] = bq[2]; f[7] = bq[3]; }
            else {
#pragma unroll
                for (int j = 0; j < 8; ++j) f[j] = 0.f; }
#pragma unroll
            for (int j = 0; j < 8; ++j) sum[j] += f[j];
            if (i == 0) {
#pragma unroll
                for (int j = 0; j < 8; ++j) cur[j] = f[j]; }
        }
        float pf[8];
#pragma unroll
        for (int j = 0; j < 8; ++j) pf[j] = sum[j] * icnt - cur[j];
        bfr[s] = __builtin_bit_cast(bf16x8, pack8(pf));
    }
    f32x16 acc[4];
#pragma unroll
    for (int db = 0; db < 4; ++db) {
#pragma unroll
        for (int i = 0; i < 16; ++i) acc[db][i] = 0.f;
        const bf16_t* ap = F.PWT + ((size_t)(l * 4 + g) * 128 + 32 * db + r) * 128 + 8 * hh;
#pragma unroll
        for (int s = 0; s < 8; ++s) acc[db] = __builtin_amdgcn_mfma_f32_32x32x16_bf16(*(const bf16x8*)(ap + 16 * s), bfr[s], acc[db], 0, 0, 0);
    }
#pragma unroll
    for (int db = 0; db < 4; ++db)
#pragma unroll
        for (int q = 0; q < 4; ++q) {
            const int col = 128 * g + 32 * db + 8 * q + 4 * hh;
            const f32x4 sc = *(const f32x4*)(F.pool_scale + l * 512 + col);
            float gf[4]; unpack4(*(const u32x2*)(F.Z2 + row * ZW + Z_GP + col), gf);
            u32x2 wv; wv.x = pg8::cvt_pk_bf16(acc[db][4 * q + 0] * sc[0] * gf[0], acc[db][4 * q + 1] * sc[1] * gf[1]);
            wv.y = pg8::cvt_pk_bf16(acc[db][4 * q + 2] * sc[2] * gf[2], acc[db][4 * q + 3] * sc[3] * gf[3]);
            *(u32x2*)(F.MIX + row * DM + 1024 + col) = wv;
        }
}

__device__ __forceinline__ void sgu_unit_o(const Frame& F, int l, int ci, int hd, LAS unsigned char* ring) {
    LAS bf16_t* VnT = (LAS bf16_t*)ring;
    const int lane = F.lane, wv = F.wave;
    const size_t R0 = (size_t)128 * ci;
    {
        const int tl = lane >> 2, q4 = lane & 3;
        const bf16_t* vrow = F.Z2 + (R0 + 16 * wv + tl) * ZW + Z_VS;
        float s = 0.f, ss = 0.f;
#pragma unroll
        for (int i = 0; i < 16; ++i) { float f[8]; unpack8(*(const u32x4*)(vrow + 128 * q4 + 8 * i), f);
#pragma unroll
            for (int j = 0; j < 8; ++j) { s += f[j]; ss += f[j] * f[j]; } }
        s += __shfl_xor(s, 1); s += __shfl_xor(s, 2); ss += __shfl_xor(ss, 1); ss += __shfl_xor(ss, 2);
        const float mean = s * (1.0f / 512.0f), var = ss * (1.0f / 512.0f) - mean * mean, rstd = rsqrtf(var + EPS);
#pragma unroll
        for (int i = 0; i < 4; ++i) { const int d = 32 * q4 + 8 * i; float f[8]; unpack8(*(const u32x4*)(vrow + 128 * hd + d), f);
            const float* gp = F.ln_g + l * 512 + 128 * hd + d; const float* bp = F.ln_b + l * 512 + 128 * hd + d;
#pragma unroll
            for (int j = 0; j < 8; ++j) { const float vn = (f[j] - mean) * rstd * gp[j] + bp[j];
                VnT[(d + j) * 136 + 16 * wv + tl] = (bf16_t)(pg8::cvt_pk_bf16(vn, 0.f) & 0xffffu); } }
    }
    __syncthreads();
    {
        const int r = lane & 31, hh = lane >> 5, db = wv & 3; const int tbA = (wv >> 2) ? 1 : 0, tbB = (wv >> 2) ? 2 : 3;
        f32x16 accA, accB;
#pragma unroll
        for (int i = 0; i < 16; ++i) { accA[i] = 0.f; accB[i] = 0.f; }
        const bf16_t* Wb = F.SGUW + (size_t)(l * 4 + hd) * 128 * 128;
#pragma unroll
        for (int s = 0; s < 8; ++s) {
            if (s < 2 * (tbB + 1)) {
                const bf16x8 a = *(const LAS bf16x8*)(VnT + (32 * db + r) * 136 + 16 * s + 8 * hh);
                accB = __builtin_amdgcn_mfma_f32_32x32x16_bf16(a, *(const bf16x8*)(Wb + (32 * tbB + r) * 128 + 16 * s + 8 * hh), accB, 0, 0, 0);
                if (s < 2 * (tbA + 1)) accA = __builtin_amdgcn_mfma_f32_32x32x16_bf16(a, *(const bf16x8*)(Wb + (32 * tbA + r) * 128 + 16 * s + 8 * hh), accA, 0, 0, 0);
            }
        }
#pragma unroll
        for (int pass = 0; pass < 2; ++pass) {
            const int tb = pass ? tbB : tbA; const f32x16 acc = pass ? accB : accA;
            const int t = 32 * tb + r; const size_t row = R0 + t; const float bias = F.sgu_b[l * 512 + hd * 128 + t];
#pragma unroll
            for (int q = 0; q < 4; ++q) { const int col = 128 * hd + 32 * db + 8 * q + 4 * hh;
                float uf[4], gf[4]; unpack4(*(const u32x2*)(F.Z2 + row * ZW + Z_U + col), uf); unpack4(*(const u32x2*)(F.Z2 + row * ZW + Z_GS + col), gf);
                u32x2 wo; wo.x = pg8::cvt_pk_bf16((acc[4 * q + 0] + bias) * uf[0] * gf[0], (acc[4 * q + 1] + bias) * uf[1] * gf[1]);
                wo.y = pg8::cvt_pk_bf16((acc[4 * q + 2] + bias) * uf[2] * gf[2], (acc[4 * q + 3] + bias) * uf[3] * gf[3]);
                *(u32x2*)(F.MIX + row * DM + 1536 + col) = wo; }
        }
    }
    __syncthreads();
}

__device__ __forceinline__ void samp_attn_o(const Frame& F, int l, int bd, int kvh, LAS unsigned char* wl) {
    LAS float* qs = (LAS float*)wl;
    LAS float* ps = (LAS float*)(wl + 4096);
    const int lane = F.lane;
    float* oKs = F.out + O_KS + (size_t)l * LS_KS; float* oVs = F.out + O_VS + (size_t)l * LS_KS;
    {
        const int qi = lane >> 2, part = lane & 3, gq = qi >> 2, tt = qi & 3;
        const bf16_t* src = F.Qc + ((size_t)MP + 4 * bd + tt) * 1024 + (4 * kvh + gq) * 64 + 16 * part;
        float f0[8], f1[8]; unpack8(*(const u32x4*)src, f0); unpack8(*(const u32x4*)(src + 8), f1);
#pragma unroll
        for (int j = 0; j < 8; ++j) { const int p0 = 16 * part + j, p1 = p0 + 8;
            qs[qi * 64 + (p0 >> 1) + 32 * (p0 & 1)] = f0[j]; qs[qi * 64 + (p1 >> 1) + 32 * (p1 & 1)] = f1[j]; }
    }
    LDS_WAIT();
    float s0[16], s1[16], s2[16];
#pragma unroll
    for (int q = 0; q < 16; ++q) { s0[q] = 0.f; s1[q] = 0.f; s2[q] = 0.f; }
    const float* k0p = F.cache_k + (((size_t)l * 128 + bd) * 128 + lane) * 256 + kvh * 64;
    const float* k1p = k0p + 64 * 256;
    const float* k2p = oKs + (((size_t)bd * 128 + 124 + (lane & 3)) * 4 + kvh) * 64;
    float* c0p = oKs + (((size_t)bd * 128 + (lane >= 4 ? lane - 4 : 0)) * 4 + kvh) * 64;
    float* c1p = oKs + (((size_t)bd * 128 + lane + 60) * 4 + kvh) * 64;
    for (int ch = 0; ch < 16; ++ch) {
        const f32x4 kx0 = *(const f32x4*)(k0p + 4 * ch), kx1 = *(const f32x4*)(k1p + 4 * ch), kx2 = *(const f32x4*)(k2p + 4 * ch);
        if (lane >= 4) *(f32x4*)(c0p + 4 * ch) = kx0;
        *(f32x4*)(c1p + 4 * ch) = kx1;
#pragma unroll
        for (int q = 0; q < 16; ++q) { const f32x4 qv = *(const LAS f32x4*)(qs + q * 64 + 4 * ch);
            s0[q] += (qv[0] * kx0[0] + qv[1] * kx0[1]) + (qv[2] * kx0[2] + qv[3] * kx0[3]);
            s1[q] += (qv[0] * kx1[0] + qv[1] * kx1[1]) + (qv[2] * kx1[2] + qv[3] * kx1[3]);
            s2[q] += (qv[0] * kx2[0] + qv[1] * kx2[1]) + (qv[2] * kx2[2] + qv[3] * kx2[3]); }
    }
    float inv[16];
#pragma unroll
    for (int q = 0; q < 16; ++q) {
        const int tt = q & 3; const float sink2 = F.sinks[l * 16 + 4 * kvh + (q >> 2)] * LOG2E;
        const bool v0 = lane >= tt + 1, v2 = (lane < 4) && (lane <= tt);
        float m = s1[q]; if (v0) m = fmaxf(m, s0[q]); if (v2) m = fmaxf(m, s2[q]);
        m = fmaxf(wave_max(m), sink2);
        const float p0 = v0 ? __builtin_amdgcn_exp2f(s0[q] - m) : 0.f, p1 = __builtin_amdgcn_exp2f(s1[q] - m), p2 = v2 ? __builtin_amdgcn_exp2f(s2[q] - m) : 0.f;
        const float sum = wave_sum(p0 + p1 + p2);
        inv[q] = 1.0f / (sum + __builtin_amdgcn_exp2f(sink2 - m));
        ps[lane * 16 + q] = p0; ps[(lane + 64) * 16 + q] = p1; if (lane < 4) ps[(128 + lane) * 16 + q] = p2;
    }
    LDS_WAIT();
    float o[16];
#pragma unroll
    for (int q = 0; q < 16; ++q) o[q] = 0.f;
    const float* vcp = F.cache_v + (((size_t)l * 128 + bd) * 128) * 256 + kvh * 64 + lane;
    float* vop = oVs + ((size_t)bd * 128) * 256 + kvh * 64 + lane;
    for (int key = 0; key < 132; ++key) {
        float v;
        if (key < 128) { v = vcp[(size_t)key * 256]; if (key >= 4) vop[(size_t)(key - 4) * 256] = v; }
        else v = vop[(size_t)(key - 4) * 256];
#pragma unroll
        for (int q4 = 0; q4 < 4; ++q4) { const f32x4 pv = *(const LAS f32x4*)(ps + key * 16 + 4 * q4);
            o[4 * q4 + 0] += pv[0] * v; o[4 * q4 + 1] += pv[1] * v; o[4 * q4 + 2] += pv[2] * v; o[4 * q4 + 3] += pv[3] * v; }
    }
#pragma unroll
    for (int q = 0; q < 16; ++q) { const int tt = q & 3, head = 4 * kvh + (q >> 2); const size_t row = (size_t)MP + 4 * bd + tt;
        const float gv = __uint_as_float(((unsigned)F.Z2[row * ZW + Z_GA + head * 64 + lane]) << 16);
        F.MIX[row * DM + head * 64 + lane] = (bf16_t)(pg8::cvt_pk_bf16(o[q] * inv[q] * gv, 0.f) & 0xffffu); }
    LDS_WAIT();
}
__device__ __forceinline__ void samp_sgu_o(const Frame& F, int l, int bd) {
    const int lane = F.lane, c0 = 8 * lane, hd = lane >> 4;
    float* oCV = F.out + O_CV + (size_t)l * LS_CV;
    float gl[8], bl[8];
#pragma unroll
    for (int j = 0; j < 8; ++j) { gl[j] = F.ln_g[l * 512 + c0 + j]; bl[j] = F.ln_b[l * 512 + c0 + j]; }
    float vn[4][8];
#pragma unroll
    for (int tt = 0; tt < 4; ++tt) { const size_t row = (size_t)MP + 4 * bd + tt; float f[8]; unpack8(*(const u32x4*)(F.Z2 + row * ZW + Z_VS + c0), f);
        float s = 0.f, ss = 0.f;
#pragma unroll
        for (int j = 0; j < 8; ++j) { s += f[j]; ss += f[j] * f[j]; }
        s = wave_sum(s); ss = wave_sum(ss);
        const float mean = s * (1.0f / 512.0f), var = ss * (1.0f / 512.0f) - mean * mean, rstd = rsqrtf(var + EPS);
#pragma unroll
        for (int j = 0; j < 8; ++j) vn[tt][j] = (f[j] - mean) * rstd * gl[j] + bl[j];
        float* o = oCV + ((size_t)bd * 4 + tt) * 512 + c0;
        *(f32x4*)o = (f32x4){vn[tt][0], vn[tt][1], vn[tt][2], vn[tt][3]}; *(f32x4*)(o + 4) = (f32x4){vn[tt][4], vn[tt][5], vn[tt][6], vn[tt][7]}; }
#pragma unroll
    for (int tt = 0; tt < 4; ++tt) { const size_t row = (size_t)MP + 4 * bd + tt;
        float mx[8]; const float bias = F.sgu_b[l * 512 + hd * 128 + tt];
#pragma unroll
        for (int j = 0; j < 8; ++j) mx[j] = bias;
#pragma unroll
        for (int s2 = 0; s2 < 4; ++s2) if (s2 <= tt) { const float w = F.sgu_w[((size_t)(l * 4 + hd) * 128 + tt) * 128 + s2];
#pragma unroll
            for (int j = 0; j < 8; ++j) mx[j] += w * vn[s2][j]; }
        float uf[8], gf[8]; unpack8(*(const u32x4*)(F.Z2 + row * ZW + Z_U + c0), uf); unpack8(*(const u32x4*)(F.Z2 + row * ZW + Z_GS + c0), gf);
#pragma unroll
        for (int j = 0; j < 8; ++j) mx[j] = mx[j] * uf[j] * gf[j];
        *(u32x4*)(F.MIX + row * DM + 1536 + c0) = pack8(mx); }
}

#endif
struct NormRowIn { u32x4 yv[4]; f32x4 xv[4][2]; };
__device__ __forceinline__ void norm_row_load(NormRowIn& in, const Frame& F, int l, int row) {
    const int lane = F.lane;
    const bf16_t* yr = F.Yb + (size_t)row * DM + 8 * lane;
    const float* xr = ((l == 0) ? (row < MP ? F.xp + (size_t)row * DM : F.xs + (size_t)(row - MP) * DM) : F.out + (size_t)row * DM) + 8 * lane;
#pragma unroll
    for (int j = 0; j < 4; ++j) { in.yv[j] = __builtin_nontemporal_load((const u32x4*)(yr + 512 * j)); in.xv[j][0] = __builtin_nontemporal_load((const f32x4*)(xr + 512 * j)); in.xv[j][1] = __builtin_nontemporal_load((const f32x4*)(xr + 512 * j + 4)); }
}
__device__ __forceinline__ void norm_row_finish(const NormRowIn& in, const Frame& F, int l, int row) {
    const int lane = F.lane;
    float* orow = F.out + (size_t)row * DM + 8 * lane;
    const float* pg = F.norm_post + l * DM + 8 * lane; const float* g1 = F.norm_pre + DM + 8 * lane;
    float y[4][8]; float ss = 0.f;
#pragma unroll
    for (int j = 0; j < 4; ++j) { unpack8(in.yv[j], y[j]);
#pragma unroll
        for (int e = 0; e < 8; ++e) ss += y[j][e] * y[j][e]; }
    ss = wave_sum(ss);
    const float ry = rsqrtf(ss * (1.0f / 2048.0f) + EPS);
    float s1 = 0.f;
#pragma unroll
    for (int j = 0; j < 4; ++j) { const f32x4 ga = *(const f32x4*)(pg + 512 * j), gb = *(const f32x4*)(pg + 512 * j + 4);
#pragma unroll
        for (int e = 0; e < 4; ++e) { y[j][e] = in.xv[j][0][e] + y[j][e] * ry * ga[e]; y[j][4 + e] = in.xv[j][1][e] + y[j][4 + e] * ry * gb[e]; }
        __builtin_nontemporal_store((f32x4){y[j][0], y[j][1], y[j][2], y[j][3]}, (f32x4*)(orow + 512 * j)); __builtin_nontemporal_store((f32x4){y[j][4], y[j][5], y[j][6], y[j][7]}, (f32x4*)(orow + 512 * j + 4));
#pragma unroll
        for (int e = 0; e < 8; ++e) s1 += y[j][e] * y[j][e]; }
    if (l == 0) {
        s1 = wave_sum(s1);
        const float r1 = rsqrtf(s1 * (1.0f / 2048.0f) + EPS);
        bf16_t* hrow = F.H + (size_t)row * DM + 8 * lane;
#pragma unroll
        for (int j = 0; j < 4; ++j) { const f32x4 ga = *(const f32x4*)(g1 + 512 * j), gb = *(const f32x4*)(g1 + 512 * j + 4); float o[8];
#pragma unroll
            for (int e = 0; e < 4; ++e) { o[e] = y[j][e] * r1 * ga[e]; o[4 + e] = y[j][4 + e] * r1 * gb[e]; }
            *(u32x4*)(hrow + 512 * j) = pack8(o); }
    }
}
__device__ __forceinline__ void norm_rows4(int l, int row0) { LOCAL_FRAME;
#pragma unroll 1
    for (int k = 0; k < 4; k += 2) { NormRowIn a, b; norm_row_load(a, F, l, row0 + k); norm_row_load(b, F, l, row0 + k + 1);
        norm_row_finish(a, F, l, row0 + k); norm_row_finish(b, F, l, row0 + k + 1); } }

constexpr int Q2_G = 40, Q2_AT = Q2_G + 256, Q2_SG = Q2_AT + 256, Q2_SA = Q2_SG + 64, Q2_SS = Q2_SA + 16, Q2_SP = Q2_SS + 8, Q2_PO = Q2_SP + 256;
__device__ __forceinline__ void slot2(int l, LAS unsigned char* L, LAS unsigned char* ring) {
    int t_ = threadIdx.x; asm volatile("" : "+v"(t_)); const int wave = __builtin_amdgcn_readfirstlane(t_ >> 6);
    unsigned* head = ctl_word(CW_Q + 64 * (2 * l));
    EV_T0();
#pragma unroll 1
    for (;;) {
        const int it = q_pop(head, L);
        if (it >= Q2_PO + (l == 0 ? TR_ITEMS : 0)) { if (l == 0) { EV_MAX(0); EV_MIN(1); } break; }
        if (it < Q2_G) {
            unsigned char* ws = (unsigned char*)kargs()->ws;
            pg8::Gemm g{(const bf16_t*)(ws + WS_H), (const bf16_t*)(ws + WS_WTIN) + (size_t)l * DIN * DM, MT, DIN, DM};
            OneUnit S; S.u.pm = 64 + it / 20; S.u.pn = it % 20;
            pg8::EpiIn E{l};
            pg8::gemm_phase<pg8::EpiIn, OneUnit, false, true>(ring, g, S, E);
            publish(ctl_word(CW_ZS + 64 * (2 * l + it / 20)));
            if (l == 0) { EV_MAX(2); EV_MIN(3); }
        }
        else if (it < Q2_AT) { attn_unit(l, it - Q2_G, ring); if (l == 0) EV_MAX(4); }
        else if (it < Q2_SG) { const int u = it - Q2_AT; sgu_unit(l, u >> 1, u & 1, ring); if (l == 0) EV_MAX(5); }
        else if (it < Q2_SA) { const int i = it - Q2_SG; dep_wait(ctl_word(CW_ZS + 64 * (2 * l + (i >> 5))), 20u); if (l == 0) EV_MIN(6); const int k = 8 * i + wave; samp_attn(l, k >> 2, k & 3, ring + wave * 9472); __syncthreads(); if (l == 0) EV_MAX(7); }
        else if (it < Q2_SS) { const int i = it - Q2_SA; dep_wait(ctl_word(CW_ZS + 64 * (2 * l + (i >> 3))), 20u); samp_sgu(l, 8 * i + wave); }
        else if (it < Q2_SP) { const int i = it - Q2_SS; dep_wait(ctl_word(CW_ZS + 64 * (2 * l + (i >> 2))), 20u); const int k = 8 * i + wave; pool_sample(l, k & 3, k >> 2); }
        else if (it < Q2_PO) { const int i = 8 * (it - Q2_SP) + wave; pool_prompt(l, i & 3, i >> 2, ring + wave * PL_WBYTES); }
        else { LOCAL_FRAME; transpose_item(F, 1, it - Q2_PO, ring); }
    }
}
constexpr int Q4_G = 16, Q4_P = Q4_G + 512, Q4_S = Q4_P + 16;
__device__ __forceinline__ void slot4(int l, LAS unsigned char* L, LAS unsigned char* ring) {
    int t_ = threadIdx.x; asm volatile("" : "+v"(t_)); const int wave = __builtin_amdgcn_readfirstlane(t_ >> 6);
    unsigned* head = ctl_word(CW_Q + 64 * (2 * l + 1));
#pragma unroll 1
    for (;;) {
        const int it = q_pop(head, L);
        if (it >= Q4_S) break;
        if (it < Q4_G) {
            unsigned char* ws = (unsigned char*)kargs()->ws;
            pg8::Gemm g{(const bf16_t*)(ws + WS_MIX), (const bf16_t*)(ws + WS_WTOUT) + (size_t)l * DM * DM, MT, DM, DM};
            OneUnit S; S.u.pm = 64 + it / 8; S.u.pn = it % 8;
            pg8::EpiOut E{};
            pg8::gemm_phase<pg8::EpiOut, OneUnit, false, true>(ring, g, S, E);
            publish(ctl_word(CW_YS + 64 * (2 * l + it / 8)));
        }
        else if (it < Q4_P) norm_rows4(l, 32 * (it - Q4_G) + 4 * wave);
        else { const int i = it - Q4_P; dep_wait(ctl_word(CW_YS + 64 * (2 * l + (i >> 3))), 8u); norm_rows4(l, MP + 32 * i + 4 * wave); }
    }
}

__global__ void __launch_bounds__(NTHREADS, 2) hymba_fwd(Args a_unused) {
    extern __shared__ __attribute__((aligned(16))) unsigned char lds[];
    LAS unsigned char* L = (LAS unsigned char*)lds;
    if (threadIdx.x < 256) ((LAS unsigned*)L)[threadIdx.x] = 0u;
    __syncthreads();
    XcdBarrier bar = xcd_barrier_post((unsigned*)((unsigned char*)kargs()->ws + WS_CTL) + CW_BAR, (volatile LAS unsigned*)L + 8);
    LAS unsigned char* ring = L + RING_OFF;
    STAMP(0);
#ifndef NO_P0
    { Frame F; make_frame(F, kargs()); p0_prologue(F, ring); }
#endif
    xcd_barrier(bar);
    STAMP(1);
#pragma unroll 1
    for (int l = 0; l < 2; ++l) {
#ifndef NO_P1
        {
            KArgs ka = kargs(); unsigned char* ws = (unsigned char*)ka->ws;
            pg8::Gemm g{(const bf16_t*)(ws + WS_H), (const bf16_t*)(ws + WS_WTIN) + (size_t)l * DIN * DM, MP, DIN, DM}; pg8::StaticOrder S; S.init(MP, DIN, (int)gridDim.x, (int)blockIdx.x);
            pg8::EpiIn E{l};
            pg8::gemm_phase<pg8::EpiIn, pg8::StaticOrder, true, true>(ring, g, S, E);
        }
#endif
        xcd_barrier(bar);
        STAMP(2 + 4 * l);
#ifndef NO_P2
        slot2(l, L, ring);
#endif
        xcd_barrier(bar);
        STAMP(3 + 4 * l);
#ifndef NO_P3
        {
            KArgs ka = kargs(); unsigned char* ws = (unsigned char*)ka->ws;
            pg8::Gemm g{(const bf16_t*)(ws + WS_MIX), (const bf16_t*)(ws + WS_WTOUT) + (size_t)l * DM * DM, MP, DM, DM}; pg8::StaticOrder S; S.init(MP, DM, (int)gridDim.x, (int)blockIdx.x);
            pg8::EpiOut E{};
            pg8::gemm_phase<pg8::EpiOut, pg8::StaticOrder, true, true>(ring, g, S, E);
        }
#endif
        xcd_barrier(bar);
        STAMP(4 + 4 * l);
#ifndef NO_P4
        slot4(l, L, ring);
#endif
        if (l == 0) xcd_barrier(bar);
#if PROBE_SEL
        if (l == 1) __syncthreads();
#endif
        STAMP(5 + 4 * l);
    }
#if PROBE_SEL
    if (blockIdx.x == 0 && threadIdx.x == 0) {
#if PROBE_SEL >= 10
        unsigned ea = __hip_atomic_load(ctl_word(CW_EV + 64 * PEA), __ATOMIC_RELAXED, __HIP_MEMORY_SCOPE_AGENT), eb = __hip_atomic_load(ctl_word(CW_EV + 64 * PEB), __ATOMIC_RELAXED, __HIP_MEMORY_SCOPE_AGENT);
        if (PEA_MIN) ea = 0x40000000u - ea; if (PEB_MIN) eb = 0x40000000u - eb;
        unsigned long long da = (ea + 400) / 800, db = (eb + 400) / 800;
#else
        LAS unsigned long long* ts = (LAS unsigned long long*)(L + 256);
        unsigned long long da = (ts[PA1] - ts[PA0] + 400) / 800, db = (ts[PB1] - ts[PB0] + 400) / 800;
#endif
        if (da > 63) da = 63; if (db > 63) db = 63;
        const unsigned long long extra = (da + 64 * db) * 1600ull, t0 = __builtin_amdgcn_s_memrealtime();
        while (__builtin_amdgcn_s_memrealtime() - t0 < extra) __builtin_amdgcn_s_sleep(32);
    }
#endif
}

extern "C" void kernel_launch(void* const* d_in, const int* in_sizes, int n_in, void* d_out, int out_size, void* d_ws, size_t ws_size, hipStream_t stream) {
    static int grid = 0;
    if (grid == 0) {
        if (n_in != 16 || (size_t)out_size != O_END || ws_size < WS_END) { fprintf(stderr, "kernel_launch: unexpected shapes: n_in %d out %d ws %zu (need %zu)\n", n_in, out_size, ws_size, (size_t)WS_END); grid = -1; return; }
        int dev = 0, cus = 0, per_cu = 0;
        if (hipGetDevice(&dev) != hipSuccess || hipDeviceGetAttribute(&cus, hipDeviceAttributeMultiprocessorCount, dev) != hipSuccess) { fprintf(stderr, "kernel_launch: device query failed\n"); grid = -1; return; }
        if (hipFuncSetAttribute((const void*)hymba_fwd, hipFuncAttributeMaxDynamicSharedMemorySize, LDS_BYTES) != hipSuccess) { fprintf(stderr, "kernel_launch: hipFuncSetAttribute failed\n"); grid = -1; return; }
        if (hipOccupancyMaxActiveBlocksPerMultiprocessor(&per_cu, (const void*)hymba_fwd, NTHREADS, LDS_BYTES) != hipSuccess || per_cu < 1) { fprintf(stderr, "kernel_launch: occupancy query says %d blocks/CU\n", per_cu); (void)hipGetLastError(); grid = -1; return; }
        grid = cus;
    }
    if (grid < 0) return;
    (void)hipMemsetAsync((char*)d_ws + WS_CTL, 0, CTL_ZERO_BYTES, stream);
    Args a{};
    for (int i = 0; i < 16; ++i) a.in[i] = (const float*)d_in[i];
    a.out = (float*)d_out; a.ws = (unsigned char*)d_ws;
    void* params[] = {&a};
    hipError_t e = hipLaunchCooperativeKernel((const void*)hymba_fwd, dim3(grid), dim3(NTHREADS), params, LDS_BYTES, stream);
    if (e != hipSuccess) fprintf(stderr, "kernel_launch: cooperative launch failed: %s (grid %d)\n", hipGetErrorString(e), grid);
}
```

```cpp
#include <hip/hip_runtime.h>
#include <cstdio>
#include <cstdint>
#include <cmath>
namespace pg8 {
#define PG8_LAS __attribute__((address_space(3)))
typedef unsigned short bf16_t;
typedef short bf16x8 __attribute__((ext_vector_type(8)));
typedef float f32x4 __attribute__((ext_vector_type(4)));
typedef unsigned u32x4 __attribute__((ext_vector_type(4)));
constexpr int BM = 256, BK = 64, HALF = 128, HTB = HALF * BK * 2  , STAGE_BYTES = 8 * HTB, NXCD = 8, WGM = 8;

__host__ __device__ __forceinline__ int lds_byte(int r, int c) { const int st = (r >> 4) * 2 + (c >> 5), rr = r & 15, cc = c & 31, ob = rr * 64 + cc * 2; return st * 1024 + (ob ^ (((ob >> 9) & 1) << 5)); }
__host__ __device__ __forceinline__ void stage_rc(int b, int& R, int& C) { const int st = b / 1024, sb = b % 1024, swz = sb ^ (((sb >> 9) & 1) << 5); R = (st >> 1) * 16 + swz / 64; C = (st & 1) * 32 + (swz % 64) / 2; }
__host__ __device__ __forceinline__ int perm32(int rho) { const int n = rho >> 4, i = rho & 15; return 8 * (i >> 2) + 4 * n + (i & 3); }

struct Unit { int pm, pn; };
struct Gemm { const bf16_t* A; const bf16_t* Bt; int M, N, K; };

struct StaticOrder {
    int nM, nN, nwg, G, c;
    __host__ __device__ void init(int M, int N, int G_, int c_) { nM = M / BM; nN = N / BM; nwg = nM * nN; G = G_; c = c_; }
    __host__ __device__ bool next(int i, Unit& u) const {
        const long L = (long)i * G + c; if (L >= nwg) return false;
        int wgid = (int)L; { const int q = nwg / NXCD, r = nwg % NXCD, xcd = wgid % NXCD, off = wgid / NXCD; wgid = (xcd < r ? xcd * (q + 1) : r * (q + 1) + (xcd - r) * q) + off; }
        const int nig = WGM * nN, gid = wgid / nig, fm = gid * WGM, gsz = (nM - fm) < WGM ? (nM - fm) : WGM;
        u.pm = fm + ((wgid % nig) % gsz); u.pn = (wgid % nig) / gsz; return true;
    }
    __device__ __forceinline__ void a_ready(const Unit&) const {}
    __device__ __forceinline__ void done(const Unit&) const {}
};

constexpr int DM = 2048, MP = 16384, MS = 512, MT = MP + MS, DIN = 5120;
constexpr int ZW = 3584;
constexpr int Z_GA = 0, Z_XB = 1024, Z_GP = 1536, Z_U = 2048, Z_VS = 2560, Z_GS = 3072;
constexpr float LOG2E = 1.4426950408889634f, QSCALE = 0.125f * LOG2E, EPS = 1e-6f;

__device__ __forceinline__ unsigned cvt_pk_bf16(float lo, float hi) { unsigned r; asm("v_cvt_pk_bf16_f32 %0, %1, %2" : "=v"(r) : "v"(lo), "v"(hi)); return r; }
__device__ __forceinline__ float silu_f(float x) { return x * __builtin_amdgcn_rcpf(1.0f + __builtin_amdgcn_exp2f(-x * LOG2E)); }
__device__ __forceinline__ int vperm32(int x) { return ((x >> 2) & 1) * 16 + (x >> 3) * 4 + (x & 3); }

struct EpiPtrs { const __attribute__((address_space(1))) float* in[16]; __attribute__((address_space(1))) float* out; __attribute__((address_space(1))) unsigned char* ws; };
constexpr size_t EP_ROPE = (size_t)1 << 20, EP_QC = (size_t)192 << 20, EP_KC = (size_t)225 << 20, EP_VTP = (size_t)233 << 20, EP_Z2 = (size_t)241 << 20, EP_Y = (size_t)357 << 20;
constexpr size_t EO_KP = 34603008, EO_VP = 35127296, EO_PP = 35651584, EO_KS = 35774464, EO_VS = 44163072, EO_PS = 52551680;
struct EpiIn {
    static constexpr bool PERM = true, AFTER_DRAIN = false;
    int l;
    __device__ __forceinline__ void operator()(const f32x4 (&acc)[2][2][4][2], const Unit& u, int wr, int wc, int fr, int fq) const {
        const __attribute__((address_space(4))) EpiPtrs* kp = (const __attribute__((address_space(4))) EpiPtrs*)__builtin_amdgcn_kernarg_segment_ptr(); asm volatile("" : "+s"(kp));
        unsigned char* ws = (unsigned char*)kp->ws; float* outp = (float*)kp->out;
        bf16_t* Qc = (bf16_t*)(ws + EP_QC); bf16_t* Kc = (bf16_t*)(ws + EP_KC); bf16_t* VTP = (bf16_t*)(ws + EP_VTP); bf16_t* Z2 = (bf16_t*)(ws + EP_Z2); const float* rope = (const float*)(ws + EP_ROPE);
        float* oKp = outp + EO_KP + (size_t)l * 262144; float* oVp = outp + EO_VP + (size_t)l * 262144; float* oPp = outp + EO_PP + (size_t)l * 61440;
        float* oKs = outp + EO_KS + (size_t)l * 4194304; float* oVs = outp + EO_VS + (size_t)l * 4194304; float* oPs = outp + EO_PS + (size_t)l * 983040;
        const int pn = u.pn;
        const int row0 = u.pm * 256 + wr * 64 + fr;
        const int cw = wc * 32 + 8 * fq;
        if (pn < 5) {
#pragma unroll
            for (int ai = 0; ai < 2; ++ai)
#pragma unroll
                for (int m = 0; m < 4; ++m) {
                    const int row = row0 + ai * 128 + m * 16;
                    const bool smp = row >= MP;
                    const int tpos = smp ? 2048 + (row & 3) : (row & 2047);
                    const float* rp = rope + tpos * 64;
#pragma unroll
                    for (int bj = 0; bj < 2; ++bj) {
                        const int c = pn * 256 + bj * 128 + cw;
                        const int i0 = (c & 63) >> 1;
                        const f32x4 cs = *(const f32x4*)(rp + i0), sn = *(const f32x4*)(rp + 32 + i0);
                        const f32x4 v0 = acc[ai][bj][m][0], v1 = acc[ai][bj][m][1];
                        f32x4 o1, o2;
                        o1[0] = v0[0] * cs[0] - v0[1] * sn[0]; o2[0] = v0[1] * cs[0] + v0[0] * sn[0];
                        o1[1] = v0[2] * cs[1] - v0[3] * sn[1]; o2[1] = v0[3] * cs[1] + v0[2] * sn[1];
                        o1[2] = v1[0] * cs[2] - v1[1] * sn[2]; o2[2] = v1[1] * cs[2] + v1[0] * sn[2];
                        o1[3] = v1[2] * cs[3] - v1[3] * sn[3]; o2[3] = v1[3] * cs[3] + v1[2] * sn[3];
                        if (pn < 4) {
                            o1 = o1 * QSCALE; o2 = o2 * QSCALE;
                            u32x4 w; w.x = cvt_pk_bf16(o1[0], o2[0]); w.y = cvt_pk_bf16(o1[1], o2[1]); w.z = cvt_pk_bf16(o1[2], o2[2]); w.w = cvt_pk_bf16(o1[3], o2[3]);
                            *(u32x4*)(Qc + (size_t)row * 1024 + c) = w;
                        } else {
                            const int kvh = (c - 1024) >> 6;
                            if (!smp) {
                                const int b = row >> 11, t = row & 2047;
                                u32x4 w; w.x = cvt_pk_bf16(o1[0], o2[0]); w.y = cvt_pk_bf16(o1[1], o2[1]); w.z = cvt_pk_bf16(o1[2], o2[2]); w.w = cvt_pk_bf16(o1[3], o2[3]);
                                *(u32x4*)(Kc + ((size_t)((b * 4 + kvh) * 2048 + t)) * 64 + (c & 63)) = w;
                                if (t >= 1920) { float* o = oKp + ((size_t)((b * 128 + t - 1920) * 4 + kvh)) * 64 + i0; *(f32x4*)o = o1; *(f32x4*)(o + 32) = o2; }
                            } else {
                                const int bd = (row - MP) >> 2, tt = row & 3;
                                float* o = oKs + ((size_t)((bd * 128 + 124 + tt) * 4 + kvh)) * 64 + i0; *(f32x4*)o = o1; *(f32x4*)(o + 32) = o2;
                            }
                        }
                    }
                }
        } else if (pn == 5) {
#pragma unroll
            for (int ai = 0; ai < 2; ++ai)
#pragma unroll
                for (int m = 0; m < 4; ++m) {
                    const int row = row0 + ai * 128 + m * 16;
                    const bool smp = row >= MP;
#pragma unroll
                    for (int bj = 0; bj < 2; ++bj) {
                        const int cv = bj * 128 + cw;
                        const int kvh = cv >> 6, d0 = cv & 63;
                        const f32x4 v0 = acc[ai][bj][m][0], v1 = acc[ai][bj][m][1];
                        if (!smp) {
                            const int b = row >> 11, t = row & 2047;
                            bf16_t* vp = VTP + ((size_t)((b * 4 + kvh) * 64 + (t >> 5))) * 2048 + d0 * 32 + vperm32(t & 31);
                            const unsigned w0 = cvt_pk_bf16(v0[0], v0[1]), w1 = cvt_pk_bf16(v0[2], v0[3]), w2 = cvt_pk_bf16(v1[0], v1[1]), w3 = cvt_pk_bf16(v1[2], v1[3]);
                            vp[0] = (bf16_t)(w0 & 0xffffu); vp[32] = (bf16_t)(w0 >> 16); vp[64] = (bf16_t)(w1 & 0xffffu); vp[96] = (bf16_t)(w1 >> 16);
                            vp[128] = (bf16_t)(w2 & 0xffffu); vp[160] = (bf16_t)(w2 >> 16); vp[192] = (bf16_t)(w3 & 0xffffu); vp[224] = (bf16_t)(w3 >> 16);
                            if (t >= 1920) { float* o = oVp + ((size_t)((b * 128 + t - 1920) * 4 + kvh)) * 64 + d0; *(f32x4*)o = v0; *(f32x4*)(o + 4) = v1; }
                        } else {
                            const int bd = (row - MP) >> 2, tt = row & 3;
                            float* o = oVs + ((size_t)((bd * 128 + 124 + tt) * 4 + kvh)) * 64 + d0; *(f32x4*)o = v0; *(f32x4*)(o + 4) = v1;
                        }
                    }
                }
        } else {
            const bool gate = (pn < 10) || (pn == 12) || (pn == 13) || (pn >= 18);
            const bool isxb = (pn == 10) || (pn == 11);
#pragma unroll
            for (int ai = 0; ai < 2; ++ai)
#pragma unroll
                for (int m = 0; m < 4; ++m) {
                    const int row = row0 + ai * 128 + m * 16;
                    const bool smp = row >= MP;
#pragma unroll
                    for (int bj = 0; bj < 2; ++bj) {
                        const int c = pn * 256 + bj * 128 + cw;
                        f32x4 v0 = acc[ai][bj][m][0], v1 = acc[ai][bj][m][1];
                        if (isxb) {
                            const int cx = c - 2560;
                            if (!smp) { const int t = row & 2047; if (t >= 2033) { const int b = row >> 11; float* o = oPp + ((size_t)(b * 15 + t - 2033)) * 512 + cx; *(f32x4*)o = v0; *(f32x4*)(o + 4) = v1; } }
                            else { const int bd = (row - MP) >> 2, tt = row & 3; float* o = oPs + ((size_t)(bd * 15 + 11 + tt)) * 512 + cx; *(f32x4*)o = v0; *(f32x4*)(o + 4) = v1; }
                        }
                        if (gate) {
#pragma unroll
                            for (int j = 0; j < 4; ++j) { v0[j] = silu_f(v0[j]); v1[j] = silu_f(v1[j]); }
                        }
                        u32x4 w; w.x = cvt_pk_bf16(v0[0], v0[1]); w.y = cvt_pk_bf16(v0[2], v0[3]); w.z = cvt_pk_bf16(v1[0], v1[1]); w.w = cvt_pk_bf16(v1[2], v1[3]);
                        *(u32x4*)(Z2 + (size_t)row * ZW + (c - 1536)) = w;
                    }
                }
        }
    }
};

struct EpiOut {
    static constexpr bool PERM = true, AFTER_DRAIN = false;
    __device__ __forceinline__ void operator()(const f32x4 (&acc)[2][2][4][2], const Unit& u, int wr, int wc, int fr, int fq) const {
        const __attribute__((address_space(4))) EpiPtrs* kp = (const __attribute__((address_space(4))) EpiPtrs*)__builtin_amdgcn_kernarg_segment_ptr(); asm volatile("" : "+s"(kp));
        bf16_t* C = (bf16_t*)((unsigned char*)kp->ws + EP_Y);
        const int row0 = u.pm * BM + wr * 64 + fr, col0 = u.pn * BM + wc * 32 + 8 * fq;
#pragma unroll
        for (int ai = 0; ai < 2; ++ai)
#pragma unroll
            for (int m = 0; m < 4; ++m) { bf16_t* rowp = C + (size_t)(row0 + ai * HALF + m * 16) * DM + col0;
#pragma unroll
                for (int bj = 0; bj < 2; ++bj) { const f32x4 v0 = acc[ai][bj][m][0], v1 = acc[ai][bj][m][1];
                    u32x4 w; w.x = cvt_pk_bf16(v0[0], v0[1]); w.y = cvt_pk_bf16(v0[2], v0[3]); w.z = cvt_pk_bf16(v1[0], v1[1]); w.w = cvt_pk_bf16(v1[2], v1[3]);
                    *(u32x4*)(rowp + bj * HALF) = w; } }
    }
};
template <class Epi, class Sched, bool ALIGN_EPI = false, bool SP2 = false>
__device__ __forceinline__ void gemm_phase(PG8_LAS unsigned char* lds, const Gemm g, const Sched& S, const Epi& E) {
    int tid_ = threadIdx.x; asm volatile("" : "+v"(tid_));
    const int tid = tid_, wid = __builtin_amdgcn_readfirstlane(tid >> 6), lane = tid & 63, wr = wid >> 2, wc = wid & 3, fr = lane & 15, fq = lane >> 4;
    const int K = g.K, nt = K / BK;
    unsigned voffA[2], voffB[2];
#pragma unroll
    for (int i = 0; i < 2; ++i) { int R, C; stage_rc(tid * 16 + i * 8192, R, C); const int Rb = Epi::PERM ? ((R & ~31) + perm32(R & 31)) : R;
        voffA[i] = (unsigned)(R * K + C) * 2u; voffB[i] = (unsigned)(Rb * K + C) * 2u; }
    const size_t kstep = (size_t)(BK * 2);
    const size_t hstep = (size_t)HALF * K * 2;
    const size_t tstep = 2 * hstep;
    const unsigned ldsw = (unsigned)wid * 1024u;
    const int aoff = lds_byte(wr * 64 + fr, fq * 8), boff = lds_byte(wc * 32 + fr, fq * 8);
#define PG8_SA(b, h) (((b) * 2 + (h)) * HTB)
#define PG8_SB(b, h) ((4 + (b) * 2 + (h)) * HTB)
#define PG8_STAGE(bufoff, gbase, voff) do { _Pragma("unroll") for (int _i = 0; _i < 2; ++_i) \
        __builtin_amdgcn_global_load_lds((const unsigned*)((const char*)(gbase) + (voff)[_i]), (PG8_LAS unsigned*)(lds + (bufoff) + ldsw + _i * 8192), 16, 0, 0); } while (0)
#define PG8_LDA(dst, b, h) do { _Pragma("unroll") for (int m = 0; m < 4; ++m) _Pragma("unroll") for (int k = 0; k < 2; ++k) dst[m][k] = *(const PG8_LAS bf16x8*)(lds + PG8_SA(b, h) + aoff + m * 2048 + k * 1024); } while (0)
#define PG8_LDB(dst, b, h) do { _Pragma("unroll") for (int n = 0; n < 2; ++n) _Pragma("unroll") for (int k = 0; k < 2; ++k) dst[n][k] = *(const PG8_LAS bf16x8*)(lds + PG8_SB(b, h) + boff + n * 2048 + k * 1024); } while (0)
#define PG8_MMA(ai, bj, At, Bt) do { __builtin_amdgcn_s_setprio(1); _Pragma("unroll") for (int m = 0; m < 4; ++m) _Pragma("unroll") for (int n = 0; n < 2; ++n) _Pragma("unroll") for (int k = 0; k < 2; ++k) \
        acc[ai][bj][m][n] = __builtin_amdgcn_mfma_f32_16x16x32_bf16(Bt[n][k], At[m][k], acc[ai][bj][m][n], 0, 0, 0); __builtin_amdgcn_s_setprio(0); } while (0)
#define PG8_WAIT_V(n) asm volatile("s_waitcnt vmcnt(" #n ")" ::: "memory")
#define PG8_WAIT_L(n) asm volatile("s_waitcnt lgkmcnt(" #n ")" ::: "memory")
#define PG8_BAR __builtin_amdgcn_s_barrier()
#define PG8_SCHED __builtin_amdgcn_sched_barrier(0)
    Unit cur, nxt; int ui = 0;
    if (!S.next(0, cur)) return;
    f32x4 acc[2][2][4][2];
#pragma unroll
    for (int a = 0; a < 2; ++a)
#pragma unroll
        for (int b = 0; b < 2; ++b)
#pragma unroll
            for (int m = 0; m < 4; ++m)
#pragma unroll
                for (int n = 0; n < 2; ++n) acc[a][b][m][n] = (f32x4){0.f, 0.f, 0.f, 0.f};
    bf16x8 At[4][2], B0[2][2], B1[2][2];
    const char* cA = (const char*)g.A + (size_t)cur.pm * tstep; const char* cB = (const char*)g.Bt + (size_t)cur.pn * tstep;
    S.a_ready(cur);
    if constexpr (SP2) {
        PG8_STAGE(PG8_SB(0, 0), cB, voffB); PG8_STAGE(PG8_SB(0, 1), cB + hstep, voffB); PG8_STAGE(PG8_SA(0, 0), cA, voffA); PG8_STAGE(PG8_SA(0, 1), cA + hstep, voffA);
        if (wr == 1) PG8_BAR;
        PG8_WAIT_V(2); PG8_BAR;
        PG8_STAGE(PG8_SB(1, 0), cB + kstep, voffB); PG8_STAGE(PG8_SA(1, 0), cA + kstep, voffA); PG8_STAGE(PG8_SB(1, 1), cB + hstep + kstep, voffB);
        PG8_WAIT_V(6); PG8_BAR;
    } else {
        PG8_STAGE(PG8_SB(0, 0), cB, voffB); PG8_STAGE(PG8_SA(0, 0), cA, voffA); PG8_STAGE(PG8_SB(0, 1), cB + hstep, voffB); PG8_STAGE(PG8_SA(0, 1), cA + hstep, voffA);
        if (wr == 1) PG8_BAR;
        PG8_WAIT_V(4); PG8_BAR;
        PG8_STAGE(PG8_SB(1, 0), cB + kstep, voffB); PG8_STAGE(PG8_SA(1, 0), cA + kstep, voffA); PG8_STAGE(PG8_SB(1, 1), cB + hstep + kstep, voffB);
        PG8_WAIT_V(6); PG8_BAR;
    }
    for (;;) {
        const bool has_next = S.next(ui + 1, nxt);
        const char* nA = has_next ? (const char*)g.A + (size_t)nxt.pm * tstep : cA; const char* nB = has_next ? (const char*)g.Bt + (size_t)nxt.pn * tstep : cB;
        for (int t = 0; t < nt; t += 2) {
            const bool last = (t == nt - 2);
            const char* a1 = cA + (size_t)(t + 1) * kstep;
            const char* a2 = last ? nA : cA + (size_t)(t + 2) * kstep; const char* b2 = last ? nB : cB + (size_t)(t + 2) * kstep;
            const char* a3 = a2 + kstep; const char* b3 = b2 + kstep;
            if (last && has_next) S.a_ready(nxt);
            if constexpr (SP2) {
            PG8_LDB(B0, 0, 0); PG8_LDB(B1, 0, 1); PG8_SCHED; PG8_LDA(At, 0, 0); PG8_STAGE(PG8_SA(1, 1), a1 + hstep, voffA);
            PG8_WAIT_V(8); PG8_WAIT_L(0); PG8_BAR; PG8_MMA(0, 0, At, B0); PG8_MMA(0, 1, At, B1); PG8_BAR; PG8_SCHED;
            PG8_LDA(At, 0, 1); PG8_STAGE(PG8_SB(0, 0), b2, voffB); PG8_STAGE(PG8_SB(0, 1), b2 + hstep, voffB); PG8_STAGE(PG8_SA(0, 0), a2, voffA);
            PG8_WAIT_V(8); PG8_WAIT_L(0); PG8_BAR; PG8_MMA(1, 0, At, B0); PG8_MMA(1, 1, At, B1); PG8_BAR; PG8_SCHED;
            PG8_LDB(B0, 1, 0); PG8_LDB(B1, 1, 1); PG8_SCHED; PG8_LDA(At, 1, 0); PG8_STAGE(PG8_SA(0, 1), a2 + hstep, voffA);
            PG8_WAIT_V(8); PG8_WAIT_L(0); PG8_BAR; PG8_MMA(0, 0, At, B0); PG8_MMA(0, 1, At, B1); PG8_BAR; PG8_SCHED;
            PG8_LDA(At, 1, 1); PG8_STAGE(PG8_SB(1, 0), b3, voffB); PG8_STAGE(PG8_SB(1, 1), b3 + hstep, voffB); PG8_STAGE(PG8_SA(1, 0), a3, voffA);
            PG8_WAIT_V(8); PG8_WAIT_L(0); PG8_BAR; PG8_MMA(1, 0, At, B0); PG8_MMA(1, 1, At, B1); PG8_BAR; PG8_SCHED;
            } else {
            PG8_LDB(B0, 0, 0); PG8_SCHED; PG8_LDA(At, 0, 0); PG8_STAGE(PG8_SA(1, 1), a1 + hstep, voffA);
            PG8_WAIT_L(8); PG8_BAR; PG8_WAIT_L(0); PG8_MMA(0, 0, At, B0); PG8_BAR; PG8_SCHED;
            PG8_LDB(B1, 0, 1); PG8_STAGE(PG8_SB(0, 0), b2, voffB);
            PG8_BAR; PG8_WAIT_L(0); PG8_MMA(0, 1, At, B1); PG8_BAR;
            PG8_LDA(At, 0, 1); PG8_STAGE(PG8_SA(0, 0), a2, voffA);
            PG8_BAR; PG8_WAIT_L(0); PG8_MMA(1, 0, At, B0); PG8_BAR; PG8_SCHED;
            PG8_STAGE(PG8_SB(0, 1), b2 + hstep, voffB);
            PG8_WAIT_V(6); PG8_BAR; PG8_MMA(1, 1, At, B1); PG8_BAR;
            PG8_LDB(B0, 1, 0); PG8_SCHED; PG8_LDA(At, 1, 0); PG8_STAGE(PG8_SA(0, 1), a2 + hstep, voffA);
            PG8_WAIT_L(8); PG8_BAR; PG8_WAIT_L(0); PG8_MMA(0, 0, At, B0); PG8_BAR; PG8_SCHED;
            PG8_LDB(B1, 1, 1); PG8_STAGE(PG8_SB(1, 0), b3, voffB);
            PG8_BAR; PG8_WAIT_L(0); PG8_MMA(0, 1, At, B1); PG8_BAR;
            PG8_LDA(At, 1, 1); PG8_STAGE(PG8_SA(1, 0), a3, voffA);
            PG8_BAR; PG8_WAIT_L(0); PG8_MMA(1, 0, At, B0); PG8_BAR; PG8_SCHED;
            PG8_STAGE(PG8_SB(1, 1), b3 + hstep, voffB);
            PG8_WAIT_V(6); PG8_BAR; PG8_MMA(1, 1, At, B1); PG8_BAR;
            }
        }
        if constexpr (ALIGN_EPI) { if (wr == 0) PG8_BAR; }
        if constexpr (!Epi::AFTER_DRAIN) { E(acc, cur, wr, wc, fr, fq); S.done(cur); }
        if (!has_next) break;
#pragma unroll
        for (int a = 0; a < 2; ++a)
#pragma unroll
            for (int b = 0; b < 2; ++b)
#pragma unroll
                for (int m = 0; m < 4; ++m)
#pragma unroll
                    for (int n = 0; n < 2; ++n) acc[a][b][m][n] = (f32x4){0.f, 0.f, 0.f, 0.f};
        cur = nxt; cA = nA; cB = nB; ++ui;
        if constexpr (ALIGN_EPI) { if (wr == 1) PG8_BAR; }
    }
    PG8_WAIT_V(0);
    if constexpr (!ALIGN_EPI) { if (wr == 0) PG8_BAR; }
    PG8_BAR;
    if constexpr (Epi::AFTER_DRAIN) { E.fused(acc, cur, wr, wc, fr, fq, lds, wid, lane); S.done(cur); }
#undef PG8_SA
#undef PG8_SB
#undef PG8_STAGE
#undef PG8_LDA
#undef PG8_LDB
#undef PG8_MMA
#undef PG8_WAIT_V
#undef PG8_WAIT_L
#undef PG8_BAR
#undef PG8_SCHED
}
}
#define GAS __attribute__((address_space(1)))
#define LAS __attribute__((address_space(3)))
typedef GAS unsigned gu32;
typedef GAS unsigned long long gu64;
#define RLX_AGENT __ATOMIC_RELAXED, __HIP_MEMORY_SCOPE_AGENT
#define VM_WAIT() asm volatile("s_waitcnt vmcnt(0)" ::: "memory")
__device__ __forceinline__ unsigned long long rt() { return __builtin_amdgcn_s_memrealtime(); }
__device__ __forceinline__ unsigned f2bf(float f) { unsigned u = __builtin_bit_cast(unsigned, f); return (u + 0x7fffu + ((u >> 16) & 1u)) >> 16; }
__device__ __forceinline__ unsigned pk2(float lo, float hi) { return f2bf(lo) | (f2bf(hi) << 16); }

#define XB_TMO      128
#define XB_XCNT(j)  (256  + 64 * (j))
#define XB_XSUB(j)  (1280 + 64 * (j))
#define XB_XGEN(j)  (2304 + 64 * (j))
#define XB_TOP      3328
#define XB_TOPGEN   3392
#define XCD_BAR_WORDS 3456
#define XB_SPIN_CAP (1u << 18)

__device__ __forceinline__ unsigned xb_ld(unsigned* p)              { return __hip_atomic_load(p, __ATOMIC_RELAXED, __HIP_MEMORY_SCOPE_AGENT); }
__device__ __forceinline__ unsigned xb_add(unsigned* p, unsigned v) { return __hip_atomic_fetch_add(p, v, __ATOMIC_RELAXED, __HIP_MEMORY_SCOPE_AGENT); }
__device__ __forceinline__ unsigned xb_xcc_id() { return (unsigned)__builtin_amdgcn_s_getreg((3 << 11) | 20) & 0xFu; }
#define XB_SPIN(cond, bar) do { unsigned _sp = 0; while (cond) { __builtin_amdgcn_s_sleep(1); \
    if ((++_sp & 255u) == 0u) { if (xb_ld(&(bar)[XB_TMO])) break; if (_sp > XB_SPIN_CAP) { atomicAdd(&(bar)[XB_TMO], 1u); break; } } } } while (0)

struct XcdBarrier {
    unsigned* bar; unsigned x;
    volatile LAS unsigned* st;
};

__device__ __forceinline__ XcdBarrier xcd_barrier_post(unsigned* bar, volatile LAS unsigned* st) {
    XcdBarrier b; b.bar = bar; b.x = xb_xcc_id(); b.st = st;
    if (threadIdx.x == 0) (void)xb_add(&bar[XB_XCNT(b.x)], 1u);
    return b;
}
__device__ __forceinline__ void xcd_barrier_complete(unsigned* bar, unsigned x, unsigned& nloc, unsigned& nx) {
    const unsigned G = gridDim.x * gridDim.y * gridDim.z;
    unsigned sum, cnt, mine, sp = 0u;
    for (;;) {
        sum = 0u; cnt = 0u; mine = 0u;
#pragma unroll
        for (unsigned j = 0; j < 16; ++j) { const unsigned c = xb_ld(&bar[XB_XCNT(j)]); sum += c; cnt += (c > 0u) ? 1u : 0u; mine = (j == x) ? c : mine; }
        if (sum == G) break;
        __builtin_amdgcn_s_sleep(1);
        if ((++sp & 255u) == 0u) { if (xb_ld(&bar[XB_TMO])) break; if (sp > XB_SPIN_CAP) { atomicAdd(&bar[XB_TMO], 1u); break; } }
    }
    nloc = mine > 0u ? mine : 1u; nx = cnt > 0u ? cnt : 1u;
}

__device__ __forceinline__ void xcd_barrier(const XcdBarrier& b) {
    asm volatile("s_waitcnt vmcnt(0)" ::: "memory");
    __syncthreads();
    if (threadIdx.x == 0) {
        unsigned* bar = b.bar;
        __builtin_amdgcn_s_waitcnt(0);
        unsigned nloc = b.st[0], nx = b.st[1];
        if (nloc == 0u) { xcd_barrier_complete(bar, b.x, nloc, nx); b.st[0] = nloc; b.st[1] = nx; }
        const unsigned old = xb_add(&bar[XB_XSUB(b.x)], 1u);
        const unsigned gen = old / nloc;
        if (old + 1u == (gen + 1u) * nloc) {
            __builtin_amdgcn_fence(__ATOMIC_RELEASE, "agent");
            asm volatile("s_waitcnt vmcnt(0)" ::: "memory");
            const unsigned og = xb_add(&bar[XB_TOP], 1u);
            const unsigned tg = og / nx;
            if (og + 1u == (tg + 1u) * nx) xb_add(&bar[XB_TOPGEN], 1u);
            else XB_SPIN(xb_ld(&bar[XB_TOPGEN]) == tg, bar);
            __builtin_amdgcn_fence(__ATOMIC_ACQUIRE, "agent");
            xb_add(&bar[XB_XGEN(b.x)], 1u);
            asm volatile("s_waitcnt vmcnt(0)" ::: "memory");
        } else {
            XB_SPIN(xb_ld(&bar[XB_XGEN(b.x)]) == gen, bar);
            __builtin_amdgcn_fence(__ATOMIC_ACQUIRE, "agent");
            asm volatile("s_waitcnt vmcnt(0)" ::: "memory");
        }
    }
    __syncthreads();
}

using pg8::bf16_t; using pg8::bf16x8; using pg8::f32x4; using pg8::u32x4;
using pg8::DM; using pg8::MP; using pg8::MS; using pg8::MT; using pg8::DIN; using pg8::ZW;
using pg8::Z_GA; using pg8::Z_XB; using pg8::Z_GP; using pg8::Z_U; using pg8::Z_VS; using pg8::Z_GS; using pg8::LOG2E; using pg8::EPS;
typedef float f32x16 __attribute__((ext_vector_type(16)));
typedef unsigned u32x2 __attribute__((ext_vector_type(2)));
typedef short v4i16_t __attribute__((ext_vector_type(4)));

constexpr int NWAVES = 8, NTHREADS = 512;
constexpr int LDS_BYTES = 147456;
constexpr int RING_OFF = 1024;

constexpr size_t O_YP = 0, O_YS = 33554432, O_KP = 34603008, O_VP = 35127296, O_PP = 35651584, O_KS = 35774464, O_VS = 44163072, O_PS = 52551680, O_CV = 54517760, O_END = 55042048;
constexpr size_t LS_KP = 262144, LS_PP = 61440, LS_KS = 4194304, LS_PS = 983040, LS_CV = 262144;
constexpr size_t MiB = 1u << 20;
constexpr size_t WS_CTL = 0, CTL_ZERO_BYTES = 65536;
constexpr size_t WS_ROPE = 1 * MiB, WS_SGUW = 2 * MiB, WS_RSW = 2 * MiB + 256 * 1024, WS_PWT = 2 * MiB + 512 * 1024;
constexpr size_t WS_WTIN = 4 * MiB, WS_WTOUT = 44 * MiB, WS_H = 60 * MiB, WS_MIX = 126 * MiB, WS_QC = 192 * MiB, WS_KC = 225 * MiB, WS_VTP = 233 * MiB, WS_Z2 = 241 * MiB, WS_Y = 357 * MiB, WS_END = 489 * MiB;
constexpr int CW_BAR = 1024;

__constant__ double ROPE_INV[32] = {1.0, 0.7498942093324559, 0.5623413251903491, 0.4216965034285822, 0.31622776601683794, 0.23713737056616552, 0.1778279410038923, 0.1333521432163324, 0.1, 0.07498942093324558, 0.05623413251903491, 0.042169650342858224, 0.03162277660168379, 0.023713737056616554, 0.01778279410038923, 0.01333521432163324, 0.01, 0.007498942093324558, 0.005623413251903491, 0.004216965034285823, 0.0031622776601683794, 0.0023713737056616554, 0.0017782794100389228, 0.001333521432163324, 0.001, 0.0007498942093324559, 0.0005623413251903491, 0.00042169650342858224, 0.00031622776601683794, 0.00023713737056616554, 0.00017782794100389227, 0.0001333521432163324};

struct Args { const float* in[16]; float* out; unsigned char* ws; };

struct Frame {
    int tid, lane, wave, bid, G;
    const float *xp, *xs, *cache_k, *cache_v, *state_pool, *w_in, *w_out, *norm_pre, *norm_post, *sinks, *pool_w, *pool_scale, *ln_g, *ln_b, *sgu_w, *sgu_b;
    float* out;
    float* rope; float* RSW; bf16_t *SGUW, *PWT, *WTIN, *WTOUT, *H, *MIX, *Qc, *Kc, *VTP, *Z2, *Yb;
};

__device__ __forceinline__ float wave_sum(float v) {
#pragma unroll
    for (int o = 1; o < 64; o <<= 1) v += __shfl_xor(v, o);
    return v;
}
__device__ __forceinline__ float wave_max(float v) {
#pragma unroll
    for (int o = 1; o < 64; o <<= 1) v = fmaxf(v, __shfl_xor(v, o));
    return v;
}
__device__ __forceinline__ float bflo(unsigned w) { return __uint_as_float(w << 16); }
__device__ __forceinline__ float bfhi(unsigned w) { return __uint_as_float(w & 0xffff0000u); }
__device__ __forceinline__ void unpack8(const u32x4 w, float (&f)[8]) { f[0] = bflo(w.x); f[1] = bfhi(w.x); f[2] = bflo(w.y); f[3] = bfhi(w.y); f[4] = bflo(w.z); f[5] = bfhi(w.z); f[6] = bflo(w.w); f[7] = bfhi(w.w); }
__device__ __forceinline__ void unpack4(const u32x2 w, float (&f)[4]) { f[0] = bflo(w.x); f[1] = bfhi(w.x); f[2] = bflo(w.y); f[3] = bfhi(w.y); }
__device__ __forceinline__ u32x4 pack8(const float (&f)[8]) { u32x4 w; w.x = pg8::cvt_pk_bf16(f[0], f[1]); w.y = pg8::cvt_pk_bf16(f[2], f[3]); w.z = pg8::cvt_pk_bf16(f[4], f[5]); w.w = pg8::cvt_pk_bf16(f[6], f[7]); return w; }
__device__ __forceinline__ int crow(int r, int hi) { return (r & 3) + 8 * (r >> 2) + 4 * hi; }
#define LDS_WAIT() asm volatile("s_waitcnt lgkmcnt(0)" ::: "memory")


struct ArgsG { const __attribute__((address_space(1))) float* in[16]; __attribute__((address_space(1))) float* out; __attribute__((address_space(1))) unsigned char* ws; };
typedef const __attribute__((address_space(4))) ArgsG* KArgs;
__device__ __forceinline__ KArgs kargs() { KArgs p = (KArgs)__builtin_amdgcn_kernarg_segment_ptr(); asm volatile("" : "+s"(p)); return p; }
__device__ __forceinline__ void make_frame(Frame& F, KArgs a) {
    { int t_ = threadIdx.x; asm volatile("" : "+v"(t_)); F.tid = t_; } F.lane = F.tid & 63; F.wave = __builtin_amdgcn_readfirstlane(F.tid >> 6); F.bid = blockIdx.x; F.G = gridDim.x;
    F.xp = (const float*)a->in[0]; F.xs = (const float*)a->in[1]; F.cache_k = (const float*)a->in[2]; F.cache_v = (const float*)a->in[3]; F.state_pool = (const float*)a->in[4]; F.w_in = (const float*)a->in[5]; F.w_out = (const float*)a->in[6]; F.norm_pre = (const float*)a->in[7]; F.norm_post = (const float*)a->in[8];
    F.sinks = (const float*)a->in[9]; F.pool_w = (const float*)a->in[10]; F.pool_scale = (const float*)a->in[11]; F.ln_g = (const float*)a->in[12]; F.ln_b = (const float*)a->in[13]; F.sgu_w = (const float*)a->in[14]; F.sgu_b = (const float*)a->in[15];
    F.out = (float*)a->out;
    unsigned char* ws = (unsigned char*)a->ws;
    F.rope = (float*)(ws + WS_ROPE); F.RSW = (float*)(ws + WS_RSW); F.SGUW = (bf16_t*)(ws + WS_SGUW); F.PWT = (bf16_t*)(ws + WS_PWT); F.WTIN = (bf16_t*)(ws + WS_WTIN); F.WTOUT = (bf16_t*)(ws + WS_WTOUT);
    F.H = (bf16_t*)(ws + WS_H); F.MIX = (bf16_t*)(ws + WS_MIX); F.Qc = (bf16_t*)(ws + WS_QC); F.Kc = (bf16_t*)(ws + WS_KC); F.VTP = (bf16_t*)(ws + WS_VTP); F.Z2 = (bf16_t*)(ws + WS_Z2); F.Yb = (bf16_t*)(ws + WS_Y);
}

#define LOCAL_FRAME Frame F; make_frame(F, kargs())

constexpr int CW_Q = 8192;
constexpr int CW_ZS = 8192 + 64 * 8;
constexpr int CW_YS = 8192 + 64 * 16;
constexpr int CW_EV = 8192 + 64 * 32;
__device__ __forceinline__ unsigned* ctl_word(int idx) { return (unsigned*)((unsigned char*)kargs()->ws + WS_CTL) + idx; }
__device__ __forceinline__ int q_pop(unsigned* head, LAS unsigned char* L) {
    volatile LAS int* slot = (volatile LAS int*)(L + 64);
    __syncthreads();
    if (threadIdx.x == 0) *slot = (int)__hip_atomic_fetch_add(head, 1u, __ATOMIC_RELAXED, __HIP_MEMORY_SCOPE_AGENT);
    __syncthreads();
    return __builtin_amdgcn_readfirstlane(*slot);
}
__device__ __forceinline__ void publish(unsigned* ctr) {
    asm volatile("s_waitcnt vmcnt(0)" ::: "memory");
    __syncthreads();
    if (threadIdx.x == 0) { __builtin_amdgcn_fence(__ATOMIC_RELEASE, "agent"); asm volatile("s_waitcnt vmcnt(0)" ::: "memory");
        __hip_atomic_fetch_add(ctr, 1u, __ATOMIC_RELAXED, __HIP_MEMORY_SCOPE_AGENT); }
}
__device__ __forceinline__ void dep_wait(unsigned* ctr, unsigned need) {
    if (threadIdx.x == 0) {
        unsigned sp = 0;
        while (__hip_atomic_load(ctr, __ATOMIC_RELAXED, __HIP_MEMORY_SCOPE_AGENT) < need) { __builtin_amdgcn_s_sleep(16); if (++sp > (1u << 21)) break; }
        __builtin_amdgcn_fence(__ATOMIC_ACQUIRE, "agent"); asm volatile("s_waitcnt vmcnt(0)" ::: "memory");
    }
    __syncthreads();
}

#if PROBE_SEL >= 10
#define EV_T0() const unsigned long long ev_t0 = __builtin_amdgcn_s_memrealtime()
#define EV_MAX(k) do { if (threadIdx.x == 0) __hip_atomic_fetch_max(ctl_word(CW_EV + 64 * (k)), (unsigned)(__builtin_amdgcn_s_memrealtime() - ev_t0), __ATOMIC_RELAXED, __HIP_MEMORY_SCOPE_AGENT); } while (0)
#define EV_MIN(k) do { if (threadIdx.x == 0) __hip_atomic_fetch_max(ctl_word(CW_EV + 64 * (k)), 0x40000000u - (unsigned)(__builtin_amdgcn_s_memrealtime() - ev_t0), __ATOMIC_RELAXED, __HIP_MEMORY_SCOPE_AGENT); } while (0)
#else
#define EV_T0() do {} while (0)
#define EV_MAX(k) do {} while (0)
#define EV_MIN(k) do {} while (0)
#endif
struct OneUnit {
    pg8::Unit u;
    __device__ __forceinline__ bool next(int i, pg8::Unit& o) const { if (i) return false; o = u; return true; }
    __device__ __forceinline__ void a_ready(const pg8::Unit&) const {}
    __device__ __forceinline__ void done(const pg8::Unit&) const {}
};

#ifndef PROBE_SEL
#define PROBE_SEL 0
#endif
#if PROBE_SEL
#define STAMP(k) do { if (blockIdx.x == 0 && threadIdx.x == 0) ((LAS unsigned long long*)(L + 256))[k] = __builtin_amdgcn_s_memrealtime(); } while (0)
#define STAMP2(k) do { if (blockIdx.x == 0) { __syncthreads(); if (threadIdx.x == 0) ((LAS unsigned long long*)((LAS unsigned char*)ring - RING_OFF + 256))[k] = __builtin_amdgcn_s_memrealtime(); } } while (0)
#else
#define STAMP(k) do {} while (0)
#define STAMP2(k) do {} while (0)
#endif
#if PROBE_SEL == 1
#define PA0 0
#define PA1 1
#define PB0 1
#define PB1 2
#elif PROBE_SEL == 2
#define PA0 2
#define PA1 3
#define PB0 3
#define PB1 4
#elif PROBE_SEL == 3
#define PA0 4
#define PA1 5
#define PB0 8
#define PB1 9
#elif PROBE_SEL == 4
#define PA0 2
#define PA1 10
#define PB0 10
#define PB1 11
#elif PROBE_SEL == 5
#define PA0 11
#define PA1 12
#define PB0 12
#define PB1 13
#elif PROBE_SEL == 7
#define PA0 1
#define PA1 2
#define PB0 0
#define PB1 1
#elif PROBE_SEL == 8
#define PA0 3
#define PA1 4
#define PB0 2
#define PB1 3
#elif PROBE_SEL == 9
#define PA0 6
#define PA1 7
#define PB0 4
#define PB1 5
#elif PROBE_SEL == 6
#define PA0 5
#define PA1 6
#define PB0 7
#define PB1 8
#elif PROBE_SEL == 10
#define PEA 0
#define PEA_MIN 0
#define PEB 1
#define PEB_MIN 1
#elif PROBE_SEL == 11
#define PEA 2
#define PEA_MIN 0
#define PEB 3
#define PEB_MIN 1
#elif PROBE_SEL == 12
#define PEA 4
#define PEA_MIN 0
#define PEB 5
#define PEB_MIN 0
#elif PROBE_SEL == 14
#define PEA 8
#define PEA_MIN 0
#define PEB 9
#define PEB_MIN 0
#elif PROBE_SEL == 13
#define PEA 6
#define PEA_MIN 1
#define PEB 7
#define PEB_MIN 0
#endif

__device__ __forceinline__ void p0_transpose_blk(const float* W, int K, int N, bf16_t* WT, bool permqk, LAS unsigned char* T, int item, int tid) {
    const int nblk = N >> 8, kb = item / nblk, nb = item - kb * nblk, k0 = kb * 128, n0 = nb * 256;
    const int n4 = tid & 63, kr = tid >> 6;
    f32x4 v[16];
#pragma unroll
    for (int i = 0; i < 16; ++i) v[i] = __builtin_nontemporal_load((const f32x4*)(W + (size_t)(k0 + 16 * kr + i) * N + n0 + 4 * n4));
#pragma unroll
    for (int e = 0; e < 4; ++e) {
        u32x4 lo, hi;
        lo.x = pg8::cvt_pk_bf16(v[0][e], v[1][e]); lo.y = pg8::cvt_pk_bf16(v[2][e], v[3][e]); lo.z = pg8::cvt_pk_bf16(v[4][e], v[5][e]); lo.w = pg8::cvt_pk_bf16(v[6][e], v[7][e]);
        hi.x = pg8::cvt_pk_bf16(v[8][e], v[9][e]); hi.y = pg8::cvt_pk_bf16(v[10][e], v[11][e]); hi.z = pg8::cvt_pk_bf16(v[12][e], v[13][e]); hi.w = pg8::cvt_pk_bf16(v[14][e], v[15][e]);
        LAS unsigned char* p = T + (64 * e + n4) * 272 + 32 * kr;
        *(LAS u32x4*)p = lo; *(LAS u32x4*)(p + 16) = hi;
    }
    LDS_WAIT();
    __syncthreads();
    {
        const int rho = tid >> 1, half = tid & 1, n = n0 + 4 * (rho & 63) + (rho >> 6);
        int nrow = n;
        if (permqk && n < 1280) { const int p = n & 63; nrow = (n & ~63) + 2 * (p & 31) + (p >> 5); }
        const LAS unsigned char* src = T + rho * 272 + 128 * half;
        bf16_t* dst = WT + (size_t)nrow * K + k0 + 64 * half;
        u32x4 o[8];
#pragma unroll
        for (int c = 0; c < 8; ++c) o[c] = *(const LAS u32x4*)(src + 16 * c);
#pragma unroll
        for (int c = 0; c < 8; ++c) *(u32x4*)(dst + 8 * c) = o[c];
    }
    LDS_WAIT();
    __syncthreads();
}
__device__ __forceinline__ void prenorm_finish(const f32x4 (&v)[8], const float* g, bf16_t* hrow, int lane) {
    float ss = 0.f;
#pragma unroll
    for (int j = 0; j < 8; ++j) ss += (v[j][0] * v[j][0] + v[j][1] * v[j][1]) + (v[j][2] * v[j][2] + v[j][3] * v[j][3]);
    ss = wave_sum(ss);
    const float r = rsqrtf(ss * (1.0f / 2048.0f) + EPS);
#pragma unroll
    for (int j = 0; j < 8; ++j) { const f32x4 gg = *(const f32x4*)(g + 4 * lane + 256 * j); const f32x4 o = v[j] * r * gg;
        u32x2 w; w.x = pg8::cvt_pk_bf16(o[0], o[1]); w.y = pg8::cvt_pk_bf16(o[2], o[3]); *(u32x2*)(hrow + 4 * lane + 256 * j) = w; }
}
constexpr int TR_IN = 16 * 20, TR_OUT = 16 * 8, TR_ITEMS = TR_IN + TR_OUT;
__device__ __forceinline__ void transpose_item(const Frame& F, int l, int r, LAS unsigned char* ring) {
    if (r < TR_IN) p0_transpose_blk(F.w_in + (size_t)l * DM * DIN, DM, DIN, F.WTIN + (size_t)l * DIN * DM, true, ring, r, F.tid);
    else p0_transpose_blk(F.w_out + (size_t)l * DM * DM, DM, DM, F.WTOUT + (size_t)l * DM * DM, false, ring, r - TR_IN, F.tid);
}
__device__ __forceinline__ void p0_prologue(const Frame& F, LAS unsigned char* ring) {
    const int gw = F.bid * NWAVES + F.wave, NGW = F.G * NWAVES;
    EV_T0();
    for (int it = F.bid; it < TR_ITEMS; it += F.G) transpose_item(F, 0, it, ring);
    __syncthreads(); EV_MAX(8);
    for (int m = 2 * gw; m < MT; m += 2 * NGW) {
        const float* xa = m < MP ? F.xp + (size_t)m * DM : F.xs + (size_t)(m - MP) * DM; const float* xb = (m + 1) < MP ? F.xp + (size_t)(m + 1) * DM : F.xs + (size_t)(m + 1 - MP) * DM;
        f32x4 va[8], vb[8];
#pragma unroll
        for (int j = 0; j < 8; ++j) { va[j] = __builtin_nontemporal_load((const f32x4*)(xa + 4 * F.lane + 256 * j)); vb[j] = __builtin_nontemporal_load((const f32x4*)(xb + 4 * F.lane + 256 * j)); }
        prenorm_finish(va, F.norm_pre, F.H + (size_t)m * DM, F.lane); prenorm_finish(vb, F.norm_pre, F.H + (size_t)(m + 1) * DM, F.lane); }
    __syncthreads(); EV_MAX(9);
    const int gt = F.bid * NTHREADS + F.tid, NGT = F.G * NTHREADS;
    for (int e = gt; e < 2052 * 32; e += NGT) { const int tp = e >> 5, i = e & 31; const double pos = (double)(tp < 2048 ? tp : 8192 + (tp - 2048));
        const double rev = pos * ROPE_INV[i] * 0.15915494309189535; const float fr = (float)(rev - floor(rev));
        F.rope[tp * 64 + i] = __builtin_amdgcn_cosf(fr); F.rope[tp * 64 + 32 + i] = __builtin_amdgcn_sinf(fr); }
    for (int e = gt; e < 2 * 4 * 128 * 128; e += NGT) { const int s = e & 127, t = (e >> 7) & 127; const float w = F.sgu_w[e];
        F.SGUW[e] = (bf16_t)(pg8::cvt_pk_bf16(s <= t ? w : 0.f, 0.f) & 0xffffu); }
    for (int e = gt; e < 2 * 4 * 128; e += NGT) { const int t = e & 127; const float* wr = F.sgu_w + (size_t)e * 128; float acc = 0.f;
        for (int s2 = 0; s2 <= t; ++s2) acc += __uint_as_float(pg8::cvt_pk_bf16(wr[s2], 0.f) << 16);
        F.RSW[e] = acc; }
    for (int e = gt; e < 2 * 4 * 128 * 128; e += NGT) { const int c = e & 127, d = (e >> 7) & 127, lg = e >> 14;
        F.PWT[e] = (bf16_t)(pg8::cvt_pk_bf16(F.pool_w[((size_t)lg * 128 + c) * 128 + d], 0.f) & 0xffffu); }
}

constexpr int AT_K = 0, AT_V = 49152, AT_STG = 98304, AT_WSTRIDE = 4352;
__device__ __forceinline__ void attn_stage_kv(const Frame& F, int b, int kvh, int nbp, LAS unsigned char* ring) {
    const int tid = F.tid;
    const bf16_t* kg = F.Kc + ((size_t)(b * 4 + kvh) * 2048 + 256 * nbp - 128) * 64;
    const bf16_t* vg = F.VTP + ((size_t)(b * 4 + kvh) * 64 + 8 * nbp - 4) * 2048;
    u32x4 kv[6], vv[6];
#pragma unroll
    for (int i = 0; i < 6; ++i) { const int ch = tid + 512 * i, row0 = ch >> 3, c8 = ch & 7, row = (nbp > 0 || row0 >= 128) ? row0 : row0 + 128;
        kv[i] = __builtin_nontemporal_load((const u32x4*)(kg + row * 64 + c8 * 8)); }
#pragma unroll
    for (int i = 0; i < 6; ++i) { const int ch = tid + 512 * i, tile0 = ch >> 8, rem = ch & 255, d = rem >> 2, c4 = rem & 3, tile = (nbp > 0 || tile0 >= 4) ? tile0 : tile0 + 4;
        vv[i] = __builtin_nontemporal_load((const u32x4*)(vg + tile * 2048 + d * 32 + c4 * 8)); }
#pragma unroll
    for (int i = 0; i < 6; ++i) { const int ch = tid + 512 * i, row = ch >> 3, c8 = ch & 7;
        *(LAS u32x4*)(ring + AT_K + row * 128 + ((c8 ^ (row & 7)) << 4)) = kv[i]; }
#pragma unroll
    for (int i = 0; i < 6; ++i) { const int ch = tid + 512 * i, tile = ch >> 8, rem = ch & 255, d = rem >> 2, c4 = rem & 3;
        *(LAS u32x4*)(ring + AT_V + tile * 4096 + d * 64 + ((c4 ^ ((d >> 2) & 3)) << 4)) = vv[i]; }
}
__device__ __forceinline__ void attn_task(const Frame& F, int l, int b, int nbp, int head, int j, const bf16x8 (&qf)[4], LAS unsigned char* ring) {
    const int lane = F.lane, r = lane & 31, hh = lane >> 5;
    LAS unsigned char* wl = ring + AT_STG + F.wave * AT_WSTRIDE;
    LAS float* wsf = (LAS float*)wl; LAS bf16_t* stg = (LAS bf16_t*)(wl + 256);
    const size_t qrow0 = (size_t)b * 2048 + 256 * nbp + 32 * j;
    u32x4 gv[4];
#pragma unroll
    for (int i = 0; i < 4; ++i) gv[i] = __builtin_nontemporal_load((const u32x4*)(F.Z2 + (qrow0 + i * 8 + (lane >> 3)) * ZW + Z_GA + head * 64 + (lane & 7) * 8));
    const int cmin = (nbp > 0) ? 0 : (j < 4 ? 4 - j : 0);
    f32x16 S[5];
#pragma unroll
    for (int c = 0; c < 5; ++c) {
        f32x16 a;
#pragma unroll
        for (int i = 0; i < 16; ++i) a[i] = 0.f;
        if (c >= cmin) {
            LAS unsigned char* kp = ring + AT_K + (32 * (j + c) + r) * 128;
#pragma unroll
            for (int s = 0; s < 4; ++s) a = __builtin_amdgcn_mfma_f32_32x32x16_bf16(*(const LAS bf16x8*)(kp + (((2 * s + hh) ^ (r & 7)) << 4)), qf[s], a, 0, 0, 0);
        }
        S[c] = a;
    }
    const float NEG = -INFINITY;
#pragma unroll
    for (int i = 0; i < 16; ++i) { const int kap = crow(i, hh); if (kap <= r) S[0][i] = NEG; if (kap > r) S[4][i] = NEG; }
    const float sink2 = F.sinks[l * 16 + head] * LOG2E;
    float m = sink2;
#pragma unroll
    for (int c = 0; c < 5; ++c) if (c >= cmin) {
#pragma unroll
        for (int i = 0; i < 16; ++i) m = fmaxf(m, S[c][i]); }
    m = fmaxf(m, __shfl_xor(m, 32));
    float sum = 0.f;
#pragma unroll
    for (int c = 0; c < 5; ++c) if (c >= cmin) {
#pragma unroll
        for (int i = 0; i < 16; ++i) { const float p = __builtin_amdgcn_exp2f(S[c][i] - m); S[c][i] = p; sum += p; } }
    sum += __shfl_xor(sum, 32);
    const float inv = 1.0f / (sum + __builtin_amdgcn_exp2f(sink2 - m));
    f32x16 o[2];
#pragma unroll
    for (int i = 0; i < 16; ++i) { o[0][i] = 0.f; o[1][i] = 0.f; }
#pragma unroll
    for (int c = 0; c < 5; ++c) if (c >= cmin) {
        LAS unsigned char* vt = ring + AT_V + (j + c) * 4096 + r * 64;
#pragma unroll
        for (int s = 0; s < 2; ++s) {
            u32x4 pw; pw.x = pg8::cvt_pk_bf16(S[c][8 * s + 0], S[c][8 * s + 1]); pw.y = pg8::cvt_pk_bf16(S[c][8 * s + 2], S[c][8 * s + 3]);
            pw.z = pg8::cvt_pk_bf16(S[c][8 * s + 4], S[c][8 * s + 5]); pw.w = pg8::cvt_pk_bf16(S[c][8 * s + 6], S[c][8 * s + 7]);
            const bf16x8 pa = __builtin_bit_cast(bf16x8, pw);
            const int sw = (((2 * hh + s) ^ ((r >> 2) & 3)) << 4);
#pragma unroll
            for (int db = 0; db < 2; ++db) o[db] = __builtin_amdgcn_mfma_f32_32x32x16_bf16(pa, *(const LAS bf16x8*)(vt + db * 2048 + sw), o[db], 0, 0, 0);
        }
    }
    if (hh == 0) wsf[r] = inv;
    LDS_WAIT();
#pragma unroll
    for (int i = 0; i < 16; ++i) { const int q = crow(i, hh); const float rl = wsf[q];
        stg[q * 64 + r] = (bf16_t)(pg8::cvt_pk_bf16(o[0][i] * rl, 0.f) & 0xffffu);
        stg[q * 64 + 32 + r] = (bf16_t)(pg8::cvt_pk_bf16(o[1][i] * rl, 0.f) & 0xffffu); }
    LDS_WAIT();
#pragma unroll
    for (int i = 0; i < 4; ++i) { const int row = i * 8 + (lane >> 3), ch = lane & 7;
        const u32x4 ov = *(const LAS u32x4*)(stg + row * 64 + ch * 8);
        float of[8], gf[8]; unpack8(ov, of); unpack8(gv[i], gf);
#pragma unroll
        for (int jj = 0; jj < 8; ++jj) of[jj] *= gf[jj];
        *(u32x4*)(F.MIX + (qrow0 + row) * DM + head * 64 + ch * 8) = pack8(of); }
    LDS_WAIT();
}
__device__ __forceinline__ void attn_unit(int l, int a, LAS unsigned char* ring) {
    LOCAL_FRAME;
    const int kvh = a & 3, nbp = (a >> 2) & 7, b = a >> 5;
    const int lane = F.lane, r = lane & 31, hh = lane >> 5;
    const int head = 4 * kvh + (F.wave >> 1), j0 = 4 * (F.wave & 1);
    const bf16_t* qp = F.Qc + ((size_t)b * 2048 + 256 * nbp + 32 * j0 + r) * 1024 + head * 64 + 8 * hh;
    bf16x8 qa[4], qb[4];
#pragma unroll
    for (int s = 0; s < 4; ++s) qa[s] = __builtin_nontemporal_load((const bf16x8*)(qp + 16 * s));
#ifdef EXP_ZERO_LDS
    for (int e = F.tid; e < 134144 / 16; e += NTHREADS) *(LAS u32x4*)(ring + 16 * e) = (u32x4){0u, 0u, 0u, 0u};
    LDS_WAIT(); __syncthreads();
#endif
    attn_stage_kv(F, b, kvh, nbp, ring);
    LDS_WAIT();
    __syncthreads();
#pragma unroll
    for (int s = 0; s < 4; ++s) qb[s] = __builtin_nontemporal_load((const bf16x8*)(qp + 32 * 1024 + 16 * s));
    attn_task(F, l, b, nbp, head, j0 + 0, qa, ring);
#pragma unroll
    for (int s = 0; s < 4; ++s) qa[s] = __builtin_nontemporal_load((const bf16x8*)(qp + 64 * 1024 + 16 * s));
    attn_task(F, l, b, nbp, head, j0 + 1, qb, ring);
#pragma unroll
    for (int s = 0; s < 4; ++s) qb[s] = __builtin_nontemporal_load((const bf16x8*)(qp + 96 * 1024 + 16 * s));
    attn_task(F, l, b, nbp, head, j0 + 2, qa, ring);
    attn_task(F, l, b, nbp, head, j0 + 3, qb, ring);
    __syncthreads();
}

constexpr int PL_STRIDE = 272, PL_WBYTES = 47 * 272;
template <int G>
__device__ __forceinline__ void pool_unit_p(int l, int tile, LAS unsigned char* wl) {
    LOCAL_FRAME;
    constexpr int W = 2 << G, HIST = W - 1, NROW = 32 + HIST, NLD = (NROW * 16 + 63) / 64;
    const int lane = F.lane, r = lane & 31, hh = lane >> 5;
    const size_t R0 = (size_t)32 * tile;
    const int t0 = (int)(R0 & 2047);
    {
        u32x4 x[NLD];
#pragma unroll
        for (int k = 0; k < NLD; ++k) { const int id = lane + 64 * k, lr = id >> 4, c16 = id & 15; const int lrc = lr < NROW ? lr : NROW - 1;
            const int back = HIST - lrc; const size_t grow = (back <= t0) ? R0 - back : R0;
            x[k] = __builtin_nontemporal_load((const u32x4*)(F.Z2 + grow * ZW + Z_XB + 128 * G + 8 * c16)); }
#pragma unroll
        for (int k = 0; k < NLD; ++k) { const int id = lane + 64 * k, lr = id >> 4, c16 = id & 15; if (lr < NROW) *(LAS u32x4*)(wl + lr * PL_STRIDE + c16 * 16) = x[k]; }
    }
    const size_t row = R0 + r; const int t = t0 + r;
    u32x2 gq[4][4];
#pragma unroll
    for (int db = 0; db < 4; ++db)
#pragma unroll
        for (int q = 0; q < 4; ++q) gq[db][q] = __builtin_nontemporal_load((const u32x2*)(F.Z2 + row * ZW + Z_GP + 128 * G + 32 * db + 8 * q + 4 * hh));
    const float icnt = 1.0f / (float)(W < t + 1 ? W : t + 1);
    LDS_WAIT();
    bf16x8 bfr[8];
#pragma unroll
    for (int s = 0; s < 8; ++s) {
        LAS unsigned char* bp = wl + (r + HIST) * PL_STRIDE + (16 * s + 8 * hh) * 2;
        float cur[8], sum[8]; unpack8(*(const LAS u32x4*)bp, cur);
#pragma unroll
        for (int jj = 0; jj < 8; ++jj) sum[jj] = cur[jj];
#pragma unroll
        for (int i = 1; i < W; ++i) { float f[8]; unpack8(*(const LAS u32x4*)(bp - i * PL_STRIDE), f); const float wgt = i <= t ? 1.f : 0.f;
#pragma unroll
            for (int jj = 0; jj < 8; ++jj) sum[jj] += wgt * f[jj]; }
#pragma unroll
        for (int jj = 0; jj < 8; ++jj) sum[jj] = sum[jj] * icnt - cur[jj];
        bfr[s] = __builtin_bit_cast(bf16x8, pack8(sum));
        __builtin_amdgcn_sched_barrier(0);
    }
    f32x16 acc[4];
#pragma unroll
    for (int db = 0; db < 4; ++db) {
#pragma unroll
        for (int i = 0; i < 16; ++i) acc[db][i] = 0.f;
        const bf16_t* ap = F.PWT + ((size_t)(l * 4 + G) * 128 + 32 * db + r) * 128 + 8 * hh;
#pragma unroll
        for (int s = 0; s < 8; ++s) acc[db] = __builtin_amdgcn_mfma_f32_32x32x16_bf16(*(const bf16x8*)(ap + 16 * s), bfr[s], acc[db], 0, 0, 0);
        __builtin_amdgcn_sched_barrier(0);
    }
#pragma unroll
    for (int db = 0; db < 4; ++db)
#pragma unroll
        for (int q = 0; q < 4; ++q) {
            const int col = 128 * G + 32 * db + 8 * q + 4 * hh;
            const f32x4 sc = *(const f32x4*)(F.pool_scale + l * 512 + col);
            float gf[4]; unpack4(gq[db][q], gf);
            u32x2 wv; wv.x = pg8::cvt_pk_bf16(acc[db][4 * q + 0] * sc[0] * gf[0], acc[db][4 * q + 1] * sc[1] * gf[1]);
            wv.y = pg8::cvt_pk_bf16(acc[db][4 * q + 2] * sc[2] * gf[2], acc[db][4 * q + 3] * sc[3] * gf[3]);
            *(u32x2*)(F.MIX + row * DM + 1024 + col) = wv;
        }
    LDS_WAIT();
}
__device__ __forceinline__ void pool_prompt(int l, int g, int tile, LAS unsigned char* wl) {
    if (g == 0) pool_unit_p<0>(l, tile, wl); else if (g == 1) pool_unit_p<1>(l, tile, wl); else if (g == 2) pool_unit_p<2>(l, tile, wl); else pool_unit_p<3>(l, tile, wl);
}
template <int G>
__device__ __forceinline__ void pool_unit_s(int l, int tile) {
    LOCAL_FRAME;
    constexpr int W = 2 << G;
    const int lane = F.lane, r = lane & 31, hh = lane >> 5;
    const size_t row = (size_t)MP + 32 * tile + r;
    const int tt = (int)(row & 3), bd = (int)((row - MP) >> 2);
    const float* stb = F.state_pool + ((size_t)l * 128 + bd) * 15 * 512;
    const float icnt = 1.0f / (float)W;
    bf16x8 bfr[8];
#pragma unroll
    for (int s = 0; s < 8; ++s) {
        const int c0 = 128 * G + 16 * s + 8 * hh;
        float sum[8], cur[8];
        {
            constexpr int NL = W < 4 ? W : 4;
            u32x4 zn[NL]; f32x4 sa[NL], sb[NL];
#pragma unroll
            for (int i = 0; i < NL; ++i) { const int back = i <= tt ? i : tt; int si = 15 + tt - i; si = si > 14 ? 14 : si;
                zn[i] = *(const u32x4*)(F.Z2 + (row - back) * ZW + Z_XB + c0); sa[i] = *(const f32x4*)(stb + si * 512 + c0); sb[i] = *(const f32x4*)(stb + si * 512 + c0 + 4); }
            unpack8(zn[0], cur);
#pragma unroll
            for (int jj = 0; jj < 8; ++jj) sum[jj] = cur[jj];
#pragma unroll
            for (int i = 1; i < NL; ++i) { float f[8]; unpack8(zn[i], f); const bool nw = i <= tt;
#pragma unroll
                for (int jj = 0; jj < 4; ++jj) { sum[jj] += nw ? f[jj] : sa[i][jj]; sum[4 + jj] += nw ? f[4 + jj] : sb[i][jj]; } }
        }
#pragma unroll
        for (int i0 = 4; i0 < W; i0 += 4) {
            f32x4 sa[4], sb[4];
#pragma unroll
            for (int i = 0; i < 4; ++i) { const int si = 15 + tt - (i0 + i); sa[i] = *(const f32x4*)(stb + si * 512 + c0); sb[i] = *(const f32x4*)(stb + si * 512 + c0 + 4); }
#pragma unroll
            for (int i = 0; i < 4; ++i)
#pragma unroll
                for (int jj = 0; jj < 4; ++jj) { sum[jj] += sa[i][jj]; sum[4 + jj] += sb[i][jj]; }
        }
#pragma unroll
        for (int jj = 0; jj < 8; ++jj) sum[jj] = sum[jj] * icnt - cur[jj];
        bfr[s] = __builtin_bit_cast(bf16x8, pack8(sum));
        __builtin_amdgcn_sched_barrier(0);
    }
    f32x16 acc[4];
#pragma unroll
    for (int db = 0; db < 4; ++db) {
#pragma unroll
        for (int i = 0; i < 16; ++i) acc[db][i] = 0.f;
        const bf16_t* ap = F.PWT + ((size_t)(l * 4 + G) * 128 + 32 * db + r) * 128 + 8 * hh;
#pragma unroll
        for (int s = 0; s < 8; ++s) acc[db] = __builtin_amdgcn_mfma_f32_32x32x16_bf16(*(const bf16x8*)(ap + 16 * s), bfr[s], acc[db], 0, 0, 0);
        __builtin_amdgcn_sched_barrier(0);
    }
#pragma unroll
    for (int db = 0; db < 4; ++db)
#pragma unroll
        for (int q = 0; q < 4; ++q) {
            const int col = 128 * G + 32 * db + 8 * q + 4 * hh;
            const f32x4 sc = *(const f32x4*)(F.pool_scale + l * 512 + col);
            float gf[4]; unpack4(*(const u32x2*)(F.Z2 + row * ZW + Z_GP + col), gf);
            u32x2 wv; wv.x = pg8::cvt_pk_bf16(acc[db][4 * q + 0] * sc[0] * gf[0], acc[db][4 * q + 1] * sc[1] * gf[1]);
            wv.y = pg8::cvt_pk_bf16(acc[db][4 * q + 2] * sc[2] * gf[2], acc[db][4 * q + 3] * sc[3] * gf[3]);
            *(u32x2*)(F.MIX + row * DM + 1024 + col) = wv;
        }
}
__device__ __forceinline__ void pool_sample(int l, int g, int tile) {
    if (g == 0) pool_unit_s<0>(l, tile); else if (g == 1) pool_unit_s<1>(l, tile); else if (g == 2) pool_unit_s<2>(l, tile); else pool_unit_s<3>(l, tile);
}

struct SguOps { bf16x8 wB[8], wA[4]; u32x2 uu[2][4], gg[2][4]; float bias[2], rsw[2]; };
__device__ __forceinline__ void sgu_load_ops(SguOps& o, const Frame& F, int l, int hd, size_t R0, int r, int hh, int db, int tbA, int tbB) {
    const bf16_t* Wb = F.SGUW + (size_t)(l * 4 + hd) * 128 * 128;
#pragma unroll
    for (int s = 0; s < 8; ++s) { o.wB[s] = (bf16x8){0, 0, 0, 0, 0, 0, 0, 0}; if (s < 2 * (tbB + 1)) o.wB[s] = *(const bf16x8*)(Wb + (32 * tbB + r) * 128 + 16 * s + 8 * hh); }
#pragma unroll
    for (int s = 0; s < 4; ++s) { o.wA[s] = (bf16x8){0, 0, 0, 0, 0, 0, 0, 0}; if (s < 2 * (tbA + 1)) o.wA[s] = *(const bf16x8*)(Wb + (32 * tbA + r) * 128 + 16 * s + 8 * hh); }
#pragma unroll
    for (int pass = 0; pass < 2; ++pass) { const int tb = pass ? tbB : tbA; const size_t row = R0 + 32 * tb + r;
        o.bias[pass] = F.sgu_b[l * 512 + hd * 128 + 32 * tb + r]; o.rsw[pass] = F.RSW[(l * 4 + hd) * 128 + 32 * tb + r];
#pragma unroll
        for (int q = 0; q < 4; ++q) { const int col = 128 * hd + 32 * db + 8 * q + 4 * hh;
            o.uu[pass][q] = __builtin_nontemporal_load((const u32x2*)(F.Z2 + row * ZW + Z_U + col)); o.gg[pass][q] = __builtin_nontemporal_load((const u32x2*)(F.Z2 + row * ZW + Z_GS + col)); } }
}
__device__ __forceinline__ void sgu_mfma(const SguOps& o, LAS bf16_t* VnT, int h2, int r, int hh, int db, int tbA, int tbB, f32x16& accA, f32x16& accB) {
#pragma unroll
    for (int i = 0; i < 16; ++i) { accA[i] = 0.f; accB[i] = 0.f; }
#pragma unroll
    for (int s = 0; s < 8; ++s) {
        if (s < 2 * (tbB + 1)) {
            const LAS unsigned char* ap = (const LAS unsigned char*)VnT + (h2 * 128 + 16 * s + 8 * hh + ((r & 15) >> 2)) * 320 + (32 * db + (r & 16) + 4 * (r & 3)) * 2;
            const v4i16_t lo = __builtin_amdgcn_ds_read_tr16_b64_v4i16((LAS v4i16_t*)ap), hi = __builtin_amdgcn_ds_read_tr16_b64_v4i16((LAS v4i16_t*)(ap + 4 * 320));
            const bf16x8 a = (bf16x8){lo[0], lo[1], lo[2], lo[3], hi[0], hi[1], hi[2], hi[3]};
            accB = __builtin_amdgcn_mfma_f32_32x32x16_bf16(a, o.wB[s], accB, 0, 0, 0);
            if (s < 4) { if (s < 2 * (tbA + 1)) accA = __builtin_amdgcn_mfma_f32_32x32x16_bf16(a, o.wA[s], accA, 0, 0, 0); }
        }
    }
}
__device__ __forceinline__ void sgu_epi(const SguOps& o, const Frame& F, int l, int hd, size_t R0, int r, int hh, int db, int tbA, int tbB, const f32x16& accA, const f32x16& accB) {
    f32x4 lg[4], lb[4];
#pragma unroll
    for (int q = 0; q < 4; ++q) { const int col = 128 * hd + 32 * db + 8 * q + 4 * hh; lg[q] = *(const f32x4*)(F.ln_g + l * 512 + col); lb[q] = *(const f32x4*)(F.ln_b + l * 512 + col); }
#pragma unroll
    for (int pass = 0; pass < 2; ++pass) {
        const int tb = pass ? tbB : tbA; const f32x16 acc = pass ? accB : accA;
        const size_t row = R0 + 32 * tb + r; const float bs = o.bias[pass], rs = o.rsw[pass];
#pragma unroll
        for (int q = 0; q < 4; ++q) { const int col = 128 * hd + 32 * db + 8 * q + 4 * hh;
            float uf[4], gf[4]; unpack4(o.uu[pass][q], uf); unpack4(o.gg[pass][q], gf);
            float m[4];
#pragma unroll
            for (int e = 0; e < 4; ++e) m[e] = (lg[q][e] * acc[4 * q + e] + lb[q][e] * rs + bs) * uf[e] * gf[e];
            u32x2 wo; wo.x = pg8::cvt_pk_bf16(m[0], m[1]); wo.y = pg8::cvt_pk_bf16(m[2], m[3]);
            *(u32x2*)(F.MIX + row * DM + 1536 + col) = wo; }
    }
}
__device__ __forceinline__ void sgu_unit(int l, int ci, int hp, LAS unsigned char* ring) {
    LOCAL_FRAME;
    LAS bf16_t* VnT = (LAS bf16_t*)ring;
    const int lane = F.lane, wv = F.wave;
    const size_t R0 = (size_t)128 * ci;
    const int r = lane & 31, hh = lane >> 5, db = wv & 3; const int tbA = (wv >> 2) ? 1 : 0, tbB = (wv >> 2) ? 2 : 3;
    SguOps op0;
    {
        const int tl = lane >> 2, q4 = lane & 3;
        const bf16_t* vrow = F.Z2 + (R0 + 16 * wv + tl) * ZW + Z_VS + 32 * q4;
        u32x4 x[4][4];
#pragma unroll
        for (int h = 0; h < 4; ++h)
#pragma unroll
            for (int i = 0; i < 4; ++i) x[h][i] = *(const u32x4*)(vrow + 128 * h + 8 * i);
        sgu_load_ops(op0, F, l, 2 * hp, R0, r, hh, db, tbA, tbB);
        float s = 0.f, ss = 0.f;
#pragma unroll
        for (int h = 0; h < 4; ++h)
#pragma unroll
            for (int i = 0; i < 4; ++i) { float f[8]; unpack8(x[h][i], f);
#pragma unroll
                for (int jj = 0; jj < 8; ++jj) { s += f[jj]; ss += f[jj] * f[jj]; } }
        s += __shfl_xor(s, 1); s += __shfl_xor(s, 2); ss += __shfl_xor(ss, 1); ss += __shfl_xor(ss, 2);
        const float mean = s * (1.0f / 512.0f), var = ss * (1.0f / 512.0f) - mean * mean, rstd = rsqrtf(var + EPS);
#pragma unroll
        for (int h2 = 0; h2 < 2; ++h2)
#pragma unroll
            for (int i = 0; i < 4; ++i) { const int d = 32 * q4 + 8 * i;
                const u32x4 xv = hp ? x[2 + h2][i] : x[h2][i];
                float f[8]; unpack8(xv, f);
#pragma unroll
                for (int jj = 0; jj < 8; ++jj) f[jj] = (f[jj] - mean) * rstd;
                *(LAS u32x4*)((LAS unsigned char*)VnT + (h2 * 128 + 16 * wv + tl) * 320 + d * 2) = pack8(f); }
    }
    LDS_WAIT();
    __syncthreads();
    f32x16 accA, accB;
    sgu_mfma(op0, VnT, 0, r, hh, db, tbA, tbB, accA, accB);
    SguOps op1;
    sgu_load_ops(op1, F, l, 2 * hp + 1, R0, r, hh, db, tbA, tbB);
    sgu_epi(op0, F, l, 2 * hp, R0, r, hh, db, tbA, tbB, accA, accB);
    sgu_mfma(op1, VnT, 1, r, hh, db, tbA, tbB, accA, accB);
    sgu_epi(op1, F, l, 2 * hp + 1, R0, r, hh, db, tbA, tbB, accA, accB);
    __syncthreads();
}

__device__ __forceinline__ void samp_attn(int l, int bd, int kvh, LAS unsigned char* wl) {
    LOCAL_FRAME;
    LAS float* ps = (LAS float*)wl;
    LAS float* invs = ps + 144 * 16;
    const int lane = F.lane, fr = lane & 15, fq = lane >> 4, gq = fr >> 2, tt = fr & 3;
    float* oKs = F.out + O_KS + (size_t)l * LS_KS; float* oVs = F.out + O_VS + (size_t)l * LS_KS;
    bf16x8 qfr[2];
    {
        const bf16_t* qsrc = F.Qc + ((size_t)MP + 4 * bd + tt) * 1024 + (4 * kvh + gq) * 64 + 16 * fq;
        const u32x4 qa = *(const u32x4*)qsrc, qb = *(const u32x4*)(qsrc + 8);
        u32x4 lo, hi;
        lo.x = (qa.x & 0xffffu) | (qa.y << 16); lo.y = (qa.z & 0xffffu) | (qa.w << 16); lo.z = (qb.x & 0xffffu) | (qb.y << 16); lo.w = (qb.z & 0xffffu) | (qb.w << 16);
        hi.x = (qa.x >> 16) | (qa.y & 0xffff0000u); hi.y = (qa.z >> 16) | (qa.w & 0xffff0000u); hi.z = (qb.x >> 16) | (qb.y & 0xffff0000u); hi.w = (qb.z >> 16) | (qb.w & 0xffff0000u);
        qfr[0] = __builtin_bit_cast(bf16x8, lo); qfr[1] = __builtin_bit_cast(bf16x8, hi);
    }
    const float* kc = F.cache_k + (((size_t)l * 128 + bd) * 128) * 256 + kvh * 64 + 8 * fq;
    const float* kn = oKs + (((size_t)bd * 128 + 124 + (fr & 3)) * 4 + kvh) * 64 + 8 * fq;
    float* kd = oKs + ((size_t)bd * 128 * 4 + kvh) * 64 + 8 * fq;
    f32x4 S[9];
#pragma unroll
    for (int T = 0; T < 9; ++T) S[T] = (f32x4){0.f, 0.f, 0.f, 0.f};
#pragma unroll
    for (int T0 = 0; T0 < 9; T0 += 3) {
        f32x4 x[3][2][2];
#pragma unroll
        for (int u = 0; u < 3; ++u) { const int T = T0 + u; const float* src = (T < 8) ? kc + (size_t)(16 * T + fr) * 256 : kn;
#pragma unroll
            for (int ks = 0; ks < 2; ++ks) { x[u][ks][0] = __builtin_nontemporal_load((const f32x4*)(src + 32 * ks)); x[u][ks][1] = __builtin_nontemporal_load((const f32x4*)(src + 32 * ks + 4)); } }
#pragma unroll
        for (int u = 0; u < 3; ++u) { const int T = T0 + u; const int key = 16 * T + fr;
            if (T < 8 && key >= 4) {
#pragma unroll
                for (int ks = 0; ks < 2; ++ks) { float* dst = kd + (size_t)(key - 4) * 256 + 32 * ks; __builtin_nontemporal_store(x[u][ks][0], (f32x4*)dst); __builtin_nontemporal_store(x[u][ks][1], (f32x4*)(dst + 4)); } } }
#pragma unroll
        for (int u = 0; u < 3; ++u)
#pragma unroll
            for (int ks = 0; ks < 2; ++ks) { u32x4 w; w.x = pg8::cvt_pk_bf16(x[u][ks][0][0], x[u][ks][0][1]); w.y = pg8::cvt_pk_bf16(x[u][ks][0][2], x[u][ks][0][3]);
                w.z = pg8::cvt_pk_bf16(x[u][ks][1][0], x[u][ks][1][1]); w.w = pg8::cvt_pk_bf16(x[u][ks][1][2], x[u][ks][1][3]);
                S[T0 + u] = __builtin_amdgcn_mfma_f32_16x16x32_bf16(__builtin_bit_cast(bf16x8, w), qfr[ks], S[T0 + u], 0, 0, 0); }
        __builtin_amdgcn_sched_barrier(0);
    }
    const float sink2 = F.sinks[l * 16 + 4 * kvh + gq] * LOG2E;
    float m = sink2;
#pragma unroll
    for (int T = 0; T < 9; ++T)
#pragma unroll
        for (int rg = 0; rg < 4; ++rg) { const int key = 16 * T + 4 * fq + rg; const bool ok = (T < 8) ? (key >= tt + 1) : (fq == 0 && rg <= tt);
            S[T][rg] = ok ? S[T][rg] : -INFINITY; m = fmaxf(m, S[T][rg]); }
    m = fmaxf(m, __shfl_xor(m, 16)); m = fmaxf(m, __shfl_xor(m, 32));
    float sum = 0.f;
#pragma unroll
    for (int T = 0; T < 9; ++T)
#pragma unroll
        for (int rg = 0; rg < 4; ++rg) { const float p = __builtin_amdgcn_exp2f(S[T][rg] - m); sum += p; ps[(16 * T + 4 * fq + rg) * 16 + fr] = p; }
    sum += __shfl_xor(sum, 16); sum += __shfl_xor(sum, 32);
    if (fq == 0) invs[fr] = 1.0f / (sum + __builtin_amdgcn_exp2f(sink2 - m));
    LDS_WAIT();
    const int kq = lane >> 4, dq = lane & 15;
    const float* vcp = F.cache_v + (((size_t)l * 128 + bd) * 128 + kq) * 256 + kvh * 64 + 4 * dq;
    float* vop = oVs + ((size_t)bd * 128 + kq) * 256 + kvh * 64 + 4 * dq;
#pragma unroll 1
    for (int pass = 0; pass < 2; ++pass) {
        float o[8][4];
#pragma unroll
        for (int q = 0; q < 8; ++q) { o[q][0] = 0.f; o[q][1] = 0.f; o[q][2] = 0.f; o[q][3] = 0.f; }
#pragma unroll 1
        for (int blk = 0; blk < 3; ++blk) {
            f32x4 vx[11];
#pragma unroll
            for (int ii = 0; ii < 11; ++ii) { const int i = blk * 11 + ii; const float* src = (i < 32) ? vcp + (size_t)i * 1024 : vop + (size_t)31 * 1024; vx[ii] = __builtin_nontemporal_load((const f32x4*)src); }
            if (pass == 0) {
#pragma unroll
                for (int ii = 0; ii < 11; ++ii) { const int i = blk * 11 + ii; if (i >= 1 && i < 32) __builtin_nontemporal_store(vx[ii], (f32x4*)(vop + (size_t)(i - 1) * 1024)); } }
#pragma unroll
            for (int ii = 0; ii < 11; ++ii) { const int key = 4 * (blk * 11 + ii) + kq;
                const f32x4 pa = *(const LAS f32x4*)(ps + key * 16 + 8 * pass), pb = *(const LAS f32x4*)(ps + key * 16 + 8 * pass + 4);
#pragma unroll
                for (int e = 0; e < 4; ++e) { o[0][e] += pa[0] * vx[ii][e]; o[1][e] += pa[1] * vx[ii][e]; o[2][e] += pa[2] * vx[ii][e]; o[3][e] += pa[3] * vx[ii][e];
                    o[4][e] += pb[0] * vx[ii][e]; o[5][e] += pb[1] * vx[ii][e]; o[6][e] += pb[2] * vx[ii][e]; o[7][e] += pb[3] * vx[ii][e]; }
                __builtin_amdgcn_sched_barrier(0); }
        }
#pragma unroll
        for (int q = 0; q < 8; ++q)
#pragma unroll
            for (int e = 0; e < 4; ++e) { float v = o[q][e]; v += __shfl_xor(v, 16); v += __shfl_xor(v, 32); o[q][e] = v; }
#pragma unroll
        for (int q = 0; q < 8; ++q) if ((q >> 1) == kq) { const int qq = 8 * pass + q, t2 = qq & 3, head = 4 * kvh + (qq >> 2); const size_t row = (size_t)MP + 4 * bd + t2;
            float gf[4]; unpack4(*(const u32x2*)(F.Z2 + row * ZW + Z_GA + head * 64 + 4 * dq), gf);
            const float iq = invs[qq];
            u32x2 wv; wv.x = pg8::cvt_pk_bf16(o[q][0] * iq * gf[0], o[q][1] * iq * gf[1]); wv.y = pg8::cvt_pk_bf16(o[q][2] * iq * gf[2], o[q][3] * iq * gf[3]);
            *(u32x2*)(F.MIX + row * DM + head * 64 + 4 * dq) = wv; }
    }
    LDS_WAIT();
}
__device__ __forceinline__ void samp_sgu(int l, int bd) {
    LOCAL_FRAME;
    const int lane = F.lane, c0 = 8 * lane, hd = lane >> 4;
    {
        float* oPs = F.out + O_PS + (size_t)l * LS_PS + (size_t)bd * 15 * 512; const float* sp = F.state_pool + (size_t)l * LS_PS + (size_t)bd * 15 * 512 + 4 * 512;
        f32x4 cp[22];
#pragma unroll
        for (int k = 0; k < 22; ++k) cp[k] = __builtin_nontemporal_load((const f32x4*)(sp + 4 * (lane + 64 * k)));
#pragma unroll
        for (int k = 0; k < 22; ++k) __builtin_nontemporal_store(cp[k], (f32x4*)(oPs + 4 * (lane + 64 * k)));
    }
    float* oCV = F.out + O_CV + (size_t)l * LS_CV;
    float gl[8], bl[8];
#pragma unroll
    for (int j = 0; j < 8; ++j) { gl[j] = F.ln_g[l * 512 + c0 + j]; bl[j] = F.ln_b[l * 512 + c0 + j]; }
    u32x4 xr[4], ur[4], gr[4];
#pragma unroll
    for (int tt = 0; tt < 4; ++tt) { const size_t row = (size_t)MP + 4 * bd + tt; xr[tt] = *(const u32x4*)(F.Z2 + row * ZW + Z_VS + c0); ur[tt] = *(const u32x4*)(F.Z2 + row * ZW + Z_U + c0); gr[tt] = *(const u32x4*)(F.Z2 + row * ZW + Z_GS + c0); }
    float vn[4][8];
#pragma unroll
    for (int tt = 0; tt < 4; ++tt) { float f[8]; unpack8(xr[tt], f);
        float s = 0.f, ss = 0.f;
#pragma unroll
        for (int j = 0; j < 8; ++j) { s += f[j]; ss += f[j] * f[j]; }
        s = wave_sum(s); ss = wave_sum(ss);
        const float mean = s * (1.0f / 512.0f), var = ss * (1.0f / 512.0f) - mean * mean, rstd = rsqrtf(var + EPS);
#pragma unroll
        for (int j = 0; j < 8; ++j) vn[tt][j] = (f[j] - mean) * rstd * gl[j] + bl[j];
        float* o = oCV + ((size_t)bd * 4 + tt) * 512 + c0;
        *(f32x4*)o = (f32x4){vn[tt][0], vn[tt][1], vn[tt][2], vn[tt][3]}; *(f32x4*)(o + 4) = (f32x4){vn[tt][4], vn[tt][5], vn[tt][6], vn[tt][7]}; }
#pragma unroll
    for (int tt = 0; tt < 4; ++tt) { const size_t row = (size_t)MP + 4 * bd + tt;
        float mx[8]; const float bias = F.sgu_b[l * 512 + hd * 128 + tt];
#pragma unroll
        for (int j = 0; j < 8; ++j) mx[j] = bias;
#pragma unroll
        for (int s2 = 0; s2 < 4; ++s2) if (s2 <= tt) { const float w = F.sgu_w[((size_t)(l * 4 + hd) * 128 + tt) * 128 + s2];
#pragma unroll
            for (int j = 0; j < 8; ++j) mx[j] += w * vn[s2][j]; }
        float uf[8], gf[8]; unpack8(ur[tt], uf); unpack8(gr[tt], gf);
#pragma unroll
        for (int j = 0; j < 8; ++j) mx[j] = mx[j] * uf[j] * gf[j];
        *(u32x4*)(F.MIX + row * DM + 1536 + c0) = pack8(mx); }
}

#ifdef HYBRID
__device__ __forceinline__ void attn_task_o(const Frame& F, int l, int b, int nb, int head, int qs, LAS unsigned char* wl) {
    const int lane = F.lane, r = lane & 31, hh = lane >> 5, kvh = head >> 2;
    LAS float* wsf = (LAS float*)wl; LAS bf16_t* stg = (LAS bf16_t*)(wl + 256);
    const int t0 = 128 * nb + 32 * qs;
    const size_t qrow0 = (size_t)b * 2048 + t0;
    const bf16_t* qp = F.Qc + (qrow0 + r) * 1024 + head * 64 + 8 * hh;
    bf16x8 qf[4];
#pragma unroll
    for (int s = 0; s < 4; ++s) qf[s] = *(const bf16x8*)(qp + 16 * s);
    const bf16_t* kbase = F.Kc + (size_t)(b * 4 + kvh) * 2048 * 64;
    const bf16_t* vbase = F.VTP + (size_t)(b * 4 + kvh) * 64 * 2048;
    const int cmin = (nb > 0) ? 0 : (4 - qs);
    f32x16 S[5];
#pragma unroll
    for (int c = 0; c < 5; ++c) {
        f32x16 a;
#pragma unroll
        for (int i = 0; i < 16; ++i) a[i] = 0.f;
        if (c >= cmin) {
            const bf16_t* kp = kbase + (size_t)(t0 - 128 + 32 * c + r) * 64 + 8 * hh;
#pragma unroll
            for (int s = 0; s < 4; ++s) a = __builtin_amdgcn_mfma_f32_32x32x16_bf16(*(const bf16x8*)(kp + 16 * s), qf[s], a, 0, 0, 0);
        }
        S[c] = a;
    }
    const float NEG = -INFINITY;
#pragma unroll
    for (int i = 0; i < 16; ++i) { const int kap = crow(i, hh); if (kap <= r) S[0][i] = NEG; if (kap > r) S[4][i] = NEG; }
    const float sink2 = F.sinks[l * 16 + head] * LOG2E;
    float m = sink2;
#pragma unroll
    for (int c = 0; c < 5; ++c) if (c >= cmin) {
#pragma unroll
        for (int i = 0; i < 16; ++i) m = fmaxf(m, S[c][i]); }
    m = fmaxf(m, __shfl_xor(m, 32));
    float sum = 0.f;
#pragma unroll
    for (int c = 0; c < 5; ++c) if (c >= cmin) {
#pragma unroll
        for (int i = 0; i < 16; ++i) { const float p = __builtin_amdgcn_exp2f(S[c][i] - m); S[c][i] = p; sum += p; } }
    sum += __shfl_xor(sum, 32);
    const float inv = 1.0f / (sum + __builtin_amdgcn_exp2f(sink2 - m));
    f32x16 o[2];
#pragma unroll
    for (int i = 0; i < 16; ++i) { o[0][i] = 0.f; o[1][i] = 0.f; }
#pragma unroll
    for (int c = 0; c < 5; ++c) if (c >= cmin) {
        const bf16_t* vt = vbase + (size_t)((t0 - 128 + 32 * c) >> 5) * 2048 + r * 32 + 16 * hh;
#pragma unroll
        for (int s = 0; s < 2; ++s) {
            u32x4 pw; pw.x = pg8::cvt_pk_bf16(S[c][8 * s + 0], S[c][8 * s + 1]); pw.y = pg8::cvt_pk_bf16(S[c][8 * s + 2], S[c][8 * s + 3]);
            pw.z = pg8::cvt_pk_bf16(S[c][8 * s + 4], S[c][8 * s + 5]); pw.w = pg8::cvt_pk_bf16(S[c][8 * s + 6], S[c][8 * s + 7]);
            const bf16x8 pa = __builtin_bit_cast(bf16x8, pw);
#pragma unroll
            for (int db = 0; db < 2; ++db) o[db] = __builtin_amdgcn_mfma_f32_32x32x16_bf16(pa, *(const bf16x8*)(vt + db * 1024 + 8 * s), o[db], 0, 0, 0);
        }
    }
    if (hh == 0) wsf[r] = inv;
    LDS_WAIT();
#pragma unroll
    for (int i = 0; i < 16; ++i) { const int q = crow(i, hh); const float rl = wsf[q];
        stg[q * 64 + r] = (bf16_t)(pg8::cvt_pk_bf16(o[0][i] * rl, 0.f) & 0xffffu);
        stg[q * 64 + 32 + r] = (bf16_t)(pg8::cvt_pk_bf16(o[1][i] * rl, 0.f) & 0xffffu); }
    LDS_WAIT();
#pragma unroll
    for (int i = 0; i < 4; ++i) { const int row = i * 8 + (lane >> 3), ch = lane & 7;
        const u32x4 ov = *(const LAS u32x4*)(stg + row * 64 + ch * 8);
        const u32x4 gv = *(const u32x4*)(F.Z2 + (qrow0 + row) * ZW + Z_GA + head * 64 + ch * 8);
        float of[8], gf[8]; unpack8(ov, of); unpack8(gv, gf);
#pragma unroll
        for (int j = 0; j < 8; ++j) of[j] *= gf[j];
        *(u32x4*)(F.MIX + (qrow0 + row) * DM + head * 64 + ch * 8) = pack8(of); }
    LDS_WAIT();
}

template <bool SAMPLE>
__device__ __forceinline__ void pool_unit_o(const Frame& F, int l, int g, int tile) {
    const int lane = F.lane, r = lane & 31, hh = lane >> 5, w = 2 << g;
    const size_t row = (size_t)(SAMPLE ? MP : 0) + 32 * tile + r;
    const int t = SAMPLE ? (int)(row & 3) : (int)(row & 2047);
    const int bd = SAMPLE ? (int)((row - MP) >> 2) : 0;
    const float icnt = SAMPLE ? 1.0f / (float)w : 1.0f / (float)(w < t + 1 ? w : t + 1);
    bf16x8 bfr[8];
#pragma unroll
    for (int s = 0; s < 8; ++s) {
        const int c0 = 128 * g + 16 * s + 8 * hh;
        float sum[8], cur[8];
#pragma unroll
        for (int j = 0; j < 8; ++j) { sum[j] = 0.f; cur[j] = 0.f; }
        for (int i = 0; i < w; ++i) {
            float f[8];
            const int e = t - i;
            if (e >= 0) { unpack8(*(const u32x4*)(F.Z2 + (row - i) * ZW + Z_XB + c0), f); }
            else if (SAMPLE) { const float* sp = F.state_pool + (((size_t)l * 128 + bd) * 15 + 15 + e) * 512 + c0;
                const f32x4 a = *(const f32x4*)sp, bq = *(const f32x4*)(sp + 4); f[0] = a[0]; f[1] = a[1]; f[2] = a[2]; f[3] = a[3]; f[4] = bq[0]; f[5] = bq[1]; f[6] = bq[2]; f[7] = bq[3]; }
            else {
#pragma unroll
                for (int j = 0; j < 8; ++j) f[j] = 0.f; }
#pragma unroll
            for (int j = 0; j < 8; ++j) sum[j] += f[j];
            if (i == 0) {
#pragma unroll
                for (int j = 0; j < 8; ++j) cur[j] = f[j]; }
        }
        float pf[8];
#pragma unroll
        for (int j = 0; j < 8; ++j) pf[j] = sum[j] * icnt - cur[j];
        bfr[s] = __builtin_bit_cast(bf16x8, pack8(pf));
    }
    f32x16 acc[4];
#pragma unroll
    for (int db = 0; db < 4; ++db) {
#pragma unroll
        for (int i = 0; i < 16; ++i) acc[db][i] = 0.f;
        const bf16_t* ap = F.PWT + ((size_t)(l * 4 + g) * 128 + 32 * db + r) * 128 + 8 * hh;
#pragma unroll
        for (int s = 0; s < 8; ++s) acc[db] = __builtin_amdgcn_mfma_f32_32x32x16_bf16(*(const bf16x8*)(ap + 16 * s), bfr[s], acc[db], 0, 0, 0);
    }
#pragma unroll
    for (int db = 0; db < 4; ++db)
#pragma unroll
        for (int q = 0; q < 4; ++q) {
            const int col = 128 * g + 32 * db + 8 * q + 4 * hh;
            const f32x4 sc = *(const f32x4*)(F.pool_scale + l * 512 + col);
            float gf[4]; unpack4(*(const u32x2*)(F.Z2 + row * ZW + Z_GP + col), gf);
            u32x2 wv; wv.x = pg8::cvt_pk_bf16(acc[db][4 * q + 0] * sc[0] * gf[0], acc[db][4 * q + 1] * sc[1] * gf[1]);
            wv.y = pg8::cvt_pk_bf16(acc[db][4 * q + 2] * sc[2] * gf[2], acc[db][4 * q + 3] * sc[3] * gf[3]);
            *(u32x2*)(F.MIX + row * DM + 1024 + col) = wv;
        }
}

__device__ __forceinline__ void sgu_unit_o(const Frame& F, int l, int ci, int hd, LAS unsigned char* ring) {
    LAS bf16_t* VnT = (LAS bf16_t*)ring;
    const int lane = F.lane, wv = F.wave;
    const size_t R0 = (size_t)128 * ci;
    {
        const int tl = lane >> 2, q4 = lane & 3;
        const bf16_t* vrow = F.Z2 + (R0 + 16 * wv + tl) * ZW + Z_VS;
        float s = 0.f, ss = 0.f;
#pragma unroll
        for (int i = 0; i < 16; ++i) { float f[8]; unpack8(*(const u32x4*)(vrow + 128 * q4 + 8 * i), f);
#pragma unroll
            for (int j = 0; j < 8; ++j) { s += f[j]; ss += f[j] * f[j]; } }
        s += __shfl_xor(s, 1); s += __shfl_xor(s, 2); ss += __shfl_xor(ss, 1); ss += __shfl_xor(ss, 2);
        const float mean = s * (1.0f / 512.0f), var = ss * (1.0f / 512.0f) - mean * mean, rstd = rsqrtf(var + EPS);
#pragma unroll
        for (int i = 0; i < 4; ++i) { const int d = 32 * q4 + 8 * i; float f[8]; unpack8(*(const u32x4*)(vrow + 128 * hd + d), f);
            const float* gp = F.ln_g + l * 512 + 128 * hd + d; const float* bp = F.ln_b + l * 512 + 128 * hd + d;
#pragma unroll
            for (int j = 0; j < 8; ++j) { const float vn = (f[j] - mean) * rstd * gp[j] + bp[j];
                VnT[(d + j) * 136 + 16 * wv + tl] = (bf16_t)(pg8::cvt_pk_bf16(vn, 0.f) & 0xffffu); } }
    }
    __syncthreads();
    {
        const int r = lane & 31, hh = lane >> 5, db = wv & 3; const int tbA = (wv >> 2) ? 1 : 0, tbB = (wv >> 2) ? 2 : 3;
        f32x16 accA, accB;
#pragma unroll
        for (int i = 0; i < 16; ++i) { accA[i] = 0.f; accB[i] = 0.f; }
        const bf16_t* Wb = F.SGUW + (size_t)(l * 4 + hd) * 128 * 128;
#pragma unroll
        for (int s = 0; s < 8; ++s) {
            if (s < 2 * (tbB + 1)) {
                const bf16x8 a = *(const LAS bf16x8*)(VnT + (32 * db + r) * 136 + 16 * s + 8 * hh);
                accB = __builtin_amdgcn_mfma_f32_32x32x16_bf16(a, *(const bf16x8*)(Wb + (32 * tbB + r) * 128 + 16 * s + 8 * hh), accB, 0, 0, 0);
                if (s < 2 * (tbA + 1)) accA = __builtin_amdgcn_mfma_f32_32x32x16_bf16(a, *(const bf16x8*)(Wb + (32 * tbA + r) * 128 + 16 * s + 8 * hh), accA, 0, 0, 0);
            }
        }
#pragma unroll
        for (int pass = 0; pass < 2; ++pass) {
            const int tb = pass ? tbB : tbA; const f32x16 acc = pass ? accB : accA;
            const int t = 32 * tb + r; const size_t row = R0 + t; const float bias = F.sgu_b[l * 512 + hd * 128 + t];
#pragma unroll
            for (int q = 0; q < 4; ++q) { const int col = 128 * hd + 32 * db + 8 * q + 4 * hh;
                float uf[4], gf[4]; unpack4(*(const u32x2*)(F.Z2 + row * ZW + Z_U + col), uf); unpack4(*(const u32x2*)(F.Z2 + row * ZW + Z_GS + col), gf);
                u32x2 wo; wo.x = pg8::cvt_pk_bf16((acc[4 * q + 0] + bias) * uf[0] * gf[0], (acc[4 * q + 1] + bias) * uf[1] * gf[1]);
                wo.y = pg8::cvt_pk_bf16((acc[4 * q + 2] + bias) * uf[2] * gf[2], (acc[4 * q + 3] + bias) * uf[3] * gf[3]);
                *(u32x2*)(F.MIX + row * DM + 1536 + col) = wo; }
        }
    }
    __syncthreads();
}

__device__ __forceinline__ void samp_attn_o(const Frame& F, int l, int bd, int kvh, LAS unsigned char* wl) {
    LAS float* qs = (LAS float*)wl;
    LAS float* ps = (LAS float*)(wl + 4096);
    const int lane = F.lane;
    float* oKs = F.out + O_KS + (size_t)l * LS_KS; float* oVs = F.out + O_VS + (size_t)l * LS_KS;
    {
        const int qi = lane >> 2, part = lane & 3, gq = qi >> 2, tt = qi & 3;
        const bf16_t* src = F.Qc + ((size_t)MP + 4 * bd + tt) * 1024 + (4 * kvh + gq) * 64 + 16 * part;
        float f0[8], f1[8]; unpack8(*(const u32x4*)src, f0); unpack8(*(const u32x4*)(src + 8), f1);
#pragma unroll
        for (int j = 0; j < 8; ++j) { const int p0 = 16 * part + j, p1 = p0 + 8;
            qs[qi * 64 + (p0 >> 1) + 32 * (p0 & 1)] = f0[j]; qs[qi * 64 + (p1 >> 1) + 32 * (p1 & 1)] = f1[j]; }
    }
    LDS_WAIT();
    float s0[16], s1[16], s2[16];
#pragma unroll
    for (int q = 0; q < 16; ++q) { s0[q] = 0.f; s1[q] = 0.f; s2[q] = 0.f; }
    const float* k0p = F.cache_k + (((size_t)l * 128 + bd) * 128 + lane) * 256 + kvh * 64;
    const float* k1p = k0p + 64 * 256;
    const float* k2p = oKs + (((size_t)bd * 128 + 124 + (lane & 3)) * 4 + kvh) * 64;
    float* c0p = oKs + (((size_t)bd * 128 + (lane >= 4 ? lane - 4 : 0)) * 4 + kvh) * 64;
    float* c1p = oKs + (((size_t)bd * 128 + lane + 60) * 4 + kvh) * 64;
    for (int ch = 0; ch < 16; ++ch) {
        const f32x4 kx0 = *(const f32x4*)(k0p + 4 * ch), kx1 = *(const f32x4*)(k1p + 4 * ch), kx2 = *(const f32x4*)(k2p + 4 * ch);
        if (lane >= 4) *(f32x4*)(c0p + 4 * ch) = kx0;
        *(f32x4*)(c1p + 4 * ch) = kx1;
#pragma unroll
        for (int q = 0; q < 16; ++q) { const f32x4 qv = *(const LAS f32x4*)(qs + q * 64 + 4 * ch);
            s0[q] += (qv[0] * kx0[0] + qv[1] * kx0[1]) + (qv[2] * kx0[2] + qv[3] * kx0[3]);
            s1[q] += (qv[0] * kx1[0] + qv[1] * kx1[1]) + (qv[2] * kx1[2] + qv[3] * kx1[3]);
            s2[q] += (qv[0] * kx2[0] + qv[1] * kx2[1]) + (qv[2] * kx2[2] + qv[3] * kx2[3]); }
    }
    float inv[16];
#pragma unroll
    for (int q = 0; q < 16; ++q) {
        const int tt = q & 3; const float sink2 = F.sinks[l * 16 + 4 * kvh + (q >> 2)] * LOG2E;
        const bool v0 = lane >= tt + 1, v2 = (lane < 4) && (lane <= tt);
        float m = s1[q]; if (v0) m = fmaxf(m, s0[q]); if (v2) m = fmaxf(m, s2[q]);
        m = fmaxf(wave_max(m), sink2);
        const float p0 = v0 ? __builtin_amdgcn_exp2f(s0[q] - m) : 0.f, p1 = __builtin_amdgcn_exp2f(s1[q] - m), p2 = v2 ? __builtin_amdgcn_exp2f(s2[q] - m) : 0.f;
        const float sum = wave_sum(p0 + p1 + p2);
        inv[q] = 1.0f / (sum + __builtin_amdgcn_exp2f(sink2 - m));
        ps[lane * 16 + q] = p0; ps[(lane + 64) * 16 + q] = p1; if (lane < 4) ps[(128 + lane) * 16 + q] = p2;
    }
    LDS_WAIT();
    float o[16];
#pragma unroll
    for (int q = 0; q < 16; ++q) o[q] = 0.f;
    const float* vcp = F.cache_v + (((size_t)l * 128 + bd) * 128) * 256 + kvh * 64 + lane;
    float* vop = oVs + ((size_t)bd * 128) * 256 + kvh * 64 + lane;
    for (int key = 0; key < 132; ++key) {
        float v;
        if (key < 128) { v = vcp[(size_t)key * 256]; if (key >= 4) vop[(size_t)(key - 4) * 256] = v; }
        else v = vop[(size_t)(key - 4) * 256];
#pragma unroll
        for (int q4 = 0; q4 < 4; ++q4) { const f32x4 pv = *(const LAS f32x4*)(ps + key * 16 + 4 * q4);
            o[4 * q4 + 0] += pv[0] * v; o[4 * q4 + 1] += pv[1] * v; o[4 * q4 + 2] += pv[2] * v; o[4 * q4 + 3] += pv[3] * v; }
    }
#pragma unroll
    for (int q = 0; q < 16; ++q) { const int tt = q & 3, head = 4 * kvh + (q >> 2); const size_t row = (size_t)MP + 4 * bd + tt;
        const float gv = __uint_as_float(((unsigned)F.Z2[row * ZW + Z_GA + head * 64 + lane]) << 16);
        F.MIX[row * DM + head * 64 + lane] = (bf16_t)(pg8::cvt_pk_bf16(o[q] * inv[q] * gv, 0.f) & 0xffffu); }
    LDS_WAIT();
}
__device__ __forceinline__ void samp_sgu_o(const Frame& F, int l, int bd) {
    const int lane = F.lane, c0 = 8 * lane, hd = lane >> 4;
    float* oCV = F.out + O_CV + (size_t)l * LS_CV;
    float gl[8], bl[8];
#pragma unroll
    for (int j = 0; j < 8; ++j) { gl[j] = F.ln_g[l * 512 + c0 + j]; bl[j] = F.ln_b[l * 512 + c0 + j]; }
    float vn[4][8];
#pragma unroll
    for (int tt = 0; tt < 4; ++tt) { const size_t row = (size_t)MP + 4 * bd + tt; float f[8]; unpack8(*(const u32x4*)(F.Z2 + row * ZW + Z_VS + c0), f);
        float s = 0.f, ss = 0.f;
#pragma unroll
        for (int j = 0; j < 8; ++j) { s += f[j]; ss += f[j] * f[j]; }
        s = wave_sum(s); ss = wave_sum(ss);
        const float mean = s * (1.0f / 512.0f), var = ss * (1.0f / 512.0f) - mean * mean, rstd = rsqrtf(var + EPS);
#pragma unroll
        for (int j = 0; j < 8; ++j) vn[tt][j] = (f[j] - mean) * rstd * gl[j] + bl[j];
        float* o = oCV + ((size_t)bd * 4 + tt) * 512 + c0;
        *(f32x4*)o = (f32x4){vn[tt][0], vn[tt][1], vn[tt][2], vn[tt][3]}; *(f32x4*)(o + 4) = (f32x4){vn[tt][4], vn[tt][5], vn[tt][6], vn[tt][7]}; }
#pragma unroll
    for (int tt = 0; tt < 4; ++tt) { const size_t row = (size_t)MP + 4 * bd + tt;
        float mx[8]; const float bias = F.sgu_b[l * 512 + hd * 128 + tt];
#pragma unroll
        for (int j = 0; j < 8; ++j) mx[j] = bias;
#pragma unroll
        for (int s2 = 0; s2 < 4; ++s2) if (s2 <= tt) { const float w = F.sgu_w[((size_t)(l * 4 + hd) * 128 + tt) * 128 + s2];
#pragma unroll
            for (int j = 0; j < 8; ++j) mx[j] += w * vn[s2][j]; }
        float uf[8], gf[8]; unpack8(*(const u32x4*)(F.Z2 + row * ZW + Z_U + c0), uf); unpack8(*(const u32x4*)(F.Z2 + row * ZW + Z_GS + c0), gf);
#pragma unroll
        for (int j = 0; j < 8; ++j) mx[j] = mx[j] * uf[j] * gf[j];
        *(u32x4*)(F.MIX + row * DM + 1536 + c0) = pack8(mx); }
}

#endif
struct NormRowIn { u32x4 yv[4]; f32x4 xv[4][2]; };
__device__ __forceinline__ void norm_row_load(NormRowIn& in, const Frame& F, int l, int row) {
    const int lane = F.lane;
    const bf16_t* yr = F.Yb + (size_t)row * DM + 8 * lane;
    const float* xr = ((l == 0) ? (row < MP ? F.xp + (size_t)row * DM : F.xs + (size_t)(row - MP) * DM) : F.out + (size_t)row * DM) + 8 * lane;
#pragma unroll
    for (int j = 0; j < 4; ++j) { in.yv[j] = __builtin_nontemporal_load((const u32x4*)(yr + 512 * j)); in.xv[j][0] = __builtin_nontemporal_load((const f32x4*)(xr + 512 * j)); in.xv[j][1] = __builtin_nontemporal_load((const f32x4*)(xr + 512 * j + 4)); }
}
__device__ __forceinline__ void norm_row_finish(const NormRowIn& in, const Frame& F, int l, int row) {
    const int lane = F.lane;
    float* orow = F.out + (size_t)row * DM + 8 * lane;
    const float* pg = F.norm_post + l * DM + 8 * lane; const float* g1 = F.norm_pre + DM + 8 * lane;
    float y[4][8]; float ss = 0.f;
#pragma unroll
    for (int j = 0; j < 4; ++j) { unpack8(in.yv[j], y[j]);
#pragma unroll
        for (int e = 0; e < 8; ++e) ss += y[j][e] * y[j][e]; }
    ss = wave_sum(ss);
    const float ry = rsqrtf(ss * (1.0f / 2048.0f) + EPS);
    float s1 = 0.f;
#pragma unroll
    for (int j = 0; j < 4; ++j) { const f32x4 ga = *(const f32x4*)(pg + 512 * j), gb = *(const f32x4*)(pg + 512 * j + 4);
#pragma unroll
        for (int e = 0; e < 4; ++e) { y[j][e] = in.xv[j][0][e] + y[j][e] * ry * ga[e]; y[j][4 + e] = in.xv[j][1][e] + y[j][4 + e] * ry * gb[e]; }
        __builtin_nontemporal_store((f32x4){y[j][0], y[j][1], y[j][2], y[j][3]}, (f32x4*)(orow + 512 * j)); __builtin_nontemporal_store((f32x4){y[j][4], y[j][5], y[j][6], y[j][7]}, (f32x4*)(orow + 512 * j + 4));
#pragma unroll
        for (int e = 0; e < 8; ++e) s1 += y[j][e] * y[j][e]; }
    if (l == 0) {
        s1 = wave_sum(s1);
        const float r1 = rsqrtf(s1 * (1.0f / 2048.0f) + EPS);
        bf16_t* hrow = F.H + (size_t)row * DM + 8 * lane;
#pragma unroll
        for (int j = 0; j < 4; ++j) { const f32x4 ga = *(const f32x4*)(g1 + 512 * j), gb = *(const f32x4*)(g1 + 512 * j + 4); float o[8];
#pragma unroll
            for (int e = 0; e < 4; ++e) { o[e] = y[j][e] * r1 * ga[e]; o[4 + e] = y[j][4 + e] * r1 * gb[e]; }
            *(u32x4*)(hrow + 512 * j) = pack8(o); }
    }
}
__device__ __forceinline__ void norm_rows4(int l, int row0) { LOCAL_FRAME;
#pragma unroll 1
    for (int k = 0; k < 4; k += 2) { NormRowIn a, b; norm_row_load(a, F, l, row0 + k); norm_row_load(b, F, l, row0 + k + 1);
        norm_row_finish(a, F, l, row0 + k); norm_row_finish(b, F, l, row0 + k + 1); } }

constexpr int Q2_G = 40, Q2_AT = Q2_G + 256, Q2_SG = Q2_AT + 256, Q2_SA = Q2_SG + 64, Q2_SS = Q2_SA + 16, Q2_SP = Q2_SS + 8, Q2_PO = Q2_SP + 256;
__device__ __forceinline__ void slot2(int l, LAS unsigned char* L, LAS unsigned char* ring) {
    int t_ = threadIdx.x; asm volatile("" : "+v"(t_)); const int wave = __builtin_amdgcn_readfirstlane(t_ >> 6);
    unsigned* head = ctl_word(CW_Q + 64 * (2 * l));
    EV_T0();
#pragma unroll 1
    for (;;) {
        const int it = q_pop(head, L);
        if (it >= Q2_PO + (l == 0 ? TR_ITEMS : 0)) { if (l == 0) { EV_MAX(0); EV_MIN(1); } break; }
        if (it < Q2_G) {
            unsigned char* ws = (unsigned char*)kargs()->ws;
            pg8::Gemm g{(const bf16_t*)(ws + WS_H), (const bf16_t*)(ws + WS_WTIN) + (size_t)l * DIN * DM, MT, DIN, DM};
            OneUnit S; S.u.pm = 64 + it / 20; S.u.pn = it % 20;
            pg8::EpiIn E{l};
            pg8::gemm_phase<pg8::EpiIn, OneUnit, false, true>(ring, g, S, E);
            publish(ctl_word(CW_ZS + 64 * (2 * l + it / 20)));
            if (l == 0) { EV_MAX(2); EV_MIN(3); }
        }
        else if (it < Q2_AT) { const int u = it - Q2_G; sgu_unit(l, u >> 1, u & 1, ring); if (l == 0) EV_MAX(5); }
        else if (it < Q2_SG) { attn_unit(l, it - Q2_AT, ring); if (l == 0) EV_MAX(4); }
        else if (it < Q2_SA) { const int i = it - Q2_SG; dep_wait(ctl_word(CW_ZS + 64 * (2 * l + (i >> 5))), 20u); if (l == 0) EV_MIN(6); const int k = 8 * i + wave; samp_attn(l, k >> 2, k & 3, ring + wave * 9472); __syncthreads(); if (l == 0) EV_MAX(7); }
        else if (it < Q2_SS) { const int i = it - Q2_SA; dep_wait(ctl_word(CW_ZS + 64 * (2 * l + (i >> 3))), 20u); samp_sgu(l, 8 * i + wave); }
        else if (it < Q2_SP) { const int i = it - Q2_SS; dep_wait(ctl_word(CW_ZS + 64 * (2 * l + (i >> 2))), 20u); const int k = 8 * i + wave; pool_sample(l, k & 3, k >> 2); }
        else if (it < Q2_PO) { const int i = 8 * (it - Q2_SP) + wave; pool_prompt(l, i & 3, i >> 2, ring + wave * PL_WBYTES); }
        else { LOCAL_FRAME; transpose_item(F, 1, it - Q2_PO, ring); }
    }
}
constexpr int Q4_G = 16, Q4_P = Q4_G + 512, Q4_S = Q4_P + 16;
__device__ __forceinline__ void slot4(int l, LAS unsigned char* L, LAS unsigned char* ring) {
    int t_ = threadIdx.x; asm volatile("" : "+v"(t_)); const int wave = __builtin_amdgcn_readfirstlane(t_ >> 6);
    unsigned* head = ctl_word(CW_Q + 64 * (2 * l + 1));
#pragma unroll 1
    for (;;) {
        const int it = q_pop(head, L);
        if (it >= Q4_S) break;
        if (it < Q4_G) {
            unsigned char* ws = (unsigned char*)kargs()->ws;
            pg8::Gemm g{(const bf16_t*)(ws + WS_MIX), (const bf16_t*)(ws + WS_WTOUT) + (size_t)l * DM * DM, MT, DM, DM};
            OneUnit S; S.u.pm = 64 + it / 8; S.u.pn = it % 8;
            pg8::EpiOut E{};
            pg8::gemm_phase<pg8::EpiOut, OneUnit, false, true>(ring, g, S, E);
            publish(ctl_word(CW_YS + 64 * (2 * l + it / 8)));
        }
        else if (it < Q4_P) norm_rows4(l, 32 * (it - Q4_G) + 4 * wave);
        else { const int i = it - Q4_P; dep_wait(ctl_word(CW_YS + 64 * (2 * l + (i >> 3))), 8u); norm_rows4(l, MP + 32 * i + 4 * wave); }
    }
}

__global__ void __launch_bounds__(NTHREADS, 2) hymba_fwd(Args a_unused) {
    extern __shared__ __attribute__((aligned(16))) unsigned char lds[];
    LAS unsigned char* L = (LAS unsigned char*)lds;
    if (threadIdx.x < 256) ((LAS unsigned*)L)[threadIdx.x] = 0u;
    __syncthreads();
    XcdBarrier bar = xcd_barrier_post((unsigned*)((unsigned char*)kargs()->ws + WS_CTL) + CW_BAR, (volatile LAS unsigned*)L + 8);
    LAS unsigned char* ring = L + RING_OFF;
    STAMP(0);
#ifndef NO_P0
    { Frame F; make_frame(F, kargs()); p0_prologue(F, ring); }
#endif
    xcd_barrier(bar);
    STAMP(1);
#pragma unroll 1
    for (int l = 0; l < 2; ++l) {
#ifndef NO_P1
        {
            KArgs ka = kargs(); unsigned char* ws = (unsigned char*)ka->ws;
            pg8::Gemm g{(const bf16_t*)(ws + WS_H), (const bf16_t*)(ws + WS_WTIN) + (size_t)l * DIN * DM, MP, DIN, DM}; pg8::StaticOrder S; S.init(MP, DIN, (int)gridDim.x, (int)blockIdx.x);
            pg8::EpiIn E{l};
            pg8::gemm_phase<pg8::EpiIn, pg8::StaticOrder, true, true>(ring, g, S, E);
        }
#endif
        xcd_barrier(bar);
        STAMP(2 + 4 * l);
#ifndef NO_P2
        slot2(l, L, ring);
#endif
        xcd_barrier(bar);
        STAMP(3 + 4 * l);
#ifndef NO_P3
        {
            KArgs ka = kargs(); unsigned char* ws = (unsigned char*)ka->ws;
            pg8::Gemm g{(const bf16_t*)(ws + WS_MIX), (const bf16_t*)(ws + WS_WTOUT) + (size_t)l * DM * DM, MP, DM, DM}; pg8::StaticOrder S; S.init(MP, DM, (int)gridDim.x, (int)blockIdx.x);
            pg8::EpiOut E{};
            pg8::gemm_phase<pg8::EpiOut, pg8::StaticOrder, true, true>(ring, g, S, E);
        }
#endif
        xcd_barrier(bar);
        STAMP(4 + 4 * l);
#ifndef NO_P4
        slot4(l, L, ring);
#endif
        if (l == 0) xcd_barrier(bar);
#if PROBE_SEL
        if (l == 1) __syncthreads();
#endif
        STAMP(5 + 4 * l);
    }
#if PROBE_SEL
    if (blockIdx.x == 0 && threadIdx.x == 0) {
#if PROBE_SEL >= 10
        unsigned ea = __hip_atomic_load(ctl_word(CW_EV + 64 * PEA), __ATOMIC_RELAXED, __HIP_MEMORY_SCOPE_AGENT), eb = __hip_atomic_load(ctl_word(CW_EV + 64 * PEB), __ATOMIC_RELAXED, __HIP_MEMORY_SCOPE_AGENT);
        if (PEA_MIN) ea = 0x40000000u - ea; if (PEB_MIN) eb = 0x40000000u - eb;
        unsigned long long da = (ea + 400) / 800, db = (eb + 400) / 800;
#else
        LAS unsigned long long* ts = (LAS unsigned long long*)(L + 256);
        unsigned long long da = (ts[PA1] - ts[PA0] + 400) / 800, db = (ts[PB1] - ts[PB0] + 400) / 800;
#endif
        if (da > 63) da = 63; if (db > 63) db = 63;
        const unsigned long long extra = (da + 64 * db) * 1600ull, t0 = __builtin_amdgcn_s_memrealtime();
        while (__builtin_amdgcn_s_memrealtime() - t0 < extra) __builtin_amdgcn_s_sleep(32);
    }
#endif
}

extern "C" void kernel_launch(void* const* d_in, const int* in_sizes, int n_in, void* d_out, int out_size, void* d_ws, size_t ws_size, hipStream_t stream) {
    static int grid = 0;
    if (grid == 0) {
        if (n_in != 16 || (size_t)out_size != O_END || ws_size < WS_END) { fprintf(stderr, "kernel_launch: unexpected shapes: n_in %d out %d ws %zu (need %zu)\n", n_in, out_size, ws_size, (size_t)WS_END); grid = -1; return; }
        int dev = 0, cus = 0, per_cu = 0;
        if (hipGetDevice(&dev) != hipSuccess || hipDeviceGetAttribute(&cus, hipDeviceAttributeMultiprocessorCount, dev) != hipSuccess) { fprintf(stderr, "kernel_launch: device query failed\n"); grid = -1; return; }
        if (hipFuncSetAttribute((const void*)hymba_fwd, hipFuncAttributeMaxDynamicSharedMemorySize, LDS_BYTES) != hipSuccess) { fprintf(stderr, "kernel_launch: hipFuncSetAttribute failed\n"); grid = -1; return; }
        if (hipOccupancyMaxActiveBlocksPerMultiprocessor(&per_cu, (const void*)hymba_fwd, NTHREADS, LDS_BYTES) != hipSuccess || per_cu < 1) { fprintf(stderr, "kernel_launch: occupancy query says %d blocks/CU\n", per_cu); (void)hipGetLastError(); grid = -1; return; }
        grid = cus;
    }
    if (grid < 0) return;
    (void)hipMemsetAsync((char*)d_ws + WS_CTL, 0, CTL_ZERO_BYTES, stream);
    Args a{};
    for (int i = 0; i < 16; ++i) a.in[i] = (const float*)d_in[i];
    a.out = (float*)d_out; a.ws = (unsigned char*)d_ws;
    void* params[] = {&a};
    hipError_t e = hipLaunchCooperativeKernel((const void*)hymba_fwd, dim3(grid), dim3(NTHREADS), params, LDS_BYTES, stream);
    if (e != hipSuccess) fprintf(stderr, "kernel_launch: cooperative launch failed: %s (grid %d)\n", hipGetErrorString(e), grid);
}
```

```cpp
#include <hip/hip_runtime.h>
#include <cstdio>
#include <cstdint>
#include <cmath>
namespace pg8 {
#define PG8_LAS __attribute__((address_space(3)))
typedef unsigned short bf16_t;
typedef short bf16x8 __attribute__((ext_vector_type(8)));
typedef float f32x4 __attribute__((ext_vector_type(4)));
typedef unsigned u32x4 __attribute__((ext_vector_type(4)));
constexpr int BM = 256, BK = 64, HALF = 128, HTB = HALF * BK * 2  , STAGE_BYTES = 8 * HTB, NXCD = 8, WGM = 8;

__host__ __device__ __forceinline__ int lds_byte(int r, int c) { const int st = (r >> 4) * 2 + (c >> 5), rr = r & 15, cc = c & 31, ob = rr * 64 + cc * 2; return st * 1024 + (ob ^ (((ob >> 9) & 1) << 5)); }
__host__ __device__ __forceinline__ void stage_rc(int b, int& R, int& C) { const int st = b / 1024, sb = b % 1024, swz = sb ^ (((sb >> 9) & 1) << 5); R = (st >> 1) * 16 + swz / 64; C = (st & 1) * 32 + (swz % 64) / 2; }
__host__ __device__ __forceinline__ int perm32(int rho) { const int n = rho >> 4, i = rho & 15; return 8 * (i >> 2) + 4 * n + (i & 3); }

struct Unit { int pm, pn; };
struct Gemm { const bf16_t* A; const bf16_t* Bt; int M, N, K; };

struct StaticOrder {
    int nM, nN, nwg, G, c;
    __host__ __device__ void init(int M, int N, int G_, int c_) { nM = M / BM; nN = N / BM; nwg = nM * nN; G = G_; c = c_; }
    __host__ __device__ bool next(int i, Unit& u) const {
        const long L = (long)i * G + c; if (L >= nwg) return false;
        int wgid = (int)L; { const int q = nwg / NXCD, r = nwg % NXCD, xcd = wgid % NXCD, off = wgid / NXCD; wgid = (xcd < r ? xcd * (q + 1) : r * (q + 1) + (xcd - r) * q) + off; }
        const int nig = WGM * nN, gid = wgid / nig, fm = gid * WGM, gsz = (nM - fm) < WGM ? (nM - fm) : WGM;
        u.pm = fm + ((wgid % nig) % gsz); u.pn = (wgid % nig) / gsz; return true;
    }
    __device__ __forceinline__ void a_ready(const Unit&) const {}
    __device__ __forceinline__ void done(const Unit&) const {}
};

constexpr int DM = 2048, MP = 16384, MS = 512, MT = MP + MS, DIN = 5120;
constexpr int ZW = 3584;
constexpr int Z_GA = 0, Z_XB = 1024, Z_GP = 1536, Z_U = 2048, Z_VS = 2560, Z_GS = 3072;
constexpr float LOG2E = 1.4426950408889634f, QSCALE = 0.125f * LOG2E, EPS = 1e-6f;

__device__ __forceinline__ unsigned cvt_pk_bf16(float lo, float hi) { unsigned r; asm("v_cvt_pk_bf16_f32 %0, %1, %2" : "=v"(r) : "v"(lo), "v"(hi)); return r; }
__device__ __forceinline__ float silu_f(float x) { return x * __builtin_amdgcn_rcpf(1.0f + __builtin_amdgcn_exp2f(-x * LOG2E)); }
__device__ __forceinline__ int vperm32(int x) { return ((x >> 2) & 1) * 16 + (x >> 3) * 4 + (x & 3); }

struct EpiPtrs { const __attribute__((address_space(1))) float* in[16]; __attribute__((address_space(1))) float* out; __attribute__((address_space(1))) unsigned char* ws; };
constexpr size_t EP_RSTD = (size_t)3 << 20, EP_ROPE = (size_t)1 << 20, EP_QC = (size_t)192 << 20, EP_KC = (size_t)225 << 20, EP_VTP = (size_t)233 << 20, EP_Z2 = (size_t)241 << 20, EP_Y = (size_t)357 << 20;
constexpr size_t EO_KP = 34603008, EO_VP = 35127296, EO_PP = 35651584, EO_KS = 35774464, EO_VS = 44163072, EO_PS = 52551680;
struct EpiIn {
    static constexpr bool PERM = true, AFTER_DRAIN = false;
    int l;
    __device__ __forceinline__ void operator()(const f32x4 (&acc)[2][2][4][2], const Unit& u, int wr, int wc, int fr, int fq) const {
        const __attribute__((address_space(4))) EpiPtrs* kp = (const __attribute__((address_space(4))) EpiPtrs*)__builtin_amdgcn_kernarg_segment_ptr(); asm volatile("" : "+s"(kp));
        unsigned char* ws = (unsigned char*)kp->ws; float* outp = (float*)kp->out;
        bf16_t* Qc = (bf16_t*)(ws + EP_QC); bf16_t* Kc = (bf16_t*)(ws + EP_KC); bf16_t* VTP = (bf16_t*)(ws + EP_VTP); bf16_t* Z2 = (bf16_t*)(ws + EP_Z2); const float* rope = (const float*)(ws + EP_ROPE);
        float* oKp = outp + EO_KP + (size_t)l * 262144; float* oVp = outp + EO_VP + (size_t)l * 262144; float* oPp = outp + EO_PP + (size_t)l * 61440;
        float* oKs = outp + EO_KS + (size_t)l * 4194304; float* oVs = outp + EO_VS + (size_t)l * 4194304; float* oPs = outp + EO_PS + (size_t)l * 983040;
        const int pn = u.pn;
        const int row0 = u.pm * 256 + wr * 64 + fr;
        const int cw = wc * 32 + 8 * fq;
        const float* rstd = (const float*)(ws + EP_RSTD) + (size_t)l * MT;
        if (pn < 5) {
#pragma unroll
            for (int ai = 0; ai < 2; ++ai)
#pragma unroll
                for (int m = 0; m < 4; ++m) {
                    const int row = row0 + ai * 128 + m * 16;
                    const bool smp = row >= MP;
                    const int tpos = smp ? 2048 + (row & 3) : (row & 2047);
                    const float* rp = rope + tpos * 64; const float rs = rstd[row];
#pragma unroll
                    for (int bj = 0; bj < 2; ++bj) {
                        const int c = pn * 256 + bj * 128 + cw;
                        const int i0 = (c & 63) >> 1;
                        const f32x4 cs = *(const f32x4*)(rp + i0), sn = *(const f32x4*)(rp + 32 + i0);
                        const f32x4 v0 = acc[ai][bj][m][0] * rs, v1 = acc[ai][bj][m][1] * rs;
                        f32x4 o1, o2;
                        o1[0] = v0[0] * cs[0] - v0[1] * sn[0]; o2[0] = v0[1] * cs[0] + v0[0] * sn[0];
                        o1[1] = v0[2] * cs[1] - v0[3] * sn[1]; o2[1] = v0[3] * cs[1] + v0[2] * sn[1];
                        o1[2] = v1[0] * cs[2] - v1[1] * sn[2]; o2[2] = v1[1] * cs[2] + v1[0] * sn[2];
                        o1[3] = v1[2] * cs[3] - v1[3] * sn[3]; o2[3] = v1[3] * cs[3] + v1[2] * sn[3];
                        if (pn < 4) {
                            o1 = o1 * QSCALE; o2 = o2 * QSCALE;
                            u32x4 w; w.x = cvt_pk_bf16(o1[0], o2[0]); w.y = cvt_pk_bf16(o1[1], o2[1]); w.z = cvt_pk_bf16(o1[2], o2[2]); w.w = cvt_pk_bf16(o1[3], o2[3]);
                            *(u32x4*)(Qc + (size_t)row * 1024 + c) = w;
                        } else {
                            const int kvh = (c - 1024) >> 6;
                            if (!smp) {
                                const int b = row >> 11, t = row & 2047;
                                u32x4 w; w.x = cvt_pk_bf16(o1[0], o2[0]); w.y = cvt_pk_bf16(o1[1], o2[1]); w.z = cvt_pk_bf16(o1[2], o2[2]); w.w = cvt_pk_bf16(o1[3], o2[3]);
                                *(u32x4*)(Kc + ((size_t)((b * 4 + kvh) * 2048 + t)) * 64 + (c & 63)) = w;
                                if (t >= 1920) { float* o = oKp + ((size_t)((b * 128 + t - 1920) * 4 + kvh)) * 64 + i0; *(f32x4*)o = o1; *(f32x4*)(o + 32) = o2; }
                            } else {
                                const int bd = (row - MP) >> 2, tt = row & 3;
                                float* o = oKs + ((size_t)((bd * 128 + 124 + tt) * 4 + kvh)) * 64 + i0; *(f32x4*)o = o1; *(f32x4*)(o + 32) = o2;
                            }
                        }
                    }
                }
        } else if (pn == 5) {
#pragma unroll
            for (int ai = 0; ai < 2; ++ai)
#pragma unroll
                for (int m = 0; m < 4; ++m) {
                    const int row = row0 + ai * 128 + m * 16;
                    const bool smp = row >= MP; const float rs = rstd[row];
#pragma unroll
                    for (int bj = 0; bj < 2; ++bj) {
                        const int cv = bj * 128 + cw;
                        const int kvh = cv >> 6, d0 = cv & 63;
                        const f32x4 v0 = acc[ai][bj][m][0] * rs, v1 = acc[ai][bj][m][1] * rs;
                        if (!smp) {
                            const int b = row >> 11, t = row & 2047;
                            bf16_t* vp = VTP + ((size_t)((b * 4 + kvh) * 64 + (t >> 5))) * 2048 + d0 * 32 + vperm32(t & 31);
                            const unsigned w0 = cvt_pk_bf16(v0[0], v0[1]), w1 = cvt_pk_bf16(v0[2], v0[3]), w2 = cvt_pk_bf16(v1[0], v1[1]), w3 = cvt_pk_bf16(v1[2], v1[3]);
                            vp[0] = (bf16_t)(w0 & 0xffffu); vp[32] = (bf16_t)(w0 >> 16); vp[64] = (bf16_t)(w1 & 0xffffu); vp[96] = (bf16_t)(w1 >> 16);
                            vp[128] = (bf16_t)(w2 & 0xffffu); vp[160] = (bf16_t)(w2 >> 16); vp[192] = (bf16_t)(w3 & 0xffffu); vp[224] = (bf16_t)(w3 >> 16);
                            if (t >= 1920) { float* o = oVp + ((size_t)((b * 128 + t - 1920) * 4 + kvh)) * 64 + d0; *(f32x4*)o = v0; *(f32x4*)(o + 4) = v1; }
                        } else {
                            const int bd = (row - MP) >> 2, tt = row & 3;
                            float* o = oVs + ((size_t)((bd * 128 + 124 + tt) * 4 + kvh)) * 64 + d0; *(f32x4*)o = v0; *(f32x4*)(o + 4) = v1;
                        }
                    }
                }
        } else {
            const bool gate = (pn < 10) || (pn == 12) || (pn == 13) || (pn >= 18);
            const bool isxb = (pn == 10) || (pn == 11);
#pragma unroll
            for (int ai = 0; ai < 2; ++ai)
#pragma unroll
                for (int m = 0; m < 4; ++m) {
                    const int row = row0 + ai * 128 + m * 16;
                    const bool smp = row >= MP; const float rs = rstd[row];
#pragma unroll
                    for (int bj = 0; bj < 2; ++bj) {
                        const int c = pn * 256 + bj * 128 + cw;
                        f32x4 v0 = acc[ai][bj][m][0] * rs, v1 = acc[ai][bj][m][1] * rs;
                        if (isxb) {
                            const int cx = c - 2560;
                            if (!smp) { const int t = row & 2047; if (t >= 2033) { const int b = row >> 11; float* o = oPp + ((size_t)(b * 15 + t - 2033)) * 512 + cx; *(f32x4*)o = v0; *(f32x4*)(o + 4) = v1; } }
                            else { const int bd = (row - MP) >> 2, tt = row & 3; float* o = oPs + ((size_t)(bd * 15 + 11 + tt)) * 512 + cx; *(f32x4*)o = v0; *(f32x4*)(o + 4) = v1; }
                        }
                        if (gate) {
#pragma unroll
                            for (int j = 0; j < 4; ++j) { v0[j] = silu_f(v0[j]); v1[j] = silu_f(v1[j]); }
                        }
                        u32x4 w; w.x = cvt_pk_bf16(v0[0], v0[1]); w.y = cvt_pk_bf16(v0[2], v0[3]); w.z = cvt_pk_bf16(v1[0], v1[1]); w.w = cvt_pk_bf16(v1[2], v1[3]);
                        *(u32x4*)(Z2 + (size_t)row * ZW + (c - 1536)) = w;
                    }
                }
        }
    }
};

struct EpiOut {
    static constexpr bool PERM = true, AFTER_DRAIN = false;
    __device__ __forceinline__ void operator()(const f32x4 (&acc)[2][2][4][2], const Unit& u, int wr, int wc, int fr, int fq) const {
        const __attribute__((address_space(4))) EpiPtrs* kp = (const __attribute__((address_space(4))) EpiPtrs*)__builtin_amdgcn_kernarg_segment_ptr(); asm volatile("" : "+s"(kp));
        bf16_t* C = (bf16_t*)((unsigned char*)kp->ws + EP_Y);
        const int row0 = u.pm * BM + wr * 64 + fr, col0 = u.pn * BM + wc * 32 + 8 * fq;
#pragma unroll
        for (int ai = 0; ai < 2; ++ai)
#pragma unroll
            for (int m = 0; m < 4; ++m) { bf16_t* rowp = C + (size_t)(row0 + ai * HALF + m * 16) * DM + col0;
#pragma unroll
                for (int bj = 0; bj < 2; ++bj) { const f32x4 v0 = acc[ai][bj][m][0], v1 = acc[ai][bj][m][1];
                    u32x4 w; w.x = cvt_pk_bf16(v0[0], v0[1]); w.y = cvt_pk_bf16(v0[2], v0[3]); w.z = cvt_pk_bf16(v1[0], v1[1]); w.w = cvt_pk_bf16(v1[2], v1[3]);
                    *(u32x4*)(rowp + bj * HALF) = w; } }
    }
};
template <class Epi, class Sched, bool ALIGN_EPI = false, bool SP2 = false>
__device__ __forceinline__ void gemm_phase(PG8_LAS unsigned char* lds, const Gemm g, const Sched& S, const Epi& E) {
    int tid_ = threadIdx.x; asm volatile("" : "+v"(tid_));
    const int tid = tid_, wid = __builtin_amdgcn_readfirstlane(tid >> 6), lane = tid & 63, wr = wid >> 2, wc = wid & 3, fr = lane & 15, fq = lane >> 4;
    const int K = g.K, nt = K / BK;
    unsigned voffA[2], voffB[2];
#pragma unroll
    for (int i = 0; i < 2; ++i) { int R, C; stage_rc(tid * 16 + i * 8192, R, C); const int Rb = Epi::PERM ? ((R & ~31) + perm32(R & 31)) : R;
        voffA[i] = (unsigned)(R * K + C) * 2u; voffB[i] = (unsigned)(Rb * K + C) * 2u; }
    const size_t kstep = (size_t)(BK * 2);
    const size_t hstep = (size_t)HALF * K * 2;
    const size_t tstep = 2 * hstep;
    const unsigned ldsw = (unsigned)wid * 1024u;
    const int aoff = lds_byte(wr * 64 + fr, fq * 8), boff = lds_byte(wc * 32 + fr, fq * 8);
#define PG8_SA(b, h) (((b) * 2 + (h)) * HTB)
#define PG8_SB(b, h) ((4 + (b) * 2 + (h)) * HTB)
#define PG8_STAGE(bufoff, gbase, voff) do { _Pragma("unroll") for (int _i = 0; _i < 2; ++_i) \
        __builtin_amdgcn_global_load_lds((const unsigned*)((const char*)(gbase) + (voff)[_i]), (PG8_LAS unsigned*)(lds + (bufoff) + ldsw + _i * 8192), 16, 0, 0); } while (0)
#define PG8_LDA(dst, b, h) do { _Pragma("unroll") for (int m = 0; m < 4; ++m) _Pragma("unroll") for (int k = 0; k < 2; ++k) dst[m][k] = *(const PG8_LAS bf16x8*)(lds + PG8_SA(b, h) + aoff + m * 2048 + k * 1024); } while (0)
#define PG8_LDB(dst, b, h) do { _Pragma("unroll") for (int n = 0; n < 2; ++n) _Pragma("unroll") for (int k = 0; k < 2; ++k) dst[n][k] = *(const PG8_LAS bf16x8*)(lds + PG8_SB(b, h) + boff + n * 2048 + k * 1024); } while (0)
#define PG8_MMA(ai, bj, At, Bt) do { __builtin_amdgcn_s_setprio(1); _Pragma("unroll") for (int m = 0; m < 4; ++m) _Pragma("unroll") for (int n = 0; n < 2; ++n) _Pragma("unroll") for (int k = 0; k < 2; ++k) \
        acc[ai][bj][m][n] = __builtin_amdgcn_mfma_f32_16x16x32_bf16(Bt[n][k], At[m][k], acc[ai][bj][m][n], 0, 0, 0); __builtin_amdgcn_s_setprio(0); } while (0)
#define PG8_WAIT_V(n) asm volatile("s_waitcnt vmcnt(" #n ")" ::: "memory")
#define PG8_WAIT_L(n) asm volatile("s_waitcnt lgkmcnt(" #n ")" ::: "memory")
#define PG8_BAR __builtin_amdgcn_s_barrier()
#define PG8_SCHED __builtin_amdgcn_sched_barrier(0)
    Unit cur, nxt; int ui = 0;
    if (!S.next(0, cur)) return;
    f32x4 acc[2][2][4][2];
#pragma unroll
    for (int a = 0; a < 2; ++a)
#pragma unroll
        for (int b = 0; b < 2; ++b)
#pragma unroll
            for (int m = 0; m < 4; ++m)
#pragma unroll
                for (int n = 0; n < 2; ++n) acc[a][b][m][n] = (f32x4){0.f, 0.f, 0.f, 0.f};
    bf16x8 At[4][2], B0[2][2], B1[2][2];
    const char* cA = (const char*)g.A + (size_t)cur.pm * tstep; const char* cB = (const char*)g.Bt + (size_t)cur.pn * tstep;
    S.a_ready(cur);
    if constexpr (SP2) {
        PG8_STAGE(PG8_SB(0, 0), cB, voffB); PG8_STAGE(PG8_SB(0, 1), cB + hstep, voffB); PG8_STAGE(PG8_SA(0, 0), cA, voffA); PG8_STAGE(PG8_SA(0, 1), cA + hstep, voffA);
        if (wr == 1) PG8_BAR;
        PG8_WAIT_V(2); PG8_BAR;
        PG8_STAGE(PG8_SB(1, 0), cB + kstep, voffB); PG8_STAGE(PG8_SA(1, 0), cA + kstep, voffA); PG8_STAGE(PG8_SB(1, 1), cB + hstep + kstep, voffB);
        PG8_WAIT_V(6); PG8_BAR;
    } else {
        PG8_STAGE(PG8_SB(0, 0), cB, voffB); PG8_STAGE(PG8_SA(0, 0), cA, voffA); PG8_STAGE(PG8_SB(0, 1), cB + hstep, voffB); PG8_STAGE(PG8_SA(0, 1), cA + hstep, voffA);
        if (wr == 1) PG8_BAR;
        PG8_WAIT_V(4); PG8_BAR;
        PG8_STAGE(PG8_SB(1, 0), cB + kstep, voffB); PG8_STAGE(PG8_SA(1, 0), cA + kstep, voffA); PG8_STAGE(PG8_SB(1, 1), cB + hstep + kstep, voffB);
        PG8_WAIT_V(6); PG8_BAR;
    }
    for (;;) {
        const bool has_next = S.next(ui + 1, nxt);
        const char* nA = has_next ? (const char*)g.A + (size_t)nxt.pm * tstep : cA; const char* nB = has_next ? (const char*)g.Bt + (size_t)nxt.pn * tstep : cB;
        for (int t = 0; t < nt; t += 2) {
            const bool last = (t == nt - 2);
            const char* a1 = cA + (size_t)(t + 1) * kstep;
            const char* a2 = last ? nA : cA + (size_t)(t + 2) * kstep; const char* b2 = last ? nB : cB + (size_t)(t + 2) * kstep;
            const char* a3 = a2 + kstep; const char* b3 = b2 + kstep;
            if (last && has_next) S.a_ready(nxt);
            if constexpr (SP2) {
            PG8_LDB(B0, 0, 0); PG8_LDB(B1, 0, 1); PG8_SCHED; PG8_LDA(At, 0, 0); PG8_STAGE(PG8_SA(1, 1), a1 + hstep, voffA);
            PG8_WAIT_V(8); PG8_WAIT_L(0); PG8_BAR; PG8_MMA(0, 0, At, B0); PG8_MMA(0, 1, At, B1); PG8_BAR; PG8_SCHED;
            PG8_LDA(At, 0, 1); PG8_STAGE(PG8_SB(0, 0), b2, voffB); PG8_STAGE(PG8_SB(0, 1), b2 + hstep, voffB); PG8_STAGE(PG8_SA(0, 0), a2, voffA);
            PG8_WAIT_V(8); PG8_WAIT_L(0); PG8_BAR; PG8_MMA(1, 0, At, B0); PG8_MMA(1, 1, At, B1); PG8_BAR; PG8_SCHED;
            PG8_LDB(B0, 1, 0); PG8_LDB(B1, 1, 1); PG8_SCHED; PG8_LDA(At, 1, 0); PG8_STAGE(PG8_SA(0, 1), a2 + hstep, voffA);
            PG8_WAIT_V(8); PG8_WAIT_L(0); PG8_BAR; PG8_MMA(0, 0, At, B0); PG8_MMA(0, 1, At, B1); PG8_BAR; PG8_SCHED;
            PG8_LDA(At, 1, 1); PG8_STAGE(PG8_SB(1, 0), b3, voffB); PG8_STAGE(PG8_SB(1, 1), b3 + hstep, voffB); PG8_STAGE(PG8_SA(1, 0), a3, voffA);
            PG8_WAIT_V(8); PG8_WAIT_L(0); PG8_BAR; PG8_MMA(1, 0, At, B0); PG8_MMA(1, 1, At, B1); PG8_BAR; PG8_SCHED;
            } else {
            PG8_LDB(B0, 0, 0); PG8_SCHED; PG8_LDA(At, 0, 0); PG8_STAGE(PG8_SA(1, 1), a1 + hstep, voffA);
            PG8_WAIT_L(8); PG8_BAR; PG8_WAIT_L(0); PG8_MMA(0, 0, At, B0); PG8_BAR; PG8_SCHED;
            PG8_LDB(B1, 0, 1); PG8_STAGE(PG8_SB(0, 0), b2, voffB);
            PG8_BAR; PG8_WAIT_L(0); PG8_MMA(0, 1, At, B1); PG8_BAR;
            PG8_LDA(At, 0, 1); PG8_STAGE(PG8_SA(0, 0), a2, voffA);
            PG8_BAR; PG8_WAIT_L(0); PG8_MMA(1, 0, At, B0); PG8_BAR; PG8_SCHED;
            PG8_STAGE(PG8_SB(0, 1), b2 + hstep, voffB);
            PG8_WAIT_V(6); PG8_BAR; PG8_MMA(1, 1, At, B1); PG8_BAR;
            PG8_LDB(B0, 1, 0); PG8_SCHED; PG8_LDA(At, 1, 0); PG8_STAGE(PG8_SA(0, 1), a2 + hstep, voffA);
            PG8_WAIT_L(8); PG8_BAR; PG8_WAIT_L(0); PG8_MMA(0, 0, At, B0); PG8_BAR; PG8_SCHED;
            PG8_LDB(B1, 1, 1); PG8_STAGE(PG8_SB(1, 0), b3, voffB);
            PG8_BAR; PG8_WAIT_L(0); PG8_MMA(0, 1, At, B1); PG8_BAR;
            PG8_LDA(At, 1, 1); PG8_STAGE(PG8_SA(1, 0), a3, voffA);
            PG8_BAR; PG8_WAIT_L(0); PG8_MMA(1, 0, At, B0); PG8_BAR; PG8_SCHED;
            PG8_STAGE(PG8_SB(1, 1), b3 + hstep, voffB);
            PG8_WAIT_V(6); PG8_BAR; PG8_MMA(1, 1, At, B1); PG8_BAR;
            }
        }
        if constexpr (ALIGN_EPI) { if (wr == 0) PG8_BAR; }
        if constexpr (!Epi::AFTER_DRAIN) { E(acc, cur, wr, wc, fr, fq); S.done(cur); }
        if (!has_next) break;
#pragma unroll
        for (int a = 0; a < 2; ++a)
#pragma unroll
            for (int b = 0; b < 2; ++b)
#pragma unroll
                for (int m = 0; m < 4; ++m)
#pragma unroll
                    for (int n = 0; n < 2; ++n) acc[a][b][m][n] = (f32x4){0.f, 0.f, 0.f, 0.f};
        cur = nxt; cA = nA; cB = nB; ++ui;
        if constexpr (ALIGN_EPI) { if (wr == 1) PG8_BAR; }
    }
    PG8_WAIT_V(0);
    if constexpr (!ALIGN_EPI) { if (wr == 0) PG8_BAR; }
    PG8_BAR;
    if constexpr (Epi::AFTER_DRAIN) { E.fused(acc, cur, wr, wc, fr, fq, lds, wid, lane); S.done(cur); }
#undef PG8_SA
#undef PG8_SB
#undef PG8_STAGE
#undef PG8_LDA
#undef PG8_LDB
#undef PG8_MMA
#undef PG8_WAIT_V
#undef PG8_WAIT_L
#undef PG8_BAR
#undef PG8_SCHED
}
}
#define GAS __attribute__((address_space(1)))
#define LAS __attribute__((address_space(3)))
typedef GAS unsigned gu32;
typedef GAS unsigned long long gu64;
#define RLX_AGENT __ATOMIC_RELAXED, __HIP_MEMORY_SCOPE_AGENT
#define VM_WAIT() asm volatile("s_waitcnt vmcnt(0)" ::: "memory")
__device__ __forceinline__ unsigned long long rt() { return __builtin_amdgcn_s_memrealtime(); }
__device__ __forceinline__ unsigned f2bf(float f) { unsigned u = __builtin_bit_cast(unsigned, f); return (u + 0x7fffu + ((u >> 16) & 1u)) >> 16; }
__device__ __forceinline__ unsigned pk2(float lo, float hi) { return f2bf(lo) | (f2bf(hi) << 16); }

#define XB_TMO      128
#define XB_XCNT(j)  (256  + 64 * (j))
#define XB_XSUB(j)  (1280 + 64 * (j))
#define XB_XGEN(j)  (2304 + 64 * (j))
#define XB_TOP      3328
#define XB_TOPGEN   3392
#define XCD_BAR_WORDS 3456
#define XB_SPIN_CAP (1u << 18)

__device__ __forceinline__ unsigned xb_ld(unsigned* p)              { return __hip_atomic_load(p, __ATOMIC_RELAXED, __HIP_MEMORY_SCOPE_AGENT); }
__device__ __forceinline__ unsigned xb_add(unsigned* p, unsigned v) { return __hip_atomic_fetch_add(p, v, __ATOMIC_RELAXED, __HIP_MEMORY_SCOPE_AGENT); }
__device__ __forceinline__ unsigned xb_xcc_id() { return (unsigned)__builtin_amdgcn_s_getreg((3 << 11) | 20) & 0xFu; }
#define XB_SPIN(cond, bar) do { unsigned _sp = 0; while (cond) { __builtin_amdgcn_s_sleep(1); \
    if ((++_sp & 255u) == 0u) { if (xb_ld(&(bar)[XB_TMO])) break; if (_sp > XB_SPIN_CAP) { atomicAdd(&(bar)[XB_TMO], 1u); break; } } } } while (0)

struct XcdBarrier {
    unsigned* bar; unsigned x;
    volatile LAS unsigned* st;
};

__device__ __forceinline__ XcdBarrier xcd_barrier_post(unsigned* bar, volatile LAS unsigned* st) {
    XcdBarrier b; b.bar = bar; b.x = xb_xcc_id(); b.st = st;
    if (threadIdx.x == 0) (void)xb_add(&bar[XB_XCNT(b.x)], 1u);
    return b;
}
__device__ __forceinline__ void xcd_barrier_complete(unsigned* bar, unsigned x, unsigned& nloc, unsigned& nx) {
    const unsigned G = gridDim.x * gridDim.y * gridDim.z;
    unsigned sum, cnt, mine, sp = 0u;
    for (;;) {
        sum = 0u; cnt = 0u; mine = 0u;
#pragma unroll
        for (unsigned j = 0; j < 16; ++j) { const unsigned c = xb_ld(&bar[XB_XCNT(j)]); sum += c; cnt += (c > 0u) ? 1u : 0u; mine = (j == x) ? c : mine; }
        if (sum == G) break;
        __builtin_amdgcn_s_sleep(1);
        if ((++sp & 255u) == 0u) { if (xb_ld(&bar[XB_TMO])) break; if (sp > XB_SPIN_CAP) { atomicAdd(&bar[XB_TMO], 1u); break; } }
    }
    nloc = mine > 0u ? mine : 1u; nx = cnt > 0u ? cnt : 1u;
}

__device__ __forceinline__ void xcd_barrier(const XcdBarrier& b) {
    asm volatile("s_waitcnt vmcnt(0)" ::: "memory");
    __syncthreads();
    if (threadIdx.x == 0) {
        unsigned* bar = b.bar;
        __builtin_amdgcn_s_waitcnt(0);
        unsigned nloc = b.st[0], nx = b.st[1];
        if (nloc == 0u) { xcd_barrier_complete(bar, b.x, nloc, nx); b.st[0] = nloc; b.st[1] = nx; }
        const unsigned old = xb_add(&bar[XB_XSUB(b.x)], 1u);
        const unsigned gen = old / nloc;
        if (old + 1u == (gen + 1u) * nloc) {
            __builtin_amdgcn_fence(__ATOMIC_RELEASE, "agent");
            asm volatile("s_waitcnt vmcnt(0)" ::: "memory");
            const unsigned og = xb_add(&bar[XB_TOP], 1u);
            const unsigned tg = og / nx;
            if (og + 1u == (tg + 1u) * nx) xb_add(&bar[XB_TOPGEN], 1u);
            else XB_SPIN(xb_ld(&bar[XB_TOPGEN]) == tg, bar);
            __builtin_amdgcn_fence(__ATOMIC_ACQUIRE, "agent");
            xb_add(&bar[XB_XGEN(b.x)], 1u);
            asm volatile("s_waitcnt vmcnt(0)" ::: "memory");
        } else {
            XB_SPIN(xb_ld(&bar[XB_XGEN(b.x)]) == gen, bar);
            __builtin_amdgcn_fence(__ATOMIC_ACQUIRE, "agent");
            asm volatile("s_waitcnt vmcnt(0)" ::: "memory");
        }
    }
    __syncthreads();
}

using pg8::bf16_t; using pg8::bf16x8; using pg8::f32x4; using pg8::u32x4;
using pg8::DM; using pg8::MP; using pg8::MS; using pg8::MT; using pg8::DIN; using pg8::ZW;
using pg8::Z_GA; using pg8::Z_XB; using pg8::Z_GP; using pg8::Z_U; using pg8::Z_VS; using pg8::Z_GS; using pg8::LOG2E; using pg8::EPS;
typedef float f32x16 __attribute__((ext_vector_type(16)));
typedef unsigned u32x2 __attribute__((ext_vector_type(2)));
typedef short v4i16_t __attribute__((ext_vector_type(4)));

constexpr int NWAVES = 8, NTHREADS = 512;
constexpr int LDS_BYTES = 147456;
constexpr int RING_OFF = 1024;

constexpr size_t O_YP = 0, O_YS = 33554432, O_KP = 34603008, O_VP = 35127296, O_PP = 35651584, O_KS = 35774464, O_VS = 44163072, O_PS = 52551680, O_CV = 54517760, O_END = 55042048;
constexpr size_t LS_KP = 262144, LS_PP = 61440, LS_KS = 4194304, LS_PS = 983040, LS_CV = 262144;
constexpr size_t MiB = 1u << 20;
constexpr size_t WS_CTL = 0, CTL_ZERO_BYTES = 65536;
constexpr size_t WS_ROPE = 1 * MiB, WS_SGUW = 2 * MiB, WS_RSW = 2 * MiB + 256 * 1024, WS_PWT = 2 * MiB + 512 * 1024, WS_RSTD = 3 * MiB;
constexpr size_t WS_WTIN = 4 * MiB, WS_WTOUT = 44 * MiB, WS_H = 60 * MiB, WS_MIX = 126 * MiB, WS_QC = 192 * MiB, WS_KC = 225 * MiB, WS_VTP = 233 * MiB, WS_Z2 = 241 * MiB, WS_Y = 357 * MiB, WS_END = 489 * MiB;
constexpr int CW_BAR = 1024;

__constant__ double ROPE_INV[32] = {1.0, 0.7498942093324559, 0.5623413251903491, 0.4216965034285822, 0.31622776601683794, 0.23713737056616552, 0.1778279410038923, 0.1333521432163324, 0.1, 0.07498942093324558, 0.05623413251903491, 0.042169650342858224, 0.03162277660168379, 0.023713737056616554, 0.01778279410038923, 0.01333521432163324, 0.01, 0.007498942093324558, 0.005623413251903491, 0.004216965034285823, 0.0031622776601683794, 0.0023713737056616554, 0.0017782794100389228, 0.001333521432163324, 0.001, 0.0007498942093324559, 0.0005623413251903491, 0.00042169650342858224, 0.00031622776601683794, 0.00023713737056616554, 0.00017782794100389227, 0.0001333521432163324};

struct Args { const float* in[16]; float* out; unsigned char* ws; };

struct Frame {
    int tid, lane, wave, bid, G;
    const float *xp, *xs, *cache_k, *cache_v, *state_pool, *w_in, *w_out, *norm_pre, *norm_post, *sinks, *pool_w, *pool_scale, *ln_g, *ln_b, *sgu_w, *sgu_b;
    float* out;
    float* rope; float* RSW; float* RSTD; bf16_t *SGUW, *PWT, *WTIN, *WTOUT, *H, *MIX, *Qc, *Kc, *VTP, *Z2, *Yb;
};

__device__ __forceinline__ float wave_sum(float v) {
#pragma unroll
    for (int o = 1; o < 64; o <<= 1) v += __shfl_xor(v, o);
    return v;
}
__device__ __forceinline__ float wave_max(float v) {
#pragma unroll
    for (int o = 1; o < 64; o <<= 1) v = fmaxf(v, __shfl_xor(v, o));
    return v;
}
__device__ __forceinline__ float bflo(unsigned w) { return __uint_as_float(w << 16); }
__device__ __forceinline__ float bfhi(unsigned w) { return __uint_as_float(w & 0xffff0000u); }
__device__ __forceinline__ void unpack8(const u32x4 w, float (&f)[8]) { f[0] = bflo(w.x); f[1] = bfhi(w.x); f[2] = bflo(w.y); f[3] = bfhi(w.y); f[4] = bflo(w.z); f[5] = bfhi(w.z); f[6] = bflo(w.w); f[7] = bfhi(w.w); }
__device__ __forceinline__ void unpack4(const u32x2 w, float (&f)[4]) { f[0] = bflo(w.x); f[1] = bfhi(w.x); f[2] = bflo(w.y); f[3] = bfhi(w.y); }
__device__ __forceinline__ u32x4 pack8(const float (&f)[8]) { u32x4 w; w.x = pg8::cvt_pk_bf16(f[0], f[1]); w.y = pg8::cvt_pk_bf16(f[2], f[3]); w.z = pg8::cvt_pk_bf16(f[4], f[5]); w.w = pg8::cvt_pk_bf16(f[6], f[7]); return w; }
__device__ __forceinline__ int crow(int r, int hi) { return (r & 3) + 8 * (r >> 2) + 4 * hi; }
#define LDS_WAIT() asm volatile("s_waitcnt lgkmcnt(0)" ::: "memory")


struct ArgsG { const __attribute__((address_space(1))) float* in[16]; __attribute__((address_space(1))) float* out; __attribute__((address_space(1))) unsigned char* ws; };
typedef const __attribute__((address_space(4))) ArgsG* KArgs;
__device__ __forceinline__ KArgs kargs() { KArgs p = (KArgs)__builtin_amdgcn_kernarg_segment_ptr(); asm volatile("" : "+s"(p)); return p; }
__device__ __forceinline__ void make_frame(Frame& F, KArgs a) {
    { int t_ = threadIdx.x; asm volatile("" : "+v"(t_)); F.tid = t_; } F.lane = F.tid & 63; F.wave = __builtin_amdgcn_readfirstlane(F.tid >> 6); F.bid = blockIdx.x; F.G = gridDim.x;
    F.xp = (const float*)a->in[0]; F.xs = (const float*)a->in[1]; F.cache_k = (const float*)a->in[2]; F.cache_v = (const float*)a->in[3]; F.state_pool = (const float*)a->in[4]; F.w_in = (const float*)a->in[5]; F.w_out = (const float*)a->in[6]; F.norm_pre = (const float*)a->in[7]; F.norm_post = (const float*)a->in[8];
    F.sinks = (const float*)a->in[9]; F.pool_w = (const float*)a->in[10]; F.pool_scale = (const float*)a->in[11]; F.ln_g = (const float*)a->in[12]; F.ln_b = (const float*)a->in[13]; F.sgu_w = (const float*)a->in[14]; F.sgu_b = (const float*)a->in[15];
    F.out = (float*)a->out;
    unsigned char* ws = (unsigned char*)a->ws;
    F.rope = (float*)(ws + WS_ROPE); F.RSW = (float*)(ws + WS_RSW); F.RSTD = (float*)(ws + WS_RSTD); F.SGUW = (bf16_t*)(ws + WS_SGUW); F.PWT = (bf16_t*)(ws + WS_PWT); F.WTIN = (bf16_t*)(ws + WS_WTIN); F.WTOUT = (bf16_t*)(ws + WS_WTOUT);
    F.H = (bf16_t*)(ws + WS_H); F.MIX = (bf16_t*)(ws + WS_MIX); F.Qc = (bf16_t*)(ws + WS_QC); F.Kc = (bf16_t*)(ws + WS_KC); F.VTP = (bf16_t*)(ws + WS_VTP); F.Z2 = (bf16_t*)(ws + WS_Z2); F.Yb = (bf16_t*)(ws + WS_Y);
}

#define LOCAL_FRAME Frame F; make_frame(F, kargs())

constexpr int CW_Q = 8192;
constexpr int CW_ZS = 8192 + 64 * 8;
constexpr int CW_YS = 8192 + 64 * 16;
constexpr int CW_EV = 8192 + 64 * 32;
__device__ __forceinline__ unsigned* ctl_word(int idx) { return (unsigned*)((unsigned char*)kargs()->ws + WS_CTL) + idx; }
__device__ __forceinline__ int q_pop(unsigned* head, LAS unsigned char* L) {
    volatile LAS int* slot = (volatile LAS int*)(L + 64);
    __syncthreads();
    if (threadIdx.x == 0) *slot = (int)__hip_atomic_fetch_add(head, 1u, __ATOMIC_RELAXED, __HIP_MEMORY_SCOPE_AGENT);
    __syncthreads();
    return __builtin_amdgcn_readfirstlane(*slot);
}
__device__ __forceinline__ void publish(unsigned* ctr) {
    asm volatile("s_waitcnt vmcnt(0)" ::: "memory");
    __syncthreads();
    if (threadIdx.x == 0) { __builtin_amdgcn_fence(__ATOMIC_RELEASE, "agent"); asm volatile("s_waitcnt vmcnt(0)" ::: "memory");
        __hip_atomic_fetch_add(ctr, 1u, __ATOMIC_RELAXED, __HIP_MEMORY_SCOPE_AGENT); }
}
__device__ __forceinline__ void dep_wait(unsigned* ctr, unsigned need) {
    if (threadIdx.x == 0) {
        unsigned sp = 0;
        while (__hip_atomic_load(ctr, __ATOMIC_RELAXED, __HIP_MEMORY_SCOPE_AGENT) < need) { __builtin_amdgcn_s_sleep(16); if (++sp > (1u << 21)) break; }
        __builtin_amdgcn_fence(__ATOMIC_ACQUIRE, "agent"); asm volatile("s_waitcnt vmcnt(0)" ::: "memory");
    }
    __syncthreads();
}

#if PROBE_SEL >= 10
#define EV_T0() const unsigned long long ev_t0 = __builtin_amdgcn_s_memrealtime()
#define EV_MAX(k) do { if (threadIdx.x == 0) __hip_atomic_fetch_max(ctl_word(CW_EV + 64 * (k)), (unsigned)(__builtin_amdgcn_s_memrealtime() - ev_t0), __ATOMIC_RELAXED, __HIP_MEMORY_SCOPE_AGENT); } while (0)
#define EV_MIN(k) do { if (threadIdx.x == 0) __hip_atomic_fetch_max(ctl_word(CW_EV + 64 * (k)), 0x40000000u - (unsigned)(__builtin_amdgcn_s_memrealtime() - ev_t0), __ATOMIC_RELAXED, __HIP_MEMORY_SCOPE_AGENT); } while (0)
#else
#define EV_T0() do {} while (0)
#define EV_MAX(k) do {} while (0)
#define EV_MIN(k) do {} while (0)
#endif
struct OneUnit {
    pg8::Unit u;
    __device__ __forceinline__ bool next(int i, pg8::Unit& o) const { if (i) return false; o = u; return true; }
    __device__ __forceinline__ void a_ready(const pg8::Unit&) const {}
    __device__ __forceinline__ void done(const pg8::Unit&) const {}
};

#ifndef PROBE_SEL
#define PROBE_SEL 0
#endif
#if PROBE_SEL
#define STAMP(k) do { if (blockIdx.x == 0 && threadIdx.x == 0) ((LAS unsigned long long*)(L + 256))[k] = __builtin_amdgcn_s_memrealtime(); } while (0)
#define STAMP2(k) do { if (blockIdx.x == 0) { __syncthreads(); if (threadIdx.x == 0) ((LAS unsigned long long*)((LAS unsigned char*)ring - RING_OFF + 256))[k] = __builtin_amdgcn_s_memrealtime(); } } while (0)
#else
#define STAMP(k) do {} while (0)
#define STAMP2(k) do {} while (0)
#endif
#if PROBE_SEL == 1
#define PA0 0
#define PA1 1
#define PB0 1
#define PB1 2
#elif PROBE_SEL == 2
#define PA0 2
#define PA1 3
#define PB0 3
#define PB1 4
#elif PROBE_SEL == 3
#define PA0 4
#define PA1 5
#define PB0 8
#define PB1 9
#elif PROBE_SEL == 4
#define PA0 2
#define PA1 10
#define PB0 10
#define PB1 11
#elif PROBE_SEL == 5
#define PA0 11
#define PA1 12
#define PB0 12
#define PB1 13
#elif PROBE_SEL == 7
#define PA0 1
#define PA1 2
#define PB0 0
#define PB1 1
#elif PROBE_SEL == 8
#define PA0 3
#define PA1 4
#define PB0 2
#define PB1 3
#elif PROBE_SEL == 9
#define PA0 6
#define PA1 7
#define PB0 4
#define PB1 5
#elif PROBE_SEL == 6
#define PA0 5
#define PA1 6
#define PB0 7
#define PB1 8
#elif PROBE_SEL == 10
#define PEA 0
#define PEA_MIN 0
#define PEB 1
#define PEB_MIN 1
#elif PROBE_SEL == 11
#define PEA 2
#define PEA_MIN 0
#define PEB 3
#define PEB_MIN 1
#elif PROBE_SEL == 12
#define PEA 4
#define PEA_MIN 0
#define PEB 5
#define PEB_MIN 0
#elif PROBE_SEL == 14
#define PEA 8
#define PEA_MIN 0
#define PEB 9
#define PEB_MIN 0
#elif PROBE_SEL == 13
#define PEA 6
#define PEA_MIN 1
#define PEB 7
#define PEB_MIN 0
#endif

__device__ __forceinline__ void p0_transpose_blk(const float* W, int K, int N, bf16_t* WT, bool permqk, const float* kgain, LAS unsigned char* T, int item, int tid) {
    const int nblk = N >> 8, kb = item / nblk, nb = item - kb * nblk, k0 = kb * 128, n0 = nb * 256;
    const int n4 = tid & 63, kr = tid >> 6;
    f32x4 v[16];
#pragma unroll
    for (int i = 0; i < 16; ++i) v[i] = __builtin_nontemporal_load((const f32x4*)(W + (size_t)(k0 + 16 * kr + i) * N + n0 + 4 * n4));
    if (kgain) {
        const float* gp = kgain + k0 + 16 * kr;
#pragma unroll
        for (int i4 = 0; i4 < 4; ++i4) { const f32x4 gg = *(const f32x4*)(gp + 4 * i4);
#pragma unroll
            for (int j = 0; j < 4; ++j) v[4 * i4 + j] = v[4 * i4 + j] * gg[j]; }
    }
#pragma unroll
    for (int e = 0; e < 4; ++e) {
        u32x4 lo, hi;
        lo.x = pg8::cvt_pk_bf16(v[0][e], v[1][e]); lo.y = pg8::cvt_pk_bf16(v[2][e], v[3][e]); lo.z = pg8::cvt_pk_bf16(v[4][e], v[5][e]); lo.w = pg8::cvt_pk_bf16(v[6][e], v[7][e]);
        hi.x = pg8::cvt_pk_bf16(v[8][e], v[9][e]); hi.y = pg8::cvt_pk_bf16(v[10][e], v[11][e]); hi.z = pg8::cvt_pk_bf16(v[12][e], v[13][e]); hi.w = pg8::cvt_pk_bf16(v[14][e], v[15][e]);
        LAS unsigned char* p = T + (64 * e + n4) * 272 + 32 * kr;
        *(LAS u32x4*)p = lo; *(LAS u32x4*)(p + 16) = hi;
    }
    LDS_WAIT();
    __syncthreads();
    {
        const int rho = tid >> 1, half = tid & 1, n = n0 + 4 * (rho & 63) + (rho >> 6);
        int nrow = n;
        if (permqk && n < 1280) { const int p = n & 63; nrow = (n & ~63) + 2 * (p & 31) + (p >> 5); }
        const LAS unsigned char* src = T + rho * 272 + 128 * half;
        bf16_t* dst = WT + (size_t)nrow * K + k0 + 64 * half;
        u32x4 o[8];
#pragma unroll
        for (int c = 0; c < 8; ++c) o[c] = *(const LAS u32x4*)(src + 16 * c);
#pragma unroll
        for (int c = 0; c < 8; ++c) *(u32x4*)(dst + 8 * c) = o[c];
    }
    LDS_WAIT();
    __syncthreads();
}
__device__ __forceinline__ void prenorm_finish(const f32x4 (&v)[8], float* rstd, bf16_t* hrow, int lane) {
    float ss = 0.f;
#pragma unroll
    for (int j = 0; j < 8; ++j) ss += (v[j][0] * v[j][0] + v[j][1] * v[j][1]) + (v[j][2] * v[j][2] + v[j][3] * v[j][3]);
    ss = wave_sum(ss);
    if (lane == 0) *rstd = rsqrtf(ss * (1.0f / 2048.0f) + EPS);
#pragma unroll
    for (int j = 0; j < 8; ++j) { u32x2 w; w.x = pg8::cvt_pk_bf16(v[j][0], v[j][1]); w.y = pg8::cvt_pk_bf16(v[j][2], v[j][3]); *(u32x2*)(hrow + 4 * lane + 256 * j) = w; }
}
constexpr int TR_IN = 16 * 20, TR_OUT = 16 * 8, TR_ITEMS = TR_IN + TR_OUT;
__device__ __forceinline__ void transpose_item(const Frame& F, int l, int r, LAS unsigned char* ring) {
    if (r < TR_IN) p0_transpose_blk(F.w_in + (size_t)l * DM * DIN, DM, DIN, F.WTIN + (size_t)l * DIN * DM, true, F.norm_pre + l * DM, ring, r, F.tid);
    else p0_transpose_blk(F.w_out + (size_t)l * DM * DM, DM, DM, F.WTOUT + (size_t)l * DM * DM, false, nullptr, ring, r - TR_IN, F.tid);
}
__device__ __forceinline__ void p0_prologue(const Frame& F, LAS unsigned char* ring) {
    const int gw = F.bid * NWAVES + F.wave, NGW = F.G * NWAVES;
    EV_T0();
    for (int it = F.bid; it < TR_ITEMS; it += F.G) transpose_item(F, 0, it, ring);
    __syncthreads(); EV_MAX(8);
    for (int m = 2 * gw; m < MT; m += 2 * NGW) {
        const float* xa = m < MP ? F.xp + (size_t)m * DM : F.xs + (size_t)(m - MP) * DM; const float* xb = (m + 1) < MP ? F.xp + (size_t)(m + 1) * DM : F.xs + (size_t)(m + 1 - MP) * DM;
        f32x4 va[8], vb[8];
#pragma unroll
        for (int j = 0; j < 8; ++j) { va[j] = __builtin_nontemporal_load((const f32x4*)(xa + 4 * F.lane + 256 * j)); vb[j] = __builtin_nontemporal_load((const f32x4*)(xb + 4 * F.lane + 256 * j)); }
        prenorm_finish(va, F.RSTD + m, F.H + (size_t)m * DM, F.lane); prenorm_finish(vb, F.RSTD + m + 1, F.H + (size_t)(m + 1) * DM, F.lane); }
    __syncthreads(); EV_MAX(9);
    const int gt = F.bid * NTHREADS + F.tid, NGT = F.G * NTHREADS;
    for (int e = gt; e < 2052 * 32; e += NGT) { const int tp = e >> 5, i = e & 31; const double pos = (double)(tp < 2048 ? tp : 8192 + (tp - 2048));
        const double rev = pos * ROPE_INV[i] * 0.15915494309189535; const float fr = (float)(rev - floor(rev));
        F.rope[tp * 64 + i] = __builtin_amdgcn_cosf(fr); F.rope[tp * 64 + 32 + i] = __builtin_amdgcn_sinf(fr); }
    for (int e = gt; e < 2 * 4 * 128 * 128; e += NGT) { const int s = e & 127, t = (e >> 7) & 127; const float w = F.sgu_w[e];
        F.SGUW[e] = (bf16_t)(pg8::cvt_pk_bf16(s <= t ? w : 0.f, 0.f) & 0xffffu); }
    for (int e = gt; e < 2 * 4 * 128; e += NGT) { const int t = e & 127; const float* wr = F.sgu_w + (size_t)e * 128; float acc = 0.f;
        for (int s2 = 0; s2 <= t; ++s2) acc += __uint_as_float(pg8::cvt_pk_bf16(wr[s2], 0.f) << 16);
        F.RSW[e] = acc; }
    for (int e = gt; e < 2 * 4 * 128 * 128; e += NGT) { const int c = e & 127, d = (e >> 7) & 127, lg = e >> 14;
        F.PWT[e] = (bf16_t)(pg8::cvt_pk_bf16(F.pool_w[((size_t)lg * 128 + c) * 128 + d], 0.f) & 0xffffu); }
}

constexpr int AT_K = 0, AT_V = 49152, AT_STG = 98304, AT_WSTRIDE = 4352;
__device__ __forceinline__ void attn_stage_kv(const Frame& F, int b, int kvh, int nbp, LAS unsigned char* ring) {
    const int tid = F.tid;
    const bf16_t* kg = F.Kc + ((size_t)(b * 4 + kvh) * 2048 + 256 * nbp - 128) * 64;
    const bf16_t* vg = F.VTP + ((size_t)(b * 4 + kvh) * 64 + 8 * nbp - 4) * 2048;
    u32x4 kv[6], vv[6];
#pragma unroll
    for (int i = 0; i < 6; ++i) { const int ch = tid + 512 * i, row0 = ch >> 3, c8 = ch & 7, row = (nbp > 0 || row0 >= 128) ? row0 : row0 + 128;
        kv[i] = __builtin_nontemporal_load((const u32x4*)(kg + row * 64 + c8 * 8)); }
#pragma unroll
    for (int i = 0; i < 6; ++i) { const int ch = tid + 512 * i, tile0 = ch >> 8, rem = ch & 255, d = rem >> 2, c4 = rem & 3, tile = (nbp > 0 || tile0 >= 4) ? tile0 : tile0 + 4;
        vv[i] = __builtin_nontemporal_load((const u32x4*)(vg + tile * 2048 + d * 32 + c4 * 8)); }
#pragma unroll
    for (int i = 0; i < 6; ++i) { const int ch = tid + 512 * i, row = ch >> 3, c8 = ch & 7;
        *(LAS u32x4*)(ring + AT_K + row * 128 + ((c8 ^ (row & 7)) << 4)) = kv[i]; }
#pragma unroll
    for (int i = 0; i < 6; ++i) { const int ch = tid + 512 * i, tile = ch >> 8, rem = ch & 255, d = rem >> 2, c4 = rem & 3;
        *(LAS u32x4*)(ring + AT_V + tile * 4096 + d * 64 + ((c4 ^ ((d >> 2) & 3)) << 4)) = vv[i]; }
}
__device__ __forceinline__ void attn_task(const Frame& F, int l, int b, int nbp, int head, int j, const bf16x8 (&qf)[4], LAS unsigned char* ring) {
    const int lane = F.lane, r = lane & 31, hh = lane >> 5;
    LAS unsigned char* wl = ring + AT_STG + F.wave * AT_WSTRIDE;
    LAS float* wsf = (LAS float*)wl; LAS bf16_t* stg = (LAS bf16_t*)(wl + 256);
    const size_t qrow0 = (size_t)b * 2048 + 256 * nbp + 32 * j;
    u32x4 gv[4];
#pragma unroll
    for (int i = 0; i < 4; ++i) gv[i] = __builtin_nontemporal_load((const u32x4*)(F.Z2 + (qrow0 + i * 8 + (lane >> 3)) * ZW + Z_GA + head * 64 + (lane & 7) * 8));
    const int cmin = (nbp > 0) ? 0 : (j < 4 ? 4 - j : 0);
    f32x16 S[5];
#pragma unroll
    for (int c = 0; c < 5; ++c) {
        f32x16 a;
#pragma unroll
        for (int i = 0; i < 16; ++i) a[i] = 0.f;
        if (c >= cmin) {
            LAS unsigned char* kp = ring + AT_K + (32 * (j + c) + r) * 128;
#pragma unroll
            for (int s = 0; s < 4; ++s) a = __builtin_amdgcn_mfma_f32_32x32x16_bf16(*(const LAS bf16x8*)(kp + (((2 * s + hh) ^ (r & 7)) << 4)), qf[s], a, 0, 0, 0);
        }
        S[c] = a;
    }
    const float NEG = -INFINITY;
#pragma unroll
    for (int i = 0; i < 16; ++i) { const int kap = crow(i, hh); if (kap <= r) S[0][i] = NEG; if (kap > r) S[4][i] = NEG; }
    const float sink2 = F.sinks[l * 16 + head] * LOG2E;
    float m = sink2;
#pragma unroll
    for (int c = 0; c < 5; ++c) if (c >= cmin) {
#pragma unroll
        for (int i = 0; i < 16; ++i) m = fmaxf(m, S[c][i]); }
    m = fmaxf(m, __shfl_xor(m, 32));
    float sum = 0.f;
#pragma unroll
    for (int c = 0; c < 5; ++c) if (c >= cmin) {
#pragma unroll
        for (int i = 0; i < 16; ++i) { const float p = __builtin_amdgcn_exp2f(S[c][i] - m); S[c][i] = p; sum += p; } }
    sum += __shfl_xor(sum, 32);
    const float inv = 1.0f / (sum + __builtin_amdgcn_exp2f(sink2 - m));
    f32x16 o[2];
#pragma unroll
    for (int i = 0; i < 16; ++i) { o[0][i] = 0.f; o[1][i] = 0.f; }
#pragma unroll
    for (int c = 0; c < 5; ++c) if (c >= cmin) {
        LAS unsigned char* vt = ring + AT_V + (j + c) * 4096 + r * 64;
#pragma unroll
        for (int s = 0; s < 2; ++s) {
            u32x4 pw; pw.x = pg8::cvt_pk_bf16(S[c][8 * s + 0], S[c][8 * s + 1]); pw.y = pg8::cvt_pk_bf16(S[c][8 * s + 2], S[c][8 * s + 3]);
            pw.z = pg8::cvt_pk_bf16(S[c][8 * s + 4], S[c][8 * s + 5]); pw.w = pg8::cvt_pk_bf16(S[c][8 * s + 6], S[c][8 * s + 7]);
            const bf16x8 pa = __builtin_bit_cast(bf16x8, pw);
            const int sw = (((2 * hh + s) ^ ((r >> 2) & 3)) << 4);
#pragma unroll
            for (int db = 0; db < 2; ++db) o[db] = __builtin_amdgcn_mfma_f32_32x32x16_bf16(pa, *(const LAS bf16x8*)(vt + db * 2048 + sw), o[db], 0, 0, 0);
        }
    }
    if (hh == 0) wsf[r] = inv;
    LDS_WAIT();
#pragma unroll
    for (int i = 0; i < 16; ++i) { const int q = crow(i, hh); const float rl = wsf[q];
        stg[q * 64 + r] = (bf16_t)(pg8::cvt_pk_bf16(o[0][i] * rl, 0.f) & 0xffffu);
        stg[q * 64 + 32 + r] = (bf16_t)(pg8::cvt_pk_bf16(o[1][i] * rl, 0.f) & 0xffffu); }
    LDS_WAIT();
#pragma unroll
    for (int i = 0; i < 4; ++i) { const int row = i * 8 + (lane >> 3), ch = lane & 7;
        const u32x4 ov = *(const LAS u32x4*)(stg + row * 64 + ch * 8);
        float of[8], gf[8]; unpack8(ov, of); unpack8(gv[i], gf);
#pragma unroll
        for (int jj = 0; jj < 8; ++jj) of[jj] *= gf[jj];
        *(u32x4*)(F.MIX + (qrow0 + row) * DM + head * 64 + ch * 8) = pack8(of); }
    LDS_WAIT();
}
__device__ __forceinline__ void attn_unit(int l, int a, LAS unsigned char* ring) {
    LOCAL_FRAME;
    const int kvh = a & 3, nbp = (a >> 2) & 7, b = a >> 5;
    const int lane = F.lane, r = lane & 31, hh = lane >> 5;
    const int head = 4 * kvh + (F.wave >> 1), j0 = 4 * (F.wave & 1);
    const bf16_t* qp = F.Qc + ((size_t)b * 2048 + 256 * nbp + 32 * j0 + r) * 1024 + head * 64 + 8 * hh;
    bf16x8 qa[4], qb[4];
#pragma unroll
    for (int s = 0; s < 4; ++s) qa[s] = __builtin_nontemporal_load((const bf16x8*)(qp + 16 * s));
#ifdef EXP_ZERO_LDS
    for (int e = F.tid; e < 134144 / 16; e += NTHREADS) *(LAS u32x4*)(ring + 16 * e) = (u32x4){0u, 0u, 0u, 0u};
    LDS_WAIT(); __syncthreads();
#endif
    attn_stage_kv(F, b, kvh, nbp, ring);
    LDS_WAIT();
    __syncthreads();
#pragma unroll
    for (int s = 0; s < 4; ++s) qb[s] = __builtin_nontemporal_load((const bf16x8*)(qp + 32 * 1024 + 16 * s));
    attn_task(F, l, b, nbp, head, j0 + 0, qa, ring);
#pragma unroll
    for (int s = 0; s < 4; ++s) qa[s] = __builtin_nontemporal_load((const bf16x8*)(qp + 64 * 1024 + 16 * s));
    attn_task(F, l, b, nbp, head, j0 + 1, qb, ring);
#pragma unroll
    for (int s = 0; s < 4; ++s) qb[s] = __builtin_nontemporal_load((const bf16x8*)(qp + 96 * 1024 + 16 * s));
    attn_task(F, l, b, nbp, head, j0 + 2, qa, ring);
    attn_task(F, l, b, nbp, head, j0 + 3, qb, ring);
    __syncthreads();
}

constexpr int PL_STRIDE = 272, PL_WBYTES = 47 * 272;
template <int G>
__device__ __forceinline__ void pool_unit_p(int l, int tile, LAS unsigned char* wl) {
    LOCAL_FRAME;
    constexpr int W = 2 << G, HIST = W - 1, NROW = 32 + HIST, NLD = (NROW * 16 + 63) / 64;
    const int lane = F.lane, r = lane & 31, hh = lane >> 5;
    const size_t R0 = (size_t)32 * tile;
    const int t0 = (int)(R0 & 2047);
    {
        u32x4 x[NLD];
#pragma unroll
        for (int k = 0; k < NLD; ++k) { const int id = lane + 64 * k, lr = id >> 4, c16 = id & 15; const int lrc = lr < NROW ? lr : NROW - 1;
            const int back = HIST - lrc; const size_t grow = (back <= t0) ? R0 - back : R0;
            x[k] = __builtin_nontemporal_load((const u32x4*)(F.Z2 + grow * ZW + Z_XB + 128 * G + 8 * c16)); }
#pragma unroll
        for (int k = 0; k < NLD; ++k) { const int id = lane + 64 * k, lr = id >> 4, c16 = id & 15; if (lr < NROW) *(LAS u32x4*)(wl + lr * PL_STRIDE + c16 * 16) = x[k]; }
    }
    const size_t row = R0 + r; const int t = t0 + r;
    u32x2 gq[4][4];
#pragma unroll
    for (int db = 0; db < 4; ++db)
#pragma unroll
        for (int q = 0; q < 4; ++q) gq[db][q] = __builtin_nontemporal_load((const u32x2*)(F.Z2 + row * ZW + Z_GP + 128 * G + 32 * db + 8 * q + 4 * hh));
    const float icnt = 1.0f / (float)(W < t + 1 ? W : t + 1);
    LDS_WAIT();
    bf16x8 bfr[8];
#pragma unroll
    for (int s = 0; s < 8; ++s) {
        LAS unsigned char* bp = wl + (r + HIST) * PL_STRIDE + (16 * s + 8 * hh) * 2;
        float cur[8], sum[8]; unpack8(*(const LAS u32x4*)bp, cur);
#pragma unroll
        for (int jj = 0; jj < 8; ++jj) sum[jj] = cur[jj];
#pragma unroll
        for (int i = 1; i < W; ++i) { float f[8]; unpack8(*(const LAS u32x4*)(bp - i * PL_STRIDE), f); const float wgt = i <= t ? 1.f : 0.f;
#pragma unroll
            for (int jj = 0; jj < 8; ++jj) sum[jj] += wgt * f[jj]; }
#pragma unroll
        for (int jj = 0; jj < 8; ++jj) sum[jj] = sum[jj] * icnt - cur[jj];
        bfr[s] = __builtin_bit_cast(bf16x8, pack8(sum));
        __builtin_amdgcn_sched_barrier(0);
    }
    f32x16 acc[4];
#pragma unroll
    for (int db = 0; db < 4; ++db) {
#pragma unroll
        for (int i = 0; i < 16; ++i) acc[db][i] = 0.f;
        const bf16_t* ap = F.PWT + ((size_t)(l * 4 + G) * 128 + 32 * db + r) * 128 + 8 * hh;
#pragma unroll
        for (int s = 0; s < 8; ++s) acc[db] = __builtin_amdgcn_mfma_f32_32x32x16_bf16(*(const bf16x8*)(ap + 16 * s), bfr[s], acc[db], 0, 0, 0);
        __builtin_amdgcn_sched_barrier(0);
    }
#pragma unroll
    for (int db = 0; db < 4; ++db)
#pragma unroll
        for (int q = 0; q < 4; ++q) {
            const int col = 128 * G + 32 * db + 8 * q + 4 * hh;
            const f32x4 sc = *(const f32x4*)(F.pool_scale + l * 512 + col);
            float gf[4]; unpack4(gq[db][q], gf);
            u32x2 wv; wv.x = pg8::cvt_pk_bf16(acc[db][4 * q + 0] * sc[0] * gf[0], acc[db][4 * q + 1] * sc[1] * gf[1]);
            wv.y = pg8::cvt_pk_bf16(acc[db][4 * q + 2] * sc[2] * gf[2], acc[db][4 * q + 3] * sc[3] * gf[3]);
            *(u32x2*)(F.MIX + row * DM + 1024 + col) = wv;
        }
    LDS_WAIT();
}
__device__ __forceinline__ void pool_prompt(int l, int g, int tile, LAS unsigned char* wl) {
    if (g == 0) pool_unit_p<0>(l, tile, wl); else if (g == 1) pool_unit_p<1>(l, tile, wl); else if (g == 2) pool_unit_p<2>(l, tile, wl); else pool_unit_p<3>(l, tile, wl);
}
template <int G>
__device__ __forceinline__ void pool_unit_s(int l, int tile) {
    LOCAL_FRAME;
    constexpr int W = 2 << G;
    const int lane = F.lane, r = lane & 31, hh = lane >> 5;
    const size_t row = (size_t)MP + 32 * tile + r;
    const int tt = (int)(row & 3), bd = (int)((row - MP) >> 2);
    const float* stb = F.state_pool + ((size_t)l * 128 + bd) * 15 * 512;
    const float icnt = 1.0f / (float)W;
    bf16x8 bfr[8];
#pragma unroll
    for (int s = 0; s < 8; ++s) {
        const int c0 = 128 * G + 16 * s + 8 * hh;
        float sum[8], cur[8];
        {
            constexpr int NL = W < 4 ? W : 4;
            u32x4 zn[NL]; f32x4 sa[NL], sb[NL];
#pragma unroll
            for (int i = 0; i < NL; ++i) { const int back = i <= tt ? i : tt; int si = 15 + tt - i; si = si > 14 ? 14 : si;
                zn[i] = *(const u32x4*)(F.Z2 + (row - back) * ZW + Z_XB + c0); sa[i] = *(const f32x4*)(stb + si * 512 + c0); sb[i] = *(const f32x4*)(stb + si * 512 + c0 + 4); }
            unpack8(zn[0], cur);
#pragma unroll
            for (int jj = 0; jj < 8; ++jj) sum[jj] = cur[jj];
#pragma unroll
            for (int i = 1; i < NL; ++i) { float f[8]; unpack8(zn[i], f); const bool nw = i <= tt;
#pragma unroll
                for (int jj = 0; jj < 4; ++jj) { sum[jj] += nw ? f[jj] : sa[i][jj]; sum[4 + jj] += nw ? f[4 + jj] : sb[i][jj]; } }
        }
#pragma unroll
        for (int i0 = 4; i0 < W; i0 += 4) {
            f32x4 sa[4], sb[4];
#pragma unroll
            for (int i = 0; i < 4; ++i) { const int si = 15 + tt - (i0 + i); sa[i] = *(const f32x4*)(stb + si * 512 + c0); sb[i] = *(const f32x4*)(stb + si * 512 + c0 + 4); }
#pragma unroll
            for (int i = 0; i < 4; ++i)
#pragma unroll
                for (int jj = 0; jj < 4; ++jj) { sum[jj] += sa[i][jj]; sum[4 + jj] += sb[i][jj]; }
        }
#pragma unroll
        for (int jj = 0; jj < 8; ++jj) sum[jj] = sum[jj] * icnt - cur[jj];
        bfr[s] = __builtin_bit_cast(bf16x8, pack8(sum));
        __builtin_amdgcn_sched_barrier(0);
    }
    f32x16 acc[4];
#pragma unroll
    for (int db = 0; db < 4; ++db) {
#pragma unroll
        for (int i = 0; i < 16; ++i) acc[db][i] = 0.f;
        const bf16_t* ap = F.PWT + ((size_t)(l * 4 + G) * 128 + 32 * db + r) * 128 + 8 * hh;
#pragma unroll
        for (int s = 0; s < 8; ++s) acc[db] = __builtin_amdgcn_mfma_f32_32x32x16_bf16(*(const bf16x8*)(ap + 16 * s), bfr[s], acc[db], 0, 0, 0);
        __builtin_amdgcn_sched_barrier(0);
    }
#pragma unroll
    for (int db = 0; db < 4; ++db)
#pragma unroll
        for (int q = 0; q < 4; ++q) {
            const int col = 128 * G + 32 * db + 8 * q + 4 * hh;
            const f32x4 sc = *(const f32x4*)(F.pool_scale + l * 512 + col);
            float gf[4]; unpack4(*(const u32x2*)(F.Z2 + row * ZW + Z_GP + col), gf);
            u32x2 wv; wv.x = pg8::cvt_pk_bf16(acc[db][4 * q + 0] * sc[0] * gf[0], acc[db][4 * q + 1] * sc[1] * gf[1]);
            wv.y = pg8::cvt_pk_bf16(acc[db][4 * q + 2] * sc[2] * gf[2], acc[db][4 * q + 3] * sc[3] * gf[3]);
            *(u32x2*)(F.MIX + row * DM + 1024 + col) = wv;
        }
}
__device__ __forceinline__ void pool_sample(int l, int g, int tile) {
    if (g == 0) pool_unit_s<0>(l, tile); else if (g == 1) pool_unit_s<1>(l, tile); else if (g == 2) pool_unit_s<2>(l, tile); else pool_unit_s<3>(l, tile);
}

struct SguOps { bf16x8 wB[8], wA[4]; u32x2 uu[2][4], gg[2][4]; float bias[2], rsw[2]; };
__device__ __forceinline__ void sgu_load_ops(SguOps& o, const Frame& F, int l, int hd, size_t R0, int r, int hh, int db, int tbA, int tbB) {
    const bf16_t* Wb = F.SGUW + (size_t)(l * 4 + hd) * 128 * 128;
#pragma unroll
    for (int s = 0; s < 8; ++s) { o.wB[s] = (bf16x8){0, 0, 0, 0, 0, 0, 0, 0}; if (s < 2 * (tbB + 1)) o.wB[s] = *(const bf16x8*)(Wb + (32 * tbB + r) * 128 + 16 * s + 8 * hh); }
#pragma unroll
    for (int s = 0; s < 4; ++s) { o.wA[s] = (bf16x8){0, 0, 0, 0, 0, 0, 0, 0}; if (s < 2 * (tbA + 1)) o.wA[s] = *(const bf16x8*)(Wb + (32 * tbA + r) * 128 + 16 * s + 8 * hh); }
#pragma unroll
    for (int pass = 0; pass < 2; ++pass) { const int tb = pass ? tbB : tbA; const size_t row = R0 + 32 * tb + r;
        o.bias[pass] = F.sgu_b[l * 512 + hd * 128 + 32 * tb + r]; o.rsw[pass] = F.RSW[(l * 4 + hd) * 128 + 32 * tb + r];
#pragma unroll
        for (int q = 0; q < 4; ++q) { const int col = 128 * hd + 32 * db + 8 * q + 4 * hh;
            o.uu[pass][q] = __builtin_nontemporal_load((const u32x2*)(F.Z2 + row * ZW + Z_U + col)); o.gg[pass][q] = __builtin_nontemporal_load((const u32x2*)(F.Z2 + row * ZW + Z_GS + col)); } }
}
__device__ __forceinline__ void sgu_mfma(const SguOps& o, LAS bf16_t* VnT, int h2, int r, int hh, int db, int tbA, int tbB, f32x16& accA, f32x16& accB) {
#pragma unroll
    for (int i = 0; i < 16; ++i) { accA[i] = 0.f; accB[i] = 0.f; }
#pragma unroll
    for (int s = 0; s < 8; ++s) {
        if (s < 2 * (tbB + 1)) {
            const LAS unsigned char* ap = (const LAS unsigned char*)VnT + (h2 * 128 + 16 * s + 8 * hh + ((r & 15) >> 2)) * 320 + (32 * db + (r & 16) + 4 * (r & 3)) * 2;
            const v4i16_t lo = __builtin_amdgcn_ds_read_tr16_b64_v4i16((LAS v4i16_t*)ap), hi = __builtin_amdgcn_ds_read_tr16_b64_v4i16((LAS v4i16_t*)(ap + 4 * 320));
            const bf16x8 a = (bf16x8){lo[0], lo[1], lo[2], lo[3], hi[0], hi[1], hi[2], hi[3]};
            accB = __builtin_amdgcn_mfma_f32_32x32x16_bf16(a, o.wB[s], accB, 0, 0, 0);
            if (s < 4) { if (s < 2 * (tbA + 1)) accA = __builtin_amdgcn_mfma_f32_32x32x16_bf16(a, o.wA[s], accA, 0, 0, 0); }
        }
    }
}
__device__ __forceinline__ void sgu_epi(const SguOps& o, const Frame& F, int l, int hd, size_t R0, int r, int hh, int db, int tbA, int tbB, const f32x16& accA, const f32x16& accB) {
    f32x4 lg[4], lb[4];
#pragma unroll
    for (int q = 0; q < 4; ++q) { const int col = 128 * hd + 32 * db + 8 * q + 4 * hh; lg[q] = *(const f32x4*)(F.ln_g + l * 512 + col); lb[q] = *(const f32x4*)(F.ln_b + l * 512 + col); }
#pragma unroll
    for (int pass = 0; pass < 2; ++pass) {
        const int tb = pass ? tbB : tbA; const f32x16 acc = pass ? accB : accA;
        const size_t row = R0 + 32 * tb + r; const float bs = o.bias[pass], rs = o.rsw[pass];
#pragma unroll
        for (int q = 0; q < 4; ++q) { const int col = 128 * hd + 32 * db + 8 * q + 4 * hh;
            float uf[4], gf[4]; unpack4(o.uu[pass][q], uf); unpack4(o.gg[pass][q], gf);
            float m[4];
#pragma unroll
            for (int e = 0; e < 4; ++e) m[e] = (lg[q][e] * acc[4 * q + e] + lb[q][e] * rs + bs) * uf[e] * gf[e];
            u32x2 wo; wo.x = pg8::cvt_pk_bf16(m[0], m[1]); wo.y = pg8::cvt_pk_bf16(m[2], m[3]);
            *(u32x2*)(F.MIX + row * DM + 1536 + col) = wo; }
    }
}
__device__ __forceinline__ void sgu_unit(int l, int ci, int hp, LAS unsigned char* ring) {
    LOCAL_FRAME;
    LAS bf16_t* VnT = (LAS bf16_t*)ring;
    const int lane = F.lane, wv = F.wave;
    const size_t R0 = (size_t)128 * ci;
    const int r = lane & 31, hh = lane >> 5, db = wv & 3; const int tbA = (wv >> 2) ? 1 : 0, tbB = (wv >> 2) ? 2 : 3;
    SguOps op0;
    {
        const int tl = lane >> 2, q4 = lane & 3;
        const bf16_t* vrow = F.Z2 + (R0 + 16 * wv + tl) * ZW + Z_VS + 32 * q4;
        u32x4 x[4][4];
#pragma unroll
        for (int h = 0; h < 4; ++h)
#pragma unroll
            for (int i = 0; i < 4; ++i) x[h][i] = *(const u32x4*)(vrow + 128 * h + 8 * i);
        sgu_load_ops(op0, F, l, 2 * hp, R0, r, hh, db, tbA, tbB);
        float s = 0.f, ss = 0.f;
#pragma unroll
        for (int h = 0; h < 4; ++h)
#pragma unroll
            for (int i = 0; i < 4; ++i) { float f[8]; unpack8(x[h][i], f);
#pragma unroll
                for (int jj = 0; jj < 8; ++jj) { s += f[jj]; ss += f[jj] * f[jj]; } }
        s += __shfl_xor(s, 1); s += __shfl_xor(s, 2); ss += __shfl_xor(ss, 1); ss += __shfl_xor(ss, 2);
        const float mean = s * (1.0f / 512.0f), var = ss * (1.0f / 512.0f) - mean * mean, rstd = rsqrtf(var + EPS);
#pragma unroll
        for (int h2 = 0; h2 < 2; ++h2)
#pragma unroll
            for (int i = 0; i < 4; ++i) { const int d = 32 * q4 + 8 * i;
                const u32x4 xv = hp ? x[2 + h2][i] : x[h2][i];
                float f[8]; unpack8(xv, f);
#pragma unroll
                for (int jj = 0; jj < 8; ++jj) f[jj] = (f[jj] - mean) * rstd;
                *(LAS u32x4*)((LAS unsigned char*)VnT + (h2 * 128 + 16 * wv + tl) * 320 + d * 2) = pack8(f); }
    }
    LDS_WAIT();
    __syncthreads();
    f32x16 accA, accB;
    sgu_mfma(op0, VnT, 0, r, hh, db, tbA, tbB, accA, accB);
    SguOps op1;
    sgu_load_ops(op1, F, l, 2 * hp + 1, R0, r, hh, db, tbA, tbB);
    sgu_epi(op0, F, l, 2 * hp, R0, r, hh, db, tbA, tbB, accA, accB);
    sgu_mfma(op1, VnT, 1, r, hh, db, tbA, tbB, accA, accB);
    sgu_epi(op1, F, l, 2 * hp + 1, R0, r, hh, db, tbA, tbB, accA, accB);
    __syncthreads();
}

__device__ __forceinline__ void samp_attn(int l, int bd, int kvh, LAS unsigned char* wl) {
    LOCAL_FRAME;
    LAS float* ps = (LAS float*)wl;
    LAS float* invs = ps + 144 * 16;
    const int lane = F.lane, fr = lane & 15, fq = lane >> 4, gq = fr >> 2, tt = fr & 3;
    float* oKs = F.out + O_KS + (size_t)l * LS_KS; float* oVs = F.out + O_VS + (size_t)l * LS_KS;
    bf16x8 qfr[2];
    {
        const bf16_t* qsrc = F.Qc + ((size_t)MP + 4 * bd + tt) * 1024 + (4 * kvh + gq) * 64 + 16 * fq;
        const u32x4 qa = *(const u32x4*)qsrc, qb = *(const u32x4*)(qsrc + 8);
        u32x4 lo, hi;
        lo.x = (qa.x & 0xffffu) | (qa.y << 16); lo.y = (qa.z & 0xffffu) | (qa.w << 16); lo.z = (qb.x & 0xffffu) | (qb.y << 16); lo.w = (qb.z & 0xffffu) | (qb.w << 16);
        hi.x = (qa.x >> 16) | (qa.y & 0xffff0000u); hi.y = (qa.z >> 16) | (qa.w & 0xffff0000u); hi.z = (qb.x >> 16) | (qb.y & 0xffff0000u); hi.w = (qb.z >> 16) | (qb.w & 0xffff0000u);
        qfr[0] = __builtin_bit_cast(bf16x8, lo); qfr[1] = __builtin_bit_cast(bf16x8, hi);
    }
    const float* kc = F.cache_k + (((size_t)l * 128 + bd) * 128) * 256 + kvh * 64 + 8 * fq;
    const float* kn = oKs + (((size_t)bd * 128 + 124 + (fr & 3)) * 4 + kvh) * 64 + 8 * fq;
    float* kd = oKs + ((size_t)bd * 128 * 4 + kvh) * 64 + 8 * fq;
    f32x4 S[9];
#pragma unroll
    for (int T = 0; T < 9; ++T) S[T] = (f32x4){0.f, 0.f, 0.f, 0.f};
#pragma unroll
    for (int T0 = 0; T0 < 9; T0 += 3) {
        f32x4 x[3][2][2];
#pragma unroll
        for (int u = 0; u < 3; ++u) { const int T = T0 + u; const float* src = (T < 8) ? kc + (size_t)(16 * T + fr) * 256 : kn;
#pragma unroll
            for (int ks = 0; ks < 2; ++ks) { x[u][ks][0] = __builtin_nontemporal_load((const f32x4*)(src + 32 * ks)); x[u][ks][1] = __builtin_nontemporal_load((const f32x4*)(src + 32 * ks + 4)); } }
#pragma unroll
        for (int u = 0; u < 3; ++u) { const int T = T0 + u; const int key = 16 * T + fr;
            if (T < 8 && key >= 4) {
#pragma unroll
                for (int ks = 0; ks < 2; ++ks) { float* dst = kd + (size_t)(key - 4) * 256 + 32 * ks; __builtin_nontemporal_store(x[u][ks][0], (f32x4*)dst); __builtin_nontemporal_store(x[u][ks][1], (f32x4*)(dst + 4)); } } }
#pragma unroll
        for (int u = 0; u < 3; ++u)
#pragma unroll
            for (int ks = 0; ks < 2; ++ks) { u32x4 w; w.x = pg8::cvt_pk_bf16(x[u][ks][0][0], x[u][ks][0][1]); w.y = pg8::cvt_pk_bf16(x[u][ks][0][2], x[u][ks][0][3]);
                w.z = pg8::cvt_pk_bf16(x[u][ks][1][0], x[u][ks][1][1]); w.w = pg8::cvt_pk_bf16(x[u][ks][1][2], x[u][ks][1][3]);
                S[T0 + u] = __builtin_amdgcn_mfma_f32_16x16x32_bf16(__builtin_bit_cast(bf16x8, w), qfr[ks], S[T0 + u], 0, 0, 0); }
        __builtin_amdgcn_sched_barrier(0);
    }
    const float sink2 = F.sinks[l * 16 + 4 * kvh + gq] * LOG2E;
    float m = sink2;
#pragma unroll
    for (int T = 0; T < 9; ++T)
#pragma unroll
        for (int rg = 0; rg < 4; ++rg) { const int key = 16 * T + 4 * fq + rg; const bool ok = (T < 8) ? (key >= tt + 1) : (fq == 0 && rg <= tt);
            S[T][rg] = ok ? S[T][rg] : -INFINITY; m = fmaxf(m, S[T][rg]); }
    m = fmaxf(m, __shfl_xor(m, 16)); m = fmaxf(m, __shfl_xor(m, 32));
    float sum = 0.f;
#pragma unroll
    for (int T = 0; T < 9; ++T)
#pragma unroll
        for (int rg = 0; rg < 4; ++rg) { const float p = __builtin_amdgcn_exp2f(S[T][rg] - m); sum += p; ps[(16 * T + 4 * fq + rg) * 16 + fr] = p; }
    sum += __shfl_xor(sum, 16); sum += __shfl_xor(sum, 32);
    if (fq == 0) invs[fr] = 1.0f / (sum + __builtin_amdgcn_exp2f(sink2 - m));
    LDS_WAIT();
    const int kq = lane >> 4, dq = lane & 15;
    const float* vcp = F.cache_v + (((size_t)l * 128 + bd) * 128 + kq) * 256 + kvh * 64 + 4 * dq;
    float* vop = oVs + ((size_t)bd * 128 + kq) * 256 + kvh * 64 + 4 * dq;
#pragma unroll 1
    for (int pass = 0; pass < 2; ++pass) {
        float o[8][4];
#pragma unroll
        for (int q = 0; q < 8; ++q) { o[q][0] = 0.f; o[q][1] = 0.f; o[q][2] = 0.f; o[q][3] = 0.f; }
#pragma unroll 1
        for (int blk = 0; blk < 3; ++blk) {
            f32x4 vx[11];
#pragma unroll
            for (int ii = 0; ii < 11; ++ii) { const int i = blk * 11 + ii; const float* src = (i < 32) ? vcp + (size_t)i * 1024 : vop + (size_t)31 * 1024; vx[ii] = __builtin_nontemporal_load((const f32x4*)src); }
            if (pass == 0) {
#pragma unroll
                for (int ii = 0; ii < 11; ++ii) { const int i = blk * 11 + ii; if (i >= 1 && i < 32) __builtin_nontemporal_store(vx[ii], (f32x4*)(vop + (size_t)(i - 1) * 1024)); } }
#pragma unroll
            for (int ii = 0; ii < 11; ++ii) { const int key = 4 * (blk * 11 + ii) + kq;
                const f32x4 pa = *(const LAS f32x4*)(ps + key * 16 + 8 * pass), pb = *(const LAS f32x4*)(ps + key * 16 + 8 * pass + 4);
#pragma unroll
                for (int e = 0; e < 4; ++e) { o[0][e] += pa[0] * vx[ii][e]; o[1][e] += pa[1] * vx[ii][e]; o[2][e] += pa[2] * vx[ii][e]; o[3][e] += pa[3] * vx[ii][e];
                    o[4][e] += pb[0] * vx[ii][e]; o[5][e] += pb[1] * vx[ii][e]; o[6][e] += pb[2] * vx[ii][e]; o[7][e] += pb[3] * vx[ii][e]; }
                __builtin_amdgcn_sched_barrier(0); }
        }
#pragma unroll
        for (int q = 0; q < 8; ++q)
#pragma unroll
            for (int e = 0; e < 4; ++e) { float v = o[q][e]; v += __shfl_xor(v, 16); v += __shfl_xor(v, 32); o[q][e] = v; }
#pragma unroll
        for (int q = 0; q < 8; ++q) if ((q >> 1) == kq) { const int qq = 8 * pass + q, t2 = qq & 3, head = 4 * kvh + (qq >> 2); const size_t row = (size_t)MP + 4 * bd + t2;
            float gf[4]; unpack4(*(const u32x2*)(F.Z2 + row * ZW + Z_GA + head * 64 + 4 * dq), gf);
            const float iq = invs[qq];
            u32x2 wv; wv.x = pg8::cvt_pk_bf16(o[q][0] * iq * gf[0], o[q][1] * iq * gf[1]); wv.y = pg8::cvt_pk_bf16(o[q][2] * iq * gf[2], o[q][3] * iq * gf[3]);
            *(u32x2*)(F.MIX + row * DM + head * 64 + 4 * dq) = wv; }
    }
    LDS_WAIT();
}
__device__ __forceinline__ void samp_sgu(int l, int bd) {
    LOCAL_FRAME;
    const int lane = F.lane, c0 = 8 * lane, hd = lane >> 4;
    {
        float* oPs = F.out + O_PS + (size_t)l * LS_PS + (size_t)bd * 15 * 512; const float* sp = F.state_pool + (size_t)l * LS_PS + (size_t)bd * 15 * 512 + 4 * 512;
        f32x4 cp[22];
#pragma unroll
        for (int k = 0; k < 22; ++k) cp[k] = __builtin_nontemporal_load((const f32x4*)(sp + 4 * (lane + 64 * k)));
#pragma unroll
        for (int k = 0; k < 22; ++k) __builtin_nontemporal_store(cp[k], (f32x4*)(oPs + 4 * (lane + 64 * k)));
    }
    float* oCV = F.out + O_CV + (size_t)l * LS_CV;
    float gl[8], bl[8];
#pragma unroll
    for (int j = 0; j < 8; ++j) { gl[j] = F.ln_g[l * 512 + c0 + j]; bl[j] = F.ln_b[l * 512 + c0 + j]; }
    u32x4 xr[4], ur[4], gr[4];
#pragma unroll
    for (int tt = 0; tt < 4; ++tt) { const size_t row = (size_t)MP + 4 * bd + tt; xr[tt] = *(const u32x4*)(F.Z2 + row * ZW + Z_VS + c0); ur[tt] = *(const u32x4*)(F.Z2 + row * ZW + Z_U + c0); gr[tt] = *(const u32x4*)(F.Z2 + row * ZW + Z_GS + c0); }
    float vn[4][8];
#pragma unroll
    for (int tt = 0; tt < 4; ++tt) { float f[8]; unpack8(xr[tt], f);
        float s = 0.f, ss = 0.f;
#pragma unroll
        for (int j = 0; j < 8; ++j) { s += f[j]; ss += f[j] * f[j]; }
        s = wave_sum(s); ss = wave_sum(ss);
        const float mean = s * (1.0f / 512.0f), var = ss * (1.0f / 512.0f) - mean * mean, rstd = rsqrtf(var + EPS);
#pragma unroll
        for (int j = 0; j < 8; ++j) vn[tt][j] = (f[j] - mean) * rstd * gl[j] + bl[j];
        float* o = oCV + ((size_t)bd * 4 + tt) * 512 + c0;
        *(f32x4*)o = (f32x4){vn[tt][0], vn[tt][1], vn[tt][2], vn[tt][3]}; *(f32x4*)(o + 4) = (f32x4){vn[tt][4], vn[tt][5], vn[tt][6], vn[tt][7]}; }
#pragma unroll
    for (int tt = 0; tt < 4; ++tt) { const size_t row = (size_t)MP + 4 * bd + tt;
        float mx[8]; const float bias = F.sgu_b[l * 512 + hd * 128 + tt];
#pragma unroll
        for (int j = 0; j < 8; ++j) mx[j] = bias;
#pragma unroll
        for (int s2 = 0; s2 < 4; ++s2) if (s2 <= tt) { const float w = F.sgu_w[((size_t)(l * 4 + hd) * 128 + tt) * 128 + s2];
#pragma unroll
            for (int j = 0; j < 8; ++j) mx[j] += w * vn[s2][j]; }
        float uf[8], gf[8]; unpack8(ur[tt], uf); unpack8(gr[tt], gf);
#pragma unroll
        for (int j = 0; j < 8; ++j) mx[j] = mx[j] * uf[j] * gf[j];
        *(u32x4*)(F.MIX + row * DM + 1536 + c0) = pack8(mx); }
}

#ifdef HYBRID
__device__ __forceinline__ void attn_task_o(const Frame& F, int l, int b, int nb, int head, int qs, LAS unsigned char* wl) {
    const int lane = F.lane, r = lane & 31, hh = lane >> 5, kvh = head >> 2;
    LAS float* wsf = (LAS float*)wl; LAS bf16_t* stg = (LAS bf16_t*)(wl + 256);
    const int t0 = 128 * nb + 32 * qs;
    const size_t qrow0 = (size_t)b * 2048 + t0;
    const bf16_t* qp = F.Qc + (qrow0 + r) * 1024 + head * 64 + 8 * hh;
    bf16x8 qf[4];
#pragma unroll
    for (int s = 0; s < 4; ++s) qf[s] = *(const bf16x8*)(qp + 16 * s);
    const bf16_t* kbase = F.Kc + (size_t)(b * 4 + kvh) * 2048 * 64;
    const bf16_t* vbase = F.VTP + (size_t)(b * 4 + kvh) * 64 * 2048;
    const int cmin = (nb > 0) ? 0 : (4 - qs);
    f32x16 S[5];
#pragma unroll
    for (int c = 0; c < 5; ++c) {
        f32x16 a;
#pragma unroll
        for (int i = 0; i < 16; ++i) a[i] = 0.f;
        if (c >= cmin) {
            const bf16_t* kp = kbase + (size_t)(t0 - 128 + 32 * c + r) * 64 + 8 * hh;
#pragma unroll
            for (int s = 0; s < 4; ++s) a = __builtin_amdgcn_mfma_f32_32x32x16_bf16(*(const bf16x8*)(kp + 16 * s), qf[s], a, 0, 0, 0);
        }
        S[c] = a;
    }
    const float NEG = -INFINITY;
#pragma unroll
    for (int i = 0; i < 16; ++i) { const int kap = crow(i, hh); if (kap <= r) S[0][i] = NEG; if (kap > r) S[4][i] = NEG; }
    const float sink2 = F.sinks[l * 16 + head] * LOG2E;
    float m = sink2;
#pragma unroll
    for (int c = 0; c < 5; ++c) if (c >= cmin) {
#pragma unroll
        for (int i = 0; i < 16; ++i) m = fmaxf(m, S[c][i]); }
    m = fmaxf(m, __shfl_xor(m, 32));
    float sum = 0.f;
#pragma unroll
    for (int c = 0; c < 5; ++c) if (c >= cmin) {
#pragma unroll
        for (int i = 0; i < 16; ++i) { const float p = __builtin_amdgcn_exp2f(S[c][i] - m); S[c][i] = p; sum += p; } }
    sum += __shfl_xor(sum, 32);
    const float inv = 1.0f / (sum + __builtin_amdgcn_exp2f(sink2 - m));
    f32x16 o[2];
#pragma unroll
    for (int i = 0; i < 16; ++i) { o[0][i] = 0.f; o[1][i] = 0.f; }
#pragma unroll
    for (int c = 0; c < 5; ++c) if (c >= cmin) {
        const bf16_t* vt = vbase + (size_t)((t0 - 128 + 32 * c) >> 5) * 2048 + r * 32 + 16 * hh;
#pragma unroll
        for (int s = 0; s < 2; ++s) {
            u32x4 pw; pw.x = pg8::cvt_pk_bf16(S[c][8 * s + 0], S[c][8 * s + 1]); pw.y = pg8::cvt_pk_bf16(S[c][8 * s + 2], S[c][8 * s + 3]);
            pw.z = pg8::cvt_pk_bf16(S[c][8 * s + 4], S[c][8 * s + 5]); pw.w = pg8::cvt_pk_bf16(S[c][8 * s + 6], S[c][8 * s + 7]);
            const bf16x8 pa = __builtin_bit_cast(bf16x8, pw);
#pragma unroll
            for (int db = 0; db < 2; ++db) o[db] = __builtin_amdgcn_mfma_f32_32x32x16_bf16(pa, *(const bf16x8*)(vt + db * 1024 + 8 * s), o[db], 0, 0, 0);
        }
    }
    if (hh == 0) wsf[r] = inv;
    LDS_WAIT();
#pragma unroll
    for (int i = 0; i < 16; ++i) { const int q = crow(i, hh); const float rl = wsf[q];
        stg[q * 64 + r] = (bf16_t)(pg8::cvt_pk_bf16(o[0][i] * rl, 0.f) & 0xffffu);
        stg[q * 64 + 32 + r] = (bf16_t)(pg8::cvt_pk_bf16(o[1][i] * rl, 0.f) & 0xffffu); }
    LDS_WAIT();
#pragma unroll
    for (int i = 0; i < 4; ++i) { const int row = i * 8 + (lane >> 3), ch = lane & 7;
        const u32x4 ov = *(const LAS u32x4*)(stg + row * 64 + ch * 8);
        const u32x4 gv = *(const u32x4*)(F.Z2 + (qrow0 + row) * ZW + Z_GA + head * 64 + ch * 8);
        float of[8], gf[8]; unpack8(ov, of); unpack8(gv, gf);
#pragma unroll
        for (int j = 0; j < 8; ++j) of[j] *= gf[j];
        *(u32x4*)(F.MIX + (qrow0 + row) * DM + head * 64 + ch * 8) = pack8(of); }
    LDS_WAIT();
}

template <bool SAMPLE>
__device__ __forceinline__ void pool_unit_o(const Frame& F, int l, int g, int tile) {
    const int lane = F.lane, r = lane & 31, hh = lane >> 5, w = 2 << g;
    const size_t row = (size_t)(SAMPLE ? MP : 0) + 32 * tile + r;
    const int t = SAMPLE ? (int)(row & 3) : (int)(row & 2047);
    const int bd = SAMPLE ? (int)((row - MP) >> 2) : 0;
    const float icnt = SAMPLE ? 1.0f / (float)w : 1.0f / (float)(w < t + 1 ? w : t + 1);
    bf16x8 bfr[8];
#pragma unroll
    for (int s = 0; s < 8; ++s) {
        const int c0 = 128 * g + 16 * s + 8 * hh;
        float sum[8], cur[8];
#pragma unroll
        for (int j = 0; j < 8; ++j) { sum[j] = 0.f; cur[j] = 0.f; }
        for (int i = 0; i < w; ++i) {
            float f[8];
            const int e = t - i;
            if (e >= 0) { unpack8(*(const u32x4*)(F.Z2 + (row - i) * ZW + Z_XB + c0), f); }
            else if (SAMPLE) { const float* sp = F.state_pool + (((size_t)l * 128 + bd) * 15 + 15 + e) * 512 + c0;
                const f32x4 a = *(const f32x4*)sp, bq = *(const f32x4*)(sp + 4); f[0] = a[0]; f[1] = a[1]; f[2] = a[2]; f[3] = a[3]; f[4] = bq[0]; f[5] = bq[1]; f[6] = bq[2]; f[7] = bq[3]; }
            else {
#pragma unroll
                for (int j = 0; j < 8; ++j) f[j] = 0.f; }
#pragma unroll
            for (int j = 0; j < 8; ++j) sum[j] += f[j];
            if (i == 0) {
#pragma unroll
                for (int j = 0; j < 8; ++j) cur[j] = f[j]; }
        }
        float pf[8];
#pragma unroll
        for (int j = 0; j < 8; ++j) pf[j] = sum[j] * icnt - cur[j];
        bfr[s] = __builtin_bit_cast(bf16x8, pack8(pf));
    }
    f32x16 acc[4];
#pragma unroll
    for (int db = 0; db < 4; ++db) {
#pragma unroll
        for (int i = 0; i < 16; ++i) acc[db][i] = 0.f;
        const bf16_t* ap = F.PWT + ((size_t)(l * 4 + g) * 128 + 32 * db + r) * 128 + 8 * hh;
#pragma unroll
        for (int s = 0; s < 8; ++s) acc[db] = __builtin_amdgcn_mfma_f32_32x32x16_bf16(*(const bf16x8*)(ap + 16 * s), bfr[s], acc[db], 0, 0, 0);
    }
#pragma unroll
    for (int db = 0; db < 4; ++db)
#pragma unroll
        for (int q = 0; q < 4; ++q) {
            const int col = 128 * g + 32 * db + 8 * q + 4 * hh;
            const f32x4 sc = *(const f32x4*)(F.pool_scale + l * 512 + col);
            float gf[4]; unpack4(*(const u32x2*)(F.Z2 + row * ZW + Z_GP + col), gf);
            u32x2 wv; wv.x = pg8::cvt_pk_bf16(acc[db][4 * q + 0] * sc[0] * gf[0], acc[db][4 * q + 1] * sc[1] * gf[1]);
            wv.y = pg8::cvt_pk_bf16(acc[db][4 * q + 2] * sc[2] * gf[2], acc[db][4 * q + 3] * sc[3] * gf[3]);
            *(u32x2*)(F.MIX + row * DM + 1024 + col) = wv;
        }
}

__device__ __forceinline__ void sgu_unit_o(const Frame& F, int l, int ci, int hd, LAS unsigned char* ring) {
    LAS bf16_t* VnT = (LAS bf16_t*)ring;
    const int lane = F.lane, wv = F.wave;
    const size_t R0 = (size_t)128 * ci;
    {
        const int tl = lane >> 2, q4 = lane & 3;
        const bf16_t* vrow = F.Z2 + (R0 + 16 * wv + tl) * ZW + Z_VS;
        float s = 0.f, ss = 0.f;
#pragma unroll
        for (int i = 0; i < 16; ++i) { float f[8]; unpack8(*(const u32x4*)(vrow + 128 * q4 + 8 * i), f);
#pragma unroll
            for (int j = 0; j < 8; ++j) { s += f[j]; ss += f[j] * f[j]; } }
        s += __shfl_xor(s, 1); s += __shfl_xor(s, 2); ss += __shfl_xor(ss, 1); ss += __shfl_xor(ss, 2);
        const float mean = s * (1.0f / 512.0f), var = ss * (1.0f / 512.0f) - mean * mean, rstd = rsqrtf(var + EPS);
#pragma unroll
        for (int i = 0; i < 4; ++i) { const int d = 32 * q4 + 8 * i; float f[8]; unpack8(*(const u32x4*)(vrow + 128 * hd + d), f);
            const float* gp = F.ln_g + l * 512 + 128 * hd + d; const float* bp = F.ln_b + l * 512 + 128 * hd + d;
#pragma unroll
            for (int j = 0; j < 8; ++j) { const float vn = (f[j] - mean) * rstd * gp[j] + bp[j];
                VnT[(d + j) * 136 + 16 * wv + tl] = (bf16_t)(pg8::cvt_pk_bf16(vn, 0.f) & 0xffffu); } }
    }
    __syncthreads();
    {
        const int r = lane & 31, hh = lane >> 5, db = wv & 3; const int tbA = (wv >> 2) ? 1 : 0, tbB = (wv >> 2) ? 2 : 3;
        f32x16 accA, accB;
#pragma unroll
        for (int i = 0; i < 16; ++i) { accA[i] = 0.f; accB[i] = 0.f; }
        const bf16_t* Wb = F.SGUW + (size_t)(l * 4 + hd) * 128 * 128;
#pragma unroll
        for (int s = 0; s < 8; ++s) {
            if (s < 2 * (tbB + 1)) {
                const bf16x8 a = *(const LAS bf16x8*)(VnT + (32 * db + r) * 136 + 16 * s + 8 * hh);
                accB = __builtin_amdgcn_mfma_f32_32x32x16_bf16(a, *(const bf16x8*)(Wb + (32 * tbB + r) * 128 + 16 * s + 8 * hh), accB, 0, 0, 0);
                if (s < 2 * (tbA + 1)) accA = __builtin_amdgcn_mfma_f32_32x32x16_bf16(a, *(const bf16x8*)(Wb + (32 * tbA + r) * 128 + 16 * s + 8 * hh), accA, 0, 0, 0);
            }
        }
#pragma unroll
        for (int pass = 0; pass < 2; ++pass) {
            const int tb = pass ? tbB : tbA; const f32x16 acc = pass ? accB : accA;
            const int t = 32 * tb + r; const size_t row = R0 + t; const float bias = F.sgu_b[l * 512 + hd * 128 + t];
#pragma unroll
            for (int q = 0; q < 4; ++q) { const int col = 128 * hd + 32 * db + 8 * q + 4 * hh;
                float uf[4], gf[4]; unpack4(*(const u32x2*)(F.Z2 + row * ZW + Z_U + col), uf); unpack4(*(const u32x2*)(F.Z2 + row * ZW + Z_GS + col), gf);
                u32x2 wo; wo.x = pg8::cvt_pk_bf16((acc[4 * q + 0] + bias) * uf[0] * gf[0], (acc[4 * q + 1] + bias) * uf[1] * gf[1]);
                wo.y = pg8::cvt_pk_bf16((acc[4 * q + 2] + bias) * uf[2] * gf[2], (acc[4 * q + 3] + bias) * uf[3] * gf[3]);
                *(u32x2*)(F.MIX + row * DM + 1536 + col) = wo; }
        }
    }
    __syncthreads();
}

__device__ __forceinline__ void samp_attn_o(const Frame& F, int l, int bd, int kvh, LAS unsigned char* wl) {
    LAS float* qs = (LAS float*)wl;
    LAS float* ps = (LAS float*)(wl + 4096);
    const int lane = F.lane;
    float* oKs = F.out + O_KS + (size_t)l * LS_KS; float* oVs = F.out + O_VS + (size_t)l * LS_KS;
    {
        const int qi = lane >> 2, part = lane & 3, gq = qi >> 2, tt = qi & 3;
        const bf16_t* src = F.Qc + ((size_t)MP + 4 * bd + tt) * 1024 + (4 * kvh + gq) * 64 + 16 * part;
        float f0[8], f1[8]; unpack8(*(const u32x4*)src, f0); unpack8(*(const u32x4*)(src + 8), f1);
#pragma unroll
        for (int j = 0; j < 8; ++j) { const int p0 = 16 * part + j, p1 = p0 + 8;
            qs[qi * 64 + (p0 >> 1) + 32 * (p0 & 1)] = f0[j]; qs[qi * 64 + (p1 >> 1) + 32 * (p1 & 1)] = f1[j]; }
    }
    LDS_WAIT();
    float s0[16], s1[16], s2[16];
#pragma unroll
    for (int q = 0; q < 16; ++q) { s0[q] = 0.f; s1[q] = 0.f; s2[q] = 0.f; }
    const float* k0p = F.cache_k + (((size_t)l * 128 + bd) * 128 + lane) * 256 + kvh * 64;
    const float* k1p = k0p + 64 * 256;
    const float* k2p = oKs + (((size_t)bd * 128 + 124 + (lane & 3)) * 4 + kvh) * 64;
    float* c0p = oKs + (((size_t)bd * 128 + (lane >= 4 ? lane - 4 : 0)) * 4 + kvh) * 64;
    float* c1p = oKs + (((size_t)bd * 128 + lane + 60) * 4 + kvh) * 64;
    for (int ch = 0; ch < 16; ++ch) {
        const f32x4 kx0 = *(const f32x4*)(k0p + 4 * ch), kx1 = *(const f32x4*)(k1p + 4 * ch), kx2 = *(const f32x4*)(k2p + 4 * ch);
        if (lane >= 4) *(f32x4*)(c0p + 4 * ch) = kx0;
        *(f32x4*)(c1p + 4 * ch) = kx1;
#pragma unroll
        for (int q = 0; q < 16; ++q) { const f32x4 qv = *(const LAS f32x4*)(qs + q * 64 + 4 * ch);
            s0[q] += (qv[0] * kx0[0] + qv[1] * kx0[1]) + (qv[2] * kx0[2] + qv[3] * kx0[3]);
            s1[q] += (qv[0] * kx1[0] + qv[1] * kx1[1]) + (qv[2] * kx1[2] + qv[3] * kx1[3]);
            s2[q] += (qv[0] * kx2[0] + qv[1] * kx2[1]) + (qv[2] * kx2[2] + qv[3] * kx2[3]); }
    }
    float inv[16];
#pragma unroll
    for (int q = 0; q < 16; ++q) {
        const int tt = q & 3; const float sink2 = F.sinks[l * 16 + 4 * kvh + (q >> 2)] * LOG2E;
        const bool v0 = lane >= tt + 1, v2 = (lane < 4) && (lane <= tt);
        float m = s1[q]; if (v0) m = fmaxf(m, s0[q]); if (v2) m = fmaxf(m, s2[q]);
        m = fmaxf(wave_max(m), sink2);
        const float p0 = v0 ? __builtin_amdgcn_exp2f(s0[q] - m) : 0.f, p1 = __builtin_amdgcn_exp2f(s1[q] - m), p2 = v2 ? __builtin_amdgcn_exp2f(s2[q] - m) : 0.f;
        const float sum = wave_sum(p0 + p1 + p2);
        inv[q] = 1.0f / (sum + __builtin_amdgcn_exp2f(sink2 - m));
        ps[lane * 16 + q] = p0; ps[(lane + 64) * 16 + q] = p1; if (lane < 4) ps[(128 + lane) * 16 + q] = p2;
    }
    LDS_WAIT();
    float o[16];
#pragma unroll
    for (int q = 0; q < 16; ++q) o[q] = 0.f;
    const float* vcp = F.cache_v + (((size_t)l * 128 + bd) * 128) * 256 + kvh * 64 + lane;
    float* vop = oVs + ((size_t)bd * 128) * 256 + kvh * 64 + lane;
    for (int key = 0; key < 132; ++key) {
        float v;
        if (key < 128) { v = vcp[(size_t)key * 256]; if (key >= 4) vop[(size_t)(key - 4) * 256] = v; }
        else v = vop[(size_t)(key - 4) * 256];
#pragma unroll
        for (int q4 = 0; q4 < 4; ++q4) { const f32x4 pv = *(const LAS f32x4*)(ps + key * 16 + 4 * q4);
            o[4 * q4 + 0] += pv[0] * v; o[4 * q4 + 1] += pv[1] * v; o[4 * q4 + 2] += pv[2] * v; o[4 * q4 + 3] += pv[3] * v; }
    }
#pragma unroll
    for (int q = 0; q < 16; ++q) { const int tt = q & 3, head = 4 * kvh + (q >> 2); const size_t row = (size_t)MP + 4 * bd + tt;
        const float gv = __uint_as_float(((unsigned)F.Z2[row * ZW + Z_GA + head * 64 + lane]) << 16);
        F.MIX[row * DM + head * 64 + lane] = (bf16_t)(pg8::cvt_pk_bf16(o[q] * inv[q] * gv, 0.f) & 0xffffu); }
    LDS_WAIT();
}
__device__ __forceinline__ void samp_sgu_o(const Frame& F, int l, int bd) {
    const int lane = F.lane, c0 = 8 * lane, hd = lane >> 4;
    float* oCV = F.out + O_CV + (size_t)l * LS_CV;
    float gl[8], bl[8];
#pragma unroll
    for (int j = 0; j < 8; ++j) { gl[j] = F.ln_g[l * 512 + c0 + j]; bl[j] = F.ln_b[l * 512 + c0 + j]; }
    float vn[4][8];
#pragma unroll
    for (int tt = 0; tt < 4; ++tt) { const size_t row = (size_t)MP + 4 * bd + tt; float f[8]; unpack8(*(const u32x4*)(F.Z2 + row * ZW + Z_VS + c0), f);
        float s = 0.f, ss = 0.f;
#pragma unroll
        for (int j = 0; j < 8; ++j) { s += f[j]; ss += f[j] * f[j]; }
        s = wave_sum(s); ss = wave_sum(ss);
        const float mean = s * (1.0f / 512.0f), var = ss * (1.0f / 512.0f) - mean * mean, rstd = rsqrtf(var + EPS);
#pragma unroll
        for (int j = 0; j < 8; ++j) vn[tt][j] = (f[j] - mean) * rstd * gl[j] + bl[j];
        float* o = oCV + ((size_t)bd * 4 + tt) * 512 + c0;
        *(f32x4*)o = (f32x4){vn[tt][0], vn[tt][1], vn[tt][2], vn[tt][3]}; *(f32x4*)(o + 4) = (f32x4){vn[tt][4], vn[tt][5], vn[tt][6], vn[tt][7]}; }
#pragma unroll
    for (int tt = 0; tt < 4; ++tt) { const size_t row = (size_t)MP + 4 * bd + tt;
        float mx[8]; const float bias = F.sgu_b[l * 512 + hd * 128 + tt];
#pragma unroll
        for (int j = 0; j < 8; ++j) mx[j] = bias;
#pragma unroll
        for (int s2 = 0; s2 < 4; ++s2) if (s2 <= tt) { const float w = F.sgu_w[((size_t)(l * 4 + hd) * 128 + tt) * 128 + s2];
#pragma unroll
            for (int j = 0; j < 8; ++j) mx[j] += w * vn[s2][j]; }
        float uf[8], gf[8]; unpack8(*(const u32x4*)(F.Z2 + row * ZW + Z_U + c0), uf); unpack8(*(const u32x4*)(F.Z2 + row * ZW + Z_GS + c0), gf);
#pragma unroll
        for (int j = 0; j < 8; ++j) mx[j] = mx[j] * uf[j] * gf[j];
        *(u32x4*)(F.MIX + row * DM + 1536 + c0) = pack8(mx); }
}

#endif
struct NormRowIn { u32x4 yv[4]; f32x4 xv[4][2]; u32x4 xb[4]; };
__device__ __forceinline__ void norm_row_load(NormRowIn& in, const Frame& F, int l, int row) {
    const int lane = F.lane;
    const bf16_t* yr = F.Yb + (size_t)row * DM + 8 * lane;
#pragma unroll
    for (int j = 0; j < 4; ++j) in.yv[j] = __builtin_nontemporal_load((const u32x4*)(yr + 512 * j));
    if (l == 0) {
        const float* xr = (row < MP ? F.xp + (size_t)row * DM : F.xs + (size_t)(row - MP) * DM) + 8 * lane;
#pragma unroll
        for (int j = 0; j < 4; ++j) { in.xv[j][0] = __builtin_nontemporal_load((const f32x4*)(xr + 512 * j)); in.xv[j][1] = __builtin_nontemporal_load((const f32x4*)(xr + 512 * j + 4)); }
    } else {
        const bf16_t* xr = F.H + (size_t)row * DM + 8 * lane;
#pragma unroll
        for (int j = 0; j < 4; ++j) in.xb[j] = __builtin_nontemporal_load((const u32x4*)(xr + 512 * j));
    }
}
__device__ __forceinline__ void norm_row_finish(const NormRowIn& in, const Frame& F, int l, int row) {
    const int lane = F.lane;
    const float* pg = F.norm_post + l * DM + 8 * lane;
    float y[4][8]; float ss = 0.f;
#pragma unroll
    for (int j = 0; j < 4; ++j) { unpack8(in.yv[j], y[j]);
#pragma unroll
        for (int e = 0; e < 8; ++e) ss += y[j][e] * y[j][e]; }
    ss = wave_sum(ss);
    const float ry = rsqrtf(ss * (1.0f / 2048.0f) + EPS);
    if (l == 0) {
        float s1 = 0.f; bf16_t* hrow = F.H + (size_t)row * DM + 8 * lane;
#pragma unroll
        for (int j = 0; j < 4; ++j) { const f32x4 ga = *(const f32x4*)(pg + 512 * j), gb = *(const f32x4*)(pg + 512 * j + 4);
#pragma unroll
            for (int e = 0; e < 4; ++e) { y[j][e] = in.xv[j][0][e] + y[j][e] * ry * ga[e]; y[j][4 + e] = in.xv[j][1][e] + y[j][4 + e] * ry * gb[e]; }
#pragma unroll
            for (int e = 0; e < 8; ++e) s1 += y[j][e] * y[j][e];
            *(u32x4*)(hrow + 512 * j) = pack8(y[j]); }
        s1 = wave_sum(s1);
        if (lane == 0) F.RSTD[MT + row] = rsqrtf(s1 * (1.0f / 2048.0f) + EPS);
    } else {
        float* orow = F.out + (size_t)row * DM + 8 * lane;
#pragma unroll
        for (int j = 0; j < 4; ++j) { const f32x4 ga = *(const f32x4*)(pg + 512 * j), gb = *(const f32x4*)(pg + 512 * j + 4); float xf[8]; unpack8(in.xb[j], xf);
#pragma unroll
            for (int e = 0; e < 4; ++e) { y[j][e] = xf[e] + y[j][e] * ry * ga[e]; y[j][4 + e] = xf[4 + e] + y[j][4 + e] * ry * gb[e]; }
            __builtin_nontemporal_store((f32x4){y[j][0], y[j][1], y[j][2], y[j][3]}, (f32x4*)(orow + 512 * j)); __builtin_nontemporal_store((f32x4){y[j][4], y[j][5], y[j][6], y[j][7]}, (f32x4*)(orow + 512 * j + 4)); }
    }
}
__device__ __forceinline__ void norm_rows4(int l, int row0) { LOCAL_FRAME;
#pragma unroll 1
    for (int k = 0; k < 4; k += 2) { NormRowIn a, b; norm_row_load(a, F, l, row0 + k); norm_row_load(b, F, l, row0 + k + 1);
        norm_row_finish(a, F, l, row0 + k); norm_row_finish(b, F, l, row0 + k + 1); } }

constexpr int Q2_G = 40, Q2_AT = Q2_G + 256, Q2_SG = Q2_AT + 256, Q2_SA = Q2_SG + 64, Q2_SS = Q2_SA + 16, Q2_SP = Q2_SS + 8, Q2_PO = Q2_SP + 256;
__device__ __forceinline__ void slot2(int l, LAS unsigned char* L, LAS unsigned char* ring) {
    int t_ = threadIdx.x; asm volatile("" : "+v"(t_)); const int wave = __builtin_amdgcn_readfirstlane(t_ >> 6);
    unsigned* head = ctl_word(CW_Q + 64 * (2 * l));
    EV_T0();
#pragma unroll 1
    for (;;) {
        const int it = q_pop(head, L);
        if (it >= Q2_PO + (l == 0 ? TR_ITEMS : 0)) { if (l == 0) { EV_MAX(0); EV_MIN(1); } break; }
        if (it < Q2_G) {
            unsigned char* ws = (unsigned char*)kargs()->ws;
            pg8::Gemm g{(const bf16_t*)(ws + WS_H), (const bf16_t*)(ws + WS_WTIN) + (size_t)l * DIN * DM, MT, DIN, DM};
            OneUnit S; S.u.pm = 64 + it / 20; S.u.pn = it % 20;
            pg8::EpiIn E{l};
            pg8::gemm_phase<pg8::EpiIn, OneUnit, false, true>(ring, g, S, E);
            publish(ctl_word(CW_ZS + 64 * (2 * l + it / 20)));
            if (l == 0) { EV_MAX(2); EV_MIN(3); }
        }
        else if (it < Q2_AT) { const int u = it - Q2_G; sgu_unit(l, u >> 1, u & 1, ring); if (l == 0) EV_MAX(5); }
        else if (it < Q2_SG) { attn_unit(l, it - Q2_AT, ring); if (l == 0) EV_MAX(4); }
        else if (it < Q2_SA) { const int i = it - Q2_SG; dep_wait(ctl_word(CW_ZS + 64 * (2 * l + (i >> 5))), 20u); if (l == 0) EV_MIN(6); const int k = 8 * i + wave; samp_attn(l, k >> 2, k & 3, ring + wave * 9472); __syncthreads(); if (l == 0) EV_MAX(7); }
        else if (it < Q2_SS) { const int i = it - Q2_SA; dep_wait(ctl_word(CW_ZS + 64 * (2 * l + (i >> 3))), 20u); samp_sgu(l, 8 * i + wave); }
        else if (it < Q2_SP) { const int i = it - Q2_SS; dep_wait(ctl_word(CW_ZS + 64 * (2 * l + (i >> 2))), 20u); const int k = 8 * i + wave; pool_sample(l, k & 3, k >> 2); }
        else if (it < Q2_PO) { const int i = 8 * (it - Q2_SP) + wave; pool_prompt(l, i & 3, i >> 2, ring + wave * PL_WBYTES); }
        else { LOCAL_FRAME; transpose_item(F, 1, it - Q2_PO, ring); }
    }
}
constexpr int Q4_G = 16, Q4_P = Q4_G + 512, Q4_S = Q4_P + 16;
__device__ __forceinline__ void slot4(int l, LAS unsigned char* L, LAS unsigned char* ring) {
    int t_ = threadIdx.x; asm volatile("" : "+v"(t_)); const int wave = __builtin_amdgcn_readfirstlane(t_ >> 6);
    unsigned* head = ctl_word(CW_Q + 64 * (2 * l + 1));
#pragma unroll 1
    for (;;) {
        const int it = q_pop(head, L);
        if (it >= Q4_S) break;
        if (it < Q4_G) {
            unsigned char* ws = (unsigned char*)kargs()->ws;
            pg8::Gemm g{(const bf16_t*)(ws + WS_MIX), (const bf16_t*)(ws + WS_WTOUT) + (size_t)l * DM * DM, MT, DM, DM};
            OneUnit S; S.u.pm = 64 + it / 8; S.u.pn = it % 8;
            pg8::EpiOut E{};
            pg8::gemm_phase<pg8::EpiOut, OneUnit, false, true>(ring, g, S, E);
            publish(ctl_word(CW_YS + 64 * (2 * l + it / 8)));
        }
        else if (it < Q4_P) norm_rows4(l, 32 * (it - Q4_G) + 4 * wave);
        else { const int i = it - Q4_P; dep_wait(ctl_word(CW_YS + 64 * (2 * l + (i >> 3))), 8u); norm_rows4(l, MP + 32 * i + 4 * wave); }
    }
}

__global__ void __launch_bounds__(NTHREADS, 2) hymba_fwd(Args a_unused) {
    extern __shared__ __attribute__((aligned(16))) unsigned char lds[];
    LAS unsigned char* L = (LAS unsigned char*)lds;
    if (threadIdx.x < 256) ((LAS unsigned*)L)[threadIdx.x] = 0u;
    __syncthreads();
    XcdBarrier bar = xcd_barrier_post((unsigned*)((unsigned char*)kargs()->ws + WS_CTL) + CW_BAR, (volatile LAS unsigned*)L + 8);
    LAS unsigned char* ring = L + RING_OFF;
    STAMP(0);
#ifndef NO_P0
    { Frame F; make_frame(F, kargs()); p0_prologue(F, ring); }
#endif
    xcd_barrier(bar);
    STAMP(1);
#pragma unroll 1
    for (int l = 0; l < 2; ++l) {
#ifndef NO_P1
        {
            KArgs ka = kargs(); unsigned char* ws = (unsigned char*)ka->ws;
            pg8::Gemm g{(const bf16_t*)(ws + WS_H), (const bf16_t*)(ws + WS_WTIN) + (size_t)l * DIN * DM, MP, DIN, DM}; pg8::StaticOrder S; S.init(MP, DIN, (int)gridDim.x, (int)blockIdx.x);
            pg8::EpiIn E{l};
            pg8::gemm_phase<pg8::EpiIn, pg8::StaticOrder, true, true>(ring, g, S, E);
        }
#endif
        xcd_barrier(bar);
        STAMP(2 + 4 * l);
#ifndef NO_P2
        slot2(l, L, ring);
#endif
        xcd_barrier(bar);
        STAMP(3 + 4 * l);
#ifndef NO_P3
        {
            KArgs ka = kargs(); unsigned char* ws = (unsigned char*)ka->ws;
            pg8::Gemm g{(const bf16_t*)(ws + WS_MIX), (const bf16_t*)(ws + WS_WTOUT) + (size_t)l * DM * DM, MP, DM, DM}; pg8::StaticOrder S; S.init(MP, DM, (int)gridDim.x, (int)blockIdx.x);
            pg8::EpiOut E{};
            pg8::gemm_phase<pg8::EpiOut, pg8::StaticOrder, true, true>(ring, g, S, E);
        }
#endif
        xcd_barrier(bar);
        STAMP(4 + 4 * l);
#ifndef NO_P4
        slot4(l, L, ring);
#endif
        if (l == 0) xcd_barrier(bar);
#if PROBE_SEL
        if (l == 1) __syncthreads();
#endif
        STAMP(5 + 4 * l);
    }
#if PROBE_SEL
    if (blockIdx.x == 0 && threadIdx.x == 0) {
#if PROBE_SEL >= 10
        unsigned ea = __hip_atomic_load(ctl_word(CW_EV + 64 * PEA), __ATOMIC_RELAXED, __HIP_MEMORY_SCOPE_AGENT), eb = __hip_atomic_load(ctl_word(CW_EV + 64 * PEB), __ATOMIC_RELAXED, __HIP_MEMORY_SCOPE_AGENT);
        if (PEA_MIN) ea = 0x40000000u - ea; if (PEB_MIN) eb = 0x40000000u - eb;
        unsigned long long da = (ea + 400) / 800, db = (eb + 400) / 800;
#else
        LAS unsigned long long* ts = (LAS unsigned long long*)(L + 256);
        unsigned long long da = (ts[PA1] - ts[PA0] + 400) / 800, db = (ts[PB1] - ts[PB0] + 400) / 800;
#endif
        if (da > 63) da = 63; if (db > 63) db = 63;
        const unsigned long long extra = (da + 64 * db) * 1600ull, t0 = __builtin_amdgcn_s_memrealtime();
        while (__builtin_amdgcn_s_memrealtime() - t0 < extra) __builtin_amdgcn_s_sleep(32);
    }
#endif
}

extern "C" void kernel_launch(void* const* d_in, const int* in_sizes, int n_in, void* d_out, int out_size, void* d_ws, size_t ws_size, hipStream_t stream) {
    static int grid = 0;
    if (grid == 0) {
        if (n_in != 16 || (size_t)out_size != O_END || ws_size < WS_END) { fprintf(stderr, "kernel_launch: unexpected shapes: n_in %d out %d ws %zu (need %zu)\n", n_in, out_size, ws_size, (size_t)WS_END); grid = -1; return; }
        int dev = 0, cus = 0, per_cu = 0;
        if (hipGetDevice(&dev) != hipSuccess || hipDeviceGetAttribute(&cus, hipDeviceAttributeMultiprocessorCount, dev) != hipSuccess) { fprintf(stderr, "kernel_launch: device query failed\n"); grid = -1; return; }
        if (hipFuncSetAttribute((const void*)hymba_fwd, hipFuncAttributeMaxDynamicSharedMemorySize, LDS_BYTES) != hipSuccess) { fprintf(stderr, "kernel_launch: hipFuncSetAttribute failed\n"); grid = -1; return; }
        if (hipOccupancyMaxActiveBlocksPerMultiprocessor(&per_cu, (const void*)hymba_fwd, NTHREADS, LDS_BYTES) != hipSuccess || per_cu < 1) { fprintf(stderr, "kernel_launch: occupancy query says %d blocks/CU\n", per_cu); (void)hipGetLastError(); grid = -1; return; }
        grid = cus;
    }
    if (grid < 0) return;
    (void)hipMemsetAsync((char*)d_ws + WS_CTL, 0, CTL_ZERO_BYTES, stream);
    Args a{};
    for (int i = 0; i < 16; ++i) a.in[i] = (const float*)d_in[i];
    a.out = (float*)d_out; a.ws = (unsigned char*)d_ws;
    void* params[] = {&a};
    hipError_t e = hipLaunchCooperativeKernel((const void*)hymba_fwd, dim3(grid), dim3(NTHREADS), params, LDS_BYTES, stream);
    if (e != hipSuccess) fprintf(stderr, "kernel_launch: cooperative launch failed: %s (grid %d)\n", hipGetErrorString(e), grid);
}
```

```cpp
#include <hip/hip_runtime.h>
#include <cstdio>
#include <cstdint>
#include <cmath>
namespace pg8 {
#define PG8_LAS __attribute__((address_space(3)))
typedef unsigned short bf16_t;
typedef short bf16x8 __attribute__((ext_vector_type(8)));
typedef float f32x4 __attribute__((ext_vector_type(4)));
typedef unsigned u32x4 __attribute__((ext_vector_type(4)));
constexpr int BM = 256, BK = 64, HALF = 128, HTB = HALF * BK * 2  , STAGE_BYTES = 8 * HTB, NXCD = 8, WGM = 8;

__host__ __device__ __forceinline__ int lds_byte(int r, int c) { const int st = (r >> 4) * 2 + (c >> 5), rr = r & 15, cc = c & 31, ob = rr * 64 + cc * 2; return st * 1024 + (ob ^ (((ob >> 9) & 1) << 5)); }
__host__ __device__ __forceinline__ void stage_rc(int b, int& R, int& C) { const int st = b / 1024, sb = b % 1024, swz = sb ^ (((sb >> 9) & 1) << 5); R = (st >> 1) * 16 + swz / 64; C = (st & 1) * 32 + (swz % 64) / 2; }
__host__ __device__ __forceinline__ int perm32(int rho) { const int n = rho >> 4, i = rho & 15; return 8 * (i >> 2) + 4 * n + (i & 3); }

struct Unit { int pm, pn; };
struct Gemm { const bf16_t* A; const bf16_t* Bt; int M, N, K; };

struct StaticOrder {
    int nM, nN, nwg, G, c;
    __host__ __device__ void init(int M, int N, int G_, int c_) { nM = M / BM; nN = N / BM; nwg = nM * nN; G = G_; c = c_; }
    __host__ __device__ bool next(int i, Unit& u) const {
        const long L = (long)i * G + c; if (L >= nwg) return false;
        int wgid = (int)L; { const int q = nwg / NXCD, r = nwg % NXCD, xcd = wgid % NXCD, off = wgid / NXCD; wgid = (xcd < r ? xcd * (q + 1) : r * (q + 1) + (xcd - r) * q) + off; }
        const int nig = WGM * nN, gid = wgid / nig, fm = gid * WGM, gsz = (nM - fm) < WGM ? (nM - fm) : WGM;
        u.pm = fm + ((wgid % nig) % gsz); u.pn = (wgid % nig) / gsz; return true;
    }
    __device__ __forceinline__ void a_ready(const Unit&) const {}
    __device__ __forceinline__ void done(const Unit&) const {}
};

constexpr int DM = 2048, MP = 16384, MS = 512, MT = MP + MS, DIN = 5120;
constexpr int ZW = 3584;
constexpr int Z_GA = 0, Z_XB = 1024, Z_GP = 1536, Z_U = 2048, Z_VS = 2560, Z_GS = 3072;
constexpr float LOG2E = 1.4426950408889634f, QSCALE = 0.125f * LOG2E, EPS = 1e-6f;

__device__ __forceinline__ unsigned cvt_pk_bf16(float lo, float hi) { unsigned r; asm("v_cvt_pk_bf16_f32 %0, %1, %2" : "=v"(r) : "v"(lo), "v"(hi)); return r; }
__device__ __forceinline__ float silu_f(float x) { return x * __builtin_amdgcn_rcpf(1.0f + __builtin_amdgcn_exp2f(-x * LOG2E)); }
__device__ __forceinline__ int vperm32(int x) { return ((x >> 2) & 1) * 16 + (x >> 3) * 4 + (x & 3); }

struct EpiPtrs { const __attribute__((address_space(1))) float* in[16]; __attribute__((address_space(1))) float* out; __attribute__((address_space(1))) unsigned char* ws; };
constexpr size_t EP_RSTD = (size_t)3 << 20, EP_ROPE = (size_t)1 << 20, EP_QC = (size_t)192 << 20, EP_KC = (size_t)225 << 20, EP_VTP = (size_t)233 << 20, EP_Z2 = (size_t)241 << 20, EP_Y = (size_t)357 << 20;
constexpr size_t EO_KP = 34603008, EO_VP = 35127296, EO_PP = 35651584, EO_KS = 35774464, EO_VS = 44163072, EO_PS = 52551680;
struct EpiIn {
    static constexpr bool PERM = true, AFTER_DRAIN = false;
    int l;
    __device__ __forceinline__ void operator()(const f32x4 (&acc)[2][2][4][2], const Unit& u, int wr, int wc, int fr, int fq) const {
        const __attribute__((address_space(4))) EpiPtrs* kp = (const __attribute__((address_space(4))) EpiPtrs*)__builtin_amdgcn_kernarg_segment_ptr(); asm volatile("" : "+s"(kp));
        unsigned char* ws = (unsigned char*)kp->ws; float* outp = (float*)kp->out;
        bf16_t* Qc = (bf16_t*)(ws + EP_QC); bf16_t* Kc = (bf16_t*)(ws + EP_KC); bf16_t* VTP = (bf16_t*)(ws + EP_VTP); bf16_t* Z2 = (bf16_t*)(ws + EP_Z2); const float* rope = (const float*)(ws + EP_ROPE);
        float* oKp = outp + EO_KP + (size_t)l * 262144; float* oVp = outp + EO_VP + (size_t)l * 262144; float* oPp = outp + EO_PP + (size_t)l * 61440;
        float* oKs = outp + EO_KS + (size_t)l * 4194304; float* oVs = outp + EO_VS + (size_t)l * 4194304; float* oPs = outp + EO_PS + (size_t)l * 983040;
        const int pn = u.pn;
        const int row0 = u.pm * 256 + wr * 64 + fr;
        const int cw = wc * 32 + 8 * fq;
        const float* rstd = (const float*)(ws + EP_RSTD) + (size_t)l * MT;
        if (pn < 5) {
#pragma unroll
            for (int ai = 0; ai < 2; ++ai)
#pragma unroll
                for (int m = 0; m < 4; ++m) {
                    const int row = row0 + ai * 128 + m * 16;
                    const bool smp = row >= MP;
                    const int tpos = smp ? 2048 + (row & 3) : (row & 2047);
                    const float* rp = rope + tpos * 64; const float rs = rstd[row];
#pragma unroll
                    for (int bj = 0; bj < 2; ++bj) {
                        const int c = pn * 256 + bj * 128 + cw;
                        const int i0 = (c & 63) >> 1;
                        const f32x4 cs = *(const f32x4*)(rp + i0), sn = *(const f32x4*)(rp + 32 + i0);
                        const f32x4 v0 = acc[ai][bj][m][0] * rs, v1 = acc[ai][bj][m][1] * rs;
                        f32x4 o1, o2;
                        o1[0] = v0[0] * cs[0] - v0[1] * sn[0]; o2[0] = v0[1] * cs[0] + v0[0] * sn[0];
                        o1[1] = v0[2] * cs[1] - v0[3] * sn[1]; o2[1] = v0[3] * cs[1] + v0[2] * sn[1];
                        o1[2] = v1[0] * cs[2] - v1[1] * sn[2]; o2[2] = v1[1] * cs[2] + v1[0] * sn[2];
                        o1[3] = v1[2] * cs[3] - v1[3] * sn[3]; o2[3] = v1[3] * cs[3] + v1[2] * sn[3];
                        if (pn < 4) {
                            o1 = o1 * QSCALE; o2 = o2 * QSCALE;
                            u32x4 w; w.x = cvt_pk_bf16(o1[0], o2[0]); w.y = cvt_pk_bf16(o1[1], o2[1]); w.z = cvt_pk_bf16(o1[2], o2[2]); w.w = cvt_pk_bf16(o1[3], o2[3]);
                            *(u32x4*)(Qc + (size_t)row * 1024 + c) = w;
                        } else {
                            const int kvh = (c - 1024) >> 6;
                            if (!smp) {
                                const int b = row >> 11, t = row & 2047;
                                u32x4 w; w.x = cvt_pk_bf16(o1[0], o2[0]); w.y = cvt_pk_bf16(o1[1], o2[1]); w.z = cvt_pk_bf16(o1[2], o2[2]); w.w = cvt_pk_bf16(o1[3], o2[3]);
                                *(u32x4*)(Kc + ((size_t)((b * 4 + kvh) * 2048 + t)) * 64 + (c & 63)) = w;
                                if (t >= 1920) { float* o = oKp + ((size_t)((b * 128 + t - 1920) * 4 + kvh)) * 64 + i0; *(f32x4*)o = o1; *(f32x4*)(o + 32) = o2; }
                            } else {
                                const int bd = (row - MP) >> 2, tt = row & 3;
                                float* o = oKs + ((size_t)((bd * 128 + 124 + tt) * 4 + kvh)) * 64 + i0; *(f32x4*)o = o1; *(f32x4*)(o + 32) = o2;
                            }
                        }
                    }
                }
        } else if (pn == 5) {
#pragma unroll
            for (int ai = 0; ai < 2; ++ai)
#pragma unroll
                for (int m = 0; m < 4; ++m) {
                    const int row = row0 + ai * 128 + m * 16;
                    const bool smp = row >= MP; const float rs = rstd[row];
#pragma unroll
                    for (int bj = 0; bj < 2; ++bj) {
                        const int cv = bj * 128 + cw;
                        const int kvh = cv >> 6, d0 = cv & 63;
                        const f32x4 v0 = acc[ai][bj][m][0] * rs, v1 = acc[ai][bj][m][1] * rs;
                        if (!smp) {
                            const int b = row >> 11, t = row & 2047;
                            bf16_t* vp = VTP + ((size_t)((b * 4 + kvh) * 64 + (t >> 5))) * 2048 + d0 * 32 + vperm32(t & 31);
                            const unsigned w0 = cvt_pk_bf16(v0[0], v0[1]), w1 = cvt_pk_bf16(v0[2], v0[3]), w2 = cvt_pk_bf16(v1[0], v1[1]), w3 = cvt_pk_bf16(v1[2], v1[3]);
                            vp[0] = (bf16_t)(w0 & 0xffffu); vp[32] = (bf16_t)(w0 >> 16); vp[64] = (bf16_t)(w1 & 0xffffu); vp[96] = (bf16_t)(w1 >> 16);
                            vp[128] = (bf16_t)(w2 & 0xffffu); vp[160] = (bf16_t)(w2 >> 16); vp[192] = (bf16_t)(w3 & 0xffffu); vp[224] = (bf16_t)(w3 >> 16);
                            if (t >= 1920) { float* o = oVp + ((size_t)((b * 128 + t - 1920) * 4 + kvh)) * 64 + d0; *(f32x4*)o = v0; *(f32x4*)(o + 4) = v1; }
                        } else {
                            const int bd = (row - MP) >> 2, tt = row & 3;
                            float* o = oVs + ((size_t)((bd * 128 + 124 + tt) * 4 + kvh)) * 64 + d0; *(f32x4*)o = v0; *(f32x4*)(o + 4) = v1;
                        }
                    }
                }
        } else {
            const bool gate = (pn < 10) || (pn == 12) || (pn == 13) || (pn >= 18);
            const bool isxb = (pn == 10) || (pn == 11);
#pragma unroll
            for (int ai = 0; ai < 2; ++ai)
#pragma unroll
                for (int m = 0; m < 4; ++m) {
                    const int row = row0 + ai * 128 + m * 16;
                    const bool smp = row >= MP; const float rs = rstd[row];
#pragma unroll
                    for (int bj = 0; bj < 2; ++bj) {
                        const int c = pn * 256 + bj * 128 + cw;
                        f32x4 v0 = acc[ai][bj][m][0] * rs, v1 = acc[ai][bj][m][1] * rs;
                        if (isxb) {
                            const int cx = c - 2560;
                            if (!smp) { const int t = row & 2047; if (t >= 2033) { const int b = row >> 11; float* o = oPp + ((size_t)(b * 15 + t - 2033)) * 512 + cx; *(f32x4*)o = v0; *(f32x4*)(o + 4) = v1; } }
                            else { const int bd = (row - MP) >> 2, tt = row & 3; float* o = oPs + ((size_t)(bd * 15 + 11 + tt)) * 512 + cx; *(f32x4*)o = v0; *(f32x4*)(o + 4) = v1; }
                        }
                        if (gate) {
#pragma unroll
                            for (int j = 0; j < 4; ++j) { v0[j] = silu_f(v0[j]); v1[j] = silu_f(v1[j]); }
                        }
                        u32x4 w; w.x = cvt_pk_bf16(v0[0], v0[1]); w.y = cvt_pk_bf16(v0[2], v0[3]); w.z = cvt_pk_bf16(v1[0], v1[1]); w.w = cvt_pk_bf16(v1[2], v1[3]);
                        *(u32x4*)(Z2 + (size_t)row * ZW + (c - 1536)) = w;
                    }
                }
        }
    }
};

struct EpiOut {
    static constexpr bool PERM = true, AFTER_DRAIN = false;
    __device__ __forceinline__ void operator()(const f32x4 (&acc)[2][2][4][2], const Unit& u, int wr, int wc, int fr, int fq) const {
        const __attribute__((address_space(4))) EpiPtrs* kp = (const __attribute__((address_space(4))) EpiPtrs*)__builtin_amdgcn_kernarg_segment_ptr(); asm volatile("" : "+s"(kp));
        bf16_t* C = (bf16_t*)((unsigned char*)kp->ws + EP_Y);
        const int row0 = u.pm * BM + wr * 64 + fr, col0 = u.pn * BM + wc * 32 + 8 * fq;
#pragma unroll
        for (int ai = 0; ai < 2; ++ai)
#pragma unroll
            for (int m = 0; m < 4; ++m) { bf16_t* rowp = C + (size_t)(row0 + ai * HALF + m * 16) * DM + col0;
#pragma unroll
                for (int bj = 0; bj < 2; ++bj) { const f32x4 v0 = acc[ai][bj][m][0], v1 = acc[ai][bj][m][1];
                    u32x4 w; w.x = cvt_pk_bf16(v0[0], v0[1]); w.y = cvt_pk_bf16(v0[2], v0[3]); w.z = cvt_pk_bf16(v1[0], v1[1]); w.w = cvt_pk_bf16(v1[2], v1[3]);
                    *(u32x4*)(rowp + bj * HALF) = w; } }
    }
};
template <class Epi, class Sched, bool ALIGN_EPI = false, bool SP2 = false>
__device__ __forceinline__ void gemm_phase(PG8_LAS unsigned char* lds, const Gemm g, const Sched& S, const Epi& E) {
    int tid_ = threadIdx.x; asm volatile("" : "+v"(tid_));
    const int tid = tid_, wid = __builtin_amdgcn_readfirstlane(tid >> 6), lane = tid & 63, wr = wid >> 2, wc = wid & 3, fr = lane & 15, fq = lane >> 4;
    const int K = g.K, nt = K / BK;
    unsigned voffA[2], voffB[2];
#pragma unroll
    for (int i = 0; i < 2; ++i) { int R, C; stage_rc(tid * 16 + i * 8192, R, C); const int Rb = Epi::PERM ? ((R & ~31) + perm32(R & 31)) : R;
        voffA[i] = (unsigned)(R * K + C) * 2u; voffB[i] = (unsigned)(Rb * K + C) * 2u; }
    const size_t kstep = (size_t)(BK * 2);
    const size_t hstep = (size_t)HALF * K * 2;
    const size_t tstep = 2 * hstep;
    const unsigned ldsw = (unsigned)wid * 1024u;
    const int aoff = lds_byte(wr * 64 + fr, fq * 8), boff = lds_byte(wc * 32 + fr, fq * 8);
#define PG8_SA(b, h) (((b) * 2 + (h)) * HTB)
#define PG8_SB(b, h) ((4 + (b) * 2 + (h)) * HTB)
#define PG8_STAGE(bufoff, gbase, voff) do { _Pragma("unroll") for (int _i = 0; _i < 2; ++_i) \
        __builtin_amdgcn_global_load_lds((const unsigned*)((const char*)(gbase) + (voff)[_i]), (PG8_LAS unsigned*)(lds + (bufoff) + ldsw + _i * 8192), 16, 0, 0); } while (0)
#define PG8_LDA(dst, b, h) do { _Pragma("unroll") for (int m = 0; m < 4; ++m) _Pragma("unroll") for (int k = 0; k < 2; ++k) dst[m][k] = *(const PG8_LAS bf16x8*)(lds + PG8_SA(b, h) + aoff + m * 2048 + k * 1024); } while (0)
#define PG8_LDB(dst, b, h) do { _Pragma("unroll") for (int n = 0; n < 2; ++n) _Pragma("unroll") for (int k = 0; k < 2; ++k) dst[n][k] = *(const PG8_LAS bf16x8*)(lds + PG8_SB(b, h) + boff + n * 2048 + k * 1024); } while (0)
#define PG8_MMA(ai, bj, At, Bt) do { __builtin_amdgcn_s_setprio(1); _Pragma("unroll") for (int m = 0; m < 4; ++m) _Pragma("unroll") for (int n = 0; n < 2; ++n) _Pragma("unroll") for (int k = 0; k < 2; ++k) \
        acc[ai][bj][m][n] = __builtin_amdgcn_mfma_f32_16x16x32_bf16(Bt[n][k], At[m][k], acc[ai][bj][m][n], 0, 0, 0); __builtin_amdgcn_s_setprio(0); } while (0)
#define PG8_WAIT_V(n) asm volatile("s_waitcnt vmcnt(" #n ")" ::: "memory")
#define PG8_WAIT_L(n) asm volatile("s_waitcnt lgkmcnt(" #n ")" ::: "memory")
#define PG8_BAR __builtin_amdgcn_s_barrier()
#define PG8_SCHED __builtin_amdgcn_sched_barrier(0)
    Unit cur, nxt; int ui = 0;
    if (!S.next(0, cur)) return;
    f32x4 acc[2][2][4][2];
#pragma unroll
    for (int a = 0; a < 2; ++a)
#pragma unroll
        for (int b = 0; b < 2; ++b)
#pragma unroll
            for (int m = 0; m < 4; ++m)
#pragma unroll
                for (int n = 0; n < 2; ++n) acc[a][b][m][n] = (f32x4){0.f, 0.f, 0.f, 0.f};
    bf16x8 At[4][2], B0[2][2], B1[2][2];
    const char* cA = (const char*)g.A + (size_t)cur.pm * tstep; const char* cB = (const char*)g.Bt + (size_t)cur.pn * tstep;
    S.a_ready(cur);
    if constexpr (SP2) {
        PG8_STAGE(PG8_SB(0, 0), cB, voffB); PG8_STAGE(PG8_SB(0, 1), cB + hstep, voffB); PG8_STAGE(PG8_SA(0, 0), cA, voffA); PG8_STAGE(PG8_SA(0, 1), cA + hstep, voffA);
        if (wr == 1) PG8_BAR;
        PG8_WAIT_V(2); PG8_BAR;
        PG8_STAGE(PG8_SB(1, 0), cB + kstep, voffB); PG8_STAGE(PG8_SA(1, 0), cA + kstep, voffA); PG8_STAGE(PG8_SB(1, 1), cB + hstep + kstep, voffB);
        PG8_WAIT_V(6); PG8_BAR;
    } else {
        PG8_STAGE(PG8_SB(0, 0), cB, voffB); PG8_STAGE(PG8_SA(0, 0), cA, voffA); PG8_STAGE(PG8_SB(0, 1), cB + hstep, voffB); PG8_STAGE(PG8_SA(0, 1), cA + hstep, voffA);
        if (wr == 1) PG8_BAR;
        PG8_WAIT_V(4); PG8_BAR;
        PG8_STAGE(PG8_SB(1, 0), cB + kstep, voffB); PG8_STAGE(PG8_SA(1, 0), cA + kstep, voffA); PG8_STAGE(PG8_SB(1, 1), cB + hstep + kstep, voffB);
        PG8_WAIT_V(6); PG8_BAR;
    }
    for (;;) {
        const bool has_next = S.next(ui + 1, nxt);
        const char* nA = has_next ? (const char*)g.A + (size_t)nxt.pm * tstep : cA; const char* nB = has_next ? (const char*)g.Bt + (size_t)nxt.pn * tstep : cB;
        for (int t = 0; t < nt; t += 2) {
            const bool last = (t == nt - 2);
            const char* a1 = cA + (size_t)(t + 1) * kstep;
            const char* a2 = last ? nA : cA + (size_t)(t + 2) * kstep; const char* b2 = last ? nB : cB + (size_t)(t + 2) * kstep;
            const char* a3 = a2 + kstep; const char* b3 = b2 + kstep;
            if (last && has_next) S.a_ready(nxt);
            if constexpr (SP2) {
            PG8_LDB(B0, 0, 0); PG8_LDB(B1, 0, 1); PG8_SCHED; PG8_LDA(At, 0, 0); PG8_STAGE(PG8_SA(1, 1), a1 + hstep, voffA);
            PG8_WAIT_V(8); PG8_WAIT_L(0); PG8_BAR; PG8_MMA(0, 0, At, B0); PG8_MMA(0, 1, At, B1); PG8_BAR; PG8_SCHED;
            PG8_LDA(At, 0, 1); PG8_STAGE(PG8_SB(0, 0), b2, voffB); PG8_STAGE(PG8_SB(0, 1), b2 + hstep, voffB); PG8_STAGE(PG8_SA(0, 0), a2, voffA);
            PG8_WAIT_V(8); PG8_WAIT_L(0); PG8_BAR; PG8_MMA(1, 0, At, B0); PG8_MMA(1, 1, At, B1); PG8_BAR; PG8_SCHED;
            PG8_LDB(B0, 1, 0); PG8_LDB(B1, 1, 1); PG8_SCHED; PG8_LDA(At, 1, 0); PG8_STAGE(PG8_SA(0, 1), a2 + hstep, voffA);
            PG8_WAIT_V(8); PG8_WAIT_L(0); PG8_BAR; PG8_MMA(0, 0, At, B0); PG8_MMA(0, 1, At, B1); PG8_BAR; PG8_SCHED;
            PG8_LDA(At, 1, 1); PG8_STAGE(PG8_SB(1, 0), b3, voffB); PG8_STAGE(PG8_SB(1, 1), b3 + hstep, voffB); PG8_STAGE(PG8_SA(1, 0), a3, voffA);
            PG8_WAIT_V(8); PG8_WAIT_L(0); PG8_BAR; PG8_MMA(1, 0, At, B0); PG8_MMA(1, 1, At, B1); PG8_BAR; PG8_SCHED;
            } else {
            PG8_LDB(B0, 0, 0); PG8_SCHED; PG8_LDA(At, 0, 0); PG8_STAGE(PG8_SA(1, 1), a1 + hstep, voffA);
            PG8_WAIT_L(8); PG8_BAR; PG8_WAIT_L(0); PG8_MMA(0, 0, At, B0); PG8_BAR; PG8_SCHED;
            PG8_LDB(B1, 0, 1); PG8_STAGE(PG8_SB(0, 0), b2, voffB);
            PG8_BAR; PG8_WAIT_L(0); PG8_MMA(0, 1, At, B1); PG8_BAR;
            PG8_LDA(At, 0, 1); PG8_STAGE(PG8_SA(0, 0), a2, voffA);
            PG8_BAR; PG8_WAIT_L(0); PG8_MMA(1, 0, At, B0); PG8_BAR; PG8_SCHED;
            PG8_STAGE(PG8_SB(0, 1), b2 + hstep, voffB);
            PG8_WAIT_V(6); PG8_BAR; PG8_MMA(1, 1, At, B1); PG8_BAR;
            PG8_LDB(B0, 1, 0); PG8_SCHED; PG8_LDA(At, 1, 0); PG8_STAGE(PG8_SA(0, 1), a2 + hstep, voffA);
            PG8_WAIT_L(8); PG8_BAR; PG8_WAIT_L(0); PG8_MMA(0, 0, At, B0); PG8_BAR; PG8_SCHED;
            PG8_LDB(B1, 1, 1); PG8_STAGE(PG8_SB(1, 0), b3, voffB);
            PG8_BAR; PG8_WAIT_L(0); PG8_MMA(0, 1, At, B1); PG8_BAR;
            PG8_LDA(At, 1, 1); PG8_STAGE(PG8_SA(1, 0), a3, voffA);
            PG8_BAR; PG8_WAIT_L(0); PG8_MMA(1, 0, At, B0); PG8_BAR; PG8_SCHED;
            PG8_STAGE(PG8_SB(1, 1), b3 + hstep, voffB);
            PG8_WAIT_V(6); PG8_BAR; PG8_MMA(1, 1, At, B1); PG8_BAR;
            }
        }
        if constexpr (ALIGN_EPI) { if (wr == 0) PG8_BAR; }
        if constexpr (!Epi::AFTER_DRAIN) { E(acc, cur, wr, wc, fr, fq); S.done(cur); }
        if (!has_next) break;
#pragma unroll
        for (int a = 0; a < 2; ++a)
#pragma unroll
            for (int b = 0; b < 2; ++b)
#pragma unroll
                for (int m = 0; m < 4; ++m)
#pragma unroll
                    for (int n = 0; n < 2; ++n) acc[a][b][m][n] = (f32x4){0.f, 0.f, 0.f, 0.f};
        cur = nxt; cA = nA; cB = nB; ++ui;
        if constexpr (ALIGN_EPI) { if (wr == 1) PG8_BAR; }
    }
    PG8_WAIT_V(0);
    if constexpr (!ALIGN_EPI) { if (wr == 0) PG8_BAR; }
    PG8_BAR;
    if constexpr (Epi::AFTER_DRAIN) { E.fused(acc, cur, wr, wc, fr, fq, lds, wid, lane); S.done(cur); }
#undef PG8_SA
#undef PG8_SB
#undef PG8_STAGE
#undef PG8_LDA
#undef PG8_LDB
#undef PG8_MMA
#undef PG8_WAIT_V
#undef PG8_WAIT_L
#undef PG8_BAR
#undef PG8_SCHED
}
}
#define GAS __attribute__((address_space(1)))
#define LAS __attribute__((address_space(3)))
typedef GAS unsigned gu32;
typedef GAS unsigned long long gu64;
#define RLX_AGENT __ATOMIC_RELAXED, __HIP_MEMORY_SCOPE_AGENT
#define VM_WAIT() asm volatile("s_waitcnt vmcnt(0)" ::: "memory")
__device__ __forceinline__ unsigned long long rt() { return __builtin_amdgcn_s_memrealtime(); }
__device__ __forceinline__ unsigned f2bf(float f) { unsigned u = __builtin_bit_cast(unsigned, f); return (u + 0x7fffu + ((u >> 16) & 1u)) >> 16; }
__device__ __forceinline__ unsigned pk2(float lo, float hi) { return f2bf(lo) | (f2bf(hi) << 16); }

#define XB_TMO      128
#define XB_XCNT(j)  (256  + 64 * (j))
#define XB_XSUB(j)  (1280 + 64 * (j))
#define XB_XGEN(j)  (2304 + 64 * (j))
#define XB_TOP      3328
#define XB_TOPGEN   3392
#define XCD_BAR_WORDS 3456
#define XB_SPIN_CAP (1u << 18)

__device__ __forceinline__ unsigned xb_ld(unsigned* p)              { return __hip_atomic_load(p, __ATOMIC_RELAXED, __HIP_MEMORY_SCOPE_AGENT); }
__device__ __forceinline__ unsigned xb_add(unsigned* p, unsigned v) { return __hip_atomic_fetch_add(p, v, __ATOMIC_RELAXED, __HIP_MEMORY_SCOPE_AGENT); }
__device__ __forceinline__ unsigned xb_xcc_id() { return (unsigned)__builtin_amdgcn_s_getreg((3 << 11) | 20) & 0xFu; }
#define XB_SPIN(cond, bar) do { unsigned _sp = 0; while (cond) { __builtin_amdgcn_s_sleep(1); \
    if ((++_sp & 255u) == 0u) { if (xb_ld(&(bar)[XB_TMO])) break; if (_sp > XB_SPIN_CAP) { atomicAdd(&(bar)[XB_TMO], 1u); break; } } } } while (0)

struct XcdBarrier {
    unsigned* bar; unsigned x;
    volatile LAS unsigned* st;
};

__device__ __forceinline__ XcdBarrier xcd_barrier_post(unsigned* bar, volatile LAS unsigned* st) {
    XcdBarrier b; b.bar = bar; b.x = xb_xcc_id(); b.st = st;
    if (threadIdx.x == 0) (void)xb_add(&bar[XB_XCNT(b.x)], 1u);
    return b;
}
__device__ __forceinline__ void xcd_barrier_complete(unsigned* bar, unsigned x, unsigned& nloc, unsigned& nx) {
    const unsigned G = gridDim.x * gridDim.y * gridDim.z;
    unsigned sum, cnt, mine, sp = 0u;
    for (;;) {
        sum = 0u; cnt = 0u; mine = 0u;
#pragma unroll
        for (unsigned j = 0; j < 16; ++j) { const unsigned c = xb_ld(&bar[XB_XCNT(j)]); sum += c; cnt += (c > 0u) ? 1u : 0u; mine = (j == x) ? c : mine; }
        if (sum == G) break;
        __builtin_amdgcn_s_sleep(1);
        if ((++sp & 255u) == 0u) { if (xb_ld(&bar[XB_TMO])) break; if (sp > XB_SPIN_CAP) { atomicAdd(&bar[XB_TMO], 1u); break; } }
    }
    nloc = mine > 0u ? mine : 1u; nx = cnt > 0u ? cnt : 1u;
}

__device__ __forceinline__ void xcd_barrier(const XcdBarrier& b) {
    asm volatile("s_waitcnt vmcnt(0)" ::: "memory");
    __syncthreads();
    if (threadIdx.x == 0) {
        unsigned* bar = b.bar;
        __builtin_amdgcn_s_waitcnt(0);
        unsigned nloc = b.st[0], nx = b.st[1];
        if (nloc == 0u) { xcd_barrier_complete(bar, b.x, nloc, nx); b.st[0] = nloc; b.st[1] = nx; }
        const unsigned old = xb_add(&bar[XB_XSUB(b.x)], 1u);
        const unsigned gen = old / nloc;
        if (old + 1u == (gen + 1u) * nloc) {
            __builtin_amdgcn_fence(__ATOMIC_RELEASE, "agent");
            asm volatile("s_waitcnt vmcnt(0)" ::: "memory");
            const unsigned og = xb_add(&bar[XB_TOP], 1u);
            const unsigned tg = og / nx;
            if (og + 1u == (tg + 1u) * nx) xb_add(&bar[XB_TOPGEN], 1u);
            else XB_SPIN(xb_ld(&bar[XB_TOPGEN]) == tg, bar);
            __builtin_amdgcn_fence(__ATOMIC_ACQUIRE, "agent");
            xb_add(&bar[XB_XGEN(b.x)], 1u);
            asm volatile("s_waitcnt vmcnt(0)" ::: "memory");
        } else {
            XB_SPIN(xb_ld(&bar[XB_XGEN(b.x)]) == gen, bar);
            __builtin_amdgcn_fence(__ATOMIC_ACQUIRE, "agent");
            asm volatile("s_waitcnt vmcnt(0)" ::: "memory");
        }
    }
    __syncthreads();
}

using pg8::bf16_t; using pg8::bf16x8; using pg8::f32x4; using pg8::u32x4;
using pg8::DM; using pg8::MP; using pg8::MS; using pg8::MT; using pg8::DIN; using pg8::ZW;
using pg8::Z_GA; using pg8::Z_XB; using pg8::Z_GP; using pg8::Z_U; using pg8::Z_VS; using pg8::Z_GS; using pg8::LOG2E; using pg8::EPS;
typedef float f32x16 __attribute__((ext_vector_type(16)));
typedef unsigned u32x2 __attribute__((ext_vector_type(2)));
typedef short v4i16_t __attribute__((ext_vector_type(4)));

constexpr int NWAVES = 8, NTHREADS = 512;
constexpr int LDS_BYTES = 147456;
constexpr int RING_OFF = 1024;

constexpr size_t O_YP = 0, O_YS = 33554432, O_KP = 34603008, O_VP = 35127296, O_PP = 35651584, O_KS = 35774464, O_VS = 44163072, O_PS = 52551680, O_CV = 54517760, O_END = 55042048;
constexpr size_t LS_KP = 262144, LS_PP = 61440, LS_KS = 4194304, LS_PS = 983040, LS_CV = 262144;
constexpr size_t MiB = 1u << 20;
constexpr size_t WS_CTL = 0, CTL_ZERO_BYTES = 65536;
constexpr size_t WS_ROPE = 1 * MiB, WS_SGUW = 2 * MiB, WS_RSW = 2 * MiB + 256 * 1024, WS_PWT = 2 * MiB + 512 * 1024, WS_RSTD = 3 * MiB;
constexpr size_t WS_WTIN = 4 * MiB, WS_WTOUT = 44 * MiB, WS_H = 60 * MiB, WS_MIX = 126 * MiB, WS_QC = 192 * MiB, WS_KC = 225 * MiB, WS_VTP = 233 * MiB, WS_Z2 = 241 * MiB, WS_Y = 357 * MiB, WS_END = 489 * MiB;
constexpr int CW_BAR = 1024;

__constant__ double ROPE_INV[32] = {1.0, 0.7498942093324559, 0.5623413251903491, 0.4216965034285822, 0.31622776601683794, 0.23713737056616552, 0.1778279410038923, 0.1333521432163324, 0.1, 0.07498942093324558, 0.05623413251903491, 0.042169650342858224, 0.03162277660168379, 0.023713737056616554, 0.01778279410038923, 0.01333521432163324, 0.01, 0.007498942093324558, 0.005623413251903491, 0.004216965034285823, 0.0031622776601683794, 0.0023713737056616554, 0.0017782794100389228, 0.001333521432163324, 0.001, 0.0007498942093324559, 0.0005623413251903491, 0.00042169650342858224, 0.00031622776601683794, 0.00023713737056616554, 0.00017782794100389227, 0.0001333521432163324};

struct Args { const float* in[16]; float* out; unsigned char* ws; };

struct Frame {
    int tid, lane, wave, bid, G;
    const float *xp, *xs, *cache_k, *cache_v, *state_pool, *w_in, *w_out, *norm_pre, *norm_post, *sinks, *pool_w, *pool_scale, *ln_g, *ln_b, *sgu_w, *sgu_b;
    float* out;
    float* rope; float* RSW; float* RSTD; bf16_t *SGUW, *PWT, *WTIN, *WTOUT, *H, *MIX, *Qc, *Kc, *VTP, *Z2, *Yb;
};

__device__ __forceinline__ float wave_sum(float v) {
#pragma unroll
    for (int o = 1; o < 64; o <<= 1) v += __shfl_xor(v, o);
    return v;
}
__device__ __forceinline__ float wave_max(float v) {
#pragma unroll
    for (int o = 1; o < 64; o <<= 1) v = fmaxf(v, __shfl_xor(v, o));
    return v;
}
__device__ __forceinline__ float bflo(unsigned w) { return __uint_as_float(w << 16); }
__device__ __forceinline__ float bfhi(unsigned w) { return __uint_as_float(w & 0xffff0000u); }
__device__ __forceinline__ void unpack8(const u32x4 w, float (&f)[8]) { f[0] = bflo(w.x); f[1] = bfhi(w.x); f[2] = bflo(w.y); f[3] = bfhi(w.y); f[4] = bflo(w.z); f[5] = bfhi(w.z); f[6] = bflo(w.w); f[7] = bfhi(w.w); }
__device__ __forceinline__ void unpack4(const u32x2 w, float (&f)[4]) { f[0] = bflo(w.x); f[1] = bfhi(w.x); f[2] = bflo(w.y); f[3] = bfhi(w.y); }
__device__ __forceinline__ u32x4 pack8(const float (&f)[8]) { u32x4 w; w.x = pg8::cvt_pk_bf16(f[0], f[1]); w.y = pg8::cvt_pk_bf16(f[2], f[3]); w.z = pg8::cvt_pk_bf16(f[4], f[5]); w.w = pg8::cvt_pk_bf16(f[6], f[7]); return w; }
__device__ __forceinline__ int crow(int r, int hi) { return (r & 3) + 8 * (r >> 2) + 4 * hi; }
#define LDS_WAIT() asm volatile("s_waitcnt lgkmcnt(0)" ::: "memory")


struct ArgsG { const __attribute__((address_space(1))) float* in[16]; __attribute__((address_space(1))) float* out; __attribute__((address_space(1))) unsigned char* ws; };
typedef const __attribute__((address_space(4))) ArgsG* KArgs;
__device__ __forceinline__ KArgs kargs() { KArgs p = (KArgs)__builtin_amdgcn_kernarg_segment_ptr(); asm volatile("" : "+s"(p)); return p; }
__device__ __forceinline__ void make_frame(Frame& F, KArgs a) {
    { int t_ = threadIdx.x; asm volatile("" : "+v"(t_)); F.tid = t_; } F.lane = F.tid & 63; F.wave = __builtin_amdgcn_readfirstlane(F.tid >> 6); F.bid = blockIdx.x; F.G = gridDim.x;
    F.xp = (const float*)a->in[0]; F.xs = (const float*)a->in[1]; F.cache_k = (const float*)a->in[2]; F.cache_v = (const float*)a->in[3]; F.state_pool = (const float*)a->in[4]; F.w_in = (const float*)a->in[5]; F.w_out = (const float*)a->in[6]; F.norm_pre = (const float*)a->in[7]; F.norm_post = (const float*)a->in[8];
    F.sinks = (const float*)a->in[9]; F.pool_w = (const float*)a->in[10]; F.pool_scale = (const float*)a->in[11]; F.ln_g = (const float*)a->in[12]; F.ln_b = (const float*)a->in[13]; F.sgu_w = (const float*)a->in[14]; F.sgu_b = (const float*)a->in[15];
    F.out = (float*)a->out;
    unsigned char* ws = (unsigned char*)a->ws;
    F.rope = (float*)(ws + WS_ROPE); F.RSW = (float*)(ws + WS_RSW); F.RSTD = (float*)(ws + WS_RSTD); F.SGUW = (bf16_t*)(ws + WS_SGUW); F.PWT = (bf16_t*)(ws + WS_PWT); F.WTIN = (bf16_t*)(ws + WS_WTIN); F.WTOUT = (bf16_t*)(ws + WS_WTOUT);
    F.H = (bf16_t*)(ws + WS_H); F.MIX = (bf16_t*)(ws + WS_MIX); F.Qc = (bf16_t*)(ws + WS_QC); F.Kc = (bf16_t*)(ws + WS_KC); F.VTP = (bf16_t*)(ws + WS_VTP); F.Z2 = (bf16_t*)(ws + WS_Z2); F.Yb = (bf16_t*)(ws + WS_Y);
}

#define LOCAL_FRAME Frame F; make_frame(F, kargs())

constexpr int CW_Q = 8192;
constexpr int CW_ZS = 8192 + 64 * 8;
constexpr int CW_YS = 8192 + 64 * 16;
constexpr int CW_EV = 8192 + 64 * 32;
__device__ __forceinline__ unsigned* ctl_word(int idx) { return (unsigned*)((unsigned char*)kargs()->ws + WS_CTL) + idx; }
__device__ __forceinline__ int q_pop(unsigned* head, LAS unsigned char* L) {
    volatile LAS int* slot = (volatile LAS int*)(L + 64);
    __syncthreads();
    if (threadIdx.x == 0) *slot = (int)__hip_atomic_fetch_add(head, 1u, __ATOMIC_RELAXED, __HIP_MEMORY_SCOPE_AGENT);
    __syncthreads();
    return __builtin_amdgcn_readfirstlane(*slot);
}
__device__ __forceinline__ void publish(unsigned* ctr) {
    asm volatile("s_waitcnt vmcnt(0)" ::: "memory");
    __syncthreads();
    if (threadIdx.x == 0) { __builtin_amdgcn_fence(__ATOMIC_RELEASE, "agent"); asm volatile("s_waitcnt vmcnt(0)" ::: "memory");
        __hip_atomic_fetch_add(ctr, 1u, __ATOMIC_RELAXED, __HIP_MEMORY_SCOPE_AGENT); }
}
__device__ __forceinline__ void dep_wait(unsigned* ctr, unsigned need) {
    if (threadIdx.x == 0) {
        unsigned sp = 0;
        while (__hip_atomic_load(ctr, __ATOMIC_RELAXED, __HIP_MEMORY_SCOPE_AGENT) < need) { __builtin_amdgcn_s_sleep(16); if (++sp > (1u << 21)) break; }
        __builtin_amdgcn_fence(__ATOMIC_ACQUIRE, "agent"); asm volatile("s_waitcnt vmcnt(0)" ::: "memory");
    }
    __syncthreads();
}

#if PROBE_SEL >= 10
#define EV_T0() const unsigned long long ev_t0 = __builtin_amdgcn_s_memrealtime()
#define EV_MAX(k) do { if (threadIdx.x == 0) __hip_atomic_fetch_max(ctl_word(CW_EV + 64 * (k)), (unsigned)(__builtin_amdgcn_s_memrealtime() - ev_t0), __ATOMIC_RELAXED, __HIP_MEMORY_SCOPE_AGENT); } while (0)
#define EV_MIN(k) do { if (threadIdx.x == 0) __hip_atomic_fetch_max(ctl_word(CW_EV + 64 * (k)), 0x40000000u - (unsigned)(__builtin_amdgcn_s_memrealtime() - ev_t0), __ATOMIC_RELAXED, __HIP_MEMORY_SCOPE_AGENT); } while (0)
#else
#define EV_T0() do {} while (0)
#define EV_MAX(k) do {} while (0)
#define EV_MIN(k) do {} while (0)
#endif
struct OneUnit {
    pg8::Unit u;
    __device__ __forceinline__ bool next(int i, pg8::Unit& o) const { if (i) return false; o = u; return true; }
    __device__ __forceinline__ void a_ready(const pg8::Unit&) const {}
    __device__ __forceinline__ void done(const pg8::Unit&) const {}
};

#ifndef PROBE_SEL
#define PROBE_SEL 0
#endif
#if PROBE_SEL
#define STAMP(k) do { if (blockIdx.x == 0 && threadIdx.x == 0) ((LAS unsigned long long*)(L + 256))[k] = __builtin_amdgcn_s_memrealtime(); } while (0)
#define STAMP2(k) do { if (blockIdx.x == 0) { __syncthreads(); if (threadIdx.x == 0) ((LAS unsigned long long*)((LAS unsigned char*)ring - RING_OFF + 256))[k] = __builtin_amdgcn_s_memrealtime(); } } while (0)
#else
#define STAMP(k) do {} while (0)
#define STAMP2(k) do {} while (0)
#endif
#if PROBE_SEL == 1
#define PA0 0
#define PA1 1
#define PB0 1
#define PB1 2
#elif PROBE_SEL == 2
#define PA0 2
#define PA1 3
#define PB0 3
#define PB1 4
#elif PROBE_SEL == 3
#define PA0 4
#define PA1 5
#define PB0 8
#define PB1 9
#elif PROBE_SEL == 4
#define PA0 2
#define PA1 10
#define PB0 10
#define PB1 11
#elif PROBE_SEL == 5
#define PA0 11
#define PA1 12
#define PB0 12
#define PB1 13
#elif PROBE_SEL == 7
#define PA0 1
#define PA1 2
#define PB0 0
#define PB1 1
#elif PROBE_SEL == 8
#define PA0 3
#define PA1 4
#define PB0 2
#define PB1 3
#elif PROBE_SEL == 9
#define PA0 6
#define PA1 7
#define PB0 4
#define PB1 5
#elif PROBE_SEL == 6
#define PA0 5
#define PA1 6
#define PB0 7
#define PB1 8
#elif PROBE_SEL == 10
#define PEA 0
#define PEA_MIN 0
#define PEB 1
#define PEB_MIN 1
#elif PROBE_SEL == 11
#define PEA 2
#define PEA_MIN 0
#define PEB 3
#define PEB_MIN 1
#elif PROBE_SEL == 12
#define PEA 4
#define PEA_MIN 0
#define PEB 5
#define PEB_MIN 0
#elif PROBE_SEL == 14
#define PEA 8
#define PEA_MIN 0
#define PEB 9
#define PEB_MIN 0
#elif PROBE_SEL == 13
#define PEA 6
#define PEA_MIN 1
#define PEB 7
#define PEB_MIN 0
#endif

__device__ __forceinline__ void p0_transpose_blk(const float* W, int K, int N, bf16_t* WT, bool permqk, const float* kgain, LAS unsigned char* T, int item, int tid) {
    const int nblk = N >> 8, kb = item / nblk, nb = item - kb * nblk, k0 = kb * 128, n0 = nb * 256;
    const int n4 = tid & 63, kr = tid >> 6;
    f32x4 v[16];
#pragma unroll
    for (int i = 0; i < 16; ++i) v[i] = __builtin_nontemporal_load((const f32x4*)(W + (size_t)(k0 + 16 * kr + i) * N + n0 + 4 * n4));
    if (kgain) {
        const float* gp = kgain + k0 + 16 * kr;
#pragma unroll
        for (int i4 = 0; i4 < 4; ++i4) { const f32x4 gg = *(const f32x4*)(gp + 4 * i4);
#pragma unroll
            for (int j = 0; j < 4; ++j) v[4 * i4 + j] = v[4 * i4 + j] * gg[j]; }
    }
#pragma unroll
    for (int e = 0; e < 4; ++e) {
        u32x4 lo, hi;
        lo.x = pg8::cvt_pk_bf16(v[0][e], v[1][e]); lo.y = pg8::cvt_pk_bf16(v[2][e], v[3][e]); lo.z = pg8::cvt_pk_bf16(v[4][e], v[5][e]); lo.w = pg8::cvt_pk_bf16(v[6][e], v[7][e]);
        hi.x = pg8::cvt_pk_bf16(v[8][e], v[9][e]); hi.y = pg8::cvt_pk_bf16(v[10][e], v[11][e]); hi.z = pg8::cvt_pk_bf16(v[12][e], v[13][e]); hi.w = pg8::cvt_pk_bf16(v[14][e], v[15][e]);
        LAS unsigned char* p = T + (64 * e + n4) * 272 + 32 * kr;
        *(LAS u32x4*)p = lo; *(LAS u32x4*)(p + 16) = hi;
    }
    LDS_WAIT();
    __syncthreads();
    {
        const int rho = tid >> 1, half = tid & 1, n = n0 + 4 * (rho & 63) + (rho >> 6);
        int nrow = n;
        if (permqk && n < 1280) { const int p = n & 63; nrow = (n & ~63) + 2 * (p & 31) + (p >> 5); }
        const LAS unsigned char* src = T + rho * 272 + 128 * half;
        bf16_t* dst = WT + (size_t)nrow * K + k0 + 64 * half;
        u32x4 o[8];
#pragma unroll
        for (int c = 0; c < 8; ++c) o[c] = *(const LAS u32x4*)(src + 16 * c);
#pragma unroll
        for (int c = 0; c < 8; ++c) *(u32x4*)(dst + 8 * c) = o[c];
    }
    LDS_WAIT();
    __syncthreads();
}
__device__ __forceinline__ void prenorm_finish(const f32x4 (&v)[8], float* rstd, bf16_t* hrow, int lane) {
    float ss = 0.f;
#pragma unroll
    for (int j = 0; j < 8; ++j) ss += (v[j][0] * v[j][0] + v[j][1] * v[j][1]) + (v[j][2] * v[j][2] + v[j][3] * v[j][3]);
    ss = wave_sum(ss);
    if (lane == 0) *rstd = rsqrtf(ss * (1.0f / 2048.0f) + EPS);
#pragma unroll
    for (int j = 0; j < 8; ++j) { u32x2 w; w.x = pg8::cvt_pk_bf16(v[j][0], v[j][1]); w.y = pg8::cvt_pk_bf16(v[j][2], v[j][3]); *(u32x2*)(hrow + 4 * lane + 256 * j) = w; }
}
constexpr int TR_IN = 16 * 20, TR_OUT = 16 * 8, TR_ITEMS = TR_IN + TR_OUT;
__device__ __forceinline__ void transpose_item(const Frame& F, int l, int r, LAS unsigned char* ring) {
    if (r < TR_IN) p0_transpose_blk(F.w_in + (size_t)l * DM * DIN, DM, DIN, F.WTIN + (size_t)l * DIN * DM, true, F.norm_pre + l * DM, ring, r, F.tid);
    else p0_transpose_blk(F.w_out + (size_t)l * DM * DM, DM, DM, F.WTOUT + (size_t)l * DM * DM, false, nullptr, ring, r - TR_IN, F.tid);
}
__device__ __forceinline__ void p0_prologue(const Frame& F, LAS unsigned char* ring) {
    const int gw = F.bid * NWAVES + F.wave, NGW = F.G * NWAVES;
    EV_T0();
    for (int it = F.bid; it < TR_ITEMS; it += F.G) transpose_item(F, 0, it, ring);
    __syncthreads(); EV_MAX(8);
    for (int m = 2 * gw; m < MT; m += 2 * NGW) {
        const float* xa = m < MP ? F.xp + (size_t)m * DM : F.xs + (size_t)(m - MP) * DM; const float* xb = (m + 1) < MP ? F.xp + (size_t)(m + 1) * DM : F.xs + (size_t)(m + 1 - MP) * DM;
        f32x4 va[8], vb[8];
#pragma unroll
        for (int j = 0; j < 8; ++j) { va[j] = __builtin_nontemporal_load((const f32x4*)(xa + 4 * F.lane + 256 * j)); vb[j] = __builtin_nontemporal_load((const f32x4*)(xb + 4 * F.lane + 256 * j)); }
        prenorm_finish(va, F.RSTD + m, F.H + (size_t)m * DM, F.lane); prenorm_finish(vb, F.RSTD + m + 1, F.H + (size_t)(m + 1) * DM, F.lane); }
    __syncthreads(); EV_MAX(9);
    const int gt = F.bid * NTHREADS + F.tid, NGT = F.G * NTHREADS;
    for (int e = gt; e < 2052 * 32; e += NGT) { const int tp = e >> 5, i = e & 31; const double pos = (double)(tp < 2048 ? tp : 8192 + (tp - 2048));
        const double rev = pos * ROPE_INV[i] * 0.15915494309189535; const float fr = (float)(rev - floor(rev));
        F.rope[tp * 64 + i] = __builtin_amdgcn_cosf(fr); F.rope[tp * 64 + 32 + i] = __builtin_amdgcn_sinf(fr); }
    for (int e = gt; e < 2 * 4 * 128 * 128; e += NGT) { const int s = e & 127, t = (e >> 7) & 127; const float w = F.sgu_w[e];
        F.SGUW[e] = (bf16_t)(pg8::cvt_pk_bf16(s <= t ? w : 0.f, 0.f) & 0xffffu); }
    for (int e = gt; e < 2 * 4 * 128; e += NGT) { const int t = e & 127; const float* wr = F.sgu_w + (size_t)e * 128; float acc = 0.f;
        for (int s2 = 0; s2 <= t; ++s2) acc += __uint_as_float(pg8::cvt_pk_bf16(wr[s2], 0.f) << 16);
        F.RSW[e] = acc; }
    for (int e = gt; e < 2 * 4 * 128 * 128; e += NGT) { const int c = e & 127, d = (e >> 7) & 127, lg = e >> 14;
        F.PWT[e] = (bf16_t)(pg8::cvt_pk_bf16(F.pool_w[((size_t)lg * 128 + c) * 128 + d], 0.f) & 0xffffu); }
}

constexpr int AT_K = 0, AT_V = 49152, AT_STG = 98304, AT_WSTRIDE = 4352;
__device__ __forceinline__ void attn_stage_kv(const Frame& F, int b, int kvh, int nbp, LAS unsigned char* ring) {
    const int tid = F.tid;
    const bf16_t* kg = F.Kc + ((size_t)(b * 4 + kvh) * 2048 + 256 * nbp - 128) * 64;
    const bf16_t* vg = F.VTP + ((size_t)(b * 4 + kvh) * 64 + 8 * nbp - 4) * 2048;
    u32x4 kv[6], vv[6];
#pragma unroll
    for (int i = 0; i < 6; ++i) { const int ch = tid + 512 * i, row0 = ch >> 3, c8 = ch & 7, row = (nbp > 0 || row0 >= 128) ? row0 : row0 + 128;
        kv[i] = __builtin_nontemporal_load((const u32x4*)(kg + row * 64 + c8 * 8)); }
#pragma unroll
    for (int i = 0; i < 6; ++i) { const int ch = tid + 512 * i, tile0 = ch >> 8, rem = ch & 255, d = rem >> 2, c4 = rem & 3, tile = (nbp > 0 || tile0 >= 4) ? tile0 : tile0 + 4;
        vv[i] = __builtin_nontemporal_load((const u32x4*)(vg + tile * 2048 + d * 32 + c4 * 8)); }
#pragma unroll
    for (int i = 0; i < 6; ++i) { const int ch = tid + 512 * i, row = ch >> 3, c8 = ch & 7;
        *(LAS u32x4*)(ring + AT_K + row * 128 + ((c8 ^ (row & 7)) << 4)) = kv[i]; }
#pragma unroll
    for (int i = 0; i < 6; ++i) { const int ch = tid + 512 * i, tile = ch >> 8, rem = ch & 255, d = rem >> 2, c4 = rem & 3;
        *(LAS u32x4*)(ring + AT_V + tile * 4096 + d * 64 + ((c4 ^ ((d >> 2) & 3)) << 4)) = vv[i]; }
}
__device__ __forceinline__ void attn_task(const Frame& F, int l, int b, int nbp, int head, int j, const bf16x8 (&qf)[4], LAS unsigned char* ring) {
    const int lane = F.lane, r = lane & 31, hh = lane >> 5;
    LAS unsigned char* wl = ring + AT_STG + F.wave * AT_WSTRIDE;
    LAS float* wsf = (LAS float*)wl; LAS bf16_t* stg = (LAS bf16_t*)(wl + 256);
    const size_t qrow0 = (size_t)b * 2048 + 256 * nbp + 32 * j;
    u32x4 gv[4];
#pragma unroll
    for (int i = 0; i < 4; ++i) gv[i] = __builtin_nontemporal_load((const u32x4*)(F.Z2 + (qrow0 + i * 8 + (lane >> 3)) * ZW + Z_GA + head * 64 + (lane & 7) * 8));
    const int cmin = (nbp > 0) ? 0 : (j < 4 ? 4 - j : 0);
    f32x16 S[5];
#pragma unroll
    for (int c = 0; c < 5; ++c) {
        f32x16 a;
#pragma unroll
        for (int i = 0; i < 16; ++i) a[i] = 0.f;
        if (c >= cmin) {
            LAS unsigned char* kp = ring + AT_K + (32 * (j + c) + r) * 128;
#pragma unroll
            for (int s = 0; s < 4; ++s) a = __builtin_amdgcn_mfma_f32_32x32x16_bf16(*(const LAS bf16x8*)(kp + (((2 * s + hh) ^ (r & 7)) << 4)), qf[s], a, 0, 0, 0);
        }
        S[c] = a;
    }
    const float NEG = -INFINITY;
#pragma unroll
    for (int i = 0; i < 16; ++i) { const int kap = crow(i, hh); if (kap <= r) S[0][i] = NEG; if (kap > r) S[4][i] = NEG; }
    const float sink2 = F.sinks[l * 16 + head] * LOG2E;
    float m = sink2;
#pragma unroll
    for (int c = 0; c < 5; ++c) if (c >= cmin) {
#pragma unroll
        for (int i = 0; i < 16; ++i) m = fmaxf(m, S[c][i]); }
    m = fmaxf(m, __shfl_xor(m, 32));
    float sum = 0.f;
#pragma unroll
    for (int c = 0; c < 5; ++c) if (c >= cmin) {
#pragma unroll
        for (int i = 0; i < 16; ++i) { const float p = __builtin_amdgcn_exp2f(S[c][i] - m); S[c][i] = p; sum += p; } }
    sum += __shfl_xor(sum, 32);
    const float inv = 1.0f / (sum + __builtin_amdgcn_exp2f(sink2 - m));
    f32x16 o[2];
#pragma unroll
    for (int i = 0; i < 16; ++i) { o[0][i] = 0.f; o[1][i] = 0.f; }
#pragma unroll
    for (int c = 0; c < 5; ++c) if (c >= cmin) {
        LAS unsigned char* vt = ring + AT_V + (j + c) * 4096 + r * 64;
#pragma unroll
        for (int s = 0; s < 2; ++s) {
            u32x4 pw; pw.x = pg8::cvt_pk_bf16(S[c][8 * s + 0], S[c][8 * s + 1]); pw.y = pg8::cvt_pk_bf16(S[c][8 * s + 2], S[c][8 * s + 3]);
            pw.z = pg8::cvt_pk_bf16(S[c][8 * s + 4], S[c][8 * s + 5]); pw.w = pg8::cvt_pk_bf16(S[c][8 * s + 6], S[c][8 * s + 7]);
            const bf16x8 pa = __builtin_bit_cast(bf16x8, pw);
            const int sw = (((2 * hh + s) ^ ((r >> 2) & 3)) << 4);
#pragma unroll
            for (int db = 0; db < 2; ++db) o[db] = __builtin_amdgcn_mfma_f32_32x32x16_bf16(pa, *(const LAS bf16x8*)(vt + db * 2048 + sw), o[db], 0, 0, 0);
        }
    }
    if (hh == 0) wsf[r] = inv;
    LDS_WAIT();
#pragma unroll
    for (int i = 0; i < 16; ++i) { const int q = crow(i, hh); const float rl = wsf[q];
        stg[q * 64 + r] = (bf16_t)(pg8::cvt_pk_bf16(o[0][i] * rl, 0.f) & 0xffffu);
        stg[q * 64 + 32 + r] = (bf16_t)(pg8::cvt_pk_bf16(o[1][i] * rl, 0.f) & 0xffffu); }
    LDS_WAIT();
#pragma unroll
    for (int i = 0; i < 4; ++i) { const int row = i * 8 + (lane >> 3), ch = lane & 7;
        const u32x4 ov = *(const LAS u32x4*)(stg + row * 64 + ch * 8);
        float of[8], gf[8]; unpack8(ov, of); unpack8(gv[i], gf);
#pragma unroll
        for (int jj = 0; jj < 8; ++jj) of[jj] *= gf[jj];
        *(u32x4*)(F.MIX + (qrow0 + row) * DM + head * 64 + ch * 8) = pack8(of); }
    LDS_WAIT();
}
__device__ __forceinline__ void attn_unit(int l, int a, LAS unsigned char* ring) {
    LOCAL_FRAME;
    const int kvh = a & 3, nbp = (a >> 2) & 7, b = a >> 5;
    const int lane = F.lane, r = lane & 31, hh = lane >> 5;
    const int head = 4 * kvh + (F.wave >> 1), j0 = 4 * (F.wave & 1);
    const bf16_t* qp = F.Qc + ((size_t)b * 2048 + 256 * nbp + 32 * j0 + r) * 1024 + head * 64 + 8 * hh;
    bf16x8 qa[4], qb[4];
#pragma unroll
    for (int s = 0; s < 4; ++s) qa[s] = __builtin_nontemporal_load((const bf16x8*)(qp + 16 * s));
#ifdef EXP_ZERO_LDS
    for (int e = F.tid; e < 134144 / 16; e += NTHREADS) *(LAS u32x4*)(ring + 16 * e) = (u32x4){0u, 0u, 0u, 0u};
    LDS_WAIT(); __syncthreads();
#endif
    attn_stage_kv(F, b, kvh, nbp, ring);
    LDS_WAIT();
    __syncthreads();
#pragma unroll
    for (int s = 0; s < 4; ++s) qb[s] = __builtin_nontemporal_load((const bf16x8*)(qp + 32 * 1024 + 16 * s));
    attn_task(F, l, b, nbp, head, j0 + 0, qa, ring);
#pragma unroll
    for (int s = 0; s < 4; ++s) qa[s] = __builtin_nontemporal_load((const bf16x8*)(qp + 64 * 1024 + 16 * s));
    attn_task(F, l, b, nbp, head, j0 + 1, qb, ring);
#pragma unroll
    for (int s = 0; s < 4; ++s) qb[s] = __builtin_nontemporal_load((const bf16x8*)(qp + 96 * 1024 + 16 * s));
    attn_task(F, l, b, nbp, head, j0 + 2, qa, ring);
    attn_task(F, l, b, nbp, head, j0 + 3, qb, ring);
    __syncthreads();
}

constexpr int PL_STRIDE = 272, PL_WBYTES = 47 * 272;
template <int G>
__device__ __forceinline__ void pool_unit_p(int l, int tile, LAS unsigned char* wl) {
    LOCAL_FRAME;
    constexpr int W = 2 << G, HIST = W - 1, NROW = 32 + HIST, NLD = (NROW * 16 + 63) / 64;
    const int lane = F.lane, r = lane & 31, hh = lane >> 5;
    const size_t R0 = (size_t)32 * tile;
    const int t0 = (int)(R0 & 2047);
    {
        u32x4 x[NLD];
#pragma unroll
        for (int k = 0; k < NLD; ++k) { const int id = lane + 64 * k, lr = id >> 4, c16 = id & 15; const int lrc = lr < NROW ? lr : NROW - 1;
            const int back = HIST - lrc; const size_t grow = (back <= t0) ? R0 - back : R0;
            x[k] = __builtin_nontemporal_load((const u32x4*)(F.Z2 + grow * ZW + Z_XB + 128 * G + 8 * c16)); }
#pragma unroll
        for (int k = 0; k < NLD; ++k) { const int id = lane + 64 * k, lr = id >> 4, c16 = id & 15; if (lr < NROW) *(LAS u32x4*)(wl + lr * PL_STRIDE + c16 * 16) = x[k]; }
    }
    const int t = t0 + r;
    const float icnt = 1.0f / (float)(W < t + 1 ? W : t + 1);
    LDS_WAIT();
    bf16x8 bfr[8];
#pragma unroll
    for (int s = 0; s < 8; ++s) {
        LAS unsigned char* bp = wl + (r + HIST) * PL_STRIDE + (16 * s + 8 * hh) * 2;
        float cur[8], sum[8]; unpack8(*(const LAS u32x4*)bp, cur);
#pragma unroll
        for (int jj = 0; jj < 8; ++jj) sum[jj] = cur[jj];
#pragma unroll
        for (int i = 1; i < W; ++i) { float f[8]; unpack8(*(const LAS u32x4*)(bp - i * PL_STRIDE), f); const float wgt = i <= t ? 1.f : 0.f;
#pragma unroll
            for (int jj = 0; jj < 8; ++jj) sum[jj] += wgt * f[jj]; }
#pragma unroll
        for (int jj = 0; jj < 8; ++jj) sum[jj] = sum[jj] * icnt - cur[jj];
        bfr[s] = __builtin_bit_cast(bf16x8, pack8(sum));
        __builtin_amdgcn_sched_barrier(0);
    }
#pragma unroll
    for (int db = 0; db < 4; ++db) {
        const int col = 128 * G + 32 * db + r;
        unsigned short gq[16];
#pragma unroll
        for (int i = 0; i < 16; ++i) gq[i] = __builtin_nontemporal_load(F.Z2 + (R0 + crow(i, hh)) * ZW + Z_GP + col);
        const float sc = F.pool_scale[l * 512 + col];
        f32x16 acc;
#pragma unroll
        for (int i = 0; i < 16; ++i) acc[i] = 0.f;
        const bf16_t* bp2 = F.PWT + ((size_t)(l * 4 + G) * 128 + 32 * db + r) * 128 + 8 * hh;
#pragma unroll
        for (int s = 0; s < 8; ++s) acc = __builtin_amdgcn_mfma_f32_32x32x16_bf16(bfr[s], *(const bf16x8*)(bp2 + 16 * s), acc, 0, 0, 0);
#pragma unroll
        for (int i = 0; i < 16; ++i) { const float gf = __uint_as_float((unsigned)gq[i] << 16);
            F.MIX[(R0 + crow(i, hh)) * DM + 1024 + col] = (bf16_t)(pg8::cvt_pk_bf16(acc[i] * sc * gf, 0.f) & 0xffffu); }
        __builtin_amdgcn_sched_barrier(0);
    }
    LDS_WAIT();
}
__device__ __forceinline__ void pool_prompt(int l, int g, int tile, LAS unsigned char* wl) {
    if (g == 0) pool_unit_p<0>(l, tile, wl); else if (g == 1) pool_unit_p<1>(l, tile, wl); else if (g == 2) pool_unit_p<2>(l, tile, wl); else pool_unit_p<3>(l, tile, wl);
}
template <int G>
__device__ __forceinline__ void pool_unit_s(int l, int tile) {
    LOCAL_FRAME;
    constexpr int W = 2 << G;
    const int lane = F.lane, r = lane & 31, hh = lane >> 5;
    const size_t row = (size_t)MP + 32 * tile + r;
    const int tt = (int)(row & 3), bd = (int)((row - MP) >> 2);
    const float* stb = F.state_pool + ((size_t)l * 128 + bd) * 15 * 512;
    const float icnt = 1.0f / (float)W;
    bf16x8 bfr[8];
#pragma unroll
    for (int s = 0; s < 8; ++s) {
        const int c0 = 128 * G + 16 * s + 8 * hh;
        float sum[8], cur[8];
        {
            constexpr int NL = W < 4 ? W : 4;
            u32x4 zn[NL]; f32x4 sa[NL], sb[NL];
#pragma unroll
            for (int i = 0; i < NL; ++i) { const int back = i <= tt ? i : tt; int si = 15 + tt - i; si = si > 14 ? 14 : si;
                zn[i] = *(const u32x4*)(F.Z2 + (row - back) * ZW + Z_XB + c0); sa[i] = *(const f32x4*)(stb + si * 512 + c0); sb[i] = *(const f32x4*)(stb + si * 512 + c0 + 4); }
            unpack8(zn[0], cur);
#pragma unroll
            for (int jj = 0; jj < 8; ++jj) sum[jj] = cur[jj];
#pragma unroll
            for (int i = 1; i < NL; ++i) { float f[8]; unpack8(zn[i], f); const bool nw = i <= tt;
#pragma unroll
                for (int jj = 0; jj < 4; ++jj) { sum[jj] += nw ? f[jj] : sa[i][jj]; sum[4 + jj] += nw ? f[4 + jj] : sb[i][jj]; } }
        }
#pragma unroll
        for (int i0 = 4; i0 < W; i0 += 4) {
            f32x4 sa[4], sb[4];
#pragma unroll
            for (int i = 0; i < 4; ++i) { const int si = 15 + tt - (i0 + i); sa[i] = *(const f32x4*)(stb + si * 512 + c0); sb[i] = *(const f32x4*)(stb + si * 512 + c0 + 4); }
#pragma unroll
            for (int i = 0; i < 4; ++i)
#pragma unroll
                for (int jj = 0; jj < 4; ++jj) { sum[jj] += sa[i][jj]; sum[4 + jj] += sb[i][jj]; }
        }
#pragma unroll
        for (int jj = 0; jj < 8; ++jj) sum[jj] = sum[jj] * icnt - cur[jj];
        bfr[s] = __builtin_bit_cast(bf16x8, pack8(sum));
        __builtin_amdgcn_sched_barrier(0);
    }
    f32x16 acc[4];
#pragma unroll
    for (int db = 0; db < 4; ++db) {
#pragma unroll
        for (int i = 0; i < 16; ++i) acc[db][i] = 0.f;
        const bf16_t* ap = F.PWT + ((size_t)(l * 4 + G) * 128 + 32 * db + r) * 128 + 8 * hh;
#pragma unroll
        for (int s = 0; s < 8; ++s) acc[db] = __builtin_amdgcn_mfma_f32_32x32x16_bf16(*(const bf16x8*)(ap + 16 * s), bfr[s], acc[db], 0, 0, 0);
        __builtin_amdgcn_sched_barrier(0);
    }
#pragma unroll
    for (int db = 0; db < 4; ++db)
#pragma unroll
        for (int q = 0; q < 4; ++q) {
            const int col = 128 * G + 32 * db + 8 * q + 4 * hh;
            const f32x4 sc = *(const f32x4*)(F.pool_scale + l * 512 + col);
            float gf[4]; unpack4(*(const u32x2*)(F.Z2 + row * ZW + Z_GP + col), gf);
            u32x2 wv; wv.x = pg8::cvt_pk_bf16(acc[db][4 * q + 0] * sc[0] * gf[0], acc[db][4 * q + 1] * sc[1] * gf[1]);
            wv.y = pg8::cvt_pk_bf16(acc[db][4 * q + 2] * sc[2] * gf[2], acc[db][4 * q + 3] * sc[3] * gf[3]);
            *(u32x2*)(F.MIX + row * DM + 1024 + col) = wv;
        }
}
__device__ __forceinline__ void pool_sample(int l, int g, int tile) {
    if (g == 0) pool_unit_s<0>(l, tile); else if (g == 1) pool_unit_s<1>(l, tile); else if (g == 2) pool_unit_s<2>(l, tile); else pool_unit_s<3>(l, tile);
}

struct SguOps { bf16x8 wB[8], wA[4]; };
__device__ __forceinline__ void sgu_load_ops(SguOps& o, const Frame& F, int l, int hd, size_t R0, int r, int hh, int db, int tbA, int tbB) {
    const bf16_t* Wb = F.SGUW + (size_t)(l * 4 + hd) * 128 * 128;
#pragma unroll
    for (int s = 0; s < 8; ++s) { o.wB[s] = (bf16x8){0, 0, 0, 0, 0, 0, 0, 0}; if (s < 2 * (tbB + 1)) o.wB[s] = *(const bf16x8*)(Wb + (32 * tbB + r) * 128 + 16 * s + 8 * hh); }
#pragma unroll
    for (int s = 0; s < 4; ++s) { o.wA[s] = (bf16x8){0, 0, 0, 0, 0, 0, 0, 0}; if (s < 2 * (tbA + 1)) o.wA[s] = *(const bf16x8*)(Wb + (32 * tbA + r) * 128 + 16 * s + 8 * hh); }
}
struct SguUG { unsigned short uu[16], gg[16]; };
__device__ __forceinline__ void sgu_load_ug(SguUG& o, const Frame& F, int hd, size_t R0, int r, int hh, int db, int tb) {
    const bf16_t* p = F.Z2 + (R0 + 32 * tb + 4 * hh) * ZW + Z_U + 128 * hd + 32 * db + r;
#pragma unroll
    for (int i = 0; i < 16; ++i) { o.uu[i] = __builtin_nontemporal_load(p); o.gg[i] = __builtin_nontemporal_load(p + (Z_GS - Z_U));
        p += ((i & 3) == 3 ? 5 : 1) * ZW; asm volatile("" : "+v"(p)); }
}
__device__ __forceinline__ void sgu_mfma(const SguOps& o, LAS bf16_t* VnT, int h2, int r, int hh, int db, int tbA, int tbB, f32x16& accA, f32x16& accB) {
#pragma unroll
    for (int i = 0; i < 16; ++i) { accA[i] = 0.f; accB[i] = 0.f; }
#pragma unroll
    for (int s = 0; s < 8; ++s) {
        if (s < 2 * (tbB + 1)) {
            const LAS unsigned char* ap = (const LAS unsigned char*)VnT + (h2 * 128 + 16 * s + 8 * hh + ((r & 15) >> 2)) * 320 + (32 * db + (r & 16) + 4 * (r & 3)) * 2;
            const v4i16_t lo = __builtin_amdgcn_ds_read_tr16_b64_v4i16((LAS v4i16_t*)ap), hi = __builtin_amdgcn_ds_read_tr16_b64_v4i16((LAS v4i16_t*)(ap + 4 * 320));
            const bf16x8 a = (bf16x8){lo[0], lo[1], lo[2], lo[3], hi[0], hi[1], hi[2], hi[3]};
            accB = __builtin_amdgcn_mfma_f32_32x32x16_bf16(o.wB[s], a, accB, 0, 0, 0);
            if (s < 4) { if (s < 2 * (tbA + 1)) accA = __builtin_amdgcn_mfma_f32_32x32x16_bf16(o.wA[s], a, accA, 0, 0, 0); }
        }
    }
}
__device__ __forceinline__ void sgu_epi(const SguUG& o, const Frame& F, int l, int hd, size_t R0, int r, int hh, int db, int tb, const f32x16& acc) {
    const int col = 128 * hd + 32 * db + r;
    const float lg = F.ln_g[l * 512 + col], lb = F.ln_b[l * 512 + col];
    const float* bsp = F.sgu_b + l * 512 + hd * 128 + 32 * tb + 4 * hh; const float* rsp = F.RSW + (l * 4 + hd) * 128 + 32 * tb + 4 * hh;
    bf16_t* q = F.MIX + (R0 + 32 * tb + 4 * hh) * DM + 1536 + col;
#pragma unroll
    for (int i = 0; i < 16; ++i) { const int dt = (i & 3) + 8 * (i >> 2);
        const float uf = __uint_as_float((unsigned)o.uu[i] << 16), gf = __uint_as_float((unsigned)o.gg[i] << 16);
        const float m = (lg * acc[i] + lb * rsp[dt] + bsp[dt]) * uf * gf;
        *q = (bf16_t)(pg8::cvt_pk_bf16(m, 0.f) & 0xffffu);
        q += ((i & 3) == 3 ? 5 : 1) * DM; asm volatile("" : "+v"(q)); }
}
__device__ __forceinline__ void sgu_unit(int l, int ci, int hp, LAS unsigned char* ring) {
    LOCAL_FRAME;
    LAS bf16_t* VnT = (LAS bf16_t*)ring;
    const int lane = F.lane, wv = F.wave;
    const size_t R0 = (size_t)128 * ci;
    const int r = lane & 31, hh = lane >> 5, db = wv & 3; const int tbA = (wv >> 2) ? 1 : 0, tbB = (wv >> 2) ? 2 : 3;
    SguOps op0;
    {
        const int tl = lane >> 2, q4 = lane & 3;
        const bf16_t* vrow = F.Z2 + (R0 + 16 * wv + tl) * ZW + Z_VS + 32 * q4;
        u32x4 x[4][4];
#pragma unroll
        for (int h = 0; h < 4; ++h)
#pragma unroll
            for (int i = 0; i < 4; ++i) x[h][i] = *(const u32x4*)(vrow + 128 * h + 8 * i);
        sgu_load_ops(op0, F, l, 2 * hp, R0, r, hh, db, tbA, tbB);
        float s = 0.f, ss = 0.f;
#pragma unroll
        for (int h = 0; h < 4; ++h)
#pragma unroll
            for (int i = 0; i < 4; ++i) { float f[8]; unpack8(x[h][i], f);
#pragma unroll
                for (int jj = 0; jj < 8; ++jj) { s += f[jj]; ss += f[jj] * f[jj]; } }
        s += __shfl_xor(s, 1); s += __shfl_xor(s, 2); ss += __shfl_xor(ss, 1); ss += __shfl_xor(ss, 2);
        const float mean = s * (1.0f / 512.0f), var = ss * (1.0f / 512.0f) - mean * mean, rstd = rsqrtf(var + EPS);
#pragma unroll
        for (int h2 = 0; h2 < 2; ++h2)
#pragma unroll
            for (int i = 0; i < 4; ++i) { const int d = 32 * q4 + 8 * i;
                const u32x4 xv = hp ? x[2 + h2][i] : x[h2][i];
                float f[8]; unpack8(xv, f);
#pragma unroll
                for (int jj = 0; jj < 8; ++jj) f[jj] = (f[jj] - mean) * rstd;
                *(LAS u32x4*)((LAS unsigned char*)VnT + (h2 * 128 + 16 * wv + tl) * 320 + d * 2) = pack8(f); }
    }
    LDS_WAIT();
    __syncthreads();
    f32x16 accA, accB;
    SguUG ua, ub;
    sgu_load_ug(ua, F, 2 * hp, R0, r, hh, db, tbA);
    sgu_mfma(op0, VnT, 0, r, hh, db, tbA, tbB, accA, accB);
    sgu_load_ug(ub, F, 2 * hp, R0, r, hh, db, tbB);
    SguOps op1;
    sgu_load_ops(op1, F, l, 2 * hp + 1, R0, r, hh, db, tbA, tbB);
    sgu_epi(ua, F, l, 2 * hp, R0, r, hh, db, tbA, accA);
    sgu_epi(ub, F, l, 2 * hp, R0, r, hh, db, tbB, accB);
    sgu_load_ug(ua, F, 2 * hp + 1, R0, r, hh, db, tbA);
    sgu_mfma(op1, VnT, 1, r, hh, db, tbA, tbB, accA, accB);
    sgu_load_ug(ub, F, 2 * hp + 1, R0, r, hh, db, tbB);
    sgu_epi(ua, F, l, 2 * hp + 1, R0, r, hh, db, tbA, accA);
    sgu_epi(ub, F, l, 2 * hp + 1, R0, r, hh, db, tbB, accB);
    __syncthreads();
}

__device__ __forceinline__ void samp_attn(int l, int bd, int kvh, LAS unsigned char* wl) {
    LOCAL_FRAME;
    LAS float* ps = (LAS float*)wl;
    LAS float* invs = ps + 144 * 16;
    const int lane = F.lane, fr = lane & 15, fq = lane >> 4, gq = fr >> 2, tt = fr & 3;
    float* oKs = F.out + O_KS + (size_t)l * LS_KS; float* oVs = F.out + O_VS + (size_t)l * LS_KS;
    bf16x8 qfr[2];
    {
        const bf16_t* qsrc = F.Qc + ((size_t)MP + 4 * bd + tt) * 1024 + (4 * kvh + gq) * 64 + 16 * fq;
        const u32x4 qa = *(const u32x4*)qsrc, qb = *(const u32x4*)(qsrc + 8);
        u32x4 lo, hi;
        lo.x = (qa.x & 0xffffu) | (qa.y << 16); lo.y = (qa.z & 0xffffu) | (qa.w << 16); lo.z = (qb.x & 0xffffu) | (qb.y << 16); lo.w = (qb.z & 0xffffu) | (qb.w << 16);
        hi.x = (qa.x >> 16) | (qa.y & 0xffff0000u); hi.y = (qa.z >> 16) | (qa.w & 0xffff0000u); hi.z = (qb.x >> 16) | (qb.y & 0xffff0000u); hi.w = (qb.z >> 16) | (qb.w & 0xffff0000u);
        qfr[0] = __builtin_bit_cast(bf16x8, lo); qfr[1] = __builtin_bit_cast(bf16x8, hi);
    }
    const float* kc = F.cache_k + (((size_t)l * 128 + bd) * 128) * 256 + kvh * 64 + 8 * fq;
    const float* kn = oKs + (((size_t)bd * 128 + 124 + (fr & 3)) * 4 + kvh) * 64 + 8 * fq;
    float* kd = oKs + ((size_t)bd * 128 * 4 + kvh) * 64 + 8 * fq;
    f32x4 S[9];
#pragma unroll
    for (int T = 0; T < 9; ++T) S[T] = (f32x4){0.f, 0.f, 0.f, 0.f};
#pragma unroll
    for (int T0 = 0; T0 < 9; T0 += 3) {
        f32x4 x[3][2][2];
#pragma unroll
        for (int u = 0; u < 3; ++u) { const int T = T0 + u; const float* src = (T < 8) ? kc + (size_t)(16 * T + fr) * 256 : kn;
#pragma unroll
            for (int ks = 0; ks < 2; ++ks) { x[u][ks][0] = __builtin_nontemporal_load((const f32x4*)(src + 32 * ks)); x[u][ks][1] = __builtin_nontemporal_load((const f32x4*)(src + 32 * ks + 4)); } }
#pragma unroll
        for (int u = 0; u < 3; ++u) { const int T = T0 + u; const int key = 16 * T + fr;
            if (T < 8 && key >= 4) {
#pragma unroll
                for (int ks = 0; ks < 2; ++ks) { float* dst = kd + (size_t)(key - 4) * 256 + 32 * ks; __builtin_nontemporal_store(x[u][ks][0], (f32x4*)dst); __builtin_nontemporal_store(x[u][ks][1], (f32x4*)(dst + 4)); } } }
#pragma unroll
        for (int u = 0; u < 3; ++u)
#pragma unroll
            for (int ks = 0; ks < 2; ++ks) { u32x4 w; w.x = pg8::cvt_pk_bf16(x[u][ks][0][0], x[u][ks][0][1]); w.y = pg8::cvt_pk_bf16(x[u][ks][0][2], x[u][ks][0][3]);
                w.z = pg8::cvt_pk_bf16(x[u][ks][1][0], x[u][ks][1][1]); w.w = pg8::cvt_pk_bf16(x[u][ks][1][2], x[u][ks][1][3]);
                S[T0 + u] = __builtin_amdgcn_mfma_f32_16x16x32_bf16(__builtin_bit_cast(bf16x8, w), qfr[ks], S[T0 + u], 0, 0, 0); }
        __builtin_amdgcn_sched_barrier(0);
    }
    const float sink2 = F.sinks[l * 16 + 4 * kvh + gq] * LOG2E;
    float m = sink2;
#pragma unroll
    for (int T = 0; T < 9; ++T)
#pragma unroll
        for (int rg = 0; rg < 4; ++rg) { const int key = 16 * T + 4 * fq + rg; const bool ok = (T < 8) ? (key >= tt + 1) : (fq == 0 && rg <= tt);
            S[T][rg] = ok ? S[T][rg] : -INFINITY; m = fmaxf(m, S[T][rg]); }
    m = fmaxf(m, __shfl_xor(m, 16)); m = fmaxf(m, __shfl_xor(m, 32));
    float sum = 0.f;
#pragma unroll
    for (int T = 0; T < 9; ++T)
#pragma unroll
        for (int rg = 0; rg < 4; ++rg) { const float p = __builtin_amdgcn_exp2f(S[T][rg] - m); sum += p; ps[(16 * T + 4 * fq + rg) * 16 + fr] = p; }
    sum += __shfl_xor(sum, 16); sum += __shfl_xor(sum, 32);
    if (fq == 0) invs[fr] = 1.0f / (sum + __builtin_amdgcn_exp2f(sink2 - m));
    LDS_WAIT();
    const int kq = lane >> 4, dq = lane & 15;
    const float* vcp = F.cache_v + (((size_t)l * 128 + bd) * 128 + kq) * 256 + kvh * 64 + 4 * dq;
    float* vop = oVs + ((size_t)bd * 128 + kq) * 256 + kvh * 64 + 4 * dq;
#pragma unroll 1
    for (int pass = 0; pass < 2; ++pass) {
        float o[8][4];
#pragma unroll
        for (int q = 0; q < 8; ++q) { o[q][0] = 0.f; o[q][1] = 0.f; o[q][2] = 0.f; o[q][3] = 0.f; }
#pragma unroll 1
        for (int blk = 0; blk < 3; ++blk) {
            f32x4 vx[11];
#pragma unroll
            for (int ii = 0; ii < 11; ++ii) { const int i = blk * 11 + ii; const float* src = (i < 32) ? vcp + (size_t)i * 1024 : vop + (size_t)31 * 1024; vx[ii] = __builtin_nontemporal_load((const f32x4*)src); }
            if (pass == 0) {
#pragma unroll
                for (int ii = 0; ii < 11; ++ii) { const int i = blk * 11 + ii; if (i >= 1 && i < 32) __builtin_nontemporal_store(vx[ii], (f32x4*)(vop + (size_t)(i - 1) * 1024)); } }
#pragma unroll
            for (int ii = 0; ii < 11; ++ii) { const int key = 4 * (blk * 11 + ii) + kq;
                const f32x4 pa = *(const LAS f32x4*)(ps + key * 16 + 8 * pass), pb = *(const LAS f32x4*)(ps + key * 16 + 8 * pass + 4);
#pragma unroll
                for (int e = 0; e < 4; ++e) { o[0][e] += pa[0] * vx[ii][e]; o[1][e] += pa[1] * vx[ii][e]; o[2][e] += pa[2] * vx[ii][e]; o[3][e] += pa[3] * vx[ii][e];
                    o[4][e] += pb[0] * vx[ii][e]; o[5][e] += pb[1] * vx[ii][e]; o[6][e] += pb[2] * vx[ii][e]; o[7][e] += pb[3] * vx[ii][e]; }
                __builtin_amdgcn_sched_barrier(0); }
        }
#pragma unroll
        for (int q = 0; q < 8; ++q)
#pragma unroll
            for (int e = 0; e < 4; ++e) { float v = o[q][e]; v += __shfl_xor(v, 16); v += __shfl_xor(v, 32); o[q][e] = v; }
#pragma unroll
        for (int q = 0; q < 8; ++q) if ((q >> 1) == kq) { const int qq = 8 * pass + q, t2 = qq & 3, head = 4 * kvh + (qq >> 2); const size_t row = (size_t)MP + 4 * bd + t2;
            float gf[4]; unpack4(*(const u32x2*)(F.Z2 + row * ZW + Z_GA + head * 64 + 4 * dq), gf);
            const float iq = invs[qq];
            u32x2 wv; wv.x = pg8::cvt_pk_bf16(o[q][0] * iq * gf[0], o[q][1] * iq * gf[1]); wv.y = pg8::cvt_pk_bf16(o[q][2] * iq * gf[2], o[q][3] * iq * gf[3]);
            *(u32x2*)(F.MIX + row * DM + head * 64 + 4 * dq) = wv; }
    }
    LDS_WAIT();
}
__device__ __forceinline__ void samp_sgu(int l, int bd) {
    LOCAL_FRAME;
    const int lane = F.lane, c0 = 8 * lane, hd = lane >> 4;
    {
        float* oPs = F.out + O_PS + (size_t)l * LS_PS + (size_t)bd * 15 * 512; const float* sp = F.state_pool + (size_t)l * LS_PS + (size_t)bd * 15 * 512 + 4 * 512;
        f32x4 cp[22];
#pragma unroll
        for (int k = 0; k < 22; ++k) cp[k] = __builtin_nontemporal_load((const f32x4*)(sp + 4 * (lane + 64 * k)));
#pragma unroll
        for (int k = 0; k < 22; ++k) __builtin_nontemporal_store(cp[k], (f32x4*)(oPs + 4 * (lane + 64 * k)));
    }
    float* oCV = F.out + O_CV + (size_t)l * LS_CV;
    float gl[8], bl[8];
#pragma unroll
    for (int j = 0; j < 8; ++j) { gl[j] = F.ln_g[l * 512 + c0 + j]; bl[j] = F.ln_b[l * 512 + c0 + j]; }
    u32x4 xr[4], ur[4], gr[4];
#pragma unroll
    for (int tt = 0; tt < 4; ++tt) { const size_t row = (size_t)MP + 4 * bd + tt; xr[tt] = *(const u32x4*)(F.Z2 + row * ZW + Z_VS + c0); ur[tt] = *(const u32x4*)(F.Z2 + row * ZW + Z_U + c0); gr[tt] = *(const u32x4*)(F.Z2 + row * ZW + Z_GS + c0); }
    float vn[4][8];
#pragma unroll
    for (int tt = 0; tt < 4; ++tt) { float f[8]; unpack8(xr[tt], f);
        float s = 0.f, ss = 0.f;
#pragma unroll
        for (int j = 0; j < 8; ++j) { s += f[j]; ss += f[j] * f[j]; }
        s = wave_sum(s); ss = wave_sum(ss);
        const float mean = s * (1.0f / 512.0f), var = ss * (1.0f / 512.0f) - mean * mean, rstd = rsqrtf(var + EPS);
#pragma unroll
        for (int j = 0; j < 8; ++j) vn[tt][j] = (f[j] - mean) * rstd * gl[j] + bl[j];
        float* o = oCV + ((size_t)bd * 4 + tt) * 512 + c0;
        *(f32x4*)o = (f32x4){vn[tt][0], vn[tt][1], vn[tt][2], vn[tt][3]}; *(f32x4*)(o + 4) = (f32x4){vn[tt][4], vn[tt][5], vn[tt][6], vn[tt][7]}; }
#pragma unroll
    for (int tt = 0; tt < 4; ++tt) { const size_t row = (size_t)MP + 4 * bd + tt;
        float mx[8]; const float bias = F.sgu_b[l * 512 + hd * 128 + tt];
#pragma unroll
        for (int j = 0; j < 8; ++j) mx[j] = bias;
#pragma unroll
        for (int s2 = 0; s2 < 4; ++s2) if (s2 <= tt) { const float w = F.sgu_w[((size_t)(l * 4 + hd) * 128 + tt) * 128 + s2];
#pragma unroll
            for (int j = 0; j < 8; ++j) mx[j] += w * vn[s2][j]; }
        float uf[8], gf[8]; unpack8(ur[tt], uf); unpack8(gr[tt], gf);
#pragma unroll
        for (int j = 0; j < 8; ++j) mx[j] = mx[j] * uf[j] * gf[j];
        *(u32x4*)(F.MIX + row * DM + 1536 + c0) = pack8(mx); }
}

#ifdef HYBRID
__device__ __forceinline__ void attn_task_o(const Frame& F, int l, int b, int nb, int head, int qs, LAS unsigned char* wl) {
    const int lane = F.lane, r = lane & 31, hh = lane >> 5, kvh = head >> 2;
    LAS float* wsf = (LAS float*)wl; LAS bf16_t* stg = (LAS bf16_t*)(wl + 256);
    const int t0 = 128 * nb + 32 * qs;
    const size_t qrow0 = (size_t)b * 2048 + t0;
    const bf16_t* qp = F.Qc + (qrow0 + r) * 1024 + head * 64 + 8 * hh;
    bf16x8 qf[4];
#pragma unroll
    for (int s = 0; s < 4; ++s) qf[s] = *(const bf16x8*)(qp + 16 * s);
    const bf16_t* kbase = F.Kc + (size_t)(b * 4 + kvh) * 2048 * 64;
    const bf16_t* vbase = F.VTP + (size_t)(b * 4 + kvh) * 64 * 2048;
    const int cmin = (nb > 0) ? 0 : (4 - qs);
    f32x16 S[5];
#pragma unroll
    for (int c = 0; c < 5; ++c) {
        f32x16 a;
#pragma unroll
        for (int i = 0; i < 16; ++i) a[i] = 0.f;
        if (c >= cmin) {
            const bf16_t* kp = kbase + (size_t)(t0 - 128 + 32 * c + r) * 64 + 8 * hh;
#pragma unroll
            for (int s = 0; s < 4; ++s) a = __builtin_amdgcn_mfma_f32_32x32x16_bf16(*(const bf16x8*)(kp + 16 * s), qf[s], a, 0, 0, 0);
        }
        S[c] = a;
    }
    const float NEG = -INFINITY;
#pragma unroll
    for (int i = 0; i < 16; ++i) { const int kap = crow(i, hh); if (kap <= r) S[0][i] = NEG; if (kap > r) S[4][i] = NEG; }
    const float sink2 = F.sinks[l * 16 + head] * LOG2E;
    float m = sink2;
#pragma unroll
    for (int c = 0; c < 5; ++c) if (c >= cmin) {
#pragma unroll
        for (int i = 0; i < 16; ++i) m = fmaxf(m, S[c][i]); }
    m = fmaxf(m, __shfl_xor(m, 32));
    float sum = 0.f;
#pragma unroll
    for (int c = 0; c < 5; ++c) if (c >= cmin) {
#pragma unroll
        for (int i = 0; i < 16; ++i) { const float p = __builtin_amdgcn_exp2f(S[c][i] - m); S[c][i] = p; sum += p; } }
    sum += __shfl_xor(sum, 32);
    const float inv = 1.0f / (sum + __builtin_amdgcn_exp2f(sink2 - m));
    f32x16 o[2];
#pragma unroll
    for (int i = 0; i < 16; ++i) { o[0][i] = 0.f; o[1][i] = 0.f; }
#pragma unroll
    for (int c = 0; c < 5; ++c) if (c >= cmin) {
        const bf16_t* vt = vbase + (size_t)((t0 - 128 + 32 * c) >> 5) * 2048 + r * 32 + 16 * hh;
#pragma unroll
        for (int s = 0; s < 2; ++s) {
            u32x4 pw; pw.x = pg8::cvt_pk_bf16(S[c][8 * s + 0], S[c][8 * s + 1]); pw.y = pg8::cvt_pk_bf16(S[c][8 * s + 2], S[c][8 * s + 3]);
            pw.z = pg8::cvt_pk_bf16(S[c][8 * s + 4], S[c][8 * s + 5]); pw.w = pg8::cvt_pk_bf16(S[c][8 * s + 6], S[c][8 * s + 7]);
            const bf16x8 pa = __builtin_bit_cast(bf16x8, pw);
#pragma unroll
            for (int db = 0; db < 2; ++db) o[db] = __builtin_amdgcn_mfma_f32_32x32x16_bf16(pa, *(const bf16x8*)(vt + db * 1024 + 8 * s), o[db], 0, 0, 0);
        }
    }
    if (hh == 0) wsf[r] = inv;
    LDS_WAIT();
#pragma unroll
    for (int i = 0; i < 16; ++i) { const int q = crow(i, hh); const float rl = wsf[q];
        stg[q * 64 + r] = (bf16_t)(pg8::cvt_pk_bf16(o[0][i] * rl, 0.f) & 0xffffu);
        stg[q * 64 + 32 + r] = (bf16_t)(pg8::cvt_pk_bf16(o[1][i] * rl, 0.f) & 0xffffu); }
    LDS_WAIT();
#pragma unroll
    for (int i = 0; i < 4; ++i) { const int row = i * 8 + (lane >> 3), ch = lane & 7;
        const u32x4 ov = *(const LAS u32x4*)(stg + row * 64 + ch * 8);
        const u32x4 gv = *(const u32x4*)(F.Z2 + (qrow0 + row) * ZW + Z_GA + head * 64 + ch * 8);
        float of[8], gf[8]; unpack8(ov, of); unpack8(gv, gf);
#pragma unroll
        for (int j = 0; j < 8; ++j) of[j] *= gf[j];
        *(u32x4*)(F.MIX + (qrow0 + row) * DM + head * 64 + ch * 8) = pack8(of); }
    LDS_WAIT();
}

template <bool SAMPLE>
__device__ __forceinline__ void pool_unit_o(const Frame& F, int l, int g, int tile) {
    const int lane = F.lane, r = lane & 31, hh = lane >> 5, w = 2 << g;
    const size_t row = (size_t)(SAMPLE ? MP : 0) + 32 * tile + r;
    const int t = SAMPLE ? (int)(row & 3) : (int)(row & 2047);
    const int bd = SAMPLE ? (int)((row - MP) >> 2) : 0;
    const float icnt = SAMPLE ? 1.0f / (float)w : 1.0f / (float)(w < t + 1 ? w : t + 1);
    bf16x8 bfr[8];
#pragma unroll
    for (int s = 0; s < 8; ++s) {
        const int c0 = 128 * g + 16 * s + 8 * hh;
        float sum[8], cur[8];
#pragma unroll
        for (int j = 0; j < 8; ++j) { sum[j] = 0.f; cur[j] = 0.f; }
        for (int i = 0; i < w; ++i) {
            float f[8];
            const int e = t - i;
            if (e >= 0) { unpack8(*(const u32x4*)(F.Z2 + (row - i) * ZW + Z_XB + c0), f); }
            else if (SAMPLE) { const float* sp = F.state_pool + (((size_t)l * 128 + bd) * 15 + 15 + e) * 512 + c0;
                const f32x4 a = *(const f32x4*)sp, bq = *(const f32x4*)(sp + 4); f[0] = a[0]; f[1] = a[1]; f[2] = a[2]; f[3] = a[3]; f[4] = bq[0]; f[5] = bq[1]; f[6] = bq[2]; f[7] = bq[3]; }
            else {
#pragma unroll
                for (int j = 0; j < 8; ++j) f[j] = 0.f; }
#pragma unroll
            for (int j = 0; j < 8; ++j) sum[j] += f[j];
            if (i == 0) {
#pragma unroll
                for (int j = 0; j < 8; ++j) cur[j] = f[j]; }
        }
        float pf[8];
#pragma unroll
        for (int j = 0; j < 8; ++j) pf[j] = sum[j] * icnt - cur[j];
        bfr[s] = __builtin_bit_cast(bf16x8, pack8(pf));
    }
    f32x16 acc[4];
#pragma unroll
    for (int db = 0; db < 4; ++db) {
#pragma unroll
        for (int i = 0; i < 16; ++i) acc[db][i] = 0.f;
        const bf16_t* ap = F.PWT + ((size_t)(l * 4 + g) * 128 + 32 * db + r) * 128 + 8 * hh;
#pragma unroll
        for (int s = 0; s < 8; ++s) acc[db] = __builtin_amdgcn_mfma_f32_32x32x16_bf16(*(const bf16x8*)(ap + 16 * s), bfr[s], acc[db], 0, 0, 0);
    }
#pragma unroll
    for (int db = 0; db < 4; ++db)
#pragma unroll
        for (int q = 0; q < 4; ++q) {
            const int col = 128 * g + 32 * db + 8 * q + 4 * hh;
            const f32x4 sc = *(const f32x4*)(F.pool_scale + l * 512 + col);
            float gf[4]; unpack4(*(const u32x2*)(F.Z2 + row * ZW + Z_GP + col), gf);
            u32x2 wv; wv.x = pg8::cvt_pk_bf16(acc[db][4 * q + 0] * sc[0] * gf[0], acc[db][4 * q + 1] * sc[1] * gf[1]);
            wv.y = pg8::cvt_pk_bf16(acc[db][4 * q + 2] * sc[2] * gf[2], acc[db][4 * q + 3] * sc[3] * gf[3]);
            *(u32x2*)(F.MIX + row * DM + 1024 + col) = wv;
        }
}

__device__ __forceinline__ void sgu_unit_o(const Frame& F, int l, int ci, int hd, LAS unsigned char* ring) {
    LAS bf16_t* VnT = (LAS bf16_t*)ring;
    const int lane = F.lane, wv = F.wave;
    const size_t R0 = (size_t)128 * ci;
    {
        const int tl = lane >> 2, q4 = lane & 3;
        const bf16_t* vrow = F.Z2 + (R0 + 16 * wv + tl) * ZW + Z_VS;
        float s = 0.f, ss = 0.f;
#pragma unroll
        for (int i = 0; i < 16; ++i) { float f[8]; unpack8(*(const u32x4*)(vrow + 128 * q4 + 8 * i), f);
#pragma unroll
            for (int j = 0; j < 8; ++j) { s += f[j]; ss += f[j] * f[j]; } }
        s += __shfl_xor(s, 1); s += __shfl_xor(s, 2); ss += __shfl_xor(ss, 1); ss += __shfl_xor(ss, 2);
        const float mean = s * (1.0f / 512.0f), var = ss * (1.0f / 512.0f) - mean * mean, rstd = rsqrtf(var + EPS);
#pragma unroll
        for (int i = 0; i < 4; ++i) { const int d = 32 * q4 + 8 * i; float f[8]; unpack8(*(const u32x4*)(vrow + 128 * hd + d), f);
            const float* gp = F.ln_g + l * 512 + 128 * hd + d; const float* bp = F.ln_b + l * 512 + 128 * hd + d;
#pragma unroll
            for (int j = 0; j < 8; ++j) { const float vn = (f[j] - mean) * rstd * gp[j] + bp[j];
                VnT[(d + j) * 136 + 16 * wv + tl] = (bf16_t)(pg8::cvt_pk_bf16(vn, 0.f) & 0xffffu); } }
    }
    __syncthreads();
    {
        const int r = lane & 31, hh = lane >> 5, db = wv & 3; const int tbA = (wv >> 2) ? 1 : 0, tbB = (wv >> 2) ? 2 : 3;
        f32x16 accA, accB;
#pragma unroll
        for (int i = 0; i < 16; ++i) { accA[i] = 0.f; accB[i] = 0.f; }
        const bf16_t* Wb = F.SGUW + (size_t)(l * 4 + hd) * 128 * 128;
#pragma unroll
        for (int s = 0; s < 8; ++s) {
            if (s < 2 * (tbB + 1)) {
                const bf16x8 a = *(const LAS bf16x8*)(VnT + (32 * db + r) * 136 + 16 * s + 8 * hh);
                accB = __builtin_amdgcn_mfma_f32_32x32x16_bf16(a, *(const bf16x8*)(Wb + (32 * tbB + r) * 128 + 16 * s + 8 * hh), accB, 0, 0, 0);
                if (s < 2 * (tbA + 1)) accA = __builtin_amdgcn_mfma_f32_32x32x16_bf16(a, *(const bf16x8*)(Wb + (32 * tbA + r) * 128 + 16 * s + 8 * hh), accA, 0, 0, 0);
            }
        }
#pragma unroll
        for (int pass = 0; pass < 2; ++pass) {
            const int tb = pass ? tbB : tbA; const f32x16 acc = pass ? accB : accA;
            const int t = 32 * tb + r; const size_t row = R0 + t; const float bias = F.sgu_b[l * 512 + hd * 128 + t];
#pragma unroll
            for (int q = 0; q < 4; ++q) { const int col = 128 * hd + 32 * db + 8 * q + 4 * hh;
                float uf[4], gf[4]; unpack4(*(const u32x2*)(F.Z2 + row * ZW + Z_U + col), uf); unpack4(*(const u32x2*)(F.Z2 + row * ZW + Z_GS + col), gf);
                u32x2 wo; wo.x = pg8::cvt_pk_bf16((acc[4 * q + 0] + bias) * uf[0] * gf[0], (acc[4 * q + 1] + bias) * uf[1] * gf[1]);
                wo.y = pg8::cvt_pk_bf16((acc[4 * q + 2] + bias) * uf[2] * gf[2], (acc[4 * q + 3] + bias) * uf[3] * gf[3]);
                *(u32x2*)(F.MIX + row * DM + 1536 + col) = wo; }
        }
    }
    __syncthreads();
}

__device__ __forceinline__ void samp_attn_o(const Frame& F, int l, int bd, int kvh, LAS unsigned char* wl) {
    LAS float* qs = (LAS float*)wl;
    LAS float* ps = (LAS float*)(wl + 4096);
    const int lane = F.lane;
    float* oKs = F.out + O_KS + (size_t)l * LS_KS; float* oVs = F.out + O_VS + (size_t)l * LS_KS;
    {
        const int qi = lane >> 2, part = lane & 3, gq = qi >> 2, tt = qi & 3;
        const bf16_t* src = F.Qc + ((size_t)MP + 4 * bd + tt) * 1024 + (4 * kvh + gq) * 64 + 16 * part;
        float f0[8], f1[8]; unpack8(*(const u32x4*)src, f0); unpack8(*(const u32x4*)(src + 8), f1);
#pragma unroll
        for (int j = 0; j < 8; ++j) { const int p0 = 16 * part + j, p1 = p0 + 8;
            qs[qi * 64 + (p0 >> 1) + 32 * (p0 & 1)] = f0[j]; qs[qi * 64 + (p1 >> 1) + 32 * (p1 & 1)] = f1[j]; }
    }
    LDS_WAIT();
    float s0[16], s1[16], s2[16];
#pragma unroll
    for (int q = 0; q < 16; ++q) { s0[q] = 0.f; s1[q] = 0.f; s2[q] = 0.f; }
    const float* k0p = F.cache_k + (((size_t)l * 128 + bd) * 128 + lane) * 256 + kvh * 64;
    const float* k1p = k0p + 64 * 256;
    const float* k2p = oKs + (((size_t)bd * 128 + 124 + (lane & 3)) * 4 + kvh) * 64;
    float* c0p = oKs + (((size_t)bd * 128 + (lane >= 4 ? lane - 4 : 0)) * 4 + kvh) * 64;
    float* c1p = oKs + (((size_t)bd * 128 + lane + 60) * 4 + kvh) * 64;
    for (int ch = 0; ch < 16; ++ch) {
        const f32x4 kx0 = *(const f32x4*)(k0p + 4 * ch), kx1 = *(const f32x4*)(k1p + 4 * ch), kx2 = *(const f32x4*)(k2p + 4 * ch);
        if (lane >= 4) *(f32x4*)(c0p + 4 * ch) = kx0;
        *(f32x4*)(c1p + 4 * ch) = kx1;
#pragma unroll
        for (int q = 0; q < 16; ++q) { const f32x4 qv = *(const LAS f32x4*)(qs + q * 64 + 4 * ch);
            s0[q] += (qv[0] * kx0[0] + qv[1] * kx0[1]) + (qv[2] * kx0[2] + qv[3] * kx0[3]);
            s1[q] += (qv[0] * kx1[0] + qv[1] * kx1[1]) + (qv[2] * kx1[2] + qv[3] * kx1[3]);
            s2[q] += (qv[0] * kx2[0] + qv[1] * kx2[1]) + (qv[2] * kx2[2] + qv[3] * kx2[3]); }
    }
    float inv[16];
#pragma unroll
    for (int q = 0; q < 16; ++q) {
        const int tt = q & 3; const float sink2 = F.sinks[l * 16 + 4 * kvh + (q >> 2)] * LOG2E;
        const bool v0 = lane >= tt + 1, v2 = (lane < 4) && (lane <= tt);
        float m = s1[q]; if (v0) m = fmaxf(m, s0[q]); if (v2) m = fmaxf(m, s2[q]);
        m = fmaxf(wave_max(m), sink2);
        const float p0 = v0 ? __builtin_amdgcn_exp2f(s0[q] - m) : 0.f, p1 = __builtin_amdgcn_exp2f(s1[q] - m), p2 = v2 ? __builtin_amdgcn_exp2f(s2[q] - m) : 0.f;
        const float sum = wave_sum(p0 + p1 + p2);
        inv[q] = 1.0f / (sum + __builtin_amdgcn_exp2f(sink2 - m));
        ps[lane * 16 + q] = p0; ps[(lane + 64) * 16 + q] = p1; if (lane < 4) ps[(128 + lane) * 16 + q] = p2;
    }
    LDS_WAIT();
    float o[16];
#pragma unroll
    for (int q = 0; q < 16; ++q) o[q] = 0.f;
    const float* vcp = F.cache_v + (((size_t)l * 128 + bd) * 128) * 256 + kvh * 64 + lane;
    float* vop = oVs + ((size_t)bd * 128) * 256 + kvh * 64 + lane;
    for (int key = 0; key < 132; ++key) {
        float v;
        if (key < 128) { v = vcp[(size_t)key * 256]; if (key >= 4) vop[(size_t)(key - 4) * 256] = v; }
        else v = vop[(size_t)(key - 4) * 256];
#pragma unroll
        for (int q4 = 0; q4 < 4; ++q4) { const f32x4 pv = *(const LAS f32x4*)(ps + key * 16 + 4 * q4);
            o[4 * q4 + 0] += pv[0] * v; o[4 * q4 + 1] += pv[1] * v; o[4 * q4 + 2] += pv[2] * v; o[4 * q4 + 3] += pv[3] * v; }
    }
#pragma unroll
    for (int q = 0; q < 16; ++q) { const int tt = q & 3, head = 4 * kvh + (q >> 2); const size_t row = (size_t)MP + 4 * bd + tt;
        const float gv = __uint_as_float(((unsigned)F.Z2[row * ZW + Z_GA + head * 64 + lane]) << 16);
        F.MIX[row * DM + head * 64 + lane] = (bf16_t)(pg8::cvt_pk_bf16(o[q] * inv[q] * gv, 0.f) & 0xffffu); }
    LDS_WAIT();
}
__device__ __forceinline__ void samp_sgu_o(const Frame& F, int l, int bd) {
    const int lane = F.lane, c0 = 8 * lane, hd = lane >> 4;
    float* oCV = F.out + O_CV + (size_t)l * LS_CV;
    float gl[8], bl[8];
#pragma unroll
    for (int j = 0; j < 8; ++j) { gl[j] = F.ln_g[l * 512 + c0 + j]; bl[j] = F.ln_b[l * 512 + c0 + j]; }
    float vn[4][8];
#pragma unroll
    for (int tt = 0; tt < 4; ++tt) { const size_t row = (size_t)MP + 4 * bd + tt; float f[8]; unpack8(*(const u32x4*)(F.Z2 + row * ZW + Z_VS + c0), f);
        float s = 0.f, ss = 0.f;
#pragma unroll
        for (int j = 0; j < 8; ++j) { s += f[j]; ss += f[j] * f[j]; }
        s = wave_sum(s); ss = wave_sum(ss);
        const float mean = s * (1.0f / 512.0f), var = ss * (1.0f / 512.0f) - mean * mean, rstd = rsqrtf(var + EPS);
#pragma unroll
        for (int j = 0; j < 8; ++j) vn[tt][j] = (f[j] - mean) * rstd * gl[j] + bl[j];
        float* o = oCV + ((size_t)bd * 4 + tt) * 512 + c0;
        *(f32x4*)o = (f32x4){vn[tt][0], vn[tt][1], vn[tt][2], vn[tt][3]}; *(f32x4*)(o + 4) = (f32x4){vn[tt][4], vn[tt][5], vn[tt][6], vn[tt][7]}; }
#pragma unroll
    for (int tt = 0; tt < 4; ++tt) { const size_t row = (size_t)MP + 4 * bd + tt;
        float mx[8]; const float bias = F.sgu_b[l * 512 + hd * 128 + tt];
#pragma unroll
        for (int j = 0; j < 8; ++j) mx[j] = bias;
#pragma unroll
        for (int s2 = 0; s2 < 4; ++s2) if (s2 <= tt) { const float w = F.sgu_w[((size_t)(l * 4 + hd) * 128 + tt) * 128 + s2];
#pragma unroll
            for (int j = 0; j < 8; ++j) mx[j] += w * vn[s2][j]; }
        float uf[8], gf[8]; unpack8(*(const u32x4*)(F.Z2 + row * ZW + Z_U + c0), uf); unpack8(*(const u32x4*)(F.Z2 + row * ZW + Z_GS + c0), gf);
#pragma unroll
        for (int j = 0; j < 8; ++j) mx[j] = mx[j] * uf[j] * gf[j];
        *(u32x4*)(F.MIX + row * DM + 1536 + c0) = pack8(mx); }
}

#endif
struct NormRowIn { u32x4 yv[4]; f32x4 xv[4][2]; u32x4 xb[4]; };
__device__ __forceinline__ void norm_row_load(NormRowIn& in, const Frame& F, int l, int row) {
    const int lane = F.lane;
    const bf16_t* yr = F.Yb + (size_t)row * DM + 8 * lane;
#pragma unroll
    for (int j = 0; j < 4; ++j) in.yv[j] = __builtin_nontemporal_load((const u32x4*)(yr + 512 * j));
    if (l == 0) {
        const float* xr = (row < MP ? F.xp + (size_t)row * DM : F.xs + (size_t)(row - MP) * DM) + 8 * lane;
#pragma unroll
        for (int j = 0; j < 4; ++j) { in.xv[j][0] = __builtin_nontemporal_load((const f32x4*)(xr + 512 * j)); in.xv[j][1] = __builtin_nontemporal_load((const f32x4*)(xr + 512 * j + 4)); }
    } else {
        const bf16_t* xr = F.H + (size_t)row * DM + 8 * lane;
#pragma unroll
        for (int j = 0; j < 4; ++j) in.xb[j] = __builtin_nontemporal_load((const u32x4*)(xr + 512 * j));
    }
}
__device__ __forceinline__ void norm_row_finish(const NormRowIn& in, const Frame& F, int l, int row) {
    const int lane = F.lane;
    const float* pg = F.norm_post + l * DM + 8 * lane;
    float y[4][8]; float ss = 0.f;
#pragma unroll
    for (int j = 0; j < 4; ++j) { unpack8(in.yv[j], y[j]);
#pragma unroll
        for (int e = 0; e < 8; ++e) ss += y[j][e] * y[j][e]; }
    ss = wave_sum(ss);
    const float ry = rsqrtf(ss * (1.0f / 2048.0f) + EPS);
    if (l == 0) {
        float s1 = 0.f; bf16_t* hrow = F.H + (size_t)row * DM + 8 * lane;
#pragma unroll
        for (int j = 0; j < 4; ++j) { const f32x4 ga = *(const f32x4*)(pg + 512 * j), gb = *(const f32x4*)(pg + 512 * j + 4);
#pragma unroll
            for (int e = 0; e < 4; ++e) { y[j][e] = in.xv[j][0][e] + y[j][e] * ry * ga[e]; y[j][4 + e] = in.xv[j][1][e] + y[j][4 + e] * ry * gb[e]; }
#pragma unroll
            for (int e = 0; e < 8; ++e) s1 += y[j][e] * y[j][e];
            *(u32x4*)(hrow + 512 * j) = pack8(y[j]); }
        s1 = wave_sum(s1);
        if (lane == 0) F.RSTD[MT + row] = rsqrtf(s1 * (1.0f / 2048.0f) + EPS);
    } else {
        float* orow = F.out + (size_t)row * DM + 8 * lane;
#pragma unroll
        for (int j = 0; j < 4; ++j) { const f32x4 ga = *(const f32x4*)(pg + 512 * j), gb = *(const f32x4*)(pg + 512 * j + 4); float xf[8]; unpack8(in.xb[j], xf);
#pragma unroll
            for (int e = 0; e < 4; ++e) { y[j][e] = xf[e] + y[j][e] * ry * ga[e]; y[j][4 + e] = xf[4 + e] + y[j][4 + e] * ry * gb[e]; }
            __builtin_nontemporal_store((f32x4){y[j][0], y[j][1], y[j][2], y[j][3]}, (f32x4*)(orow + 512 * j)); __builtin_nontemporal_store((f32x4){y[j][4], y[j][5], y[j][6], y[j][7]}, (f32x4*)(orow + 512 * j + 4)); }
    }
}
__device__ __forceinline__ void norm_rows4(int l, int row0) { LOCAL_FRAME;
#pragma unroll 1
    for (int k = 0; k < 4; k += 2) { NormRowIn a, b; norm_row_load(a, F, l, row0 + k); norm_row_load(b, F, l, row0 + k + 1);
        norm_row_finish(a, F, l, row0 + k); norm_row_finish(b, F, l, row0 + k + 1); } }

constexpr int Q2_G = 40, Q2_AT = Q2_G + 256, Q2_SG = Q2_AT + 256, Q2_SA = Q2_SG + 64, Q2_SS = Q2_SA + 16, Q2_SP = Q2_SS + 8, Q2_PO = Q2_SP + 256;
__device__ __forceinline__ void slot2(int l, LAS unsigned char* L, LAS unsigned char* ring) {
    int t_ = threadIdx.x; asm volatile("" : "+v"(t_)); const int wave = __builtin_amdgcn_readfirstlane(t_ >> 6);
    unsigned* head = ctl_word(CW_Q + 64 * (2 * l));
    EV_T0();
#pragma unroll 1
    for (;;) {
        const int it = q_pop(head, L);
        if (it >= Q2_PO + (l == 0 ? TR_ITEMS : 0)) { if (l == 0) { EV_MAX(0); EV_MIN(1); } break; }
        if (it < Q2_G) {
            unsigned char* ws = (unsigned char*)kargs()->ws;
            pg8::Gemm g{(const bf16_t*)(ws + WS_H), (const bf16_t*)(ws + WS_WTIN) + (size_t)l * DIN * DM, MT, DIN, DM};
            OneUnit S; S.u.pm = 64 + it / 20; S.u.pn = it % 20;
            pg8::EpiIn E{l};
            pg8::gemm_phase<pg8::EpiIn, OneUnit, false, true>(ring, g, S, E);
            publish(ctl_word(CW_ZS + 64 * (2 * l + it / 20)));
            if (l == 0) { EV_MAX(2); EV_MIN(3); }
        }
#ifndef NO_SGU
        else if (it < Q2_AT) { const int u = it - Q2_G; sgu_unit(l, u >> 1, u & 1, ring); if (l == 0) EV_MAX(5); }
#endif
        else if (it < Q2_SG) { attn_unit(l, it - Q2_AT, ring); if (l == 0) EV_MAX(4); }
        else if (it < Q2_SA) { const int i = it - Q2_SG; dep_wait(ctl_word(CW_ZS + 64 * (2 * l + (i >> 5))), 20u); if (l == 0) EV_MIN(6); const int k = 8 * i + wave; samp_attn(l, k >> 2, k & 3, ring + wave * 9472); __syncthreads(); if (l == 0) EV_MAX(7); }
        else if (it < Q2_SS) { const int i = it - Q2_SA; dep_wait(ctl_word(CW_ZS + 64 * (2 * l + (i >> 3))), 20u); samp_sgu(l, 8 * i + wave); }
        else if (it < Q2_SP) { const int i = it - Q2_SS; dep_wait(ctl_word(CW_ZS + 64 * (2 * l + (i >> 2))), 20u); const int k = 8 * i + wave; pool_sample(l, k & 3, k >> 2); }
        else if (it < Q2_PO) { const int i = 8 * (it - Q2_SP) + wave; pool_prompt(l, i & 3, i >> 2, ring + wave * PL_WBYTES); }
        else { LOCAL_FRAME; transpose_item(F, 1, it - Q2_PO, ring); }
    }
}
constexpr int Q4_G = 16, Q4_P = Q4_G + 512, Q4_S = Q4_P + 16;
__device__ __forceinline__ void slot4(int l, LAS unsigned char* L, LAS unsigned char* ring) {
    int t_ = threadIdx.x; asm volatile("" : "+v"(t_)); const int wave = __builtin_amdgcn_readfirstlane(t_ >> 6);
    unsigned* head = ctl_word(CW_Q + 64 * (2 * l + 1));
#pragma unroll 1
    for (;;) {
        const int it = q_pop(head, L);
        if (it >= Q4_S) break;
        if (it < Q4_G) {
            unsigned char* ws = (unsigned char*)kargs()->ws;
            pg8::Gemm g{(const bf16_t*)(ws + WS_MIX), (const bf16_t*)(ws + WS_WTOUT) + (size_t)l * DM * DM, MT, DM, DM};
            OneUnit S; S.u.pm = 64 + it / 8; S.u.pn = it % 8;
            pg8::EpiOut E{};
            pg8::gemm_phase<pg8::EpiOut, OneUnit, false, true>(ring, g, S, E);
            publish(ctl_word(CW_YS + 64 * (2 * l + it / 8)));
        }
        else if (it < Q4_P) norm_rows4(l, 32 * (it - Q4_G) + 4 * wave);
        else { const int i = it - Q4_P; dep_wait(ctl_word(CW_YS + 64 * (2 * l + (i >> 3))), 8u); norm_rows4(l, MP + 32 * i + 4 * wave); }
    }
}

__global__ void __launch_bounds__(NTHREADS, 2) hymba_fwd(Args a_unused) {
    extern __shared__ __attribute__((aligned(16))) unsigned char lds[];
    LAS unsigned char* L = (LAS unsigned char*)lds;
    if (threadIdx.x < 256) ((LAS unsigned*)L)[threadIdx.x] = 0u;
    __syncthreads();
    XcdBarrier bar = xcd_barrier_post((unsigned*)((unsigned char*)kargs()->ws + WS_CTL) + CW_BAR, (volatile LAS unsigned*)L + 8);
    LAS unsigned char* ring = L + RING_OFF;
    STAMP(0);
#ifndef NO_P0
    { Frame F; make_frame(F, kargs()); p0_prologue(F, ring); }
#endif
    xcd_barrier(bar);
    STAMP(1);
#pragma unroll 1
    for (int l = 0; l < 2; ++l) {
#ifndef NO_P1
        {
            KArgs ka = kargs(); unsigned char* ws = (unsigned char*)ka->ws;
            pg8::Gemm g{(const bf16_t*)(ws + WS_H), (const bf16_t*)(ws + WS_WTIN) + (size_t)l * DIN * DM, MP, DIN, DM}; pg8::StaticOrder S; S.init(MP, DIN, (int)gridDim.x, (int)blockIdx.x);
            pg8::EpiIn E{l};
            pg8::gemm_phase<pg8::EpiIn, pg8::StaticOrder, true, true>(ring, g, S, E);
        }
#endif
        xcd_barrier(bar);
        STAMP(2 + 4 * l);
#ifndef NO_P2
        slot2(l, L, ring);
#endif
        xcd_barrier(bar);
        STAMP(3 + 4 * l);
#ifndef NO_P3
        {
            KArgs ka = kargs(); unsigned char* ws = (unsigned char*)ka->ws;
            pg8::Gemm g{(const bf16_t*)(ws + WS_MIX), (const bf16_t*)(ws + WS_WTOUT) + (size_t)l * DM * DM, MP, DM, DM}; pg8::StaticOrder S; S.init(MP, DM, (int)gridDim.x, (int)blockIdx.x);
            pg8::EpiOut E{};
            pg8::gemm_phase<pg8::EpiOut, pg8::StaticOrder, true, true>(ring, g, S, E);
        }
#endif
        xcd_barrier(bar);
        STAMP(4 + 4 * l);
#ifndef NO_P4
        slot4(l, L, ring);
#endif
        if (l == 0) xcd_barrier(bar);
#if PROBE_SEL
        if (l == 1) __syncthreads();
#endif
        STAMP(5 + 4 * l);
    }
#if PROBE_SEL
    if (blockIdx.x == 0 && threadIdx.x == 0) {
#if PROBE_SEL >= 10
        unsigned ea = __hip_atomic_load(ctl_word(CW_EV + 64 * PEA), __ATOMIC_RELAXED, __HIP_MEMORY_SCOPE_AGENT), eb = __hip_atomic_load(ctl_word(CW_EV + 64 * PEB), __ATOMIC_RELAXED, __HIP_MEMORY_SCOPE_AGENT);
        if (PEA_MIN) ea = 0x40000000u - ea; if (PEB_MIN) eb = 0x40000000u - eb;
        unsigned long long da = (ea + 400) / 800, db = (eb + 400) / 800;
#else
        LAS unsigned long long* ts = (LAS unsigned long long*)(L + 256);
        unsigned long long da = (ts[PA1] - ts[PA0] + 400) / 800, db = (ts[PB1] - ts[PB0] + 400) / 800;
#endif
        if (da > 63) da = 63; if (db > 63) db = 63;
        const unsigned long long extra = (da + 64 * db) * 1600ull, t0 = __builtin_amdgcn_s_memrealtime();
        while (__builtin_amdgcn_s_memrealtime() - t0 < extra) __builtin_amdgcn_s_sleep(32);
    }
#endif
}

extern "C" void kernel_launch(void* const* d_in, const int* in_sizes, int n_in, void* d_out, int out_size, void* d_ws, size_t ws_size, hipStream_t stream) {
    static int grid = 0;
    if (grid == 0) {
        if (n_in != 16 || (size_t)out_size != O_END || ws_size < WS_END) { fprintf(stderr, "kernel_launch: unexpected shapes: n_in %d out %d ws %zu (need %zu)\n", n_in, out_size, ws_size, (size_t)WS_END); grid = -1; return; }
        int dev = 0, cus = 0, per_cu = 0;
        if (hipGetDevice(&dev) != hipSuccess || hipDeviceGetAttribute(&cus, hipDeviceAttributeMultiprocessorCount, dev) != hipSuccess) { fprintf(stderr, "kernel_launch: device query failed\n"); grid = -1; return; }
        if (hipFuncSetAttribute((const void*)hymba_fwd, hipFuncAttributeMaxDynamicSharedMemorySize, LDS_BYTES) != hipSuccess) { fprintf(stderr, "kernel_launch: hipFuncSetAttribute failed\n"); grid = -1; return; }
        if (hipOccupancyMaxActiveBlocksPerMultiprocessor(&per_cu, (const void*)hymba_fwd, NTHREADS, LDS_BYTES) != hipSuccess || per_cu < 1) { fprintf(stderr, "kernel_launch: occupancy query says %d blocks/CU\n", per_cu); (void)hipGetLastError(); grid = -1; return; }
        grid = cus;
    }
    if (grid < 0) return;
    (void)hipMemsetAsync((char*)d_ws + WS_CTL, 0, CTL_ZERO_BYTES, stream);
    Args a{};
    for (int i = 0; i < 16; ++i) a.in[i] = (const float*)d_in[i];
    a.out = (float*)d_out; a.ws = (unsigned char*)d_ws;
    void* params[] = {&a};
    hipError_t e = hipLaunchCooperativeKernel((const void*)hymba_fwd, dim3(grid), dim3(NTHREADS), params, LDS_BYTES, stream);
    if (e != hipSuccess) fprintf(stderr, "kernel_launch: cooperative launch failed: %s (grid %d)\n", hipGetErrorString(e), grid);
}
```

```cpp
#include <hip/hip_runtime.h>
#include <cstdio>
#include <cstdint>
#include <cmath>
namespace pg8 {
#define PG8_LAS __attribute__((address_space(3)))
typedef unsigned short bf16_t;
typedef short bf16x8 __attribute__((ext_vector_type(8)));
typedef float f32x4 __attribute__((ext_vector_type(4)));
typedef unsigned u32x4 __attribute__((ext_vector_type(4)));
constexpr int BM = 256, BK = 64, HALF = 128, HTB = HALF * BK * 2  , STAGE_BYTES = 8 * HTB, NXCD = 8, WGM = 8;

__host__ __device__ __forceinline__ int lds_byte(int r, int c) { const int st = (r >> 4) * 2 + (c >> 5), rr = r & 15, cc = c & 31, ob = rr * 64 + cc * 2; return st * 1024 + (ob ^ (((ob >> 9) & 1) << 5)); }
__host__ __device__ __forceinline__ void stage_rc(int b, int& R, int& C) { const int st = b / 1024, sb = b % 1024, swz = sb ^ (((sb >> 9) & 1) << 5); R = (st >> 1) * 16 + swz / 64; C = (st & 1) * 32 + (swz % 64) / 2; }
__host__ __device__ __forceinline__ int perm32(int rho) { const int n = rho >> 4, i = rho & 15; return 8 * (i >> 2) + 4 * n + (i & 3); }

struct Unit { int pm, pn; };
struct Gemm { const bf16_t* A; const bf16_t* Bt; int M, N, K; };

struct StaticOrder {
    int nM, nN, nwg, G, c;
    __host__ __device__ void init(int M, int N, int G_, int c_) { nM = M / BM; nN = N / BM; nwg = nM * nN; G = G_; c = c_; }
    __host__ __device__ bool next(int i, Unit& u) const {
        const long L = (long)i * G + c; if (L >= nwg) return false;
        int wgid = (int)L; { const int q = nwg / NXCD, r = nwg % NXCD, xcd = wgid % NXCD, off = wgid / NXCD; wgid = (xcd < r ? xcd * (q + 1) : r * (q + 1) + (xcd - r) * q) + off; }
        const int nig = WGM * nN, gid = wgid / nig, fm = gid * WGM, gsz = (nM - fm) < WGM ? (nM - fm) : WGM;
        u.pm = fm + ((wgid % nig) % gsz); u.pn = (wgid % nig) / gsz; return true;
    }
    __device__ __forceinline__ void a_ready(const Unit&) const {}
    __device__ __forceinline__ void done(const Unit&) const {}
};

constexpr int DM = 2048, MP = 16384, MS = 512, MT = MP + MS, DIN = 5120;
constexpr int ZW = 3584;
constexpr int Z_GA = 0, Z_XB = 1024, Z_GP = 1536, Z_U = 2048, Z_VS = 2560, Z_GS = 3072;
constexpr float LOG2E = 1.4426950408889634f, QSCALE = 0.125f * LOG2E, EPS = 1e-6f;

__device__ __forceinline__ unsigned cvt_pk_bf16(float lo, float hi) { unsigned r; asm("v_cvt_pk_bf16_f32 %0, %1, %2" : "=v"(r) : "v"(lo), "v"(hi)); return r; }
__device__ __forceinline__ float silu_f(float x) { return x * __builtin_amdgcn_rcpf(1.0f + __builtin_amdgcn_exp2f(-x * LOG2E)); }
__device__ __forceinline__ int vperm32(int x) { return ((x >> 2) & 1) * 16 + (x >> 3) * 4 + (x & 3); }

struct EpiPtrs { const __attribute__((address_space(1))) float* in[16]; __attribute__((address_space(1))) float* out; __attribute__((address_space(1))) unsigned char* ws; };
constexpr size_t EP_RSTD = (size_t)3 << 20, EP_ROPE = (size_t)1 << 20, EP_QC = (size_t)192 << 20, EP_KC = (size_t)225 << 20, EP_VTP = (size_t)233 << 20, EP_Z2 = (size_t)241 << 20, EP_Y = (size_t)357 << 20;
constexpr size_t EO_KP = 34603008, EO_VP = 35127296, EO_PP = 35651584, EO_KS = 35774464, EO_VS = 44163072, EO_PS = 52551680;
struct EpiIn {
    static constexpr bool PERM = true, AFTER_DRAIN = false;
    int l;
    __device__ __forceinline__ void operator()(const f32x4 (&acc)[2][2][4][2], const Unit& u, int wr, int wc, int fr, int fq) const {
        const __attribute__((address_space(4))) EpiPtrs* kp = (const __attribute__((address_space(4))) EpiPtrs*)__builtin_amdgcn_kernarg_segment_ptr(); asm volatile("" : "+s"(kp));
        unsigned char* ws = (unsigned char*)kp->ws; float* outp = (float*)kp->out;
        bf16_t* Qc = (bf16_t*)(ws + EP_QC); bf16_t* Kc = (bf16_t*)(ws + EP_KC); bf16_t* VTP = (bf16_t*)(ws + EP_VTP); bf16_t* Z2 = (bf16_t*)(ws + EP_Z2); const float* rope = (const float*)(ws + EP_ROPE);
        float* oKp = outp + EO_KP + (size_t)l * 262144; float* oVp = outp + EO_VP + (size_t)l * 262144; float* oPp = outp + EO_PP + (size_t)l * 61440;
        float* oKs = outp + EO_KS + (size_t)l * 4194304; float* oVs = outp + EO_VS + (size_t)l * 4194304; float* oPs = outp + EO_PS + (size_t)l * 983040;
        const int pn = u.pn;
        const int row0 = u.pm * 256 + wr * 64 + fr;
        const int cw = wc * 32 + 8 * fq;
        const float* rstd = (const float*)(ws + EP_RSTD) + (size_t)l * MT;
        if (pn < 5) {
#pragma unroll
            for (int ai = 0; ai < 2; ++ai)
#pragma unroll
                for (int m = 0; m < 4; ++m) {
                    const int row = row0 + ai * 128 + m * 16;
                    const bool smp = row >= MP;
                    const int tpos = smp ? 2048 + (row & 3) : (row & 2047);
                    const float* rp = rope + tpos * 64; const float rs = rstd[row];
#pragma unroll
                    for (int bj = 0; bj < 2; ++bj) {
                        const int c = pn * 256 + bj * 128 + cw;
                        const int i0 = (c & 63) >> 1;
                        const f32x4 cs = *(const f32x4*)(rp + i0), sn = *(const f32x4*)(rp + 32 + i0);
                        const f32x4 v0 = acc[ai][bj][m][0] * rs, v1 = acc[ai][bj][m][1] * rs;
                        f32x4 o1, o2;
                        o1[0] = v0[0] * cs[0] - v0[1] * sn[0]; o2[0] = v0[1] * cs[0] + v0[0] * sn[0];
                        o1[1] = v0[2] * cs[1] - v0[3] * sn[1]; o2[1] = v0[3] * cs[1] + v0[2] * sn[1];
                        o1[2] = v1[0] * cs[2] - v1[1] * sn[2]; o2[2] = v1[1] * cs[2] + v1[0] * sn[2];
                        o1[3] = v1[2] * cs[3] - v1[3] * sn[3]; o2[3] = v1[3] * cs[3] + v1[2] * sn[3];
                        if (pn < 4) {
                            o1 = o1 * QSCALE; o2 = o2 * QSCALE;
                            u32x4 w; w.x = cvt_pk_bf16(o1[0], o2[0]); w.y = cvt_pk_bf16(o1[1], o2[1]); w.z = cvt_pk_bf16(o1[2], o2[2]); w.w = cvt_pk_bf16(o1[3], o2[3]);
                            *(u32x4*)(Qc + (size_t)row * 1024 + c) = w;
                        } else {
                            const int kvh = (c - 1024) >> 6;
                            if (!smp) {
                                const int b = row >> 11, t = row & 2047;
                                u32x4 w; w.x = cvt_pk_bf16(o1[0], o2[0]); w.y = cvt_pk_bf16(o1[1], o2[1]); w.z = cvt_pk_bf16(o1[2], o2[2]); w.w = cvt_pk_bf16(o1[3], o2[3]);
                                *(u32x4*)(Kc + ((size_t)((b * 4 + kvh) * 2048 + t)) * 64 + (c & 63)) = w;
                                if (t >= 1920) { float* o = oKp + ((size_t)((b * 128 + t - 1920) * 4 + kvh)) * 64 + i0; *(f32x4*)o = o1; *(f32x4*)(o + 32) = o2; }
                            } else {
                                const int bd = (row - MP) >> 2, tt = row & 3;
                                float* o = oKs + ((size_t)((bd * 128 + 124 + tt) * 4 + kvh)) * 64 + i0; *(f32x4*)o = o1; *(f32x4*)(o + 32) = o2;
                            }
                        }
                    }
                }
        } else if (pn == 5) {
#pragma unroll
            for (int ai = 0; ai < 2; ++ai)
#pragma unroll
                for (int m = 0; m < 4; ++m) {
                    const int row = row0 + ai * 128 + m * 16;
                    const bool smp = row >= MP; const float rs = rstd[row];
#pragma unroll
                    for (int bj = 0; bj < 2; ++bj) {
                        const int cv = bj * 128 + cw;
                        const int kvh = cv >> 6, d0 = cv & 63;
                        const f32x4 v0 = acc[ai][bj][m][0] * rs, v1 = acc[ai][bj][m][1] * rs;
                        if (!smp) {
                            const int b = row >> 11, t = row & 2047;
                            bf16_t* vp = VTP + ((size_t)((b * 4 + kvh) * 64 + (t >> 5))) * 2048 + d0 * 32 + vperm32(t & 31);
                            const unsigned w0 = cvt_pk_bf16(v0[0], v0[1]), w1 = cvt_pk_bf16(v0[2], v0[3]), w2 = cvt_pk_bf16(v1[0], v1[1]), w3 = cvt_pk_bf16(v1[2], v1[3]);
                            vp[0] = (bf16_t)(w0 & 0xffffu); vp[32] = (bf16_t)(w0 >> 16); vp[64] = (bf16_t)(w1 & 0xffffu); vp[96] = (bf16_t)(w1 >> 16);
                            vp[128] = (bf16_t)(w2 & 0xffffu); vp[160] = (bf16_t)(w2 >> 16); vp[192] = (bf16_t)(w3 & 0xffffu); vp[224] = (bf16_t)(w3 >> 16);
                            if (t >= 1920) { float* o = oVp + ((size_t)((b * 128 + t - 1920) * 4 + kvh)) * 64 + d0; *(f32x4*)o = v0; *(f32x4*)(o + 4) = v1; }
                        } else {
                            const int bd = (row - MP) >> 2, tt = row & 3;
                            float* o = oVs + ((size_t)((bd * 128 + 124 + tt) * 4 + kvh)) * 64 + d0; *(f32x4*)o = v0; *(f32x4*)(o + 4) = v1;
                        }
                    }
                }
        } else {
            const bool gate = (pn < 10) || (pn == 12) || (pn == 13) || (pn >= 18);
            const bool isxb = (pn == 10) || (pn == 11);
#pragma unroll
            for (int ai = 0; ai < 2; ++ai)
#pragma unroll
                for (int m = 0; m < 4; ++m) {
                    const int row = row0 + ai * 128 + m * 16;
                    const bool smp = row >= MP; const float rs = rstd[row];
#pragma unroll
                    for (int bj = 0; bj < 2; ++bj) {
                        const int c = pn * 256 + bj * 128 + cw;
                        f32x4 v0 = acc[ai][bj][m][0] * rs, v1 = acc[ai][bj][m][1] * rs;
                        if (isxb) {
                            const int cx = c - 2560;
                            if (!smp) { const int t = row & 2047; if (t >= 2033) { const int b = row >> 11; float* o = oPp + ((size_t)(b * 15 + t - 2033)) * 512 + cx; *(f32x4*)o = v0; *(f32x4*)(o + 4) = v1; } }
                            else { const int bd = (row - MP) >> 2, tt = row & 3; float* o = oPs + ((size_t)(bd * 15 + 11 + tt)) * 512 + cx; *(f32x4*)o = v0; *(f32x4*)(o + 4) = v1; }
                        }
                        if (gate) {
#pragma unroll
                            for (int j = 0; j < 4; ++j) { v0[j] = silu_f(v0[j]); v1[j] = silu_f(v1[j]); }
                        }
                        u32x4 w; w.x = cvt_pk_bf16(v0[0], v0[1]); w.y = cvt_pk_bf16(v0[2], v0[3]); w.z = cvt_pk_bf16(v1[0], v1[1]); w.w = cvt_pk_bf16(v1[2], v1[3]);
                        *(u32x4*)(Z2 + (size_t)row * ZW + (c - 1536)) = w;
                    }
                }
        }
    }
};

struct EpiOut {
    static constexpr bool PERM = true, AFTER_DRAIN = false;
    __device__ __forceinline__ void operator()(const f32x4 (&acc)[2][2][4][2], const Unit& u, int wr, int wc, int fr, int fq) const {
        const __attribute__((address_space(4))) EpiPtrs* kp = (const __attribute__((address_space(4))) EpiPtrs*)__builtin_amdgcn_kernarg_segment_ptr(); asm volatile("" : "+s"(kp));
        bf16_t* C = (bf16_t*)((unsigned char*)kp->ws + EP_Y);
        const int row0 = u.pm * BM + wr * 64 + fr, col0 = u.pn * BM + wc * 32 + 8 * fq;
#pragma unroll
        for (int ai = 0; ai < 2; ++ai)
#pragma unroll
            for (int m = 0; m < 4; ++m) { bf16_t* rowp = C + (size_t)(row0 + ai * HALF + m * 16) * DM + col0;
#pragma unroll
                for (int bj = 0; bj < 2; ++bj) { const f32x4 v0 = acc[ai][bj][m][0], v1 = acc[ai][bj][m][1];
                    u32x4 w; w.x = cvt_pk_bf16(v0[0], v0[1]); w.y = cvt_pk_bf16(v0[2], v0[3]); w.z = cvt_pk_bf16(v1[0], v1[1]); w.w = cvt_pk_bf16(v1[2], v1[3]);
                    *(u32x4*)(rowp + bj * HALF) = w; } }
    }
};
template <class Epi, class Sched, bool ALIGN_EPI = false, bool SP2 = false>
__device__ __forceinline__ void gemm_phase(PG8_LAS unsigned char* lds, const Gemm g, const Sched& S, const Epi& E) {
    int tid_ = threadIdx.x; asm volatile("" : "+v"(tid_));
    const int tid = tid_, wid = __builtin_amdgcn_readfirstlane(tid >> 6), lane = tid & 63, wr = wid >> 2, wc = wid & 3, fr = lane & 15, fq = lane >> 4;
    const int K = g.K, nt = K / BK;
    unsigned voffA[2], voffB[2];
#pragma unroll
    for (int i = 0; i < 2; ++i) { int R, C; stage_rc(tid * 16 + i * 8192, R, C); const int Rb = Epi::PERM ? ((R & ~31) + perm32(R & 31)) : R;
        voffA[i] = (unsigned)(R * K + C) * 2u; voffB[i] = (unsigned)(Rb * K + C) * 2u; }
    const size_t kstep = (size_t)(BK * 2);
    const size_t hstep = (size_t)HALF * K * 2;
    const size_t tstep = 2 * hstep;
    const unsigned ldsw = (unsigned)wid * 1024u;
    const int aoff = lds_byte(wr * 64 + fr, fq * 8), boff = lds_byte(wc * 32 + fr, fq * 8);
#define PG8_SA(b, h) (((b) * 2 + (h)) * HTB)
#define PG8_SB(b, h) ((4 + (b) * 2 + (h)) * HTB)
#define PG8_STAGE(bufoff, gbase, voff) do { _Pragma("unroll") for (int _i = 0; _i < 2; ++_i) \
        __builtin_amdgcn_global_load_lds((const unsigned*)((const char*)(gbase) + (voff)[_i]), (PG8_LAS unsigned*)(lds + (bufoff) + ldsw + _i * 8192), 16, 0, 0); } while (0)
#define PG8_LDA(dst, b, h) do { _Pragma("unroll") for (int m = 0; m < 4; ++m) _Pragma("unroll") for (int k = 0; k < 2; ++k) dst[m][k] = *(const PG8_LAS bf16x8*)(lds + PG8_SA(b, h) + aoff + m * 2048 + k * 1024); } while (0)
#define PG8_LDB(dst, b, h) do { _Pragma("unroll") for (int n = 0; n < 2; ++n) _Pragma("unroll") for (int k = 0; k < 2; ++k) dst[n][k] = *(const PG8_LAS bf16x8*)(lds + PG8_SB(b, h) + boff + n * 2048 + k * 1024); } while (0)
#define PG8_MMA(ai, bj, At, Bt) do { __builtin_amdgcn_s_setprio(1); _Pragma("unroll") for (int m = 0; m < 4; ++m) _Pragma("unroll") for (int n = 0; n < 2; ++n) _Pragma("unroll") for (int k = 0; k < 2; ++k) \
        acc[ai][bj][m][n] = __builtin_amdgcn_mfma_f32_16x16x32_bf16(Bt[n][k], At[m][k], acc[ai][bj][m][n], 0, 0, 0); __builtin_amdgcn_s_setprio(0); } while (0)
#define PG8_WAIT_V(n) asm volatile("s_waitcnt vmcnt(" #n ")" ::: "memory")
#define PG8_WAIT_L(n) asm volatile("s_waitcnt lgkmcnt(" #n ")" ::: "memory")
#define PG8_BAR __builtin_amdgcn_s_barrier()
#define PG8_SCHED __builtin_amdgcn_sched_barrier(0)
    Unit cur, nxt; int ui = 0;
    if (!S.next(0, cur)) return;
    f32x4 acc[2][2][4][2];
#pragma unroll
    for (int a = 0; a < 2; ++a)
#pragma unroll
        for (int b = 0; b < 2; ++b)
#pragma unroll
            for (int m = 0; m < 4; ++m)
#pragma unroll
                for (int n = 0; n < 2; ++n) acc[a][b][m][n] = (f32x4){0.f, 0.f, 0.f, 0.f};
    bf16x8 At[4][2], B0[2][2], B1[2][2];
    const char* cA = (const char*)g.A + (size_t)cur.pm * tstep; const char* cB = (const char*)g.Bt + (size_t)cur.pn * tstep;
    S.a_ready(cur);
    if constexpr (SP2) {
        PG8_STAGE(PG8_SB(0, 0), cB, voffB); PG8_STAGE(PG8_SB(0, 1), cB + hstep, voffB); PG8_STAGE(PG8_SA(0, 0), cA, voffA); PG8_STAGE(PG8_SA(0, 1), cA + hstep, voffA);
        if (wr == 1) PG8_BAR;
        PG8_WAIT_V(2); PG8_BAR;
        PG8_STAGE(PG8_SB(1, 0), cB + kstep, voffB); PG8_STAGE(PG8_SA(1, 0), cA + kstep, voffA); PG8_STAGE(PG8_SB(1, 1), cB + hstep + kstep, voffB);
        PG8_WAIT_V(6); PG8_BAR;
    } else {
        PG8_STAGE(PG8_SB(0, 0), cB, voffB); PG8_STAGE(PG8_SA(0, 0), cA, voffA); PG8_STAGE(PG8_SB(0, 1), cB + hstep, voffB); PG8_STAGE(PG8_SA(0, 1), cA + hstep, voffA);
        if (wr == 1) PG8_BAR;
        PG8_WAIT_V(4); PG8_BAR;
        PG8_STAGE(PG8_SB(1, 0), cB + kstep, voffB); PG8_STAGE(PG8_SA(1, 0), cA + kstep, voffA); PG8_STAGE(PG8_SB(1, 1), cB + hstep + kstep, voffB);
        PG8_WAIT_V(6); PG8_BAR;
    }
    for (;;) {
        const bool has_next = S.next(ui + 1, nxt);
        const char* nA = has_next ? (const char*)g.A + (size_t)nxt.pm * tstep : cA; const char* nB = has_next ? (const char*)g.Bt + (size_t)nxt.pn * tstep : cB;
        for (int t = 0; t < nt; t += 2) {
            const bool last = (t == nt - 2);
            const char* a1 = cA + (size_t)(t + 1) * kstep;
            const char* a2 = last ? nA : cA + (size_t)(t + 2) * kstep; const char* b2 = last ? nB : cB + (size_t)(t + 2) * kstep;
            const char* a3 = a2 + kstep; const char* b3 = b2 + kstep;
            if (last && has_next) S.a_ready(nxt);
            if constexpr (SP2) {
            PG8_LDB(B0, 0, 0); PG8_LDB(B1, 0, 1); PG8_SCHED; PG8_LDA(At, 0, 0); PG8_STAGE(PG8_SA(1, 1), a1 + hstep, voffA);
            PG8_WAIT_V(8); PG8_WAIT_L(0); PG8_BAR; PG8_MMA(0, 0, At, B0); PG8_MMA(0, 1, At, B1); PG8_BAR; PG8_SCHED;
            PG8_LDA(At, 0, 1); PG8_STAGE(PG8_SB(0, 0), b2, voffB); PG8_STAGE(PG8_SB(0, 1), b2 + hstep, voffB); PG8_STAGE(PG8_SA(0, 0), a2, voffA);
            PG8_WAIT_V(8); PG8_WAIT_L(0); PG8_BAR; PG8_MMA(1, 0, At, B0); PG8_MMA(1, 1, At, B1); PG8_BAR; PG8_SCHED;
            PG8_LDB(B0, 1, 0); PG8_LDB(B1, 1, 1); PG8_SCHED; PG8_LDA(At, 1, 0); PG8_STAGE(PG8_SA(0, 1), a2 + hstep, voffA);
            PG8_WAIT_V(8); PG8_WAIT_L(0); PG8_BAR; PG8_MMA(0, 0, At, B0); PG8_MMA(0, 1, At, B1); PG8_BAR; PG8_SCHED;
            PG8_LDA(At, 1, 1); PG8_STAGE(PG8_SB(1, 0), b3, voffB); PG8_STAGE(PG8_SB(1, 1), b3 + hstep, voffB); PG8_STAGE(PG8_SA(1, 0), a3, voffA);
            PG8_WAIT_V(8); PG8_WAIT_L(0); PG8_BAR; PG8_MMA(1, 0, At, B0); PG8_MMA(1, 1, At, B1); PG8_BAR; PG8_SCHED;
            } else {
            PG8_LDB(B0, 0, 0); PG8_SCHED; PG8_LDA(At, 0, 0); PG8_STAGE(PG8_SA(1, 1), a1 + hstep, voffA);
            PG8_WAIT_L(8); PG8_BAR; PG8_WAIT_L(0); PG8_MMA(0, 0, At, B0); PG8_BAR; PG8_SCHED;
            PG8_LDB(B1, 0, 1); PG8_STAGE(PG8_SB(0, 0), b2, voffB);
            PG8_BAR; PG8_WAIT_L(0); PG8_MMA(0, 1, At, B1); PG8_BAR;
            PG8_LDA(At, 0, 1); PG8_STAGE(PG8_SA(0, 0), a2, voffA);
            PG8_BAR; PG8_WAIT_L(0); PG8_MMA(1, 0, At, B0); PG8_BAR; PG8_SCHED;
            PG8_STAGE(PG8_SB(0, 1), b2 + hstep, voffB);
            PG8_WAIT_V(6); PG8_BAR; PG8_MMA(1, 1, At, B1); PG8_BAR;
            PG8_LDB(B0, 1, 0); PG8_SCHED; PG8_LDA(At, 1, 0); PG8_STAGE(PG8_SA(0, 1), a2 + hstep, voffA);
            PG8_WAIT_L(8); PG8_BAR; PG8_WAIT_L(0); PG8_MMA(0, 0, At, B0); PG8_BAR; PG8_SCHED;
            PG8_LDB(B1, 1, 1); PG8_STAGE(PG8_SB(1, 0), b3, voffB);
            PG8_BAR; PG8_WAIT_L(0); PG8_MMA(0, 1, At, B1); PG8_BAR;
            PG8_LDA(At, 1, 1); PG8_STAGE(PG8_SA(1, 0), a3, voffA);
            PG8_BAR; PG8_WAIT_L(0); PG8_MMA(1, 0, At, B0); PG8_BAR; PG8_SCHED;
            PG8_STAGE(PG8_SB(1, 1), b3 + hstep, voffB);
            PG8_WAIT_V(6); PG8_BAR; PG8_MMA(1, 1, At, B1); PG8_BAR;
            }
        }
        if constexpr (ALIGN_EPI) { if (wr == 0) PG8_BAR; }
        if constexpr (!Epi::AFTER_DRAIN) { E(acc, cur, wr, wc, fr, fq); S.done(cur); }
        if (!has_next) break;
#pragma unroll
        for (int a = 0; a < 2; ++a)
#pragma unroll
            for (int b = 0; b < 2; ++b)
#pragma unroll
                for (int m = 0; m < 4; ++m)
#pragma unroll
                    for (int n = 0; n < 2; ++n) acc[a][b][m][n] = (f32x4){0.f, 0.f, 0.f, 0.f};
        cur = nxt; cA = nA; cB = nB; ++ui;
        if constexpr (ALIGN_EPI) { if (wr == 1) PG8_BAR; }
    }
    PG8_WAIT_V(0);
    if constexpr (!ALIGN_EPI) { if (wr == 0) PG8_BAR; }
    PG8_BAR;
    if constexpr (Epi::AFTER_DRAIN) { E.fused(acc, cur, wr, wc, fr, fq, lds, wid, lane); S.done(cur); }
#undef PG8_SA
#undef PG8_SB
#undef PG8_STAGE
#undef PG8_LDA
#undef PG8_LDB
#undef PG8_MMA
#undef PG8_WAIT_V
#undef PG8_WAIT_L
#undef PG8_BAR
#undef PG8_SCHED
}
}
#define GAS __attribute__((address_space(1)))
#define LAS __attribute__((address_space(3)))
typedef GAS unsigned gu32;
typedef GAS unsigned long long gu64;
#define RLX_AGENT __ATOMIC_RELAXED, __HIP_MEMORY_SCOPE_AGENT
#define VM_WAIT() asm volatile("s_waitcnt vmcnt(0)" ::: "memory")
__device__ __forceinline__ unsigned long long rt() { return __builtin_amdgcn_s_memrealtime(); }
__device__ __forceinline__ unsigned f2bf(float f) { unsigned u = __builtin_bit_cast(unsigned, f); return (u + 0x7fffu + ((u >> 16) & 1u)) >> 16; }
__device__ __forceinline__ unsigned pk2(float lo, float hi) { return f2bf(lo) | (f2bf(hi) << 16); }

#define XB_TMO      128
#define XB_XCNT(j)  (256  + 64 * (j))
#define XB_XSUB(j)  (1280 + 64 * (j))
#define XB_XGEN(j)  (2304 + 64 * (j))
#define XB_TOP      3328
#define XB_TOPGEN   3392
#define XCD_BAR_WORDS 3456
#define XB_SPIN_CAP (1u << 18)

__device__ __forceinline__ unsigned xb_ld(unsigned* p)              { return __hip_atomic_load(p, __ATOMIC_RELAXED, __HIP_MEMORY_SCOPE_AGENT); }
__device__ __forceinline__ unsigned xb_add(unsigned* p, unsigned v) { return __hip_atomic_fetch_add(p, v, __ATOMIC_RELAXED, __HIP_MEMORY_SCOPE_AGENT); }
__device__ __forceinline__ unsigned xb_xcc_id() { return (unsigned)__builtin_amdgcn_s_getreg((3 << 11) | 20) & 0xFu; }
#define XB_SPIN(cond, bar) do { unsigned _sp = 0; while (cond) { __builtin_amdgcn_s_sleep(1); \
    if ((++_sp & 255u) == 0u) { if (xb_ld(&(bar)[XB_TMO])) break; if (_sp > XB_SPIN_CAP) { atomicAdd(&(bar)[XB_TMO], 1u); break; } } } } while (0)

struct XcdBarrier {
    unsigned* bar; unsigned x;
    volatile LAS unsigned* st;
};

__device__ __forceinline__ XcdBarrier xcd_barrier_post(unsigned* bar, volatile LAS unsigned* st) {
    XcdBarrier b; b.bar = bar; b.x = xb_xcc_id(); b.st = st;
    if (threadIdx.x == 0) (void)xb_add(&bar[XB_XCNT(b.x)], 1u);
    return b;
}
__device__ __forceinline__ void xcd_barrier_complete(unsigned* bar, unsigned x, unsigned& nloc, unsigned& nx) {
    const unsigned G = gridDim.x * gridDim.y * gridDim.z;
    unsigned sum, cnt, mine, sp = 0u;
    for (;;) {
        sum = 0u; cnt = 0u; mine = 0u;
#pragma unroll
        for (unsigned j = 0; j < 16; ++j) { const unsigned c = xb_ld(&bar[XB_XCNT(j)]); sum += c; cnt += (c > 0u) ? 1u : 0u; mine = (j == x) ? c : mine; }
        if (sum == G) break;
        __builtin_amdgcn_s_sleep(1);
        if ((++sp & 255u) == 0u) { if (xb_ld(&bar[XB_TMO])) break; if (sp > XB_SPIN_CAP) { atomicAdd(&bar[XB_TMO], 1u); break; } }
    }
    nloc = mine > 0u ? mine : 1u; nx = cnt > 0u ? cnt : 1u;
}

__device__ __forceinline__ void xcd_barrier(const XcdBarrier& b) {
    asm volatile("s_waitcnt vmcnt(0)" ::: "memory");
    __syncthreads();
    if (threadIdx.x == 0) {
        unsigned* bar = b.bar;
        __builtin_amdgcn_s_waitcnt(0);
        unsigned nloc = b.st[0], nx = b.st[1];
        if (nloc == 0u) { xcd_barrier_complete(bar, b.x, nloc, nx); b.st[0] = nloc; b.st[1] = nx; }
        const unsigned old = xb_add(&bar[XB_XSUB(b.x)], 1u);
        const unsigned gen = old / nloc;
        if (old + 1u == (gen + 1u) * nloc) {
            __builtin_amdgcn_fence(__ATOMIC_RELEASE, "agent");
            asm volatile("s_waitcnt vmcnt(0)" ::: "memory");
            const unsigned og = xb_add(&bar[XB_TOP], 1u);
            const unsigned tg = og / nx;
            if (og + 1u == (tg + 1u) * nx) xb_add(&bar[XB_TOPGEN], 1u);
            else XB_SPIN(xb_ld(&bar[XB_TOPGEN]) == tg, bar);
            __builtin_amdgcn_fence(__ATOMIC_ACQUIRE, "agent");
            xb_add(&bar[XB_XGEN(b.x)], 1u);
            asm volatile("s_waitcnt vmcnt(0)" ::: "memory");
        } else {
            XB_SPIN(xb_ld(&bar[XB_XGEN(b.x)]) == gen, bar);
            __builtin_amdgcn_fence(__ATOMIC_ACQUIRE, "agent");
            asm volatile("s_waitcnt vmcnt(0)" ::: "memory");
        }
    }
    __syncthreads();
}

using pg8::bf16_t; using pg8::bf16x8; using pg8::f32x4; using pg8::u32x4;
using pg8::DM; using pg8::MP; using pg8::MS; using pg8::MT; using pg8::DIN; using pg8::ZW;
using pg8::Z_GA; using pg8::Z_XB; using pg8::Z_GP; using pg8::Z_U; using pg8::Z_VS; using pg8::Z_GS; using pg8::LOG2E; using pg8::EPS;
typedef float f32x16 __attribute__((ext_vector_type(16)));
typedef unsigned u32x2 __attribute__((ext_vector_type(2)));
typedef short v4i16_t __attribute__((ext_vector_type(4)));

constexpr int NWAVES = 8, NTHREADS = 512;
constexpr int LDS_BYTES = 147456;
constexpr int RING_OFF = 1024;

constexpr size_t O_YP = 0, O_YS = 33554432, O_KP = 34603008, O_VP = 35127296, O_PP = 35651584, O_KS = 35774464, O_VS = 44163072, O_PS = 52551680, O_CV = 54517760, O_END = 55042048;
constexpr size_t LS_KP = 262144, LS_PP = 61440, LS_KS = 4194304, LS_PS = 983040, LS_CV = 262144;
constexpr size_t MiB = 1u << 20;
constexpr size_t WS_CTL = 0, CTL_ZERO_BYTES = 65536;
constexpr size_t WS_ROPE = 1 * MiB, WS_SGUW = 2 * MiB, WS_RSW = 2 * MiB + 256 * 1024, WS_PWT = 2 * MiB + 512 * 1024, WS_RSTD = 3 * MiB;
constexpr size_t WS_WTIN = 4 * MiB, WS_WTOUT = 44 * MiB, WS_H = 60 * MiB, WS_MIX = 126 * MiB, WS_QC = 192 * MiB, WS_KC = 225 * MiB, WS_VTP = 233 * MiB, WS_Z2 = 241 * MiB, WS_Y = 357 * MiB, WS_END = 489 * MiB;
constexpr int CW_BAR = 1024;

__constant__ double ROPE_INV[32] = {1.0, 0.7498942093324559, 0.5623413251903491, 0.4216965034285822, 0.31622776601683794, 0.23713737056616552, 0.1778279410038923, 0.1333521432163324, 0.1, 0.07498942093324558, 0.05623413251903491, 0.042169650342858224, 0.03162277660168379, 0.023713737056616554, 0.01778279410038923, 0.01333521432163324, 0.01, 0.007498942093324558, 0.005623413251903491, 0.004216965034285823, 0.0031622776601683794, 0.0023713737056616554, 0.0017782794100389228, 0.001333521432163324, 0.001, 0.0007498942093324559, 0.0005623413251903491, 0.00042169650342858224, 0.00031622776601683794, 0.00023713737056616554, 0.00017782794100389227, 0.0001333521432163324};

struct Args { const float* in[16]; float* out; unsigned char* ws; };

struct Frame {
    int tid, lane, wave, bid, G;
    const float *xp, *xs, *cache_k, *cache_v, *state_pool, *w_in, *w_out, *norm_pre, *norm_post, *sinks, *pool_w, *pool_scale, *ln_g, *ln_b, *sgu_w, *sgu_b;
    float* out;
    float* rope; float* RSW; float* RSTD; bf16_t *SGUW, *PWT, *WTIN, *WTOUT, *H, *MIX, *Qc, *Kc, *VTP, *Z2, *Yb;
};

__device__ __forceinline__ float wave_sum(float v) {
#pragma unroll
    for (int o = 1; o < 64; o <<= 1) v += __shfl_xor(v, o);
    return v;
}
__device__ __forceinline__ float wave_max(float v) {
#pragma unroll
    for (int o = 1; o < 64; o <<= 1) v = fmaxf(v, __shfl_xor(v, o));
    return v;
}
__device__ __forceinline__ float bflo(unsigned w) { return __uint_as_float(w << 16); }
__device__ __forceinline__ float bfhi(unsigned w) { return __uint_as_float(w & 0xffff0000u); }
__device__ __forceinline__ void unpack8(const u32x4 w, float (&f)[8]) { f[0] = bflo(w.x); f[1] = bfhi(w.x); f[2] = bflo(w.y); f[3] = bfhi(w.y); f[4] = bflo(w.z); f[5] = bfhi(w.z); f[6] = bflo(w.w); f[7] = bfhi(w.w); }
__device__ __forceinline__ void unpack4(const u32x2 w, float (&f)[4]) { f[0] = bflo(w.x); f[1] = bfhi(w.x); f[2] = bflo(w.y); f[3] = bfhi(w.y); }
__device__ __forceinline__ u32x4 pack8(const float (&f)[8]) { u32x4 w; w.x = pg8::cvt_pk_bf16(f[0], f[1]); w.y = pg8::cvt_pk_bf16(f[2], f[3]); w.z = pg8::cvt_pk_bf16(f[4], f[5]); w.w = pg8::cvt_pk_bf16(f[6], f[7]); return w; }
__device__ __forceinline__ int crow(int r, int hi) { return (r & 3) + 8 * (r >> 2) + 4 * hi; }
#define LDS_WAIT() asm volatile("s_waitcnt lgkmcnt(0)" ::: "memory")


struct ArgsG { const __attribute__((address_space(1))) float* in[16]; __attribute__((address_space(1))) float* out; __attribute__((address_space(1))) unsigned char* ws; };
typedef const __attribute__((address_space(4))) ArgsG* KArgs;
__device__ __forceinline__ KArgs kargs() { KArgs p = (KArgs)__builtin_amdgcn_kernarg_segment_ptr(); asm volatile("" : "+s"(p)); return p; }
__device__ __forceinline__ void make_frame(Frame& F, KArgs a) {
    { int t_ = threadIdx.x; asm volatile("" : "+v"(t_)); F.tid = t_; } F.lane = F.tid & 63; F.wave = __builtin_amdgcn_readfirstlane(F.tid >> 6); F.bid = blockIdx.x; F.G = gridDim.x;
    F.xp = (const float*)a->in[0]; F.xs = (const float*)a->in[1]; F.cache_k = (const float*)a->in[2]; F.cache_v = (const float*)a->in[3]; F.state_pool = (const float*)a->in[4]; F.w_in = (const float*)a->in[5]; F.w_out = (const float*)a->in[6]; F.norm_pre = (const float*)a->in[7]; F.norm_post = (const float*)a->in[8];
    F.sinks = (const float*)a->in[9]; F.pool_w = (const float*)a->in[10]; F.pool_scale = (const float*)a->in[11]; F.ln_g = (const float*)a->in[12]; F.ln_b = (const float*)a->in[13]; F.sgu_w = (const float*)a->in[14]; F.sgu_b = (const float*)a->in[15];
    F.out = (float*)a->out;
    unsigned char* ws = (unsigned char*)a->ws;
    F.rope = (float*)(ws + WS_ROPE); F.RSW = (float*)(ws + WS_RSW); F.RSTD = (float*)(ws + WS_RSTD); F.SGUW = (bf16_t*)(ws + WS_SGUW); F.PWT = (bf16_t*)(ws + WS_PWT); F.WTIN = (bf16_t*)(ws + WS_WTIN); F.WTOUT = (bf16_t*)(ws + WS_WTOUT);
    F.H = (bf16_t*)(ws + WS_H); F.MIX = (bf16_t*)(ws + WS_MIX); F.Qc = (bf16_t*)(ws + WS_QC); F.Kc = (bf16_t*)(ws + WS_KC); F.VTP = (bf16_t*)(ws + WS_VTP); F.Z2 = (bf16_t*)(ws + WS_Z2); F.Yb = (bf16_t*)(ws + WS_Y);
}

#define LOCAL_FRAME Frame F; make_frame(F, kargs())

constexpr int CW_Q = 8192;
constexpr int CW_ZS = 8192 + 64 * 8;
constexpr int CW_YS = 8192 + 64 * 16;
constexpr int CW_EV = 8192 + 64 * 32;
__device__ __forceinline__ unsigned* ctl_word(int idx) { return (unsigned*)((unsigned char*)kargs()->ws + WS_CTL) + idx; }
__device__ __forceinline__ int q_pop(unsigned* head, LAS unsigned char* L) {
    volatile LAS int* slot = (volatile LAS int*)(L + 64);
    __syncthreads();
    if (threadIdx.x == 0) *slot = (int)__hip_atomic_fetch_add(head, 1u, __ATOMIC_RELAXED, __HIP_MEMORY_SCOPE_AGENT);
    __syncthreads();
    return __builtin_amdgcn_readfirstlane(*slot);
}
__device__ __forceinline__ void publish(unsigned* ctr) {
    asm volatile("s_waitcnt vmcnt(0)" ::: "memory");
    __syncthreads();
    if (threadIdx.x == 0) { __builtin_amdgcn_fence(__ATOMIC_RELEASE, "agent"); asm volatile("s_waitcnt vmcnt(0)" ::: "memory");
        __hip_atomic_fetch_add(ctr, 1u, __ATOMIC_RELAXED, __HIP_MEMORY_SCOPE_AGENT); }
}
__device__ __forceinline__ void dep_wait(unsigned* ctr, unsigned need) {
    if (threadIdx.x == 0) {
        unsigned sp = 0;
        while (__hip_atomic_load(ctr, __ATOMIC_RELAXED, __HIP_MEMORY_SCOPE_AGENT) < need) { __builtin_amdgcn_s_sleep(16); if (++sp > (1u << 21)) break; }
        __builtin_amdgcn_fence(__ATOMIC_ACQUIRE, "agent"); asm volatile("s_waitcnt vmcnt(0)" ::: "memory");
    }
    __syncthreads();
}

#if PROBE_SEL >= 10
#define EV_T0() const unsigned long long ev_t0 = __builtin_amdgcn_s_memrealtime()
#define EV_MAX(k) do { if (threadIdx.x == 0) __hip_atomic_fetch_max(ctl_word(CW_EV + 64 * (k)), (unsigned)(__builtin_amdgcn_s_memrealtime() - ev_t0), __ATOMIC_RELAXED, __HIP_MEMORY_SCOPE_AGENT); } while (0)
#define EV_MIN(k) do { if (threadIdx.x == 0) __hip_atomic_fetch_max(ctl_word(CW_EV + 64 * (k)), 0x40000000u - (unsigned)(__builtin_amdgcn_s_memrealtime() - ev_t0), __ATOMIC_RELAXED, __HIP_MEMORY_SCOPE_AGENT); } while (0)
#else
#define EV_T0() do {} while (0)
#define EV_MAX(k) do {} while (0)
#define EV_MIN(k) do {} while (0)
#endif
struct OneUnit {
    pg8::Unit u;
    __device__ __forceinline__ bool next(int i, pg8::Unit& o) const { if (i) return false; o = u; return true; }
    __device__ __forceinline__ void a_ready(const pg8::Unit&) const {}
    __device__ __forceinline__ void done(const pg8::Unit&) const {}
};

#ifndef PROBE_SEL
#define PROBE_SEL 0
#endif
#if PROBE_SEL
#define STAMP(k) do { if (blockIdx.x == 0 && threadIdx.x == 0) ((LAS unsigned long long*)(L + 256))[k] = __builtin_amdgcn_s_memrealtime(); } while (0)
#define STAMP2(k) do { if (blockIdx.x == 0) { __syncthreads(); if (threadIdx.x == 0) ((LAS unsigned long long*)((LAS unsigned char*)ring - RING_OFF + 256))[k] = __builtin_amdgcn_s_memrealtime(); } } while (0)
#else
#define STAMP(k) do {} while (0)
#define STAMP2(k) do {} while (0)
#endif
#if PROBE_SEL == 1
#define PA0 0
#define PA1 1
#define PB0 1
#define PB1 2
#elif PROBE_SEL == 2
#define PA0 2
#define PA1 3
#define PB0 3
#define PB1 4
#elif PROBE_SEL == 3
#define PA0 4
#define PA1 5
#define PB0 8
#define PB1 9
#elif PROBE_SEL == 4
#define PA0 2
#define PA1 10
#define PB0 10
#define PB1 11
#elif PROBE_SEL == 5
#define PA0 11
#define PA1 12
#define PB0 12
#define PB1 13
#elif PROBE_SEL == 7
#define PA0 1
#define PA1 2
#define PB0 0
#define PB1 1
#elif PROBE_SEL == 8
#define PA0 3
#define PA1 4
#define PB0 2
#define PB1 3
#elif PROBE_SEL == 9
#define PA0 6
#define PA1 7
#define PB0 4
#define PB1 5
#elif PROBE_SEL == 6
#define PA0 5
#define PA1 6
#define PB0 7
#define PB1 8
#elif PROBE_SEL == 10
#define PEA 0
#define PEA_MIN 0
#define PEB 1
#define PEB_MIN 1
#elif PROBE_SEL == 11
#define PEA 2
#define PEA_MIN 0
#define PEB 3
#define PEB_MIN 1
#elif PROBE_SEL == 12
#define PEA 4
#define PEA_MIN 0
#define PEB 5
#define PEB_MIN 0
#elif PROBE_SEL == 14
#define PEA 8
#define PEA_MIN 0
#define PEB 9
#define PEB_MIN 0
#elif PROBE_SEL == 13
#define PEA 6
#define PEA_MIN 1
#define PEB 7
#define PEB_MIN 0
#endif

__device__ __forceinline__ void p0_transpose_blk(const float* W, int K, int N, bf16_t* WT, bool permqk, const float* kgain, LAS unsigned char* T, int item, int tid) {
    const int nblk = N >> 8, kb = item / nblk, nb = item - kb * nblk, k0 = kb * 128, n0 = nb * 256;
    const int n4 = tid & 63, kr = tid >> 6;
    f32x4 v[16];
#pragma unroll
    for (int i = 0; i < 16; ++i) v[i] = __builtin_nontemporal_load((const f32x4*)(W + (size_t)(k0 + 16 * kr + i) * N + n0 + 4 * n4));
    if (kgain) {
        const float* gp = kgain + k0 + 16 * kr;
#pragma unroll
        for (int i4 = 0; i4 < 4; ++i4) { const f32x4 gg = *(const f32x4*)(gp + 4 * i4);
#pragma unroll
            for (int j = 0; j < 4; ++j) v[4 * i4 + j] = v[4 * i4 + j] * gg[j]; }
    }
#pragma unroll
    for (int e = 0; e < 4; ++e) {
        u32x4 lo, hi;
        lo.x = pg8::cvt_pk_bf16(v[0][e], v[1][e]); lo.y = pg8::cvt_pk_bf16(v[2][e], v[3][e]); lo.z = pg8::cvt_pk_bf16(v[4][e], v[5][e]); lo.w = pg8::cvt_pk_bf16(v[6][e], v[7][e]);
        hi.x = pg8::cvt_pk_bf16(v[8][e], v[9][e]); hi.y = pg8::cvt_pk_bf16(v[10][e], v[11][e]); hi.z = pg8::cvt_pk_bf16(v[12][e], v[13][e]); hi.w = pg8::cvt_pk_bf16(v[14][e], v[15][e]);
        LAS unsigned char* p = T + (64 * e + n4) * 272 + 32 * kr;
        *(LAS u32x4*)p = lo; *(LAS u32x4*)(p + 16) = hi;
    }
    LDS_WAIT();
    __syncthreads();
    {
        const int rho = tid >> 1, half = tid & 1, n = n0 + 4 * (rho & 63) + (rho >> 6);
        int nrow = n;
        if (permqk && n < 1280) { const int p = n & 63; nrow = (n & ~63) + 2 * (p & 31) + (p >> 5); }
        const LAS unsigned char* src = T + rho * 272 + 128 * half;
        bf16_t* dst = WT + (size_t)nrow * K + k0 + 64 * half;
        u32x4 o[8];
#pragma unroll
        for (int c = 0; c < 8; ++c) o[c] = *(const LAS u32x4*)(src + 16 * c);
#pragma unroll
        for (int c = 0; c < 8; ++c) *(u32x4*)(dst + 8 * c) = o[c];
    }
    LDS_WAIT();
    __syncthreads();
}
__device__ __forceinline__ void prenorm_finish(const f32x4 (&v)[8], float* rstd, bf16_t* hrow, int lane) {
    float ss = 0.f;
#pragma unroll
    for (int j = 0; j < 8; ++j) ss += (v[j][0] * v[j][0] + v[j][1] * v[j][1]) + (v[j][2] * v[j][2] + v[j][3] * v[j][3]);
    ss = wave_sum(ss);
    if (lane == 0) *rstd = rsqrtf(ss * (1.0f / 2048.0f) + EPS);
#pragma unroll
    for (int j = 0; j < 8; ++j) { u32x2 w; w.x = pg8::cvt_pk_bf16(v[j][0], v[j][1]); w.y = pg8::cvt_pk_bf16(v[j][2], v[j][3]); *(u32x2*)(hrow + 4 * lane + 256 * j) = w; }
}
constexpr int TR_IN = 16 * 20, TR_OUT = 16 * 8, TR_ITEMS = TR_IN + TR_OUT;
__device__ __forceinline__ void transpose_item(const Frame& F, int l, int r, LAS unsigned char* ring) {
    if (r < TR_IN) p0_transpose_blk(F.w_in + (size_t)l * DM * DIN, DM, DIN, F.WTIN + (size_t)l * DIN * DM, true, F.norm_pre + l * DM, ring, r, F.tid);
    else p0_transpose_blk(F.w_out + (size_t)l * DM * DM, DM, DM, F.WTOUT + (size_t)l * DM * DM, false, nullptr, ring, r - TR_IN, F.tid);
}
__device__ __forceinline__ void p0_prologue(const Frame& F, LAS unsigned char* ring) {
    const int gw = F.bid * NWAVES + F.wave, NGW = F.G * NWAVES;
    EV_T0();
    for (int it = F.bid; it < TR_ITEMS; it += F.G) transpose_item(F, 0, it, ring);
    __syncthreads(); EV_MAX(8);
    for (int m = 2 * gw; m < MT; m += 2 * NGW) {
        const float* xa = m < MP ? F.xp + (size_t)m * DM : F.xs + (size_t)(m - MP) * DM; const float* xb = (m + 1) < MP ? F.xp + (size_t)(m + 1) * DM : F.xs + (size_t)(m + 1 - MP) * DM;
        f32x4 va[8], vb[8];
#pragma unroll
        for (int j = 0; j < 8; ++j) { va[j] = __builtin_nontemporal_load((const f32x4*)(xa + 4 * F.lane + 256 * j)); vb[j] = __builtin_nontemporal_load((const f32x4*)(xb + 4 * F.lane + 256 * j)); }
        prenorm_finish(va, F.RSTD + m, F.H + (size_t)m * DM, F.lane); prenorm_finish(vb, F.RSTD + m + 1, F.H + (size_t)(m + 1) * DM, F.lane); }
    __syncthreads(); EV_MAX(9);
    const int gt = F.bid * NTHREADS + F.tid, NGT = F.G * NTHREADS;
    for (int e = gt; e < 2052 * 32; e += NGT) { const int tp = e >> 5, i = e & 31; const double pos = (double)(tp < 2048 ? tp : 8192 + (tp - 2048));
        const double rev = pos * ROPE_INV[i] * 0.15915494309189535; const float fr = (float)(rev - floor(rev));
        F.rope[tp * 64 + i] = __builtin_amdgcn_cosf(fr); F.rope[tp * 64 + 32 + i] = __builtin_amdgcn_sinf(fr); }
    for (int e = gt; e < 2 * 4 * 128 * 128; e += NGT) { const int s = e & 127, t = (e >> 7) & 127; const float w = F.sgu_w[e];
        F.SGUW[e] = (bf16_t)(pg8::cvt_pk_bf16(s <= t ? w : 0.f, 0.f) & 0xffffu); }
    for (int e = gt; e < 2 * 4 * 128; e += NGT) { const int t = e & 127; const float* wr = F.sgu_w + (size_t)e * 128; float acc = 0.f;
        for (int s2 = 0; s2 <= t; ++s2) acc += __uint_as_float(pg8::cvt_pk_bf16(wr[s2], 0.f) << 16);
        F.RSW[e] = acc; }
    for (int e = gt; e < 2 * 4 * 128 * 128; e += NGT) { const int c = e & 127, d = (e >> 7) & 127, lg = e >> 14;
        F.PWT[e] = (bf16_t)(pg8::cvt_pk_bf16(F.pool_w[((size_t)lg * 128 + c) * 128 + d], 0.f) & 0xffffu); }
}

constexpr int AT_K = 0, AT_V = 49152, AT_STG = 98304, AT_WSTRIDE = 4352;
__device__ __forceinline__ void attn_stage_kv(const Frame& F, int b, int kvh, int nbp, LAS unsigned char* ring) {
    const int tid = F.tid;
    const bf16_t* kg = F.Kc + ((size_t)(b * 4 + kvh) * 2048 + 256 * nbp - 128) * 64;
    const bf16_t* vg = F.VTP + ((size_t)(b * 4 + kvh) * 64 + 8 * nbp - 4) * 2048;
    u32x4 kv[6], vv[6];
#pragma unroll
    for (int i = 0; i < 6; ++i) { const int ch = tid + 512 * i, row0 = ch >> 3, c8 = ch & 7, row = (nbp > 0 || row0 >= 128) ? row0 : row0 + 128;
        kv[i] = __builtin_nontemporal_load((const u32x4*)(kg + row * 64 + c8 * 8)); }
#pragma unroll
    for (int i = 0; i < 6; ++i) { const int ch = tid + 512 * i, tile0 = ch >> 8, rem = ch & 255, d = rem >> 2, c4 = rem & 3, tile = (nbp > 0 || tile0 >= 4) ? tile0 : tile0 + 4;
        vv[i] = __builtin_nontemporal_load((const u32x4*)(vg + tile * 2048 + d * 32 + c4 * 8)); }
#pragma unroll
    for (int i = 0; i < 6; ++i) { const int ch = tid + 512 * i, row = ch >> 3, c8 = ch & 7;
        *(LAS u32x4*)(ring + AT_K + row * 128 + ((c8 ^ (row & 7)) << 4)) = kv[i]; }
#pragma unroll
    for (int i = 0; i < 6; ++i) { const int ch = tid + 512 * i, tile = ch >> 8, rem = ch & 255, d = rem >> 2, c4 = rem & 3;
        *(LAS u32x4*)(ring + AT_V + tile * 4096 + d * 64 + ((c4 ^ ((d >> 2) & 3)) << 4)) = vv[i]; }
}
__device__ __forceinline__ void attn_task(const Frame& F, int l, int b, int nbp, int head, int j, const bf16x8 (&qf)[4], LAS unsigned char* ring) {
    const int lane = F.lane, r = lane & 31, hh = lane >> 5;
    LAS unsigned char* wl = ring + AT_STG + F.wave * AT_WSTRIDE;
    LAS float* wsf = (LAS float*)wl; LAS bf16_t* stg = (LAS bf16_t*)(wl + 256);
    const size_t qrow0 = (size_t)b * 2048 + 256 * nbp + 32 * j;
    u32x4 gv[4];
#pragma unroll
    for (int i = 0; i < 4; ++i) gv[i] = __builtin_nontemporal_load((const u32x4*)(F.Z2 + (qrow0 + i * 8 + (lane >> 3)) * ZW + Z_GA + head * 64 + (lane & 7) * 8));
    const int cmin = (nbp > 0) ? 0 : (j < 4 ? 4 - j : 0);
    f32x16 S[5];
#pragma unroll
    for (int c = 0; c < 5; ++c) {
        f32x16 a;
#pragma unroll
        for (int i = 0; i < 16; ++i) a[i] = 0.f;
        if (c >= cmin) {
            LAS unsigned char* kp = ring + AT_K + (32 * (j + c) + r) * 128;
#pragma unroll
            for (int s = 0; s < 4; ++s) a = __builtin_amdgcn_mfma_f32_32x32x16_bf16(*(const LAS bf16x8*)(kp + (((2 * s + hh) ^ (r & 7)) << 4)), qf[s], a, 0, 0, 0);
        }
        S[c] = a;
    }
    const float NEG = -INFINITY;
#pragma unroll
    for (int i = 0; i < 16; ++i) { const int kap = crow(i, hh); if (kap <= r) S[0][i] = NEG; if (kap > r) S[4][i] = NEG; }
    const float sink2 = F.sinks[l * 16 + head] * LOG2E;
    float m = sink2;
#pragma unroll
    for (int c = 0; c < 5; ++c) if (c >= cmin) {
#pragma unroll
        for (int i = 0; i < 16; ++i) m = fmaxf(m, S[c][i]); }
    m = fmaxf(m, __shfl_xor(m, 32));
    float sum = 0.f;
#pragma unroll
    for (int c = 0; c < 5; ++c) if (c >= cmin) {
#pragma unroll
        for (int i = 0; i < 16; ++i) { const float p = __builtin_amdgcn_exp2f(S[c][i] - m); S[c][i] = p; sum += p; } }
    sum += __shfl_xor(sum, 32);
    const float inv = 1.0f / (sum + __builtin_amdgcn_exp2f(sink2 - m));
    f32x16 o[2];
#pragma unroll
    for (int i = 0; i < 16; ++i) { o[0][i] = 0.f; o[1][i] = 0.f; }
#pragma unroll
    for (int c = 0; c < 5; ++c) if (c >= cmin) {
        LAS unsigned char* vt = ring + AT_V + (j + c) * 4096 + r * 64;
#pragma unroll
        for (int s = 0; s < 2; ++s) {
            u32x4 pw; pw.x = pg8::cvt_pk_bf16(S[c][8 * s + 0], S[c][8 * s + 1]); pw.y = pg8::cvt_pk_bf16(S[c][8 * s + 2], S[c][8 * s + 3]);
            pw.z = pg8::cvt_pk_bf16(S[c][8 * s + 4], S[c][8 * s + 5]); pw.w = pg8::cvt_pk_bf16(S[c][8 * s + 6], S[c][8 * s + 7]);
            const bf16x8 pa = __builtin_bit_cast(bf16x8, pw);
            const int sw = (((2 * hh + s) ^ ((r >> 2) & 3)) << 4);
#pragma unroll
            for (int db = 0; db < 2; ++db) o[db] = __builtin_amdgcn_mfma_f32_32x32x16_bf16(pa, *(const LAS bf16x8*)(vt + db * 2048 + sw), o[db], 0, 0, 0);
        }
    }
    if (hh == 0) wsf[r] = inv;
    LDS_WAIT();
#pragma unroll
    for (int i = 0; i < 16; ++i) { const int q = crow(i, hh); const float rl = wsf[q];
        stg[q * 64 + r] = (bf16_t)(pg8::cvt_pk_bf16(o[0][i] * rl, 0.f) & 0xffffu);
        stg[q * 64 + 32 + r] = (bf16_t)(pg8::cvt_pk_bf16(o[1][i] * rl, 0.f) & 0xffffu); }
    LDS_WAIT();
#pragma unroll
    for (int i = 0; i < 4; ++i) { const int row = i * 8 + (lane >> 3), ch = lane & 7;
        const u32x4 ov = *(const LAS u32x4*)(stg + row * 64 + ch * 8);
        float of[8], gf[8]; unpack8(ov, of); unpack8(gv[i], gf);
#pragma unroll
        for (int jj = 0; jj < 8; ++jj) of[jj] *= gf[jj];
        *(u32x4*)(F.MIX + (qrow0 + row) * DM + head * 64 + ch * 8) = pack8(of); }
    LDS_WAIT();
}
__device__ __forceinline__ void attn_unit(int l, int a, LAS unsigned char* ring) {
    LOCAL_FRAME;
    const int kvh = a & 3, nbp = (a >> 2) & 7, b = a >> 5;
    const int lane = F.lane, r = lane & 31, hh = lane >> 5;
    const int head = 4 * kvh + (F.wave >> 1), j0 = 4 * (F.wave & 1);
    const bf16_t* qp = F.Qc + ((size_t)b * 2048 + 256 * nbp + 32 * j0 + r) * 1024 + head * 64 + 8 * hh;
    bf16x8 qa[4], qb[4];
#pragma unroll
    for (int s = 0; s < 4; ++s) qa[s] = __builtin_nontemporal_load((const bf16x8*)(qp + 16 * s));
#ifdef EXP_ZERO_LDS
    for (int e = F.tid; e < 134144 / 16; e += NTHREADS) *(LAS u32x4*)(ring + 16 * e) = (u32x4){0u, 0u, 0u, 0u};
    LDS_WAIT(); __syncthreads();
#endif
    attn_stage_kv(F, b, kvh, nbp, ring);
    LDS_WAIT();
    __syncthreads();
#pragma unroll
    for (int s = 0; s < 4; ++s) qb[s] = __builtin_nontemporal_load((const bf16x8*)(qp + 32 * 1024 + 16 * s));
    attn_task(F, l, b, nbp, head, j0 + 0, qa, ring);
#pragma unroll
    for (int s = 0; s < 4; ++s) qa[s] = __builtin_nontemporal_load((const bf16x8*)(qp + 64 * 1024 + 16 * s));
    attn_task(F, l, b, nbp, head, j0 + 1, qb, ring);
#pragma unroll
    for (int s = 0; s < 4; ++s) qb[s] = __builtin_nontemporal_load((const bf16x8*)(qp + 96 * 1024 + 16 * s));
    attn_task(F, l, b, nbp, head, j0 + 2, qa, ring);
    attn_task(F, l, b, nbp, head, j0 + 3, qb, ring);
    __syncthreads();
}

constexpr int PL_STRIDE = 272, PL_WBYTES = 47 * 272;
template <int G>
__device__ __forceinline__ void pool_unit_p(int l, int tile, LAS unsigned char* wl) {
    LOCAL_FRAME;
    constexpr int W = 2 << G, HIST = W - 1, NROW = 32 + HIST, NLD = (NROW * 16 + 63) / 64;
    const int lane = F.lane, r = lane & 31, hh = lane >> 5;
    const size_t R0 = (size_t)32 * tile;
    const int t0 = (int)(R0 & 2047);
    {
        u32x4 x[NLD];
#pragma unroll
        for (int k = 0; k < NLD; ++k) { const int id = lane + 64 * k, lr = id >> 4, c16 = id & 15; const int lrc = lr < NROW ? lr : NROW - 1;
            const int back = HIST - lrc; const size_t grow = (back <= t0) ? R0 - back : R0;
            x[k] = __builtin_nontemporal_load((const u32x4*)(F.Z2 + grow * ZW + Z_XB + 128 * G + 8 * c16)); }
#pragma unroll
        for (int k = 0; k < NLD; ++k) { const int id = lane + 64 * k, lr = id >> 4, c16 = id & 15; if (lr < NROW) *(LAS u32x4*)(wl + lr * PL_STRIDE + c16 * 16) = x[k]; }
    }
    const int t = t0 + r;
    const float icnt = 1.0f / (float)(W < t + 1 ? W : t + 1);
    LDS_WAIT();
    bf16x8 bfr[8];
#pragma unroll
    for (int s = 0; s < 8; ++s) {
        LAS unsigned char* bp = wl + (r + HIST) * PL_STRIDE + (16 * s + 8 * hh) * 2;
        float cur[8], sum[8]; unpack8(*(const LAS u32x4*)bp, cur);
#pragma unroll
        for (int jj = 0; jj < 8; ++jj) sum[jj] = cur[jj];
#pragma unroll
        for (int i = 1; i < W; ++i) { float f[8]; unpack8(*(const LAS u32x4*)(bp - i * PL_STRIDE), f); const float wgt = i <= t ? 1.f : 0.f;
#pragma unroll
            for (int jj = 0; jj < 8; ++jj) sum[jj] += wgt * f[jj]; }
#pragma unroll
        for (int jj = 0; jj < 8; ++jj) sum[jj] = sum[jj] * icnt - cur[jj];
        bfr[s] = __builtin_bit_cast(bf16x8, pack8(sum));
        __builtin_amdgcn_sched_barrier(0);
    }
#pragma unroll
    for (int db = 0; db < 4; ++db) {
        const int col = 128 * G + 32 * db + r;
        unsigned short gq[16];
#pragma unroll
        for (int i = 0; i < 16; ++i) gq[i] = __builtin_nontemporal_load(F.Z2 + (R0 + crow(i, hh)) * ZW + Z_GP + col);
        const float sc = F.pool_scale[l * 512 + col];
        f32x16 acc;
#pragma unroll
        for (int i = 0; i < 16; ++i) acc[i] = 0.f;
        const bf16_t* bp2 = F.PWT + ((size_t)(l * 4 + G) * 128 + 32 * db + r) * 128 + 8 * hh;
#pragma unroll
        for (int s = 0; s < 8; ++s) acc = __builtin_amdgcn_mfma_f32_32x32x16_bf16(bfr[s], *(const bf16x8*)(bp2 + 16 * s), acc, 0, 0, 0);
#pragma unroll
        for (int i = 0; i < 16; ++i) { const float gf = __uint_as_float((unsigned)gq[i] << 16);
            F.MIX[(R0 + crow(i, hh)) * DM + 1024 + col] = (bf16_t)(pg8::cvt_pk_bf16(acc[i] * sc * gf, 0.f) & 0xffffu); }
        __builtin_amdgcn_sched_barrier(0);
    }
    LDS_WAIT();
}
__device__ __forceinline__ void pool_prompt(int l, int g, int tile, LAS unsigned char* wl) {
    if (g == 0) pool_unit_p<0>(l, tile, wl); else if (g == 1) pool_unit_p<1>(l, tile, wl); else if (g == 2) pool_unit_p<2>(l, tile, wl); else pool_unit_p<3>(l, tile, wl);
}
template <int G>
__device__ __forceinline__ void pool_unit_s(int l, int tile) {
    LOCAL_FRAME;
    constexpr int W = 2 << G;
    const int lane = F.lane, r = lane & 31, hh = lane >> 5;
    const size_t row = (size_t)MP + 32 * tile + r;
    const int tt = (int)(row & 3), bd = (int)((row - MP) >> 2);
    const float* stb = F.state_pool + ((size_t)l * 128 + bd) * 15 * 512;
    const float icnt = 1.0f / (float)W;
    bf16x8 bfr[8];
#pragma unroll
    for (int s = 0; s < 8; ++s) {
        const int c0 = 128 * G + 16 * s + 8 * hh;
        float sum[8], cur[8];
        {
            constexpr int NL = W < 4 ? W : 4;
            u32x4 zn[NL]; f32x4 sa[NL], sb[NL];
#pragma unroll
            for (int i = 0; i < NL; ++i) { const int back = i <= tt ? i : tt; int si = 15 + tt - i; si = si > 14 ? 14 : si;
                zn[i] = *(const u32x4*)(F.Z2 + (row - back) * ZW + Z_XB + c0); sa[i] = *(const f32x4*)(stb + si * 512 + c0); sb[i] = *(const f32x4*)(stb + si * 512 + c0 + 4); }
            unpack8(zn[0], cur);
#pragma unroll
            for (int jj = 0; jj < 8; ++jj) sum[jj] = cur[jj];
#pragma unroll
            for (int i = 1; i < NL; ++i) { float f[8]; unpack8(zn[i], f); const bool nw = i <= tt;
#pragma unroll
                for (int jj = 0; jj < 4; ++jj) { sum[jj] += nw ? f[jj] : sa[i][jj]; sum[4 + jj] += nw ? f[4 + jj] : sb[i][jj]; } }
        }
#pragma unroll
        for (int i0 = 4; i0 < W; i0 += 4) {
            f32x4 sa[4], sb[4];
#pragma unroll
            for (int i = 0; i < 4; ++i) { const int si = 15 + tt - (i0 + i); sa[i] = *(const f32x4*)(stb + si * 512 + c0); sb[i] = *(const f32x4*)(stb + si * 512 + c0 + 4); }
#pragma unroll
            for (int i = 0; i < 4; ++i)
#pragma unroll
                for (int jj = 0; jj < 4; ++jj) { sum[jj] += sa[i][jj]; sum[4 + jj] += sb[i][jj]; }
        }
#pragma unroll
        for (int jj = 0; jj < 8; ++jj) sum[jj] = sum[jj] * icnt - cur[jj];
        bfr[s] = __builtin_bit_cast(bf16x8, pack8(sum));
        __builtin_amdgcn_sched_barrier(0);
    }
    f32x16 acc[4];
#pragma unroll
    for (int db = 0; db < 4; ++db) {
#pragma unroll
        for (int i = 0; i < 16; ++i) acc[db][i] = 0.f;
        const bf16_t* ap = F.PWT + ((size_t)(l * 4 + G) * 128 + 32 * db + r) * 128 + 8 * hh;
#pragma unroll
        for (int s = 0; s < 8; ++s) acc[db] = __builtin_amdgcn_mfma_f32_32x32x16_bf16(*(const bf16x8*)(ap + 16 * s), bfr[s], acc[db], 0, 0, 0);
        __builtin_amdgcn_sched_barrier(0);
    }
#pragma unroll
    for (int db = 0; db < 4; ++db)
#pragma unroll
        for (int q = 0; q < 4; ++q) {
            const int col = 128 * G + 32 * db + 8 * q + 4 * hh;
            const f32x4 sc = *(const f32x4*)(F.pool_scale + l * 512 + col);
            float gf[4]; unpack4(*(const u32x2*)(F.Z2 + row * ZW + Z_GP + col), gf);
            u32x2 wv; wv.x = pg8::cvt_pk_bf16(acc[db][4 * q + 0] * sc[0] * gf[0], acc[db][4 * q + 1] * sc[1] * gf[1]);
            wv.y = pg8::cvt_pk_bf16(acc[db][4 * q + 2] * sc[2] * gf[2], acc[db][4 * q + 3] * sc[3] * gf[3]);
            *(u32x2*)(F.MIX + row * DM + 1024 + col) = wv;
        }
}
__device__ __forceinline__ void pool_sample(int l, int g, int tile) {
    if (g == 0) pool_unit_s<0>(l, tile); else if (g == 1) pool_unit_s<1>(l, tile); else if (g == 2) pool_unit_s<2>(l, tile); else pool_unit_s<3>(l, tile);
}

struct SguOps { bf16x8 wB[8], wA[4]; };
__device__ __forceinline__ void sgu_load_ops(SguOps& o, const Frame& F, int l, int hd, size_t R0, int r, int hh, int db, int tbA, int tbB) {
    const bf16_t* Wb = F.SGUW + (size_t)(l * 4 + hd) * 128 * 128;
#pragma unroll
    for (int s = 0; s < 8; ++s) { o.wB[s] = (bf16x8){0, 0, 0, 0, 0, 0, 0, 0}; if (s < 2 * (tbB + 1)) o.wB[s] = *(const bf16x8*)(Wb + (32 * tbB + r) * 128 + 16 * s + 8 * hh); }
#pragma unroll
    for (int s = 0; s < 4; ++s) { o.wA[s] = (bf16x8){0, 0, 0, 0, 0, 0, 0, 0}; if (s < 2 * (tbA + 1)) o.wA[s] = *(const bf16x8*)(Wb + (32 * tbA + r) * 128 + 16 * s + 8 * hh); }
}
struct SguUG { unsigned short uu[16], gg[16]; };
__device__ __forceinline__ void sgu_load_ug(SguUG& o, const Frame& F, int hd, size_t R0, int r, int hh, int db, int tb) {
    const bf16_t* p = F.Z2 + (R0 + 32 * tb + 4 * hh) * ZW + Z_U + 128 * hd + 32 * db + r;
#pragma unroll
    for (int i = 0; i < 16; ++i) { o.uu[i] = __builtin_nontemporal_load(p); o.gg[i] = __builtin_nontemporal_load(p + (Z_GS - Z_U));
        p += ((i & 3) == 3 ? 5 : 1) * ZW; asm volatile("" : "+v"(p)); }
}
__device__ __forceinline__ void sgu_mfma(const SguOps& o, LAS bf16_t* VnT, int h2, int r, int hh, int db, int tbA, int tbB, f32x16& accA, f32x16& accB) {
#pragma unroll
    for (int i = 0; i < 16; ++i) { accA[i] = 0.f; accB[i] = 0.f; }
#pragma unroll
    for (int s = 0; s < 8; ++s) {
        if (s < 2 * (tbB + 1)) {
            const LAS unsigned char* ap = (const LAS unsigned char*)VnT + (h2 * 128 + 16 * s + 8 * hh + ((r & 15) >> 2)) * 320 + (32 * db + (r & 16) + 4 * (r & 3)) * 2;
            const v4i16_t lo = __builtin_amdgcn_ds_read_tr16_b64_v4i16((LAS v4i16_t*)ap), hi = __builtin_amdgcn_ds_read_tr16_b64_v4i16((LAS v4i16_t*)(ap + 4 * 320));
            const bf16x8 a = (bf16x8){lo[0], lo[1], lo[2], lo[3], hi[0], hi[1], hi[2], hi[3]};
            accB = __builtin_amdgcn_mfma_f32_32x32x16_bf16(o.wB[s], a, accB, 0, 0, 0);
            if (s < 4) { if (s < 2 * (tbA + 1)) accA = __builtin_amdgcn_mfma_f32_32x32x16_bf16(o.wA[s], a, accA, 0, 0, 0); }
        }
    }
}
__device__ __forceinline__ void sgu_epi(const SguUG& o, const Frame& F, int l, int hd, size_t R0, int r, int hh, int db, int tb, const f32x16& acc) {
    const int col = 128 * hd + 32 * db + r;
    const float lg = F.ln_g[l * 512 + col], lb = F.ln_b[l * 512 + col];
    const float* bsp = F.sgu_b + l * 512 + hd * 128 + 32 * tb + 4 * hh; const float* rsp = F.RSW + (l * 4 + hd) * 128 + 32 * tb + 4 * hh;
    bf16_t* q = F.MIX + (R0 + 32 * tb + 4 * hh) * DM + 1536 + col;
#pragma unroll
    for (int i = 0; i < 16; ++i) { const int dt = (i & 3) + 8 * (i >> 2);
        const float uf = __uint_as_float((unsigned)o.uu[i] << 16), gf = __uint_as_float((unsigned)o.gg[i] << 16);
        const float m = (lg * acc[i] + lb * rsp[dt] + bsp[dt]) * uf * gf;
        *q = (bf16_t)(pg8::cvt_pk_bf16(m, 0.f) & 0xffffu);
        q += ((i & 3) == 3 ? 5 : 1) * DM; asm volatile("" : "+v"(q)); }
}
__device__ __forceinline__ void sgu_unit(int l, int ci, int hp, LAS unsigned char* ring) {
    LOCAL_FRAME;
    LAS bf16_t* VnT = (LAS bf16_t*)ring;
    const int lane = F.lane, wv = F.wave;
    const size_t R0 = (size_t)128 * ci;
    const int r = lane & 31, hh = lane >> 5, db = wv & 3; const int tbA = (wv >> 2) ? 1 : 0, tbB = (wv >> 2) ? 2 : 3;
    SguOps op0;
    {
        const int tl = lane >> 2, q4 = lane & 3;
        const bf16_t* vrow = F.Z2 + (R0 + 16 * wv + tl) * ZW + Z_VS + 32 * q4;
        u32x4 x[4][4];
#pragma unroll
        for (int h = 0; h < 4; ++h)
#pragma unroll
            for (int i = 0; i < 4; ++i) x[h][i] = *(const u32x4*)(vrow + 128 * h + 8 * i);
        sgu_load_ops(op0, F, l, 2 * hp, R0, r, hh, db, tbA, tbB);
        float s = 0.f, ss = 0.f;
#pragma unroll
        for (int h = 0; h < 4; ++h)
#pragma unroll
            for (int i = 0; i < 4; ++i) { float f[8]; unpack8(x[h][i], f);
#pragma unroll
                for (int jj = 0; jj < 8; ++jj) { s += f[jj]; ss += f[jj] * f[jj]; } }
        s += __shfl_xor(s, 1); s += __shfl_xor(s, 2); ss += __shfl_xor(ss, 1); ss += __shfl_xor(ss, 2);
        const float mean = s * (1.0f / 512.0f), var = ss * (1.0f / 512.0f) - mean * mean, rstd = rsqrtf(var + EPS);
#pragma unroll
        for (int h2 = 0; h2 < 2; ++h2)
#pragma unroll
            for (int i = 0; i < 4; ++i) { const int d = 32 * q4 + 8 * i;
                const u32x4 xv = hp ? x[2 + h2][i] : x[h2][i];
                float f[8]; unpack8(xv, f);
#pragma unroll
                for (int jj = 0; jj < 8; ++jj) f[jj] = (f[jj] - mean) * rstd;
                *(LAS u32x4*)((LAS unsigned char*)VnT + (h2 * 128 + 16 * wv + tl) * 320 + d * 2) = pack8(f); }
    }
    LDS_WAIT();
    __syncthreads();
    f32x16 accA, accB;
    SguUG ua, ub;
    sgu_load_ug(ua, F, 2 * hp, R0, r, hh, db, tbA);
    sgu_mfma(op0, VnT, 0, r, hh, db, tbA, tbB, accA, accB);
    sgu_load_ug(ub, F, 2 * hp, R0, r, hh, db, tbB);
    SguOps op1;
    sgu_load_ops(op1, F, l, 2 * hp + 1, R0, r, hh, db, tbA, tbB);
    sgu_epi(ua, F, l, 2 * hp, R0, r, hh, db, tbA, accA);
    sgu_epi(ub, F, l, 2 * hp, R0, r, hh, db, tbB, accB);
    sgu_load_ug(ua, F, 2 * hp + 1, R0, r, hh, db, tbA);
    sgu_mfma(op1, VnT, 1, r, hh, db, tbA, tbB, accA, accB);
    sgu_load_ug(ub, F, 2 * hp + 1, R0, r, hh, db, tbB);
    sgu_epi(ua, F, l, 2 * hp + 1, R0, r, hh, db, tbA, accA);
    sgu_epi(ub, F, l, 2 * hp + 1, R0, r, hh, db, tbB, accB);
    __syncthreads();
}

__device__ __forceinline__ void samp_attn(int l, int bd, int kvh, LAS unsigned char* wl) {
    LOCAL_FRAME;
    LAS float* ps = (LAS float*)wl;
    LAS float* invs = ps + 144 * 16;
    const int lane = F.lane, fr = lane & 15, fq = lane >> 4, gq = fr >> 2, tt = fr & 3;
    float* oKs = F.out + O_KS + (size_t)l * LS_KS; float* oVs = F.out + O_VS + (size_t)l * LS_KS;
    bf16x8 qfr[2];
    {
        const bf16_t* qsrc = F.Qc + ((size_t)MP + 4 * bd + tt) * 1024 + (4 * kvh + gq) * 64 + 16 * fq;
        const u32x4 qa = *(const u32x4*)qsrc, qb = *(const u32x4*)(qsrc + 8);
        u32x4 lo, hi;
        lo.x = (qa.x & 0xffffu) | (qa.y << 16); lo.y = (qa.z & 0xffffu) | (qa.w << 16); lo.z = (qb.x & 0xffffu) | (qb.y << 16); lo.w = (qb.z & 0xffffu) | (qb.w << 16);
        hi.x = (qa.x >> 16) | (qa.y & 0xffff0000u); hi.y = (qa.z >> 16) | (qa.w & 0xffff0000u); hi.z = (qb.x >> 16) | (qb.y & 0xffff0000u); hi.w = (qb.z >> 16) | (qb.w & 0xffff0000u);
        qfr[0] = __builtin_bit_cast(bf16x8, lo); qfr[1] = __builtin_bit_cast(bf16x8, hi);
    }
    const float* kc = F.cache_k + (((size_t)l * 128 + bd) * 128) * 256 + kvh * 64 + 8 * fq;
    const float* kn = oKs + (((size_t)bd * 128 + 124 + (fr & 3)) * 4 + kvh) * 64 + 8 * fq;
    float* kd = oKs + ((size_t)bd * 128 * 4 + kvh) * 64 + 8 * fq;
    f32x4 S[9];
#pragma unroll
    for (int T = 0; T < 9; ++T) S[T] = (f32x4){0.f, 0.f, 0.f, 0.f};
#pragma unroll
    for (int T0 = 0; T0 < 9; T0 += 3) {
        f32x4 x[3][2][2];
#pragma unroll
        for (int u = 0; u < 3; ++u) { const int T = T0 + u; const float* src = (T < 8) ? kc + (size_t)(16 * T + fr) * 256 : kn;
#pragma unroll
            for (int ks = 0; ks < 2; ++ks) { x[u][ks][0] = __builtin_nontemporal_load((const f32x4*)(src + 32 * ks)); x[u][ks][1] = __builtin_nontemporal_load((const f32x4*)(src + 32 * ks + 4)); } }
#pragma unroll
        for (int u = 0; u < 3; ++u) { const int T = T0 + u; const int key = 16 * T + fr;
            if (T < 8 && key >= 4) {
#pragma unroll
                for (int ks = 0; ks < 2; ++ks) { float* dst = kd + (size_t)(key - 4) * 256 + 32 * ks; __builtin_nontemporal_store(x[u][ks][0], (f32x4*)dst); __builtin_nontemporal_store(x[u][ks][1], (f32x4*)(dst + 4)); } } }
#pragma unroll
        for (int u = 0; u < 3; ++u)
#pragma unroll
            for (int ks = 0; ks < 2; ++ks) { u32x4 w; w.x = pg8::cvt_pk_bf16(x[u][ks][0][0], x[u][ks][0][1]); w.y = pg8::cvt_pk_bf16(x[u][ks][0][2], x[u][ks][0][3]);
                w.z = pg8::cvt_pk_bf16(x[u][ks][1][0], x[u][ks][1][1]); w.w = pg8::cvt_pk_bf16(x[u][ks][1][2], x[u][ks][1][3]);
                S[T0 + u] = __builtin_amdgcn_mfma_f32_16x16x32_bf16(__builtin_bit_cast(bf16x8, w), qfr[ks], S[T0 + u], 0, 0, 0); }
        __builtin_amdgcn_sched_barrier(0);
    }
    const float sink2 = F.sinks[l * 16 + 4 * kvh + gq] * LOG2E;
    float m = sink2;
#pragma unroll
    for (int T = 0; T < 9; ++T)
#pragma unroll
        for (int rg = 0; rg < 4; ++rg) { const int key = 16 * T + 4 * fq + rg; const bool ok = (T < 8) ? (key >= tt + 1) : (fq == 0 && rg <= tt);
            S[T][rg] = ok ? S[T][rg] : -INFINITY; m = fmaxf(m, S[T][rg]); }
    m = fmaxf(m, __shfl_xor(m, 16)); m = fmaxf(m, __shfl_xor(m, 32));
    float sum = 0.f;
#pragma unroll
    for (int T = 0; T < 9; ++T)
#pragma unroll
        for (int rg = 0; rg < 4; ++rg) { const float p = __builtin_amdgcn_exp2f(S[T][rg] - m); sum += p; ps[(16 * T + 4 * fq + rg) * 16 + fr] = p; }
    sum += __shfl_xor(sum, 16); sum += __shfl_xor(sum, 32);
    if (fq == 0) invs[fr] = 1.0f / (sum + __builtin_amdgcn_exp2f(sink2 - m));
    LDS_WAIT();
    const int kq = lane >> 4, dq = lane & 15;
    const float* vcp = F.cache_v + (((size_t)l * 128 + bd) * 128 + kq) * 256 + kvh * 64 + 4 * dq;
    float* vop = oVs + ((size_t)bd * 128 + kq) * 256 + kvh * 64 + 4 * dq;
#pragma unroll 1
    for (int pass = 0; pass < 2; ++pass) {
        float o[8][4];
#pragma unroll
        for (int q = 0; q < 8; ++q) { o[q][0] = 0.f; o[q][1] = 0.f; o[q][2] = 0.f; o[q][3] = 0.f; }
#pragma unroll 1
        for (int blk = 0; blk < 3; ++blk) {
            f32x4 vx[11];
#pragma unroll
            for (int ii = 0; ii < 11; ++ii) { const int i = blk * 11 + ii; const float* src = (i < 32) ? vcp + (size_t)i * 1024 : vop + (size_t)31 * 1024; vx[ii] = __builtin_nontemporal_load((const f32x4*)src); }
            if (pass == 0) {
#pragma unroll
                for (int ii = 0; ii < 11; ++ii) { const int i = blk * 11 + ii; if (i >= 1 && i < 32) __builtin_nontemporal_store(vx[ii], (f32x4*)(vop + (size_t)(i - 1) * 1024)); } }
#pragma unroll
            for (int ii = 0; ii < 11; ++ii) { const int key = 4 * (blk * 11 + ii) + kq;
                const f32x4 pa = *(const LAS f32x4*)(ps + key * 16 + 8 * pass), pb = *(const LAS f32x4*)(ps + key * 16 + 8 * pass + 4);
#pragma unroll
                for (int e = 0; e < 4; ++e) { o[0][e] += pa[0] * vx[ii][e]; o[1][e] += pa[1] * vx[ii][e]; o[2][e] += pa[2] * vx[ii][e]; o[3][e] += pa[3] * vx[ii][e];
                    o[4][e] += pb[0] * vx[ii][e]; o[5][e] += pb[1] * vx[ii][e]; o[6][e] += pb[2] * vx[ii][e]; o[7][e] += pb[3] * vx[ii][e]; }
                __builtin_amdgcn_sched_barrier(0); }
        }
#pragma unroll
        for (int q = 0; q < 8; ++q)
#pragma unroll
            for (int e = 0; e < 4; ++e) { float v = o[q][e]; v += __shfl_xor(v, 16); v += __shfl_xor(v, 32); o[q][e] = v; }
#pragma unroll
        for (int q = 0; q < 8; ++q) if ((q >> 1) == kq) { const int qq = 8 * pass + q, t2 = qq & 3, head = 4 * kvh + (qq >> 2); const size_t row = (size_t)MP + 4 * bd + t2;
            float gf[4]; unpack4(*(const u32x2*)(F.Z2 + row * ZW + Z_GA + head * 64 + 4 * dq), gf);
            const float iq = invs[qq];
            u32x2 wv; wv.x = pg8::cvt_pk_bf16(o[q][0] * iq * gf[0], o[q][1] * iq * gf[1]); wv.y = pg8::cvt_pk_bf16(o[q][2] * iq * gf[2], o[q][3] * iq * gf[3]);
            *(u32x2*)(F.MIX + row * DM + head * 64 + 4 * dq) = wv; }
    }
    LDS_WAIT();
}
__device__ __forceinline__ void samp_sgu(int l, int bd) {
    LOCAL_FRAME;
    const int lane = F.lane, c0 = 8 * lane, hd = lane >> 4;
    {
        float* oPs = F.out + O_PS + (size_t)l * LS_PS + (size_t)bd * 15 * 512; const float* sp = F.state_pool + (size_t)l * LS_PS + (size_t)bd * 15 * 512 + 4 * 512;
        f32x4 cp[22];
#pragma unroll
        for (int k = 0; k < 22; ++k) cp[k] = __builtin_nontemporal_load((const f32x4*)(sp + 4 * (lane + 64 * k)));
#pragma unroll
        for (int k = 0; k < 22; ++k) __builtin_nontemporal_store(cp[k], (f32x4*)(oPs + 4 * (lane + 64 * k)));
    }
    float* oCV = F.out + O_CV + (size_t)l * LS_CV;
    float gl[8], bl[8];
#pragma unroll
    for (int j = 0; j < 8; ++j) { gl[j] = F.ln_g[l * 512 + c0 + j]; bl[j] = F.ln_b[l * 512 + c0 + j]; }
    u32x4 xr[4], ur[4], gr[4];
#pragma unroll
    for (int tt = 0; tt < 4; ++tt) { const size_t row = (size_t)MP + 4 * bd + tt; xr[tt] = *(const u32x4*)(F.Z2 + row * ZW + Z_VS + c0); ur[tt] = *(const u32x4*)(F.Z2 + row * ZW + Z_U + c0); gr[tt] = *(const u32x4*)(F.Z2 + row * ZW + Z_GS + c0); }
    float vn[4][8];
#pragma unroll
    for (int tt = 0; tt < 4; ++tt) { float f[8]; unpack8(xr[tt], f);
        float s = 0.f, ss = 0.f;
#pragma unroll
        for (int j = 0; j < 8; ++j) { s += f[j]; ss += f[j] * f[j]; }
        s = wave_sum(s); ss = wave_sum(ss);
        const float mean = s * (1.0f / 512.0f), var = ss * (1.0f / 512.0f) - mean * mean, rstd = rsqrtf(var + EPS);
#pragma unroll
        for (int j = 0; j < 8; ++j) vn[tt][j] = (f[j] - mean) * rstd * gl[j] + bl[j];
        float* o = oCV + ((size_t)bd * 4 + tt) * 512 + c0;
        *(f32x4*)o = (f32x4){vn[tt][0], vn[tt][1], vn[tt][2], vn[tt][3]}; *(f32x4*)(o + 4) = (f32x4){vn[tt][4], vn[tt][5], vn[tt][6], vn[tt][7]}; }
#pragma unroll
    for (int tt = 0; tt < 4; ++tt) { const size_t row = (size_t)MP + 4 * bd + tt;
        float mx[8]; const float bias = F.sgu_b[l * 512 + hd * 128 + tt];
#pragma unroll
        for (int j = 0; j < 8; ++j) mx[j] = bias;
#pragma unroll
        for (int s2 = 0; s2 < 4; ++s2) if (s2 <= tt) { const float w = F.sgu_w[((size_t)(l * 4 + hd) * 128 + tt) * 128 + s2];
#pragma unroll
            for (int j = 0; j < 8; ++j) mx[j] += w * vn[s2][j]; }
        float uf[8], gf[8]; unpack8(ur[tt], uf); unpack8(gr[tt], gf);
#pragma unroll
        for (int j = 0; j < 8; ++j) mx[j] = mx[j] * uf[j] * gf[j];
        *(u32x4*)(F.MIX + row * DM + 1536 + c0) = pack8(mx); }
}

#ifdef HYBRID
__device__ __forceinline__ void attn_task_o(const Frame& F, int l, int b, int nb, int head, int qs, LAS unsigned char* wl) {
    const int lane = F.lane, r = lane & 31, hh = lane >> 5, kvh = head >> 2;
    LAS float* wsf = (LAS float*)wl; LAS bf16_t* stg = (LAS bf16_t*)(wl + 256);
    const int t0 = 128 * nb + 32 * qs;
    const size_t qrow0 = (size_t)b * 2048 + t0;
    const bf16_t* qp = F.Qc + (qrow0 + r) * 1024 + head * 64 + 8 * hh;
    bf16x8 qf[4];
#pragma unroll
    for (int s = 0; s < 4; ++s) qf[s] = *(const bf16x8*)(qp + 16 * s);
    const bf16_t* kbase = F.Kc + (size_t)(b * 4 + kvh) * 2048 * 64;
    const bf16_t* vbase = F.VTP + (size_t)(b * 4 + kvh) * 64 * 2048;
    const int cmin = (nb > 0) ? 0 : (4 - qs);
    f32x16 S[5];
#pragma unroll
    for (int c = 0; c < 5; ++c) {
        f32x16 a;
#pragma unroll
        for (int i = 0; i < 16; ++i) a[i] = 0.f;
        if (c >= cmin) {
            const bf16_t* kp = kbase + (size_t)(t0 - 128 + 32 * c + r) * 64 + 8 * hh;
#pragma unroll
            for (int s = 0; s < 4; ++s) a = __builtin_amdgcn_mfma_f32_32x32x16_bf16(*(const bf16x8*)(kp + 16 * s), qf[s], a, 0, 0, 0);
        }
        S[c] = a;
    }
    const float NEG = -INFINITY;
#pragma unroll
    for (int i = 0; i < 16; ++i) { const int kap = crow(i, hh); if (kap <= r) S[0][i] = NEG; if (kap > r) S[4][i] = NEG; }
    const float sink2 = F.sinks[l * 16 + head] * LOG2E;
    float m = sink2;
#pragma unroll
    for (int c = 0; c < 5; ++c) if (c >= cmin) {
#pragma unroll
        for (int i = 0; i < 16; ++i) m = fmaxf(m, S[c][i]); }
    m = fmaxf(m, __shfl_xor(m, 32));
    float sum = 0.f;
#pragma unroll
    for (int c = 0; c < 5; ++c) if (c >= cmin) {
#pragma unroll
        for (int i = 0; i < 16; ++i) { const float p = __builtin_amdgcn_exp2f(S[c][i] - m); S[c][i] = p; sum += p; } }
    sum += __shfl_xor(sum, 32);
    const float inv = 1.0f / (sum + __builtin_amdgcn_exp2f(sink2 - m));
    f32x16 o[2];
#pragma unroll
    for (int i = 0; i < 16; ++i) { o[0][i] = 0.f; o[1][i] = 0.f; }
#pragma unroll
    for (int c = 0; c < 5; ++c) if (c >= cmin) {
        const bf16_t* vt = vbase + (size_t)((t0 - 128 + 32 * c) >> 5) * 2048 + r * 32 + 16 * hh;
#pragma unroll
        for (int s = 0; s < 2; ++s) {
            u32x4 pw; pw.x = pg8::cvt_pk_bf16(S[c][8 * s + 0], S[c][8 * s + 1]); pw.y = pg8::cvt_pk_bf16(S[c][8 * s + 2], S[c][8 * s + 3]);
            pw.z = pg8::cvt_pk_bf16(S[c][8 * s + 4], S[c][8 * s + 5]); pw.w = pg8::cvt_pk_bf16(S[c][8 * s + 6], S[c][8 * s + 7]);
            const bf16x8 pa = __builtin_bit_cast(bf16x8, pw);
#pragma unroll
            for (int db = 0; db < 2; ++db) o[db] = __builtin_amdgcn_mfma_f32_32x32x16_bf16(pa, *(const bf16x8*)(vt + db * 1024 + 8 * s), o[db], 0, 0, 0);
        }
    }
    if (hh == 0) wsf[r] = inv;
    LDS_WAIT();
#pragma unroll
    for (int i = 0; i < 16; ++i) { const int q = crow(i, hh); const float rl = wsf[q];
        stg[q * 64 + r] = (bf16_t)(pg8::cvt_pk_bf16(o[0][i] * rl, 0.f) & 0xffffu);
        stg[q * 64 + 32 + r] = (bf16_t)(pg8::cvt_pk_bf16(o[1][i] * rl, 0.f) & 0xffffu); }
    LDS_WAIT();
#pragma unroll
    for (int i = 0; i < 4; ++i) { const int row = i * 8 + (lane >> 3), ch = lane & 7;
        const u32x4 ov = *(const LAS u32x4*)(stg + row * 64 + ch * 8);
        const u32x4 gv = *(const u32x4*)(F.Z2 + (qrow0 + row) * ZW + Z_GA + head * 64 + ch * 8);
        float of[8], gf[8]; unpack8(ov, of); unpack8(gv, gf);
#pragma unroll
        for (int j = 0; j < 8; ++j) of[j] *= gf[j];
        *(u32x4*)(F.MIX + (qrow0 + row) * DM + head * 64 + ch * 8) = pack8(of); }
    LDS_WAIT();
}

template <bool SAMPLE>
__device__ __forceinline__ void pool_unit_o(const Frame& F, int l, int g, int tile) {
    const int lane = F.lane, r = lane & 31, hh = lane >> 5, w = 2 << g;
    const size_t row = (size_t)(SAMPLE ? MP : 0) + 32 * tile + r;
    const int t = SAMPLE ? (int)(row & 3) : (int)(row & 2047);
    const int bd = SAMPLE ? (int)((row - MP) >> 2) : 0;
    const float icnt = SAMPLE ? 1.0f / (float)w : 1.0f / (float)(w < t + 1 ? w : t + 1);
    bf16x8 bfr[8];
#pragma unroll
    for (int s = 0; s < 8; ++s) {
        const int c0 = 128 * g + 16 * s + 8 * hh;
        float sum[8], cur[8];
#pragma unroll
        for (int j = 0; j < 8; ++j) { sum[j] = 0.f; cur[j] = 0.f; }
        for (int i = 0; i < w; ++i) {
            float f[8];
            const int e = t - i;
            if (e >= 0) { unpack8(*(const u32x4*)(F.Z2 + (row - i) * ZW + Z_XB + c0), f); }
            else if (SAMPLE) { const float* sp = F.state_pool + (((size_t)l * 128 + bd) * 15 + 15 + e) * 512 + c0;
                const f32x4 a = *(const f32x4*)sp, bq = *(const f32x4*)(sp + 4); f[0] = a[0]; f[1] = a[1]; f[2] = a[2]; f[3] = a[3]; f[4] = bq[0]; f[5] = bq[1]; f[6] = bq[2]; f[7] = bq[3]; }
            else {
#pragma unroll
                for (int j = 0; j < 8; ++j) f[j] = 0.f; }
#pragma unroll
            for (int j = 0; j < 8; ++j) sum[j] += f[j];
            if (i == 0) {
#pragma unroll
                for (int j = 0; j < 8; ++j) cur[j] = f[j]; }
        }
        float pf[8];
#pragma unroll
        for (int j = 0; j < 8; ++j) pf[j] = sum[j] * icnt - cur[j];
        bfr[s] = __builtin_bit_cast(bf16x8, pack8(pf));
    }
    f32x16 acc[4];
#pragma unroll
    for (int db = 0; db < 4; ++db) {
#pragma unroll
        for (int i = 0; i < 16; ++i) acc[db][i] = 0.f;
        const bf16_t* ap = F.PWT + ((size_t)(l * 4 + g) * 128 + 32 * db + r) * 128 + 8 * hh;
#pragma unroll
        for (int s = 0; s < 8; ++s) acc[db] = __builtin_amdgcn_mfma_f32_32x32x16_bf16(*(const bf16x8*)(ap + 16 * s), bfr[s], acc[db], 0, 0, 0);
    }
#pragma unroll
    for (int db = 0; db < 4; ++db)
#pragma unroll
        for (int q = 0; q < 4; ++q) {
            const int col = 128 * g + 32 * db + 8 * q + 4 * hh;
            const f32x4 sc = *(const f32x4*)(F.pool_scale + l * 512 + col);
            float gf[4]; unpack4(*(const u32x2*)(F.Z2 + row * ZW + Z_GP + col), gf);
            u32x2 wv; wv.x = pg8::cvt_pk_bf16(acc[db][4 * q + 0] * sc[0] * gf[0], acc[db][4 * q + 1] * sc[1] * gf[1]);
            wv.y = pg8::cvt_pk_bf16(acc[db][4 * q + 2] * sc[2] * gf[2], acc[db][4 * q + 3] * sc[3] * gf[3]);
            *(u32x2*)(F.MIX + row * DM + 1024 + col) = wv;
        }
}

__device__ __forceinline__ void sgu_unit_o(const Frame& F, int l, int ci, int hd, LAS unsigned char* ring) {
    LAS bf16_t* VnT = (LAS bf16_t*)ring;
    const int lane = F.lane, wv = F.wave;
    const size_t R0 = (size_t)128 * ci;
    {
        const int tl = lane >> 2, q4 = lane & 3;
        const bf16_t* vrow = F.Z2 + (R0 + 16 * wv + tl) * ZW + Z_VS;
        float s = 0.f, ss = 0.f;
#pragma unroll
        for (int i = 0; i < 16; ++i) { float f[8]; unpack8(*(const u32x4*)(vrow + 128 * q4 + 8 * i), f);
#pragma unroll
            for (int j = 0; j < 8; ++j) { s += f[j]; ss += f[j] * f[j]; } }
        s += __shfl_xor(s, 1); s += __shfl_xor(s, 2); ss += __shfl_xor(ss, 1); ss += __shfl_xor(ss, 2);
        const float mean = s * (1.0f / 512.0f), var = ss * (1.0f / 512.0f) - mean * mean, rstd = rsqrtf(var + EPS);
#pragma unroll
        for (int i = 0; i < 4; ++i) { const int d = 32 * q4 + 8 * i; float f[8]; unpack8(*(const u32x4*)(vrow + 128 * hd + d), f);
            const float* gp = F.ln_g + l * 512 + 128 * hd + d; const float* bp = F.ln_b + l * 512 + 128 * hd + d;
#pragma unroll
            for (int j = 0; j < 8; ++j) { const float vn = (f[j] - mean) * rstd * gp[j] + bp[j];
                VnT[(d + j) * 136 + 16 * wv + tl] = (bf16_t)(pg8::cvt_pk_bf16(vn, 0.f) & 0xffffu); } }
    }
    __syncthreads();
    {
        const int r = lane & 31, hh = lane >> 5, db = wv & 3; const int tbA = (wv >> 2) ? 1 : 0, tbB = (wv >> 2) ? 2 : 3;
        f32x16 accA, accB;
#pragma unroll
        for (int i = 0; i < 16; ++i) { accA[i] = 0.f; accB[i] = 0.f; }
        const bf16_t* Wb = F.SGUW + (size_t)(l * 4 + hd) * 128 * 128;
#pragma unroll
        for (int s = 0; s < 8; ++s) {
            if (s < 2 * (tbB + 1)) {
                const bf16x8 a = *(const LAS bf16x8*)(VnT + (32 * db + r) * 136 + 16 * s + 8 * hh);
                accB = __builtin_amdgcn_mfma_f32_32x32x16_bf16(a, *(const bf16x8*)(Wb + (32 * tbB + r) * 128 + 16 * s + 8 * hh), accB, 0, 0, 0);
                if (s < 2 * (tbA + 1)) accA = __builtin_amdgcn_mfma_f32_32x32x16_bf16(a, *(const bf16x8*)(Wb + (32 * tbA + r) * 128 + 16 * s + 8 * hh), accA, 0, 0, 0);
            }
        }
#pragma unroll
        for (int pass = 0; pass < 2; ++pass) {
            const int tb = pass ? tbB : tbA; const f32x16 acc = pass ? accB : accA;
            const int t = 32 * tb + r; const size_t row = R0 + t; const float bias = F.sgu_b[l * 512 + hd * 128 + t];
#pragma unroll
            for (int q = 0; q < 4; ++q) { const int col = 128 * hd + 32 * db + 8 * q + 4 * hh;
                float uf[4], gf[4]; unpack4(*(const u32x2*)(F.Z2 + row * ZW + Z_U + col), uf); unpack4(*(const u32x2*)(F.Z2 + row * ZW + Z_GS + col), gf);
                u32x2 wo; wo.x = pg8::cvt_pk_bf16((acc[4 * q + 0] + bias) * uf[0] * gf[0], (acc[4 * q + 1] + bias) * uf[1] * gf[1]);
                wo.y = pg8::cvt_pk_bf16((acc[4 * q + 2] + bias) * uf[2] * gf[2], (acc[4 * q + 3] + bias) * uf[3] * gf[3]);
                *(u32x2*)(F.MIX + row * DM + 1536 + col) = wo; }
        }
    }
    __syncthreads();
}

__device__ __forceinline__ void samp_attn_o(const Frame& F, int l, int bd, int kvh, LAS unsigned char* wl) {
    LAS float* qs = (LAS float*)wl;
    LAS float* ps = (LAS float*)(wl + 4096);
    const int lane = F.lane;
    float* oKs = F.out + O_KS + (size_t)l * LS_KS; float* oVs = F.out + O_VS + (size_t)l * LS_KS;
    {
        const int qi = lane >> 2, part = lane & 3, gq = qi >> 2, tt = qi & 3;
        const bf16_t* src = F.Qc + ((size_t)MP + 4 * bd + tt) * 1024 + (4 * kvh + gq) * 64 + 16 * part;
        float f0[8], f1[8]; unpack8(*(const u32x4*)src, f0); unpack8(*(const u32x4*)(src + 8), f1);
#pragma unroll
        for (int j = 0; j < 8; ++j) { const int p0 = 16 * part + j, p1 = p0 + 8;
            qs[qi * 64 + (p0 >> 1) + 32 * (p0 & 1)] = f0[j]; qs[qi * 64 + (p1 >> 1) + 32 * (p1 & 1)] = f1[j]; }
    }
    LDS_WAIT();
    float s0[16], s1[16], s2[16];
#pragma unroll
    for (int q = 0; q < 16; ++q) { s0[q] = 0.f; s1[q] = 0.f; s2[q] = 0.f; }
    const float* k0p = F.cache_k + (((size_t)l * 128 + bd) * 128 + lane) * 256 + kvh * 64;
    const float* k1p = k0p + 64 * 256;
    const float* k2p = oKs + (((size_t)bd * 128 + 124 + (lane & 3)) * 4 + kvh) * 64;
    float* c0p = oKs + (((size_t)bd * 128 + (lane >= 4 ? lane - 4 : 0)) * 4 + kvh) * 64;
    float* c1p = oKs + (((size_t)bd * 128 + lane + 60) * 4 + kvh) * 64;
    for (int ch = 0; ch < 16; ++ch) {
        const f32x4 kx0 = *(const f32x4*)(k0p + 4 * ch), kx1 = *(const f32x4*)(k1p + 4 * ch), kx2 = *(const f32x4*)(k2p + 4 * ch);
        if (lane >= 4) *(f32x4*)(c0p + 4 * ch) = kx0;
        *(f32x4*)(c1p + 4 * ch) = kx1;
#pragma unroll
        for (int q = 0; q < 16; ++q) { const f32x4 qv = *(const LAS f32x4*)(qs + q * 64 + 4 * ch);
            s0[q] += (qv[0] * kx0[0] + qv[1] * kx0[1]) + (qv[2] * kx0[2] + qv[3] * kx0[3]);
            s1[q] += (qv[0] * kx1[0] + qv[1] * kx1[1]) + (qv[2] * kx1[2] + qv[3] * kx1[3]);
            s2[q] += (qv[0] * kx2[0] + qv[1] * kx2[1]) + (qv[2] * kx2[2] + qv[3] * kx2[3]); }
    }
    float inv[16];
#pragma unroll
    for (int q = 0; q < 16; ++q) {
        const int tt = q & 3; const float sink2 = F.sinks[l * 16 + 4 * kvh + (q >> 2)] * LOG2E;
        const bool v0 = lane >= tt + 1, v2 = (lane < 4) && (lane <= tt);
        float m = s1[q]; if (v0) m = fmaxf(m, s0[q]); if (v2) m = fmaxf(m, s2[q]);
        m = fmaxf(wave_max(m), sink2);
        const float p0 = v0 ? __builtin_amdgcn_exp2f(s0[q] - m) : 0.f, p1 = __builtin_amdgcn_exp2f(s1[q] - m), p2 = v2 ? __builtin_amdgcn_exp2f(s2[q] - m) : 0.f;
        const float sum = wave_sum(p0 + p1 + p2);
        inv[q] = 1.0f / (sum + __builtin_amdgcn_exp2f(sink2 - m));
        ps[lane * 16 + q] = p0; ps[(lane + 64) * 16 + q] = p1; if (lane < 4) ps[(128 + lane) * 16 + q] = p2;
    }
    LDS_WAIT();
    float o[16];
#pragma unroll
    for (int q = 0; q < 16; ++q) o[q] = 0.f;
    const float* vcp = F.cache_v + (((size_t)l * 128 + bd) * 128) * 256 + kvh * 64 + lane;
    float* vop = oVs + ((size_t)bd * 128) * 256 + kvh * 64 + lane;
    for (int key = 0; key < 132; ++key) {
        float v;
        if (key < 128) { v = vcp[(size_t)key * 256]; if (key >= 4) vop[(size_t)(key - 4) * 256] = v; }
        else v = vop[(size_t)(key - 4) * 256];
#pragma unroll
        for (int q4 = 0; q4 < 4; ++q4) { const f32x4 pv = *(const LAS f32x4*)(ps + key * 16 + 4 * q4);
            o[4 * q4 + 0] += pv[0] * v; o[4 * q4 + 1] += pv[1] * v; o[4 * q4 + 2] += pv[2] * v; o[4 * q4 + 3] += pv[3] * v; }
    }
#pragma unroll
    for (int q = 0; q < 16; ++q) { const int tt = q & 3, head = 4 * kvh + (q >> 2); const size_t row = (size_t)MP + 4 * bd + tt;
        const float gv = __uint_as_float(((unsigned)F.Z2[row * ZW + Z_GA + head * 64 + lane]) << 16);
        F.MIX[row * DM + head * 64 + lane] = (bf16_t)(pg8::cvt_pk_bf16(o[q] * inv[q] * gv, 0.f) & 0xffffu); }
    LDS_WAIT();
}
__device__ __forceinline__ void samp_sgu_o(const Frame& F, int l, int bd) {
    const int lane = F.lane, c0 = 8 * lane, hd = lane >> 4;
    float* oCV = F.out + O_CV + (size_t)l * LS_CV;
    float gl[8], bl[8];
#pragma unroll
    for (int j = 0; j < 8; ++j) { gl[j] = F.ln_g[l * 512 + c0 + j]; bl[j] = F.ln_b[l * 512 + c0 + j]; }
    float vn[4][8];
#pragma unroll
    for (int tt = 0; tt < 4; ++tt) { const size_t row = (size_t)MP + 4 * bd + tt; float f[8]; unpack8(*(const u32x4*)(F.Z2 + row * ZW + Z_VS + c0), f);
        float s = 0.f, ss = 0.f;
#pragma unroll
        for (int j = 0; j < 8; ++j) { s += f[j]; ss += f[j] * f[j]; }
        s = wave_sum(s); ss = wave_sum(ss);
        const float mean = s * (1.0f / 512.0f), var = ss * (1.0f / 512.0f) - mean * mean, rstd = rsqrtf(var + EPS);
#pragma unroll
        for (int j = 0; j < 8; ++j) vn[tt][j] = (f[j] - mean) * rstd * gl[j] + bl[j];
        float* o = oCV + ((size_t)bd * 4 + tt) * 512 + c0;
        *(f32x4*)o = (f32x4){vn[tt][0], vn[tt][1], vn[tt][2], vn[tt][3]}; *(f32x4*)(o + 4) = (f32x4){vn[tt][4], vn[tt][5], vn[tt][6], vn[tt][7]}; }
#pragma unroll
    for (int tt = 0; tt < 4; ++tt) { const size_t row = (size_t)MP + 4 * bd + tt;
        float mx[8]; const float bias = F.sgu_b[l * 512 + hd * 128 + tt];
#pragma unroll
        for (int j = 0; j < 8; ++j) mx[j] = bias;
#pragma unroll
        for (int s2 = 0; s2 < 4; ++s2) if (s2 <= tt) { const float w = F.sgu_w[((size_t)(l * 4 + hd) * 128 + tt) * 128 + s2];
#pragma unroll
            for (int j = 0; j < 8; ++j) mx[j] += w * vn[s2][j]; }
        float uf[8], gf[8]; unpack8(*(const u32x4*)(F.Z2 + row * ZW + Z_U + c0), uf); unpack8(*(const u32x4*)(F.Z2 + row * ZW + Z_GS + c0), gf);
#pragma unroll
        for (int j = 0; j < 8; ++j) mx[j] = mx[j] * uf[j] * gf[j];
        *(u32x4*)(F.MIX + row * DM + 1536 + c0) = pack8(mx); }
}

#endif
struct NormRowIn { u32x4 yv[4]; f32x4 xv[4][2]; u32x4 xb[4]; };
__device__ __forceinline__ void norm_row_load(NormRowIn& in, const Frame& F, int l, int row) {
    const int lane = F.lane;
    const bf16_t* yr = F.Yb + (size_t)row * DM + 8 * lane;
#pragma unroll
    for (int j = 0; j < 4; ++j) in.yv[j] = __builtin_nontemporal_load((const u32x4*)(yr + 512 * j));
    if (l == 0) {
        const float* xr = (row < MP ? F.xp + (size_t)row * DM : F.xs + (size_t)(row - MP) * DM) + 8 * lane;
#pragma unroll
        for (int j = 0; j < 4; ++j) { in.xv[j][0] = __builtin_nontemporal_load((const f32x4*)(xr + 512 * j)); in.xv[j][1] = __builtin_nontemporal_load((const f32x4*)(xr + 512 * j + 4)); }
    } else {
        const bf16_t* xr = F.H + (size_t)row * DM + 8 * lane;
#pragma unroll
        for (int j = 0; j < 4; ++j) in.xb[j] = __builtin_nontemporal_load((const u32x4*)(xr + 512 * j));
    }
}
__device__ __forceinline__ void norm_row_finish(const NormRowIn& in, const Frame& F, int l, int row) {
    const int lane = F.lane;
    const float* pg = F.norm_post + l * DM + 8 * lane;
    float y[4][8]; float ss = 0.f;
#pragma unroll
    for (int j = 0; j < 4; ++j) { unpack8(in.yv[j], y[j]);
#pragma unroll
        for (int e = 0; e < 8; ++e) ss += y[j][e] * y[j][e]; }
    ss = wave_sum(ss);
    const float ry = rsqrtf(ss * (1.0f / 2048.0f) + EPS);
    if (l == 0) {
        float s1 = 0.f; bf16_t* hrow = F.H + (size_t)row * DM + 8 * lane;
#pragma unroll
        for (int j = 0; j < 4; ++j) { const f32x4 ga = *(const f32x4*)(pg + 512 * j), gb = *(const f32x4*)(pg + 512 * j + 4);
#pragma unroll
            for (int e = 0; e < 4; ++e) { y[j][e] = in.xv[j][0][e] + y[j][e] * ry * ga[e]; y[j][4 + e] = in.xv[j][1][e] + y[j][4 + e] * ry * gb[e]; }
#pragma unroll
            for (int e = 0; e < 8; ++e) s1 += y[j][e] * y[j][e];
            *(u32x4*)(hrow + 512 * j) = pack8(y[j]); }
        s1 = wave_sum(s1);
        if (lane == 0) F.RSTD[MT + row] = rsqrtf(s1 * (1.0f / 2048.0f) + EPS);
    } else {
        float* orow = F.out + (size_t)row * DM + 8 * lane;
#pragma unroll
        for (int j = 0; j < 4; ++j) { const f32x4 ga = *(const f32x4*)(pg + 512 * j), gb = *(const f32x4*)(pg + 512 * j + 4); float xf[8]; unpack8(in.xb[j], xf);
#pragma unroll
            for (int e = 0; e < 4; ++e) { y[j][e] = xf[e] + y[j][e] * ry * ga[e]; y[j][4 + e] = xf[4 + e] + y[j][4 + e] * ry * gb[e]; }
            __builtin_nontemporal_store((f32x4){y[j][0], y[j][1], y[j][2], y[j][3]}, (f32x4*)(orow + 512 * j)); __builtin_nontemporal_store((f32x4){y[j][4], y[j][5], y[j][6], y[j][7]}, (f32x4*)(orow + 512 * j + 4)); }
    }
}
__device__ __forceinline__ void norm_rows4(int l, int row0) { LOCAL_FRAME;
#pragma unroll 1
    for (int k = 0; k < 4; k += 2) { NormRowIn a, b; norm_row_load(a, F, l, row0 + k); norm_row_load(b, F, l, row0 + k + 1);
        norm_row_finish(a, F, l, row0 + k); norm_row_finish(b, F, l, row0 + k + 1); } }

constexpr int Q2_G = 40, Q2_AT = Q2_G + 256, Q2_SG = Q2_AT + 256, Q2_SA = Q2_SG + 64, Q2_SS = Q2_SA + 16, Q2_SP = Q2_SS + 8, Q2_PO = Q2_SP + 256;
__device__ __forceinline__ void slot2(int l, LAS unsigned char* L, LAS unsigned char* ring) {
    int t_ = threadIdx.x; asm volatile("" : "+v"(t_)); const int wave = __builtin_amdgcn_readfirstlane(t_ >> 6);
    unsigned* head = ctl_word(CW_Q + 64 * (2 * l));
    EV_T0();
#pragma unroll 1
    for (;;) {
        const int it = q_pop(head, L);
        if (it >= Q2_PO + (l == 0 ? TR_ITEMS : 0)) { if (l == 0) { EV_MAX(0); EV_MIN(1); } break; }
        if (it < Q2_G) {
            unsigned char* ws = (unsigned char*)kargs()->ws;
            pg8::Gemm g{(const bf16_t*)(ws + WS_H), (const bf16_t*)(ws + WS_WTIN) + (size_t)l * DIN * DM, MT, DIN, DM};
            OneUnit S; S.u.pm = 64 + it / 20; S.u.pn = it % 20;
            pg8::EpiIn E{l};
            pg8::gemm_phase<pg8::EpiIn, OneUnit, false, true>(ring, g, S, E);
            publish(ctl_word(CW_ZS + 64 * (2 * l + it / 20)));
            if (l == 0) { EV_MAX(2); EV_MIN(3); }
        }
#ifndef NO_SGU
        else if (it < Q2_AT) { const int u = it - Q2_G; sgu_unit(l, u >> 1, u & 1, ring); if (l == 0) EV_MAX(5); }
#endif
        else if (it < Q2_SG) { attn_unit(l, it - Q2_AT, ring); if (l == 0) EV_MAX(4); }
        else if (it < Q2_SA) { const int i = it - Q2_SG; dep_wait(ctl_word(CW_ZS + 64 * (2 * l + (i >> 5))), 20u); if (l == 0) EV_MIN(6); const int k = 8 * i + wave; samp_attn(l, k >> 2, k & 3, ring + wave * 9472); __syncthreads(); if (l == 0) EV_MAX(7); }
        else if (it < Q2_SS) { const int i = it - Q2_SA; dep_wait(ctl_word(CW_ZS + 64 * (2 * l + (i >> 3))), 20u); samp_sgu(l, 8 * i + wave); }
        else if (it < Q2_SP) { const int i = it - Q2_SS; dep_wait(ctl_word(CW_ZS + 64 * (2 * l + (i >> 2))), 20u); const int k = 8 * i + wave; pool_sample(l, k & 3, k >> 2); }
        else if (it < Q2_PO) { const int i = 8 * (it - Q2_SP) + wave; pool_prompt(l, i & 3, i >> 2, ring + wave * PL_WBYTES); }
        else { LOCAL_FRAME; transpose_item(F, 1, it - Q2_PO, ring); }
    }
}
constexpr int Q4_G = 16, Q4_P = Q4_G + 512, Q4_S = Q4_P + 16;
__device__ __forceinline__ void slot4(int l, LAS unsigned char* L, LAS unsigned char* ring) {
    int t_ = threadIdx.x; asm volatile("" : "+v"(t_)); const int wave = __builtin_amdgcn_readfirstlane(t_ >> 6);
    unsigned* head = ctl_word(CW_Q + 64 * (2 * l + 1));
#pragma unroll 1
    for (;;) {
        const int it = q_pop(head, L);
        if (it >= Q4_S) break;
        if (it < Q4_G) {
            unsigned char* ws = (unsigned char*)kargs()->ws;
            pg8::Gemm g{(const bf16_t*)(ws + WS_MIX), (const bf16_t*)(ws + WS_WTOUT) + (size_t)l * DM * DM, MT, DM, DM};
            OneUnit S; S.u.pm = 64 + it / 8; S.u.pn = it % 8;
            pg8::EpiOut E{};
            pg8::gemm_phase<pg8::EpiOut, OneUnit, false, true>(ring, g, S, E);
            publish(ctl_word(CW_YS + 64 * (2 * l + it / 8)));
        }
        else if (it < Q4_P) norm_rows4(l, 32 * (it - Q4_G) + 4 * wave);
        else { const int i = it - Q4_P; dep_wait(ctl_word(CW_YS + 64 * (2 * l + (i >> 3))), 8u); norm_rows4(l, MP + 32 * i + 4 * wave); }
    }
}

__device__ __forceinline__ void grid_barrier(LAS unsigned char* L) {
    XcdBarrier b; b.bar = (unsigned*)((unsigned char*)kargs()->ws + WS_CTL) + CW_BAR; b.x = xb_xcc_id(); b.st = (volatile LAS unsigned*)L + 8;
    xcd_barrier(b);
}
__global__ void __launch_bounds__(NTHREADS, 2) hymba_fwd(Args a_unused) {
    extern __shared__ __attribute__((aligned(16))) unsigned char lds[];
    LAS unsigned char* L = (LAS unsigned char*)lds;
    if (threadIdx.x < 256) ((LAS unsigned*)L)[threadIdx.x] = 0u;
    __syncthreads();
    (void)xcd_barrier_post((unsigned*)((unsigned char*)kargs()->ws + WS_CTL) + CW_BAR, (volatile LAS unsigned*)L + 8);
    LAS unsigned char* ring = L + RING_OFF;
    STAMP(0);
#ifndef NO_P0
    { Frame F; make_frame(F, kargs()); p0_prologue(F, ring); }
#endif
    grid_barrier(L);
    STAMP(1);
#pragma unroll 1
    for (int l = 0; l < 2; ++l) {
#ifndef NO_P1
        {
            KArgs ka = kargs(); unsigned char* ws = (unsigned char*)ka->ws;
            pg8::Gemm g{(const bf16_t*)(ws + WS_H), (const bf16_t*)(ws + WS_WTIN) + (size_t)l * DIN * DM, MP, DIN, DM}; pg8::StaticOrder S; S.init(MP, DIN, (int)gridDim.x, (int)blockIdx.x);
            pg8::EpiIn E{l};
            pg8::gemm_phase<pg8::EpiIn, pg8::StaticOrder, true, true>(ring, g, S, E);
        }
#endif
        grid_barrier(L);
        STAMP(2 + 4 * l);
#ifndef NO_P2
        slot2(l, L, ring);
#endif
        grid_barrier(L);
        STAMP(3 + 4 * l);
#ifndef NO_P3
        {
            KArgs ka = kargs(); unsigned char* ws = (unsigned char*)ka->ws;
            pg8::Gemm g{(const bf16_t*)(ws + WS_MIX), (const bf16_t*)(ws + WS_WTOUT) + (size_t)l * DM * DM, MP, DM, DM}; pg8::StaticOrder S; S.init(MP, DM, (int)gridDim.x, (int)blockIdx.x);
            pg8::EpiOut E{};
            pg8::gemm_phase<pg8::EpiOut, pg8::StaticOrder, true, true>(ring, g, S, E);
        }
#endif
        grid_barrier(L);
        STAMP(4 + 4 * l);
#ifndef NO_P4
        slot4(l, L, ring);
#endif
        if (l == 0) grid_barrier(L);
#if PROBE_SEL
        if (l == 1) __syncthreads();
#endif
        STAMP(5 + 4 * l);
    }
#if PROBE_SEL
    if (blockIdx.x == 0 && threadIdx.x == 0) {
#if PROBE_SEL >= 10
        unsigned ea = __hip_atomic_load(ctl_word(CW_EV + 64 * PEA), __ATOMIC_RELAXED, __HIP_MEMORY_SCOPE_AGENT), eb = __hip_atomic_load(ctl_word(CW_EV + 64 * PEB), __ATOMIC_RELAXED, __HIP_MEMORY_SCOPE_AGENT);
        if (PEA_MIN) ea = 0x40000000u - ea; if (PEB_MIN) eb = 0x40000000u - eb;
        unsigned long long da = (ea + 400) / 800, db = (eb + 400) / 800;
#else
        LAS unsigned long long* ts = (LAS unsigned long long*)(L + 256);
        unsigned long long da = (ts[PA1] - ts[PA0] + 400) / 800, db = (ts[PB1] - ts[PB0] + 400) / 800;
#endif
        if (da > 63) da = 63; if (db > 63) db = 63;
        const unsigned long long extra = (da + 64 * db) * 1600ull, t0 = __builtin_amdgcn_s_memrealtime();
        while (__builtin_amdgcn_s_memrealtime() - t0 < extra) __builtin_amdgcn_s_sleep(32);
    }
#endif
}

extern "C" void kernel_launch(void* const* d_in, const int* in_sizes, int n_in, void* d_out, int out_size, void* d_ws, size_t ws_size, hipStream_t stream) {
    static int grid = 0;
    if (grid == 0) {
        if (n_in != 16 || (size_t)out_size != O_END || ws_size < WS_END) { fprintf(stderr, "kernel_launch: unexpected shapes: n_in %d out %d ws %zu (need %zu)\n", n_in, out_size, ws_size, (size_t)WS_END); grid = -1; return; }
        int dev = 0, cus = 0, per_cu = 0;
        if (hipGetDevice(&dev) != hipSuccess || hipDeviceGetAttribute(&cus, hipDeviceAttributeMultiprocessorCount, dev) != hipSuccess) { fprintf(stderr, "kernel_launch: device query failed\n"); grid = -1; return; }
        if (hipFuncSetAttribute((const void*)hymba_fwd, hipFuncAttributeMaxDynamicSharedMemorySize, LDS_BYTES) != hipSuccess) { fprintf(stderr, "kernel_launch: hipFuncSetAttribute failed\n"); grid = -1; return; }
        if (hipOccupancyMaxActiveBlocksPerMultiprocessor(&per_cu, (const void*)hymba_fwd, NTHREADS, LDS_BYTES) != hipSuccess || per_cu < 1) { fprintf(stderr, "kernel_launch: occupancy query says %d blocks/CU\n", per_cu); (void)hipGetLastError(); grid = -1; return; }
        grid = cus;
    }
    if (grid < 0) return;
    (void)hipMemsetAsync((char*)d_ws + WS_CTL, 0, CTL_ZERO_BYTES, stream);
    Args a{};
    for (int i = 0; i < 16; ++i) a.in[i] = (const float*)d_in[i];
    a.out = (float*)d_out; a.ws = (unsigned char*)d_ws;
    void* params[] = {&a};
    hipError_t e = hipLaunchCooperativeKernel((const void*)hymba_fwd, dim3(grid), dim3(NTHREADS), params, LDS_BYTES, stream);
    if (e != hipSuccess) fprintf(stderr, "kernel_launch: cooperative launch failed: %s (grid %d)\n", hipGetErrorString(e), grid);
}
```

```cpp
#include <hip/hip_runtime.h>
#include <cstdio>
#include <cstdint>
#include <cmath>
namespace pg8 {
#define PG8_LAS __attribute__((address_space(3)))
typedef unsigned short bf16_t;
typedef short bf16x8 __attribute__((ext_vector_type(8)));
typedef float f32x4 __attribute__((ext_vector_type(4)));
typedef unsigned u32x4 __attribute__((ext_vector_type(4)));
constexpr int BM = 256, BK = 64, HALF = 128, HTB = HALF * BK * 2  , STAGE_BYTES = 8 * HTB, NXCD = 8, WGM = 8;

__host__ __device__ __forceinline__ int lds_byte(int r, int c) { const int st = (r >> 4) * 2 + (c >> 5), rr = r & 15, cc = c & 31, ob = rr * 64 + cc * 2; return st * 1024 + (ob ^ (((ob >> 9) & 1) << 5)); }
__host__ __device__ __forceinline__ void stage_rc(int b, int& R, int& C) { const int st = b / 1024, sb = b % 1024, swz = sb ^ (((sb >> 9) & 1) << 5); R = (st >> 1) * 16 + swz / 64; C = (st & 1) * 32 + (swz % 64) / 2; }
__host__ __device__ __forceinline__ int perm32(int rho) { const int n = rho >> 4, i = rho & 15; return 8 * (i >> 2) + 4 * n + (i & 3); }

struct Unit { int pm, pn; };
struct Gemm { const bf16_t* A; const bf16_t* Bt; int M, N, K; };

struct StaticOrder {
    int nM, nN, nwg, G, c;
    __host__ __device__ void init(int M, int N, int G_, int c_) { nM = M / BM; nN = N / BM; nwg = nM * nN; G = G_; c = c_; }
    __host__ __device__ bool next(int i, Unit& u) const {
        const long L = (long)i * G + c; if (L >= nwg) return false;
        int wgid = (int)L; { const int q = nwg / NXCD, r = nwg % NXCD, xcd = wgid % NXCD, off = wgid / NXCD; wgid = (xcd < r ? xcd * (q + 1) : r * (q + 1) + (xcd - r) * q) + off; }
        const int nig = WGM * nN, gid = wgid / nig, fm = gid * WGM, gsz = (nM - fm) < WGM ? (nM - fm) : WGM;
        u.pm = fm + ((wgid % nig) % gsz); u.pn = (wgid % nig) / gsz; return true;
    }
    __device__ __forceinline__ void a_ready(const Unit&) const {}
    __device__ __forceinline__ void done(const Unit&) const {}
};

constexpr int DM = 2048, MP = 16384, MS = 512, MT = MP + MS, DIN = 5120;
constexpr int ZW = 3584;
constexpr int Z_GA = 0, Z_XB = 1024, Z_GP = 1536, Z_U = 2048, Z_VS = 2560, Z_GS = 3072;
constexpr float LOG2E = 1.4426950408889634f, QSCALE = 0.125f * LOG2E, EPS = 1e-6f;

__device__ __forceinline__ unsigned cvt_pk_bf16(float lo, float hi) { unsigned r; asm("v_cvt_pk_bf16_f32 %0, %1, %2" : "=v"(r) : "v"(lo), "v"(hi)); return r; }
__device__ __forceinline__ float silu_f(float x) { return x * __builtin_amdgcn_rcpf(1.0f + __builtin_amdgcn_exp2f(-x * LOG2E)); }
__device__ __forceinline__ int vperm32(int x) { return ((x >> 2) & 1) * 16 + (x >> 3) * 4 + (x & 3); }

struct EpiPtrs { const __attribute__((address_space(1))) float* in[16]; __attribute__((address_space(1))) float* out; __attribute__((address_space(1))) unsigned char* ws; };
constexpr size_t EP_RSTD = (size_t)3 << 20, EP_ROPE = (size_t)1 << 20, EP_QC = (size_t)192 << 20, EP_KC = (size_t)225 << 20, EP_VTP = (size_t)233 << 20, EP_Z2 = (size_t)241 << 20, EP_Y = (size_t)357 << 20;
constexpr size_t EO_KP = 34603008, EO_VP = 35127296, EO_PP = 35651584, EO_KS = 35774464, EO_VS = 44163072, EO_PS = 52551680;
struct EpiIn {
    static constexpr bool PERM = true, AFTER_DRAIN = false;
    int l;
    __device__ __forceinline__ void operator()(const f32x4 (&acc)[2][2][4][2], const Unit& u, int wr, int wc, int fr, int fq) const {
        const __attribute__((address_space(4))) EpiPtrs* kp = (const __attribute__((address_space(4))) EpiPtrs*)__builtin_amdgcn_kernarg_segment_ptr(); asm volatile("" : "+s"(kp));
        unsigned char* ws = (unsigned char*)kp->ws; float* outp = (float*)kp->out;
        bf16_t* Qc = (bf16_t*)(ws + EP_QC); bf16_t* Kc = (bf16_t*)(ws + EP_KC); bf16_t* VTP = (bf16_t*)(ws + EP_VTP); bf16_t* Z2 = (bf16_t*)(ws + EP_Z2); const float* rope = (const float*)(ws + EP_ROPE);
        float* oKp = outp + EO_KP + (size_t)l * 262144; float* oVp = outp + EO_VP + (size_t)l * 262144; float* oPp = outp + EO_PP + (size_t)l * 61440;
        float* oKs = outp + EO_KS + (size_t)l * 4194304; float* oVs = outp + EO_VS + (size_t)l * 4194304; float* oPs = outp + EO_PS + (size_t)l * 983040;
        const int pn = u.pn;
        const int row0 = u.pm * 256 + wr * 64 + fr;
        const int cw = wc * 32 + 8 * fq;
        if (pn < 5) {
#pragma unroll
            for (int ai = 0; ai < 2; ++ai)
#pragma unroll
                for (int m = 0; m < 4; ++m) {
                    const int row = row0 + ai * 128 + m * 16;
                    const bool smp = row >= MP;
                    const int tpos = smp ? 2048 + (row & 3) : (row & 2047);
                    const float* rp = rope + tpos * 64;
#pragma unroll
                    for (int bj = 0; bj < 2; ++bj) {
                        const int c = pn * 256 + bj * 128 + cw;
                        const int i0 = (c & 63) >> 1;
                        const f32x4 cs = *(const f32x4*)(rp + i0), sn = *(const f32x4*)(rp + 32 + i0);
                        const f32x4 v0 = acc[ai][bj][m][0], v1 = acc[ai][bj][m][1];
                        f32x4 o1, o2;
                        o1[0] = v0[0] * cs[0] - v0[1] * sn[0]; o2[0] = v0[1] * cs[0] + v0[0] * sn[0];
                        o1[1] = v0[2] * cs[1] - v0[3] * sn[1]; o2[1] = v0[3] * cs[1] + v0[2] * sn[1];
                        o1[2] = v1[0] * cs[2] - v1[1] * sn[2]; o2[2] = v1[1] * cs[2] + v1[0] * sn[2];
                        o1[3] = v1[2] * cs[3] - v1[3] * sn[3]; o2[3] = v1[3] * cs[3] + v1[2] * sn[3];
                        if (pn < 4) {
                            o1 = o1 * QSCALE; o2 = o2 * QSCALE;
                            u32x4 w; w.x = cvt_pk_bf16(o1[0], o2[0]); w.y = cvt_pk_bf16(o1[1], o2[1]); w.z = cvt_pk_bf16(o1[2], o2[2]); w.w = cvt_pk_bf16(o1[3], o2[3]);
                            *(u32x4*)(Qc + (size_t)row * 1024 + c) = w;
                        } else {
                            const int kvh = (c - 1024) >> 6;
                            if (!smp) {
                                const int b = row >> 11, t = row & 2047;
                                u32x4 w; w.x = cvt_pk_bf16(o1[0], o2[0]); w.y = cvt_pk_bf16(o1[1], o2[1]); w.z = cvt_pk_bf16(o1[2], o2[2]); w.w = cvt_pk_bf16(o1[3], o2[3]);
                                *(u32x4*)(Kc + ((size_t)((b * 4 + kvh) * 2048 + t)) * 64 + (c & 63)) = w;
                                if (t >= 1920) { float* o = oKp + ((size_t)((b * 128 + t - 1920) * 4 + kvh)) * 64 + i0; *(f32x4*)o = o1; *(f32x4*)(o + 32) = o2; }
                            } else {
                                const int bd = (row - MP) >> 2, tt = row & 3;
                                float* o = oKs + ((size_t)((bd * 128 + 124 + tt) * 4 + kvh)) * 64 + i0; *(f32x4*)o = o1; *(f32x4*)(o + 32) = o2;
                            }
                        }
                    }
                }
        } else if (pn == 5) {
#pragma unroll
            for (int ai = 0; ai < 2; ++ai)
#pragma unroll
                for (int m = 0; m < 4; ++m) {
                    const int row = row0 + ai * 128 + m * 16;
                    const bool smp = row >= MP;
#pragma unroll
                    for (int bj = 0; bj < 2; ++bj) {
                        const int cv = bj * 128 + cw;
                        const int kvh = cv >> 6, d0 = cv & 63;
                        const f32x4 v0 = acc[ai][bj][m][0], v1 = acc[ai][bj][m][1];
                        if (!smp) {
                            const int b = row >> 11, t = row & 2047;
                            bf16_t* vp = VTP + ((size_t)((b * 4 + kvh) * 64 + (t >> 5))) * 2048 + d0 * 32 + vperm32(t & 31);
                            const unsigned w0 = cvt_pk_bf16(v0[0], v0[1]), w1 = cvt_pk_bf16(v0[2], v0[3]), w2 = cvt_pk_bf16(v1[0], v1[1]), w3 = cvt_pk_bf16(v1[2], v1[3]);
                            vp[0] = (bf16_t)(w0 & 0xffffu); vp[32] = (bf16_t)(w0 >> 16); vp[64] = (bf16_t)(w1 & 0xffffu); vp[96] = (bf16_t)(w1 >> 16);
                            vp[128] = (bf16_t)(w2 & 0xffffu); vp[160] = (bf16_t)(w2 >> 16); vp[192] = (bf16_t)(w3 & 0xffffu); vp[224] = (bf16_t)(w3 >> 16);
                            if (t >= 1920) { float* o = oVp + ((size_t)((b * 128 + t - 1920) * 4 + kvh)) * 64 + d0; *(f32x4*)o = v0; *(f32x4*)(o + 4) = v1; }
                        } else {
                            const int bd = (row - MP) >> 2, tt = row & 3;
                            float* o = oVs + ((size_t)((bd * 128 + 124 + tt) * 4 + kvh)) * 64 + d0; *(f32x4*)o = v0; *(f32x4*)(o + 4) = v1;
                        }
                    }
                }
        } else {
            const bool gate = (pn < 10) || (pn == 12) || (pn == 13) || (pn >= 18);
            const bool isxb = (pn == 10) || (pn == 11);
#pragma unroll
            for (int ai = 0; ai < 2; ++ai)
#pragma unroll
                for (int m = 0; m < 4; ++m) {
                    const int row = row0 + ai * 128 + m * 16;
                    const bool smp = row >= MP;
#pragma unroll
                    for (int bj = 0; bj < 2; ++bj) {
                        const int c = pn * 256 + bj * 128 + cw;
                        f32x4 v0 = acc[ai][bj][m][0], v1 = acc[ai][bj][m][1];
                        if (isxb) {
                            const int cx = c - 2560;
                            if (!smp) { const int t = row & 2047; if (t >= 2033) { const int b = row >> 11; float* o = oPp + ((size_t)(b * 15 + t - 2033)) * 512 + cx; *(f32x4*)o = v0; *(f32x4*)(o + 4) = v1; } }
                            else { const int bd = (row - MP) >> 2, tt = row & 3; float* o = oPs + ((size_t)(bd * 15 + 11 + tt)) * 512 + cx; *(f32x4*)o = v0; *(f32x4*)(o + 4) = v1; }
                        }
                        if (gate) {
#pragma unroll
                            for (int j = 0; j < 4; ++j) { v0[j] = silu_f(v0[j]); v1[j] = silu_f(v1[j]); }
                        }
                        u32x4 w; w.x = cvt_pk_bf16(v0[0], v0[1]); w.y = cvt_pk_bf16(v0[2], v0[3]); w.z = cvt_pk_bf16(v1[0], v1[1]); w.w = cvt_pk_bf16(v1[2], v1[3]);
                        *(u32x4*)(Z2 + (size_t)row * ZW + (c - 1536)) = w;
                    }
                }
        }
    }
};

struct EpiOut {
    static constexpr bool PERM = true, AFTER_DRAIN = false;
    __device__ __forceinline__ void operator()(const f32x4 (&acc)[2][2][4][2], const Unit& u, int wr, int wc, int fr, int fq) const {
        const __attribute__((address_space(4))) EpiPtrs* kp = (const __attribute__((address_space(4))) EpiPtrs*)__builtin_amdgcn_kernarg_segment_ptr(); asm volatile("" : "+s"(kp));
        bf16_t* C = (bf16_t*)((unsigned char*)kp->ws + EP_Y);
        const int row0 = u.pm * BM + wr * 64 + fr, col0 = u.pn * BM + wc * 32 + 8 * fq;
#pragma unroll
        for (int ai = 0; ai < 2; ++ai)
#pragma unroll
            for (int m = 0; m < 4; ++m) { bf16_t* rowp = C + (size_t)(row0 + ai * HALF + m * 16) * DM + col0;
#pragma unroll
                for (int bj = 0; bj < 2; ++bj) { const f32x4 v0 = acc[ai][bj][m][0], v1 = acc[ai][bj][m][1];
                    u32x4 w; w.x = cvt_pk_bf16(v0[0], v0[1]); w.y = cvt_pk_bf16(v0[2], v0[3]); w.z = cvt_pk_bf16(v1[0], v1[1]); w.w = cvt_pk_bf16(v1[2], v1[3]);
                    *(u32x4*)(rowp + bj * HALF) = w; } }
    }
};
template <class Epi, class Sched, bool ALIGN_EPI = false, bool SP2 = false>
__device__ __forceinline__ void gemm_phase(PG8_LAS unsigned char* lds, const Gemm g, const Sched& S, const Epi& E) {
    int tid_ = threadIdx.x; asm volatile("" : "+v"(tid_));
    const int tid = tid_, wid = __builtin_amdgcn_readfirstlane(tid >> 6), lane = tid & 63, wr = wid >> 2, wc = wid & 3, fr = lane & 15, fq = lane >> 4;
    const int K = g.K, nt = K / BK;
    unsigned voffA[2], voffB[2];
#pragma unroll
    for (int i = 0; i < 2; ++i) { int R, C; stage_rc(tid * 16 + i * 8192, R, C); const int Rb = Epi::PERM ? ((R & ~31) + perm32(R & 31)) : R;
        voffA[i] = (unsigned)(R * K + C) * 2u; voffB[i] = (unsigned)(Rb * K + C) * 2u; }
    const size_t kstep = (size_t)(BK * 2);
    const size_t hstep = (size_t)HALF * K * 2;
    const size_t tstep = 2 * hstep;
    const unsigned ldsw = (unsigned)wid * 1024u;
    const int aoff = lds_byte(wr * 64 + fr, fq * 8), boff = lds_byte(wc * 32 + fr, fq * 8);
#define PG8_SA(b, h) (((b) * 2 + (h)) * HTB)
#define PG8_SB(b, h) ((4 + (b) * 2 + (h)) * HTB)
#define PG8_STAGE(bufoff, gbase, voff) do { _Pragma("unroll") for (int _i = 0; _i < 2; ++_i) \
        __builtin_amdgcn_global_load_lds((const unsigned*)((const char*)(gbase) + (voff)[_i]), (PG8_LAS unsigned*)(lds + (bufoff) + ldsw + _i * 8192), 16, 0, 0); } while (0)
#define PG8_LDA(dst, b, h) do { _Pragma("unroll") for (int m = 0; m < 4; ++m) _Pragma("unroll") for (int k = 0; k < 2; ++k) dst[m][k] = *(const PG8_LAS bf16x8*)(lds + PG8_SA(b, h) + aoff + m * 2048 + k * 1024); } while (0)
#define PG8_LDB(dst, b, h) do { _Pragma("unroll") for (int n = 0; n < 2; ++n) _Pragma("unroll") for (int k = 0; k < 2; ++k) dst[n][k] = *(const PG8_LAS bf16x8*)(lds + PG8_SB(b, h) + boff + n * 2048 + k * 1024); } while (0)
#define PG8_MMA(ai, bj, At, Bt) do { __builtin_amdgcn_s_setprio(1); _Pragma("unroll") for (int m = 0; m < 4; ++m) _Pragma("unroll") for (int n = 0; n < 2; ++n) _Pragma("unroll") for (int k = 0; k < 2; ++k) \
        acc[ai][bj][m][n] = __builtin_amdgcn_mfma_f32_16x16x32_bf16(Bt[n][k], At[m][k], acc[ai][bj][m][n], 0, 0, 0); __builtin_amdgcn_s_setprio(0); } while (0)
#define PG8_WAIT_V(n) asm volatile("s_waitcnt vmcnt(" #n ")" ::: "memory")
#define PG8_WAIT_L(n) asm volatile("s_waitcnt lgkmcnt(" #n ")" ::: "memory")
#define PG8_BAR __builtin_amdgcn_s_barrier()
#define PG8_SCHED __builtin_amdgcn_sched_barrier(0)
    Unit cur, nxt; int ui = 0;
    if (!S.next(0, cur)) return;
    f32x4 acc[2][2][4][2];
#pragma unroll
    for (int a = 0; a < 2; ++a)
#pragma unroll
        for (int b = 0; b < 2; ++b)
#pragma unroll
            for (int m = 0; m < 4; ++m)
#pragma unroll
                for (int n = 0; n < 2; ++n) acc[a][b][m][n] = (f32x4){0.f, 0.f, 0.f, 0.f};
    bf16x8 At[4][2], B0[2][2], B1[2][2];
    const char* cA = (const char*)g.A + (size_t)cur.pm * tstep; const char* cB = (const char*)g.Bt + (size_t)cur.pn * tstep;
    S.a_ready(cur);
    if constexpr (SP2) {
        PG8_STAGE(PG8_SB(0, 0), cB, voffB); PG8_STAGE(PG8_SB(0, 1), cB + hstep, voffB); PG8_STAGE(PG8_SA(0, 0), cA, voffA); PG8_STAGE(PG8_SA(0, 1), cA + hstep, voffA);
        if (wr == 1) PG8_BAR;
        PG8_WAIT_V(2); PG8_BAR;
        PG8_STAGE(PG8_SB(1, 0), cB + kstep, voffB); PG8_STAGE(PG8_SA(1, 0), cA + kstep, voffA); PG8_STAGE(PG8_SB(1, 1), cB + hstep + kstep, voffB);
        PG8_WAIT_V(6); PG8_BAR;
    } else {
        PG8_STAGE(PG8_SB(0, 0), cB, voffB); PG8_STAGE(PG8_SA(0, 0), cA, voffA); PG8_STAGE(PG8_SB(0, 1), cB + hstep, voffB); PG8_STAGE(PG8_SA(0, 1), cA + hstep, voffA);
        if (wr == 1) PG8_BAR;
        PG8_WAIT_V(4); PG8_BAR;
        PG8_STAGE(PG8_SB(1, 0), cB + kstep, voffB); PG8_STAGE(PG8_SA(1, 0), cA + kstep, voffA); PG8_STAGE(PG8_SB(1, 1), cB + hstep + kstep, voffB);
        PG8_WAIT_V(6); PG8_BAR;
    }
    for (;;) {
        const bool has_next = S.next(ui + 1, nxt);
        const char* nA = has_next ? (const char*)g.A + (size_t)nxt.pm * tstep : cA; const char* nB = has_next ? (const char*)g.Bt + (size_t)nxt.pn * tstep : cB;
        for (int t = 0; t < nt; t += 2) {
            const bool last = (t == nt - 2);
            const char* a1 = cA + (size_t)(t + 1) * kstep;
            const char* a2 = last ? nA : cA + (size_t)(t + 2) * kstep; const char* b2 = last ? nB : cB + (size_t)(t + 2) * kstep;
            const char* a3 = a2 + kstep; const char* b3 = b2 + kstep;
            if (last && has_next) S.a_ready(nxt);
            if constexpr (SP2) {
            PG8_LDB(B0, 0, 0); PG8_LDB(B1, 0, 1); PG8_SCHED; PG8_LDA(At, 0, 0); PG8_STAGE(PG8_SA(1, 1), a1 + hstep, voffA);
            PG8_WAIT_V(8); PG8_WAIT_L(0); PG8_BAR; PG8_MMA(0, 0, At, B0); PG8_MMA(0, 1, At, B1); PG8_BAR; PG8_SCHED;
            PG8_LDA(At, 0, 1); PG8_STAGE(PG8_SB(0, 0), b2, voffB); PG8_STAGE(PG8_SB(0, 1), b2 + hstep, voffB); PG8_STAGE(PG8_SA(0, 0), a2, voffA);
            PG8_WAIT_V(8); PG8_WAIT_L(0); PG8_BAR; PG8_MMA(1, 0, At, B0); PG8_MMA(1, 1, At, B1); PG8_BAR; PG8_SCHED;
            PG8_LDB(B0, 1, 0); PG8_LDB(B1, 1, 1); PG8_SCHED; PG8_LDA(At, 1, 0); PG8_STAGE(PG8_SA(0, 1), a2 + hstep, voffA);
            PG8_WAIT_V(8); PG8_WAIT_L(0); PG8_BAR; PG8_MMA(0, 0, At, B0); PG8_MMA(0, 1, At, B1); PG8_BAR; PG8_SCHED;
            PG8_LDA(At, 1, 1); PG8_STAGE(PG8_SB(1, 0), b3, voffB); PG8_STAGE(PG8_SB(1, 1), b3 + hstep, voffB); PG8_STAGE(PG8_SA(1, 0), a3, voffA);
            PG8_WAIT_V(8); PG8_WAIT_L(0); PG8_BAR; PG8_MMA(1, 0, At, B0); PG8_MMA(1, 1, At, B1); PG8_BAR; PG8_SCHED;
            } else {
            PG8_LDB(B0, 0, 0); PG8_SCHED; PG8_LDA(At, 0, 0); PG8_STAGE(PG8_SA(1, 1), a1 + hstep, voffA);
            PG8_WAIT_L(8); PG8_BAR; PG8_WAIT_L(0); PG8_MMA(0, 0, At, B0); PG8_BAR; PG8_SCHED;
            PG8_LDB(B1, 0, 1); PG8_STAGE(PG8_SB(0, 0), b2, voffB);
            PG8_BAR; PG8_WAIT_L(0); PG8_MMA(0, 1, At, B1); PG8_BAR;
            PG8_LDA(At, 0, 1); PG8_STAGE(PG8_SA(0, 0), a2, voffA);
            PG8_BAR; PG8_WAIT_L(0); PG8_MMA(1, 0, At, B0); PG8_BAR; PG8_SCHED;
            PG8_STAGE(PG8_SB(0, 1), b2 + hstep, voffB);
            PG8_WAIT_V(6); PG8_BAR; PG8_MMA(1, 1, At, B1); PG8_BAR;
            PG8_LDB(B0, 1, 0); PG8_SCHED; PG8_LDA(At, 1, 0); PG8_STAGE(PG8_SA(0, 1), a2 + hstep, voffA);
            PG8_WAIT_L(8); PG8_BAR; PG8_WAIT_L(0); PG8_MMA(0, 0, At, B0); PG8_BAR; PG8_SCHED;
            PG8_LDB(B1, 1, 1); PG8_STAGE(PG8_SB(1, 0), b3, voffB);
            PG8_BAR; PG8_WAIT_L(0); PG8_MMA(0, 1, At, B1); PG8_BAR;
            PG8_LDA(At, 1, 1); PG8_STAGE(PG8_SA(1, 0), a3, voffA);
            PG8_BAR; PG8_WAIT_L(0); PG8_MMA(1, 0, At, B0); PG8_BAR; PG8_SCHED;
            PG8_STAGE(PG8_SB(1, 1), b3 + hstep, voffB);
            PG8_WAIT_V(6); PG8_BAR; PG8_MMA(1, 1, At, B1); PG8_BAR;
            }
        }
        if constexpr (ALIGN_EPI) { if (wr == 0) PG8_BAR; }
        if constexpr (!Epi::AFTER_DRAIN) { E(acc, cur, wr, wc, fr, fq); S.done(cur); }
        if (!has_next) break;
#pragma unroll
        for (int a = 0; a < 2; ++a)
#pragma unroll
            for (int b = 0; b < 2; ++b)
#pragma unroll
                for (int m = 0; m < 4; ++m)
#pragma unroll
                    for (int n = 0; n < 2; ++n) acc[a][b][m][n] = (f32x4){0.f, 0.f, 0.f, 0.f};
        cur = nxt; cA = nA; cB = nB; ++ui;
        if constexpr (ALIGN_EPI) { if (wr == 1) PG8_BAR; }
    }
    PG8_WAIT_V(0);
    if constexpr (!ALIGN_EPI) { if (wr == 0) PG8_BAR; }
    PG8_BAR;
    if constexpr (Epi::AFTER_DRAIN) { E.fused(acc, cur, wr, wc, fr, fq, lds, wid, lane); S.done(cur); }
#undef PG8_SA
#undef PG8_SB
#undef PG8_STAGE
#undef PG8_LDA
#undef PG8_LDB
#undef PG8_MMA
#undef PG8_WAIT_V
#undef PG8_WAIT_L
#undef PG8_BAR
#undef PG8_SCHED
}
}
#define GAS __attribute__((address_space(1)))
#define LAS __attribute__((address_space(3)))
typedef GAS unsigned gu32;
typedef GAS unsigned long long gu64;
#define RLX_AGENT __ATOMIC_RELAXED, __HIP_MEMORY_SCOPE_AGENT
#define VM_WAIT() asm volatile("s_waitcnt vmcnt(0)" ::: "memory")
__device__ __forceinline__ unsigned long long rt() { return __builtin_amdgcn_s_memrealtime(); }
__device__ __forceinline__ unsigned f2bf(float f) { unsigned u = __builtin_bit_cast(unsigned, f); return (u + 0x7fffu + ((u >> 16) & 1u)) >> 16; }
__device__ __forceinline__ unsigned pk2(float lo, float hi) { return f2bf(lo) | (f2bf(hi) << 16); }

#define XB_TMO      128
#define XB_XCNT(j)  (256  + 64 * (j))
#define XB_XSUB(j)  (1280 + 64 * (j))
#define XB_XGEN(j)  (2304 + 64 * (j))
#define XB_TOP      3328
#define XB_TOPGEN   3392
#define XCD_BAR_WORDS 3456
#define XB_SPIN_CAP (1u << 18)

__device__ __forceinline__ unsigned xb_ld(unsigned* p)              { return __hip_atomic_load(p, __ATOMIC_RELAXED, __HIP_MEMORY_SCOPE_AGENT); }
__device__ __forceinline__ unsigned xb_add(unsigned* p, unsigned v) { return __hip_atomic_fetch_add(p, v, __ATOMIC_RELAXED, __HIP_MEMORY_SCOPE_AGENT); }
__device__ __forceinline__ unsigned xb_xcc_id() { return (unsigned)__builtin_amdgcn_s_getreg((3 << 11) | 20) & 0xFu; }
#define XB_SPIN(cond, bar) do { unsigned _sp = 0; while (cond) { __builtin_amdgcn_s_sleep(1); \
    if ((++_sp & 255u) == 0u) { if (xb_ld(&(bar)[XB_TMO])) break; if (_sp > XB_SPIN_CAP) { atomicAdd(&(bar)[XB_TMO], 1u); break; } } } } while (0)

struct XcdBarrier {
    unsigned* bar; unsigned x;
    volatile LAS unsigned* st;
};

__device__ __forceinline__ XcdBarrier xcd_barrier_post(unsigned* bar, volatile LAS unsigned* st) {
    XcdBarrier b; b.bar = bar; b.x = xb_xcc_id(); b.st = st;
    if (threadIdx.x == 0) (void)xb_add(&bar[XB_XCNT(b.x)], 1u);
    return b;
}
__device__ __forceinline__ void xcd_barrier_complete(unsigned* bar, unsigned x, unsigned& nloc, unsigned& nx) {
    const unsigned G = gridDim.x * gridDim.y * gridDim.z;
    unsigned sum, cnt, mine, sp = 0u;
    for (;;) {
        sum = 0u; cnt = 0u; mine = 0u;
#pragma unroll
        for (unsigned j = 0; j < 16; ++j) { const unsigned c = xb_ld(&bar[XB_XCNT(j)]); sum += c; cnt += (c > 0u) ? 1u : 0u; mine = (j == x) ? c : mine; }
        if (sum == G) break;
        __builtin_amdgcn_s_sleep(1);
        if ((++sp & 255u) == 0u) { if (xb_ld(&bar[XB_TMO])) break; if (sp > XB_SPIN_CAP) { atomicAdd(&bar[XB_TMO], 1u); break; } }
    }
    nloc = mine > 0u ? mine : 1u; nx = cnt > 0u ? cnt : 1u;
}

__device__ __forceinline__ void xcd_barrier(const XcdBarrier& b) {
    asm volatile("s_waitcnt vmcnt(0)" ::: "memory");
    __syncthreads();
    if (threadIdx.x == 0) {
        unsigned* bar = b.bar;
        __builtin_amdgcn_s_waitcnt(0);
        unsigned nloc = b.st[0], nx = b.st[1];
        if (nloc == 0u) { xcd_barrier_complete(bar, b.x, nloc, nx); b.st[0] = nloc; b.st[1] = nx; }
        const unsigned old = xb_add(&bar[XB_XSUB(b.x)], 1u);
        const unsigned gen = old / nloc;
        if (old + 1u == (gen + 1u) * nloc) {
            __builtin_amdgcn_fence(__ATOMIC_RELEASE, "agent");
            asm volatile("s_waitcnt vmcnt(0)" ::: "memory");
            const unsigned og = xb_add(&bar[XB_TOP], 1u);
            const unsigned tg = og / nx;
            if (og + 1u == (tg + 1u) * nx) xb_add(&bar[XB_TOPGEN], 1u);
            else XB_SPIN(xb_ld(&bar[XB_TOPGEN]) == tg, bar);
            __builtin_amdgcn_fence(__ATOMIC_ACQUIRE, "agent");
            xb_add(&bar[XB_XGEN(b.x)], 1u);
            asm volatile("s_waitcnt vmcnt(0)" ::: "memory");
        } else {
            XB_SPIN(xb_ld(&bar[XB_XGEN(b.x)]) == gen, bar);
            __builtin_amdgcn_fence(__ATOMIC_ACQUIRE, "agent");
            asm volatile("s_waitcnt vmcnt(0)" ::: "memory");
        }
    }
    __syncthreads();
}

using pg8::bf16_t; using pg8::bf16x8; using pg8::f32x4; using pg8::u32x4;
using pg8::DM; using pg8::MP; using pg8::MS; using pg8::MT; using pg8::DIN; using pg8::ZW;
using pg8::Z_GA; using pg8::Z_XB; using pg8::Z_GP; using pg8::Z_U; using pg8::Z_VS; using pg8::Z_GS; using pg8::LOG2E; using pg8::EPS;
typedef float f32x16 __attribute__((ext_vector_type(16)));
typedef unsigned u32x2 __attribute__((ext_vector_type(2)));
typedef short v4i16_t __attribute__((ext_vector_type(4)));

constexpr int NWAVES = 8, NTHREADS = 512;
constexpr int LDS_BYTES = 147456;
constexpr int RING_OFF = 1024;

constexpr size_t O_YP = 0, O_YS = 33554432, O_KP = 34603008, O_VP = 35127296, O_PP = 35651584, O_KS = 35774464, O_VS = 44163072, O_PS = 52551680, O_CV = 54517760, O_END = 55042048;
constexpr size_t LS_KP = 262144, LS_PP = 61440, LS_KS = 4194304, LS_PS = 983040, LS_CV = 262144;
constexpr size_t MiB = 1u << 20;
constexpr size_t WS_CTL = 0, CTL_ZERO_BYTES = 65536;
constexpr size_t WS_ROPE = 1 * MiB, WS_SGUW = 2 * MiB, WS_RSW = 2 * MiB + 256 * 1024, WS_PWT = 2 * MiB + 512 * 1024, WS_RSTD = 3 * MiB;
constexpr size_t WS_WTIN = 4 * MiB, WS_WTOUT = 44 * MiB, WS_H = 60 * MiB, WS_MIX = 126 * MiB, WS_QC = 192 * MiB, WS_KC = 225 * MiB, WS_VTP = 233 * MiB, WS_Z2 = 241 * MiB, WS_Y = 357 * MiB, WS_END = 489 * MiB;
constexpr int CW_BAR = 1024;

__constant__ double ROPE_INV[32] = {1.0, 0.7498942093324559, 0.5623413251903491, 0.4216965034285822, 0.31622776601683794, 0.23713737056616552, 0.1778279410038923, 0.1333521432163324, 0.1, 0.07498942093324558, 0.05623413251903491, 0.042169650342858224, 0.03162277660168379, 0.023713737056616554, 0.01778279410038923, 0.01333521432163324, 0.01, 0.007498942093324558, 0.005623413251903491, 0.004216965034285823, 0.0031622776601683794, 0.0023713737056616554, 0.0017782794100389228, 0.001333521432163324, 0.001, 0.0007498942093324559, 0.0005623413251903491, 0.00042169650342858224, 0.00031622776601683794, 0.00023713737056616554, 0.00017782794100389227, 0.0001333521432163324};

struct Args { const float* in[16]; float* out; unsigned char* ws; };

struct Frame {
    int tid, lane, wave, bid, G;
    const float *xp, *xs, *cache_k, *cache_v, *state_pool, *w_in, *w_out, *norm_pre, *norm_post, *sinks, *pool_w, *pool_scale, *ln_g, *ln_b, *sgu_w, *sgu_b;
    float* out;
    float* rope; float* RSW; float* RSTD; bf16_t *SGUW, *PWT, *WTIN, *WTOUT, *H, *MIX, *Qc, *Kc, *VTP, *Z2, *Yb;
};

__device__ __forceinline__ float wave_sum(float v) {
#pragma unroll
    for (int o = 1; o < 64; o <<= 1) v += __shfl_xor(v, o);
    return v;
}
__device__ __forceinline__ float wave_max(float v) {
#pragma unroll
    for (int o = 1; o < 64; o <<= 1) v = fmaxf(v, __shfl_xor(v, o));
    return v;
}
__device__ __forceinline__ float bflo(unsigned w) { return __uint_as_float(w << 16); }
__device__ __forceinline__ float bfhi(unsigned w) { return __uint_as_float(w & 0xffff0000u); }
__device__ __forceinline__ void unpack8(const u32x4 w, float (&f)[8]) { f[0] = bflo(w.x); f[1] = bfhi(w.x); f[2] = bflo(w.y); f[3] = bfhi(w.y); f[4] = bflo(w.z); f[5] = bfhi(w.z); f[6] = bflo(w.w); f[7] = bfhi(w.w); }
__device__ __forceinline__ void unpack4(const u32x2 w, float (&f)[4]) { f[0] = bflo(w.x); f[1] = bfhi(w.x); f[2] = bflo(w.y); f[3] = bfhi(w.y); }
__device__ __forceinline__ u32x4 pack8(const float (&f)[8]) { u32x4 w; w.x = pg8::cvt_pk_bf16(f[0], f[1]); w.y = pg8::cvt_pk_bf16(f[2], f[3]); w.z = pg8::cvt_pk_bf16(f[4], f[5]); w.w = pg8::cvt_pk_bf16(f[6], f[7]); return w; }
__device__ __forceinline__ int crow(int r, int hi) { return (r & 3) + 8 * (r >> 2) + 4 * hi; }
#define LDS_WAIT() asm volatile("s_waitcnt lgkmcnt(0)" ::: "memory")


struct ArgsG { const __attribute__((address_space(1))) float* in[16]; __attribute__((address_space(1))) float* out; __attribute__((address_space(1))) unsigned char* ws; };
typedef const __attribute__((address_space(4))) ArgsG* KArgs;
__device__ __forceinline__ KArgs kargs() { KArgs p = (KArgs)__builtin_amdgcn_kernarg_segment_ptr(); asm volatile("" : "+s"(p)); return p; }
__device__ __forceinline__ void make_frame(Frame& F, KArgs a) {
    { int t_ = threadIdx.x; asm volatile("" : "+v"(t_)); F.tid = t_; } F.lane = F.tid & 63; F.wave = __builtin_amdgcn_readfirstlane(F.tid >> 6); F.bid = blockIdx.x; F.G = gridDim.x;
    F.xp = (const float*)a->in[0]; F.xs = (const float*)a->in[1]; F.cache_k = (const float*)a->in[2]; F.cache_v = (const float*)a->in[3]; F.state_pool = (const float*)a->in[4]; F.w_in = (const float*)a->in[5]; F.w_out = (const float*)a->in[6]; F.norm_pre = (const float*)a->in[7]; F.norm_post = (const float*)a->in[8];
    F.sinks = (const float*)a->in[9]; F.pool_w = (const float*)a->in[10]; F.pool_scale = (const float*)a->in[11]; F.ln_g = (const float*)a->in[12]; F.ln_b = (const float*)a->in[13]; F.sgu_w = (const float*)a->in[14]; F.sgu_b = (const float*)a->in[15];
    F.out = (float*)a->out;
    unsigned char* ws = (unsigned char*)a->ws;
    F.rope = (float*)(ws + WS_ROPE); F.RSW = (float*)(ws + WS_RSW); F.RSTD = (float*)(ws + WS_RSTD); F.SGUW = (bf16_t*)(ws + WS_SGUW); F.PWT = (bf16_t*)(ws + WS_PWT); F.WTIN = (bf16_t*)(ws + WS_WTIN); F.WTOUT = (bf16_t*)(ws + WS_WTOUT);
    F.H = (bf16_t*)(ws + WS_H); F.MIX = (bf16_t*)(ws + WS_MIX); F.Qc = (bf16_t*)(ws + WS_QC); F.Kc = (bf16_t*)(ws + WS_KC); F.VTP = (bf16_t*)(ws + WS_VTP); F.Z2 = (bf16_t*)(ws + WS_Z2); F.Yb = (bf16_t*)(ws + WS_Y);
}

#define LOCAL_FRAME Frame F; make_frame(F, kargs())

constexpr int CW_Q = 8192;
constexpr int CW_ZS = 8192 + 64 * 8;
constexpr int CW_YS = 8192 + 64 * 16;
constexpr int CW_EV = 8192 + 64 * 32;
__device__ __forceinline__ unsigned* ctl_word(int idx) { return (unsigned*)((unsigned char*)kargs()->ws + WS_CTL) + idx; }
__device__ __forceinline__ int q_pop(unsigned* head, LAS unsigned char* L) {
    volatile LAS int* slot = (volatile LAS int*)(L + 64);
    __syncthreads();
    if (threadIdx.x == 0) *slot = (int)__hip_atomic_fetch_add(head, 1u, __ATOMIC_RELAXED, __HIP_MEMORY_SCOPE_AGENT);
    __syncthreads();
    return __builtin_amdgcn_readfirstlane(*slot);
}
__device__ __forceinline__ void publish(unsigned* ctr) {
    asm volatile("s_waitcnt vmcnt(0)" ::: "memory");
    __syncthreads();
    if (threadIdx.x == 0) { __builtin_amdgcn_fence(__ATOMIC_RELEASE, "agent"); asm volatile("s_waitcnt vmcnt(0)" ::: "memory");
        __hip_atomic_fetch_add(ctr, 1u, __ATOMIC_RELAXED, __HIP_MEMORY_SCOPE_AGENT); }
}
__device__ __forceinline__ void dep_wait(unsigned* ctr, unsigned need) {
    if (threadIdx.x == 0) {
        unsigned sp = 0;
        while (__hip_atomic_load(ctr, __ATOMIC_RELAXED, __HIP_MEMORY_SCOPE_AGENT) < need) { __builtin_amdgcn_s_sleep(16); if (++sp > (1u << 21)) break; }
        __builtin_amdgcn_fence(__ATOMIC_ACQUIRE, "agent"); asm volatile("s_waitcnt vmcnt(0)" ::: "memory");
    }
    __syncthreads();
}

#if PROBE_SEL >= 10
#define EV_T0() const unsigned long long ev_t0 = __builtin_amdgcn_s_memrealtime()
#define EV_MAX(k) do { if (threadIdx.x == 0) __hip_atomic_fetch_max(ctl_word(CW_EV + 64 * (k)), (unsigned)(__builtin_amdgcn_s_memrealtime() - ev_t0), __ATOMIC_RELAXED, __HIP_MEMORY_SCOPE_AGENT); } while (0)
#define EV_MIN(k) do { if (threadIdx.x == 0) __hip_atomic_fetch_max(ctl_word(CW_EV + 64 * (k)), 0x40000000u - (unsigned)(__builtin_amdgcn_s_memrealtime() - ev_t0), __ATOMIC_RELAXED, __HIP_MEMORY_SCOPE_AGENT); } while (0)
#else
#define EV_T0() do {} while (0)
#define EV_MAX(k) do {} while (0)
#define EV_MIN(k) do {} while (0)
#endif
struct OneUnit {
    pg8::Unit u;
    __device__ __forceinline__ bool next(int i, pg8::Unit& o) const { if (i) return false; o = u; return true; }
    __device__ __forceinline__ void a_ready(const pg8::Unit&) const {}
    __device__ __forceinline__ void done(const pg8::Unit&) const {}
};

#ifndef PROBE_SEL
#define PROBE_SEL 0
#endif
#if PROBE_SEL
#define STAMP(k) do { if (blockIdx.x == 0 && threadIdx.x == 0) ((LAS unsigned long long*)(L + 256))[k] = __builtin_amdgcn_s_memrealtime(); } while (0)
#define STAMP2(k) do { if (blockIdx.x == 0) { __syncthreads(); if (threadIdx.x == 0) ((LAS unsigned long long*)((LAS unsigned char*)ring - RING_OFF + 256))[k] = __builtin_amdgcn_s_memrealtime(); } } while (0)
#else
#define STAMP(k) do {} while (0)
#define STAMP2(k) do {} while (0)
#endif
#if PROBE_SEL == 1
#define PA0 0
#define PA1 1
#define PB0 1
#define PB1 2
#elif PROBE_SEL == 2
#define PA0 2
#define PA1 3
#define PB0 3
#define PB1 4
#elif PROBE_SEL == 3
#define PA0 4
#define PA1 5
#define PB0 8
#define PB1 9
#elif PROBE_SEL == 4
#define PA0 2
#define PA1 10
#define PB0 10
#define PB1 11
#elif PROBE_SEL == 5
#define PA0 11
#define PA1 12
#define PB0 12
#define PB1 13
#elif PROBE_SEL == 7
#define PA0 1
#define PA1 2
#define PB0 0
#define PB1 1
#elif PROBE_SEL == 8
#define PA0 3
#define PA1 4
#define PB0 2
#define PB1 3
#elif PROBE_SEL == 9
#define PA0 6
#define PA1 7
#define PB0 4
#define PB1 5
#elif PROBE_SEL == 6
#define PA0 5
#define PA1 6
#define PB0 7
#define PB1 8
#elif PROBE_SEL == 10
#define PEA 0
#define PEA_MIN 0
#define PEB 1
#define PEB_MIN 1
#elif PROBE_SEL == 11
#define PEA 2
#define PEA_MIN 0
#define PEB 3
#define PEB_MIN 1
#elif PROBE_SEL == 12
#define PEA 4
#define PEA_MIN 0
#define PEB 5
#define PEB_MIN 0
#elif PROBE_SEL == 14
#define PEA 8
#define PEA_MIN 0
#define PEB 9
#define PEB_MIN 0
#elif PROBE_SEL == 13
#define PEA 6
#define PEA_MIN 1
#define PEB 7
#define PEB_MIN 0
#endif

__device__ __forceinline__ void p0_transpose_blk(const float* W, int K, int N, bf16_t* WT, bool permqk, const float* kgain, LAS unsigned char* T, int item, int tid) {
    const int nblk = N >> 8, kb = item / nblk, nb = item - kb * nblk, k0 = kb * 128, n0 = nb * 256;
    const int n4 = tid & 63, kr = tid >> 6;
    f32x4 v[16];
#pragma unroll
    for (int i = 0; i < 16; ++i) v[i] = __builtin_nontemporal_load((const f32x4*)(W + (size_t)(k0 + 16 * kr + i) * N + n0 + 4 * n4));
    if (kgain) {
        const float* gp = kgain + k0 + 16 * kr;
#pragma unroll
        for (int i4 = 0; i4 < 4; ++i4) { const f32x4 gg = *(const f32x4*)(gp + 4 * i4);
#pragma unroll
            for (int j = 0; j < 4; ++j) v[4 * i4 + j] = v[4 * i4 + j] * gg[j]; }
    }
#pragma unroll
    for (int e = 0; e < 4; ++e) {
        u32x4 lo, hi;
        lo.x = pg8::cvt_pk_bf16(v[0][e], v[1][e]); lo.y = pg8::cvt_pk_bf16(v[2][e], v[3][e]); lo.z = pg8::cvt_pk_bf16(v[4][e], v[5][e]); lo.w = pg8::cvt_pk_bf16(v[6][e], v[7][e]);
        hi.x = pg8::cvt_pk_bf16(v[8][e], v[9][e]); hi.y = pg8::cvt_pk_bf16(v[10][e], v[11][e]); hi.z = pg8::cvt_pk_bf16(v[12][e], v[13][e]); hi.w = pg8::cvt_pk_bf16(v[14][e], v[15][e]);
        LAS unsigned char* p = T + (64 * e + n4) * 272 + 32 * kr;
        *(LAS u32x4*)p = lo; *(LAS u32x4*)(p + 16) = hi;
    }
    LDS_WAIT();
    __syncthreads();
    {
        const int rho = tid >> 1, half = tid & 1, n = n0 + 4 * (rho & 63) + (rho >> 6);
        int nrow = n;
        if (permqk && n < 1280) { const int p = n & 63; nrow = (n & ~63) + 2 * (p & 31) + (p >> 5); }
        const LAS unsigned char* src = T + rho * 272 + 128 * half;
        bf16_t* dst = WT + (size_t)nrow * K + k0 + 64 * half;
        u32x4 o[8];
#pragma unroll
        for (int c = 0; c < 8; ++c) o[c] = *(const LAS u32x4*)(src + 16 * c);
#pragma unroll
        for (int c = 0; c < 8; ++c) *(u32x4*)(dst + 8 * c) = o[c];
    }
    LDS_WAIT();
    __syncthreads();
}
__device__ __forceinline__ void prenorm_finish(const f32x4 (&v)[8], bf16_t* hrow, int lane) {
    float ss = 0.f;
#pragma unroll
    for (int j = 0; j < 8; ++j) ss += (v[j][0] * v[j][0] + v[j][1] * v[j][1]) + (v[j][2] * v[j][2] + v[j][3] * v[j][3]);
    ss = wave_sum(ss);
    const float r = rsqrtf(ss * (1.0f / 2048.0f) + EPS);
#pragma unroll
    for (int j = 0; j < 8; ++j) { const f32x4 o = v[j] * r; u32x2 w; w.x = pg8::cvt_pk_bf16(o[0], o[1]); w.y = pg8::cvt_pk_bf16(o[2], o[3]); *(u32x2*)(hrow + 4 * lane + 256 * j) = w; }
}
constexpr int TR_IN = 16 * 20, TR_OUT = 16 * 8, TR_ITEMS = TR_IN + TR_OUT;
__device__ __forceinline__ void transpose_item(const Frame& F, int l, int r, LAS unsigned char* ring) {
    if (r < TR_IN) p0_transpose_blk(F.w_in + (size_t)l * DM * DIN, DM, DIN, F.WTIN + (size_t)l * DIN * DM, true, F.norm_pre + l * DM, ring, r, F.tid);
    else p0_transpose_blk(F.w_out + (size_t)l * DM * DM, DM, DM, F.WTOUT + (size_t)l * DM * DM, false, nullptr, ring, r - TR_IN, F.tid);
}
__device__ __forceinline__ void p0_prologue(const Frame& F, LAS unsigned char* ring) {
    const int gw = F.bid * NWAVES + F.wave, NGW = F.G * NWAVES;
    EV_T0();
    for (int it = F.bid; it < TR_ITEMS; it += F.G) transpose_item(F, 0, it, ring);
    __syncthreads(); EV_MAX(8);
    for (int m = 2 * gw; m < MT; m += 2 * NGW) {
        const float* xa = m < MP ? F.xp + (size_t)m * DM : F.xs + (size_t)(m - MP) * DM; const float* xb = (m + 1) < MP ? F.xp + (size_t)(m + 1) * DM : F.xs + (size_t)(m + 1 - MP) * DM;
        f32x4 va[8], vb[8];
#pragma unroll
        for (int j = 0; j < 8; ++j) { va[j] = __builtin_nontemporal_load((const f32x4*)(xa + 4 * F.lane + 256 * j)); vb[j] = __builtin_nontemporal_load((const f32x4*)(xb + 4 * F.lane + 256 * j)); }
        prenorm_finish(va, F.H + (size_t)m * DM, F.lane); prenorm_finish(vb, F.H + (size_t)(m + 1) * DM, F.lane); }
    __syncthreads(); EV_MAX(9);
    const int gt = F.bid * NTHREADS + F.tid, NGT = F.G * NTHREADS;
    for (int e = gt; e < 2052 * 32; e += NGT) { const int tp = e >> 5, i = e & 31; const double pos = (double)(tp < 2048 ? tp : 8192 + (tp - 2048));
        const double rev = pos * ROPE_INV[i] * 0.15915494309189535; const float fr = (float)(rev - floor(rev));
        F.rope[tp * 64 + i] = __builtin_amdgcn_cosf(fr); F.rope[tp * 64 + 32 + i] = __builtin_amdgcn_sinf(fr); }
    for (int e = gt; e < 2 * 4 * 128 * 128; e += NGT) { const int s = e & 127, t = (e >> 7) & 127; const float w = F.sgu_w[e];
        F.SGUW[e] = (bf16_t)(pg8::cvt_pk_bf16(s <= t ? w : 0.f, 0.f) & 0xffffu); }
    for (int e = gt; e < 2 * 4 * 128; e += NGT) { const int t = e & 127; const float* wr = F.sgu_w + (size_t)e * 128; float acc = 0.f;
        for (int s2 = 0; s2 <= t; ++s2) acc += __uint_as_float(pg8::cvt_pk_bf16(wr[s2], 0.f) << 16);
        F.RSW[e] = acc; }
    for (int e = gt; e < 2 * 4 * 128 * 128; e += NGT) { const int c = e & 127, d = (e >> 7) & 127, lg = e >> 14;
        F.PWT[e] = (bf16_t)(pg8::cvt_pk_bf16(F.pool_w[((size_t)lg * 128 + c) * 128 + d], 0.f) & 0xffffu); }
}

constexpr int AT_K = 0, AT_V = 49152, AT_STG = 98304, AT_WSTRIDE = 4352;
__device__ __forceinline__ void attn_stage_kv(const Frame& F, int b, int kvh, int nbp, LAS unsigned char* ring) {
    const int tid = F.tid;
    const bf16_t* kg = F.Kc + ((size_t)(b * 4 + kvh) * 2048 + 256 * nbp - 128) * 64;
    const bf16_t* vg = F.VTP + ((size_t)(b * 4 + kvh) * 64 + 8 * nbp - 4) * 2048;
    u32x4 kv[6], vv[6];
#pragma unroll
    for (int i = 0; i < 6; ++i) { const int ch = tid + 512 * i, row0 = ch >> 3, c8 = ch & 7, row = (nbp > 0 || row0 >= 128) ? row0 : row0 + 128;
        kv[i] = __builtin_nontemporal_load((const u32x4*)(kg + row * 64 + c8 * 8)); }
#pragma unroll
    for (int i = 0; i < 6; ++i) { const int ch = tid + 512 * i, tile0 = ch >> 8, rem = ch & 255, d = rem >> 2, c4 = rem & 3, tile = (nbp > 0 || tile0 >= 4) ? tile0 : tile0 + 4;
        vv[i] = __builtin_nontemporal_load((const u32x4*)(vg + tile * 2048 + d * 32 + c4 * 8)); }
#pragma unroll
    for (int i = 0; i < 6; ++i) { const int ch = tid + 512 * i, row = ch >> 3, c8 = ch & 7;
        *(LAS u32x4*)(ring + AT_K + row * 128 + ((c8 ^ (row & 7)) << 4)) = kv[i]; }
#pragma unroll
    for (int i = 0; i < 6; ++i) { const int ch = tid + 512 * i, tile = ch >> 8, rem = ch & 255, d = rem >> 2, c4 = rem & 3;
        *(LAS u32x4*)(ring + AT_V + tile * 4096 + d * 64 + ((c4 ^ ((d >> 2) & 3)) << 4)) = vv[i]; }
}
__device__ __forceinline__ void attn_task(const Frame& F, int l, int b, int nbp, int head, int j, const bf16x8 (&qf)[4], LAS unsigned char* ring) {
    const int lane = F.lane, r = lane & 31, hh = lane >> 5;
    LAS unsigned char* wl = ring + AT_STG + F.wave * AT_WSTRIDE;
    LAS float* wsf = (LAS float*)wl; LAS bf16_t* stg = (LAS bf16_t*)(wl + 256);
    const size_t qrow0 = (size_t)b * 2048 + 256 * nbp + 32 * j;
    u32x4 gv[4];
#pragma unroll
    for (int i = 0; i < 4; ++i) gv[i] = __builtin_nontemporal_load((const u32x4*)(F.Z2 + (qrow0 + i * 8 + (lane >> 3)) * ZW + Z_GA + head * 64 + (lane & 7) * 8));
    const int cmin = (nbp > 0) ? 0 : (j < 4 ? 4 - j : 0);
    f32x16 S[5];
#pragma unroll
    for (int c = 0; c < 5; ++c) {
        f32x16 a;
#pragma unroll
        for (int i = 0; i < 16; ++i) a[i] = 0.f;
        if (c >= cmin) {
            LAS unsigned char* kp = ring + AT_K + (32 * (j + c) + r) * 128;
#pragma unroll
            for (int s = 0; s < 4; ++s) a = __builtin_amdgcn_mfma_f32_32x32x16_bf16(*(const LAS bf16x8*)(kp + (((2 * s + hh) ^ (r & 7)) << 4)), qf[s], a, 0, 0, 0);
        }
        S[c] = a;
    }
    const float NEG = -INFINITY;
#pragma unroll
    for (int i = 0; i < 16; ++i) { const int kap = crow(i, hh); if (kap <= r) S[0][i] = NEG; if (kap > r) S[4][i] = NEG; }
    const float sink2 = F.sinks[l * 16 + head] * LOG2E;
    float m = sink2;
#pragma unroll
    for (int c = 0; c < 5; ++c) if (c >= cmin) {
#pragma unroll
        for (int i = 0; i < 16; ++i) m = fmaxf(m, S[c][i]); }
    m = fmaxf(m, __shfl_xor(m, 32));
    float sum = 0.f;
#pragma unroll
    for (int c = 0; c < 5; ++c) if (c >= cmin) {
#pragma unroll
        for (int i = 0; i < 16; ++i) { const float p = __builtin_amdgcn_exp2f(S[c][i] - m); S[c][i] = p; sum += p; } }
    sum += __shfl_xor(sum, 32);
    const float inv = 1.0f / (sum + __builtin_amdgcn_exp2f(sink2 - m));
    f32x16 o[2];
#pragma unroll
    for (int i = 0; i < 16; ++i) { o[0][i] = 0.f; o[1][i] = 0.f; }
#pragma unroll
    for (int c = 0; c < 5; ++c) if (c >= cmin) {
        LAS unsigned char* vt = ring + AT_V + (j + c) * 4096 + r * 64;
#pragma unroll
        for (int s = 0; s < 2; ++s) {
            u32x4 pw; pw.x = pg8::cvt_pk_bf16(S[c][8 * s + 0], S[c][8 * s + 1]); pw.y = pg8::cvt_pk_bf16(S[c][8 * s + 2], S[c][8 * s + 3]);
            pw.z = pg8::cvt_pk_bf16(S[c][8 * s + 4], S[c][8 * s + 5]); pw.w = pg8::cvt_pk_bf16(S[c][8 * s + 6], S[c][8 * s + 7]);
            const bf16x8 pa = __builtin_bit_cast(bf16x8, pw);
            const int sw = (((2 * hh + s) ^ ((r >> 2) & 3)) << 4);
#pragma unroll
            for (int db = 0; db < 2; ++db) o[db] = __builtin_amdgcn_mfma_f32_32x32x16_bf16(pa, *(const LAS bf16x8*)(vt + db * 2048 + sw), o[db], 0, 0, 0);
        }
    }
    if (hh == 0) wsf[r] = inv;
    LDS_WAIT();
#pragma unroll
    for (int i = 0; i < 16; ++i) { const int q = crow(i, hh); const float rl = wsf[q];
        stg[q * 64 + r] = (bf16_t)(pg8::cvt_pk_bf16(o[0][i] * rl, 0.f) & 0xffffu);
        stg[q * 64 + 32 + r] = (bf16_t)(pg8::cvt_pk_bf16(o[1][i] * rl, 0.f) & 0xffffu); }
    LDS_WAIT();
#pragma unroll
    for (int i = 0; i < 4; ++i) { const int row = i * 8 + (lane >> 3), ch = lane & 7;
        const u32x4 ov = *(const LAS u32x4*)(stg + row * 64 + ch * 8);
        float of[8], gf[8]; unpack8(ov, of); unpack8(gv[i], gf);
#pragma unroll
        for (int jj = 0; jj < 8; ++jj) of[jj] *= gf[jj];
        *(u32x4*)(F.MIX + (qrow0 + row) * DM + head * 64 + ch * 8) = pack8(of); }
    LDS_WAIT();
}
__device__ __forceinline__ void attn_unit(int l, int a, LAS unsigned char* ring) {
    LOCAL_FRAME;
    const int kvh = a & 3, nbp = (a >> 2) & 7, b = a >> 5;
    const int lane = F.lane, r = lane & 31, hh = lane >> 5;
    const int head = 4 * kvh + (F.wave >> 1), j0 = 4 * (F.wave & 1);
    const bf16_t* qp = F.Qc + ((size_t)b * 2048 + 256 * nbp + 32 * j0 + r) * 1024 + head * 64 + 8 * hh;
    bf16x8 qa[4], qb[4];
#pragma unroll
    for (int s = 0; s < 4; ++s) qa[s] = __builtin_nontemporal_load((const bf16x8*)(qp + 16 * s));
#ifdef EXP_ZERO_LDS
    for (int e = F.tid; e < 134144 / 16; e += NTHREADS) *(LAS u32x4*)(ring + 16 * e) = (u32x4){0u, 0u, 0u, 0u};
    LDS_WAIT(); __syncthreads();
#endif
    attn_stage_kv(F, b, kvh, nbp, ring);
    LDS_WAIT();
    __syncthreads();
#pragma unroll
    for (int s = 0; s < 4; ++s) qb[s] = __builtin_nontemporal_load((const bf16x8*)(qp + 32 * 1024 + 16 * s));
    attn_task(F, l, b, nbp, head, j0 + 0, qa, ring);
#pragma unroll
    for (int s = 0; s < 4; ++s) qa[s] = __builtin_nontemporal_load((const bf16x8*)(qp + 64 * 1024 + 16 * s));
    attn_task(F, l, b, nbp, head, j0 + 1, qb, ring);
#pragma unroll
    for (int s = 0; s < 4; ++s) qb[s] = __builtin_nontemporal_load((const bf16x8*)(qp + 96 * 1024 + 16 * s));
    attn_task(F, l, b, nbp, head, j0 + 2, qa, ring);
    attn_task(F, l, b, nbp, head, j0 + 3, qb, ring);
    __syncthreads();
}

constexpr int PL_STRIDE = 272, PL_WBYTES = 47 * 272;
template <int G>
__device__ __forceinline__ void pool_unit_p(int l, int tile, LAS unsigned char* wl) {
    LOCAL_FRAME;
    constexpr int W = 2 << G, HIST = W - 1, NROW = 32 + HIST, NLD = (NROW * 16 + 63) / 64;
    const int lane = F.lane, r = lane & 31, hh = lane >> 5;
    const size_t R0 = (size_t)32 * tile;
    const int t0 = (int)(R0 & 2047);
    {
        u32x4 x[NLD];
#pragma unroll
        for (int k = 0; k < NLD; ++k) { const int id = lane + 64 * k, lr = id >> 4, c16 = id & 15; const int lrc = lr < NROW ? lr : NROW - 1;
            const int back = HIST - lrc; const size_t grow = (back <= t0) ? R0 - back : R0;
            x[k] = __builtin_nontemporal_load((const u32x4*)(F.Z2 + grow * ZW + Z_XB + 128 * G + 8 * c16)); }
#pragma unroll
        for (int k = 0; k < NLD; ++k) { const int id = lane + 64 * k, lr = id >> 4, c16 = id & 15; if (lr < NROW) *(LAS u32x4*)(wl + lr * PL_STRIDE + c16 * 16) = x[k]; }
    }
    const int t = t0 + r;
    const float icnt = 1.0f / (float)(W < t + 1 ? W : t + 1);
    LDS_WAIT();
    bf16x8 bfr[8];
#pragma unroll
    for (int s = 0; s < 8; ++s) {
        LAS unsigned char* bp = wl + (r + HIST) * PL_STRIDE + (16 * s + 8 * hh) * 2;
        float cur[8], sum[8]; unpack8(*(const LAS u32x4*)bp, cur);
#pragma unroll
        for (int jj = 0; jj < 8; ++jj) sum[jj] = cur[jj];
#pragma unroll
        for (int i = 1; i < W; ++i) { float f[8]; unpack8(*(const LAS u32x4*)(bp - i * PL_STRIDE), f); const float wgt = i <= t ? 1.f : 0.f;
#pragma unroll
            for (int jj = 0; jj < 8; ++jj) sum[jj] += wgt * f[jj]; }
#pragma unroll
        for (int jj = 0; jj < 8; ++jj) sum[jj] = sum[jj] * icnt - cur[jj];
        bfr[s] = __builtin_bit_cast(bf16x8, pack8(sum));
        __builtin_amdgcn_sched_barrier(0);
    }
#pragma unroll
    for (int db = 0; db < 4; ++db) {
        const int col = 128 * G + 32 * db + r;
        unsigned short gq[16];
#pragma unroll
        for (int i = 0; i < 16; ++i) gq[i] = __builtin_nontemporal_load(F.Z2 + (R0 + crow(i, hh)) * ZW + Z_GP + col);
        const float sc = F.pool_scale[l * 512 + col];
        f32x16 acc;
#pragma unroll
        for (int i = 0; i < 16; ++i) acc[i] = 0.f;
        const bf16_t* bp2 = F.PWT + ((size_t)(l * 4 + G) * 128 + 32 * db + r) * 128 + 8 * hh;
#pragma unroll
        for (int s = 0; s < 8; ++s) acc = __builtin_amdgcn_mfma_f32_32x32x16_bf16(bfr[s], *(const bf16x8*)(bp2 + 16 * s), acc, 0, 0, 0);
#pragma unroll
        for (int i = 0; i < 16; ++i) { const float gf = __uint_as_float((unsigned)gq[i] << 16);
            F.MIX[(R0 + crow(i, hh)) * DM + 1024 + col] = (bf16_t)(pg8::cvt_pk_bf16(acc[i] * sc * gf, 0.f) & 0xffffu); }
        __builtin_amdgcn_sched_barrier(0);
    }
    LDS_WAIT();
}
__device__ __forceinline__ void pool_prompt(int l, int g, int tile, LAS unsigned char* wl) {
    if (g == 0) pool_unit_p<0>(l, tile, wl); else if (g == 1) pool_unit_p<1>(l, tile, wl); else if (g == 2) pool_unit_p<2>(l, tile, wl); else pool_unit_p<3>(l, tile, wl);
}
template <int G>
__device__ __forceinline__ void pool_unit_s(int l, int tile) {
    LOCAL_FRAME;
    constexpr int W = 2 << G;
    const int lane = F.lane, r = lane & 31, hh = lane >> 5;
    const size_t row = (size_t)MP + 32 * tile + r;
    const int tt = (int)(row & 3), bd = (int)((row - MP) >> 2);
    const float* stb = F.state_pool + ((size_t)l * 128 + bd) * 15 * 512;
    const float icnt = 1.0f / (float)W;
    bf16x8 bfr[8];
#pragma unroll
    for (int s = 0; s < 8; ++s) {
        const int c0 = 128 * G + 16 * s + 8 * hh;
        float sum[8], cur[8];
        {
            constexpr int NL = W < 4 ? W : 4;
            u32x4 zn[NL]; f32x4 sa[NL], sb[NL];
#pragma unroll
            for (int i = 0; i < NL; ++i) { const int back = i <= tt ? i : tt; int si = 15 + tt - i; si = si > 14 ? 14 : si;
                zn[i] = *(const u32x4*)(F.Z2 + (row - back) * ZW + Z_XB + c0); sa[i] = *(const f32x4*)(stb + si * 512 + c0); sb[i] = *(const f32x4*)(stb + si * 512 + c0 + 4); }
            unpack8(zn[0], cur);
#pragma unroll
            for (int jj = 0; jj < 8; ++jj) sum[jj] = cur[jj];
#pragma unroll
            for (int i = 1; i < NL; ++i) { float f[8]; unpack8(zn[i], f); const bool nw = i <= tt;
#pragma unroll
                for (int jj = 0; jj < 4; ++jj) { sum[jj] += nw ? f[jj] : sa[i][jj]; sum[4 + jj] += nw ? f[4 + jj] : sb[i][jj]; } }
        }
#pragma unroll
        for (int i0 = 4; i0 < W; i0 += 4) {
            f32x4 sa[4], sb[4];
#pragma unroll
            for (int i = 0; i < 4; ++i) { const int si = 15 + tt - (i0 + i); sa[i] = *(const f32x4*)(stb + si * 512 + c0); sb[i] = *(const f32x4*)(stb + si * 512 + c0 + 4); }
#pragma unroll
            for (int i = 0; i < 4; ++i)
#pragma unroll
                for (int jj = 0; jj < 4; ++jj) { sum[jj] += sa[i][jj]; sum[4 + jj] += sb[i][jj]; }
        }
#pragma unroll
        for (int jj = 0; jj < 8; ++jj) sum[jj] = sum[jj] * icnt - cur[jj];
        bfr[s] = __builtin_bit_cast(bf16x8, pack8(sum));
        __builtin_amdgcn_sched_barrier(0);
    }
    f32x16 acc[4];
#pragma unroll
    for (int db = 0; db < 4; ++db) {
#pragma unroll
        for (int i = 0; i < 16; ++i) acc[db][i] = 0.f;
        const bf16_t* ap = F.PWT + ((size_t)(l * 4 + G) * 128 + 32 * db + r) * 128 + 8 * hh;
#pragma unroll
        for (int s = 0; s < 8; ++s) acc[db] = __builtin_amdgcn_mfma_f32_32x32x16_bf16(*(const bf16x8*)(ap + 16 * s), bfr[s], acc[db], 0, 0, 0);
        __builtin_amdgcn_sched_barrier(0);
    }
#pragma unroll
    for (int db = 0; db < 4; ++db)
#pragma unroll
        for (int q = 0; q < 4; ++q) {
            const int col = 128 * G + 32 * db + 8 * q + 4 * hh;
            const f32x4 sc = *(const f32x4*)(F.pool_scale + l * 512 + col);
            float gf[4]; unpack4(*(const u32x2*)(F.Z2 + row * ZW + Z_GP + col), gf);
            u32x2 wv; wv.x = pg8::cvt_pk_bf16(acc[db][4 * q + 0] * sc[0] * gf[0], acc[db][4 * q + 1] * sc[1] * gf[1]);
            wv.y = pg8::cvt_pk_bf16(acc[db][4 * q + 2] * sc[2] * gf[2], acc[db][4 * q + 3] * sc[3] * gf[3]);
            *(u32x2*)(F.MIX + row * DM + 1024 + col) = wv;
        }
}
__device__ __forceinline__ void pool_sample(int l, int g, int tile) {
    if (g == 0) pool_unit_s<0>(l, tile); else if (g == 1) pool_unit_s<1>(l, tile); else if (g == 2) pool_unit_s<2>(l, tile); else pool_unit_s<3>(l, tile);
}

struct SguOps { bf16x8 wB[8], wA[4]; };
__device__ __forceinline__ void sgu_load_ops(SguOps& o, const Frame& F, int l, int hd, size_t R0, int r, int hh, int db, int tbA, int tbB) {
    const bf16_t* Wb = F.SGUW + (size_t)(l * 4 + hd) * 128 * 128;
#pragma unroll
    for (int s = 0; s < 8; ++s) { o.wB[s] = (bf16x8){0, 0, 0, 0, 0, 0, 0, 0}; if (s < 2 * (tbB + 1)) o.wB[s] = *(const bf16x8*)(Wb + (32 * tbB + r) * 128 + 16 * s + 8 * hh); }
#pragma unroll
    for (int s = 0; s < 4; ++s) { o.wA[s] = (bf16x8){0, 0, 0, 0, 0, 0, 0, 0}; if (s < 2 * (tbA + 1)) o.wA[s] = *(const bf16x8*)(Wb + (32 * tbA + r) * 128 + 16 * s + 8 * hh); }
}
struct SguUG { unsigned short uu[16], gg[16]; };
__device__ __forceinline__ void sgu_load_ug(SguUG& o, const Frame& F, int hd, size_t R0, int r, int hh, int db, int tb) {
    const bf16_t* p = F.Z2 + (R0 + 32 * tb + 4 * hh) * ZW + Z_U + 128 * hd + 32 * db + r;
#pragma unroll
    for (int i = 0; i < 16; ++i) { o.uu[i] = __builtin_nontemporal_load(p); o.gg[i] = __builtin_nontemporal_load(p + (Z_GS - Z_U));
        p += ((i & 3) == 3 ? 5 : 1) * ZW; asm volatile("" : "+v"(p)); }
}
__device__ __forceinline__ void sgu_mfma(const SguOps& o, LAS bf16_t* VnT, int h2, int r, int hh, int db, int tbA, int tbB, f32x16& accA, f32x16& accB) {
#pragma unroll
    for (int i = 0; i < 16; ++i) { accA[i] = 0.f; accB[i] = 0.f; }
#pragma unroll
    for (int s = 0; s < 8; ++s) {
        if (s < 2 * (tbB + 1)) {
            const LAS unsigned char* ap = (const LAS unsigned char*)VnT + (h2 * 128 + 16 * s + 8 * hh + ((r & 15) >> 2)) * 320 + (32 * db + (r & 16) + 4 * (r & 3)) * 2;
            const v4i16_t lo = __builtin_amdgcn_ds_read_tr16_b64_v4i16((LAS v4i16_t*)ap), hi = __builtin_amdgcn_ds_read_tr16_b64_v4i16((LAS v4i16_t*)(ap + 4 * 320));
            const bf16x8 a = (bf16x8){lo[0], lo[1], lo[2], lo[3], hi[0], hi[1], hi[2], hi[3]};
            accB = __builtin_amdgcn_mfma_f32_32x32x16_bf16(o.wB[s], a, accB, 0, 0, 0);
            if (s < 4) { if (s < 2 * (tbA + 1)) accA = __builtin_amdgcn_mfma_f32_32x32x16_bf16(o.wA[s], a, accA, 0, 0, 0); }
        }
    }
}
__device__ __forceinline__ void sgu_epi(const SguUG& o, const Frame& F, int l, int hd, size_t R0, int r, int hh, int db, int tb, const f32x16& acc) {
    const int col = 128 * hd + 32 * db + r;
    const float lg = F.ln_g[l * 512 + col], lb = F.ln_b[l * 512 + col];
    const float* bsp = F.sgu_b + l * 512 + hd * 128 + 32 * tb + 4 * hh; const float* rsp = F.RSW + (l * 4 + hd) * 128 + 32 * tb + 4 * hh;
    bf16_t* q = F.MIX + (R0 + 32 * tb + 4 * hh) * DM + 1536 + col;
#pragma unroll
    for (int i = 0; i < 16; ++i) { const int dt = (i & 3) + 8 * (i >> 2);
        const float uf = __uint_as_float((unsigned)o.uu[i] << 16), gf = __uint_as_float((unsigned)o.gg[i] << 16);
        const float m = (lg * acc[i] + lb * rsp[dt] + bsp[dt]) * uf * gf;
        *q = (bf16_t)(pg8::cvt_pk_bf16(m, 0.f) & 0xffffu);
        q += ((i & 3) == 3 ? 5 : 1) * DM; asm volatile("" : "+v"(q)); }
}
__device__ __forceinline__ void sgu_unit(int l, int ci, int hp, LAS unsigned char* ring) {
    LOCAL_FRAME;
    LAS bf16_t* VnT = (LAS bf16_t*)ring;
    const int lane = F.lane, wv = F.wave;
    const size_t R0 = (size_t)128 * ci;
    const int r = lane & 31, hh = lane >> 5, db = wv & 3; const int tbA = (wv >> 2) ? 1 : 0, tbB = (wv >> 2) ? 2 : 3;
    SguOps op0;
    {
        const int tl = lane >> 2, q4 = lane & 3;
        const bf16_t* vrow = F.Z2 + (R0 + 16 * wv + tl) * ZW + Z_VS + 32 * q4;
        u32x4 x[4][4];
#pragma unroll
        for (int h = 0; h < 4; ++h)
#pragma unroll
            for (int i = 0; i < 4; ++i) x[h][i] = *(const u32x4*)(vrow + 128 * h + 8 * i);
        sgu_load_ops(op0, F, l, 2 * hp, R0, r, hh, db, tbA, tbB);
        float s = 0.f, ss = 0.f;
#pragma unroll
        for (int h = 0; h < 4; ++h)
#pragma unroll
            for (int i = 0; i < 4; ++i) { float f[8]; unpack8(x[h][i], f);
#pragma unroll
                for (int jj = 0; jj < 8; ++jj) { s += f[jj]; ss += f[jj] * f[jj]; } }
        s += __shfl_xor(s, 1); s += __shfl_xor(s, 2); ss += __shfl_xor(ss, 1); ss += __shfl_xor(ss, 2);
        const float mean = s * (1.0f / 512.0f), var = ss * (1.0f / 512.0f) - mean * mean, rstd = rsqrtf(var + EPS);
#pragma unroll
        for (int h2 = 0; h2 < 2; ++h2)
#pragma unroll
            for (int i = 0; i < 4; ++i) { const int d = 32 * q4 + 8 * i;
                const u32x4 xv = hp ? x[2 + h2][i] : x[h2][i];
                float f[8]; unpack8(xv, f);
#pragma unroll
                for (int jj = 0; jj < 8; ++jj) f[jj] = (f[jj] - mean) * rstd;
                *(LAS u32x4*)((LAS unsigned char*)VnT + (h2 * 128 + 16 * wv + tl) * 320 + d * 2) = pack8(f); }
    }
    LDS_WAIT();
    __syncthreads();
    f32x16 accA, accB;
    SguUG ua, ub;
    sgu_load_ug(ua, F, 2 * hp, R0, r, hh, db, tbA);
    sgu_mfma(op0, VnT, 0, r, hh, db, tbA, tbB, accA, accB);
    sgu_load_ug(ub, F, 2 * hp, R0, r, hh, db, tbB);
    SguOps op1;
    sgu_load_ops(op1, F, l, 2 * hp + 1, R0, r, hh, db, tbA, tbB);
    sgu_epi(ua, F, l, 2 * hp, R0, r, hh, db, tbA, accA);
    sgu_epi(ub, F, l, 2 * hp, R0, r, hh, db, tbB, accB);
    sgu_load_ug(ua, F, 2 * hp + 1, R0, r, hh, db, tbA);
    sgu_mfma(op1, VnT, 1, r, hh, db, tbA, tbB, accA, accB);
    sgu_load_ug(ub, F, 2 * hp + 1, R0, r, hh, db, tbB);
    sgu_epi(ua, F, l, 2 * hp + 1, R0, r, hh, db, tbA, accA);
    sgu_epi(ub, F, l, 2 * hp + 1, R0, r, hh, db, tbB, accB);
    __syncthreads();
}

__device__ __forceinline__ void samp_attn(int l, int bd, int kvh, LAS unsigned char* wl) {
    LOCAL_FRAME;
    LAS float* ps = (LAS float*)wl;
    LAS float* invs = ps + 144 * 16;
    const int lane = F.lane, fr = lane & 15, fq = lane >> 4, gq = fr >> 2, tt = fr & 3;
    float* oKs = F.out + O_KS + (size_t)l * LS_KS; float* oVs = F.out + O_VS + (size_t)l * LS_KS;
    bf16x8 qfr[2];
    {
        const bf16_t* qsrc = F.Qc + ((size_t)MP + 4 * bd + tt) * 1024 + (4 * kvh + gq) * 64 + 16 * fq;
        const u32x4 qa = *(const u32x4*)qsrc, qb = *(const u32x4*)(qsrc + 8);
        u32x4 lo, hi;
        lo.x = (qa.x & 0xffffu) | (qa.y << 16); lo.y = (qa.z & 0xffffu) | (qa.w << 16); lo.z = (qb.x & 0xffffu) | (qb.y << 16); lo.w = (qb.z & 0xffffu) | (qb.w << 16);
        hi.x = (qa.x >> 16) | (qa.y & 0xffff0000u); hi.y = (qa.z >> 16) | (qa.w & 0xffff0000u); hi.z = (qb.x >> 16) | (qb.y & 0xffff0000u); hi.w = (qb.z >> 16) | (qb.w & 0xffff0000u);
        qfr[0] = __builtin_bit_cast(bf16x8, lo); qfr[1] = __builtin_bit_cast(bf16x8, hi);
    }
    const float* kc = F.cache_k + (((size_t)l * 128 + bd) * 128) * 256 + kvh * 64 + 8 * fq;
    const float* kn = oKs + (((size_t)bd * 128 + 124 + (fr & 3)) * 4 + kvh) * 64 + 8 * fq;
    float* kd = oKs + ((size_t)bd * 128 * 4 + kvh) * 64 + 8 * fq;
    f32x4 S[9];
#pragma unroll
    for (int T = 0; T < 9; ++T) S[T] = (f32x4){0.f, 0.f, 0.f, 0.f};
#pragma unroll
    for (int T0 = 0; T0 < 9; T0 += 3) {
        f32x4 x[3][2][2];
#pragma unroll
        for (int u = 0; u < 3; ++u) { const int T = T0 + u; const float* src = (T < 8) ? kc + (size_t)(16 * T + fr) * 256 : kn;
#pragma unroll
            for (int ks = 0; ks < 2; ++ks) { x[u][ks][0] = __builtin_nontemporal_load((const f32x4*)(src + 32 * ks)); x[u][ks][1] = __builtin_nontemporal_load((const f32x4*)(src + 32 * ks + 4)); } }
#pragma unroll
        for (int u = 0; u < 3; ++u) { const int T = T0 + u; const int key = 16 * T + fr;
            if (T < 8 && key >= 4) {
#pragma unroll
                for (int ks = 0; ks < 2; ++ks) { float* dst = kd + (size_t)(key - 4) * 256 + 32 * ks; __builtin_nontemporal_store(x[u][ks][0], (f32x4*)dst); __builtin_nontemporal_store(x[u][ks][1], (f32x4*)(dst + 4)); } } }
#pragma unroll
        for (int u = 0; u < 3; ++u)
#pragma unroll
            for (int ks = 0; ks < 2; ++ks) { u32x4 w; w.x = pg8::cvt_pk_bf16(x[u][ks][0][0], x[u][ks][0][1]); w.y = pg8::cvt_pk_bf16(x[u][ks][0][2], x[u][ks][0][3]);
                w.z = pg8::cvt_pk_bf16(x[u][ks][1][0], x[u][ks][1][1]); w.w = pg8::cvt_pk_bf16(x[u][ks][1][2], x[u][ks][1][3]);
                S[T0 + u] = __builtin_amdgcn_mfma_f32_16x16x32_bf16(__builtin_bit_cast(bf16x8, w), qfr[ks], S[T0 + u], 0, 0, 0); }
        __builtin_amdgcn_sched_barrier(0);
    }
    const float sink2 = F.sinks[l * 16 + 4 * kvh + gq] * LOG2E;
    float m = sink2;
#pragma unroll
    for (int T = 0; T < 9; ++T)
#pragma unroll
        for (int rg = 0; rg < 4; ++rg) { const int key = 16 * T + 4 * fq + rg; const bool ok = (T < 8) ? (key >= tt + 1) : (fq == 0 && rg <= tt);
            S[T][rg] = ok ? S[T][rg] : -INFINITY; m = fmaxf(m, S[T][rg]); }
    m = fmaxf(m, __shfl_xor(m, 16)); m = fmaxf(m, __shfl_xor(m, 32));
    float sum = 0.f;
#pragma unroll
    for (int T = 0; T < 9; ++T)
#pragma unroll
        for (int rg = 0; rg < 4; ++rg) { const float p = __builtin_amdgcn_exp2f(S[T][rg] - m); sum += p; ps[(16 * T + 4 * fq + rg) * 16 + fr] = p; }
    sum += __shfl_xor(sum, 16); sum += __shfl_xor(sum, 32);
    if (fq == 0) invs[fr] = 1.0f / (sum + __builtin_amdgcn_exp2f(sink2 - m));
    LDS_WAIT();
    const int kq = lane >> 4, dq = lane & 15;
    const float* vcp = F.cache_v + (((size_t)l * 128 + bd) * 128 + kq) * 256 + kvh * 64 + 4 * dq;
    float* vop = oVs + ((size_t)bd * 128 + kq) * 256 + kvh * 64 + 4 * dq;
#pragma unroll 1
    for (int pass = 0; pass < 2; ++pass) {
        float o[8][4];
#pragma unroll
        for (int q = 0; q < 8; ++q) { o[q][0] = 0.f; o[q][1] = 0.f; o[q][2] = 0.f; o[q][3] = 0.f; }
#pragma unroll 1
        for (int blk = 0; blk < 3; ++blk) {
            f32x4 vx[11];
#pragma unroll
            for (int ii = 0; ii < 11; ++ii) { const int i = blk * 11 + ii; const float* src = (i < 32) ? vcp + (size_t)i * 1024 : vop + (size_t)31 * 1024; vx[ii] = __builtin_nontemporal_load((const f32x4*)src); }
            if (pass == 0) {
#pragma unroll
                for (int ii = 0; ii < 11; ++ii) { const int i = blk * 11 + ii; if (i >= 1 && i < 32) __builtin_nontemporal_store(vx[ii], (f32x4*)(vop + (size_t)(i - 1) * 1024)); } }
#pragma unroll
            for (int ii = 0; ii < 11; ++ii) { const int key = 4 * (blk * 11 + ii) + kq;
                const f32x4 pa = *(const LAS f32x4*)(ps + key * 16 + 8 * pass), pb = *(const LAS f32x4*)(ps + key * 16 + 8 * pass + 4);
#pragma unroll
                for (int e = 0; e < 4; ++e) { o[0][e] += pa[0] * vx[ii][e]; o[1][e] += pa[1] * vx[ii][e]; o[2][e] += pa[2] * vx[ii][e]; o[3][e] += pa[3] * vx[ii][e];
                    o[4][e] += pb[0] * vx[ii][e]; o[5][e] += pb[1] * vx[ii][e]; o[6][e] += pb[2] * vx[ii][e]; o[7][e] += pb[3] * vx[ii][e]; }
                __builtin_amdgcn_sched_barrier(0); }
        }
#pragma unroll
        for (int q = 0; q < 8; ++q)
#pragma unroll
            for (int e = 0; e < 4; ++e) { float v = o[q][e]; v += __shfl_xor(v, 16); v += __shfl_xor(v, 32); o[q][e] = v; }
#pragma unroll
        for (int q = 0; q < 8; ++q) if ((q >> 1) == kq) { const int qq = 8 * pass + q, t2 = qq & 3, head = 4 * kvh + (qq >> 2); const size_t row = (size_t)MP + 4 * bd + t2;
            float gf[4]; unpack4(*(const u32x2*)(F.Z2 + row * ZW + Z_GA + head * 64 + 4 * dq), gf);
            const float iq = invs[qq];
            u32x2 wv; wv.x = pg8::cvt_pk_bf16(o[q][0] * iq * gf[0], o[q][1] * iq * gf[1]); wv.y = pg8::cvt_pk_bf16(o[q][2] * iq * gf[2], o[q][3] * iq * gf[3]);
            *(u32x2*)(F.MIX + row * DM + head * 64 + 4 * dq) = wv; }
    }
    LDS_WAIT();
}
__device__ __forceinline__ void samp_sgu(int l, int bd) {
    LOCAL_FRAME;
    const int lane = F.lane, c0 = 8 * lane, hd = lane >> 4;
    {
        float* oPs = F.out + O_PS + (size_t)l * LS_PS + (size_t)bd * 15 * 512; const float* sp = F.state_pool + (size_t)l * LS_PS + (size_t)bd * 15 * 512 + 4 * 512;
        f32x4 cp[22];
#pragma unroll
        for (int k = 0; k < 22; ++k) cp[k] = __builtin_nontemporal_load((const f32x4*)(sp + 4 * (lane + 64 * k)));
#pragma unroll
        for (int k = 0; k < 22; ++k) __builtin_nontemporal_store(cp[k], (f32x4*)(oPs + 4 * (lane + 64 * k)));
    }
    float* oCV = F.out + O_CV + (size_t)l * LS_CV;
    float gl[8], bl[8];
#pragma unroll
    for (int j = 0; j < 8; ++j) { gl[j] = F.ln_g[l * 512 + c0 + j]; bl[j] = F.ln_b[l * 512 + c0 + j]; }
    u32x4 xr[4], ur[4], gr[4];
#pragma unroll
    for (int tt = 0; tt < 4; ++tt) { const size_t row = (size_t)MP + 4 * bd + tt; xr[tt] = *(const u32x4*)(F.Z2 + row * ZW + Z_VS + c0); ur[tt] = *(const u32x4*)(F.Z2 + row * ZW + Z_U + c0); gr[tt] = *(const u32x4*)(F.Z2 + row * ZW + Z_GS + c0); }
    float vn[4][8];
#pragma unroll
    for (int tt = 0; tt < 4; ++tt) { float f[8]; unpack8(xr[tt], f);
        float s = 0.f, ss = 0.f;
#pragma unroll
        for (int j = 0; j < 8; ++j) { s += f[j]; ss += f[j] * f[j]; }
        s = wave_sum(s); ss = wave_sum(ss);
        const float mean = s * (1.0f / 512.0f), var = ss * (1.0f / 512.0f) - mean * mean, rstd = rsqrtf(var + EPS);
#pragma unroll
        for (int j = 0; j < 8; ++j) vn[tt][j] = (f[j] - mean) * rstd * gl[j] + bl[j];
        float* o = oCV + ((size_t)bd * 4 + tt) * 512 + c0;
        *(f32x4*)o = (f32x4){vn[tt][0], vn[tt][1], vn[tt][2], vn[tt][3]}; *(f32x4*)(o + 4) = (f32x4){vn[tt][4], vn[tt][5], vn[tt][6], vn[tt][7]}; }
#pragma unroll
    for (int tt = 0; tt < 4; ++tt) { const size_t row = (size_t)MP + 4 * bd + tt;
        float mx[8]; const float bias = F.sgu_b[l * 512 + hd * 128 + tt];
#pragma unroll
        for (int j = 0; j < 8; ++j) mx[j] = bias;
#pragma unroll
        for (int s2 = 0; s2 < 4; ++s2) if (s2 <= tt) { const float w = F.sgu_w[((size_t)(l * 4 + hd) * 128 + tt) * 128 + s2];
#pragma unroll
            for (int j = 0; j < 8; ++j) mx[j] += w * vn[s2][j]; }
        float uf[8], gf[8]; unpack8(ur[tt], uf); unpack8(gr[tt], gf);
#pragma unroll
        for (int j = 0; j < 8; ++j) mx[j] = mx[j] * uf[j] * gf[j];
        *(u32x4*)(F.MIX + row * DM + 1536 + c0) = pack8(mx); }
}

#ifdef HYBRID
__device__ __forceinline__ void attn_task_o(const Frame& F, int l, int b, int nb, int head, int qs, LAS unsigned char* wl) {
    const int lane = F.lane, r = lane & 31, hh = lane >> 5, kvh = head >> 2;
    LAS float* wsf = (LAS float*)wl; LAS bf16_t* stg = (LAS bf16_t*)(wl + 256);
    const int t0 = 128 * nb + 32 * qs;
    const size_t qrow0 = (size_t)b * 2048 + t0;
    const bf16_t* qp = F.Qc + (qrow0 + r) * 1024 + head * 64 + 8 * hh;
    bf16x8 qf[4];
#pragma unroll
    for (int s = 0; s < 4; ++s) qf[s] = *(const bf16x8*)(qp + 16 * s);
    const bf16_t* kbase = F.Kc + (size_t)(b * 4 + kvh) * 2048 * 64;
    const bf16_t* vbase = F.VTP + (size_t)(b * 4 + kvh) * 64 * 2048;
    const int cmin = (nb > 0) ? 0 : (4 - qs);
    f32x16 S[5];
#pragma unroll
    for (int c = 0; c < 5; ++c) {
        f32x16 a;
#pragma unroll
        for (int i = 0; i < 16; ++i) a[i] = 0.f;
        if (c >= cmin) {
            const bf16_t* kp = kbase + (size_t)(t0 - 128 + 32 * c + r) * 64 + 8 * hh;
#pragma unroll
            for (int s = 0; s < 4; ++s) a = __builtin_amdgcn_mfma_f32_32x32x16_bf16(*(const bf16x8*)(kp + 16 * s), qf[s], a, 0, 0, 0);
        }
        S[c] = a;
    }
    const float NEG = -INFINITY;
#pragma unroll
    for (int i = 0; i < 16; ++i) { const int kap = crow(i, hh); if (kap <= r) S[0][i] = NEG; if (kap > r) S[4][i] = NEG; }
    const float sink2 = F.sinks[l * 16 + head] * LOG2E;
    float m = sink2;
#pragma unroll
    for (int c = 0; c < 5; ++c) if (c >= cmin) {
#pragma unroll
        for (int i = 0; i < 16; ++i) m = fmaxf(m, S[c][i]); }
    m = fmaxf(m, __shfl_xor(m, 32));
    float sum = 0.f;
#pragma unroll
    for (int c = 0; c < 5; ++c) if (c >= cmin) {
#pragma unroll
        for (int i = 0; i < 16; ++i) { const float p = __builtin_amdgcn_exp2f(S[c][i] - m); S[c][i] = p; sum += p; } }
    sum += __shfl_xor(sum, 32);
    const float inv = 1.0f / (sum + __builtin_amdgcn_exp2f(sink2 - m));
    f32x16 o[2];
#pragma unroll
    for (int i = 0; i < 16; ++i) { o[0][i] = 0.f; o[1][i] = 0.f; }
#pragma unroll
    for (int c = 0; c < 5; ++c) if (c >= cmin) {
        const bf16_t* vt = vbase + (size_t)((t0 - 128 + 32 * c) >> 5) * 2048 + r * 32 + 16 * hh;
#pragma unroll
        for (int s = 0; s < 2; ++s) {
            u32x4 pw; pw.x = pg8::cvt_pk_bf16(S[c][8 * s + 0], S[c][8 * s + 1]); pw.y = pg8::cvt_pk_bf16(S[c][8 * s + 2], S[c][8 * s + 3]);
            pw.z = pg8::cvt_pk_bf16(S[c][8 * s + 4], S[c][8 * s + 5]); pw.w = pg8::cvt_pk_bf16(S[c][8 * s + 6], S[c][8 * s + 7]);
            const bf16x8 pa = __builtin_bit_cast(bf16x8, pw);
#pragma unroll
            for (int db = 0; db < 2; ++db) o[db] = __builtin_amdgcn_mfma_f32_32x32x16_bf16(pa, *(const bf16x8*)(vt + db * 1024 + 8 * s), o[db], 0, 0, 0);
        }
    }
    if (hh == 0) wsf[r] = inv;
    LDS_WAIT();
#pragma unroll
    for (int i = 0; i < 16; ++i) { const int q = crow(i, hh); const float rl = wsf[q];
        stg[q * 64 + r] = (bf16_t)(pg8::cvt_pk_bf16(o[0][i] * rl, 0.f) & 0xffffu);
        stg[q * 64 + 32 + r] = (bf16_t)(pg8::cvt_pk_bf16(o[1][i] * rl, 0.f) & 0xffffu); }
    LDS_WAIT();
#pragma unroll
    for (int i = 0; i < 4; ++i) { const int row = i * 8 + (lane >> 3), ch = lane & 7;
        const u32x4 ov = *(const LAS u32x4*)(stg + row * 64 + ch * 8);
        const u32x4 gv = *(const u32x4*)(F.Z2 + (qrow0 + row) * ZW + Z_GA + head * 64 + ch * 8);
        float of[8], gf[8]; unpack8(ov, of); unpack8(gv, gf);
#pragma unroll
        for (int j = 0; j < 8; ++j) of[j] *= gf[j];
        *(u32x4*)(F.MIX + (qrow0 + row) * DM + head * 64 + ch * 8) = pack8(of); }
    LDS_WAIT();
}

template <bool SAMPLE>
__device__ __forceinline__ void pool_unit_o(const Frame& F, int l, int g, int tile) {
    const int lane = F.lane, r = lane & 31, hh = lane >> 5, w = 2 << g;
    const size_t row = (size_t)(SAMPLE ? MP : 0) + 32 * tile + r;
    const int t = SAMPLE ? (int)(row & 3) : (int)(row & 2047);
    const int bd = SAMPLE ? (int)((row - MP) >> 2) : 0;
    const float icnt = SAMPLE ? 1.0f / (float)w : 1.0f / (float)(w < t + 1 ? w : t + 1);
    bf16x8 bfr[8];
#pragma unroll
    for (int s = 0; s < 8; ++s) {
        const int c0 = 128 * g + 16 * s + 8 * hh;
        float sum[8], cur[8];
#pragma unroll
        for (int j = 0; j < 8; ++j) { sum[j] = 0.f; cur[j] = 0.f; }
        for (int i = 0; i < w; ++i) {
            float f[8];
            const int e = t - i;
            if (e >= 0) { unpack8(*(const u32x4*)(F.Z2 + (row - i) * ZW + Z_XB + c0), f); }
            else if (SAMPLE) { const float* sp = F.state_pool + (((size_t)l * 128 + bd) * 15 + 15 + e) * 512 + c0;
                const f32x4 a = *(const f32x4*)sp, bq = *(const f32x4*)(sp + 4); f[0] = a[0]; f[1] = a[1]; f[2] = a[2]; f[3] = a[3]; f[4] = bq[0]; f[5] = bq[1]; f[6] = bq[2]; f[7] = bq[3]; }
            else {
#pragma unroll
                for (int j = 0; j < 8; ++j) f[j] = 0.f; }
#pragma unroll
            for (int j = 0; j < 8; ++j) sum[j] += f[j];
            if (i == 0) {
#pragma unroll
                for (int j = 0; j < 8; ++j) cur[j] = f[j]; }
        }
        float pf[8];
#pragma unroll
        for (int j = 0; j < 8; ++j) pf[j] = sum[j] * icnt - cur[j];
        bfr[s] = __builtin_bit_cast(bf16x8, pack8(pf));
    }
    f32x16 acc[4];
#pragma unroll
    for (int db = 0; db < 4; ++db) {
#pragma unroll
        for (int i = 0; i < 16; ++i) acc[db][i] = 0.f;
        const bf16_t* ap = F.PWT + ((size_t)(l * 4 + g) * 128 + 32 * db + r) * 128 + 8 * hh;
#pragma unroll
        for (int s = 0; s < 8; ++s) acc[db] = __builtin_amdgcn_mfma_f32_32x32x16_bf16(*(const bf16x8*)(ap + 16 * s), bfr[s], acc[db], 0, 0, 0);
    }
#pragma unroll
    for (int db = 0; db < 4; ++db)
#pragma unroll
        for (int q = 0; q < 4; ++q) {
            const int col = 128 * g + 32 * db + 8 * q + 4 * hh;
            const f32x4 sc = *(const f32x4*)(F.pool_scale + l * 512 + col);
            float gf[4]; unpack4(*(const u32x2*)(F.Z2 + row * ZW + Z_GP + col), gf);
            u32x2 wv; wv.x = pg8::cvt_pk_bf16(acc[db][4 * q + 0] * sc[0] * gf[0], acc[db][4 * q + 1] * sc[1] * gf[1]);
            wv.y = pg8::cvt_pk_bf16(acc[db][4 * q + 2] * sc[2] * gf[2], acc[db][4 * q + 3] * sc[3] * gf[3]);
            *(u32x2*)(F.MIX + row * DM + 1024 + col) = wv;
        }
}

__device__ __forceinline__ void sgu_unit_o(const Frame& F, int l, int ci, int hd, LAS unsigned char* ring) {
    LAS bf16_t* VnT = (LAS bf16_t*)ring;
    const int lane = F.lane, wv = F.wave;
    const size_t R0 = (size_t)128 * ci;
    {
        const int tl = lane >> 2, q4 = lane & 3;
        const bf16_t* vrow = F.Z2 + (R0 + 16 * wv + tl) * ZW + Z_VS;
        float s = 0.f, ss = 0.f;
#pragma unroll
        for (int i = 0; i < 16; ++i) { float f[8]; unpack8(*(const u32x4*)(vrow + 128 * q4 + 8 * i), f);
#pragma unroll
            for (int j = 0; j < 8; ++j) { s += f[j]; ss += f[j] * f[j]; } }
        s += __shfl_xor(s, 1); s += __shfl_xor(s, 2); ss += __shfl_xor(ss, 1); ss += __shfl_xor(ss, 2);
        const float mean = s * (1.0f / 512.0f), var = ss * (1.0f / 512.0f) - mean * mean, rstd = rsqrtf(var + EPS);
#pragma unroll
        for (int i = 0; i < 4; ++i) { const int d = 32 * q4 + 8 * i; float f[8]; unpack8(*(const u32x4*)(vrow + 128 * hd + d), f);
            const float* gp = F.ln_g + l * 512 + 128 * hd + d; const float* bp = F.ln_b + l * 512 + 128 * hd + d;
#pragma unroll
            for (int j = 0; j < 8; ++j) { const float vn = (f[j] - mean) * rstd * gp[j] + bp[j];
                VnT[(d + j) * 136 + 16 * wv + tl] = (bf16_t)(pg8::cvt_pk_bf16(vn, 0.f) & 0xffffu); } }
    }
    __syncthreads();
    {
        const int r = lane & 31, hh = lane >> 5, db = wv & 3; const int tbA = (wv >> 2) ? 1 : 0, tbB = (wv >> 2) ? 2 : 3;
        f32x16 accA, accB;
#pragma unroll
        for (int i = 0; i < 16; ++i) { accA[i] = 0.f; accB[i] = 0.f; }
        const bf16_t* Wb = F.SGUW + (size_t)(l * 4 + hd) * 128 * 128;
#pragma unroll
        for (int s = 0; s < 8; ++s) {
            if (s < 2 * (tbB + 1)) {
                const bf16x8 a = *(const LAS bf16x8*)(VnT + (32 * db + r) * 136 + 16 * s + 8 * hh);
                accB = __builtin_amdgcn_mfma_f32_32x32x16_bf16(a, *(const bf16x8*)(Wb + (32 * tbB + r) * 128 + 16 * s + 8 * hh), accB, 0, 0, 0);
                if (s < 2 * (tbA + 1)) accA = __builtin_amdgcn_mfma_f32_32x32x16_bf16(a, *(const bf16x8*)(Wb + (32 * tbA + r) * 128 + 16 * s + 8 * hh), accA, 0, 0, 0);
            }
        }
#pragma unroll
        for (int pass = 0; pass < 2; ++pass) {
            const int tb = pass ? tbB : tbA; const f32x16 acc = pass ? accB : accA;
            const int t = 32 * tb + r; const size_t row = R0 + t; const float bias = F.sgu_b[l * 512 + hd * 128 + t];
#pragma unroll
            for (int q = 0; q < 4; ++q) { const int col = 128 * hd + 32 * db + 8 * q + 4 * hh;
                float uf[4], gf[4]; unpack4(*(const u32x2*)(F.Z2 + row * ZW + Z_U + col), uf); unpack4(*(const u32x2*)(F.Z2 + row * ZW + Z_GS + col), gf);
                u32x2 wo; wo.x = pg8::cvt_pk_bf16((acc[4 * q + 0] + bias) * uf[0] * gf[0], (acc[4 * q + 1] + bias) * uf[1] * gf[1]);
                wo.y = pg8::cvt_pk_bf16((acc[4 * q + 2] + bias) * uf[2] * gf[2], (acc[4 * q + 3] + bias) * uf[3] * gf[3]);
                *(u32x2*)(F.MIX + row * DM + 1536 + col) = wo; }
        }
    }
    __syncthreads();
}

__device__ __forceinline__ void samp_attn_o(const Frame& F, int l, int bd, int kvh, LAS unsigned char* wl) {
    LAS float* qs = (LAS float*)wl;
    LAS float* ps = (LAS float*)(wl + 4096);
    const int lane = F.lane;
    float* oKs = F.out + O_KS + (size_t)l * LS_KS; float* oVs = F.out + O_VS + (size_t)l * LS_KS;
    {
        const int qi = lane >> 2, part = lane & 3, gq = qi >> 2, tt = qi & 3;
        const bf16_t* src = F.Qc + ((size_t)MP + 4 * bd + tt) * 1024 + (4 * kvh + gq) * 64 + 16 * part;
        float f0[8], f1[8]; unpack8(*(const u32x4*)src, f0); unpack8(*(const u32x4*)(src + 8), f1);
#pragma unroll
        for (int j = 0; j < 8; ++j) { const int p0 = 16 * part + j, p1 = p0 + 8;
            qs[qi * 64 + (p0 >> 1) + 32 * (p0 & 1)] = f0[j]; qs[qi * 64 + (p1 >> 1) + 32 * (p1 & 1)] = f1[j]; }
    }
    LDS_WAIT();
    float s0[16], s1[16], s2[16];
#pragma unroll
    for (int q = 0; q < 16; ++q) { s0[q] = 0.f; s1[q] = 0.f; s2[q] = 0.f; }
    const float* k0p = F.cache_k + (((size_t)l * 128 + bd) * 128 + lane) * 256 + kvh * 64;
    const float* k1p = k0p + 64 * 256;
    const float* k2p = oKs + (((size_t)bd * 128 + 124 + (lane & 3)) * 4 + kvh) * 64;
    float* c0p = oKs + (((size_t)bd * 128 + (lane >= 4 ? lane - 4 : 0)) * 4 + kvh) * 64;
    float* c1p = oKs + (((size_t)bd * 128 + lane + 60) * 4 + kvh) * 64;
    for (int ch = 0; ch < 16; ++ch) {
        const f32x4 kx0 = *(const f32x4*)(k0p + 4 * ch), kx1 = *(const f32x4*)(k1p + 4 * ch), kx2 = *(const f32x4*)(k2p + 4 * ch);
        if (lane >= 4) *(f32x4*)(c0p + 4 * ch) = kx0;
        *(f32x4*)(c1p + 4 * ch) = kx1;
#pragma unroll
        for (int q = 0; q < 16; ++q) { const f32x4 qv = *(const LAS f32x4*)(qs + q * 64 + 4 * ch);
            s0[q] += (qv[0] * kx0[0] + qv[1] * kx0[1]) + (qv[2] * kx0[2] + qv[3] * kx0[3]);
            s1[q] += (qv[0] * kx1[0] + qv[1] * kx1[1]) + (qv[2] * kx1[2] + qv[3] * kx1[3]);
            s2[q] += (qv[0] * kx2[0] + qv[1] * kx2[1]) + (qv[2] * kx2[2] + qv[3] * kx2[3]); }
    }
    float inv[16];
#pragma unroll
    for (int q = 0; q < 16; ++q) {
        const int tt = q & 3; const float sink2 = F.sinks[l * 16 + 4 * kvh + (q >> 2)] * LOG2E;
        const bool v0 = lane >= tt + 1, v2 = (lane < 4) && (lane <= tt);
        float m = s1[q]; if (v0) m = fmaxf(m, s0[q]); if (v2) m = fmaxf(m, s2[q]);
        m = fmaxf(wave_max(m), sink2);
        const float p0 = v0 ? __builtin_amdgcn_exp2f(s0[q] - m) : 0.f, p1 = __builtin_amdgcn_exp2f(s1[q] - m), p2 = v2 ? __builtin_amdgcn_exp2f(s2[q] - m) : 0.f;
        const float sum = wave_sum(p0 + p1 + p2);
        inv[q] = 1.0f / (sum + __builtin_amdgcn_exp2f(sink2 - m));
        ps[lane * 16 + q] = p0; ps[(lane + 64) * 16 + q] = p1; if (lane < 4) ps[(128 + lane) * 16 + q] = p2;
    }
    LDS_WAIT();
    float o[16];
#pragma unroll
    for (int q = 0; q < 16; ++q) o[q] = 0.f;
    const float* vcp = F.cache_v + (((size_t)l * 128 + bd) * 128) * 256 + kvh * 64 + lane;
    float* vop = oVs + ((size_t)bd * 128) * 256 + kvh * 64 + lane;
    for (int key = 0; key < 132; ++key) {
        float v;
        if (key < 128) { v = vcp[(size_t)key * 256]; if (key >= 4) vop[(size_t)(key - 4) * 256] = v; }
        else v = vop[(size_t)(key - 4) * 256];
#pragma unroll
        for (int q4 = 0; q4 < 4; ++q4) { const f32x4 pv = *(const LAS f32x4*)(ps + key * 16 + 4 * q4);
            o[4 * q4 + 0] += pv[0] * v; o[4 * q4 + 1] += pv[1] * v; o[4 * q4 + 2] += pv[2] * v; o[4 * q4 + 3] += pv[3] * v; }
    }
#pragma unroll
    for (int q = 0; q < 16; ++q) { const int tt = q & 3, head = 4 * kvh + (q >> 2); const size_t row = (size_t)MP + 4 * bd + tt;
        const float gv = __uint_as_float(((unsigned)F.Z2[row * ZW + Z_GA + head * 64 + lane]) << 16);
        F.MIX[row * DM + head * 64 + lane] = (bf16_t)(pg8::cvt_pk_bf16(o[q] * inv[q] * gv, 0.f) & 0xffffu); }
    LDS_WAIT();
}
__device__ __forceinline__ void samp_sgu_o(const Frame& F, int l, int bd) {
    const int lane = F.lane, c0 = 8 * lane, hd = lane >> 4;
    float* oCV = F.out + O_CV + (size_t)l * LS_CV;
    float gl[8], bl[8];
#pragma unroll
    for (int j = 0; j < 8; ++j) { gl[j] = F.ln_g[l * 512 + c0 + j]; bl[j] = F.ln_b[l * 512 + c0 + j]; }
    float vn[4][8];
#pragma unroll
    for (int tt = 0; tt < 4; ++tt) { const size_t row = (size_t)MP + 4 * bd + tt; float f[8]; unpack8(*(const u32x4*)(F.Z2 + row * ZW + Z_VS + c0), f);
        float s = 0.f, ss = 0.f;
#pragma unroll
        for (int j = 0; j < 8; ++j) { s += f[j]; ss += f[j] * f[j]; }
        s = wave_sum(s); ss = wave_sum(ss);
        const float mean = s * (1.0f / 512.0f), var = ss * (1.0f / 512.0f) - mean * mean, rstd = rsqrtf(var + EPS);
#pragma unroll
        for (int j = 0; j < 8; ++j) vn[tt][j] = (f[j] - mean) * rstd * gl[j] + bl[j];
        float* o = oCV + ((size_t)bd * 4 + tt) * 512 + c0;
        *(f32x4*)o = (f32x4){vn[tt][0], vn[tt][1], vn[tt][2], vn[tt][3]}; *(f32x4*)(o + 4) = (f32x4){vn[tt][4], vn[tt][5], vn[tt][6], vn[tt][7]}; }
#pragma unroll
    for (int tt = 0; tt < 4; ++tt) { const size_t row = (size_t)MP + 4 * bd + tt;
        float mx[8]; const float bias = F.sgu_b[l * 512 + hd * 128 + tt];
#pragma unroll
        for (int j = 0; j < 8; ++j) mx[j] = bias;
#pragma unroll
        for (int s2 = 0; s2 < 4; ++s2) if (s2 <= tt) { const float w = F.sgu_w[((size_t)(l * 4 + hd) * 128 + tt) * 128 + s2];
#pragma unroll
            for (int j = 0; j < 8; ++j) mx[j] += w * vn[s2][j]; }
        float uf[8], gf[8]; unpack8(*(const u32x4*)(F.Z2 + row * ZW + Z_U + c0), uf); unpack8(*(const u32x4*)(F.Z2 + row * ZW + Z_GS + c0), gf);
#pragma unroll
        for (int j = 0; j < 8; ++j) mx[j] = mx[j] * uf[j] * gf[j];
        *(u32x4*)(F.MIX + row * DM + 1536 + c0) = pack8(mx); }
}

#endif
struct NormRowIn { u32x4 yv[4]; f32x4 xv[4][2]; u32x4 xb[4]; };
__device__ __forceinline__ void norm_row_load(NormRowIn& in, const Frame& F, int l, int row) {
    const int lane = F.lane;
    const bf16_t* yr = F.Yb + (size_t)row * DM + 8 * lane;
#pragma unroll
    for (int j = 0; j < 4; ++j) in.yv[j] = __builtin_nontemporal_load((const u32x4*)(yr + 512 * j));
    if (l == 0) {
        const float* xr = (row < MP ? F.xp + (size_t)row * DM : F.xs + (size_t)(row - MP) * DM) + 8 * lane;
#pragma unroll
        for (int j = 0; j < 4; ++j) { in.xv[j][0] = __builtin_nontemporal_load((const f32x4*)(xr + 512 * j)); in.xv[j][1] = __builtin_nontemporal_load((const f32x4*)(xr + 512 * j + 4)); }
    } else {
        const bf16_t* xr = F.H + (size_t)row * DM + 8 * lane;
#pragma unroll
        for (int j = 0; j < 4; ++j) in.xb[j] = __builtin_nontemporal_load((const u32x4*)(xr + 512 * j));
    }
}
__device__ __forceinline__ void norm_row_finish(const NormRowIn& in, const Frame& F, int l, int row) {
    const int lane = F.lane;
    const float* pg = F.norm_post + l * DM + 8 * lane;
    float y[4][8]; float ss = 0.f;
#pragma unroll
    for (int j = 0; j < 4; ++j) { unpack8(in.yv[j], y[j]);
#pragma unroll
        for (int e = 0; e < 8; ++e) ss += y[j][e] * y[j][e]; }
    ss = wave_sum(ss);
    const float ry = rsqrtf(ss * (1.0f / 2048.0f) + EPS);
    if (l == 0) {
        float s1 = 0.f; bf16_t* hrow = F.H + (size_t)row * DM + 8 * lane;
#pragma unroll
        for (int j = 0; j < 4; ++j) { const f32x4 ga = *(const f32x4*)(pg + 512 * j), gb = *(const f32x4*)(pg + 512 * j + 4);
#pragma unroll
            for (int e = 0; e < 4; ++e) { y[j][e] = in.xv[j][0][e] + y[j][e] * ry * ga[e]; y[j][4 + e] = in.xv[j][1][e] + y[j][4 + e] * ry * gb[e]; }
#pragma unroll
            for (int e = 0; e < 8; ++e) s1 += y[j][e] * y[j][e]; }
        s1 = wave_sum(s1);
        const float ms = s1 * (1.0f / 2048.0f) + EPS, r1 = rsqrtf(ms);
        if (lane == 0) F.RSTD[row] = ms * r1;
#pragma unroll
        for (int j = 0; j < 4; ++j) {
#pragma unroll
            for (int e = 0; e < 8; ++e) y[j][e] *= r1;
            *(u32x4*)(hrow + 512 * j) = pack8(y[j]); }
    } else {
        float* orow = F.out + (size_t)row * DM + 8 * lane;
        const float rms = F.RSTD[row];
#pragma unroll
        for (int j = 0; j < 4; ++j) { const f32x4 ga = *(const f32x4*)(pg + 512 * j), gb = *(const f32x4*)(pg + 512 * j + 4); float xf[8]; unpack8(in.xb[j], xf);
#pragma unroll
            for (int e = 0; e < 4; ++e) { y[j][e] = xf[e] * rms + y[j][e] * ry * ga[e]; y[j][4 + e] = xf[4 + e] * rms + y[j][4 + e] * ry * gb[e]; }
            __builtin_nontemporal_store((f32x4){y[j][0], y[j][1], y[j][2], y[j][3]}, (f32x4*)(orow + 512 * j)); __builtin_nontemporal_store((f32x4){y[j][4], y[j][5], y[j][6], y[j][7]}, (f32x4*)(orow + 512 * j + 4)); }
    }
}
__device__ __forceinline__ void norm_rows4(int l, int row0) { LOCAL_FRAME;
#pragma unroll 1
    for (int k = 0; k < 4; k += 2) { NormRowIn a, b; norm_row_load(a, F, l, row0 + k); norm_row_load(b, F, l, row0 + k + 1);
        norm_row_finish(a, F, l, row0 + k); norm_row_finish(b, F, l, row0 + k + 1); } }

constexpr int Q2_G = 40, Q2_AT = Q2_G + 256, Q2_SG = Q2_AT + 256, Q2_SA = Q2_SG + 64, Q2_SS = Q2_SA + 16, Q2_SP = Q2_SS + 8, Q2_PO = Q2_SP + 256;
__device__ __forceinline__ void slot2(int l, LAS unsigned char* L, LAS unsigned char* ring) {
    int t_ = threadIdx.x; asm volatile("" : "+v"(t_)); const int wave = __builtin_amdgcn_readfirstlane(t_ >> 6);
    unsigned* head = ctl_word(CW_Q + 64 * (2 * l));
    EV_T0();
#pragma unroll 1
    for (;;) {
        const int it = q_pop(head, L);
        if (it >= Q2_PO + (l == 0 ? TR_ITEMS : 0)) { if (l == 0) { EV_MAX(0); EV_MIN(1); } break; }
        if (it < Q2_G) {
            unsigned char* ws = (unsigned char*)kargs()->ws;
            pg8::Gemm g{(const bf16_t*)(ws + WS_H), (const bf16_t*)(ws + WS_WTIN) + (size_t)l * DIN * DM, MT, DIN, DM};
            OneUnit S; S.u.pm = 64 + it / 20; S.u.pn = it % 20;
            pg8::EpiIn E{l};
            pg8::gemm_phase<pg8::EpiIn, OneUnit, false, true>(ring, g, S, E);
            publish(ctl_word(CW_ZS + 64 * (2 * l + it / 20)));
            if (l == 0) { EV_MAX(2); EV_MIN(3); }
        }
#ifndef NO_SGU
        else if (it < Q2_AT) { const int u = it - Q2_G; sgu_unit(l, u >> 1, u & 1, ring); if (l == 0) EV_MAX(5); }
#endif
        else if (it < Q2_SG) { attn_unit(l, it - Q2_AT, ring); if (l == 0) EV_MAX(4); }
        else if (it < Q2_SA) { const int i = it - Q2_SG; dep_wait(ctl_word(CW_ZS + 64 * (2 * l + (i >> 5))), 20u); if (l == 0) EV_MIN(6); const int k = 8 * i + wave; samp_attn(l, k >> 2, k & 3, ring + wave * 9472); __syncthreads(); if (l == 0) EV_MAX(7); }
        else if (it < Q2_SS) { const int i = it - Q2_SA; dep_wait(ctl_word(CW_ZS + 64 * (2 * l + (i >> 3))), 20u); samp_sgu(l, 8 * i + wave); }
        else if (it < Q2_SP) { const int i = it - Q2_SS; dep_wait(ctl_word(CW_ZS + 64 * (2 * l + (i >> 2))), 20u); const int k = 8 * i + wave; pool_sample(l, k & 3, k >> 2); }
        else if (it < Q2_PO) { const int i = 8 * (it - Q2_SP) + wave; pool_prompt(l, i & 3, i >> 2, ring + wave * PL_WBYTES); }
        else { LOCAL_FRAME; transpose_item(F, 1, it - Q2_PO, ring); }
    }
}
constexpr int Q4_G = 16, Q4_P = Q4_G + 512, Q4_S = Q4_P + 16;
__device__ __forceinline__ void slot4(int l, LAS unsigned char* L, LAS unsigned char* ring) {
    int t_ = threadIdx.x; asm volatile("" : "+v"(t_)); const int wave = __builtin_amdgcn_readfirstlane(t_ >> 6);
    unsigned* head = ctl_word(CW_Q + 64 * (2 * l + 1));
#pragma unroll 1
    for (;;) {
        const int it = q_pop(head, L);
        if (it >= Q4_S) break;
        if (it < Q4_G) {
            unsigned char* ws = (unsigned char*)kargs()->ws;
            pg8::Gemm g{(const bf16_t*)(ws + WS_MIX), (const bf16_t*)(ws + WS_WTOUT) + (size_t)l * DM * DM, MT, DM, DM};
            OneUnit S; S.u.pm = 64 + it / 8; S.u.pn = it % 8;
            pg8::EpiOut E{};
            pg8::gemm_phase<pg8::EpiOut, OneUnit, false, true>(ring, g, S, E);
            publish(ctl_word(CW_YS + 64 * (2 * l + it / 8)));
        }
        else if (it < Q4_P) norm_rows4(l, 32 * (it - Q4_G) + 4 * wave);
        else { const int i = it - Q4_P; dep_wait(ctl_word(CW_YS + 64 * (2 * l + (i >> 3))), 8u); norm_rows4(l, MP + 32 * i + 4 * wave); }
    }
}

__device__ __forceinline__ void grid_barrier(LAS unsigned char* L) {
    XcdBarrier b; b.bar = (unsigned*)((unsigned char*)kargs()->ws + WS_CTL) + CW_BAR; b.x = xb_xcc_id(); b.st = (volatile LAS unsigned*)L + 8;
    xcd_barrier(b);
}
__global__ void __launch_bounds__(NTHREADS, 2) hymba_fwd(Args a_unused) {
    extern __shared__ __attribute__((aligned(16))) unsigned char lds[];
    LAS unsigned char* L = (LAS unsigned char*)lds;
    if (threadIdx.x < 256) ((LAS unsigned*)L)[threadIdx.x] = 0u;
    __syncthreads();
    (void)xcd_barrier_post((unsigned*)((unsigned char*)kargs()->ws + WS_CTL) + CW_BAR, (volatile LAS unsigned*)L + 8);
    LAS unsigned char* ring = L + RING_OFF;
    STAMP(0);
#ifndef NO_P0
    { Frame F; make_frame(F, kargs()); p0_prologue(F, ring); }
#endif
    grid_barrier(L);
    STAMP(1);
#pragma unroll 1
    for (int l = 0; l < 2; ++l) {
#ifndef NO_P1
        {
            KArgs ka = kargs(); unsigned char* ws = (unsigned char*)ka->ws;
            pg8::Gemm g{(const bf16_t*)(ws + WS_H), (const bf16_t*)(ws + WS_WTIN) + (size_t)l * DIN * DM, MP, DIN, DM}; pg8::StaticOrder S; S.init(MP, DIN, (int)gridDim.x, (int)blockIdx.x);
            pg8::EpiIn E{l};
            pg8::gemm_phase<pg8::EpiIn, pg8::StaticOrder, true, true>(ring, g, S, E);
        }
#endif
        grid_barrier(L);
        STAMP(2 + 4 * l);
#ifndef NO_P2
        slot2(l, L, ring);
#endif
        grid_barrier(L);
        STAMP(3 + 4 * l);
#ifndef NO_P3
        {
            KArgs ka = kargs(); unsigned char* ws = (unsigned char*)ka->ws;
            pg8::Gemm g{(const bf16_t*)(ws + WS_MIX), (const bf16_t*)(ws + WS_WTOUT) + (size_t)l * DM * DM, MP, DM, DM}; pg8::StaticOrder S; S.init(MP, DM, (int)gridDim.x, (int)blockIdx.x);
            pg8::EpiOut E{};
            pg8::gemm_phase<pg8::EpiOut, pg8::StaticOrder, true, true>(ring, g, S, E);
        }
#endif
        grid_barrier(L);
        STAMP(4 + 4 * l);
#ifndef NO_P4
        slot4(l, L, ring);
#endif
        if (l == 0) grid_barrier(L);
#if PROBE_SEL
        if (l == 1) __syncthreads();
#endif
        STAMP(5 + 4 * l);
    }
#if PROBE_SEL
    if (blockIdx.x == 0 && threadIdx.x == 0) {
#if PROBE_SEL >= 10
        unsigned ea = __hip_atomic_load(ctl_word(CW_EV + 64 * PEA), __ATOMIC_RELAXED, __HIP_MEMORY_SCOPE_AGENT), eb = __hip_atomic_load(ctl_word(CW_EV + 64 * PEB), __ATOMIC_RELAXED, __HIP_MEMORY_SCOPE_AGENT);
        if (PEA_MIN) ea = 0x40000000u - ea; if (PEB_MIN) eb = 0x40000000u - eb;
        unsigned long long da = (ea + 400) / 800, db = (eb + 400) / 800;
#else
        LAS unsigned long long* ts = (LAS unsigned long long*)(L + 256);
        unsigned long long da = (ts[PA1] - ts[PA0] + 400) / 800, db = (ts[PB1] - ts[PB0] + 400) / 800;
#endif
        if (da > 63) da = 63; if (db > 63) db = 63;
        const unsigned long long extra = (da + 64 * db) * 1600ull, t0 = __builtin_amdgcn_s_memrealtime();
        while (__builtin_amdgcn_s_memrealtime() - t0 < extra) __builtin_amdgcn_s_sleep(32);
    }
#endif
}

extern "C" void kernel_launch(void* const* d_in, const int* in_sizes, int n_in, void* d_out, int out_size, void* d_ws, size_t ws_size, hipStream_t stream) {
    static int grid = 0;
    if (grid == 0) {
        if (n_in != 16 || (size_t)out_size != O_END || ws_size < WS_END) { fprintf(stderr, "kernel_launch: unexpected shapes: n_in %d out %d ws %zu (need %zu)\n", n_in, out_size, ws_size, (size_t)WS_END); grid = -1; return; }
        int dev = 0, cus = 0, per_cu = 0;
        if (hipGetDevice(&dev) != hipSuccess || hipDeviceGetAttribute(&cus, hipDeviceAttributeMultiprocessorCount, dev) != hipSuccess) { fprintf(stderr, "kernel_launch: device query failed\n"); grid = -1; return; }
        if (hipFuncSetAttribute((const void*)hymba_fwd, hipFuncAttributeMaxDynamicSharedMemorySize, LDS_BYTES) != hipSuccess) { fprintf(stderr, "kernel_launch: hipFuncSetAttribute failed\n"); grid = -1; return; }
        if (hipOccupancyMaxActiveBlocksPerMultiprocessor(&per_cu, (const void*)hymba_fwd, NTHREADS, LDS_BYTES) != hipSuccess || per_cu < 1) { fprintf(stderr, "kernel_launch: occupancy query says %d blocks/CU\n", per_cu); (void)hipGetLastError(); grid = -1; return; }
        grid = cus;
    }
    if (grid < 0) return;
    (void)hipMemsetAsync((char*)d_ws + WS_CTL, 0, CTL_ZERO_BYTES, stream);
    Args a{};
    for (int i = 0; i < 16; ++i) a.in[i] = (const float*)d_in[i];
    a.out = (float*)d_out; a.ws = (unsigned char*)d_ws;
    void* params[] = {&a};
    hipError_t e = hipLaunchCooperativeKernel((const void*)hymba_fwd, dim3(grid), dim3(NTHREADS), params, LDS_BYTES, stream);
    if (e != hipSuccess) fprintf(stderr, "kernel_launch: cooperative launch failed: %s (grid %d)\n", hipGetErrorString(e), grid);
}
```

```cpp
#include <hip/hip_runtime.h>
#include <cstdio>
#include <cstdint>
#include <cmath>
namespace pg8 {
#define PG8_LAS __attribute__((address_space(3)))
typedef unsigned short bf16_t;
typedef short bf16x8 __attribute__((ext_vector_type(8)));
typedef float f32x4 __attribute__((ext_vector_type(4)));
typedef unsigned u32x4 __attribute__((ext_vector_type(4)));
constexpr int BM = 256, BK = 64, HALF = 128, HTB = HALF * BK * 2  , STAGE_BYTES = 8 * HTB, NXCD = 8, WGM = 8;

__host__ __device__ __forceinline__ int lds_byte(int r, int c) { const int st = (r >> 4) * 2 + (c >> 5), rr = r & 15, cc = c & 31, ob = rr * 64 + cc * 2; return st * 1024 + (ob ^ (((ob >> 9) & 1) << 5)); }
__host__ __device__ __forceinline__ void stage_rc(int b, int& R, int& C) { const int st = b / 1024, sb = b % 1024, swz = sb ^ (((sb >> 9) & 1) << 5); R = (st >> 1) * 16 + swz / 64; C = (st & 1) * 32 + (swz % 64) / 2; }
__host__ __device__ __forceinline__ int perm32(int rho) { const int n = rho >> 4, i = rho & 15; return 8 * (i >> 2) + 4 * n + (i & 3); }

struct Unit { int pm, pn; };
struct Gemm { const bf16_t* A; const bf16_t* Bt; int M, N, K; };

struct StaticOrder {
    int nM, nN, nwg, G, c;
    __host__ __device__ void init(int M, int N, int G_, int c_) { nM = M / BM; nN = N / BM; nwg = nM * nN; G = G_; c = c_; }
    __host__ __device__ bool next(int i, Unit& u) const {
        const long L = (long)i * G + c; if (L >= nwg) return false;
        int wgid = (int)L; { const int q = nwg / NXCD, r = nwg % NXCD, xcd = wgid % NXCD, off = wgid / NXCD; wgid = (xcd < r ? xcd * (q + 1) : r * (q + 1) + (xcd - r) * q) + off; }
        const int nig = WGM * nN, gid = wgid / nig, fm = gid * WGM, gsz = (nM - fm) < WGM ? (nM - fm) : WGM;
        u.pm = fm + ((wgid % nig) % gsz); u.pn = (wgid % nig) / gsz; return true;
    }
    __device__ __forceinline__ void a_ready(const Unit&) const {}
    __device__ __forceinline__ void done(const Unit&) const {}
};

constexpr int DM = 2048, MP = 16384, MS = 512, MT = MP + MS, DIN = 5120;
constexpr int ZW = 3584;
constexpr int Z_GA = 0, Z_XB = 1024, Z_GP = 1536, Z_U = 2048, Z_VS = 2560, Z_GS = 3072;
constexpr float LOG2E = 1.4426950408889634f, QSCALE = 0.125f * LOG2E, EPS = 1e-6f;

__device__ __forceinline__ unsigned cvt_pk_bf16(float lo, float hi) { unsigned r; asm("v_cvt_pk_bf16_f32 %0, %1, %2" : "=v"(r) : "v"(lo), "v"(hi)); return r; }
__device__ __forceinline__ float silu_f(float x) { return x * __builtin_amdgcn_rcpf(1.0f + __builtin_amdgcn_exp2f(-x * LOG2E)); }
__device__ __forceinline__ int vperm32(int x) { return ((x >> 2) & 1) * 16 + (x >> 3) * 4 + (x & 3); }

struct EpiPtrs { const __attribute__((address_space(1))) float* in[16]; __attribute__((address_space(1))) float* out; __attribute__((address_space(1))) unsigned char* ws; };
constexpr size_t EP_RSTD = (size_t)3 << 20, EP_ROPE = (size_t)1 << 20, EP_QC = (size_t)192 << 20, EP_KC = (size_t)225 << 20, EP_VTP = (size_t)233 << 20, EP_Z2 = (size_t)241 << 20, EP_Y = (size_t)357 << 20;
constexpr size_t EO_KP = 34603008, EO_VP = 35127296, EO_PP = 35651584, EO_KS = 35774464, EO_VS = 44163072, EO_PS = 52551680;
struct EpiIn {
    static constexpr bool PERM = true, AFTER_DRAIN = false;
    int l;
    __device__ __forceinline__ void operator()(const f32x4 (&acc)[2][2][4][2], const Unit& u, int wr, int wc, int fr, int fq) const {
        const __attribute__((address_space(4))) EpiPtrs* kp = (const __attribute__((address_space(4))) EpiPtrs*)__builtin_amdgcn_kernarg_segment_ptr(); asm volatile("" : "+s"(kp));
        unsigned char* ws = (unsigned char*)kp->ws; float* outp = (float*)kp->out;
        bf16_t* Qc = (bf16_t*)(ws + EP_QC); bf16_t* Kc = (bf16_t*)(ws + EP_KC); bf16_t* VTP = (bf16_t*)(ws + EP_VTP); bf16_t* Z2 = (bf16_t*)(ws + EP_Z2); const float* rope = (const float*)(ws + EP_ROPE);
        float* oKp = outp + EO_KP + (size_t)l * 262144; float* oVp = outp + EO_VP + (size_t)l * 262144; float* oPp = outp + EO_PP + (size_t)l * 61440;
        float* oKs = outp + EO_KS + (size_t)l * 4194304; float* oVs = outp + EO_VS + (size_t)l * 4194304; float* oPs = outp + EO_PS + (size_t)l * 983040;
        const int pn = u.pn;
        const int row0 = u.pm * 256 + wr * 64 + fr;
        const int cw = wc * 32 + 8 * fq;
        if (pn < 5) {
#pragma unroll
            for (int ai = 0; ai < 2; ++ai)
#pragma unroll
                for (int m = 0; m < 4; ++m) {
                    const int row = row0 + ai * 128 + m * 16;
                    const bool smp = row >= MP;
                    const int tpos = smp ? 2048 + (row & 3) : (row & 2047);
                    const float* rp = rope + tpos * 64;
#pragma unroll
                    for (int bj = 0; bj < 2; ++bj) {
                        const int c = pn * 256 + bj * 128 + cw;
                        const int i0 = (c & 63) >> 1;
                        const f32x4 cs = *(const f32x4*)(rp + i0), sn = *(const f32x4*)(rp + 32 + i0);
                        const f32x4 v0 = acc[ai][bj][m][0], v1 = acc[ai][bj][m][1];
                        f32x4 o1, o2;
                        o1[0] = v0[0] * cs[0] - v0[1] * sn[0]; o2[0] = v0[1] * cs[0] + v0[0] * sn[0];
                        o1[1] = v0[2] * cs[1] - v0[3] * sn[1]; o2[1] = v0[3] * cs[1] + v0[2] * sn[1];
                        o1[2] = v1[0] * cs[2] - v1[1] * sn[2]; o2[2] = v1[1] * cs[2] + v1[0] * sn[2];
                        o1[3] = v1[2] * cs[3] - v1[3] * sn[3]; o2[3] = v1[3] * cs[3] + v1[2] * sn[3];
                        if (pn < 4) {
                            o1 = o1 * QSCALE; o2 = o2 * QSCALE;
                            u32x4 w; w.x = cvt_pk_bf16(o1[0], o2[0]); w.y = cvt_pk_bf16(o1[1], o2[1]); w.z = cvt_pk_bf16(o1[2], o2[2]); w.w = cvt_pk_bf16(o1[3], o2[3]);
                            *(u32x4*)(Qc + (size_t)row * 1024 + c) = w;
                        } else {
                            const int kvh = (c - 1024) >> 6;
                            if (!smp) {
                                const int b = row >> 11, t = row & 2047;
                                u32x4 w; w.x = cvt_pk_bf16(o1[0], o2[0]); w.y = cvt_pk_bf16(o1[1], o2[1]); w.z = cvt_pk_bf16(o1[2], o2[2]); w.w = cvt_pk_bf16(o1[3], o2[3]);
                                *(u32x4*)(Kc + ((size_t)((b * 4 + kvh) * 2048 + t)) * 64 + (c & 63)) = w;
                                if (t >= 1920) { float* o = oKp + ((size_t)((b * 128 + t - 1920) * 4 + kvh)) * 64 + i0; *(f32x4*)o = o1; *(f32x4*)(o + 32) = o2; }
                            } else {
                                const int bd = (row - MP) >> 2, tt = row & 3;
                                float* o = oKs + ((size_t)((bd * 128 + 124 + tt) * 4 + kvh)) * 64 + i0; *(f32x4*)o = o1; *(f32x4*)(o + 32) = o2;
                            }
                        }
                    }
                }
        } else if (pn == 5) {
#pragma unroll
            for (int ai = 0; ai < 2; ++ai)
#pragma unroll
                for (int m = 0; m < 4; ++m) {
                    const int row = row0 + ai * 128 + m * 16;
                    const bool smp = row >= MP;
#pragma unroll
                    for (int bj = 0; bj < 2; ++bj) {
                        const int cv = bj * 128 + cw;
                        const int kvh = cv >> 6, d0 = cv & 63;
                        const f32x4 v0 = acc[ai][bj][m][0], v1 = acc[ai][bj][m][1];
                        if (!smp) {
                            const int b = row >> 11, t = row & 2047;
                            bf16_t* vp = VTP + ((size_t)((b * 4 + kvh) * 64 + (t >> 5))) * 2048 + d0 * 32 + vperm32(t & 31);
                            const unsigned w0 = cvt_pk_bf16(v0[0], v0[1]), w1 = cvt_pk_bf16(v0[2], v0[3]), w2 = cvt_pk_bf16(v1[0], v1[1]), w3 = cvt_pk_bf16(v1[2], v1[3]);
                            vp[0] = (bf16_t)(w0 & 0xffffu); vp[32] = (bf16_t)(w0 >> 16); vp[64] = (bf16_t)(w1 & 0xffffu); vp[96] = (bf16_t)(w1 >> 16);
                            vp[128] = (bf16_t)(w2 & 0xffffu); vp[160] = (bf16_t)(w2 >> 16); vp[192] = (bf16_t)(w3 & 0xffffu); vp[224] = (bf16_t)(w3 >> 16);
                            if (t >= 1920) { float* o = oVp + ((size_t)((b * 128 + t - 1920) * 4 + kvh)) * 64 + d0; *(f32x4*)o = v0; *(f32x4*)(o + 4) = v1; }
                        } else {
                            const int bd = (row - MP) >> 2, tt = row & 3;
                            float* o = oVs + ((size_t)((bd * 128 + 124 + tt) * 4 + kvh)) * 64 + d0; *(f32x4*)o = v0; *(f32x4*)(o + 4) = v1;
                        }
                    }
                }
        } else {
            const bool gate = (pn < 10) || (pn == 12) || (pn == 13) || (pn >= 18);
            const bool isxb = (pn == 10) || (pn == 11);
#pragma unroll
            for (int ai = 0; ai < 2; ++ai)
#pragma unroll
                for (int m = 0; m < 4; ++m) {
                    const int row = row0 + ai * 128 + m * 16;
                    const bool smp = row >= MP;
#pragma unroll
                    for (int bj = 0; bj < 2; ++bj) {
                        const int c = pn * 256 + bj * 128 + cw;
                        f32x4 v0 = acc[ai][bj][m][0], v1 = acc[ai][bj][m][1];
                        if (isxb) {
                            const int cx = c - 2560;
                            if (!smp) { const int t = row & 2047; if (t >= 2033) { const int b = row >> 11; float* o = oPp + ((size_t)(b * 15 + t - 2033)) * 512 + cx; *(f32x4*)o = v0; *(f32x4*)(o + 4) = v1; } }
                            else { const int bd = (row - MP) >> 2, tt = row & 3; float* o = oPs + ((size_t)(bd * 15 + 11 + tt)) * 512 + cx; *(f32x4*)o = v0; *(f32x4*)(o + 4) = v1; }
                        }
                        if (gate) {
#pragma unroll
                            for (int j = 0; j < 4; ++j) { v0[j] = silu_f(v0[j]); v1[j] = silu_f(v1[j]); }
                        }
                        u32x4 w; w.x = cvt_pk_bf16(v0[0], v0[1]); w.y = cvt_pk_bf16(v0[2], v0[3]); w.z = cvt_pk_bf16(v1[0], v1[1]); w.w = cvt_pk_bf16(v1[2], v1[3]);
                        *(u32x4*)(Z2 + (size_t)row * ZW + (c - 1536)) = w;
                    }
                }
        }
    }
};

struct EpiOut {
    static constexpr bool PERM = true, AFTER_DRAIN = false;
    __device__ __forceinline__ void operator()(const f32x4 (&acc)[2][2][4][2], const Unit& u, int wr, int wc, int fr, int fq) const {
        const __attribute__((address_space(4))) EpiPtrs* kp = (const __attribute__((address_space(4))) EpiPtrs*)__builtin_amdgcn_kernarg_segment_ptr(); asm volatile("" : "+s"(kp));
        bf16_t* C = (bf16_t*)((unsigned char*)kp->ws + EP_Y);
        const int row0 = u.pm * BM + wr * 64 + fr, col0 = u.pn * BM + wc * 32 + 8 * fq;
#pragma unroll
        for (int ai = 0; ai < 2; ++ai)
#pragma unroll
            for (int m = 0; m < 4; ++m) { bf16_t* rowp = C + (size_t)(row0 + ai * HALF + m * 16) * DM + col0;
#pragma unroll
                for (int bj = 0; bj < 2; ++bj) { const f32x4 v0 = acc[ai][bj][m][0], v1 = acc[ai][bj][m][1];
                    u32x4 w; w.x = cvt_pk_bf16(v0[0], v0[1]); w.y = cvt_pk_bf16(v0[2], v0[3]); w.z = cvt_pk_bf16(v1[0], v1[1]); w.w = cvt_pk_bf16(v1[2], v1[3]);
                    *(u32x4*)(rowp + bj * HALF) = w; } }
    }
};
template <class Epi, class Sched, bool ALIGN_EPI = false, bool SP2 = false>
__device__ __forceinline__ void gemm_phase(PG8_LAS unsigned char* lds, const Gemm g, const Sched& S, const Epi& E) {
    int tid_ = threadIdx.x; asm volatile("" : "+v"(tid_));
    const int tid = tid_, wid = __builtin_amdgcn_readfirstlane(tid >> 6), lane = tid & 63, wr = wid >> 2, wc = wid & 3, fr = lane & 15, fq = lane >> 4;
    const int K = g.K, nt = K / BK;
    unsigned voffA[2], voffB[2];
#pragma unroll
    for (int i = 0; i < 2; ++i) { int R, C; stage_rc(tid * 16 + i * 8192, R, C); const int Rb = Epi::PERM ? ((R & ~31) + perm32(R & 31)) : R;
        voffA[i] = (unsigned)(R * K + C) * 2u; voffB[i] = (unsigned)(Rb * K + C) * 2u; }
    const size_t kstep = (size_t)(BK * 2);
    const size_t hstep = (size_t)HALF * K * 2;
    const size_t tstep = 2 * hstep;
    const unsigned ldsw = (unsigned)wid * 1024u;
    const int aoff = lds_byte(wr * 64 + fr, fq * 8), boff = lds_byte(wc * 32 + fr, fq * 8);
#define PG8_SA(b, h) (((b) * 2 + (h)) * HTB)
#define PG8_SB(b, h) ((4 + (b) * 2 + (h)) * HTB)
#define PG8_STAGE(bufoff, gbase, voff) do { _Pragma("unroll") for (int _i = 0; _i < 2; ++_i) \
        __builtin_amdgcn_global_load_lds((const unsigned*)((const char*)(gbase) + (voff)[_i]), (PG8_LAS unsigned*)(lds + (bufoff) + ldsw + _i * 8192), 16, 0, 0); } while (0)
#define PG8_LDA(dst, b, h) do { _Pragma("unroll") for (int m = 0; m < 4; ++m) _Pragma("unroll") for (int k = 0; k < 2; ++k) dst[m][k] = *(const PG8_LAS bf16x8*)(lds + PG8_SA(b, h) + aoff + m * 2048 + k * 1024); } while (0)
#define PG8_LDB(dst, b, h) do { _Pragma("unroll") for (int n = 0; n < 2; ++n) _Pragma("unroll") for (int k = 0; k < 2; ++k) dst[n][k] = *(const PG8_LAS bf16x8*)(lds + PG8_SB(b, h) + boff + n * 2048 + k * 1024); } while (0)
#define PG8_MMA(ai, bj, At, Bt) do { __builtin_amdgcn_s_setprio(1); _Pragma("unroll") for (int m = 0; m < 4; ++m) _Pragma("unroll") for (int n = 0; n < 2; ++n) _Pragma("unroll") for (int k = 0; k < 2; ++k) \
        acc[ai][bj][m][n] = __builtin_amdgcn_mfma_f32_16x16x32_bf16(Bt[n][k], At[m][k], acc[ai][bj][m][n], 0, 0, 0); __builtin_amdgcn_s_setprio(0); } while (0)
#define PG8_WAIT_V(n) asm volatile("s_waitcnt vmcnt(" #n ")" ::: "memory")
#define PG8_WAIT_L(n) asm volatile("s_waitcnt lgkmcnt(" #n ")" ::: "memory")
#define PG8_BAR __builtin_amdgcn_s_barrier()
#define PG8_SCHED __builtin_amdgcn_sched_barrier(0)
    Unit cur, nxt; int ui = 0;
    if (!S.next(0, cur)) return;
    f32x4 acc[2][2][4][2];
#pragma unroll
    for (int a = 0; a < 2; ++a)
#pragma unroll
        for (int b = 0; b < 2; ++b)
#pragma unroll
            for (int m = 0; m < 4; ++m)
#pragma unroll
                for (int n = 0; n < 2; ++n) acc[a][b][m][n] = (f32x4){0.f, 0.f, 0.f, 0.f};
    bf16x8 At[4][2], B0[2][2], B1[2][2];
    const char* cA = (const char*)g.A + (size_t)cur.pm * tstep; const char* cB = (const char*)g.Bt + (size_t)cur.pn * tstep;
    S.a_ready(cur);
    if constexpr (SP2) {
        PG8_STAGE(PG8_SB(0, 0), cB, voffB); PG8_STAGE(PG8_SB(0, 1), cB + hstep, voffB); PG8_STAGE(PG8_SA(0, 0), cA, voffA); PG8_STAGE(PG8_SA(0, 1), cA + hstep, voffA);
        if (wr == 1) PG8_BAR;
        PG8_WAIT_V(2); PG8_BAR;
        PG8_STAGE(PG8_SB(1, 0), cB + kstep, voffB); PG8_STAGE(PG8_SA(1, 0), cA + kstep, voffA); PG8_STAGE(PG8_SB(1, 1), cB + hstep + kstep, voffB);
        PG8_WAIT_V(6); PG8_BAR;
    } else {
        PG8_STAGE(PG8_SB(0, 0), cB, voffB); PG8_STAGE(PG8_SA(0, 0), cA, voffA); PG8_STAGE(PG8_SB(0, 1), cB + hstep, voffB); PG8_STAGE(PG8_SA(0, 1), cA + hstep, voffA);
        if (wr == 1) PG8_BAR;
        PG8_WAIT_V(4); PG8_BAR;
        PG8_STAGE(PG8_SB(1, 0), cB + kstep, voffB); PG8_STAGE(PG8_SA(1, 0), cA + kstep, voffA); PG8_STAGE(PG8_SB(1, 1), cB + hstep + kstep, voffB);
        PG8_WAIT_V(6); PG8_BAR;
    }
    for (;;) {
        const bool has_next = S.next(ui + 1, nxt);
        const char* nA = has_next ? (const char*)g.A + (size_t)nxt.pm * tstep : cA; const char* nB = has_next ? (const char*)g.Bt + (size_t)nxt.pn * tstep : cB;
        for (int t = 0; t < nt; t += 2) {
            const bool last = (t == nt - 2);
            const char* a1 = cA + (size_t)(t + 1) * kstep;
            const char* a2 = last ? nA : cA + (size_t)(t + 2) * kstep; const char* b2 = last ? nB : cB + (size_t)(t + 2) * kstep;
            const char* a3 = a2 + kstep; const char* b3 = b2 + kstep;
            if (last && has_next) S.a_ready(nxt);
            if constexpr (SP2) {
            PG8_LDB(B0, 0, 0); PG8_LDB(B1, 0, 1); PG8_SCHED; PG8_LDA(At, 0, 0); PG8_STAGE(PG8_SA(1, 1), a1 + hstep, voffA);
            PG8_WAIT_V(8); PG8_WAIT_L(0); PG8_BAR; PG8_MMA(0, 0, At, B0); PG8_MMA(0, 1, At, B1); PG8_BAR; PG8_SCHED;
            PG8_LDA(At, 0, 1); PG8_STAGE(PG8_SB(0, 0), b2, voffB); PG8_STAGE(PG8_SB(0, 1), b2 + hstep, voffB); PG8_STAGE(PG8_SA(0, 0), a2, voffA);
            PG8_WAIT_V(8); PG8_WAIT_L(0); PG8_BAR; PG8_MMA(1, 0, At, B0); PG8_MMA(1, 1, At, B1); PG8_BAR; PG8_SCHED;
            PG8_LDB(B0, 1, 0); PG8_LDB(B1, 1, 1); PG8_SCHED; PG8_LDA(At, 1, 0); PG8_STAGE(PG8_SA(0, 1), a2 + hstep, voffA);
            PG8_WAIT_V(8); PG8_WAIT_L(0); PG8_BAR; PG8_MMA(0, 0, At, B0); PG8_MMA(0, 1, At, B1); PG8_BAR; PG8_SCHED;
            PG8_LDA(At, 1, 1); PG8_STAGE(PG8_SB(1, 0), b3, voffB); PG8_STAGE(PG8_SB(1, 1), b3 + hstep, voffB); PG8_STAGE(PG8_SA(1, 0), a3, voffA);
            PG8_WAIT_V(8); PG8_WAIT_L(0); PG8_BAR; PG8_MMA(1, 0, At, B0); PG8_MMA(1, 1, At, B1); PG8_BAR; PG8_SCHED;
            } else {
            PG8_LDB(B0, 0, 0); PG8_SCHED; PG8_LDA(At, 0, 0); PG8_STAGE(PG8_SA(1, 1), a1 + hstep, voffA);
            PG8_WAIT_L(8); PG8_BAR; PG8_WAIT_L(0); PG8_MMA(0, 0, At, B0); PG8_BAR; PG8_SCHED;
            PG8_LDB(B1, 0, 1); PG8_STAGE(PG8_SB(0, 0), b2, voffB);
            PG8_BAR; PG8_WAIT_L(0); PG8_MMA(0, 1, At, B1); PG8_BAR;
            PG8_LDA(At, 0, 1); PG8_STAGE(PG8_SA(0, 0), a2, voffA);
            PG8_BAR; PG8_WAIT_L(0); PG8_MMA(1, 0, At, B0); PG8_BAR; PG8_SCHED;
            PG8_STAGE(PG8_SB(0, 1), b2 + hstep, voffB);
            PG8_WAIT_V(6); PG8_BAR; PG8_MMA(1, 1, At, B1); PG8_BAR;
            PG8_LDB(B0, 1, 0); PG8_SCHED; PG8_LDA(At, 1, 0); PG8_STAGE(PG8_SA(0, 1), a2 + hstep, voffA);
            PG8_WAIT_L(8); PG8_BAR; PG8_WAIT_L(0); PG8_MMA(0, 0, At, B0); PG8_BAR; PG8_SCHED;
            PG8_LDB(B1, 1, 1); PG8_STAGE(PG8_SB(1, 0), b3, voffB);
            PG8_BAR; PG8_WAIT_L(0); PG8_MMA(0, 1, At, B1); PG8_BAR;
            PG8_LDA(At, 1, 1); PG8_STAGE(PG8_SA(1, 0), a3, voffA);
            PG8_BAR; PG8_WAIT_L(0); PG8_MMA(1, 0, At, B0); PG8_BAR; PG8_SCHED;
            PG8_STAGE(PG8_SB(1, 1), b3 + hstep, voffB);
            PG8_WAIT_V(6); PG8_BAR; PG8_MMA(1, 1, At, B1); PG8_BAR;
            }
        }
        if constexpr (ALIGN_EPI) { if (wr == 0) PG8_BAR; }
        if constexpr (!Epi::AFTER_DRAIN) { E(acc, cur, wr, wc, fr, fq); S.done(cur); }
        if (!has_next) break;
#pragma unroll
        for (int a = 0; a < 2; ++a)
#pragma unroll
            for (int b = 0; b < 2; ++b)
#pragma unroll
                for (int m = 0; m < 4; ++m)
#pragma unroll
                    for (int n = 0; n < 2; ++n) acc[a][b][m][n] = (f32x4){0.f, 0.f, 0.f, 0.f};
        cur = nxt; cA = nA; cB = nB; ++ui;
        if constexpr (ALIGN_EPI) { if (wr == 1) PG8_BAR; }
    }
    PG8_WAIT_V(0);
    if constexpr (!ALIGN_EPI) { if (wr == 0) PG8_BAR; }
    PG8_BAR;
    if constexpr (Epi::AFTER_DRAIN) { E.fused(acc, cur, wr, wc, fr, fq, lds, wid, lane); S.done(cur); }
#undef PG8_SA
#undef PG8_SB
#undef PG8_STAGE
#undef PG8_LDA
#undef PG8_LDB
#undef PG8_MMA
#undef PG8_WAIT_V
#undef PG8_WAIT_L
#undef PG8_BAR
#undef PG8_SCHED
}
}
#define GAS __attribute__((address_space(1)))
#define LAS __attribute__((address_space(3)))
typedef GAS unsigned gu32;
typedef GAS unsigned long long gu64;
#define RLX_AGENT __ATOMIC_RELAXED, __HIP_MEMORY_SCOPE_AGENT
#define VM_WAIT() asm volatile("s_waitcnt vmcnt(0)" ::: "memory")
__device__ __forceinline__ unsigned long long rt() { return __builtin_amdgcn_s_memrealtime(); }
__device__ __forceinline__ unsigned f2bf(float f) { unsigned u = __builtin_bit_cast(unsigned, f); return (u + 0x7fffu + ((u >> 16) & 1u)) >> 16; }
__device__ __forceinline__ unsigned pk2(float lo, float hi) { return f2bf(lo) | (f2bf(hi) << 16); }

#define XB_TMO      128
#define XB_XCNT(j)  (256  + 64 * (j))
#define XB_XSUB(j)  (1280 + 64 * (j))
#define XB_XGEN(j)  (2304 + 64 * (j))
#define XB_TOP      3328
#define XB_TOPGEN   3392
#define XCD_BAR_WORDS 3456
#define XB_SPIN_CAP (1u << 18)

__device__ __forceinline__ unsigned xb_ld(unsigned* p)              { return __hip_atomic_load(p, __ATOMIC_RELAXED, __HIP_MEMORY_SCOPE_AGENT); }
__device__ __forceinline__ unsigned xb_add(unsigned* p, unsigned v) { return __hip_atomic_fetch_add(p, v, __ATOMIC_RELAXED, __HIP_MEMORY_SCOPE_AGENT); }
__device__ __forceinline__ unsigned xb_xcc_id() { return (unsigned)__builtin_amdgcn_s_getreg((3 << 11) | 20) & 0xFu; }
#define XB_SPIN(cond, bar) do { unsigned _sp = 0; while (cond) { __builtin_amdgcn_s_sleep(1); \
    if ((++_sp & 255u) == 0u) { if (xb_ld(&(bar)[XB_TMO])) break; if (_sp > XB_SPIN_CAP) { atomicAdd(&(bar)[XB_TMO], 1u); break; } } } } while (0)

struct XcdBarrier {
    unsigned* bar; unsigned x;
    volatile LAS unsigned* st;
};

__device__ __forceinline__ XcdBarrier xcd_barrier_post(unsigned* bar, volatile LAS unsigned* st) {
    XcdBarrier b; b.bar = bar; b.x = xb_xcc_id(); b.st = st;
    if (threadIdx.x == 0) (void)xb_add(&bar[XB_XCNT(b.x)], 1u);
    return b;
}
__device__ __forceinline__ void xcd_barrier_complete(unsigned* bar, unsigned x, unsigned& nloc, unsigned& nx) {
    const unsigned G = gridDim.x * gridDim.y * gridDim.z;
    unsigned sum, cnt, mine, sp = 0u;
    for (;;) {
        sum = 0u; cnt = 0u; mine = 0u;
#pragma unroll
        for (unsigned j = 0; j < 16; ++j) { const unsigned c = xb_ld(&bar[XB_XCNT(j)]); sum += c; cnt += (c > 0u) ? 1u : 0u; mine = (j == x) ? c : mine; }
        if (sum == G) break;
        __builtin_amdgcn_s_sleep(1);
        if ((++sp & 255u) == 0u) { if (xb_ld(&bar[XB_TMO])) break; if (sp > XB_SPIN_CAP) { atomicAdd(&bar[XB_TMO], 1u); break; } }
    }
    nloc = mine > 0u ? mine : 1u; nx = cnt > 0u ? cnt : 1u;
}

__device__ __forceinline__ void xcd_barrier(const XcdBarrier& b) {
    asm volatile("s_waitcnt vmcnt(0)" ::: "memory");
    __syncthreads();
    if (threadIdx.x == 0) {
        unsigned* bar = b.bar;
        __builtin_amdgcn_s_waitcnt(0);
        unsigned nloc = b.st[0], nx = b.st[1];
        if (nloc == 0u) { xcd_barrier_complete(bar, b.x, nloc, nx); b.st[0] = nloc; b.st[1] = nx; }
        const unsigned old = xb_add(&bar[XB_XSUB(b.x)], 1u);
        const unsigned gen = old / nloc;
        if (old + 1u == (gen + 1u) * nloc) {
            __builtin_amdgcn_fence(__ATOMIC_RELEASE, "agent");
            asm volatile("s_waitcnt vmcnt(0)" ::: "memory");
            const unsigned og = xb_add(&bar[XB_TOP], 1u);
            const unsigned tg = og / nx;
            if (og + 1u == (tg + 1u) * nx) xb_add(&bar[XB_TOPGEN], 1u);
            else XB_SPIN(xb_ld(&bar[XB_TOPGEN]) == tg, bar);
            __builtin_amdgcn_fence(__ATOMIC_ACQUIRE, "agent");
            xb_add(&bar[XB_XGEN(b.x)], 1u);
            asm volatile("s_waitcnt vmcnt(0)" ::: "memory");
        } else {
            XB_SPIN(xb_ld(&bar[XB_XGEN(b.x)]) == gen, bar);
            __builtin_amdgcn_fence(__ATOMIC_ACQUIRE, "agent");
            asm volatile("s_waitcnt vmcnt(0)" ::: "memory");
        }
    }
    __syncthreads();
}

using pg8::bf16_t; using pg8::bf16x8; using pg8::f32x4; using pg8::u32x4;
using pg8::DM; using pg8::MP; using pg8::MS; using pg8::MT; using pg8::DIN; using pg8::ZW;
using pg8::Z_GA; using pg8::Z_XB; using pg8::Z_GP; using pg8::Z_U; using pg8::Z_VS; using pg8::Z_GS; using pg8::LOG2E; using pg8::EPS;
typedef float f32x16 __attribute__((ext_vector_type(16)));
typedef unsigned u32x2 __attribute__((ext_vector_type(2)));
typedef short v4i16_t __attribute__((ext_vector_type(4)));

constexpr int NWAVES = 8, NTHREADS = 512;
constexpr int LDS_BYTES = 147456;
constexpr int RING_OFF = 1024;

constexpr size_t O_YP = 0, O_YS = 33554432, O_KP = 34603008, O_VP = 35127296, O_PP = 35651584, O_KS = 35774464, O_VS = 44163072, O_PS = 52551680, O_CV = 54517760, O_END = 55042048;
constexpr size_t LS_KP = 262144, LS_PP = 61440, LS_KS = 4194304, LS_PS = 983040, LS_CV = 262144;
constexpr size_t MiB = 1u << 20;
constexpr size_t WS_CTL = 0, CTL_ZERO_BYTES = 65536;
constexpr size_t WS_ROPE = 1 * MiB, WS_SGUW = 2 * MiB, WS_RSW = 2 * MiB + 256 * 1024, WS_PWT = 2 * MiB + 512 * 1024, WS_RSTD = 3 * MiB;
constexpr size_t WS_WTIN = 4 * MiB, WS_WTOUT = 44 * MiB, WS_H = 60 * MiB, WS_MIX = 126 * MiB, WS_QC = 192 * MiB, WS_KC = 225 * MiB, WS_VTP = 233 * MiB, WS_Z2 = 241 * MiB, WS_Y = 357 * MiB, WS_END = 489 * MiB;
constexpr int CW_BAR = 1024;

__constant__ double ROPE_INV[32] = {1.0, 0.7498942093324559, 0.5623413251903491, 0.4216965034285822, 0.31622776601683794, 0.23713737056616552, 0.1778279410038923, 0.1333521432163324, 0.1, 0.07498942093324558, 0.05623413251903491, 0.042169650342858224, 0.03162277660168379, 0.023713737056616554, 0.01778279410038923, 0.01333521432163324, 0.01, 0.007498942093324558, 0.005623413251903491, 0.004216965034285823, 0.0031622776601683794, 0.0023713737056616554, 0.0017782794100389228, 0.001333521432163324, 0.001, 0.0007498942093324559, 0.0005623413251903491, 0.00042169650342858224, 0.00031622776601683794, 0.00023713737056616554, 0.00017782794100389227, 0.0001333521432163324};

struct Args { const float* in[16]; float* out; unsigned char* ws; };

struct Frame {
    int tid, lane, wave, bid, G;
    const float *xp, *xs, *cache_k, *cache_v, *state_pool, *w_in, *w_out, *norm_pre, *norm_post, *sinks, *pool_w, *pool_scale, *ln_g, *ln_b, *sgu_w, *sgu_b;
    float* out;
    float* rope; float* RSW; float* RSTD; bf16_t *SGUW, *PWT, *WTIN, *WTOUT, *H, *MIX, *Qc, *Kc, *VTP, *Z2, *Yb;
};

__device__ __forceinline__ float wave_sum(float v) {
#pragma unroll
    for (int o = 1; o < 64; o <<= 1) v += __shfl_xor(v, o);
    return v;
}
__device__ __forceinline__ float wave_max(float v) {
#pragma unroll
    for (int o = 1; o < 64; o <<= 1) v = fmaxf(v, __shfl_xor(v, o));
    return v;
}
__device__ __forceinline__ float bflo(unsigned w) { return __uint_as_float(w << 16); }
__device__ __forceinline__ float bfhi(unsigned w) { return __uint_as_float(w & 0xffff0000u); }
__device__ __forceinline__ void unpack8(const u32x4 w, float (&f)[8]) { f[0] = bflo(w.x); f[1] = bfhi(w.x); f[2] = bflo(w.y); f[3] = bfhi(w.y); f[4] = bflo(w.z); f[5] = bfhi(w.z); f[6] = bflo(w.w); f[7] = bfhi(w.w); }
__device__ __forceinline__ void unpack4(const u32x2 w, float (&f)[4]) { f[0] = bflo(w.x); f[1] = bfhi(w.x); f[2] = bflo(w.y); f[3] = bfhi(w.y); }
__device__ __forceinline__ u32x4 pack8(const float (&f)[8]) { u32x4 w; w.x = pg8::cvt_pk_bf16(f[0], f[1]); w.y = pg8::cvt_pk_bf16(f[2], f[3]); w.z = pg8::cvt_pk_bf16(f[4], f[5]); w.w = pg8::cvt_pk_bf16(f[6], f[7]); return w; }
__device__ __forceinline__ int crow(int r, int hi) { return (r & 3) + 8 * (r >> 2) + 4 * hi; }
#define LDS_WAIT() asm volatile("s_waitcnt lgkmcnt(0)" ::: "memory")


struct ArgsG { const __attribute__((address_space(1))) float* in[16]; __attribute__((address_space(1))) float* out; __attribute__((address_space(1))) unsigned char* ws; };
typedef const __attribute__((address_space(4))) ArgsG* KArgs;
__device__ __forceinline__ KArgs kargs() { KArgs p = (KArgs)__builtin_amdgcn_kernarg_segment_ptr(); asm volatile("" : "+s"(p)); return p; }
__device__ __forceinline__ void make_frame(Frame& F, KArgs a) {
    { int t_ = threadIdx.x; asm volatile("" : "+v"(t_)); F.tid = t_; } F.lane = F.tid & 63; F.wave = __builtin_amdgcn_readfirstlane(F.tid >> 6); F.bid = blockIdx.x; F.G = gridDim.x;
    F.xp = (const float*)a->in[0]; F.xs = (const float*)a->in[1]; F.cache_k = (const float*)a->in[2]; F.cache_v = (const float*)a->in[3]; F.state_pool = (const float*)a->in[4]; F.w_in = (const float*)a->in[5]; F.w_out = (const float*)a->in[6]; F.norm_pre = (const float*)a->in[7]; F.norm_post = (const float*)a->in[8];
    F.sinks = (const float*)a->in[9]; F.pool_w = (const float*)a->in[10]; F.pool_scale = (const float*)a->in[11]; F.ln_g = (const float*)a->in[12]; F.ln_b = (const float*)a->in[13]; F.sgu_w = (const float*)a->in[14]; F.sgu_b = (const float*)a->in[15];
    F.out = (float*)a->out;
    unsigned char* ws = (unsigned char*)a->ws;
    F.rope = (float*)(ws + WS_ROPE); F.RSW = (float*)(ws + WS_RSW); F.RSTD = (float*)(ws + WS_RSTD); F.SGUW = (bf16_t*)(ws + WS_SGUW); F.PWT = (bf16_t*)(ws + WS_PWT); F.WTIN = (bf16_t*)(ws + WS_WTIN); F.WTOUT = (bf16_t*)(ws + WS_WTOUT);
    F.H = (bf16_t*)(ws + WS_H); F.MIX = (bf16_t*)(ws + WS_MIX); F.Qc = (bf16_t*)(ws + WS_QC); F.Kc = (bf16_t*)(ws + WS_KC); F.VTP = (bf16_t*)(ws + WS_VTP); F.Z2 = (bf16_t*)(ws + WS_Z2); F.Yb = (bf16_t*)(ws + WS_Y);
}

#define LOCAL_FRAME Frame F; make_frame(F, kargs())

constexpr int CW_Q = 8192;
constexpr int CW_ZS = 8192 + 64 * 8;
constexpr int CW_YS = 8192 + 64 * 16;
constexpr int CW_EV = 8192 + 64 * 32;
__device__ __forceinline__ unsigned* ctl_word(int idx) { return (unsigned*)((unsigned char*)kargs()->ws + WS_CTL) + idx; }
__device__ __forceinline__ int q_pop(unsigned* head, LAS unsigned char* L) {
    volatile LAS int* slot = (volatile LAS int*)(L + 64);
    __syncthreads();
    if (threadIdx.x == 0) *slot = (int)__hip_atomic_fetch_add(head, 1u, __ATOMIC_RELAXED, __HIP_MEMORY_SCOPE_AGENT);
    __syncthreads();
    return __builtin_amdgcn_readfirstlane(*slot);
}
__device__ __forceinline__ void publish(unsigned* ctr) {
    asm volatile("s_waitcnt vmcnt(0)" ::: "memory");
    __syncthreads();
    if (threadIdx.x == 0) { __builtin_amdgcn_fence(__ATOMIC_RELEASE, "agent"); asm volatile("s_waitcnt vmcnt(0)" ::: "memory");
        __hip_atomic_fetch_add(ctr, 1u, __ATOMIC_RELAXED, __HIP_MEMORY_SCOPE_AGENT); }
}
__device__ __forceinline__ void dep_wait(unsigned* ctr, unsigned need) {
    if (threadIdx.x == 0) {
        unsigned sp = 0;
        while (__hip_atomic_load(ctr, __ATOMIC_RELAXED, __HIP_MEMORY_SCOPE_AGENT) < need) { __builtin_amdgcn_s_sleep(16); if (++sp > (1u << 21)) break; }
        __builtin_amdgcn_fence(__ATOMIC_ACQUIRE, "agent"); asm volatile("s_waitcnt vmcnt(0)" ::: "memory");
    }
    __syncthreads();
}

#if PROBE_SEL >= 10
#define EV_T0() const unsigned long long ev_t0 = __builtin_amdgcn_s_memrealtime()
#define EV_MAX(k) do { if (threadIdx.x == 0) __hip_atomic_fetch_max(ctl_word(CW_EV + 64 * (k)), (unsigned)(__builtin_amdgcn_s_memrealtime() - ev_t0), __ATOMIC_RELAXED, __HIP_MEMORY_SCOPE_AGENT); } while (0)
#define EV_MIN(k) do { if (threadIdx.x == 0) __hip_atomic_fetch_max(ctl_word(CW_EV + 64 * (k)), 0x40000000u - (unsigned)(__builtin_amdgcn_s_memrealtime() - ev_t0), __ATOMIC_RELAXED, __HIP_MEMORY_SCOPE_AGENT); } while (0)
#else
#define EV_T0() do {} while (0)
#define EV_MAX(k) do {} while (0)
#define EV_MIN(k) do {} while (0)
#endif
struct OneUnit {
    pg8::Unit u;
    __device__ __forceinline__ bool next(int i, pg8::Unit& o) const { if (i) return false; o = u; return true; }
    __device__ __forceinline__ void a_ready(const pg8::Unit&) const {}
    __device__ __forceinline__ void done(const pg8::Unit&) const {}
};

#ifndef PROBE_SEL
#define PROBE_SEL 0
#endif
#if PROBE_SEL
#define STAMP(k) do { if (blockIdx.x == 0 && threadIdx.x == 0) ((LAS unsigned long long*)(L + 256))[k] = __builtin_amdgcn_s_memrealtime(); } while (0)
#define STAMP2(k) do { if (blockIdx.x == 0) { __syncthreads(); if (threadIdx.x == 0) ((LAS unsigned long long*)((LAS unsigned char*)ring - RING_OFF + 256))[k] = __builtin_amdgcn_s_memrealtime(); } } while (0)
#else
#define STAMP(k) do {} while (0)
#define STAMP2(k) do {} while (0)
#endif
#if PROBE_SEL == 1
#define PA0 0
#define PA1 1
#define PB0 1
#define PB1 2
#elif PROBE_SEL == 2
#define PA0 2
#define PA1 3
#define PB0 3
#define PB1 4
#elif PROBE_SEL == 3
#define PA0 4
#define PA1 5
#define PB0 8
#define PB1 9
#elif PROBE_SEL == 4
#define PA0 2
#define PA1 10
#define PB0 10
#define PB1 11
#elif PROBE_SEL == 5
#define PA0 11
#define PA1 12
#define PB0 12
#define PB1 13
#elif PROBE_SEL == 7
#define PA0 1
#define PA1 2
#define PB0 0
#define PB1 1
#elif PROBE_SEL == 8
#define PA0 3
#define PA1 4
#define PB0 2
#define PB1 3
#elif PROBE_SEL == 9
#define PA0 6
#define PA1 7
#define PB0 4
#define PB1 5
#elif PROBE_SEL == 6
#define PA0 5
#define PA1 6
#define PB0 7
#define PB1 8
#elif PROBE_SEL == 10
#define PEA 0
#define PEA_MIN 0
#define PEB 1
#define PEB_MIN 1
#elif PROBE_SEL == 11
#define PEA 2
#define PEA_MIN 0
#define PEB 3
#define PEB_MIN 1
#elif PROBE_SEL == 12
#define PEA 4
#define PEA_MIN 0
#define PEB 5
#define PEB_MIN 0
#elif PROBE_SEL == 14
#define PEA 8
#define PEA_MIN 0
#define PEB 9
#define PEB_MIN 0
#elif PROBE_SEL == 13
#define PEA 6
#define PEA_MIN 1
#define PEB 7
#define PEB_MIN 0
#endif

__device__ __forceinline__ void p0_transpose_blk(const float* W, int K, int N, bf16_t* WT, bool permqk, const float* kgain, LAS unsigned char* T, int item, int tid) {
    const int nblk = N >> 8, kb = item / nblk, nb = item - kb * nblk, k0 = kb * 128, n0 = nb * 256;
    const int n4 = tid & 63, kr = tid >> 6;
    f32x4 v[16];
#pragma unroll
    for (int i = 0; i < 16; ++i) v[i] = __builtin_nontemporal_load((const f32x4*)(W + (size_t)(k0 + 16 * kr + i) * N + n0 + 4 * n4));
    if (kgain) {
        const float* gp = kgain + k0 + 16 * kr;
#pragma unroll
        for (int i4 = 0; i4 < 4; ++i4) { const f32x4 gg = *(const f32x4*)(gp + 4 * i4);
#pragma unroll
            for (int j = 0; j < 4; ++j) v[4 * i4 + j] = v[4 * i4 + j] * gg[j]; }
    }
#pragma unroll
    for (int e = 0; e < 4; ++e) {
        u32x4 lo, hi;
        lo.x = pg8::cvt_pk_bf16(v[0][e], v[1][e]); lo.y = pg8::cvt_pk_bf16(v[2][e], v[3][e]); lo.z = pg8::cvt_pk_bf16(v[4][e], v[5][e]); lo.w = pg8::cvt_pk_bf16(v[6][e], v[7][e]);
        hi.x = pg8::cvt_pk_bf16(v[8][e], v[9][e]); hi.y = pg8::cvt_pk_bf16(v[10][e], v[11][e]); hi.z = pg8::cvt_pk_bf16(v[12][e], v[13][e]); hi.w = pg8::cvt_pk_bf16(v[14][e], v[15][e]);
        LAS unsigned char* p = T + (64 * e + n4) * 272 + 32 * kr;
        *(LAS u32x4*)p = lo; *(LAS u32x4*)(p + 16) = hi;
    }
    LDS_WAIT();
    __syncthreads();
    {
        const int rho = tid >> 1, half = tid & 1, n = n0 + 4 * (rho & 63) + (rho >> 6);
        int nrow = n;
        if (permqk && n < 1280) { const int p = n & 63; nrow = (n & ~63) + 2 * (p & 31) + (p >> 5); }
        const LAS unsigned char* src = T + rho * 272 + 128 * half;
        bf16_t* dst = WT + (size_t)nrow * K + k0 + 64 * half;
        u32x4 o[8];
#pragma unroll
        for (int c = 0; c < 8; ++c) o[c] = *(const LAS u32x4*)(src + 16 * c);
#pragma unroll
        for (int c = 0; c < 8; ++c) *(u32x4*)(dst + 8 * c) = o[c];
    }
    LDS_WAIT();
    __syncthreads();
}
__device__ __forceinline__ void prenorm_finish(const f32x4 (&v)[8], bf16_t* hrow, int lane) {
    float ss = 0.f;
#pragma unroll
    for (int j = 0; j < 8; ++j) ss += (v[j][0] * v[j][0] + v[j][1] * v[j][1]) + (v[j][2] * v[j][2] + v[j][3] * v[j][3]);
    ss = wave_sum(ss);
    const float r = rsqrtf(ss * (1.0f / 2048.0f) + EPS);
#pragma unroll
    for (int j = 0; j < 8; ++j) { const f32x4 o = v[j] * r; u32x2 w; w.x = pg8::cvt_pk_bf16(o[0], o[1]); w.y = pg8::cvt_pk_bf16(o[2], o[3]); *(u32x2*)(hrow + 4 * lane + 256 * j) = w; }
}
constexpr int TR_IN = 16 * 20, TR_OUT = 16 * 8, TR_ITEMS = TR_IN + TR_OUT;
__device__ __forceinline__ void transpose_item(const Frame& F, int l, int r, LAS unsigned char* ring) {
    if (r < TR_IN) p0_transpose_blk(F.w_in + (size_t)l * DM * DIN, DM, DIN, F.WTIN + (size_t)l * DIN * DM, true, F.norm_pre + l * DM, ring, r, F.tid);
    else p0_transpose_blk(F.w_out + (size_t)l * DM * DM, DM, DM, F.WTOUT + (size_t)l * DM * DM, false, nullptr, ring, r - TR_IN, F.tid);
}
__device__ __forceinline__ void p0_prologue(const Frame& F, LAS unsigned char* ring) {
    const int gw = F.bid * NWAVES + F.wave, NGW = F.G * NWAVES;
    EV_T0();
    for (int it = F.bid; it < TR_ITEMS; it += F.G) transpose_item(F, 0, it, ring);
    __syncthreads(); EV_MAX(8);
    for (int m = 2 * gw; m < MT; m += 2 * NGW) {
        const float* xa = m < MP ? F.xp + (size_t)m * DM : F.xs + (size_t)(m - MP) * DM; const float* xb = (m + 1) < MP ? F.xp + (size_t)(m + 1) * DM : F.xs + (size_t)(m + 1 - MP) * DM;
        f32x4 va[8], vb[8];
#pragma unroll
        for (int j = 0; j < 8; ++j) { va[j] = __builtin_nontemporal_load((const f32x4*)(xa + 4 * F.lane + 256 * j)); vb[j] = __builtin_nontemporal_load((const f32x4*)(xb + 4 * F.lane + 256 * j)); }
        prenorm_finish(va, F.H + (size_t)m * DM, F.lane); prenorm_finish(vb, F.H + (size_t)(m + 1) * DM, F.lane); }
    __syncthreads(); EV_MAX(9);
    const int gt = F.bid * NTHREADS + F.tid, NGT = F.G * NTHREADS;
    for (int e = gt; e < 2052 * 32; e += NGT) { const int tp = e >> 5, i = e & 31; const double pos = (double)(tp < 2048 ? tp : 8192 + (tp - 2048));
        const double rev = pos * ROPE_INV[i] * 0.15915494309189535; const float fr = (float)(rev - floor(rev));
        F.rope[tp * 64 + i] = __builtin_amdgcn_cosf(fr); F.rope[tp * 64 + 32 + i] = __builtin_amdgcn_sinf(fr); }
    for (int e = gt; e < 2 * 4 * 128 * 128; e += NGT) { const int s = e & 127, t = (e >> 7) & 127; const float w = F.sgu_w[e];
        F.SGUW[e] = (bf16_t)(pg8::cvt_pk_bf16(s <= t ? w : 0.f, 0.f) & 0xffffu); }
    for (int e = gt; e < 2 * 4 * 128; e += NGT) { const int t = e & 127; const float* wr = F.sgu_w + (size_t)e * 128; float acc = 0.f;
        for (int s2 = 0; s2 <= t; ++s2) acc += __uint_as_float(pg8::cvt_pk_bf16(wr[s2], 0.f) << 16);
        F.RSW[e] = acc; }
    for (int e = gt; e < 2 * 4 * 128 * 128; e += NGT) { const int c = e & 127, d = (e >> 7) & 127, lg = e >> 14;
        F.PWT[e] = (bf16_t)(pg8::cvt_pk_bf16(F.pool_w[((size_t)lg * 128 + c) * 128 + d], 0.f) & 0xffffu); }
}

constexpr int AT_K = 0, AT_V = 49152, AT_STG = 98304, AT_WSTRIDE = 4352;
__device__ __forceinline__ void attn_stage_kv(const Frame& F, int b, int kvh, int nbp, LAS unsigned char* ring) {
    const int tid = F.tid;
    const bf16_t* kg = F.Kc + ((size_t)(b * 4 + kvh) * 2048 + 256 * nbp - 128) * 64;
    const bf16_t* vg = F.VTP + ((size_t)(b * 4 + kvh) * 64 + 8 * nbp - 4) * 2048;
    u32x4 kv[6], vv[6];
#pragma unroll
    for (int i = 0; i < 6; ++i) { const int ch = tid + 512 * i, row0 = ch >> 3, c8 = ch & 7, row = (nbp > 0 || row0 >= 128) ? row0 : row0 + 128;
        kv[i] = __builtin_nontemporal_load((const u32x4*)(kg + row * 64 + c8 * 8)); }
#pragma unroll
    for (int i = 0; i < 6; ++i) { const int ch = tid + 512 * i, tile0 = ch >> 8, rem = ch & 255, d = rem >> 2, c4 = rem & 3, tile = (nbp > 0 || tile0 >= 4) ? tile0 : tile0 + 4;
        vv[i] = __builtin_nontemporal_load((const u32x4*)(vg + tile * 2048 + d * 32 + c4 * 8)); }
#pragma unroll
    for (int i = 0; i < 6; ++i) { const int ch = tid + 512 * i, row = ch >> 3, c8 = ch & 7;
        *(LAS u32x4*)(ring + AT_K + row * 128 + ((c8 ^ (row & 7)) << 4)) = kv[i]; }
#pragma unroll
    for (int i = 0; i < 6; ++i) { const int ch = tid + 512 * i, tile = ch >> 8, rem = ch & 255, d = rem >> 2, c4 = rem & 3;
        *(LAS u32x4*)(ring + AT_V + tile * 4096 + d * 64 + ((c4 ^ ((d >> 2) & 3)) << 4)) = vv[i]; }
}
__device__ __forceinline__ void attn_task(const Frame& F, int l, int b, int nbp, int head, int j, const bf16x8 (&qf)[4], LAS unsigned char* ring) {
    const int lane = F.lane, r = lane & 31, hh = lane >> 5;
    LAS unsigned char* wl = ring + AT_STG + F.wave * AT_WSTRIDE;
    LAS float* wsf = (LAS float*)wl; LAS bf16_t* stg = (LAS bf16_t*)(wl + 256);
    const size_t qrow0 = (size_t)b * 2048 + 256 * nbp + 32 * j;
    u32x4 gv[4];
#pragma unroll
    for (int i = 0; i < 4; ++i) gv[i] = __builtin_nontemporal_load((const u32x4*)(F.Z2 + (qrow0 + i * 8 + (lane >> 3)) * ZW + Z_GA + head * 64 + (lane & 7) * 8));
    const int cmin = (nbp > 0) ? 0 : (j < 4 ? 4 - j : 0);
    f32x16 S[5];
#pragma unroll
    for (int c = 0; c < 5; ++c) {
        f32x16 a;
#pragma unroll
        for (int i = 0; i < 16; ++i) a[i] = 0.f;
        if (c >= cmin) {
            LAS unsigned char* kp = ring + AT_K + (32 * (j + c) + r) * 128;
#pragma unroll
            for (int s = 0; s < 4; ++s) a = __builtin_amdgcn_mfma_f32_32x32x16_bf16(*(const LAS bf16x8*)(kp + (((2 * s + hh) ^ (r & 7)) << 4)), qf[s], a, 0, 0, 0);
        }
        S[c] = a;
    }
    const float NEG = -INFINITY;
#pragma unroll
    for (int i = 0; i < 16; ++i) { const int kap = crow(i, hh); if (kap <= r) S[0][i] = NEG; if (kap > r) S[4][i] = NEG; }
    const float sink2 = F.sinks[l * 16 + head] * LOG2E;
    float m = sink2;
#pragma unroll
    for (int c = 0; c < 5; ++c) if (c >= cmin) {
#pragma unroll
        for (int i = 0; i < 16; ++i) m = fmaxf(m, S[c][i]); }
    m = fmaxf(m, __shfl_xor(m, 32));
    float sum = 0.f;
#pragma unroll
    for (int c = 0; c < 5; ++c) if (c >= cmin) {
#pragma unroll
        for (int i = 0; i < 16; ++i) { const float p = __builtin_amdgcn_exp2f(S[c][i] - m); S[c][i] = p; sum += p; } }
    sum += __shfl_xor(sum, 32);
    const float inv = 1.0f / (sum + __builtin_amdgcn_exp2f(sink2 - m));
    f32x16 o[2];
#pragma unroll
    for (int i = 0; i < 16; ++i) { o[0][i] = 0.f; o[1][i] = 0.f; }
#pragma unroll
    for (int c = 0; c < 5; ++c) if (c >= cmin) {
        LAS unsigned char* vt = ring + AT_V + (j + c) * 4096 + r * 64;
#pragma unroll
        for (int s = 0; s < 2; ++s) {
            u32x4 pw; pw.x = pg8::cvt_pk_bf16(S[c][8 * s + 0], S[c][8 * s + 1]); pw.y = pg8::cvt_pk_bf16(S[c][8 * s + 2], S[c][8 * s + 3]);
            pw.z = pg8::cvt_pk_bf16(S[c][8 * s + 4], S[c][8 * s + 5]); pw.w = pg8::cvt_pk_bf16(S[c][8 * s + 6], S[c][8 * s + 7]);
            const bf16x8 pa = __builtin_bit_cast(bf16x8, pw);
            const int sw = (((2 * hh + s) ^ ((r >> 2) & 3)) << 4);
#pragma unroll
            for (int db = 0; db < 2; ++db) o[db] = __builtin_amdgcn_mfma_f32_32x32x16_bf16(pa, *(const LAS bf16x8*)(vt + db * 2048 + sw), o[db], 0, 0, 0);
        }
    }
    if (hh == 0) wsf[r] = inv;
    LDS_WAIT();
#pragma unroll
    for (int i = 0; i < 16; ++i) { const int q = crow(i, hh); const float rl = wsf[q];
        stg[q * 64 + r] = (bf16_t)(pg8::cvt_pk_bf16(o[0][i] * rl, 0.f) & 0xffffu);
        stg[q * 64 + 32 + r] = (bf16_t)(pg8::cvt_pk_bf16(o[1][i] * rl, 0.f) & 0xffffu); }
    LDS_WAIT();
#pragma unroll
    for (int i = 0; i < 4; ++i) { const int row = i * 8 + (lane >> 3), ch = lane & 7;
        const u32x4 ov = *(const LAS u32x4*)(stg + row * 64 + ch * 8);
        float of[8], gf[8]; unpack8(ov, of); unpack8(gv[i], gf);
#pragma unroll
        for (int jj = 0; jj < 8; ++jj) of[jj] *= gf[jj];
        *(u32x4*)(F.MIX + (qrow0 + row) * DM + head * 64 + ch * 8) = pack8(of); }
    LDS_WAIT();
}
__device__ __forceinline__ void attn_unit(int l, int a, LAS unsigned char* ring) {
    LOCAL_FRAME;
    const int kvh = a & 3, nbp = (a >> 2) & 7, b = a >> 5;
    const int lane = F.lane, r = lane & 31, hh = lane >> 5;
    const int head = 4 * kvh + (F.wave >> 1), j0 = 4 * (F.wave & 1);
    const bf16_t* qp = F.Qc + ((size_t)b * 2048 + 256 * nbp + 32 * j0 + r) * 1024 + head * 64 + 8 * hh;
    bf16x8 qa[4], qb[4];
#pragma unroll
    for (int s = 0; s < 4; ++s) qa[s] = __builtin_nontemporal_load((const bf16x8*)(qp + 16 * s));
#ifdef EXP_ZERO_LDS
    for (int e = F.tid; e < 134144 / 16; e += NTHREADS) *(LAS u32x4*)(ring + 16 * e) = (u32x4){0u, 0u, 0u, 0u};
    LDS_WAIT(); __syncthreads();
#endif
    attn_stage_kv(F, b, kvh, nbp, ring);
    LDS_WAIT();
    __syncthreads();
#pragma unroll
    for (int s = 0; s < 4; ++s) qb[s] = __builtin_nontemporal_load((const bf16x8*)(qp + 32 * 1024 + 16 * s));
    attn_task(F, l, b, nbp, head, j0 + 0, qa, ring);
#pragma unroll
    for (int s = 0; s < 4; ++s) qa[s] = __builtin_nontemporal_load((const bf16x8*)(qp + 64 * 1024 + 16 * s));
    attn_task(F, l, b, nbp, head, j0 + 1, qb, ring);
#pragma unroll
    for (int s = 0; s < 4; ++s) qb[s] = __builtin_nontemporal_load((const bf16x8*)(qp + 96 * 1024 + 16 * s));
    attn_task(F, l, b, nbp, head, j0 + 2, qa, ring);
    attn_task(F, l, b, nbp, head, j0 + 3, qb, ring);
    __syncthreads();
}

constexpr int PL_STRIDE = 272, PL_WBYTES = 47 * 272;
template <int G>
__device__ __forceinline__ void pool_unit_p(int l, int tile, LAS unsigned char* wl) {
    LOCAL_FRAME;
    constexpr int W = 2 << G, HIST = W - 1, NROW = 32 + HIST, NLD = (NROW * 16 + 63) / 64;
    const int lane = F.lane, r = lane & 31, hh = lane >> 5;
    const size_t R0 = (size_t)32 * tile;
    const int t0 = (int)(R0 & 2047);
    {
        u32x4 x[NLD];
#pragma unroll
        for (int k = 0; k < NLD; ++k) { const int id = lane + 64 * k, lr = id >> 4, c16 = id & 15; const int lrc = lr < NROW ? lr : NROW - 1;
            const int back = HIST - lrc; const size_t grow = (back <= t0) ? R0 - back : R0;
            x[k] = __builtin_nontemporal_load((const u32x4*)(F.Z2 + grow * ZW + Z_XB + 128 * G + 8 * c16)); }
#pragma unroll
        for (int k = 0; k < NLD; ++k) { const int id = lane + 64 * k, lr = id >> 4, c16 = id & 15; if (lr < NROW) *(LAS u32x4*)(wl + lr * PL_STRIDE + c16 * 16) = x[k]; }
    }
    const int t = t0 + r;
    const float icnt = 1.0f / (float)(W < t + 1 ? W : t + 1);
    LDS_WAIT();
    bf16x8 bfr[8];
#pragma unroll
    for (int s = 0; s < 8; ++s) {
        LAS unsigned char* bp = wl + (r + HIST) * PL_STRIDE + (16 * s + 8 * hh) * 2;
        float cur[8], sum[8]; unpack8(*(const LAS u32x4*)bp, cur);
#pragma unroll
        for (int jj = 0; jj < 8; ++jj) sum[jj] = cur[jj];
#pragma unroll
        for (int i = 1; i < W; ++i) { float f[8]; unpack8(*(const LAS u32x4*)(bp - i * PL_STRIDE), f); const float wgt = i <= t ? 1.f : 0.f;
#pragma unroll
            for (int jj = 0; jj < 8; ++jj) sum[jj] += wgt * f[jj]; }
#pragma unroll
        for (int jj = 0; jj < 8; ++jj) sum[jj] = sum[jj] * icnt - cur[jj];
        bfr[s] = __builtin_bit_cast(bf16x8, pack8(sum));
        __builtin_amdgcn_sched_barrier(0);
    }
#pragma unroll
    for (int db = 0; db < 4; ++db) {
        const int col = 128 * G + 32 * db + r;
        unsigned short gq[16];
#pragma unroll
        for (int i = 0; i < 16; ++i) gq[i] = __builtin_nontemporal_load(F.Z2 + (R0 + crow(i, hh)) * ZW + Z_GP + col);
        const float sc = F.pool_scale[l * 512 + col];
        f32x16 acc;
#pragma unroll
        for (int i = 0; i < 16; ++i) acc[i] = 0.f;
        const bf16_t* bp2 = F.PWT + ((size_t)(l * 4 + G) * 128 + 32 * db + r) * 128 + 8 * hh;
#pragma unroll
        for (int s = 0; s < 8; ++s) acc = __builtin_amdgcn_mfma_f32_32x32x16_bf16(bfr[s], *(const bf16x8*)(bp2 + 16 * s), acc, 0, 0, 0);
#pragma unroll
        for (int i = 0; i < 16; ++i) { const float gf = __uint_as_float((unsigned)gq[i] << 16);
            F.MIX[(R0 + crow(i, hh)) * DM + 1024 + col] = (bf16_t)(pg8::cvt_pk_bf16(acc[i] * sc * gf, 0.f) & 0xffffu); }
        __builtin_amdgcn_sched_barrier(0);
    }
    LDS_WAIT();
}
__device__ __forceinline__ void pool_prompt(int l, int g, int tile, LAS unsigned char* wl) {
    if (g == 0) pool_unit_p<0>(l, tile, wl); else if (g == 1) pool_unit_p<1>(l, tile, wl); else if (g == 2) pool_unit_p<2>(l, tile, wl); else pool_unit_p<3>(l, tile, wl);
}
template <int G>
__device__ __forceinline__ void pool_unit_s(int l, int tile) {
    LOCAL_FRAME;
    constexpr int W = 2 << G;
    const int lane = F.lane, r = lane & 31, hh = lane >> 5;
    const size_t row = (size_t)MP + 32 * tile + r;
    const int tt = (int)(row & 3), bd = (int)((row - MP) >> 2);
    const float* stb = F.state_pool + ((size_t)l * 128 + bd) * 15 * 512;
    const float icnt = 1.0f / (float)W;
    bf16x8 bfr[8];
#pragma unroll
    for (int s = 0; s < 8; ++s) {
        const int c0 = 128 * G + 16 * s + 8 * hh;
        float sum[8], cur[8];
        {
            constexpr int NL = W < 4 ? W : 4;
            u32x4 zn[NL]; f32x4 sa[NL], sb[NL];
#pragma unroll
            for (int i = 0; i < NL; ++i) { const int back = i <= tt ? i : tt; int si = 15 + tt - i; si = si > 14 ? 14 : si;
                zn[i] = *(const u32x4*)(F.Z2 + (row - back) * ZW + Z_XB + c0); sa[i] = *(const f32x4*)(stb + si * 512 + c0); sb[i] = *(const f32x4*)(stb + si * 512 + c0 + 4); }
            unpack8(zn[0], cur);
#pragma unroll
            for (int jj = 0; jj < 8; ++jj) sum[jj] = cur[jj];
#pragma unroll
            for (int i = 1; i < NL; ++i) { float f[8]; unpack8(zn[i], f); const bool nw = i <= tt;
#pragma unroll
                for (int jj = 0; jj < 4; ++jj) { sum[jj] += nw ? f[jj] : sa[i][jj]; sum[4 + jj] += nw ? f[4 + jj] : sb[i][jj]; } }
        }
#pragma unroll
        for (int i0 = 4; i0 < W; i0 += 4) {
            f32x4 sa[4], sb[4];
#pragma unroll
            for (int i = 0; i < 4; ++i) { const int si = 15 + tt - (i0 + i); sa[i] = *(const f32x4*)(stb + si * 512 + c0); sb[i] = *(const f32x4*)(stb + si * 512 + c0 + 4); }
#pragma unroll
            for (int i = 0; i < 4; ++i)
#pragma unroll
                for (int jj = 0; jj < 4; ++jj) { sum[jj] += sa[i][jj]; sum[4 + jj] += sb[i][jj]; }
        }
#pragma unroll
        for (int jj = 0; jj < 8; ++jj) sum[jj] = sum[jj] * icnt - cur[jj];
        bfr[s] = __builtin_bit_cast(bf16x8, pack8(sum));
        __builtin_amdgcn_sched_barrier(0);
    }
    f32x16 acc[4];
#pragma unroll
    for (int db = 0; db < 4; ++db) {
#pragma unroll
        for (int i = 0; i < 16; ++i) acc[db][i] = 0.f;
        const bf16_t* ap = F.PWT + ((size_t)(l * 4 + G) * 128 + 32 * db + r) * 128 + 8 * hh;
#pragma unroll
        for (int s = 0; s < 8; ++s) acc[db] = __builtin_amdgcn_mfma_f32_32x32x16_bf16(*(const bf16x8*)(ap + 16 * s), bfr[s], acc[db], 0, 0, 0);
        __builtin_amdgcn_sched_barrier(0);
    }
#pragma unroll
    for (int db = 0; db < 4; ++db)
#pragma unroll
        for (int q = 0; q < 4; ++q) {
            const int col = 128 * G + 32 * db + 8 * q + 4 * hh;
            const f32x4 sc = *(const f32x4*)(F.pool_scale + l * 512 + col);
            float gf[4]; unpack4(*(const u32x2*)(F.Z2 + row * ZW + Z_GP + col), gf);
            u32x2 wv; wv.x = pg8::cvt_pk_bf16(acc[db][4 * q + 0] * sc[0] * gf[0], acc[db][4 * q + 1] * sc[1] * gf[1]);
            wv.y = pg8::cvt_pk_bf16(acc[db][4 * q + 2] * sc[2] * gf[2], acc[db][4 * q + 3] * sc[3] * gf[3]);
            *(u32x2*)(F.MIX + row * DM + 1024 + col) = wv;
        }
}
__device__ __forceinline__ void pool_sample(int l, int g, int tile) {
    if (g == 0) pool_unit_s<0>(l, tile); else if (g == 1) pool_unit_s<1>(l, tile); else if (g == 2) pool_unit_s<2>(l, tile); else pool_unit_s<3>(l, tile);
}

struct SguOps { bf16x8 wB[8], wA[4]; };
__device__ __forceinline__ void sgu_load_ops(SguOps& o, const Frame& F, int l, int hd, size_t R0, int r, int hh, int db, int tbA, int tbB) {
    const bf16_t* Wb = F.SGUW + (size_t)(l * 4 + hd) * 128 * 128;
#pragma unroll
    for (int s = 0; s < 8; ++s) { o.wB[s] = (bf16x8){0, 0, 0, 0, 0, 0, 0, 0}; if (s < 2 * (tbB + 1)) o.wB[s] = *(const bf16x8*)(Wb + (32 * tbB + r) * 128 + 16 * s + 8 * hh); }
#pragma unroll
    for (int s = 0; s < 4; ++s) { o.wA[s] = (bf16x8){0, 0, 0, 0, 0, 0, 0, 0}; if (s < 2 * (tbA + 1)) o.wA[s] = *(const bf16x8*)(Wb + (32 * tbA + r) * 128 + 16 * s + 8 * hh); }
}
constexpr int SG_TOFF = 81920, SG_TBYTES = 32 * 144;
struct SguUG { u32x4 uu[2], gg[2]; };
__device__ __forceinline__ void sgu_load_ug(SguUG& o, const Frame& F, int hd, size_t R0, int lane, int db, int tb) {
#pragma unroll
    for (int k = 0; k < 2; ++k) { const int id = lane + 64 * k; const size_t row = R0 + 32 * tb + (id >> 2); const int col = 128 * hd + 32 * db + 8 * (id & 3);
        o.uu[k] = __builtin_nontemporal_load((const u32x4*)(F.Z2 + row * ZW + Z_U + col)); o.gg[k] = __builtin_nontemporal_load((const u32x4*)(F.Z2 + row * ZW + Z_GS + col)); }
}
__device__ __forceinline__ void sgu_mfma(const SguOps& o, LAS bf16_t* VnT, int h2, int r, int hh, int db, int tbA, int tbB, f32x16& accA, f32x16& accB) {
#pragma unroll
    for (int i = 0; i < 16; ++i) { accA[i] = 0.f; accB[i] = 0.f; }
#pragma unroll
    for (int s = 0; s < 8; ++s) {
        if (s < 2 * (tbB + 1)) {
            const LAS unsigned char* ap = (const LAS unsigned char*)VnT + (h2 * 128 + 16 * s + 8 * hh + ((r & 15) >> 2)) * 320 + (32 * db + (r & 16) + 4 * (r & 3)) * 2;
            const v4i16_t lo = __builtin_amdgcn_ds_read_tr16_b64_v4i16((LAS v4i16_t*)ap), hi = __builtin_amdgcn_ds_read_tr16_b64_v4i16((LAS v4i16_t*)(ap + 4 * 320));
            const bf16x8 a = (bf16x8){lo[0], lo[1], lo[2], lo[3], hi[0], hi[1], hi[2], hi[3]};
            accB = __builtin_amdgcn_mfma_f32_32x32x16_bf16(a, o.wB[s], accB, 0, 0, 0);
            if (s < 4) { if (s < 2 * (tbA + 1)) accA = __builtin_amdgcn_mfma_f32_32x32x16_bf16(a, o.wA[s], accA, 0, 0, 0); }
        }
    }
}
__device__ __forceinline__ void sgu_epi(const SguUG& o, const Frame& F, int l, int hd, size_t R0, int lane, int db, int tb, const f32x16& acc, LAS unsigned char* T) {
    const int r = lane & 31, hh = lane >> 5;
#pragma unroll
    for (int q = 0; q < 4; ++q) *(LAS f32x4*)(T + r * 144 + (8 * q + 4 * hh) * 4) = (f32x4){acc[4 * q + 0], acc[4 * q + 1], acc[4 * q + 2], acc[4 * q + 3]};
    LDS_WAIT();
#pragma unroll
    for (int k = 0; k < 2; ++k) { const int id = lane + 64 * k, tl = id >> 2, c8 = 8 * (id & 3); const int t = 32 * tb + tl, col = 128 * hd + 32 * db + c8;
        const f32x4 v0 = *(const LAS f32x4*)(T + tl * 144 + c8 * 4), v1 = *(const LAS f32x4*)(T + tl * 144 + c8 * 4 + 16);
        const f32x4 g0 = *(const f32x4*)(F.ln_g + l * 512 + col), g1 = *(const f32x4*)(F.ln_g + l * 512 + col + 4), b0 = *(const f32x4*)(F.ln_b + l * 512 + col), b1 = *(const f32x4*)(F.ln_b + l * 512 + col + 4);
        const float bs = F.sgu_b[l * 512 + hd * 128 + t], rs = F.RSW[(l * 4 + hd) * 128 + t];
        float uf[8], gf[8], m[8]; unpack8(o.uu[k], uf); unpack8(o.gg[k], gf);
#pragma unroll
        for (int e = 0; e < 4; ++e) { m[e] = (g0[e] * v0[e] + b0[e] * rs + bs) * uf[e] * gf[e]; m[4 + e] = (g1[e] * v1[e] + b1[e] * rs + bs) * uf[4 + e] * gf[4 + e]; }
        *(u32x4*)(F.MIX + (R0 + t) * DM + 1536 + col) = pack8(m); }
    LDS_WAIT();
}
__device__ __forceinline__ void sgu_unit(int l, int ci, int hp, LAS unsigned char* ring) {
    LOCAL_FRAME;
    LAS bf16_t* VnT = (LAS bf16_t*)ring;
    const int lane = F.lane, wv = F.wave;
    const size_t R0 = (size_t)128 * ci;
    const int r = lane & 31, hh = lane >> 5, db = wv & 3; const int tbA = (wv >> 2) ? 1 : 0, tbB = (wv >> 2) ? 2 : 3;
    SguOps op0;
    {
        const int tl = lane >> 2, q4 = lane & 3;
        const bf16_t* vrow = F.Z2 + (R0 + 16 * wv + tl) * ZW + Z_VS + 32 * q4;
        u32x4 x[4][4];
#pragma unroll
        for (int h = 0; h < 4; ++h)
#pragma unroll
            for (int i = 0; i < 4; ++i) x[h][i] = *(const u32x4*)(vrow + 128 * h + 8 * i);
        sgu_load_ops(op0, F, l, 2 * hp, R0, r, hh, db, tbA, tbB);
        float s = 0.f, ss = 0.f;
#pragma unroll
        for (int h = 0; h < 4; ++h)
#pragma unroll
            for (int i = 0; i < 4; ++i) { float f[8]; unpack8(x[h][i], f);
#pragma unroll
                for (int jj = 0; jj < 8; ++jj) { s += f[jj]; ss += f[jj] * f[jj]; } }
        s += __shfl_xor(s, 1); s += __shfl_xor(s, 2); ss += __shfl_xor(ss, 1); ss += __shfl_xor(ss, 2);
        const float mean = s * (1.0f / 512.0f), var = ss * (1.0f / 512.0f) - mean * mean, rstd = rsqrtf(var + EPS);
#pragma unroll
        for (int h2 = 0; h2 < 2; ++h2)
#pragma unroll
            for (int i = 0; i < 4; ++i) { const int d = 32 * q4 + 8 * i;
                const u32x4 xv = hp ? x[2 + h2][i] : x[h2][i];
                float f[8]; unpack8(xv, f);
#pragma unroll
                for (int jj = 0; jj < 8; ++jj) f[jj] = (f[jj] - mean) * rstd;
                *(LAS u32x4*)((LAS unsigned char*)VnT + (h2 * 128 + 16 * wv + tl) * 320 + d * 2) = pack8(f); }
    }
    LDS_WAIT();
    __syncthreads();
    f32x16 accA, accB;
    SguUG ua, ub;
    LAS unsigned char* T = ring + SG_TOFF + wv * SG_TBYTES;
    sgu_load_ug(ua, F, 2 * hp, R0, lane, db, tbA); sgu_load_ug(ub, F, 2 * hp, R0, lane, db, tbB);
    sgu_mfma(op0, VnT, 0, r, hh, db, tbA, tbB, accA, accB);
    SguOps op1;
    sgu_load_ops(op1, F, l, 2 * hp + 1, R0, r, hh, db, tbA, tbB);
    sgu_epi(ua, F, l, 2 * hp, R0, lane, db, tbA, accA, T);
    sgu_epi(ub, F, l, 2 * hp, R0, lane, db, tbB, accB, T);
    sgu_load_ug(ua, F, 2 * hp + 1, R0, lane, db, tbA); sgu_load_ug(ub, F, 2 * hp + 1, R0, lane, db, tbB);
    sgu_mfma(op1, VnT, 1, r, hh, db, tbA, tbB, accA, accB);
    sgu_epi(ua, F, l, 2 * hp + 1, R0, lane, db, tbA, accA, T);
    sgu_epi(ub, F, l, 2 * hp + 1, R0, lane, db, tbB, accB, T);
    __syncthreads();
}

__device__ __forceinline__ void samp_attn(int l, int bd, int kvh, LAS unsigned char* wl) {
    LOCAL_FRAME;
    LAS float* ps = (LAS float*)wl;
    LAS float* invs = ps + 144 * 16;
    const int lane = F.lane, fr = lane & 15, fq = lane >> 4, gq = fr >> 2, tt = fr & 3;
    float* oKs = F.out + O_KS + (size_t)l * LS_KS; float* oVs = F.out + O_VS + (size_t)l * LS_KS;
    bf16x8 qfr[2];
    {
        const bf16_t* qsrc = F.Qc + ((size_t)MP + 4 * bd + tt) * 1024 + (4 * kvh + gq) * 64 + 16 * fq;
        const u32x4 qa = *(const u32x4*)qsrc, qb = *(const u32x4*)(qsrc + 8);
        u32x4 lo, hi;
        lo.x = (qa.x & 0xffffu) | (qa.y << 16); lo.y = (qa.z & 0xffffu) | (qa.w << 16); lo.z = (qb.x & 0xffffu) | (qb.y << 16); lo.w = (qb.z & 0xffffu) | (qb.w << 16);
        hi.x = (qa.x >> 16) | (qa.y & 0xffff0000u); hi.y = (qa.z >> 16) | (qa.w & 0xffff0000u); hi.z = (qb.x >> 16) | (qb.y & 0xffff0000u); hi.w = (qb.z >> 16) | (qb.w & 0xffff0000u);
        qfr[0] = __builtin_bit_cast(bf16x8, lo); qfr[1] = __builtin_bit_cast(bf16x8, hi);
    }
    const float* kc = F.cache_k + (((size_t)l * 128 + bd) * 128) * 256 + kvh * 64 + 8 * fq;
    const float* kn = oKs + (((size_t)bd * 128 + 124 + (fr & 3)) * 4 + kvh) * 64 + 8 * fq;
    float* kd = oKs + ((size_t)bd * 128 * 4 + kvh) * 64 + 8 * fq;
    f32x4 S[9];
#pragma unroll
    for (int T = 0; T < 9; ++T) S[T] = (f32x4){0.f, 0.f, 0.f, 0.f};
#pragma unroll
    for (int T0 = 0; T0 < 9; T0 += 3) {
        f32x4 x[3][2][2];
#pragma unroll
        for (int u = 0; u < 3; ++u) { const int T = T0 + u; const float* src = (T < 8) ? kc + (size_t)(16 * T + fr) * 256 : kn;
#pragma unroll
            for (int ks = 0; ks < 2; ++ks) { x[u][ks][0] = __builtin_nontemporal_load((const f32x4*)(src + 32 * ks)); x[u][ks][1] = __builtin_nontemporal_load((const f32x4*)(src + 32 * ks + 4)); } }
#pragma unroll
        for (int u = 0; u < 3; ++u) { const int T = T0 + u; const int key = 16 * T + fr;
            if (T < 8 && key >= 4) {
#pragma unroll
                for (int ks = 0; ks < 2; ++ks) { float* dst = kd + (size_t)(key - 4) * 256 + 32 * ks; __builtin_nontemporal_store(x[u][ks][0], (f32x4*)dst); __builtin_nontemporal_store(x[u][ks][1], (f32x4*)(dst + 4)); } } }
#pragma unroll
        for (int u = 0; u < 3; ++u)
#pragma unroll
            for (int ks = 0; ks < 2; ++ks) { u32x4 w; w.x = pg8::cvt_pk_bf16(x[u][ks][0][0], x[u][ks][0][1]); w.y = pg8::cvt_pk_bf16(x[u][ks][0][2], x[u][ks][0][3]);
                w.z = pg8::cvt_pk_bf16(x[u][ks][1][0], x[u][ks][1][1]); w.w = pg8::cvt_pk_bf16(x[u][ks][1][2], x[u][ks][1][3]);
                S[T0 + u] = __builtin_amdgcn_mfma_f32_16x16x32_bf16(__builtin_bit_cast(bf16x8, w), qfr[ks], S[T0 + u], 0, 0, 0); }
        __builtin_amdgcn_sched_barrier(0);
    }
    const float sink2 = F.sinks[l * 16 + 4 * kvh + gq] * LOG2E;
    float m = sink2;
#pragma unroll
    for (int T = 0; T < 9; ++T)
#pragma unroll
        for (int rg = 0; rg < 4; ++rg) { const int key = 16 * T + 4 * fq + rg; const bool ok = (T < 8) ? (key >= tt + 1) : (fq == 0 && rg <= tt);
            S[T][rg] = ok ? S[T][rg] : -INFINITY; m = fmaxf(m, S[T][rg]); }
    m = fmaxf(m, __shfl_xor(m, 16)); m = fmaxf(m, __shfl_xor(m, 32));
    float sum = 0.f;
#pragma unroll
    for (int T = 0; T < 9; ++T)
#pragma unroll
        for (int rg = 0; rg < 4; ++rg) { const float p = __builtin_amdgcn_exp2f(S[T][rg] - m); sum += p; ps[(16 * T + 4 * fq + rg) * 16 + fr] = p; }
    sum += __shfl_xor(sum, 16); sum += __shfl_xor(sum, 32);
    if (fq == 0) invs[fr] = 1.0f / (sum + __builtin_amdgcn_exp2f(sink2 - m));
    LDS_WAIT();
    const int kq = lane >> 4, dq = lane & 15;
    const float* vcp = F.cache_v + (((size_t)l * 128 + bd) * 128 + kq) * 256 + kvh * 64 + 4 * dq;
    float* vop = oVs + ((size_t)bd * 128 + kq) * 256 + kvh * 64 + 4 * dq;
#pragma unroll 1
    for (int pass = 0; pass < 2; ++pass) {
        float o[8][4];
#pragma unroll
        for (int q = 0; q < 8; ++q) { o[q][0] = 0.f; o[q][1] = 0.f; o[q][2] = 0.f; o[q][3] = 0.f; }
#pragma unroll 1
        for (int blk = 0; blk < 3; ++blk) {
            f32x4 vx[11];
#pragma unroll
            for (int ii = 0; ii < 11; ++ii) { const int i = blk * 11 + ii; const float* src = (i < 32) ? vcp + (size_t)i * 1024 : vop + (size_t)31 * 1024; vx[ii] = __builtin_nontemporal_load((const f32x4*)src); }
            if (pass == 0) {
#pragma unroll
                for (int ii = 0; ii < 11; ++ii) { const int i = blk * 11 + ii; if (i >= 1 && i < 32) __builtin_nontemporal_store(vx[ii], (f32x4*)(vop + (size_t)(i - 1) * 1024)); } }
#pragma unroll
            for (int ii = 0; ii < 11; ++ii) { const int key = 4 * (blk * 11 + ii) + kq;
                const f32x4 pa = *(const LAS f32x4*)(ps + key * 16 + 8 * pass), pb = *(const LAS f32x4*)(ps + key * 16 + 8 * pass + 4);
#pragma unroll
                for (int e = 0; e < 4; ++e) { o[0][e] += pa[0] * vx[ii][e]; o[1][e] += pa[1] * vx[ii][e]; o[2][e] += pa[2] * vx[ii][e]; o[3][e] += pa[3] * vx[ii][e];
                    o[4][e] += pb[0] * vx[ii][e]; o[5][e] += pb[1] * vx[ii][e]; o[6][e] += pb[2] * vx[ii][e]; o[7][e] += pb[3] * vx[ii][e]; }
                __builtin_amdgcn_sched_barrier(0); }
        }
#pragma unroll
        for (int q = 0; q < 8; ++q)
#pragma unroll
            for (int e = 0; e < 4; ++e) { float v = o[q][e]; v += __shfl_xor(v, 16); v += __shfl_xor(v, 32); o[q][e] = v; }
#pragma unroll
        for (int q = 0; q < 8; ++q) if ((q >> 1) == kq) { const int qq = 8 * pass + q, t2 = qq & 3, head = 4 * kvh + (qq >> 2); const size_t row = (size_t)MP + 4 * bd + t2;
            float gf[4]; unpack4(*(const u32x2*)(F.Z2 + row * ZW + Z_GA + head * 64 + 4 * dq), gf);
            const float iq = invs[qq];
            u32x2 wv; wv.x = pg8::cvt_pk_bf16(o[q][0] * iq * gf[0], o[q][1] * iq * gf[1]); wv.y = pg8::cvt_pk_bf16(o[q][2] * iq * gf[2], o[q][3] * iq * gf[3]);
            *(u32x2*)(F.MIX + row * DM + head * 64 + 4 * dq) = wv; }
    }
    LDS_WAIT();
}
__device__ __forceinline__ void samp_sgu(int l, int bd) {
    LOCAL_FRAME;
    const int lane = F.lane, c0 = 8 * lane, hd = lane >> 4;
    {
        float* oPs = F.out + O_PS + (size_t)l * LS_PS + (size_t)bd * 15 * 512; const float* sp = F.state_pool + (size_t)l * LS_PS + (size_t)bd * 15 * 512 + 4 * 512;
        f32x4 cp[22];
#pragma unroll
        for (int k = 0; k < 22; ++k) cp[k] = __builtin_nontemporal_load((const f32x4*)(sp + 4 * (lane + 64 * k)));
#pragma unroll
        for (int k = 0; k < 22; ++k) __builtin_nontemporal_store(cp[k], (f32x4*)(oPs + 4 * (lane + 64 * k)));
    }
    float* oCV = F.out + O_CV + (size_t)l * LS_CV;
    float gl[8], bl[8];
#pragma unroll
    for (int j = 0; j < 8; ++j) { gl[j] = F.ln_g[l * 512 + c0 + j]; bl[j] = F.ln_b[l * 512 + c0 + j]; }
    u32x4 xr[4], ur[4], gr[4];
#pragma unroll
    for (int tt = 0; tt < 4; ++tt) { const size_t row = (size_t)MP + 4 * bd + tt; xr[tt] = *(const u32x4*)(F.Z2 + row * ZW + Z_VS + c0); ur[tt] = *(const u32x4*)(F.Z2 + row * ZW + Z_U + c0); gr[tt] = *(const u32x4*)(F.Z2 + row * ZW + Z_GS + c0); }
    float vn[4][8];
#pragma unroll
    for (int tt = 0; tt < 4; ++tt) { float f[8]; unpack8(xr[tt], f);
        float s = 0.f, ss = 0.f;
#pragma unroll
        for (int j = 0; j < 8; ++j) { s += f[j]; ss += f[j] * f[j]; }
        s = wave_sum(s); ss = wave_sum(ss);
        const float mean = s * (1.0f / 512.0f), var = ss * (1.0f / 512.0f) - mean * mean, rstd = rsqrtf(var + EPS);
#pragma unroll
        for (int j = 0; j < 8; ++j) vn[tt][j] = (f[j] - mean) * rstd * gl[j] + bl[j];
        float* o = oCV + ((size_t)bd * 4 + tt) * 512 + c0;
        *(f32x4*)o = (f32x4){vn[tt][0], vn[tt][1], vn[tt][2], vn[tt][3]}; *(f32x4*)(o + 4) = (f32x4){vn[tt][4], vn[tt][5], vn[tt][6], vn[tt][7]}; }
#pragma unroll
    for (int tt = 0; tt < 4; ++tt) { const size_t row = (size_t)MP + 4 * bd + tt;
        float mx[8]; const float bias = F.sgu_b[l * 512 + hd * 128 + tt];
#pragma unroll
        for (int j = 0; j < 8; ++j) mx[j] = bias;
#pragma unroll
        for (int s2 = 0; s2 < 4; ++s2) if (s2 <= tt) { const float w = F.sgu_w[((size_t)(l * 4 + hd) * 128 + tt) * 128 + s2];
#pragma unroll
            for (int j = 0; j < 8; ++j) mx[j] += w * vn[s2][j]; }
        float uf[8], gf[8]; unpack8(ur[tt], uf); unpack8(gr[tt], gf);
#pragma unroll
        for (int j = 0; j < 8; ++j) mx[j] = mx[j] * uf[j] * gf[j];
        *(u32x4*)(F.MIX + row * DM + 1536 + c0) = pack8(mx); }
}

#ifdef HYBRID
__device__ __forceinline__ void attn_task_o(const Frame& F, int l, int b, int nb, int head, int qs, LAS unsigned char* wl) {
    const int lane = F.lane, r = lane & 31, hh = lane >> 5, kvh = head >> 2;
    LAS float* wsf = (LAS float*)wl; LAS bf16_t* stg = (LAS bf16_t*)(wl + 256);
    const int t0 = 128 * nb + 32 * qs;
    const size_t qrow0 = (size_t)b * 2048 + t0;
    const bf16_t* qp = F.Qc + (qrow0 + r) * 1024 + head * 64 + 8 * hh;
    bf16x8 qf[4];
#pragma unroll
    for (int s = 0; s < 4; ++s) qf[s] = *(const bf16x8*)(qp + 16 * s);
    const bf16_t* kbase = F.Kc + (size_t)(b * 4 + kvh) * 2048 * 64;
    const bf16_t* vbase = F.VTP + (size_t)(b * 4 + kvh) * 64 * 2048;
    const int cmin = (nb > 0) ? 0 : (4 - qs);
    f32x16 S[5];
#pragma unroll
    for (int c = 0; c < 5; ++c) {
        f32x16 a;
#pragma unroll
        for (int i = 0; i < 16; ++i) a[i] = 0.f;
        if (c >= cmin) {
            const bf16_t* kp = kbase + (size_t)(t0 - 128 + 32 * c + r) * 64 + 8 * hh;
#pragma unroll
            for (int s = 0; s < 4; ++s) a = __builtin_amdgcn_mfma_f32_32x32x16_bf16(*(const bf16x8*)(kp + 16 * s), qf[s], a, 0, 0, 0);
        }
        S[c] = a;
    }
    const float NEG = -INFINITY;
#pragma unroll
    for (int i = 0; i < 16; ++i) { const int kap = crow(i, hh); if (kap <= r) S[0][i] = NEG; if (kap > r) S[4][i] = NEG; }
    const float sink2 = F.sinks[l * 16 + head] * LOG2E;
    float m = sink2;
#pragma unroll
    for (int c = 0; c < 5; ++c) if (c >= cmin) {
#pragma unroll
        for (int i = 0; i < 16; ++i) m = fmaxf(m, S[c][i]); }
    m = fmaxf(m, __shfl_xor(m, 32));
    float sum = 0.f;
#pragma unroll
    for (int c = 0; c < 5; ++c) if (c >= cmin) {
#pragma unroll
        for (int i = 0; i < 16; ++i) { const float p = __builtin_amdgcn_exp2f(S[c][i] - m); S[c][i] = p; sum += p; } }
    sum += __shfl_xor(sum, 32);
    const float inv = 1.0f / (sum + __builtin_amdgcn_exp2f(sink2 - m));
    f32x16 o[2];
#pragma unroll
    for (int i = 0; i < 16; ++i) { o[0][i] = 0.f; o[1][i] = 0.f; }
#pragma unroll
    for (int c = 0; c < 5; ++c) if (c >= cmin) {
        const bf16_t* vt = vbase + (size_t)((t0 - 128 + 32 * c) >> 5) * 2048 + r * 32 + 16 * hh;
#pragma unroll
        for (int s = 0; s < 2; ++s) {
            u32x4 pw; pw.x = pg8::cvt_pk_bf16(S[c][8 * s + 0], S[c][8 * s + 1]); pw.y = pg8::cvt_pk_bf16(S[c][8 * s + 2], S[c][8 * s + 3]);
            pw.z = pg8::cvt_pk_bf16(S[c][8 * s + 4], S[c][8 * s + 5]); pw.w = pg8::cvt_pk_bf16(S[c][8 * s + 6], S[c][8 * s + 7]);
            const bf16x8 pa = __builtin_bit_cast(bf16x8, pw);
#pragma unroll
            for (int db = 0; db < 2; ++db) o[db] = __builtin_amdgcn_mfma_f32_32x32x16_bf16(pa, *(const bf16x8*)(vt + db * 1024 + 8 * s), o[db], 0, 0, 0);
        }
    }
    if (hh == 0) wsf[r] = inv;
    LDS_WAIT();
#pragma unroll
    for (int i = 0; i < 16; ++i) { const int q = crow(i, hh); const float rl = wsf[q];
        stg[q * 64 + r] = (bf16_t)(pg8::cvt_pk_bf16(o[0][i] * rl, 0.f) & 0xffffu);
        stg[q * 64 + 32 + r] = (bf16_t)(pg8::cvt_pk_bf16(o[1][i] * rl, 0.f) & 0xffffu); }
    LDS_WAIT();
#pragma unroll
    for (int i = 0; i < 4; ++i) { const int row = i * 8 + (lane >> 3), ch = lane & 7;
        const u32x4 ov = *(const LAS u32x4*)(stg + row * 64 + ch * 8);
        const u32x4 gv = *(const u32x4*)(F.Z2 + (qrow0 + row) * ZW + Z_GA + head * 64 + ch * 8);
        float of[8], gf[8]; unpack8(ov, of); unpack8(gv, gf);
#pragma unroll
        for (int j = 0; j < 8; ++j) of[j] *= gf[j];
        *(u32x4*)(F.MIX + (qrow0 + row) * DM + head * 64 + ch * 8) = pack8(of); }
    LDS_WAIT();
}

template <bool SAMPLE>
__device__ __forceinline__ void pool_unit_o(const Frame& F, int l, int g, int tile) {
    const int lane = F.lane, r = lane & 31, hh = lane >> 5, w = 2 << g;
    const size_t row = (size_t)(SAMPLE ? MP : 0) + 32 * tile + r;
    const int t = SAMPLE ? (int)(row & 3) : (int)(row & 2047);
    const int bd = SAMPLE ? (int)((row - MP) >> 2) : 0;
    const float icnt = SAMPLE ? 1.0f / (float)w : 1.0f / (float)(w < t + 1 ? w : t + 1);
    bf16x8 bfr[8];
#pragma unroll
    for (int s = 0; s < 8; ++s) {
        const int c0 = 128 * g + 16 * s + 8 * hh;
        float sum[8], cur[8];
#pragma unroll
        for (int j = 0; j < 8; ++j) { sum[j] = 0.f; cur[j] = 0.f; }
        for (int i = 0; i < w; ++i) {
            float f[8];
            const int e = t - i;
            if (e >= 0) { unpack8(*(const u32x4*)(F.Z2 + (row - i) * ZW + Z_XB + c0), f); }
            else if (SAMPLE) { const float* sp = F.state_pool + (((size_t)l * 128 + bd) * 15 + 15 + e) * 512 + c0;
                const f32x4 a = *(const f32x4*)sp, bq = *(const f32x4*)(sp + 4); f[0] = a[0]; f[1] = a[1]; f[2] = a[2]; f[3] = a[3]; f[4] = bq[0]; f[5] = bq[1]; f[6] = bq[2]; f[7] = bq[3]; }
            else {
#pragma unroll
                for (int j = 0; j < 8; ++j) f[j] = 0.f; }
#pragma unroll
            for (int j = 0; j < 8; ++j) sum[j] += f[j];
            if (i == 0) {
#pragma unroll
                for (int j = 0; j < 8; ++j) cur[j] = f[j]; }
        }
        float pf[8];
#pragma unroll
        for (int j = 0; j < 8; ++j) pf[j] = sum[j] * icnt - cur[j];
        bfr[s] = __builtin_bit_cast(bf16x8, pack8(pf));
    }
    f32x16 acc[4];
#pragma unroll
    for (int db = 0; db < 4; ++db) {
#pragma unroll
        for (int i = 0; i < 16; ++i) acc[db][i] = 0.f;
        const bf16_t* ap = F.PWT + ((size_t)(l * 4 + g) * 128 + 32 * db + r) * 128 + 8 * hh;
#pragma unroll
        for (int s = 0; s < 8; ++s) acc[db] = __builtin_amdgcn_mfma_f32_32x32x16_bf16(*(const bf16x8*)(ap + 16 * s), bfr[s], acc[db], 0, 0, 0);
    }
#pragma unroll
    for (int db = 0; db < 4; ++db)
#pragma unroll
        for (int q = 0; q < 4; ++q) {
            const int col = 128 * g + 32 * db + 8 * q + 4 * hh;
            const f32x4 sc = *(const f32x4*)(F.pool_scale + l * 512 + col);
            float gf[4]; unpack4(*(const u32x2*)(F.Z2 + row * ZW + Z_GP + col), gf);
            u32x2 wv; wv.x = pg8::cvt_pk_bf16(acc[db][4 * q + 0] * sc[0] * gf[0], acc[db][4 * q + 1] * sc[1] * gf[1]);
            wv.y = pg8::cvt_pk_bf16(acc[db][4 * q + 2] * sc[2] * gf[2], acc[db][4 * q + 3] * sc[3] * gf[3]);
            *(u32x2*)(F.MIX + row * DM + 1024 + col) = wv;
        }
}

__device__ __forceinline__ void sgu_unit_o(const Frame& F, int l, int ci, int hd, LAS unsigned char* ring) {
    LAS bf16_t* VnT = (LAS bf16_t*)ring;
    const int lane = F.lane, wv = F.wave;
    const size_t R0 = (size_t)128 * ci;
    {
        const int tl = lane >> 2, q4 = lane & 3;
        const bf16_t* vrow = F.Z2 + (R0 + 16 * wv + tl) * ZW + Z_VS;
        float s = 0.f, ss = 0.f;
#pragma unroll
        for (int i = 0; i < 16; ++i) { float f[8]; unpack8(*(const u32x4*)(vrow + 128 * q4 + 8 * i), f);
#pragma unroll
            for (int j = 0; j < 8; ++j) { s += f[j]; ss += f[j] * f[j]; } }
        s += __shfl_xor(s, 1); s += __shfl_xor(s, 2); ss += __shfl_xor(ss, 1); ss += __shfl_xor(ss, 2);
        const float mean = s * (1.0f / 512.0f), var = ss * (1.0f / 512.0f) - mean * mean, rstd = rsqrtf(var + EPS);
#pragma unroll
        for (int i = 0; i < 4; ++i) { const int d = 32 * q4 + 8 * i; float f[8]; unpack8(*(const u32x4*)(vrow + 128 * hd + d), f);
            const float* gp = F.ln_g + l * 512 + 128 * hd + d; const float* bp = F.ln_b + l * 512 + 128 * hd + d;
#pragma unroll
            for (int j = 0; j < 8; ++j) { const float vn = (f[j] - mean) * rstd * gp[j] + bp[j];
                VnT[(d + j) * 136 + 16 * wv + tl] = (bf16_t)(pg8::cvt_pk_bf16(vn, 0.f) & 0xffffu); } }
    }
    __syncthreads();
    {
        const int r = lane & 31, hh = lane >> 5, db = wv & 3; const int tbA = (wv >> 2) ? 1 : 0, tbB = (wv >> 2) ? 2 : 3;
        f32x16 accA, accB;
#pragma unroll
        for (int i = 0; i < 16; ++i) { accA[i] = 0.f; accB[i] = 0.f; }
        const bf16_t* Wb = F.SGUW + (size_t)(l * 4 + hd) * 128 * 128;
#pragma unroll
        for (int s = 0; s < 8; ++s) {
            if (s < 2 * (tbB + 1)) {
                const bf16x8 a = *(const LAS bf16x8*)(VnT + (32 * db + r) * 136 + 16 * s + 8 * hh);
                accB = __builtin_amdgcn_mfma_f32_32x32x16_bf16(a, *(const bf16x8*)(Wb + (32 * tbB + r) * 128 + 16 * s + 8 * hh), accB, 0, 0, 0);
                if (s < 2 * (tbA + 1)) accA = __builtin_amdgcn_mfma_f32_32x32x16_bf16(a, *(const bf16x8*)(Wb + (32 * tbA + r) * 128 + 16 * s + 8 * hh), accA, 0, 0, 0);
            }
        }
#pragma unroll
        for (int pass = 0; pass < 2; ++pass) {
            const int tb = pass ? tbB : tbA; const f32x16 acc = pass ? accB : accA;
            const int t = 32 * tb + r; const size_t row = R0 + t; const float bias = F.sgu_b[l * 512 + hd * 128 + t];
#pragma unroll
            for (int q = 0; q < 4; ++q) { const int col = 128 * hd + 32 * db + 8 * q + 4 * hh;
                float uf[4], gf[4]; unpack4(*(const u32x2*)(F.Z2 + row * ZW + Z_U + col), uf); unpack4(*(const u32x2*)(F.Z2 + row * ZW + Z_GS + col), gf);
                u32x2 wo; wo.x = pg8::cvt_pk_bf16((acc[4 * q + 0] + bias) * uf[0] * gf[0], (acc[4 * q + 1] + bias) * uf[1] * gf[1]);
                wo.y = pg8::cvt_pk_bf16((acc[4 * q + 2] + bias) * uf[2] * gf[2], (acc[4 * q + 3] + bias) * uf[3] * gf[3]);
                *(u32x2*)(F.MIX + row * DM + 1536 + col) = wo; }
        }
    }
    __syncthreads();
}

__device__ __forceinline__ void samp_attn_o(const Frame& F, int l, int bd, int kvh, LAS unsigned char* wl) {
    LAS float* qs = (LAS float*)wl;
    LAS float* ps = (LAS float*)(wl + 4096);
    const int lane = F.lane;
    float* oKs = F.out + O_KS + (size_t)l * LS_KS; float* oVs = F.out + O_VS + (size_t)l * LS_KS;
    {
        const int qi = lane >> 2, part = lane & 3, gq = qi >> 2, tt = qi & 3;
        const bf16_t* src = F.Qc + ((size_t)MP + 4 * bd + tt) * 1024 + (4 * kvh + gq) * 64 + 16 * part;
        float f0[8], f1[8]; unpack8(*(const u32x4*)src, f0); unpack8(*(const u32x4*)(src + 8), f1);
#pragma unroll
        for (int j = 0; j < 8; ++j) { const int p0 = 16 * part + j, p1 = p0 + 8;
            qs[qi * 64 + (p0 >> 1) + 32 * (p0 & 1)] = f0[j]; qs[qi * 64 + (p1 >> 1) + 32 * (p1 & 1)] = f1[j]; }
    }
    LDS_WAIT();
    float s0[16], s1[16], s2[16];
#pragma unroll
    for (int q = 0; q < 16; ++q) { s0[q] = 0.f; s1[q] = 0.f; s2[q] = 0.f; }
    const float* k0p = F.cache_k + (((size_t)l * 128 + bd) * 128 + lane) * 256 + kvh * 64;
    const float* k1p = k0p + 64 * 256;
    const float* k2p = oKs + (((size_t)bd * 128 + 124 + (lane & 3)) * 4 + kvh) * 64;
    float* c0p = oKs + (((size_t)bd * 128 + (lane >= 4 ? lane - 4 : 0)) * 4 + kvh) * 64;
    float* c1p = oKs + (((size_t)bd * 128 + lane + 60) * 4 + kvh) * 64;
    for (int ch = 0; ch < 16; ++ch) {
        const f32x4 kx0 = *(const f32x4*)(k0p + 4 * ch), kx1 = *(const f32x4*)(k1p + 4 * ch), kx2 = *(const f32x4*)(k2p + 4 * ch);
        if (lane >= 4) *(f32x4*)(c0p + 4 * ch) = kx0;
        *(f32x4*)(c1p + 4 * ch) = kx1;
#pragma unroll
        for (int q = 0; q < 16; ++q) { const f32x4 qv = *(const LAS f32x4*)(qs + q * 64 + 4 * ch);
            s0[q] += (qv[0] * kx0[0] + qv[1] * kx0[1]) + (qv[2] * kx0[2] + qv[3] * kx0[3]);
            s1[q] += (qv[0] * kx1[0] + qv[1] * kx1[1]) + (qv[2] * kx1[2] + qv[3] * kx1[3]);
            s2[q] += (qv[0] * kx2[0] + qv[1] * kx2[1]) + (qv[2] * kx2[2] + qv[3] * kx2[3]); }
    }
    float inv[16];
#pragma unroll
    for (int q = 0; q < 16; ++q) {
        const int tt = q & 3; const float sink2 = F.sinks[l * 16 + 4 * kvh + (q >> 2)] * LOG2E;
        const bool v0 = lane >= tt + 1, v2 = (lane < 4) && (lane <= tt);
        float m = s1[q]; if (v0) m = fmaxf(m, s0[q]); if (v2) m = fmaxf(m, s2[q]);
        m = fmaxf(wave_max(m), sink2);
        const float p0 = v0 ? __builtin_amdgcn_exp2f(s0[q] - m) : 0.f, p1 = __builtin_amdgcn_exp2f(s1[q] - m), p2 = v2 ? __builtin_amdgcn_exp2f(s2[q] - m) : 0.f;
        const float sum = wave_sum(p0 + p1 + p2);
        inv[q] = 1.0f / (sum + __builtin_amdgcn_exp2f(sink2 - m));
        ps[lane * 16 + q] = p0; ps[(lane + 64) * 16 + q] = p1; if (lane < 4) ps[(128 + lane) * 16 + q] = p2;
    }
    LDS_WAIT();
    float o[16];
#pragma unroll
    for (int q = 0; q < 16; ++q) o[q] = 0.f;
    const float* vcp = F.cache_v + (((size_t)l * 128 + bd) * 128) * 256 + kvh * 64 + lane;
    float* vop = oVs + ((size_t)bd * 128) * 256 + kvh * 64 + lane;
    for (int key = 0; key < 132; ++key) {
        float v;
        if (key < 128) { v = vcp[(size_t)key * 256]; if (key >= 4) vop[(size_t)(key - 4) * 256] = v; }
        else v = vop[(size_t)(key - 4) * 256];
#pragma unroll
        for (int q4 = 0; q4 < 4; ++q4) { const f32x4 pv = *(const LAS f32x4*)(ps + key * 16 + 4 * q4);
            o[4 * q4 + 0] += pv[0] * v; o[4 * q4 + 1] += pv[1] * v; o[4 * q4 + 2] += pv[2] * v; o[4 * q4 + 3] += pv[3] * v; }
    }
#pragma unroll
    for (int q = 0; q < 16; ++q) { const int tt = q & 3, head = 4 * kvh + (q >> 2); const size_t row = (size_t)MP + 4 * bd + tt;
        const float gv = __uint_as_float(((unsigned)F.Z2[row * ZW + Z_GA + head * 64 + lane]) << 16);
        F.MIX[row * DM + head * 64 + lane] = (bf16_t)(pg8::cvt_pk_bf16(o[q] * inv[q] * gv, 0.f) & 0xffffu); }
    LDS_WAIT();
}
__device__ __forceinline__ void samp_sgu_o(const Frame& F, int l, int bd) {
    const int lane = F.lane, c0 = 8 * lane, hd = lane >> 4;
    float* oCV = F.out + O_CV + (size_t)l * LS_CV;
    float gl[8], bl[8];
#pragma unroll
    for (int j = 0; j < 8; ++j) { gl[j] = F.ln_g[l * 512 + c0 + j]; bl[j] = F.ln_b[l * 512 + c0 + j]; }
    float vn[4][8];
#pragma unroll
    for (int tt = 0; tt < 4; ++tt) { const size_t row = (size_t)MP + 4 * bd + tt; float f[8]; unpack8(*(const u32x4*)(F.Z2 + row * ZW + Z_VS + c0), f);
        float s = 0.f, ss = 0.f;
#pragma unroll
        for (int j = 0; j < 8; ++j) { s += f[j]; ss += f[j] * f[j]; }
        s = wave_sum(s); ss = wave_sum(ss);
        const float mean = s * (1.0f / 512.0f), var = ss * (1.0f / 512.0f) - mean * mean, rstd = rsqrtf(var + EPS);
#pragma unroll
        for (int j = 0; j < 8; ++j) vn[tt][j] = (f[j] - mean) * rstd * gl[j] + bl[j];
        float* o = oCV + ((size_t)bd * 4 + tt) * 512 + c0;
        *(f32x4*)o = (f32x4){vn[tt][0], vn[tt][1], vn[tt][2], vn[tt][3]}; *(f32x4*)(o + 4) = (f32x4){vn[tt][4], vn[tt][5], vn[tt][6], vn[tt][7]}; }
#pragma unroll
    for (int tt = 0; tt < 4; ++tt) { const size_t row = (size_t)MP + 4 * bd + tt;
        float mx[8]; const float bias = F.sgu_b[l * 512 + hd * 128 + tt];
#pragma unroll
        for (int j = 0; j < 8; ++j) mx[j] = bias;
#pragma unroll
        for (int s2 = 0; s2 < 4; ++s2) if (s2 <= tt) { const float w = F.sgu_w[((size_t)(l * 4 + hd) * 128 + tt) * 128 + s2];
#pragma unroll
            for (int j = 0; j < 8; ++j) mx[j] += w * vn[s2][j]; }
        float uf[8], gf[8]; unpack8(*(const u32x4*)(F.Z2 + row * ZW + Z_U + c0), uf); unpack8(*(const u32x4*)(F.Z2 + row * ZW + Z_GS + c0), gf);
#pragma unroll
        for (int j = 0; j < 8; ++j) mx[j] = mx[j] * uf[j] * gf[j];
        *(u32x4*)(F.MIX + row * DM + 1536 + c0) = pack8(mx); }
}

#endif
struct NormRowIn { u32x4 yv[4]; f32x4 xv[4][2]; u32x4 xb[4]; };
__device__ __forceinline__ void norm_row_load(NormRowIn& in, const Frame& F, int l, int row) {
    const int lane = F.lane;
    const bf16_t* yr = F.Yb + (size_t)row * DM + 8 * lane;
#pragma unroll
    for (int j = 0; j < 4; ++j) in.yv[j] = __builtin_nontemporal_load((const u32x4*)(yr + 512 * j));
    if (l == 0) {
        const float* xr = (row < MP ? F.xp + (size_t)row * DM : F.xs + (size_t)(row - MP) * DM) + 8 * lane;
#pragma unroll
        for (int j = 0; j < 4; ++j) { in.xv[j][0] = __builtin_nontemporal_load((const f32x4*)(xr + 512 * j)); in.xv[j][1] = __builtin_nontemporal_load((const f32x4*)(xr + 512 * j + 4)); }
    } else {
        const bf16_t* xr = F.H + (size_t)row * DM + 8 * lane;
#pragma unroll
        for (int j = 0; j < 4; ++j) in.xb[j] = __builtin_nontemporal_load((const u32x4*)(xr + 512 * j));
    }
}
__device__ __forceinline__ void norm_row_finish(const NormRowIn& in, const Frame& F, int l, int row) {
    const int lane = F.lane;
    const float* pg = F.norm_post + l * DM + 8 * lane;
    float y[4][8]; float ss = 0.f;
#pragma unroll
    for (int j = 0; j < 4; ++j) { unpack8(in.yv[j], y[j]);
#pragma unroll
        for (int e = 0; e < 8; ++e) ss += y[j][e] * y[j][e]; }
    ss = wave_sum(ss);
    const float ry = rsqrtf(ss * (1.0f / 2048.0f) + EPS);
    if (l == 0) {
        float s1 = 0.f; bf16_t* hrow = F.H + (size_t)row * DM + 8 * lane;
#pragma unroll
        for (int j = 0; j < 4; ++j) { const f32x4 ga = *(const f32x4*)(pg + 512 * j), gb = *(const f32x4*)(pg + 512 * j + 4);
#pragma unroll
            for (int e = 0; e < 4; ++e) { y[j][e] = in.xv[j][0][e] + y[j][e] * ry * ga[e]; y[j][4 + e] = in.xv[j][1][e] + y[j][4 + e] * ry * gb[e]; }
#pragma unroll
            for (int e = 0; e < 8; ++e) s1 += y[j][e] * y[j][e]; }
        s1 = wave_sum(s1);
        const float ms = s1 * (1.0f / 2048.0f) + EPS, r1 = rsqrtf(ms);
        if (lane == 0) F.RSTD[row] = ms * r1;
#pragma unroll
        for (int j = 0; j < 4; ++j) {
#pragma unroll
            for (int e = 0; e < 8; ++e) y[j][e] *= r1;
            *(u32x4*)(hrow + 512 * j) = pack8(y[j]); }
    } else {
        float* orow = F.out + (size_t)row * DM + 8 * lane;
        const float rms = F.RSTD[row];
#pragma unroll
        for (int j = 0; j < 4; ++j) { const f32x4 ga = *(const f32x4*)(pg + 512 * j), gb = *(const f32x4*)(pg + 512 * j + 4); float xf[8]; unpack8(in.xb[j], xf);
#pragma unroll
            for (int e = 0; e < 4; ++e) { y[j][e] = xf[e] * rms + y[j][e] * ry * ga[e]; y[j][4 + e] = xf[4 + e] * rms + y[j][4 + e] * ry * gb[e]; }
            __builtin_nontemporal_store((f32x4){y[j][0], y[j][1], y[j][2], y[j][3]}, (f32x4*)(orow + 512 * j)); __builtin_nontemporal_store((f32x4){y[j][4], y[j][5], y[j][6], y[j][7]}, (f32x4*)(orow + 512 * j + 4)); }
    }
}
__device__ __forceinline__ void norm_rows4(int l, int row0) { LOCAL_FRAME;
#pragma unroll 1
    for (int k = 0; k < 4; k += 2) { NormRowIn a, b; norm_row_load(a, F, l, row0 + k); norm_row_load(b, F, l, row0 + k + 1);
        norm_row_finish(a, F, l, row0 + k); norm_row_finish(b, F, l, row0 + k + 1); } }

constexpr int Q2_G = 40, Q2_AT = Q2_G + 256, Q2_SG = Q2_AT + 256, Q2_SA = Q2_SG + 64, Q2_SS = Q2_SA + 16, Q2_SP = Q2_SS + 8, Q2_PO = Q2_SP + 256;
__device__ __forceinline__ void slot2(int l, LAS unsigned char* L, LAS unsigned char* ring) {
    int t_ = threadIdx.x; asm volatile("" : "+v"(t_)); const int wave = __builtin_amdgcn_readfirstlane(t_ >> 6);
    unsigned* head = ctl_word(CW_Q + 64 * (2 * l));
    EV_T0();
#pragma unroll 1
    for (;;) {
        const int it = q_pop(head, L);
        if (it >= Q2_PO + (l == 0 ? TR_ITEMS : 0)) { if (l == 0) { EV_MAX(0); EV_MIN(1); } break; }
        if (it < Q2_G) {
            unsigned char* ws = (unsigned char*)kargs()->ws;
            pg8::Gemm g{(const bf16_t*)(ws + WS_H), (const bf16_t*)(ws + WS_WTIN) + (size_t)l * DIN * DM, MT, DIN, DM};
            OneUnit S; S.u.pm = 64 + it / 20; S.u.pn = it % 20;
            pg8::EpiIn E{l};
            pg8::gemm_phase<pg8::EpiIn, OneUnit, false, true>(ring, g, S, E);
            publish(ctl_word(CW_ZS + 64 * (2 * l + it / 20)));
            if (l == 0) { EV_MAX(2); EV_MIN(3); }
        }
#ifndef NO_SGU
        else if (it < Q2_AT) { const int u = it - Q2_G; sgu_unit(l, u >> 1, u & 1, ring); if (l == 0) EV_MAX(5); }
#endif
        else if (it < Q2_SG) { attn_unit(l, it - Q2_AT, ring); if (l == 0) EV_MAX(4); }
        else if (it < Q2_SA) { const int i = it - Q2_SG; dep_wait(ctl_word(CW_ZS + 64 * (2 * l + (i >> 5))), 20u); if (l == 0) EV_MIN(6); const int k = 8 * i + wave; samp_attn(l, k >> 2, k & 3, ring + wave * 9472); __syncthreads(); if (l == 0) EV_MAX(7); }
        else if (it < Q2_SS) { const int i = it - Q2_SA; dep_wait(ctl_word(CW_ZS + 64 * (2 * l + (i >> 3))), 20u); samp_sgu(l, 8 * i + wave); }
        else if (it < Q2_SP) { const int i = it - Q2_SS; dep_wait(ctl_word(CW_ZS + 64 * (2 * l + (i >> 2))), 20u); const int k = 8 * i + wave; pool_sample(l, k & 3, k >> 2); }
        else if (it < Q2_PO) { const int i = 8 * (it - Q2_SP) + wave; pool_prompt(l, i & 3, i >> 2, ring + wave * PL_WBYTES); }
        else { LOCAL_FRAME; transpose_item(F, 1, it - Q2_PO, ring); }
    }
}
constexpr int Q4_G = 16, Q4_P = Q4_G + 512, Q4_S = Q4_P + 16;
__device__ __forceinline__ void slot4(int l, LAS unsigned char* L, LAS unsigned char* ring) {
    int t_ = threadIdx.x; asm volatile("" : "+v"(t_)); const int wave = __builtin_amdgcn_readfirstlane(t_ >> 6);
    unsigned* head = ctl_word(CW_Q + 64 * (2 * l + 1));
#pragma unroll 1
    for (;;) {
        const int it = q_pop(head, L);
        if (it >= Q4_S) break;
        if (it < Q4_G) {
            unsigned char* ws = (unsigned char*)kargs()->ws;
            pg8::Gemm g{(const bf16_t*)(ws + WS_MIX), (const bf16_t*)(ws + WS_WTOUT) + (size_t)l * DM * DM, MT, DM, DM};
            OneUnit S; S.u.pm = 64 + it / 8; S.u.pn = it % 8;
            pg8::EpiOut E{};
            pg8::gemm_phase<pg8::EpiOut, OneUnit, false, true>(ring, g, S, E);
            publish(ctl_word(CW_YS + 64 * (2 * l + it / 8)));
        }
        else if (it < Q4_P) norm_rows4(l, 32 * (it - Q4_G) + 4 * wave);
        else { const int i = it - Q4_P; dep_wait(ctl_word(CW_YS + 64 * (2 * l + (i >> 3))), 8u); norm_rows4(l, MP + 32 * i + 4 * wave); }
    }
}

__device__ __forceinline__ void grid_barrier(LAS unsigned char* L) {
    XcdBarrier b; b.bar = (unsigned*)((unsigned char*)kargs()->ws + WS_CTL) + CW_BAR; b.x = xb_xcc_id(); b.st = (volatile LAS unsigned*)L + 8;
    xcd_barrier(b);
}
__global__ void __launch_bounds__(NTHREADS, 2) hymba_fwd(Args a_unused) {
    extern __shared__ __attribute__((aligned(16))) unsigned char lds[];
    LAS unsigned char* L = (LAS unsigned char*)lds;
    if (threadIdx.x < 256) ((LAS unsigned*)L)[threadIdx.x] = 0u;
    __syncthreads();
    (void)xcd_barrier_post((unsigned*)((unsigned char*)kargs()->ws + WS_CTL) + CW_BAR, (volatile LAS unsigned*)L + 8);
    LAS unsigned char* ring = L + RING_OFF;
    STAMP(0);
#ifndef NO_P0
    { Frame F; make_frame(F, kargs()); p0_prologue(F, ring); }
#endif
    grid_barrier(L);
    STAMP(1);
#pragma unroll 1
    for (int l = 0; l < 2; ++l) {
#ifndef NO_P1
        {
            KArgs ka = kargs(); unsigned char* ws = (unsigned char*)ka->ws;
            pg8::Gemm g{(const bf16_t*)(ws + WS_H), (const bf16_t*)(ws + WS_WTIN) + (size_t)l * DIN * DM, MP, DIN, DM}; pg8::StaticOrder S; S.init(MP, DIN, (int)gridDim.x, (int)blockIdx.x);
            pg8::EpiIn E{l};
            pg8::gemm_phase<pg8::EpiIn, pg8::StaticOrder, true, true>(ring, g, S, E);
        }
#endif
        grid_barrier(L);
        STAMP(2 + 4 * l);
#ifndef NO_P2
        slot2(l, L, ring);
#endif
        grid_barrier(L);
        STAMP(3 + 4 * l);
#ifndef NO_P3
        {
            KArgs ka = kargs(); unsigned char* ws = (unsigned char*)ka->ws;
            pg8::Gemm g{(const bf16_t*)(ws + WS_MIX), (const bf16_t*)(ws + WS_WTOUT) + (size_t)l * DM * DM, MP, DM, DM}; pg8::StaticOrder S; S.init(MP, DM, (int)gridDim.x, (int)blockIdx.x);
            pg8::EpiOut E{};
            pg8::gemm_phase<pg8::EpiOut, pg8::StaticOrder, true, true>(ring, g, S, E);
        }
#endif
        grid_barrier(L);
        STAMP(4 + 4 * l);
#ifndef NO_P4
        slot4(l, L, ring);
#endif
        if (l == 0) grid_barrier(L);
#if PROBE_SEL
        if (l == 1) __syncthreads();
#endif
        STAMP(5 + 4 * l);
    }
#if PROBE_SEL
    if (blockIdx.x == 0 && threadIdx.x == 0) {
#if PROBE_SEL >= 10
        unsigned ea = __hip_atomic_load(ctl_word(CW_EV + 64 * PEA), __ATOMIC_RELAXED, __HIP_MEMORY_SCOPE_AGENT), eb = __hip_atomic_load(ctl_word(CW_EV + 64 * PEB), __ATOMIC_RELAXED, __HIP_MEMORY_SCOPE_AGENT);
        if (PEA_MIN) ea = 0x40000000u - ea; if (PEB_MIN) eb = 0x40000000u - eb;
        unsigned long long da = (ea + 400) / 800, db = (eb + 400) / 800;
#else
        LAS unsigned long long* ts = (LAS unsigned long long*)(L + 256);
        unsigned long long da = (ts[PA1] - ts[PA0] + 400) / 800, db = (ts[PB1] - ts[PB0] + 400) / 800;
#endif
        if (da > 63) da = 63; if (db > 63) db = 63;
        const unsigned long long extra = (da + 64 * db) * 1600ull, t0 = __builtin_amdgcn_s_memrealtime();
        while (__builtin_amdgcn_s_memrealtime() - t0 < extra) __builtin_amdgcn_s_sleep(32);
    }
#endif
}

extern "C" void kernel_launch(void* const* d_in, const int* in_sizes, int n_in, void* d_out, int out_size, void* d_ws, size_t ws_size, hipStream_t stream) {
    static int grid = 0;
    if (grid == 0) {
        if (n_in != 16 || (size_t)out_size != O_END || ws_size < WS_END) { fprintf(stderr, "kernel_launch: unexpected shapes: n_in %d out %d ws %zu (need %zu)\n", n_in, out_size, ws_size, (size_t)WS_END); grid = -1; return; }
        int dev = 0, cus = 0, per_cu = 0;
        if (hipGetDevice(&dev) != hipSuccess || hipDeviceGetAttribute(&cus, hipDeviceAttributeMultiprocessorCount, dev) != hipSuccess) { fprintf(stderr, "kernel_launch: device query failed\n"); grid = -1; return; }
        if (hipFuncSetAttribute((const void*)hymba_fwd, hipFuncAttributeMaxDynamicSharedMemorySize, LDS_BYTES) != hipSuccess) { fprintf(stderr, "kernel_launch: hipFuncSetAttribute failed\n"); grid = -1; return; }
        if (hipOccupancyMaxActiveBlocksPerMultiprocessor(&per_cu, (const void*)hymba_fwd, NTHREADS, LDS_BYTES) != hipSuccess || per_cu < 1) { fprintf(stderr, "kernel_launch: occupancy query says %d blocks/CU\n", per_cu); (void)hipGetLastError(); grid = -1; return; }
        grid = cus;
    }
    if (grid < 0) return;
    (void)hipMemsetAsync((char*)d_ws + WS_CTL, 0, CTL_ZERO_BYTES, stream);
    Args a{};
    for (int i = 0; i < 16; ++i) a.in[i] = (const float*)d_in[i];
    a.out = (float*)d_out; a.ws = (unsigned char*)d_ws;
    void* params[] = {&a};
    hipError_t e = hipLaunchCooperativeKernel((const void*)hymba_fwd, dim3(grid), dim3(NTHREADS), params, LDS_BYTES, stream);
    if (e != hipSuccess) fprintf(stderr, "kernel_launch: cooperative launch failed: %s (grid %d)\n", hipGetErrorString(e), grid);
}
```

```cpp
#include <hip/hip_runtime.h>
#include <cstdio>
#include <cstdint>
#include <cmath>
namespace pg8 {
#define PG8_LAS __attribute__((address_space(3)))
typedef unsigned short bf16_t;
typedef short bf16x8 __attribute__((ext_vector_type(8)));
typedef float f32x4 __attribute__((ext_vector_type(4)));
typedef unsigned u32x4 __attribute__((ext_vector_type(4)));
typedef unsigned u32x2 __attribute__((ext_vector_type(2)));
constexpr int BM = 256, BK = 64, HALF = 128, HTB = HALF * BK * 2  , STAGE_BYTES = 8 * HTB, NXCD = 8, WGM = 8;

__host__ __device__ __forceinline__ int lds_byte(int r, int c) { const int st = (r >> 4) * 2 + (c >> 5), rr = r & 15, cc = c & 31, ob = rr * 64 + cc * 2; return st * 1024 + (ob ^ (((ob >> 9) & 1) << 5)); }
__host__ __device__ __forceinline__ void stage_rc(int b, int& R, int& C) { const int st = b / 1024, sb = b % 1024, swz = sb ^ (((sb >> 9) & 1) << 5); R = (st >> 1) * 16 + swz / 64; C = (st & 1) * 32 + (swz % 64) / 2; }
__host__ __device__ __forceinline__ int perm32(int rho) { const int n = rho >> 4, i = rho & 15; return 8 * (i >> 2) + 4 * n + (i & 3); }

struct Unit { int pm, pn; };
struct Gemm { const bf16_t* A; const bf16_t* Bt; int M, N, K; };

struct StaticOrder {
    int nM, nN, nwg, G, c;
    __host__ __device__ void init(int M, int N, int G_, int c_) { nM = M / BM; nN = N / BM; nwg = nM * nN; G = G_; c = c_; }
    __host__ __device__ bool next(int i, Unit& u) const {
        const long L = (long)i * G + c; if (L >= nwg) return false;
        int wgid = (int)L; { const int q = nwg / NXCD, r = nwg % NXCD, xcd = wgid % NXCD, off = wgid / NXCD; wgid = (xcd < r ? xcd * (q + 1) : r * (q + 1) + (xcd - r) * q) + off; }
        const int nig = WGM * nN, gid = wgid / nig, fm = gid * WGM, gsz = (nM - fm) < WGM ? (nM - fm) : WGM;
        u.pm = fm + ((wgid % nig) % gsz); u.pn = (wgid % nig) / gsz; return true;
    }
    __device__ __forceinline__ void a_ready(const Unit&) const {}
    __device__ __forceinline__ void done(const Unit&) const {}
};

constexpr int DM = 2048, MP = 16384, MS = 512, MT = MP + MS, DIN = 5120;
constexpr int ZW = 3584;
constexpr int Z_GA = 0, Z_XB = 1024, Z_GP = 1536, Z_U = 2048, Z_VS = 2560, Z_GS = 3072;
constexpr float LOG2E = 1.4426950408889634f, QSCALE = 0.125f * LOG2E, EPS = 1e-6f;

__device__ __forceinline__ unsigned cvt_pk_bf16(float lo, float hi) { unsigned r; asm("v_cvt_pk_bf16_f32 %0, %1, %2" : "=v"(r) : "v"(lo), "v"(hi)); return r; }
__device__ __forceinline__ float silu_f(float x) { return x * __builtin_amdgcn_rcpf(1.0f + __builtin_amdgcn_exp2f(-x * LOG2E)); }
__device__ __forceinline__ int vperm32(int x) { return ((x >> 2) & 1) * 16 + (x >> 3) * 4 + (x & 3); }

struct EpiPtrs { const __attribute__((address_space(1))) float* in[16]; __attribute__((address_space(1))) float* out; __attribute__((address_space(1))) unsigned char* ws; };
constexpr size_t EP_RSTD = (size_t)3 << 20, EP_ROPE = (size_t)1 << 20, EP_QC = (size_t)192 << 20, EP_KC = (size_t)225 << 20, EP_VTP = (size_t)233 << 20, EP_Z2 = (size_t)241 << 20, EP_Y = (size_t)357 << 20;
constexpr size_t EO_KP = 34603008, EO_VP = 35127296, EO_PP = 35651584, EO_KS = 35774464, EO_VS = 44163072, EO_PS = 52551680;
struct EpiIn {
    static constexpr bool PERM = true, AFTER_DRAIN = false;
    int l;
    __device__ __forceinline__ void operator()(const f32x4 (&acc)[2][2][4][2], const Unit& u, int wr, int wc, int fr, int fq) const {
        const __attribute__((address_space(4))) EpiPtrs* kp = (const __attribute__((address_space(4))) EpiPtrs*)__builtin_amdgcn_kernarg_segment_ptr(); asm volatile("" : "+s"(kp));
        unsigned char* ws = (unsigned char*)kp->ws; float* outp = (float*)kp->out;
        bf16_t* Qc = (bf16_t*)(ws + EP_QC); bf16_t* Kc = (bf16_t*)(ws + EP_KC); bf16_t* VTP = (bf16_t*)(ws + EP_VTP); bf16_t* Z2 = (bf16_t*)(ws + EP_Z2); const float* rope = (const float*)(ws + EP_ROPE);
        float* oKp = outp + EO_KP + (size_t)l * 262144; float* oVp = outp + EO_VP + (size_t)l * 262144; float* oPp = outp + EO_PP + (size_t)l * 61440;
        float* oKs = outp + EO_KS + (size_t)l * 4194304; float* oVs = outp + EO_VS + (size_t)l * 4194304; float* oPs = outp + EO_PS + (size_t)l * 983040;
        const int pn = u.pn;
        const int row0 = u.pm * 256 + wr * 64 + fr;
        const int cw = wc * 32 + 8 * fq;
        if (pn < 5) {
            float invr[4];
#pragma unroll
            for (int e = 0; e < 4; ++e) invr[e] = __builtin_amdgcn_exp2f(-(float)(((cw & 63) >> 1) + e) * 0.41524101186092f) * 0.15915494309189535f;
#pragma unroll
            for (int ai = 0; ai < 2; ++ai)
#pragma unroll
                for (int m = 0; m < 4; ++m) {
                    const int row = row0 + ai * 128 + m * 16;
                    const bool smp = row >= MP;
                    const float pos = (float)(smp ? 8192 + (row & 3) : (row & 2047));
                    f32x4 cs, sn;
#pragma unroll
                    for (int e = 0; e < 4; ++e) { const float fr_ = __builtin_amdgcn_fractf(pos * invr[e]); cs[e] = __builtin_amdgcn_cosf(fr_); sn[e] = __builtin_amdgcn_sinf(fr_); }
#pragma unroll
                    for (int bj = 0; bj < 2; ++bj) {
                        const int c = pn * 256 + bj * 128 + cw;
                        const int i0 = (c & 63) >> 1;
                        const f32x4 v0 = acc[ai][bj][m][0], v1 = acc[ai][bj][m][1];
                        f32x4 o1, o2;
                        o1[0] = v0[0] * cs[0] - v0[1] * sn[0]; o2[0] = v0[1] * cs[0] + v0[0] * sn[0];
                        o1[1] = v0[2] * cs[1] - v0[3] * sn[1]; o2[1] = v0[3] * cs[1] + v0[2] * sn[1];
                        o1[2] = v1[0] * cs[2] - v1[1] * sn[2]; o2[2] = v1[1] * cs[2] + v1[0] * sn[2];
                        o1[3] = v1[2] * cs[3] - v1[3] * sn[3]; o2[3] = v1[3] * cs[3] + v1[2] * sn[3];
                        if (pn < 4) {
                            o1 = o1 * QSCALE; o2 = o2 * QSCALE;
                            u32x4 w; w.x = cvt_pk_bf16(o1[0], o2[0]); w.y = cvt_pk_bf16(o1[1], o2[1]); w.z = cvt_pk_bf16(o1[2], o2[2]); w.w = cvt_pk_bf16(o1[3], o2[3]);
                            *(u32x4*)(Qc + (size_t)row * 1024 + c) = w;
                        } else {
                            const int kvh = (c - 1024) >> 6;
                            if (!smp) {
                                const int b = row >> 11, t = row & 2047;
                                u32x4 w; w.x = cvt_pk_bf16(o1[0], o2[0]); w.y = cvt_pk_bf16(o1[1], o2[1]); w.z = cvt_pk_bf16(o1[2], o2[2]); w.w = cvt_pk_bf16(o1[3], o2[3]);
                                *(u32x4*)(Kc + ((size_t)((b * 4 + kvh) * 2048 + t)) * 64 + (c & 63)) = w;
                                if (t >= 1920) { float* o = oKp + ((size_t)((b * 128 + t - 1920) * 4 + kvh)) * 64 + i0; *(f32x4*)o = o1; *(f32x4*)(o + 32) = o2; }
                            } else {
                                const int bd = (row - MP) >> 2, tt = row & 3;
                                float* o = oKs + ((size_t)((bd * 128 + 124 + tt) * 4 + kvh)) * 64 + i0; *(f32x4*)o = o1; *(f32x4*)(o + 32) = o2;
                            }
                        }
                    }
                }
        } else if (pn == 5) {
#pragma unroll
            for (int ai = 0; ai < 2; ++ai)
#pragma unroll
                for (int m = 0; m < 4; ++m) {
                    const int row = row0 + ai * 128 + m * 16;
                    const bool smp = row >= MP;
#pragma unroll
                    for (int bj = 0; bj < 2; ++bj) {
                        const int cv = bj * 128 + cw;
                        const int kvh = cv >> 6, d0 = cv & 63;
                        const f32x4 v0 = acc[ai][bj][m][0], v1 = acc[ai][bj][m][1];
                        if (!smp) {
                            const int b = row >> 11, t = row & 2047;
                            bf16_t* vp = VTP + ((size_t)((b * 4 + kvh) * 64 + (t >> 5))) * 2048 + d0 * 32 + vperm32(t & 31);
                            const unsigned w0 = cvt_pk_bf16(v0[0], v0[1]), w1 = cvt_pk_bf16(v0[2], v0[3]), w2 = cvt_pk_bf16(v1[0], v1[1]), w3 = cvt_pk_bf16(v1[2], v1[3]);
                            vp[0] = (bf16_t)(w0 & 0xffffu); vp[32] = (bf16_t)(w0 >> 16); vp[64] = (bf16_t)(w1 & 0xffffu); vp[96] = (bf16_t)(w1 >> 16);
                            vp[128] = (bf16_t)(w2 & 0xffffu); vp[160] = (bf16_t)(w2 >> 16); vp[192] = (bf16_t)(w3 & 0xffffu); vp[224] = (bf16_t)(w3 >> 16);
                            if (t >= 1920) { float* o = oVp + ((size_t)((b * 128 + t - 1920) * 4 + kvh)) * 64 + d0; *(f32x4*)o = v0; *(f32x4*)(o + 4) = v1; }
                        } else {
                            const int bd = (row - MP) >> 2, tt = row & 3;
                            float* o = oVs + ((size_t)((bd * 128 + 124 + tt) * 4 + kvh)) * 64 + d0; *(f32x4*)o = v0; *(f32x4*)(o + 4) = v1;
                        }
                    }
                }
        } else {
            const bool gate = (pn < 10) || (pn == 12) || (pn == 13) || (pn >= 18);
            const bool isxb = (pn == 10) || (pn == 11);
#pragma unroll
            for (int ai = 0; ai < 2; ++ai)
#pragma unroll
                for (int m = 0; m < 4; ++m) {
                    const int row = row0 + ai * 128 + m * 16;
                    const bool smp = row >= MP;
#pragma unroll
                    for (int bj = 0; bj < 2; ++bj) {
                        const int c = pn * 256 + bj * 128 + cw;
                        f32x4 v0 = acc[ai][bj][m][0], v1 = acc[ai][bj][m][1];
                        if (isxb) {
                            const int cx = c - 2560;
                            if (!smp) { const int t = row & 2047; if (t >= 2033) { const int b = row >> 11; float* o = oPp + ((size_t)(b * 15 + t - 2033)) * 512 + cx; *(f32x4*)o = v0; *(f32x4*)(o + 4) = v1; } }
                            else { const int bd = (row - MP) >> 2, tt = row & 3; float* o = oPs + ((size_t)(bd * 15 + 11 + tt)) * 512 + cx; *(f32x4*)o = v0; *(f32x4*)(o + 4) = v1; }
                        }
                        if (gate) {
#pragma unroll
                            for (int j = 0; j < 4; ++j) { v0[j] = silu_f(v0[j]); v1[j] = silu_f(v1[j]); }
                        }
                        u32x4 w; w.x = cvt_pk_bf16(v0[0], v0[1]); w.y = cvt_pk_bf16(v0[2], v0[3]); w.z = cvt_pk_bf16(v1[0], v1[1]); w.w = cvt_pk_bf16(v1[2], v1[3]);
                        *(u32x4*)(Z2 + (size_t)row * ZW + (c - 1536)) = w;
                    }
                }
        }
    }
};

struct EpiOut {
    static constexpr bool PERM = true, AFTER_DRAIN = false;
    __device__ __forceinline__ void operator()(const f32x4 (&acc)[2][2][4][2], const Unit& u, int wr, int wc, int fr, int fq) const {
        const __attribute__((address_space(4))) EpiPtrs* kp = (const __attribute__((address_space(4))) EpiPtrs*)__builtin_amdgcn_kernarg_segment_ptr(); asm volatile("" : "+s"(kp));
        bf16_t* C = (bf16_t*)((unsigned char*)kp->ws + EP_Y);
        const int row0 = u.pm * BM + wr * 64 + fr, col0 = u.pn * BM + wc * 32 + 8 * fq;
#pragma unroll
        for (int ai = 0; ai < 2; ++ai)
#pragma unroll
            for (int m = 0; m < 4; ++m) { bf16_t* rowp = C + (size_t)(row0 + ai * HALF + m * 16) * DM + col0;
#pragma unroll
                for (int bj = 0; bj < 2; ++bj) { const f32x4 v0 = acc[ai][bj][m][0], v1 = acc[ai][bj][m][1];
                    u32x4 w; w.x = cvt_pk_bf16(v0[0], v0[1]); w.y = cvt_pk_bf16(v0[2], v0[3]); w.z = cvt_pk_bf16(v1[0], v1[1]); w.w = cvt_pk_bf16(v1[2], v1[3]);
                    *(u32x4*)(rowp + bj * HALF) = w; } }
    }
};
template <class Epi, class Sched, bool ALIGN_EPI = false, bool SP2 = false>
__device__ __forceinline__ void gemm_phase(PG8_LAS unsigned char* lds, const Gemm g, const Sched& S, const Epi& E) {
    int tid_ = threadIdx.x; asm volatile("" : "+v"(tid_));
    const int tid = tid_, wid = __builtin_amdgcn_readfirstlane(tid >> 6), lane = tid & 63, wr = wid >> 2, wc = wid & 3, fr = lane & 15, fq = lane >> 4;
    const int K = g.K, nt = K / BK;
    unsigned voffA[2], voffB[2];
#pragma unroll
    for (int i = 0; i < 2; ++i) { int R, C; stage_rc(tid * 16 + i * 8192, R, C); const int Rb = Epi::PERM ? ((R & ~31) + perm32(R & 31)) : R;
        voffA[i] = (unsigned)(R * K + C) * 2u; voffB[i] = (unsigned)(Rb * K + C) * 2u; }
    const size_t kstep = (size_t)(BK * 2);
    const size_t hstep = (size_t)HALF * K * 2;
    const size_t tstep = 2 * hstep;
    const unsigned ldsw = (unsigned)wid * 1024u;
    const int aoff = lds_byte(wr * 64 + fr, fq * 8), boff = lds_byte(wc * 32 + fr, fq * 8);
#define PG8_SA(b, h) (((b) * 2 + (h)) * HTB)
#define PG8_SB(b, h) ((4 + (b) * 2 + (h)) * HTB)
#define PG8_STAGE(bufoff, gbase, voff) do { _Pragma("unroll") for (int _i = 0; _i < 2; ++_i) \
        __builtin_amdgcn_global_load_lds((const unsigned*)((const char*)(gbase) + (voff)[_i]), (PG8_LAS unsigned*)(lds + (bufoff) + ldsw + _i * 8192), 16, 0, 0); } while (0)
#define PG8_LDA(dst, b, h) do { _Pragma("unroll") for (int m = 0; m < 4; ++m) _Pragma("unroll") for (int k = 0; k < 2; ++k) dst[m][k] = *(const PG8_LAS bf16x8*)(lds + PG8_SA(b, h) + aoff + m * 2048 + k * 1024); } while (0)
#define PG8_LDB(dst, b, h) do { _Pragma("unroll") for (int n = 0; n < 2; ++n) _Pragma("unroll") for (int k = 0; k < 2; ++k) dst[n][k] = *(const PG8_LAS bf16x8*)(lds + PG8_SB(b, h) + boff + n * 2048 + k * 1024); } while (0)
#define PG8_MMA(ai, bj, At, Bt) do { __builtin_amdgcn_s_setprio(1); _Pragma("unroll") for (int m = 0; m < 4; ++m) _Pragma("unroll") for (int n = 0; n < 2; ++n) _Pragma("unroll") for (int k = 0; k < 2; ++k) \
        acc[ai][bj][m][n] = __builtin_amdgcn_mfma_f32_16x16x32_bf16(Bt[n][k], At[m][k], acc[ai][bj][m][n], 0, 0, 0); __builtin_amdgcn_s_setprio(0); } while (0)
#define PG8_WAIT_V(n) asm volatile("s_waitcnt vmcnt(" #n ")" ::: "memory")
#define PG8_WAIT_L(n) asm volatile("s_waitcnt lgkmcnt(" #n ")" ::: "memory")
#define PG8_BAR __builtin_amdgcn_s_barrier()
#define PG8_SCHED __builtin_amdgcn_sched_barrier(0)
    Unit cur, nxt; int ui = 0;
    if (!S.next(0, cur)) return;
    f32x4 acc[2][2][4][2];
#pragma unroll
    for (int a = 0; a < 2; ++a)
#pragma unroll
        for (int b = 0; b < 2; ++b)
#pragma unroll
            for (int m = 0; m < 4; ++m)
#pragma unroll
                for (int n = 0; n < 2; ++n) acc[a][b][m][n] = (f32x4){0.f, 0.f, 0.f, 0.f};
    bf16x8 At[4][2], B0[2][2], B1[2][2];
    const char* cA = (const char*)g.A + (size_t)cur.pm * tstep; const char* cB = (const char*)g.Bt + (size_t)cur.pn * tstep;
    S.a_ready(cur);
    if constexpr (SP2) {
        PG8_STAGE(PG8_SB(0, 0), cB, voffB); PG8_STAGE(PG8_SB(0, 1), cB + hstep, voffB); PG8_STAGE(PG8_SA(0, 0), cA, voffA); PG8_STAGE(PG8_SA(0, 1), cA + hstep, voffA);
        if (wr == 1) PG8_BAR;
        PG8_WAIT_V(2); PG8_BAR;
        PG8_STAGE(PG8_SB(1, 0), cB + kstep, voffB); PG8_STAGE(PG8_SA(1, 0), cA + kstep, voffA); PG8_STAGE(PG8_SB(1, 1), cB + hstep + kstep, voffB);
        PG8_WAIT_V(6); PG8_BAR;
    } else {
        PG8_STAGE(PG8_SB(0, 0), cB, voffB); PG8_STAGE(PG8_SA(0, 0), cA, voffA); PG8_STAGE(PG8_SB(0, 1), cB + hstep, voffB); PG8_STAGE(PG8_SA(0, 1), cA + hstep, voffA);
        if (wr == 1) PG8_BAR;
        PG8_WAIT_V(4); PG8_BAR;
        PG8_STAGE(PG8_SB(1, 0), cB + kstep, voffB); PG8_STAGE(PG8_SA(1, 0), cA + kstep, voffA); PG8_STAGE(PG8_SB(1, 1), cB + hstep + kstep, voffB);
        PG8_WAIT_V(6); PG8_BAR;
    }
    for (;;) {
        const bool has_next = S.next(ui + 1, nxt);
        const char* nA = has_next ? (const char*)g.A + (size_t)nxt.pm * tstep : cA; const char* nB = has_next ? (const char*)g.Bt + (size_t)nxt.pn * tstep : cB;
        for (int t = 0; t < nt; t += 2) {
            const bool last = (t == nt - 2);
            const char* a1 = cA + (size_t)(t + 1) * kstep;
            const char* a2 = last ? nA : cA + (size_t)(t + 2) * kstep; const char* b2 = last ? nB : cB + (size_t)(t + 2) * kstep;
            const char* a3 = a2 + kstep; const char* b3 = b2 + kstep;
            if (last && has_next) S.a_ready(nxt);
            if constexpr (SP2) {
            PG8_LDB(B0, 0, 0); PG8_LDB(B1, 0, 1); PG8_SCHED; PG8_LDA(At, 0, 0); PG8_STAGE(PG8_SA(1, 1), a1 + hstep, voffA);
            PG8_WAIT_V(8); PG8_WAIT_L(0); PG8_BAR; PG8_MMA(0, 0, At, B0); PG8_MMA(0, 1, At, B1); PG8_BAR; PG8_SCHED;
            PG8_LDA(At, 0, 1); PG8_STAGE(PG8_SB(0, 0), b2, voffB); PG8_STAGE(PG8_SB(0, 1), b2 + hstep, voffB); PG8_STAGE(PG8_SA(0, 0), a2, voffA);
            PG8_WAIT_V(8); PG8_WAIT_L(0); PG8_BAR; PG8_MMA(1, 0, At, B0); PG8_MMA(1, 1, At, B1); PG8_BAR; PG8_SCHED;
            PG8_LDB(B0, 1, 0); PG8_LDB(B1, 1, 1); PG8_SCHED; PG8_LDA(At, 1, 0); PG8_STAGE(PG8_SA(0, 1), a2 + hstep, voffA);
            PG8_WAIT_V(8); PG8_WAIT_L(0); PG8_BAR; PG8_MMA(0, 0, At, B0); PG8_MMA(0, 1, At, B1); PG8_BAR; PG8_SCHED;
            PG8_LDA(At, 1, 1); PG8_STAGE(PG8_SB(1, 0), b3, voffB); PG8_STAGE(PG8_SB(1, 1), b3 + hstep, voffB); PG8_STAGE(PG8_SA(1, 0), a3, voffA);
            PG8_WAIT_V(8); PG8_WAIT_L(0); PG8_BAR; PG8_MMA(1, 0, At, B0); PG8_MMA(1, 1, At, B1); PG8_BAR; PG8_SCHED;
            } else {
            PG8_LDB(B0, 0, 0); PG8_SCHED; PG8_LDA(At, 0, 0); PG8_STAGE(PG8_SA(1, 1), a1 + hstep, voffA);
            PG8_WAIT_L(8); PG8_BAR; PG8_WAIT_L(0); PG8_MMA(0, 0, At, B0); PG8_BAR; PG8_SCHED;
            PG8_LDB(B1, 0, 1); PG8_STAGE(PG8_SB(0, 0), b2, voffB);
            PG8_BAR; PG8_WAIT_L(0); PG8_MMA(0, 1, At, B1); PG8_BAR;
            PG8_LDA(At, 0, 1); PG8_STAGE(PG8_SA(0, 0), a2, voffA);
            PG8_BAR; PG8_WAIT_L(0); PG8_MMA(1, 0, At, B0); PG8_BAR; PG8_SCHED;
            PG8_STAGE(PG8_SB(0, 1), b2 + hstep, voffB);
            PG8_WAIT_V(6); PG8_BAR; PG8_MMA(1, 1, At, B1); PG8_BAR;
            PG8_LDB(B0, 1, 0); PG8_SCHED; PG8_LDA(At, 1, 0); PG8_STAGE(PG8_SA(0, 1), a2 + hstep, voffA);
            PG8_WAIT_L(8); PG8_BAR; PG8_WAIT_L(0); PG8_MMA(0, 0, At, B0); PG8_BAR; PG8_SCHED;
            PG8_LDB(B1, 1, 1); PG8_STAGE(PG8_SB(1, 0), b3, voffB);
            PG8_BAR; PG8_WAIT_L(0); PG8_MMA(0, 1, At, B1); PG8_BAR;
            PG8_LDA(At, 1, 1); PG8_STAGE(PG8_SA(1, 0), a3, voffA);
            PG8_BAR; PG8_WAIT_L(0); PG8_MMA(1, 0, At, B0); PG8_BAR; PG8_SCHED;
            PG8_STAGE(PG8_SB(1, 1), b3 + hstep, voffB);
            PG8_WAIT_V(6); PG8_BAR; PG8_MMA(1, 1, At, B1); PG8_BAR;
            }
        }
        if constexpr (ALIGN_EPI) { if (wr == 0) PG8_BAR; }
        if constexpr (!Epi::AFTER_DRAIN) { E(acc, cur, wr, wc, fr, fq); S.done(cur); }
        if (!has_next) break;
#pragma unroll
        for (int a = 0; a < 2; ++a)
#pragma unroll
            for (int b = 0; b < 2; ++b)
#pragma unroll
                for (int m = 0; m < 4; ++m)
#pragma unroll
                    for (int n = 0; n < 2; ++n) acc[a][b][m][n] = (f32x4){0.f, 0.f, 0.f, 0.f};
        cur = nxt; cA = nA; cB = nB; ++ui;
        if constexpr (ALIGN_EPI) { if (wr == 1) PG8_BAR; }
    }
    PG8_WAIT_V(0);
    if constexpr (!ALIGN_EPI) { if (wr == 0) PG8_BAR; }
    PG8_BAR;
    if constexpr (Epi::AFTER_DRAIN) { E.fused(acc, cur, wr, wc, fr, fq, lds, wid, lane); S.done(cur); }
#undef PG8_SA
#undef PG8_SB
#undef PG8_STAGE
#undef PG8_LDA
#undef PG8_LDB
#undef PG8_MMA
#undef PG8_WAIT_V
#undef PG8_WAIT_L
#undef PG8_BAR
#undef PG8_SCHED
}
}
#define GAS __attribute__((address_space(1)))
#define LAS __attribute__((address_space(3)))
typedef GAS unsigned gu32;
typedef GAS unsigned long long gu64;
#define RLX_AGENT __ATOMIC_RELAXED, __HIP_MEMORY_SCOPE_AGENT
#define VM_WAIT() asm volatile("s_waitcnt vmcnt(0)" ::: "memory")
__device__ __forceinline__ unsigned long long rt() { return __builtin_amdgcn_s_memrealtime(); }
__device__ __forceinline__ unsigned f2bf(float f) { unsigned u = __builtin_bit_cast(unsigned, f); return (u + 0x7fffu + ((u >> 16) & 1u)) >> 16; }
__device__ __forceinline__ unsigned pk2(float lo, float hi) { return f2bf(lo) | (f2bf(hi) << 16); }

#define XB_TMO      128
#define XB_XCNT(j)  (256  + 64 * (j))
#define XB_XSUB(j)  (1280 + 64 * (j))
#define XB_XGEN(j)  (2304 + 64 * (j))
#define XB_TOP      3328
#define XB_TOPGEN   3392
#define XCD_BAR_WORDS 3456
#define XB_SPIN_CAP (1u << 18)

__device__ __forceinline__ unsigned xb_ld(unsigned* p)              { return __hip_atomic_load(p, __ATOMIC_RELAXED, __HIP_MEMORY_SCOPE_AGENT); }
__device__ __forceinline__ unsigned xb_add(unsigned* p, unsigned v) { return __hip_atomic_fetch_add(p, v, __ATOMIC_RELAXED, __HIP_MEMORY_SCOPE_AGENT); }
__device__ __forceinline__ unsigned xb_xcc_id() { return (unsigned)__builtin_amdgcn_s_getreg((3 << 11) | 20) & 0xFu; }
#define XB_SPIN(cond, bar) do { unsigned _sp = 0; while (cond) { __builtin_amdgcn_s_sleep(1); \
    if ((++_sp & 255u) == 0u) { if (xb_ld(&(bar)[XB_TMO])) break; if (_sp > XB_SPIN_CAP) { atomicAdd(&(bar)[XB_TMO], 1u); break; } } } } while (0)

struct XcdBarrier {
    unsigned* bar; unsigned x;
    volatile LAS unsigned* st;
};

__device__ __forceinline__ XcdBarrier xcd_barrier_post(unsigned* bar, volatile LAS unsigned* st) {
    XcdBarrier b; b.bar = bar; b.x = xb_xcc_id(); b.st = st;
    if (threadIdx.x == 0) (void)xb_add(&bar[XB_XCNT(b.x)], 1u);
    return b;
}
__device__ __forceinline__ void xcd_barrier_complete(unsigned* bar, unsigned x, unsigned& nloc, unsigned& nx) {
    const unsigned G = gridDim.x * gridDim.y * gridDim.z;
    unsigned sum, cnt, mine, sp = 0u;
    for (;;) {
        sum = 0u; cnt = 0u; mine = 0u;
#pragma unroll
        for (unsigned j = 0; j < 16; ++j) { const unsigned c = xb_ld(&bar[XB_XCNT(j)]); sum += c; cnt += (c > 0u) ? 1u : 0u; mine = (j == x) ? c : mine; }
        if (sum == G) break;
        __builtin_amdgcn_s_sleep(1);
        if ((++sp & 255u) == 0u) { if (xb_ld(&bar[XB_TMO])) break; if (sp > XB_SPIN_CAP) { atomicAdd(&bar[XB_TMO], 1u); break; } }
    }
    nloc = mine > 0u ? mine : 1u; nx = cnt > 0u ? cnt : 1u;
}

__device__ __forceinline__ void xcd_barrier(const XcdBarrier& b) {
    asm volatile("s_waitcnt vmcnt(0)" ::: "memory");
    __syncthreads();
    if (threadIdx.x == 0) {
        unsigned* bar = b.bar;
        __builtin_amdgcn_s_waitcnt(0);
        unsigned nloc = b.st[0], nx = b.st[1];
        if (nloc == 0u) { xcd_barrier_complete(bar, b.x, nloc, nx); b.st[0] = nloc; b.st[1] = nx; }
        const unsigned old = xb_add(&bar[XB_XSUB(b.x)], 1u);
        const unsigned gen = old / nloc;
        if (old + 1u == (gen + 1u) * nloc) {
            __builtin_amdgcn_fence(__ATOMIC_RELEASE, "agent");
            asm volatile("s_waitcnt vmcnt(0)" ::: "memory");
            const unsigned og = xb_add(&bar[XB_TOP], 1u);
            const unsigned tg = og / nx;
            if (og + 1u == (tg + 1u) * nx) xb_add(&bar[XB_TOPGEN], 1u);
            else XB_SPIN(xb_ld(&bar[XB_TOPGEN]) == tg, bar);
            __builtin_amdgcn_fence(__ATOMIC_ACQUIRE, "agent");
            xb_add(&bar[XB_XGEN(b.x)], 1u);
            asm volatile("s_waitcnt vmcnt(0)" ::: "memory");
        } else {
            XB_SPIN(xb_ld(&bar[XB_XGEN(b.x)]) == gen, bar);
            __builtin_amdgcn_fence(__ATOMIC_ACQUIRE, "agent");
            asm volatile("s_waitcnt vmcnt(0)" ::: "memory");
        }
    }
    __syncthreads();
}

using pg8::bf16_t; using pg8::bf16x8; using pg8::f32x4; using pg8::u32x4;
using pg8::DM; using pg8::MP; using pg8::MS; using pg8::MT; using pg8::DIN; using pg8::ZW;
using pg8::Z_GA; using pg8::Z_XB; using pg8::Z_GP; using pg8::Z_U; using pg8::Z_VS; using pg8::Z_GS; using pg8::LOG2E; using pg8::EPS;
typedef float f32x16 __attribute__((ext_vector_type(16)));
typedef unsigned u32x2 __attribute__((ext_vector_type(2)));
typedef short v4i16_t __attribute__((ext_vector_type(4)));

constexpr int NWAVES = 8, NTHREADS = 512;
constexpr int LDS_BYTES = 147456;
constexpr int RING_OFF = 1024;

constexpr size_t O_YP = 0, O_YS = 33554432, O_KP = 34603008, O_VP = 35127296, O_PP = 35651584, O_KS = 35774464, O_VS = 44163072, O_PS = 52551680, O_CV = 54517760, O_END = 55042048;
constexpr size_t LS_KP = 262144, LS_PP = 61440, LS_KS = 4194304, LS_PS = 983040, LS_CV = 262144;
constexpr size_t MiB = 1u << 20;
constexpr size_t WS_CTL = 0, CTL_ZERO_BYTES = 65536;
constexpr size_t WS_ROPE = 1 * MiB, WS_SGUW = 2 * MiB, WS_RSW = 2 * MiB + 256 * 1024, WS_PWT = 2 * MiB + 512 * 1024, WS_RSTD = 3 * MiB;
constexpr size_t WS_WTIN = 4 * MiB, WS_WTOUT = 44 * MiB, WS_H = 60 * MiB, WS_MIX = 126 * MiB, WS_QC = 192 * MiB, WS_KC = 225 * MiB, WS_VTP = 233 * MiB, WS_Z2 = 241 * MiB, WS_Y = 357 * MiB, WS_END = 489 * MiB;
constexpr int CW_BAR = 1024;

__constant__ double ROPE_INV[32] = {1.0, 0.7498942093324559, 0.5623413251903491, 0.4216965034285822, 0.31622776601683794, 0.23713737056616552, 0.1778279410038923, 0.1333521432163324, 0.1, 0.07498942093324558, 0.05623413251903491, 0.042169650342858224, 0.03162277660168379, 0.023713737056616554, 0.01778279410038923, 0.01333521432163324, 0.01, 0.007498942093324558, 0.005623413251903491, 0.004216965034285823, 0.0031622776601683794, 0.0023713737056616554, 0.0017782794100389228, 0.001333521432163324, 0.001, 0.0007498942093324559, 0.0005623413251903491, 0.00042169650342858224, 0.00031622776601683794, 0.00023713737056616554, 0.00017782794100389227, 0.0001333521432163324};

struct Args { const float* in[16]; float* out; unsigned char* ws; };

struct Frame {
    int tid, lane, wave, bid, G;
    const float *xp, *xs, *cache_k, *cache_v, *state_pool, *w_in, *w_out, *norm_pre, *norm_post, *sinks, *pool_w, *pool_scale, *ln_g, *ln_b, *sgu_w, *sgu_b;
    float* out;
    float* rope; float* RSW; float* RSTD; bf16_t *SGUW, *PWT, *WTIN, *WTOUT, *H, *MIX, *Qc, *Kc, *VTP, *Z2, *Yb;
};

__device__ __forceinline__ float wave_sum(float v) {
#pragma unroll
    for (int o = 1; o < 64; o <<= 1) v += __shfl_xor(v, o);
    return v;
}
__device__ __forceinline__ float wave_max(float v) {
#pragma unroll
    for (int o = 1; o < 64; o <<= 1) v = fmaxf(v, __shfl_xor(v, o));
    return v;
}
__device__ __forceinline__ float bflo(unsigned w) { return __uint_as_float(w << 16); }
__device__ __forceinline__ float bfhi(unsigned w) { return __uint_as_float(w & 0xffff0000u); }
__device__ __forceinline__ void unpack8(const u32x4 w, float (&f)[8]) { f[0] = bflo(w.x); f[1] = bfhi(w.x); f[2] = bflo(w.y); f[3] = bfhi(w.y); f[4] = bflo(w.z); f[5] = bfhi(w.z); f[6] = bflo(w.w); f[7] = bfhi(w.w); }
__device__ __forceinline__ void unpack4(const u32x2 w, float (&f)[4]) { f[0] = bflo(w.x); f[1] = bfhi(w.x); f[2] = bflo(w.y); f[3] = bfhi(w.y); }
__device__ __forceinline__ u32x4 pack8(const float (&f)[8]) { u32x4 w; w.x = pg8::cvt_pk_bf16(f[0], f[1]); w.y = pg8::cvt_pk_bf16(f[2], f[3]); w.z = pg8::cvt_pk_bf16(f[4], f[5]); w.w = pg8::cvt_pk_bf16(f[6], f[7]); return w; }
__device__ __forceinline__ int crow(int r, int hi) { return (r & 3) + 8 * (r >> 2) + 4 * hi; }
#define LDS_WAIT() asm volatile("s_waitcnt lgkmcnt(0)" ::: "memory")


struct ArgsG { const __attribute__((address_space(1))) float* in[16]; __attribute__((address_space(1))) float* out; __attribute__((address_space(1))) unsigned char* ws; };
typedef const __attribute__((address_space(4))) ArgsG* KArgs;
__device__ __forceinline__ KArgs kargs() { KArgs p = (KArgs)__builtin_amdgcn_kernarg_segment_ptr(); asm volatile("" : "+s"(p)); return p; }
__device__ __forceinline__ void make_frame(Frame& F, KArgs a) {
    { int t_ = threadIdx.x; asm volatile("" : "+v"(t_)); F.tid = t_; } F.lane = F.tid & 63; F.wave = __builtin_amdgcn_readfirstlane(F.tid >> 6); F.bid = blockIdx.x; F.G = gridDim.x;
    F.xp = (const float*)a->in[0]; F.xs = (const float*)a->in[1]; F.cache_k = (const float*)a->in[2]; F.cache_v = (const float*)a->in[3]; F.state_pool = (const float*)a->in[4]; F.w_in = (const float*)a->in[5]; F.w_out = (const float*)a->in[6]; F.norm_pre = (const float*)a->in[7]; F.norm_post = (const float*)a->in[8];
    F.sinks = (const float*)a->in[9]; F.pool_w = (const float*)a->in[10]; F.pool_scale = (const float*)a->in[11]; F.ln_g = (const float*)a->in[12]; F.ln_b = (const float*)a->in[13]; F.sgu_w = (const float*)a->in[14]; F.sgu_b = (const float*)a->in[15];
    F.out = (float*)a->out;
    unsigned char* ws = (unsigned char*)a->ws;
    F.rope = (float*)(ws + WS_ROPE); F.RSW = (float*)(ws + WS_RSW); F.RSTD = (float*)(ws + WS_RSTD); F.SGUW = (bf16_t*)(ws + WS_SGUW); F.PWT = (bf16_t*)(ws + WS_PWT); F.WTIN = (bf16_t*)(ws + WS_WTIN); F.WTOUT = (bf16_t*)(ws + WS_WTOUT);
    F.H = (bf16_t*)(ws + WS_H); F.MIX = (bf16_t*)(ws + WS_MIX); F.Qc = (bf16_t*)(ws + WS_QC); F.Kc = (bf16_t*)(ws + WS_KC); F.VTP = (bf16_t*)(ws + WS_VTP); F.Z2 = (bf16_t*)(ws + WS_Z2); F.Yb = (bf16_t*)(ws + WS_Y);
}

#define LOCAL_FRAME Frame F; make_frame(F, kargs())

constexpr int CW_Q = 8192;
constexpr int CW_ZS = 8192 + 64 * 8;
constexpr int CW_YS = 8192 + 64 * 16;
constexpr int CW_EV = 8192 + 64 * 32;
__device__ __forceinline__ unsigned* ctl_word(int idx) { return (unsigned*)((unsigned char*)kargs()->ws + WS_CTL) + idx; }
__device__ __forceinline__ int q_pop(unsigned* head, LAS unsigned char* L) {
    volatile LAS int* slot = (volatile LAS int*)(L + 64);
    __syncthreads();
    if (threadIdx.x == 0) *slot = (int)__hip_atomic_fetch_add(head, 1u, __ATOMIC_RELAXED, __HIP_MEMORY_SCOPE_AGENT);
    __syncthreads();
    return __builtin_amdgcn_readfirstlane(*slot);
}
__device__ __forceinline__ void publish(unsigned* ctr) {
    asm volatile("s_waitcnt vmcnt(0)" ::: "memory");
    __syncthreads();
    if (threadIdx.x == 0) { __builtin_amdgcn_fence(__ATOMIC_RELEASE, "agent"); asm volatile("s_waitcnt vmcnt(0)" ::: "memory");
        __hip_atomic_fetch_add(ctr, 1u, __ATOMIC_RELAXED, __HIP_MEMORY_SCOPE_AGENT); }
}
__device__ __forceinline__ void dep_wait(unsigned* ctr, unsigned need) {
    if (threadIdx.x == 0) {
        unsigned sp = 0;
        while (__hip_atomic_load(ctr, __ATOMIC_RELAXED, __HIP_MEMORY_SCOPE_AGENT) < need) { __builtin_amdgcn_s_sleep(16); if (++sp > (1u << 21)) break; }
        __builtin_amdgcn_fence(__ATOMIC_ACQUIRE, "agent"); asm volatile("s_waitcnt vmcnt(0)" ::: "memory");
    }
    __syncthreads();
}

#if PROBE_SEL >= 10 && (PROBE_SEL < 30 || PROBE_SEL >= 40)
#define EV_T0() const unsigned long long ev_t0 = __builtin_amdgcn_s_memrealtime()
#define EV_MAX(k) do { if (threadIdx.x == 0) __hip_atomic_fetch_max(ctl_word(CW_EV + 64 * (k)), (unsigned)(__builtin_amdgcn_s_memrealtime() - ev_t0), __ATOMIC_RELAXED, __HIP_MEMORY_SCOPE_AGENT); } while (0)
#define EV_MIN(k) do { if (threadIdx.x == 0) __hip_atomic_fetch_max(ctl_word(CW_EV + 64 * (k)), 0x40000000u - (unsigned)(__builtin_amdgcn_s_memrealtime() - ev_t0), __ATOMIC_RELAXED, __HIP_MEMORY_SCOPE_AGENT); } while (0)
#else
#define EV_T0() do {} while (0)
#define EV_MAX(k) do {} while (0)
#define EV_MIN(k) do {} while (0)
#endif
struct OneUnit {
    pg8::Unit u;
    __device__ __forceinline__ bool next(int i, pg8::Unit& o) const { if (i) return false; o = u; return true; }
    __device__ __forceinline__ void a_ready(const pg8::Unit&) const {}
    __device__ __forceinline__ void done(const pg8::Unit&) const {}
};

#ifndef PROBE_SEL
#define PROBE_SEL 0
#endif
#if PROBE_SEL
#define STAMP(k) do { if (blockIdx.x == 0 && threadIdx.x == 0) ((LAS unsigned long long*)(L + 256))[k] = __builtin_amdgcn_s_memrealtime(); } while (0)
#define STAMP2(k) do { if (blockIdx.x == 0) { __syncthreads(); if (threadIdx.x == 0) ((LAS unsigned long long*)((LAS unsigned char*)ring - RING_OFF + 256))[k] = __builtin_amdgcn_s_memrealtime(); } } while (0)
#else
#define STAMP(k) do {} while (0)
#define STAMP2(k) do {} while (0)
#endif
#if PROBE_SEL == 1
#define PA0 0
#define PA1 1
#define PB0 1
#define PB1 2
#elif PROBE_SEL == 2
#define PA0 2
#define PA1 3
#define PB0 3
#define PB1 4
#elif PROBE_SEL == 3
#define PA0 4
#define PA1 5
#define PB0 8
#define PB1 9
#elif PROBE_SEL == 4
#define PA0 2
#define PA1 10
#define PB0 10
#define PB1 11
#elif PROBE_SEL == 5
#define PA0 11
#define PA1 12
#define PB0 12
#define PB1 13
#elif PROBE_SEL == 7
#define PA0 1
#define PA1 2
#define PB0 0
#define PB1 1
#elif PROBE_SEL == 8
#define PA0 3
#define PA1 4
#define PB0 2
#define PB1 3
#elif PROBE_SEL == 9
#define PA0 6
#define PA1 7
#define PB0 4
#define PB1 5
#elif PROBE_SEL == 6
#define PA0 5
#define PA1 6
#define PB0 7
#define PB1 8
#elif PROBE_SEL >= 40 && PROBE_SEL < 60
#define PEA (PROBE_SEL - 40 + 16)
#define PEA_MIN (PROBE_SEL == 52)
#define PEB 0
#define PEB_MIN 0
#elif PROBE_SEL == 10
#define PEA 0
#define PEA_MIN 0
#define PEB 1
#define PEB_MIN 1
#elif PROBE_SEL == 11
#define PEA 2
#define PEA_MIN 0
#define PEB 3
#define PEB_MIN 1
#elif PROBE_SEL == 12
#define PEA 4
#define PEA_MIN 0
#define PEB 5
#define PEB_MIN 0
#elif PROBE_SEL == 14
#define PEA 8
#define PEA_MIN 0
#define PEB 9
#define PEB_MIN 0
#elif PROBE_SEL == 13
#define PEA 6
#define PEA_MIN 1
#define PEB 7
#define PEB_MIN 0
#endif

__device__ __forceinline__ void p0_transpose_blk(const float* W, int K, int N, bf16_t* WT, bool permqk, const float* kgain, LAS unsigned char* T, int item, int tid) {
    const int nblk = N >> 8, kb = item / nblk, nb = item - kb * nblk, k0 = kb * 128, n0 = nb * 256;
    const int n4 = tid & 63, kr = tid >> 6;
    f32x4 v[16];
#pragma unroll
    for (int i = 0; i < 16; ++i) v[i] = __builtin_nontemporal_load((const f32x4*)(W + (size_t)(k0 + 16 * kr + i) * N + n0 + 4 * n4));
    if (kgain) {
        const float* gp = kgain + k0 + 16 * kr;
#pragma unroll
        for (int i4 = 0; i4 < 4; ++i4) { const f32x4 gg = *(const f32x4*)(gp + 4 * i4);
#pragma unroll
            for (int j = 0; j < 4; ++j) v[4 * i4 + j] = v[4 * i4 + j] * gg[j]; }
    }
#pragma unroll
    for (int e = 0; e < 4; ++e) {
        u32x4 lo, hi;
        lo.x = pg8::cvt_pk_bf16(v[0][e], v[1][e]); lo.y = pg8::cvt_pk_bf16(v[2][e], v[3][e]); lo.z = pg8::cvt_pk_bf16(v[4][e], v[5][e]); lo.w = pg8::cvt_pk_bf16(v[6][e], v[7][e]);
        hi.x = pg8::cvt_pk_bf16(v[8][e], v[9][e]); hi.y = pg8::cvt_pk_bf16(v[10][e], v[11][e]); hi.z = pg8::cvt_pk_bf16(v[12][e], v[13][e]); hi.w = pg8::cvt_pk_bf16(v[14][e], v[15][e]);
        LAS unsigned char* p = T + (64 * e + n4) * 272 + 32 * kr;
        *(LAS u32x4*)p = lo; *(LAS u32x4*)(p + 16) = hi;
    }
    LDS_WAIT();
    __syncthreads();
    {
        const int rho = tid >> 1, half = tid & 1, n = n0 + 4 * (rho & 63) + (rho >> 6);
        int nrow = n;
        if (permqk && n < 1280) { const int p = n & 63; nrow = (n & ~63) + 2 * (p & 31) + (p >> 5); }
        const LAS unsigned char* src = T + rho * 272 + 128 * half;
        bf16_t* dst = WT + (size_t)nrow * K + k0 + 64 * half;
        u32x4 o[8];
#pragma unroll
        for (int c = 0; c < 8; ++c) o[c] = *(const LAS u32x4*)(src + 16 * c);
#pragma unroll
        for (int c = 0; c < 8; ++c) *(u32x4*)(dst + 8 * c) = o[c];
    }
    LDS_WAIT();
    __syncthreads();
}
__device__ __forceinline__ void prenorm_finish(const f32x4 (&v)[8], bf16_t* hrow, int lane) {
    float ss = 0.f;
#pragma unroll
    for (int j = 0; j < 8; ++j) ss += (v[j][0] * v[j][0] + v[j][1] * v[j][1]) + (v[j][2] * v[j][2] + v[j][3] * v[j][3]);
    ss = wave_sum(ss);
    const float r = rsqrtf(ss * (1.0f / 2048.0f) + EPS);
#pragma unroll
    for (int j = 0; j < 8; ++j) { const f32x4 o = v[j] * r; u32x2 w; w.x = pg8::cvt_pk_bf16(o[0], o[1]); w.y = pg8::cvt_pk_bf16(o[2], o[3]); *(u32x2*)(hrow + 4 * lane + 256 * j) = w; }
}
constexpr int TR_IN = 16 * 20, TR_OUT = 16 * 8, TR_ITEMS = TR_IN + TR_OUT;
__device__ __forceinline__ void transpose_item(const Frame& F, int l, int r, LAS unsigned char* ring) {
    if (r < TR_IN) p0_transpose_blk(F.w_in + (size_t)l * DM * DIN, DM, DIN, F.WTIN + (size_t)l * DIN * DM, true, F.norm_pre + l * DM, ring, r, F.tid);
    else p0_transpose_blk(F.w_out + (size_t)l * DM * DM, DM, DM, F.WTOUT + (size_t)l * DM * DM, false, nullptr, ring, r - TR_IN, F.tid);
}
__device__ __forceinline__ void p0_prologue(const Frame& F, LAS unsigned char* ring) {
    const int gw = F.bid * NWAVES + F.wave, NGW = F.G * NWAVES;
    EV_T0();
    for (int it = F.bid; it < TR_ITEMS; it += F.G) transpose_item(F, 0, it, ring);
    __syncthreads(); EV_MAX(8);
    for (int m = 2 * gw; m < MT; m += 2 * NGW) {
        const float* xa = m < MP ? F.xp + (size_t)m * DM : F.xs + (size_t)(m - MP) * DM; const float* xb = (m + 1) < MP ? F.xp + (size_t)(m + 1) * DM : F.xs + (size_t)(m + 1 - MP) * DM;
        f32x4 va[8], vb[8];
#pragma unroll
        for (int j = 0; j < 8; ++j) { va[j] = __builtin_nontemporal_load((const f32x4*)(xa + 4 * F.lane + 256 * j)); vb[j] = __builtin_nontemporal_load((const f32x4*)(xb + 4 * F.lane + 256 * j)); }
        prenorm_finish(va, F.H + (size_t)m * DM, F.lane); prenorm_finish(vb, F.H + (size_t)(m + 1) * DM, F.lane); }
    __syncthreads(); EV_MAX(9);
    const int gt = F.bid * NTHREADS + F.tid, NGT = F.G * NTHREADS;
    for (int e = gt; e < 2 * 4 * 128 * 128; e += NGT) { const int s = e & 127, t = (e >> 7) & 127; const float w = F.sgu_w[e];
        F.SGUW[e] = (bf16_t)(pg8::cvt_pk_bf16(s <= t ? w : 0.f, 0.f) & 0xffffu); }
    for (int e = gt; e < 2 * 4 * 128; e += NGT) { const int t = e & 127; const float* wr = F.sgu_w + (size_t)e * 128; float acc = 0.f;
        for (int s2 = 0; s2 <= t; ++s2) acc += __uint_as_float(pg8::cvt_pk_bf16(wr[s2], 0.f) << 16);
        F.RSW[e] = acc; }
    for (int e = gt; e < 2 * 4 * 128 * 128; e += NGT) { const int c = e & 127, d = (e >> 7) & 127, lg = e >> 14;
        F.PWT[e] = (bf16_t)(pg8::cvt_pk_bf16(F.pool_w[((size_t)lg * 128 + c) * 128 + d], 0.f) & 0xffffu); }
}

constexpr int AT_K = 0, AT_V = 49152, AT_STG = 98304, AT_WSTRIDE = 4352;
__device__ __forceinline__ void attn_stage_kv(const Frame& F, int b, int kvh, int nbp, LAS unsigned char* ring) {
    const int tid = F.tid;
    const bf16_t* kg = F.Kc + ((size_t)(b * 4 + kvh) * 2048 + 256 * nbp - 128) * 64;
    const bf16_t* vg = F.VTP + ((size_t)(b * 4 + kvh) * 64 + 8 * nbp - 4) * 2048;
    u32x4 kv[6], vv[6];
#pragma unroll
    for (int i = 0; i < 6; ++i) { const int ch = tid + 512 * i, row0 = ch >> 3, c8 = ch & 7, row = (nbp > 0 || row0 >= 128) ? row0 : row0 + 128;
        kv[i] = __builtin_nontemporal_load((const u32x4*)(kg + row * 64 + c8 * 8)); }
#pragma unroll
    for (int i = 0; i < 6; ++i) { const int ch = tid + 512 * i, tile0 = ch >> 8, rem = ch & 255, d = rem >> 2, c4 = rem & 3, tile = (nbp > 0 || tile0 >= 4) ? tile0 : tile0 + 4;
        vv[i] = __builtin_nontemporal_load((const u32x4*)(vg + tile * 2048 + d * 32 + c4 * 8)); }
#pragma unroll
    for (int i = 0; i < 6; ++i) { const int ch = tid + 512 * i, row = ch >> 3, c8 = ch & 7;
        *(LAS u32x4*)(ring + AT_K + row * 128 + ((c8 ^ (row & 7)) << 4)) = kv[i]; }
#pragma unroll
    for (int i = 0; i < 6; ++i) { const int ch = tid + 512 * i, tile = ch >> 8, rem = ch & 255, d = rem >> 2, c4 = rem & 3;
        *(LAS u32x4*)(ring + AT_V + tile * 4096 + d * 64 + ((c4 ^ ((d >> 2) & 3)) << 4)) = vv[i]; }
}
__device__ __forceinline__ void attn_task(const Frame& F, int l, int b, int nbp, int head, int j, const bf16x8 (&qf)[4], LAS unsigned char* ring) {
    const int lane = F.lane, r = lane & 31, hh = lane >> 5;
    LAS unsigned char* wl = ring + AT_STG + F.wave * AT_WSTRIDE;
    LAS float* wsf = (LAS float*)wl; LAS bf16_t* stg = (LAS bf16_t*)(wl + 256);
    const size_t qrow0 = (size_t)b * 2048 + 256 * nbp + 32 * j;
    u32x4 gv[4];
#pragma unroll
    for (int i = 0; i < 4; ++i) gv[i] = __builtin_nontemporal_load((const u32x4*)(F.Z2 + (qrow0 + i * 8 + (lane >> 3)) * ZW + Z_GA + head * 64 + (lane & 7) * 8));
    const int cmin = (nbp > 0) ? 0 : (j < 4 ? 4 - j : 0);
    f32x16 S[5];
#pragma unroll
    for (int c = 0; c < 5; ++c) {
        f32x16 a;
#pragma unroll
        for (int i = 0; i < 16; ++i) a[i] = 0.f;
        if (c >= cmin) {
            LAS unsigned char* kp = ring + AT_K + (32 * (j + c) + r) * 128;
#pragma unroll
            for (int s = 0; s < 4; ++s) a = __builtin_amdgcn_mfma_f32_32x32x16_bf16(*(const LAS bf16x8*)(kp + (((2 * s + hh) ^ (r & 7)) << 4)), qf[s], a, 0, 0, 0);
        }
        S[c] = a;
    }
    const float NEG = -INFINITY;
#pragma unroll
    for (int i = 0; i < 16; ++i) { const int kap = crow(i, hh); if (kap <= r) S[0][i] = NEG; if (kap > r) S[4][i] = NEG; }
    const float sink2 = F.sinks[l * 16 + head] * LOG2E;
    float m = sink2;
#pragma unroll
    for (int c = 0; c < 5; ++c) if (c >= cmin) {
#pragma unroll
        for (int i = 0; i < 16; ++i) m = fmaxf(m, S[c][i]); }
    m = fmaxf(m, __shfl_xor(m, 32));
    float sum = 0.f;
#pragma unroll
    for (int c = 0; c < 5; ++c) if (c >= cmin) {
#pragma unroll
        for (int i = 0; i < 16; ++i) { const float p = __builtin_amdgcn_exp2f(S[c][i] - m); S[c][i] = p; sum += p; } }
    sum += __shfl_xor(sum, 32);
    const float inv = 1.0f / (sum + __builtin_amdgcn_exp2f(sink2 - m));
    f32x16 o[2];
#pragma unroll
    for (int i = 0; i < 16; ++i) { o[0][i] = 0.f; o[1][i] = 0.f; }
#pragma unroll
    for (int c = 0; c < 5; ++c) if (c >= cmin) {
        LAS unsigned char* vt = ring + AT_V + (j + c) * 4096 + r * 64;
#pragma unroll
        for (int s = 0; s < 2; ++s) {
            u32x4 pw; pw.x = pg8::cvt_pk_bf16(S[c][8 * s + 0], S[c][8 * s + 1]); pw.y = pg8::cvt_pk_bf16(S[c][8 * s + 2], S[c][8 * s + 3]);
            pw.z = pg8::cvt_pk_bf16(S[c][8 * s + 4], S[c][8 * s + 5]); pw.w = pg8::cvt_pk_bf16(S[c][8 * s + 6], S[c][8 * s + 7]);
            const bf16x8 pa = __builtin_bit_cast(bf16x8, pw);
            const int sw = (((2 * hh + s) ^ ((r >> 2) & 3)) << 4);
#pragma unroll
            for (int db = 0; db < 2; ++db) o[db] = __builtin_amdgcn_mfma_f32_32x32x16_bf16(pa, *(const LAS bf16x8*)(vt + db * 2048 + sw), o[db], 0, 0, 0);
        }
    }
    if (hh == 0) wsf[r] = inv;
    LDS_WAIT();
#pragma unroll
    for (int i = 0; i < 16; ++i) { const int q = crow(i, hh); const float rl = wsf[q];
        stg[q * 64 + r] = (bf16_t)(pg8::cvt_pk_bf16(o[0][i] * rl, 0.f) & 0xffffu);
        stg[q * 64 + 32 + r] = (bf16_t)(pg8::cvt_pk_bf16(o[1][i] * rl, 0.f) & 0xffffu); }
    LDS_WAIT();
#pragma unroll
    for (int i = 0; i < 4; ++i) { const int row = i * 8 + (lane >> 3), ch = lane & 7;
        const u32x4 ov = *(const LAS u32x4*)(stg + row * 64 + ch * 8);
        float of[8], gf[8]; unpack8(ov, of); unpack8(gv[i], gf);
#pragma unroll
        for (int jj = 0; jj < 8; ++jj) of[jj] *= gf[jj];
        *(u32x4*)(F.MIX + (qrow0 + row) * DM + head * 64 + ch * 8) = pack8(of); }
    LDS_WAIT();
}
__device__ __forceinline__ void attn_unit(int l, int a, LAS unsigned char* ring) {
    LOCAL_FRAME;
    const int kvh = a & 3, nbp = (a >> 2) & 7, b = a >> 5;
    const int lane = F.lane, r = lane & 31, hh = lane >> 5;
    const int head = 4 * kvh + (F.wave >> 1), j0 = 4 * (F.wave & 1);
    const bf16_t* qp = F.Qc + ((size_t)b * 2048 + 256 * nbp + 32 * j0 + r) * 1024 + head * 64 + 8 * hh;
    bf16x8 qa[4], qb[4];
#pragma unroll
    for (int s = 0; s < 4; ++s) qa[s] = __builtin_nontemporal_load((const bf16x8*)(qp + 16 * s));
#ifdef EXP_ZERO_LDS
    for (int e = F.tid; e < 134144 / 16; e += NTHREADS) *(LAS u32x4*)(ring + 16 * e) = (u32x4){0u, 0u, 0u, 0u};
    LDS_WAIT(); __syncthreads();
#endif
    attn_stage_kv(F, b, kvh, nbp, ring);
    LDS_WAIT();
    __syncthreads();
#pragma unroll
    for (int s = 0; s < 4; ++s) qb[s] = __builtin_nontemporal_load((const bf16x8*)(qp + 32 * 1024 + 16 * s));
    attn_task(F, l, b, nbp, head, j0 + 0, qa, ring);
#pragma unroll
    for (int s = 0; s < 4; ++s) qa[s] = __builtin_nontemporal_load((const bf16x8*)(qp + 64 * 1024 + 16 * s));
    attn_task(F, l, b, nbp, head, j0 + 1, qb, ring);
#pragma unroll
    for (int s = 0; s < 4; ++s) qb[s] = __builtin_nontemporal_load((const bf16x8*)(qp + 96 * 1024 + 16 * s));
    attn_task(F, l, b, nbp, head, j0 + 2, qa, ring);
    attn_task(F, l, b, nbp, head, j0 + 3, qb, ring);
    __syncthreads();
}

constexpr int PL_STRIDE = 272, PL_WBYTES = 47 * 272;
template <int G>
__device__ __forceinline__ void pool_unit_p(int l, int tile, LAS unsigned char* wl) {
    LOCAL_FRAME;
    constexpr int W = 2 << G, HIST = W - 1, NROW = 32 + HIST, NLD = (NROW * 16 + 63) / 64;
    const int lane = F.lane, r = lane & 31, hh = lane >> 5;
    const size_t R0 = (size_t)32 * tile;
    const int t0 = (int)(R0 & 2047);
    {
        u32x4 x[NLD];
#pragma unroll
        for (int k = 0; k < NLD; ++k) { const int id = lane + 64 * k, lr = id >> 4, c16 = id & 15; const int lrc = lr < NROW ? lr : NROW - 1;
            const int back = HIST - lrc; const size_t grow = (back <= t0) ? R0 - back : R0;
            x[k] = __builtin_nontemporal_load((const u32x4*)(F.Z2 + grow * ZW + Z_XB + 128 * G + 8 * c16)); }
#pragma unroll
        for (int k = 0; k < NLD; ++k) { const int id = lane + 64 * k, lr = id >> 4, c16 = id & 15; if (lr < NROW) *(LAS u32x4*)(wl + lr * PL_STRIDE + c16 * 16) = x[k]; }
    }
    const int t = t0 + r;
    const float icnt = 1.0f / (float)(W < t + 1 ? W : t + 1);
    LDS_WAIT();
    bf16x8 bfr[8];
#pragma unroll
    for (int s = 0; s < 8; ++s) {
        LAS unsigned char* bp = wl + (r + HIST) * PL_STRIDE + (16 * s + 8 * hh) * 2;
        float cur[8], sum[8]; unpack8(*(const LAS u32x4*)bp, cur);
#pragma unroll
        for (int jj = 0; jj < 8; ++jj) sum[jj] = cur[jj];
#pragma unroll
        for (int i = 1; i < W; ++i) { float f[8]; unpack8(*(const LAS u32x4*)(bp - i * PL_STRIDE), f); const float wgt = i <= t ? 1.f : 0.f;
#pragma unroll
            for (int jj = 0; jj < 8; ++jj) sum[jj] += wgt * f[jj]; }
#pragma unroll
        for (int jj = 0; jj < 8; ++jj) sum[jj] = sum[jj] * icnt - cur[jj];
        bfr[s] = __builtin_bit_cast(bf16x8, pack8(sum));
        __builtin_amdgcn_sched_barrier(0);
    }
#pragma unroll
    for (int db = 0; db < 4; ++db) {
        const int col = 128 * G + 32 * db + r;
        unsigned short gq[16];
#pragma unroll
        for (int i = 0; i < 16; ++i) gq[i] = __builtin_nontemporal_load(F.Z2 + (R0 + crow(i, hh)) * ZW + Z_GP + col);
        const float sc = F.pool_scale[l * 512 + col];
        f32x16 acc;
#pragma unroll
        for (int i = 0; i < 16; ++i) acc[i] = 0.f;
        const bf16_t* bp2 = F.PWT + ((size_t)(l * 4 + G) * 128 + 32 * db + r) * 128 + 8 * hh;
#pragma unroll
        for (int s = 0; s < 8; ++s) acc = __builtin_amdgcn_mfma_f32_32x32x16_bf16(bfr[s], *(const bf16x8*)(bp2 + 16 * s), acc, 0, 0, 0);
#pragma unroll
        for (int i = 0; i < 16; ++i) { const float gf = __uint_as_float((unsigned)gq[i] << 16);
            F.MIX[(R0 + crow(i, hh)) * DM + 1024 + col] = (bf16_t)(pg8::cvt_pk_bf16(acc[i] * sc * gf, 0.f) & 0xffffu); }
        __builtin_amdgcn_sched_barrier(0);
    }
    LDS_WAIT();
}
__device__ __forceinline__ void pool_prompt(int l, int g, int tile, LAS unsigned char* wl) {
    if (g == 0) pool_unit_p<0>(l, tile, wl); else if (g == 1) pool_unit_p<1>(l, tile, wl); else if (g == 2) pool_unit_p<2>(l, tile, wl); else pool_unit_p<3>(l, tile, wl);
}
template <int G>
__device__ __forceinline__ void pool_unit_s(int l, int tile) {
    LOCAL_FRAME;
    constexpr int W = 2 << G;
    const int lane = F.lane, r = lane & 31, hh = lane >> 5;
    const size_t row = (size_t)MP + 32 * tile + r;
    const int tt = (int)(row & 3), bd = (int)((row - MP) >> 2);
    const float* stb = F.state_pool + ((size_t)l * 128 + bd) * 15 * 512;
    const float icnt = 1.0f / (float)W;
    bf16x8 bfr[8];
#pragma unroll
    for (int s = 0; s < 8; ++s) {
        const int c0 = 128 * G + 16 * s + 8 * hh;
        float sum[8], cur[8];
        {
            constexpr int NL = W < 4 ? W : 4;
            u32x4 zn[NL]; f32x4 sa[NL], sb[NL];
#pragma unroll
            for (int i = 0; i < NL; ++i) { const int back = i <= tt ? i : tt; int si = 15 + tt - i; si = si > 14 ? 14 : si;
                zn[i] = *(const u32x4*)(F.Z2 + (row - back) * ZW + Z_XB + c0); sa[i] = *(const f32x4*)(stb + si * 512 + c0); sb[i] = *(const f32x4*)(stb + si * 512 + c0 + 4); }
            unpack8(zn[0], cur);
#pragma unroll
            for (int jj = 0; jj < 8; ++jj) sum[jj] = cur[jj];
#pragma unroll
            for (int i = 1; i < NL; ++i) { float f[8]; unpack8(zn[i], f); const bool nw = i <= tt;
#pragma unroll
                for (int jj = 0; jj < 4; ++jj) { sum[jj] += nw ? f[jj] : sa[i][jj]; sum[4 + jj] += nw ? f[4 + jj] : sb[i][jj]; } }
        }
#pragma unroll
        for (int i0 = 4; i0 < W; i0 += 4) {
            f32x4 sa[4], sb[4];
#pragma unroll
            for (int i = 0; i < 4; ++i) { const int si = 15 + tt - (i0 + i); sa[i] = *(const f32x4*)(stb + si * 512 + c0); sb[i] = *(const f32x4*)(stb + si * 512 + c0 + 4); }
#pragma unroll
            for (int i = 0; i < 4; ++i)
#pragma unroll
                for (int jj = 0; jj < 4; ++jj) { sum[jj] += sa[i][jj]; sum[4 + jj] += sb[i][jj]; }
        }
#pragma unroll
        for (int jj = 0; jj < 8; ++jj) sum[jj] = sum[jj] * icnt - cur[jj];
        bfr[s] = __builtin_bit_cast(bf16x8, pack8(sum));
        __builtin_amdgcn_sched_barrier(0);
    }
    f32x16 acc[4];
#pragma unroll
    for (int db = 0; db < 4; ++db) {
#pragma unroll
        for (int i = 0; i < 16; ++i) acc[db][i] = 0.f;
        const bf16_t* ap = F.PWT + ((size_t)(l * 4 + G) * 128 + 32 * db + r) * 128 + 8 * hh;
#pragma unroll
        for (int s = 0; s < 8; ++s) acc[db] = __builtin_amdgcn_mfma_f32_32x32x16_bf16(*(const bf16x8*)(ap + 16 * s), bfr[s], acc[db], 0, 0, 0);
        __builtin_amdgcn_sched_barrier(0);
    }
#pragma unroll
    for (int db = 0; db < 4; ++db)
#pragma unroll
        for (int q = 0; q < 4; ++q) {
            const int col = 128 * G + 32 * db + 8 * q + 4 * hh;
            const f32x4 sc = *(const f32x4*)(F.pool_scale + l * 512 + col);
            float gf[4]; unpack4(*(const u32x2*)(F.Z2 + row * ZW + Z_GP + col), gf);
            u32x2 wv; wv.x = pg8::cvt_pk_bf16(acc[db][4 * q + 0] * sc[0] * gf[0], acc[db][4 * q + 1] * sc[1] * gf[1]);
            wv.y = pg8::cvt_pk_bf16(acc[db][4 * q + 2] * sc[2] * gf[2], acc[db][4 * q + 3] * sc[3] * gf[3]);
            *(u32x2*)(F.MIX + row * DM + 1024 + col) = wv;
        }
}
__device__ __forceinline__ void pool_sample(int l, int g, int tile) {
    if (g == 0) pool_unit_s<0>(l, tile); else if (g == 1) pool_unit_s<1>(l, tile); else if (g == 2) pool_unit_s<2>(l, tile); else pool_unit_s<3>(l, tile);
}

struct SguOps { bf16x8 wB[8], wA[4]; };
__device__ __forceinline__ void sgu_load_ops(SguOps& o, const Frame& F, int l, int hd, size_t R0, int r, int hh, int db, int tbA, int tbB) {
    const bf16_t* Wb = F.SGUW + (size_t)(l * 4 + hd) * 128 * 128;
#pragma unroll
    for (int s = 0; s < 8; ++s) { o.wB[s] = (bf16x8){0, 0, 0, 0, 0, 0, 0, 0}; if (s < 2 * (tbB + 1)) o.wB[s] = *(const bf16x8*)(Wb + (32 * tbB + r) * 128 + 16 * s + 8 * hh); }
#pragma unroll
    for (int s = 0; s < 4; ++s) { o.wA[s] = (bf16x8){0, 0, 0, 0, 0, 0, 0, 0}; if (s < 2 * (tbA + 1)) o.wA[s] = *(const bf16x8*)(Wb + (32 * tbA + r) * 128 + 16 * s + 8 * hh); }
}
constexpr int SG_TOFF = 81920, SG_TBYTES = 32 * 144;
struct SguUG { u32x4 uu[2], gg[2]; };
__device__ __forceinline__ void sgu_load_ug(SguUG& o, const Frame& F, int hd, size_t R0, int lane, int db, int tb) {
#pragma unroll
    for (int k = 0; k < 2; ++k) { const int id = lane + 64 * k; const size_t row = R0 + 32 * tb + (id >> 2); const int col = 128 * hd + 32 * db + 8 * (id & 3);
        o.uu[k] = __builtin_nontemporal_load((const u32x4*)(F.Z2 + row * ZW + Z_U + col)); o.gg[k] = __builtin_nontemporal_load((const u32x4*)(F.Z2 + row * ZW + Z_GS + col)); }
}
__device__ __forceinline__ void sgu_mfma(const SguOps& o, LAS bf16_t* VnT, int h2, int r, int hh, int db, int tbA, int tbB, f32x16& accA, f32x16& accB) {
#pragma unroll
    for (int i = 0; i < 16; ++i) { accA[i] = 0.f; accB[i] = 0.f; }
#pragma unroll
    for (int s = 0; s < 8; ++s) {
        if (s < 2 * (tbB + 1)) {
            const LAS unsigned char* ap = (const LAS unsigned char*)VnT + (h2 * 128 + 16 * s + 8 * hh + ((r & 15) >> 2)) * 320 + (32 * db + (r & 16) + 4 * (r & 3)) * 2;
            const v4i16_t lo = __builtin_amdgcn_ds_read_tr16_b64_v4i16((LAS v4i16_t*)ap), hi = __builtin_amdgcn_ds_read_tr16_b64_v4i16((LAS v4i16_t*)(ap + 4 * 320));
            const bf16x8 a = (bf16x8){lo[0], lo[1], lo[2], lo[3], hi[0], hi[1], hi[2], hi[3]};
            accB = __builtin_amdgcn_mfma_f32_32x32x16_bf16(a, o.wB[s], accB, 0, 0, 0);
            if (s < 4) { if (s < 2 * (tbA + 1)) accA = __builtin_amdgcn_mfma_f32_32x32x16_bf16(a, o.wA[s], accA, 0, 0, 0); }
        }
    }
}
__device__ __forceinline__ void sgu_epi(const SguUG& o, const Frame& F, int l, int hd, size_t R0, int lane, int db, int tb, const f32x16& acc, LAS unsigned char* T) {
    const int r = lane & 31, hh = lane >> 5;
#pragma unroll
    for (int q = 0; q < 4; ++q) *(LAS f32x4*)(T + r * 144 + (8 * q + 4 * hh) * 4) = (f32x4){acc[4 * q + 0], acc[4 * q + 1], acc[4 * q + 2], acc[4 * q + 3]};
    LDS_WAIT();
#pragma unroll
    for (int k = 0; k < 2; ++k) { const int id = lane + 64 * k, tl = id >> 2, c8 = 8 * (id & 3); const int t = 32 * tb + tl, col = 128 * hd + 32 * db + c8;
        const f32x4 v0 = *(const LAS f32x4*)(T + tl * 144 + c8 * 4), v1 = *(const LAS f32x4*)(T + tl * 144 + c8 * 4 + 16);
        const f32x4 g0 = *(const f32x4*)(F.ln_g + l * 512 + col), g1 = *(const f32x4*)(F.ln_g + l * 512 + col + 4), b0 = *(const f32x4*)(F.ln_b + l * 512 + col), b1 = *(const f32x4*)(F.ln_b + l * 512 + col + 4);
        const float bs = F.sgu_b[l * 512 + hd * 128 + t], rs = F.RSW[(l * 4 + hd) * 128 + t];
        float uf[8], gf[8], m[8]; unpack8(o.uu[k], uf); unpack8(o.gg[k], gf);
#pragma unroll
        for (int e = 0; e < 4; ++e) { m[e] = (g0[e] * v0[e] + b0[e] * rs + bs) * uf[e] * gf[e]; m[4 + e] = (g1[e] * v1[e] + b1[e] * rs + bs) * uf[4 + e] * gf[4 + e]; }
        *(u32x4*)(F.MIX + (R0 + t) * DM + 1536 + col) = pack8(m); }
    LDS_WAIT();
}
__device__ __forceinline__ void sgu_unit(int l, int ci, int hp, LAS unsigned char* ring) {
    LOCAL_FRAME;
    LAS bf16_t* VnT = (LAS bf16_t*)ring;
    const int lane = F.lane, wv = F.wave;
    const size_t R0 = (size_t)128 * ci;
    const int r = lane & 31, hh = lane >> 5, db = wv & 3; const int tbA = (wv >> 2) ? 1 : 0, tbB = (wv >> 2) ? 2 : 3;
    SguOps op0;
    {
        const int tl = lane >> 2, q4 = lane & 3;
        const bf16_t* vrow = F.Z2 + (R0 + 16 * wv + tl) * ZW + Z_VS + 32 * q4;
        u32x4 x[4][4];
#pragma unroll
        for (int h = 0; h < 4; ++h)
#pragma unroll
            for (int i = 0; i < 4; ++i) x[h][i] = *(const u32x4*)(vrow + 128 * h + 8 * i);
        sgu_load_ops(op0, F, l, 2 * hp, R0, r, hh, db, tbA, tbB);
        float s = 0.f, ss = 0.f;
#pragma unroll
        for (int h = 0; h < 4; ++h)
#pragma unroll
            for (int i = 0; i < 4; ++i) { float f[8]; unpack8(x[h][i], f);
#pragma unroll
                for (int jj = 0; jj < 8; ++jj) { s += f[jj]; ss += f[jj] * f[jj]; } }
        s += __shfl_xor(s, 1); s += __shfl_xor(s, 2); ss += __shfl_xor(ss, 1); ss += __shfl_xor(ss, 2);
        const float mean = s * (1.0f / 512.0f), var = ss * (1.0f / 512.0f) - mean * mean, rstd = rsqrtf(var + EPS);
#pragma unroll
        for (int h2 = 0; h2 < 2; ++h2)
#pragma unroll
            for (int i = 0; i < 4; ++i) { const int d = 32 * q4 + 8 * i;
                const u32x4 xv = hp ? x[2 + h2][i] : x[h2][i];
                float f[8]; unpack8(xv, f);
#pragma unroll
                for (int jj = 0; jj < 8; ++jj) f[jj] = (f[jj] - mean) * rstd;
                *(LAS u32x4*)((LAS unsigned char*)VnT + (h2 * 128 + 16 * wv + tl) * 320 + d * 2) = pack8(f); }
    }
    LDS_WAIT();
    __syncthreads();
    f32x16 accA, accB;
    SguUG ua, ub;
    LAS unsigned char* T = ring + SG_TOFF + wv * SG_TBYTES;
    sgu_load_ug(ua, F, 2 * hp, R0, lane, db, tbA); sgu_load_ug(ub, F, 2 * hp, R0, lane, db, tbB);
    sgu_mfma(op0, VnT, 0, r, hh, db, tbA, tbB, accA, accB);
    SguOps op1;
    sgu_load_ops(op1, F, l, 2 * hp + 1, R0, r, hh, db, tbA, tbB);
    sgu_epi(ua, F, l, 2 * hp, R0, lane, db, tbA, accA, T);
    sgu_epi(ub, F, l, 2 * hp, R0, lane, db, tbB, accB, T);
    sgu_load_ug(ua, F, 2 * hp + 1, R0, lane, db, tbA); sgu_load_ug(ub, F, 2 * hp + 1, R0, lane, db, tbB);
    sgu_mfma(op1, VnT, 1, r, hh, db, tbA, tbB, accA, accB);
    sgu_epi(ua, F, l, 2 * hp + 1, R0, lane, db, tbA, accA, T);
    sgu_epi(ub, F, l, 2 * hp + 1, R0, lane, db, tbB, accB, T);
    __syncthreads();
}

__device__ __forceinline__ void samp_attn(int l, int bd, int kvh, LAS unsigned char* wl) {
    LOCAL_FRAME;
    LAS float* ps = (LAS float*)wl;
    LAS float* invs = ps + 144 * 16;
    const int lane = F.lane, fr = lane & 15, fq = lane >> 4, gq = fr >> 2, tt = fr & 3;
    float* oKs = F.out + O_KS + (size_t)l * LS_KS; float* oVs = F.out + O_VS + (size_t)l * LS_KS;
    bf16x8 qfr[2];
    {
        const bf16_t* qsrc = F.Qc + ((size_t)MP + 4 * bd + tt) * 1024 + (4 * kvh + gq) * 64 + 16 * fq;
        const u32x4 qa = *(const u32x4*)qsrc, qb = *(const u32x4*)(qsrc + 8);
        u32x4 lo, hi;
        lo.x = (qa.x & 0xffffu) | (qa.y << 16); lo.y = (qa.z & 0xffffu) | (qa.w << 16); lo.z = (qb.x & 0xffffu) | (qb.y << 16); lo.w = (qb.z & 0xffffu) | (qb.w << 16);
        hi.x = (qa.x >> 16) | (qa.y & 0xffff0000u); hi.y = (qa.z >> 16) | (qa.w & 0xffff0000u); hi.z = (qb.x >> 16) | (qb.y & 0xffff0000u); hi.w = (qb.z >> 16) | (qb.w & 0xffff0000u);
        qfr[0] = __builtin_bit_cast(bf16x8, lo); qfr[1] = __builtin_bit_cast(bf16x8, hi);
    }
    const float* kc = F.cache_k + (((size_t)l * 128 + bd) * 128) * 256 + kvh * 64 + 8 * fq;
    const float* kn = oKs + (((size_t)bd * 128 + 124 + (fr & 3)) * 4 + kvh) * 64 + 8 * fq;
    float* kd = oKs + ((size_t)bd * 128 * 4 + kvh) * 64 + 8 * fq;
    f32x4 S[9];
#pragma unroll
    for (int T = 0; T < 9; ++T) S[T] = (f32x4){0.f, 0.f, 0.f, 0.f};
#pragma unroll
    for (int T0 = 0; T0 < 9; T0 += 3) {
        f32x4 x[3][2][2];
#pragma unroll
        for (int u = 0; u < 3; ++u) { const int T = T0 + u; const float* src = (T < 8) ? kc + (size_t)(16 * T + fr) * 256 : kn;
#pragma unroll
            for (int ks = 0; ks < 2; ++ks) { x[u][ks][0] = __builtin_nontemporal_load((const f32x4*)(src + 32 * ks)); x[u][ks][1] = __builtin_nontemporal_load((const f32x4*)(src + 32 * ks + 4)); } }
#pragma unroll
        for (int u = 0; u < 3; ++u) { const int T = T0 + u; const int key = 16 * T + fr;
            if (T < 8 && key >= 4) {
#pragma unroll
                for (int ks = 0; ks < 2; ++ks) { float* dst = kd + (size_t)(key - 4) * 256 + 32 * ks; __builtin_nontemporal_store(x[u][ks][0], (f32x4*)dst); __builtin_nontemporal_store(x[u][ks][1], (f32x4*)(dst + 4)); } } }
#pragma unroll
        for (int u = 0; u < 3; ++u)
#pragma unroll
            for (int ks = 0; ks < 2; ++ks) { u32x4 w; w.x = pg8::cvt_pk_bf16(x[u][ks][0][0], x[u][ks][0][1]); w.y = pg8::cvt_pk_bf16(x[u][ks][0][2], x[u][ks][0][3]);
                w.z = pg8::cvt_pk_bf16(x[u][ks][1][0], x[u][ks][1][1]); w.w = pg8::cvt_pk_bf16(x[u][ks][1][2], x[u][ks][1][3]);
                S[T0 + u] = __builtin_amdgcn_mfma_f32_16x16x32_bf16(__builtin_bit_cast(bf16x8, w), qfr[ks], S[T0 + u], 0, 0, 0); }
        __builtin_amdgcn_sched_barrier(0);
    }
    const float sink2 = F.sinks[l * 16 + 4 * kvh + gq] * LOG2E;
    float m = sink2;
#pragma unroll
    for (int T = 0; T < 9; ++T)
#pragma unroll
        for (int rg = 0; rg < 4; ++rg) { const int key = 16 * T + 4 * fq + rg; const bool ok = (T < 8) ? (key >= tt + 1) : (fq == 0 && rg <= tt);
            S[T][rg] = ok ? S[T][rg] : -INFINITY; m = fmaxf(m, S[T][rg]); }
    m = fmaxf(m, __shfl_xor(m, 16)); m = fmaxf(m, __shfl_xor(m, 32));
    float sum = 0.f;
#pragma unroll
    for (int T = 0; T < 9; ++T)
#pragma unroll
        for (int rg = 0; rg < 4; ++rg) { const float p = __builtin_amdgcn_exp2f(S[T][rg] - m); sum += p; ps[(16 * T + 4 * fq + rg) * 16 + fr] = p; }
    sum += __shfl_xor(sum, 16); sum += __shfl_xor(sum, 32);
    if (fq == 0) invs[fr] = 1.0f / (sum + __builtin_amdgcn_exp2f(sink2 - m));
    LDS_WAIT();
    const int kq = lane >> 4, dq = lane & 15;
    const float* vcp = F.cache_v + (((size_t)l * 128 + bd) * 128 + kq) * 256 + kvh * 64 + 4 * dq;
    float* vop = oVs + ((size_t)bd * 128 + kq) * 256 + kvh * 64 + 4 * dq;
#pragma unroll 1
    for (int pass = 0; pass < 2; ++pass) {
        float o[8][4];
#pragma unroll
        for (int q = 0; q < 8; ++q) { o[q][0] = 0.f; o[q][1] = 0.f; o[q][2] = 0.f; o[q][3] = 0.f; }
#pragma unroll 1
        for (int blk = 0; blk < 3; ++blk) {
            f32x4 vx[11];
#pragma unroll
            for (int ii = 0; ii < 11; ++ii) { const int i = blk * 11 + ii; const float* src = (i < 32) ? vcp + (size_t)i * 1024 : vop + (size_t)31 * 1024; vx[ii] = __builtin_nontemporal_load((const f32x4*)src); }
            if (pass == 0) {
#pragma unroll
                for (int ii = 0; ii < 11; ++ii) { const int i = blk * 11 + ii; if (i >= 1 && i < 32) __builtin_nontemporal_store(vx[ii], (f32x4*)(vop + (size_t)(i - 1) * 1024)); } }
#pragma unroll
            for (int ii = 0; ii < 11; ++ii) { const int key = 4 * (blk * 11 + ii) + kq;
                const f32x4 pa = *(const LAS f32x4*)(ps + key * 16 + 8 * pass), pb = *(const LAS f32x4*)(ps + key * 16 + 8 * pass + 4);
#pragma unroll
                for (int e = 0; e < 4; ++e) { o[0][e] += pa[0] * vx[ii][e]; o[1][e] += pa[1] * vx[ii][e]; o[2][e] += pa[2] * vx[ii][e]; o[3][e] += pa[3] * vx[ii][e];
                    o[4][e] += pb[0] * vx[ii][e]; o[5][e] += pb[1] * vx[ii][e]; o[6][e] += pb[2] * vx[ii][e]; o[7][e] += pb[3] * vx[ii][e]; }
                __builtin_amdgcn_sched_barrier(0); }
        }
#pragma unroll
        for (int q = 0; q < 8; ++q)
#pragma unroll
            for (int e = 0; e < 4; ++e) { float v = o[q][e]; v += __shfl_xor(v, 16); v += __shfl_xor(v, 32); o[q][e] = v; }
#pragma unroll
        for (int q = 0; q < 8; ++q) if ((q >> 1) == kq) { const int qq = 8 * pass + q, t2 = qq & 3, head = 4 * kvh + (qq >> 2); const size_t row = (size_t)MP + 4 * bd + t2;
            float gf[4]; unpack4(*(const u32x2*)(F.Z2 + row * ZW + Z_GA + head * 64 + 4 * dq), gf);
            const float iq = invs[qq];
            u32x2 wv; wv.x = pg8::cvt_pk_bf16(o[q][0] * iq * gf[0], o[q][1] * iq * gf[1]); wv.y = pg8::cvt_pk_bf16(o[q][2] * iq * gf[2], o[q][3] * iq * gf[3]);
            *(u32x2*)(F.MIX + row * DM + head * 64 + 4 * dq) = wv; }
    }
    LDS_WAIT();
}
__device__ __forceinline__ void samp_sgu(int l, int bd) {
    LOCAL_FRAME;
    const int lane = F.lane, c0 = 8 * lane, hd = lane >> 4;
    {
        float* oPs = F.out + O_PS + (size_t)l * LS_PS + (size_t)bd * 15 * 512; const float* sp = F.state_pool + (size_t)l * LS_PS + (size_t)bd * 15 * 512 + 4 * 512;
        f32x4 cp[22];
#pragma unroll
        for (int k = 0; k < 22; ++k) cp[k] = __builtin_nontemporal_load((const f32x4*)(sp + 4 * (lane + 64 * k)));
#pragma unroll
        for (int k = 0; k < 22; ++k) __builtin_nontemporal_store(cp[k], (f32x4*)(oPs + 4 * (lane + 64 * k)));
    }
    float* oCV = F.out + O_CV + (size_t)l * LS_CV;
    float gl[8], bl[8];
#pragma unroll
    for (int j = 0; j < 8; ++j) { gl[j] = F.ln_g[l * 512 + c0 + j]; bl[j] = F.ln_b[l * 512 + c0 + j]; }
    u32x4 xr[4], ur[4], gr[4];
#pragma unroll
    for (int tt = 0; tt < 4; ++tt) { const size_t row = (size_t)MP + 4 * bd + tt; xr[tt] = *(const u32x4*)(F.Z2 + row * ZW + Z_VS + c0); ur[tt] = *(const u32x4*)(F.Z2 + row * ZW + Z_U + c0); gr[tt] = *(const u32x4*)(F.Z2 + row * ZW + Z_GS + c0); }
    float vn[4][8];
#pragma unroll
    for (int tt = 0; tt < 4; ++tt) { float f[8]; unpack8(xr[tt], f);
        float s = 0.f, ss = 0.f;
#pragma unroll
        for (int j = 0; j < 8; ++j) { s += f[j]; ss += f[j] * f[j]; }
        s = wave_sum(s); ss = wave_sum(ss);
        const float mean = s * (1.0f / 512.0f), var = ss * (1.0f / 512.0f) - mean * mean, rstd = rsqrtf(var + EPS);
#pragma unroll
        for (int j = 0; j < 8; ++j) vn[tt][j] = (f[j] - mean) * rstd * gl[j] + bl[j];
        float* o = oCV + ((size_t)bd * 4 + tt) * 512 + c0;
        *(f32x4*)o = (f32x4){vn[tt][0], vn[tt][1], vn[tt][2], vn[tt][3]}; *(f32x4*)(o + 4) = (f32x4){vn[tt][4], vn[tt][5], vn[tt][6], vn[tt][7]}; }
#pragma unroll
    for (int tt = 0; tt < 4; ++tt) { const size_t row = (size_t)MP + 4 * bd + tt;
        float mx[8]; const float bias = F.sgu_b[l * 512 + hd * 128 + tt];
#pragma unroll
        for (int j = 0; j < 8; ++j) mx[j] = bias;
#pragma unroll
        for (int s2 = 0; s2 < 4; ++s2) if (s2 <= tt) { const float w = F.sgu_w[((size_t)(l * 4 + hd) * 128 + tt) * 128 + s2];
#pragma unroll
            for (int j = 0; j < 8; ++j) mx[j] += w * vn[s2][j]; }
        float uf[8], gf[8]; unpack8(ur[tt], uf); unpack8(gr[tt], gf);
#pragma unroll
        for (int j = 0; j < 8; ++j) mx[j] = mx[j] * uf[j] * gf[j];
        *(u32x4*)(F.MIX + row * DM + 1536 + c0) = pack8(mx); }
}

#ifdef HYBRID
__device__ __forceinline__ void attn_task_o(const Frame& F, int l, int b, int nb, int head, int qs, LAS unsigned char* wl) {
    const int lane = F.lane, r = lane & 31, hh = lane >> 5, kvh = head >> 2;
    LAS float* wsf = (LAS float*)wl; LAS bf16_t* stg = (LAS bf16_t*)(wl + 256);
    const int t0 = 128 * nb + 32 * qs;
    const size_t qrow0 = (size_t)b * 2048 + t0;
    const bf16_t* qp = F.Qc + (qrow0 + r) * 1024 + head * 64 + 8 * hh;
    bf16x8 qf[4];
#pragma unroll
    for (int s = 0; s < 4; ++s) qf[s] = *(const bf16x8*)(qp + 16 * s);
    const bf16_t* kbase = F.Kc + (size_t)(b * 4 + kvh) * 2048 * 64;
    const bf16_t* vbase = F.VTP + (size_t)(b * 4 + kvh) * 64 * 2048;
    const int cmin = (nb > 0) ? 0 : (4 - qs);
    f32x16 S[5];
#pragma unroll
    for (int c = 0; c < 5; ++c) {
        f32x16 a;
#pragma unroll
        for (int i = 0; i < 16; ++i) a[i] = 0.f;
        if (c >= cmin) {
            const bf16_t* kp = kbase + (size_t)(t0 - 128 + 32 * c + r) * 64 + 8 * hh;
#pragma unroll
            for (int s = 0; s < 4; ++s) a = __builtin_amdgcn_mfma_f32_32x32x16_bf16(*(const bf16x8*)(kp + 16 * s), qf[s], a, 0, 0, 0);
        }
        S[c] = a;
    }
    const float NEG = -INFINITY;
#pragma unroll
    for (int i = 0; i < 16; ++i) { const int kap = crow(i, hh); if (kap <= r) S[0][i] = NEG; if (kap > r) S[4][i] = NEG; }
    const float sink2 = F.sinks[l * 16 + head] * LOG2E;
    float m = sink2;
#pragma unroll
    for (int c = 0; c < 5; ++c) if (c >= cmin) {
#pragma unroll
        for (int i = 0; i < 16; ++i) m = fmaxf(m, S[c][i]); }
    m = fmaxf(m, __shfl_xor(m, 32));
    float sum = 0.f;
#pragma unroll
    for (int c = 0; c < 5; ++c) if (c >= cmin) {
#pragma unroll
        for (int i = 0; i < 16; ++i) { const float p = __builtin_amdgcn_exp2f(S[c][i] - m); S[c][i] = p; sum += p; } }
    sum += __shfl_xor(sum, 32);
    const float inv = 1.0f / (sum + __builtin_amdgcn_exp2f(sink2 - m));
    f32x16 o[2];
#pragma unroll
    for (int i = 0; i < 16; ++i) { o[0][i] = 0.f; o[1][i] = 0.f; }
#pragma unroll
    for (int c = 0; c < 5; ++c) if (c >= cmin) {
        const bf16_t* vt = vbase + (size_t)((t0 - 128 + 32 * c) >> 5) * 2048 + r * 32 + 16 * hh;
#pragma unroll
        for (int s = 0; s < 2; ++s) {
            u32x4 pw; pw.x = pg8::cvt_pk_bf16(S[c][8 * s + 0], S[c][8 * s + 1]); pw.y = pg8::cvt_pk_bf16(S[c][8 * s + 2], S[c][8 * s + 3]);
            pw.z = pg8::cvt_pk_bf16(S[c][8 * s + 4], S[c][8 * s + 5]); pw.w = pg8::cvt_pk_bf16(S[c][8 * s + 6], S[c][8 * s + 7]);
            const bf16x8 pa = __builtin_bit_cast(bf16x8, pw);
#pragma unroll
            for (int db = 0; db < 2; ++db) o[db] = __builtin_amdgcn_mfma_f32_32x32x16_bf16(pa, *(const bf16x8*)(vt + db * 1024 + 8 * s), o[db], 0, 0, 0);
        }
    }
    if (hh == 0) wsf[r] = inv;
    LDS_WAIT();
#pragma unroll
    for (int i = 0; i < 16; ++i) { const int q = crow(i, hh); const float rl = wsf[q];
        stg[q * 64 + r] = (bf16_t)(pg8::cvt_pk_bf16(o[0][i] * rl, 0.f) & 0xffffu);
        stg[q * 64 + 32 + r] = (bf16_t)(pg8::cvt_pk_bf16(o[1][i] * rl, 0.f) & 0xffffu); }
    LDS_WAIT();
#pragma unroll
    for (int i = 0; i < 4; ++i) { const int row = i * 8 + (lane >> 3), ch = lane & 7;
        const u32x4 ov = *(const LAS u32x4*)(stg + row * 64 + ch * 8);
        const u32x4 gv = *(const u32x4*)(F.Z2 + (qrow0 + row) * ZW + Z_GA + head * 64 + ch * 8);
        float of[8], gf[8]; unpack8(ov, of); unpack8(gv, gf);
#pragma unroll
        for (int j = 0; j < 8; ++j) of[j] *= gf[j];
        *(u32x4*)(F.MIX + (qrow0 + row) * DM + head * 64 + ch * 8) = pack8(of); }
    LDS_WAIT();
}

template <bool SAMPLE>
__device__ __forceinline__ void pool_unit_o(const Frame& F, int l, int g, int tile) {
    const int lane = F.lane, r = lane & 31, hh = lane >> 5, w = 2 << g;
    const size_t row = (size_t)(SAMPLE ? MP : 0) + 32 * tile + r;
    const int t = SAMPLE ? (int)(row & 3) : (int)(row & 2047);
    const int bd = SAMPLE ? (int)((row - MP) >> 2) : 0;
    const float icnt = SAMPLE ? 1.0f / (float)w : 1.0f / (float)(w < t + 1 ? w : t + 1);
    bf16x8 bfr[8];
#pragma unroll
    for (int s = 0; s < 8; ++s) {
        const int c0 = 128 * g + 16 * s + 8 * hh;
        float sum[8], cur[8];
#pragma unroll
        for (int j = 0; j < 8; ++j) { sum[j] = 0.f; cur[j] = 0.f; }
        for (int i = 0; i < w; ++i) {
            float f[8];
            const int e = t - i;
            if (e >= 0) { unpack8(*(const u32x4*)(F.Z2 + (row - i) * ZW + Z_XB + c0), f); }
            else if (SAMPLE) { const float* sp = F.state_pool + (((size_t)l * 128 + bd) * 15 + 15 + e) * 512 + c0;
                const f32x4 a = *(const f32x4*)sp, bq = *(const f32x4*)(sp + 4); f[0] = a[0]; f[1] = a[1]; f[2] = a[2]; f[3] = a[3]; f[4] = bq[0]; f[5] = bq[1]; f[6] = bq[2]; f[7] = bq[3]; }
            else {
#pragma unroll
                for (int j = 0; j < 8; ++j) f[j] = 0.f; }
#pragma unroll
            for (int j = 0; j < 8; ++j) sum[j] += f[j];
            if (i == 0) {
#pragma unroll
                for (int j = 0; j < 8; ++j) cur[j] = f[j]; }
        }
        float pf[8];
#pragma unroll
        for (int j = 0; j < 8; ++j) pf[j] = sum[j] * icnt - cur[j];
        bfr[s] = __builtin_bit_cast(bf16x8, pack8(pf));
    }
    f32x16 acc[4];
#pragma unroll
    for (int db = 0; db < 4; ++db) {
#pragma unroll
        for (int i = 0; i < 16; ++i) acc[db][i] = 0.f;
        const bf16_t* ap = F.PWT + ((size_t)(l * 4 + g) * 128 + 32 * db + r) * 128 + 8 * hh;
#pragma unroll
        for (int s = 0; s < 8; ++s) acc[db] = __builtin_amdgcn_mfma_f32_32x32x16_bf16(*(const bf16x8*)(ap + 16 * s), bfr[s], acc[db], 0, 0, 0);
    }
#pragma unroll
    for (int db = 0; db < 4; ++db)
#pragma unroll
        for (int q = 0; q < 4; ++q) {
            const int col = 128 * g + 32 * db + 8 * q + 4 * hh;
            const f32x4 sc = *(const f32x4*)(F.pool_scale + l * 512 + col);
            float gf[4]; unpack4(*(const u32x2*)(F.Z2 + row * ZW + Z_GP + col), gf);
            u32x2 wv; wv.x = pg8::cvt_pk_bf16(acc[db][4 * q + 0] * sc[0] * gf[0], acc[db][4 * q + 1] * sc[1] * gf[1]);
            wv.y = pg8::cvt_pk_bf16(acc[db][4 * q + 2] * sc[2] * gf[2], acc[db][4 * q + 3] * sc[3] * gf[3]);
            *(u32x2*)(F.MIX + row * DM + 1024 + col) = wv;
        }
}

__device__ __forceinline__ void sgu_unit_o(const Frame& F, int l, int ci, int hd, LAS unsigned char* ring) {
    LAS bf16_t* VnT = (LAS bf16_t*)ring;
    const int lane = F.lane, wv = F.wave;
    const size_t R0 = (size_t)128 * ci;
    {
        const int tl = lane >> 2, q4 = lane & 3;
        const bf16_t* vrow = F.Z2 + (R0 + 16 * wv + tl) * ZW + Z_VS;
        float s = 0.f, ss = 0.f;
#pragma unroll
        for (int i = 0; i < 16; ++i) { float f[8]; unpack8(*(const u32x4*)(vrow + 128 * q4 + 8 * i), f);
#pragma unroll
            for (int j = 0; j < 8; ++j) { s += f[j]; ss += f[j] * f[j]; } }
        s += __shfl_xor(s, 1); s += __shfl_xor(s, 2); ss += __shfl_xor(ss, 1); ss += __shfl_xor(ss, 2);
        const float mean = s * (1.0f / 512.0f), var = ss * (1.0f / 512.0f) - mean * mean, rstd = rsqrtf(var + EPS);
#pragma unroll
        for (int i = 0; i < 4; ++i) { const int d = 32 * q4 + 8 * i; float f[8]; unpack8(*(const u32x4*)(vrow + 128 * hd + d), f);
            const float* gp = F.ln_g + l * 512 + 128 * hd + d; const float* bp = F.ln_b + l * 512 + 128 * hd + d;
#pragma unroll
            for (int j = 0; j < 8; ++j) { const float vn = (f[j] - mean) * rstd * gp[j] + bp[j];
                VnT[(d + j) * 136 + 16 * wv + tl] = (bf16_t)(pg8::cvt_pk_bf16(vn, 0.f) & 0xffffu); } }
    }
    __syncthreads();
    {
        const int r = lane & 31, hh = lane >> 5, db = wv & 3; const int tbA = (wv >> 2) ? 1 : 0, tbB = (wv >> 2) ? 2 : 3;
        f32x16 accA, accB;
#pragma unroll
        for (int i = 0; i < 16; ++i) { accA[i] = 0.f; accB[i] = 0.f; }
        const bf16_t* Wb = F.SGUW + (size_t)(l * 4 + hd) * 128 * 128;
#pragma unroll
        for (int s = 0; s < 8; ++s) {
            if (s < 2 * (tbB + 1)) {
                const bf16x8 a = *(const LAS bf16x8*)(VnT + (32 * db + r) * 136 + 16 * s + 8 * hh);
                accB = __builtin_amdgcn_mfma_f32_32x32x16_bf16(a, *(const bf16x8*)(Wb + (32 * tbB + r) * 128 + 16 * s + 8 * hh), accB, 0, 0, 0);
                if (s < 2 * (tbA + 1)) accA = __builtin_amdgcn_mfma_f32_32x32x16_bf16(a, *(const bf16x8*)(Wb + (32 * tbA + r) * 128 + 16 * s + 8 * hh), accA, 0, 0, 0);
            }
        }
#pragma unroll
        for (int pass = 0; pass < 2; ++pass) {
            const int tb = pass ? tbB : tbA; const f32x16 acc = pass ? accB : accA;
            const int t = 32 * tb + r; const size_t row = R0 + t; const float bias = F.sgu_b[l * 512 + hd * 128 + t];
#pragma unroll
            for (int q = 0; q < 4; ++q) { const int col = 128 * hd + 32 * db + 8 * q + 4 * hh;
                float uf[4], gf[4]; unpack4(*(const u32x2*)(F.Z2 + row * ZW + Z_U + col), uf); unpack4(*(const u32x2*)(F.Z2 + row * ZW + Z_GS + col), gf);
                u32x2 wo; wo.x = pg8::cvt_pk_bf16((acc[4 * q + 0] + bias) * uf[0] * gf[0], (acc[4 * q + 1] + bias) * uf[1] * gf[1]);
                wo.y = pg8::cvt_pk_bf16((acc[4 * q + 2] + bias) * uf[2] * gf[2], (acc[4 * q + 3] + bias) * uf[3] * gf[3]);
                *(u32x2*)(F.MIX + row * DM + 1536 + col) = wo; }
        }
    }
    __syncthreads();
}

__device__ __forceinline__ void samp_attn_o(const Frame& F, int l, int bd, int kvh, LAS unsigned char* wl) {
    LAS float* qs = (LAS float*)wl;
    LAS float* ps = (LAS float*)(wl + 4096);
    const int lane = F.lane;
    float* oKs = F.out + O_KS + (size_t)l * LS_KS; float* oVs = F.out + O_VS + (size_t)l * LS_KS;
    {
        const int qi = lane >> 2, part = lane & 3, gq = qi >> 2, tt = qi & 3;
        const bf16_t* src = F.Qc + ((size_t)MP + 4 * bd + tt) * 1024 + (4 * kvh + gq) * 64 + 16 * part;
        float f0[8], f1[8]; unpack8(*(const u32x4*)src, f0); unpack8(*(const u32x4*)(src + 8), f1);
#pragma unroll
        for (int j = 0; j < 8; ++j) { const int p0 = 16 * part + j, p1 = p0 + 8;
            qs[qi * 64 + (p0 >> 1) + 32 * (p0 & 1)] = f0[j]; qs[qi * 64 + (p1 >> 1) + 32 * (p1 & 1)] = f1[j]; }
    }
    LDS_WAIT();
    float s0[16], s1[16], s2[16];
#pragma unroll
    for (int q = 0; q < 16; ++q) { s0[q] = 0.f; s1[q] = 0.f; s2[q] = 0.f; }
    const float* k0p = F.cache_k + (((size_t)l * 128 + bd) * 128 + lane) * 256 + kvh * 64;
    const float* k1p = k0p + 64 * 256;
    const float* k2p = oKs + (((size_t)bd * 128 + 124 + (lane & 3)) * 4 + kvh) * 64;
    float* c0p = oKs + (((size_t)bd * 128 + (lane >= 4 ? lane - 4 : 0)) * 4 + kvh) * 64;
    float* c1p = oKs + (((size_t)bd * 128 + lane + 60) * 4 + kvh) * 64;
    for (int ch = 0; ch < 16; ++ch) {
        const f32x4 kx0 = *(const f32x4*)(k0p + 4 * ch), kx1 = *(const f32x4*)(k1p + 4 * ch), kx2 = *(const f32x4*)(k2p + 4 * ch);
        if (lane >= 4) *(f32x4*)(c0p + 4 * ch) = kx0;
        *(f32x4*)(c1p + 4 * ch) = kx1;
#pragma unroll
        for (int q = 0; q < 16; ++q) { const f32x4 qv = *(const LAS f32x4*)(qs + q * 64 + 4 * ch);
            s0[q] += (qv[0] * kx0[0] + qv[1] * kx0[1]) + (qv[2] * kx0[2] + qv[3] * kx0[3]);
            s1[q] += (qv[0] * kx1[0] + qv[1] * kx1[1]) + (qv[2] * kx1[2] + qv[3] * kx1[3]);
            s2[q] += (qv[0] * kx2[0] + qv[1] * kx2[1]) + (qv[2] * kx2[2] + qv[3] * kx2[3]); }
    }
    float inv[16];
#pragma unroll
    for (int q = 0; q < 16; ++q) {
        const int tt = q & 3; const float sink2 = F.sinks[l * 16 + 4 * kvh + (q >> 2)] * LOG2E;
        const bool v0 = lane >= tt + 1, v2 = (lane < 4) && (lane <= tt);
        float m = s1[q]; if (v0) m = fmaxf(m, s0[q]); if (v2) m = fmaxf(m, s2[q]);
        m = fmaxf(wave_max(m), sink2);
        const float p0 = v0 ? __builtin_amdgcn_exp2f(s0[q] - m) : 0.f, p1 = __builtin_amdgcn_exp2f(s1[q] - m), p2 = v2 ? __builtin_amdgcn_exp2f(s2[q] - m) : 0.f;
        const float sum = wave_sum(p0 + p1 + p2);
        inv[q] = 1.0f / (sum + __builtin_amdgcn_exp2f(sink2 - m));
        ps[lane * 16 + q] = p0; ps[(lane + 64) * 16 + q] = p1; if (lane < 4) ps[(128 + lane) * 16 + q] = p2;
    }
    LDS_WAIT();
    float o[16];
#pragma unroll
    for (int q = 0; q < 16; ++q) o[q] = 0.f;
    const float* vcp = F.cache_v + (((size_t)l * 128 + bd) * 128) * 256 + kvh * 64 + lane;
    float* vop = oVs + ((size_t)bd * 128) * 256 + kvh * 64 + lane;
    for (int key = 0; key < 132; ++key) {
        float v;
        if (key < 128) { v = vcp[(size_t)key * 256]; if (key >= 4) vop[(size_t)(key - 4) * 256] = v; }
        else v = vop[(size_t)(key - 4) * 256];
#pragma unroll
        for (int q4 = 0; q4 < 4; ++q4) { const f32x4 pv = *(const LAS f32x4*)(ps + key * 16 + 4 * q4);
            o[4 * q4 + 0] += pv[0] * v; o[4 * q4 + 1] += pv[1] * v; o[4 * q4 + 2] += pv[2] * v; o[4 * q4 + 3] += pv[3] * v; }
    }
#pragma unroll
    for (int q = 0; q < 16; ++q) { const int tt = q & 3, head = 4 * kvh + (q >> 2); const size_t row = (size_t)MP + 4 * bd + tt;
        const float gv = __uint_as_float(((unsigned)F.Z2[row * ZW + Z_GA + head * 64 + lane]) << 16);
        F.MIX[row * DM + head * 64 + lane] = (bf16_t)(pg8::cvt_pk_bf16(o[q] * inv[q] * gv, 0.f) & 0xffffu); }
    LDS_WAIT();
}
__device__ __forceinline__ void samp_sgu_o(const Frame& F, int l, int bd) {
    const int lane = F.lane, c0 = 8 * lane, hd = lane >> 4;
    float* oCV = F.out + O_CV + (size_t)l * LS_CV;
    float gl[8], bl[8];
#pragma unroll
    for (int j = 0; j < 8; ++j) { gl[j] = F.ln_g[l * 512 + c0 + j]; bl[j] = F.ln_b[l * 512 + c0 + j]; }
    float vn[4][8];
#pragma unroll
    for (int tt = 0; tt < 4; ++tt) { const size_t row = (size_t)MP + 4 * bd + tt; float f[8]; unpack8(*(const u32x4*)(F.Z2 + row * ZW + Z_VS + c0), f);
        float s = 0.f, ss = 0.f;
#pragma unroll
        for (int j = 0; j < 8; ++j) { s += f[j]; ss += f[j] * f[j]; }
        s = wave_sum(s); ss = wave_sum(ss);
        const float mean = s * (1.0f / 512.0f), var = ss * (1.0f / 512.0f) - mean * mean, rstd = rsqrtf(var + EPS);
#pragma unroll
        for (int j = 0; j < 8; ++j) vn[tt][j] = (f[j] - mean) * rstd * gl[j] + bl[j];
        float* o = oCV + ((size_t)bd * 4 + tt) * 512 + c0;
        *(f32x4*)o = (f32x4){vn[tt][0], vn[tt][1], vn[tt][2], vn[tt][3]}; *(f32x4*)(o + 4) = (f32x4){vn[tt][4], vn[tt][5], vn[tt][6], vn[tt][7]}; }
#pragma unroll
    for (int tt = 0; tt < 4; ++tt) { const size_t row = (size_t)MP + 4 * bd + tt;
        float mx[8]; const float bias = F.sgu_b[l * 512 + hd * 128 + tt];
#pragma unroll
        for (int j = 0; j < 8; ++j) mx[j] = bias;
#pragma unroll
        for (int s2 = 0; s2 < 4; ++s2) if (s2 <= tt) { const float w = F.sgu_w[((size_t)(l * 4 + hd) * 128 + tt) * 128 + s2];
#pragma unroll
            for (int j = 0; j < 8; ++j) mx[j] += w * vn[s2][j]; }
        float uf[8], gf[8]; unpack8(*(const u32x4*)(F.Z2 + row * ZW + Z_U + c0), uf); unpack8(*(const u32x4*)(F.Z2 + row * ZW + Z_GS + c0), gf);
#pragma unroll
        for (int j = 0; j < 8; ++j) mx[j] = mx[j] * uf[j] * gf[j];
        *(u32x4*)(F.MIX + row * DM + 1536 + c0) = pack8(mx); }
}

#endif
struct NormRowIn { u32x4 yv[4]; f32x4 xv[4][2]; u32x4 xb[4]; };
__device__ __forceinline__ void norm_row_load(NormRowIn& in, const Frame& F, int l, int row) {
    const int lane = F.lane;
    const bf16_t* yr = F.Yb + (size_t)row * DM + 8 * lane;
#pragma unroll
    for (int j = 0; j < 4; ++j) in.yv[j] = __builtin_nontemporal_load((const u32x4*)(yr + 512 * j));
    if (l == 0) {
        const float* xr = (row < MP ? F.xp + (size_t)row * DM : F.xs + (size_t)(row - MP) * DM) + 8 * lane;
#pragma unroll
        for (int j = 0; j < 4; ++j) { in.xv[j][0] = __builtin_nontemporal_load((const f32x4*)(xr + 512 * j)); in.xv[j][1] = __builtin_nontemporal_load((const f32x4*)(xr + 512 * j + 4)); }
    } else {
        const bf16_t* xr = F.H + (size_t)row * DM + 8 * lane;
#pragma unroll
        for (int j = 0; j < 4; ++j) in.xb[j] = __builtin_nontemporal_load((const u32x4*)(xr + 512 * j));
    }
}
__device__ __forceinline__ void norm_row_finish(const NormRowIn& in, const Frame& F, int l, int row) {
    const int lane = F.lane;
    const float* pg = F.norm_post + l * DM + 8 * lane;
    float y[4][8]; float ss = 0.f;
#pragma unroll
    for (int j = 0; j < 4; ++j) { unpack8(in.yv[j], y[j]);
#pragma unroll
        for (int e = 0; e < 8; ++e) ss += y[j][e] * y[j][e]; }
    ss = wave_sum(ss);
    const float ry = rsqrtf(ss * (1.0f / 2048.0f) + EPS);
    if (l == 0) {
        float s1 = 0.f; bf16_t* hrow = F.H + (size_t)row * DM + 8 * lane;
#pragma unroll
        for (int j = 0; j < 4; ++j) { const f32x4 ga = *(const f32x4*)(pg + 512 * j), gb = *(const f32x4*)(pg + 512 * j + 4);
#pragma unroll
            for (int e = 0; e < 4; ++e) { y[j][e] = in.xv[j][0][e] + y[j][e] * ry * ga[e]; y[j][4 + e] = in.xv[j][1][e] + y[j][4 + e] * ry * gb[e]; }
#pragma unroll
            for (int e = 0; e < 8; ++e) s1 += y[j][e] * y[j][e]; }
        s1 = wave_sum(s1);
        const float ms = s1 * (1.0f / 2048.0f) + EPS, r1 = rsqrtf(ms);
        if (lane == 0) F.RSTD[row] = ms * r1;
#pragma unroll
        for (int j = 0; j < 4; ++j) {
#pragma unroll
            for (int e = 0; e < 8; ++e) y[j][e] *= r1;
            *(u32x4*)(hrow + 512 * j) = pack8(y[j]); }
    } else {
        float* orow = F.out + (size_t)row * DM + 8 * lane;
        const float rms = F.RSTD[row];
#pragma unroll
        for (int j = 0; j < 4; ++j) { const f32x4 ga = *(const f32x4*)(pg + 512 * j), gb = *(const f32x4*)(pg + 512 * j + 4); float xf[8]; unpack8(in.xb[j], xf);
#pragma unroll
            for (int e = 0; e < 4; ++e) { y[j][e] = xf[e] * rms + y[j][e] * ry * ga[e]; y[j][4 + e] = xf[4 + e] * rms + y[j][4 + e] * ry * gb[e]; }
            __builtin_nontemporal_store((f32x4){y[j][0], y[j][1], y[j][2], y[j][3]}, (f32x4*)(orow + 512 * j)); __builtin_nontemporal_store((f32x4){y[j][4], y[j][5], y[j][6], y[j][7]}, (f32x4*)(orow + 512 * j + 4)); }
    }
}
__device__ __forceinline__ void norm_rows4(int l, int row0) { LOCAL_FRAME;
#pragma unroll 1
    for (int k = 0; k < 4; k += 2) { NormRowIn a, b; norm_row_load(a, F, l, row0 + k); norm_row_load(b, F, l, row0 + k + 1);
        norm_row_finish(a, F, l, row0 + k); norm_row_finish(b, F, l, row0 + k + 1); } }

constexpr int Q2_G = 40, Q2_AT = Q2_G + 256, Q2_SG = Q2_AT + 256, Q2_SA = Q2_SG + 64, Q2_SS = Q2_SA + 16, Q2_SP = Q2_SS + 8, Q2_PO = Q2_SP + 256;
__device__ __forceinline__ void slot2(int l, LAS unsigned char* L, LAS unsigned char* ring) {
    int t_ = threadIdx.x; asm volatile("" : "+v"(t_)); const int wave = __builtin_amdgcn_readfirstlane(t_ >> 6);
    unsigned* head = ctl_word(CW_Q + 64 * (2 * l));
    EV_T0();
#pragma unroll 1
    for (;;) {
        const int it = q_pop(head, L);
        if (it >= Q2_PO + (l == 0 ? TR_ITEMS : 0)) { if (l == 0) { EV_MAX(0); EV_MIN(1); } break; }
        if (it < Q2_G) {
            unsigned char* ws = (unsigned char*)kargs()->ws;
            pg8::Gemm g{(const bf16_t*)(ws + WS_H), (const bf16_t*)(ws + WS_WTIN) + (size_t)l * DIN * DM, MT, DIN, DM};
            OneUnit S; S.u.pm = 64 + it / 20; S.u.pn = it % 20;
            pg8::EpiIn E{l};
            pg8::gemm_phase<pg8::EpiIn, OneUnit, false, true>(ring, g, S, E);
            publish(ctl_word(CW_ZS + 64 * (2 * l + it / 20)));
            if (l == 0) { EV_MAX(2); EV_MIN(3); }
        }
#ifndef NO_SGU
        else if (it < Q2_AT) { const int u = it - Q2_G; sgu_unit(l, u >> 1, u & 1, ring); if (l == 0) EV_MAX(5); }
#endif
        else if (it < Q2_SG) { attn_unit(l, it - Q2_AT, ring); if (l == 0) EV_MAX(4); }
        else if (it < Q2_SA) { const int i = it - Q2_SG; dep_wait(ctl_word(CW_ZS + 64 * (2 * l + (i >> 5))), 20u); if (l == 0) EV_MIN(6); const int k = 8 * i + wave; samp_attn(l, k >> 2, k & 3, ring + wave * 9472); __syncthreads(); if (l == 0) EV_MAX(7); }
        else if (it < Q2_SS) { const int i = it - Q2_SA; dep_wait(ctl_word(CW_ZS + 64 * (2 * l + (i >> 3))), 20u); samp_sgu(l, 8 * i + wave); }
        else if (it < Q2_SP) { const int i = it - Q2_SS; dep_wait(ctl_word(CW_ZS + 64 * (2 * l + (i >> 2))), 20u); const int k = 8 * i + wave; pool_sample(l, k & 3, k >> 2); }
        else if (it < Q2_PO) { const int i = 8 * (it - Q2_SP) + wave; pool_prompt(l, i & 3, i >> 2, ring + wave * PL_WBYTES); }
        else { LOCAL_FRAME; transpose_item(F, 1, it - Q2_PO, ring); }
    }
}
constexpr int Q4_G = 16, Q4_P = Q4_G + 512, Q4_S = Q4_P + 16;
__device__ __forceinline__ void slot4(int l, LAS unsigned char* L, LAS unsigned char* ring) {
    int t_ = threadIdx.x; asm volatile("" : "+v"(t_)); const int wave = __builtin_amdgcn_readfirstlane(t_ >> 6);
    unsigned* head = ctl_word(CW_Q + 64 * (2 * l + 1));
#pragma unroll 1
    for (;;) {
        const int it = q_pop(head, L);
        if (it >= Q4_S) break;
        if (it < Q4_G) {
            unsigned char* ws = (unsigned char*)kargs()->ws;
            pg8::Gemm g{(const bf16_t*)(ws + WS_MIX), (const bf16_t*)(ws + WS_WTOUT) + (size_t)l * DM * DM, MT, DM, DM};
            OneUnit S; S.u.pm = 64 + it / 8; S.u.pn = it % 8;
            pg8::EpiOut E{};
            pg8::gemm_phase<pg8::EpiOut, OneUnit, false, true>(ring, g, S, E);
            publish(ctl_word(CW_YS + 64 * (2 * l + it / 8)));
        }
        else if (it < Q4_P) norm_rows4(l, 32 * (it - Q4_G) + 4 * wave);
        else { const int i = it - Q4_P; dep_wait(ctl_word(CW_YS + 64 * (2 * l + (i >> 3))), 8u); norm_rows4(l, MP + 32 * i + 4 * wave); }
    }
}

__device__ __forceinline__ void grid_barrier(LAS unsigned char* L) {
    XcdBarrier b; b.bar = (unsigned*)((unsigned char*)kargs()->ws + WS_CTL) + CW_BAR; b.x = xb_xcc_id(); b.st = (volatile LAS unsigned*)L + 8;
    xcd_barrier(b);
}
__global__ void __launch_bounds__(NTHREADS, 2) hymba_fwd(Args a_unused) {
    extern __shared__ __attribute__((aligned(16))) unsigned char lds[];
    LAS unsigned char* L = (LAS unsigned char*)lds;
    if (threadIdx.x < 256) ((LAS unsigned*)L)[threadIdx.x] = 0u;
    __syncthreads();
    (void)xcd_barrier_post((unsigned*)((unsigned char*)kargs()->ws + WS_CTL) + CW_BAR, (volatile LAS unsigned*)L + 8);
    LAS unsigned char* ring = L + RING_OFF;
    STAMP(0);
#ifndef NO_P0
    { Frame F; make_frame(F, kargs()); p0_prologue(F, ring); }
#endif
    grid_barrier(L);
    STAMP(1);
#pragma unroll 1
    for (int l = 0; l < 2; ++l) {
#ifndef NO_P1
        {
            KArgs ka = kargs(); unsigned char* ws = (unsigned char*)ka->ws;
            pg8::Gemm g{(const bf16_t*)(ws + WS_H), (const bf16_t*)(ws + WS_WTIN) + (size_t)l * DIN * DM, MP, DIN, DM}; pg8::StaticOrder S; S.init(MP, DIN, (int)gridDim.x, (int)blockIdx.x);
            pg8::EpiIn E{l};
            EV_T0();
            pg8::gemm_phase<pg8::EpiIn, pg8::StaticOrder, true, true>(ring, g, S, E);
#if PROBE_SEL >= 40
            if (l == 0) { const int jj = ((int)blockIdx.x >> 3) >> 3, xx = (int)blockIdx.x & 7;
                if (threadIdx.x == 0) { const unsigned dt = (unsigned)(__builtin_amdgcn_s_memrealtime() - ev_t0);
                    __hip_atomic_fetch_max(ctl_word(CW_EV + 64 * (16 + jj)), dt, __ATOMIC_RELAXED, __HIP_MEMORY_SCOPE_AGENT); __hip_atomic_fetch_max(ctl_word(CW_EV + 64 * (20 + xx)), dt, __ATOMIC_RELAXED, __HIP_MEMORY_SCOPE_AGENT);
                    __hip_atomic_fetch_max(ctl_word(CW_EV + 64 * 28), 0x40000000u - dt, __ATOMIC_RELAXED, __HIP_MEMORY_SCOPE_AGENT); } }
#endif
        }
#endif
        grid_barrier(L);
        STAMP(2 + 4 * l);
#ifndef NO_P2
        slot2(l, L, ring);
#endif
        grid_barrier(L);
        STAMP(3 + 4 * l);
#ifndef NO_P3
        {
            KArgs ka = kargs(); unsigned char* ws = (unsigned char*)ka->ws;
            pg8::Gemm g{(const bf16_t*)(ws + WS_MIX), (const bf16_t*)(ws + WS_WTOUT) + (size_t)l * DM * DM, MP, DM, DM}; pg8::StaticOrder S; S.init(MP, DM, (int)gridDim.x, (int)blockIdx.x);
            pg8::EpiOut E{};
            pg8::gemm_phase<pg8::EpiOut, pg8::StaticOrder, true, true>(ring, g, S, E);
        }
#endif
        grid_barrier(L);
        STAMP(4 + 4 * l);
#ifndef NO_P4
        slot4(l, L, ring);
#endif
        if (l == 0) grid_barrier(L);
#if PROBE_SEL
        if (l == 1) __syncthreads();
#endif
        STAMP(5 + 4 * l);
    }
#if PROBE_SEL
    if (blockIdx.x == 0 && threadIdx.x == 0) {
#if PROBE_SEL >= 40
        unsigned ea = __hip_atomic_load(ctl_word(CW_EV + 64 * PEA), __ATOMIC_RELAXED, __HIP_MEMORY_SCOPE_AGENT);
        if (PEA_MIN) ea = 0x40000000u - ea;
        unsigned long long da = ea > 21500u ? (ea - 21500u + 50) / 100 : 0, db = 0;
#elif PROBE_SEL >= 10
        unsigned ea = __hip_atomic_load(ctl_word(CW_EV + 64 * PEA), __ATOMIC_RELAXED, __HIP_MEMORY_SCOPE_AGENT), eb = __hip_atomic_load(ctl_word(CW_EV + 64 * PEB), __ATOMIC_RELAXED, __HIP_MEMORY_SCOPE_AGENT);
        if (PEA_MIN) ea = 0x40000000u - ea; if (PEB_MIN) eb = 0x40000000u - eb;
        unsigned long long da = (ea + 400) / 800, db = (eb + 400) / 800;
#else
        LAS unsigned long long* ts = (LAS unsigned long long*)(L + 256);
        unsigned long long da = (ts[PA1] - ts[PA0] + 400) / 800, db = (ts[PB1] - ts[PB0] + 400) / 800;
#endif
        if (da > 63) da = 63; if (db > 63) db = 63;
        const unsigned long long extra = (da + 64 * db) * 1600ull, t0 = __builtin_amdgcn_s_memrealtime();
        while (__builtin_amdgcn_s_memrealtime() - t0 < extra) __builtin_amdgcn_s_sleep(32);
    }
#endif
}

extern "C" void kernel_launch(void* const* d_in, const int* in_sizes, int n_in, void* d_out, int out_size, void* d_ws, size_t ws_size, hipStream_t stream) {
    static int grid = 0;
    if (grid == 0) {
        if (n_in != 16 || (size_t)out_size != O_END || ws_size < WS_END) { fprintf(stderr, "kernel_launch: unexpected shapes: n_in %d out %d ws %zu (need %zu)\n", n_in, out_size, ws_size, (size_t)WS_END); grid = -1; return; }
        int dev = 0, cus = 0, per_cu = 0;
        if (hipGetDevice(&dev) != hipSuccess || hipDeviceGetAttribute(&cus, hipDeviceAttributeMultiprocessorCount, dev) != hipSuccess) { fprintf(stderr, "kernel_launch: device query failed\n"); grid = -1; return; }
        if (hipFuncSetAttribute((const void*)hymba_fwd, hipFuncAttributeMaxDynamicSharedMemorySize, LDS_BYTES) != hipSuccess) { fprintf(stderr, "kernel_launch: hipFuncSetAttribute failed\n"); grid = -1; return; }
        if (hipOccupancyMaxActiveBlocksPerMultiprocessor(&per_cu, (const void*)hymba_fwd, NTHREADS, LDS_BYTES) != hipSuccess || per_cu < 1) { fprintf(stderr, "kernel_launch: occupancy query says %d blocks/CU\n", per_cu); (void)hipGetLastError(); grid = -1; return; }
        grid = cus;
    }
    if (grid < 0) return;
    (void)hipMemsetAsync((char*)d_ws + WS_CTL, 0, CTL_ZERO_BYTES, stream);
    Args a{};
    for (int i = 0; i < 16; ++i) a.in[i] = (const float*)d_in[i];
    a.out = (float*)d_out; a.ws = (unsigned char*)d_ws;
    void* params[] = {&a};
    hipError_t e = hipLaunchCooperativeKernel((const void*)hymba_fwd, dim3(grid), dim3(NTHREADS), params, LDS_BYTES, stream);
    if (e != hipSuccess) fprintf(stderr, "kernel_launch: cooperative launch failed: %s (grid %d)\n", hipGetErrorString(e), grid);
}
```

```cpp
#include <hip/hip_runtime.h>
#include <cstdio>
#include <cstdint>
#include <cmath>
namespace pg8 {
#define PG8_LAS __attribute__((address_space(3)))
typedef unsigned short bf16_t;
typedef short bf16x8 __attribute__((ext_vector_type(8)));
typedef float f32x4 __attribute__((ext_vector_type(4)));
typedef unsigned u32x4 __attribute__((ext_vector_type(4)));
typedef unsigned u32x2 __attribute__((ext_vector_type(2)));
constexpr int BM = 256, BK = 64, HALF = 128, HTB = HALF * BK * 2  , STAGE_BYTES = 8 * HTB, NXCD = 8, WGM = 8;

__host__ __device__ __forceinline__ int lds_byte(int r, int c) { const int st = (r >> 4) * 2 + (c >> 5), rr = r & 15, cc = c & 31, ob = rr * 64 + cc * 2; return st * 1024 + (ob ^ (((ob >> 9) & 1) << 5)); }
__host__ __device__ __forceinline__ void stage_rc(int b, int& R, int& C) { const int st = b / 1024, sb = b % 1024, swz = sb ^ (((sb >> 9) & 1) << 5); R = (st >> 1) * 16 + swz / 64; C = (st & 1) * 32 + (swz % 64) / 2; }
__host__ __device__ __forceinline__ int perm32(int rho) { const int n = rho >> 4, i = rho & 15; return 8 * (i >> 2) + 4 * n + (i & 3); }

struct Unit { int pm, pn; };
struct Gemm { const bf16_t* A; const bf16_t* Bt; int M, N, K, ld; };

struct StaticOrder {
    int nM, nN, nwg, G, c;
    __host__ __device__ void init(int M, int N, int G_, int c_) { nM = M / BM; nN = N / BM; nwg = nM * nN; G = G_; c = c_; }
    __host__ __device__ bool next(int i, Unit& u) const {
        const long L = (long)i * G + c; if (L >= nwg) return false;
        int wgid = (int)L; { const int q = nwg / NXCD, r = nwg % NXCD, xcd = wgid % NXCD, off = wgid / NXCD; wgid = (xcd < r ? xcd * (q + 1) : r * (q + 1) + (xcd - r) * q) + off; }
        const int nig = WGM * nN, gid = wgid / nig, fm = gid * WGM, gsz = (nM - fm) < WGM ? (nM - fm) : WGM;
        u.pm = fm + ((wgid % nig) % gsz); u.pn = (wgid % nig) / gsz; return true;
    }
    __device__ __forceinline__ void a_ready(const Unit&) const {}
    __device__ __forceinline__ void done(const Unit&) const {}
};

constexpr int DM = 2048, MP = 16384, MS = 512, MT = MP + MS, DIN = 5120;
constexpr int ZW = 3584;
constexpr int Z_GA = 0, Z_XB = 1024, Z_GP = 1536, Z_U = 2048, Z_VS = 2560, Z_GS = 3072;
constexpr float LOG2E = 1.4426950408889634f, QSCALE = 0.125f * LOG2E, EPS = 1e-6f;

__device__ __forceinline__ unsigned cvt_pk_bf16(float lo, float hi) { unsigned r; asm("v_cvt_pk_bf16_f32 %0, %1, %2" : "=v"(r) : "v"(lo), "v"(hi)); return r; }
__device__ __forceinline__ float silu_f(float x) { return x * __builtin_amdgcn_rcpf(1.0f + __builtin_amdgcn_exp2f(-x * LOG2E)); }
__device__ __forceinline__ int vperm32(int x) { return ((x >> 2) & 1) * 16 + (x >> 3) * 4 + (x & 3); }

struct EpiPtrs { const __attribute__((address_space(1))) float* in[16]; __attribute__((address_space(1))) float* out; __attribute__((address_space(1))) unsigned char* ws; };
constexpr size_t EP_RSTD = (size_t)3 << 20, EP_ROPE = (size_t)1 << 20, EP_QC = (size_t)192 << 20, EP_KC = (size_t)225 << 20, EP_VTP = (size_t)233 << 20, EP_Z2 = (size_t)241 << 20, EP_Y = (size_t)357 << 20;
constexpr size_t EO_KP = 34603008, EO_VP = 35127296, EO_PP = 35651584, EO_KS = 35774464, EO_VS = 44163072, EO_PS = 52551680;
struct EpiIn {
    static constexpr bool PERM = true, AFTER_DRAIN = false;
    int l;
    __device__ __forceinline__ void operator()(const f32x4 (&acc)[2][2][4][2], const Unit& u, int wr, int wc, int fr, int fq) const {
        const __attribute__((address_space(4))) EpiPtrs* kp = (const __attribute__((address_space(4))) EpiPtrs*)__builtin_amdgcn_kernarg_segment_ptr(); asm volatile("" : "+s"(kp));
        unsigned char* ws = (unsigned char*)kp->ws; float* outp = (float*)kp->out;
        bf16_t* Qc = (bf16_t*)(ws + EP_QC); bf16_t* Kc = (bf16_t*)(ws + EP_KC); bf16_t* VTP = (bf16_t*)(ws + EP_VTP); bf16_t* Z2 = (bf16_t*)(ws + EP_Z2); const float* rope = (const float*)(ws + EP_ROPE);
        float* oKp = outp + EO_KP + (size_t)l * 262144; float* oVp = outp + EO_VP + (size_t)l * 262144; float* oPp = outp + EO_PP + (size_t)l * 61440;
        float* oKs = outp + EO_KS + (size_t)l * 4194304; float* oVs = outp + EO_VS + (size_t)l * 4194304; float* oPs = outp + EO_PS + (size_t)l * 983040;
        const int pn = u.pn;
        const int row0 = u.pm * 256 + wr * 64 + fr;
        const int cw = wc * 32 + 8 * fq;
        if (pn < 5) {
            float invr[4];
#pragma unroll
            for (int e = 0; e < 4; ++e) invr[e] = __builtin_amdgcn_exp2f(-(float)(((cw & 63) >> 1) + e) * 0.41524101186092f) * 0.15915494309189535f;
#pragma unroll
            for (int ai = 0; ai < 2; ++ai)
#pragma unroll
                for (int m = 0; m < 4; ++m) {
                    const int row = row0 + ai * 128 + m * 16;
                    const bool smp = row >= MP;
                    const float pos = (float)(smp ? 8192 + (row & 3) : (row & 2047));
                    f32x4 cs, sn;
#pragma unroll
                    for (int e = 0; e < 4; ++e) { const float fr_ = __builtin_amdgcn_fractf(pos * invr[e]); cs[e] = __builtin_amdgcn_cosf(fr_); sn[e] = __builtin_amdgcn_sinf(fr_); }
#pragma unroll
                    for (int bj = 0; bj < 2; ++bj) {
                        const int c = pn * 256 + bj * 128 + cw;
                        const int i0 = (c & 63) >> 1;
                        const f32x4 v0 = acc[ai][bj][m][0], v1 = acc[ai][bj][m][1];
                        f32x4 o1, o2;
                        o1[0] = v0[0] * cs[0] - v0[1] * sn[0]; o2[0] = v0[1] * cs[0] + v0[0] * sn[0];
                        o1[1] = v0[2] * cs[1] - v0[3] * sn[1]; o2[1] = v0[3] * cs[1] + v0[2] * sn[1];
                        o1[2] = v1[0] * cs[2] - v1[1] * sn[2]; o2[2] = v1[1] * cs[2] + v1[0] * sn[2];
                        o1[3] = v1[2] * cs[3] - v1[3] * sn[3]; o2[3] = v1[3] * cs[3] + v1[2] * sn[3];
                        if (pn < 4) {
                            o1 = o1 * QSCALE; o2 = o2 * QSCALE;
                            u32x4 w; w.x = cvt_pk_bf16(o1[0], o2[0]); w.y = cvt_pk_bf16(o1[1], o2[1]); w.z = cvt_pk_bf16(o1[2], o2[2]); w.w = cvt_pk_bf16(o1[3], o2[3]);
                            *(u32x4*)(Qc + (size_t)row * 1024 + c) = w;
                        } else {
                            const int kvh = (c - 1024) >> 6;
                            if (!smp) {
                                const int b = row >> 11, t = row & 2047;
                                u32x4 w; w.x = cvt_pk_bf16(o1[0], o2[0]); w.y = cvt_pk_bf16(o1[1], o2[1]); w.z = cvt_pk_bf16(o1[2], o2[2]); w.w = cvt_pk_bf16(o1[3], o2[3]);
                                *(u32x4*)(Kc + ((size_t)((b * 4 + kvh) * 2048 + t)) * 64 + (c & 63)) = w;
                                if (t >= 1920) { float* o = oKp + ((size_t)((b * 128 + t - 1920) * 4 + kvh)) * 64 + i0; *(f32x4*)o = o1; *(f32x4*)(o + 32) = o2; }
                            } else {
                                const int bd = (row - MP) >> 2, tt = row & 3;
                                float* o = oKs + ((size_t)((bd * 128 + 124 + tt) * 4 + kvh)) * 64 + i0; *(f32x4*)o = o1; *(f32x4*)(o + 32) = o2;
                            }
                        }
                    }
                }
        } else if (pn == 5) {
#pragma unroll
            for (int ai = 0; ai < 2; ++ai)
#pragma unroll
                for (int m = 0; m < 4; ++m) {
                    const int row = row0 + ai * 128 + m * 16;
                    const bool smp = row >= MP;
#pragma unroll
                    for (int bj = 0; bj < 2; ++bj) {
                        const int cv = bj * 128 + cw;
                        const int kvh = cv >> 6, d0 = cv & 63;
                        const f32x4 v0 = acc[ai][bj][m][0], v1 = acc[ai][bj][m][1];
                        if (!smp) {
                            const int b = row >> 11, t = row & 2047;
                            bf16_t* vp = VTP + ((size_t)((b * 4 + kvh) * 64 + (t >> 5))) * 2048 + d0 * 32 + vperm32(t & 31);
                            const unsigned w0 = cvt_pk_bf16(v0[0], v0[1]), w1 = cvt_pk_bf16(v0[2], v0[3]), w2 = cvt_pk_bf16(v1[0], v1[1]), w3 = cvt_pk_bf16(v1[2], v1[3]);
                            vp[0] = (bf16_t)(w0 & 0xffffu); vp[32] = (bf16_t)(w0 >> 16); vp[64] = (bf16_t)(w1 & 0xffffu); vp[96] = (bf16_t)(w1 >> 16);
                            vp[128] = (bf16_t)(w2 & 0xffffu); vp[160] = (bf16_t)(w2 >> 16); vp[192] = (bf16_t)(w3 & 0xffffu); vp[224] = (bf16_t)(w3 >> 16);
                            if (t >= 1920) { float* o = oVp + ((size_t)((b * 128 + t - 1920) * 4 + kvh)) * 64 + d0; *(f32x4*)o = v0; *(f32x4*)(o + 4) = v1; }
                        } else {
                            const int bd = (row - MP) >> 2, tt = row & 3;
                            float* o = oVs + ((size_t)((bd * 128 + 124 + tt) * 4 + kvh)) * 64 + d0; *(f32x4*)o = v0; *(f32x4*)(o + 4) = v1;
                        }
                    }
                }
        } else {
            const bool gate = (pn < 10) || (pn == 12) || (pn == 13) || (pn >= 18);
            const bool isxb = (pn == 10) || (pn == 11);
#pragma unroll
            for (int ai = 0; ai < 2; ++ai)
#pragma unroll
                for (int m = 0; m < 4; ++m) {
                    const int row = row0 + ai * 128 + m * 16;
                    const bool smp = row >= MP;
#pragma unroll
                    for (int bj = 0; bj < 2; ++bj) {
                        const int c = pn * 256 + bj * 128 + cw;
                        f32x4 v0 = acc[ai][bj][m][0], v1 = acc[ai][bj][m][1];
                        if (isxb) {
                            const int cx = c - 2560;
                            if (!smp) { const int t = row & 2047; if (t >= 2033) { const int b = row >> 11; float* o = oPp + ((size_t)(b * 15 + t - 2033)) * 512 + cx; *(f32x4*)o = v0; *(f32x4*)(o + 4) = v1; } }
                            else { const int bd = (row - MP) >> 2, tt = row & 3; float* o = oPs + ((size_t)(bd * 15 + 11 + tt)) * 512 + cx; *(f32x4*)o = v0; *(f32x4*)(o + 4) = v1; }
                        }
                        if (gate) {
#pragma unroll
                            for (int j = 0; j < 4; ++j) { v0[j] = silu_f(v0[j]); v1[j] = silu_f(v1[j]); }
                        }
                        u32x4 w; w.x = cvt_pk_bf16(v0[0], v0[1]); w.y = cvt_pk_bf16(v0[2], v0[3]); w.z = cvt_pk_bf16(v1[0], v1[1]); w.w = cvt_pk_bf16(v1[2], v1[3]);
                        *(u32x4*)(Z2 + (size_t)row * ZW + (c - 1536)) = w;
                    }
                }
        }
    }
};

struct EpiSlab {
    static constexpr bool PERM = true, AFTER_DRAIN = false;
    int kh;
    __device__ __forceinline__ void operator()(const f32x4 (&acc)[2][2][4][2], const Unit& u, int wr, int wc, int fr, int fq) const {
        const __attribute__((address_space(4))) EpiPtrs* kp = (const __attribute__((address_space(4))) EpiPtrs*)__builtin_amdgcn_kernarg_segment_ptr(); asm volatile("" : "+s"(kp));
        float* C = (float*)((unsigned char*)kp->ws + EP_Z2) + (size_t)kh * MS * DM;
        const int row0 = u.pm * BM - MP + wr * 64 + fr, col0 = u.pn * BM + wc * 32 + 8 * fq;
#pragma unroll
        for (int ai = 0; ai < 2; ++ai)
#pragma unroll
            for (int m = 0; m < 4; ++m) { float* rowp = C + (size_t)(row0 + ai * HALF + m * 16) * DM + col0;
#pragma unroll
                for (int bj = 0; bj < 2; ++bj) { *(f32x4*)(rowp + bj * HALF) = acc[ai][bj][m][0]; *(f32x4*)(rowp + bj * HALF + 4) = acc[ai][bj][m][1]; } }
    }
};

struct EpiOut {
    static constexpr bool PERM = true, AFTER_DRAIN = false;
    __device__ __forceinline__ void operator()(const f32x4 (&acc)[2][2][4][2], const Unit& u, int wr, int wc, int fr, int fq) const {
        const __attribute__((address_space(4))) EpiPtrs* kp = (const __attribute__((address_space(4))) EpiPtrs*)__builtin_amdgcn_kernarg_segment_ptr(); asm volatile("" : "+s"(kp));
        bf16_t* C = (bf16_t*)((unsigned char*)kp->ws + EP_Y);
        const int row0 = u.pm * BM + wr * 64 + fr, col0 = u.pn * BM + wc * 32 + 8 * fq;
#pragma unroll
        for (int ai = 0; ai < 2; ++ai)
#pragma unroll
            for (int m = 0; m < 4; ++m) { bf16_t* rowp = C + (size_t)(row0 + ai * HALF + m * 16) * DM + col0;
#pragma unroll
                for (int bj = 0; bj < 2; ++bj) { const f32x4 v0 = acc[ai][bj][m][0], v1 = acc[ai][bj][m][1];
                    u32x4 w; w.x = cvt_pk_bf16(v0[0], v0[1]); w.y = cvt_pk_bf16(v0[2], v0[3]); w.z = cvt_pk_bf16(v1[0], v1[1]); w.w = cvt_pk_bf16(v1[2], v1[3]);
                    *(u32x4*)(rowp + bj * HALF) = w; } }
    }
};
template <class Epi, class Sched, bool ALIGN_EPI = false, bool SP2 = false>
__device__ __forceinline__ void gemm_phase(PG8_LAS unsigned char* lds, const Gemm g, const Sched& S, const Epi& E) {
    int tid_ = threadIdx.x; asm volatile("" : "+v"(tid_));
    const int tid = tid_, wid = __builtin_amdgcn_readfirstlane(tid >> 6), lane = tid & 63, wr = wid >> 2, wc = wid & 3, fr = lane & 15, fq = lane >> 4;
    const int K = g.ld, nt = g.K / BK;
    unsigned voffA[2], voffB[2];
#pragma unroll
    for (int i = 0; i < 2; ++i) { int R, C; stage_rc(tid * 16 + i * 8192, R, C); const int Rb = Epi::PERM ? ((R & ~31) + perm32(R & 31)) : R;
        voffA[i] = (unsigned)(R * K + C) * 2u; voffB[i] = (unsigned)(Rb * K + C) * 2u; }
    const size_t kstep = (size_t)(BK * 2);
    const size_t hstep = (size_t)HALF * K * 2;
    const size_t tstep = 2 * hstep;
    const unsigned ldsw = (unsigned)wid * 1024u;
    const int aoff = lds_byte(wr * 64 + fr, fq * 8), boff = lds_byte(wc * 32 + fr, fq * 8);
#define PG8_SA(b, h) (((b) * 2 + (h)) * HTB)
#define PG8_SB(b, h) ((4 + (b) * 2 + (h)) * HTB)
#define PG8_STAGE(bufoff, gbase, voff) do { _Pragma("unroll") for (int _i = 0; _i < 2; ++_i) \
        __builtin_amdgcn_global_load_lds((const unsigned*)((const char*)(gbase) + (voff)[_i]), (PG8_LAS unsigned*)(lds + (bufoff) + ldsw + _i * 8192), 16, 0, 0); } while (0)
#define PG8_LDA(dst, b, h) do { _Pragma("unroll") for (int m = 0; m < 4; ++m) _Pragma("unroll") for (int k = 0; k < 2; ++k) dst[m][k] = *(const PG8_LAS bf16x8*)(lds + PG8_SA(b, h) + aoff + m * 2048 + k * 1024); } while (0)
#define PG8_LDB(dst, b, h) do { _Pragma("unroll") for (int n = 0; n < 2; ++n) _Pragma("unroll") for (int k = 0; k < 2; ++k) dst[n][k] = *(const PG8_LAS bf16x8*)(lds + PG8_SB(b, h) + boff + n * 2048 + k * 1024); } while (0)
#define PG8_MMA(ai, bj, At, Bt) do { __builtin_amdgcn_s_setprio(1); _Pragma("unroll") for (int m = 0; m < 4; ++m) _Pragma("unroll") for (int n = 0; n < 2; ++n) _Pragma("unroll") for (int k = 0; k < 2; ++k) \
        acc[ai][bj][m][n] = __builtin_amdgcn_mfma_f32_16x16x32_bf16(Bt[n][k], At[m][k], acc[ai][bj][m][n], 0, 0, 0); __builtin_amdgcn_s_setprio(0); } while (0)
#define PG8_WAIT_V(n) asm volatile("s_waitcnt vmcnt(" #n ")" ::: "memory")
#define PG8_WAIT_L(n) asm volatile("s_waitcnt lgkmcnt(" #n ")" ::: "memory")
#define PG8_BAR __builtin_amdgcn_s_barrier()
#define PG8_SCHED __builtin_amdgcn_sched_barrier(0)
    Unit cur, nxt; int ui = 0;
    if (!S.next(0, cur)) return;
    f32x4 acc[2][2][4][2];
#pragma unroll
    for (int a = 0; a < 2; ++a)
#pragma unroll
        for (int b = 0; b < 2; ++b)
#pragma unroll
            for (int m = 0; m < 4; ++m)
#pragma unroll
                for (int n = 0; n < 2; ++n) acc[a][b][m][n] = (f32x4){0.f, 0.f, 0.f, 0.f};
    bf16x8 At[4][2], B0[2][2], B1[2][2];
    const char* cA = (const char*)g.A + (size_t)cur.pm * tstep; const char* cB = (const char*)g.Bt + (size_t)cur.pn * tstep;
    S.a_ready(cur);
    if constexpr (SP2) {
        PG8_STAGE(PG8_SB(0, 0), cB, voffB); PG8_STAGE(PG8_SB(0, 1), cB + hstep, voffB); PG8_STAGE(PG8_SA(0, 0), cA, voffA); PG8_STAGE(PG8_SA(0, 1), cA + hstep, voffA);
        if (wr == 1) PG8_BAR;
        PG8_WAIT_V(2); PG8_BAR;
        PG8_STAGE(PG8_SB(1, 0), cB + kstep, voffB); PG8_STAGE(PG8_SA(1, 0), cA + kstep, voffA); PG8_STAGE(PG8_SB(1, 1), cB + hstep + kstep, voffB);
        PG8_WAIT_V(6); PG8_BAR;
    } else {
        PG8_STAGE(PG8_SB(0, 0), cB, voffB); PG8_STAGE(PG8_SA(0, 0), cA, voffA); PG8_STAGE(PG8_SB(0, 1), cB + hstep, voffB); PG8_STAGE(PG8_SA(0, 1), cA + hstep, voffA);
        if (wr == 1) PG8_BAR;
        PG8_WAIT_V(4); PG8_BAR;
        PG8_STAGE(PG8_SB(1, 0), cB + kstep, voffB); PG8_STAGE(PG8_SA(1, 0), cA + kstep, voffA); PG8_STAGE(PG8_SB(1, 1), cB + hstep + kstep, voffB);
        PG8_WAIT_V(6); PG8_BAR;
    }
    for (;;) {
        const bool has_next = S.next(ui + 1, nxt);
        const char* nA = has_next ? (const char*)g.A + (size_t)nxt.pm * tstep : cA; const char* nB = has_next ? (const char*)g.Bt + (size_t)nxt.pn * tstep : cB;
        for (int t = 0; t < nt; t += 2) {
            const bool last = (t == nt - 2);
            const char* a1 = cA + (size_t)(t + 1) * kstep;
            const char* a2 = last ? nA : cA + (size_t)(t + 2) * kstep; const char* b2 = last ? nB : cB + (size_t)(t + 2) * kstep;
            const char* a3 = a2 + kstep; const char* b3 = b2 + kstep;
            if (last && has_next) S.a_ready(nxt);
            if constexpr (SP2) {
            PG8_LDB(B0, 0, 0); PG8_LDB(B1, 0, 1); PG8_SCHED; PG8_LDA(At, 0, 0); PG8_STAGE(PG8_SA(1, 1), a1 + hstep, voffA);
            PG8_WAIT_V(8); PG8_WAIT_L(0); PG8_BAR; PG8_MMA(0, 0, At, B0); PG8_MMA(0, 1, At, B1); PG8_BAR; PG8_SCHED;
            PG8_LDA(At, 0, 1); PG8_STAGE(PG8_SB(0, 0), b2, voffB); PG8_STAGE(PG8_SB(0, 1), b2 + hstep, voffB); PG8_STAGE(PG8_SA(0, 0), a2, voffA);
            PG8_WAIT_V(8); PG8_WAIT_L(0); PG8_BAR; PG8_MMA(1, 0, At, B0); PG8_MMA(1, 1, At, B1); PG8_BAR; PG8_SCHED;
            PG8_LDB(B0, 1, 0); PG8_LDB(B1, 1, 1); PG8_SCHED; PG8_LDA(At, 1, 0); PG8_STAGE(PG8_SA(0, 1), a2 + hstep, voffA);
            PG8_WAIT_V(8); PG8_WAIT_L(0); PG8_BAR; PG8_MMA(0, 0, At, B0); PG8_MMA(0, 1, At, B1); PG8_BAR; PG8_SCHED;
            PG8_LDA(At, 1, 1); PG8_STAGE(PG8_SB(1, 0), b3, voffB); PG8_STAGE(PG8_SB(1, 1), b3 + hstep, voffB); PG8_STAGE(PG8_SA(1, 0), a3, voffA);
            PG8_WAIT_V(8); PG8_WAIT_L(0); PG8_BAR; PG8_MMA(1, 0, At, B0); PG8_MMA(1, 1, At, B1); PG8_BAR; PG8_SCHED;
            } else {
            PG8_LDB(B0, 0, 0); PG8_SCHED; PG8_LDA(At, 0, 0); PG8_STAGE(PG8_SA(1, 1), a1 + hstep, voffA);
            PG8_WAIT_L(8); PG8_BAR; PG8_WAIT_L(0); PG8_MMA(0, 0, At, B0); PG8_BAR; PG8_SCHED;
            PG8_LDB(B1, 0, 1); PG8_STAGE(PG8_SB(0, 0), b2, voffB);
            PG8_BAR; PG8_WAIT_L(0); PG8_MMA(0, 1, At, B1); PG8_BAR;
            PG8_LDA(At, 0, 1); PG8_STAGE(PG8_SA(0, 0), a2, voffA);
            PG8_BAR; PG8_WAIT_L(0); PG8_MMA(1, 0, At, B0); PG8_BAR; PG8_SCHED;
            PG8_STAGE(PG8_SB(0, 1), b2 + hstep, voffB);
            PG8_WAIT_V(6); PG8_BAR; PG8_MMA(1, 1, At, B1); PG8_BAR;
            PG8_LDB(B0, 1, 0); PG8_SCHED; PG8_LDA(At, 1, 0); PG8_STAGE(PG8_SA(0, 1), a2 + hstep, voffA);
            PG8_WAIT_L(8); PG8_BAR; PG8_WAIT_L(0); PG8_MMA(0, 0, At, B0); PG8_BAR; PG8_SCHED;
            PG8_LDB(B1, 1, 1); PG8_STAGE(PG8_SB(1, 0), b3, voffB);
            PG8_BAR; PG8_WAIT_L(0); PG8_MMA(0, 1, At, B1); PG8_BAR;
            PG8_LDA(At, 1, 1); PG8_STAGE(PG8_SA(1, 0), a3, voffA);
            PG8_BAR; PG8_WAIT_L(0); PG8_MMA(1, 0, At, B0); PG8_BAR; PG8_SCHED;
            PG8_STAGE(PG8_SB(1, 1), b3 + hstep, voffB);
            PG8_WAIT_V(6); PG8_BAR; PG8_MMA(1, 1, At, B1); PG8_BAR;
            }
        }
        if constexpr (ALIGN_EPI) { if (wr == 0) PG8_BAR; }
        if constexpr (!Epi::AFTER_DRAIN) { E(acc, cur, wr, wc, fr, fq); S.done(cur); }
        if (!has_next) break;
#pragma unroll
        for (int a = 0; a < 2; ++a)
#pragma unroll
            for (int b = 0; b < 2; ++b)
#pragma unroll
                for (int m = 0; m < 4; ++m)
#pragma unroll
                    for (int n = 0; n < 2; ++n) acc[a][b][m][n] = (f32x4){0.f, 0.f, 0.f, 0.f};
        cur = nxt; cA = nA; cB = nB; ++ui;
        if constexpr (ALIGN_EPI) { if (wr == 1) PG8_BAR; }
    }
    PG8_WAIT_V(0);
    if constexpr (!ALIGN_EPI) { if (wr == 0) PG8_BAR; }
    PG8_BAR;
    if constexpr (Epi::AFTER_DRAIN) { E.fused(acc, cur, wr, wc, fr, fq, lds, wid, lane); S.done(cur); }
#undef PG8_SA
#undef PG8_SB
#undef PG8_STAGE
#undef PG8_LDA
#undef PG8_LDB
#undef PG8_MMA
#undef PG8_WAIT_V
#undef PG8_WAIT_L
#undef PG8_BAR
#undef PG8_SCHED
}
}
#define GAS __attribute__((address_space(1)))
#define LAS __attribute__((address_space(3)))
typedef GAS unsigned gu32;
typedef GAS unsigned long long gu64;
#define RLX_AGENT __ATOMIC_RELAXED, __HIP_MEMORY_SCOPE_AGENT
#define VM_WAIT() asm volatile("s_waitcnt vmcnt(0)" ::: "memory")
__device__ __forceinline__ unsigned long long rt() { return __builtin_amdgcn_s_memrealtime(); }
__device__ __forceinline__ unsigned f2bf(float f) { unsigned u = __builtin_bit_cast(unsigned, f); return (u + 0x7fffu + ((u >> 16) & 1u)) >> 16; }
__device__ __forceinline__ unsigned pk2(float lo, float hi) { return f2bf(lo) | (f2bf(hi) << 16); }

#define XB_TMO      128
#define XB_XCNT(j)  (256  + 64 * (j))
#define XB_XSUB(j)  (1280 + 64 * (j))
#define XB_XGEN(j)  (2304 + 64 * (j))
#define XB_TOP      3328
#define XB_TOPGEN   3392
#define XCD_BAR_WORDS 3456
#define XB_SPIN_CAP (1u << 18)

__device__ __forceinline__ unsigned xb_ld(unsigned* p)              { return __hip_atomic_load(p, __ATOMIC_RELAXED, __HIP_MEMORY_SCOPE_AGENT); }
__device__ __forceinline__ unsigned xb_add(unsigned* p, unsigned v) { return __hip_atomic_fetch_add(p, v, __ATOMIC_RELAXED, __HIP_MEMORY_SCOPE_AGENT); }
__device__ __forceinline__ unsigned xb_xcc_id() { return (unsigned)__builtin_amdgcn_s_getreg((3 << 11) | 20) & 0xFu; }
#define XB_SPIN(cond, bar) do { unsigned _sp = 0; while (cond) { __builtin_amdgcn_s_sleep(1); \
    if ((++_sp & 255u) == 0u) { if (xb_ld(&(bar)[XB_TMO])) break; if (_sp > XB_SPIN_CAP) { atomicAdd(&(bar)[XB_TMO], 1u); break; } } } } while (0)

struct XcdBarrier {
    unsigned* bar; unsigned x;
    volatile LAS unsigned* st;
};

__device__ __forceinline__ XcdBarrier xcd_barrier_post(unsigned* bar, volatile LAS unsigned* st) {
    XcdBarrier b; b.bar = bar; b.x = xb_xcc_id(); b.st = st;
    if (threadIdx.x == 0) (void)xb_add(&bar[XB_XCNT(b.x)], 1u);
    return b;
}
__device__ __forceinline__ void xcd_barrier_complete(unsigned* bar, unsigned x, unsigned& nloc, unsigned& nx) {
    const unsigned G = gridDim.x * gridDim.y * gridDim.z;
    unsigned sum, cnt, mine, sp = 0u;
    for (;;) {
        sum = 0u; cnt = 0u; mine = 0u;
#pragma unroll
        for (unsigned j = 0; j < 16; ++j) { const unsigned c = xb_ld(&bar[XB_XCNT(j)]); sum += c; cnt += (c > 0u) ? 1u : 0u; mine = (j == x) ? c : mine; }
        if (sum == G) break;
        __builtin_amdgcn_s_sleep(1);
        if ((++sp & 255u) == 0u) { if (xb_ld(&bar[XB_TMO])) break; if (sp > XB_SPIN_CAP) { atomicAdd(&bar[XB_TMO], 1u); break; } }
    }
    nloc = mine > 0u ? mine : 1u; nx = cnt > 0u ? cnt : 1u;
}

__device__ __forceinline__ void xcd_barrier(const XcdBarrier& b) {
    asm volatile("s_waitcnt vmcnt(0)" ::: "memory");
    __syncthreads();
    if (threadIdx.x == 0) {
        unsigned* bar = b.bar;
        __builtin_amdgcn_s_waitcnt(0);
        unsigned nloc = b.st[0], nx = b.st[1];
        if (nloc == 0u) { xcd_barrier_complete(bar, b.x, nloc, nx); b.st[0] = nloc; b.st[1] = nx; }
        const unsigned old = xb_add(&bar[XB_XSUB(b.x)], 1u);
        const unsigned gen = old / nloc;
        if (old + 1u == (gen + 1u) * nloc) {
            __builtin_amdgcn_fence(__ATOMIC_RELEASE, "agent");
            asm volatile("s_waitcnt vmcnt(0)" ::: "memory");
            const unsigned og = xb_add(&bar[XB_TOP], 1u);
            const unsigned tg = og / nx;
            if (og + 1u == (tg + 1u) * nx) xb_add(&bar[XB_TOPGEN], 1u);
            else XB_SPIN(xb_ld(&bar[XB_TOPGEN]) == tg, bar);
            __builtin_amdgcn_fence(__ATOMIC_ACQUIRE, "agent");
            xb_add(&bar[XB_XGEN(b.x)], 1u);
            asm volatile("s_waitcnt vmcnt(0)" ::: "memory");
        } else {
            XB_SPIN(xb_ld(&bar[XB_XGEN(b.x)]) == gen, bar);
            __builtin_amdgcn_fence(__ATOMIC_ACQUIRE, "agent");
            asm volatile("s_waitcnt vmcnt(0)" ::: "memory");
        }
    }
    __syncthreads();
}

using pg8::bf16_t; using pg8::bf16x8; using pg8::f32x4; using pg8::u32x4;
using pg8::DM; using pg8::MP; using pg8::MS; using pg8::MT; using pg8::DIN; using pg8::ZW;
using pg8::Z_GA; using pg8::Z_XB; using pg8::Z_GP; using pg8::Z_U; using pg8::Z_VS; using pg8::Z_GS; using pg8::LOG2E; using pg8::EPS;
typedef float f32x16 __attribute__((ext_vector_type(16)));
typedef unsigned u32x2 __attribute__((ext_vector_type(2)));
typedef short v4i16_t __attribute__((ext_vector_type(4)));

constexpr int NWAVES = 8, NTHREADS = 512;
constexpr int LDS_BYTES = 147456;
constexpr int RING_OFF = 1024;

constexpr size_t O_YP = 0, O_YS = 33554432, O_KP = 34603008, O_VP = 35127296, O_PP = 35651584, O_KS = 35774464, O_VS = 44163072, O_PS = 52551680, O_CV = 54517760, O_END = 55042048;
constexpr size_t LS_KP = 262144, LS_PP = 61440, LS_KS = 4194304, LS_PS = 983040, LS_CV = 262144;
constexpr size_t MiB = 1u << 20;
constexpr size_t WS_CTL = 0, CTL_ZERO_BYTES = 65536;
constexpr size_t WS_ROPE = 1 * MiB, WS_SGUW = 2 * MiB, WS_RSW = 2 * MiB + 256 * 1024, WS_PWT = 2 * MiB + 512 * 1024, WS_RSTD = 3 * MiB;
constexpr size_t WS_WTIN = 4 * MiB, WS_WTOUT = 44 * MiB, WS_H = 60 * MiB, WS_MIX = 126 * MiB, WS_QC = 192 * MiB, WS_KC = 225 * MiB, WS_VTP = 233 * MiB, WS_Z2 = 241 * MiB, WS_Y = 357 * MiB, WS_END = 489 * MiB;
constexpr int CW_BAR = 1024;

__constant__ double ROPE_INV[32] = {1.0, 0.7498942093324559, 0.5623413251903491, 0.4216965034285822, 0.31622776601683794, 0.23713737056616552, 0.1778279410038923, 0.1333521432163324, 0.1, 0.07498942093324558, 0.05623413251903491, 0.042169650342858224, 0.03162277660168379, 0.023713737056616554, 0.01778279410038923, 0.01333521432163324, 0.01, 0.007498942093324558, 0.005623413251903491, 0.004216965034285823, 0.0031622776601683794, 0.0023713737056616554, 0.0017782794100389228, 0.001333521432163324, 0.001, 0.0007498942093324559, 0.0005623413251903491, 0.00042169650342858224, 0.00031622776601683794, 0.00023713737056616554, 0.00017782794100389227, 0.0001333521432163324};

struct Args { const float* in[16]; float* out; unsigned char* ws; };

struct Frame {
    int tid, lane, wave, bid, G;
    const float *xp, *xs, *cache_k, *cache_v, *state_pool, *w_in, *w_out, *norm_pre, *norm_post, *sinks, *pool_w, *pool_scale, *ln_g, *ln_b, *sgu_w, *sgu_b;
    float* out;
    float* rope; float* RSW; float* RSTD; bf16_t *SGUW, *PWT, *WTIN, *WTOUT, *H, *MIX, *Qc, *Kc, *VTP, *Z2, *Yb;
};

__device__ __forceinline__ float wave_sum(float v) {
#pragma unroll
    for (int o = 1; o < 64; o <<= 1) v += __shfl_xor(v, o);
    return v;
}
__device__ __forceinline__ float wave_max(float v) {
#pragma unroll
    for (int o = 1; o < 64; o <<= 1) v = fmaxf(v, __shfl_xor(v, o));
    return v;
}
__device__ __forceinline__ float bflo(unsigned w) { return __uint_as_float(w << 16); }
__device__ __forceinline__ float bfhi(unsigned w) { return __uint_as_float(w & 0xffff0000u); }
__device__ __forceinline__ void unpack8(const u32x4 w, float (&f)[8]) { f[0] = bflo(w.x); f[1] = bfhi(w.x); f[2] = bflo(w.y); f[3] = bfhi(w.y); f[4] = bflo(w.z); f[5] = bfhi(w.z); f[6] = bflo(w.w); f[7] = bfhi(w.w); }
__device__ __forceinline__ void unpack4(const u32x2 w, float (&f)[4]) { f[0] = bflo(w.x); f[1] = bfhi(w.x); f[2] = bflo(w.y); f[3] = bfhi(w.y); }
__device__ __forceinline__ u32x4 pack8(const float (&f)[8]) { u32x4 w; w.x = pg8::cvt_pk_bf16(f[0], f[1]); w.y = pg8::cvt_pk_bf16(f[2], f[3]); w.z = pg8::cvt_pk_bf16(f[4], f[5]); w.w = pg8::cvt_pk_bf16(f[6], f[7]); return w; }
__device__ __forceinline__ int crow(int r, int hi) { return (r & 3) + 8 * (r >> 2) + 4 * hi; }
#define LDS_WAIT() asm volatile("s_waitcnt lgkmcnt(0)" ::: "memory")


struct ArgsG { const __attribute__((address_space(1))) float* in[16]; __attribute__((address_space(1))) float* out; __attribute__((address_space(1))) unsigned char* ws; };
typedef const __attribute__((address_space(4))) ArgsG* KArgs;
__device__ __forceinline__ KArgs kargs() { KArgs p = (KArgs)__builtin_amdgcn_kernarg_segment_ptr(); asm volatile("" : "+s"(p)); return p; }
__device__ __forceinline__ void make_frame(Frame& F, KArgs a) {
    { int t_ = threadIdx.x; asm volatile("" : "+v"(t_)); F.tid = t_; } F.lane = F.tid & 63; F.wave = __builtin_amdgcn_readfirstlane(F.tid >> 6); F.bid = blockIdx.x; F.G = gridDim.x;
    F.xp = (const float*)a->in[0]; F.xs = (const float*)a->in[1]; F.cache_k = (const float*)a->in[2]; F.cache_v = (const float*)a->in[3]; F.state_pool = (const float*)a->in[4]; F.w_in = (const float*)a->in[5]; F.w_out = (const float*)a->in[6]; F.norm_pre = (const float*)a->in[7]; F.norm_post = (const float*)a->in[8];
    F.sinks = (const float*)a->in[9]; F.pool_w = (const float*)a->in[10]; F.pool_scale = (const float*)a->in[11]; F.ln_g = (const float*)a->in[12]; F.ln_b = (const float*)a->in[13]; F.sgu_w = (const float*)a->in[14]; F.sgu_b = (const float*)a->in[15];
    F.out = (float*)a->out;
    unsigned char* ws = (unsigned char*)a->ws;
    F.rope = (float*)(ws + WS_ROPE); F.RSW = (float*)(ws + WS_RSW); F.RSTD = (float*)(ws + WS_RSTD); F.SGUW = (bf16_t*)(ws + WS_SGUW); F.PWT = (bf16_t*)(ws + WS_PWT); F.WTIN = (bf16_t*)(ws + WS_WTIN); F.WTOUT = (bf16_t*)(ws + WS_WTOUT);
    F.H = (bf16_t*)(ws + WS_H); F.MIX = (bf16_t*)(ws + WS_MIX); F.Qc = (bf16_t*)(ws + WS_QC); F.Kc = (bf16_t*)(ws + WS_KC); F.VTP = (bf16_t*)(ws + WS_VTP); F.Z2 = (bf16_t*)(ws + WS_Z2); F.Yb = (bf16_t*)(ws + WS_Y);
}

#define LOCAL_FRAME Frame F; make_frame(F, kargs())

constexpr int CW_Q = 8192;
constexpr int CW_ZS = 8192 + 64 * 8;
constexpr int CW_YS = 8192 + 64 * 16;
constexpr int CW_EV = 8192 + 64 * 32;
__device__ __forceinline__ unsigned* ctl_word(int idx) { return (unsigned*)((unsigned char*)kargs()->ws + WS_CTL) + idx; }
__device__ __forceinline__ int q_pop(unsigned* head, LAS unsigned char* L) {
    volatile LAS int* slot = (volatile LAS int*)(L + 64);
    __syncthreads();
    if (threadIdx.x == 0) *slot = (int)__hip_atomic_fetch_add(head, 1u, __ATOMIC_RELAXED, __HIP_MEMORY_SCOPE_AGENT);
    __syncthreads();
    return __builtin_amdgcn_readfirstlane(*slot);
}
__device__ __forceinline__ void publish(unsigned* ctr) {
    asm volatile("s_waitcnt vmcnt(0)" ::: "memory");
    __syncthreads();
    if (threadIdx.x == 0) { __builtin_amdgcn_fence(__ATOMIC_RELEASE, "agent"); asm volatile("s_waitcnt vmcnt(0)" ::: "memory");
        __hip_atomic_fetch_add(ctr, 1u, __ATOMIC_RELAXED, __HIP_MEMORY_SCOPE_AGENT); }
}
__device__ __forceinline__ void dep_wait(unsigned* ctr, unsigned need) {
    if (threadIdx.x == 0) {
        unsigned sp = 0;
        while (__hip_atomic_load(ctr, __ATOMIC_RELAXED, __HIP_MEMORY_SCOPE_AGENT) < need) { __builtin_amdgcn_s_sleep(16); if (++sp > (1u << 21)) break; }
        __builtin_amdgcn_fence(__ATOMIC_ACQUIRE, "agent"); asm volatile("s_waitcnt vmcnt(0)" ::: "memory");
    }
    __syncthreads();
}

#if PROBE_SEL >= 10 && (PROBE_SEL < 30 || PROBE_SEL >= 40)
#define EV_T0() const unsigned long long ev_t0 = __builtin_amdgcn_s_memrealtime()
#define EV_MAX(k) do { if (threadIdx.x == 0) __hip_atomic_fetch_max(ctl_word(CW_EV + 64 * (k)), (unsigned)(__builtin_amdgcn_s_memrealtime() - ev_t0), __ATOMIC_RELAXED, __HIP_MEMORY_SCOPE_AGENT); } while (0)
#define EV_MIN(k) do { if (threadIdx.x == 0) __hip_atomic_fetch_max(ctl_word(CW_EV + 64 * (k)), 0x40000000u - (unsigned)(__builtin_amdgcn_s_memrealtime() - ev_t0), __ATOMIC_RELAXED, __HIP_MEMORY_SCOPE_AGENT); } while (0)
#else
#define EV_T0() do {} while (0)
#define EV_MAX(k) do {} while (0)
#define EV_MIN(k) do {} while (0)
#endif
struct OneUnit {
    pg8::Unit u;
    __device__ __forceinline__ bool next(int i, pg8::Unit& o) const { if (i) return false; o = u; return true; }
    __device__ __forceinline__ void a_ready(const pg8::Unit&) const {}
    __device__ __forceinline__ void done(const pg8::Unit&) const {}
};

#ifndef PROBE_SEL
#define PROBE_SEL 0
#endif
#if PROBE_SEL
#define STAMP(k) do { if (blockIdx.x == 0 && threadIdx.x == 0) ((LAS unsigned long long*)(L + 256))[k] = __builtin_amdgcn_s_memrealtime(); } while (0)
#define STAMP2(k) do { if (blockIdx.x == 0) { __syncthreads(); if (threadIdx.x == 0) ((LAS unsigned long long*)((LAS unsigned char*)ring - RING_OFF + 256))[k] = __builtin_amdgcn_s_memrealtime(); } } while (0)
#else
#define STAMP(k) do {} while (0)
#define STAMP2(k) do {} while (0)
#endif
#if PROBE_SEL == 1
#define PA0 0
#define PA1 1
#define PB0 1
#define PB1 2
#elif PROBE_SEL == 2
#define PA0 2
#define PA1 3
#define PB0 3
#define PB1 4
#elif PROBE_SEL == 3
#define PA0 4
#define PA1 5
#define PB0 8
#define PB1 9
#elif PROBE_SEL == 4
#define PA0 2
#define PA1 10
#define PB0 10
#define PB1 11
#elif PROBE_SEL == 5
#define PA0 11
#define PA1 12
#define PB0 12
#define PB1 13
#elif PROBE_SEL == 7
#define PA0 1
#define PA1 2
#define PB0 0
#define PB1 1
#elif PROBE_SEL == 8
#define PA0 3
#define PA1 4
#define PB0 2
#define PB1 3
#elif PROBE_SEL == 9
#define PA0 6
#define PA1 7
#define PB0 4
#define PB1 5
#elif PROBE_SEL == 6
#define PA0 5
#define PA1 6
#define PB0 7
#define PB1 8
#elif PROBE_SEL >= 40 && PROBE_SEL < 60
#define PEA (PROBE_SEL - 40 + 16)
#define PEA_MIN (PROBE_SEL == 52)
#define PEB 0
#define PEB_MIN 0
#elif PROBE_SEL == 10
#define PEA 0
#define PEA_MIN 0
#define PEB 1
#define PEB_MIN 1
#elif PROBE_SEL == 11
#define PEA 2
#define PEA_MIN 0
#define PEB 3
#define PEB_MIN 1
#elif PROBE_SEL == 12
#define PEA 4
#define PEA_MIN 0
#define PEB 5
#define PEB_MIN 0
#elif PROBE_SEL == 14
#define PEA 8
#define PEA_MIN 0
#define PEB 9
#define PEB_MIN 0
#elif PROBE_SEL == 13
#define PEA 6
#define PEA_MIN 1
#define PEB 7
#define PEB_MIN 0
#endif

__device__ __forceinline__ void p0_transpose_blk(const float* W, int K, int N, bf16_t* WT, bool permqk, const float* kgain, LAS unsigned char* T, int item, int tid) {
    const int nblk = N >> 8, kb = item / nblk, nb = item - kb * nblk, k0 = kb * 128, n0 = nb * 256;
    const int n4 = tid & 63, kr = tid >> 6;
    f32x4 v[16];
#pragma unroll
    for (int i = 0; i < 16; ++i) v[i] = __builtin_nontemporal_load((const f32x4*)(W + (size_t)(k0 + 16 * kr + i) * N + n0 + 4 * n4));
    if (kgain) {
        const float* gp = kgain + k0 + 16 * kr;
#pragma unroll
        for (int i4 = 0; i4 < 4; ++i4) { const f32x4 gg = *(const f32x4*)(gp + 4 * i4);
#pragma unroll
            for (int j = 0; j < 4; ++j) v[4 * i4 + j] = v[4 * i4 + j] * gg[j]; }
    }
#pragma unroll
    for (int e = 0; e < 4; ++e) {
        u32x4 lo, hi;
        lo.x = pg8::cvt_pk_bf16(v[0][e], v[1][e]); lo.y = pg8::cvt_pk_bf16(v[2][e], v[3][e]); lo.z = pg8::cvt_pk_bf16(v[4][e], v[5][e]); lo.w = pg8::cvt_pk_bf16(v[6][e], v[7][e]);
        hi.x = pg8::cvt_pk_bf16(v[8][e], v[9][e]); hi.y = pg8::cvt_pk_bf16(v[10][e], v[11][e]); hi.z = pg8::cvt_pk_bf16(v[12][e], v[13][e]); hi.w = pg8::cvt_pk_bf16(v[14][e], v[15][e]);
        LAS unsigned char* p = T + (64 * e + n4) * 272 + 32 * kr;
        *(LAS u32x4*)p = lo; *(LAS u32x4*)(p + 16) = hi;
    }
    LDS_WAIT();
    __syncthreads();
    {
        const int rho = tid >> 1, half = tid & 1, n = n0 + 4 * (rho & 63) + (rho >> 6);
        int nrow = n;
        if (permqk && n < 1280) { const int p = n & 63; nrow = (n & ~63) + 2 * (p & 31) + (p >> 5); }
        const LAS unsigned char* src = T + rho * 272 + 128 * half;
        bf16_t* dst = WT + (size_t)nrow * K + k0 + 64 * half;
        u32x4 o[8];
#pragma unroll
        for (int c = 0; c < 8; ++c) o[c] = *(const LAS u32x4*)(src + 16 * c);
#pragma unroll
        for (int c = 0; c < 8; ++c) *(u32x4*)(dst + 8 * c) = o[c];
    }
    LDS_WAIT();
    __syncthreads();
}
__device__ __forceinline__ void prenorm_finish(const f32x4 (&v)[8], bf16_t* hrow, float* rs, int lane) {
    float ss = 0.f;
#pragma unroll
    for (int j = 0; j < 8; ++j) ss += (v[j][0] * v[j][0] + v[j][1] * v[j][1]) + (v[j][2] * v[j][2] + v[j][3] * v[j][3]);
    ss = wave_sum(ss);
    const float ms0 = ss * (1.0f / 2048.0f) + EPS, r = rsqrtf(ms0);
    if (lane == 0) *rs = ms0 * r;
#pragma unroll
    for (int j = 0; j < 8; ++j) { const f32x4 o = v[j] * r; u32x2 w; w.x = pg8::cvt_pk_bf16(o[0], o[1]); w.y = pg8::cvt_pk_bf16(o[2], o[3]); *(u32x2*)(hrow + 4 * lane + 256 * j) = w; }
}
constexpr int TR_IN = 16 * 20, TR_OUT = 16 * 8, TR_ITEMS = TR_IN + TR_OUT;
__device__ __forceinline__ void transpose_item(const Frame& F, int l, int r, LAS unsigned char* ring) {
    if (r < TR_IN) p0_transpose_blk(F.w_in + (size_t)l * DM * DIN, DM, DIN, F.WTIN + (size_t)l * DIN * DM, true, F.norm_pre + l * DM, ring, r, F.tid);
    else p0_transpose_blk(F.w_out + (size_t)l * DM * DM, DM, DM, F.WTOUT + (size_t)l * DM * DM, false, nullptr, ring, r - TR_IN, F.tid);
}
__device__ __forceinline__ void p0_prologue(const Frame& F, LAS unsigned char* ring) {
    const int gw = F.bid * NWAVES + F.wave, NGW = F.G * NWAVES;
    EV_T0();
    for (int it = F.bid; it < TR_ITEMS; it += F.G) transpose_item(F, 0, it, ring);
    __syncthreads(); EV_MAX(8);
    for (int m = 2 * gw; m < MT; m += 2 * NGW) {
        const float* xa = m < MP ? F.xp + (size_t)m * DM : F.xs + (size_t)(m - MP) * DM; const float* xb = (m + 1) < MP ? F.xp + (size_t)(m + 1) * DM : F.xs + (size_t)(m + 1 - MP) * DM;
        f32x4 va[8], vb[8];
#pragma unroll
        for (int j = 0; j < 8; ++j) { va[j] = __builtin_nontemporal_load((const f32x4*)(xa + 4 * F.lane + 256 * j)); vb[j] = __builtin_nontemporal_load((const f32x4*)(xb + 4 * F.lane + 256 * j)); }
        prenorm_finish(va, F.H + (size_t)m * DM, F.RSTD + m, F.lane); prenorm_finish(vb, F.H + (size_t)(m + 1) * DM, F.RSTD + m + 1, F.lane); }
    __syncthreads(); EV_MAX(9);
    const int gt = F.bid * NTHREADS + F.tid, NGT = F.G * NTHREADS;
    for (int e = gt; e < 2 * 4 * 128 * 128; e += NGT) { const int s = e & 127, t = (e >> 7) & 127; const float w = F.sgu_w[e];
        F.SGUW[e] = (bf16_t)(pg8::cvt_pk_bf16(s <= t ? w : 0.f, 0.f) & 0xffffu); }
    for (int e = gt; e < 2 * 4 * 128; e += NGT) { const int t = e & 127; const float* wr = F.sgu_w + (size_t)e * 128; float acc = 0.f;
        for (int s2 = 0; s2 <= t; ++s2) acc += __uint_as_float(pg8::cvt_pk_bf16(wr[s2], 0.f) << 16);
        F.RSW[e] = acc; }
    for (int e = gt; e < 2 * 4 * 128 * 128; e += NGT) { const int c = e & 127, d = (e >> 7) & 127, lg = e >> 14;
        F.PWT[e] = (bf16_t)(pg8::cvt_pk_bf16(F.pool_w[((size_t)lg * 128 + c) * 128 + d], 0.f) & 0xffffu); }
}

constexpr int AT_K = 0, AT_V = 49152, AT_STG = 98304, AT_WSTRIDE = 4352;
__device__ __forceinline__ void attn_stage_kv(const Frame& F, int b, int kvh, int nbp, LAS unsigned char* ring) {
    const int tid = F.tid;
    const bf16_t* kg = F.Kc + ((size_t)(b * 4 + kvh) * 2048 + 256 * nbp - 128) * 64;
    const bf16_t* vg = F.VTP + ((size_t)(b * 4 + kvh) * 64 + 8 * nbp - 4) * 2048;
    u32x4 kv[6], vv[6];
#pragma unroll
    for (int i = 0; i < 6; ++i) { const int ch = tid + 512 * i, row0 = ch >> 3, c8 = ch & 7, row = (nbp > 0 || row0 >= 128) ? row0 : row0 + 128;
        kv[i] = __builtin_nontemporal_load((const u32x4*)(kg + row * 64 + c8 * 8)); }
#pragma unroll
    for (int i = 0; i < 6; ++i) { const int ch = tid + 512 * i, tile0 = ch >> 8, rem = ch & 255, d = rem >> 2, c4 = rem & 3, tile = (nbp > 0 || tile0 >= 4) ? tile0 : tile0 + 4;
        vv[i] = __builtin_nontemporal_load((const u32x4*)(vg + tile * 2048 + d * 32 + c4 * 8)); }
#pragma unroll
    for (int i = 0; i < 6; ++i) { const int ch = tid + 512 * i, row = ch >> 3, c8 = ch & 7;
        *(LAS u32x4*)(ring + AT_K + row * 128 + ((c8 ^ (row & 7)) << 4)) = kv[i]; }
#pragma unroll
    for (int i = 0; i < 6; ++i) { const int ch = tid + 512 * i, tile = ch >> 8, rem = ch & 255, d = rem >> 2, c4 = rem & 3;
        *(LAS u32x4*)(ring + AT_V + tile * 4096 + d * 64 + ((c4 ^ ((d >> 2) & 3)) << 4)) = vv[i]; }
}
__device__ __forceinline__ void attn_task(const Frame& F, int l, int b, int nbp, int head, int j, const bf16x8 (&qf)[4], LAS unsigned char* ring) {
    const int lane = F.lane, r = lane & 31, hh = lane >> 5;
    LAS unsigned char* wl = ring + AT_STG + F.wave * AT_WSTRIDE;
    LAS float* wsf = (LAS float*)wl; LAS bf16_t* stg = (LAS bf16_t*)(wl + 256);
    const size_t qrow0 = (size_t)b * 2048 + 256 * nbp + 32 * j;
    u32x4 gv[4];
#pragma unroll
    for (int i = 0; i < 4; ++i) gv[i] = __builtin_nontemporal_load((const u32x4*)(F.Z2 + (qrow0 + i * 8 + (lane >> 3)) * ZW + Z_GA + head * 64 + (lane & 7) * 8));
    const int cmin = (nbp > 0) ? 0 : (j < 4 ? 4 - j : 0);
    f32x16 S[5];
#pragma unroll
    for (int c = 0; c < 5; ++c) {
        f32x16 a;
#pragma unroll
        for (int i = 0; i < 16; ++i) a[i] = 0.f;
        if (c >= cmin) {
            LAS unsigned char* kp = ring + AT_K + (32 * (j + c) + r) * 128;
#pragma unroll
            for (int s = 0; s < 4; ++s) a = __builtin_amdgcn_mfma_f32_32x32x16_bf16(*(const LAS bf16x8*)(kp + (((2 * s + hh) ^ (r & 7)) << 4)), qf[s], a, 0, 0, 0);
        }
        S[c] = a;
    }
    const float NEG = -INFINITY;
#pragma unroll
    for (int i = 0; i < 16; ++i) { const int kap = crow(i, hh); if (kap <= r) S[0][i] = NEG; if (kap > r) S[4][i] = NEG; }
    const float sink2 = F.sinks[l * 16 + head] * LOG2E;
    float m = sink2;
#pragma unroll
    for (int c = 0; c < 5; ++c) if (c >= cmin) {
#pragma unroll
        for (int i = 0; i < 16; ++i) m = fmaxf(m, S[c][i]); }
    m = fmaxf(m, __shfl_xor(m, 32));
    float sum = 0.f;
#pragma unroll
    for (int c = 0; c < 5; ++c) if (c >= cmin) {
#pragma unroll
        for (int i = 0; i < 16; ++i) { const float p = __builtin_amdgcn_exp2f(S[c][i] - m); S[c][i] = p; sum += p; } }
    sum += __shfl_xor(sum, 32);
    const float inv = 1.0f / (sum + __builtin_amdgcn_exp2f(sink2 - m));
    f32x16 o[2];
#pragma unroll
    for (int i = 0; i < 16; ++i) { o[0][i] = 0.f; o[1][i] = 0.f; }
#pragma unroll
    for (int c = 0; c < 5; ++c) if (c >= cmin) {
        LAS unsigned char* vt = ring + AT_V + (j + c) * 4096 + r * 64;
#pragma unroll
        for (int s = 0; s < 2; ++s) {
            u32x4 pw; pw.x = pg8::cvt_pk_bf16(S[c][8 * s + 0], S[c][8 * s + 1]); pw.y = pg8::cvt_pk_bf16(S[c][8 * s + 2], S[c][8 * s + 3]);
            pw.z = pg8::cvt_pk_bf16(S[c][8 * s + 4], S[c][8 * s + 5]); pw.w = pg8::cvt_pk_bf16(S[c][8 * s + 6], S[c][8 * s + 7]);
            const bf16x8 pa = __builtin_bit_cast(bf16x8, pw);
            const int sw = (((2 * hh + s) ^ ((r >> 2) & 3)) << 4);
#pragma unroll
            for (int db = 0; db < 2; ++db) o[db] = __builtin_amdgcn_mfma_f32_32x32x16_bf16(pa, *(const LAS bf16x8*)(vt + db * 2048 + sw), o[db], 0, 0, 0);
        }
    }
    if (hh == 0) wsf[r] = inv;
    LDS_WAIT();
#pragma unroll
    for (int i = 0; i < 16; ++i) { const int q = crow(i, hh); const float rl = wsf[q];
        stg[q * 64 + r] = (bf16_t)(pg8::cvt_pk_bf16(o[0][i] * rl, 0.f) & 0xffffu);
        stg[q * 64 + 32 + r] = (bf16_t)(pg8::cvt_pk_bf16(o[1][i] * rl, 0.f) & 0xffffu); }
    LDS_WAIT();
#pragma unroll
    for (int i = 0; i < 4; ++i) { const int row = i * 8 + (lane >> 3), ch = lane & 7;
        const u32x4 ov = *(const LAS u32x4*)(stg + row * 64 + ch * 8);
        float of[8], gf[8]; unpack8(ov, of); unpack8(gv[i], gf);
#pragma unroll
        for (int jj = 0; jj < 8; ++jj) of[jj] *= gf[jj];
        *(u32x4*)(F.MIX + (qrow0 + row) * DM + head * 64 + ch * 8) = pack8(of); }
    LDS_WAIT();
}
__device__ __forceinline__ void attn_unit(int l, int a, LAS unsigned char* ring) {
    LOCAL_FRAME;
    const int kvh = a & 3, nbp = (a >> 2) & 7, b = a >> 5;
    const int lane = F.lane, r = lane & 31, hh = lane >> 5;
    const int head = 4 * kvh + (F.wave >> 1), j0 = 4 * (F.wave & 1);
    const bf16_t* qp = F.Qc + ((size_t)b * 2048 + 256 * nbp + 32 * j0 + r) * 1024 + head * 64 + 8 * hh;
    bf16x8 qa[4], qb[4];
#pragma unroll
    for (int s = 0; s < 4; ++s) qa[s] = __builtin_nontemporal_load((const bf16x8*)(qp + 16 * s));
#ifdef EXP_ZERO_LDS
    for (int e = F.tid; e < 134144 / 16; e += NTHREADS) *(LAS u32x4*)(ring + 16 * e) = (u32x4){0u, 0u, 0u, 0u};
    LDS_WAIT(); __syncthreads();
#endif
    attn_stage_kv(F, b, kvh, nbp, ring);
    LDS_WAIT();
    __syncthreads();
#pragma unroll
    for (int s = 0; s < 4; ++s) qb[s] = __builtin_nontemporal_load((const bf16x8*)(qp + 32 * 1024 + 16 * s));
    attn_task(F, l, b, nbp, head, j0 + 0, qa, ring);
#pragma unroll
    for (int s = 0; s < 4; ++s) qa[s] = __builtin_nontemporal_load((const bf16x8*)(qp + 64 * 1024 + 16 * s));
    attn_task(F, l, b, nbp, head, j0 + 1, qb, ring);
#pragma unroll
    for (int s = 0; s < 4; ++s) qb[s] = __builtin_nontemporal_load((const bf16x8*)(qp + 96 * 1024 + 16 * s));
    attn_task(F, l, b, nbp, head, j0 + 2, qa, ring);
    attn_task(F, l, b, nbp, head, j0 + 3, qb, ring);
    __syncthreads();
}

constexpr int PL_STRIDE = 272, PL_WBYTES = 47 * 272;
template <int G>
__device__ __forceinline__ void pool_unit_p(int l, int tile, LAS unsigned char* wl) {
    LOCAL_FRAME;
    constexpr int W = 2 << G, HIST = W - 1, NROW = 32 + HIST, NLD = (NROW * 16 + 63) / 64;
    const int lane = F.lane, r = lane & 31, hh = lane >> 5;
    const size_t R0 = (size_t)32 * tile;
    const int t0 = (int)(R0 & 2047);
    {
        u32x4 x[NLD];
#pragma unroll
        for (int k = 0; k < NLD; ++k) { const int id = lane + 64 * k, lr = id >> 4, c16 = id & 15; const int lrc = lr < NROW ? lr : NROW - 1;
            const int back = HIST - lrc; const size_t grow = (back <= t0) ? R0 - back : R0;
            x[k] = __builtin_nontemporal_load((const u32x4*)(F.Z2 + grow * ZW + Z_XB + 128 * G + 8 * c16)); }
#pragma unroll
        for (int k = 0; k < NLD; ++k) { const int id = lane + 64 * k, lr = id >> 4, c16 = id & 15; if (lr < NROW) *(LAS u32x4*)(wl + lr * PL_STRIDE + c16 * 16) = x[k]; }
    }
    const int t = t0 + r;
    const float icnt = 1.0f / (float)(W < t + 1 ? W : t + 1);
    LDS_WAIT();
    bf16x8 bfr[8];
#pragma unroll
    for (int s = 0; s < 8; ++s) {
        LAS unsigned char* bp = wl + (r + HIST) * PL_STRIDE + (16 * s + 8 * hh) * 2;
        float cur[8], sum[8]; unpack8(*(const LAS u32x4*)bp, cur);
#pragma unroll
        for (int jj = 0; jj < 8; ++jj) sum[jj] = cur[jj];
#pragma unroll
        for (int i = 1; i < W; ++i) { float f[8]; unpack8(*(const LAS u32x4*)(bp - i * PL_STRIDE), f); const float wgt = i <= t ? 1.f : 0.f;
#pragma unroll
            for (int jj = 0; jj < 8; ++jj) sum[jj] += wgt * f[jj]; }
#pragma unroll
        for (int jj = 0; jj < 8; ++jj) sum[jj] = sum[jj] * icnt - cur[jj];
        bfr[s] = __builtin_bit_cast(bf16x8, pack8(sum));
        __builtin_amdgcn_sched_barrier(0);
    }
#pragma unroll
    for (int db = 0; db < 4; ++db) {
        const int col = 128 * G + 32 * db + r;
        unsigned short gq[16];
#pragma unroll
        for (int i = 0; i < 16; ++i) gq[i] = __builtin_nontemporal_load(F.Z2 + (R0 + crow(i, hh)) * ZW + Z_GP + col);
        const float sc = F.pool_scale[l * 512 + col];
        f32x16 acc;
#pragma unroll
        for (int i = 0; i < 16; ++i) acc[i] = 0.f;
        const bf16_t* bp2 = F.PWT + ((size_t)(l * 4 + G) * 128 + 32 * db + r) * 128 + 8 * hh;
#pragma unroll
        for (int s = 0; s < 8; ++s) acc = __builtin_amdgcn_mfma_f32_32x32x16_bf16(bfr[s], *(const bf16x8*)(bp2 + 16 * s), acc, 0, 0, 0);
#pragma unroll
        for (int i = 0; i < 16; ++i) { const float gf = __uint_as_float((unsigned)gq[i] << 16);
            F.MIX[(R0 + crow(i, hh)) * DM + 1024 + col] = (bf16_t)(pg8::cvt_pk_bf16(acc[i] * sc * gf, 0.f) & 0xffffu); }
        __builtin_amdgcn_sched_barrier(0);
    }
    LDS_WAIT();
}
__device__ __forceinline__ void pool_prompt(int l, int g, int tile, LAS unsigned char* wl) {
    if (g == 0) pool_unit_p<0>(l, tile, wl); else if (g == 1) pool_unit_p<1>(l, tile, wl); else if (g == 2) pool_unit_p<2>(l, tile, wl); else pool_unit_p<3>(l, tile, wl);
}
template <int G>
__device__ __forceinline__ void pool_unit_s(int l, int tile) {
    LOCAL_FRAME;
    constexpr int W = 2 << G;
    const int lane = F.lane, r = lane & 31, hh = lane >> 5;
    const size_t row = (size_t)MP + 32 * tile + r;
    const int tt = (int)(row & 3), bd = (int)((row - MP) >> 2);
    const float* stb = F.state_pool + ((size_t)l * 128 + bd) * 15 * 512;
    const float icnt = 1.0f / (float)W;
    bf16x8 bfr[8];
#pragma unroll
    for (int s = 0; s < 8; ++s) {
        const int c0 = 128 * G + 16 * s + 8 * hh;
        float sum[8], cur[8];
        {
            constexpr int NL = W < 4 ? W : 4;
            u32x4 zn[NL]; f32x4 sa[NL], sb[NL];
#pragma unroll
            for (int i = 0; i < NL; ++i) { const int back = i <= tt ? i : tt; int si = 15 + tt - i; si = si > 14 ? 14 : si;
                zn[i] = *(const u32x4*)(F.Z2 + (row - back) * ZW + Z_XB + c0); sa[i] = *(const f32x4*)(stb + si * 512 + c0); sb[i] = *(const f32x4*)(stb + si * 512 + c0 + 4); }
            unpack8(zn[0], cur);
#pragma unroll
            for (int jj = 0; jj < 8; ++jj) sum[jj] = cur[jj];
#pragma unroll
            for (int i = 1; i < NL; ++i) { float f[8]; unpack8(zn[i], f); const bool nw = i <= tt;
#pragma unroll
                for (int jj = 0; jj < 4; ++jj) { sum[jj] += nw ? f[jj] : sa[i][jj]; sum[4 + jj] += nw ? f[4 + jj] : sb[i][jj]; } }
        }
#pragma unroll
        for (int i0 = 4; i0 < W; i0 += 4) {
            f32x4 sa[4], sb[4];
#pragma unroll
            for (int i = 0; i < 4; ++i) { const int si = 15 + tt - (i0 + i); sa[i] = *(const f32x4*)(stb + si * 512 + c0); sb[i] = *(const f32x4*)(stb + si * 512 + c0 + 4); }
#pragma unroll
            for (int i = 0; i < 4; ++i)
#pragma unroll
                for (int jj = 0; jj < 4; ++jj) { sum[jj] += sa[i][jj]; sum[4 + jj] += sb[i][jj]; }
        }
#pragma unroll
        for (int jj = 0; jj < 8; ++jj) sum[jj] = sum[jj] * icnt - cur[jj];
        bfr[s] = __builtin_bit_cast(bf16x8, pack8(sum));
        __builtin_amdgcn_sched_barrier(0);
    }
    f32x16 acc[4];
#pragma unroll
    for (int db = 0; db < 4; ++db) {
#pragma unroll
        for (int i = 0; i < 16; ++i) acc[db][i] = 0.f;
        const bf16_t* ap = F.PWT + ((size_t)(l * 4 + G) * 128 + 32 * db + r) * 128 + 8 * hh;
#pragma unroll
        for (int s = 0; s < 8; ++s) acc[db] = __builtin_amdgcn_mfma_f32_32x32x16_bf16(*(const bf16x8*)(ap + 16 * s), bfr[s], acc[db], 0, 0, 0);
        __builtin_amdgcn_sched_barrier(0);
    }
#pragma unroll
    for (int db = 0; db < 4; ++db)
#pragma unroll
        for (int q = 0; q < 4; ++q) {
            const int col = 128 * G + 32 * db + 8 * q + 4 * hh;
            const f32x4 sc = *(const f32x4*)(F.pool_scale + l * 512 + col);
            float gf[4]; unpack4(*(const u32x2*)(F.Z2 + row * ZW + Z_GP + col), gf);
            u32x2 wv; wv.x = pg8::cvt_pk_bf16(acc[db][4 * q + 0] * sc[0] * gf[0], acc[db][4 * q + 1] * sc[1] * gf[1]);
            wv.y = pg8::cvt_pk_bf16(acc[db][4 * q + 2] * sc[2] * gf[2], acc[db][4 * q + 3] * sc[3] * gf[3]);
            *(u32x2*)(F.MIX + row * DM + 1024 + col) = wv;
        }
}
__device__ __forceinline__ void pool_sample(int l, int g, int tile) {
    if (g == 0) pool_unit_s<0>(l, tile); else if (g == 1) pool_unit_s<1>(l, tile); else if (g == 2) pool_unit_s<2>(l, tile); else pool_unit_s<3>(l, tile);
}

struct SguOps { bf16x8 wB[8], wA[4]; };
__device__ __forceinline__ void sgu_load_ops(SguOps& o, const Frame& F, int l, int hd, size_t R0, int r, int hh, int db, int tbA, int tbB) {
    const bf16_t* Wb = F.SGUW + (size_t)(l * 4 + hd) * 128 * 128;
#pragma unroll
    for (int s = 0; s < 8; ++s) { o.wB[s] = (bf16x8){0, 0, 0, 0, 0, 0, 0, 0}; if (s < 2 * (tbB + 1)) o.wB[s] = *(const bf16x8*)(Wb + (32 * tbB + r) * 128 + 16 * s + 8 * hh); }
#pragma unroll
    for (int s = 0; s < 4; ++s) { o.wA[s] = (bf16x8){0, 0, 0, 0, 0, 0, 0, 0}; if (s < 2 * (tbA + 1)) o.wA[s] = *(const bf16x8*)(Wb + (32 * tbA + r) * 128 + 16 * s + 8 * hh); }
}
constexpr int SG_TOFF = 81920, SG_TBYTES = 32 * 144;
struct SguUG { u32x4 uu[2], gg[2]; };
__device__ __forceinline__ void sgu_load_ug(SguUG& o, const Frame& F, int hd, size_t R0, int lane, int db, int tb) {
#pragma unroll
    for (int k = 0; k < 2; ++k) { const int id = lane + 64 * k; const size_t row = R0 + 32 * tb + (id >> 2); const int col = 128 * hd + 32 * db + 8 * (id & 3);
        o.uu[k] = __builtin_nontemporal_load((const u32x4*)(F.Z2 + row * ZW + Z_U + col)); o.gg[k] = __builtin_nontemporal_load((const u32x4*)(F.Z2 + row * ZW + Z_GS + col)); }
}
__device__ __forceinline__ void sgu_mfma(const SguOps& o, LAS bf16_t* VnT, int h2, int r, int hh, int db, int tbA, int tbB, f32x16& accA, f32x16& accB) {
#pragma unroll
    for (int i = 0; i < 16; ++i) { accA[i] = 0.f; accB[i] = 0.f; }
#pragma unroll
    for (int s = 0; s < 8; ++s) {
        if (s < 2 * (tbB + 1)) {
            const LAS unsigned char* ap = (const LAS unsigned char*)VnT + (h2 * 128 + 16 * s + 8 * hh + ((r & 15) >> 2)) * 320 + (32 * db + (r & 16) + 4 * (r & 3)) * 2;
            const v4i16_t lo = __builtin_amdgcn_ds_read_tr16_b64_v4i16((LAS v4i16_t*)ap), hi = __builtin_amdgcn_ds_read_tr16_b64_v4i16((LAS v4i16_t*)(ap + 4 * 320));
            const bf16x8 a = (bf16x8){lo[0], lo[1], lo[2], lo[3], hi[0], hi[1], hi[2], hi[3]};
            accB = __builtin_amdgcn_mfma_f32_32x32x16_bf16(a, o.wB[s], accB, 0, 0, 0);
            if (s < 4) { if (s < 2 * (tbA + 1)) accA = __builtin_amdgcn_mfma_f32_32x32x16_bf16(a, o.wA[s], accA, 0, 0, 0); }
        }
    }
}
__device__ __forceinline__ void sgu_epi(const SguUG& o, const Frame& F, int l, int hd, size_t R0, int lane, int db, int tb, const f32x16& acc, LAS unsigned char* T) {
    const int r = lane & 31, hh = lane >> 5;
#pragma unroll
    for (int q = 0; q < 4; ++q) *(LAS f32x4*)(T + r * 144 + (8 * q + 4 * hh) * 4) = (f32x4){acc[4 * q + 0], acc[4 * q + 1], acc[4 * q + 2], acc[4 * q + 3]};
    LDS_WAIT();
#pragma unroll
    for (int k = 0; k < 2; ++k) { const int id = lane + 64 * k, tl = id >> 2, c8 = 8 * (id & 3); const int t = 32 * tb + tl, col = 128 * hd + 32 * db + c8;
        const f32x4 v0 = *(const LAS f32x4*)(T + tl * 144 + c8 * 4), v1 = *(const LAS f32x4*)(T + tl * 144 + c8 * 4 + 16);
        const f32x4 g0 = *(const f32x4*)(F.ln_g + l * 512 + col), g1 = *(const f32x4*)(F.ln_g + l * 512 + col + 4), b0 = *(const f32x4*)(F.ln_b + l * 512 + col), b1 = *(const f32x4*)(F.ln_b + l * 512 + col + 4);
        const float bs = F.sgu_b[l * 512 + hd * 128 + t], rs = F.RSW[(l * 4 + hd) * 128 + t];
        float uf[8], gf[8], m[8]; unpack8(o.uu[k], uf); unpack8(o.gg[k], gf);
#pragma unroll
        for (int e = 0; e < 4; ++e) { m[e] = (g0[e] * v0[e] + b0[e] * rs + bs) * uf[e] * gf[e]; m[4 + e] = (g1[e] * v1[e] + b1[e] * rs + bs) * uf[4 + e] * gf[4 + e]; }
        *(u32x4*)(F.MIX + (R0 + t) * DM + 1536 + col) = pack8(m); }
    LDS_WAIT();
}
__device__ __forceinline__ void sgu_unit(int l, int ci, int hp, LAS unsigned char* ring) {
    LOCAL_FRAME;
    LAS bf16_t* VnT = (LAS bf16_t*)ring;
    const int lane = F.lane, wv = F.wave;
    const size_t R0 = (size_t)128 * ci;
    const int r = lane & 31, hh = lane >> 5, db = wv & 3; const int tbA = (wv >> 2) ? 1 : 0, tbB = (wv >> 2) ? 2 : 3;
    SguOps op0;
    {
        const int tl = lane >> 2, q4 = lane & 3;
        const bf16_t* vrow = F.Z2 + (R0 + 16 * wv + tl) * ZW + Z_VS + 32 * q4;
        u32x4 x[4][4];
#pragma unroll
        for (int h = 0; h < 4; ++h)
#pragma unroll
            for (int i = 0; i < 4; ++i) x[h][i] = *(const u32x4*)(vrow + 128 * h + 8 * i);
        sgu_load_ops(op0, F, l, 2 * hp, R0, r, hh, db, tbA, tbB);
        float s = 0.f, ss = 0.f;
#pragma unroll
        for (int h = 0; h < 4; ++h)
#pragma unroll
            for (int i = 0; i < 4; ++i) { float f[8]; unpack8(x[h][i], f);
#pragma unroll
                for (int jj = 0; jj < 8; ++jj) { s += f[jj]; ss += f[jj] * f[jj]; } }
        s += __shfl_xor(s, 1); s += __shfl_xor(s, 2); ss += __shfl_xor(ss, 1); ss += __shfl_xor(ss, 2);
        const float mean = s * (1.0f / 512.0f), var = ss * (1.0f / 512.0f) - mean * mean, rstd = rsqrtf(var + EPS);
#pragma unroll
        for (int h2 = 0; h2 < 2; ++h2)
#pragma unroll
            for (int i = 0; i < 4; ++i) { const int d = 32 * q4 + 8 * i;
                const u32x4 xv = hp ? x[2 + h2][i] : x[h2][i];
                float f[8]; unpack8(xv, f);
#pragma unroll
                for (int jj = 0; jj < 8; ++jj) f[jj] = (f[jj] - mean) * rstd;
                *(LAS u32x4*)((LAS unsigned char*)VnT + (h2 * 128 + 16 * wv + tl) * 320 + d * 2) = pack8(f); }
    }
    LDS_WAIT();
    __syncthreads();
    f32x16 accA, accB;
    SguUG ua, ub;
    LAS unsigned char* T = ring + SG_TOFF + wv * SG_TBYTES;
    sgu_load_ug(ua, F, 2 * hp, R0, lane, db, tbA); sgu_load_ug(ub, F, 2 * hp, R0, lane, db, tbB);
    sgu_mfma(op0, VnT, 0, r, hh, db, tbA, tbB, accA, accB);
    SguOps op1;
    sgu_load_ops(op1, F, l, 2 * hp + 1, R0, r, hh, db, tbA, tbB);
    sgu_epi(ua, F, l, 2 * hp, R0, lane, db, tbA, accA, T);
    sgu_epi(ub, F, l, 2 * hp, R0, lane, db, tbB, accB, T);
    sgu_load_ug(ua, F, 2 * hp + 1, R0, lane, db, tbA); sgu_load_ug(ub, F, 2 * hp + 1, R0, lane, db, tbB);
    sgu_mfma(op1, VnT, 1, r, hh, db, tbA, tbB, accA, accB);
    sgu_epi(ua, F, l, 2 * hp + 1, R0, lane, db, tbA, accA, T);
    sgu_epi(ub, F, l, 2 * hp + 1, R0, lane, db, tbB, accB, T);
    __syncthreads();
}

__device__ __forceinline__ void samp_attn(int l, int bd, int kvh, LAS unsigned char* wl) {
    LOCAL_FRAME;
    LAS float* ps = (LAS float*)wl;
    LAS float* invs = ps + 144 * 16;
    const int lane = F.lane, fr = lane & 15, fq = lane >> 4, gq = fr >> 2, tt = fr & 3;
    float* oKs = F.out + O_KS + (size_t)l * LS_KS; float* oVs = F.out + O_VS + (size_t)l * LS_KS;
    bf16x8 qfr[2];
    {
        const bf16_t* qsrc = F.Qc + ((size_t)MP + 4 * bd + tt) * 1024 + (4 * kvh + gq) * 64 + 16 * fq;
        const u32x4 qa = *(const u32x4*)qsrc, qb = *(const u32x4*)(qsrc + 8);
        u32x4 lo, hi;
        lo.x = (qa.x & 0xffffu) | (qa.y << 16); lo.y = (qa.z & 0xffffu) | (qa.w << 16); lo.z = (qb.x & 0xffffu) | (qb.y << 16); lo.w = (qb.z & 0xffffu) | (qb.w << 16);
        hi.x = (qa.x >> 16) | (qa.y & 0xffff0000u); hi.y = (qa.z >> 16) | (qa.w & 0xffff0000u); hi.z = (qb.x >> 16) | (qb.y & 0xffff0000u); hi.w = (qb.z >> 16) | (qb.w & 0xffff0000u);
        qfr[0] = __builtin_bit_cast(bf16x8, lo); qfr[1] = __builtin_bit_cast(bf16x8, hi);
    }
    const float* kc = F.cache_k + (((size_t)l * 128 + bd) * 128) * 256 + kvh * 64 + 8 * fq;
    const float* kn = oKs + (((size_t)bd * 128 + 124 + (fr & 3)) * 4 + kvh) * 64 + 8 * fq;
    float* kd = oKs + ((size_t)bd * 128 * 4 + kvh) * 64 + 8 * fq;
    f32x4 S[9];
#pragma unroll
    for (int T = 0; T < 9; ++T) S[T] = (f32x4){0.f, 0.f, 0.f, 0.f};
#pragma unroll
    for (int T0 = 0; T0 < 9; T0 += 3) {
        f32x4 x[3][2][2];
#pragma unroll
        for (int u = 0; u < 3; ++u) { const int T = T0 + u; const float* src = (T < 8) ? kc + (size_t)(16 * T + fr) * 256 : kn;
#pragma unroll
            for (int ks = 0; ks < 2; ++ks) { x[u][ks][0] = __builtin_nontemporal_load((const f32x4*)(src + 32 * ks)); x[u][ks][1] = __builtin_nontemporal_load((const f32x4*)(src + 32 * ks + 4)); } }
#pragma unroll
        for (int u = 0; u < 3; ++u) { const int T = T0 + u; const int key = 16 * T + fr;
            if (T < 8 && key >= 4) {
#pragma unroll
                for (int ks = 0; ks < 2; ++ks) { float* dst = kd + (size_t)(key - 4) * 256 + 32 * ks; __builtin_nontemporal_store(x[u][ks][0], (f32x4*)dst); __builtin_nontemporal_store(x[u][ks][1], (f32x4*)(dst + 4)); } } }
#pragma unroll
        for (int u = 0; u < 3; ++u)
#pragma unroll
            for (int ks = 0; ks < 2; ++ks) { u32x4 w; w.x = pg8::cvt_pk_bf16(x[u][ks][0][0], x[u][ks][0][1]); w.y = pg8::cvt_pk_bf16(x[u][ks][0][2], x[u][ks][0][3]);
                w.z = pg8::cvt_pk_bf16(x[u][ks][1][0], x[u][ks][1][1]); w.w = pg8::cvt_pk_bf16(x[u][ks][1][2], x[u][ks][1][3]);
                S[T0 + u] = __builtin_amdgcn_mfma_f32_16x16x32_bf16(__builtin_bit_cast(bf16x8, w), qfr[ks], S[T0 + u], 0, 0, 0); }
        __builtin_amdgcn_sched_barrier(0);
    }
    const float sink2 = F.sinks[l * 16 + 4 * kvh + gq] * LOG2E;
    float m = sink2;
#pragma unroll
    for (int T = 0; T < 9; ++T)
#pragma unroll
        for (int rg = 0; rg < 4; ++rg) { const int key = 16 * T + 4 * fq + rg; const bool ok = (T < 8) ? (key >= tt + 1) : (fq == 0 && rg <= tt);
            S[T][rg] = ok ? S[T][rg] : -INFINITY; m = fmaxf(m, S[T][rg]); }
    m = fmaxf(m, __shfl_xor(m, 16)); m = fmaxf(m, __shfl_xor(m, 32));
    float sum = 0.f;
#pragma unroll
    for (int T = 0; T < 9; ++T)
#pragma unroll
        for (int rg = 0; rg < 4; ++rg) { const float p = __builtin_amdgcn_exp2f(S[T][rg] - m); sum += p; ps[(16 * T + 4 * fq + rg) * 16 + fr] = p; }
    sum += __shfl_xor(sum, 16); sum += __shfl_xor(sum, 32);
    if (fq == 0) invs[fr] = 1.0f / (sum + __builtin_amdgcn_exp2f(sink2 - m));
    LDS_WAIT();
    const int kq = lane >> 4, dq = lane & 15;
    const float* vcp = F.cache_v + (((size_t)l * 128 + bd) * 128 + kq) * 256 + kvh * 64 + 4 * dq;
    float* vop = oVs + ((size_t)bd * 128 + kq) * 256 + kvh * 64 + 4 * dq;
#pragma unroll 1
    for (int pass = 0; pass < 2; ++pass) {
        float o[8][4];
#pragma unroll
        for (int q = 0; q < 8; ++q) { o[q][0] = 0.f; o[q][1] = 0.f; o[q][2] = 0.f; o[q][3] = 0.f; }
#pragma unroll 1
        for (int blk = 0; blk < 3; ++blk) {
            f32x4 vx[11];
#pragma unroll
            for (int ii = 0; ii < 11; ++ii) { const int i = blk * 11 + ii; const float* src = (i < 32) ? vcp + (size_t)i * 1024 : vop + (size_t)31 * 1024; vx[ii] = __builtin_nontemporal_load((const f32x4*)src); }
            if (pass == 0) {
#pragma unroll
                for (int ii = 0; ii < 11; ++ii) { const int i = blk * 11 + ii; if (i >= 1 && i < 32) __builtin_nontemporal_store(vx[ii], (f32x4*)(vop + (size_t)(i - 1) * 1024)); } }
#pragma unroll
            for (int ii = 0; ii < 11; ++ii) { const int key = 4 * (blk * 11 + ii) + kq;
                const f32x4 pa = *(const LAS f32x4*)(ps + key * 16 + 8 * pass), pb = *(const LAS f32x4*)(ps + key * 16 + 8 * pass + 4);
#pragma unroll
                for (int e = 0; e < 4; ++e) { o[0][e] += pa[0] * vx[ii][e]; o[1][e] += pa[1] * vx[ii][e]; o[2][e] += pa[2] * vx[ii][e]; o[3][e] += pa[3] * vx[ii][e];
                    o[4][e] += pb[0] * vx[ii][e]; o[5][e] += pb[1] * vx[ii][e]; o[6][e] += pb[2] * vx[ii][e]; o[7][e] += pb[3] * vx[ii][e]; }
                __builtin_amdgcn_sched_barrier(0); }
        }
#pragma unroll
        for (int q = 0; q < 8; ++q)
#pragma unroll
            for (int e = 0; e < 4; ++e) { float v = o[q][e]; v += __shfl_xor(v, 16); v += __shfl_xor(v, 32); o[q][e] = v; }
#pragma unroll
        for (int q = 0; q < 8; ++q) if ((q >> 1) == kq) { const int qq = 8 * pass + q, t2 = qq & 3, head = 4 * kvh + (qq >> 2); const size_t row = (size_t)MP + 4 * bd + t2;
            float gf[4]; unpack4(*(const u32x2*)(F.Z2 + row * ZW + Z_GA + head * 64 + 4 * dq), gf);
            const float iq = invs[qq];
            u32x2 wv; wv.x = pg8::cvt_pk_bf16(o[q][0] * iq * gf[0], o[q][1] * iq * gf[1]); wv.y = pg8::cvt_pk_bf16(o[q][2] * iq * gf[2], o[q][3] * iq * gf[3]);
            *(u32x2*)(F.MIX + row * DM + head * 64 + 4 * dq) = wv; }
    }
    LDS_WAIT();
}
__device__ __forceinline__ void samp_sgu(int l, int bd) {
    LOCAL_FRAME;
    const int lane = F.lane, c0 = 8 * lane, hd = lane >> 4;
    {
        float* oPs = F.out + O_PS + (size_t)l * LS_PS + (size_t)bd * 15 * 512; const float* sp = F.state_pool + (size_t)l * LS_PS + (size_t)bd * 15 * 512 + 4 * 512;
        f32x4 cp[22];
#pragma unroll
        for (int k = 0; k < 22; ++k) cp[k] = __builtin_nontemporal_load((const f32x4*)(sp + 4 * (lane + 64 * k)));
#pragma unroll
        for (int k = 0; k < 22; ++k) __builtin_nontemporal_store(cp[k], (f32x4*)(oPs + 4 * (lane + 64 * k)));
    }
    float* oCV = F.out + O_CV + (size_t)l * LS_CV;
    float gl[8], bl[8];
#pragma unroll
    for (int j = 0; j < 8; ++j) { gl[j] = F.ln_g[l * 512 + c0 + j]; bl[j] = F.ln_b[l * 512 + c0 + j]; }
    u32x4 xr[4], ur[4], gr[4];
#pragma unroll
    for (int tt = 0; tt < 4; ++tt) { const size_t row = (size_t)MP + 4 * bd + tt; xr[tt] = *(const u32x4*)(F.Z2 + row * ZW + Z_VS + c0); ur[tt] = *(const u32x4*)(F.Z2 + row * ZW + Z_U + c0); gr[tt] = *(const u32x4*)(F.Z2 + row * ZW + Z_GS + c0); }
    float vn[4][8];
#pragma unroll
    for (int tt = 0; tt < 4; ++tt) { float f[8]; unpack8(xr[tt], f);
        float s = 0.f, ss = 0.f;
#pragma unroll
        for (int j = 0; j < 8; ++j) { s += f[j]; ss += f[j] * f[j]; }
        s = wave_sum(s); ss = wave_sum(ss);
        const float mean = s * (1.0f / 512.0f), var = ss * (1.0f / 512.0f) - mean * mean, rstd = rsqrtf(var + EPS);
#pragma unroll
        for (int j = 0; j < 8; ++j) vn[tt][j] = (f[j] - mean) * rstd * gl[j] + bl[j];
        float* o = oCV + ((size_t)bd * 4 + tt) * 512 + c0;
        *(f32x4*)o = (f32x4){vn[tt][0], vn[tt][1], vn[tt][2], vn[tt][3]}; *(f32x4*)(o + 4) = (f32x4){vn[tt][4], vn[tt][5], vn[tt][6], vn[tt][7]}; }
#pragma unroll
    for (int tt = 0; tt < 4; ++tt) { const size_t row = (size_t)MP + 4 * bd + tt;
        float mx[8]; const float bias = F.sgu_b[l * 512 + hd * 128 + tt];
#pragma unroll
        for (int j = 0; j < 8; ++j) mx[j] = bias;
#pragma unroll
        for (int s2 = 0; s2 < 4; ++s2) if (s2 <= tt) { const float w = F.sgu_w[((size_t)(l * 4 + hd) * 128 + tt) * 128 + s2];
#pragma unroll
            for (int j = 0; j < 8; ++j) mx[j] += w * vn[s2][j]; }
        float uf[8], gf[8]; unpack8(ur[tt], uf); unpack8(gr[tt], gf);
#pragma unroll
        for (int j = 0; j < 8; ++j) mx[j] = mx[j] * uf[j] * gf[j];
        *(u32x4*)(F.MIX + row * DM + 1536 + c0) = pack8(mx); }
}

#ifdef HYBRID
__device__ __forceinline__ void attn_task_o(const Frame& F, int l, int b, int nb, int head, int qs, LAS unsigned char* wl) {
    const int lane = F.lane, r = lane & 31, hh = lane >> 5, kvh = head >> 2;
    LAS float* wsf = (LAS float*)wl; LAS bf16_t* stg = (LAS bf16_t*)(wl + 256);
    const int t0 = 128 * nb + 32 * qs;
    const size_t qrow0 = (size_t)b * 2048 + t0;
    const bf16_t* qp = F.Qc + (qrow0 + r) * 1024 + head * 64 + 8 * hh;
    bf16x8 qf[4];
#pragma unroll
    for (int s = 0; s < 4; ++s) qf[s] = *(const bf16x8*)(qp + 16 * s);
    const bf16_t* kbase = F.Kc + (size_t)(b * 4 + kvh) * 2048 * 64;
    const bf16_t* vbase = F.VTP + (size_t)(b * 4 + kvh) * 64 * 2048;
    const int cmin = (nb > 0) ? 0 : (4 - qs);
    f32x16 S[5];
#pragma unroll
    for (int c = 0; c < 5; ++c) {
        f32x16 a;
#pragma unroll
        for (int i = 0; i < 16; ++i) a[i] = 0.f;
        if (c >= cmin) {
            const bf16_t* kp = kbase + (size_t)(t0 - 128 + 32 * c + r) * 64 + 8 * hh;
#pragma unroll
            for (int s = 0; s < 4; ++s) a = __builtin_amdgcn_mfma_f32_32x32x16_bf16(*(const bf16x8*)(kp + 16 * s), qf[s], a, 0, 0, 0);
        }
        S[c] = a;
    }
    const float NEG = -INFINITY;
#pragma unroll
    for (int i = 0; i < 16; ++i) { const int kap = crow(i, hh); if (kap <= r) S[0][i] = NEG; if (kap > r) S[4][i] = NEG; }
    const float sink2 = F.sinks[l * 16 + head] * LOG2E;
    float m = sink2;
#pragma unroll
    for (int c = 0; c < 5; ++c) if (c >= cmin) {
#pragma unroll
        for (int i = 0; i < 16; ++i) m = fmaxf(m, S[c][i]); }
    m = fmaxf(m, __shfl_xor(m, 32));
    float sum = 0.f;
#pragma unroll
    for (int c = 0; c < 5; ++c) if (c >= cmin) {
#pragma unroll
        for (int i = 0; i < 16; ++i) { const float p = __builtin_amdgcn_exp2f(S[c][i] - m); S[c][i] = p; sum += p; } }
    sum += __shfl_xor(sum, 32);
    const float inv = 1.0f / (sum + __builtin_amdgcn_exp2f(sink2 - m));
    f32x16 o[2];
#pragma unroll
    for (int i = 0; i < 16; ++i) { o[0][i] = 0.f; o[1][i] = 0.f; }
#pragma unroll
    for (int c = 0; c < 5; ++c) if (c >= cmin) {
        const bf16_t* vt = vbase + (size_t)((t0 - 128 + 32 * c) >> 5) * 2048 + r * 32 + 16 * hh;
#pragma unroll
        for (int s = 0; s < 2; ++s) {
            u32x4 pw; pw.x = pg8::cvt_pk_bf16(S[c][8 * s + 0], S[c][8 * s + 1]); pw.y = pg8::cvt_pk_bf16(S[c][8 * s + 2], S[c][8 * s + 3]);
            pw.z = pg8::cvt_pk_bf16(S[c][8 * s + 4], S[c][8 * s + 5]); pw.w = pg8::cvt_pk_bf16(S[c][8 * s + 6], S[c][8 * s + 7]);
            const bf16x8 pa = __builtin_bit_cast(bf16x8, pw);
#pragma unroll
            for (int db = 0; db < 2; ++db) o[db] = __builtin_amdgcn_mfma_f32_32x32x16_bf16(pa, *(const bf16x8*)(vt + db * 1024 + 8 * s), o[db], 0, 0, 0);
        }
    }
    if (hh == 0) wsf[r] = inv;
    LDS_WAIT();
#pragma unroll
    for (int i = 0; i < 16; ++i) { const int q = crow(i, hh); const float rl = wsf[q];
        stg[q * 64 + r] = (bf16_t)(pg8::cvt_pk_bf16(o[0][i] * rl, 0.f) & 0xffffu);
        stg[q * 64 + 32 + r] = (bf16_t)(pg8::cvt_pk_bf16(o[1][i] * rl, 0.f) & 0xffffu); }
    LDS_WAIT();
#pragma unroll
    for (int i = 0; i < 4; ++i) { const int row = i * 8 + (lane >> 3), ch = lane & 7;
        const u32x4 ov = *(const LAS u32x4*)(stg + row * 64 + ch * 8);
        const u32x4 gv = *(const u32x4*)(F.Z2 + (qrow0 + row) * ZW + Z_GA + head * 64 + ch * 8);
        float of[8], gf[8]; unpack8(ov, of); unpack8(gv, gf);
#pragma unroll
        for (int j = 0; j < 8; ++j) of[j] *= gf[j];
        *(u32x4*)(F.MIX + (qrow0 + row) * DM + head * 64 + ch * 8) = pack8(of); }
    LDS_WAIT();
}

template <bool SAMPLE>
__device__ __forceinline__ void pool_unit_o(const Frame& F, int l, int g, int tile) {
    const int lane = F.lane, r = lane & 31, hh = lane >> 5, w = 2 << g;
    const size_t row = (size_t)(SAMPLE ? MP : 0) + 32 * tile + r;
    const int t = SAMPLE ? (int)(row & 3) : (int)(row & 2047);
    const int bd = SAMPLE ? (int)((row - MP) >> 2) : 0;
    const float icnt = SAMPLE ? 1.0f / (float)w : 1.0f / (float)(w < t + 1 ? w : t + 1);
    bf16x8 bfr[8];
#pragma unroll
    for (int s = 0; s < 8; ++s) {
        const int c0 = 128 * g + 16 * s + 8 * hh;
        float sum[8], cur[8];
#pragma unroll
        for (int j = 0; j < 8; ++j) { sum[j] = 0.f; cur[j] = 0.f; }
        for (int i = 0; i < w; ++i) {
            float f[8];
            const int e = t - i;
            if (e >= 0) { unpack8(*(const u32x4*)(F.Z2 + (row - i) * ZW + Z_XB + c0), f); }
            else if (SAMPLE) { const float* sp = F.state_pool + (((size_t)l * 128 + bd) * 15 + 15 + e) * 512 + c0;
                const f32x4 a = *(const f32x4*)sp, bq = *(const f32x4*)(sp + 4); f[0] = a[0]; f[1] = a[1]; f[2] = a[2]; f[3] = a[3]; f[4] = bq[0]; f[5] = bq[1]; f[6] = bq[2]; f[7] = bq[3]; }
            else {
#pragma unroll
                for (int j = 0; j < 8; ++j) f[j] = 0.f; }
#pragma unroll
            for (int j = 0; j < 8; ++j) sum[j] += f[j];
            if (i == 0) {
#pragma unroll
                for (int j = 0; j < 8; ++j) cur[j] = f[j]; }
        }
        float pf[8];
#pragma unroll
        for (int j = 0; j < 8; ++j) pf[j] = sum[j] * icnt - cur[j];
        bfr[s] = __builtin_bit_cast(bf16x8, pack8(pf));
    }
    f32x16 acc[4];
#pragma unroll
    for (int db = 0; db < 4; ++db) {
#pragma unroll
        for (int i = 0; i < 16; ++i) acc[db][i] = 0.f;
        const bf16_t* ap = F.PWT + ((size_t)(l * 4 + g) * 128 + 32 * db + r) * 128 + 8 * hh;
#pragma unroll
        for (int s = 0; s < 8; ++s) acc[db] = __builtin_amdgcn_mfma_f32_32x32x16_bf16(*(const bf16x8*)(ap + 16 * s), bfr[s], acc[db], 0, 0, 0);
    }
#pragma unroll
    for (int db = 0; db < 4; ++db)
#pragma unroll
        for (int q = 0; q < 4; ++q) {
            const int col = 128 * g + 32 * db + 8 * q + 4 * hh;
            const f32x4 sc = *(const f32x4*)(F.pool_scale + l * 512 + col);
            float gf[4]; unpack4(*(const u32x2*)(F.Z2 + row * ZW + Z_GP + col), gf);
            u32x2 wv; wv.x = pg8::cvt_pk_bf16(acc[db][4 * q + 0] * sc[0] * gf[0], acc[db][4 * q + 1] * sc[1] * gf[1]);
            wv.y = pg8::cvt_pk_bf16(acc[db][4 * q + 2] * sc[2] * gf[2], acc[db][4 * q + 3] * sc[3] * gf[3]);
            *(u32x2*)(F.MIX + row * DM + 1024 + col) = wv;
        }
}

__device__ __forceinline__ void sgu_unit_o(const Frame& F, int l, int ci, int hd, LAS unsigned char* ring) {
    LAS bf16_t* VnT = (LAS bf16_t*)ring;
    const int lane = F.lane, wv = F.wave;
    const size_t R0 = (size_t)128 * ci;
    {
        const int tl = lane >> 2, q4 = lane & 3;
        const bf16_t* vrow = F.Z2 + (R0 + 16 * wv + tl) * ZW + Z_VS;
        float s = 0.f, ss = 0.f;
#pragma unroll
        for (int i = 0; i < 16; ++i) { float f[8]; unpack8(*(const u32x4*)(vrow + 128 * q4 + 8 * i), f);
#pragma unroll
            for (int j = 0; j < 8; ++j) { s += f[j]; ss += f[j] * f[j]; } }
        s += __shfl_xor(s, 1); s += __shfl_xor(s, 2); ss += __shfl_xor(ss, 1); ss += __shfl_xor(ss, 2);
        const float mean = s * (1.0f / 512.0f), var = ss * (1.0f / 512.0f) - mean * mean, rstd = rsqrtf(var + EPS);
#pragma unroll
        for (int i = 0; i < 4; ++i) { const int d = 32 * q4 + 8 * i; float f[8]; unpack8(*(const u32x4*)(vrow + 128 * hd + d), f);
            const float* gp = F.ln_g + l * 512 + 128 * hd + d; const float* bp = F.ln_b + l * 512 + 128 * hd + d;
#pragma unroll
            for (int j = 0; j < 8; ++j) { const float vn = (f[j] - mean) * rstd * gp[j] + bp[j];
                VnT[(d + j) * 136 + 16 * wv + tl] = (bf16_t)(pg8::cvt_pk_bf16(vn, 0.f) & 0xffffu); } }
    }
    __syncthreads();
    {
        const int r = lane & 31, hh = lane >> 5, db = wv & 3; const int tbA = (wv >> 2) ? 1 : 0, tbB = (wv >> 2) ? 2 : 3;
        f32x16 accA, accB;
#pragma unroll
        for (int i = 0; i < 16; ++i) { accA[i] = 0.f; accB[i] = 0.f; }
        const bf16_t* Wb = F.SGUW + (size_t)(l * 4 + hd) * 128 * 128;
#pragma unroll
        for (int s = 0; s < 8; ++s) {
            if (s < 2 * (tbB + 1)) {
                const bf16x8 a = *(const LAS bf16x8*)(VnT + (32 * db + r) * 136 + 16 * s + 8 * hh);
                accB = __builtin_amdgcn_mfma_f32_32x32x16_bf16(a, *(const bf16x8*)(Wb + (32 * tbB + r) * 128 + 16 * s + 8 * hh), accB, 0, 0, 0);
                if (s < 2 * (tbA + 1)) accA = __builtin_amdgcn_mfma_f32_32x32x16_bf16(a, *(const bf16x8*)(Wb + (32 * tbA + r) * 128 + 16 * s + 8 * hh), accA, 0, 0, 0);
            }
        }
#pragma unroll
        for (int pass = 0; pass < 2; ++pass) {
            const int tb = pass ? tbB : tbA; const f32x16 acc = pass ? accB : accA;
            const int t = 32 * tb + r; const size_t row = R0 + t; const float bias = F.sgu_b[l * 512 + hd * 128 + t];
#pragma unroll
            for (int q = 0; q < 4; ++q) { const int col = 128 * hd + 32 * db + 8 * q + 4 * hh;
                float uf[4], gf[4]; unpack4(*(const u32x2*)(F.Z2 + row * ZW + Z_U + col), uf); unpack4(*(const u32x2*)(F.Z2 + row * ZW + Z_GS + col), gf);
                u32x2 wo; wo.x = pg8::cvt_pk_bf16((acc[4 * q + 0] + bias) * uf[0] * gf[0], (acc[4 * q + 1] + bias) * uf[1] * gf[1]);
                wo.y = pg8::cvt_pk_bf16((acc[4 * q + 2] + bias) * uf[2] * gf[2], (acc[4 * q + 3] + bias) * uf[3] * gf[3]);
                *(u32x2*)(F.MIX + row * DM + 1536 + col) = wo; }
        }
    }
    __syncthreads();
}

__device__ __forceinline__ void samp_attn_o(const Frame& F, int l, int bd, int kvh, LAS unsigned char* wl) {
    LAS float* qs = (LAS float*)wl;
    LAS float* ps = (LAS float*)(wl + 4096);
    const int lane = F.lane;
    float* oKs = F.out + O_KS + (size_t)l * LS_KS; float* oVs = F.out + O_VS + (size_t)l * LS_KS;
    {
        const int qi = lane >> 2, part = lane & 3, gq = qi >> 2, tt = qi & 3;
        const bf16_t* src = F.Qc + ((size_t)MP + 4 * bd + tt) * 1024 + (4 * kvh + gq) * 64 + 16 * part;
        float f0[8], f1[8]; unpack8(*(const u32x4*)src, f0); unpack8(*(const u32x4*)(src + 8), f1);
#pragma unroll
        for (int j = 0; j < 8; ++j) { const int p0 = 16 * part + j, p1 = p0 + 8;
            qs[qi * 64 + (p0 >> 1) + 32 * (p0 & 1)] = f0[j]; qs[qi * 64 + (p1 >> 1) + 32 * (p1 & 1)] = f1[j]; }
    }
    LDS_WAIT();
    float s0[16], s1[16], s2[16];
#pragma unroll
    for (int q = 0; q < 16; ++q) { s0[q] = 0.f; s1[q] = 0.f; s2[q] = 0.f; }
    const float* k0p = F.cache_k + (((size_t)l * 128 + bd) * 128 + lane) * 256 + kvh * 64;
    const float* k1p = k0p + 64 * 256;
    const float* k2p = oKs + (((size_t)bd * 128 + 124 + (lane & 3)) * 4 + kvh) * 64;
    float* c0p = oKs + (((size_t)bd * 128 + (lane >= 4 ? lane - 4 : 0)) * 4 + kvh) * 64;
    float* c1p = oKs + (((size_t)bd * 128 + lane + 60) * 4 + kvh) * 64;
    for (int ch = 0; ch < 16; ++ch) {
        const f32x4 kx0 = *(const f32x4*)(k0p + 4 * ch), kx1 = *(const f32x4*)(k1p + 4 * ch), kx2 = *(const f32x4*)(k2p + 4 * ch);
        if (lane >= 4) *(f32x4*)(c0p + 4 * ch) = kx0;
        *(f32x4*)(c1p + 4 * ch) = kx1;
#pragma unroll
        for (int q = 0; q < 16; ++q) { const f32x4 qv = *(const LAS f32x4*)(qs + q * 64 + 4 * ch);
            s0[q] += (qv[0] * kx0[0] + qv[1] * kx0[1]) + (qv[2] * kx0[2] + qv[3] * kx0[3]);
            s1[q] += (qv[0] * kx1[0] + qv[1] * kx1[1]) + (qv[2] * kx1[2] + qv[3] * kx1[3]);
            s2[q] += (qv[0] * kx2[0] + qv[1] * kx2[1]) + (qv[2] * kx2[2] + qv[3] * kx2[3]); }
    }
    float inv[16];
#pragma unroll
    for (int q = 0; q < 16; ++q) {
        const int tt = q & 3; const float sink2 = F.sinks[l * 16 + 4 * kvh + (q >> 2)] * LOG2E;
        const bool v0 = lane >= tt + 1, v2 = (lane < 4) && (lane <= tt);
        float m = s1[q]; if (v0) m = fmaxf(m, s0[q]); if (v2) m = fmaxf(m, s2[q]);
        m = fmaxf(wave_max(m), sink2);
        const float p0 = v0 ? __builtin_amdgcn_exp2f(s0[q] - m) : 0.f, p1 = __builtin_amdgcn_exp2f(s1[q] - m), p2 = v2 ? __builtin_amdgcn_exp2f(s2[q] - m) : 0.f;
        const float sum = wave_sum(p0 + p1 + p2);
        inv[q] = 1.0f / (sum + __builtin_amdgcn_exp2f(sink2 - m));
        ps[lane * 16 + q] = p0; ps[(lane + 64) * 16 + q] = p1; if (lane < 4) ps[(128 + lane) * 16 + q] = p2;
    }
    LDS_WAIT();
    float o[16];
#pragma unroll
    for (int q = 0; q < 16; ++q) o[q] = 0.f;
    const float* vcp = F.cache_v + (((size_t)l * 128 + bd) * 128) * 256 + kvh * 64 + lane;
    float* vop = oVs + ((size_t)bd * 128) * 256 + kvh * 64 + lane;
    for (int key = 0; key < 132; ++key) {
        float v;
        if (key < 128) { v = vcp[(size_t)key * 256]; if (key >= 4) vop[(size_t)(key - 4) * 256] = v; }
        else v = vop[(size_t)(key - 4) * 256];
#pragma unroll
        for (int q4 = 0; q4 < 4; ++q4) { const f32x4 pv = *(const LAS f32x4*)(ps + key * 16 + 4 * q4);
            o[4 * q4 + 0] += pv[0] * v; o[4 * q4 + 1] += pv[1] * v; o[4 * q4 + 2] += pv[2] * v; o[4 * q4 + 3] += pv[3] * v; }
    }
#pragma unroll
    for (int q = 0; q < 16; ++q) { const int tt = q & 3, head = 4 * kvh + (q >> 2); const size_t row = (size_t)MP + 4 * bd + tt;
        const float gv = __uint_as_float(((unsigned)F.Z2[row * ZW + Z_GA + head * 64 + lane]) << 16);
        F.MIX[row * DM + head * 64 + lane] = (bf16_t)(pg8::cvt_pk_bf16(o[q] * inv[q] * gv, 0.f) & 0xffffu); }
    LDS_WAIT();
}
__device__ __forceinline__ void samp_sgu_o(const Frame& F, int l, int bd) {
    const int lane = F.lane, c0 = 8 * lane, hd = lane >> 4;
    float* oCV = F.out + O_CV + (size_t)l * LS_CV;
    float gl[8], bl[8];
#pragma unroll
    for (int j = 0; j < 8; ++j) { gl[j] = F.ln_g[l * 512 + c0 + j]; bl[j] = F.ln_b[l * 512 + c0 + j]; }
    float vn[4][8];
#pragma unroll
    for (int tt = 0; tt < 4; ++tt) { const size_t row = (size_t)MP + 4 * bd + tt; float f[8]; unpack8(*(const u32x4*)(F.Z2 + row * ZW + Z_VS + c0), f);
        float s = 0.f, ss = 0.f;
#pragma unroll
        for (int j = 0; j < 8; ++j) { s += f[j]; ss += f[j] * f[j]; }
        s = wave_sum(s); ss = wave_sum(ss);
        const float mean = s * (1.0f / 512.0f), var = ss * (1.0f / 512.0f) - mean * mean, rstd = rsqrtf(var + EPS);
#pragma unroll
        for (int j = 0; j < 8; ++j) vn[tt][j] = (f[j] - mean) * rstd * gl[j] + bl[j];
        float* o = oCV + ((size_t)bd * 4 + tt) * 512 + c0;
        *(f32x4*)o = (f32x4){vn[tt][0], vn[tt][1], vn[tt][2], vn[tt][3]}; *(f32x4*)(o + 4) = (f32x4){vn[tt][4], vn[tt][5], vn[tt][6], vn[tt][7]}; }
#pragma unroll
    for (int tt = 0; tt < 4; ++tt) { const size_t row = (size_t)MP + 4 * bd + tt;
        float mx[8]; const float bias = F.sgu_b[l * 512 + hd * 128 + tt];
#pragma unroll
        for (int j = 0; j < 8; ++j) mx[j] = bias;
#pragma unroll
        for (int s2 = 0; s2 < 4; ++s2) if (s2 <= tt) { const float w = F.sgu_w[((size_t)(l * 4 + hd) * 128 + tt) * 128 + s2];
#pragma unroll
            for (int j = 0; j < 8; ++j) mx[j] += w * vn[s2][j]; }
        float uf[8], gf[8]; unpack8(*(const u32x4*)(F.Z2 + row * ZW + Z_U + c0), uf); unpack8(*(const u32x4*)(F.Z2 + row * ZW + Z_GS + c0), gf);
#pragma unroll
        for (int j = 0; j < 8; ++j) mx[j] = mx[j] * uf[j] * gf[j];
        *(u32x4*)(F.MIX + row * DM + 1536 + c0) = pack8(mx); }
}

#endif
struct NormRowIn { u32x4 yv[4]; u32x4 xb[4]; };
__device__ __forceinline__ void norm_row_load(NormRowIn& in, const Frame& F, int l, int row) {
    const int lane = F.lane;
    if (row < MP) {
        const bf16_t* yr = F.Yb + (size_t)row * DM + 8 * lane;
#pragma unroll
        for (int j = 0; j < 4; ++j) in.yv[j] = __builtin_nontemporal_load((const u32x4*)(yr + 512 * j));
    } else {
        const float* sa = (const float*)F.Z2 + (size_t)(row - MP) * DM + 8 * lane; const float* sb = sa + (size_t)MS * DM;
#pragma unroll
        for (int j = 0; j < 4; ++j) { const f32x4 a0 = *(const f32x4*)(sa + 512 * j), a1 = *(const f32x4*)(sa + 512 * j + 4), b0 = *(const f32x4*)(sb + 512 * j), b1 = *(const f32x4*)(sb + 512 * j + 4);
            u32x4 w; w.x = pg8::cvt_pk_bf16(a0[0] + b0[0], a0[1] + b0[1]); w.y = pg8::cvt_pk_bf16(a0[2] + b0[2], a0[3] + b0[3]); w.z = pg8::cvt_pk_bf16(a1[0] + b1[0], a1[1] + b1[1]); w.w = pg8::cvt_pk_bf16(a1[2] + b1[2], a1[3] + b1[3]);
            in.yv[j] = w; }
    }
    {
        const bf16_t* xr = F.H + (size_t)row * DM + 8 * lane;
#pragma unroll
        for (int j = 0; j < 4; ++j) in.xb[j] = __builtin_nontemporal_load((const u32x4*)(xr + 512 * j));
    }
}
__device__ __forceinline__ void norm_row_finish(const NormRowIn& in, const Frame& F, int l, int row) {
    const int lane = F.lane;
    const float* pg = F.norm_post + l * DM + 8 * lane;
    float y[4][8]; float ss = 0.f;
#pragma unroll
    for (int j = 0; j < 4; ++j) { unpack8(in.yv[j], y[j]);
#pragma unroll
        for (int e = 0; e < 8; ++e) ss += y[j][e] * y[j][e]; }
    ss = wave_sum(ss);
    const float ry = rsqrtf(ss * (1.0f / 2048.0f) + EPS);
    if (l == 0) {
        float s1 = 0.f; bf16_t* hrow = F.H + (size_t)row * DM + 8 * lane;
        const float rms0 = F.RSTD[row];
#pragma unroll
        for (int j = 0; j < 4; ++j) { const f32x4 ga = *(const f32x4*)(pg + 512 * j), gb = *(const f32x4*)(pg + 512 * j + 4); float xf[8]; unpack8(in.xb[j], xf);
#pragma unroll
            for (int e = 0; e < 4; ++e) { y[j][e] = xf[e] * rms0 + y[j][e] * ry * ga[e]; y[j][4 + e] = xf[4 + e] * rms0 + y[j][4 + e] * ry * gb[e]; }
#pragma unroll
            for (int e = 0; e < 8; ++e) s1 += y[j][e] * y[j][e]; }
        s1 = wave_sum(s1);
        const float ms = s1 * (1.0f / 2048.0f) + EPS, r1 = rsqrtf(ms);
        if (lane == 0) F.RSTD[row] = ms * r1;
#pragma unroll
        for (int j = 0; j < 4; ++j) {
#pragma unroll
            for (int e = 0; e < 8; ++e) y[j][e] *= r1;
            *(u32x4*)(hrow + 512 * j) = pack8(y[j]); }
    } else {
        float* orow = F.out + (size_t)row * DM + 8 * lane;
        const float rms = F.RSTD[row];
#pragma unroll
        for (int j = 0; j < 4; ++j) { const f32x4 ga = *(const f32x4*)(pg + 512 * j), gb = *(const f32x4*)(pg + 512 * j + 4); float xf[8]; unpack8(in.xb[j], xf);
#pragma unroll
            for (int e = 0; e < 4; ++e) { y[j][e] = xf[e] * rms + y[j][e] * ry * ga[e]; y[j][4 + e] = xf[4 + e] * rms + y[j][4 + e] * ry * gb[e]; }
            __builtin_nontemporal_store((f32x4){y[j][0], y[j][1], y[j][2], y[j][3]}, (f32x4*)(orow + 512 * j)); __builtin_nontemporal_store((f32x4){y[j][4], y[j][5], y[j][6], y[j][7]}, (f32x4*)(orow + 512 * j + 4)); }
    }
}
__device__ __forceinline__ void norm_rows4(int l, int row0) { LOCAL_FRAME;
#pragma unroll 1
    for (int k = 0; k < 4; k += 2) { NormRowIn a, b; norm_row_load(a, F, l, row0 + k); norm_row_load(b, F, l, row0 + k + 1);
        norm_row_finish(a, F, l, row0 + k); norm_row_finish(b, F, l, row0 + k + 1); } }

__device__ __forceinline__ void norm_row1(int l, int row) { LOCAL_FRAME; NormRowIn a; norm_row_load(a, F, l, row); norm_row_finish(a, F, l, row); }

constexpr int Q2_G = 40, Q2_AT = Q2_G + 256, Q2_SG = Q2_AT + 256, Q2_SA = Q2_SG + 64, Q2_SS = Q2_SA + 16, Q2_SP = Q2_SS + 8, Q2_PO = Q2_SP + 256;
__device__ __forceinline__ void slot2(int l, LAS unsigned char* L, LAS unsigned char* ring) {
    int t_ = threadIdx.x; asm volatile("" : "+v"(t_)); const int wave = __builtin_amdgcn_readfirstlane(t_ >> 6);
    unsigned* head = ctl_word(CW_Q + 64 * (2 * l));
    EV_T0();
#pragma unroll 1
    for (;;) {
        const int it = q_pop(head, L);
        if (it >= Q2_PO + (l == 0 ? TR_ITEMS : 0)) { if (l == 0) { EV_MAX(0); EV_MIN(1); } break; }
        if (it < Q2_G) {
            unsigned char* ws = (unsigned char*)kargs()->ws;
            pg8::Gemm g{(const bf16_t*)(ws + WS_H), (const bf16_t*)(ws + WS_WTIN) + (size_t)l * DIN * DM, MT, DIN, DM, DM};
            OneUnit S; S.u.pm = 64 + it / 20; S.u.pn = it % 20;
            pg8::EpiIn E{l};
            pg8::gemm_phase<pg8::EpiIn, OneUnit, false, true>(ring, g, S, E);
            publish(ctl_word(CW_ZS + 64 * (2 * l + it / 20)));
            if (l == 0) { EV_MAX(2); EV_MIN(3); }
        }
#ifndef NO_SGU
        else if (it < Q2_AT) { const int u = it - Q2_G; sgu_unit(l, u >> 1, u & 1, ring); if (l == 0) EV_MAX(5); }
#endif
        else if (it < Q2_SG) { attn_unit(l, it - Q2_AT, ring); if (l == 0) EV_MAX(4); }
        else if (it < Q2_SA) { const int i = it - Q2_SG; dep_wait(ctl_word(CW_ZS + 64 * (2 * l + (i >> 5))), 20u); if (l == 0) EV_MIN(6); const int k = 8 * i + wave; samp_attn(l, k >> 2, k & 3, ring + wave * 9472); __syncthreads(); if (l == 0) EV_MAX(7); }
        else if (it < Q2_SS) { const int i = it - Q2_SA; dep_wait(ctl_word(CW_ZS + 64 * (2 * l + (i >> 3))), 20u); samp_sgu(l, 8 * i + wave); }
        else if (it < Q2_SP) { const int i = it - Q2_SS; dep_wait(ctl_word(CW_ZS + 64 * (2 * l + (i >> 2))), 20u); const int k = 8 * i + wave; pool_sample(l, k & 3, k >> 2); }
        else if (it < Q2_PO) { const int i = 8 * (it - Q2_SP) + wave; pool_prompt(l, i & 3, i >> 2, ring + wave * PL_WBYTES); }
        else { LOCAL_FRAME; transpose_item(F, 1, it - Q2_PO, ring); }
    }
}
constexpr int Q4_G = 32, Q4_P = Q4_G + 512, Q4_S = Q4_P + 64;
__device__ __forceinline__ void slot4(int l, LAS unsigned char* L, LAS unsigned char* ring) {
    int t_ = threadIdx.x; asm volatile("" : "+v"(t_)); const int wave = __builtin_amdgcn_readfirstlane(t_ >> 6);
    unsigned* head = ctl_word(CW_Q + 64 * (2 * l + 1));
#pragma unroll 1
    for (;;) {
        const int it = q_pop(head, L);
        if (it >= Q4_S) break;
        if (it < Q4_G) {
            const int un = it >> 1, kh = it & 1;
            unsigned char* ws = (unsigned char*)kargs()->ws;
            pg8::Gemm g{(const bf16_t*)(ws + WS_MIX) + 1024 * kh, (const bf16_t*)(ws + WS_WTOUT) + (size_t)l * DM * DM + 1024 * kh, MT, DM, 1024, DM};
            OneUnit S; S.u.pm = 64 + un / 8; S.u.pn = un % 8;
            pg8::EpiSlab E{kh};
            pg8::gemm_phase<pg8::EpiSlab, OneUnit, false, true>(ring, g, S, E);
            publish(ctl_word(CW_YS + 64 * (2 * l + un / 8)));
        }
        else if (it < Q4_P) norm_rows4(l, 32 * (it - Q4_G) + 4 * wave);
        else { const int i = it - Q4_P; dep_wait(ctl_word(CW_YS + 64 * (2 * l + (i >> 5))), 16u); norm_row1(l, MP + 8 * i + wave); }
    }
}

__device__ __forceinline__ void grid_barrier(LAS unsigned char* L) {
    XcdBarrier b; b.bar = (unsigned*)((unsigned char*)kargs()->ws + WS_CTL) + CW_BAR; b.x = xb_xcc_id(); b.st = (volatile LAS unsigned*)L + 8;
    xcd_barrier(b);
}
__global__ void __launch_bounds__(NTHREADS, 2) hymba_fwd(Args a_unused) {
    extern __shared__ __attribute__((aligned(16))) unsigned char lds[];
    LAS unsigned char* L = (LAS unsigned char*)lds;
    if (threadIdx.x < 256) ((LAS unsigned*)L)[threadIdx.x] = 0u;
    __syncthreads();
    (void)xcd_barrier_post((unsigned*)((unsigned char*)kargs()->ws + WS_CTL) + CW_BAR, (volatile LAS unsigned*)L + 8);
    LAS unsigned char* ring = L + RING_OFF;
    STAMP(0);
#ifndef NO_P0
    { Frame F; make_frame(F, kargs()); p0_prologue(F, ring); }
#endif
    grid_barrier(L);
    STAMP(1);
#pragma unroll 1
    for (int l = 0; l < 2; ++l) {
#ifndef NO_P1
        {
            KArgs ka = kargs(); unsigned char* ws = (unsigned char*)ka->ws;
            pg8::Gemm g{(const bf16_t*)(ws + WS_H), (const bf16_t*)(ws + WS_WTIN) + (size_t)l * DIN * DM, MP, DIN, DM, DM}; pg8::StaticOrder S; S.init(MP, DIN, (int)gridDim.x, (int)blockIdx.x);
            pg8::EpiIn E{l};
            EV_T0();
            pg8::gemm_phase<pg8::EpiIn, pg8::StaticOrder, true, true>(ring, g, S, E);
#if PROBE_SEL >= 40
            if (l == 0) { const int jj = ((int)blockIdx.x >> 3) >> 3, xx = (int)blockIdx.x & 7;
                if (threadIdx.x == 0) { const unsigned dt = (unsigned)(__builtin_amdgcn_s_memrealtime() - ev_t0);
                    __hip_atomic_fetch_max(ctl_word(CW_EV + 64 * (16 + jj)), dt, __ATOMIC_RELAXED, __HIP_MEMORY_SCOPE_AGENT); __hip_atomic_fetch_max(ctl_word(CW_EV + 64 * (20 + xx)), dt, __ATOMIC_RELAXED, __HIP_MEMORY_SCOPE_AGENT);
                    __hip_atomic_fetch_max(ctl_word(CW_EV + 64 * 28), 0x40000000u - dt, __ATOMIC_RELAXED, __HIP_MEMORY_SCOPE_AGENT); } }
#endif
        }
#endif
        grid_barrier(L);
        STAMP(2 + 4 * l);
#ifndef NO_P2
        slot2(l, L, ring);
#endif
        grid_barrier(L);
        STAMP(3 + 4 * l);
#ifndef NO_P3
        {
            KArgs ka = kargs(); unsigned char* ws = (unsigned char*)ka->ws;
            pg8::Gemm g{(const bf16_t*)(ws + WS_MIX), (const bf16_t*)(ws + WS_WTOUT) + (size_t)l * DM * DM, MP, DM, DM, DM}; pg8::StaticOrder S; S.init(MP, DM, (int)gridDim.x, (int)blockIdx.x);
            pg8::EpiOut E{};
            pg8::gemm_phase<pg8::EpiOut, pg8::StaticOrder, true, true>(ring, g, S, E);
        }
#endif
        grid_barrier(L);
        STAMP(4 + 4 * l);
#ifndef NO_P4
        slot4(l, L, ring);
#endif
        if (l == 0) grid_barrier(L);
#if PROBE_SEL
        if (l == 1) __syncthreads();
#endif
        STAMP(5 + 4 * l);
    }
#if PROBE_SEL
    if (blockIdx.x == 0 && threadIdx.x == 0) {
#if PROBE_SEL >= 40
        unsigned ea = __hip_atomic_load(ctl_word(CW_EV + 64 * PEA), __ATOMIC_RELAXED, __HIP_MEMORY_SCOPE_AGENT);
        if (PEA_MIN) ea = 0x40000000u - ea;
        unsigned long long da = ea > 21500u ? (ea - 21500u + 50) / 100 : 0, db = 0;
#elif PROBE_SEL >= 10
        unsigned ea = __hip_atomic_load(ctl_word(CW_EV + 64 * PEA), __ATOMIC_RELAXED, __HIP_MEMORY_SCOPE_AGENT), eb = __hip_atomic_load(ctl_word(CW_EV + 64 * PEB), __ATOMIC_RELAXED, __HIP_MEMORY_SCOPE_AGENT);
        if (PEA_MIN) ea = 0x40000000u - ea; if (PEB_MIN) eb = 0x40000000u - eb;
        unsigned long long da = (ea + 400) / 800, db = (eb + 400) / 800;
#else
        LAS unsigned long long* ts = (LAS unsigned long long*)(L + 256);
        unsigned long long da = (ts[PA1] - ts[PA0] + 400) / 800, db = (ts[PB1] - ts[PB0] + 400) / 800;
#endif
        if (da > 63) da = 63; if (db > 63) db = 63;
        const unsigned long long extra = (da + 64 * db) * 1600ull, t0 = __builtin_amdgcn_s_memrealtime();
        while (__builtin_amdgcn_s_memrealtime() - t0 < extra) __builtin_amdgcn_s_sleep(32);
    }
#endif
}

extern "C" void kernel_launch(void* const* d_in, const int* in_sizes, int n_in, void* d_out, int out_size, void* d_ws, size_t ws_size, hipStream_t stream) {
    static int grid = 0;
    if (grid == 0) {
        if (n_in != 16 || (size_t)out_size != O_END || ws_size < WS_END) { fprintf(stderr, "kernel_launch: unexpected shapes: n_in %d out %d ws %zu (need %zu)\n", n_in, out_size, ws_size, (size_t)WS_END); grid = -1; return; }
        int dev = 0, cus = 0, per_cu = 0;
        if (hipGetDevice(&dev) != hipSuccess || hipDeviceGetAttribute(&cus, hipDeviceAttributeMultiprocessorCount, dev) != hipSuccess) { fprintf(stderr, "kernel_launch: device query failed\n"); grid = -1; return; }
        if (hipFuncSetAttribute((const void*)hymba_fwd, hipFuncAttributeMaxDynamicSharedMemorySize, LDS_BYTES) != hipSuccess) { fprintf(stderr, "kernel_launch: hipFuncSetAttribute failed\n"); grid = -1; return; }
        if (hipOccupancyMaxActiveBlocksPerMultiprocessor(&per_cu, (const void*)hymba_fwd, NTHREADS, LDS_BYTES) != hipSuccess || per_cu < 1) { fprintf(stderr, "kernel_launch: occupancy query says %d blocks/CU\n", per_cu); (void)hipGetLastError(); grid = -1; return; }
        grid = cus;
    }
    if (grid < 0) return;
    (void)hipMemsetAsync((char*)d_ws + WS_CTL, 0, CTL_ZERO_BYTES, stream);
    Args a{};
    for (int i = 0; i < 16; ++i) a.in[i] = (const float*)d_in[i];
    a.out = (float*)d_out; a.ws = (unsigned char*)d_ws;
    void* params[] = {&a};
    hipError_t e = hipLaunchCooperativeKernel((const void*)hymba_fwd, dim3(grid), dim3(NTHREADS), params, LDS_BYTES, stream);
    if (e != hipSuccess) fprintf(stderr, "kernel_launch: cooperative launch failed: %s (grid %d)\n", hipGetErrorString(e), grid);
}
```
